# Optimizing an MI355X kernel written in HIP

```python
import math
import jax
import jax.numpy as jnp
from jax import lax
import numpy as np

D_MODEL = 1024
BATCH = 8
SEQ = 4096
DEPTH = 1

D_MIX = D_MODEL
SB_HEADS = 8
SB_HEAD_DIM = 64
SB_WIDTH = SB_HEADS * SB_HEAD_DIM
POOL_WINDOWS = (2, 4, 8, 16)
POOL_GROUPS = len(POOL_WINDOWS)
POOL_WIDTH = D_MIX - SB_WIDTH
POOL_GROUP_DIM = POOL_WIDTH // POOL_GROUPS
IN_PROJ_COLS = 3 * SB_WIDTH + POOL_WIDTH
Q_BLOCK = 128
N_MEM = 256
MEM_HEADS = 4
MEM_HEAD_DIM = D_MODEL // MEM_HEADS
N_EXPERTS = 32
TOP_K = 4
D_FF = D_MODEL
SWIGLU_LIMIT = 7.0
SWIGLU_ALPHA = 1.702
MOE_BLOCK = 128
RMS_EPS = 1e-5

kernel_name = "hybrid_stickbreak_pool_memxattn_moe"


def rmsnorm(x, g):
    xf = x.astype(jnp.float32)
    y = xf * lax.rsqrt(jnp.mean(xf * xf, axis=-1, keepdims=True) + RMS_EPS)
    return (y * g.astype(jnp.float32)).astype(x.dtype)


def stick_breaking_attention(q, k, v):
    seq = q.shape[2]
    scale = 1.0 / math.sqrt(q.shape[-1])
    outs = []
    for i in range(seq // Q_BLOCK):
        t0 = i * Q_BLOCK
        kv_len = t0 + Q_BLOCK
        qb = q[:, :, t0:kv_len]
        kb = k[:, :, :kv_len]
        vb = v[:, :, :kv_len]
        z = jnp.einsum('bhqd,bhkd->bhqk', qb, kb).astype(jnp.float32) * scale
        t_pos = t0 + jnp.arange(Q_BLOCK)
        s_pos = jnp.arange(kv_len)
        mask = s_pos[None, :] < t_pos[:, None]
        log_stay = jnp.where(mask, jax.nn.log_sigmoid(-z), 0.0)
        rev = lax.cumsum(log_stay, axis=3, reverse=True)
        after = jnp.concatenate([rev[..., 1:], jnp.zeros_like(rev[..., :1])], axis=-1)
        w = jnp.where(mask, jnp.exp(jax.nn.log_sigmoid(z) + after), 0.0)
        outs.append(jnp.einsum('bhqk,bhkd->bhqd', w.astype(vb.dtype), vb))
    return jnp.concatenate(outs, axis=2)


def multiscale_pool(u):
    seq = u.shape[1]
    uf = u.astype(jnp.float32)
    csum = jnp.cumsum(uf, axis=1)
    outs = []
    for g, win in enumerate(POOL_WINDOWS):
        cg = csum[:, :, g]
        shifted = jnp.pad(cg, ((0, 0), (win, 0), (0, 0)))[:, :seq]
        count = jnp.minimum(jnp.arange(seq) + 1, win).astype(jnp.float32)
        outs.append((cg - shifted) / count[None, :, None] - uf[:, :, g])
    return jnp.stack(outs, axis=2).astype(u.dtype)


def memory_cross_attention(h, m, w_q, w_kv, w_o):
    b, s, d = h.shape
    q = (h @ w_q).reshape(b, s, MEM_HEADS, MEM_HEAD_DIM)
    kv = m @ w_kv
    k = kv[..., :d].reshape(b, -1, MEM_HEADS, MEM_HEAD_DIM)
    v = kv[..., d:].reshape(b, -1, MEM_HEADS, MEM_HEAD_DIM)
    scores = jnp.einsum('bshd,bmhd->bhsm', q, k).astype(jnp.float32) / math.sqrt(MEM_HEAD_DIM)
    p = jax.nn.softmax(scores, axis=-1).astype(v.dtype)
    o = jnp.einsum('bhsm,bmhd->bshd', p, v).reshape(b, s, d)
    return o @ w_o


def moe_ffn(h, w_router, b_router, w1, b1, w2, b2):
    b, s, d = h.shape
    n_tok = b * s
    hf = h.reshape(n_tok, d)
    logits = (hf @ w_router + b_router).astype(jnp.float32)
    top_val, top_idx = lax.top_k(logits, TOP_K)
    gates = jax.nn.softmax(top_val, axis=-1)
    nk = n_tok * TOP_K
    flat_e = top_idx.reshape(nk)
    flat_tok = (jnp.arange(nk, dtype=jnp.int32) // TOP_K)
    flat_g = gates.reshape(nk)
    order = jnp.argsort(flat_e)
    sorted_e = flat_e[order]
    counts = jnp.bincount(flat_e, length=N_EXPERTS)
    padded = (counts + MOE_BLOCK - 1) // MOE_BLOCK * MOE_BLOCK
    start = jnp.cumsum(counts) - counts
    pend = jnp.cumsum(padded)
    pstart = pend - padded
    dest = pstart[sorted_e] + jnp.arange(nk) - start[sorted_e]
    n_rows = (nk + MOE_BLOCK - 1) // MOE_BLOCK * MOE_BLOCK + N_EXPERTS * MOE_BLOCK
    n_blk = n_rows // MOE_BLOCK
    row_tok = jnp.zeros((n_rows,), jnp.int32).at[dest].set(flat_tok[order])
    row_g = jnp.zeros((n_rows,), h.dtype).at[dest].set(flat_g[order].astype(h.dtype))
    blk_e = jnp.minimum(jnp.searchsorted(pend, jnp.arange(n_blk) * MOE_BLOCK, side='right'),
                        N_EXPERTS - 1)

    def expert_block(args):
        e, tok, g = args
        xb = hf[tok]
        gu = xb @ w1[e] + b1[e]
        gate = jnp.minimum(gu[:, :D_FF], SWIGLU_LIMIT)
        up = jnp.clip(gu[:, D_FF:], -SWIGLU_LIMIT, SWIGLU_LIMIT)
        act = (up + 1.0) * gate * jax.nn.sigmoid(SWIGLU_ALPHA * gate)
        return (act @ w2[e] + b2[e]) * g[:, None]

    y = lax.map(expert_block, (blk_e, row_tok.reshape(n_blk, MOE_BLOCK),
                               row_g.reshape(n_blk, MOE_BLOCK)))
    out = jnp.zeros((n_tok, d), h.dtype).at[row_tok].add(y.reshape(n_rows, d))
    return out.reshape(b, s, d)


def setup_inputs(seed: int = 0) -> dict:
    key = jax.random.key(seed)
    ks = jax.random.split(key, 24)
    f32 = jnp.float32
    nrm = lambda k, shape, fan_in: jax.random.normal(k, shape, f32) * (fan_in ** -0.5)
    gain = lambda k, shape: 1.0 + 0.05 * jax.random.normal(k, shape, f32)
    L = DEPTH
    return {
        "x": jax.random.normal(ks[0], (BATCH, SEQ, D_MODEL), f32),
        "mem": jax.random.normal(ks[1], (BATCH, N_MEM, D_MODEL), f32),
        "g_mix": gain(ks[2], (L, D_MODEL)),
        "w_in": nrm(ks[3], (L, D_MODEL, IN_PROJ_COLS), D_MODEL),
        "g_sb_out": gain(ks[4], (L, SB_WIDTH)),
        "g_pool_out": gain(ks[5], (L, POOL_WIDTH)),
        "w_pool": nrm(ks[6], (L, POOL_GROUPS, POOL_GROUP_DIM, POOL_GROUP_DIM), POOL_GROUP_DIM),
        "pool_scale": 1.0 + 0.1 * jax.random.normal(ks[7], (L, POOL_WIDTH), f32),
        "w_out": nrm(ks[8], (L, D_MIX, D_MODEL), D_MIX),
        "g_mem_q": gain(ks[9], (L, D_MODEL)),
        "g_mem_kv": gain(ks[10], (L, D_MODEL)),
        "w_mem_q": nrm(ks[11], (L, D_MODEL, D_MODEL), D_MODEL),
        "w_mem_kv": nrm(ks[12], (L, D_MODEL, 2 * D_MODEL), D_MODEL),
        "w_mem_o": nrm(ks[13], (L, D_MODEL, D_MODEL), D_MODEL),
        "g_ffn": gain(ks[14], (L, D_MODEL)),
        "w_router": nrm(ks[15], (L, D_MODEL, N_EXPERTS), D_MODEL),
        "b_router": 0.01 * jax.random.normal(ks[16], (L, N_EXPERTS), f32),
        "w_expert_in": nrm(ks[17], (L, N_EXPERTS, D_MODEL, 2 * D_FF), D_MODEL),
        "b_expert_in": 0.01 * jax.random.normal(ks[18], (L, N_EXPERTS, 2 * D_FF), f32),
        "w_expert_out": nrm(ks[19], (L, N_EXPERTS, D_FF, D_MODEL), D_FF),
        "b_expert_out": 0.01 * jax.random.normal(ks[20], (L, N_EXPERTS, D_MODEL), f32),
        "g_final": gain(ks[21], (D_MODEL,)),
    }


def reference(x, mem, g_mix, w_in, g_sb_out, g_pool_out, w_pool, pool_scale, w_out,
              g_mem_q, g_mem_kv, w_mem_q, w_mem_kv, w_mem_o, g_ffn, w_router, b_router,
              w_expert_in, b_expert_in, w_expert_out, b_expert_out, g_final):
    b, s, d = x.shape
    for l in range(DEPTH):
        h = rmsnorm(x, g_mix[l])
        proj = h @ w_in[l]
        q = proj[..., :SB_WIDTH].reshape(b, s, SB_HEADS, SB_HEAD_DIM).transpose(0, 2, 1, 3)
        k = proj[..., SB_WIDTH:2 * SB_WIDTH].reshape(b, s, SB_HEADS, SB_HEAD_DIM).transpose(0, 2, 1, 3)
        v = proj[..., 2 * SB_WIDTH:3 * SB_WIDTH].reshape(b, s, SB_HEADS, SB_HEAD_DIM).transpose(0, 2, 1, 3)
        u = proj[..., 3 * SB_WIDTH:].reshape(b, s, POOL_GROUPS, POOL_GROUP_DIM)
        sb = stick_breaking_attention(q, k, v).transpose(0, 2, 1, 3).reshape(b, s, SB_WIDTH)
        pooled = multiscale_pool(u)
        pooled = jnp.einsum('bsgc,gce->bsge', pooled, w_pool[l]).reshape(b, s, POOL_WIDTH) * pool_scale[l]
        mixed = jnp.concatenate([rmsnorm(sb, g_sb_out[l]), rmsnorm(pooled, g_pool_out[l])], axis=-1)
        x = x + mixed @ w_out[l]
        x = x + memory_cross_attention(rmsnorm(x, g_mem_q[l]), rmsnorm(mem, g_mem_kv[l]),
                                       w_mem_q[l], w_mem_kv[l], w_mem_o[l])
        x = x + moe_ffn(rmsnorm(x, g_ffn[l]), w_router[l], b_router[l], w_expert_in[l],
                        b_expert_in[l], w_expert_out[l], b_expert_out[l])
    return rmsnorm(x, g_final)
```

```cpp
#include <hip/hip_runtime.h>
#include <cstdio>
#include <cstdint>

typedef unsigned short bf16_t;
typedef short bf16x8 __attribute__((ext_vector_type(8)));
typedef float f32x4 __attribute__((ext_vector_type(4)));
typedef unsigned u32x4 __attribute__((ext_vector_type(4)));

namespace cfg {
constexpr int B = 8, S = 4096, D = 1024, NTOK = B * S;
constexpr int SBW = 512, NH = 8, HD = 64, PW = 512, PG = 4, PGD = 128, INP = 2048;
constexpr int NMEM = 256, MH = 4, MHD = 256, NMROWS = B * NMEM;
constexpr int NE = 32, TOPK = 4, DFF = 1024, LCAP = NTOK;
constexpr float EPS = 1e-5f, LOG2E = 1.4426950408889634f;
constexpr float C2_SB = 0.125f * LOG2E, C2_MEM = 0.0625f * LOG2E;
constexpr float SW_LIMIT = 7.0f, SW_ALPHA = 1.702f;
constexpr int MAXTILES = 544;
constexpr size_t MiB = 1u << 20;
constexpr size_t WS_CTL = 0, CTL_BYTES = 2 * MiB;
constexpr size_t OFF_CNT = 64 * 1024, OFF_SSQSB = 512 * 1024, OFF_SSQ1 = 640 * 1024, OFF_SSQ2 = 768 * 1024;
constexpr size_t WS_WIN = 2 * MiB, WS_WOUT = 6 * MiB, WS_WQ = 8 * MiB, WS_WKV = 10 * MiB, WS_WO = 14 * MiB, WS_WP = 16 * MiB, WS_WR = 17 * MiB;
constexpr size_t WS_RSTDX = 18 * MiB, WS_RSTDM = 18 * MiB + 512 * 1024;
constexpr size_t WS_W1 = 20 * MiB, WS_W2 = 148 * MiB;
constexpr size_t WS_S0 = 212 * MiB;
constexpr size_t WS_QKVU = 276 * MiB;
constexpr size_t WS_QM = 276 * MiB, WS_OM = 340 * MiB;
constexpr size_t WS_MIXED = 404 * MiB;
constexpr size_t WS_PM = 404 * MiB;
constexpr size_t WS_ACT = 276 * MiB;
constexpr size_t WS_KM = 548 * MiB, WS_VMT = 552 * MiB, WS_MEMB = 556 * MiB, WS_LSLOT = 560 * MiB, WS_LGATE = 564 * MiB;
constexpr size_t WS_Y = 568 * MiB;
constexpr size_t WS_SCR_S = 568 * MiB, WS_SCR_POOLED = 696 * MiB, WS_SCR_POOLO = 728 * MiB;
constexpr size_t WS_END = 824 * MiB;
}
using namespace cfg;

__device__ __forceinline__ unsigned f2bf(float f) { unsigned u = __builtin_bit_cast(unsigned, f); return (u + 0x7fffu + ((u >> 16) & 1u)) >> 16; }
__device__ __forceinline__ float bf2f(bf16_t h) { return __builtin_bit_cast(float, (unsigned)h << 16); }
__device__ __forceinline__ float wave_sum(float v) {
#pragma unroll
    for (int o = 1; o < 64; o <<= 1) v += __shfl_xor(v, o);
    return v;
}

namespace nv {
__global__ void k_cvt_w(const float* src, int K, int N, bf16_t* dst, int ND, const float* gk, const float* gk2, int ksplit, const float* gn, int gnz, int mode) {
    __shared__ float t[32][33];
    const int nd0 = blockIdx.x * 32, k0 = blockIdx.y * 32, z = blockIdx.z;
    int ns0 = nd0;
    if (mode == 1) { const int pn = nd0 >> 8, j = nd0 & 255; ns0 = (j < 128) ? 128 * pn + j : 1024 + 128 * pn + (j - 128); }
    src += (size_t)z * K * N; dst += (size_t)z * ND * K;
    for (int i = threadIdx.y; i < 32; i += 8) { const int k = k0 + i, n = ns0 + threadIdx.x;
        float v = src[(size_t)k * N + n]; if (gk) v *= (k < ksplit) ? gk[k] : gk2[k - ksplit]; if (gn) v *= gn[z * gnz + n]; t[i][threadIdx.x] = v; }
    __syncthreads();
    for (int i = threadIdx.y; i < 32; i += 8) dst[(size_t)(nd0 + i) * K + k0 + threadIdx.x] = (bf16_t)f2bf(t[threadIdx.x][i]);
}
__global__ void k_cvt_router(const float* wr, const float* g, float* dst) {
    const int i = blockIdx.x * 256 + threadIdx.x; if (i >= NE * D) return; const int e = i / D, k = i % D; dst[i] = g[k] * wr[k * NE + e];
}
__global__ void k_rowstat_cvt(const float* x, bf16_t* xb, float* rstd, int rows) {
    const int row = blockIdx.x * 4 + (threadIdx.x >> 6), lane = threadIdx.x & 63; if (row >= rows) return;
    const float* xr = x + (size_t)row * D; float s = 0.f;
    for (int j = lane; j < D; j += 64) { const float v = xr[j]; s += v * v; xb[(size_t)row * D + j] = (bf16_t)f2bf(v); }
    s = wave_sum(s); if (lane == 0) rstd[row] = 1.0f / sqrtf(s * (1.0f / D) + EPS);
}

template <class RA, class RB, class MID, class EPI>
__device__ __forceinline__ void wave_gemm(int m0, int n0, int K, int kmid, RA ra, RB rb, MID mid, EPI epi) {
    const int lane = threadIdx.x & 63, r16 = lane & 15, kq = lane >> 4;
    const bf16_t* pa[2]; const bf16_t* pb[2];
#pragma unroll
    for (int i = 0; i < 2; ++i) { pa[i] = ra(m0 + i * 16 + r16) + kq * 8; pb[i] = rb(n0 + i * 16 + r16) + kq * 8; }
    f32x4 acc[2][2];
#pragma unroll
    for (int i = 0; i < 2; ++i)
#pragma unroll
        for (int j = 0; j < 2; ++j) acc[i][j] = (f32x4){0.f, 0.f, 0.f, 0.f};
    for (int k = 0; k < K; k += 32) {
        if (k == kmid) {
#pragma unroll
            for (int i = 0; i < 2; ++i)
#pragma unroll
                for (int r = 0; r < 4; ++r) { const float s = mid(m0 + i * 16 + kq * 4 + r); acc[i][0][r] *= s; acc[i][1][r] *= s; }
        }
        bf16x8 a[2], b[2];
#pragma unroll
        for (int i = 0; i < 2; ++i) { a[i] = *(const bf16x8*)(pa[i] + k); b[i] = *(const bf16x8*)(pb[i] + k); }
#pragma unroll
        for (int i = 0; i < 2; ++i)
#pragma unroll
            for (int j = 0; j < 2; ++j) acc[i][j] = __builtin_amdgcn_mfma_f32_16x16x32_bf16(a[i], b[j], acc[i][j], 0, 0, 0);
    }
#pragma unroll
    for (int i = 0; i < 2; ++i)
#pragma unroll
        for (int r = 0; r < 4; ++r) epi(m0 + i * 16 + kq * 4 + r, n0 + r16, n0 + 16 + r16, acc[i][0][r], acc[i][1][r]);
}
struct NoMid { __device__ float operator()(int) const { return 1.f; } };

#define NV_TILE() const int w = threadIdx.x >> 6, m0 = blockIdx.y * 64 + (w >> 1) * 32, n0 = blockIdx.x * 64 + (w & 1) * 32

__global__ void k_g1(const bf16_t* XB, const bf16_t* WT, const float* rstd, bf16_t* QKVU) {
    NV_TILE();
    wave_gemm(m0, n0, D, -1, [=](int r) { return XB + (size_t)r * D; }, [=](int c) { return WT + (size_t)c * D; }, NoMid(),
        [=](int r, int c0, int c1, float v0, float v1) { const float s = rstd[r];
            v0 *= s; v1 *= s; if (c0 < SBW) v0 *= C2_SB; if (c1 < SBW) v1 *= C2_SB;
            QKVU[(size_t)r * INP + c0] = (bf16_t)f2bf(v0); QKVU[(size_t)r * INP + c1] = (bf16_t)f2bf(v1); });
}
__global__ void k_g1b(const bf16_t* MEMB, const bf16_t* WT, const float* rstd, bf16_t* KM, bf16_t* VMT) {
    NV_TILE();
    wave_gemm(m0, n0, D, -1, [=](int r) { return MEMB + (size_t)r * D; }, [=](int c) { return WT + (size_t)c * D; }, NoMid(),
        [=](int r, int c0, int c1, float v0, float v1) { const float s = rstd[r]; const int cc[2] = {c0, c1}; const float vv[2] = {v0 * s, v1 * s};
#pragma unroll
            for (int q = 0; q < 2; ++q) { const int c = cc[q];
                if (c < D) KM[(size_t)r * D + c] = (bf16_t)f2bf(vv[q]);
                else VMT[((size_t)(r >> 8) * D + (c - D)) * NMEM + (r & 255)] = (bf16_t)f2bf(vv[q]); } });
}
__global__ void __launch_bounds__(256) k_sb(const bf16_t* QKVU, bf16_t* MIXED, float* SSQSB) {
    const int gid = blockIdx.x * 256 + threadIdx.x; const int t = gid & (S - 1), h = (gid >> 12) & 7, b = gid >> 15;
    const bf16_t* base = QKVU + (size_t)b * S * INP;
    float q[HD], o[HD];
    { const bf16_t* qp = base + (size_t)t * INP + h * HD;
#pragma unroll
      for (int d = 0; d < HD; ++d) { q[d] = bf2f(qp[d]); o[d] = 0.f; } }
    float P = 1.f;
    for (int s = t - 1; s >= 0; --s) {
        const bf16_t* kp = base + (size_t)s * INP + SBW + h * HD; const bf16_t* vp = kp + SBW;
        float z = 0.f;
#pragma unroll
        for (int d = 0; d < HD; ++d) z += q[d] * bf2f(kp[d]);
        const float e = exp2f(z), r = 1.0f / (1.0f + e), beta = 1.0f - r;
        const float w = bf2f((bf16_t)f2bf(beta * P));
#pragma unroll
        for (int d = 0; d < HD; ++d) o[d] += w * bf2f(vp[d]);
        P *= r;
        if (P == 0.f) break;
    }
    float ss = 0.f; bf16_t* op = MIXED + (size_t)(b * S + t) * D + h * HD;
#pragma unroll
    for (int d = 0; d < HD; ++d) { ss += o[d] * o[d]; op[d] = (bf16_t)f2bf(o[d]); }
    unsafeAtomicAdd(SSQSB + b * S + t, ss);
}
__global__ void k_pool1(const bf16_t* QKVU, bf16_t* POOLED) {
    const size_t gid = (size_t)blockIdx.x * 256 + threadIdx.x; const int c = gid & 511; const int tok = (int)(gid >> 9), t = tok & (S - 1);
    const int win = 2 << (c >> 7); const int n = (t + 1 < win) ? t + 1 : win;
    const bf16_t* up = QKVU + (size_t)tok * INP + 3 * SBW + c; float s = 0.f;
    for (int j = 0; j < n; ++j) s += bf2f(up[-(ptrdiff_t)j * INP]);
    POOLED[gid] = (bf16_t)f2bf(s / (float)n - bf2f(up[0]));
}
__global__ void k_pool2(const bf16_t* POOLED, const bf16_t* WPT, float* POOLO) {
    NV_TILE(); const int g = blockIdx.z;
    wave_gemm(m0, n0, PGD, -1, [=](int r) { return POOLED + (size_t)r * PW + g * PGD; }, [=](int c) { return WPT + ((size_t)g * PGD + c) * PGD; }, NoMid(),
        [=](int r, int c0, int c1, float v0, float v1) { POOLO[(size_t)r * PW + g * PGD + c0] = v0; POOLO[(size_t)r * PW + g * PGD + c1] = v1; });
}
__global__ void k_pool3(const float* POOLO, bf16_t* MIXED) {
    const int tok = blockIdx.x * 4 + (threadIdx.x >> 6), lane = threadIdx.x & 63;
    float v[8], s = 0.f;
#pragma unroll
    for (int j = 0; j < 8; ++j) { v[j] = POOLO[(size_t)tok * PW + lane + 64 * j]; s += v[j] * v[j]; }
    const float rs = 1.0f / sqrtf(wave_sum(s) * (1.0f / PW) + EPS);
#pragma unroll
    for (int j = 0; j < 8; ++j) MIXED[(size_t)tok * D + SBW + lane + 64 * j] = (bf16_t)f2bf(v[j] * rs);
}
__global__ void k_resid(const bf16_t* A, const bf16_t* WT, const float* xin, float* xout, bf16_t* XB, float* SSQ, const float* ssq_mid, int kmid) {
    NV_TILE();
    wave_gemm(m0, n0, D, kmid, [=](int r) { return A + (size_t)r * D; }, [=](int c) { return WT + (size_t)c * D; },
        [=](int r) { return 1.0f / sqrtf(ssq_mid[r] * (1.0f / SBW) + EPS); },
        [=](int r, int c0, int c1, float v0, float v1) {
            const float x0 = xin[(size_t)r * D + c0] + v0, x1 = xin[(size_t)r * D + c1] + v1;
            xout[(size_t)r * D + c0] = x0; xout[(size_t)r * D + c1] = x1;
            XB[(size_t)r * D + c0] = (bf16_t)f2bf(x0); XB[(size_t)r * D + c1] = (bf16_t)f2bf(x1);
            float q = x0 * x0 + x1 * x1; q += __shfl_xor(q, 1); q += __shfl_xor(q, 2); q += __shfl_xor(q, 4); q += __shfl_xor(q, 8);
            if ((threadIdx.x & 15) == 0) unsafeAtomicAdd(SSQ + r, q); });
}
__global__ void k_g3(const bf16_t* X1B, const bf16_t* WT, const float* SSQ1, bf16_t* QM) {
    NV_TILE();
    wave_gemm(m0, n0, D, -1, [=](int r) { return X1B + (size_t)r * D; }, [=](int c) { return WT + (size_t)c * D; }, NoMid(),
        [=](int r, int c0, int c1, float v0, float v1) { const float s = C2_MEM / sqrtf(SSQ1[r] * (1.0f / D) + EPS);
            QM[(size_t)r * D + c0] = (bf16_t)f2bf(v0 * s); QM[(size_t)r * D + c1] = (bf16_t)f2bf(v1 * s); });
}
__global__ void k_ms(const bf16_t* QM, const bf16_t* KM, float* SCR) {
    NV_TILE(); const int h = blockIdx.z; const int b = m0 >> 12;
    wave_gemm(m0, n0, MHD, -1, [=](int r) { return QM + (size_t)r * D + h * MHD; }, [=](int c) { return KM + ((size_t)b * NMEM + c) * D + h * MHD; }, NoMid(),
        [=](int r, int c0, int c1, float v0, float v1) { SCR[((size_t)r * MH + h) * NMEM + c0] = v0; SCR[((size_t)r * MH + h) * NMEM + c1] = v1; });
}
__global__ void k_msoftmax(const float* SCR, bf16_t* PM) {
    const int row = blockIdx.x * 4 + (threadIdx.x >> 6), lane = threadIdx.x & 63;
    float v[4], m = -INFINITY;
#pragma unroll
    for (int j = 0; j < 4; ++j) { v[j] = SCR[(size_t)row * NMEM + lane + 64 * j]; m = fmaxf(m, v[j]); }
#pragma unroll
    for (int o = 1; o < 64; o <<= 1) m = fmaxf(m, __shfl_xor(m, o));
    float s = 0.f;
#pragma unroll
    for (int j = 0; j < 4; ++j) { v[j] = exp2f(v[j] - m); s += v[j]; }
    s = 1.0f / wave_sum(s);
#pragma unroll
    for (int j = 0; j < 4; ++j) PM[(size_t)row * NMEM + lane + 64 * j] = (bf16_t)f2bf(v[j] * s);
}
__global__ void k_mpv(const bf16_t* PM, const bf16_t* VMT, bf16_t* OM) {
    NV_TILE(); const int h = blockIdx.z; const int b = m0 >> 12;
    wave_gemm(m0, n0, NMEM, -1, [=](int r) { return PM + ((size_t)r * MH + h) * NMEM; }, [=](int c) { return VMT + ((size_t)b * D + h * MHD + c) * NMEM; }, NoMid(),
        [=](int r, int c0, int c1, float v0, float v1) { OM[(size_t)r * D + h * MHD + c0] = (bf16_t)f2bf(v0); OM[(size_t)r * D + h * MHD + c1] = (bf16_t)f2bf(v1); });
}
__global__ void k_route(const float* x2, const float* SSQ2, const float* WR, const float* br, int* CNT, int* LSLOT, float* LGATE) {
    const int tok = blockIdx.x * 4 + (threadIdx.x >> 6), lane = threadIdx.x & 63;
    float xv[16];
#pragma unroll
    for (int j = 0; j < 16; ++j) xv[j] = x2[(size_t)tok * D + lane + 64 * j];
    const float rs = 1.0f / sqrtf(SSQ2[tok] * (1.0f / D) + EPS);
    float mine = 0.f;
    for (int e = 0; e < NE; ++e) { float s = 0.f;
#pragma unroll
        for (int j = 0; j < 16; ++j) s += xv[j] * WR[e * D + lane + 64 * j];
        s = wave_sum(s); if (lane == e) mine = s * rs + br[e]; }
    float tv[4]; int ti[4]; float cur = (lane < NE) ? mine : -INFINITY;
#pragma unroll
    for (int k = 0; k < 4; ++k) { float m = cur; int mi = lane;
#pragma unroll
        for (int o = 1; o < 64; o <<= 1) { const float om = __shfl_xor(m, o); const int oi = __shfl_xor(mi, o); if (om > m || (om == m && oi < mi)) { m = om; mi = oi; } }
        tv[k] = m; ti[k] = mi; if (lane == mi) cur = -INFINITY; }
    float g[4], gs = 0.f;
#pragma unroll
    for (int k = 0; k < 4; ++k) { g[k] = expf(tv[k] - tv[0]); gs += g[k]; }
    if (lane < 4) { int e = ti[0]; float gg = g[0];
        if (lane == 1) { e = ti[1]; gg = g[1]; } if (lane == 2) { e = ti[2]; gg = g[2]; } if (lane == 3) { e = ti[3]; gg = g[3]; }
        const int pos = atomicAdd(CNT + e, 1); LSLOT[(size_t)e * LCAP + pos] = tok * 4 + lane; LGATE[(size_t)e * LCAP + pos] = gg / gs; }
}
__device__ __forceinline__ int tile_base(const int* CNT, int e) { int tb = 0; for (int i = 0; i < e; ++i) tb += (CNT[i] + 255) >> 8; return tb; }
__global__ void k_w1(const bf16_t* X2B, const float* SSQ2, const bf16_t* W1T, const float* b1, const int* CNT, const int* LSLOT, bf16_t* ACT) {
    const int e = blockIdx.z, cnt = CNT[e]; const int w = threadIdx.x >> 6; const int m0 = blockIdx.y * 64 + (w >> 1) * 32; if (blockIdx.y * 64 >= cnt) return;
    const int gc0 = blockIdx.x * 32 + (w & 1) * 16;
    const int pn = gc0 >> 7, j0 = gc0 & 127; const int n0 = pn * 256 + j0;
    const int tb = tile_base(CNT, e); const bf16_t* Wt = W1T + (size_t)e * 2 * DFF * D; const int* ls = LSLOT + (size_t)e * LCAP;
    wave_gemm(m0, 0, D, -1, [=](int r) { const int tok = (r < cnt) ? (ls[r] >> 2) : 0; return X2B + (size_t)tok * D; },
        [=](int c) { const int rowb = (c < 16) ? n0 + c : n0 + 128 + (c - 16); return Wt + (size_t)rowb * D; }, NoMid(),
        [=](int r, int c0, int c1, float vg, float vu) { if (r >= cnt) return; const int tok = ls[r] >> 2; const float rs = 1.0f / sqrtf(SSQ2[tok] * (1.0f / D) + EPS);
            const int gc = gc0 + c0;
            float gate = vg * rs + b1[e * 2 * DFF + gc], up = vu * rs + b1[e * 2 * DFF + DFF + gc];
            gate = fminf(gate, SW_LIMIT); up = fminf(fmaxf(up, -SW_LIMIT), SW_LIMIT);
            const float act = (up + 1.0f) * gate / (1.0f + expf(-SW_ALPHA * gate));
            ACT[((size_t)tb * 256 + r) * DFF + gc] = (bf16_t)f2bf(act); (void)c1; });
}
__global__ void k_w2(const bf16_t* ACT, const bf16_t* W2T, const float* b2, const int* CNT, const int* LSLOT, const float* LGATE, bf16_t* Y) {
    const int e = blockIdx.z, cnt = CNT[e]; if (blockIdx.y * 64 >= cnt) return; NV_TILE();
    const int tb = tile_base(CNT, e); const bf16_t* Wt = W2T + (size_t)e * D * DFF; const int* ls = LSLOT + (size_t)e * LCAP; const float* lg = LGATE + (size_t)e * LCAP;
    wave_gemm(m0, n0, DFF, -1, [=](int r) { return ACT + ((size_t)tb * 256 + r) * DFF; }, [=](int c) { return Wt + (size_t)c * DFF; }, NoMid(),
        [=](int r, int c0, int c1, float v0, float v1) { if (r >= cnt) return; const int slot = ls[r]; const float g = lg[r];
            Y[(size_t)slot * D + c0] = (bf16_t)f2bf((v0 + b2[e * D + c0]) * g); Y[(size_t)slot * D + c1] = (bf16_t)f2bf((v1 + b2[e * D + c1]) * g); });
}
__global__ void k_final(float* out, const bf16_t* Y, const float* gf) {
    const int tok = blockIdx.x * 4 + (threadIdx.x >> 6), lane = threadIdx.x & 63;
    float v[16], s = 0.f;
#pragma unroll
    for (int j = 0; j < 16; ++j) { const int c = lane + 64 * j; float a = out[(size_t)tok * D + c];
#pragma unroll
        for (int k = 0; k < 4; ++k) a += bf2f(Y[((size_t)tok * 4 + k) * D + c]);
        v[j] = a; s += a * a; }
    const float rs = 1.0f / sqrtf(wave_sum(s) * (1.0f / D) + EPS);
#pragma unroll
    for (int j = 0; j < 16; ++j) { const int c = lane + 64 * j; out[(size_t)tok * D + c] = v[j] * rs * gf[c]; }
}
}

extern "C" void kernel_launch(void* const* d_in, const int* in_sizes, int n_in, void* d_out, int out_size, void* d_ws, size_t ws_size, hipStream_t stream) {
    if (n_in != 22 || out_size != NTOK * D || ws_size < WS_END) { fprintf(stderr, "kernel_launch: unexpected shapes (n_in %d out %d ws %zu)\n", n_in, out_size, ws_size); return; }
    const float* x = (const float*)d_in[0]; const float* mem = (const float*)d_in[1]; const float* g_mix = (const float*)d_in[2]; const float* w_in = (const float*)d_in[3];
    const float* g_sb = (const float*)d_in[4]; const float* g_pool = (const float*)d_in[5]; const float* w_pool = (const float*)d_in[6]; const float* pool_scale = (const float*)d_in[7];
    const float* w_out = (const float*)d_in[8]; const float* g_mem_q = (const float*)d_in[9]; const float* g_mem_kv = (const float*)d_in[10]; const float* w_mem_q = (const float*)d_in[11];
    const float* w_mem_kv = (const float*)d_in[12]; const float* w_mem_o = (const float*)d_in[13]; const float* g_ffn = (const float*)d_in[14]; const float* w_router = (const float*)d_in[15];
    const float* b_router = (const float*)d_in[16]; const float* w_e_in = (const float*)d_in[17]; const float* b_e_in = (const float*)d_in[18]; const float* w_e_out = (const float*)d_in[19];
    const float* b_e_out = (const float*)d_in[20]; const float* g_final = (const float*)d_in[21];
    float* out = (float*)d_out; unsigned char* ws = (unsigned char*)d_ws;
    bf16_t* WIN = (bf16_t*)(ws + WS_WIN); bf16_t* WOUT = (bf16_t*)(ws + WS_WOUT); bf16_t* WQ = (bf16_t*)(ws + WS_WQ); bf16_t* WKV = (bf16_t*)(ws + WS_WKV); bf16_t* WO = (bf16_t*)(ws + WS_WO);
    bf16_t* WP = (bf16_t*)(ws + WS_WP); float* WR = (float*)(ws + WS_WR); float* RSTDX = (float*)(ws + WS_RSTDX); float* RSTDM = (float*)(ws + WS_RSTDM);
    bf16_t* W1 = (bf16_t*)(ws + WS_W1); bf16_t* W2 = (bf16_t*)(ws + WS_W2); bf16_t* S0 = (bf16_t*)(ws + WS_S0); bf16_t* QKVU = (bf16_t*)(ws + WS_QKVU);
    bf16_t* QM = (bf16_t*)(ws + WS_QM); bf16_t* OM = (bf16_t*)(ws + WS_OM); bf16_t* MIXED = (bf16_t*)(ws + WS_MIXED); bf16_t* PM = (bf16_t*)(ws + WS_PM); bf16_t* ACT = (bf16_t*)(ws + WS_ACT);
    bf16_t* KM = (bf16_t*)(ws + WS_KM); bf16_t* VMT = (bf16_t*)(ws + WS_VMT); bf16_t* MEMB = (bf16_t*)(ws + WS_MEMB); int* LSLOT = (int*)(ws + WS_LSLOT); float* LGATE = (float*)(ws + WS_LGATE);
    bf16_t* Y = (bf16_t*)(ws + WS_Y); float* SCR_S = (float*)(ws + WS_SCR_S); bf16_t* POOLED = (bf16_t*)(ws + WS_SCR_POOLED); float* POOLO = (float*)(ws + WS_SCR_POOLO);
    int* CNT = (int*)(ws + OFF_CNT); float* SSQSB = (float*)(ws + OFF_SSQSB); float* SSQ1 = (float*)(ws + OFF_SSQ1); float* SSQ2 = (float*)(ws + OFF_SSQ2);

    hipMemsetAsync(ws + WS_CTL, 0, CTL_BYTES, stream);
    const dim3 tb(32, 8); const int BIG = 1 << 30;
    nv::k_cvt_w<<<dim3(INP / 32, D / 32, 1), tb, 0, stream>>>(w_in, D, INP, WIN, INP, g_mix, nullptr, BIG, nullptr, 0, 0);
    nv::k_cvt_w<<<dim3(D / 32, D / 32, 1), tb, 0, stream>>>(w_out, D, D, WOUT, D, g_sb, g_pool, SBW, nullptr, 0, 0);
    nv::k_cvt_w<<<dim3(D / 32, D / 32, 1), tb, 0, stream>>>(w_mem_q, D, D, WQ, D, g_mem_q, nullptr, BIG, nullptr, 0, 0);
    nv::k_cvt_w<<<dim3(2 * D / 32, D / 32, 1), tb, 0, stream>>>(w_mem_kv, D, 2 * D, WKV, 2 * D, g_mem_kv, nullptr, BIG, nullptr, 0, 0);
    nv::k_cvt_w<<<dim3(D / 32, D / 32, 1), tb, 0, stream>>>(w_mem_o, D, D, WO, D, nullptr, nullptr, BIG, nullptr, 0, 0);
    nv::k_cvt_w<<<dim3(2 * DFF / 32, D / 32, NE), tb, 0, stream>>>(w_e_in, D, 2 * DFF, W1, 2 * DFF, g_ffn, nullptr, BIG, nullptr, 0, 1);
    nv::k_cvt_w<<<dim3(D / 32, DFF / 32, NE), tb, 0, stream>>>(w_e_out, DFF, D, W2, D, nullptr, nullptr, BIG, nullptr, 0, 0);
    nv::k_cvt_w<<<dim3(PGD / 32, PGD / 32, PG), tb, 0, stream>>>(w_pool, PGD, PGD, WP, PGD, nullptr, nullptr, BIG, pool_scale, PGD, 0);
    nv::k_cvt_router<<<NE * D / 256, 256, 0, stream>>>(w_router, g_ffn, WR);
    nv::k_rowstat_cvt<<<NTOK / 4, 256, 0, stream>>>(x, S0, RSTDX, NTOK);
    nv::k_rowstat_cvt<<<NMROWS / 4, 256, 0, stream>>>(mem, MEMB, RSTDM, NMROWS);
    nv::k_g1<<<dim3(INP / 64, NTOK / 64), 256, 0, stream>>>(S0, WIN, RSTDX, QKVU);
    nv::k_g1b<<<dim3(2 * D / 64, NMROWS / 64), 256, 0, stream>>>(MEMB, WKV, RSTDM, KM, VMT);
    nv::k_sb<<<B * NH * S / 256, 256, 0, stream>>>(QKVU, MIXED, SSQSB);
    nv::k_pool1<<<(unsigned)((size_t)NTOK * PW / 256), 256, 0, stream>>>(QKVU, POOLED);
    nv::k_pool2<<<dim3(PGD / 64, NTOK / 64, PG), 256, 0, stream>>>(POOLED, WP, POOLO);
    nv::k_pool3<<<NTOK / 4, 256, 0, stream>>>(POOLO, MIXED);
    nv::k_resid<<<dim3(D / 64, NTOK / 64), 256, 0, stream>>>(MIXED, WOUT, x, out, S0, SSQ1, SSQSB, SBW);
    nv::k_g3<<<dim3(D / 64, NTOK / 64), 256, 0, stream>>>(S0, WQ, SSQ1, QM);
    nv::k_ms<<<dim3(NMEM / 64, NTOK / 64, MH), 256, 0, stream>>>(QM, KM, SCR_S);
    nv::k_msoftmax<<<NTOK * MH / 4, 256, 0, stream>>>(SCR_S, PM);
    nv::k_mpv<<<dim3(MHD / 64, NTOK / 64, MH), 256, 0, stream>>>(PM, VMT, OM);
    nv::k_resid<<<dim3(D / 64, NTOK / 64), 256, 0, stream>>>(OM, WO, out, out, S0, SSQ2, SSQ2, -1);
    nv::k_route<<<NTOK / 4, 256, 0, stream>>>(out, SSQ2, WR, b_router, CNT, LSLOT, LGATE);
    nv::k_w1<<<dim3(DFF / 32, LCAP / 64, NE), 256, 0, stream>>>(S0, SSQ2, W1, b_e_in, CNT, LSLOT, ACT);
    nv::k_w2<<<dim3(D / 64, LCAP / 64, NE), 256, 0, stream>>>(ACT, W2, b_e_out, CNT, LSLOT, LGATE, Y);
    nv::k_final<<<NTOK / 4, 256, 0, stream>>>(out, Y, g_final);
}
```

```cpp
#include <hip/hip_runtime.h>
#include <cstdio>
#include <cstdint>

typedef unsigned short bf16_t;
typedef short bf16x8 __attribute__((ext_vector_type(8)));
typedef float f32x4 __attribute__((ext_vector_type(4)));
typedef unsigned u32x4 __attribute__((ext_vector_type(4)));

namespace cfg {
constexpr int B = 8, S = 4096, D = 1024, NTOK = B * S;
constexpr int SBW = 512, NH = 8, HD = 64, PW = 512, PG = 4, PGD = 128, INP = 2048;
constexpr int NMEM = 256, MH = 4, MHD = 256, NMROWS = B * NMEM;
constexpr int NE = 32, TOPK = 4, DFF = 1024, LCAP = NTOK;
constexpr float EPS = 1e-5f, LOG2E = 1.4426950408889634f;
constexpr float C2_SB = 0.125f * LOG2E, C2_MEM = 0.0625f * LOG2E;
constexpr float SW_LIMIT = 7.0f, SW_ALPHA = 1.702f;
constexpr int MAXTILES = 544;
constexpr size_t MiB = 1u << 20;
constexpr size_t WS_CTL = 0, CTL_BYTES = 2 * MiB;
constexpr size_t OFF_CNT = 64 * 1024, OFF_SSQSB = 512 * 1024, OFF_SSQ1 = 640 * 1024, OFF_SSQ2 = 768 * 1024;
constexpr size_t WS_WIN = 2 * MiB, WS_WOUT = 6 * MiB, WS_WQ = 8 * MiB, WS_WKV = 10 * MiB, WS_WO = 14 * MiB, WS_WP = 16 * MiB, WS_WR = 17 * MiB;
constexpr size_t WS_RSTDX = 18 * MiB, WS_RSTDM = 18 * MiB + 512 * 1024;
constexpr size_t WS_W1 = 20 * MiB, WS_W2 = 148 * MiB;
constexpr size_t WS_S0 = 212 * MiB;
constexpr size_t WS_QKVU = 276 * MiB;
constexpr size_t WS_QM = 276 * MiB, WS_OM = 340 * MiB;
constexpr size_t WS_MIXED = 404 * MiB;
constexpr size_t WS_PM = 404 * MiB;
constexpr size_t WS_ACT = 276 * MiB;
constexpr size_t WS_KM = 548 * MiB, WS_VMT = 552 * MiB, WS_MEMB = 556 * MiB, WS_LSLOT = 560 * MiB, WS_LGATE = 564 * MiB;
constexpr size_t WS_Y = 568 * MiB;
constexpr size_t WS_SCR_S = 568 * MiB, WS_SCR_POOLED = 696 * MiB, WS_SCR_POOLO = 728 * MiB;
constexpr size_t WS_END = 824 * MiB;
}
using namespace cfg;

__device__ __forceinline__ unsigned f2bf(float f) { unsigned u = __builtin_bit_cast(unsigned, f); return (u + 0x7fffu + ((u >> 16) & 1u)) >> 16; }
__device__ __forceinline__ float bf2f(bf16_t h) { return __builtin_bit_cast(float, (unsigned)h << 16); }
__device__ __forceinline__ float wave_sum(float v) {
#pragma unroll
    for (int o = 1; o < 64; o <<= 1) v += __shfl_xor(v, o);
    return v;
}

namespace nv {
__global__ void k_cvt_w(const float* src, int K, int N, bf16_t* dst, int ND, const float* gk, const float* gk2, int ksplit, const float* gn, int gnz, int mode) {
    __shared__ float t[32][33];
    const int nd0 = blockIdx.x * 32, k0 = blockIdx.y * 32, z = blockIdx.z;
    int ns0 = nd0;
    if (mode == 1) { const int pn = nd0 >> 8, j = nd0 & 255; ns0 = (j < 128) ? 128 * pn + j : 1024 + 128 * pn + (j - 128); }
    src += (size_t)z * K * N; dst += (size_t)z * ND * K;
    for (int i = threadIdx.y; i < 32; i += 8) { const int k = k0 + i, n = ns0 + threadIdx.x;
        float v = src[(size_t)k * N + n]; if (gk) v *= (k < ksplit) ? gk[k] : gk2[k - ksplit]; if (gn) v *= gn[z * gnz + n]; t[i][threadIdx.x] = v; }
    __syncthreads();
    for (int i = threadIdx.y; i < 32; i += 8) dst[(size_t)(nd0 + i) * K + k0 + threadIdx.x] = (bf16_t)f2bf(t[threadIdx.x][i]);
}
__global__ void k_cvt_router(const float* wr, const float* g, float* dst) {
    const int i = blockIdx.x * 256 + threadIdx.x; if (i >= NE * D) return; const int e = i / D, k = i % D; dst[i] = g[k] * wr[k * NE + e];
}
__global__ void k_rowstat_cvt(const float* x, bf16_t* xb, float* rstd, int rows) {
    const int row = blockIdx.x * 4 + (threadIdx.x >> 6), lane = threadIdx.x & 63; if (row >= rows) return;
    const float* xr = x + (size_t)row * D; float s = 0.f;
    for (int j = lane; j < D; j += 64) { const float v = xr[j]; s += v * v; xb[(size_t)row * D + j] = (bf16_t)f2bf(v); }
    s = wave_sum(s); if (lane == 0) rstd[row] = 1.0f / sqrtf(s * (1.0f / D) + EPS);
}

template <class RA, class RB, class MID, class EPI>
__device__ __forceinline__ void wave_gemm(int m0, int n0, int K, int kmid, RA ra, RB rb, MID mid, EPI epi) {
    const int lane = threadIdx.x & 63, r16 = lane & 15, kq = lane >> 4;
    const bf16_t* pa[2]; const bf16_t* pb[2];
#pragma unroll
    for (int i = 0; i < 2; ++i) { pa[i] = ra(m0 + i * 16 + r16) + kq * 8; pb[i] = rb(n0 + i * 16 + r16) + kq * 8; }
    f32x4 acc[2][2];
#pragma unroll
    for (int i = 0; i < 2; ++i)
#pragma unroll
        for (int j = 0; j < 2; ++j) acc[i][j] = (f32x4){0.f, 0.f, 0.f, 0.f};
    for (int k = 0; k < K; k += 32) {
        if (k == kmid) {
#pragma unroll
            for (int i = 0; i < 2; ++i)
#pragma unroll
                for (int r = 0; r < 4; ++r) { const float s = mid(m0 + i * 16 + kq * 4 + r); acc[i][0][r] *= s; acc[i][1][r] *= s; }
        }
        bf16x8 a[2], b[2];
#pragma unroll
        for (int i = 0; i < 2; ++i) { a[i] = *(const bf16x8*)(pa[i] + k); b[i] = *(const bf16x8*)(pb[i] + k); }
#pragma unroll
        for (int i = 0; i < 2; ++i)
#pragma unroll
            for (int j = 0; j < 2; ++j) acc[i][j] = __builtin_amdgcn_mfma_f32_16x16x32_bf16(a[i], b[j], acc[i][j], 0, 0, 0);
    }
#pragma unroll
    for (int i = 0; i < 2; ++i)
#pragma unroll
        for (int r = 0; r < 4; ++r) epi(m0 + i * 16 + kq * 4 + r, n0 + r16, n0 + 16 + r16, acc[i][0][r], acc[i][1][r]);
}
struct NoMid { __device__ float operator()(int) const { return 1.f; } };

#define NV_TILE() const int w = threadIdx.x >> 6, m0 = blockIdx.y * 64 + (w >> 1) * 32, n0 = blockIdx.x * 64 + (w & 1) * 32

__global__ void k_g1(const bf16_t* XB, const bf16_t* WT, const float* rstd, bf16_t* QKVU) {
    NV_TILE();
    wave_gemm(m0, n0, D, -1, [=](int r) { return XB + (size_t)r * D; }, [=](int c) { return WT + (size_t)c * D; }, NoMid(),
        [=](int r, int c0, int c1, float v0, float v1) { const float s = rstd[r];
            v0 *= s; v1 *= s; if (c0 < SBW) v0 *= C2_SB; if (c1 < SBW) v1 *= C2_SB;
            QKVU[(size_t)r * INP + c0] = (bf16_t)f2bf(v0); QKVU[(size_t)r * INP + c1] = (bf16_t)f2bf(v1); });
}
__global__ void k_g1b(const bf16_t* MEMB, const bf16_t* WT, const float* rstd, bf16_t* KM, bf16_t* VMT) {
    NV_TILE();
    wave_gemm(m0, n0, D, -1, [=](int r) { return MEMB + (size_t)r * D; }, [=](int c) { return WT + (size_t)c * D; }, NoMid(),
        [=](int r, int c0, int c1, float v0, float v1) { const float s = rstd[r]; const int cc[2] = {c0, c1}; const float vv[2] = {v0 * s, v1 * s};
#pragma unroll
            for (int q = 0; q < 2; ++q) { const int c = cc[q];
                if (c < D) KM[(size_t)r * D + c] = (bf16_t)f2bf(vv[q]);
                else VMT[((size_t)(r >> 8) * D + (c - D)) * NMEM + (r & 255)] = (bf16_t)f2bf(vv[q]); } });
}
__global__ void __launch_bounds__(256) k_sb(const bf16_t* QKVU, bf16_t* MIXED, float* SSQSB) {
    const int gid = blockIdx.x * 256 + threadIdx.x; const int t = gid & (S - 1), h = (gid >> 12) & 7, b = gid >> 15;
    const bf16_t* base = QKVU + (size_t)b * S * INP;
    float q[HD], o[HD];
    { const bf16_t* qp = base + (size_t)t * INP + h * HD;
#pragma unroll
      for (int d = 0; d < HD; ++d) { q[d] = bf2f(qp[d]); o[d] = 0.f; } }
    float P = 1.f;
    for (int s = t - 1; s >= 0; --s) {
        const bf16_t* kp = base + (size_t)s * INP + SBW + h * HD; const bf16_t* vp = kp + SBW;
        float z = 0.f;
#pragma unroll
        for (int d = 0; d < HD; ++d) z += q[d] * bf2f(kp[d]);
        const float e = exp2f(z), r = 1.0f / (1.0f + e), beta = 1.0f - r;
        const float w = bf2f((bf16_t)f2bf(beta * P));
#pragma unroll
        for (int d = 0; d < HD; ++d) o[d] += w * bf2f(vp[d]);
        P *= r;
        if (P == 0.f) break;
    }
    float ss = 0.f; bf16_t* op = MIXED + (size_t)(b * S + t) * D + h * HD;
#pragma unroll
    for (int d = 0; d < HD; ++d) { ss += o[d] * o[d]; op[d] = (bf16_t)f2bf(o[d]); }
    unsafeAtomicAdd(SSQSB + b * S + t, ss);
}
__global__ void k_pool1(const bf16_t* QKVU, bf16_t* POOLED) {
    const size_t gid = (size_t)blockIdx.x * 256 + threadIdx.x; const int c = gid & 511; const int tok = (int)(gid >> 9), t = tok & (S - 1);
    const int win = 2 << (c >> 7); const int n = (t + 1 < win) ? t + 1 : win;
    const bf16_t* up = QKVU + (size_t)tok * INP + 3 * SBW + c; float s = 0.f;
    for (int j = 0; j < n; ++j) s += bf2f(up[-(ptrdiff_t)j * INP]);
    POOLED[gid] = (bf16_t)f2bf(s / (float)n - bf2f(up[0]));
}
__global__ void k_pool2(const bf16_t* POOLED, const bf16_t* WPT, float* POOLO) {
    NV_TILE(); const int g = blockIdx.z;
    wave_gemm(m0, n0, PGD, -1, [=](int r) { return POOLED + (size_t)r * PW + g * PGD; }, [=](int c) { return WPT + ((size_t)g * PGD + c) * PGD; }, NoMid(),
        [=](int r, int c0, int c1, float v0, float v1) { POOLO[(size_t)r * PW + g * PGD + c0] = v0; POOLO[(size_t)r * PW + g * PGD + c1] = v1; });
}
__global__ void k_pool3(const float* POOLO, bf16_t* MIXED) {
    const int tok = blockIdx.x * 4 + (threadIdx.x >> 6), lane = threadIdx.x & 63;
    float v[8], s = 0.f;
#pragma unroll
    for (int j = 0; j < 8; ++j) { v[j] = POOLO[(size_t)tok * PW + lane + 64 * j]; s += v[j] * v[j]; }
    const float rs = 1.0f / sqrtf(wave_sum(s) * (1.0f / PW) + EPS);
#pragma unroll
    for (int j = 0; j < 8; ++j) MIXED[(size_t)tok * D + SBW + lane + 64 * j] = (bf16_t)f2bf(v[j] * rs);
}
__global__ void k_resid(const bf16_t* A, const bf16_t* WT, const float* xin, float* xout, bf16_t* XB, float* SSQ, const float* ssq_mid, int kmid) {
    NV_TILE();
    wave_gemm(m0, n0, D, kmid, [=](int r) { return A + (size_t)r * D; }, [=](int c) { return WT + (size_t)c * D; },
        [=](int r) { return 1.0f / sqrtf(ssq_mid[r] * (1.0f / SBW) + EPS); },
        [=](int r, int c0, int c1, float v0, float v1) {
            const float x0 = xin[(size_t)r * D + c0] + v0, x1 = xin[(size_t)r * D + c1] + v1;
            xout[(size_t)r * D + c0] = x0; xout[(size_t)r * D + c1] = x1;
            XB[(size_t)r * D + c0] = (bf16_t)f2bf(x0); XB[(size_t)r * D + c1] = (bf16_t)f2bf(x1);
            float q = x0 * x0 + x1 * x1; q += __shfl_xor(q, 1); q += __shfl_xor(q, 2); q += __shfl_xor(q, 4); q += __shfl_xor(q, 8);
            if ((threadIdx.x & 15) == 0) unsafeAtomicAdd(SSQ + r, q); });
}
__global__ void k_g3(const bf16_t* X1B, const bf16_t* WT, const float* SSQ1, bf16_t* QM) {
    NV_TILE();
    wave_gemm(m0, n0, D, -1, [=](int r) { return X1B + (size_t)r * D; }, [=](int c) { return WT + (size_t)c * D; }, NoMid(),
        [=](int r, int c0, int c1, float v0, float v1) { const float s = C2_MEM / sqrtf(SSQ1[r] * (1.0f / D) + EPS);
            QM[(size_t)r * D + c0] = (bf16_t)f2bf(v0 * s); QM[(size_t)r * D + c1] = (bf16_t)f2bf(v1 * s); });
}
__global__ void k_ms(const bf16_t* QM, const bf16_t* KM, float* SCR) {
    NV_TILE(); const int h = blockIdx.z; const int b = m0 >> 12;
    wave_gemm(m0, n0, MHD, -1, [=](int r) { return QM + (size_t)r * D + h * MHD; }, [=](int c) { return KM + ((size_t)b * NMEM + c) * D + h * MHD; }, NoMid(),
        [=](int r, int c0, int c1, float v0, float v1) { SCR[((size_t)r * MH + h) * NMEM + c0] = v0; SCR[((size_t)r * MH + h) * NMEM + c1] = v1; });
}
__global__ void k_msoftmax(const float* SCR, bf16_t* PM) {
    const int row = blockIdx.x * 4 + (threadIdx.x >> 6), lane = threadIdx.x & 63;
    float v[4], m = -INFINITY;
#pragma unroll
    for (int j = 0; j < 4; ++j) { v[j] = SCR[(size_t)row * NMEM + lane + 64 * j]; m = fmaxf(m, v[j]); }
#pragma unroll
    for (int o = 1; o < 64; o <<= 1) m = fmaxf(m, __shfl_xor(m, o));
    float s = 0.f;
#pragma unroll
    for (int j = 0; j < 4; ++j) { v[j] = exp2f(v[j] - m); s += v[j]; }
    s = 1.0f / wave_sum(s);
#pragma unroll
    for (int j = 0; j < 4; ++j) PM[(size_t)row * NMEM + lane + 64 * j] = (bf16_t)f2bf(v[j] * s);
}
__global__ void k_mpv(const bf16_t* PM, const bf16_t* VMT, bf16_t* OM) {
    NV_TILE(); const int h = blockIdx.z; const int b = m0 >> 12;
    wave_gemm(m0, n0, NMEM, -1, [=](int r) { return PM + ((size_t)r * MH + h) * NMEM; }, [=](int c) { return VMT + ((size_t)b * D + h * MHD + c) * NMEM; }, NoMid(),
        [=](int r, int c0, int c1, float v0, float v1) { OM[(size_t)r * D + h * MHD + c0] = (bf16_t)f2bf(v0); OM[(size_t)r * D + h * MHD + c1] = (bf16_t)f2bf(v1); });
}
__global__ void k_route(const float* x2, const float* SSQ2, const float* WR, const float* br, int* CNT, int* LSLOT, float* LGATE) {
    const int tok = blockIdx.x * 4 + (threadIdx.x >> 6), lane = threadIdx.x & 63;
    float xv[16];
#pragma unroll
    for (int j = 0; j < 16; ++j) xv[j] = x2[(size_t)tok * D + lane + 64 * j];
    const float rs = 1.0f / sqrtf(SSQ2[tok] * (1.0f / D) + EPS);
    float mine = 0.f;
    for (int e = 0; e < NE; ++e) { float s = 0.f;
#pragma unroll
        for (int j = 0; j < 16; ++j) s += xv[j] * WR[e * D + lane + 64 * j];
        s = wave_sum(s); if (lane == e) mine = s * rs + br[e]; }
    float tv[4]; int ti[4]; float cur = (lane < NE) ? mine : -INFINITY;
#pragma unroll
    for (int k = 0; k < 4; ++k) { float m = cur; int mi = lane;
#pragma unroll
        for (int o = 1; o < 64; o <<= 1) { const float om = __shfl_xor(m, o); const int oi = __shfl_xor(mi, o); if (om > m || (om == m && oi < mi)) { m = om; mi = oi; } }
        tv[k] = m; ti[k] = mi; if (lane == mi) cur = -INFINITY; }
    float g[4], gs = 0.f;
#pragma unroll
    for (int k = 0; k < 4; ++k) { g[k] = expf(tv[k] - tv[0]); gs += g[k]; }
    if (lane < 4) { int e = ti[0]; float gg = g[0];
        if (lane == 1) { e = ti[1]; gg = g[1]; } if (lane == 2) { e = ti[2]; gg = g[2]; } if (lane == 3) { e = ti[3]; gg = g[3]; }
        const int pos = atomicAdd(CNT + e, 1); LSLOT[(size_t)e * LCAP + pos] = tok * 4 + lane; LGATE[(size_t)e * LCAP + pos] = gg / gs; }
}
__device__ __forceinline__ int tile_base(const int* CNT, int e) { int tb = 0; for (int i = 0; i < e; ++i) tb += (CNT[i] + 255) >> 8; return tb; }
__global__ void k_w1(const bf16_t* X2B, const float* SSQ2, const bf16_t* W1T, const float* b1, const int* CNT, const int* LSLOT, bf16_t* ACT) {
    const int e = blockIdx.z, cnt = CNT[e]; const int w = threadIdx.x >> 6; const int m0 = blockIdx.y * 64 + (w >> 1) * 32; if (blockIdx.y * 64 >= cnt) return;
    const int gc0 = blockIdx.x * 32 + (w & 1) * 16;
    const int pn = gc0 >> 7, j0 = gc0 & 127; const int n0 = pn * 256 + j0;
    const int tb = tile_base(CNT, e); const bf16_t* Wt = W1T + (size_t)e * 2 * DFF * D; const int* ls = LSLOT + (size_t)e * LCAP;
    wave_gemm(m0, 0, D, -1, [=](int r) { const int tok = (r < cnt) ? (ls[r] >> 2) : 0; return X2B + (size_t)tok * D; },
        [=](int c) { const int rowb = (c < 16) ? n0 + c : n0 + 128 + (c - 16); return Wt + (size_t)rowb * D; }, NoMid(),
        [=](int r, int c0, int c1, float vg, float vu) { if (r >= cnt) return; const int tok = ls[r] >> 2; const float rs = 1.0f / sqrtf(SSQ2[tok] * (1.0f / D) + EPS);
            const int gc = gc0 + c0;
            float gate = vg * rs + b1[e * 2 * DFF + gc], up = vu * rs + b1[e * 2 * DFF + DFF + gc];
            gate = fminf(gate, SW_LIMIT); up = fminf(fmaxf(up, -SW_LIMIT), SW_LIMIT);
            const float act = (up + 1.0f) * gate / (1.0f + expf(-SW_ALPHA * gate));
            ACT[((size_t)tb * 256 + r) * DFF + gc] = (bf16_t)f2bf(act); (void)c1; });
}
__global__ void k_w2(const bf16_t* ACT, const bf16_t* W2T, const float* b2, const int* CNT, const int* LSLOT, const float* LGATE, bf16_t* Y) {
    const int e = blockIdx.z, cnt = CNT[e]; if (blockIdx.y * 64 >= cnt) return; NV_TILE();
    const int tb = tile_base(CNT, e); const bf16_t* Wt = W2T + (size_t)e * D * DFF; const int* ls = LSLOT + (size_t)e * LCAP; const float* lg = LGATE + (size_t)e * LCAP;
    wave_gemm(m0, n0, DFF, -1, [=](int r) { return ACT + ((size_t)tb * 256 + r) * DFF; }, [=](int c) { return Wt + (size_t)c * DFF; }, NoMid(),
        [=](int r, int c0, int c1, float v0, float v1) { if (r >= cnt) return; const int slot = ls[r]; const float g = lg[r];
            Y[(size_t)slot * D + c0] = (bf16_t)f2bf((v0 + b2[e * D + c0]) * g); Y[(size_t)slot * D + c1] = (bf16_t)f2bf((v1 + b2[e * D + c1]) * g); });
}
__global__ void k_final(float* out, const bf16_t* Y, const float* gf) {
    const int tok = blockIdx.x * 4 + (threadIdx.x >> 6), lane = threadIdx.x & 63;
    float v[16], s = 0.f;
#pragma unroll
    for (int j = 0; j < 16; ++j) { const int c = lane + 64 * j; float a = out[(size_t)tok * D + c];
#pragma unroll
        for (int k = 0; k < 4; ++k) a += bf2f(Y[((size_t)tok * 4 + k) * D + c]);
        v[j] = a; s += a * a; }
    const float rs = 1.0f / sqrtf(wave_sum(s) * (1.0f / D) + EPS);
#pragma unroll
    for (int j = 0; j < 16; ++j) { const int c = lane + 64 * j; out[(size_t)tok * D + c] = v[j] * rs * gf[c]; }
}
}

#define LAS __attribute__((address_space(3)))
#define GAS __attribute__((address_space(1)))
namespace pg8 {
constexpr int BM = 256, BK = 64, HALF = 128, HTB = HALF * BK * 2, STAGE_BYTES = 8 * HTB, NXCD = 8, WGM = 8;
__host__ __device__ __forceinline__ int lds_byte(int r, int c) { const int st = (r >> 4) * 2 + (c >> 5), rr = r & 15, cc = c & 31, ob = rr * 64 + cc * 2; return st * 1024 + (ob ^ (((ob >> 9) & 1) << 5)); }
__host__ __device__ __forceinline__ void stage_rc(int b, int& R, int& C) { const int st = b / 1024, sb = b % 1024, swz = sb ^ (((sb >> 9) & 1) << 5); R = (st >> 1) * 16 + swz / 64; C = (st & 1) * 32 + (swz % 64) / 2; }
__host__ __device__ __forceinline__ int perm32(int rho) { const int n = rho >> 4, i = rho & 15; return 8 * (i >> 2) + 4 * n + (i & 3); }
__device__ __forceinline__ unsigned cvt_pk_bf16(float lo, float hi) { unsigned r; asm volatile("v_cvt_pk_bf16_f32 %0, %1, %2" : "=v"(r) : "v"(lo), "v"(hi)); return r; }

struct Unit { const char* A; const char* B; void* p0; void* p1; void* p2; void* p3; int pm, pn, i0, i1; };

__device__ __forceinline__ int xcd_remap(int L, int nwg) { const int q = nwg / NXCD, r = nwg % NXCD, xcd = L % NXCD, off = L / NXCD; return __builtin_amdgcn_readfirstlane((xcd < r ? xcd * (q + 1) : r * (q + 1) + (xcd - r) * q) + off); }
__device__ __forceinline__ void grouped_mn(int wgid, int nM, int nN, int& pm, int& pn) {
    const int nig = WGM * nN, gid = wgid / nig, fm = gid * WGM, gsz = (nM - fm) < WGM ? (nM - fm) : WGM; pm = __builtin_amdgcn_readfirstlane(fm + ((wgid % nig) % gsz)); pn = __builtin_amdgcn_readfirstlane((wgid % nig) / gsz); }

template <class Epi, class Sched, bool GATHER>
__device__ __forceinline__ void gemm_phase(const int wid, LAS unsigned char* lds, LAS unsigned char* epi_lds, LAS unsigned* gtab, const int lda_b, const int ldb_b, const int nt, const Sched& S, const Epi& E) {
    int lane_; asm volatile("v_mbcnt_lo_u32_b32 %0, -1, 0\n\tv_mbcnt_hi_u32_b32 %0, -1, %0" : "=v"(lane_));
    const int lane = lane_, tid = wid * 64 + lane, wr = wid >> 2, wc = wid & 3, fr = lane & 15, fq = lane >> 4;
    unsigned voffA[2], voffB[2], voffG[2][2]; int Rr[2]; unsigned Cb[2];
#pragma unroll
    for (int i = 0; i < 2; ++i) { int R, C; stage_rc(tid * 16, R, C); R += 64 * i; const int Rb = Epi::PERM ? ((R & ~31) + perm32(R & 31)) : R;
        voffA[i] = (unsigned)(R * lda_b + C * 2); voffB[i] = (unsigned)(Rb * ldb_b + C * 2); Rr[i] = R; Cb[i] = (unsigned)(C * 2); voffG[0][i] = 0; voffG[1][i] = 0; }
    const size_t kstep = (size_t)(BK * 2);
    const size_t hstepA = (size_t)HALF * lda_b, hstepB = (size_t)HALF * ldb_b;
    const unsigned ldsw = (unsigned)wid * 1024u;
    const int aoff = lds_byte(wr * 64 + fr, fq * 8), boff = lds_byte(wc * 32 + fr, fq * 8);
#define PG8_SA(b, h) (((b) * 2 + (h)) * HTB)
#define PG8_SB(b, h) ((4 + (b) * 2 + (h)) * HTB)
#define PG8_GLDS(gp, bufoff, _i) __builtin_amdgcn_global_load_lds((const unsigned*)(gp), (LAS unsigned*)(lds + (bufoff) + ldsw + (_i) * 8192), 16, 0, 0)
#define PG8_STAGE_B(bufoff, gbase) do { _Pragma("unroll") for (int _i = 0; _i < 2; ++_i) PG8_GLDS((const char*)(gbase) + voffB[_i], bufoff, _i); } while (0)
#define PG8_STAGE_A(bufoff, gbase, h) do { if constexpr (GATHER) { _Pragma("unroll") for (int _i = 0; _i < 2; ++_i) PG8_GLDS((const char*)(gbase) + voffG[h][_i], bufoff, _i); } \
        else { _Pragma("unroll") for (int _i = 0; _i < 2; ++_i) PG8_GLDS((const char*)(gbase) + (h) * hstepA + voffA[_i], bufoff, _i); } } while (0)
#define PG8_LDA(dst, b, h) do { _Pragma("unroll") for (int m = 0; m < 4; ++m) _Pragma("unroll") for (int k = 0; k < 2; ++k) dst[m][k] = *(const LAS bf16x8*)(lds + PG8_SA(b, h) + aoff + m * 2048 + k * 1024); } while (0)
#define PG8_LDB(dst, b, h) do { _Pragma("unroll") for (int n = 0; n < 2; ++n) _Pragma("unroll") for (int k = 0; k < 2; ++k) dst[n][k] = *(const LAS bf16x8*)(lds + PG8_SB(b, h) + boff + n * 2048 + k * 1024); } while (0)
#define PG8_MMA(ai, bj, At, Bt) do { __builtin_amdgcn_s_setprio(1); _Pragma("unroll") for (int m = 0; m < 4; ++m) _Pragma("unroll") for (int n = 0; n < 2; ++n) _Pragma("unroll") for (int k = 0; k < 2; ++k) \
        acc[ai][bj][m][n] = __builtin_amdgcn_mfma_f32_16x16x32_bf16(Bt[n][k], At[m][k], acc[ai][bj][m][n], 0, 0, 0); __builtin_amdgcn_s_setprio(0); } while (0)
#define PG8_WAIT_V(n) asm volatile("s_waitcnt vmcnt(" #n ")" ::: "memory")
#define PG8_WAIT_L(n) asm volatile("s_waitcnt lgkmcnt(" #n ")" ::: "memory")
#define PG8_BAR __builtin_amdgcn_s_barrier()
#define PG8_SCHED __builtin_amdgcn_sched_barrier(0)
#define PG8_GTAB_LOAD(buf, nvalid) do { _Pragma("unroll") for (int _h = 0; _h < 2; ++_h) _Pragma("unroll") for (int _i = 0; _i < 2; ++_i) { const int _row = _h * HALF + Rr[_i]; \
        const unsigned _s = gtab[(buf) * 256 + _row]; voffG[_h][_i] = ((_row < (nvalid)) ? (_s >> 2) * (unsigned)lda_b : 0u) + Cb[_i]; } } while (0)
#define PG8_GTAB_DMA(buf, src) do { if (wid == 0) __builtin_amdgcn_global_load_lds((const unsigned*)((const char*)(src) + lane * 16), (LAS unsigned*)(gtab + (buf) * 256), 16, 0, 0); } while (0)
    Unit cur, nxt; int ui = 0;
    if (!S.next(0, cur)) return;
    f32x4 acc[2][2][4][2];
#pragma unroll
    for (int a = 0; a < 2; ++a)
#pragma unroll
        for (int b = 0; b < 2; ++b)
#pragma unroll
            for (int m = 0; m < 4; ++m)
#pragma unroll
                for (int n = 0; n < 2; ++n) acc[a][b][m][n] = (f32x4){0.f, 0.f, 0.f, 0.f};
    bf16x8 At[4][2], B0[2][2], B1[2][2];
    const char* cA = cur.A; const char* cB = cur.B;
    if constexpr (GATHER) { PG8_GTAB_DMA(0, cur.p3); PG8_WAIT_V(0); PG8_WAIT_L(0); PG8_BAR; PG8_GTAB_LOAD(0, cur.i0); }
    PG8_STAGE_B(PG8_SB(0, 0), cB); PG8_STAGE_B(PG8_SB(0, 1), cB + hstepB); PG8_STAGE_A(PG8_SA(0, 0), cA, 0); PG8_STAGE_A(PG8_SA(0, 1), cA, 1);
    if (wr == 1) PG8_BAR;
    PG8_WAIT_V(2); PG8_BAR;
    PG8_STAGE_B(PG8_SB(1, 0), cB + kstep); PG8_STAGE_A(PG8_SA(1, 0), cA + kstep, 0); PG8_STAGE_B(PG8_SB(1, 1), cB + hstepB + kstep);
    PG8_WAIT_V(6); PG8_BAR;
    for (;;) {
        const bool has_next = S.next(ui + 1, nxt);
        const char* nA = has_next ? nxt.A : cA; const char* nB = has_next ? nxt.B : cB;
#pragma unroll 1
        for (int t = 0; t < nt; t += 2) {
            const bool last = (t == nt - 2);
            const char* a1 = cA + (size_t)(t + 1) * kstep;
            const char* a2 = last ? nA : cA + (size_t)(t + 2) * kstep; const char* b2 = last ? nB : cB + (size_t)(t + 2) * kstep;
            const char* a3 = a2 + kstep; const char* b3 = b2 + kstep;
            if constexpr (Epi::MIDK >= 0) { if (t == Epi::MIDK) E.midk(acc, cur, wr, fr); }
            if constexpr (GATHER) { if (t == 0 && has_next) PG8_GTAB_DMA((ui + 1) & 1, nxt.p3); }
            if constexpr (GATHER) { PG8_STAGE_A(PG8_SA(1, 1), a1, 1); if (last && has_next) PG8_GTAB_LOAD((ui + 1) & 1, nxt.i0); PG8_SCHED; }
            PG8_LDB(B0, 0, 0); PG8_LDB(B1, 0, 1); PG8_SCHED; PG8_LDA(At, 0, 0); if constexpr (!GATHER) PG8_STAGE_A(PG8_SA(1, 1), a1, 1);
            PG8_WAIT_V(8); PG8_WAIT_L(0); PG8_BAR; PG8_MMA(0, 0, At, B0); PG8_MMA(0, 1, At, B1); PG8_BAR; PG8_SCHED;
            PG8_LDA(At, 0, 1); PG8_STAGE_B(PG8_SB(0, 0), b2); PG8_STAGE_B(PG8_SB(0, 1), b2 + hstepB); PG8_STAGE_A(PG8_SA(0, 0), a2, 0);
            PG8_WAIT_V(8); PG8_WAIT_L(0); PG8_BAR; PG8_MMA(1, 0, At, B0); PG8_MMA(1, 1, At, B1); PG8_BAR; PG8_SCHED;
            PG8_LDB(B0, 1, 0); PG8_LDB(B1, 1, 1); PG8_SCHED; PG8_LDA(At, 1, 0); PG8_STAGE_A(PG8_SA(0, 1), a2, 1);
            PG8_WAIT_V(8); PG8_WAIT_L(0); PG8_BAR; PG8_MMA(0, 0, At, B0); PG8_MMA(0, 1, At, B1); PG8_BAR; PG8_SCHED;
            PG8_LDA(At, 1, 1); PG8_STAGE_B(PG8_SB(1, 0), b3); PG8_STAGE_B(PG8_SB(1, 1), b3 + hstepB); PG8_STAGE_A(PG8_SA(1, 0), a3, 0);
            PG8_WAIT_V(8); PG8_WAIT_L(0); PG8_BAR; PG8_MMA(1, 0, At, B0); PG8_MMA(1, 1, At, B1); PG8_BAR; PG8_SCHED;
        }
        if (wr == 0) PG8_BAR;
        E(acc, cur, wr, wc, fr, fq, wid, lane, epi_lds);
        if (!has_next) break;
#pragma unroll
        for (int a = 0; a < 2; ++a)
#pragma unroll
            for (int b = 0; b < 2; ++b)
#pragma unroll
                for (int m = 0; m < 4; ++m)
#pragma unroll
                    for (int n = 0; n < 2; ++n) acc[a][b][m][n] = (f32x4){0.f, 0.f, 0.f, 0.f};
        cur = nxt; cA = nA; cB = nB; ++ui;
        if (wr == 1) PG8_BAR;
    }
    PG8_WAIT_V(0);
    PG8_BAR;
#undef PG8_SA
#undef PG8_SB
#undef PG8_GLDS
#undef PG8_STAGE_A
#undef PG8_STAGE_B
#undef PG8_LDA
#undef PG8_LDB
#undef PG8_MMA
#undef PG8_WAIT_V
#undef PG8_WAIT_L
#undef PG8_BAR
#undef PG8_SCHED
#undef PG8_GTAB_LOAD
#undef PG8_GTAB_DMA
}

struct EpiBf16S {
    static constexpr bool PERM = true; static constexpr int MIDK = -1;
    __device__ __forceinline__ void midk(f32x4 (&)[2][2][4][2], const Unit&, int, int) const {}
    __device__ __forceinline__ void operator()(const f32x4 (&acc)[2][2][4][2], const Unit& u, int wr, int wc, int fr, int fq, int, int, LAS unsigned char*) const {
        bf16_t* O = (bf16_t*)u.p0; const float* rs = (const float*)u.p1; const float* cs = (const float*)u.p2; const int ldc = u.i0;
        int r0 = wr * 64 + fr, c0 = wc * 32 + 8 * fq; asm volatile("" : "+v"(r0), "+v"(c0));
        f32x4 cv[2][2];
#pragma unroll
        for (int bj = 0; bj < 2; ++bj)
#pragma unroll
            for (int n = 0; n < 2; ++n) cv[bj][n] = cs ? *(const f32x4*)(cs + c0 + bj * HALF + 4 * n) : (f32x4){1.f, 1.f, 1.f, 1.f};
#pragma unroll
        for (int ai = 0; ai < 2; ++ai)
#pragma unroll
            for (int m = 0; m < 4; ++m) { const int r = r0 + ai * HALF + m * 16; const float rv = rs ? rs[r] : 1.f; bf16_t* rowp = O + (size_t)r * ldc + c0;
#pragma unroll
                for (int bj = 0; bj < 2; ++bj) { const f32x4 v0 = acc[ai][bj][m][0] * cv[bj][0] * rv, v1 = acc[ai][bj][m][1] * cv[bj][1] * rv;
                    u32x4 w; w.x = cvt_pk_bf16(v0[0], v0[1]); w.y = cvt_pk_bf16(v0[2], v0[3]); w.z = cvt_pk_bf16(v1[0], v1[1]); w.w = cvt_pk_bf16(v1[2], v1[3]);
                    *(u32x4*)(rowp + bj * HALF) = w; } }
    }
};
}

namespace mk {
constexpr int NWAVES = 8, NPHASE = 12;
constexpr int RING_OFF = 0, RING_BYTES = 131072, EPI_OFF = 131072, EPI_BYTES = 8192, GTAB_OFF = EPI_OFF + EPI_BYTES, GTAB_BYTES = 2048, MISC_OFF = GTAB_OFF + GTAB_BYTES, MISC_BYTES = 1024;
constexpr int LDS_BYTES = 147456;
static_assert(MISC_OFF + MISC_BYTES <= LDS_BYTES, "LDS map");
constexpr size_t WS_CSG1 = 19 * MiB, WS_WRH = 19 * MiB + 64 * 1024, WS_WRL = 19 * MiB + 128 * 1024;
constexpr int CW_BAR = 1024;

#define RLX_AGENT __ATOMIC_RELAXED, __HIP_MEMORY_SCOPE_AGENT
#define LDS_WAIT() asm volatile("s_waitcnt lgkmcnt(0)" ::: "memory")
#define VM_WAIT() asm volatile("s_waitcnt vmcnt(0)" ::: "memory")
#define XB_TMO      128
#define XB_XCNT(j)  (256  + 64 * (j))
#define XB_XSUB(j)  (1280 + 64 * (j))
#define XB_XGEN(j)  (2304 + 64 * (j))
#define XB_TOP      3328
#define XB_TOPGEN   3392
#define XCD_BAR_WORDS 3456
#define XB_SPIN_CAP (1u << 20)
__device__ __forceinline__ unsigned xb_ld(unsigned* p)              { return __hip_atomic_load(p, __ATOMIC_RELAXED, __HIP_MEMORY_SCOPE_AGENT); }
__device__ __forceinline__ unsigned xb_add(unsigned* p, unsigned v) { return __hip_atomic_fetch_add(p, v, __ATOMIC_RELAXED, __HIP_MEMORY_SCOPE_AGENT); }
__device__ __forceinline__ unsigned xb_xcc_id() { return (unsigned)__builtin_amdgcn_s_getreg((3 << 11) | 20) & 0xFu; }
#define XB_SPIN(cond, bar) do { unsigned _sp = 0; while (cond) { __builtin_amdgcn_s_sleep(1); \
    if ((++_sp & 255u) == 0u) { if (xb_ld(&(bar)[XB_TMO])) break; if (_sp > XB_SPIN_CAP) { atomicAdd(&(bar)[XB_TMO], 1u); break; } } } } while (0)
struct XcdBarrier { unsigned* bar; unsigned x; volatile LAS unsigned* st; };
__device__ __forceinline__ XcdBarrier xcd_barrier_post(unsigned* bar, volatile LAS unsigned* st) {
    XcdBarrier b; b.bar = bar; b.x = xb_xcc_id(); b.st = st;
    if (threadIdx.x == 0) (void)xb_add(&bar[XB_XCNT(b.x)], 1u);
    return b;
}
__device__ __forceinline__ void xcd_barrier_complete(unsigned* bar, unsigned x, unsigned& nloc, unsigned& nx) {
    const unsigned G = gridDim.x * gridDim.y * gridDim.z;
    unsigned sum, cnt, mine, sp = 0u;
    for (;;) {
        sum = 0u; cnt = 0u; mine = 0u;
#pragma unroll
        for (unsigned j = 0; j < 16; ++j) { const unsigned c = xb_ld(&bar[XB_XCNT(j)]); sum += c; cnt += (c > 0u) ? 1u : 0u; mine = (j == x) ? c : mine; }
        if (sum == G) break;
        __builtin_amdgcn_s_sleep(1);
        if ((++sp & 255u) == 0u) { if (xb_ld(&bar[XB_TMO])) break; if (sp > XB_SPIN_CAP) { atomicAdd(&bar[XB_TMO], 1u); break; } }
    }
    nloc = mine > 0u ? mine : 1u; nx = cnt > 0u ? cnt : 1u;
}
__device__ __forceinline__ void xcd_barrier(const XcdBarrier& b) {
    asm volatile("s_waitcnt vmcnt(0)" ::: "memory");
    __syncthreads();
    if (threadIdx.x == 0) {
        unsigned* bar = b.bar;
        __builtin_amdgcn_s_waitcnt(0);
        unsigned nloc = b.st[0], nx = b.st[1];
        if (nloc == 0u) { xcd_barrier_complete(bar, b.x, nloc, nx); b.st[0] = nloc; b.st[1] = nx; }
        const unsigned old = xb_add(&bar[XB_XSUB(b.x)], 1u);
        const unsigned gen = old / nloc;
        if (old + 1u == (gen + 1u) * nloc) {
            __builtin_amdgcn_fence(__ATOMIC_RELEASE, "agent");
            asm volatile("s_waitcnt vmcnt(0)" ::: "memory");
            const unsigned og = xb_add(&bar[XB_TOP], 1u);
            const unsigned tg = og / nx;
            if (og + 1u == (tg + 1u) * nx) xb_add(&bar[XB_TOPGEN], 1u);
            else XB_SPIN(xb_ld(&bar[XB_TOPGEN]) == tg, bar);
            __builtin_amdgcn_fence(__ATOMIC_ACQUIRE, "agent");
            xb_add(&bar[XB_XGEN(b.x)], 1u);
            asm volatile("s_waitcnt vmcnt(0)" ::: "memory");
        } else {
            XB_SPIN(xb_ld(&bar[XB_XGEN(b.x)]) == gen, bar);
            __builtin_amdgcn_fence(__ATOMIC_ACQUIRE, "agent");
            asm volatile("s_waitcnt vmcnt(0)" ::: "memory");
        }
    }
    __syncthreads();
}

struct Args { const float* in[22]; float* out; unsigned char* ws; int ph_lo, ph_hi, li, pad; };

__device__ __forceinline__ void p0_item(const float* W, int K, int N, bf16_t* WT, const float* gk, const float* gk2, int ksplit, const float* gn, int mode, LAS float* scr, int item, int lane) {
    const int nblk = N / 32, kb = item / nblk, nb = item % nblk, k0 = 64 * kb, nd0 = 32 * nb;
    int ns0 = nd0; if (mode == 1) { const int pn = nd0 >> 8, j = nd0 & 255; ns0 = (j < 128) ? 128 * pn + j : 1024 + 128 * pn + (j - 128); }
    const float gnv = gn ? gn[ns0 + (lane & 31)] : 1.f;
#pragma unroll 8
    for (int i = 0; i < 32; ++i) { const int kk = 2 * i + (lane >> 5); const int k = k0 + kk; float v = W[(size_t)k * N + ns0 + (lane & 31)] * gnv;
        if (gk) v *= (k < ksplit) ? gk[k] : gk2[k - ksplit]; scr[kk * 33 + (lane & 31)] = v; }
    LDS_WAIT(); asm volatile("" ::: "memory");
    const int c = lane & 7;
#pragma unroll
    for (int j = 0; j < 4; ++j) { const int n = (lane >> 3) + 8 * j; const LAS float* s = scr + (8 * c) * 33 + n;
        u32x4 o; o.x = pg8::cvt_pk_bf16(s[0 * 33], s[1 * 33]); o.y = pg8::cvt_pk_bf16(s[2 * 33], s[3 * 33]); o.z = pg8::cvt_pk_bf16(s[4 * 33], s[5 * 33]); o.w = pg8::cvt_pk_bf16(s[6 * 33], s[7 * 33]);
        *(u32x4*)(WT + (size_t)(nd0 + n) * K + k0 + 8 * c) = o; }
    LDS_WAIT(); asm volatile("" ::: "memory");
}
__device__ __forceinline__ void p0_row(const float* xrow, bf16_t* orow, float* rstd, int lane) {
    const f32x4* xr = (const f32x4*)xrow + lane; f32x4 v[4]; float s = 0.f;
#pragma unroll
    for (int j = 0; j < 4; ++j) { v[j] = xr[64 * j]; s += (v[j].x * v[j].x + v[j].y * v[j].y) + (v[j].z * v[j].z + v[j].w * v[j].w); }
    s = wave_sum(s); if (lane == 0) *rstd = 1.0f / sqrtf(s * (1.0f / D) + EPS);
    unsigned long long* o8 = (unsigned long long*)orow + lane;
#pragma unroll
    for (int j = 0; j < 4; ++j) o8[64 * j] = (unsigned long long)pg8::cvt_pk_bf16(v[j].x, v[j].y) | ((unsigned long long)pg8::cvt_pk_bf16(v[j].z, v[j].w) << 32);
}
__device__ __forceinline__ void p0_prologue(const Args& a, LAS unsigned char* lds, int vcu, int G, int wave, int lane) {
    unsigned char* ws = a.ws;
    LAS float* scr = (LAS float*)(lds + RING_OFF + wave * 16384);
    const int gw = vcu * NWAVES + wave, NGW = G * NWAVES;
    constexpr int I_E1 = (D / 64) * (2 * DFF / 32), I_E2 = (DFF / 64) * (D / 32);
    constexpr int I_IN = (D / 64) * (INP / 32), I_SQ = (D / 64) * (D / 32), I_KV = (D / 64) * (2 * D / 32), I_P = (PGD / 64) * (PGD / 32);
    constexpr int N1 = NE * I_E1, N2 = NE * I_E2, NITEMS = N1 + N2 + I_IN + 3 * I_SQ + I_KV + PG * I_P;
    const int BIG = 1 << 30;
    for (int it = gw; it < NITEMS; it += NGW) {
        int r = it;
        if (r < N1) { const int e = r / I_E1; p0_item(a.in[17] + (size_t)e * D * 2 * DFF, D, 2 * DFF, (bf16_t*)(ws + WS_W1) + (size_t)e * 2 * DFF * D, a.in[14], nullptr, BIG, nullptr, 1, scr, r % I_E1, lane); continue; } r -= N1;
        if (r < N2) { const int e = r / I_E2; p0_item(a.in[19] + (size_t)e * DFF * D, DFF, D, (bf16_t*)(ws + WS_W2) + (size_t)e * D * DFF, nullptr, nullptr, BIG, nullptr, 0, scr, r % I_E2, lane); continue; } r -= N2;
        if (r < I_IN) { p0_item(a.in[3], D, INP, (bf16_t*)(ws + WS_WIN), a.in[2], nullptr, BIG, nullptr, 0, scr, r, lane); continue; } r -= I_IN;
        if (r < I_SQ) { p0_item(a.in[8], D, D, (bf16_t*)(ws + WS_WOUT), a.in[4], a.in[5], SBW, nullptr, 0, scr, r, lane); continue; } r -= I_SQ;
        if (r < I_SQ) { p0_item(a.in[11], D, D, (bf16_t*)(ws + WS_WQ), a.in[9], nullptr, BIG, nullptr, 0, scr, r, lane); continue; } r -= I_SQ;
        if (r < I_KV) { p0_item(a.in[12], D, 2 * D, (bf16_t*)(ws + WS_WKV), a.in[10], nullptr, BIG, nullptr, 0, scr, r, lane); continue; } r -= I_KV;
        if (r < I_SQ) { p0_item(a.in[13], D, D, (bf16_t*)(ws + WS_WO), nullptr, nullptr, BIG, nullptr, 0, scr, r, lane); continue; } r -= I_SQ;
        { const int g = r / I_P; p0_item(a.in[6] + (size_t)g * PGD * PGD, PGD, PGD, (bf16_t*)(ws + WS_WP) + (size_t)g * PGD * PGD, nullptr, nullptr, BIG, a.in[7] + g * PGD, 0, scr, r % I_P, lane); }
    }
    for (int m = gw; m < NTOK; m += NGW) p0_row(a.in[0] + (size_t)m * D, (bf16_t*)(ws + WS_S0) + (size_t)m * D, (float*)(ws + WS_RSTDX) + m, lane);
    for (int m = gw; m < NMROWS; m += NGW) p0_row(a.in[1] + (size_t)m * D, (bf16_t*)(ws + WS_MEMB) + (size_t)m * D, (float*)(ws + WS_RSTDM) + m, lane);
    const int gt = gw * 64 + lane, NGT = NGW * 64;
    for (int i = gt; i < INP; i += NGT) ((float*)(ws + WS_CSG1))[i] = (i < SBW) ? C2_SB : 1.0f;
    for (int i = gt; i < NE * D; i += NGT) { const int e = i / D, k = i % D; const float v = a.in[14][k] * a.in[15][k * NE + e];
        ((float*)(ws + WS_WR))[i] = v; const unsigned h = f2bf(v); ((bf16_t*)(ws + WS_WRH))[i] = (bf16_t)h; ((bf16_t*)(ws + WS_WRL))[i] = (bf16_t)f2bf(v - bf2f((bf16_t)h)); }
}

struct SchedP1 {
    int G, c; unsigned char* ws;
    __device__ __forceinline__ bool next(int i, pg8::Unit& u) const {
        const int L = i * G + c; constexpr int NQ = (NTOK / 256) * (INP / 256);
        if (L >= NQ + 64) return false;
        if (L < NQ) { int pm, pn; pg8::grouped_mn(pg8::xcd_remap(L, NQ), NTOK / 256, INP / 256, pm, pn);
            u.A = (const char*)(ws + WS_S0) + (size_t)pm * 256 * D * 2; u.B = (const char*)(ws + WS_WIN) + (size_t)pn * 256 * D * 2;
            u.p0 = (bf16_t*)(ws + WS_QKVU) + (size_t)pm * 256 * INP + pn * 256; u.p1 = (float*)(ws + WS_RSTDX) + pm * 256; u.p2 = (float*)(ws + WS_CSG1) + pn * 256; u.i0 = INP; u.pm = pm; u.pn = pn; }
        else if (L < NQ + 32) { const int k = L - NQ, pm = k >> 2, pn = k & 3;
            u.A = (const char*)(ws + WS_MEMB) + (size_t)pm * 256 * D * 2; u.B = (const char*)(ws + WS_WKV) + (size_t)pn * 256 * D * 2;
            u.p0 = (bf16_t*)(ws + WS_KM) + (size_t)pm * 256 * D + pn * 256; u.p1 = (float*)(ws + WS_RSTDM) + pm * 256; u.p2 = nullptr; u.i0 = D; u.pm = pm; u.pn = pn; }
        else { const int v = L - NQ - 32, b = v >> 2, dt = v & 3;
            u.A = (const char*)(ws + WS_WKV) + (size_t)(D + dt * 256) * D * 2; u.B = (const char*)(ws + WS_MEMB) + (size_t)b * 256 * D * 2;
            u.p0 = (bf16_t*)(ws + WS_VMT) + ((size_t)b * D + dt * 256) * NMEM; u.p1 = nullptr; u.p2 = (float*)(ws + WS_RSTDM) + b * 256; u.i0 = NMEM; u.pm = dt; u.pn = b; }
        u.p3 = nullptr; u.i1 = 0; return true;
    }
};
#define EPI_BAR() asm volatile("s_waitcnt lgkmcnt(0)\n\ts_barrier" ::: "memory")
struct SchedReg {
    int G, c, nM, nN; const char* A; const char* B; size_t astep, bstep; bf16_t* O; int ldc; const float* rs; const float* cs;
    __device__ __forceinline__ bool next(int i, pg8::Unit& u) const {
        const int L = i * G + c; if (L >= nM * nN) return false; int pm, pn; pg8::grouped_mn(pg8::xcd_remap(L, nM * nN), nM, nN, pm, pn);
        u.A = A + (size_t)pm * astep; u.B = B + (size_t)pn * bstep; u.pm = pm; u.pn = pn; u.i0 = ldc; u.i1 = 0;
        u.p0 = O ? (void*)(O + (size_t)pm * 256 * ldc + pn * 256) : nullptr; u.p1 = rs ? (void*)(rs + pm * 256) : nullptr; u.p2 = cs ? (void*)(cs + pn * 256) : nullptr; u.p3 = nullptr; return true;
    }
};
struct EpiBf16Ssq {
    static constexpr bool PERM = true; static constexpr int MIDK = -1; float inv_n, mult;
    __device__ __forceinline__ void midk(f32x4 (&)[2][2][4][2], const pg8::Unit&, int, int) const {}
    __device__ __forceinline__ void operator()(f32x4 (&acc)[2][2][4][2], const pg8::Unit& u, int wr, int wc, int fr, int fq, int, int, LAS unsigned char*) const {
        bf16_t* O = (bf16_t*)u.p0; const float* sq = (const float*)u.p1; const int ldc = u.i0; int r0 = wr * 64 + fr, c0 = wc * 32 + 8 * fq; asm volatile("" : "+v"(r0), "+v"(c0));
#pragma unroll
        for (int ai = 0; ai < 2; ++ai)
#pragma unroll
            for (int m = 0; m < 4; ++m) { const int r = r0 + ai * 128 + m * 16; const float rv = mult / sqrtf(sq[r] * inv_n + EPS); bf16_t* rowp = O + (size_t)r * ldc + c0;
#pragma unroll
                for (int bj = 0; bj < 2; ++bj) { const f32x4 v0 = acc[ai][bj][m][0] * rv, v1 = acc[ai][bj][m][1] * rv;
                    u32x4 w; w.x = pg8::cvt_pk_bf16(v0[0], v0[1]); w.y = pg8::cvt_pk_bf16(v0[2], v0[3]); w.z = pg8::cvt_pk_bf16(v1[0], v1[1]); w.w = pg8::cvt_pk_bf16(v1[2], v1[3]);
                    *(u32x4*)(rowp + bj * 128) = w; } }
    }
};
template <int MIDK_> struct EpiResid {
    static constexpr bool PERM = false; static constexpr int MIDK = MIDK_;
    const float* xin; float* xout; bf16_t* xb; float* ssq; const float* ssq_mid;
    __device__ __forceinline__ void midk(f32x4 (&acc)[2][2][4][2], const pg8::Unit& u, int wr, int fr) const {
#pragma unroll
        for (int ai = 0; ai < 2; ++ai)
#pragma unroll
            for (int m = 0; m < 4; ++m) { const int r = u.pm * 256 + ai * 128 + wr * 64 + m * 16 + fr; const float s = 1.0f / sqrtf(ssq_mid[r] * (1.0f / SBW) + EPS);
#pragma unroll
                for (int bj = 0; bj < 2; ++bj)
#pragma unroll
                    for (int n = 0; n < 2; ++n) acc[ai][bj][m][n] *= s; }
    }
    __device__ __forceinline__ void operator()(f32x4 (&acc)[2][2][4][2], const pg8::Unit& u, int wr, int wc, int fr, int fq, int, int, LAS unsigned char*) const {
        int row0 = u.pm * 256 + wr * 64 + fr, col0 = u.pn * 256 + wc * 32 + 4 * fq; asm volatile("" : "+v"(row0), "+v"(col0));
#pragma unroll
        for (int ai = 0; ai < 2; ++ai)
#pragma unroll
            for (int m = 0; m < 4; ++m) { const int r = row0 + ai * 128 + m * 16; const size_t off = (size_t)r * D + col0; float q = 0.f;
#pragma unroll
                for (int bj = 0; bj < 2; ++bj)
#pragma unroll
                    for (int n = 0; n < 2; ++n) { const size_t o2 = off + bj * 128 + n * 16; const f32x4 o = *(const f32x4*)(xin + o2) + acc[ai][bj][m][n];
                        *(f32x4*)(xout + o2) = o; q += (o[0] * o[0] + o[1] * o[1]) + (o[2] * o[2] + o[3] * o[3]);
                        *(unsigned long long*)(xb + o2) = (unsigned long long)pg8::cvt_pk_bf16(o[0], o[1]) | ((unsigned long long)pg8::cvt_pk_bf16(o[2], o[3]) << 32); }
                q += __shfl_xor(q, 16); q += __shfl_xor(q, 32);
                if (fq == 0) unsafeAtomicAdd(ssq + r, q);
                if (m & 1) asm volatile("" ::: "memory"); }
    }
};
struct SchedMS {
    int G, c; unsigned char* ws;
    __device__ __forceinline__ bool next(int i, pg8::Unit& u) const {
        const int L = i * G + c; constexpr int NU = (NTOK / 256) * MH; if (L >= NU) return false; const int w = pg8::xcd_remap(L, NU), pm = w >> 2, h = w & 3, b = pm >> 4;
        u.A = (const char*)(ws + WS_QM) + ((size_t)pm * 256 * D + h * MHD) * 2; u.B = (const char*)(ws + WS_KM) + ((size_t)b * NMEM * D + h * MHD) * 2;
        u.p0 = (bf16_t*)(ws + WS_PM) + (size_t)pm * 256 * D + h * NMEM; u.p1 = nullptr; u.p2 = nullptr; u.p3 = nullptr; u.i0 = D; u.i1 = 0; u.pm = pm; u.pn = h; return true;
    }
};
struct EpiSoftmax {
    static constexpr bool PERM = true; static constexpr int MIDK = -1;
    __device__ __forceinline__ void midk(f32x4 (&)[2][2][4][2], const pg8::Unit&, int, int) const {}
    __device__ __forceinline__ void operator()(f32x4 (&acc)[2][2][4][2], const pg8::Unit& u, int wr, int wc, int fr, int fq, int, int, LAS unsigned char* xl) const {
        typedef float f32x2v __attribute__((ext_vector_type(2)));
        LAS f32x2v* X = (LAS f32x2v*)xl;
        float ml[2][4];
#pragma unroll
        for (int ai = 0; ai < 2; ++ai)
#pragma unroll
            for (int m = 0; m < 4; ++m) { float mx = -INFINITY;
#pragma unroll
                for (int bj = 0; bj < 2; ++bj)
#pragma unroll
                    for (int n = 0; n < 2; ++n) { const f32x4 v = acc[ai][bj][m][n]; mx = fmaxf(fmaxf(mx, fmaxf(v[0], v[1])), fmaxf(v[2], v[3])); }
                mx = fmaxf(mx, __shfl_xor(mx, 16)); mx = fmaxf(mx, __shfl_xor(mx, 32)); ml[ai][m] = mx; float s = 0.f;
#pragma unroll
                for (int bj = 0; bj < 2; ++bj)
#pragma unroll
                    for (int n = 0; n < 2; ++n) { f32x4 v = acc[ai][bj][m][n];
#pragma unroll
                        for (int j = 0; j < 4; ++j) { v[j] = __builtin_amdgcn_exp2f(v[j] - mx); s += v[j]; }
                        acc[ai][bj][m][n] = v; }
                s += __shfl_xor(s, 16); s += __shfl_xor(s, 32);
                if (fq == 0) X[(ai * 128 + wr * 64 + m * 16 + fr) * 4 + wc] = (f32x2v){mx, s}; }
        EPI_BAR();
        bf16_t* O = (bf16_t*)u.p0; const int ldc = u.i0; int r0 = wr * 64 + fr, c0 = wc * 32 + 8 * fq; asm volatile("" : "+v"(r0), "+v"(c0));
#pragma unroll
        for (int ai = 0; ai < 2; ++ai)
#pragma unroll
            for (int m = 0; m < 4; ++m) { const int r = r0 + ai * 128 + m * 16; const f32x2v a = X[r * 4 + 0], b = X[r * 4 + 1], c = X[r * 4 + 2], d = X[r * 4 + 3];
                const float M = fmaxf(fmaxf(a.x, b.x), fmaxf(c.x, d.x));
                const float tot = a.y * __builtin_amdgcn_exp2f(a.x - M) + b.y * __builtin_amdgcn_exp2f(b.x - M) + c.y * __builtin_amdgcn_exp2f(c.x - M) + d.y * __builtin_amdgcn_exp2f(d.x - M);
                const float f = __builtin_amdgcn_exp2f(ml[ai][m] - M) / tot; bf16_t* rowp = O + (size_t)r * ldc + c0;
#pragma unroll
                for (int bj = 0; bj < 2; ++bj) { const f32x4 v0 = acc[ai][bj][m][0] * f, v1 = acc[ai][bj][m][1] * f;
                    u32x4 w; w.x = pg8::cvt_pk_bf16(v0[0], v0[1]); w.y = pg8::cvt_pk_bf16(v0[2], v0[3]); w.z = pg8::cvt_pk_bf16(v1[0], v1[1]); w.w = pg8::cvt_pk_bf16(v1[2], v1[3]);
                    *(u32x4*)(rowp + bj * 128) = w; } }
    }
};
struct SchedPV {
    int G, c; unsigned char* ws;
    __device__ __forceinline__ bool next(int i, pg8::Unit& u) const {
        const int L = i * G + c; constexpr int NU = (NTOK / 256) * MH; if (L >= NU) return false; const int w = pg8::xcd_remap(L, NU), pm = w >> 2, h = w & 3, b = pm >> 4;
        u.A = (const char*)(ws + WS_PM) + ((size_t)pm * 256 * D + h * NMEM) * 2; u.B = (const char*)(ws + WS_VMT) + ((size_t)b * D + h * MHD) * NMEM * 2;
        u.p0 = (bf16_t*)(ws + WS_OM) + (size_t)pm * 256 * D + h * MHD; u.p1 = nullptr; u.p2 = nullptr; u.p3 = nullptr; u.i0 = D; u.i1 = 0; u.pm = pm; u.pn = h; return true;
    }
};

__device__ __forceinline__ void p8_route(const Args& a, LAS unsigned char* lds, int bx, int G, int wave, int lane) {
    unsigned char* ws = a.ws; const float* x2 = a.out; const float* SSQ2 = (const float*)(ws + OFF_SSQ2); const float* br = a.in[16];
    const bf16_t* WRH = (const bf16_t*)(ws + WS_WRH); const bf16_t* WRL = (const bf16_t*)(ws + WS_WRL);
    int* CNT = (int*)(ws + OFF_CNT); int* LSLOT = (int*)(ws + WS_LSLOT); float* LGATE = (float*)(ws + WS_LGATE);
    LAS float* LG = (LAS float*)(lds + RING_OFF) + wave * 16 * 33;
    LAS int* hist = (LAS int*)(lds + RING_OFF + 32768); LAS int* base = hist + 32;
    const int tid = wave * 64 + lane;
    for (int t0 = bx * 128; t0 < NTOK; t0 += G * 128) {
        if (tid < 32) hist[tid] = 0;
        const int r16 = lane & 15, kq = lane >> 4; const int trow = t0 + wave * 16 + r16;
        const float* xp = x2 + (size_t)trow * D + kq * 8;
        f32x4 acc[2] = {(f32x4){0.f, 0.f, 0.f, 0.f}, (f32x4){0.f, 0.f, 0.f, 0.f}};
#pragma unroll 4
        for (int ks = 0; ks < 32; ++ks) {
            const f32x4 xa = *(const f32x4*)(xp + ks * 32), xc = *(const f32x4*)(xp + ks * 32 + 4);
            bf16x8 ah, al;
#pragma unroll
            for (int j = 0; j < 8; ++j) { const float v = (j < 4) ? xa[j] : xc[j - 4]; const unsigned h = f2bf(v); ah[j] = (short)h; al[j] = (short)f2bf(v - bf2f((bf16_t)h)); }
#pragma unroll
            for (int nb = 0; nb < 2; ++nb) { const size_t wo = (size_t)(nb * 16 + r16) * D + ks * 32 + kq * 8;
                const bf16x8 bh = *(const bf16x8*)(WRH + wo), bl = *(const bf16x8*)(WRL + wo);
                acc[nb] = __builtin_amdgcn_mfma_f32_16x16x32_bf16(ah, bh, acc[nb], 0, 0, 0);
                acc[nb] = __builtin_amdgcn_mfma_f32_16x16x32_bf16(al, bh, acc[nb], 0, 0, 0);
                acc[nb] = __builtin_amdgcn_mfma_f32_16x16x32_bf16(ah, bl, acc[nb], 0, 0, 0); }
        }
#pragma unroll
        for (int nb = 0; nb < 2; ++nb)
#pragma unroll
            for (int r = 0; r < 4; ++r) { const int tl = kq * 4 + r; const int tk = t0 + wave * 16 + tl; const float rs = 1.0f / sqrtf(SSQ2[tk] * (1.0f / D) + EPS);
                LG[tl * 33 + nb * 16 + r16] = acc[nb][r] * rs + br[nb * 16 + r16]; }
        LDS_WAIT(); __syncthreads();
        int te[4] = {0, 0, 0, 0}; float tg[4] = {0.f, 0.f, 0.f, 0.f}; int rk[4] = {0, 0, 0, 0};
        if (lane < 16) {
            float tv[4] = {-INFINITY, -INFINITY, -INFINITY, -INFINITY};
            for (int e = 0; e < NE; ++e) { const float v = LG[lane * 33 + e];
                if (v > tv[3]) { if (v > tv[2]) { tv[3] = tv[2]; te[3] = te[2]; if (v > tv[1]) { tv[2] = tv[1]; te[2] = te[1]; if (v > tv[0]) { tv[1] = tv[0]; te[1] = te[0]; tv[0] = v; te[0] = e; } else { tv[1] = v; te[1] = e; } } else { tv[2] = v; te[2] = e; } } else { tv[3] = v; te[3] = e; } } }
            float gs = 0.f;
#pragma unroll
            for (int k = 0; k < 4; ++k) { tg[k] = __expf(tv[k] - tv[0]); gs += tg[k]; }
            gs = 1.0f / gs;
#pragma unroll
            for (int k = 0; k < 4; ++k) { tg[k] *= gs; rk[k] = __hip_atomic_fetch_add(hist + te[k], 1, __ATOMIC_RELAXED, __HIP_MEMORY_SCOPE_WORKGROUP); }
        }
        LDS_WAIT(); __syncthreads();
        if (tid < 32) { const int n = hist[tid]; base[tid] = n ? atomicAdd(CNT + tid, n) : 0; }
        LDS_WAIT(); __syncthreads();
        if (lane < 16) { const int tk = t0 + wave * 16 + lane;
#pragma unroll
            for (int k = 0; k < 4; ++k) { const size_t p = (size_t)te[k] * LCAP + base[te[k]] + rk[k]; LSLOT[p] = tk * 4 + k; LGATE[p] = tg[k]; } }
        LDS_WAIT(); __syncthreads();
    }
}

__device__ __forceinline__ void moe_table(const Args& a, volatile LAS unsigned* MISC, int tid) {
    const int* CNT = (const int*)(a.ws + OFF_CNT);
    if (tid < 32) MISC[16 + tid] = (unsigned)CNT[tid];
    LDS_WAIT(); __syncthreads();
    if (tid == 0) { unsigned tb = 0; for (int e = 0; e < NE; ++e) { MISC[48 + e] = tb; tb += (MISC[16 + e] + 255u) >> 8; } MISC[48 + NE] = tb; }
    LDS_WAIT(); __syncthreads();
}
template <int NPN, bool W1> struct SchedMoE {
    int G, c; unsigned char* ws; volatile LAS unsigned* MISC;
    __device__ __forceinline__ bool next(int i, pg8::Unit& u) const {
        const int T = __builtin_amdgcn_readfirstlane((int)MISC[48 + NE]); const int NU = T * NPN; const int L = i * G + c; if (L >= NU) return false;
        const int w = pg8::xcd_remap(L, NU);
        int e = 0;
#pragma unroll
        for (int s = 16; s >= 1; s >>= 1) { if ((int)MISC[48 + e + s] * NPN <= w) e += s; }
        e = __builtin_amdgcn_readfirstlane(e);
        const int tb = __builtin_amdgcn_readfirstlane((int)MISC[48 + e]), cnt = __builtin_amdgcn_readfirstlane((int)MISC[16 + e]), nte = (cnt + 255) >> 8; const int idx = w - tb * NPN, pn = __builtin_amdgcn_readfirstlane(idx / nte), mt = idx - pn * nte;
        u.pm = tb + mt; u.pn = pn; u.i1 = e; const int nv = cnt - mt * 256; u.i0 = nv < 256 ? nv : 256;
        u.p3 = (int*)(ws + WS_LSLOT) + (size_t)e * LCAP + mt * 256; u.p2 = (float*)(ws + WS_LGATE) + (size_t)e * LCAP + mt * 256; u.p0 = nullptr; u.p1 = nullptr;
        if (W1) { u.A = (const char*)(ws + WS_S0); u.B = (const char*)(ws + WS_W1) + ((size_t)e * 2 * DFF + pn * 256) * D * 2; }
        else { u.A = (const char*)(ws + WS_ACT) + (size_t)(tb + mt) * 256 * DFF * 2; u.B = (const char*)(ws + WS_W2) + ((size_t)e * D + pn * 256) * DFF * 2; }
        return true;
    }
};
struct EpiSwiGLU {
    static constexpr bool PERM = true; static constexpr int MIDK = -1; const float* ssq2; const float* b1; bf16_t* act;
    __device__ __forceinline__ void midk(f32x4 (&)[2][2][4][2], const pg8::Unit&, int, int) const {}
    __device__ __forceinline__ void operator()(f32x4 (&acc)[2][2][4][2], const pg8::Unit& u, int wr, int wc, int fr, int fq, int, int, LAS unsigned char*) const {
        const int e = u.i1, nvalid = u.i0; const int* slots = (const int*)u.p3; int r0 = wr * 64 + fr, c0 = wc * 32 + 8 * fq; asm volatile("" : "+v"(r0), "+v"(c0));     const int gc0 = u.pn * 128 + c0;
        f32x4 bg[2], bu[2];
#pragma unroll
        for (int n = 0; n < 2; ++n) { bg[n] = *(const f32x4*)(b1 + (size_t)e * 2 * DFF + gc0 + 4 * n); bu[n] = *(const f32x4*)(b1 + (size_t)e * 2 * DFF + DFF + gc0 + 4 * n); }
#pragma unroll
        for (int ai = 0; ai < 2; ++ai)
#pragma unroll
            for (int m = 0; m < 4; ++m) { const int r = r0 + ai * 128 + m * 16; const bool valid = r < nvalid; const int tok = valid ? (slots[r] >> 2) : 0;
                const float rs = 1.0f / sqrtf(ssq2[tok] * (1.0f / D) + EPS); unsigned wv[4];
#pragma unroll
                for (int n = 0; n < 2; ++n) { float o[4];
#pragma unroll
                    for (int j = 0; j < 4; ++j) { float g = acc[ai][0][m][n][j] * rs + bg[n][j], up = acc[ai][1][m][n][j] * rs + bu[n][j];
                        g = fminf(g, SW_LIMIT); up = fminf(fmaxf(up, -SW_LIMIT), SW_LIMIT);
                        o[j] = (up + 1.0f) * g * __builtin_amdgcn_rcpf(1.0f + __builtin_amdgcn_exp2f(-SW_ALPHA * LOG2E * g)); }
                    wv[2 * n] = pg8::cvt_pk_bf16(o[0], o[1]); wv[2 * n + 1] = pg8::cvt_pk_bf16(o[2], o[3]); }
                if (valid) *(u32x4*)(act + ((size_t)u.pm * 256 + r) * DFF + gc0) = (u32x4){wv[0], wv[1], wv[2], wv[3]}; }
    }
};
struct EpiW2 {
    static constexpr bool PERM = true; static constexpr int MIDK = -1; const float* b2; bf16_t* Y;
    __device__ __forceinline__ void midk(f32x4 (&)[2][2][4][2], const pg8::Unit&, int, int) const {}
    __device__ __forceinline__ void operator()(f32x4 (&acc)[2][2][4][2], const pg8::Unit& u, int wr, int wc, int fr, int fq, int, int, LAS unsigned char*) const {
        const int e = u.i1, nvalid = u.i0; const int* slots = (const int*)u.p3; const float* gates = (const float*)u.p2; int r0 = wr * 64 + fr, c0 = u.pn * 256 + wc * 32 + 8 * fq; asm volatile("" : "+v"(r0), "+v"(c0));
        f32x4 bv[2][2];
#pragma unroll
        for (int bj = 0; bj < 2; ++bj)
#pragma unroll
            for (int n = 0; n < 2; ++n) bv[bj][n] = *(const f32x4*)(b2 + (size_t)e * D + c0 + bj * 128 + 4 * n);
#pragma unroll
        for (int ai = 0; ai < 2; ++ai)
#pragma unroll
            for (int m = 0; m < 4; ++m) { const int r = r0 + ai * 128 + m * 16; const bool valid = r < nvalid; const int slot = valid ? slots[r] : 0; const float g = valid ? gates[r] : 0.f;
#pragma unroll
                for (int bj = 0; bj < 2; ++bj) { const f32x4 v0 = (acc[ai][bj][m][0] + bv[bj][0]) * g, v1 = (acc[ai][bj][m][1] + bv[bj][1]) * g;
                    u32x4 w; w.x = pg8::cvt_pk_bf16(v0[0], v0[1]); w.y = pg8::cvt_pk_bf16(v0[2], v0[3]); w.z = pg8::cvt_pk_bf16(v1[0], v1[1]); w.w = pg8::cvt_pk_bf16(v1[2], v1[3]);
                    if (valid) *(u32x4*)(Y + (size_t)slot * D + c0 + bj * 128) = w; } }
    }
};

__device__ __forceinline__ void p11_final(const Args& a, int vcu, int G, int wave, int lane) {
    float* out = a.out; const bf16_t* Y = (const bf16_t*)(a.ws + WS_Y); const float* gf = a.in[21];
    const int gw = vcu * NWAVES + wave, NGW = G * NWAVES;
    f32x4 g4[4];
#pragma unroll
    for (int j = 0; j < 4; ++j) g4[j] = *(const f32x4*)(gf + 4 * lane + 256 * j);
    for (int tok = gw; tok < NTOK; tok += NGW) {
        f32x4 v[4]; float s = 0.f;
#pragma unroll
        for (int j = 0; j < 4; ++j) { v[j] = *(const f32x4*)(out + (size_t)tok * D + 4 * lane + 256 * j);
#pragma unroll
            for (int k = 0; k < 4; ++k) { const unsigned long long w = *(const unsigned long long*)(Y + ((size_t)tok * 4 + k) * D + 4 * lane + 256 * j);
                v[j][0] += __builtin_bit_cast(float, (unsigned)(w << 16)); v[j][1] += __builtin_bit_cast(float, (unsigned)w & 0xffff0000u);
                v[j][2] += __builtin_bit_cast(float, (unsigned)(w >> 32) << 16); v[j][3] += __builtin_bit_cast(float, (unsigned)(w >> 32) & 0xffff0000u); }
            s += (v[j][0] * v[j][0] + v[j][1] * v[j][1]) + (v[j][2] * v[j][2] + v[j][3] * v[j][3]); }
        const float rs = 1.0f / sqrtf(wave_sum(s) * (1.0f / D) + EPS);
#pragma unroll
        for (int j = 0; j < 4; ++j) *(f32x4*)(out + (size_t)tok * D + 4 * lane + 256 * j) = v[j] * rs * g4[j];
    }
}
constexpr size_t BAR_REGION_OFF = 1 * MiB, BAR_REGION_STRIDE = 16 * 1024;
__global__ void __launch_bounds__(NWAVES * 64, 2) mega(Args args) {
    const int li = args.li;
    extern __shared__ __attribute__((aligned(16))) unsigned char lds_raw[];
    LAS unsigned char* lds = (LAS unsigned char*)lds_raw;
    volatile LAS unsigned* MISC = (volatile LAS unsigned*)(lds + MISC_OFF);
    const int wave = __builtin_amdgcn_readfirstlane((int)threadIdx.x >> 6);
#define LANE_ID() ({ int l_; asm volatile("v_mbcnt_lo_u32_b32 %0, -1, 0\n\tv_mbcnt_hi_u32_b32 %0, -1, %0" : "=v"(l_)); l_; })
    const int G = gridDim.x; const int bx = blockIdx.x; const int vcu = (G % 8 == 0) ? (bx % 8) * (G / 8) + bx / 8 : bx;
    for (int u = wave * 64 + LANE_ID(); u < MISC_BYTES / 4; u += NWAVES * 64) MISC[u] = 0u;
    __syncthreads();
    unsigned char* ws = args.ws;
    XcdBarrier bar = xcd_barrier_post((unsigned*)(ws + BAR_REGION_OFF + (size_t)li * BAR_REGION_STRIDE), MISC + 8);
    const int lo = args.ph_lo, hi = args.ph_hi;
    LAS unsigned char* ring = lds + RING_OFF; LAS unsigned char* epi = lds + EPI_OFF; LAS unsigned* gtab = (LAS unsigned*)(lds + GTAB_OFF);
#define IN(k) (lo <= (k) && (k) < hi)
#define SEAM(k) do { if (IN(k) && IN((k) + 1)) xcd_barrier(bar); } while (0)
    if (IN(0)) { p0_prologue(args, lds, vcu, G, wave, LANE_ID()); SEAM(0); }
    if (IN(1)) { SchedP1 S{G, bx, ws}; pg8::EpiBf16S E; pg8::gemm_phase<pg8::EpiBf16S, SchedP1, false>(wave, ring, epi, gtab, D * 2, D * 2, D / 64, S, E); SEAM(1); }
    {
    const float* xin0 = args.in[0]; float* outp = args.out;
    bf16_t* S0p = (bf16_t*)(ws + WS_S0); float* SSQSBp = (float*)(ws + OFF_SSQSB); float* SSQ1p = (float*)(ws + OFF_SSQ1); float* SSQ2p = (float*)(ws + OFF_SSQ2);
    constexpr size_t TSTEP = (size_t)256 * D * 2;

#if !defined(PH_ONLY) || PH_ONLY == 3
    if (IN(3)) { SchedReg S{G, bx, NTOK / 256, D / 256, (const char*)(ws + WS_MIXED), (const char*)(ws + WS_WOUT), TSTEP, TSTEP, nullptr, D, nullptr, nullptr};
        EpiResid<8> E{xin0, outp, S0p, SSQ1p, SSQSBp}; pg8::gemm_phase<EpiResid<8>, SchedReg, false>(wave, ring, epi, gtab, D * 2, D * 2, D / 64, S, E); SEAM(3); }
#endif
#if !defined(PH_ONLY) || PH_ONLY == 4
    if (IN(4)) { SchedReg S{G, bx, NTOK / 256, D / 256, (const char*)(ws + WS_S0), (const char*)(ws + WS_WQ), TSTEP, TSTEP, (bf16_t*)(ws + WS_QM), D, SSQ1p, nullptr};
        EpiBf16Ssq E{1.0f / D, C2_MEM}; pg8::gemm_phase<EpiBf16Ssq, SchedReg, false>(wave, ring, epi, gtab, D * 2, D * 2, D / 64, S, E); SEAM(4); }
#endif
#if !defined(PH_ONLY) || PH_ONLY == 5
    if (IN(5)) { SchedMS S{G, bx, ws}; EpiSoftmax E; pg8::gemm_phase<EpiSoftmax, SchedMS, false>(wave, ring, epi, gtab, D * 2, D * 2, MHD / 64, S, E); SEAM(5); }
#endif
#if !defined(PH_ONLY) || PH_ONLY == 6
    if (IN(6)) { SchedPV S{G, bx, ws}; pg8::EpiBf16S E; pg8::gemm_phase<pg8::EpiBf16S, SchedPV, false>(wave, ring, epi, gtab, D * 2, NMEM * 2, NMEM / 64, S, E); SEAM(6); }
#endif
#if !defined(PH_ONLY) || PH_ONLY == 7
    if (IN(7)) { SchedReg S{G, bx, NTOK / 256, D / 256, (const char*)(ws + WS_OM), (const char*)(ws + WS_WO), TSTEP, TSTEP, nullptr, D, nullptr, nullptr};
        EpiResid<-1> E{outp, outp, S0p, SSQ2p, nullptr}; pg8::gemm_phase<EpiResid<-1>, SchedReg, false>(wave, ring, epi, gtab, D * 2, D * 2, D / 64, S, E); SEAM(7); }
#endif
#if !defined(PH_ONLY) || PH_ONLY == 8
    if (IN(8)) { p8_route(args, lds, bx, G, wave, LANE_ID()); SEAM(8); }
#endif
#if !defined(PH_ONLY) || PH_ONLY == 9
    if (IN(9)) { moe_table(args, MISC, wave * 64 + LANE_ID()); SchedMoE<8, true> S{G, bx, ws, MISC}; EpiSwiGLU E{SSQ2p, args.in[18], (bf16_t*)(ws + WS_ACT)};
        pg8::gemm_phase<EpiSwiGLU, SchedMoE<8, true>, true>(wave, ring, epi, gtab, D * 2, D * 2, D / 64, S, E); SEAM(9); }
#endif
#if !defined(PH_ONLY) || PH_ONLY == 10
    if (IN(10)) { moe_table(args, MISC, wave * 64 + LANE_ID()); SchedMoE<4, false> S{G, bx, ws, MISC}; EpiW2 E{args.in[20], (bf16_t*)(ws + WS_Y)};
        pg8::gemm_phase<EpiW2, SchedMoE<4, false>, false>(wave, ring, epi, gtab, DFF * 2, DFF * 2, DFF / 64, S, E); SEAM(10); }
#endif
#if !defined(PH_ONLY) || PH_ONLY == 11
    if (IN(11)) { p11_final(args, vcu, G, wave, LANE_ID()); }
#endif
}

#undef IN
#undef SEAM
}
}

#ifndef MEGA_MASK
#define MEGA_MASK 0xFFB
#endif
extern "C" void kernel_launch(void* const* d_in, const int* in_sizes, int n_in, void* d_out, int out_size, void* d_ws, size_t ws_size, hipStream_t stream) {
    if (n_in != 22 || out_size != NTOK * D || ws_size < WS_END) { fprintf(stderr, "kernel_launch: unexpected shapes (n_in %d out %d ws %zu)\n", n_in, out_size, ws_size); return; }
    static int grid = 0;
    if (grid == 0) {
        int dev = 0, cus = 0;
        if (hipGetDevice(&dev) != hipSuccess || hipDeviceGetAttribute(&cus, hipDeviceAttributeMultiprocessorCount, dev) != hipSuccess) { grid = -1; return; }
        if (hipFuncSetAttribute((const void*)mk::mega, hipFuncAttributeMaxDynamicSharedMemorySize, mk::LDS_BYTES) != hipSuccess) { fprintf(stderr, "kernel_launch: hipFuncSetAttribute failed\n"); grid = -1; return; }
        int per_cu = 0; (void)hipOccupancyMaxActiveBlocksPerMultiprocessor(&per_cu, (const void*)mk::mega, mk::NWAVES * 64, mk::LDS_BYTES); (void)hipGetLastError();
        if (per_cu < 1) fprintf(stderr, "kernel_launch: occupancy query reports %d blocks per CU\n", per_cu);
        grid = cus;
    }
    if (grid < 0) return;
    const float* x = (const float*)d_in[0]; const float* mem = (const float*)d_in[1]; const float* g_mix = (const float*)d_in[2]; const float* w_in = (const float*)d_in[3];
    const float* g_sb = (const float*)d_in[4]; const float* g_pool = (const float*)d_in[5]; const float* w_pool = (const float*)d_in[6]; const float* pool_scale = (const float*)d_in[7];
    const float* w_out = (const float*)d_in[8]; const float* g_mem_q = (const float*)d_in[9]; const float* g_mem_kv = (const float*)d_in[10]; const float* w_mem_q = (const float*)d_in[11];
    const float* w_mem_kv = (const float*)d_in[12]; const float* w_mem_o = (const float*)d_in[13]; const float* g_ffn = (const float*)d_in[14]; const float* w_router = (const float*)d_in[15];
    const float* b_router = (const float*)d_in[16]; const float* w_e_in = (const float*)d_in[17]; const float* b_e_in = (const float*)d_in[18]; const float* w_e_out = (const float*)d_in[19];
    const float* b_e_out = (const float*)d_in[20]; const float* g_final = (const float*)d_in[21];
    float* out = (float*)d_out; unsigned char* ws = (unsigned char*)d_ws;
    bf16_t* WIN = (bf16_t*)(ws + WS_WIN); bf16_t* WOUT = (bf16_t*)(ws + WS_WOUT); bf16_t* WQ = (bf16_t*)(ws + WS_WQ); bf16_t* WKV = (bf16_t*)(ws + WS_WKV); bf16_t* WO = (bf16_t*)(ws + WS_WO);
    bf16_t* WP = (bf16_t*)(ws + WS_WP); float* WR = (float*)(ws + WS_WR); float* RSTDX = (float*)(ws + WS_RSTDX); float* RSTDM = (float*)(ws + WS_RSTDM);
    bf16_t* W1 = (bf16_t*)(ws + WS_W1); bf16_t* W2 = (bf16_t*)(ws + WS_W2); bf16_t* S0 = (bf16_t*)(ws + WS_S0); bf16_t* QKVU = (bf16_t*)(ws + WS_QKVU);
    bf16_t* QM = (bf16_t*)(ws + WS_QM); bf16_t* OM = (bf16_t*)(ws + WS_OM); bf16_t* MIXED = (bf16_t*)(ws + WS_MIXED); bf16_t* PM = (bf16_t*)(ws + WS_PM); bf16_t* ACT = (bf16_t*)(ws + WS_ACT);
    bf16_t* KM = (bf16_t*)(ws + WS_KM); bf16_t* VMT = (bf16_t*)(ws + WS_VMT); bf16_t* MEMB = (bf16_t*)(ws + WS_MEMB); int* LSLOT = (int*)(ws + WS_LSLOT); float* LGATE = (float*)(ws + WS_LGATE);
    bf16_t* Y = (bf16_t*)(ws + WS_Y); float* SCR_S = (float*)(ws + WS_SCR_S); bf16_t* POOLED = (bf16_t*)(ws + WS_SCR_POOLED); float* POOLO = (float*)(ws + WS_SCR_POOLO);
    int* CNT = (int*)(ws + OFF_CNT); float* SSQSB = (float*)(ws + OFF_SSQSB); float* SSQ1 = (float*)(ws + OFF_SSQ1); float* SSQ2 = (float*)(ws + OFF_SSQ2);

    (void)hipMemsetAsync(ws + WS_CTL, 0, CTL_BYTES, stream);
    mk::Args a{}; for (int i = 0; i < 22; ++i) a.in[i] = (const float*)d_in[i]; a.out = out; a.ws = ws;
    const dim3 tb(32, 8); const int BIG = 1 << 30; int li = 0;
    for (int p = 0; p < mk::NPHASE;) {
        if ((MEGA_MASK >> p) & 1) { int q = p; while (q < mk::NPHASE && ((MEGA_MASK >> q) & 1)) ++q;
            a.ph_lo = p; a.ph_hi = q; a.li = li; hipLaunchKernelGGL(mk::mega, dim3(grid), dim3(mk::NWAVES * 64), mk::LDS_BYTES, stream, a); ++li; p = q; continue; }
        switch (p) {
        case 0:
            nv::k_cvt_w<<<dim3(INP / 32, D / 32, 1), tb, 0, stream>>>(w_in, D, INP, WIN, INP, g_mix, nullptr, BIG, nullptr, 0, 0);
            nv::k_cvt_w<<<dim3(D / 32, D / 32, 1), tb, 0, stream>>>(w_out, D, D, WOUT, D, g_sb, g_pool, SBW, nullptr, 0, 0);
            nv::k_cvt_w<<<dim3(D / 32, D / 32, 1), tb, 0, stream>>>(w_mem_q, D, D, WQ, D, g_mem_q, nullptr, BIG, nullptr, 0, 0);
            nv::k_cvt_w<<<dim3(2 * D / 32, D / 32, 1), tb, 0, stream>>>(w_mem_kv, D, 2 * D, WKV, 2 * D, g_mem_kv, nullptr, BIG, nullptr, 0, 0);
            nv::k_cvt_w<<<dim3(D / 32, D / 32, 1), tb, 0, stream>>>(w_mem_o, D, D, WO, D, nullptr, nullptr, BIG, nullptr, 0, 0);
            nv::k_cvt_w<<<dim3(2 * DFF / 32, D / 32, NE), tb, 0, stream>>>(w_e_in, D, 2 * DFF, W1, 2 * DFF, g_ffn, nullptr, BIG, nullptr, 0, 1);
            nv::k_cvt_w<<<dim3(D / 32, DFF / 32, NE), tb, 0, stream>>>(w_e_out, DFF, D, W2, D, nullptr, nullptr, BIG, nullptr, 0, 0);
            nv::k_cvt_w<<<dim3(PGD / 32, PGD / 32, PG), tb, 0, stream>>>(w_pool, PGD, PGD, WP, PGD, nullptr, nullptr, BIG, pool_scale, PGD, 0);
            nv::k_cvt_router<<<NE * D / 256, 256, 0, stream>>>(w_router, g_ffn, WR);
            nv::k_rowstat_cvt<<<NTOK / 4, 256, 0, stream>>>(x, S0, RSTDX, NTOK);
            nv::k_rowstat_cvt<<<NMROWS / 4, 256, 0, stream>>>(mem, MEMB, RSTDM, NMROWS);
            break;
        case 1:
            nv::k_g1<<<dim3(INP / 64, NTOK / 64), 256, 0, stream>>>(S0, WIN, RSTDX, QKVU);
            nv::k_g1b<<<dim3(2 * D / 64, NMROWS / 64), 256, 0, stream>>>(MEMB, WKV, RSTDM, KM, VMT);
            break;
        case 2:
            nv::k_sb<<<B * NH * S / 256, 256, 0, stream>>>(QKVU, MIXED, SSQSB);
            nv::k_pool1<<<(unsigned)((size_t)NTOK * PW / 256), 256, 0, stream>>>(QKVU, POOLED);
            nv::k_pool2<<<dim3(PGD / 64, NTOK / 64, PG), 256, 0, stream>>>(POOLED, WP, POOLO);
            nv::k_pool3<<<NTOK / 4, 256, 0, stream>>>(POOLO, MIXED);
            break;
        case 3: nv::k_resid<<<dim3(D / 64, NTOK / 64), 256, 0, stream>>>(MIXED, WOUT, x, out, S0, SSQ1, SSQSB, SBW); break;
        case 4: nv::k_g3<<<dim3(D / 64, NTOK / 64), 256, 0, stream>>>(S0, WQ, SSQ1, QM); break;
        case 5:
            nv::k_ms<<<dim3(NMEM / 64, NTOK / 64, MH), 256, 0, stream>>>(QM, KM, SCR_S);
            nv::k_msoftmax<<<NTOK * MH / 4, 256, 0, stream>>>(SCR_S, PM);
            break;
        case 6: nv::k_mpv<<<dim3(MHD / 64, NTOK / 64, MH), 256, 0, stream>>>(PM, VMT, OM); break;
        case 7: nv::k_resid<<<dim3(D / 64, NTOK / 64), 256, 0, stream>>>(OM, WO, out, out, S0, SSQ2, SSQ2, -1); break;
        case 8: nv::k_route<<<NTOK / 4, 256, 0, stream>>>(out, SSQ2, WR, b_router, CNT, LSLOT, LGATE); break;
        case 9: nv::k_w1<<<dim3(DFF / 32, LCAP / 64, NE), 256, 0, stream>>>(S0, SSQ2, W1, b_e_in, CNT, LSLOT, ACT); break;
        case 10: nv::k_w2<<<dim3(D / 64, LCAP / 64, NE), 256, 0, stream>>>(ACT, W2, b_e_out, CNT, LSLOT, LGATE, Y); break;
        case 11: nv::k_final<<<NTOK / 4, 256, 0, stream>>>(out, Y, g_final); break;
        }
        ++p;
    }
}
```

```cpp
#include <hip/hip_runtime.h>
#include <cstdio>
#include <cstdint>

typedef unsigned short bf16_t;
typedef short bf16x8 __attribute__((ext_vector_type(8)));
typedef float f32x4 __attribute__((ext_vector_type(4)));
typedef unsigned u32x4 __attribute__((ext_vector_type(4)));

namespace cfg {
constexpr int B = 8, S = 4096, D = 1024, NTOK = B * S;
constexpr int SBW = 512, NH = 8, HD = 64, PW = 512, PG = 4, PGD = 128, INP = 2048;
constexpr int NMEM = 256, MH = 4, MHD = 256, NMROWS = B * NMEM;
constexpr int NE = 32, TOPK = 4, DFF = 1024, LCAP = NTOK;
constexpr float EPS = 1e-5f, LOG2E = 1.4426950408889634f;
constexpr float C2_SB = 0.125f * LOG2E, C2_MEM = 0.0625f * LOG2E;
constexpr float SW_LIMIT = 7.0f, SW_ALPHA = 1.702f;
constexpr int MAXTILES = 544;
constexpr size_t MiB = 1u << 20;
constexpr size_t WS_CTL = 0, CTL_BYTES = 2 * MiB;
constexpr size_t OFF_CNT = 64 * 1024, OFF_SSQSB = 512 * 1024, OFF_SSQ1 = 640 * 1024, OFF_SSQ2 = 768 * 1024;
constexpr size_t WS_WIN = 2 * MiB, WS_WOUT = 6 * MiB, WS_WQ = 8 * MiB, WS_WKV = 10 * MiB, WS_WO = 14 * MiB, WS_WP = 16 * MiB, WS_WR = 17 * MiB;
constexpr size_t WS_RSTDX = 18 * MiB, WS_RSTDM = 18 * MiB + 512 * 1024;
constexpr size_t WS_W1 = 20 * MiB, WS_W2 = 148 * MiB;
constexpr size_t WS_S0 = 212 * MiB;
constexpr size_t WS_QKVU = 276 * MiB;
constexpr size_t WS_QM = 276 * MiB, WS_OM = 340 * MiB;
constexpr size_t WS_MIXED = 404 * MiB;
constexpr size_t WS_PM = 404 * MiB;
constexpr size_t WS_ACT = 276 * MiB;
constexpr size_t WS_KM = 548 * MiB, WS_VMT = 552 * MiB, WS_MEMB = 556 * MiB, WS_LSLOT = 560 * MiB, WS_LGATE = 564 * MiB;
constexpr size_t WS_Y = 568 * MiB;
constexpr size_t WS_SCR_S = 568 * MiB, WS_SCR_POOLED = 696 * MiB, WS_SCR_POOLO = 728 * MiB;
constexpr size_t WS_END = 824 * MiB;
}
using namespace cfg;

__device__ __forceinline__ unsigned f2bf(float f) { unsigned u = __builtin_bit_cast(unsigned, f); return (u + 0x7fffu + ((u >> 16) & 1u)) >> 16; }
__device__ __forceinline__ float bf2f(bf16_t h) { return __builtin_bit_cast(float, (unsigned)h << 16); }
__device__ __forceinline__ float wave_sum(float v) {
#pragma unroll
    for (int o = 1; o < 64; o <<= 1) v += __shfl_xor(v, o);
    return v;
}

namespace nv {
__global__ void k_cvt_w(const float* src, int K, int N, bf16_t* dst, int ND, const float* gk, const float* gk2, int ksplit, const float* gn, int gnz, int mode) {
    __shared__ float t[32][33];
    const int nd0 = blockIdx.x * 32, k0 = blockIdx.y * 32, z = blockIdx.z;
    int ns0 = nd0;
    if (mode == 1) { const int pn = nd0 >> 8, j = nd0 & 255; ns0 = (j < 128) ? 128 * pn + j : 1024 + 128 * pn + (j - 128); }
    src += (size_t)z * K * N; dst += (size_t)z * ND * K;
    for (int i = threadIdx.y; i < 32; i += 8) { const int k = k0 + i, n = ns0 + threadIdx.x;
        float v = src[(size_t)k * N + n]; if (gk) v *= (k < ksplit) ? gk[k] : gk2[k - ksplit]; if (gn) v *= gn[z * gnz + n]; t[i][threadIdx.x] = v; }
    __syncthreads();
    for (int i = threadIdx.y; i < 32; i += 8) dst[(size_t)(nd0 + i) * K + k0 + threadIdx.x] = (bf16_t)f2bf(t[threadIdx.x][i]);
}
__global__ void k_cvt_router(const float* wr, const float* g, float* dst) {
    const int i = blockIdx.x * 256 + threadIdx.x; if (i >= NE * D) return; const int e = i / D, k = i % D; dst[i] = g[k] * wr[k * NE + e];
}
__global__ void k_rowstat_cvt(const float* x, bf16_t* xb, float* rstd, int rows) {
    const int row = blockIdx.x * 4 + (threadIdx.x >> 6), lane = threadIdx.x & 63; if (row >= rows) return;
    const float* xr = x + (size_t)row * D; float s = 0.f;
    for (int j = lane; j < D; j += 64) { const float v = xr[j]; s += v * v; xb[(size_t)row * D + j] = (bf16_t)f2bf(v); }
    s = wave_sum(s); if (lane == 0) rstd[row] = 1.0f / sqrtf(s * (1.0f / D) + EPS);
}

template <class RA, class RB, class MID, class EPI>
__device__ __forceinline__ void wave_gemm(int m0, int n0, int K, int kmid, RA ra, RB rb, MID mid, EPI epi) {
    const int lane = threadIdx.x & 63, r16 = lane & 15, kq = lane >> 4;
    const bf16_t* pa[2]; const bf16_t* pb[2];
#pragma unroll
    for (int i = 0; i < 2; ++i) { pa[i] = ra(m0 + i * 16 + r16) + kq * 8; pb[i] = rb(n0 + i * 16 + r16) + kq * 8; }
    f32x4 acc[2][2];
#pragma unroll
    for (int i = 0; i < 2; ++i)
#pragma unroll
        for (int j = 0; j < 2; ++j) acc[i][j] = (f32x4){0.f, 0.f, 0.f, 0.f};
    for (int k = 0; k < K; k += 32) {
        if (k == kmid) {
#pragma unroll
            for (int i = 0; i < 2; ++i)
#pragma unroll
                for (int r = 0; r < 4; ++r) { const float s = mid(m0 + i * 16 + kq * 4 + r); acc[i][0][r] *= s; acc[i][1][r] *= s; }
        }
        bf16x8 a[2], b[2];
#pragma unroll
        for (int i = 0; i < 2; ++i) { a[i] = *(const bf16x8*)(pa[i] + k); b[i] = *(const bf16x8*)(pb[i] + k); }
#pragma unroll
        for (int i = 0; i < 2; ++i)
#pragma unroll
            for (int j = 0; j < 2; ++j) acc[i][j] = __builtin_amdgcn_mfma_f32_16x16x32_bf16(a[i], b[j], acc[i][j], 0, 0, 0);
    }
#pragma unroll
    for (int i = 0; i < 2; ++i)
#pragma unroll
        for (int r = 0; r < 4; ++r) epi(m0 + i * 16 + kq * 4 + r, n0 + r16, n0 + 16 + r16, acc[i][0][r], acc[i][1][r]);
}
struct NoMid { __device__ float operator()(int) const { return 1.f; } };

#define NV_TILE() const int w = threadIdx.x >> 6, m0 = blockIdx.y * 64 + (w >> 1) * 32, n0 = blockIdx.x * 64 + (w & 1) * 32

__global__ void k_g1(const bf16_t* XB, const bf16_t* WT, const float* rstd, bf16_t* QKVU) {
    NV_TILE();
    wave_gemm(m0, n0, D, -1, [=](int r) { return XB + (size_t)r * D; }, [=](int c) { return WT + (size_t)c * D; }, NoMid(),
        [=](int r, int c0, int c1, float v0, float v1) { const float s = rstd[r];
            v0 *= s; v1 *= s; if (c0 < SBW) v0 *= C2_SB; if (c1 < SBW) v1 *= C2_SB;
            QKVU[(size_t)r * INP + c0] = (bf16_t)f2bf(v0); QKVU[(size_t)r * INP + c1] = (bf16_t)f2bf(v1); });
}
__global__ void k_g1b(const bf16_t* MEMB, const bf16_t* WT, const float* rstd, bf16_t* KM, bf16_t* VMT) {
    NV_TILE();
    wave_gemm(m0, n0, D, -1, [=](int r) { return MEMB + (size_t)r * D; }, [=](int c) { return WT + (size_t)c * D; }, NoMid(),
        [=](int r, int c0, int c1, float v0, float v1) { const float s = rstd[r]; const int cc[2] = {c0, c1}; const float vv[2] = {v0 * s, v1 * s};
#pragma unroll
            for (int q = 0; q < 2; ++q) { const int c = cc[q];
                if (c < D) KM[(size_t)r * D + c] = (bf16_t)f2bf(vv[q]);
                else VMT[((size_t)(r >> 8) * D + (c - D)) * NMEM + (r & 255)] = (bf16_t)f2bf(vv[q]); } });
}
__global__ void __launch_bounds__(256) k_sb(const bf16_t* QKVU, bf16_t* MIXED, float* SSQSB) {
    const int gid = blockIdx.x * 256 + threadIdx.x; const int t = gid & (S - 1), h = (gid >> 12) & 7, b = gid >> 15;
    const bf16_t* base = QKVU + (size_t)b * S * INP;
    float q[HD], o[HD];
    { const bf16_t* qp = base + (size_t)t * INP + h * HD;
#pragma unroll
      for (int d = 0; d < HD; ++d) { q[d] = bf2f(qp[d]); o[d] = 0.f; } }
    float P = 1.f;
    for (int s = t - 1; s >= 0; --s) {
        const bf16_t* kp = base + (size_t)s * INP + SBW + h * HD; const bf16_t* vp = kp + SBW;
        float z = 0.f;
#pragma unroll
        for (int d = 0; d < HD; ++d) z += q[d] * bf2f(kp[d]);
        const float e = exp2f(z), r = 1.0f / (1.0f + e), beta = 1.0f - r;
        const float w = bf2f((bf16_t)f2bf(beta * P));
#pragma unroll
        for (int d = 0; d < HD; ++d) o[d] += w * bf2f(vp[d]);
        P *= r;
        if (P == 0.f) break;
    }
    float ss = 0.f; bf16_t* op = MIXED + (size_t)(b * S + t) * D + h * HD;
#pragma unroll
    for (int d = 0; d < HD; ++d) { ss += o[d] * o[d]; op[d] = (bf16_t)f2bf(o[d]); }
    unsafeAtomicAdd(SSQSB + b * S + t, ss);
}
__global__ void k_pool1(const bf16_t* QKVU, bf16_t* POOLED) {
    const size_t gid = (size_t)blockIdx.x * 256 + threadIdx.x; const int c = gid & 511; const int tok = (int)(gid >> 9), t = tok & (S - 1);
    const int win = 2 << (c >> 7); const int n = (t + 1 < win) ? t + 1 : win;
    const bf16_t* up = QKVU + (size_t)tok * INP + 3 * SBW + c; float s = 0.f;
    for (int j = 0; j < n; ++j) s += bf2f(up[-(ptrdiff_t)j * INP]);
    POOLED[gid] = (bf16_t)f2bf(s / (float)n - bf2f(up[0]));
}
__global__ void k_pool2(const bf16_t* POOLED, const bf16_t* WPT, float* POOLO) {
    NV_TILE(); const int g = blockIdx.z;
    wave_gemm(m0, n0, PGD, -1, [=](int r) { return POOLED + (size_t)r * PW + g * PGD; }, [=](int c) { return WPT + ((size_t)g * PGD + c) * PGD; }, NoMid(),
        [=](int r, int c0, int c1, float v0, float v1) { POOLO[(size_t)r * PW + g * PGD + c0] = v0; POOLO[(size_t)r * PW + g * PGD + c1] = v1; });
}
__global__ void k_pool3(const float* POOLO, bf16_t* MIXED) {
    const int tok = blockIdx.x * 4 + (threadIdx.x >> 6), lane = threadIdx.x & 63;
    float v[8], s = 0.f;
#pragma unroll
    for (int j = 0; j < 8; ++j) { v[j] = POOLO[(size_t)tok * PW + lane + 64 * j]; s += v[j] * v[j]; }
    const float rs = 1.0f / sqrtf(wave_sum(s) * (1.0f / PW) + EPS);
#pragma unroll
    for (int j = 0; j < 8; ++j) MIXED[(size_t)tok * D + SBW + lane + 64 * j] = (bf16_t)f2bf(v[j] * rs);
}
__global__ void k_resid(const bf16_t* A, const bf16_t* WT, const float* xin, float* xout, bf16_t* XB, float* SSQ, const float* ssq_mid, int kmid) {
    NV_TILE();
    wave_gemm(m0, n0, D, kmid, [=](int r) { return A + (size_t)r * D; }, [=](int c) { return WT + (size_t)c * D; },
        [=](int r) { return 1.0f / sqrtf(ssq_mid[r] * (1.0f / SBW) + EPS); },
        [=](int r, int c0, int c1, float v0, float v1) {
            const float x0 = xin[(size_t)r * D + c0] + v0, x1 = xin[(size_t)r * D + c1] + v1;
            xout[(size_t)r * D + c0] = x0; xout[(size_t)r * D + c1] = x1;
            XB[(size_t)r * D + c0] = (bf16_t)f2bf(x0); XB[(size_t)r * D + c1] = (bf16_t)f2bf(x1);
            float q = x0 * x0 + x1 * x1; q += __shfl_xor(q, 1); q += __shfl_xor(q, 2); q += __shfl_xor(q, 4); q += __shfl_xor(q, 8);
            if ((threadIdx.x & 15) == 0) unsafeAtomicAdd(SSQ + r, q); });
}
__global__ void k_g3(const bf16_t* X1B, const bf16_t* WT, const float* SSQ1, bf16_t* QM) {
    NV_TILE();
    wave_gemm(m0, n0, D, -1, [=](int r) { return X1B + (size_t)r * D; }, [=](int c) { return WT + (size_t)c * D; }, NoMid(),
        [=](int r, int c0, int c1, float v0, float v1) { const float s = C2_MEM / sqrtf(SSQ1[r] * (1.0f / D) + EPS);
            QM[(size_t)r * D + c0] = (bf16_t)f2bf(v0 * s); QM[(size_t)r * D + c1] = (bf16_t)f2bf(v1 * s); });
}
__global__ void k_ms(const bf16_t* QM, const bf16_t* KM, float* SCR) {
    NV_TILE(); const int h = blockIdx.z; const int b = m0 >> 12;
    wave_gemm(m0, n0, MHD, -1, [=](int r) { return QM + (size_t)r * D + h * MHD; }, [=](int c) { return KM + ((size_t)b * NMEM + c) * D + h * MHD; }, NoMid(),
        [=](int r, int c0, int c1, float v0, float v1) { SCR[((size_t)r * MH + h) * NMEM + c0] = v0; SCR[((size_t)r * MH + h) * NMEM + c1] = v1; });
}
__global__ void k_msoftmax(const float* SCR, bf16_t* PM) {
    const int row = blockIdx.x * 4 + (threadIdx.x >> 6), lane = threadIdx.x & 63;
    float v[4], m = -INFINITY;
#pragma unroll
    for (int j = 0; j < 4; ++j) { v[j] = SCR[(size_t)row * NMEM + lane + 64 * j]; m = fmaxf(m, v[j]); }
#pragma unroll
    for (int o = 1; o < 64; o <<= 1) m = fmaxf(m, __shfl_xor(m, o));
    float s = 0.f;
#pragma unroll
    for (int j = 0; j < 4; ++j) { v[j] = exp2f(v[j] - m); s += v[j]; }
    s = 1.0f / wave_sum(s);
#pragma unroll
    for (int j = 0; j < 4; ++j) PM[(size_t)row * NMEM + lane + 64 * j] = (bf16_t)f2bf(v[j] * s);
}
__global__ void k_mpv(const bf16_t* PM, const bf16_t* VMT, bf16_t* OM) {
    NV_TILE(); const int h = blockIdx.z; const int b = m0 >> 12;
    wave_gemm(m0, n0, NMEM, -1, [=](int r) { return PM + ((size_t)r * MH + h) * NMEM; }, [=](int c) { return VMT + ((size_t)b * D + h * MHD + c) * NMEM; }, NoMid(),
        [=](int r, int c0, int c1, float v0, float v1) { OM[(size_t)r * D + h * MHD + c0] = (bf16_t)f2bf(v0); OM[(size_t)r * D + h * MHD + c1] = (bf16_t)f2bf(v1); });
}
__global__ void k_route(const float* x2, const float* SSQ2, const float* WR, const float* br, int* CNT, int* LSLOT, float* LGATE) {
    const int tok = blockIdx.x * 4 + (threadIdx.x >> 6), lane = threadIdx.x & 63;
    float xv[16];
#pragma unroll
    for (int j = 0; j < 16; ++j) xv[j] = x2[(size_t)tok * D + lane + 64 * j];
    const float rs = 1.0f / sqrtf(SSQ2[tok] * (1.0f / D) + EPS);
    float mine = 0.f;
    for (int e = 0; e < NE; ++e) { float s = 0.f;
#pragma unroll
        for (int j = 0; j < 16; ++j) s += xv[j] * WR[e * D + lane + 64 * j];
        s = wave_sum(s); if (lane == e) mine = s * rs + br[e]; }
    float tv[4]; int ti[4]; float cur = (lane < NE) ? mine : -INFINITY;
#pragma unroll
    for (int k = 0; k < 4; ++k) { float m = cur; int mi = lane;
#pragma unroll
        for (int o = 1; o < 64; o <<= 1) { const float om = __shfl_xor(m, o); const int oi = __shfl_xor(mi, o); if (om > m || (om == m && oi < mi)) { m = om; mi = oi; } }
        tv[k] = m; ti[k] = mi; if (lane == mi) cur = -INFINITY; }
    float g[4], gs = 0.f;
#pragma unroll
    for (int k = 0; k < 4; ++k) { g[k] = expf(tv[k] - tv[0]); gs += g[k]; }
    if (lane < 4) { int e = ti[0]; float gg = g[0];
        if (lane == 1) { e = ti[1]; gg = g[1]; } if (lane == 2) { e = ti[2]; gg = g[2]; } if (lane == 3) { e = ti[3]; gg = g[3]; }
        const int pos = atomicAdd(CNT + e, 1); LSLOT[(size_t)e * LCAP + pos] = tok * 4 + lane; LGATE[(size_t)e * LCAP + pos] = gg / gs; }
}
__device__ __forceinline__ int tile_base(const int* CNT, int e) { int tb = 0; for (int i = 0; i < e; ++i) tb += (CNT[i] + 255) >> 8; return tb; }
__global__ void k_w1(const bf16_t* X2B, const float* SSQ2, const bf16_t* W1T, const float* b1, const int* CNT, const int* LSLOT, bf16_t* ACT) {
    const int e = blockIdx.z, cnt = CNT[e]; const int w = threadIdx.x >> 6; const int m0 = blockIdx.y * 64 + (w >> 1) * 32; if (blockIdx.y * 64 >= cnt) return;
    const int gc0 = blockIdx.x * 32 + (w & 1) * 16;
    const int pn = gc0 >> 7, j0 = gc0 & 127; const int n0 = pn * 256 + j0;
    const int tb = tile_base(CNT, e); const bf16_t* Wt = W1T + (size_t)e * 2 * DFF * D; const int* ls = LSLOT + (size_t)e * LCAP;
    wave_gemm(m0, 0, D, -1, [=](int r) { const int tok = (r < cnt) ? (ls[r] >> 2) : 0; return X2B + (size_t)tok * D; },
        [=](int c) { const int rowb = (c < 16) ? n0 + c : n0 + 128 + (c - 16); return Wt + (size_t)rowb * D; }, NoMid(),
        [=](int r, int c0, int c1, float vg, float vu) { if (r >= cnt) return; const int tok = ls[r] >> 2; const float rs = 1.0f / sqrtf(SSQ2[tok] * (1.0f / D) + EPS);
            const int gc = gc0 + c0;
            float gate = vg * rs + b1[e * 2 * DFF + gc], up = vu * rs + b1[e * 2 * DFF + DFF + gc];
            gate = fminf(gate, SW_LIMIT); up = fminf(fmaxf(up, -SW_LIMIT), SW_LIMIT);
            const float act = (up + 1.0f) * gate / (1.0f + expf(-SW_ALPHA * gate));
            ACT[((size_t)tb * 256 + r) * DFF + gc] = (bf16_t)f2bf(act); (void)c1; });
}
__global__ void k_w2(const bf16_t* ACT, const bf16_t* W2T, const float* b2, const int* CNT, const int* LSLOT, const float* LGATE, bf16_t* Y) {
    const int e = blockIdx.z, cnt = CNT[e]; if (blockIdx.y * 64 >= cnt) return; NV_TILE();
    const int tb = tile_base(CNT, e); const bf16_t* Wt = W2T + (size_t)e * D * DFF; const int* ls = LSLOT + (size_t)e * LCAP; const float* lg = LGATE + (size_t)e * LCAP;
    wave_gemm(m0, n0, DFF, -1, [=](int r) { return ACT + ((size_t)tb * 256 + r) * DFF; }, [=](int c) { return Wt + (size_t)c * DFF; }, NoMid(),
        [=](int r, int c0, int c1, float v0, float v1) { if (r >= cnt) return; const int slot = ls[r]; const float g = lg[r];
            Y[(size_t)slot * D + c0] = (bf16_t)f2bf((v0 + b2[e * D + c0]) * g); Y[(size_t)slot * D + c1] = (bf16_t)f2bf((v1 + b2[e * D + c1]) * g); });
}
__global__ void k_final(float* out, const bf16_t* Y, const float* gf) {
    const int tok = blockIdx.x * 4 + (threadIdx.x >> 6), lane = threadIdx.x & 63;
    float v[16], s = 0.f;
#pragma unroll
    for (int j = 0; j < 16; ++j) { const int c = lane + 64 * j; float a = out[(size_t)tok * D + c];
#pragma unroll
        for (int k = 0; k < 4; ++k) a += bf2f(Y[((size_t)tok * 4 + k) * D + c]);
        v[j] = a; s += a * a; }
    const float rs = 1.0f / sqrtf(wave_sum(s) * (1.0f / D) + EPS);
#pragma unroll
    for (int j = 0; j < 16; ++j) { const int c = lane + 64 * j; out[(size_t)tok * D + c] = v[j] * rs * gf[c]; }
}
}

#define LAS __attribute__((address_space(3)))
#define GAS __attribute__((address_space(1)))
namespace pg8 {
constexpr int BM = 256, BK = 64, HALF = 128, HTB = HALF * BK * 2, STAGE_BYTES = 8 * HTB, NXCD = 8, WGM = 8;
__host__ __device__ __forceinline__ int lds_byte(int r, int c) { const int st = (r >> 4) * 2 + (c >> 5), rr = r & 15, cc = c & 31, ob = rr * 64 + cc * 2; return st * 1024 + (ob ^ (((ob >> 9) & 1) << 5)); }
__host__ __device__ __forceinline__ void stage_rc(int b, int& R, int& C) { const int st = b / 1024, sb = b % 1024, swz = sb ^ (((sb >> 9) & 1) << 5); R = (st >> 1) * 16 + swz / 64; C = (st & 1) * 32 + (swz % 64) / 2; }
__host__ __device__ __forceinline__ int perm32(int rho) { const int n = rho >> 4, i = rho & 15; return 8 * (i >> 2) + 4 * n + (i & 3); }
__device__ __forceinline__ unsigned cvt_pk_bf16(float lo, float hi) { unsigned r; asm volatile("v_cvt_pk_bf16_f32 %0, %1, %2" : "=v"(r) : "v"(lo), "v"(hi)); return r; }

struct Unit { const char* A; const char* B; void* p0; void* p1; void* p2; void* p3; int pm, pn, i0, i1; };

__device__ __forceinline__ int xcd_remap(int L, int nwg) { const int q = nwg / NXCD, r = nwg % NXCD, xcd = L % NXCD, off = L / NXCD; return __builtin_amdgcn_readfirstlane((xcd < r ? xcd * (q + 1) : r * (q + 1) + (xcd - r) * q) + off); }
__device__ __forceinline__ void grouped_mn(int wgid, int nM, int nN, int& pm, int& pn) {
    const int nig = WGM * nN, gid = wgid / nig, fm = gid * WGM, gsz = (nM - fm) < WGM ? (nM - fm) : WGM; pm = __builtin_amdgcn_readfirstlane(fm + ((wgid % nig) % gsz)); pn = __builtin_amdgcn_readfirstlane((wgid % nig) / gsz); }

template <class Epi, class Sched, bool GATHER>
__device__ __forceinline__ void gemm_phase(const int wid, LAS unsigned char* lds, LAS unsigned char* epi_lds, LAS unsigned* gtab, const int lda_b, const int ldb_b, const int nt, const Sched& S, const Epi& E) {
    int lane_; asm volatile("v_mbcnt_lo_u32_b32 %0, -1, 0\n\tv_mbcnt_hi_u32_b32 %0, -1, %0" : "=v"(lane_));
    const int lane = lane_, tid = wid * 64 + lane, wr = wid >> 2, wc = wid & 3, fr = lane & 15, fq = lane >> 4;
    unsigned voffA[2], voffB[2], voffG[2][2]; int Rr[2]; unsigned Cb[2];
#pragma unroll
    for (int i = 0; i < 2; ++i) { int R, C; stage_rc(tid * 16, R, C); R += 64 * i; const int Rb = Epi::PERM ? ((R & ~31) + perm32(R & 31)) : R;
        voffA[i] = (unsigned)(R * lda_b + C * 2); voffB[i] = (unsigned)(Rb * ldb_b + C * 2); Rr[i] = R; Cb[i] = (unsigned)(C * 2); voffG[0][i] = 0; voffG[1][i] = 0; }
    const size_t kstep = (size_t)(BK * 2);
    const size_t hstepA = (size_t)HALF * lda_b, hstepB = (size_t)HALF * ldb_b;
    const unsigned ldsw = (unsigned)wid * 1024u;
    const int aoff = lds_byte(wr * 64 + fr, fq * 8), boff = lds_byte(wc * 32 + fr, fq * 8);
#define PG8_SA(b, h) (((b) * 2 + (h)) * HTB)
#define PG8_SB(b, h) ((4 + (b) * 2 + (h)) * HTB)
#define PG8_GLDS(gp, bufoff, _i) __builtin_amdgcn_global_load_lds((const unsigned*)(gp), (LAS unsigned*)(lds + (bufoff) + ldsw + (_i) * 8192), 16, 0, 0)
#define PG8_STAGE_B(bufoff, gbase) do { _Pragma("unroll") for (int _i = 0; _i < 2; ++_i) PG8_GLDS((const char*)(gbase) + voffB[_i], bufoff, _i); } while (0)
#define PG8_STAGE_A(bufoff, gbase, h) do { if constexpr (GATHER) { _Pragma("unroll") for (int _i = 0; _i < 2; ++_i) PG8_GLDS((const char*)(gbase) + voffG[h][_i], bufoff, _i); } \
        else { _Pragma("unroll") for (int _i = 0; _i < 2; ++_i) PG8_GLDS((const char*)(gbase) + (h) * hstepA + voffA[_i], bufoff, _i); } } while (0)
#define PG8_LDA(dst, b, h) do { _Pragma("unroll") for (int m = 0; m < 4; ++m) _Pragma("unroll") for (int k = 0; k < 2; ++k) dst[m][k] = *(const LAS bf16x8*)(lds + PG8_SA(b, h) + aoff + m * 2048 + k * 1024); } while (0)
#define PG8_LDB(dst, b, h) do { _Pragma("unroll") for (int n = 0; n < 2; ++n) _Pragma("unroll") for (int k = 0; k < 2; ++k) dst[n][k] = *(const LAS bf16x8*)(lds + PG8_SB(b, h) + boff + n * 2048 + k * 1024); } while (0)
#define PG8_MMA(ai, bj, At, Bt) do { __builtin_amdgcn_s_setprio(1); _Pragma("unroll") for (int m = 0; m < 4; ++m) _Pragma("unroll") for (int n = 0; n < 2; ++n) _Pragma("unroll") for (int k = 0; k < 2; ++k) \
        acc[ai][bj][m][n] = __builtin_amdgcn_mfma_f32_16x16x32_bf16(Bt[n][k], At[m][k], acc[ai][bj][m][n], 0, 0, 0); __builtin_amdgcn_s_setprio(0); } while (0)
#define PG8_WAIT_V(n) asm volatile("s_waitcnt vmcnt(" #n ")" ::: "memory")
#define PG8_WAIT_L(n) asm volatile("s_waitcnt lgkmcnt(" #n ")" ::: "memory")
#define PG8_BAR __builtin_amdgcn_s_barrier()
#define PG8_SCHED __builtin_amdgcn_sched_barrier(0)
#define PG8_GTAB_LOAD(buf, nvalid) do { _Pragma("unroll") for (int _h = 0; _h < 2; ++_h) _Pragma("unroll") for (int _i = 0; _i < 2; ++_i) { const int _row = _h * HALF + Rr[_i]; \
        const unsigned _s = gtab[(buf) * 256 + _row]; voffG[_h][_i] = ((_row < (nvalid)) ? (_s >> 2) * (unsigned)lda_b : 0u) + Cb[_i]; } } while (0)
#define PG8_GTAB_DMA(buf, src) do { if (wid == 0) __builtin_amdgcn_global_load_lds((const unsigned*)((const char*)(src) + lane * 16), (LAS unsigned*)(gtab + (buf) * 256), 16, 0, 0); } while (0)
    Unit cur, nxt; int ui = 0;
    if (!S.next(0, cur)) return;
    f32x4 acc[2][2][4][2];
#pragma unroll
    for (int a = 0; a < 2; ++a)
#pragma unroll
        for (int b = 0; b < 2; ++b)
#pragma unroll
            for (int m = 0; m < 4; ++m)
#pragma unroll
                for (int n = 0; n < 2; ++n) acc[a][b][m][n] = (f32x4){0.f, 0.f, 0.f, 0.f};
    bf16x8 At[4][2], B0[2][2], B1[2][2];
    const char* cA = cur.A; const char* cB = cur.B;
    if constexpr (GATHER) { PG8_GTAB_DMA(0, cur.p3); PG8_WAIT_V(0); PG8_WAIT_L(0); PG8_BAR; PG8_GTAB_LOAD(0, cur.i0); }
    PG8_STAGE_B(PG8_SB(0, 0), cB); PG8_STAGE_B(PG8_SB(0, 1), cB + hstepB); PG8_STAGE_A(PG8_SA(0, 0), cA, 0); PG8_STAGE_A(PG8_SA(0, 1), cA, 1);
    if (wr == 1) PG8_BAR;
    PG8_WAIT_V(2); PG8_BAR;
    PG8_STAGE_B(PG8_SB(1, 0), cB + kstep); PG8_STAGE_A(PG8_SA(1, 0), cA + kstep, 0); PG8_STAGE_B(PG8_SB(1, 1), cB + hstepB + kstep);
    PG8_WAIT_V(6); PG8_BAR;
    for (;;) {
        const bool has_next = S.next(ui + 1, nxt);
        const char* nA = has_next ? nxt.A : cA; const char* nB = has_next ? nxt.B : cB;
#pragma unroll 1
        for (int t = 0; t < nt; t += 2) {
            const bool last = (t == nt - 2);
            const char* a1 = cA + (size_t)(t + 1) * kstep;
            const char* a2 = last ? nA : cA + (size_t)(t + 2) * kstep; const char* b2 = last ? nB : cB + (size_t)(t + 2) * kstep;
            const char* a3 = a2 + kstep; const char* b3 = b2 + kstep;
            if constexpr (Epi::MIDK >= 0) { if (t == Epi::MIDK) E.midk(acc, cur, wr, fr); }
            if constexpr (GATHER) { if (t == 0 && has_next) PG8_GTAB_DMA((ui + 1) & 1, nxt.p3); }
            if constexpr (GATHER) { PG8_STAGE_A(PG8_SA(1, 1), a1, 1); if (last && has_next) PG8_GTAB_LOAD((ui + 1) & 1, nxt.i0); PG8_SCHED; }
            PG8_LDB(B0, 0, 0); PG8_LDB(B1, 0, 1); PG8_SCHED; PG8_LDA(At, 0, 0); if constexpr (!GATHER) PG8_STAGE_A(PG8_SA(1, 1), a1, 1);
            PG8_WAIT_V(8); PG8_WAIT_L(0); PG8_BAR; PG8_MMA(0, 0, At, B0); PG8_MMA(0, 1, At, B1); PG8_BAR; PG8_SCHED;
            PG8_LDA(At, 0, 1); PG8_STAGE_B(PG8_SB(0, 0), b2); PG8_STAGE_B(PG8_SB(0, 1), b2 + hstepB); PG8_STAGE_A(PG8_SA(0, 0), a2, 0);
            PG8_WAIT_V(8); PG8_WAIT_L(0); PG8_BAR; PG8_MMA(1, 0, At, B0); PG8_MMA(1, 1, At, B1); PG8_BAR; PG8_SCHED;
            PG8_LDB(B0, 1, 0); PG8_LDB(B1, 1, 1); PG8_SCHED; PG8_LDA(At, 1, 0); PG8_STAGE_A(PG8_SA(0, 1), a2, 1);
            PG8_WAIT_V(8); PG8_WAIT_L(0); PG8_BAR; PG8_MMA(0, 0, At, B0); PG8_MMA(0, 1, At, B1); PG8_BAR; PG8_SCHED;
            PG8_LDA(At, 1, 1); PG8_STAGE_B(PG8_SB(1, 0), b3); PG8_STAGE_B(PG8_SB(1, 1), b3 + hstepB); PG8_STAGE_A(PG8_SA(1, 0), a3, 0);
            PG8_WAIT_V(8); PG8_WAIT_L(0); PG8_BAR; PG8_MMA(1, 0, At, B0); PG8_MMA(1, 1, At, B1); PG8_BAR; PG8_SCHED;
        }
        if (wr == 0) PG8_BAR;
        E(acc, cur, wr, wc, fr, fq, wid, lane, epi_lds);
        if (!has_next) break;
#pragma unroll
        for (int a = 0; a < 2; ++a)
#pragma unroll
            for (int b = 0; b < 2; ++b)
#pragma unroll
                for (int m = 0; m < 4; ++m)
#pragma unroll
                    for (int n = 0; n < 2; ++n) acc[a][b][m][n] = (f32x4){0.f, 0.f, 0.f, 0.f};
        cur = nxt; cA = nA; cB = nB; ++ui;
        if (wr == 1) PG8_BAR;
    }
    PG8_WAIT_V(0);
    PG8_BAR;
#undef PG8_SA
#undef PG8_SB
#undef PG8_GLDS
#undef PG8_STAGE_A
#undef PG8_STAGE_B
#undef PG8_LDA
#undef PG8_LDB
#undef PG8_MMA
#undef PG8_WAIT_V
#undef PG8_WAIT_L
#undef PG8_BAR
#undef PG8_SCHED
#undef PG8_GTAB_LOAD
#undef PG8_GTAB_DMA
}

struct EpiBf16S {
    static constexpr bool PERM = true; static constexpr int MIDK = -1;
    __device__ __forceinline__ void midk(f32x4 (&)[2][2][4][2], const Unit&, int, int) const {}
    __device__ __forceinline__ void operator()(const f32x4 (&acc)[2][2][4][2], const Unit& u, int wr, int wc, int fr, int fq, int, int, LAS unsigned char*) const {
        bf16_t* O = (bf16_t*)u.p0; const float* rs = (const float*)u.p1; const float* cs = (const float*)u.p2; const int ldc = u.i0;
        int r0 = wr * 64 + fr, c0 = wc * 32 + 8 * fq; asm volatile("" : "+v"(r0), "+v"(c0));
        f32x4 cv[2][2];
#pragma unroll
        for (int bj = 0; bj < 2; ++bj)
#pragma unroll
            for (int n = 0; n < 2; ++n) cv[bj][n] = cs ? *(const f32x4*)(cs + c0 + bj * HALF + 4 * n) : (f32x4){1.f, 1.f, 1.f, 1.f};
#pragma unroll
        for (int ai = 0; ai < 2; ++ai)
#pragma unroll
            for (int m = 0; m < 4; ++m) { const int r = r0 + ai * HALF + m * 16; const float rv = rs ? rs[r] : 1.f; bf16_t* rowp = O + (size_t)r * ldc + c0;
#pragma unroll
                for (int bj = 0; bj < 2; ++bj) { const f32x4 v0 = acc[ai][bj][m][0] * cv[bj][0] * rv, v1 = acc[ai][bj][m][1] * cv[bj][1] * rv;
                    u32x4 w; w.x = cvt_pk_bf16(v0[0], v0[1]); w.y = cvt_pk_bf16(v0[2], v0[3]); w.z = cvt_pk_bf16(v1[0], v1[1]); w.w = cvt_pk_bf16(v1[2], v1[3]);
                    *(u32x4*)(rowp + bj * HALF) = w; } }
    }
};
}

namespace mk {
constexpr int NWAVES = 8, NPHASE = 12;
constexpr int RING_OFF = 0, RING_BYTES = 131072, EPI_OFF = 131072, EPI_BYTES = 8192, GTAB_OFF = EPI_OFF + EPI_BYTES, GTAB_BYTES = 2048, MISC_OFF = GTAB_OFF + GTAB_BYTES, MISC_BYTES = 1024;
constexpr int LDS_BYTES = 147456;
static_assert(MISC_OFF + MISC_BYTES <= LDS_BYTES, "LDS map");
constexpr size_t WS_CSG1 = 19 * MiB, WS_WRH = 19 * MiB + 64 * 1024, WS_WRL = 19 * MiB + 128 * 1024;
constexpr int CW_BAR = 1024;

#define RLX_AGENT __ATOMIC_RELAXED, __HIP_MEMORY_SCOPE_AGENT
#define LDS_WAIT() asm volatile("s_waitcnt lgkmcnt(0)" ::: "memory")
#define VM_WAIT() asm volatile("s_waitcnt vmcnt(0)" ::: "memory")
#define XB_TMO      128
#define XB_XCNT(j)  (256  + 64 * (j))
#define XB_XSUB(j)  (1280 + 64 * (j))
#define XB_XGEN(j)  (2304 + 64 * (j))
#define XB_TOP      3328
#define XB_TOPGEN   3392
#define XCD_BAR_WORDS 3456
#define XB_SPIN_CAP (1u << 20)
__device__ __forceinline__ unsigned xb_ld(unsigned* p)              { return __hip_atomic_load(p, __ATOMIC_RELAXED, __HIP_MEMORY_SCOPE_AGENT); }
__device__ __forceinline__ unsigned xb_add(unsigned* p, unsigned v) { return __hip_atomic_fetch_add(p, v, __ATOMIC_RELAXED, __HIP_MEMORY_SCOPE_AGENT); }
__device__ __forceinline__ unsigned xb_xcc_id() { return (unsigned)__builtin_amdgcn_s_getreg((3 << 11) | 20) & 0xFu; }
#define XB_SPIN(cond, bar) do { unsigned _sp = 0; while (cond) { __builtin_amdgcn_s_sleep(1); \
    if ((++_sp & 255u) == 0u) { if (xb_ld(&(bar)[XB_TMO])) break; if (_sp > XB_SPIN_CAP) { atomicAdd(&(bar)[XB_TMO], 1u); break; } } } } while (0)
struct XcdBarrier { unsigned* bar; unsigned x; volatile LAS unsigned* st; };
__device__ __forceinline__ XcdBarrier xcd_barrier_post(unsigned* bar, volatile LAS unsigned* st) {
    XcdBarrier b; b.bar = bar; b.x = xb_xcc_id(); b.st = st;
    if (threadIdx.x == 0) (void)xb_add(&bar[XB_XCNT(b.x)], 1u);
    return b;
}
__device__ __forceinline__ void xcd_barrier_complete(unsigned* bar, unsigned x, unsigned& nloc, unsigned& nx) {
    const unsigned G = gridDim.x * gridDim.y * gridDim.z;
    unsigned sum, cnt, mine, sp = 0u;
    for (;;) {
        sum = 0u; cnt = 0u; mine = 0u;
#pragma unroll
        for (unsigned j = 0; j < 16; ++j) { const unsigned c = xb_ld(&bar[XB_XCNT(j)]); sum += c; cnt += (c > 0u) ? 1u : 0u; mine = (j == x) ? c : mine; }
        if (sum == G) break;
        __builtin_amdgcn_s_sleep(1);
        if ((++sp & 255u) == 0u) { if (xb_ld(&bar[XB_TMO])) break; if (sp > XB_SPIN_CAP) { atomicAdd(&bar[XB_TMO], 1u); break; } }
    }
    nloc = mine > 0u ? mine : 1u; nx = cnt > 0u ? cnt : 1u;
}
__device__ __forceinline__ void xcd_barrier(const XcdBarrier& b) {
    asm volatile("s_waitcnt vmcnt(0)" ::: "memory");
    __syncthreads();
    if (threadIdx.x == 0) {
        unsigned* bar = b.bar;
        __builtin_amdgcn_s_waitcnt(0);
        unsigned nloc = b.st[0], nx = b.st[1];
        if (nloc == 0u) { xcd_barrier_complete(bar, b.x, nloc, nx); b.st[0] = nloc; b.st[1] = nx; }
        const unsigned old = xb_add(&bar[XB_XSUB(b.x)], 1u);
        const unsigned gen = old / nloc;
        if (old + 1u == (gen + 1u) * nloc) {
            __builtin_amdgcn_fence(__ATOMIC_RELEASE, "agent");
            asm volatile("s_waitcnt vmcnt(0)" ::: "memory");
            const unsigned og = xb_add(&bar[XB_TOP], 1u);
            const unsigned tg = og / nx;
            if (og + 1u == (tg + 1u) * nx) xb_add(&bar[XB_TOPGEN], 1u);
            else XB_SPIN(xb_ld(&bar[XB_TOPGEN]) == tg, bar);
            __builtin_amdgcn_fence(__ATOMIC_ACQUIRE, "agent");
            xb_add(&bar[XB_XGEN(b.x)], 1u);
            asm volatile("s_waitcnt vmcnt(0)" ::: "memory");
        } else {
            XB_SPIN(xb_ld(&bar[XB_XGEN(b.x)]) == gen, bar);
            __builtin_amdgcn_fence(__ATOMIC_ACQUIRE, "agent");
            asm volatile("s_waitcnt vmcnt(0)" ::: "memory");
        }
    }
    __syncthreads();
}

struct Args { const float* in[22]; float* out; unsigned char* ws; int ph_lo, ph_hi, li, pad; };

__device__ __forceinline__ void p0_item(const float* W, int K, int N, bf16_t* WT, const float* gk, const float* gk2, int ksplit, const float* gn, int mode, LAS float* scr, int item, int lane) {
    const int nblk = N / 32, kb = item / nblk, nb = item % nblk, k0 = 64 * kb, nd0 = 32 * nb;
    int ns0 = nd0; if (mode == 1) { const int pn = nd0 >> 8, j = nd0 & 255; ns0 = (j < 128) ? 128 * pn + j : 1024 + 128 * pn + (j - 128); }
    const float gnv = gn ? gn[ns0 + (lane & 31)] : 1.f;
#pragma unroll 8
    for (int i = 0; i < 32; ++i) { const int kk = 2 * i + (lane >> 5); const int k = k0 + kk; float v = W[(size_t)k * N + ns0 + (lane & 31)] * gnv;
        if (gk) v *= (k < ksplit) ? gk[k] : gk2[k - ksplit]; scr[kk * 33 + (lane & 31)] = v; }
    LDS_WAIT(); asm volatile("" ::: "memory");
    const int c = lane & 7;
#pragma unroll
    for (int j = 0; j < 4; ++j) { const int n = (lane >> 3) + 8 * j; const LAS float* s = scr + (8 * c) * 33 + n;
        u32x4 o; o.x = pg8::cvt_pk_bf16(s[0 * 33], s[1 * 33]); o.y = pg8::cvt_pk_bf16(s[2 * 33], s[3 * 33]); o.z = pg8::cvt_pk_bf16(s[4 * 33], s[5 * 33]); o.w = pg8::cvt_pk_bf16(s[6 * 33], s[7 * 33]);
        *(u32x4*)(WT + (size_t)(nd0 + n) * K + k0 + 8 * c) = o; }
    LDS_WAIT(); asm volatile("" ::: "memory");
}
__device__ __forceinline__ void p0_row(const float* xrow, bf16_t* orow, float* rstd, int lane) {
    const f32x4* xr = (const f32x4*)xrow + lane; f32x4 v[4]; float s = 0.f;
#pragma unroll
    for (int j = 0; j < 4; ++j) { v[j] = xr[64 * j]; s += (v[j].x * v[j].x + v[j].y * v[j].y) + (v[j].z * v[j].z + v[j].w * v[j].w); }
    s = wave_sum(s); if (lane == 0) *rstd = 1.0f / sqrtf(s * (1.0f / D) + EPS);
    unsigned long long* o8 = (unsigned long long*)orow + lane;
#pragma unroll
    for (int j = 0; j < 4; ++j) o8[64 * j] = (unsigned long long)pg8::cvt_pk_bf16(v[j].x, v[j].y) | ((unsigned long long)pg8::cvt_pk_bf16(v[j].z, v[j].w) << 32);
}
__device__ __forceinline__ void p0_prologue(const Args& a, LAS unsigned char* lds, int vcu, int G, int wave, int lane) {
    unsigned char* ws = a.ws;
    LAS float* scr = (LAS float*)(lds + RING_OFF + wave * 16384);
    const int gw = vcu * NWAVES + wave, NGW = G * NWAVES;
    constexpr int I_E1 = (D / 64) * (2 * DFF / 32), I_E2 = (DFF / 64) * (D / 32);
    constexpr int I_IN = (D / 64) * (INP / 32), I_SQ = (D / 64) * (D / 32), I_KV = (D / 64) * (2 * D / 32), I_P = (PGD / 64) * (PGD / 32);
    constexpr int N1 = NE * I_E1, N2 = NE * I_E2, NITEMS = N1 + N2 + I_IN + 3 * I_SQ + I_KV + PG * I_P;
    const int BIG = 1 << 30;
    for (int it = gw; it < NITEMS; it += NGW) {
        int r = it;
        if (r < N1) { const int e = r / I_E1; p0_item(a.in[17] + (size_t)e * D * 2 * DFF, D, 2 * DFF, (bf16_t*)(ws + WS_W1) + (size_t)e * 2 * DFF * D, a.in[14], nullptr, BIG, nullptr, 1, scr, r % I_E1, lane); continue; } r -= N1;
        if (r < N2) { const int e = r / I_E2; p0_item(a.in[19] + (size_t)e * DFF * D, DFF, D, (bf16_t*)(ws + WS_W2) + (size_t)e * D * DFF, nullptr, nullptr, BIG, nullptr, 0, scr, r % I_E2, lane); continue; } r -= N2;
        if (r < I_IN) { p0_item(a.in[3], D, INP, (bf16_t*)(ws + WS_WIN), a.in[2], nullptr, BIG, nullptr, 0, scr, r, lane); continue; } r -= I_IN;
        if (r < I_SQ) { p0_item(a.in[8], D, D, (bf16_t*)(ws + WS_WOUT), a.in[4], a.in[5], SBW, nullptr, 0, scr, r, lane); continue; } r -= I_SQ;
        if (r < I_SQ) { p0_item(a.in[11], D, D, (bf16_t*)(ws + WS_WQ), a.in[9], nullptr, BIG, nullptr, 0, scr, r, lane); continue; } r -= I_SQ;
        if (r < I_KV) { p0_item(a.in[12], D, 2 * D, (bf16_t*)(ws + WS_WKV), a.in[10], nullptr, BIG, nullptr, 0, scr, r, lane); continue; } r -= I_KV;
        if (r < I_SQ) { p0_item(a.in[13], D, D, (bf16_t*)(ws + WS_WO), nullptr, nullptr, BIG, nullptr, 0, scr, r, lane); continue; } r -= I_SQ;
        { const int g = r / I_P; p0_item(a.in[6] + (size_t)g * PGD * PGD, PGD, PGD, (bf16_t*)(ws + WS_WP) + (size_t)g * PGD * PGD, nullptr, nullptr, BIG, a.in[7] + g * PGD, 0, scr, r % I_P, lane); }
    }
    for (int m = gw; m < NTOK; m += NGW) p0_row(a.in[0] + (size_t)m * D, (bf16_t*)(ws + WS_S0) + (size_t)m * D, (float*)(ws + WS_RSTDX) + m, lane);
    for (int m = gw; m < NMROWS; m += NGW) p0_row(a.in[1] + (size_t)m * D, (bf16_t*)(ws + WS_MEMB) + (size_t)m * D, (float*)(ws + WS_RSTDM) + m, lane);
    const int gt = gw * 64 + lane, NGT = NGW * 64;
    for (int i = gt; i < INP; i += NGT) ((float*)(ws + WS_CSG1))[i] = (i < SBW) ? C2_SB : 1.0f;
    for (int i = gt; i < NE * D; i += NGT) { const int e = i / D, k = i % D; const float v = a.in[14][k] * a.in[15][k * NE + e];
        ((float*)(ws + WS_WR))[i] = v; const unsigned h = f2bf(v); ((bf16_t*)(ws + WS_WRH))[i] = (bf16_t)h; ((bf16_t*)(ws + WS_WRL))[i] = (bf16_t)f2bf(v - bf2f((bf16_t)h)); }
}

struct SchedP1 {
    int G, c; unsigned char* ws;
    __device__ __forceinline__ bool next(int i, pg8::Unit& u) const {
        const int L = i * G + c; constexpr int NQ = (NTOK / 256) * (INP / 256);
        if (L >= NQ + 64) return false;
        if (L < NQ) { int pm, pn; pg8::grouped_mn(pg8::xcd_remap(L, NQ), NTOK / 256, INP / 256, pm, pn);
            u.A = (const char*)(ws + WS_S0) + (size_t)pm * 256 * D * 2; u.B = (const char*)(ws + WS_WIN) + (size_t)pn * 256 * D * 2;
            u.p0 = (bf16_t*)(ws + WS_QKVU) + (size_t)pm * 256 * INP + pn * 256; u.p1 = (float*)(ws + WS_RSTDX) + pm * 256; u.p2 = (float*)(ws + WS_CSG1) + pn * 256; u.i0 = INP; u.pm = pm; u.pn = pn; }
        else if (L < NQ + 32) { const int k = L - NQ, pm = k >> 2, pn = k & 3;
            u.A = (const char*)(ws + WS_MEMB) + (size_t)pm * 256 * D * 2; u.B = (const char*)(ws + WS_WKV) + (size_t)pn * 256 * D * 2;
            u.p0 = (bf16_t*)(ws + WS_KM) + (size_t)pm * 256 * D + pn * 256; u.p1 = (float*)(ws + WS_RSTDM) + pm * 256; u.p2 = nullptr; u.i0 = D; u.pm = pm; u.pn = pn; }
        else { const int v = L - NQ - 32, b = v >> 2, dt = v & 3;
            u.A = (const char*)(ws + WS_WKV) + (size_t)(D + dt * 256) * D * 2; u.B = (const char*)(ws + WS_MEMB) + (size_t)b * 256 * D * 2;
            u.p0 = (bf16_t*)(ws + WS_VMT) + ((size_t)b * D + dt * 256) * NMEM; u.p1 = nullptr; u.p2 = (float*)(ws + WS_RSTDM) + b * 256; u.i0 = NMEM; u.pm = dt; u.pn = b; }
        u.p3 = nullptr; u.i1 = 0; return true;
    }
};
#define EPI_BAR() asm volatile("s_waitcnt lgkmcnt(0)\n\ts_barrier" ::: "memory")
struct SchedReg {
    int G, c, nM, nN; const char* A; const char* B; size_t astep, bstep; bf16_t* O; int ldc; const float* rs; const float* cs;
    __device__ __forceinline__ bool next(int i, pg8::Unit& u) const {
        const int L = i * G + c; if (L >= nM * nN) return false; int pm, pn; pg8::grouped_mn(pg8::xcd_remap(L, nM * nN), nM, nN, pm, pn);
        u.A = A + (size_t)pm * astep; u.B = B + (size_t)pn * bstep; u.pm = pm; u.pn = pn; u.i0 = ldc; u.i1 = 0;
        u.p0 = O ? (void*)(O + (size_t)pm * 256 * ldc + pn * 256) : nullptr; u.p1 = rs ? (void*)(rs + pm * 256) : nullptr; u.p2 = cs ? (void*)(cs + pn * 256) : nullptr; u.p3 = nullptr; return true;
    }
};
struct EpiBf16Ssq {
    static constexpr bool PERM = true; static constexpr int MIDK = -1; float inv_n, mult;
    __device__ __forceinline__ void midk(f32x4 (&)[2][2][4][2], const pg8::Unit&, int, int) const {}
    __device__ __forceinline__ void operator()(f32x4 (&acc)[2][2][4][2], const pg8::Unit& u, int wr, int wc, int fr, int fq, int, int, LAS unsigned char*) const {
        bf16_t* O = (bf16_t*)u.p0; const float* sq = (const float*)u.p1; const int ldc = u.i0; int r0 = wr * 64 + fr, c0 = wc * 32 + 8 * fq; asm volatile("" : "+v"(r0), "+v"(c0));
#pragma unroll
        for (int ai = 0; ai < 2; ++ai)
#pragma unroll
            for (int m = 0; m < 4; ++m) { const int r = r0 + ai * 128 + m * 16; const float rv = mult / sqrtf(sq[r] * inv_n + EPS); bf16_t* rowp = O + (size_t)r * ldc + c0;
#pragma unroll
                for (int bj = 0; bj < 2; ++bj) { const f32x4 v0 = acc[ai][bj][m][0] * rv, v1 = acc[ai][bj][m][1] * rv;
                    u32x4 w; w.x = pg8::cvt_pk_bf16(v0[0], v0[1]); w.y = pg8::cvt_pk_bf16(v0[2], v0[3]); w.z = pg8::cvt_pk_bf16(v1[0], v1[1]); w.w = pg8::cvt_pk_bf16(v1[2], v1[3]);
                    *(u32x4*)(rowp + bj * 128) = w; } }
    }
};
template <int MIDK_> struct EpiResid {
    static constexpr bool PERM = false; static constexpr int MIDK = MIDK_;
    const float* xin; float* xout; bf16_t* xb; float* ssq; const float* ssq_mid;
    __device__ __forceinline__ void midk(f32x4 (&acc)[2][2][4][2], const pg8::Unit& u, int wr, int fr) const {
#pragma unroll
        for (int ai = 0; ai < 2; ++ai)
#pragma unroll
            for (int m = 0; m < 4; ++m) { const int r = u.pm * 256 + ai * 128 + wr * 64 + m * 16 + fr; const float s = 1.0f / sqrtf(ssq_mid[r] * (1.0f / SBW) + EPS);
#pragma unroll
                for (int bj = 0; bj < 2; ++bj)
#pragma unroll
                    for (int n = 0; n < 2; ++n) acc[ai][bj][m][n] *= s; }
    }
    __device__ __forceinline__ void operator()(f32x4 (&acc)[2][2][4][2], const pg8::Unit& u, int wr, int wc, int fr, int fq, int, int, LAS unsigned char*) const {
        int row0 = u.pm * 256 + wr * 64 + fr, col0 = u.pn * 256 + wc * 32 + 4 * fq; asm volatile("" : "+v"(row0), "+v"(col0));
#pragma unroll
        for (int ai = 0; ai < 2; ++ai)
#pragma unroll
            for (int m = 0; m < 4; ++m) { const int r = row0 + ai * 128 + m * 16; const size_t off = (size_t)r * D + col0; float q = 0.f;
#pragma unroll
                for (int bj = 0; bj < 2; ++bj)
#pragma unroll
                    for (int n = 0; n < 2; ++n) { const size_t o2 = off + bj * 128 + n * 16; const f32x4 o = *(const f32x4*)(xin + o2) + acc[ai][bj][m][n];
                        *(f32x4*)(xout + o2) = o; q += (o[0] * o[0] + o[1] * o[1]) + (o[2] * o[2] + o[3] * o[3]);
                        *(unsigned long long*)(xb + o2) = (unsigned long long)pg8::cvt_pk_bf16(o[0], o[1]) | ((unsigned long long)pg8::cvt_pk_bf16(o[2], o[3]) << 32); }
                q += __shfl_xor(q, 16); q += __shfl_xor(q, 32);
                if (fq == 0) unsafeAtomicAdd(ssq + r, q);
                if (m & 1) asm volatile("" ::: "memory"); }
    }
};
struct SchedMS {
    int G, c; unsigned char* ws;
    __device__ __forceinline__ bool next(int i, pg8::Unit& u) const {
        const int L = i * G + c; constexpr int NU = (NTOK / 256) * MH; if (L >= NU) return false; const int w = pg8::xcd_remap(L, NU), pm = w >> 2, h = w & 3, b = pm >> 4;
        u.A = (const char*)(ws + WS_QM) + ((size_t)pm * 256 * D + h * MHD) * 2; u.B = (const char*)(ws + WS_KM) + ((size_t)b * NMEM * D + h * MHD) * 2;
        u.p0 = (bf16_t*)(ws + WS_PM) + (size_t)pm * 256 * D + h * NMEM; u.p1 = nullptr; u.p2 = nullptr; u.p3 = nullptr; u.i0 = D; u.i1 = 0; u.pm = pm; u.pn = h; return true;
    }
};
struct EpiSoftmax {
    static constexpr bool PERM = true; static constexpr int MIDK = -1;
    __device__ __forceinline__ void midk(f32x4 (&)[2][2][4][2], const pg8::Unit&, int, int) const {}
    __device__ __forceinline__ void operator()(f32x4 (&acc)[2][2][4][2], const pg8::Unit& u, int wr, int wc, int fr, int fq, int, int, LAS unsigned char* xl) const {
        typedef float f32x2v __attribute__((ext_vector_type(2)));
        LAS f32x2v* X = (LAS f32x2v*)xl;
        float ml[2][4];
#pragma unroll
        for (int ai = 0; ai < 2; ++ai)
#pragma unroll
            for (int m = 0; m < 4; ++m) { float mx = -INFINITY;
#pragma unroll
                for (int bj = 0; bj < 2; ++bj)
#pragma unroll
                    for (int n = 0; n < 2; ++n) { const f32x4 v = acc[ai][bj][m][n]; mx = fmaxf(fmaxf(mx, fmaxf(v[0], v[1])), fmaxf(v[2], v[3])); }
                mx = fmaxf(mx, __shfl_xor(mx, 16)); mx = fmaxf(mx, __shfl_xor(mx, 32)); ml[ai][m] = mx; float s = 0.f;
#pragma unroll
                for (int bj = 0; bj < 2; ++bj)
#pragma unroll
                    for (int n = 0; n < 2; ++n) { f32x4 v = acc[ai][bj][m][n];
#pragma unroll
                        for (int j = 0; j < 4; ++j) { v[j] = __builtin_amdgcn_exp2f(v[j] - mx); s += v[j]; }
                        acc[ai][bj][m][n] = v; }
                s += __shfl_xor(s, 16); s += __shfl_xor(s, 32);
                if (fq == 0) X[(ai * 128 + wr * 64 + m * 16 + fr) * 4 + wc] = (f32x2v){mx, s}; }
        EPI_BAR();
        bf16_t* O = (bf16_t*)u.p0; const int ldc = u.i0; int r0 = wr * 64 + fr, c0 = wc * 32 + 8 * fq; asm volatile("" : "+v"(r0), "+v"(c0));
#pragma unroll
        for (int ai = 0; ai < 2; ++ai)
#pragma unroll
            for (int m = 0; m < 4; ++m) { const int r = r0 + ai * 128 + m * 16; const f32x2v a = X[r * 4 + 0], b = X[r * 4 + 1], c = X[r * 4 + 2], d = X[r * 4 + 3];
                const float M = fmaxf(fmaxf(a.x, b.x), fmaxf(c.x, d.x));
                const float tot = a.y * __builtin_amdgcn_exp2f(a.x - M) + b.y * __builtin_amdgcn_exp2f(b.x - M) + c.y * __builtin_amdgcn_exp2f(c.x - M) + d.y * __builtin_amdgcn_exp2f(d.x - M);
                const float f = __builtin_amdgcn_exp2f(ml[ai][m] - M) / tot; bf16_t* rowp = O + (size_t)r * ldc + c0;
#pragma unroll
                for (int bj = 0; bj < 2; ++bj) { const f32x4 v0 = acc[ai][bj][m][0] * f, v1 = acc[ai][bj][m][1] * f;
                    u32x4 w; w.x = pg8::cvt_pk_bf16(v0[0], v0[1]); w.y = pg8::cvt_pk_bf16(v0[2], v0[3]); w.z = pg8::cvt_pk_bf16(v1[0], v1[1]); w.w = pg8::cvt_pk_bf16(v1[2], v1[3]);
                    *(u32x4*)(rowp + bj * 128) = w; } }
    }
};
struct SchedPV {
    int G, c; unsigned char* ws;
    __device__ __forceinline__ bool next(int i, pg8::Unit& u) const {
        const int L = i * G + c; constexpr int NU = (NTOK / 256) * MH; if (L >= NU) return false; const int w = pg8::xcd_remap(L, NU), pm = w >> 2, h = w & 3, b = pm >> 4;
        u.A = (const char*)(ws + WS_PM) + ((size_t)pm * 256 * D + h * NMEM) * 2; u.B = (const char*)(ws + WS_VMT) + ((size_t)b * D + h * MHD) * NMEM * 2;
        u.p0 = (bf16_t*)(ws + WS_OM) + (size_t)pm * 256 * D + h * MHD; u.p1 = nullptr; u.p2 = nullptr; u.p3 = nullptr; u.i0 = D; u.i1 = 0; u.pm = pm; u.pn = h; return true;
    }
};

__device__ __forceinline__ void p8_route(const Args& a, LAS unsigned char* lds, int bx, int G, int wave, int lane) {
    unsigned char* ws = a.ws; const float* x2 = a.out; const float* SSQ2 = (const float*)(ws + OFF_SSQ2); const float* br = a.in[16];
    const bf16_t* WRH = (const bf16_t*)(ws + WS_WRH); const bf16_t* WRL = (const bf16_t*)(ws + WS_WRL);
    int* CNT = (int*)(ws + OFF_CNT); int* LSLOT = (int*)(ws + WS_LSLOT); float* LGATE = (float*)(ws + WS_LGATE);
    LAS float* LG = (LAS float*)(lds + RING_OFF) + wave * 16 * 33;
    LAS int* hist = (LAS int*)(lds + RING_OFF + 32768); LAS int* base = hist + 32;
    const int tid = wave * 64 + lane;
    for (int t0 = bx * 128; t0 < NTOK; t0 += G * 128) {
        if (tid < 32) hist[tid] = 0;
        const int r16 = lane & 15, kq = lane >> 4; const int trow = t0 + wave * 16 + r16;
        const float* xp = x2 + (size_t)trow * D + kq * 8;
        f32x4 acc[2] = {(f32x4){0.f, 0.f, 0.f, 0.f}, (f32x4){0.f, 0.f, 0.f, 0.f}};
#pragma unroll 4
        for (int ks = 0; ks < 32; ++ks) {
            const f32x4 xa = *(const f32x4*)(xp + ks * 32), xc = *(const f32x4*)(xp + ks * 32 + 4);
            bf16x8 ah, al;
#pragma unroll
            for (int j = 0; j < 8; ++j) { const float v = (j < 4) ? xa[j] : xc[j - 4]; const unsigned h = f2bf(v); ah[j] = (short)h; al[j] = (short)f2bf(v - bf2f((bf16_t)h)); }
#pragma unroll
            for (int nb = 0; nb < 2; ++nb) { const size_t wo = (size_t)(nb * 16 + r16) * D + ks * 32 + kq * 8;
                const bf16x8 bh = *(const bf16x8*)(WRH + wo), bl = *(const bf16x8*)(WRL + wo);
                acc[nb] = __builtin_amdgcn_mfma_f32_16x16x32_bf16(ah, bh, acc[nb], 0, 0, 0);
                acc[nb] = __builtin_amdgcn_mfma_f32_16x16x32_bf16(al, bh, acc[nb], 0, 0, 0);
                acc[nb] = __builtin_amdgcn_mfma_f32_16x16x32_bf16(ah, bl, acc[nb], 0, 0, 0); }
        }
#pragma unroll
        for (int nb = 0; nb < 2; ++nb)
#pragma unroll
            for (int r = 0; r < 4; ++r) { const int tl = kq * 4 + r; const int tk = t0 + wave * 16 + tl; const float rs = 1.0f / sqrtf(SSQ2[tk] * (1.0f / D) + EPS);
                LG[tl * 33 + nb * 16 + r16] = acc[nb][r] * rs + br[nb * 16 + r16]; }
        LDS_WAIT(); __syncthreads();
        int te[4] = {0, 0, 0, 0}; float tg[4] = {0.f, 0.f, 0.f, 0.f}; int rk[4] = {0, 0, 0, 0};
        if (lane < 16) {
            float tv[4] = {-INFINITY, -INFINITY, -INFINITY, -INFINITY};
            for (int e = 0; e < NE; ++e) { const float v = LG[lane * 33 + e];
                if (v > tv[3]) { if (v > tv[2]) { tv[3] = tv[2]; te[3] = te[2]; if (v > tv[1]) { tv[2] = tv[1]; te[2] = te[1]; if (v > tv[0]) { tv[1] = tv[0]; te[1] = te[0]; tv[0] = v; te[0] = e; } else { tv[1] = v; te[1] = e; } } else { tv[2] = v; te[2] = e; } } else { tv[3] = v; te[3] = e; } } }
            float gs = 0.f;
#pragma unroll
            for (int k = 0; k < 4; ++k) { tg[k] = __expf(tv[k] - tv[0]); gs += tg[k]; }
            gs = 1.0f / gs;
#pragma unroll
            for (int k = 0; k < 4; ++k) { tg[k] *= gs; rk[k] = __hip_atomic_fetch_add(hist + te[k], 1, __ATOMIC_RELAXED, __HIP_MEMORY_SCOPE_WORKGROUP); }
        }
        LDS_WAIT(); __syncthreads();
        if (tid < 32) { const int n = hist[tid]; base[tid] = n ? atomicAdd(CNT + tid, n) : 0; }
        LDS_WAIT(); __syncthreads();
        if (lane < 16) { const int tk = t0 + wave * 16 + lane;
#pragma unroll
            for (int k = 0; k < 4; ++k) { const size_t p = (size_t)te[k] * LCAP + base[te[k]] + rk[k]; LSLOT[p] = tk * 4 + k; LGATE[p] = tg[k]; } }
        LDS_WAIT(); __syncthreads();
    }
}

__device__ __forceinline__ void moe_table(const Args& a, volatile LAS unsigned* MISC, int tid) {
    const int* CNT = (const int*)(a.ws + OFF_CNT);
    if (tid < 32) MISC[16 + tid] = (unsigned)CNT[tid];
    LDS_WAIT(); __syncthreads();
    if (tid == 0) { unsigned tb = 0; for (int e = 0; e < NE; ++e) { MISC[48 + e] = tb; tb += (MISC[16 + e] + 255u) >> 8; } MISC[48 + NE] = tb; }
    LDS_WAIT(); __syncthreads();
}
template <int NPN, bool W1> struct SchedMoE {
    int G, c; unsigned char* ws; volatile LAS unsigned* MISC;
    __device__ __forceinline__ bool next(int i, pg8::Unit& u) const {
        const int T = __builtin_amdgcn_readfirstlane((int)MISC[48 + NE]); const int NU = T * NPN; const int L = i * G + c; if (L >= NU) return false;
        const int w = pg8::xcd_remap(L, NU);
        int e = 0;
#pragma unroll
        for (int s = 16; s >= 1; s >>= 1) { if ((int)MISC[48 + e + s] * NPN <= w) e += s; }
        e = __builtin_amdgcn_readfirstlane(e);
        const int tb = __builtin_amdgcn_readfirstlane((int)MISC[48 + e]), cnt = __builtin_amdgcn_readfirstlane((int)MISC[16 + e]), nte = (cnt + 255) >> 8; const int idx = w - tb * NPN, pn = __builtin_amdgcn_readfirstlane(idx / nte), mt = idx - pn * nte;
        u.pm = tb + mt; u.pn = pn; u.i1 = e; const int nv = cnt - mt * 256; u.i0 = nv < 256 ? nv : 256;
        u.p3 = (int*)(ws + WS_LSLOT) + (size_t)e * LCAP + mt * 256; u.p2 = (float*)(ws + WS_LGATE) + (size_t)e * LCAP + mt * 256; u.p0 = nullptr; u.p1 = nullptr;
        if (W1) { u.A = (const char*)(ws + WS_S0); u.B = (const char*)(ws + WS_W1) + ((size_t)e * 2 * DFF + pn * 256) * D * 2; }
        else { u.A = (const char*)(ws + WS_ACT) + (size_t)(tb + mt) * 256 * DFF * 2; u.B = (const char*)(ws + WS_W2) + ((size_t)e * D + pn * 256) * DFF * 2; }
        return true;
    }
};
struct EpiSwiGLU {
    static constexpr bool PERM = true; static constexpr int MIDK = -1; const float* ssq2; const float* b1; bf16_t* act;
    __device__ __forceinline__ void midk(f32x4 (&)[2][2][4][2], const pg8::Unit&, int, int) const {}
    __device__ __forceinline__ void operator()(f32x4 (&acc)[2][2][4][2], const pg8::Unit& u, int wr, int wc, int fr, int fq, int, int, LAS unsigned char*) const {
        const int e = u.i1, nvalid = u.i0; const int* slots = (const int*)u.p3; int r0 = wr * 64 + fr, c0 = wc * 32 + 8 * fq; asm volatile("" : "+v"(r0), "+v"(c0));     const int gc0 = u.pn * 128 + c0;
        f32x4 bg[2], bu[2];
#pragma unroll
        for (int n = 0; n < 2; ++n) { bg[n] = *(const f32x4*)(b1 + (size_t)e * 2 * DFF + gc0 + 4 * n); bu[n] = *(const f32x4*)(b1 + (size_t)e * 2 * DFF + DFF + gc0 + 4 * n); }
#pragma unroll
        for (int ai = 0; ai < 2; ++ai)
#pragma unroll
            for (int m = 0; m < 4; ++m) { const int r = r0 + ai * 128 + m * 16; const bool valid = r < nvalid; const int tok = valid ? (slots[r] >> 2) : 0;
                const float rs = 1.0f / sqrtf(ssq2[tok] * (1.0f / D) + EPS); unsigned wv[4];
#pragma unroll
                for (int n = 0; n < 2; ++n) { float o[4];
#pragma unroll
                    for (int j = 0; j < 4; ++j) { float g = acc[ai][0][m][n][j] * rs + bg[n][j], up = acc[ai][1][m][n][j] * rs + bu[n][j];
                        g = fminf(g, SW_LIMIT); up = fminf(fmaxf(up, -SW_LIMIT), SW_LIMIT);
                        o[j] = (up + 1.0f) * g * __builtin_amdgcn_rcpf(1.0f + __builtin_amdgcn_exp2f(-SW_ALPHA * LOG2E * g)); }
                    wv[2 * n] = pg8::cvt_pk_bf16(o[0], o[1]); wv[2 * n + 1] = pg8::cvt_pk_bf16(o[2], o[3]); }
                if (valid) *(u32x4*)(act + ((size_t)u.pm * 256 + r) * DFF + gc0) = (u32x4){wv[0], wv[1], wv[2], wv[3]}; }
    }
};
struct EpiW2 {
    static constexpr bool PERM = true; static constexpr int MIDK = -1; const float* b2; bf16_t* Y;
    __device__ __forceinline__ void midk(f32x4 (&)[2][2][4][2], const pg8::Unit&, int, int) const {}
    __device__ __forceinline__ void operator()(f32x4 (&acc)[2][2][4][2], const pg8::Unit& u, int wr, int wc, int fr, int fq, int, int, LAS unsigned char*) const {
        const int e = u.i1, nvalid = u.i0; const int* slots = (const int*)u.p3; const float* gates = (const float*)u.p2; int r0 = wr * 64 + fr, c0 = u.pn * 256 + wc * 32 + 8 * fq; asm volatile("" : "+v"(r0), "+v"(c0));
        f32x4 bv[2][2];
#pragma unroll
        for (int bj = 0; bj < 2; ++bj)
#pragma unroll
            for (int n = 0; n < 2; ++n) bv[bj][n] = *(const f32x4*)(b2 + (size_t)e * D + c0 + bj * 128 + 4 * n);
#pragma unroll
        for (int ai = 0; ai < 2; ++ai)
#pragma unroll
            for (int m = 0; m < 4; ++m) { const int r = r0 + ai * 128 + m * 16; const bool valid = r < nvalid; const int slot = valid ? slots[r] : 0; const float g = valid ? gates[r] : 0.f;
#pragma unroll
                for (int bj = 0; bj < 2; ++bj) { const f32x4 v0 = (acc[ai][bj][m][0] + bv[bj][0]) * g, v1 = (acc[ai][bj][m][1] + bv[bj][1]) * g;
                    u32x4 w; w.x = pg8::cvt_pk_bf16(v0[0], v0[1]); w.y = pg8::cvt_pk_bf16(v0[2], v0[3]); w.z = pg8::cvt_pk_bf16(v1[0], v1[1]); w.w = pg8::cvt_pk_bf16(v1[2], v1[3]);
                    if (valid) *(u32x4*)(Y + (size_t)slot * D + c0 + bj * 128) = w; } }
    }
};

__device__ __forceinline__ void p11_final(const Args& a, int vcu, int G, int wave, int lane) {
    float* out = a.out; const bf16_t* Y = (const bf16_t*)(a.ws + WS_Y); const float* gf = a.in[21];
    const int gw = vcu * NWAVES + wave, NGW = G * NWAVES;
    f32x4 g4[4];
#pragma unroll
    for (int j = 0; j < 4; ++j) g4[j] = *(const f32x4*)(gf + 4 * lane + 256 * j);
    for (int tok = gw; tok < NTOK; tok += NGW) {
        f32x4 v[4]; float s = 0.f;
#pragma unroll
        for (int j = 0; j < 4; ++j) { v[j] = *(const f32x4*)(out + (size_t)tok * D + 4 * lane + 256 * j);
#pragma unroll
            for (int k = 0; k < 4; ++k) { const unsigned long long w = *(const unsigned long long*)(Y + ((size_t)tok * 4 + k) * D + 4 * lane + 256 * j);
                v[j][0] += __builtin_bit_cast(float, (unsigned)(w << 16)); v[j][1] += __builtin_bit_cast(float, (unsigned)w & 0xffff0000u);
                v[j][2] += __builtin_bit_cast(float, (unsigned)(w >> 32) << 16); v[j][3] += __builtin_bit_cast(float, (unsigned)(w >> 32) & 0xffff0000u); }
            s += (v[j][0] * v[j][0] + v[j][1] * v[j][1]) + (v[j][2] * v[j][2] + v[j][3] * v[j][3]); }
        const float rs = 1.0f / sqrtf(wave_sum(s) * (1.0f / D) + EPS);
#pragma unroll
        for (int j = 0; j < 4; ++j) *(f32x4*)(out + (size_t)tok * D + 4 * lane + 256 * j) = v[j] * rs * g4[j];
    }
}
typedef float f32x16 __attribute__((ext_vector_type(16)));
typedef short s16x4 __attribute__((ext_vector_type(4)));
__device__ __forceinline__ int crow(int r, int hi) { return (r & 3) + 8 * (r >> 2) + 4 * hi; }
constexpr int SB_FLAG_OFF = 32768, SB_STG_OFF = 36864;
__device__ __forceinline__ void sb_unit(int b, int h, int qb, const bf16_t* QKVU, bf16_t* MIXED, float* SSQSB, LAS unsigned char* shm, int wid, int lane) {
    const int r32 = lane & 31, hi = lane >> 5;
    const size_t rowbase = (size_t)b * S; const int q0 = qb * 256;
    const bf16_t* Qw = QKVU + (rowbase + q0 + wid * 32) * INP + h * HD;
    const bf16_t* Kh = QKVU + rowbase * INP + SBW + h * HD; const bf16_t* Vh = Kh + SBW;
    bf16x8 qr[4];
#pragma unroll
    for (int d0 = 0; d0 < 4; ++d0) qr[d0] = *(const bf16x8*)(Qw + (size_t)r32 * INP + d0 * 16 + hi * 8);
    f32x16 o[2];
#pragma unroll
    for (int r = 0; r < 16; ++r) { o[0][r] = 0.f; o[1][r] = 0.f; }
    float carry = 1.0f; bool alive = true;
    const int jtop = 4 * qb + 3, jmax_w = 4 * qb + (wid >> 1);
    const int qabs = q0 + wid * 32 + r32;
    const bf16_t* ksrc = Kh + (size_t)lane * INP + wid * 8;
    const bf16_t* vsrc = Vh + (size_t)(16 * (wid & 3) + (lane >> 2)) * INP + (wid >> 2) * 32 + (lane & 3) * 8;
    const int stoff = wid * 1024 + lane * 16;
    LAS unsigned* flags = (LAS unsigned*)(shm + SB_FLAG_OFF);
    u32x4 kreg = *(const u32x4*)(ksrc + (size_t)jtop * 64 * INP), vreg = *(const u32x4*)(vsrc + (size_t)jtop * 64 * INP);
    int p = 0;
    for (int j = jtop; j >= 0; --j) {
        LAS unsigned char* Kb = shm + p * 16384; LAS unsigned char* Vb = Kb + 8192;
        *(LAS u32x4*)(Kb + stoff) = kreg; *(LAS u32x4*)(Vb + stoff) = vreg;
        LDS_WAIT(); __syncthreads();
        if (j < jtop) { const LAS unsigned* fl = flags + (p ^ 1) * 8; const unsigned any = (fl[0] | fl[1]) | (fl[2] | fl[3]) | (fl[4] | fl[5]) | (fl[6] | fl[7]);
            if (__builtin_amdgcn_readfirstlane(any) == 0u) break; }
        if (j > 0) { kreg = *(const u32x4*)(ksrc + (size_t)(j - 1) * 64 * INP); vreg = *(const u32x4*)(vsrc + (size_t)(j - 1) * 64 * INP); }
        if (j <= jmax_w && alive) {
            f32x16 p0, p1;
#pragma unroll
            for (int r = 0; r < 16; ++r) { p0[r] = 0.f; p1[r] = 0.f; }
            const LAS unsigned char* kb = Kb + hi * 1024 + r32 * 16;
#pragma unroll
            for (int d0 = 0; d0 < 4; ++d0) { const bf16x8 b0 = *(const LAS bf16x8*)(kb + d0 * 2048), b1 = *(const LAS bf16x8*)(kb + d0 * 2048 + 512);
                p0 = __builtin_amdgcn_mfma_f32_32x32x16_bf16(b0, qr[d0], p0, 0, 0, 0); p1 = __builtin_amdgcn_mfma_f32_32x32x16_bf16(b1, qr[d0], p1, 0, 0, 0); }
            const bool diag = (j == jmax_w); const int kbase = 64 * j + 4 * hi;
#pragma unroll
            for (int r = 0; r < 16; ++r) { const int k0 = kbase + (r & 3) + 8 * (r >> 2);
                float e0 = __builtin_amdgcn_exp2f(p0[r]), e1 = __builtin_amdgcn_exp2f(p1[r]);
                float r0 = __builtin_amdgcn_rcpf(1.0f + e0), r1 = __builtin_amdgcn_rcpf(1.0f + e1);
                if (diag) { if (k0 >= qabs) r0 = 1.0f; if (k0 + 32 >= qabs) r1 = 1.0f; }
                p0[r] = r0; p1[r] = r1; }
            float sfx[8][3], A[8];
#pragma unroll
            for (int i = 0; i < 8; ++i) { const float x0 = (i < 4) ? p0[4 * i] : p1[4 * i - 16], x1 = (i < 4) ? p0[4 * i + 1] : p1[4 * i - 15], x2 = (i < 4) ? p0[4 * i + 2] : p1[4 * i - 14], x3 = (i < 4) ? p0[4 * i + 3] : p1[4 * i - 13];
                sfx[i][2] = x3; sfx[i][1] = x3 * x2; sfx[i][0] = sfx[i][1] * x1; A[i] = sfx[i][0] * x0; }
            float T = carry, E[8];
#pragma unroll
            for (int i = 7; i >= 0; --i) { const auto sw = __builtin_amdgcn_permlane32_swap(__float_as_uint(A[i]), __float_as_uint(A[i]), false, false);
                const float own_or_a = __uint_as_float(sw[0]), own_or_b = __uint_as_float(sw[1]);
                const float partner = hi ? own_or_a : own_or_b;
                E[i] = hi ? T : T * partner; T = T * (A[i] * partner); }
            carry = T;
            unsigned pw[4][4];
#pragma unroll
            for (int i = 0; i < 8; ++i) { float w4[4];
#pragma unroll
                for (int jj = 0; jj < 4; ++jj) { const float rv = (i < 4) ? p0[4 * i + jj] : p1[4 * i - 16 + jj]; const float beta = 1.0f - rv;
                    w4[jj] = beta * ((jj == 3) ? E[i] : E[i] * sfx[i][jj]); }
                pw[i >> 1][(i & 1) * 2] = pg8::cvt_pk_bf16(w4[0], w4[1]); pw[i >> 1][(i & 1) * 2 + 1] = pg8::cvt_pk_bf16(w4[2], w4[3]); }
            const LAS unsigned char* vb = Vb + ((lane >> 4) & 1) * 32 + (lane & 3) * 8 + (4 * hi + ((lane & 15) >> 2)) * 64;
#pragma unroll
            for (int d0 = 0; d0 < 2; ++d0)
#pragma unroll
                for (int ks = 0; ks < 4; ++ks) {
                    const s16x4 lo = __builtin_bit_cast(s16x4, __builtin_amdgcn_ds_read_tr16_b64_v4i16((LAS s16x4*)(vb + d0 * 4096 + ks * 1024)));
                    const s16x4 hh = __builtin_bit_cast(s16x4, __builtin_amdgcn_ds_read_tr16_b64_v4i16((LAS s16x4*)(vb + d0 * 4096 + ks * 1024 + 512)));
                    const bf16x8 vf = (bf16x8){lo[0], lo[1], lo[2], lo[3], hh[0], hh[1], hh[2], hh[3]};
                    const bf16x8 pa = __builtin_bit_cast(bf16x8, (u32x4){pw[ks][0], pw[ks][1], pw[ks][2], pw[ks][3]});
                    o[d0] = __builtin_amdgcn_mfma_f32_32x32x16_bf16(pa, vf, o[d0], 0, 0, 0); }
            alive = __any(carry != 0.0f);
        }
        if (lane == 0) flags[p * 8 + wid] = (j > jmax_w || alive) ? 1u : 0u;
        p ^= 1;
    }
    LAS bf16_t* stg = (LAS bf16_t*)(shm + SB_STG_OFF + wid * 4096);
#pragma unroll
    for (int r = 0; r < 16; ++r) { const int orow = crow(r, hi);
#pragma unroll
        for (int d0 = 0; d0 < 2; ++d0) stg[orow * 64 + d0 * 32 + r32] = (bf16_t)f2bf(o[d0][r]); }
    LDS_WAIT();
    bf16_t* Ow = MIXED + (rowbase + q0 + wid * 32) * D + h * HD;
#pragma unroll
    for (int i = 0; i < 4; ++i) { const int row = i * 8 + (lane >> 3), ch = lane & 7; const u32x4 v = *(const LAS u32x4*)(stg + row * 64 + ch * 8);
        *(u32x4*)(Ow + (size_t)row * D + ch * 8) = v; float q = 0.f;
#pragma unroll
        for (int k = 0; k < 4; ++k) { const float a = __builtin_bit_cast(float, v[k] << 16), c = __builtin_bit_cast(float, v[k] & 0xffff0000u); q += a * a + c * c; }
        q += __shfl_xor(q, 1); q += __shfl_xor(q, 2); q += __shfl_xor(q, 4);
        if (ch == 0) unsafeAtomicAdd(SSQSB + rowbase + q0 + wid * 32 + row, q); }
    LDS_WAIT(); __syncthreads();
}

constexpr int PL_PITCH = 1040, PL_PART_OFF = 83968, PL_RSTD_OFF = 86016;
__device__ __forceinline__ void pool_unit(int tile, const bf16_t* QKVU, const bf16_t* WPT, bf16_t* MIXED, LAS unsigned char* shm, int wid, int lane) {
    const int tok0 = tile * 64, tpos0 = tok0 & (S - 1); const int tid = wid * 64 + lane;
    for (int c = tid; c < 79 * 64; c += NWAVES * 64) { const int row = c >> 6, ch = c & 63; const int t = tpos0 - 15 + row;
        u32x4 v = (u32x4){0u, 0u, 0u, 0u}; if (t >= 0) v = *(const u32x4*)(QKVU + (size_t)(tok0 - 15 + row) * INP + 3 * SBW + ch * 8);
        *(LAS u32x4*)(shm + row * PL_PITCH + ch * 16) = v; }
    LDS_WAIT(); __syncthreads();
    const int g = wid >> 1, eh = wid & 1, r16 = lane & 15, kq = lane >> 4; const int win = 2 << g;
    bf16x8 Bf[4][4];
#pragma unroll
    for (int nb = 0; nb < 4; ++nb)
#pragma unroll
        for (int ks = 0; ks < 4; ++ks) Bf[nb][ks] = *(const bf16x8*)(WPT + ((size_t)(g * PGD + eh * 64 + nb * 16 + r16)) * PGD + ks * 32 + kq * 8);
    f32x4 acc[4][4];
#pragma unroll
    for (int mb = 0; mb < 4; ++mb) {
        const int lrow = 15 + mb * 16 + r16; const int n = (tpos0 + mb * 16 + r16 + 1 < win) ? tpos0 + mb * 16 + r16 + 1 : win; const float inv = 1.0f / (float)n;
        bf16x8 Af[4];
#pragma unroll
        for (int ks = 0; ks < 4; ++ks) { float s[8];
#pragma unroll
            for (int q = 0; q < 8; ++q) s[q] = 0.f;
            const LAS unsigned char* up = shm + lrow * PL_PITCH + (g * PGD + ks * 32 + kq * 8) * 2;
            for (int jw = 0; jw < win; ++jw) { const u32x4 v = *(const LAS u32x4*)(up - jw * PL_PITCH);
#pragma unroll
                for (int k = 0; k < 4; ++k) { s[2 * k] += __builtin_bit_cast(float, v[k] << 16); s[2 * k + 1] += __builtin_bit_cast(float, v[k] & 0xffff0000u); } }
            const u32x4 self = *(const LAS u32x4*)up; u32x4 pk;
#pragma unroll
            for (int k = 0; k < 4; ++k) pk[k] = pg8::cvt_pk_bf16(s[2 * k] * inv - __builtin_bit_cast(float, self[k] << 16), s[2 * k + 1] * inv - __builtin_bit_cast(float, self[k] & 0xffff0000u));
            Af[ks] = __builtin_bit_cast(bf16x8, pk); }
#pragma unroll
        for (int nb = 0; nb < 4; ++nb) { f32x4 a = (f32x4){0.f, 0.f, 0.f, 0.f};
#pragma unroll
            for (int ks = 0; ks < 4; ++ks) a = __builtin_amdgcn_mfma_f32_16x16x32_bf16(Af[ks], Bf[nb][ks], a, 0, 0, 0);
            acc[mb][nb] = a; }
    }
    LAS float* part = (LAS float*)(shm + PL_PART_OFF); LAS float* rstd = (LAS float*)(shm + PL_RSTD_OFF);
#pragma unroll
    for (int mb = 0; mb < 4; ++mb)
#pragma unroll
        for (int r = 0; r < 4; ++r) { float q = 0.f;
#pragma unroll
            for (int nb = 0; nb < 4; ++nb) q += acc[mb][nb][r] * acc[mb][nb][r];
            q += __shfl_xor(q, 1); q += __shfl_xor(q, 2); q += __shfl_xor(q, 4); q += __shfl_xor(q, 8);
            if (r16 == 0) part[wid * 64 + mb * 16 + kq * 4 + r] = q; }
    LDS_WAIT(); __syncthreads();
    if (tid < 64) { float q = 0.f;
#pragma unroll
        for (int w = 0; w < 8; ++w) q += part[w * 64 + tid];
        rstd[tid] = 1.0f / sqrtf(q * (1.0f / PW) + EPS); }
    LDS_WAIT(); __syncthreads();
#pragma unroll
    for (int mb = 0; mb < 4; ++mb)
#pragma unroll
        for (int r = 0; r < 4; ++r) { const int row = mb * 16 + kq * 4 + r; const float rs = rstd[row]; bf16_t* op = MIXED + (size_t)(tok0 + row) * D + SBW + g * PGD + eh * 64 + r16;
#pragma unroll
            for (int nb = 0; nb < 4; ++nb) op[nb * 16] = (bf16_t)f2bf(acc[mb][nb][r] * rs); }
    LDS_WAIT(); __syncthreads();
}
__device__ __forceinline__ void p2_mix(const Args& a, LAS unsigned char* lds, int bx, int G, int wid, int lane) {
    unsigned char* ws = a.ws; const bf16_t* QKVU = (const bf16_t*)(ws + WS_QKVU); bf16_t* MIXED = (bf16_t*)(ws + WS_MIXED); float* SSQSB = (float*)(ws + OFF_SSQSB);
    constexpr int NA = B * NH * (S / 256);
    for (int i = 0; i * G + bx < NA; ++i) { const int w = pg8::xcd_remap(i * G + bx, NA); const int bh = w >> 4, qb = w & 15; sb_unit(bh >> 3, bh & 7, qb, QKVU, MIXED, SSQSB, lds + RING_OFF, wid, lane); }
    for (int t = bx; t < NTOK / 64; t += G) pool_unit(t, QKVU, (const bf16_t*)(ws + WS_WP), MIXED, lds + RING_OFF, wid, lane);
}
constexpr size_t BAR_REGION_OFF = 1 * MiB, BAR_REGION_STRIDE = 16 * 1024;
__global__ void __launch_bounds__(NWAVES * 64, 2) mega(Args args) {
    const int li = args.li;
    extern __shared__ __attribute__((aligned(16))) unsigned char lds_raw[];
    LAS unsigned char* lds = (LAS unsigned char*)lds_raw;
    volatile LAS unsigned* MISC = (volatile LAS unsigned*)(lds + MISC_OFF);
    const int wave = __builtin_amdgcn_readfirstlane((int)threadIdx.x >> 6);
#define LANE_ID() ({ int l_; asm volatile("v_mbcnt_lo_u32_b32 %0, -1, 0\n\tv_mbcnt_hi_u32_b32 %0, -1, %0" : "=v"(l_)); l_; })
    const int G = gridDim.x; const int bx = blockIdx.x; const int vcu = (G % 8 == 0) ? (bx % 8) * (G / 8) + bx / 8 : bx;
    for (int u = wave * 64 + LANE_ID(); u < MISC_BYTES / 4; u += NWAVES * 64) MISC[u] = 0u;
    __syncthreads();
    unsigned char* ws = args.ws;
    XcdBarrier bar = xcd_barrier_post((unsigned*)(ws + BAR_REGION_OFF + (size_t)li * BAR_REGION_STRIDE), MISC + 8);
    const int lo = args.ph_lo, hi = args.ph_hi;
    LAS unsigned char* ring = lds + RING_OFF; LAS unsigned char* epi = lds + EPI_OFF; LAS unsigned* gtab = (LAS unsigned*)(lds + GTAB_OFF);
#define IN(k) (lo <= (k) && (k) < hi)
#define SEAM(k) do { if (IN(k) && IN((k) + 1)) xcd_barrier(bar); } while (0)
    if (IN(0)) { p0_prologue(args, lds, vcu, G, wave, LANE_ID()); SEAM(0); }
    if (IN(1)) { SchedP1 S{G, bx, ws}; pg8::EpiBf16S E; pg8::gemm_phase<pg8::EpiBf16S, SchedP1, false>(wave, ring, epi, gtab, D * 2, D * 2, D / 64, S, E); SEAM(1); }
    {
    const float* xin0 = args.in[0]; float* outp = args.out;
    bf16_t* S0p = (bf16_t*)(ws + WS_S0); float* SSQSBp = (float*)(ws + OFF_SSQSB); float* SSQ1p = (float*)(ws + OFF_SSQ1); float* SSQ2p = (float*)(ws + OFF_SSQ2);
    constexpr size_t TSTEP = (size_t)256 * D * 2;
    #if !defined(PH_ONLY) || PH_ONLY == 2
    if (IN(2)) { p2_mix(args, lds, bx, G, wave, LANE_ID()); SEAM(2); }
#endif

#if !defined(PH_ONLY) || PH_ONLY == 3
    if (IN(3)) { SchedReg S{G, bx, NTOK / 256, D / 256, (const char*)(ws + WS_MIXED), (const char*)(ws + WS_WOUT), TSTEP, TSTEP, nullptr, D, nullptr, nullptr};
        EpiResid<8> E{xin0, outp, S0p, SSQ1p, SSQSBp}; pg8::gemm_phase<EpiResid<8>, SchedReg, false>(wave, ring, epi, gtab, D * 2, D * 2, D / 64, S, E); SEAM(3); }
#endif
#if !defined(PH_ONLY) || PH_ONLY == 4
    if (IN(4)) { SchedReg S{G, bx, NTOK / 256, D / 256, (const char*)(ws + WS_S0), (const char*)(ws + WS_WQ), TSTEP, TSTEP, (bf16_t*)(ws + WS_QM), D, SSQ1p, nullptr};
        EpiBf16Ssq E{1.0f / D, C2_MEM}; pg8::gemm_phase<EpiBf16Ssq, SchedReg, false>(wave, ring, epi, gtab, D * 2, D * 2, D / 64, S, E); SEAM(4); }
#endif
#if !defined(PH_ONLY) || PH_ONLY == 5
    if (IN(5)) { SchedMS S{G, bx, ws}; EpiSoftmax E; pg8::gemm_phase<EpiSoftmax, SchedMS, false>(wave, ring, epi, gtab, D * 2, D * 2, MHD / 64, S, E); SEAM(5); }
#endif
#if !defined(PH_ONLY) || PH_ONLY == 6
    if (IN(6)) { SchedPV S{G, bx, ws}; pg8::EpiBf16S E; pg8::gemm_phase<pg8::EpiBf16S, SchedPV, false>(wave, ring, epi, gtab, D * 2, NMEM * 2, NMEM / 64, S, E); SEAM(6); }
#endif
#if !defined(PH_ONLY) || PH_ONLY == 7
    if (IN(7)) { SchedReg S{G, bx, NTOK / 256, D / 256, (const char*)(ws + WS_OM), (const char*)(ws + WS_WO), TSTEP, TSTEP, nullptr, D, nullptr, nullptr};
        EpiResid<-1> E{outp, outp, S0p, SSQ2p, nullptr}; pg8::gemm_phase<EpiResid<-1>, SchedReg, false>(wave, ring, epi, gtab, D * 2, D * 2, D / 64, S, E); SEAM(7); }
#endif
#if !defined(PH_ONLY) || PH_ONLY == 8
    if (IN(8)) { p8_route(args, lds, bx, G, wave, LANE_ID()); SEAM(8); }
#endif
#if !defined(PH_ONLY) || PH_ONLY == 9
    if (IN(9)) { moe_table(args, MISC, wave * 64 + LANE_ID()); SchedMoE<8, true> S{G, bx, ws, MISC}; EpiSwiGLU E{SSQ2p, args.in[18], (bf16_t*)(ws + WS_ACT)};
        pg8::gemm_phase<EpiSwiGLU, SchedMoE<8, true>, true>(wave, ring, epi, gtab, D * 2, D * 2, D / 64, S, E); SEAM(9); }
#endif
#if !defined(PH_ONLY) || PH_ONLY == 10
    if (IN(10)) { moe_table(args, MISC, wave * 64 + LANE_ID()); SchedMoE<4, false> S{G, bx, ws, MISC}; EpiW2 E{args.in[20], (bf16_t*)(ws + WS_Y)};
        pg8::gemm_phase<EpiW2, SchedMoE<4, false>, false>(wave, ring, epi, gtab, DFF * 2, DFF * 2, DFF / 64, S, E); SEAM(10); }
#endif
#if !defined(PH_ONLY) || PH_ONLY == 11
    if (IN(11)) { p11_final(args, vcu, G, wave, LANE_ID()); }
#endif
}

#undef IN
#undef SEAM
}
}

#ifndef MEGA_MASK
#define MEGA_MASK 0xFFF
#endif
extern "C" void kernel_launch(void* const* d_in, const int* in_sizes, int n_in, void* d_out, int out_size, void* d_ws, size_t ws_size, hipStream_t stream) {
    if (n_in != 22 || out_size != NTOK * D || ws_size < WS_END) { fprintf(stderr, "kernel_launch: unexpected shapes (n_in %d out %d ws %zu)\n", n_in, out_size, ws_size); return; }
    static int grid = 0;
    if (grid == 0) {
        int dev = 0, cus = 0;
        if (hipGetDevice(&dev) != hipSuccess || hipDeviceGetAttribute(&cus, hipDeviceAttributeMultiprocessorCount, dev) != hipSuccess) { grid = -1; return; }
        if (hipFuncSetAttribute((const void*)mk::mega, hipFuncAttributeMaxDynamicSharedMemorySize, mk::LDS_BYTES) != hipSuccess) { fprintf(stderr, "kernel_launch: hipFuncSetAttribute failed\n"); grid = -1; return; }
        int per_cu = 0; (void)hipOccupancyMaxActiveBlocksPerMultiprocessor(&per_cu, (const void*)mk::mega, mk::NWAVES * 64, mk::LDS_BYTES); (void)hipGetLastError();
        if (per_cu < 1) fprintf(stderr, "kernel_launch: occupancy query reports %d blocks per CU\n", per_cu);
        grid = cus;
    }
    if (grid < 0) return;
    const float* x = (const float*)d_in[0]; const float* mem = (const float*)d_in[1]; const float* g_mix = (const float*)d_in[2]; const float* w_in = (const float*)d_in[3];
    const float* g_sb = (const float*)d_in[4]; const float* g_pool = (const float*)d_in[5]; const float* w_pool = (const float*)d_in[6]; const float* pool_scale = (const float*)d_in[7];
    const float* w_out = (const float*)d_in[8]; const float* g_mem_q = (const float*)d_in[9]; const float* g_mem_kv = (const float*)d_in[10]; const float* w_mem_q = (const float*)d_in[11];
    const float* w_mem_kv = (const float*)d_in[12]; const float* w_mem_o = (const float*)d_in[13]; const float* g_ffn = (const float*)d_in[14]; const float* w_router = (const float*)d_in[15];
    const float* b_router = (const float*)d_in[16]; const float* w_e_in = (const float*)d_in[17]; const float* b_e_in = (const float*)d_in[18]; const float* w_e_out = (const float*)d_in[19];
    const float* b_e_out = (const float*)d_in[20]; const float* g_final = (const float*)d_in[21];
    float* out = (float*)d_out; unsigned char* ws = (unsigned char*)d_ws;
    bf16_t* WIN = (bf16_t*)(ws + WS_WIN); bf16_t* WOUT = (bf16_t*)(ws + WS_WOUT); bf16_t* WQ = (bf16_t*)(ws + WS_WQ); bf16_t* WKV = (bf16_t*)(ws + WS_WKV); bf16_t* WO = (bf16_t*)(ws + WS_WO);
    bf16_t* WP = (bf16_t*)(ws + WS_WP); float* WR = (float*)(ws + WS_WR); float* RSTDX = (float*)(ws + WS_RSTDX); float* RSTDM = (float*)(ws + WS_RSTDM);
    bf16_t* W1 = (bf16_t*)(ws + WS_W1); bf16_t* W2 = (bf16_t*)(ws + WS_W2); bf16_t* S0 = (bf16_t*)(ws + WS_S0); bf16_t* QKVU = (bf16_t*)(ws + WS_QKVU);
    bf16_t* QM = (bf16_t*)(ws + WS_QM); bf16_t* OM = (bf16_t*)(ws + WS_OM); bf16_t* MIXED = (bf16_t*)(ws + WS_MIXED); bf16_t* PM = (bf16_t*)(ws + WS_PM); bf16_t* ACT = (bf16_t*)(ws + WS_ACT);
    bf16_t* KM = (bf16_t*)(ws + WS_KM); bf16_t* VMT = (bf16_t*)(ws + WS_VMT); bf16_t* MEMB = (bf16_t*)(ws + WS_MEMB); int* LSLOT = (int*)(ws + WS_LSLOT); float* LGATE = (float*)(ws + WS_LGATE);
    bf16_t* Y = (bf16_t*)(ws + WS_Y); float* SCR_S = (float*)(ws + WS_SCR_S); bf16_t* POOLED = (bf16_t*)(ws + WS_SCR_POOLED); float* POOLO = (float*)(ws + WS_SCR_POOLO);
    int* CNT = (int*)(ws + OFF_CNT); float* SSQSB = (float*)(ws + OFF_SSQSB); float* SSQ1 = (float*)(ws + OFF_SSQ1); float* SSQ2 = (float*)(ws + OFF_SSQ2);

    (void)hipMemsetAsync(ws + WS_CTL, 0, CTL_BYTES, stream);
    mk::Args a{}; for (int i = 0; i < 22; ++i) a.in[i] = (const float*)d_in[i]; a.out = out; a.ws = ws;
    const dim3 tb(32, 8); const int BIG = 1 << 30; int li = 0;
    for (int p = 0; p < mk::NPHASE;) {
        if ((MEGA_MASK >> p) & 1) { int q = p; while (q < mk::NPHASE && ((MEGA_MASK >> q) & 1)) ++q;
            a.ph_lo = p; a.ph_hi = q; a.li = li; hipLaunchKernelGGL(mk::mega, dim3(grid), dim3(mk::NWAVES * 64), mk::LDS_BYTES, stream, a); ++li; p = q; continue; }
        switch (p) {
        case 0:
            nv::k_cvt_w<<<dim3(INP / 32, D / 32, 1), tb, 0, stream>>>(w_in, D, INP, WIN, INP, g_mix, nullptr, BIG, nullptr, 0, 0);
            nv::k_cvt_w<<<dim3(D / 32, D / 32, 1), tb, 0, stream>>>(w_out, D, D, WOUT, D, g_sb, g_pool, SBW, nullptr, 0, 0);
            nv::k_cvt_w<<<dim3(D / 32, D / 32, 1), tb, 0, stream>>>(w_mem_q, D, D, WQ, D, g_mem_q, nullptr, BIG, nullptr, 0, 0);
            nv::k_cvt_w<<<dim3(2 * D / 32, D / 32, 1), tb, 0, stream>>>(w_mem_kv, D, 2 * D, WKV, 2 * D, g_mem_kv, nullptr, BIG, nullptr, 0, 0);
            nv::k_cvt_w<<<dim3(D / 32, D / 32, 1), tb, 0, stream>>>(w_mem_o, D, D, WO, D, nullptr, nullptr, BIG, nullptr, 0, 0);
            nv::k_cvt_w<<<dim3(2 * DFF / 32, D / 32, NE), tb, 0, stream>>>(w_e_in, D, 2 * DFF, W1, 2 * DFF, g_ffn, nullptr, BIG, nullptr, 0, 1);
            nv::k_cvt_w<<<dim3(D / 32, DFF / 32, NE), tb, 0, stream>>>(w_e_out, DFF, D, W2, D, nullptr, nullptr, BIG, nullptr, 0, 0);
            nv::k_cvt_w<<<dim3(PGD / 32, PGD / 32, PG), tb, 0, stream>>>(w_pool, PGD, PGD, WP, PGD, nullptr, nullptr, BIG, pool_scale, PGD, 0);
            nv::k_cvt_router<<<NE * D / 256, 256, 0, stream>>>(w_router, g_ffn, WR);
            nv::k_rowstat_cvt<<<NTOK / 4, 256, 0, stream>>>(x, S0, RSTDX, NTOK);
            nv::k_rowstat_cvt<<<NMROWS / 4, 256, 0, stream>>>(mem, MEMB, RSTDM, NMROWS);
            break;
        case 1:
            nv::k_g1<<<dim3(INP / 64, NTOK / 64), 256, 0, stream>>>(S0, WIN, RSTDX, QKVU);
            nv::k_g1b<<<dim3(2 * D / 64, NMROWS / 64), 256, 0, stream>>>(MEMB, WKV, RSTDM, KM, VMT);
            break;
        case 2:
            nv::k_sb<<<B * NH * S / 256, 256, 0, stream>>>(QKVU, MIXED, SSQSB);
            nv::k_pool1<<<(unsigned)((size_t)NTOK * PW / 256), 256, 0, stream>>>(QKVU, POOLED);
            nv::k_pool2<<<dim3(PGD / 64, NTOK / 64, PG), 256, 0, stream>>>(POOLED, WP, POOLO);
            nv::k_pool3<<<NTOK / 4, 256, 0, stream>>>(POOLO, MIXED);
            break;
        case 3: nv::k_resid<<<dim3(D / 64, NTOK / 64), 256, 0, stream>>>(MIXED, WOUT, x, out, S0, SSQ1, SSQSB, SBW); break;
        case 4: nv::k_g3<<<dim3(D / 64, NTOK / 64), 256, 0, stream>>>(S0, WQ, SSQ1, QM); break;
        case 5:
            nv::k_ms<<<dim3(NMEM / 64, NTOK / 64, MH), 256, 0, stream>>>(QM, KM, SCR_S);
            nv::k_msoftmax<<<NTOK * MH / 4, 256, 0, stream>>>(SCR_S, PM);
            break;
        case 6: nv::k_mpv<<<dim3(MHD / 64, NTOK / 64, MH), 256, 0, stream>>>(PM, VMT, OM); break;
        case 7: nv::k_resid<<<dim3(D / 64, NTOK / 64), 256, 0, stream>>>(OM, WO, out, out, S0, SSQ2, SSQ2, -1); break;
        case 8: nv::k_route<<<NTOK / 4, 256, 0, stream>>>(out, SSQ2, WR, b_router, CNT, LSLOT, LGATE); break;
        case 9: nv::k_w1<<<dim3(DFF / 32, LCAP / 64, NE), 256, 0, stream>>>(S0, SSQ2, W1, b_e_in, CNT, LSLOT, ACT); break;
        case 10: nv::k_w2<<<dim3(D / 64, LCAP / 64, NE), 256, 0, stream>>>(ACT, W2, b_e_out, CNT, LSLOT, LGATE, Y); break;
        case 11: nv::k_final<<<NTOK / 4, 256, 0, stream>>>(out, Y, g_final); break;
        }
        ++p;
    }
}
```

```cpp
#include <hip/hip_runtime.h>
#include <cstdio>
#include <cstdint>

typedef unsigned short bf16_t;
typedef short bf16x8 __attribute__((ext_vector_type(8)));
typedef float f32x4 __attribute__((ext_vector_type(4)));
typedef unsigned u32x4 __attribute__((ext_vector_type(4)));

namespace cfg {
constexpr int B = 8, S = 4096, D = 1024, NTOK = B * S;
constexpr int SBW = 512, NH = 8, HD = 64, PW = 512, PG = 4, PGD = 128, INP = 2048;
constexpr int NMEM = 256, MH = 4, MHD = 256, NMROWS = B * NMEM;
constexpr int NE = 32, TOPK = 4, DFF = 1024, LCAP = NTOK;
constexpr float EPS = 1e-5f, LOG2E = 1.4426950408889634f;
constexpr float C2_SB = 0.125f * LOG2E, C2_MEM = 0.0625f * LOG2E;
constexpr float SW_LIMIT = 7.0f, SW_ALPHA = 1.702f;
constexpr int MAXTILES = 544;
constexpr size_t MiB = 1u << 20;
constexpr size_t WS_CTL = 0, CTL_BYTES = 2 * MiB;
constexpr size_t OFF_CNT = 64 * 1024, OFF_SSQSB = 512 * 1024, OFF_SSQ1 = 640 * 1024, OFF_SSQ2 = 768 * 1024;
constexpr size_t WS_WIN = 2 * MiB, WS_WOUT = 6 * MiB, WS_WQ = 8 * MiB, WS_WKV = 10 * MiB, WS_WO = 14 * MiB, WS_WP = 16 * MiB, WS_WR = 17 * MiB;
constexpr size_t WS_RSTDX = 18 * MiB, WS_RSTDM = 18 * MiB + 512 * 1024;
constexpr size_t WS_W1 = 20 * MiB, WS_W2 = 148 * MiB;
constexpr size_t WS_S0 = 212 * MiB;
constexpr size_t WS_QKVU = 276 * MiB;
constexpr size_t WS_QM = 276 * MiB, WS_OM = 340 * MiB;
constexpr size_t WS_MIXED = 404 * MiB;
constexpr size_t WS_PM = 404 * MiB;
constexpr size_t WS_ACT = 276 * MiB;
constexpr size_t WS_KM = 548 * MiB, WS_VMT = 552 * MiB, WS_MEMB = 556 * MiB, WS_LSLOT = 560 * MiB, WS_LGATE = 564 * MiB;
constexpr size_t WS_Y = 568 * MiB;
constexpr size_t WS_SCR_S = 568 * MiB, WS_SCR_POOLED = 696 * MiB, WS_SCR_POOLO = 728 * MiB;
constexpr size_t WS_END = 824 * MiB;
}
using namespace cfg;

__device__ __forceinline__ unsigned f2bf(float f) { unsigned u = __builtin_bit_cast(unsigned, f); return (u + 0x7fffu + ((u >> 16) & 1u)) >> 16; }
__device__ __forceinline__ float bf2f(bf16_t h) { return __builtin_bit_cast(float, (unsigned)h << 16); }
__device__ __forceinline__ float wave_sum(float v) {
#pragma unroll
    for (int o = 1; o < 64; o <<= 1) v += __shfl_xor(v, o);
    return v;
}

namespace nv {
__global__ void k_cvt_w(const float* src, int K, int N, bf16_t* dst, int ND, const float* gk, const float* gk2, int ksplit, const float* gn, int gnz, int mode) {
    __shared__ float t[32][33];
    const int nd0 = blockIdx.x * 32, k0 = blockIdx.y * 32, z = blockIdx.z;
    int ns0 = nd0;
    if (mode == 1) { const int pn = nd0 >> 8, j = nd0 & 255; ns0 = (j < 128) ? 128 * pn + j : 1024 + 128 * pn + (j - 128); }
    src += (size_t)z * K * N; dst += (size_t)z * ND * K;
    for (int i = threadIdx.y; i < 32; i += 8) { const int k = k0 + i, n = ns0 + threadIdx.x;
        float v = src[(size_t)k * N + n]; if (gk) v *= (k < ksplit) ? gk[k] : gk2[k - ksplit]; if (gn) v *= gn[z * gnz + n]; t[i][threadIdx.x] = v; }
    __syncthreads();
    for (int i = threadIdx.y; i < 32; i += 8) dst[(size_t)(nd0 + i) * K + k0 + threadIdx.x] = (bf16_t)f2bf(t[threadIdx.x][i]);
}
__global__ void k_cvt_router(const float* wr, const float* g, float* dst) {
    const int i = blockIdx.x * 256 + threadIdx.x; if (i >= NE * D) return; const int e = i / D, k = i % D; dst[i] = g[k] * wr[k * NE + e];
}
__global__ void k_rowstat_cvt(const float* x, bf16_t* xb, float* rstd, int rows) {
    const int row = blockIdx.x * 4 + (threadIdx.x >> 6), lane = threadIdx.x & 63; if (row >= rows) return;
    const float* xr = x + (size_t)row * D; float s = 0.f;
    for (int j = lane; j < D; j += 64) { const float v = xr[j]; s += v * v; xb[(size_t)row * D + j] = (bf16_t)f2bf(v); }
    s = wave_sum(s); if (lane == 0) rstd[row] = 1.0f / sqrtf(s * (1.0f / D) + EPS);
}

template <class RA, class RB, class MID, class EPI>
__device__ __forceinline__ void wave_gemm(int m0, int n0, int K, int kmid, RA ra, RB rb, MID mid, EPI epi) {
    const int lane = threadIdx.x & 63, r16 = lane & 15, kq = lane >> 4;
    const bf16_t* pa[2]; const bf16_t* pb[2];
#pragma unroll
    for (int i = 0; i < 2; ++i) { pa[i] = ra(m0 + i * 16 + r16) + kq * 8; pb[i] = rb(n0 + i * 16 + r16) + kq * 8; }
    f32x4 acc[2][2];
#pragma unroll
    for (int i = 0; i < 2; ++i)
#pragma unroll
        for (int j = 0; j < 2; ++j) acc[i][j] = (f32x4){0.f, 0.f, 0.f, 0.f};
    for (int k = 0; k < K; k += 32) {
        if (k == kmid) {
#pragma unroll
            for (int i = 0; i < 2; ++i)
#pragma unroll
                for (int r = 0; r < 4; ++r) { const float s = mid(m0 + i * 16 + kq * 4 + r); acc[i][0][r] *= s; acc[i][1][r] *= s; }
        }
        bf16x8 a[2], b[2];
#pragma unroll
        for (int i = 0; i < 2; ++i) { a[i] = *(const bf16x8*)(pa[i] + k); b[i] = *(const bf16x8*)(pb[i] + k); }
#pragma unroll
        for (int i = 0; i < 2; ++i)
#pragma unroll
            for (int j = 0; j < 2; ++j) acc[i][j] = __builtin_amdgcn_mfma_f32_16x16x32_bf16(a[i], b[j], acc[i][j], 0, 0, 0);
    }
#pragma unroll
    for (int i = 0; i < 2; ++i)
#pragma unroll
        for (int r = 0; r < 4; ++r) epi(m0 + i * 16 + kq * 4 + r, n0 + r16, n0 + 16 + r16, acc[i][0][r], acc[i][1][r]);
}
struct NoMid { __device__ float operator()(int) const { return 1.f; } };

#define NV_TILE() const int w = threadIdx.x >> 6, m0 = blockIdx.y * 64 + (w >> 1) * 32, n0 = blockIdx.x * 64 + (w & 1) * 32

__global__ void k_g1(const bf16_t* XB, const bf16_t* WT, const float* rstd, bf16_t* QKVU) {
    NV_TILE();
    wave_gemm(m0, n0, D, -1, [=](int r) { return XB + (size_t)r * D; }, [=](int c) { return WT + (size_t)c * D; }, NoMid(),
        [=](int r, int c0, int c1, float v0, float v1) { const float s = rstd[r];
            v0 *= s; v1 *= s; if (c0 < SBW) v0 *= C2_SB; if (c1 < SBW) v1 *= C2_SB;
            QKVU[(size_t)r * INP + c0] = (bf16_t)f2bf(v0); QKVU[(size_t)r * INP + c1] = (bf16_t)f2bf(v1); });
}
__global__ void k_g1b(const bf16_t* MEMB, const bf16_t* WT, const float* rstd, bf16_t* KM, bf16_t* VMT) {
    NV_TILE();
    wave_gemm(m0, n0, D, -1, [=](int r) { return MEMB + (size_t)r * D; }, [=](int c) { return WT + (size_t)c * D; }, NoMid(),
        [=](int r, int c0, int c1, float v0, float v1) { const float s = rstd[r]; const int cc[2] = {c0, c1}; const float vv[2] = {v0 * s, v1 * s};
#pragma unroll
            for (int q = 0; q < 2; ++q) { const int c = cc[q];
                if (c < D) KM[(size_t)r * D + c] = (bf16_t)f2bf(vv[q]);
                else VMT[((size_t)(r >> 8) * D + (c - D)) * NMEM + (r & 255)] = (bf16_t)f2bf(vv[q]); } });
}
__global__ void __launch_bounds__(256) k_sb(const bf16_t* QKVU, bf16_t* MIXED, float* SSQSB) {
    const int gid = blockIdx.x * 256 + threadIdx.x; const int t = gid & (S - 1), h = (gid >> 12) & 7, b = gid >> 15;
    const bf16_t* base = QKVU + (size_t)b * S * INP;
    float q[HD], o[HD];
    { const bf16_t* qp = base + (size_t)t * INP + h * HD;
#pragma unroll
      for (int d = 0; d < HD; ++d) { q[d] = bf2f(qp[d]); o[d] = 0.f; } }
    float P = 1.f;
    for (int s = t - 1; s >= 0; --s) {
        const bf16_t* kp = base + (size_t)s * INP + SBW + h * HD; const bf16_t* vp = kp + SBW;
        float z = 0.f;
#pragma unroll
        for (int d = 0; d < HD; ++d) z += q[d] * bf2f(kp[d]);
        const float e = exp2f(z), r = 1.0f / (1.0f + e), beta = 1.0f - r;
        const float w = bf2f((bf16_t)f2bf(beta * P));
#pragma unroll
        for (int d = 0; d < HD; ++d) o[d] += w * bf2f(vp[d]);
        P *= r;
        if (P == 0.f) break;
    }
    float ss = 0.f; bf16_t* op = MIXED + (size_t)(b * S + t) * D + h * HD;
#pragma unroll
    for (int d = 0; d < HD; ++d) { ss += o[d] * o[d]; op[d] = (bf16_t)f2bf(o[d]); }
    unsafeAtomicAdd(SSQSB + b * S + t, ss);
}
__global__ void k_pool1(const bf16_t* QKVU, bf16_t* POOLED) {
    const size_t gid = (size_t)blockIdx.x * 256 + threadIdx.x; const int c = gid & 511; const int tok = (int)(gid >> 9), t = tok & (S - 1);
    const int win = 2 << (c >> 7); const int n = (t + 1 < win) ? t + 1 : win;
    const bf16_t* up = QKVU + (size_t)tok * INP + 3 * SBW + c; float s = 0.f;
    for (int j = 0; j < n; ++j) s += bf2f(up[-(ptrdiff_t)j * INP]);
    POOLED[gid] = (bf16_t)f2bf(s / (float)n - bf2f(up[0]));
}
__global__ void k_pool2(const bf16_t* POOLED, const bf16_t* WPT, float* POOLO) {
    NV_TILE(); const int g = blockIdx.z;
    wave_gemm(m0, n0, PGD, -1, [=](int r) { return POOLED + (size_t)r * PW + g * PGD; }, [=](int c) { return WPT + ((size_t)g * PGD + c) * PGD; }, NoMid(),
        [=](int r, int c0, int c1, float v0, float v1) { POOLO[(size_t)r * PW + g * PGD + c0] = v0; POOLO[(size_t)r * PW + g * PGD + c1] = v1; });
}
__global__ void k_pool3(const float* POOLO, bf16_t* MIXED) {
    const int tok = blockIdx.x * 4 + (threadIdx.x >> 6), lane = threadIdx.x & 63;
    float v[8], s = 0.f;
#pragma unroll
    for (int j = 0; j < 8; ++j) { v[j] = POOLO[(size_t)tok * PW + lane + 64 * j]; s += v[j] * v[j]; }
    const float rs = 1.0f / sqrtf(wave_sum(s) * (1.0f / PW) + EPS);
#pragma unroll
    for (int j = 0; j < 8; ++j) MIXED[(size_t)tok * D + SBW + lane + 64 * j] = (bf16_t)f2bf(v[j] * rs);
}
__global__ void k_resid(const bf16_t* A, const bf16_t* WT, const float* xin, float* xout, bf16_t* XB, float* SSQ, const float* ssq_mid, int kmid) {
    NV_TILE();
    wave_gemm(m0, n0, D, kmid, [=](int r) { return A + (size_t)r * D; }, [=](int c) { return WT + (size_t)c * D; },
        [=](int r) { return 1.0f / sqrtf(ssq_mid[r] * (1.0f / SBW) + EPS); },
        [=](int r, int c0, int c1, float v0, float v1) {
            const float x0 = xin[(size_t)r * D + c0] + v0, x1 = xin[(size_t)r * D + c1] + v1;
            xout[(size_t)r * D + c0] = x0; xout[(size_t)r * D + c1] = x1;
            XB[(size_t)r * D + c0] = (bf16_t)f2bf(x0); XB[(size_t)r * D + c1] = (bf16_t)f2bf(x1);
            float q = x0 * x0 + x1 * x1; q += __shfl_xor(q, 1); q += __shfl_xor(q, 2); q += __shfl_xor(q, 4); q += __shfl_xor(q, 8);
            if ((threadIdx.x & 15) == 0) unsafeAtomicAdd(SSQ + r, q); });
}
__global__ void k_g3(const bf16_t* X1B, const bf16_t* WT, const float* SSQ1, bf16_t* QM) {
    NV_TILE();
    wave_gemm(m0, n0, D, -1, [=](int r) { return X1B + (size_t)r * D; }, [=](int c) { return WT + (size_t)c * D; }, NoMid(),
        [=](int r, int c0, int c1, float v0, float v1) { const float s = C2_MEM / sqrtf(SSQ1[r] * (1.0f / D) + EPS);
            QM[(size_t)r * D + c0] = (bf16_t)f2bf(v0 * s); QM[(size_t)r * D + c1] = (bf16_t)f2bf(v1 * s); });
}
__global__ void k_ms(const bf16_t* QM, const bf16_t* KM, float* SCR) {
    NV_TILE(); const int h = blockIdx.z; const int b = m0 >> 12;
    wave_gemm(m0, n0, MHD, -1, [=](int r) { return QM + (size_t)r * D + h * MHD; }, [=](int c) { return KM + ((size_t)b * NMEM + c) * D + h * MHD; }, NoMid(),
        [=](int r, int c0, int c1, float v0, float v1) { SCR[((size_t)r * MH + h) * NMEM + c0] = v0; SCR[((size_t)r * MH + h) * NMEM + c1] = v1; });
}
__global__ void k_msoftmax(const float* SCR, bf16_t* PM) {
    const int row = blockIdx.x * 4 + (threadIdx.x >> 6), lane = threadIdx.x & 63;
    float v[4], m = -INFINITY;
#pragma unroll
    for (int j = 0; j < 4; ++j) { v[j] = SCR[(size_t)row * NMEM + lane + 64 * j]; m = fmaxf(m, v[j]); }
#pragma unroll
    for (int o = 1; o < 64; o <<= 1) m = fmaxf(m, __shfl_xor(m, o));
    float s = 0.f;
#pragma unroll
    for (int j = 0; j < 4; ++j) { v[j] = exp2f(v[j] - m); s += v[j]; }
    s = 1.0f / wave_sum(s);
#pragma unroll
    for (int j = 0; j < 4; ++j) PM[(size_t)row * NMEM + lane + 64 * j] = (bf16_t)f2bf(v[j] * s);
}
__global__ void k_mpv(const bf16_t* PM, const bf16_t* VMT, bf16_t* OM) {
    NV_TILE(); const int h = blockIdx.z; const int b = m0 >> 12;
    wave_gemm(m0, n0, NMEM, -1, [=](int r) { return PM + ((size_t)r * MH + h) * NMEM; }, [=](int c) { return VMT + ((size_t)b * D + h * MHD + c) * NMEM; }, NoMid(),
        [=](int r, int c0, int c1, float v0, float v1) { OM[(size_t)r * D + h * MHD + c0] = (bf16_t)f2bf(v0); OM[(size_t)r * D + h * MHD + c1] = (bf16_t)f2bf(v1); });
}
__global__ void k_route(const float* x2, const float* SSQ2, const float* WR, const float* br, int* CNT, int* LSLOT, float* LGATE) {
    const int tok = blockIdx.x * 4 + (threadIdx.x >> 6), lane = threadIdx.x & 63;
    float xv[16];
#pragma unroll
    for (int j = 0; j < 16; ++j) xv[j] = x2[(size_t)tok * D + lane + 64 * j];
    const float rs = 1.0f / sqrtf(SSQ2[tok] * (1.0f / D) + EPS);
    float mine = 0.f;
    for (int e = 0; e < NE; ++e) { float s = 0.f;
#pragma unroll
        for (int j = 0; j < 16; ++j) s += xv[j] * WR[e * D + lane + 64 * j];
        s = wave_sum(s); if (lane == e) mine = s * rs + br[e]; }
    float tv[4]; int ti[4]; float cur = (lane < NE) ? mine : -INFINITY;
#pragma unroll
    for (int k = 0; k < 4; ++k) { float m = cur; int mi = lane;
#pragma unroll
        for (int o = 1; o < 64; o <<= 1) { const float om = __shfl_xor(m, o); const int oi = __shfl_xor(mi, o); if (om > m || (om == m && oi < mi)) { m = om; mi = oi; } }
        tv[k] = m; ti[k] = mi; if (lane == mi) cur = -INFINITY; }
    float g[4], gs = 0.f;
#pragma unroll
    for (int k = 0; k < 4; ++k) { g[k] = expf(tv[k] - tv[0]); gs += g[k]; }
    if (lane < 4) { int e = ti[0]; float gg = g[0];
        if (lane == 1) { e = ti[1]; gg = g[1]; } if (lane == 2) { e = ti[2]; gg = g[2]; } if (lane == 3) { e = ti[3]; gg = g[3]; }
        const int pos = atomicAdd(CNT + e, 1); LSLOT[(size_t)e * LCAP + pos] = tok * 4 + lane; LGATE[(size_t)e * LCAP + pos] = gg / gs; }
}
__device__ __forceinline__ int tile_base(const int* CNT, int e) { int tb = 0; for (int i = 0; i < e; ++i) tb += (CNT[i] + 255) >> 8; return tb; }
__global__ void k_w1(const bf16_t* X2B, const float* SSQ2, const bf16_t* W1T, const float* b1, const int* CNT, const int* LSLOT, bf16_t* ACT) {
    const int e = blockIdx.z, cnt = CNT[e]; const int w = threadIdx.x >> 6; const int m0 = blockIdx.y * 64 + (w >> 1) * 32; if (blockIdx.y * 64 >= cnt) return;
    const int gc0 = blockIdx.x * 32 + (w & 1) * 16;
    const int pn = gc0 >> 7, j0 = gc0 & 127; const int n0 = pn * 256 + j0;
    const int tb = tile_base(CNT, e); const bf16_t* Wt = W1T + (size_t)e * 2 * DFF * D; const int* ls = LSLOT + (size_t)e * LCAP;
    wave_gemm(m0, 0, D, -1, [=](int r) { const int tok = (r < cnt) ? (ls[r] >> 2) : 0; return X2B + (size_t)tok * D; },
        [=](int c) { const int rowb = (c < 16) ? n0 + c : n0 + 128 + (c - 16); return Wt + (size_t)rowb * D; }, NoMid(),
        [=](int r, int c0, int c1, float vg, float vu) { if (r >= cnt) return; const int tok = ls[r] >> 2; const float rs = 1.0f / sqrtf(SSQ2[tok] * (1.0f / D) + EPS);
            const int gc = gc0 + c0;
            float gate = vg * rs + b1[e * 2 * DFF + gc], up = vu * rs + b1[e * 2 * DFF + DFF + gc];
            gate = fminf(gate, SW_LIMIT); up = fminf(fmaxf(up, -SW_LIMIT), SW_LIMIT);
            const float act = (up + 1.0f) * gate / (1.0f + expf(-SW_ALPHA * gate));
            ACT[((size_t)tb * 256 + r) * DFF + gc] = (bf16_t)f2bf(act); (void)c1; });
}
__global__ void k_w2(const bf16_t* ACT, const bf16_t* W2T, const float* b2, const int* CNT, const int* LSLOT, const float* LGATE, bf16_t* Y) {
    const int e = blockIdx.z, cnt = CNT[e]; if (blockIdx.y * 64 >= cnt) return; NV_TILE();
    const int tb = tile_base(CNT, e); const bf16_t* Wt = W2T + (size_t)e * D * DFF; const int* ls = LSLOT + (size_t)e * LCAP; const float* lg = LGATE + (size_t)e * LCAP;
    wave_gemm(m0, n0, DFF, -1, [=](int r) { return ACT + ((size_t)tb * 256 + r) * DFF; }, [=](int c) { return Wt + (size_t)c * DFF; }, NoMid(),
        [=](int r, int c0, int c1, float v0, float v1) { if (r >= cnt) return; const int slot = ls[r]; const float g = lg[r];
            Y[(size_t)slot * D + c0] = (bf16_t)f2bf((v0 + b2[e * D + c0]) * g); Y[(size_t)slot * D + c1] = (bf16_t)f2bf((v1 + b2[e * D + c1]) * g); });
}
__global__ void k_final(float* out, const bf16_t* Y, const float* gf) {
    const int tok = blockIdx.x * 4 + (threadIdx.x >> 6), lane = threadIdx.x & 63;
    float v[16], s = 0.f;
#pragma unroll
    for (int j = 0; j < 16; ++j) { const int c = lane + 64 * j; float a = out[(size_t)tok * D + c];
#pragma unroll
        for (int k = 0; k < 4; ++k) a += bf2f(Y[((size_t)tok * 4 + k) * D + c]);
        v[j] = a; s += a * a; }
    const float rs = 1.0f / sqrtf(wave_sum(s) * (1.0f / D) + EPS);
#pragma unroll
    for (int j = 0; j < 16; ++j) { const int c = lane + 64 * j; out[(size_t)tok * D + c] = v[j] * rs * gf[c]; }
}
}

#define LAS __attribute__((address_space(3)))
#define GAS __attribute__((address_space(1)))
namespace pg8 {
constexpr int BM = 256, BK = 64, HALF = 128, HTB = HALF * BK * 2, STAGE_BYTES = 8 * HTB, NXCD = 8, WGM = 8;
__host__ __device__ __forceinline__ int lds_byte(int r, int c) { const int st = (r >> 4) * 2 + (c >> 5), rr = r & 15, cc = c & 31, ob = rr * 64 + cc * 2; return st * 1024 + (ob ^ (((ob >> 9) & 1) << 5)); }
__host__ __device__ __forceinline__ void stage_rc(int b, int& R, int& C) { const int st = b / 1024, sb = b % 1024, swz = sb ^ (((sb >> 9) & 1) << 5); R = (st >> 1) * 16 + swz / 64; C = (st & 1) * 32 + (swz % 64) / 2; }
__host__ __device__ __forceinline__ int perm32(int rho) { const int n = rho >> 4, i = rho & 15; return 8 * (i >> 2) + 4 * n + (i & 3); }
__device__ __forceinline__ unsigned cvt_pk_bf16(float lo, float hi) { unsigned r; asm volatile("v_cvt_pk_bf16_f32 %0, %1, %2" : "=v"(r) : "v"(lo), "v"(hi)); return r; }

struct Unit { const char* A; const char* B; void* p0; void* p1; void* p2; void* p3; int pm, pn, i0, i1, ghost; };

__device__ __forceinline__ int xcd_remap(int L, int nwg) { const int q = nwg / NXCD, r = nwg % NXCD, xcd = L % NXCD, off = L / NXCD; return __builtin_amdgcn_readfirstlane((xcd < r ? xcd * (q + 1) : r * (q + 1) + (xcd - r) * q) + off); }
__device__ __forceinline__ void grouped_mn(int wgid, int nM, int nN, int& pm, int& pn) {
    const int nig = WGM * nN, gid = wgid / nig, fm = gid * WGM, gsz = (nM - fm) < WGM ? (nM - fm) : WGM; pm = __builtin_amdgcn_readfirstlane(fm + ((wgid % nig) % gsz)); pn = __builtin_amdgcn_readfirstlane((wgid % nig) / gsz); }

template <class Epi, class Sched, bool GATHER, int REP = 1, int REPE = 1>
__device__ __forceinline__ void gemm_phase(const int wid, LAS unsigned char* lds, LAS unsigned char* epi_lds, LAS unsigned* gtab, const int lda_b, const int ldb_b, const int nt, const Sched& S, const Epi& E) {
    int lane_; asm volatile("v_mbcnt_lo_u32_b32 %0, -1, 0\n\tv_mbcnt_hi_u32_b32 %0, -1, %0" : "=v"(lane_));
    const int lane = lane_, tid = wid * 64 + lane, wr = wid >> 2, wc = wid & 3, fr = lane & 15, fq = lane >> 4;
    unsigned voffA[2], voffB[2], voffG[2][2]; int Rr[2]; unsigned Cb[2];
#pragma unroll
    for (int i = 0; i < 2; ++i) { int R, C; stage_rc(tid * 16, R, C); R += 64 * i; const int Rb = Epi::PERM ? ((R & ~31) + perm32(R & 31)) : R;
        voffA[i] = (unsigned)(R * lda_b + C * 2); voffB[i] = (unsigned)(Rb * ldb_b + C * 2); Rr[i] = R; Cb[i] = (unsigned)(C * 2); voffG[0][i] = 0; voffG[1][i] = 0; }
    const size_t kstep = (size_t)(BK * 2);
    const size_t hstepA = (size_t)HALF * lda_b, hstepB = (size_t)HALF * ldb_b;
    const unsigned ldsw = (unsigned)wid * 1024u;
    const int aoff = lds_byte(wr * 64 + fr, fq * 8), boff = lds_byte(wc * 32 + fr, fq * 8);
#define PG8_SA(b, h) (((b) * 2 + (h)) * HTB)
#define PG8_SB(b, h) ((4 + (b) * 2 + (h)) * HTB)
#define PG8_GLDS(gp, bufoff, _i) __builtin_amdgcn_global_load_lds((const unsigned*)(gp), (LAS unsigned*)(lds + (bufoff) + ldsw + (_i) * 8192), 16, 0, 0)
#define PG8_STAGE_B(bufoff, gbase) do { _Pragma("unroll") for (int _i = 0; _i < 2; ++_i) PG8_GLDS((const char*)(gbase) + voffB[_i], bufoff, _i); } while (0)
#define PG8_STAGE_A(bufoff, gbase, h) do { if constexpr (GATHER) { _Pragma("unroll") for (int _i = 0; _i < 2; ++_i) PG8_GLDS((const char*)(gbase) + voffG[h][_i], bufoff, _i); } \
        else { _Pragma("unroll") for (int _i = 0; _i < 2; ++_i) PG8_GLDS((const char*)(gbase) + (h) * hstepA + voffA[_i], bufoff, _i); } } while (0)
#define PG8_LDA(dst, b, h) do { _Pragma("unroll") for (int m = 0; m < 4; ++m) _Pragma("unroll") for (int k = 0; k < 2; ++k) dst[m][k] = *(const LAS bf16x8*)(lds + PG8_SA(b, h) + aoff + m * 2048 + k * 1024); } while (0)
#define PG8_LDB(dst, b, h) do { _Pragma("unroll") for (int n = 0; n < 2; ++n) _Pragma("unroll") for (int k = 0; k < 2; ++k) dst[n][k] = *(const LAS bf16x8*)(lds + PG8_SB(b, h) + boff + n * 2048 + k * 1024); } while (0)
#define PG8_MMA(ai, bj, At, Bt) do { __builtin_amdgcn_s_setprio(1); _Pragma("unroll") for (int m = 0; m < 4; ++m) _Pragma("unroll") for (int n = 0; n < 2; ++n) _Pragma("unroll") for (int k = 0; k < 2; ++k) \
        acc[ai][bj][m][n] = __builtin_amdgcn_mfma_f32_16x16x32_bf16(Bt[n][k], At[m][k], acc[ai][bj][m][n], 0, 0, 0); __builtin_amdgcn_s_setprio(0); } while (0)
#define PG8_WAIT_V(n) asm volatile("s_waitcnt vmcnt(" #n ")" ::: "memory")
#define PG8_WAIT_L(n) asm volatile("s_waitcnt lgkmcnt(" #n ")" ::: "memory")
#define PG8_BAR __builtin_amdgcn_s_barrier()
#define PG8_SCHED __builtin_amdgcn_sched_barrier(0)
#define PG8_GTAB_LOAD(buf, nvalid) do { _Pragma("unroll") for (int _h = 0; _h < 2; ++_h) _Pragma("unroll") for (int _i = 0; _i < 2; ++_i) { const int _row = _h * HALF + Rr[_i]; \
        const unsigned _s = gtab[(buf) * 256 + _row]; voffG[_h][_i] = ((_row < (nvalid)) ? (_s >> 2) * (unsigned)lda_b : 0u) + Cb[_i]; } } while (0)
#define PG8_GTAB_DMA(buf, src) do { if (wid == 0) __builtin_amdgcn_global_load_lds((const unsigned*)((const char*)(src) + lane * 16), (LAS unsigned*)(gtab + (buf) * 256), 16, 0, 0); } while (0)
    auto nextu = [&](int i, Unit& u) -> bool { if constexpr (REP > 1) { const bool ok = S.next(i / REP, u); u.ghost = (i % REP) != REP - 1; return ok; } else { u.ghost = 0; return S.next(i, u); } };
    Unit cur, nxt; int ui = 0;
    if (!nextu(0, cur)) return;
    f32x4 acc[2][2][4][2];
#pragma unroll
    for (int a = 0; a < 2; ++a)
#pragma unroll
        for (int b = 0; b < 2; ++b)
#pragma unroll
            for (int m = 0; m < 4; ++m)
#pragma unroll
                for (int n = 0; n < 2; ++n) acc[a][b][m][n] = (f32x4){0.f, 0.f, 0.f, 0.f};
    bf16x8 At[4][2], B0[2][2], B1[2][2];
    const char* cA = cur.A; const char* cB = cur.B;
    if constexpr (GATHER) { PG8_GTAB_DMA(0, cur.p3); PG8_WAIT_V(0); PG8_WAIT_L(0); PG8_BAR; PG8_GTAB_LOAD(0, cur.i0); }
    PG8_STAGE_B(PG8_SB(0, 0), cB); PG8_STAGE_B(PG8_SB(0, 1), cB + hstepB); PG8_STAGE_A(PG8_SA(0, 0), cA, 0); PG8_STAGE_A(PG8_SA(0, 1), cA, 1);
    if (wr == 1) PG8_BAR;
    PG8_WAIT_V(2); PG8_BAR;
    PG8_STAGE_B(PG8_SB(1, 0), cB + kstep); PG8_STAGE_A(PG8_SA(1, 0), cA + kstep, 0); PG8_STAGE_B(PG8_SB(1, 1), cB + hstepB + kstep);
    PG8_WAIT_V(6); PG8_BAR;
    for (;;) {
        const bool has_next = nextu(ui + 1, nxt);
        const char* nA = has_next ? nxt.A : cA; const char* nB = has_next ? nxt.B : cB;
#pragma unroll 1
        for (int t = 0; t < nt; t += 2) {
            const bool last = (t == nt - 2);
            const char* a1 = cA + (size_t)(t + 1) * kstep;
            const char* a2 = last ? nA : cA + (size_t)(t + 2) * kstep; const char* b2 = last ? nB : cB + (size_t)(t + 2) * kstep;
            const char* a3 = a2 + kstep; const char* b3 = b2 + kstep;
            if constexpr (Epi::MIDK >= 0) { if (t == Epi::MIDK) E.midk(acc, cur, wr, fr); }
            if constexpr (GATHER) { if (t == 0 && has_next) PG8_GTAB_DMA((ui + 1) & 1, nxt.p3); }
            if constexpr (GATHER) { PG8_STAGE_A(PG8_SA(1, 1), a1, 1); if (last && has_next) PG8_GTAB_LOAD((ui + 1) & 1, nxt.i0); PG8_SCHED; }
            PG8_LDB(B0, 0, 0); PG8_LDB(B1, 0, 1); PG8_SCHED; PG8_LDA(At, 0, 0); if constexpr (!GATHER) PG8_STAGE_A(PG8_SA(1, 1), a1, 1);
            PG8_WAIT_V(8); PG8_WAIT_L(0); PG8_BAR; PG8_MMA(0, 0, At, B0); PG8_MMA(0, 1, At, B1); PG8_BAR; PG8_SCHED;
            PG8_LDA(At, 0, 1); PG8_STAGE_B(PG8_SB(0, 0), b2); PG8_STAGE_B(PG8_SB(0, 1), b2 + hstepB); PG8_STAGE_A(PG8_SA(0, 0), a2, 0);
            PG8_WAIT_V(8); PG8_WAIT_L(0); PG8_BAR; PG8_MMA(1, 0, At, B0); PG8_MMA(1, 1, At, B1); PG8_BAR; PG8_SCHED;
            PG8_LDB(B0, 1, 0); PG8_LDB(B1, 1, 1); PG8_SCHED; PG8_LDA(At, 1, 0); PG8_STAGE_A(PG8_SA(0, 1), a2, 1);
            PG8_WAIT_V(8); PG8_WAIT_L(0); PG8_BAR; PG8_MMA(0, 0, At, B0); PG8_MMA(0, 1, At, B1); PG8_BAR; PG8_SCHED;
            PG8_LDA(At, 1, 1); PG8_STAGE_B(PG8_SB(1, 0), b3); PG8_STAGE_B(PG8_SB(1, 1), b3 + hstepB); PG8_STAGE_A(PG8_SA(1, 0), a3, 0);
            PG8_WAIT_V(8); PG8_WAIT_L(0); PG8_BAR; PG8_MMA(1, 0, At, B0); PG8_MMA(1, 1, At, B1); PG8_BAR; PG8_SCHED;
        }
        if (wr == 0) PG8_BAR;
        if (!cur.ghost) { E(acc, cur, wr, wc, fr, fq, wid, lane, epi_lds); if constexpr (REPE > 1) { asm volatile("" ::: "memory"); E(acc, cur, wr, wc, fr, fq, wid, lane, epi_lds); } }
        if (!has_next) break;
#pragma unroll
        for (int a = 0; a < 2; ++a)
#pragma unroll
            for (int b = 0; b < 2; ++b)
#pragma unroll
                for (int m = 0; m < 4; ++m)
#pragma unroll
                    for (int n = 0; n < 2; ++n) acc[a][b][m][n] = (f32x4){0.f, 0.f, 0.f, 0.f};
        cur = nxt; cA = nA; cB = nB; ++ui;
        if (wr == 1) PG8_BAR;
    }
    PG8_WAIT_V(0);
    PG8_BAR;
#undef PG8_SA
#undef PG8_SB
#undef PG8_GLDS
#undef PG8_STAGE_A
#undef PG8_STAGE_B
#undef PG8_LDA
#undef PG8_LDB
#undef PG8_MMA
#undef PG8_WAIT_V
#undef PG8_WAIT_L
#undef PG8_BAR
#undef PG8_SCHED
#undef PG8_GTAB_LOAD
#undef PG8_GTAB_DMA
}

struct EpiBf16S {
    static constexpr bool PERM = true; static constexpr int MIDK = -1;
    __device__ __forceinline__ void midk(f32x4 (&)[2][2][4][2], const Unit&, int, int) const {}
    __device__ __forceinline__ void operator()(const f32x4 (&acc)[2][2][4][2], const Unit& u, int wr, int wc, int fr, int fq, int, int, LAS unsigned char*) const {
        bf16_t* O = (bf16_t*)u.p0; const float* rs = (const float*)u.p1; const float* cs = (const float*)u.p2; const int ldc = u.i0;
        int r0 = wr * 64 + fr, c0 = wc * 32 + 8 * fq; asm volatile("" : "+v"(r0), "+v"(c0));
        f32x4 cv[2][2];
#pragma unroll
        for (int bj = 0; bj < 2; ++bj)
#pragma unroll
            for (int n = 0; n < 2; ++n) cv[bj][n] = cs ? *(const f32x4*)(cs + c0 + bj * HALF + 4 * n) : (f32x4){1.f, 1.f, 1.f, 1.f};
#pragma unroll
        for (int ai = 0; ai < 2; ++ai)
#pragma unroll
            for (int m = 0; m < 4; ++m) { const int r = r0 + ai * HALF + m * 16; const float rv = rs ? rs[r] : 1.f; bf16_t* rowp = O + (size_t)r * ldc + c0;
#pragma unroll
                for (int bj = 0; bj < 2; ++bj) { const f32x4 v0 = acc[ai][bj][m][0] * cv[bj][0] * rv, v1 = acc[ai][bj][m][1] * cv[bj][1] * rv;
                    u32x4 w; w.x = cvt_pk_bf16(v0[0], v0[1]); w.y = cvt_pk_bf16(v0[2], v0[3]); w.z = cvt_pk_bf16(v1[0], v1[1]); w.w = cvt_pk_bf16(v1[2], v1[3]);
                    *(u32x4*)(rowp + bj * HALF) = w; } }
    }
};
}

namespace mk {
constexpr int NWAVES = 8, NPHASE = 12;
constexpr int RING_OFF = 0, RING_BYTES = 131072, EPI_OFF = 131072, EPI_BYTES = 8192, GTAB_OFF = EPI_OFF + EPI_BYTES, GTAB_BYTES = 2048, MISC_OFF = GTAB_OFF + GTAB_BYTES, MISC_BYTES = 1024;
constexpr int LDS_BYTES = 147456;
static_assert(MISC_OFF + MISC_BYTES <= LDS_BYTES, "LDS map");
constexpr size_t WS_CSG1 = 19 * MiB, WS_WRH = 19 * MiB + 64 * 1024, WS_WRL = 19 * MiB + 128 * 1024;
constexpr int CW_BAR = 1024;

#define RLX_AGENT __ATOMIC_RELAXED, __HIP_MEMORY_SCOPE_AGENT
#define LDS_WAIT() asm volatile("s_waitcnt lgkmcnt(0)" ::: "memory")
#define VM_WAIT() asm volatile("s_waitcnt vmcnt(0)" ::: "memory")
#define XB_TMO      128
#define XB_XCNT(j)  (256  + 64 * (j))
#define XB_XSUB(j)  (1280 + 64 * (j))
#define XB_XGEN(j)  (2304 + 64 * (j))
#define XB_TOP      3328
#define XB_TOPGEN   3392
#define XCD_BAR_WORDS 3456
#define XB_SPIN_CAP (1u << 20)
__device__ __forceinline__ unsigned xb_ld(unsigned* p)              { return __hip_atomic_load(p, __ATOMIC_RELAXED, __HIP_MEMORY_SCOPE_AGENT); }
__device__ __forceinline__ unsigned xb_add(unsigned* p, unsigned v) { return __hip_atomic_fetch_add(p, v, __ATOMIC_RELAXED, __HIP_MEMORY_SCOPE_AGENT); }
__device__ __forceinline__ unsigned xb_xcc_id() { return (unsigned)__builtin_amdgcn_s_getreg((3 << 11) | 20) & 0xFu; }
#define XB_SPIN(cond, bar) do { unsigned _sp = 0; while (cond) { __builtin_amdgcn_s_sleep(1); \
    if ((++_sp & 255u) == 0u) { if (xb_ld(&(bar)[XB_TMO])) break; if (_sp > XB_SPIN_CAP) { atomicAdd(&(bar)[XB_TMO], 1u); break; } } } } while (0)
struct XcdBarrier { unsigned* bar; unsigned x; volatile LAS unsigned* st; };
__device__ __forceinline__ XcdBarrier xcd_barrier_post(unsigned* bar, volatile LAS unsigned* st) {
    XcdBarrier b; b.bar = bar; b.x = xb_xcc_id(); b.st = st;
    if (threadIdx.x == 0) (void)xb_add(&bar[XB_XCNT(b.x)], 1u);
    return b;
}
__device__ __forceinline__ void xcd_barrier_complete(unsigned* bar, unsigned x, unsigned& nloc, unsigned& nx) {
    const unsigned G = gridDim.x * gridDim.y * gridDim.z;
    unsigned sum, cnt, mine, sp = 0u;
    for (;;) {
        sum = 0u; cnt = 0u; mine = 0u;
#pragma unroll
        for (unsigned j = 0; j < 16; ++j) { const unsigned c = xb_ld(&bar[XB_XCNT(j)]); sum += c; cnt += (c > 0u) ? 1u : 0u; mine = (j == x) ? c : mine; }
        if (sum == G) break;
        __builtin_amdgcn_s_sleep(1);
        if ((++sp & 255u) == 0u) { if (xb_ld(&bar[XB_TMO])) break; if (sp > XB_SPIN_CAP) { atomicAdd(&bar[XB_TMO], 1u); break; } }
    }
    nloc = mine > 0u ? mine : 1u; nx = cnt > 0u ? cnt : 1u;
}
__device__ __forceinline__ void xcd_barrier(const XcdBarrier& b) {
    asm volatile("s_waitcnt vmcnt(0)" ::: "memory");
    __syncthreads();
    if (threadIdx.x == 0) {
        unsigned* bar = b.bar;
        __builtin_amdgcn_s_waitcnt(0);
        unsigned nloc = b.st[0], nx = b.st[1];
        if (nloc == 0u) { xcd_barrier_complete(bar, b.x, nloc, nx); b.st[0] = nloc; b.st[1] = nx; }
        const unsigned old = xb_add(&bar[XB_XSUB(b.x)], 1u);
        const unsigned gen = old / nloc;
        if (old + 1u == (gen + 1u) * nloc) {
            __builtin_amdgcn_fence(__ATOMIC_RELEASE, "agent");
            asm volatile("s_waitcnt vmcnt(0)" ::: "memory");
            const unsigned og = xb_add(&bar[XB_TOP], 1u);
            const unsigned tg = og / nx;
            if (og + 1u == (tg + 1u) * nx) xb_add(&bar[XB_TOPGEN], 1u);
            else XB_SPIN(xb_ld(&bar[XB_TOPGEN]) == tg, bar);
            __builtin_amdgcn_fence(__ATOMIC_ACQUIRE, "agent");
            xb_add(&bar[XB_XGEN(b.x)], 1u);
            asm volatile("s_waitcnt vmcnt(0)" ::: "memory");
        } else {
            XB_SPIN(xb_ld(&bar[XB_XGEN(b.x)]) == gen, bar);
            __builtin_amdgcn_fence(__ATOMIC_ACQUIRE, "agent");
            asm volatile("s_waitcnt vmcnt(0)" ::: "memory");
        }
    }
    __syncthreads();
}

struct Args { const float* in[22]; float* out; unsigned char* ws; int ph_lo, ph_hi, li, pad; };

__device__ __forceinline__ void p0_item(const float* W, int K, int N, bf16_t* WT, const float* gk, const float* gk2, int ksplit, const float* gn, int mode, LAS float* scr, int item, int lane) {
    const int nblk = N / 32, kb = item / nblk, nb = item % nblk, k0 = 64 * kb, nd0 = 32 * nb;
    int ns0 = nd0; if (mode == 1) { const int pn = nd0 >> 8, j = nd0 & 255; ns0 = (j < 128) ? 128 * pn + j : 1024 + 128 * pn + (j - 128); }
    const int kr = lane >> 3, n4 = (lane & 7) * 4;
    f32x4 v[8];
#pragma unroll
    for (int i = 0; i < 8; ++i) v[i] = *(const f32x4*)(W + (size_t)(k0 + 8 * i + kr) * N + ns0 + n4);
    f32x4 gnv = (f32x4){1.f, 1.f, 1.f, 1.f}; if (gn) gnv = *(const f32x4*)(gn + ns0 + n4);
#pragma unroll
    for (int i = 0; i < 8; ++i) { const int kk = 8 * i + kr, k = k0 + kk; float g = 1.f; if (gk) g = (k < ksplit) ? gk[k] : gk2[k - ksplit];
        const f32x4 t = v[i] * gnv * g; LAS float* d = scr + kk * 33 + n4; d[0] = t[0]; d[1] = t[1]; d[2] = t[2]; d[3] = t[3]; }
    LDS_WAIT(); asm volatile("" ::: "memory");
    const int c = lane & 7;
#pragma unroll
    for (int j = 0; j < 4; ++j) { const int n = (lane >> 3) + 8 * j; const LAS float* s = scr + (8 * c) * 33 + n;
        u32x4 o; o.x = pg8::cvt_pk_bf16(s[0 * 33], s[1 * 33]); o.y = pg8::cvt_pk_bf16(s[2 * 33], s[3 * 33]); o.z = pg8::cvt_pk_bf16(s[4 * 33], s[5 * 33]); o.w = pg8::cvt_pk_bf16(s[6 * 33], s[7 * 33]);
        *(u32x4*)(WT + (size_t)(nd0 + n) * K + k0 + 8 * c) = o; }
    LDS_WAIT(); asm volatile("" ::: "memory");
}
__device__ __forceinline__ void p0_row(const float* xrow, bf16_t* orow, float* rstd, int lane) {
    const f32x4* xr = (const f32x4*)xrow + lane; f32x4 v[4]; float s = 0.f;
#pragma unroll
    for (int j = 0; j < 4; ++j) { v[j] = xr[64 * j]; s += (v[j].x * v[j].x + v[j].y * v[j].y) + (v[j].z * v[j].z + v[j].w * v[j].w); }
    s = wave_sum(s); if (lane == 0) *rstd = 1.0f / sqrtf(s * (1.0f / D) + EPS);
    unsigned long long* o8 = (unsigned long long*)orow + lane;
#pragma unroll
    for (int j = 0; j < 4; ++j) o8[64 * j] = (unsigned long long)pg8::cvt_pk_bf16(v[j].x, v[j].y) | ((unsigned long long)pg8::cvt_pk_bf16(v[j].z, v[j].w) << 32);
}
__device__ __forceinline__ void p0_prologue(const Args& a, LAS unsigned char* lds, int vcu, int G, int wave, int lane) {
    unsigned char* ws = a.ws;
    LAS float* scr = (LAS float*)(lds + RING_OFF + wave * 16384);
    const int gw = vcu * NWAVES + wave, NGW = G * NWAVES;
    constexpr int I_E1 = (D / 64) * (2 * DFF / 32), I_E2 = (DFF / 64) * (D / 32);
    constexpr int I_IN = (D / 64) * (INP / 32), I_SQ = (D / 64) * (D / 32), I_KV = (D / 64) * (2 * D / 32), I_P = (PGD / 64) * (PGD / 32);
    constexpr int N1 = NE * I_E1, N2 = NE * I_E2, NITEMS = N1 + N2 + I_IN + 3 * I_SQ + I_KV + PG * I_P;
    const int BIG = 1 << 30;
    for (int it = gw; it < NITEMS; it += NGW) {
        int r = it;
        if (r < N1) { const int e = r / I_E1; p0_item(a.in[17] + (size_t)e * D * 2 * DFF, D, 2 * DFF, (bf16_t*)(ws + WS_W1) + (size_t)e * 2 * DFF * D, a.in[14], nullptr, BIG, nullptr, 1, scr, r % I_E1, lane); continue; } r -= N1;
        if (r < N2) { const int e = r / I_E2; p0_item(a.in[19] + (size_t)e * DFF * D, DFF, D, (bf16_t*)(ws + WS_W2) + (size_t)e * D * DFF, nullptr, nullptr, BIG, nullptr, 0, scr, r % I_E2, lane); continue; } r -= N2;
        if (r < I_IN) { p0_item(a.in[3], D, INP, (bf16_t*)(ws + WS_WIN), a.in[2], nullptr, BIG, nullptr, 0, scr, r, lane); continue; } r -= I_IN;
        if (r < I_SQ) { p0_item(a.in[8], D, D, (bf16_t*)(ws + WS_WOUT), a.in[4], a.in[5], SBW, nullptr, 0, scr, r, lane); continue; } r -= I_SQ;
        if (r < I_SQ) { p0_item(a.in[11], D, D, (bf16_t*)(ws + WS_WQ), a.in[9], nullptr, BIG, nullptr, 0, scr, r, lane); continue; } r -= I_SQ;
        if (r < I_KV) { p0_item(a.in[12], D, 2 * D, (bf16_t*)(ws + WS_WKV), a.in[10], nullptr, BIG, nullptr, 0, scr, r, lane); continue; } r -= I_KV;
        if (r < I_SQ) { p0_item(a.in[13], D, D, (bf16_t*)(ws + WS_WO), nullptr, nullptr, BIG, nullptr, 0, scr, r, lane); continue; } r -= I_SQ;
        { const int g = r / I_P; p0_item(a.in[6] + (size_t)g * PGD * PGD, PGD, PGD, (bf16_t*)(ws + WS_WP) + (size_t)g * PGD * PGD, nullptr, nullptr, BIG, a.in[7] + g * PGD, 0, scr, r % I_P, lane); }
    }
    for (int m = gw; m < NTOK; m += NGW) p0_row(a.in[0] + (size_t)m * D, (bf16_t*)(ws + WS_S0) + (size_t)m * D, (float*)(ws + WS_RSTDX) + m, lane);
    for (int m = gw; m < NMROWS; m += NGW) p0_row(a.in[1] + (size_t)m * D, (bf16_t*)(ws + WS_MEMB) + (size_t)m * D, (float*)(ws + WS_RSTDM) + m, lane);
    const int gt = gw * 64 + lane, NGT = NGW * 64;
    for (int i = gt; i < INP; i += NGT) ((float*)(ws + WS_CSG1))[i] = (i < SBW) ? C2_SB : 1.0f;
    for (int i = gt; i < NE * D; i += NGT) { const int e = i / D, k = i % D; const float v = a.in[14][k] * a.in[15][k * NE + e];
        ((float*)(ws + WS_WR))[i] = v; const unsigned h = f2bf(v); ((bf16_t*)(ws + WS_WRH))[i] = (bf16_t)h; ((bf16_t*)(ws + WS_WRL))[i] = (bf16_t)f2bf(v - bf2f((bf16_t)h)); }
}

struct SchedP1 {
    int G, c; unsigned char* ws;
    __device__ __forceinline__ bool next(int i, pg8::Unit& u) const {
        const int L = i * G + c; constexpr int NQ = (NTOK / 256) * (INP / 256);
        if (L >= NQ + 64) return false;
        if (L < NQ) { int pm, pn; pg8::grouped_mn(pg8::xcd_remap(L, NQ), NTOK / 256, INP / 256, pm, pn);
            u.A = (const char*)(ws + WS_S0) + (size_t)pm * 256 * D * 2; u.B = (const char*)(ws + WS_WIN) + (size_t)pn * 256 * D * 2;
            u.p0 = (bf16_t*)(ws + WS_QKVU) + (size_t)pm * 256 * INP + pn * 256; u.p1 = (float*)(ws + WS_RSTDX) + pm * 256; u.p2 = (float*)(ws + WS_CSG1) + pn * 256; u.i0 = INP; u.pm = pm; u.pn = pn; }
        else if (L < NQ + 32) { const int k = L - NQ, pm = k >> 2, pn = k & 3;
            u.A = (const char*)(ws + WS_MEMB) + (size_t)pm * 256 * D * 2; u.B = (const char*)(ws + WS_WKV) + (size_t)pn * 256 * D * 2;
            u.p0 = (bf16_t*)(ws + WS_KM) + (size_t)pm * 256 * D + pn * 256; u.p1 = (float*)(ws + WS_RSTDM) + pm * 256; u.p2 = nullptr; u.i0 = D; u.pm = pm; u.pn = pn; }
        else { const int v = L - NQ - 32, b = v >> 2, dt = v & 3;
            u.A = (const char*)(ws + WS_WKV) + (size_t)(D + dt * 256) * D * 2; u.B = (const char*)(ws + WS_MEMB) + (size_t)b * 256 * D * 2;
            u.p0 = (bf16_t*)(ws + WS_VMT) + ((size_t)b * D + dt * 256) * NMEM; u.p1 = nullptr; u.p2 = (float*)(ws + WS_RSTDM) + b * 256; u.i0 = NMEM; u.pm = dt; u.pn = b; }
        u.p3 = nullptr; u.i1 = 0; return true;
    }
};
#define EPI_BAR() asm volatile("s_waitcnt lgkmcnt(0)\n\ts_barrier" ::: "memory")
struct SchedReg {
    int G, c, nM, nN; const char* A; const char* B; size_t astep, bstep; bf16_t* O; int ldc; const float* rs; const float* cs;
    __device__ __forceinline__ bool next(int i, pg8::Unit& u) const {
        const int L = i * G + c; if (L >= nM * nN) return false; int pm, pn; pg8::grouped_mn(pg8::xcd_remap(L, nM * nN), nM, nN, pm, pn);
        u.A = A + (size_t)pm * astep; u.B = B + (size_t)pn * bstep; u.pm = pm; u.pn = pn; u.i0 = ldc; u.i1 = 0;
        u.p0 = O ? (void*)(O + (size_t)pm * 256 * ldc + pn * 256) : nullptr; u.p1 = rs ? (void*)(rs + pm * 256) : nullptr; u.p2 = cs ? (void*)(cs + pn * 256) : nullptr; u.p3 = nullptr; return true;
    }
};
struct EpiBf16Ssq {
    static constexpr bool PERM = true; static constexpr int MIDK = -1; float inv_n, mult;
    __device__ __forceinline__ void midk(f32x4 (&)[2][2][4][2], const pg8::Unit&, int, int) const {}
    __device__ __forceinline__ void operator()(f32x4 (&acc)[2][2][4][2], const pg8::Unit& u, int wr, int wc, int fr, int fq, int, int, LAS unsigned char*) const {
        bf16_t* O = (bf16_t*)u.p0; const float* sq = (const float*)u.p1; const int ldc = u.i0; int r0 = wr * 64 + fr, c0 = wc * 32 + 8 * fq; asm volatile("" : "+v"(r0), "+v"(c0));
#pragma unroll
        for (int ai = 0; ai < 2; ++ai)
#pragma unroll
            for (int m = 0; m < 4; ++m) { const int r = r0 + ai * 128 + m * 16; const float rv = mult / sqrtf(sq[r] * inv_n + EPS); bf16_t* rowp = O + (size_t)r * ldc + c0;
#pragma unroll
                for (int bj = 0; bj < 2; ++bj) { const f32x4 v0 = acc[ai][bj][m][0] * rv, v1 = acc[ai][bj][m][1] * rv;
                    u32x4 w; w.x = pg8::cvt_pk_bf16(v0[0], v0[1]); w.y = pg8::cvt_pk_bf16(v0[2], v0[3]); w.z = pg8::cvt_pk_bf16(v1[0], v1[1]); w.w = pg8::cvt_pk_bf16(v1[2], v1[3]);
                    *(u32x4*)(rowp + bj * 128) = w; } }
    }
};
template <int MIDK_> struct EpiResid {
    static constexpr bool PERM = false; static constexpr int MIDK = MIDK_;
    const float* xin; float* xout; bf16_t* xb; float* ssq; const float* ssq_mid;
    __device__ __forceinline__ void midk(f32x4 (&acc)[2][2][4][2], const pg8::Unit& u, int wr, int fr) const {
#pragma unroll
        for (int ai = 0; ai < 2; ++ai)
#pragma unroll
            for (int m = 0; m < 4; ++m) { const int r = u.pm * 256 + ai * 128 + wr * 64 + m * 16 + fr; const float s = 1.0f / sqrtf(ssq_mid[r] * (1.0f / SBW) + EPS);
#pragma unroll
                for (int bj = 0; bj < 2; ++bj)
#pragma unroll
                    for (int n = 0; n < 2; ++n) acc[ai][bj][m][n] *= s; }
    }
    __device__ __forceinline__ void operator()(f32x4 (&acc)[2][2][4][2], const pg8::Unit& u, int wr, int wc, int fr, int fq, int, int, LAS unsigned char*) const {
        int row0 = u.pm * 256 + wr * 64 + fr, col0 = u.pn * 256 + wc * 32 + 4 * fq; asm volatile("" : "+v"(row0), "+v"(col0));
#pragma unroll
        for (int ai = 0; ai < 2; ++ai)
#pragma unroll
            for (int m = 0; m < 4; ++m) { const int r = row0 + ai * 128 + m * 16; const size_t off = (size_t)r * D + col0; float q = 0.f;
#pragma unroll
                for (int bj = 0; bj < 2; ++bj)
#pragma unroll
                    for (int n = 0; n < 2; ++n) { const size_t o2 = off + bj * 128 + n * 16; const f32x4 o = *(const f32x4*)(xin + o2) + acc[ai][bj][m][n];
                        *(f32x4*)(xout + o2) = o; q += (o[0] * o[0] + o[1] * o[1]) + (o[2] * o[2] + o[3] * o[3]);
                        *(unsigned long long*)(xb + o2) = (unsigned long long)pg8::cvt_pk_bf16(o[0], o[1]) | ((unsigned long long)pg8::cvt_pk_bf16(o[2], o[3]) << 32); }
                q += __shfl_xor(q, 16); q += __shfl_xor(q, 32);
                if (fq == 0) unsafeAtomicAdd(ssq + r, q);
                if (m & 1) asm volatile("" ::: "memory"); }
    }
};
struct SchedMS {
    int G, c; unsigned char* ws;
    __device__ __forceinline__ bool next(int i, pg8::Unit& u) const {
        const int L = i * G + c; constexpr int NU = (NTOK / 256) * MH; if (L >= NU) return false; const int w = pg8::xcd_remap(L, NU), pm = w >> 2, h = w & 3, b = pm >> 4;
        u.A = (const char*)(ws + WS_QM) + ((size_t)pm * 256 * D + h * MHD) * 2; u.B = (const char*)(ws + WS_KM) + ((size_t)b * NMEM * D + h * MHD) * 2;
        u.p0 = (bf16_t*)(ws + WS_PM) + (size_t)pm * 256 * D + h * NMEM; u.p1 = nullptr; u.p2 = nullptr; u.p3 = nullptr; u.i0 = D; u.i1 = 0; u.pm = pm; u.pn = h; return true;
    }
};
struct EpiSoftmax {
    static constexpr bool PERM = true; static constexpr int MIDK = -1;
    __device__ __forceinline__ void midk(f32x4 (&)[2][2][4][2], const pg8::Unit&, int, int) const {}
    __device__ __forceinline__ void operator()(f32x4 (&acc)[2][2][4][2], const pg8::Unit& u, int wr, int wc, int fr, int fq, int, int, LAS unsigned char* xl) const {
        typedef float f32x2v __attribute__((ext_vector_type(2)));
        LAS f32x2v* X = (LAS f32x2v*)xl;
        float ml[2][4];
#pragma unroll
        for (int ai = 0; ai < 2; ++ai)
#pragma unroll
            for (int m = 0; m < 4; ++m) { float mx = -INFINITY;
#pragma unroll
                for (int bj = 0; bj < 2; ++bj)
#pragma unroll
                    for (int n = 0; n < 2; ++n) { const f32x4 v = acc[ai][bj][m][n]; mx = fmaxf(fmaxf(mx, fmaxf(v[0], v[1])), fmaxf(v[2], v[3])); }
                mx = fmaxf(mx, __shfl_xor(mx, 16)); mx = fmaxf(mx, __shfl_xor(mx, 32)); ml[ai][m] = mx; float s = 0.f;
#pragma unroll
                for (int bj = 0; bj < 2; ++bj)
#pragma unroll
                    for (int n = 0; n < 2; ++n) { f32x4 v = acc[ai][bj][m][n];
#pragma unroll
                        for (int j = 0; j < 4; ++j) { v[j] = __builtin_amdgcn_exp2f(v[j] - mx); s += v[j]; }
                        acc[ai][bj][m][n] = v; }
                s += __shfl_xor(s, 16); s += __shfl_xor(s, 32);
                if (fq == 0) X[(ai * 128 + wr * 64 + m * 16 + fr) * 4 + wc] = (f32x2v){mx, s}; }
        EPI_BAR();
        bf16_t* O = (bf16_t*)u.p0; const int ldc = u.i0; int r0 = wr * 64 + fr, c0 = wc * 32 + 8 * fq; asm volatile("" : "+v"(r0), "+v"(c0));
#pragma unroll
        for (int ai = 0; ai < 2; ++ai)
#pragma unroll
            for (int m = 0; m < 4; ++m) { const int r = r0 + ai * 128 + m * 16; const f32x2v a = X[r * 4 + 0], b = X[r * 4 + 1], c = X[r * 4 + 2], d = X[r * 4 + 3];
                const float M = fmaxf(fmaxf(a.x, b.x), fmaxf(c.x, d.x));
                const float tot = a.y * __builtin_amdgcn_exp2f(a.x - M) + b.y * __builtin_amdgcn_exp2f(b.x - M) + c.y * __builtin_amdgcn_exp2f(c.x - M) + d.y * __builtin_amdgcn_exp2f(d.x - M);
                const float f = __builtin_amdgcn_exp2f(ml[ai][m] - M) / tot; bf16_t* rowp = O + (size_t)r * ldc + c0;
#pragma unroll
                for (int bj = 0; bj < 2; ++bj) { const f32x4 v0 = acc[ai][bj][m][0] * f, v1 = acc[ai][bj][m][1] * f;
                    u32x4 w; w.x = pg8::cvt_pk_bf16(v0[0], v0[1]); w.y = pg8::cvt_pk_bf16(v0[2], v0[3]); w.z = pg8::cvt_pk_bf16(v1[0], v1[1]); w.w = pg8::cvt_pk_bf16(v1[2], v1[3]);
                    *(u32x4*)(rowp + bj * 128) = w; } }
    }
};
struct SchedPV {
    int G, c; unsigned char* ws;
    __device__ __forceinline__ bool next(int i, pg8::Unit& u) const {
        const int L = i * G + c; constexpr int NU = (NTOK / 256) * MH; if (L >= NU) return false; const int w = pg8::xcd_remap(L, NU), pm = w >> 2, h = w & 3, b = pm >> 4;
        u.A = (const char*)(ws + WS_PM) + ((size_t)pm * 256 * D + h * NMEM) * 2; u.B = (const char*)(ws + WS_VMT) + ((size_t)b * D + h * MHD) * NMEM * 2;
        u.p0 = (bf16_t*)(ws + WS_OM) + (size_t)pm * 256 * D + h * MHD; u.p1 = nullptr; u.p2 = nullptr; u.p3 = nullptr; u.i0 = D; u.i1 = 0; u.pm = pm; u.pn = h; return true;
    }
};

__device__ __forceinline__ void p8_route(const Args& a, LAS unsigned char* lds, int bx, int G, int wave, int lane, int* CNT) {
    unsigned char* ws = a.ws; const float* x2 = a.out; const float* SSQ2 = (const float*)(ws + OFF_SSQ2); const float* br = a.in[16];
    const bf16_t* WRH = (const bf16_t*)(ws + WS_WRH); const bf16_t* WRL = (const bf16_t*)(ws + WS_WRL);
    int* LSLOT = (int*)(ws + WS_LSLOT); float* LGATE = (float*)(ws + WS_LGATE);
    LAS float* LG = (LAS float*)(lds + RING_OFF) + wave * 16 * 33;
    LAS int* hist = (LAS int*)(lds + RING_OFF + 32768); LAS int* base = hist + 32;
    const int tid = wave * 64 + lane;
    for (int t0 = bx * 128; t0 < NTOK; t0 += G * 128) {
        if (tid < 32) hist[tid] = 0;
        const int r16 = lane & 15, kq = lane >> 4; const int trow = t0 + wave * 16 + r16;
        const float* xp = x2 + (size_t)trow * D + kq * 8;
        f32x4 acc[2] = {(f32x4){0.f, 0.f, 0.f, 0.f}, (f32x4){0.f, 0.f, 0.f, 0.f}};
#pragma unroll 4
        for (int ks = 0; ks < 32; ++ks) {
            const f32x4 xa = *(const f32x4*)(xp + ks * 32), xc = *(const f32x4*)(xp + ks * 32 + 4);
            bf16x8 ah, al;
#pragma unroll
            for (int j = 0; j < 8; ++j) { const float v = (j < 4) ? xa[j] : xc[j - 4]; const unsigned h = f2bf(v); ah[j] = (short)h; al[j] = (short)f2bf(v - bf2f((bf16_t)h)); }
#pragma unroll
            for (int nb = 0; nb < 2; ++nb) { const size_t wo = (size_t)(nb * 16 + r16) * D + ks * 32 + kq * 8;
                const bf16x8 bh = *(const bf16x8*)(WRH + wo), bl = *(const bf16x8*)(WRL + wo);
                acc[nb] = __builtin_amdgcn_mfma_f32_16x16x32_bf16(ah, bh, acc[nb], 0, 0, 0);
                acc[nb] = __builtin_amdgcn_mfma_f32_16x16x32_bf16(al, bh, acc[nb], 0, 0, 0);
                acc[nb] = __builtin_amdgcn_mfma_f32_16x16x32_bf16(ah, bl, acc[nb], 0, 0, 0); }
        }
#pragma unroll
        for (int nb = 0; nb < 2; ++nb)
#pragma unroll
            for (int r = 0; r < 4; ++r) { const int tl = kq * 4 + r; const int tk = t0 + wave * 16 + tl; const float rs = 1.0f / sqrtf(SSQ2[tk] * (1.0f / D) + EPS);
                LG[tl * 33 + nb * 16 + r16] = acc[nb][r] * rs + br[nb * 16 + r16]; }
        LDS_WAIT(); __syncthreads();
        int te[4] = {0, 0, 0, 0}; float tg[4] = {0.f, 0.f, 0.f, 0.f}; int rk[4] = {0, 0, 0, 0};
        if (lane < 16) {
            float tv[4] = {-INFINITY, -INFINITY, -INFINITY, -INFINITY};
            for (int e = 0; e < NE; ++e) { const float v = LG[lane * 33 + e];
                if (v > tv[3]) { if (v > tv[2]) { tv[3] = tv[2]; te[3] = te[2]; if (v > tv[1]) { tv[2] = tv[1]; te[2] = te[1]; if (v > tv[0]) { tv[1] = tv[0]; te[1] = te[0]; tv[0] = v; te[0] = e; } else { tv[1] = v; te[1] = e; } } else { tv[2] = v; te[2] = e; } } else { tv[3] = v; te[3] = e; } } }
            float gs = 0.f;
#pragma unroll
            for (int k = 0; k < 4; ++k) { tg[k] = __expf(tv[k] - tv[0]); gs += tg[k]; }
            gs = 1.0f / gs;
#pragma unroll
            for (int k = 0; k < 4; ++k) { tg[k] *= gs; rk[k] = __hip_atomic_fetch_add(hist + te[k], 1, __ATOMIC_RELAXED, __HIP_MEMORY_SCOPE_WORKGROUP); }
        }
        LDS_WAIT(); __syncthreads();
        if (tid < 32) { const int n = hist[tid]; base[tid] = n ? atomicAdd(CNT + tid, n) : 0; }
        LDS_WAIT(); __syncthreads();
        if (lane < 16) { const int tk = t0 + wave * 16 + lane;
#pragma unroll
            for (int k = 0; k < 4; ++k) { const size_t p = (size_t)te[k] * LCAP + base[te[k]] + rk[k]; LSLOT[p] = tk * 4 + k; LGATE[p] = tg[k]; } }
        LDS_WAIT(); __syncthreads();
    }
}

__device__ __forceinline__ void moe_table(const Args& a, volatile LAS unsigned* MISC, int tid) {
    const int* CNT = (const int*)(a.ws + OFF_CNT);
    if (tid < 32) MISC[16 + tid] = (unsigned)CNT[tid];
    LDS_WAIT(); __syncthreads();
    if (tid == 0) { unsigned tb = 0; for (int e = 0; e < NE; ++e) { MISC[48 + e] = tb; tb += (MISC[16 + e] + 255u) >> 8; } MISC[48 + NE] = tb; }
    LDS_WAIT(); __syncthreads();
}
template <int NPN, bool W1> struct SchedMoE {
    int G, c; unsigned char* ws; volatile LAS unsigned* MISC;
    __device__ __forceinline__ bool next(int i, pg8::Unit& u) const {
        const int T = __builtin_amdgcn_readfirstlane((int)MISC[48 + NE]); const int NU = T * NPN; const int L = i * G + c; if (L >= NU) return false;
        const int w = pg8::xcd_remap(L, NU);
        int e = 0;
#pragma unroll
        for (int s = 16; s >= 1; s >>= 1) { if ((int)MISC[48 + e + s] * NPN <= w) e += s; }
        e = __builtin_amdgcn_readfirstlane(e);
        const int tb = __builtin_amdgcn_readfirstlane((int)MISC[48 + e]), cnt = __builtin_amdgcn_readfirstlane((int)MISC[16 + e]), nte = (cnt + 255) >> 8; const int idx = w - tb * NPN, pn = __builtin_amdgcn_readfirstlane(idx / nte), mt = idx - pn * nte;
        u.pm = tb + mt; u.pn = pn; u.i1 = e; const int nv = cnt - mt * 256; u.i0 = nv < 256 ? nv : 256;
        u.p3 = (int*)(ws + WS_LSLOT) + (size_t)e * LCAP + mt * 256; u.p2 = (float*)(ws + WS_LGATE) + (size_t)e * LCAP + mt * 256; u.p0 = nullptr; u.p1 = nullptr;
        if (W1) { u.A = (const char*)(ws + WS_S0); u.B = (const char*)(ws + WS_W1) + ((size_t)e * 2 * DFF + pn * 256) * D * 2; }
        else { u.A = (const char*)(ws + WS_ACT) + (size_t)(tb + mt) * 256 * DFF * 2; u.B = (const char*)(ws + WS_W2) + ((size_t)e * D + pn * 256) * DFF * 2; }
        return true;
    }
};
struct EpiSwiGLU {
    static constexpr bool PERM = true; static constexpr int MIDK = -1; const float* ssq2; const float* b1; bf16_t* act;
    __device__ __forceinline__ void midk(f32x4 (&)[2][2][4][2], const pg8::Unit&, int, int) const {}
    __device__ __forceinline__ void operator()(f32x4 (&acc)[2][2][4][2], const pg8::Unit& u, int wr, int wc, int fr, int fq, int, int, LAS unsigned char*) const {
        const int e = u.i1, nvalid = u.i0; const int* slots = (const int*)u.p3; int r0 = wr * 64 + fr, c0 = wc * 32 + 8 * fq; asm volatile("" : "+v"(r0), "+v"(c0));     const int gc0 = u.pn * 128 + c0;
        f32x4 bg[2], bu[2];
#pragma unroll
        for (int n = 0; n < 2; ++n) { bg[n] = *(const f32x4*)(b1 + (size_t)e * 2 * DFF + gc0 + 4 * n); bu[n] = *(const f32x4*)(b1 + (size_t)e * 2 * DFF + DFF + gc0 + 4 * n); }
#pragma unroll
        for (int ai = 0; ai < 2; ++ai)
#pragma unroll
            for (int m = 0; m < 4; ++m) { const int r = r0 + ai * 128 + m * 16; const bool valid = r < nvalid; const int tok = valid ? (slots[r] >> 2) : 0;
                const float rs = 1.0f / sqrtf(ssq2[tok] * (1.0f / D) + EPS); unsigned wv[4];
#pragma unroll
                for (int n = 0; n < 2; ++n) { float o[4];
#pragma unroll
                    for (int j = 0; j < 4; ++j) { float g = acc[ai][0][m][n][j] * rs + bg[n][j], up = acc[ai][1][m][n][j] * rs + bu[n][j];
                        g = fminf(g, SW_LIMIT); up = fminf(fmaxf(up, -SW_LIMIT), SW_LIMIT);
                        o[j] = (up + 1.0f) * g * __builtin_amdgcn_rcpf(1.0f + __builtin_amdgcn_exp2f(-SW_ALPHA * LOG2E * g)); }
                    wv[2 * n] = pg8::cvt_pk_bf16(o[0], o[1]); wv[2 * n + 1] = pg8::cvt_pk_bf16(o[2], o[3]); }
                if (valid) *(u32x4*)(act + ((size_t)u.pm * 256 + r) * DFF + gc0) = (u32x4){wv[0], wv[1], wv[2], wv[3]}; }
    }
};
struct EpiW2 {
    static constexpr bool PERM = true; static constexpr int MIDK = -1; const float* b2; bf16_t* Y;
    __device__ __forceinline__ void midk(f32x4 (&)[2][2][4][2], const pg8::Unit&, int, int) const {}
    __device__ __forceinline__ void operator()(f32x4 (&acc)[2][2][4][2], const pg8::Unit& u, int wr, int wc, int fr, int fq, int, int, LAS unsigned char*) const {
        const int e = u.i1, nvalid = u.i0; const int* slots = (const int*)u.p3; const float* gates = (const float*)u.p2; int r0 = wr * 64 + fr, c0 = u.pn * 256 + wc * 32 + 8 * fq; asm volatile("" : "+v"(r0), "+v"(c0));
        f32x4 bv[2][2];
#pragma unroll
        for (int bj = 0; bj < 2; ++bj)
#pragma unroll
            for (int n = 0; n < 2; ++n) bv[bj][n] = *(const f32x4*)(b2 + (size_t)e * D + c0 + bj * 128 + 4 * n);
#pragma unroll
        for (int ai = 0; ai < 2; ++ai)
#pragma unroll
            for (int m = 0; m < 4; ++m) { const int r = r0 + ai * 128 + m * 16; const bool valid = r < nvalid; const int slot = valid ? slots[r] : 0; const float g = valid ? gates[r] : 0.f;
#pragma unroll
                for (int bj = 0; bj < 2; ++bj) { const f32x4 v0 = (acc[ai][bj][m][0] + bv[bj][0]) * g, v1 = (acc[ai][bj][m][1] + bv[bj][1]) * g;
                    u32x4 w; w.x = pg8::cvt_pk_bf16(v0[0], v0[1]); w.y = pg8::cvt_pk_bf16(v0[2], v0[3]); w.z = pg8::cvt_pk_bf16(v1[0], v1[1]); w.w = pg8::cvt_pk_bf16(v1[2], v1[3]);
                    if (valid) *(u32x4*)(Y + (size_t)slot * D + c0 + bj * 128) = w; } }
    }
};

__device__ __forceinline__ void p11_final(const Args& a, int vcu, int G, int wave, int lane, float* dst) {
    const float* out = a.out; const bf16_t* Y = (const bf16_t*)(a.ws + WS_Y); const float* gf = a.in[21];
    const int gw = vcu * NWAVES + wave, NGW = G * NWAVES;
    f32x4 g4[4];
#pragma unroll
    for (int j = 0; j < 4; ++j) g4[j] = *(const f32x4*)(gf + 4 * lane + 256 * j);
    for (int tok = gw; tok < NTOK; tok += NGW) {
        f32x4 v[4]; float s = 0.f;
#pragma unroll
        for (int j = 0; j < 4; ++j) { v[j] = *(const f32x4*)(out + (size_t)tok * D + 4 * lane + 256 * j);
#pragma unroll
            for (int k = 0; k < 4; ++k) { const unsigned long long w = *(const unsigned long long*)(Y + ((size_t)tok * 4 + k) * D + 4 * lane + 256 * j);
                v[j][0] += __builtin_bit_cast(float, (unsigned)(w << 16)); v[j][1] += __builtin_bit_cast(float, (unsigned)w & 0xffff0000u);
                v[j][2] += __builtin_bit_cast(float, (unsigned)(w >> 32) << 16); v[j][3] += __builtin_bit_cast(float, (unsigned)(w >> 32) & 0xffff0000u); }
            s += (v[j][0] * v[j][0] + v[j][1] * v[j][1]) + (v[j][2] * v[j][2] + v[j][3] * v[j][3]); }
        const float rs = 1.0f / sqrtf(wave_sum(s) * (1.0f / D) + EPS);
#pragma unroll
        for (int j = 0; j < 4; ++j) *(f32x4*)(dst + (size_t)tok * D + 4 * lane + 256 * j) = v[j] * rs * g4[j];
    }
}
typedef float f32x16 __attribute__((ext_vector_type(16)));
typedef short s16x4 __attribute__((ext_vector_type(4)));
__device__ __forceinline__ int crow(int r, int hi) { return (r & 3) + 8 * (r >> 2) + 4 * hi; }
constexpr int SB_FLAG_OFF = 32768, SB_STG_OFF = 36864;
__device__ __forceinline__ void sb_unit(int b, int h, int qb, const bf16_t* QKVU, bf16_t* MIXED, float* SSQSB, LAS unsigned char* shm, int wid, int lane) {
    const int r32 = lane & 31, hi = lane >> 5;
    const size_t rowbase = (size_t)b * S; const int q0 = qb * 256;
    const bf16_t* Qw = QKVU + (rowbase + q0 + wid * 32) * INP + h * HD;
    const bf16_t* Kh = QKVU + rowbase * INP + SBW + h * HD; const bf16_t* Vh = Kh + SBW;
    bf16x8 qr[4];
#pragma unroll
    for (int d0 = 0; d0 < 4; ++d0) qr[d0] = *(const bf16x8*)(Qw + (size_t)r32 * INP + d0 * 16 + hi * 8);
    f32x16 o[2];
#pragma unroll
    for (int r = 0; r < 16; ++r) { o[0][r] = 0.f; o[1][r] = 0.f; }
    float carry = 1.0f; bool alive = true;
    const int jtop = 4 * qb + 3, jmax_w = 4 * qb + (wid >> 1);
    const int qabs = q0 + wid * 32 + r32;
    const bf16_t* ksrc = Kh + (size_t)lane * INP + wid * 8;
    const bf16_t* vsrc = Vh + (size_t)(16 * (wid & 3) + (lane >> 2)) * INP + (wid >> 2) * 32 + (lane & 3) * 8;
    const int stoff = wid * 1024 + lane * 16;
    LAS unsigned* flags = (LAS unsigned*)(shm + SB_FLAG_OFF);
    u32x4 kreg = *(const u32x4*)(ksrc + (size_t)jtop * 64 * INP), vreg = *(const u32x4*)(vsrc + (size_t)jtop * 64 * INP);
    int p = 0;
    for (int j = jtop; j >= 0; --j) {
        LAS unsigned char* Kb = shm + p * 16384; LAS unsigned char* Vb = Kb + 8192;
        *(LAS u32x4*)(Kb + stoff) = kreg; *(LAS u32x4*)(Vb + stoff) = vreg;
        LDS_WAIT(); __syncthreads();
        if (j < jtop) { const LAS unsigned* fl = flags + (p ^ 1) * 8; const unsigned any = (fl[0] | fl[1]) | (fl[2] | fl[3]) | (fl[4] | fl[5]) | (fl[6] | fl[7]);
            if (__builtin_amdgcn_readfirstlane(any) == 0u) break; }
        if (j > 0) { kreg = *(const u32x4*)(ksrc + (size_t)(j - 1) * 64 * INP); vreg = *(const u32x4*)(vsrc + (size_t)(j - 1) * 64 * INP); }
        if (j <= jmax_w && alive) {
            f32x16 p0, p1;
#pragma unroll
            for (int r = 0; r < 16; ++r) { p0[r] = 0.f; p1[r] = 0.f; }
            const LAS unsigned char* kb = Kb + hi * 1024 + r32 * 16;
#pragma unroll
            for (int d0 = 0; d0 < 4; ++d0) { const bf16x8 b0 = *(const LAS bf16x8*)(kb + d0 * 2048), b1 = *(const LAS bf16x8*)(kb + d0 * 2048 + 512);
                p0 = __builtin_amdgcn_mfma_f32_32x32x16_bf16(b0, qr[d0], p0, 0, 0, 0); p1 = __builtin_amdgcn_mfma_f32_32x32x16_bf16(b1, qr[d0], p1, 0, 0, 0); }
            const bool diag = (j == jmax_w); const int kbase = 64 * j + 4 * hi;
#pragma unroll
            for (int r = 0; r < 16; ++r) { const int k0 = kbase + (r & 3) + 8 * (r >> 2);
                float e0 = __builtin_amdgcn_exp2f(p0[r]), e1 = __builtin_amdgcn_exp2f(p1[r]);
                float r0 = __builtin_amdgcn_rcpf(1.0f + e0), r1 = __builtin_amdgcn_rcpf(1.0f + e1);
                if (diag) { if (k0 >= qabs) r0 = 1.0f; if (k0 + 32 >= qabs) r1 = 1.0f; }
                p0[r] = r0; p1[r] = r1; }
            float sfx[8][3], A[8];
#pragma unroll
            for (int i = 0; i < 8; ++i) { const float x0 = (i < 4) ? p0[4 * i] : p1[4 * i - 16], x1 = (i < 4) ? p0[4 * i + 1] : p1[4 * i - 15], x2 = (i < 4) ? p0[4 * i + 2] : p1[4 * i - 14], x3 = (i < 4) ? p0[4 * i + 3] : p1[4 * i - 13];
                sfx[i][2] = x3; sfx[i][1] = x3 * x2; sfx[i][0] = sfx[i][1] * x1; A[i] = sfx[i][0] * x0; }
            float T = carry, E[8];
#pragma unroll
            for (int i = 7; i >= 0; --i) { const auto sw = __builtin_amdgcn_permlane32_swap(__float_as_uint(A[i]), __float_as_uint(A[i]), false, false);
                const float own_or_a = __uint_as_float(sw[0]), own_or_b = __uint_as_float(sw[1]);
                const float partner = hi ? own_or_a : own_or_b;
                E[i] = hi ? T : T * partner; T = T * (A[i] * partner); }
            carry = T;
            unsigned pw[4][4];
#pragma unroll
            for (int i = 0; i < 8; ++i) { float w4[4];
#pragma unroll
                for (int jj = 0; jj < 4; ++jj) { const float rv = (i < 4) ? p0[4 * i + jj] : p1[4 * i - 16 + jj]; const float beta = 1.0f - rv;
                    w4[jj] = beta * ((jj == 3) ? E[i] : E[i] * sfx[i][jj]); }
                pw[i >> 1][(i & 1) * 2] = pg8::cvt_pk_bf16(w4[0], w4[1]); pw[i >> 1][(i & 1) * 2 + 1] = pg8::cvt_pk_bf16(w4[2], w4[3]); }
            const LAS unsigned char* vb = Vb + ((lane >> 4) & 1) * 32 + (lane & 3) * 8 + (4 * hi + ((lane & 15) >> 2)) * 64;
#pragma unroll
            for (int d0 = 0; d0 < 2; ++d0)
#pragma unroll
                for (int ks = 0; ks < 4; ++ks) {
                    const s16x4 lo = __builtin_bit_cast(s16x4, __builtin_amdgcn_ds_read_tr16_b64_v4i16((LAS s16x4*)(vb + d0 * 4096 + ks * 1024)));
                    const s16x4 hh = __builtin_bit_cast(s16x4, __builtin_amdgcn_ds_read_tr16_b64_v4i16((LAS s16x4*)(vb + d0 * 4096 + ks * 1024 + 512)));
                    const bf16x8 vf = (bf16x8){lo[0], lo[1], lo[2], lo[3], hh[0], hh[1], hh[2], hh[3]};
                    const bf16x8 pa = __builtin_bit_cast(bf16x8, (u32x4){pw[ks][0], pw[ks][1], pw[ks][2], pw[ks][3]});
                    o[d0] = __builtin_amdgcn_mfma_f32_32x32x16_bf16(pa, vf, o[d0], 0, 0, 0); }
            alive = __any(carry != 0.0f);
        }
        if (lane == 0) flags[p * 8 + wid] = (j > jmax_w || alive) ? 1u : 0u;
        p ^= 1;
    }
    LAS bf16_t* stg = (LAS bf16_t*)(shm + SB_STG_OFF + wid * 4096);
#pragma unroll
    for (int r = 0; r < 16; ++r) { const int orow = crow(r, hi);
#pragma unroll
        for (int d0 = 0; d0 < 2; ++d0) stg[orow * 64 + d0 * 32 + r32] = (bf16_t)f2bf(o[d0][r]); }
    LDS_WAIT();
    bf16_t* Ow = MIXED + (rowbase + q0 + wid * 32) * D + h * HD;
#pragma unroll
    for (int i = 0; i < 4; ++i) { const int row = i * 8 + (lane >> 3), ch = lane & 7; const u32x4 v = *(const LAS u32x4*)(stg + row * 64 + ch * 8);
        *(u32x4*)(Ow + (size_t)row * D + ch * 8) = v; float q = 0.f;
#pragma unroll
        for (int k = 0; k < 4; ++k) { const float a = __builtin_bit_cast(float, v[k] << 16), c = __builtin_bit_cast(float, v[k] & 0xffff0000u); q += a * a + c * c; }
        q += __shfl_xor(q, 1); q += __shfl_xor(q, 2); q += __shfl_xor(q, 4);
        if (ch == 0) unsafeAtomicAdd(SSQSB + rowbase + q0 + wid * 32 + row, q); }
    LDS_WAIT(); __syncthreads();
}

constexpr int PL_PITCH = 1040, PL_PART_OFF = 83968, PL_RSTD_OFF = 86016;
__device__ __forceinline__ void pool_unit(int tile, const bf16_t* QKVU, const bf16_t* WPT, bf16_t* MIXED, LAS unsigned char* shm, int wid, int lane) {
    const int tok0 = tile * 64, tpos0 = tok0 & (S - 1); const int tid = wid * 64 + lane;
    for (int c = tid; c < 79 * 64; c += NWAVES * 64) { const int row = c >> 6, ch = c & 63; const int t = tpos0 - 15 + row;
        u32x4 v = (u32x4){0u, 0u, 0u, 0u}; if (t >= 0) v = *(const u32x4*)(QKVU + (size_t)(tok0 - 15 + row) * INP + 3 * SBW + ch * 8);
        *(LAS u32x4*)(shm + row * PL_PITCH + ch * 16) = v; }
    LDS_WAIT(); __syncthreads();
    const int g = wid >> 1, eh = wid & 1, r16 = lane & 15, kq = lane >> 4; const int win = 2 << g;
    bf16x8 Bf[4][4];
#pragma unroll
    for (int nb = 0; nb < 4; ++nb)
#pragma unroll
        for (int ks = 0; ks < 4; ++ks) Bf[nb][ks] = *(const bf16x8*)(WPT + ((size_t)(g * PGD + eh * 64 + nb * 16 + r16)) * PGD + ks * 32 + kq * 8);
    f32x4 acc[4][4];
#pragma unroll
    for (int mb = 0; mb < 4; ++mb) {
        const int lrow = 15 + mb * 16 + r16; const int n = (tpos0 + mb * 16 + r16 + 1 < win) ? tpos0 + mb * 16 + r16 + 1 : win; const float inv = 1.0f / (float)n;
        bf16x8 Af[4];
#pragma unroll
        for (int ks = 0; ks < 4; ++ks) { float s[8];
#pragma unroll
            for (int q = 0; q < 8; ++q) s[q] = 0.f;
            const LAS unsigned char* up = shm + lrow * PL_PITCH + (g * PGD + ks * 32 + kq * 8) * 2;
            for (int jw = 0; jw < win; ++jw) { const u32x4 v = *(const LAS u32x4*)(up - jw * PL_PITCH);
#pragma unroll
                for (int k = 0; k < 4; ++k) { s[2 * k] += __builtin_bit_cast(float, v[k] << 16); s[2 * k + 1] += __builtin_bit_cast(float, v[k] & 0xffff0000u); } }
            const u32x4 self = *(const LAS u32x4*)up; u32x4 pk;
#pragma unroll
            for (int k = 0; k < 4; ++k) pk[k] = pg8::cvt_pk_bf16(s[2 * k] * inv - __builtin_bit_cast(float, self[k] << 16), s[2 * k + 1] * inv - __builtin_bit_cast(float, self[k] & 0xffff0000u));
            Af[ks] = __builtin_bit_cast(bf16x8, pk); }
#pragma unroll
        for (int nb = 0; nb < 4; ++nb) { f32x4 a = (f32x4){0.f, 0.f, 0.f, 0.f};
#pragma unroll
            for (int ks = 0; ks < 4; ++ks) a = __builtin_amdgcn_mfma_f32_16x16x32_bf16(Af[ks], Bf[nb][ks], a, 0, 0, 0);
            acc[mb][nb] = a; }
    }
    LAS float* part = (LAS float*)(shm + PL_PART_OFF); LAS float* rstd = (LAS float*)(shm + PL_RSTD_OFF);
#pragma unroll
    for (int mb = 0; mb < 4; ++mb)
#pragma unroll
        for (int r = 0; r < 4; ++r) { float q = 0.f;
#pragma unroll
            for (int nb = 0; nb < 4; ++nb) q += acc[mb][nb][r] * acc[mb][nb][r];
            q += __shfl_xor(q, 1); q += __shfl_xor(q, 2); q += __shfl_xor(q, 4); q += __shfl_xor(q, 8);
            if (r16 == 0) part[wid * 64 + mb * 16 + kq * 4 + r] = q; }
    LDS_WAIT(); __syncthreads();
    if (tid < 64) { float q = 0.f;
#pragma unroll
        for (int w = 0; w < 8; ++w) q += part[w * 64 + tid];
        rstd[tid] = 1.0f / sqrtf(q * (1.0f / PW) + EPS); }
    LDS_WAIT(); __syncthreads();
#pragma unroll
    for (int mb = 0; mb < 4; ++mb)
#pragma unroll
        for (int r = 0; r < 4; ++r) { const int row = mb * 16 + kq * 4 + r; const float rs = rstd[row]; bf16_t* op = MIXED + (size_t)(tok0 + row) * D + SBW + g * PGD + eh * 64 + r16;
#pragma unroll
            for (int nb = 0; nb < 4; ++nb) op[nb * 16] = (bf16_t)f2bf(acc[mb][nb][r] * rs); }
    LDS_WAIT(); __syncthreads();
}
__device__ __forceinline__ void p2_mix(const Args& a, LAS unsigned char* lds, int bx, int G, int wid, int lane, float* SSQSB) {
    unsigned char* ws = a.ws; const bf16_t* QKVU = (const bf16_t*)(ws + WS_QKVU); bf16_t* MIXED = (bf16_t*)(ws + WS_MIXED);
    constexpr int NA = B * NH * (S / 256);
    for (int i = 0; i * G + bx < NA; ++i) { const int w = pg8::xcd_remap(i * G + bx, NA); const int bh = w >> 4, qb = w & 15; sb_unit(bh >> 3, bh & 7, qb, QKVU, MIXED, SSQSB, lds + RING_OFF, wid, lane); }
    for (int t = bx; t < NTOK / 64; t += G) pool_unit(t, QKVU, (const bf16_t*)(ws + WS_WP), MIXED, lds + RING_OFF, wid, lane);
}
constexpr size_t BAR_REGION_OFF = 1 * MiB, BAR_REGION_STRIDE = 16 * 1024;
__global__ void __launch_bounds__(NWAVES * 64, 2) mega(Args args) {
    const int li = args.li;
    extern __shared__ __attribute__((aligned(16))) unsigned char lds_raw[];
    LAS unsigned char* lds = (LAS unsigned char*)lds_raw;
    volatile LAS unsigned* MISC = (volatile LAS unsigned*)(lds + MISC_OFF);
    const int wave = __builtin_amdgcn_readfirstlane((int)threadIdx.x >> 6);
#define LANE_ID() ({ int l_; asm volatile("v_mbcnt_lo_u32_b32 %0, -1, 0\n\tv_mbcnt_hi_u32_b32 %0, -1, %0" : "=v"(l_)); l_; })
    const int G = gridDim.x; const int bx = blockIdx.x; const int vcu = (G % 8 == 0) ? (bx % 8) * (G / 8) + bx / 8 : bx;
    for (int u = wave * 64 + LANE_ID(); u < MISC_BYTES / 4; u += NWAVES * 64) MISC[u] = 0u;
    __syncthreads();
    unsigned char* ws = args.ws;
    XcdBarrier bar = xcd_barrier_post((unsigned*)(ws + BAR_REGION_OFF + (size_t)li * BAR_REGION_STRIDE), MISC + 8);
    const int lo = args.ph_lo, hi = args.ph_hi;
    LAS unsigned char* ring = lds + RING_OFF; LAS unsigned char* epi = lds + EPI_OFF; LAS unsigned* gtab = (LAS unsigned*)(lds + GTAB_OFF);
#ifndef TIME_PHASE
#define TIME_PHASE -1
#endif
#define REP_OF(k) ((TIME_PHASE == (k)) ? 2 : 1)
#define REPE_OF(k) ((TIME_PHASE == 20 + (k)) ? 2 : 1)
#define IN(k) (lo <= (k) && (k) < hi)
#define SEAM(k) do { if (IN(k) && IN((k) + 1)) xcd_barrier(bar); } while (0)
    if (IN(0)) { p0_prologue(args, lds, vcu, G, wave, LANE_ID()); if (TIME_PHASE == 0) { xcd_barrier(bar); p0_prologue(args, lds, vcu, G, wave, LANE_ID()); } SEAM(0); }
    if (IN(1)) { SchedP1 S{G, bx, ws}; pg8::EpiBf16S E; pg8::gemm_phase<pg8::EpiBf16S, SchedP1, false, REP_OF(1), REPE_OF(1)>(wave, ring, epi, gtab, D * 2, D * 2, D / 64, S, E); SEAM(1); }
    {
    const float* xin0 = args.in[0]; float* outp = args.out;
    bf16_t* S0p = (bf16_t*)(ws + WS_S0); float* SSQSBp = (float*)(ws + OFF_SSQSB); float* SSQ1p = (float*)(ws + OFF_SSQ1); float* SSQ2p = (float*)(ws + OFF_SSQ2);
    constexpr size_t TSTEP = (size_t)256 * D * 2;
    #if !defined(PH_ONLY) || PH_ONLY == 2
    if (IN(2)) { if (TIME_PHASE == 2) { p2_mix(args, lds, bx, G, wave, LANE_ID(), (float*)(ws + 1536 * 1024)); xcd_barrier(bar); } p2_mix(args, lds, bx, G, wave, LANE_ID(), (float*)(ws + OFF_SSQSB)); SEAM(2); }
#endif

#if !defined(PH_ONLY) || PH_ONLY == 3
    if (IN(3)) { SchedReg S{G, bx, NTOK / 256, D / 256, (const char*)(ws + WS_MIXED), (const char*)(ws + WS_WOUT), TSTEP, TSTEP, nullptr, D, nullptr, nullptr};
        EpiResid<8> E{xin0, outp, S0p, SSQ1p, SSQSBp}; pg8::gemm_phase<EpiResid<8>, SchedReg, false, REP_OF(3)>(wave, ring, epi, gtab, D * 2, D * 2, D / 64, S, E); SEAM(3); }
#endif
#if !defined(PH_ONLY) || PH_ONLY == 4
    if (IN(4)) { SchedReg S{G, bx, NTOK / 256, D / 256, (const char*)(ws + WS_S0), (const char*)(ws + WS_WQ), TSTEP, TSTEP, (bf16_t*)(ws + WS_QM), D, SSQ1p, nullptr};
        EpiBf16Ssq E{1.0f / D, C2_MEM}; pg8::gemm_phase<EpiBf16Ssq, SchedReg, false, REP_OF(4)>(wave, ring, epi, gtab, D * 2, D * 2, D / 64, S, E); SEAM(4); }
#endif
#if !defined(PH_ONLY) || PH_ONLY == 5
    if (IN(5)) { SchedMS S{G, bx, ws}; EpiSoftmax E; pg8::gemm_phase<EpiSoftmax, SchedMS, false, REP_OF(5)>(wave, ring, epi, gtab, D * 2, D * 2, MHD / 64, S, E); SEAM(5); }
#endif
#if !defined(PH_ONLY) || PH_ONLY == 6
    if (IN(6)) { SchedPV S{G, bx, ws}; pg8::EpiBf16S E; pg8::gemm_phase<pg8::EpiBf16S, SchedPV, false, REP_OF(6)>(wave, ring, epi, gtab, D * 2, NMEM * 2, NMEM / 64, S, E); SEAM(6); }
#endif
#if !defined(PH_ONLY) || PH_ONLY == 7
    if (IN(7)) { SchedReg S{G, bx, NTOK / 256, D / 256, (const char*)(ws + WS_OM), (const char*)(ws + WS_WO), TSTEP, TSTEP, nullptr, D, nullptr, nullptr};
        EpiResid<-1> E{outp, outp, S0p, SSQ2p, nullptr}; pg8::gemm_phase<EpiResid<-1>, SchedReg, false, REP_OF(7)>(wave, ring, epi, gtab, D * 2, D * 2, D / 64, S, E); SEAM(7); }
#endif
#if !defined(PH_ONLY) || PH_ONLY == 8
    if (IN(8)) { if (TIME_PHASE == 8) { p8_route(args, lds, bx, G, wave, LANE_ID(), (int*)(ws + 1536 * 1024)); xcd_barrier(bar); } p8_route(args, lds, bx, G, wave, LANE_ID(), (int*)(ws + OFF_CNT)); SEAM(8); }
#endif
#if !defined(PH_ONLY) || PH_ONLY == 9
    if (IN(9)) { moe_table(args, MISC, wave * 64 + LANE_ID()); SchedMoE<8, true> S{G, bx, ws, MISC}; EpiSwiGLU E{SSQ2p, args.in[18], (bf16_t*)(ws + WS_ACT)};
        pg8::gemm_phase<EpiSwiGLU, SchedMoE<8, true>, true, REP_OF(9), REPE_OF(9)>(wave, ring, epi, gtab, D * 2, D * 2, D / 64, S, E); SEAM(9); }
#endif
#if !defined(PH_ONLY) || PH_ONLY == 10
    if (IN(10)) { moe_table(args, MISC, wave * 64 + LANE_ID()); SchedMoE<4, false> S{G, bx, ws, MISC}; EpiW2 E{args.in[20], (bf16_t*)(ws + WS_Y)};
        pg8::gemm_phase<EpiW2, SchedMoE<4, false>, false, REP_OF(10), REPE_OF(10)>(wave, ring, epi, gtab, DFF * 2, DFF * 2, DFF / 64, S, E); SEAM(10); }
#endif
#if !defined(PH_ONLY) || PH_ONLY == 11
    if (IN(11)) { if (TIME_PHASE == 11) { p11_final(args, vcu, G, wave, LANE_ID(), (float*)(ws + WS_ACT)); xcd_barrier(bar); } p11_final(args, vcu, G, wave, LANE_ID(), args.out); }
#endif
}

    if (TIME_PHASE == 12) { for (int q = 0; q < 10; ++q) xcd_barrier(bar); }
#undef IN
#undef SEAM
}
}

#ifndef MEGA_MASK
#define MEGA_MASK 0xFFF
#endif
extern "C" void kernel_launch(void* const* d_in, const int* in_sizes, int n_in, void* d_out, int out_size, void* d_ws, size_t ws_size, hipStream_t stream) {
    if (n_in != 22 || out_size != NTOK * D || ws_size < WS_END) { fprintf(stderr, "kernel_launch: unexpected shapes (n_in %d out %d ws %zu)\n", n_in, out_size, ws_size); return; }
    static int grid = 0;
    if (grid == 0) {
        int dev = 0, cus = 0;
        if (hipGetDevice(&dev) != hipSuccess || hipDeviceGetAttribute(&cus, hipDeviceAttributeMultiprocessorCount, dev) != hipSuccess) { grid = -1; return; }
        if (hipFuncSetAttribute((const void*)mk::mega, hipFuncAttributeMaxDynamicSharedMemorySize, mk::LDS_BYTES) != hipSuccess) { fprintf(stderr, "kernel_launch: hipFuncSetAttribute failed\n"); grid = -1; return; }
        int per_cu = 0; (void)hipOccupancyMaxActiveBlocksPerMultiprocessor(&per_cu, (const void*)mk::mega, mk::NWAVES * 64, mk::LDS_BYTES); (void)hipGetLastError();
        if (per_cu < 1) fprintf(stderr, "kernel_launch: occupancy query reports %d blocks per CU\n", per_cu);
        grid = cus;
    }
    if (grid < 0) return;
    const float* x = (const float*)d_in[0]; const float* mem = (const float*)d_in[1]; const float* g_mix = (const float*)d_in[2]; const float* w_in = (const float*)d_in[3];
    const float* g_sb = (const float*)d_in[4]; const float* g_pool = (const float*)d_in[5]; const float* w_pool = (const float*)d_in[6]; const float* pool_scale = (const float*)d_in[7];
    const float* w_out = (const float*)d_in[8]; const float* g_mem_q = (const float*)d_in[9]; const float* g_mem_kv = (const float*)d_in[10]; const float* w_mem_q = (const float*)d_in[11];
    const float* w_mem_kv = (const float*)d_in[12]; const float* w_mem_o = (const float*)d_in[13]; const float* g_ffn = (const float*)d_in[14]; const float* w_router = (const float*)d_in[15];
    const float* b_router = (const float*)d_in[16]; const float* w_e_in = (const float*)d_in[17]; const float* b_e_in = (const float*)d_in[18]; const float* w_e_out = (const float*)d_in[19];
    const float* b_e_out = (const float*)d_in[20]; const float* g_final = (const float*)d_in[21];
    float* out = (float*)d_out; unsigned char* ws = (unsigned char*)d_ws;
    bf16_t* WIN = (bf16_t*)(ws + WS_WIN); bf16_t* WOUT = (bf16_t*)(ws + WS_WOUT); bf16_t* WQ = (bf16_t*)(ws + WS_WQ); bf16_t* WKV = (bf16_t*)(ws + WS_WKV); bf16_t* WO = (bf16_t*)(ws + WS_WO);
    bf16_t* WP = (bf16_t*)(ws + WS_WP); float* WR = (float*)(ws + WS_WR); float* RSTDX = (float*)(ws + WS_RSTDX); float* RSTDM = (float*)(ws + WS_RSTDM);
    bf16_t* W1 = (bf16_t*)(ws + WS_W1); bf16_t* W2 = (bf16_t*)(ws + WS_W2); bf16_t* S0 = (bf16_t*)(ws + WS_S0); bf16_t* QKVU = (bf16_t*)(ws + WS_QKVU);
    bf16_t* QM = (bf16_t*)(ws + WS_QM); bf16_t* OM = (bf16_t*)(ws + WS_OM); bf16_t* MIXED = (bf16_t*)(ws + WS_MIXED); bf16_t* PM = (bf16_t*)(ws + WS_PM); bf16_t* ACT = (bf16_t*)(ws + WS_ACT);
    bf16_t* KM = (bf16_t*)(ws + WS_KM); bf16_t* VMT = (bf16_t*)(ws + WS_VMT); bf16_t* MEMB = (bf16_t*)(ws + WS_MEMB); int* LSLOT = (int*)(ws + WS_LSLOT); float* LGATE = (float*)(ws + WS_LGATE);
    bf16_t* Y = (bf16_t*)(ws + WS_Y); float* SCR_S = (float*)(ws + WS_SCR_S); bf16_t* POOLED = (bf16_t*)(ws + WS_SCR_POOLED); float* POOLO = (float*)(ws + WS_SCR_POOLO);
    int* CNT = (int*)(ws + OFF_CNT); float* SSQSB = (float*)(ws + OFF_SSQSB); float* SSQ1 = (float*)(ws + OFF_SSQ1); float* SSQ2 = (float*)(ws + OFF_SSQ2);

    (void)hipMemsetAsync(ws + WS_CTL, 0, CTL_BYTES, stream);
    mk::Args a{}; for (int i = 0; i < 22; ++i) a.in[i] = (const float*)d_in[i]; a.out = out; a.ws = ws;
    const dim3 tb(32, 8); const int BIG = 1 << 30; int li = 0;
    for (int p = 0; p < mk::NPHASE;) {
        if ((MEGA_MASK >> p) & 1) { int q = p; while (q < mk::NPHASE && ((MEGA_MASK >> q) & 1)) ++q;
            a.ph_lo = p; a.ph_hi = q; a.li = li; hipLaunchKernelGGL(mk::mega, dim3(grid), dim3(mk::NWAVES * 64), mk::LDS_BYTES, stream, a); ++li; p = q; continue; }
        switch (p) {
        case 0:
            nv::k_cvt_w<<<dim3(INP / 32, D / 32, 1), tb, 0, stream>>>(w_in, D, INP, WIN, INP, g_mix, nullptr, BIG, nullptr, 0, 0);
            nv::k_cvt_w<<<dim3(D / 32, D / 32, 1), tb, 0, stream>>>(w_out, D, D, WOUT, D, g_sb, g_pool, SBW, nullptr, 0, 0);
            nv::k_cvt_w<<<dim3(D / 32, D / 32, 1), tb, 0, stream>>>(w_mem_q, D, D, WQ, D, g_mem_q, nullptr, BIG, nullptr, 0, 0);
            nv::k_cvt_w<<<dim3(2 * D / 32, D / 32, 1), tb, 0, stream>>>(w_mem_kv, D, 2 * D, WKV, 2 * D, g_mem_kv, nullptr, BIG, nullptr, 0, 0);
            nv::k_cvt_w<<<dim3(D / 32, D / 32, 1), tb, 0, stream>>>(w_mem_o, D, D, WO, D, nullptr, nullptr, BIG, nullptr, 0, 0);
            nv::k_cvt_w<<<dim3(2 * DFF / 32, D / 32, NE), tb, 0, stream>>>(w_e_in, D, 2 * DFF, W1, 2 * DFF, g_ffn, nullptr, BIG, nullptr, 0, 1);
            nv::k_cvt_w<<<dim3(D / 32, DFF / 32, NE), tb, 0, stream>>>(w_e_out, DFF, D, W2, D, nullptr, nullptr, BIG, nullptr, 0, 0);
            nv::k_cvt_w<<<dim3(PGD / 32, PGD / 32, PG), tb, 0, stream>>>(w_pool, PGD, PGD, WP, PGD, nullptr, nullptr, BIG, pool_scale, PGD, 0);
            nv::k_cvt_router<<<NE * D / 256, 256, 0, stream>>>(w_router, g_ffn, WR);
            nv::k_rowstat_cvt<<<NTOK / 4, 256, 0, stream>>>(x, S0, RSTDX, NTOK);
            nv::k_rowstat_cvt<<<NMROWS / 4, 256, 0, stream>>>(mem, MEMB, RSTDM, NMROWS);
            break;
        case 1:
            nv::k_g1<<<dim3(INP / 64, NTOK / 64), 256, 0, stream>>>(S0, WIN, RSTDX, QKVU);
            nv::k_g1b<<<dim3(2 * D / 64, NMROWS / 64), 256, 0, stream>>>(MEMB, WKV, RSTDM, KM, VMT);
            break;
        case 2:
            nv::k_sb<<<B * NH * S / 256, 256, 0, stream>>>(QKVU, MIXED, SSQSB);
            nv::k_pool1<<<(unsigned)((size_t)NTOK * PW / 256), 256, 0, stream>>>(QKVU, POOLED);
            nv::k_pool2<<<dim3(PGD / 64, NTOK / 64, PG), 256, 0, stream>>>(POOLED, WP, POOLO);
            nv::k_pool3<<<NTOK / 4, 256, 0, stream>>>(POOLO, MIXED);
            break;
        case 3: nv::k_resid<<<dim3(D / 64, NTOK / 64), 256, 0, stream>>>(MIXED, WOUT, x, out, S0, SSQ1, SSQSB, SBW); break;
        case 4: nv::k_g3<<<dim3(D / 64, NTOK / 64), 256, 0, stream>>>(S0, WQ, SSQ1, QM); break;
        case 5:
            nv::k_ms<<<dim3(NMEM / 64, NTOK / 64, MH), 256, 0, stream>>>(QM, KM, SCR_S);
            nv::k_msoftmax<<<NTOK * MH / 4, 256, 0, stream>>>(SCR_S, PM);
            break;
        case 6: nv::k_mpv<<<dim3(MHD / 64, NTOK / 64, MH), 256, 0, stream>>>(PM, VMT, OM); break;
        case 7: nv::k_resid<<<dim3(D / 64, NTOK / 64), 256, 0, stream>>>(OM, WO, out, out, S0, SSQ2, SSQ2, -1); break;
        case 8: nv::k_route<<<NTOK / 4, 256, 0, stream>>>(out, SSQ2, WR, b_router, CNT, LSLOT, LGATE); break;
        case 9: nv::k_w1<<<dim3(DFF / 32, LCAP / 64, NE), 256, 0, stream>>>(S0, SSQ2, W1, b_e_in, CNT, LSLOT, ACT); break;
        case 10: nv::k_w2<<<dim3(D / 64, LCAP / 64, NE), 256, 0, stream>>>(ACT, W2, b_e_out, CNT, LSLOT, LGATE, Y); break;
        case 11: nv::k_final<<<NTOK / 4, 256, 0, stream>>>(out, Y, g_final); break;
        }
        ++p;
    }
}
```

```cpp
#include <hip/hip_runtime.h>
#include <cstdio>
#include <cstdint>

typedef unsigned short bf16_t;
typedef short bf16x8 __attribute__((ext_vector_type(8)));
typedef float f32x4 __attribute__((ext_vector_type(4)));
typedef unsigned u32x4 __attribute__((ext_vector_type(4)));

namespace cfg {
constexpr int B = 8, S = 4096, D = 1024, NTOK = B * S;
constexpr int SBW = 512, NH = 8, HD = 64, PW = 512, PG = 4, PGD = 128, INP = 2048;
constexpr int NMEM = 256, MH = 4, MHD = 256, NMROWS = B * NMEM;
constexpr int NE = 32, TOPK = 4, DFF = 1024, LCAP = NTOK;
constexpr float EPS = 1e-5f, LOG2E = 1.4426950408889634f;
constexpr float C2_SB = 0.125f * LOG2E, C2_MEM = 0.0625f * LOG2E;
constexpr float SW_LIMIT = 7.0f, SW_ALPHA = 1.702f;
constexpr int MAXTILES = 544;
constexpr size_t MiB = 1u << 20;
constexpr size_t WS_CTL = 0, CTL_BYTES = 2 * MiB;
constexpr size_t OFF_CNT = 64 * 1024, OFF_SSQSB = 512 * 1024, OFF_SSQ1 = 640 * 1024, OFF_SSQ2 = 768 * 1024;
constexpr size_t WS_WIN = 2 * MiB, WS_WOUT = 6 * MiB, WS_WQ = 8 * MiB, WS_WKV = 10 * MiB, WS_WO = 14 * MiB, WS_WP = 16 * MiB, WS_WR = 17 * MiB;
constexpr size_t WS_RSTDX = 18 * MiB, WS_RSTDM = 18 * MiB + 512 * 1024;
constexpr size_t WS_W1 = 20 * MiB, WS_W2 = 148 * MiB;
constexpr size_t WS_S0 = 212 * MiB;
constexpr size_t WS_QKVU = 276 * MiB;
constexpr size_t WS_QM = 276 * MiB, WS_OM = 340 * MiB;
constexpr size_t WS_MIXED = 404 * MiB;
constexpr size_t WS_PM = 404 * MiB;
constexpr size_t WS_ACT = 276 * MiB;
constexpr size_t WS_KM = 548 * MiB, WS_VMT = 552 * MiB, WS_MEMB = 556 * MiB, WS_LSLOT = 560 * MiB, WS_LGATE = 564 * MiB;
constexpr size_t WS_Y = 568 * MiB;
constexpr size_t WS_SCR_S = 568 * MiB, WS_SCR_POOLED = 696 * MiB, WS_SCR_POOLO = 728 * MiB;
constexpr size_t WS_END = 824 * MiB;
}
using namespace cfg;

__device__ __forceinline__ unsigned f2bf(float f) { unsigned u = __builtin_bit_cast(unsigned, f); return (u + 0x7fffu + ((u >> 16) & 1u)) >> 16; }
__device__ __forceinline__ float bf2f(bf16_t h) { return __builtin_bit_cast(float, (unsigned)h << 16); }
__device__ __forceinline__ float wave_sum(float v) {
#pragma unroll
    for (int o = 1; o < 64; o <<= 1) v += __shfl_xor(v, o);
    return v;
}

namespace nv {
__global__ void k_cvt_w(const float* src, int K, int N, bf16_t* dst, int ND, const float* gk, const float* gk2, int ksplit, const float* gn, int gnz, int mode) {
    __shared__ float t[32][33];
    const int nd0 = blockIdx.x * 32, k0 = blockIdx.y * 32, z = blockIdx.z;
    int ns0 = nd0;
    if (mode == 1) { const int pn = nd0 >> 8, j = nd0 & 255; ns0 = (j < 128) ? 128 * pn + j : 1024 + 128 * pn + (j - 128); }
    src += (size_t)z * K * N; dst += (size_t)z * ND * K;
    for (int i = threadIdx.y; i < 32; i += 8) { const int k = k0 + i, n = ns0 + threadIdx.x;
        float v = src[(size_t)k * N + n]; if (gk) v *= (k < ksplit) ? gk[k] : gk2[k - ksplit]; if (gn) v *= gn[z * gnz + n]; t[i][threadIdx.x] = v; }
    __syncthreads();
    for (int i = threadIdx.y; i < 32; i += 8) dst[(size_t)(nd0 + i) * K + k0 + threadIdx.x] = (bf16_t)f2bf(t[threadIdx.x][i]);
}
__global__ void k_cvt_router(const float* wr, const float* g, float* dst) {
    const int i = blockIdx.x * 256 + threadIdx.x; if (i >= NE * D) return; const int e = i / D, k = i % D; dst[i] = g[k] * wr[k * NE + e];
}
__global__ void k_rowstat_cvt(const float* x, bf16_t* xb, float* rstd, int rows) {
    const int row = blockIdx.x * 4 + (threadIdx.x >> 6), lane = threadIdx.x & 63; if (row >= rows) return;
    const float* xr = x + (size_t)row * D; float s = 0.f;
    for (int j = lane; j < D; j += 64) { const float v = xr[j]; s += v * v; xb[(size_t)row * D + j] = (bf16_t)f2bf(v); }
    s = wave_sum(s); if (lane == 0) rstd[row] = 1.0f / sqrtf(s * (1.0f / D) + EPS);
}

template <class RA, class RB, class MID, class EPI>
__device__ __forceinline__ void wave_gemm(int m0, int n0, int K, int kmid, RA ra, RB rb, MID mid, EPI epi) {
    const int lane = threadIdx.x & 63, r16 = lane & 15, kq = lane >> 4;
    const bf16_t* pa[2]; const bf16_t* pb[2];
#pragma unroll
    for (int i = 0; i < 2; ++i) { pa[i] = ra(m0 + i * 16 + r16) + kq * 8; pb[i] = rb(n0 + i * 16 + r16) + kq * 8; }
    f32x4 acc[2][2];
#pragma unroll
    for (int i = 0; i < 2; ++i)
#pragma unroll
        for (int j = 0; j < 2; ++j) acc[i][j] = (f32x4){0.f, 0.f, 0.f, 0.f};
    for (int k = 0; k < K; k += 32) {
        if (k == kmid) {
#pragma unroll
            for (int i = 0; i < 2; ++i)
#pragma unroll
                for (int r = 0; r < 4; ++r) { const float s = mid(m0 + i * 16 + kq * 4 + r); acc[i][0][r] *= s; acc[i][1][r] *= s; }
        }
        bf16x8 a[2], b[2];
#pragma unroll
        for (int i = 0; i < 2; ++i) { a[i] = *(const bf16x8*)(pa[i] + k); b[i] = *(const bf16x8*)(pb[i] + k); }
#pragma unroll
        for (int i = 0; i < 2; ++i)
#pragma unroll
            for (int j = 0; j < 2; ++j) acc[i][j] = __builtin_amdgcn_mfma_f32_16x16x32_bf16(a[i], b[j], acc[i][j], 0, 0, 0);
    }
#pragma unroll
    for (int i = 0; i < 2; ++i)
#pragma unroll
        for (int r = 0; r < 4; ++r) epi(m0 + i * 16 + kq * 4 + r, n0 + r16, n0 + 16 + r16, acc[i][0][r], acc[i][1][r]);
}
struct NoMid { __device__ float operator()(int) const { return 1.f; } };

#define NV_TILE() const int w = threadIdx.x >> 6, m0 = blockIdx.y * 64 + (w >> 1) * 32, n0 = blockIdx.x * 64 + (w & 1) * 32

__global__ void k_g1(const bf16_t* XB, const bf16_t* WT, const float* rstd, bf16_t* QKVU) {
    NV_TILE();
    wave_gemm(m0, n0, D, -1, [=](int r) { return XB + (size_t)r * D; }, [=](int c) { return WT + (size_t)c * D; }, NoMid(),
        [=](int r, int c0, int c1, float v0, float v1) { const float s = rstd[r];
            v0 *= s; v1 *= s; if (c0 < SBW) v0 *= C2_SB; if (c1 < SBW) v1 *= C2_SB;
            QKVU[(size_t)r * INP + c0] = (bf16_t)f2bf(v0); QKVU[(size_t)r * INP + c1] = (bf16_t)f2bf(v1); });
}
__global__ void k_g1b(const bf16_t* MEMB, const bf16_t* WT, const float* rstd, bf16_t* KM, bf16_t* VMT) {
    NV_TILE();
    wave_gemm(m0, n0, D, -1, [=](int r) { return MEMB + (size_t)r * D; }, [=](int c) { return WT + (size_t)c * D; }, NoMid(),
        [=](int r, int c0, int c1, float v0, float v1) { const float s = rstd[r]; const int cc[2] = {c0, c1}; const float vv[2] = {v0 * s, v1 * s};
#pragma unroll
            for (int q = 0; q < 2; ++q) { const int c = cc[q];
                if (c < D) KM[(size_t)r * D + c] = (bf16_t)f2bf(vv[q]);
                else VMT[((size_t)(r >> 8) * D + (c - D)) * NMEM + (r & 255)] = (bf16_t)f2bf(vv[q]); } });
}
__global__ void __launch_bounds__(256) k_sb(const bf16_t* QKVU, bf16_t* MIXED, float* SSQSB) {
    const int gid = blockIdx.x * 256 + threadIdx.x; const int t = gid & (S - 1), h = (gid >> 12) & 7, b = gid >> 15;
    const bf16_t* base = QKVU + (size_t)b * S * INP;
    float q[HD], o[HD];
    { const bf16_t* qp = base + (size_t)t * INP + h * HD;
#pragma unroll
      for (int d = 0; d < HD; ++d) { q[d] = bf2f(qp[d]); o[d] = 0.f; } }
    float P = 1.f;
    for (int s = t - 1; s >= 0; --s) {
        const bf16_t* kp = base + (size_t)s * INP + SBW + h * HD; const bf16_t* vp = kp + SBW;
        float z = 0.f;
#pragma unroll
        for (int d = 0; d < HD; ++d) z += q[d] * bf2f(kp[d]);
        const float e = exp2f(z), r = 1.0f / (1.0f + e), beta = 1.0f - r;
        const float w = bf2f((bf16_t)f2bf(beta * P));
#pragma unroll
        for (int d = 0; d < HD; ++d) o[d] += w * bf2f(vp[d]);
        P *= r;
        if (P == 0.f) break;
    }
    float ss = 0.f; bf16_t* op = MIXED + (size_t)(b * S + t) * D + h * HD;
#pragma unroll
    for (int d = 0; d < HD; ++d) { ss += o[d] * o[d]; op[d] = (bf16_t)f2bf(o[d]); }
    unsafeAtomicAdd(SSQSB + b * S + t, ss);
}
__global__ void k_pool1(const bf16_t* QKVU, bf16_t* POOLED) {
    const size_t gid = (size_t)blockIdx.x * 256 + threadIdx.x; const int c = gid & 511; const int tok = (int)(gid >> 9), t = tok & (S - 1);
    const int win = 2 << (c >> 7); const int n = (t + 1 < win) ? t + 1 : win;
    const bf16_t* up = QKVU + (size_t)tok * INP + 3 * SBW + c; float s = 0.f;
    for (int j = 0; j < n; ++j) s += bf2f(up[-(ptrdiff_t)j * INP]);
    POOLED[gid] = (bf16_t)f2bf(s / (float)n - bf2f(up[0]));
}
__global__ void k_pool2(const bf16_t* POOLED, const bf16_t* WPT, float* POOLO) {
    NV_TILE(); const int g = blockIdx.z;
    wave_gemm(m0, n0, PGD, -1, [=](int r) { return POOLED + (size_t)r * PW + g * PGD; }, [=](int c) { return WPT + ((size_t)g * PGD + c) * PGD; }, NoMid(),
        [=](int r, int c0, int c1, float v0, float v1) { POOLO[(size_t)r * PW + g * PGD + c0] = v0; POOLO[(size_t)r * PW + g * PGD + c1] = v1; });
}
__global__ void k_pool3(const float* POOLO, bf16_t* MIXED) {
    const int tok = blockIdx.x * 4 + (threadIdx.x >> 6), lane = threadIdx.x & 63;
    float v[8], s = 0.f;
#pragma unroll
    for (int j = 0; j < 8; ++j) { v[j] = POOLO[(size_t)tok * PW + lane + 64 * j]; s += v[j] * v[j]; }
    const float rs = 1.0f / sqrtf(wave_sum(s) * (1.0f / PW) + EPS);
#pragma unroll
    for (int j = 0; j < 8; ++j) MIXED[(size_t)tok * D + SBW + lane + 64 * j] = (bf16_t)f2bf(v[j] * rs);
}
__global__ void k_resid(const bf16_t* A, const bf16_t* WT, const float* xin, float* xout, bf16_t* XB, float* SSQ, const float* ssq_mid, int kmid) {
    NV_TILE();
    wave_gemm(m0, n0, D, kmid, [=](int r) { return A + (size_t)r * D; }, [=](int c) { return WT + (size_t)c * D; },
        [=](int r) { return 1.0f / sqrtf(ssq_mid[r] * (1.0f / SBW) + EPS); },
        [=](int r, int c0, int c1, float v0, float v1) {
            const float x0 = xin[(size_t)r * D + c0] + v0, x1 = xin[(size_t)r * D + c1] + v1;
            xout[(size_t)r * D + c0] = x0; xout[(size_t)r * D + c1] = x1;
            XB[(size_t)r * D + c0] = (bf16_t)f2bf(x0); XB[(size_t)r * D + c1] = (bf16_t)f2bf(x1);
            float q = x0 * x0 + x1 * x1; q += __shfl_xor(q, 1); q += __shfl_xor(q, 2); q += __shfl_xor(q, 4); q += __shfl_xor(q, 8);
            if ((threadIdx.x & 15) == 0) unsafeAtomicAdd(SSQ + r, q); });
}
__global__ void k_g3(const bf16_t* X1B, const bf16_t* WT, const float* SSQ1, bf16_t* QM) {
    NV_TILE();
    wave_gemm(m0, n0, D, -1, [=](int r) { return X1B + (size_t)r * D; }, [=](int c) { return WT + (size_t)c * D; }, NoMid(),
        [=](int r, int c0, int c1, float v0, float v1) { const float s = C2_MEM / sqrtf(SSQ1[r] * (1.0f / D) + EPS);
            QM[(size_t)r * D + c0] = (bf16_t)f2bf(v0 * s); QM[(size_t)r * D + c1] = (bf16_t)f2bf(v1 * s); });
}
__global__ void k_ms(const bf16_t* QM, const bf16_t* KM, float* SCR) {
    NV_TILE(); const int h = blockIdx.z; const int b = m0 >> 12;
    wave_gemm(m0, n0, MHD, -1, [=](int r) { return QM + (size_t)r * D + h * MHD; }, [=](int c) { return KM + ((size_t)b * NMEM + c) * D + h * MHD; }, NoMid(),
        [=](int r, int c0, int c1, float v0, float v1) { SCR[((size_t)r * MH + h) * NMEM + c0] = v0; SCR[((size_t)r * MH + h) * NMEM + c1] = v1; });
}
__global__ void k_msoftmax(const float* SCR, bf16_t* PM) {
    const int row = blockIdx.x * 4 + (threadIdx.x >> 6), lane = threadIdx.x & 63;
    float v[4], m = -INFINITY;
#pragma unroll
    for (int j = 0; j < 4; ++j) { v[j] = SCR[(size_t)row * NMEM + lane + 64 * j]; m = fmaxf(m, v[j]); }
#pragma unroll
    for (int o = 1; o < 64; o <<= 1) m = fmaxf(m, __shfl_xor(m, o));
    float s = 0.f;
#pragma unroll
    for (int j = 0; j < 4; ++j) { v[j] = exp2f(v[j] - m); s += v[j]; }
    s = 1.0f / wave_sum(s);
#pragma unroll
    for (int j = 0; j < 4; ++j) PM[(size_t)row * NMEM + lane + 64 * j] = (bf16_t)f2bf(v[j] * s);
}
__global__ void k_mpv(const bf16_t* PM, const bf16_t* VMT, bf16_t* OM) {
    NV_TILE(); const int h = blockIdx.z; const int b = m0 >> 12;
    wave_gemm(m0, n0, NMEM, -1, [=](int r) { return PM + ((size_t)r * MH + h) * NMEM; }, [=](int c) { return VMT + ((size_t)b * D + h * MHD + c) * NMEM; }, NoMid(),
        [=](int r, int c0, int c1, float v0, float v1) { OM[(size_t)r * D + h * MHD + c0] = (bf16_t)f2bf(v0); OM[(size_t)r * D + h * MHD + c1] = (bf16_t)f2bf(v1); });
}
__global__ void k_route(const float* x2, const float* SSQ2, const float* WR, const float* br, int* CNT, int* LSLOT, float* LGATE) {
    const int tok = blockIdx.x * 4 + (threadIdx.x >> 6), lane = threadIdx.x & 63;
    float xv[16];
#pragma unroll
    for (int j = 0; j < 16; ++j) xv[j] = x2[(size_t)tok * D + lane + 64 * j];
    const float rs = 1.0f / sqrtf(SSQ2[tok] * (1.0f / D) + EPS);
    float mine = 0.f;
    for (int e = 0; e < NE; ++e) { float s = 0.f;
#pragma unroll
        for (int j = 0; j < 16; ++j) s += xv[j] * WR[e * D + lane + 64 * j];
        s = wave_sum(s); if (lane == e) mine = s * rs + br[e]; }
    float tv[4]; int ti[4]; float cur = (lane < NE) ? mine : -INFINITY;
#pragma unroll
    for (int k = 0; k < 4; ++k) { float m = cur; int mi = lane;
#pragma unroll
        for (int o = 1; o < 64; o <<= 1) { const float om = __shfl_xor(m, o); const int oi = __shfl_xor(mi, o); if (om > m || (om == m && oi < mi)) { m = om; mi = oi; } }
        tv[k] = m; ti[k] = mi; if (lane == mi) cur = -INFINITY; }
    float g[4], gs = 0.f;
#pragma unroll
    for (int k = 0; k < 4; ++k) { g[k] = expf(tv[k] - tv[0]); gs += g[k]; }
    if (lane < 4) { int e = ti[0]; float gg = g[0];
        if (lane == 1) { e = ti[1]; gg = g[1]; } if (lane == 2) { e = ti[2]; gg = g[2]; } if (lane == 3) { e = ti[3]; gg = g[3]; }
        const int pos = atomicAdd(CNT + e, 1); LSLOT[(size_t)e * LCAP + pos] = tok * 4 + lane; LGATE[(size_t)e * LCAP + pos] = gg / gs; }
}
__device__ __forceinline__ int tile_base(const int* CNT, int e) { int tb = 0; for (int i = 0; i < e; ++i) tb += (CNT[i] + 255) >> 8; return tb; }
__global__ void k_w1(const bf16_t* X2B, const float* SSQ2, const bf16_t* W1T, const float* b1, const int* CNT, const int* LSLOT, bf16_t* ACT) {
    const int e = blockIdx.z, cnt = CNT[e]; const int w = threadIdx.x >> 6; const int m0 = blockIdx.y * 64 + (w >> 1) * 32; if (blockIdx.y * 64 >= cnt) return;
    const int gc0 = blockIdx.x * 32 + (w & 1) * 16;
    const int pn = gc0 >> 7, j0 = gc0 & 127; const int n0 = pn * 256 + j0;
    const int tb = tile_base(CNT, e); const bf16_t* Wt = W1T + (size_t)e * 2 * DFF * D; const int* ls = LSLOT + (size_t)e * LCAP;
    wave_gemm(m0, 0, D, -1, [=](int r) { const int tok = (r < cnt) ? (ls[r] >> 2) : 0; return X2B + (size_t)tok * D; },
        [=](int c) { const int rowb = (c < 16) ? n0 + c : n0 + 128 + (c - 16); return Wt + (size_t)rowb * D; }, NoMid(),
        [=](int r, int c0, int c1, float vg, float vu) { if (r >= cnt) return; const int tok = ls[r] >> 2; const float rs = 1.0f / sqrtf(SSQ2[tok] * (1.0f / D) + EPS);
            const int gc = gc0 + c0;
            float gate = vg * rs + b1[e * 2 * DFF + gc], up = vu * rs + b1[e * 2 * DFF + DFF + gc];
            gate = fminf(gate, SW_LIMIT); up = fminf(fmaxf(up, -SW_LIMIT), SW_LIMIT);
            const float act = (up + 1.0f) * gate / (1.0f + expf(-SW_ALPHA * gate));
            ACT[((size_t)tb * 256 + r) * DFF + gc] = (bf16_t)f2bf(act); (void)c1; });
}
__global__ void k_w2(const bf16_t* ACT, const bf16_t* W2T, const float* b2, const int* CNT, const int* LSLOT, const float* LGATE, bf16_t* Y) {
    const int e = blockIdx.z, cnt = CNT[e]; if (blockIdx.y * 64 >= cnt) return; NV_TILE();
    const int tb = tile_base(CNT, e); const bf16_t* Wt = W2T + (size_t)e * D * DFF; const int* ls = LSLOT + (size_t)e * LCAP; const float* lg = LGATE + (size_t)e * LCAP;
    wave_gemm(m0, n0, DFF, -1, [=](int r) { return ACT + ((size_t)tb * 256 + r) * DFF; }, [=](int c) { return Wt + (size_t)c * DFF; }, NoMid(),
        [=](int r, int c0, int c1, float v0, float v1) { if (r >= cnt) return; const int slot = ls[r]; const float g = lg[r];
            Y[(size_t)slot * D + c0] = (bf16_t)f2bf((v0 + b2[e * D + c0]) * g); Y[(size_t)slot * D + c1] = (bf16_t)f2bf((v1 + b2[e * D + c1]) * g); });
}
__global__ void k_final(float* out, const bf16_t* Y, const float* gf) {
    const int tok = blockIdx.x * 4 + (threadIdx.x >> 6), lane = threadIdx.x & 63;
    float v[16], s = 0.f;
#pragma unroll
    for (int j = 0; j < 16; ++j) { const int c = lane + 64 * j; float a = out[(size_t)tok * D + c];
#pragma unroll
        for (int k = 0; k < 4; ++k) a += bf2f(Y[((size_t)tok * 4 + k) * D + c]);
        v[j] = a; s += a * a; }
    const float rs = 1.0f / sqrtf(wave_sum(s) * (1.0f / D) + EPS);
#pragma unroll
    for (int j = 0; j < 16; ++j) { const int c = lane + 64 * j; out[(size_t)tok * D + c] = v[j] * rs * gf[c]; }
}
}

#define LAS __attribute__((address_space(3)))
#define GAS __attribute__((address_space(1)))
typedef int v4i_t __attribute__((ext_vector_type(4)));
typedef int v8i_t __attribute__((ext_vector_type(8)));
namespace pg8 {
constexpr int BM = 256, BK = 64, HALF = 128, HTB = HALF * BK * 2, STAGE_BYTES = 8 * HTB, NXCD = 8, WGM = 8;
__host__ __device__ __forceinline__ int lds_byte(int r, int c) { const int st = (r >> 4) * 2 + (c >> 5), rr = r & 15, cc = c & 31, ob = rr * 64 + cc * 2; return st * 1024 + (ob ^ (((ob >> 9) & 1) << 5)); }
__host__ __device__ __forceinline__ void stage_rc(int b, int& R, int& C) { const int st = b / 1024, sb = b % 1024, swz = sb ^ (((sb >> 9) & 1) << 5); R = (st >> 1) * 16 + swz / 64; C = (st & 1) * 32 + (swz % 64) / 2; }
__host__ __device__ __forceinline__ int perm32(int rho) { const int n = rho >> 4, i = rho & 15; return 8 * (i >> 2) + 4 * n + (i & 3); }
__device__ __forceinline__ unsigned cvt_pk_bf16(float lo, float hi) { unsigned r; asm volatile("v_cvt_pk_bf16_f32 %0, %1, %2" : "=v"(r) : "v"(lo), "v"(hi)); return r; }

__device__ __forceinline__ int fresh_lane() { int l; asm volatile("v_mbcnt_lo_u32_b32 %0, -1, 0\n\tv_mbcnt_hi_u32_b32 %0, -1, %0" : "=v"(l)); return l; }
struct Unit { const char* A; const char* B; void* p0; void* p1; void* p2; void* p3; int pm, pn, i0, i1, ghost; };

__device__ __forceinline__ int xcd_remap(int L, int nwg) { const int q = nwg / NXCD, r = nwg % NXCD, xcd = L % NXCD, off = L / NXCD; return __builtin_amdgcn_readfirstlane((xcd < r ? xcd * (q + 1) : r * (q + 1) + (xcd - r) * q) + off); }
__device__ __forceinline__ void grouped_mn(int wgid, int nM, int nN, int& pm, int& pn) {
    const int nig = WGM * nN, gid = wgid / nig, fm = gid * WGM, gsz = (nM - fm) < WGM ? (nM - fm) : WGM; pm = __builtin_amdgcn_readfirstlane(fm + ((wgid % nig) % gsz)); pn = __builtin_amdgcn_readfirstlane((wgid % nig) / gsz); }

template <class Epi, class Sched, bool GATHER, int REP = 1, int REPE = 1, bool F8 = false>
__device__ __forceinline__ void gemm_phase(const int wid, LAS unsigned char* lds, LAS unsigned char* epi_lds, LAS unsigned* gtab, const int lda_b, const int ldb_b, const int nt, const Sched& S, const Epi& E) {
    const int wr = wid >> 2, wc = wid & 3;
    unsigned voffA, voffB, voffG[2][2]; int aoff, boff;
    { const int lane = fresh_lane(); int R, C; stage_rc(wid * 1024 + lane * 16, R, C); const int Rb = Epi::PERM ? ((R & ~31) + perm32(R & 31)) : R;
      voffA = (unsigned)(R * lda_b + C * 2); voffB = (unsigned)(Rb * ldb_b + C * 2); voffG[0][0] = voffG[0][1] = voffG[1][0] = voffG[1][1] = 0;
      aoff = lds_byte(wr * 64 + (lane & 15), (lane >> 4) * 8); boff = lds_byte(wc * 32 + (lane & 15), (lane >> 4) * 8); }
    const size_t kstep = (size_t)(BK * 2);
    const size_t hstepA = (size_t)HALF * lda_b, hstepB = (size_t)HALF * ldb_b;
    const unsigned ldsw = (unsigned)wid * 1024u;
#define PG8_SA(b, h) (((b) * 2 + (h)) * HTB)
#define PG8_SB(b, h) ((4 + (b) * 2 + (h)) * HTB)
#define PG8_GLDS(ugp, voff, bufoff, _i) do { const char* _u = (const char*)(ugp); asm volatile("" : "+s"(_u));     \
        __builtin_amdgcn_global_load_lds((const unsigned*)(_u + (voff)), (LAS unsigned*)(lds + (bufoff) + ldsw + (_i) * 8192), 16, 0, 0); } while (0)
#define PG8_STAGE_B(bufoff, gbase) do { _Pragma("unroll") for (int _i = 0; _i < 2; ++_i) PG8_GLDS((const char*)(gbase) + (size_t)_i * 64 * ldb_b, voffB, bufoff, _i); } while (0)
#define PG8_STAGE_A(bufoff, gbase, h) do { if constexpr (GATHER) { _Pragma("unroll") for (int _i = 0; _i < 2; ++_i) PG8_GLDS((const char*)(gbase), voffG[h][_i], bufoff, _i); } \
        else { _Pragma("unroll") for (int _i = 0; _i < 2; ++_i) PG8_GLDS((const char*)(gbase) + (h) * hstepA + (size_t)_i * 64 * lda_b, voffA, bufoff, _i); } } while (0)
#define PG8_LDA(dst, b, h) do { _Pragma("unroll") for (int m = 0; m < 4; ++m) _Pragma("unroll") for (int k = 0; k < 2; ++k) dst[m][k] = *(const LAS bf16x8*)(lds + PG8_SA(b, h) + aoff + m * 2048 + k * 1024); } while (0)
#define PG8_LDB(dst, b, h) do { _Pragma("unroll") for (int n = 0; n < 2; ++n) _Pragma("unroll") for (int k = 0; k < 2; ++k) dst[n][k] = *(const LAS bf16x8*)(lds + PG8_SB(b, h) + boff + n * 2048 + k * 1024); } while (0)
#define PG8_CAT(x0, x1) __builtin_shufflevector(__builtin_bit_cast(v4i_t, x0), __builtin_bit_cast(v4i_t, x1), 0, 1, 2, 3, 4, 5, 6, 7)
#define PG8_MMA(ai, bj, At, Bt) do { __builtin_amdgcn_s_setprio(1); _Pragma("unroll") for (int m = 0; m < 4; ++m) _Pragma("unroll") for (int n = 0; n < 2; ++n) { \
        if constexpr (F8) acc[ai][bj][m][n] = __builtin_amdgcn_mfma_scale_f32_16x16x128_f8f6f4(PG8_CAT(Bt[n][0], Bt[n][1]), PG8_CAT(At[m][0], At[m][1]), acc[ai][bj][m][n], 0, 0, 0, 0, 0, 0); \
        else { _Pragma("unroll") for (int k = 0; k < 2; ++k) acc[ai][bj][m][n] = __builtin_amdgcn_mfma_f32_16x16x32_bf16(Bt[n][k], At[m][k], acc[ai][bj][m][n], 0, 0, 0); } } __builtin_amdgcn_s_setprio(0); } while (0)
#define PG8_WAIT_V(n) asm volatile("s_waitcnt vmcnt(" #n ")" ::: "memory")
#define PG8_WAIT_L(n) asm volatile("s_waitcnt lgkmcnt(" #n ")" ::: "memory")
#define PG8_BAR __builtin_amdgcn_s_barrier()
#define PG8_SCHED __builtin_amdgcn_sched_barrier(0)
#define PG8_GTAB_LOAD(buf, nvalid) do { const int _l = fresh_lane(); int _R, _C; stage_rc(wid * 1024 + _l * 16, _R, _C); _Pragma("unroll") for (int _h = 0; _h < 2; ++_h) _Pragma("unroll") for (int _i = 0; _i < 2; ++_i) { \
        const int _row = _h * HALF + _R + 64 * _i; const unsigned _s = gtab[(buf) * 256 + _row]; voffG[_h][_i] = ((_row < (nvalid)) ? (_s >> 2) * (unsigned)lda_b : 0u) + (unsigned)(_C * 2); } } while (0)
#define PG8_GTAB_DMA(buf, src) do { if (wid == 0) __builtin_amdgcn_global_load_lds((const unsigned*)((const char*)(src) + fresh_lane() * 16), (LAS unsigned*)(gtab + (buf) * 256), 16, 0, 0); } while (0)
    auto nextu = [&](int i, Unit& u) -> bool { if constexpr (REP > 1) { const bool ok = S.next(i / REP, u); u.ghost = (i % REP) != REP - 1; return ok; } else { u.ghost = 0; return S.next(i, u); } };
    Unit cur, nxt; int ui = 0;
    if (!nextu(0, cur)) return;
    f32x4 acc[2][2][4][2];
#pragma unroll
    for (int a = 0; a < 2; ++a)
#pragma unroll
        for (int b = 0; b < 2; ++b)
#pragma unroll
            for (int m = 0; m < 4; ++m)
#pragma unroll
                for (int n = 0; n < 2; ++n) acc[a][b][m][n] = (f32x4){0.f, 0.f, 0.f, 0.f};
    bf16x8 At[4][2], B0[2][2], B1[2][2];
    const char* cA = cur.A; const char* cB = cur.B;
    if constexpr (GATHER) { PG8_GTAB_DMA(0, cur.p3); PG8_WAIT_V(0); PG8_WAIT_L(0); PG8_BAR; PG8_GTAB_LOAD(0, cur.i0); }
    PG8_STAGE_B(PG8_SB(0, 0), cB); PG8_STAGE_B(PG8_SB(0, 1), cB + hstepB); PG8_STAGE_A(PG8_SA(0, 0), cA, 0); PG8_STAGE_A(PG8_SA(0, 1), cA, 1);
    if (wr == 1) PG8_BAR;
    PG8_WAIT_V(2); PG8_BAR;
    PG8_STAGE_B(PG8_SB(1, 0), cB + kstep); PG8_STAGE_A(PG8_SA(1, 0), cA + kstep, 0); PG8_STAGE_B(PG8_SB(1, 1), cB + hstepB + kstep);
    PG8_WAIT_V(6); PG8_BAR;
    for (;;) {
        const bool has_next = nextu(ui + 1, nxt);
        const char* nA = has_next ? nxt.A : cA; const char* nB = has_next ? nxt.B : cB;
#pragma unroll 1
        for (int t = 0; t < nt; t += 2) {
            const bool last = (t == nt - 2);
            const char* a1 = cA + (size_t)(t + 1) * kstep;
            const char* a2 = last ? nA : cA + (size_t)(t + 2) * kstep; const char* b2 = last ? nB : cB + (size_t)(t + 2) * kstep;
            const char* a3 = a2 + kstep; const char* b3 = b2 + kstep;
            if constexpr (Epi::MIDK >= 0) { if (t == Epi::MIDK) E.midk(acc, cur, wr, fresh_lane() & 15); }
            if constexpr (GATHER) { if (t == 0 && has_next) PG8_GTAB_DMA((ui + 1) & 1, nxt.p3); }
            if constexpr (GATHER) { PG8_STAGE_A(PG8_SA(1, 1), a1, 1); if (last && has_next) PG8_GTAB_LOAD((ui + 1) & 1, nxt.i0); PG8_SCHED; }
            PG8_LDB(B0, 0, 0); PG8_LDB(B1, 0, 1); PG8_SCHED; PG8_LDA(At, 0, 0); if constexpr (!GATHER) PG8_STAGE_A(PG8_SA(1, 1), a1, 1);
            PG8_WAIT_V(8); PG8_WAIT_L(0); PG8_BAR; PG8_MMA(0, 0, At, B0); PG8_MMA(0, 1, At, B1); PG8_BAR; PG8_SCHED;
            PG8_LDA(At, 0, 1); PG8_STAGE_B(PG8_SB(0, 0), b2); PG8_STAGE_B(PG8_SB(0, 1), b2 + hstepB); PG8_STAGE_A(PG8_SA(0, 0), a2, 0);
            PG8_WAIT_V(8); PG8_WAIT_L(0); PG8_BAR; PG8_MMA(1, 0, At, B0); PG8_MMA(1, 1, At, B1); PG8_BAR; PG8_SCHED;
            PG8_LDB(B0, 1, 0); PG8_LDB(B1, 1, 1); PG8_SCHED; PG8_LDA(At, 1, 0); PG8_STAGE_A(PG8_SA(0, 1), a2, 1);
            PG8_WAIT_V(8); PG8_WAIT_L(0); PG8_BAR; PG8_MMA(0, 0, At, B0); PG8_MMA(0, 1, At, B1); PG8_BAR; PG8_SCHED;
            PG8_LDA(At, 1, 1); PG8_STAGE_B(PG8_SB(1, 0), b3); PG8_STAGE_B(PG8_SB(1, 1), b3 + hstepB); PG8_STAGE_A(PG8_SA(1, 0), a3, 0);
            PG8_WAIT_V(8); PG8_WAIT_L(0); PG8_BAR; PG8_MMA(1, 0, At, B0); PG8_MMA(1, 1, At, B1); PG8_BAR; PG8_SCHED;
        }
        if (wr == 0) PG8_BAR;
        if (!cur.ghost) { const int el = fresh_lane(); E(acc, cur, wr, wc, el & 15, el >> 4, wid, el, epi_lds); if constexpr (REPE > 1) { asm volatile("" ::: "memory"); E(acc, cur, wr, wc, el & 15, el >> 4, wid, el, epi_lds); } }
        if (!has_next) break;
#pragma unroll
        for (int a = 0; a < 2; ++a)
#pragma unroll
            for (int b = 0; b < 2; ++b)
#pragma unroll
                for (int m = 0; m < 4; ++m)
#pragma unroll
                    for (int n = 0; n < 2; ++n) acc[a][b][m][n] = (f32x4){0.f, 0.f, 0.f, 0.f};
        cur = nxt; cA = nA; cB = nB; ++ui;
        if (wr == 1) PG8_BAR;
    }
    PG8_WAIT_V(0);
    PG8_BAR;
#undef PG8_SA
#undef PG8_SB
#undef PG8_GLDS
#undef PG8_STAGE_A
#undef PG8_STAGE_B
#undef PG8_LDA
#undef PG8_LDB
#undef PG8_MMA
#undef PG8_CAT
#undef PG8_WAIT_V
#undef PG8_WAIT_L
#undef PG8_BAR
#undef PG8_SCHED
#undef PG8_GTAB_LOAD
#undef PG8_GTAB_DMA
}

struct EpiBf16S {
    static constexpr bool PERM = true; static constexpr int MIDK = -1;
    __device__ __forceinline__ void midk(f32x4 (&)[2][2][4][2], const Unit&, int, int) const {}
    __device__ __forceinline__ void operator()(const f32x4 (&acc)[2][2][4][2], const Unit& u, int wr, int wc, int fr, int fq, int, int, LAS unsigned char*) const {
        bf16_t* O = (bf16_t*)u.p0; const float* rs = (const float*)u.p1; const float* cs = (const float*)u.p2; const int ldc = u.i0;
        int r0 = wr * 64 + fr, c0 = wc * 32 + 8 * fq; asm volatile("" : "+v"(r0), "+v"(c0));
        f32x4 cv[2][2];
#pragma unroll
        for (int bj = 0; bj < 2; ++bj)
#pragma unroll
            for (int n = 0; n < 2; ++n) cv[bj][n] = cs ? *(const f32x4*)(cs + c0 + bj * HALF + 4 * n) : (f32x4){1.f, 1.f, 1.f, 1.f};
#pragma unroll
        for (int ai = 0; ai < 2; ++ai)
#pragma unroll
            for (int m = 0; m < 4; ++m) { const int r = r0 + ai * HALF + m * 16; const float rv = rs ? rs[r] : 1.f; bf16_t* rowp = O + (size_t)r * ldc + c0;
#pragma unroll
                for (int bj = 0; bj < 2; ++bj) { const f32x4 v0 = acc[ai][bj][m][0] * cv[bj][0] * rv, v1 = acc[ai][bj][m][1] * cv[bj][1] * rv;
                    u32x4 w; w.x = cvt_pk_bf16(v0[0], v0[1]); w.y = cvt_pk_bf16(v0[2], v0[3]); w.z = cvt_pk_bf16(v1[0], v1[1]); w.w = cvt_pk_bf16(v1[2], v1[3]);
                    *(u32x4*)(rowp + bj * HALF) = w; } }
    }
};
}

namespace mk {
constexpr int NWAVES = 8, NPHASE = 12;
constexpr int RING_OFF = 0, RING_BYTES = 131072, EPI_OFF = 131072, EPI_BYTES = 8192, GTAB_OFF = EPI_OFF + EPI_BYTES, GTAB_BYTES = 2048, MISC_OFF = GTAB_OFF + GTAB_BYTES, MISC_BYTES = 1024;
constexpr int LDS_BYTES = 147456;
static_assert(MISC_OFF + MISC_BYTES <= LDS_BYTES, "LDS map");
constexpr size_t WS_CSG1 = 19 * MiB, WS_WRH = 19 * MiB + 64 * 1024, WS_WRL = 19 * MiB + 128 * 1024;
constexpr float WSCALE = 32.0f;
constexpr int CW_BAR = 1024;

#define RLX_AGENT __ATOMIC_RELAXED, __HIP_MEMORY_SCOPE_AGENT
#define LDS_WAIT() asm volatile("s_waitcnt lgkmcnt(0)" ::: "memory")
#define VM_WAIT() asm volatile("s_waitcnt vmcnt(0)" ::: "memory")
#define XB_TMO      128
#define XB_XCNT(j)  (256  + 64 * (j))
#define XB_XSUB(j)  (1280 + 64 * (j))
#define XB_XGEN(j)  (2304 + 64 * (j))
#define XB_TOP      3328
#define XB_TOPGEN   3392
#define XCD_BAR_WORDS 3456
#define XB_SPIN_CAP (1u << 20)
__device__ __forceinline__ unsigned xb_ld(unsigned* p)              { return __hip_atomic_load(p, __ATOMIC_RELAXED, __HIP_MEMORY_SCOPE_AGENT); }
__device__ __forceinline__ unsigned xb_add(unsigned* p, unsigned v) { return __hip_atomic_fetch_add(p, v, __ATOMIC_RELAXED, __HIP_MEMORY_SCOPE_AGENT); }
__device__ __forceinline__ unsigned xb_xcc_id() { return (unsigned)__builtin_amdgcn_s_getreg((3 << 11) | 20) & 0xFu; }
#define XB_SPIN(cond, bar) do { unsigned _sp = 0; while (cond) { __builtin_amdgcn_s_sleep(1); \
    if ((++_sp & 255u) == 0u) { if (xb_ld(&(bar)[XB_TMO])) break; if (_sp > XB_SPIN_CAP) { atomicAdd(&(bar)[XB_TMO], 1u); break; } } } } while (0)
struct XcdBarrier { unsigned* bar; unsigned x; volatile LAS unsigned* st; };
__device__ __forceinline__ XcdBarrier xcd_barrier_post(unsigned* bar, volatile LAS unsigned* st) {
    XcdBarrier b; b.bar = bar; b.x = xb_xcc_id(); b.st = st;
    if (threadIdx.x == 0) (void)xb_add(&bar[XB_XCNT(b.x)], 1u);
    return b;
}
__device__ __forceinline__ void xcd_barrier_complete(unsigned* bar, unsigned x, unsigned& nloc, unsigned& nx) {
    const unsigned G = gridDim.x * gridDim.y * gridDim.z;
    unsigned sum, cnt, mine, sp = 0u;
    for (;;) {
        sum = 0u; cnt = 0u; mine = 0u;
#pragma unroll
        for (unsigned j = 0; j < 16; ++j) { const unsigned c = xb_ld(&bar[XB_XCNT(j)]); sum += c; cnt += (c > 0u) ? 1u : 0u; mine = (j == x) ? c : mine; }
        if (sum == G) break;
        __builtin_amdgcn_s_sleep(1);
        if ((++sp & 255u) == 0u) { if (xb_ld(&bar[XB_TMO])) break; if (sp > XB_SPIN_CAP) { atomicAdd(&bar[XB_TMO], 1u); break; } }
    }
    nloc = mine > 0u ? mine : 1u; nx = cnt > 0u ? cnt : 1u;
}
__device__ __forceinline__ void xcd_barrier(const XcdBarrier& b) {
    asm volatile("s_waitcnt vmcnt(0)" ::: "memory");
    __syncthreads();
    if (threadIdx.x == 0) {
        unsigned* bar = b.bar;
        __builtin_amdgcn_s_waitcnt(0);
        unsigned nloc = b.st[0], nx = b.st[1];
        if (nloc == 0u) { xcd_barrier_complete(bar, b.x, nloc, nx); b.st[0] = nloc; b.st[1] = nx; }
        const unsigned old = xb_add(&bar[XB_XSUB(b.x)], 1u);
        const unsigned gen = old / nloc;
        if (old + 1u == (gen + 1u) * nloc) {
            __builtin_amdgcn_fence(__ATOMIC_RELEASE, "agent");
            asm volatile("s_waitcnt vmcnt(0)" ::: "memory");
            const unsigned og = xb_add(&bar[XB_TOP], 1u);
            const unsigned tg = og / nx;
            if (og + 1u == (tg + 1u) * nx) xb_add(&bar[XB_TOPGEN], 1u);
            else XB_SPIN(xb_ld(&bar[XB_TOPGEN]) == tg, bar);
            __builtin_amdgcn_fence(__ATOMIC_ACQUIRE, "agent");
            xb_add(&bar[XB_XGEN(b.x)], 1u);
            asm volatile("s_waitcnt vmcnt(0)" ::: "memory");
        } else {
            XB_SPIN(xb_ld(&bar[XB_XGEN(b.x)]) == gen, bar);
            __builtin_amdgcn_fence(__ATOMIC_ACQUIRE, "agent");
            asm volatile("s_waitcnt vmcnt(0)" ::: "memory");
        }
    }
    __syncthreads();
}

struct Args { const float* in[22]; float* out; unsigned char* ws; int ph_lo, ph_hi, li, pad; };

template <bool F8OUT>
__device__ __forceinline__ void p0_item(const float* W, int K, int N, void* WTv, const float* gk, const float* gk2, int ksplit, const float* gn, int mode, LAS float* scr, int item, int lane, float mult = 1.0f) {
    const int nblk = N / 32, kb = item / nblk, nb = item % nblk, k0 = 64 * kb, nd0 = 32 * nb;
    int ns0 = nd0; if (mode == 1) { const int pn = nd0 >> 8, j = nd0 & 255; ns0 = (j < 128) ? 128 * pn + j : 1024 + 128 * pn + (j - 128); }
    const int kr = lane >> 3, n4 = (lane & 7) * 4;
    f32x4 v[8];
#pragma unroll
    for (int i = 0; i < 8; ++i) v[i] = *(const f32x4*)(W + (size_t)(k0 + 8 * i + kr) * N + ns0 + n4);
    f32x4 gnv = (f32x4){1.f, 1.f, 1.f, 1.f}; if (gn) gnv = *(const f32x4*)(gn + ns0 + n4);
#pragma unroll
    for (int i = 0; i < 8; ++i) { const int kk = 8 * i + kr, k = k0 + kk; float g = 1.f; if (gk) g = (k < ksplit) ? gk[k] : gk2[k - ksplit];
        const f32x4 t = v[i] * gnv * (g * mult); LAS float* d = scr + kk * 33 + n4; d[0] = t[0]; d[1] = t[1]; d[2] = t[2]; d[3] = t[3]; }
    LDS_WAIT(); asm volatile("" ::: "memory");
    const int c = lane & 7;
#pragma unroll
    for (int j = 0; j < 4; ++j) { const int n = (lane >> 3) + 8 * j; const LAS float* s = scr + (8 * c) * 33 + n;
        if constexpr (F8OUT) { int lo = __builtin_amdgcn_cvt_pk_fp8_f32(s[0 * 33], s[1 * 33], 0, false); lo = __builtin_amdgcn_cvt_pk_fp8_f32(s[2 * 33], s[3 * 33], lo, true);
            int hi2 = __builtin_amdgcn_cvt_pk_fp8_f32(s[4 * 33], s[5 * 33], 0, false); hi2 = __builtin_amdgcn_cvt_pk_fp8_f32(s[6 * 33], s[7 * 33], hi2, true);
            *(unsigned long long*)((unsigned char*)WTv + (size_t)(nd0 + n) * K + k0 + 8 * c) = (unsigned long long)(unsigned)lo | ((unsigned long long)(unsigned)hi2 << 32); }
        else { u32x4 o; o.x = pg8::cvt_pk_bf16(s[0 * 33], s[1 * 33]); o.y = pg8::cvt_pk_bf16(s[2 * 33], s[3 * 33]); o.z = pg8::cvt_pk_bf16(s[4 * 33], s[5 * 33]); o.w = pg8::cvt_pk_bf16(s[6 * 33], s[7 * 33]);
            *(u32x4*)((bf16_t*)WTv + (size_t)(nd0 + n) * K + k0 + 8 * c) = o; } }
    LDS_WAIT(); asm volatile("" ::: "memory");
}
__device__ __forceinline__ void p0_row(const float* xrow, bf16_t* orow, float* rstd, int lane) {
    const f32x4* xr = (const f32x4*)xrow + lane; f32x4 v[4]; float s = 0.f;
#pragma unroll
    for (int j = 0; j < 4; ++j) { v[j] = xr[64 * j]; s += (v[j].x * v[j].x + v[j].y * v[j].y) + (v[j].z * v[j].z + v[j].w * v[j].w); }
    s = wave_sum(s); if (lane == 0) *rstd = 1.0f / sqrtf(s * (1.0f / D) + EPS);
    unsigned long long* o8 = (unsigned long long*)orow + lane;
#pragma unroll
    for (int j = 0; j < 4; ++j) o8[64 * j] = (unsigned long long)pg8::cvt_pk_bf16(v[j].x, v[j].y) | ((unsigned long long)pg8::cvt_pk_bf16(v[j].z, v[j].w) << 32);
}
__device__ __forceinline__ void p0_prologue(const Args& a, LAS unsigned char* lds, int vcu, int G, int wave, int lane) {
    unsigned char* ws = a.ws;
    LAS float* scr = (LAS float*)(lds + RING_OFF + wave * 16384);
    const int gw = vcu * NWAVES + wave, NGW = G * NWAVES;
    constexpr int I_E1 = (D / 64) * (2 * DFF / 32), I_E2 = (DFF / 64) * (D / 32);
    constexpr int I_IN = (D / 64) * (INP / 32), I_SQ = (D / 64) * (D / 32), I_KV = (D / 64) * (2 * D / 32), I_P = (PGD / 64) * (PGD / 32);
    constexpr int N1 = NE * I_E1, N2 = NE * I_E2, NITEMS = N1 + N2 + I_IN + 3 * I_SQ + I_KV + PG * I_P;
    const int BIG = 1 << 30;
    for (int it = gw; it < NITEMS; it += NGW) {
        int r = it;
        if (r < N1) { const int e = r / I_E1; p0_item<true>(a.in[17] + (size_t)e * D * 2 * DFF, D, 2 * DFF, ws + WS_W1 + (size_t)e * 2 * DFF * D, a.in[14], nullptr, BIG, nullptr, 1, scr, r % I_E1, lane, WSCALE); continue; } r -= N1;
        if (r < N2) { const int e = r / I_E2; p0_item<true>(a.in[19] + (size_t)e * DFF * D, DFF, D, ws + WS_W2 + (size_t)e * D * DFF, nullptr, nullptr, BIG, nullptr, 0, scr, r % I_E2, lane, WSCALE); continue; } r -= N2;
        if (r < I_IN) { p0_item<false>(a.in[3], D, INP, (bf16_t*)(ws + WS_WIN), a.in[2], nullptr, BIG, nullptr, 0, scr, r, lane); continue; } r -= I_IN;
        if (r < I_SQ) { p0_item<false>(a.in[8], D, D, (bf16_t*)(ws + WS_WOUT), a.in[4], a.in[5], SBW, nullptr, 0, scr, r, lane); continue; } r -= I_SQ;
        if (r < I_SQ) { p0_item<false>(a.in[11], D, D, (bf16_t*)(ws + WS_WQ), a.in[9], nullptr, BIG, nullptr, 0, scr, r, lane); continue; } r -= I_SQ;
        if (r < I_KV) { p0_item<false>(a.in[12], D, 2 * D, (bf16_t*)(ws + WS_WKV), a.in[10], nullptr, BIG, nullptr, 0, scr, r, lane); continue; } r -= I_KV;
        if (r < I_SQ) { p0_item<false>(a.in[13], D, D, (bf16_t*)(ws + WS_WO), nullptr, nullptr, BIG, nullptr, 0, scr, r, lane); continue; } r -= I_SQ;
        { const int g = r / I_P; p0_item<false>(a.in[6] + (size_t)g * PGD * PGD, PGD, PGD, (bf16_t*)(ws + WS_WP) + (size_t)g * PGD * PGD, nullptr, nullptr, BIG, a.in[7] + g * PGD, 0, scr, r % I_P, lane); }
    }
    for (int m = gw; m < NTOK; m += NGW) p0_row(a.in[0] + (size_t)m * D, (bf16_t*)(ws + WS_S0) + (size_t)m * D, (float*)(ws + WS_RSTDX) + m, lane);
    for (int m = gw; m < NMROWS; m += NGW) p0_row(a.in[1] + (size_t)m * D, (bf16_t*)(ws + WS_MEMB) + (size_t)m * D, (float*)(ws + WS_RSTDM) + m, lane);
    const int gt = gw * 64 + lane, NGT = NGW * 64;
    for (int i = gt; i < INP; i += NGT) ((float*)(ws + WS_CSG1))[i] = (i < SBW) ? C2_SB : 1.0f;
    for (int i = gt; i < NE * D; i += NGT) { const int e = i / D, k = i % D; const float v = a.in[14][k] * a.in[15][k * NE + e];
        ((float*)(ws + WS_WR))[i] = v; const unsigned h = f2bf(v); ((bf16_t*)(ws + WS_WRH))[i] = (bf16_t)h; ((bf16_t*)(ws + WS_WRL))[i] = (bf16_t)f2bf(v - bf2f((bf16_t)h)); }
}

struct SchedP1 {
    int G, c; unsigned char* ws;
    __device__ __forceinline__ bool next(int i, pg8::Unit& u) const {
        const int L = i * G + c; constexpr int NQ = (NTOK / 256) * (INP / 256);
        if (L >= NQ + 64) return false;
        if (L < NQ) { int pm, pn; pg8::grouped_mn(pg8::xcd_remap(L, NQ), NTOK / 256, INP / 256, pm, pn);
            u.A = (const char*)(ws + WS_S0) + (size_t)pm * 256 * D * 2; u.B = (const char*)(ws + WS_WIN) + (size_t)pn * 256 * D * 2;
            u.p0 = (bf16_t*)(ws + WS_QKVU) + (size_t)pm * 256 * INP + pn * 256; u.p1 = (float*)(ws + WS_RSTDX) + pm * 256; u.p2 = (float*)(ws + WS_CSG1) + pn * 256; u.i0 = INP; u.pm = pm; u.pn = pn; }
        else if (L < NQ + 32) { const int k = L - NQ, pm = k >> 2, pn = k & 3;
            u.A = (const char*)(ws + WS_MEMB) + (size_t)pm * 256 * D * 2; u.B = (const char*)(ws + WS_WKV) + (size_t)pn * 256 * D * 2;
            u.p0 = (bf16_t*)(ws + WS_KM) + (size_t)pm * 256 * D + pn * 256; u.p1 = (float*)(ws + WS_RSTDM) + pm * 256; u.p2 = nullptr; u.i0 = D; u.pm = pm; u.pn = pn; }
        else { const int v = L - NQ - 32, b = v >> 2, dt = v & 3;
            u.A = (const char*)(ws + WS_WKV) + (size_t)(D + dt * 256) * D * 2; u.B = (const char*)(ws + WS_MEMB) + (size_t)b * 256 * D * 2;
            u.p0 = (bf16_t*)(ws + WS_VMT) + ((size_t)b * D + dt * 256) * NMEM; u.p1 = nullptr; u.p2 = (float*)(ws + WS_RSTDM) + b * 256; u.i0 = NMEM; u.pm = dt; u.pn = b; }
        u.p3 = nullptr; u.i1 = 0; return true;
    }
};
#define EPI_BAR() asm volatile("s_waitcnt lgkmcnt(0)\n\ts_barrier" ::: "memory")
struct SchedReg {
    int G, c, nM, nN; const char* A; const char* B; size_t astep, bstep; bf16_t* O; int ldc; const float* rs; const float* cs;
    __device__ __forceinline__ bool next(int i, pg8::Unit& u) const {
        const int L = i * G + c; if (L >= nM * nN) return false; int pm, pn; pg8::grouped_mn(pg8::xcd_remap(L, nM * nN), nM, nN, pm, pn);
        u.A = A + (size_t)pm * astep; u.B = B + (size_t)pn * bstep; u.pm = pm; u.pn = pn; u.i0 = ldc; u.i1 = 0;
        u.p0 = O ? (void*)(O + (size_t)pm * 256 * ldc + pn * 256) : nullptr; u.p1 = rs ? (void*)(rs + pm * 256) : nullptr; u.p2 = cs ? (void*)(cs + pn * 256) : nullptr; u.p3 = nullptr; return true;
    }
};
struct EpiBf16Ssq {
    static constexpr bool PERM = true; static constexpr int MIDK = -1; float inv_n, mult;
    __device__ __forceinline__ void midk(f32x4 (&)[2][2][4][2], const pg8::Unit&, int, int) const {}
    __device__ __forceinline__ void operator()(f32x4 (&acc)[2][2][4][2], const pg8::Unit& u, int wr, int wc, int fr, int fq, int, int, LAS unsigned char*) const {
        bf16_t* O = (bf16_t*)u.p0; const float* sq = (const float*)u.p1; const int ldc = u.i0; int r0 = wr * 64 + fr, c0 = wc * 32 + 8 * fq; asm volatile("" : "+v"(r0), "+v"(c0));
#pragma unroll
        for (int ai = 0; ai < 2; ++ai)
#pragma unroll
            for (int m = 0; m < 4; ++m) { const int r = r0 + ai * 128 + m * 16; const float rv = mult / sqrtf(sq[r] * inv_n + EPS); bf16_t* rowp = O + (size_t)r * ldc + c0;
#pragma unroll
                for (int bj = 0; bj < 2; ++bj) { const f32x4 v0 = acc[ai][bj][m][0] * rv, v1 = acc[ai][bj][m][1] * rv;
                    u32x4 w; w.x = pg8::cvt_pk_bf16(v0[0], v0[1]); w.y = pg8::cvt_pk_bf16(v0[2], v0[3]); w.z = pg8::cvt_pk_bf16(v1[0], v1[1]); w.w = pg8::cvt_pk_bf16(v1[2], v1[3]);
                    *(u32x4*)(rowp + bj * 128) = w; } }
    }
};
template <int MIDK_, bool F8OUT = false> struct EpiResid {
    static constexpr bool PERM = false; static constexpr int MIDK = MIDK_;
    const float* xin; float* xout; bf16_t* xb; float* ssq; const float* ssq_mid;
    __device__ __forceinline__ void midk(f32x4 (&acc)[2][2][4][2], const pg8::Unit& u, int wr, int fr) const {
#pragma unroll
        for (int ai = 0; ai < 2; ++ai)
#pragma unroll
            for (int m = 0; m < 4; ++m) { const int r = u.pm * 256 + ai * 128 + wr * 64 + m * 16 + fr; const float s = 1.0f / sqrtf(ssq_mid[r] * (1.0f / SBW) + EPS);
#pragma unroll
                for (int bj = 0; bj < 2; ++bj)
#pragma unroll
                    for (int n = 0; n < 2; ++n) acc[ai][bj][m][n] *= s; }
    }
    __device__ __forceinline__ void operator()(f32x4 (&acc)[2][2][4][2], const pg8::Unit& u, int wr, int wc, int fr, int fq, int, int, LAS unsigned char*) const {
        int row0 = u.pm * 256 + wr * 64 + fr, col0 = u.pn * 256 + wc * 32 + 4 * fq; asm volatile("" : "+v"(row0), "+v"(col0));
#pragma unroll
        for (int ai = 0; ai < 2; ++ai)
#pragma unroll
            for (int m = 0; m < 4; ++m) { const int r = row0 + ai * 128 + m * 16; const size_t off = (size_t)r * D + col0; float q = 0.f;
#pragma unroll
                for (int bj = 0; bj < 2; ++bj)
#pragma unroll
                    for (int n = 0; n < 2; ++n) { const size_t o2 = off + bj * 128 + n * 16; const f32x4 o = *(const f32x4*)(xin + o2) + acc[ai][bj][m][n];
                        *(f32x4*)(xout + o2) = o; q += (o[0] * o[0] + o[1] * o[1]) + (o[2] * o[2] + o[3] * o[3]);
                        if constexpr (F8OUT) { int w8 = __builtin_amdgcn_cvt_pk_fp8_f32(o[0], o[1], 0, false); w8 = __builtin_amdgcn_cvt_pk_fp8_f32(o[2], o[3], w8, true); *(int*)((unsigned char*)xb + o2) = w8; }
                        else *(unsigned long long*)(xb + o2) = (unsigned long long)pg8::cvt_pk_bf16(o[0], o[1]) | ((unsigned long long)pg8::cvt_pk_bf16(o[2], o[3]) << 32); }
                q += __shfl_xor(q, 16); q += __shfl_xor(q, 32);
                if (fq == 0) unsafeAtomicAdd(ssq + r, q);
                if (m & 1) asm volatile("" ::: "memory"); }
    }
};
struct SchedMS {
    int G, c; unsigned char* ws;
    __device__ __forceinline__ bool next(int i, pg8::Unit& u) const {
        const int L = i * G + c; constexpr int NU = (NTOK / 256) * MH; if (L >= NU) return false; const int w = pg8::xcd_remap(L, NU), pm = w >> 2, h = w & 3, b = pm >> 4;
        u.A = (const char*)(ws + WS_QM) + ((size_t)pm * 256 * D + h * MHD) * 2; u.B = (const char*)(ws + WS_KM) + ((size_t)b * NMEM * D + h * MHD) * 2;
        u.p0 = (bf16_t*)(ws + WS_PM) + (size_t)pm * 256 * D + h * NMEM; u.p1 = nullptr; u.p2 = nullptr; u.p3 = nullptr; u.i0 = D; u.i1 = 0; u.pm = pm; u.pn = h; return true;
    }
};
struct EpiSoftmax {
    static constexpr bool PERM = true; static constexpr int MIDK = -1;
    __device__ __forceinline__ void midk(f32x4 (&)[2][2][4][2], const pg8::Unit&, int, int) const {}
    __device__ __forceinline__ void operator()(f32x4 (&acc)[2][2][4][2], const pg8::Unit& u, int wr, int wc, int fr, int fq, int, int, LAS unsigned char* xl) const {
        typedef float f32x2v __attribute__((ext_vector_type(2)));
        LAS f32x2v* X = (LAS f32x2v*)xl;
        float ml[2][4];
#pragma unroll
        for (int ai = 0; ai < 2; ++ai)
#pragma unroll
            for (int m = 0; m < 4; ++m) { float mx = -INFINITY;
#pragma unroll
                for (int bj = 0; bj < 2; ++bj)
#pragma unroll
                    for (int n = 0; n < 2; ++n) { const f32x4 v = acc[ai][bj][m][n]; mx = fmaxf(fmaxf(mx, fmaxf(v[0], v[1])), fmaxf(v[2], v[3])); }
                mx = fmaxf(mx, __shfl_xor(mx, 16)); mx = fmaxf(mx, __shfl_xor(mx, 32)); ml[ai][m] = mx; float s = 0.f;
#pragma unroll
                for (int bj = 0; bj < 2; ++bj)
#pragma unroll
                    for (int n = 0; n < 2; ++n) { f32x4 v = acc[ai][bj][m][n];
#pragma unroll
                        for (int j = 0; j < 4; ++j) { v[j] = __builtin_amdgcn_exp2f(v[j] - mx); s += v[j]; }
                        acc[ai][bj][m][n] = v; }
                s += __shfl_xor(s, 16); s += __shfl_xor(s, 32);
                if (fq == 0) X[(ai * 128 + wr * 64 + m * 16 + fr) * 4 + wc] = (f32x2v){mx, s}; }
        EPI_BAR();
        bf16_t* O = (bf16_t*)u.p0; const int ldc = u.i0; int r0 = wr * 64 + fr, c0 = wc * 32 + 8 * fq; asm volatile("" : "+v"(r0), "+v"(c0));
#pragma unroll
        for (int ai = 0; ai < 2; ++ai)
#pragma unroll
            for (int m = 0; m < 4; ++m) { const int r = r0 + ai * 128 + m * 16; const f32x2v a = X[r * 4 + 0], b = X[r * 4 + 1], c = X[r * 4 + 2], d = X[r * 4 + 3];
                const float M = fmaxf(fmaxf(a.x, b.x), fmaxf(c.x, d.x));
                const float tot = a.y * __builtin_amdgcn_exp2f(a.x - M) + b.y * __builtin_amdgcn_exp2f(b.x - M) + c.y * __builtin_amdgcn_exp2f(c.x - M) + d.y * __builtin_amdgcn_exp2f(d.x - M);
                const float f = __builtin_amdgcn_exp2f(ml[ai][m] - M) / tot; bf16_t* rowp = O + (size_t)r * ldc + c0;
#pragma unroll
                for (int bj = 0; bj < 2; ++bj) { const f32x4 v0 = acc[ai][bj][m][0] * f, v1 = acc[ai][bj][m][1] * f;
                    u32x4 w; w.x = pg8::cvt_pk_bf16(v0[0], v0[1]); w.y = pg8::cvt_pk_bf16(v0[2], v0[3]); w.z = pg8::cvt_pk_bf16(v1[0], v1[1]); w.w = pg8::cvt_pk_bf16(v1[2], v1[3]);
                    *(u32x4*)(rowp + bj * 128) = w; } }
    }
};
struct SchedPV {
    int G, c; unsigned char* ws;
    __device__ __forceinline__ bool next(int i, pg8::Unit& u) const {
        const int L = i * G + c; constexpr int NU = (NTOK / 256) * MH; if (L >= NU) return false; const int w = pg8::xcd_remap(L, NU), pm = w >> 2, h = w & 3, b = pm >> 4;
        u.A = (const char*)(ws + WS_PM) + ((size_t)pm * 256 * D + h * NMEM) * 2; u.B = (const char*)(ws + WS_VMT) + ((size_t)b * D + h * MHD) * NMEM * 2;
        u.p0 = (bf16_t*)(ws + WS_OM) + (size_t)pm * 256 * D + h * MHD; u.p1 = nullptr; u.p2 = nullptr; u.p3 = nullptr; u.i0 = D; u.i1 = 0; u.pm = pm; u.pn = h; return true;
    }
};

__device__ __forceinline__ void p8_route(const Args& a, LAS unsigned char* lds, int bx, int G, int wave, int lane, int* CNT) {
    unsigned char* ws = a.ws; const float* x2 = a.out; const float* SSQ2 = (const float*)(ws + OFF_SSQ2); const float* br = a.in[16];
    const bf16_t* WRH = (const bf16_t*)(ws + WS_WRH); const bf16_t* WRL = (const bf16_t*)(ws + WS_WRL);
    int* LSLOT = (int*)(ws + WS_LSLOT); float* LGATE = (float*)(ws + WS_LGATE);
    LAS float* LG = (LAS float*)(lds + RING_OFF) + wave * 16 * 33;
    LAS int* hist = (LAS int*)(lds + RING_OFF + 32768); LAS int* base = hist + 32;
    const int tid = wave * 64 + lane;
    for (int t0 = bx * 128; t0 < NTOK; t0 += G * 128) {
        if (tid < 32) hist[tid] = 0;
        const int r16 = lane & 15, kq = lane >> 4; const int trow = t0 + wave * 16 + r16;
        const float* xp = x2 + (size_t)trow * D + kq * 8;
        f32x4 acc[2] = {(f32x4){0.f, 0.f, 0.f, 0.f}, (f32x4){0.f, 0.f, 0.f, 0.f}};
#pragma unroll 4
        for (int ks = 0; ks < 32; ++ks) {
            const f32x4 xa = *(const f32x4*)(xp + ks * 32), xc = *(const f32x4*)(xp + ks * 32 + 4);
            bf16x8 ah, al;
#pragma unroll
            for (int j = 0; j < 8; ++j) { const float v = (j < 4) ? xa[j] : xc[j - 4]; const unsigned h = f2bf(v); ah[j] = (short)h; al[j] = (short)f2bf(v - bf2f((bf16_t)h)); }
#pragma unroll
            for (int nb = 0; nb < 2; ++nb) { const size_t wo = (size_t)(nb * 16 + r16) * D + ks * 32 + kq * 8;
                const bf16x8 bh = *(const bf16x8*)(WRH + wo), bl = *(const bf16x8*)(WRL + wo);
                acc[nb] = __builtin_amdgcn_mfma_f32_16x16x32_bf16(ah, bh, acc[nb], 0, 0, 0);
                acc[nb] = __builtin_amdgcn_mfma_f32_16x16x32_bf16(al, bh, acc[nb], 0, 0, 0);
                acc[nb] = __builtin_amdgcn_mfma_f32_16x16x32_bf16(ah, bl, acc[nb], 0, 0, 0); }
        }
#pragma unroll
        for (int nb = 0; nb < 2; ++nb)
#pragma unroll
            for (int r = 0; r < 4; ++r) { const int tl = kq * 4 + r; const int tk = t0 + wave * 16 + tl; const float rs = 1.0f / sqrtf(SSQ2[tk] * (1.0f / D) + EPS);
                LG[tl * 33 + nb * 16 + r16] = acc[nb][r] * rs + br[nb * 16 + r16]; }
        LDS_WAIT(); __syncthreads();
        int te[4] = {0, 0, 0, 0}; float tg[4] = {0.f, 0.f, 0.f, 0.f}; int rk[4] = {0, 0, 0, 0};
        if (lane < 16) {
            float tv[4] = {-INFINITY, -INFINITY, -INFINITY, -INFINITY};
            for (int e = 0; e < NE; ++e) { const float v = LG[lane * 33 + e];
                if (v > tv[3]) { if (v > tv[2]) { tv[3] = tv[2]; te[3] = te[2]; if (v > tv[1]) { tv[2] = tv[1]; te[2] = te[1]; if (v > tv[0]) { tv[1] = tv[0]; te[1] = te[0]; tv[0] = v; te[0] = e; } else { tv[1] = v; te[1] = e; } } else { tv[2] = v; te[2] = e; } } else { tv[3] = v; te[3] = e; } } }
            float gs = 0.f;
#pragma unroll
            for (int k = 0; k < 4; ++k) { tg[k] = __expf(tv[k] - tv[0]); gs += tg[k]; }
            gs = 1.0f / gs;
#pragma unroll
            for (int k = 0; k < 4; ++k) { tg[k] *= gs; rk[k] = __hip_atomic_fetch_add(hist + te[k], 1, __ATOMIC_RELAXED, __HIP_MEMORY_SCOPE_WORKGROUP); }
        }
        LDS_WAIT(); __syncthreads();
        if (tid < 32) { const int n = hist[tid]; base[tid] = n ? atomicAdd(CNT + tid, n) : 0; }
        LDS_WAIT(); __syncthreads();
        if (lane < 16) { const int tk = t0 + wave * 16 + lane;
#pragma unroll
            for (int k = 0; k < 4; ++k) { const size_t p = (size_t)te[k] * LCAP + base[te[k]] + rk[k]; LSLOT[p] = tk * 4 + k; LGATE[p] = tg[k]; } }
        LDS_WAIT(); __syncthreads();
    }
}

__device__ __forceinline__ void moe_table(const Args& a, volatile LAS unsigned* MISC, int tid) {
    const int* CNT = (const int*)(a.ws + OFF_CNT);
    if (tid < 32) MISC[16 + tid] = (unsigned)CNT[tid];
    LDS_WAIT(); __syncthreads();
    if (tid == 0) { unsigned tb = 0; for (int e = 0; e < NE; ++e) { MISC[48 + e] = tb; tb += (MISC[16 + e] + 255u) >> 8; } MISC[48 + NE] = tb; }
    LDS_WAIT(); __syncthreads();
}
template <int NPN, bool W1> struct SchedMoE {
    int G, c; unsigned char* ws; volatile LAS unsigned* MISC;
    __device__ __forceinline__ bool next(int i, pg8::Unit& u) const {
        const int T = __builtin_amdgcn_readfirstlane((int)MISC[48 + NE]); const int NU = T * NPN; const int L = i * G + c; if (L >= NU) return false;
        const int w = pg8::xcd_remap(L, NU);
        int e = 0;
#pragma unroll
        for (int s = 16; s >= 1; s >>= 1) { if ((int)MISC[48 + e + s] * NPN <= w) e += s; }
        e = __builtin_amdgcn_readfirstlane(e);
        const int tb = __builtin_amdgcn_readfirstlane((int)MISC[48 + e]), cnt = __builtin_amdgcn_readfirstlane((int)MISC[16 + e]), nte = (cnt + 255) >> 8; const int idx = w - tb * NPN, pn = __builtin_amdgcn_readfirstlane(idx / nte), mt = idx - pn * nte;
        u.pm = tb + mt; u.pn = pn; u.i1 = e; const int nv = cnt - mt * 256; u.i0 = nv < 256 ? nv : 256;
        u.p3 = (int*)(ws + WS_LSLOT) + (size_t)e * LCAP + mt * 256; u.p2 = (float*)(ws + WS_LGATE) + (size_t)e * LCAP + mt * 256; u.p0 = nullptr; u.p1 = nullptr;
        if (W1) { u.A = (const char*)(ws + WS_S0); u.B = (const char*)(ws + WS_W1) + ((size_t)e * 2 * DFF + pn * 256) * D; }
        else { u.A = (const char*)(ws + WS_ACT) + (size_t)(tb + mt) * 256 * DFF; u.B = (const char*)(ws + WS_W2) + ((size_t)e * D + pn * 256) * DFF; }
        return true;
    }
};
struct EpiSwiGLU {
    static constexpr bool PERM = true; static constexpr int MIDK = -1; const float* ssq2; const float* b1; unsigned char* act;
    __device__ __forceinline__ void midk(f32x4 (&)[2][2][4][2], const pg8::Unit&, int, int) const {}
    __device__ __forceinline__ void operator()(f32x4 (&acc)[2][2][4][2], const pg8::Unit& u, int wr, int wc, int fr, int fq, int, int, LAS unsigned char*) const {
        const int e = u.i1, nvalid = u.i0; const int* slots = (const int*)u.p3; int r0 = wr * 64 + fr, c0 = wc * 32 + 8 * fq; asm volatile("" : "+v"(r0), "+v"(c0));     const int gc0 = u.pn * 128 + c0;
        f32x4 bg[2], bu[2];
#pragma unroll
        for (int n = 0; n < 2; ++n) { bg[n] = *(const f32x4*)(b1 + (size_t)e * 2 * DFF + gc0 + 4 * n); bu[n] = *(const f32x4*)(b1 + (size_t)e * 2 * DFF + DFF + gc0 + 4 * n); }
#pragma unroll
        for (int ai = 0; ai < 2; ++ai)
#pragma unroll
            for (int m = 0; m < 4; ++m) { const int r = r0 + ai * 128 + m * 16; const bool valid = r < nvalid; const int tok = valid ? (slots[r] >> 2) : 0;
                const float rs = (1.0f / WSCALE) / sqrtf(ssq2[tok] * (1.0f / D) + EPS); int wv[2];
#pragma unroll
                for (int n = 0; n < 2; ++n) { float o[4];
#pragma unroll
                    for (int j = 0; j < 4; ++j) { float g = acc[ai][0][m][n][j] * rs + bg[n][j], up = acc[ai][1][m][n][j] * rs + bu[n][j];
                        g = fminf(g, SW_LIMIT); up = fminf(fmaxf(up, -SW_LIMIT), SW_LIMIT);
                        o[j] = (up + 1.0f) * g * __builtin_amdgcn_rcpf(1.0f + __builtin_amdgcn_exp2f(-SW_ALPHA * LOG2E * g)); }
                    wv[n] = __builtin_amdgcn_cvt_pk_fp8_f32(o[0], o[1], 0, false); wv[n] = __builtin_amdgcn_cvt_pk_fp8_f32(o[2], o[3], wv[n], true); }
                if (valid) *(unsigned long long*)(act + ((size_t)u.pm * 256 + r) * DFF + gc0) = (unsigned long long)(unsigned)wv[0] | ((unsigned long long)(unsigned)wv[1] << 32); }
    }
};
struct EpiW2 {
    static constexpr bool PERM = true; static constexpr int MIDK = -1; const float* b2; bf16_t* Y;
    __device__ __forceinline__ void midk(f32x4 (&)[2][2][4][2], const pg8::Unit&, int, int) const {}
    __device__ __forceinline__ void operator()(f32x4 (&acc)[2][2][4][2], const pg8::Unit& u, int wr, int wc, int fr, int fq, int, int, LAS unsigned char*) const {
        const int e = u.i1, nvalid = u.i0; const int* slots = (const int*)u.p3; const float* gates = (const float*)u.p2; int r0 = wr * 64 + fr, c0 = u.pn * 256 + wc * 32 + 8 * fq; asm volatile("" : "+v"(r0), "+v"(c0));
        f32x4 bv[2][2];
#pragma unroll
        for (int bj = 0; bj < 2; ++bj)
#pragma unroll
            for (int n = 0; n < 2; ++n) bv[bj][n] = *(const f32x4*)(b2 + (size_t)e * D + c0 + bj * 128 + 4 * n);
#pragma unroll
        for (int ai = 0; ai < 2; ++ai)
#pragma unroll
            for (int m = 0; m < 4; ++m) { const int r = r0 + ai * 128 + m * 16; const bool valid = r < nvalid; const int slot = valid ? slots[r] : 0; const float g = valid ? gates[r] : 0.f;
#pragma unroll
                for (int bj = 0; bj < 2; ++bj) { const f32x4 v0 = (acc[ai][bj][m][0] * (1.0f / WSCALE) + bv[bj][0]) * g, v1 = (acc[ai][bj][m][1] * (1.0f / WSCALE) + bv[bj][1]) * g;
                    u32x4 w; w.x = pg8::cvt_pk_bf16(v0[0], v0[1]); w.y = pg8::cvt_pk_bf16(v0[2], v0[3]); w.z = pg8::cvt_pk_bf16(v1[0], v1[1]); w.w = pg8::cvt_pk_bf16(v1[2], v1[3]);
                    if (valid) *(u32x4*)(Y + (size_t)slot * D + c0 + bj * 128) = w; } }
    }
};

__device__ __forceinline__ void p11_final(const Args& a, int vcu, int G, int wave, int lane, float* dst) {
    const float* out = a.out; const bf16_t* Y = (const bf16_t*)(a.ws + WS_Y); const float* gf = a.in[21];
    const int gw = vcu * NWAVES + wave, NGW = G * NWAVES;
    f32x4 g4[4];
#pragma unroll
    for (int j = 0; j < 4; ++j) g4[j] = *(const f32x4*)(gf + 4 * lane + 256 * j);
    for (int tok = gw; tok < NTOK; tok += NGW) {
        f32x4 v[4]; float s = 0.f;
#pragma unroll
        for (int j = 0; j < 4; ++j) { v[j] = *(const f32x4*)(out + (size_t)tok * D + 4 * lane + 256 * j);
#pragma unroll
            for (int k = 0; k < 4; ++k) { const unsigned long long w = *(const unsigned long long*)(Y + ((size_t)tok * 4 + k) * D + 4 * lane + 256 * j);
                v[j][0] += __builtin_bit_cast(float, (unsigned)(w << 16)); v[j][1] += __builtin_bit_cast(float, (unsigned)w & 0xffff0000u);
                v[j][2] += __builtin_bit_cast(float, (unsigned)(w >> 32) << 16); v[j][3] += __builtin_bit_cast(float, (unsigned)(w >> 32) & 0xffff0000u); }
            s += (v[j][0] * v[j][0] + v[j][1] * v[j][1]) + (v[j][2] * v[j][2] + v[j][3] * v[j][3]); }
        const float rs = 1.0f / sqrtf(wave_sum(s) * (1.0f / D) + EPS);
#pragma unroll
        for (int j = 0; j < 4; ++j) *(f32x4*)(dst + (size_t)tok * D + 4 * lane + 256 * j) = v[j] * rs * g4[j];
    }
}
typedef float f32x16 __attribute__((ext_vector_type(16)));
typedef short s16x4 __attribute__((ext_vector_type(4)));
__device__ __forceinline__ int crow(int r, int hi) { return (r & 3) + 8 * (r >> 2) + 4 * hi; }
constexpr int SB_FLAG_OFF = 32768, SB_STG_OFF = 36864;
__device__ __forceinline__ void sb_unit(int b, int h, int qb, const bf16_t* QKVU, bf16_t* MIXED, float* SSQSB, LAS unsigned char* shm, int wid, int lane) {
    const int r32 = lane & 31, hi = lane >> 5;
    const size_t rowbase = (size_t)b * S; const int q0 = qb * 256;
    const bf16_t* Qw = QKVU + (rowbase + q0 + wid * 32) * INP + h * HD;
    const bf16_t* Kh = QKVU + rowbase * INP + SBW + h * HD; const bf16_t* Vh = Kh + SBW;
    bf16x8 qr[4];
#pragma unroll
    for (int d0 = 0; d0 < 4; ++d0) qr[d0] = *(const bf16x8*)(Qw + (size_t)r32 * INP + d0 * 16 + hi * 8);
    f32x16 o[2];
#pragma unroll
    for (int r = 0; r < 16; ++r) { o[0][r] = 0.f; o[1][r] = 0.f; }
    float carry = 1.0f; bool alive = true;
    const int jtop = 4 * qb + 3, jmax_w = 4 * qb + (wid >> 1);
    const int qabs = q0 + wid * 32 + r32;
    const bf16_t* ksrc = Kh + (size_t)lane * INP + wid * 8;
    const bf16_t* vsrc = Vh + (size_t)(16 * (wid & 3) + (lane >> 2)) * INP + (wid >> 2) * 32 + (lane & 3) * 8;
    const int stoff = wid * 1024 + lane * 16;
    LAS unsigned* flags = (LAS unsigned*)(shm + SB_FLAG_OFF);
    u32x4 kreg = *(const u32x4*)(ksrc + (size_t)jtop * 64 * INP), vreg = *(const u32x4*)(vsrc + (size_t)jtop * 64 * INP);
    int p = 0;
    for (int j = jtop; j >= 0; --j) {
        LAS unsigned char* Kb = shm + p * 16384; LAS unsigned char* Vb = Kb + 8192;
        *(LAS u32x4*)(Kb + stoff) = kreg; *(LAS u32x4*)(Vb + stoff) = vreg;
        LDS_WAIT(); __syncthreads();
        if (j < jtop) { const LAS unsigned* fl = flags + (p ^ 1) * 8; const unsigned any = (fl[0] | fl[1]) | (fl[2] | fl[3]) | (fl[4] | fl[5]) | (fl[6] | fl[7]);
            if (__builtin_amdgcn_readfirstlane(any) == 0u) break; }
        if (j > 0) { kreg = *(const u32x4*)(ksrc + (size_t)(j - 1) * 64 * INP); vreg = *(const u32x4*)(vsrc + (size_t)(j - 1) * 64 * INP); }
        if (j <= jmax_w && alive) {
            f32x16 p0, p1;
#pragma unroll
            for (int r = 0; r < 16; ++r) { p0[r] = 0.f; p1[r] = 0.f; }
            const LAS unsigned char* kb = Kb + hi * 1024 + r32 * 16;
#pragma unroll
            for (int d0 = 0; d0 < 4; ++d0) { const bf16x8 b0 = *(const LAS bf16x8*)(kb + d0 * 2048), b1 = *(const LAS bf16x8*)(kb + d0 * 2048 + 512);
                p0 = __builtin_amdgcn_mfma_f32_32x32x16_bf16(b0, qr[d0], p0, 0, 0, 0); p1 = __builtin_amdgcn_mfma_f32_32x32x16_bf16(b1, qr[d0], p1, 0, 0, 0); }
            const bool diag = (j == jmax_w); const int kbase = 64 * j + 4 * hi;
#pragma unroll
            for (int r = 0; r < 16; ++r) { const int k0 = kbase + (r & 3) + 8 * (r >> 2);
                float e0 = __builtin_amdgcn_exp2f(p0[r]), e1 = __builtin_amdgcn_exp2f(p1[r]);
                float r0 = __builtin_amdgcn_rcpf(1.0f + e0), r1 = __builtin_amdgcn_rcpf(1.0f + e1);
                if (diag) { if (k0 >= qabs) r0 = 1.0f; if (k0 + 32 >= qabs) r1 = 1.0f; }
                p0[r] = r0; p1[r] = r1; }
            float sfx[8][3], A[8];
#pragma unroll
            for (int i = 0; i < 8; ++i) { const float x0 = (i < 4) ? p0[4 * i] : p1[4 * i - 16], x1 = (i < 4) ? p0[4 * i + 1] : p1[4 * i - 15], x2 = (i < 4) ? p0[4 * i + 2] : p1[4 * i - 14], x3 = (i < 4) ? p0[4 * i + 3] : p1[4 * i - 13];
                sfx[i][2] = x3; sfx[i][1] = x3 * x2; sfx[i][0] = sfx[i][1] * x1; A[i] = sfx[i][0] * x0; }
            float T = carry, E[8];
#pragma unroll
            for (int i = 7; i >= 0; --i) { const auto sw = __builtin_amdgcn_permlane32_swap(__float_as_uint(A[i]), __float_as_uint(A[i]), false, false);
                const float own_or_a = __uint_as_float(sw[0]), own_or_b = __uint_as_float(sw[1]);
                const float partner = hi ? own_or_a : own_or_b;
                E[i] = hi ? T : T * partner; T = T * (A[i] * partner); }
            carry = T;
            unsigned pw[4][4];
#pragma unroll
            for (int i = 0; i < 8; ++i) { float w4[4];
#pragma unroll
                for (int jj = 0; jj < 4; ++jj) { const float rv = (i < 4) ? p0[4 * i + jj] : p1[4 * i - 16 + jj]; const float beta = 1.0f - rv;
                    w4[jj] = beta * ((jj == 3) ? E[i] : E[i] * sfx[i][jj]); }
                pw[i >> 1][(i & 1) * 2] = pg8::cvt_pk_bf16(w4[0], w4[1]); pw[i >> 1][(i & 1) * 2 + 1] = pg8::cvt_pk_bf16(w4[2], w4[3]); }
            const LAS unsigned char* vb = Vb + ((lane >> 4) & 1) * 32 + (lane & 3) * 8 + (4 * hi + ((lane & 15) >> 2)) * 64;
#pragma unroll
            for (int d0 = 0; d0 < 2; ++d0)
#pragma unroll
                for (int ks = 0; ks < 4; ++ks) {
                    const s16x4 lo = __builtin_bit_cast(s16x4, __builtin_amdgcn_ds_read_tr16_b64_v4i16((LAS s16x4*)(vb + d0 * 4096 + ks * 1024)));
                    const s16x4 hh = __builtin_bit_cast(s16x4, __builtin_amdgcn_ds_read_tr16_b64_v4i16((LAS s16x4*)(vb + d0 * 4096 + ks * 1024 + 512)));
                    const bf16x8 vf = (bf16x8){lo[0], lo[1], lo[2], lo[3], hh[0], hh[1], hh[2], hh[3]};
                    const bf16x8 pa = __builtin_bit_cast(bf16x8, (u32x4){pw[ks][0], pw[ks][1], pw[ks][2], pw[ks][3]});
                    o[d0] = __builtin_amdgcn_mfma_f32_32x32x16_bf16(pa, vf, o[d0], 0, 0, 0); }
            alive = __any(carry != 0.0f);
        }
        if (lane == 0) flags[p * 8 + wid] = (j > jmax_w || alive) ? 1u : 0u;
        p ^= 1;
    }
    LAS bf16_t* stg = (LAS bf16_t*)(shm + SB_STG_OFF + wid * 4096);
#pragma unroll
    for (int r = 0; r < 16; ++r) { const int orow = crow(r, hi);
#pragma unroll
        for (int d0 = 0; d0 < 2; ++d0) stg[orow * 64 + d0 * 32 + r32] = (bf16_t)f2bf(o[d0][r]); }
    LDS_WAIT();
    bf16_t* Ow = MIXED + (rowbase + q0 + wid * 32) * D + h * HD;
#pragma unroll
    for (int i = 0; i < 4; ++i) { const int row = i * 8 + (lane >> 3), ch = lane & 7; const u32x4 v = *(const LAS u32x4*)(stg + row * 64 + ch * 8);
        *(u32x4*)(Ow + (size_t)row * D + ch * 8) = v; float q = 0.f;
#pragma unroll
        for (int k = 0; k < 4; ++k) { const float a = __builtin_bit_cast(float, v[k] << 16), c = __builtin_bit_cast(float, v[k] & 0xffff0000u); q += a * a + c * c; }
        q += __shfl_xor(q, 1); q += __shfl_xor(q, 2); q += __shfl_xor(q, 4);
        if (ch == 0) unsafeAtomicAdd(SSQSB + rowbase + q0 + wid * 32 + row, q); }
    LDS_WAIT(); __syncthreads();
}

constexpr int PL_PITCH = 1040, PL_PART_OFF = 83968, PL_RSTD_OFF = 86016;
__device__ __forceinline__ void pool_unit(int tile, const bf16_t* QKVU, const bf16_t* WPT, bf16_t* MIXED, LAS unsigned char* shm, int wid, int lane) {
    const int tok0 = tile * 64, tpos0 = tok0 & (S - 1); const int tid = wid * 64 + lane;
    for (int c = tid; c < 79 * 64; c += NWAVES * 64) { const int row = c >> 6, ch = c & 63; const int t = tpos0 - 15 + row;
        u32x4 v = (u32x4){0u, 0u, 0u, 0u}; if (t >= 0) v = *(const u32x4*)(QKVU + (size_t)(tok0 - 15 + row) * INP + 3 * SBW + ch * 8);
        *(LAS u32x4*)(shm + row * PL_PITCH + ch * 16) = v; }
    LDS_WAIT(); __syncthreads();
    const int g = wid >> 1, eh = wid & 1, r16 = lane & 15, kq = lane >> 4; const int win = 2 << g;
    bf16x8 Bf[4][4];
#pragma unroll
    for (int nb = 0; nb < 4; ++nb)
#pragma unroll
        for (int ks = 0; ks < 4; ++ks) Bf[nb][ks] = *(const bf16x8*)(WPT + ((size_t)(g * PGD + eh * 64 + nb * 16 + r16)) * PGD + ks * 32 + kq * 8);
    f32x4 acc[4][4];
#pragma unroll
    for (int mb = 0; mb < 4; ++mb) {
        const int lrow = 15 + mb * 16 + r16; const int n = (tpos0 + mb * 16 + r16 + 1 < win) ? tpos0 + mb * 16 + r16 + 1 : win; const float inv = 1.0f / (float)n;
        bf16x8 Af[4];
#pragma unroll
        for (int ks = 0; ks < 4; ++ks) { float s[8];
#pragma unroll
            for (int q = 0; q < 8; ++q) s[q] = 0.f;
            const LAS unsigned char* up = shm + lrow * PL_PITCH + (g * PGD + ks * 32 + kq * 8) * 2;
            for (int jw = 0; jw < win; ++jw) { const u32x4 v = *(const LAS u32x4*)(up - jw * PL_PITCH);
#pragma unroll
                for (int k = 0; k < 4; ++k) { s[2 * k] += __builtin_bit_cast(float, v[k] << 16); s[2 * k + 1] += __builtin_bit_cast(float, v[k] & 0xffff0000u); } }
            const u32x4 self = *(const LAS u32x4*)up; u32x4 pk;
#pragma unroll
            for (int k = 0; k < 4; ++k) pk[k] = pg8::cvt_pk_bf16(s[2 * k] * inv - __builtin_bit_cast(float, self[k] << 16), s[2 * k + 1] * inv - __builtin_bit_cast(float, self[k] & 0xffff0000u));
            Af[ks] = __builtin_bit_cast(bf16x8, pk); }
#pragma unroll
        for (int nb = 0; nb < 4; ++nb) { f32x4 a = (f32x4){0.f, 0.f, 0.f, 0.f};
#pragma unroll
            for (int ks = 0; ks < 4; ++ks) a = __builtin_amdgcn_mfma_f32_16x16x32_bf16(Af[ks], Bf[nb][ks], a, 0, 0, 0);
            acc[mb][nb] = a; }
    }
    LAS float* part = (LAS float*)(shm + PL_PART_OFF); LAS float* rstd = (LAS float*)(shm + PL_RSTD_OFF);
#pragma unroll
    for (int mb = 0; mb < 4; ++mb)
#pragma unroll
        for (int r = 0; r < 4; ++r) { float q = 0.f;
#pragma unroll
            for (int nb = 0; nb < 4; ++nb) q += acc[mb][nb][r] * acc[mb][nb][r];
            q += __shfl_xor(q, 1); q += __shfl_xor(q, 2); q += __shfl_xor(q, 4); q += __shfl_xor(q, 8);
            if (r16 == 0) part[wid * 64 + mb * 16 + kq * 4 + r] = q; }
    LDS_WAIT(); __syncthreads();
    if (tid < 64) { float q = 0.f;
#pragma unroll
        for (int w = 0; w < 8; ++w) q += part[w * 64 + tid];
        rstd[tid] = 1.0f / sqrtf(q * (1.0f / PW) + EPS); }
    LDS_WAIT(); __syncthreads();
#pragma unroll
    for (int mb = 0; mb < 4; ++mb)
#pragma unroll
        for (int r = 0; r < 4; ++r) { const int row = mb * 16 + kq * 4 + r; const float rs = rstd[row]; bf16_t* op = MIXED + (size_t)(tok0 + row) * D + SBW + g * PGD + eh * 64 + r16;
#pragma unroll
            for (int nb = 0; nb < 4; ++nb) op[nb * 16] = (bf16_t)f2bf(acc[mb][nb][r] * rs); }
    LDS_WAIT(); __syncthreads();
}
__device__ __forceinline__ void p2_mix(const Args& a, LAS unsigned char* lds, int bx, int G, int wid, int lane, float* SSQSB) {
    unsigned char* ws = a.ws; const bf16_t* QKVU = (const bf16_t*)(ws + WS_QKVU); bf16_t* MIXED = (bf16_t*)(ws + WS_MIXED);
    constexpr int NA = B * NH * (S / 256);
    for (int i = 0; i * G + bx < NA; ++i) { const int w = pg8::xcd_remap(i * G + bx, NA); const int bh = w >> 4, qb = w & 15; sb_unit(bh >> 3, bh & 7, qb, QKVU, MIXED, SSQSB, lds + RING_OFF, wid, lane); }
    for (int t = bx; t < NTOK / 64; t += G) pool_unit(t, QKVU, (const bf16_t*)(ws + WS_WP), MIXED, lds + RING_OFF, wid, lane);
}
constexpr size_t BAR_REGION_OFF = 1 * MiB, BAR_REGION_STRIDE = 16 * 1024;
__global__ void __launch_bounds__(NWAVES * 64, 2) mega(Args args) {
    const int li = args.li;
    extern __shared__ __attribute__((aligned(16))) unsigned char lds_raw[];
    LAS unsigned char* lds = (LAS unsigned char*)lds_raw;
    volatile LAS unsigned* MISC = (volatile LAS unsigned*)(lds + MISC_OFF);
    const int wave = __builtin_amdgcn_readfirstlane((int)threadIdx.x >> 6);
#define LANE_ID() ({ int l_; asm volatile("v_mbcnt_lo_u32_b32 %0, -1, 0\n\tv_mbcnt_hi_u32_b32 %0, -1, %0" : "=v"(l_)); l_; })
    const int G = gridDim.x; const int bx = blockIdx.x; const int vcu = (G % 8 == 0) ? (bx % 8) * (G / 8) + bx / 8 : bx;
    for (int u = wave * 64 + LANE_ID(); u < MISC_BYTES / 4; u += NWAVES * 64) MISC[u] = 0u;
    __syncthreads();
    unsigned char* ws = args.ws;
    XcdBarrier bar = xcd_barrier_post((unsigned*)(ws + BAR_REGION_OFF + (size_t)li * BAR_REGION_STRIDE), MISC + 8);
    const int lo = args.ph_lo, hi = args.ph_hi;
    LAS unsigned char* ring = lds + RING_OFF; LAS unsigned char* epi = lds + EPI_OFF; LAS unsigned* gtab = (LAS unsigned*)(lds + GTAB_OFF);
#ifndef TIME_PHASE
#define TIME_PHASE -1
#endif
#define REP_OF(k) ((TIME_PHASE == (k)) ? 2 : 1)
#define REPE_OF(k) ((TIME_PHASE == 20 + (k)) ? 2 : 1)
#define IN(k) (lo <= (k) && (k) < hi)
#define SEAM(k) do { if (IN(k) && IN((k) + 1)) xcd_barrier(bar); } while (0)
    if (IN(0)) { p0_prologue(args, lds, vcu, G, wave, LANE_ID()); if (TIME_PHASE == 0) { xcd_barrier(bar); p0_prologue(args, lds, vcu, G, wave, LANE_ID()); } SEAM(0); }
    if (IN(1)) { SchedP1 S{G, bx, ws}; pg8::EpiBf16S E; pg8::gemm_phase<pg8::EpiBf16S, SchedP1, false, REP_OF(1), REPE_OF(1)>(wave, ring, epi, gtab, D * 2, D * 2, D / 64, S, E); SEAM(1); }
    {
    const float* xin0 = args.in[0]; float* outp = args.out;
    bf16_t* S0p = (bf16_t*)(ws + WS_S0); float* SSQSBp = (float*)(ws + OFF_SSQSB); float* SSQ1p = (float*)(ws + OFF_SSQ1); float* SSQ2p = (float*)(ws + OFF_SSQ2);
    constexpr size_t TSTEP = (size_t)256 * D * 2;
    #if !defined(PH_ONLY) || PH_ONLY == 2
    if (IN(2)) { if (TIME_PHASE == 2) { p2_mix(args, lds, bx, G, wave, LANE_ID(), (float*)(ws + 1536 * 1024)); xcd_barrier(bar); } p2_mix(args, lds, bx, G, wave, LANE_ID(), (float*)(ws + OFF_SSQSB)); SEAM(2); }
#endif

#if !defined(PH_ONLY) || PH_ONLY == 3
    if (IN(3)) { SchedReg S{G, bx, NTOK / 256, D / 256, (const char*)(ws + WS_MIXED), (const char*)(ws + WS_WOUT), TSTEP, TSTEP, nullptr, D, nullptr, nullptr};
        EpiResid<8> E{xin0, outp, S0p, SSQ1p, SSQSBp}; pg8::gemm_phase<EpiResid<8>, SchedReg, false, REP_OF(3)>(wave, ring, epi, gtab, D * 2, D * 2, D / 64, S, E); SEAM(3); }
#endif
#if !defined(PH_ONLY) || PH_ONLY == 4
    if (IN(4)) { SchedReg S{G, bx, NTOK / 256, D / 256, (const char*)(ws + WS_S0), (const char*)(ws + WS_WQ), TSTEP, TSTEP, (bf16_t*)(ws + WS_QM), D, SSQ1p, nullptr};
        EpiBf16Ssq E{1.0f / D, C2_MEM}; pg8::gemm_phase<EpiBf16Ssq, SchedReg, false, REP_OF(4)>(wave, ring, epi, gtab, D * 2, D * 2, D / 64, S, E); SEAM(4); }
#endif
#if !defined(PH_ONLY) || PH_ONLY == 5
    if (IN(5)) { SchedMS S{G, bx, ws}; EpiSoftmax E; pg8::gemm_phase<EpiSoftmax, SchedMS, false, REP_OF(5)>(wave, ring, epi, gtab, D * 2, D * 2, MHD / 64, S, E); SEAM(5); }
#endif
#if !defined(PH_ONLY) || PH_ONLY == 6
    if (IN(6)) { SchedPV S{G, bx, ws}; pg8::EpiBf16S E; pg8::gemm_phase<pg8::EpiBf16S, SchedPV, false, REP_OF(6)>(wave, ring, epi, gtab, D * 2, NMEM * 2, NMEM / 64, S, E); SEAM(6); }
#endif
#if !defined(PH_ONLY) || PH_ONLY == 7
    if (IN(7)) { SchedReg S{G, bx, NTOK / 256, D / 256, (const char*)(ws + WS_OM), (const char*)(ws + WS_WO), TSTEP, TSTEP, nullptr, D, nullptr, nullptr};
        EpiResid<-1, true> E{outp, outp, S0p, SSQ2p, nullptr}; pg8::gemm_phase<EpiResid<-1, true>, SchedReg, false, REP_OF(7)>(wave, ring, epi, gtab, D * 2, D * 2, D / 64, S, E); SEAM(7); }
#endif
#if !defined(PH_ONLY) || PH_ONLY == 8
    if (IN(8)) { if (TIME_PHASE == 8) { p8_route(args, lds, bx, G, wave, LANE_ID(), (int*)(ws + 1536 * 1024)); xcd_barrier(bar); } p8_route(args, lds, bx, G, wave, LANE_ID(), (int*)(ws + OFF_CNT)); SEAM(8); }
#endif
#if !defined(PH_ONLY) || PH_ONLY == 9
    if (IN(9)) { moe_table(args, MISC, wave * 64 + LANE_ID()); SchedMoE<8, true> S{G, bx, ws, MISC}; EpiSwiGLU E{SSQ2p, args.in[18], ws + WS_ACT};
        pg8::gemm_phase<EpiSwiGLU, SchedMoE<8, true>, true, REP_OF(9), REPE_OF(9), true>(wave, ring, epi, gtab, D, D, D / 128, S, E); SEAM(9); }
#endif
#if !defined(PH_ONLY) || PH_ONLY == 10
    if (IN(10)) { moe_table(args, MISC, wave * 64 + LANE_ID()); SchedMoE<4, false> S{G, bx, ws, MISC}; EpiW2 E{args.in[20], (bf16_t*)(ws + WS_Y)};
        pg8::gemm_phase<EpiW2, SchedMoE<4, false>, false, REP_OF(10), REPE_OF(10), true>(wave, ring, epi, gtab, DFF, DFF, DFF / 128, S, E); SEAM(10); }
#endif
#if !defined(PH_ONLY) || PH_ONLY == 11
    if (IN(11)) { if (TIME_PHASE == 11) { p11_final(args, vcu, G, wave, LANE_ID(), (float*)(ws + WS_ACT)); xcd_barrier(bar); } p11_final(args, vcu, G, wave, LANE_ID(), args.out); }
#endif
}

    if (TIME_PHASE == 12) { for (int q = 0; q < 10; ++q) xcd_barrier(bar); }
#undef IN
#undef SEAM
}
}

#ifndef MEGA_MASK
#define MEGA_MASK 0xFFF
#endif
extern "C" void kernel_launch(void* const* d_in, const int* in_sizes, int n_in, void* d_out, int out_size, void* d_ws, size_t ws_size, hipStream_t stream) {
    if (n_in != 22 || out_size != NTOK * D || ws_size < WS_END) { fprintf(stderr, "kernel_launch: unexpected shapes (n_in %d out %d ws %zu)\n", n_in, out_size, ws_size); return; }
    static int grid = 0;
    if (grid == 0) {
        int dev = 0, cus = 0;
        if (hipGetDevice(&dev) != hipSuccess || hipDeviceGetAttribute(&cus, hipDeviceAttributeMultiprocessorCount, dev) != hipSuccess) { grid = -1; return; }
        if (hipFuncSetAttribute((const void*)mk::mega, hipFuncAttributeMaxDynamicSharedMemorySize, mk::LDS_BYTES) != hipSuccess) { fprintf(stderr, "kernel_launch: hipFuncSetAttribute failed\n"); grid = -1; return; }
        int per_cu = 0; (void)hipOccupancyMaxActiveBlocksPerMultiprocessor(&per_cu, (const void*)mk::mega, mk::NWAVES * 64, mk::LDS_BYTES); (void)hipGetLastError();
        if (per_cu < 1) fprintf(stderr, "kernel_launch: occupancy query reports %d blocks per CU\n", per_cu);
        grid = cus;
    }
    if (grid < 0) return;
    const float* x = (const float*)d_in[0]; const float* mem = (const float*)d_in[1]; const float* g_mix = (const float*)d_in[2]; const float* w_in = (const float*)d_in[3];
    const float* g_sb = (const float*)d_in[4]; const float* g_pool = (const float*)d_in[5]; const float* w_pool = (const float*)d_in[6]; const float* pool_scale = (const float*)d_in[7];
    const float* w_out = (const float*)d_in[8]; const float* g_mem_q = (const float*)d_in[9]; const float* g_mem_kv = (const float*)d_in[10]; const float* w_mem_q = (const float*)d_in[11];
    const float* w_mem_kv = (const float*)d_in[12]; const float* w_mem_o = (const float*)d_in[13]; const float* g_ffn = (const float*)d_in[14]; const float* w_router = (const float*)d_in[15];
    const float* b_router = (const float*)d_in[16]; const float* w_e_in = (const float*)d_in[17]; const float* b_e_in = (const float*)d_in[18]; const float* w_e_out = (const float*)d_in[19];
    const float* b_e_out = (const float*)d_in[20]; const float* g_final = (const float*)d_in[21];
    float* out = (float*)d_out; unsigned char* ws = (unsigned char*)d_ws;
    bf16_t* WIN = (bf16_t*)(ws + WS_WIN); bf16_t* WOUT = (bf16_t*)(ws + WS_WOUT); bf16_t* WQ = (bf16_t*)(ws + WS_WQ); bf16_t* WKV = (bf16_t*)(ws + WS_WKV); bf16_t* WO = (bf16_t*)(ws + WS_WO);
    bf16_t* WP = (bf16_t*)(ws + WS_WP); float* WR = (float*)(ws + WS_WR); float* RSTDX = (float*)(ws + WS_RSTDX); float* RSTDM = (float*)(ws + WS_RSTDM);
    bf16_t* W1 = (bf16_t*)(ws + WS_W1); bf16_t* W2 = (bf16_t*)(ws + WS_W2); bf16_t* S0 = (bf16_t*)(ws + WS_S0); bf16_t* QKVU = (bf16_t*)(ws + WS_QKVU);
    bf16_t* QM = (bf16_t*)(ws + WS_QM); bf16_t* OM = (bf16_t*)(ws + WS_OM); bf16_t* MIXED = (bf16_t*)(ws + WS_MIXED); bf16_t* PM = (bf16_t*)(ws + WS_PM); bf16_t* ACT = (bf16_t*)(ws + WS_ACT);
    bf16_t* KM = (bf16_t*)(ws + WS_KM); bf16_t* VMT = (bf16_t*)(ws + WS_VMT); bf16_t* MEMB = (bf16_t*)(ws + WS_MEMB); int* LSLOT = (int*)(ws + WS_LSLOT); float* LGATE = (float*)(ws + WS_LGATE);
    bf16_t* Y = (bf16_t*)(ws + WS_Y); float* SCR_S = (float*)(ws + WS_SCR_S); bf16_t* POOLED = (bf16_t*)(ws + WS_SCR_POOLED); float* POOLO = (float*)(ws + WS_SCR_POOLO);
    int* CNT = (int*)(ws + OFF_CNT); float* SSQSB = (float*)(ws + OFF_SSQSB); float* SSQ1 = (float*)(ws + OFF_SSQ1); float* SSQ2 = (float*)(ws + OFF_SSQ2);

    (void)hipMemsetAsync(ws + WS_CTL, 0, CTL_BYTES, stream);
    mk::Args a{}; for (int i = 0; i < 22; ++i) a.in[i] = (const float*)d_in[i]; a.out = out; a.ws = ws;
    const dim3 tb(32, 8); const int BIG = 1 << 30; int li = 0;
    for (int p = 0; p < mk::NPHASE;) {
        if ((MEGA_MASK >> p) & 1) { int q = p; while (q < mk::NPHASE && ((MEGA_MASK >> q) & 1)) ++q;
            a.ph_lo = p; a.ph_hi = q; a.li = li; hipLaunchKernelGGL(mk::mega, dim3(grid), dim3(mk::NWAVES * 64), mk::LDS_BYTES, stream, a); ++li; p = q; continue; }
        switch (p) {
        case 0:
            nv::k_cvt_w<<<dim3(INP / 32, D / 32, 1), tb, 0, stream>>>(w_in, D, INP, WIN, INP, g_mix, nullptr, BIG, nullptr, 0, 0);
            nv::k_cvt_w<<<dim3(D / 32, D / 32, 1), tb, 0, stream>>>(w_out, D, D, WOUT, D, g_sb, g_pool, SBW, nullptr, 0, 0);
            nv::k_cvt_w<<<dim3(D / 32, D / 32, 1), tb, 0, stream>>>(w_mem_q, D, D, WQ, D, g_mem_q, nullptr, BIG, nullptr, 0, 0);
            nv::k_cvt_w<<<dim3(2 * D / 32, D / 32, 1), tb, 0, stream>>>(w_mem_kv, D, 2 * D, WKV, 2 * D, g_mem_kv, nullptr, BIG, nullptr, 0, 0);
            nv::k_cvt_w<<<dim3(D / 32, D / 32, 1), tb, 0, stream>>>(w_mem_o, D, D, WO, D, nullptr, nullptr, BIG, nullptr, 0, 0);
            nv::k_cvt_w<<<dim3(2 * DFF / 32, D / 32, NE), tb, 0, stream>>>(w_e_in, D, 2 * DFF, W1, 2 * DFF, g_ffn, nullptr, BIG, nullptr, 0, 1);
            nv::k_cvt_w<<<dim3(D / 32, DFF / 32, NE), tb, 0, stream>>>(w_e_out, DFF, D, W2, D, nullptr, nullptr, BIG, nullptr, 0, 0);
            nv::k_cvt_w<<<dim3(PGD / 32, PGD / 32, PG), tb, 0, stream>>>(w_pool, PGD, PGD, WP, PGD, nullptr, nullptr, BIG, pool_scale, PGD, 0);
            nv::k_cvt_router<<<NE * D / 256, 256, 0, stream>>>(w_router, g_ffn, WR);
            nv::k_rowstat_cvt<<<NTOK / 4, 256, 0, stream>>>(x, S0, RSTDX, NTOK);
            nv::k_rowstat_cvt<<<NMROWS / 4, 256, 0, stream>>>(mem, MEMB, RSTDM, NMROWS);
            break;
        case 1:
            nv::k_g1<<<dim3(INP / 64, NTOK / 64), 256, 0, stream>>>(S0, WIN, RSTDX, QKVU);
            nv::k_g1b<<<dim3(2 * D / 64, NMROWS / 64), 256, 0, stream>>>(MEMB, WKV, RSTDM, KM, VMT);
            break;
        case 2:
            nv::k_sb<<<B * NH * S / 256, 256, 0, stream>>>(QKVU, MIXED, SSQSB);
            nv::k_pool1<<<(unsigned)((size_t)NTOK * PW / 256), 256, 0, stream>>>(QKVU, POOLED);
            nv::k_pool2<<<dim3(PGD / 64, NTOK / 64, PG), 256, 0, stream>>>(POOLED, WP, POOLO);
            nv::k_pool3<<<NTOK / 4, 256, 0, stream>>>(POOLO, MIXED);
            break;
        case 3: nv::k_resid<<<dim3(D / 64, NTOK / 64), 256, 0, stream>>>(MIXED, WOUT, x, out, S0, SSQ1, SSQSB, SBW); break;
        case 4: nv::k_g3<<<dim3(D / 64, NTOK / 64), 256, 0, stream>>>(S0, WQ, SSQ1, QM); break;
        case 5:
            nv::k_ms<<<dim3(NMEM / 64, NTOK / 64, MH), 256, 0, stream>>>(QM, KM, SCR_S);
            nv::k_msoftmax<<<NTOK * MH / 4, 256, 0, stream>>>(SCR_S, PM);
            break;
        case 6: nv::k_mpv<<<dim3(MHD / 64, NTOK / 64, MH), 256, 0, stream>>>(PM, VMT, OM); break;
        case 7: nv::k_resid<<<dim3(D / 64, NTOK / 64), 256, 0, stream>>>(OM, WO, out, out, S0, SSQ2, SSQ2, -1); break;
        case 8: nv::k_route<<<NTOK / 4, 256, 0, stream>>>(out, SSQ2, WR, b_router, CNT, LSLOT, LGATE); break;
        case 9: nv::k_w1<<<dim3(DFF / 32, LCAP / 64, NE), 256, 0, stream>>>(S0, SSQ2, W1, b_e_in, CNT, LSLOT, ACT); break;
        case 10: nv::k_w2<<<dim3(D / 64, LCAP / 64, NE), 256, 0, stream>>>(ACT, W2, b_e_out, CNT, LSLOT, LGATE, Y); break;
        case 11: nv::k_final<<<NTOK / 4, 256, 0, stream>>>(out, Y, g_final); break;
        }
        ++p;
    }
}
```

```cpp
#include <hip/hip_runtime.h>
#include <cstdio>
#include <cstdint>

typedef unsigned short bf16_t;
typedef short bf16x8 __attribute__((ext_vector_type(8)));
typedef float f32x4 __attribute__((ext_vector_type(4)));
typedef unsigned u32x4 __attribute__((ext_vector_type(4)));

namespace cfg {
constexpr int B = 8, S = 4096, D = 1024, NTOK = B * S;
constexpr int SBW = 512, NH = 8, HD = 64, PW = 512, PG = 4, PGD = 128, INP = 2048;
constexpr int NMEM = 256, MH = 4, MHD = 256, NMROWS = B * NMEM;
constexpr int NE = 32, TOPK = 4, DFF = 1024, LCAP = NTOK;
constexpr float EPS = 1e-5f, LOG2E = 1.4426950408889634f;
constexpr float C2_SB = 0.125f * LOG2E, C2_MEM = 0.0625f * LOG2E;
constexpr float SW_LIMIT = 7.0f, SW_ALPHA = 1.702f;
constexpr int MAXTILES = 544;
constexpr size_t MiB = 1u << 20;
constexpr size_t WS_CTL = 0, CTL_BYTES = 2 * MiB;
constexpr size_t OFF_CNT = 64 * 1024, OFF_SSQSB = 512 * 1024, OFF_SSQ1 = 640 * 1024, OFF_SSQ2 = 768 * 1024;
constexpr size_t WS_WIN = 2 * MiB, WS_WOUT = 6 * MiB, WS_WQ = 8 * MiB, WS_WKV = 10 * MiB, WS_WO = 14 * MiB, WS_WP = 16 * MiB, WS_WR = 17 * MiB;
constexpr size_t WS_RSTDX = 18 * MiB, WS_RSTDM = 18 * MiB + 512 * 1024;
constexpr size_t WS_W1 = 20 * MiB, WS_W2 = 148 * MiB;
constexpr size_t WS_S0 = 212 * MiB;
constexpr size_t WS_QKVU = 276 * MiB;
constexpr size_t WS_QM = 276 * MiB, WS_OM = 340 * MiB;
constexpr size_t WS_MIXED = 404 * MiB;
constexpr size_t WS_PM = 404 * MiB;
constexpr size_t WS_ACT = 276 * MiB;
constexpr size_t WS_KM = 548 * MiB, WS_VMT = 552 * MiB, WS_MEMB = 556 * MiB, WS_LSLOT = 560 * MiB, WS_LGATE = 564 * MiB;
constexpr size_t WS_Y = 568 * MiB;
constexpr size_t WS_SCR_S = 568 * MiB, WS_SCR_POOLED = 696 * MiB, WS_SCR_POOLO = 728 * MiB;
constexpr size_t WS_END = 824 * MiB;
}
using namespace cfg;

__device__ __forceinline__ unsigned f2bf(float f) { unsigned u = __builtin_bit_cast(unsigned, f); return (u + 0x7fffu + ((u >> 16) & 1u)) >> 16; }
__device__ __forceinline__ float bf2f(bf16_t h) { return __builtin_bit_cast(float, (unsigned)h << 16); }
__device__ __forceinline__ float wave_sum(float v) {
#pragma unroll
    for (int o = 1; o < 64; o <<= 1) v += __shfl_xor(v, o);
    return v;
}

namespace nv {
__global__ void k_cvt_w(const float* src, int K, int N, bf16_t* dst, int ND, const float* gk, const float* gk2, int ksplit, const float* gn, int gnz, int mode) {
    __shared__ float t[32][33];
    const int nd0 = blockIdx.x * 32, k0 = blockIdx.y * 32, z = blockIdx.z;
    int ns0 = nd0;
    if (mode == 1) { const int pn = nd0 >> 8, j = nd0 & 255; ns0 = (j < 128) ? 128 * pn + j : 1024 + 128 * pn + (j - 128); }
    src += (size_t)z * K * N; dst += (size_t)z * ND * K;
    for (int i = threadIdx.y; i < 32; i += 8) { const int k = k0 + i, n = ns0 + threadIdx.x;
        float v = src[(size_t)k * N + n]; if (gk) v *= (k < ksplit) ? gk[k] : gk2[k - ksplit]; if (gn) v *= gn[z * gnz + n]; t[i][threadIdx.x] = v; }
    __syncthreads();
    for (int i = threadIdx.y; i < 32; i += 8) dst[(size_t)(nd0 + i) * K + k0 + threadIdx.x] = (bf16_t)f2bf(t[threadIdx.x][i]);
}
__global__ void k_cvt_router(const float* wr, const float* g, float* dst) {
    const int i = blockIdx.x * 256 + threadIdx.x; if (i >= NE * D) return; const int e = i / D, k = i % D; dst[i] = g[k] * wr[k * NE + e];
}
__global__ void k_rowstat_cvt(const float* x, bf16_t* xb, float* rstd, int rows) {
    const int row = blockIdx.x * 4 + (threadIdx.x >> 6), lane = threadIdx.x & 63; if (row >= rows) return;
    const float* xr = x + (size_t)row * D; float s = 0.f;
    for (int j = lane; j < D; j += 64) { const float v = xr[j]; s += v * v; xb[(size_t)row * D + j] = (bf16_t)f2bf(v); }
    s = wave_sum(s); if (lane == 0) rstd[row] = 1.0f / sqrtf(s * (1.0f / D) + EPS);
}

template <class RA, class RB, class MID, class EPI>
__device__ __forceinline__ void wave_gemm(int m0, int n0, int K, int kmid, RA ra, RB rb, MID mid, EPI epi) {
    const int lane = threadIdx.x & 63, r16 = lane & 15, kq = lane >> 4;
    const bf16_t* pa[2]; const bf16_t* pb[2];
#pragma unroll
    for (int i = 0; i < 2; ++i) { pa[i] = ra(m0 + i * 16 + r16) + kq * 8; pb[i] = rb(n0 + i * 16 + r16) + kq * 8; }
    f32x4 acc[2][2];
#pragma unroll
    for (int i = 0; i < 2; ++i)
#pragma unroll
        for (int j = 0; j < 2; ++j) acc[i][j] = (f32x4){0.f, 0.f, 0.f, 0.f};
    for (int k = 0; k < K; k += 32) {
        if (k == kmid) {
#pragma unroll
            for (int i = 0; i < 2; ++i)
#pragma unroll
                for (int r = 0; r < 4; ++r) { const float s = mid(m0 + i * 16 + kq * 4 + r); acc[i][0][r] *= s; acc[i][1][r] *= s; }
        }
        bf16x8 a[2], b[2];
#pragma unroll
        for (int i = 0; i < 2; ++i) { a[i] = *(const bf16x8*)(pa[i] + k); b[i] = *(const bf16x8*)(pb[i] + k); }
#pragma unroll
        for (int i = 0; i < 2; ++i)
#pragma unroll
            for (int j = 0; j < 2; ++j) acc[i][j] = __builtin_amdgcn_mfma_f32_16x16x32_bf16(a[i], b[j], acc[i][j], 0, 0, 0);
    }
#pragma unroll
    for (int i = 0; i < 2; ++i)
#pragma unroll
        for (int r = 0; r < 4; ++r) epi(m0 + i * 16 + kq * 4 + r, n0 + r16, n0 + 16 + r16, acc[i][0][r], acc[i][1][r]);
}
struct NoMid { __device__ float operator()(int) const { return 1.f; } };

#define NV_TILE() const int w = threadIdx.x >> 6, m0 = blockIdx.y * 64 + (w >> 1) * 32, n0 = blockIdx.x * 64 + (w & 1) * 32

__global__ void k_g1(const bf16_t* XB, const bf16_t* WT, const float* rstd, bf16_t* QKVU) {
    NV_TILE();
    wave_gemm(m0, n0, D, -1, [=](int r) { return XB + (size_t)r * D; }, [=](int c) { return WT + (size_t)c * D; }, NoMid(),
        [=](int r, int c0, int c1, float v0, float v1) { const float s = rstd[r];
            v0 *= s; v1 *= s; if (c0 < SBW) v0 *= C2_SB; if (c1 < SBW) v1 *= C2_SB;
            QKVU[(size_t)r * INP + c0] = (bf16_t)f2bf(v0); QKVU[(size_t)r * INP + c1] = (bf16_t)f2bf(v1); });
}
__global__ void k_g1b(const bf16_t* MEMB, const bf16_t* WT, const float* rstd, bf16_t* KM, bf16_t* VMT) {
    NV_TILE();
    wave_gemm(m0, n0, D, -1, [=](int r) { return MEMB + (size_t)r * D; }, [=](int c) { return WT + (size_t)c * D; }, NoMid(),
        [=](int r, int c0, int c1, float v0, float v1) { const float s = rstd[r]; const int cc[2] = {c0, c1}; const float vv[2] = {v0 * s, v1 * s};
#pragma unroll
            for (int q = 0; q < 2; ++q) { const int c = cc[q];
                if (c < D) KM[(size_t)r * D + c] = (bf16_t)f2bf(vv[q]);
                else VMT[((size_t)(r >> 8) * D + (c - D)) * NMEM + (r & 255)] = (bf16_t)f2bf(vv[q]); } });
}
__global__ void __launch_bounds__(256) k_sb(const bf16_t* QKVU, bf16_t* MIXED, float* SSQSB) {
    const int gid = blockIdx.x * 256 + threadIdx.x; const int t = gid & (S - 1), h = (gid >> 12) & 7, b = gid >> 15;
    const bf16_t* base = QKVU + (size_t)b * S * INP;
    float q[HD], o[HD];
    { const bf16_t* qp = base + (size_t)t * INP + h * HD;
#pragma unroll
      for (int d = 0; d < HD; ++d) { q[d] = bf2f(qp[d]); o[d] = 0.f; } }
    float P = 1.f;
    for (int s = t - 1; s >= 0; --s) {
        const bf16_t* kp = base + (size_t)s * INP + SBW + h * HD; const bf16_t* vp = kp + SBW;
        float z = 0.f;
#pragma unroll
        for (int d = 0; d < HD; ++d) z += q[d] * bf2f(kp[d]);
        const float e = exp2f(z), r = 1.0f / (1.0f + e), beta = 1.0f - r;
        const float w = bf2f((bf16_t)f2bf(beta * P));
#pragma unroll
        for (int d = 0; d < HD; ++d) o[d] += w * bf2f(vp[d]);
        P *= r;
        if (P == 0.f) break;
    }
    float ss = 0.f; bf16_t* op = MIXED + (size_t)(b * S + t) * D + h * HD;
#pragma unroll
    for (int d = 0; d < HD; ++d) { ss += o[d] * o[d]; op[d] = (bf16_t)f2bf(o[d]); }
    unsafeAtomicAdd(SSQSB + b * S + t, ss);
}
__global__ void k_pool1(const bf16_t* QKVU, bf16_t* POOLED) {
    const size_t gid = (size_t)blockIdx.x * 256 + threadIdx.x; const int c = gid & 511; const int tok = (int)(gid >> 9), t = tok & (S - 1);
    const int win = 2 << (c >> 7); const int n = (t + 1 < win) ? t + 1 : win;
    const bf16_t* up = QKVU + (size_t)tok * INP + 3 * SBW + c; float s = 0.f;
    for (int j = 0; j < n; ++j) s += bf2f(up[-(ptrdiff_t)j * INP]);
    POOLED[gid] = (bf16_t)f2bf(s / (float)n - bf2f(up[0]));
}
__global__ void k_pool2(const bf16_t* POOLED, const bf16_t* WPT, float* POOLO) {
    NV_TILE(); const int g = blockIdx.z;
    wave_gemm(m0, n0, PGD, -1, [=](int r) { return POOLED + (size_t)r * PW + g * PGD; }, [=](int c) { return WPT + ((size_t)g * PGD + c) * PGD; }, NoMid(),
        [=](int r, int c0, int c1, float v0, float v1) { POOLO[(size_t)r * PW + g * PGD + c0] = v0; POOLO[(size_t)r * PW + g * PGD + c1] = v1; });
}
__global__ void k_pool3(const float* POOLO, bf16_t* MIXED) {
    const int tok = blockIdx.x * 4 + (threadIdx.x >> 6), lane = threadIdx.x & 63;
    float v[8], s = 0.f;
#pragma unroll
    for (int j = 0; j < 8; ++j) { v[j] = POOLO[(size_t)tok * PW + lane + 64 * j]; s += v[j] * v[j]; }
    const float rs = 1.0f / sqrtf(wave_sum(s) * (1.0f / PW) + EPS);
#pragma unroll
    for (int j = 0; j < 8; ++j) MIXED[(size_t)tok * D + SBW + lane + 64 * j] = (bf16_t)f2bf(v[j] * rs);
}
__global__ void k_resid(const bf16_t* A, const bf16_t* WT, const float* xin, float* xout, bf16_t* XB, float* SSQ, const float* ssq_mid, int kmid) {
    NV_TILE();
    wave_gemm(m0, n0, D, kmid, [=](int r) { return A + (size_t)r * D; }, [=](int c) { return WT + (size_t)c * D; },
        [=](int r) { return 1.0f / sqrtf(ssq_mid[r] * (1.0f / SBW) + EPS); },
        [=](int r, int c0, int c1, float v0, float v1) {
            const float x0 = xin[(size_t)r * D + c0] + v0, x1 = xin[(size_t)r * D + c1] + v1;
            xout[(size_t)r * D + c0] = x0; xout[(size_t)r * D + c1] = x1;
            XB[(size_t)r * D + c0] = (bf16_t)f2bf(x0); XB[(size_t)r * D + c1] = (bf16_t)f2bf(x1);
            float q = x0 * x0 + x1 * x1; q += __shfl_xor(q, 1); q += __shfl_xor(q, 2); q += __shfl_xor(q, 4); q += __shfl_xor(q, 8);
            if ((threadIdx.x & 15) == 0) unsafeAtomicAdd(SSQ + r, q); });
}
__global__ void k_g3(const bf16_t* X1B, const bf16_t* WT, const float* SSQ1, bf16_t* QM) {
    NV_TILE();
    wave_gemm(m0, n0, D, -1, [=](int r) { return X1B + (size_t)r * D; }, [=](int c) { return WT + (size_t)c * D; }, NoMid(),
        [=](int r, int c0, int c1, float v0, float v1) { const float s = C2_MEM / sqrtf(SSQ1[r] * (1.0f / D) + EPS);
            QM[(size_t)r * D + c0] = (bf16_t)f2bf(v0 * s); QM[(size_t)r * D + c1] = (bf16_t)f2bf(v1 * s); });
}
__global__ void k_ms(const bf16_t* QM, const bf16_t* KM, float* SCR) {
    NV_TILE(); const int h = blockIdx.z; const int b = m0 >> 12;
    wave_gemm(m0, n0, MHD, -1, [=](int r) { return QM + (size_t)r * D + h * MHD; }, [=](int c) { return KM + ((size_t)b * NMEM + c) * D + h * MHD; }, NoMid(),
        [=](int r, int c0, int c1, float v0, float v1) { SCR[((size_t)r * MH + h) * NMEM + c0] = v0; SCR[((size_t)r * MH + h) * NMEM + c1] = v1; });
}
__global__ void k_msoftmax(const float* SCR, bf16_t* PM) {
    const int row = blockIdx.x * 4 + (threadIdx.x >> 6), lane = threadIdx.x & 63;
    float v[4], m = -INFINITY;
#pragma unroll
    for (int j = 0; j < 4; ++j) { v[j] = SCR[(size_t)row * NMEM + lane + 64 * j]; m = fmaxf(m, v[j]); }
#pragma unroll
    for (int o = 1; o < 64; o <<= 1) m = fmaxf(m, __shfl_xor(m, o));
    float s = 0.f;
#pragma unroll
    for (int j = 0; j < 4; ++j) { v[j] = exp2f(v[j] - m); s += v[j]; }
    s = 1.0f / wave_sum(s);
#pragma unroll
    for (int j = 0; j < 4; ++j) PM[(size_t)row * NMEM + lane + 64 * j] = (bf16_t)f2bf(v[j] * s);
}
__global__ void k_mpv(const bf16_t* PM, const bf16_t* VMT, bf16_t* OM) {
    NV_TILE(); const int h = blockIdx.z; const int b = m0 >> 12;
    wave_gemm(m0, n0, NMEM, -1, [=](int r) { return PM + ((size_t)r * MH + h) * NMEM; }, [=](int c) { return VMT + ((size_t)b * D + h * MHD + c) * NMEM; }, NoMid(),
        [=](int r, int c0, int c1, float v0, float v1) { OM[(size_t)r * D + h * MHD + c0] = (bf16_t)f2bf(v0); OM[(size_t)r * D + h * MHD + c1] = (bf16_t)f2bf(v1); });
}
__global__ void k_route(const float* x2, const float* SSQ2, const float* WR, const float* br, int* CNT, int* LSLOT, float* LGATE) {
    const int tok = blockIdx.x * 4 + (threadIdx.x >> 6), lane = threadIdx.x & 63;
    float xv[16];
#pragma unroll
    for (int j = 0; j < 16; ++j) xv[j] = x2[(size_t)tok * D + lane + 64 * j];
    const float rs = 1.0f / sqrtf(SSQ2[tok] * (1.0f / D) + EPS);
    float mine = 0.f;
    for (int e = 0; e < NE; ++e) { float s = 0.f;
#pragma unroll
        for (int j = 0; j < 16; ++j) s += xv[j] * WR[e * D + lane + 64 * j];
        s = wave_sum(s); if (lane == e) mine = s * rs + br[e]; }
    float tv[4]; int ti[4]; float cur = (lane < NE) ? mine : -INFINITY;
#pragma unroll
    for (int k = 0; k < 4; ++k) { float m = cur; int mi = lane;
#pragma unroll
        for (int o = 1; o < 64; o <<= 1) { const float om = __shfl_xor(m, o); const int oi = __shfl_xor(mi, o); if (om > m || (om == m && oi < mi)) { m = om; mi = oi; } }
        tv[k] = m; ti[k] = mi; if (lane == mi) cur = -INFINITY; }
    float g[4], gs = 0.f;
#pragma unroll
    for (int k = 0; k < 4; ++k) { g[k] = expf(tv[k] - tv[0]); gs += g[k]; }
    if (lane < 4) { int e = ti[0]; float gg = g[0];
        if (lane == 1) { e = ti[1]; gg = g[1]; } if (lane == 2) { e = ti[2]; gg = g[2]; } if (lane == 3) { e = ti[3]; gg = g[3]; }
        const int pos = atomicAdd(CNT + e, 1); LSLOT[(size_t)e * LCAP + pos] = tok * 4 + lane; LGATE[(size_t)e * LCAP + pos] = gg / gs; }
}
__device__ __forceinline__ int tile_base(const int* CNT, int e) { int tb = 0; for (int i = 0; i < e; ++i) tb += (CNT[i] + 255) >> 8; return tb; }
__global__ void k_w1(const bf16_t* X2B, const float* SSQ2, const bf16_t* W1T, const float* b1, const int* CNT, const int* LSLOT, bf16_t* ACT) {
    const int e = blockIdx.z, cnt = CNT[e]; const int w = threadIdx.x >> 6; const int m0 = blockIdx.y * 64 + (w >> 1) * 32; if (blockIdx.y * 64 >= cnt) return;
    const int gc0 = blockIdx.x * 32 + (w & 1) * 16;
    const int pn = gc0 >> 7, j0 = gc0 & 127; const int n0 = pn * 256 + j0;
    const int tb = tile_base(CNT, e); const bf16_t* Wt = W1T + (size_t)e * 2 * DFF * D; const int* ls = LSLOT + (size_t)e * LCAP;
    wave_gemm(m0, 0, D, -1, [=](int r) { const int tok = (r < cnt) ? (ls[r] >> 2) : 0; return X2B + (size_t)tok * D; },
        [=](int c) { const int rowb = (c < 16) ? n0 + c : n0 + 128 + (c - 16); return Wt + (size_t)rowb * D; }, NoMid(),
        [=](int r, int c0, int c1, float vg, float vu) { if (r >= cnt) return; const int tok = ls[r] >> 2; const float rs = 1.0f / sqrtf(SSQ2[tok] * (1.0f / D) + EPS);
            const int gc = gc0 + c0;
            float gate = vg * rs + b1[e * 2 * DFF + gc], up = vu * rs + b1[e * 2 * DFF + DFF + gc];
            gate = fminf(gate, SW_LIMIT); up = fminf(fmaxf(up, -SW_LIMIT), SW_LIMIT);
            const float act = (up + 1.0f) * gate / (1.0f + expf(-SW_ALPHA * gate));
            ACT[((size_t)tb * 256 + r) * DFF + gc] = (bf16_t)f2bf(act); (void)c1; });
}
__global__ void k_w2(const bf16_t* ACT, const bf16_t* W2T, const float* b2, const int* CNT, const int* LSLOT, const float* LGATE, bf16_t* Y) {
    const int e = blockIdx.z, cnt = CNT[e]; if (blockIdx.y * 64 >= cnt) return; NV_TILE();
    const int tb = tile_base(CNT, e); const bf16_t* Wt = W2T + (size_t)e * D * DFF; const int* ls = LSLOT + (size_t)e * LCAP; const float* lg = LGATE + (size_t)e * LCAP;
    wave_gemm(m0, n0, DFF, -1, [=](int r) { return ACT + ((size_t)tb * 256 + r) * DFF; }, [=](int c) { return Wt + (size_t)c * DFF; }, NoMid(),
        [=](int r, int c0, int c1, float v0, float v1) { if (r >= cnt) return; const int slot = ls[r]; const float g = lg[r];
            Y[(size_t)slot * D + c0] = (bf16_t)f2bf((v0 + b2[e * D + c0]) * g); Y[(size_t)slot * D + c1] = (bf16_t)f2bf((v1 + b2[e * D + c1]) * g); });
}
__global__ void k_final(float* out, const bf16_t* Y, const float* gf) {
    const int tok = blockIdx.x * 4 + (threadIdx.x >> 6), lane = threadIdx.x & 63;
    float v[16], s = 0.f;
#pragma unroll
    for (int j = 0; j < 16; ++j) { const int c = lane + 64 * j; float a = out[(size_t)tok * D + c];
#pragma unroll
        for (int k = 0; k < 4; ++k) a += bf2f(Y[((size_t)tok * 4 + k) * D + c]);
        v[j] = a; s += a * a; }
    const float rs = 1.0f / sqrtf(wave_sum(s) * (1.0f / D) + EPS);
#pragma unroll
    for (int j = 0; j < 16; ++j) { const int c = lane + 64 * j; out[(size_t)tok * D + c] = v[j] * rs * gf[c]; }
}
}

#define LAS __attribute__((address_space(3)))
#define GAS __attribute__((address_space(1)))
typedef int v4i_t __attribute__((ext_vector_type(4)));
typedef int v8i_t __attribute__((ext_vector_type(8)));
namespace pg8 {
constexpr int BM = 256, BK = 64, HALF = 128, HTB = HALF * BK * 2, STAGE_BYTES = 8 * HTB, NXCD = 8, WGM = 8;
__host__ __device__ __forceinline__ int lds_byte(int r, int c) { const int st = (r >> 4) * 2 + (c >> 5), rr = r & 15, cc = c & 31, ob = rr * 64 + cc * 2; return st * 1024 + (ob ^ (((ob >> 9) & 1) << 5)); }
__host__ __device__ __forceinline__ void stage_rc(int b, int& R, int& C) { const int st = b / 1024, sb = b % 1024, swz = sb ^ (((sb >> 9) & 1) << 5); R = (st >> 1) * 16 + swz / 64; C = (st & 1) * 32 + (swz % 64) / 2; }
__host__ __device__ __forceinline__ int perm32(int rho) { const int n = rho >> 4, i = rho & 15; return 8 * (i >> 2) + 4 * n + (i & 3); }
__device__ __forceinline__ unsigned cvt_pk_bf16(float lo, float hi) { unsigned r; asm volatile("v_cvt_pk_bf16_f32 %0, %1, %2" : "=v"(r) : "v"(lo), "v"(hi)); return r; }

#define WTMASK 0x008
#ifndef WTMASK
#define WTMASK 0x1ff
#endif
#define WT_ON(bit) (((WTMASK) >> (bit)) & 1)
__device__ __forceinline__ void st16_wt(void* p, u32x4 v) { asm volatile("global_store_dwordx4 %0, %1, off sc1\n\ts_nop 1" :: "v"(p), "v"(v)); }
__device__ __forceinline__ void st16_wt(void* p, f32x4 v) { asm volatile("global_store_dwordx4 %0, %1, off sc1\n\ts_nop 1" :: "v"(p), "v"(v)); }
template <int BIT, class V> __device__ __forceinline__ void st16(void* p, V v) { if constexpr (WT_ON(BIT)) st16_wt(p, v); else *(V*)p = v; }
#ifndef WT8
#define WT8 0
#endif
__device__ __forceinline__ void st8_wt(void* p, unsigned long long v) { if (WT8) __hip_atomic_store((unsigned long long*)p, v, __ATOMIC_RELAXED, __HIP_MEMORY_SCOPE_AGENT); else *(unsigned long long*)p = v; }
__device__ __forceinline__ void st4_wt(void* p, unsigned v) { if (WT8) __hip_atomic_store((unsigned*)p, v, __ATOMIC_RELAXED, __HIP_MEMORY_SCOPE_AGENT); else *(unsigned*)p = v; }
__device__ __forceinline__ int fresh_lane() { int l; asm volatile("v_mbcnt_lo_u32_b32 %0, -1, 0\n\tv_mbcnt_hi_u32_b32 %0, -1, %0" : "=v"(l)); return l; }
struct Unit { const char* A; const char* B; void* p0; void* p1; void* p2; void* p3; int pm, pn, i0, i1, ghost; };

__device__ __forceinline__ int xcd_remap(int L, int nwg) { const int q = nwg / NXCD, r = nwg % NXCD, xcd = L % NXCD, off = L / NXCD; return __builtin_amdgcn_readfirstlane((xcd < r ? xcd * (q + 1) : r * (q + 1) + (xcd - r) * q) + off); }
__device__ __forceinline__ void grouped_mn(int wgid, int nM, int nN, int& pm, int& pn) {
    const int nig = WGM * nN, gid = wgid / nig, fm = gid * WGM, gsz = (nM - fm) < WGM ? (nM - fm) : WGM; pm = __builtin_amdgcn_readfirstlane(fm + ((wgid % nig) % gsz)); pn = __builtin_amdgcn_readfirstlane((wgid % nig) / gsz); }

template <class Epi, class Sched, bool GATHER, int REP = 1, int REPE = 1, bool F8 = false>
__device__ __forceinline__ void gemm_phase(const int wid, LAS unsigned char* lds, LAS unsigned char* epi_lds, LAS unsigned* gtab, const int lda_b, const int ldb_b, const int nt, const Sched& S, const Epi& E) {
    const int wr = wid >> 2, wc = wid & 3;
    unsigned voffA, voffB, voffG[2][2]; int aoff, boff;
    { const int lane = fresh_lane(); int R, C; stage_rc(wid * 1024 + lane * 16, R, C); const int Rb = Epi::PERM ? ((R & ~31) + perm32(R & 31)) : R;
      voffA = (unsigned)(R * lda_b + C * 2); voffB = (unsigned)(Rb * ldb_b + C * 2); voffG[0][0] = voffG[0][1] = voffG[1][0] = voffG[1][1] = 0;
      aoff = lds_byte(wr * 64 + (lane & 15), (lane >> 4) * 8); boff = lds_byte(wc * 32 + (lane & 15), (lane >> 4) * 8); }
    const size_t kstep = (size_t)(BK * 2);
    const size_t hstepA = (size_t)HALF * lda_b, hstepB = (size_t)HALF * ldb_b;
    const unsigned ldsw = (unsigned)wid * 1024u;
#define PG8_SA(b, h) (((b) * 2 + (h)) * HTB)
#define PG8_SB(b, h) ((4 + (b) * 2 + (h)) * HTB)
#define PG8_GLDS(ugp, voff, bufoff, _i) do { const char* _u = (const char*)(ugp); asm volatile("" : "+s"(_u));     \
        __builtin_amdgcn_global_load_lds((const unsigned*)(_u + (voff)), (LAS unsigned*)(lds + (bufoff) + ldsw + (_i) * 8192), 16, 0, 0); } while (0)
#define PG8_STAGE_B(bufoff, gbase) do { _Pragma("unroll") for (int _i = 0; _i < 2; ++_i) PG8_GLDS((const char*)(gbase) + (size_t)_i * 64 * ldb_b, voffB, bufoff, _i); } while (0)
#define PG8_STAGE_A(bufoff, gbase, h) do { if constexpr (GATHER) { _Pragma("unroll") for (int _i = 0; _i < 2; ++_i) PG8_GLDS((const char*)(gbase), voffG[h][_i], bufoff, _i); } \
        else { _Pragma("unroll") for (int _i = 0; _i < 2; ++_i) PG8_GLDS((const char*)(gbase) + (h) * hstepA + (size_t)_i * 64 * lda_b, voffA, bufoff, _i); } } while (0)
#define PG8_LDA(dst, b, h) do { _Pragma("unroll") for (int m = 0; m < 4; ++m) _Pragma("unroll") for (int k = 0; k < 2; ++k) dst[m][k] = *(const LAS bf16x8*)(lds + PG8_SA(b, h) + aoff + m * 2048 + k * 1024); } while (0)
#define PG8_LDB(dst, b, h) do { _Pragma("unroll") for (int n = 0; n < 2; ++n) _Pragma("unroll") for (int k = 0; k < 2; ++k) dst[n][k] = *(const LAS bf16x8*)(lds + PG8_SB(b, h) + boff + n * 2048 + k * 1024); } while (0)
#define PG8_CAT(x0, x1) __builtin_shufflevector(__builtin_bit_cast(v4i_t, x0), __builtin_bit_cast(v4i_t, x1), 0, 1, 2, 3, 4, 5, 6, 7)
#define PG8_MMA(ai, bj, At, Bt) do { __builtin_amdgcn_s_setprio(1); _Pragma("unroll") for (int m = 0; m < 4; ++m) _Pragma("unroll") for (int n = 0; n < 2; ++n) { \
        if constexpr (F8) acc[ai][bj][m][n] = __builtin_amdgcn_mfma_scale_f32_16x16x128_f8f6f4(PG8_CAT(Bt[n][0], Bt[n][1]), PG8_CAT(At[m][0], At[m][1]), acc[ai][bj][m][n], 0, 0, 0, 0, 0, 0); \
        else { _Pragma("unroll") for (int k = 0; k < 2; ++k) acc[ai][bj][m][n] = __builtin_amdgcn_mfma_f32_16x16x32_bf16(Bt[n][k], At[m][k], acc[ai][bj][m][n], 0, 0, 0); } } __builtin_amdgcn_s_setprio(0); } while (0)
#define PG8_WAIT_V(n) asm volatile("s_waitcnt vmcnt(" #n ")" ::: "memory")
#define PG8_WAIT_L(n) asm volatile("s_waitcnt lgkmcnt(" #n ")" ::: "memory")
#define PG8_BAR __builtin_amdgcn_s_barrier()
#define PG8_SCHED __builtin_amdgcn_sched_barrier(0)
#define PG8_GTAB_LOAD(buf, nvalid) do { const int _l = fresh_lane(); int _R, _C; stage_rc(wid * 1024 + _l * 16, _R, _C); _Pragma("unroll") for (int _h = 0; _h < 2; ++_h) _Pragma("unroll") for (int _i = 0; _i < 2; ++_i) { \
        const int _row = _h * HALF + _R + 64 * _i; const unsigned _s = gtab[(buf) * 256 + _row]; voffG[_h][_i] = ((_row < (nvalid)) ? (_s >> 2) * (unsigned)lda_b : 0u) + (unsigned)(_C * 2); } } while (0)
#define PG8_GTAB_DMA(buf, src) do { if (wid == 0) __builtin_amdgcn_global_load_lds((const unsigned*)((const char*)(src) + fresh_lane() * 16), (LAS unsigned*)(gtab + (buf) * 256), 16, 0, 0); } while (0)
    auto nextu = [&](int i, Unit& u) -> bool { if constexpr (REP > 1) { const bool ok = S.next(i / REP, u); u.ghost = (i % REP) != REP - 1; return ok; } else { u.ghost = 0; return S.next(i, u); } };
    Unit cur, nxt; int ui = 0;
    if (!nextu(0, cur)) return;
    f32x4 acc[2][2][4][2];
#pragma unroll
    for (int a = 0; a < 2; ++a)
#pragma unroll
        for (int b = 0; b < 2; ++b)
#pragma unroll
            for (int m = 0; m < 4; ++m)
#pragma unroll
                for (int n = 0; n < 2; ++n) acc[a][b][m][n] = (f32x4){0.f, 0.f, 0.f, 0.f};
    bf16x8 At[4][2], B0[2][2], B1[2][2];
    const char* cA = cur.A; const char* cB = cur.B;
    if constexpr (GATHER) { PG8_GTAB_DMA(0, cur.p3); PG8_WAIT_V(0); PG8_WAIT_L(0); PG8_BAR; PG8_GTAB_LOAD(0, cur.i0); }
    PG8_STAGE_B(PG8_SB(0, 0), cB); PG8_STAGE_B(PG8_SB(0, 1), cB + hstepB); PG8_STAGE_A(PG8_SA(0, 0), cA, 0); PG8_STAGE_A(PG8_SA(0, 1), cA, 1);
    if (wr == 1) PG8_BAR;
    PG8_WAIT_V(2); PG8_BAR;
    PG8_STAGE_B(PG8_SB(1, 0), cB + kstep); PG8_STAGE_A(PG8_SA(1, 0), cA + kstep, 0); PG8_STAGE_B(PG8_SB(1, 1), cB + hstepB + kstep);
    PG8_WAIT_V(6); PG8_BAR;
    for (;;) {
        const bool has_next = nextu(ui + 1, nxt);
        const char* nA = has_next ? nxt.A : cA; const char* nB = has_next ? nxt.B : cB;
#pragma unroll 1
        for (int t = 0; t < nt; t += 2) {
            const bool last = (t == nt - 2);
            const char* a1 = cA + (size_t)(t + 1) * kstep;
            const char* a2 = last ? nA : cA + (size_t)(t + 2) * kstep; const char* b2 = last ? nB : cB + (size_t)(t + 2) * kstep;
            const char* a3 = a2 + kstep; const char* b3 = b2 + kstep;
            if constexpr (Epi::MIDK >= 0) { if (t == Epi::MIDK) E.midk(acc, cur, wr, fresh_lane() & 15); }
            if constexpr (GATHER) { if (t == 0 && has_next) PG8_GTAB_DMA((ui + 1) & 1, nxt.p3); }
            if constexpr (GATHER) { PG8_STAGE_A(PG8_SA(1, 1), a1, 1); if (last && has_next) PG8_GTAB_LOAD((ui + 1) & 1, nxt.i0); PG8_SCHED; }
            PG8_LDB(B0, 0, 0); PG8_LDB(B1, 0, 1); PG8_SCHED; PG8_LDA(At, 0, 0); if constexpr (!GATHER) PG8_STAGE_A(PG8_SA(1, 1), a1, 1);
            PG8_WAIT_V(8); PG8_WAIT_L(0); PG8_BAR; PG8_MMA(0, 0, At, B0); PG8_MMA(0, 1, At, B1); PG8_BAR; PG8_SCHED;
            PG8_LDA(At, 0, 1); PG8_STAGE_B(PG8_SB(0, 0), b2); PG8_STAGE_B(PG8_SB(0, 1), b2 + hstepB); PG8_STAGE_A(PG8_SA(0, 0), a2, 0);
            PG8_WAIT_V(8); PG8_WAIT_L(0); PG8_BAR; PG8_MMA(1, 0, At, B0); PG8_MMA(1, 1, At, B1); PG8_BAR; PG8_SCHED;
            PG8_LDB(B0, 1, 0); PG8_LDB(B1, 1, 1); PG8_SCHED; PG8_LDA(At, 1, 0); PG8_STAGE_A(PG8_SA(0, 1), a2, 1);
            PG8_WAIT_V(8); PG8_WAIT_L(0); PG8_BAR; PG8_MMA(0, 0, At, B0); PG8_MMA(0, 1, At, B1); PG8_BAR; PG8_SCHED;
            PG8_LDA(At, 1, 1); PG8_STAGE_B(PG8_SB(1, 0), b3); PG8_STAGE_B(PG8_SB(1, 1), b3 + hstepB); PG8_STAGE_A(PG8_SA(1, 0), a3, 0);
            PG8_WAIT_V(8); PG8_WAIT_L(0); PG8_BAR; PG8_MMA(1, 0, At, B0); PG8_MMA(1, 1, At, B1); PG8_BAR; PG8_SCHED;
        }
        if (wr == 0) PG8_BAR;
        if (!cur.ghost) { const int el = fresh_lane(); E(acc, cur, wr, wc, el & 15, el >> 4, wid, el, epi_lds); if constexpr (REPE > 1) { asm volatile("" ::: "memory"); E(acc, cur, wr, wc, el & 15, el >> 4, wid, el, epi_lds); } }
        if (!has_next) break;
#pragma unroll
        for (int a = 0; a < 2; ++a)
#pragma unroll
            for (int b = 0; b < 2; ++b)
#pragma unroll
                for (int m = 0; m < 4; ++m)
#pragma unroll
                    for (int n = 0; n < 2; ++n) acc[a][b][m][n] = (f32x4){0.f, 0.f, 0.f, 0.f};
        cur = nxt; cA = nA; cB = nB; ++ui;
        if (wr == 1) PG8_BAR;
    }
    PG8_WAIT_V(0);
    PG8_BAR;
#undef PG8_SA
#undef PG8_SB
#undef PG8_GLDS
#undef PG8_STAGE_A
#undef PG8_STAGE_B
#undef PG8_LDA
#undef PG8_LDB
#undef PG8_MMA
#undef PG8_CAT
#undef PG8_WAIT_V
#undef PG8_WAIT_L
#undef PG8_BAR
#undef PG8_SCHED
#undef PG8_GTAB_LOAD
#undef PG8_GTAB_DMA
}

struct EpiBf16S {
    static constexpr bool PERM = true; static constexpr int MIDK = -1;
    __device__ __forceinline__ void midk(f32x4 (&)[2][2][4][2], const Unit&, int, int) const {}
    __device__ __forceinline__ void operator()(const f32x4 (&acc)[2][2][4][2], const Unit& u, int wr, int wc, int fr, int fq, int, int, LAS unsigned char*) const {
        bf16_t* O = (bf16_t*)u.p0; const float* rs = (const float*)u.p1; const float* cs = (const float*)u.p2; const int ldc = u.i0;
        int r0 = wr * 64 + fr, c0 = wc * 32 + 8 * fq; asm volatile("" : "+v"(r0), "+v"(c0));
        f32x4 cv[2][2];
#pragma unroll
        for (int bj = 0; bj < 2; ++bj)
#pragma unroll
            for (int n = 0; n < 2; ++n) cv[bj][n] = cs ? *(const f32x4*)(cs + c0 + bj * HALF + 4 * n) : (f32x4){1.f, 1.f, 1.f, 1.f};
#pragma unroll
        for (int ai = 0; ai < 2; ++ai)
#pragma unroll
            for (int m = 0; m < 4; ++m) { const int r = r0 + ai * HALF + m * 16; const float rv = rs ? rs[r] : 1.f; bf16_t* rowp = O + (size_t)r * ldc + c0;
#pragma unroll
                for (int bj = 0; bj < 2; ++bj) { const f32x4 v0 = acc[ai][bj][m][0] * cv[bj][0] * rv, v1 = acc[ai][bj][m][1] * cv[bj][1] * rv;
                    u32x4 w; w.x = cvt_pk_bf16(v0[0], v0[1]); w.y = cvt_pk_bf16(v0[2], v0[3]); w.z = cvt_pk_bf16(v1[0], v1[1]); w.w = cvt_pk_bf16(v1[2], v1[3]);
                    st16<1>(rowp + bj * HALF, w); } }
    }
};
}

namespace mk {
constexpr int NWAVES = 8, NPHASE = 12;
constexpr int RING_OFF = 0, RING_BYTES = 131072, EPI_OFF = 131072, EPI_BYTES = 8192, GTAB_OFF = EPI_OFF + EPI_BYTES, GTAB_BYTES = 2048, MISC_OFF = GTAB_OFF + GTAB_BYTES, MISC_BYTES = 1024;
constexpr int LDS_BYTES = 147456;
static_assert(MISC_OFF + MISC_BYTES <= LDS_BYTES, "LDS map");
constexpr size_t WS_X2F8 = WS_Y;
constexpr size_t WS_CSG1 = 19 * MiB, WS_WRH = 19 * MiB + 64 * 1024, WS_WRL = 19 * MiB + 128 * 1024;
constexpr float WSCALE = 32.0f;
constexpr int CW_BAR = 1024;

#define RLX_AGENT __ATOMIC_RELAXED, __HIP_MEMORY_SCOPE_AGENT
#define LDS_WAIT() asm volatile("s_waitcnt lgkmcnt(0)" ::: "memory")
#define VM_WAIT() asm volatile("s_waitcnt vmcnt(0)" ::: "memory")
#define XB_TMO      128
#define XB_XCNT(j)  (256  + 64 * (j))
#define XB_XSUB(j)  (1280 + 64 * (j))
#define XB_XGEN(j)  (2304 + 64 * (j))
#define XB_TOP      3328
#define XB_TOPGEN   3392
#define XCD_BAR_WORDS 3456
#define XB_SPIN_CAP (1u << 20)
__device__ __forceinline__ unsigned xb_ld(unsigned* p)              { return __hip_atomic_load(p, __ATOMIC_RELAXED, __HIP_MEMORY_SCOPE_AGENT); }
__device__ __forceinline__ unsigned xb_add(unsigned* p, unsigned v) { return __hip_atomic_fetch_add(p, v, __ATOMIC_RELAXED, __HIP_MEMORY_SCOPE_AGENT); }
__device__ __forceinline__ unsigned xb_xcc_id() { return (unsigned)__builtin_amdgcn_s_getreg((3 << 11) | 20) & 0xFu; }
#define XB_SPIN(cond, bar) do { unsigned _sp = 0; while (cond) { __builtin_amdgcn_s_sleep(1); \
    if ((++_sp & 255u) == 0u) { if (xb_ld(&(bar)[XB_TMO])) break; if (_sp > XB_SPIN_CAP) { atomicAdd(&(bar)[XB_TMO], 1u); break; } } } } while (0)
struct XcdBarrier { unsigned* bar; unsigned x; volatile LAS unsigned* st; };
__device__ __forceinline__ XcdBarrier xcd_barrier_post(unsigned* bar, volatile LAS unsigned* st) {
    XcdBarrier b; b.bar = bar; b.x = xb_xcc_id(); b.st = st;
    if (threadIdx.x == 0) (void)xb_add(&bar[XB_XCNT(b.x)], 1u);
    return b;
}
__device__ __forceinline__ void xcd_barrier_complete(unsigned* bar, unsigned x, unsigned& nloc, unsigned& nx) {
    const unsigned G = gridDim.x * gridDim.y * gridDim.z;
    unsigned sum, cnt, mine, sp = 0u;
    for (;;) {
        sum = 0u; cnt = 0u; mine = 0u;
#pragma unroll
        for (unsigned j = 0; j < 16; ++j) { const unsigned c = xb_ld(&bar[XB_XCNT(j)]); sum += c; cnt += (c > 0u) ? 1u : 0u; mine = (j == x) ? c : mine; }
        if (sum == G) break;
        __builtin_amdgcn_s_sleep(1);
        if ((++sp & 255u) == 0u) { if (xb_ld(&bar[XB_TMO])) break; if (sp > XB_SPIN_CAP) { atomicAdd(&bar[XB_TMO], 1u); break; } }
    }
    nloc = mine > 0u ? mine : 1u; nx = cnt > 0u ? cnt : 1u;
}
__device__ __forceinline__ void xcd_barrier(const XcdBarrier& b) {
    asm volatile("s_waitcnt vmcnt(0)" ::: "memory");
    __syncthreads();
    if (threadIdx.x == 0) {
        unsigned* bar = b.bar;
        __builtin_amdgcn_s_waitcnt(0);
        unsigned nloc = b.st[0], nx = b.st[1];
        if (nloc == 0u) { xcd_barrier_complete(bar, b.x, nloc, nx); b.st[0] = nloc; b.st[1] = nx; }
        const unsigned old = xb_add(&bar[XB_XSUB(b.x)], 1u);
        const unsigned gen = old / nloc;
        if (old + 1u == (gen + 1u) * nloc) {
            __builtin_amdgcn_fence(__ATOMIC_RELEASE, "agent");
            asm volatile("s_waitcnt vmcnt(0)" ::: "memory");
            const unsigned og = xb_add(&bar[XB_TOP], 1u);
            const unsigned tg = og / nx;
            if (og + 1u == (tg + 1u) * nx) xb_add(&bar[XB_TOPGEN], 1u);
            else XB_SPIN(xb_ld(&bar[XB_TOPGEN]) == tg, bar);
            __builtin_amdgcn_fence(__ATOMIC_ACQUIRE, "agent");
            xb_add(&bar[XB_XGEN(b.x)], 1u);
            asm volatile("s_waitcnt vmcnt(0)" ::: "memory");
        } else {
            XB_SPIN(xb_ld(&bar[XB_XGEN(b.x)]) == gen, bar);
            __builtin_amdgcn_fence(__ATOMIC_ACQUIRE, "agent");
            asm volatile("s_waitcnt vmcnt(0)" ::: "memory");
        }
    }
    __syncthreads();
}

struct Args { const float* in[22]; float* out; unsigned char* ws; int ph_lo, ph_hi, li, pad; };

template <bool F8OUT>
__device__ __forceinline__ void p0_item(const float* W, int K, int N, void* WTv, const float* gk, const float* gk2, int ksplit, const float* gn, int mode, LAS float* scr, int item, int lane, float mult = 1.0f) {
    const int nblk = N / 32, kb = item / nblk, nb = item % nblk, k0 = 64 * kb, nd0 = 32 * nb;
    int ns0 = nd0; if (mode == 1) { const int pn = nd0 >> 8, j = nd0 & 255; ns0 = (j < 128) ? 128 * pn + j : 1024 + 128 * pn + (j - 128); }
    const int kr = lane >> 3, n4 = (lane & 7) * 4;
    f32x4 v[8];
#pragma unroll
    for (int i = 0; i < 8; ++i) v[i] = *(const f32x4*)(W + (size_t)(k0 + 8 * i + kr) * N + ns0 + n4);
    f32x4 gnv = (f32x4){1.f, 1.f, 1.f, 1.f}; if (gn) gnv = *(const f32x4*)(gn + ns0 + n4);
#pragma unroll
    for (int i = 0; i < 8; ++i) { const int kk = 8 * i + kr, k = k0 + kk; float g = 1.f; if (gk) g = (k < ksplit) ? gk[k] : gk2[k - ksplit];
        const f32x4 t = v[i] * gnv * (g * mult); LAS float* d = scr + kk * 33 + n4; d[0] = t[0]; d[1] = t[1]; d[2] = t[2]; d[3] = t[3]; }
    LDS_WAIT(); asm volatile("" ::: "memory");
    const int c = lane & 7;
#pragma unroll
    for (int j = 0; j < 4; ++j) { const int n = (lane >> 3) + 8 * j; const LAS float* s = scr + (8 * c) * 33 + n;
        if constexpr (F8OUT) { int lo = __builtin_amdgcn_cvt_pk_fp8_f32(s[0 * 33], s[1 * 33], 0, false); lo = __builtin_amdgcn_cvt_pk_fp8_f32(s[2 * 33], s[3 * 33], lo, true);
            int hi2 = __builtin_amdgcn_cvt_pk_fp8_f32(s[4 * 33], s[5 * 33], 0, false); hi2 = __builtin_amdgcn_cvt_pk_fp8_f32(s[6 * 33], s[7 * 33], hi2, true);
            pg8::st8_wt((unsigned char*)WTv + (size_t)(nd0 + n) * K + k0 + 8 * c, (unsigned long long)(unsigned)lo | ((unsigned long long)(unsigned)hi2 << 32)); }
        else { u32x4 o; o.x = pg8::cvt_pk_bf16(s[0 * 33], s[1 * 33]); o.y = pg8::cvt_pk_bf16(s[2 * 33], s[3 * 33]); o.z = pg8::cvt_pk_bf16(s[4 * 33], s[5 * 33]); o.w = pg8::cvt_pk_bf16(s[6 * 33], s[7 * 33]);
            pg8::st16<0>((bf16_t*)WTv + (size_t)(nd0 + n) * K + k0 + 8 * c, o); } }
    LDS_WAIT(); asm volatile("" ::: "memory");
}
__device__ __forceinline__ void p0_row(const float* xrow, bf16_t* orow, float* rstd, int lane) {
    const f32x4* xr = (const f32x4*)xrow + 2 * lane; f32x4 v[4]; float s = 0.f;
#pragma unroll
    for (int j = 0; j < 4; ++j) { v[j] = xr[(j >> 1) * 128 + (j & 1)]; s += (v[j].x * v[j].x + v[j].y * v[j].y) + (v[j].z * v[j].z + v[j].w * v[j].w); }
    s = wave_sum(s); if (lane == 0) *rstd = 1.0f / sqrtf(s * (1.0f / D) + EPS);
#pragma unroll
    for (int j = 0; j < 2; ++j) { u32x4 o; o.x = pg8::cvt_pk_bf16(v[2 * j].x, v[2 * j].y); o.y = pg8::cvt_pk_bf16(v[2 * j].z, v[2 * j].w); o.z = pg8::cvt_pk_bf16(v[2 * j + 1].x, v[2 * j + 1].y); o.w = pg8::cvt_pk_bf16(v[2 * j + 1].z, v[2 * j + 1].w);
        pg8::st16<0>(orow + j * 512 + 8 * lane, o); }
}
__device__ __forceinline__ void p0_prologue(const Args& a, LAS unsigned char* lds, int vcu, int G, int wave, int lane) {
    unsigned char* ws = a.ws;
    LAS float* scr = (LAS float*)(lds + RING_OFF + wave * 16384);
    const int gw = vcu * NWAVES + wave, NGW = G * NWAVES;
    constexpr int I_E1 = (D / 64) * (2 * DFF / 32), I_E2 = (DFF / 64) * (D / 32);
    constexpr int I_IN = (D / 64) * (INP / 32), I_SQ = (D / 64) * (D / 32), I_KV = (D / 64) * (2 * D / 32), I_P = (PGD / 64) * (PGD / 32);
    constexpr int N1 = NE * I_E1, N2 = NE * I_E2, NITEMS = N1 + N2 + I_IN + 3 * I_SQ + I_KV + PG * I_P;
    const int BIG = 1 << 30;
    for (int it = gw; it < NITEMS; it += NGW) {
        int r = it;
        if (r < N1) { const int e = r / I_E1; p0_item<true>(a.in[17] + (size_t)e * D * 2 * DFF, D, 2 * DFF, ws + WS_W1 + (size_t)e * 2 * DFF * D, a.in[14], nullptr, BIG, nullptr, 1, scr, r % I_E1, lane, WSCALE); continue; } r -= N1;
        if (r < N2) { const int e = r / I_E2; p0_item<true>(a.in[19] + (size_t)e * DFF * D, DFF, D, ws + WS_W2 + (size_t)e * D * DFF, nullptr, nullptr, BIG, nullptr, 0, scr, r % I_E2, lane, WSCALE); continue; } r -= N2;
        if (r < I_IN) { p0_item<false>(a.in[3], D, INP, (bf16_t*)(ws + WS_WIN), a.in[2], nullptr, BIG, nullptr, 0, scr, r, lane); continue; } r -= I_IN;
        if (r < I_SQ) { p0_item<false>(a.in[8], D, D, (bf16_t*)(ws + WS_WOUT), a.in[4], a.in[5], SBW, nullptr, 0, scr, r, lane); continue; } r -= I_SQ;
        if (r < I_SQ) { p0_item<false>(a.in[11], D, D, (bf16_t*)(ws + WS_WQ), a.in[9], nullptr, BIG, nullptr, 0, scr, r, lane); continue; } r -= I_SQ;
        if (r < I_KV) { p0_item<false>(a.in[12], D, 2 * D, (bf16_t*)(ws + WS_WKV), a.in[10], nullptr, BIG, nullptr, 0, scr, r, lane); continue; } r -= I_KV;
        if (r < I_SQ) { p0_item<false>(a.in[13], D, D, (bf16_t*)(ws + WS_WO), nullptr, nullptr, BIG, nullptr, 0, scr, r, lane); continue; } r -= I_SQ;
        { const int g = r / I_P; p0_item<false>(a.in[6] + (size_t)g * PGD * PGD, PGD, PGD, (bf16_t*)(ws + WS_WP) + (size_t)g * PGD * PGD, nullptr, nullptr, BIG, a.in[7] + g * PGD, 0, scr, r % I_P, lane); }
    }
    for (int m = gw; m < NTOK; m += NGW) p0_row(a.in[0] + (size_t)m * D, (bf16_t*)(ws + WS_S0) + (size_t)m * D, (float*)(ws + WS_RSTDX) + m, lane);
    for (int m = gw; m < NMROWS; m += NGW) p0_row(a.in[1] + (size_t)m * D, (bf16_t*)(ws + WS_MEMB) + (size_t)m * D, (float*)(ws + WS_RSTDM) + m, lane);
    const int gt = gw * 64 + lane, NGT = NGW * 64;
    for (int i = gt; i < INP; i += NGT) ((float*)(ws + WS_CSG1))[i] = (i < SBW) ? C2_SB : 1.0f;
    for (int i = gt; i < NE * D; i += NGT) { const int e = i / D, k = i % D; const float v = a.in[14][k] * a.in[15][k * NE + e];
        ((float*)(ws + WS_WR))[i] = v; const unsigned h = f2bf(v); ((bf16_t*)(ws + WS_WRH))[i] = (bf16_t)h; ((bf16_t*)(ws + WS_WRL))[i] = (bf16_t)f2bf(v - bf2f((bf16_t)h)); }
}

struct SchedP1 {
    int G, c; unsigned char* ws;
    __device__ __forceinline__ bool next(int i, pg8::Unit& u) const {
        const int L = i * G + c; constexpr int NQ = (NTOK / 256) * (INP / 256);
        if (L >= NQ + 64) return false;
        if (L < NQ) { int pm, pn; pg8::grouped_mn(pg8::xcd_remap(L, NQ), NTOK / 256, INP / 256, pm, pn);
            u.A = (const char*)(ws + WS_S0) + (size_t)pm * 256 * D * 2; u.B = (const char*)(ws + WS_WIN) + (size_t)pn * 256 * D * 2;
            u.p0 = (bf16_t*)(ws + WS_QKVU) + (size_t)pm * 256 * INP + pn * 256; u.p1 = (float*)(ws + WS_RSTDX) + pm * 256; u.p2 = (float*)(ws + WS_CSG1) + pn * 256; u.i0 = INP; u.pm = pm; u.pn = pn; }
        else if (L < NQ + 32) { const int k = L - NQ, pm = k >> 2, pn = k & 3;
            u.A = (const char*)(ws + WS_MEMB) + (size_t)pm * 256 * D * 2; u.B = (const char*)(ws + WS_WKV) + (size_t)pn * 256 * D * 2;
            u.p0 = (bf16_t*)(ws + WS_KM) + (size_t)pm * 256 * D + pn * 256; u.p1 = (float*)(ws + WS_RSTDM) + pm * 256; u.p2 = nullptr; u.i0 = D; u.pm = pm; u.pn = pn; }
        else { const int v = L - NQ - 32, b = v >> 2, dt = v & 3;
            u.A = (const char*)(ws + WS_WKV) + (size_t)(D + dt * 256) * D * 2; u.B = (const char*)(ws + WS_MEMB) + (size_t)b * 256 * D * 2;
            u.p0 = (bf16_t*)(ws + WS_VMT) + ((size_t)b * D + dt * 256) * NMEM; u.p1 = nullptr; u.p2 = (float*)(ws + WS_RSTDM) + b * 256; u.i0 = NMEM; u.pm = dt; u.pn = b; }
        u.p3 = nullptr; u.i1 = 0; return true;
    }
};
#define EPI_BAR() asm volatile("s_waitcnt lgkmcnt(0)\n\ts_barrier" ::: "memory")
struct SchedReg {
    int G, c, nM, nN; const char* A; const char* B; size_t astep, bstep; bf16_t* O; int ldc; const float* rs; const float* cs;
    __device__ __forceinline__ bool next(int i, pg8::Unit& u) const {
        const int L = i * G + c; if (L >= nM * nN) return false; int pm, pn; pg8::grouped_mn(pg8::xcd_remap(L, nM * nN), nM, nN, pm, pn);
        u.A = A + (size_t)pm * astep; u.B = B + (size_t)pn * bstep; u.pm = pm; u.pn = pn; u.i0 = ldc; u.i1 = 0;
        u.p0 = O ? (void*)(O + (size_t)pm * 256 * ldc + pn * 256) : nullptr; u.p1 = rs ? (void*)(rs + pm * 256) : nullptr; u.p2 = cs ? (void*)(cs + pn * 256) : nullptr; u.p3 = nullptr; return true;
    }
};
struct EpiBf16Ssq {
    static constexpr bool PERM = true; static constexpr int MIDK = -1; float inv_n, mult;
    __device__ __forceinline__ void midk(f32x4 (&)[2][2][4][2], const pg8::Unit&, int, int) const {}
    __device__ __forceinline__ void operator()(f32x4 (&acc)[2][2][4][2], const pg8::Unit& u, int wr, int wc, int fr, int fq, int, int, LAS unsigned char*) const {
        bf16_t* O = (bf16_t*)u.p0; const float* sq = (const float*)u.p1; const int ldc = u.i0; int r0 = wr * 64 + fr, c0 = wc * 32 + 8 * fq; asm volatile("" : "+v"(r0), "+v"(c0));
#pragma unroll
        for (int ai = 0; ai < 2; ++ai)
#pragma unroll
            for (int m = 0; m < 4; ++m) { const int r = r0 + ai * 128 + m * 16; const float rv = mult / sqrtf(sq[r] * inv_n + EPS); bf16_t* rowp = O + (size_t)r * ldc + c0;
#pragma unroll
                for (int bj = 0; bj < 2; ++bj) { const f32x4 v0 = acc[ai][bj][m][0] * rv, v1 = acc[ai][bj][m][1] * rv;
                    u32x4 w; w.x = pg8::cvt_pk_bf16(v0[0], v0[1]); w.y = pg8::cvt_pk_bf16(v0[2], v0[3]); w.z = pg8::cvt_pk_bf16(v1[0], v1[1]); w.w = pg8::cvt_pk_bf16(v1[2], v1[3]);
                    pg8::st16<5>(rowp + bj * 128, w); } }
    }
};
template <int MIDK_, bool XIN_BF16, bool F8OUT> struct EpiResid {
    static constexpr bool PERM = true; static constexpr int MIDK = MIDK_;
    const float* xin; bf16_t* xb; unsigned char* x8; float* ssq; const float* ssq_mid;
    __device__ __forceinline__ void midk(f32x4 (&acc)[2][2][4][2], const pg8::Unit& u, int wr, int fr) const {
#pragma unroll
        for (int ai = 0; ai < 2; ++ai)
#pragma unroll
            for (int m = 0; m < 4; ++m) { const int r = u.pm * 256 + ai * 128 + wr * 64 + m * 16 + fr; const float s = 1.0f / sqrtf(ssq_mid[r] * (1.0f / SBW) + EPS);
#pragma unroll
                for (int bj = 0; bj < 2; ++bj)
#pragma unroll
                    for (int n = 0; n < 2; ++n) acc[ai][bj][m][n] *= s; }
    }
    __device__ __forceinline__ void operator()(f32x4 (&acc)[2][2][4][2], const pg8::Unit& u, int wr, int wc, int fr, int fq, int, int, LAS unsigned char*) const {
        int row0 = u.pm * 256 + wr * 64 + fr, col0 = u.pn * 256 + wc * 32 + 8 * fq; asm volatile("" : "+v"(row0), "+v"(col0));
#pragma unroll
        for (int ai = 0; ai < 2; ++ai)
#pragma unroll
            for (int m = 0; m < 4; ++m) { const int r = row0 + ai * 128 + m * 16; const size_t off = (size_t)r * D + col0; float q = 0.f;
#pragma unroll
                for (int bj = 0; bj < 2; ++bj) { const size_t o2 = off + bj * 128; f32x4 o0, o1;
                    if constexpr (XIN_BF16) { const u32x4 xv = *(const u32x4*)(xb + o2);
                        o0 = (f32x4){__builtin_bit_cast(float, xv.x << 16), __builtin_bit_cast(float, xv.x & 0xffff0000u), __builtin_bit_cast(float, xv.y << 16), __builtin_bit_cast(float, xv.y & 0xffff0000u)};
                        o1 = (f32x4){__builtin_bit_cast(float, xv.z << 16), __builtin_bit_cast(float, xv.z & 0xffff0000u), __builtin_bit_cast(float, xv.w << 16), __builtin_bit_cast(float, xv.w & 0xffff0000u)}; }
                    else { o0 = *(const f32x4*)(xin + o2); o1 = *(const f32x4*)(xin + o2 + 4); }
                    o0 += acc[ai][bj][m][0]; o1 += acc[ai][bj][m][1];
                    q += (o0[0] * o0[0] + o0[1] * o0[1]) + (o0[2] * o0[2] + o0[3] * o0[3]) + (o1[0] * o1[0] + o1[1] * o1[1]) + (o1[2] * o1[2] + o1[3] * o1[3]);
                    if constexpr (F8OUT) { int w0 = __builtin_amdgcn_cvt_pk_fp8_f32(o0[0], o0[1], 0, false); w0 = __builtin_amdgcn_cvt_pk_fp8_f32(o0[2], o0[3], w0, true);
                        int w1 = __builtin_amdgcn_cvt_pk_fp8_f32(o1[0], o1[1], 0, false); w1 = __builtin_amdgcn_cvt_pk_fp8_f32(o1[2], o1[3], w1, true);
                        pg8::st8_wt(x8 + o2, (unsigned long long)(unsigned)w0 | ((unsigned long long)(unsigned)w1 << 32)); }
                    u32x4 w; w.x = pg8::cvt_pk_bf16(o0[0], o0[1]); w.y = pg8::cvt_pk_bf16(o0[2], o0[3]); w.z = pg8::cvt_pk_bf16(o1[0], o1[1]); w.w = pg8::cvt_pk_bf16(o1[2], o1[3]); pg8::st16<4>(xb + o2, w); }
                q += __shfl_xor(q, 16); q += __shfl_xor(q, 32);
                if (fq == 0) unsafeAtomicAdd(ssq + r, q);
                if (m & 1) asm volatile("" ::: "memory"); }
    }
};
struct SchedMS {
    int G, c; unsigned char* ws;
    __device__ __forceinline__ bool next(int i, pg8::Unit& u) const {
        const int L = i * G + c; constexpr int NU = (NTOK / 256) * MH; if (L >= NU) return false; const int w = pg8::xcd_remap(L, NU), pm = w >> 2, h = w & 3, b = pm >> 4;
        u.A = (const char*)(ws + WS_QM) + ((size_t)pm * 256 * D + h * MHD) * 2; u.B = (const char*)(ws + WS_KM) + ((size_t)b * NMEM * D + h * MHD) * 2;
        u.p0 = (bf16_t*)(ws + WS_PM) + (size_t)pm * 256 * D + h * NMEM; u.p1 = nullptr; u.p2 = nullptr; u.p3 = nullptr; u.i0 = D; u.i1 = 0; u.pm = pm; u.pn = h; return true;
    }
};
struct EpiSoftmax {
    static constexpr bool PERM = true; static constexpr int MIDK = -1;
    __device__ __forceinline__ void midk(f32x4 (&)[2][2][4][2], const pg8::Unit&, int, int) const {}
    __device__ __forceinline__ void operator()(f32x4 (&acc)[2][2][4][2], const pg8::Unit& u, int wr, int wc, int fr, int fq, int, int, LAS unsigned char* xl) const {
        typedef float f32x2v __attribute__((ext_vector_type(2)));
        LAS f32x2v* X = (LAS f32x2v*)xl;
        float ml[2][4];
#pragma unroll
        for (int ai = 0; ai < 2; ++ai)
#pragma unroll
            for (int m = 0; m < 4; ++m) { float mx = -INFINITY;
#pragma unroll
                for (int bj = 0; bj < 2; ++bj)
#pragma unroll
                    for (int n = 0; n < 2; ++n) { const f32x4 v = acc[ai][bj][m][n]; mx = fmaxf(fmaxf(mx, fmaxf(v[0], v[1])), fmaxf(v[2], v[3])); }
                mx = fmaxf(mx, __shfl_xor(mx, 16)); mx = fmaxf(mx, __shfl_xor(mx, 32)); ml[ai][m] = mx; float s = 0.f;
#pragma unroll
                for (int bj = 0; bj < 2; ++bj)
#pragma unroll
                    for (int n = 0; n < 2; ++n) { f32x4 v = acc[ai][bj][m][n];
#pragma unroll
                        for (int j = 0; j < 4; ++j) { v[j] = __builtin_amdgcn_exp2f(v[j] - mx); s += v[j]; }
                        acc[ai][bj][m][n] = v; }
                s += __shfl_xor(s, 16); s += __shfl_xor(s, 32);
                if (fq == 0) X[(ai * 128 + wr * 64 + m * 16 + fr) * 4 + wc] = (f32x2v){mx, s}; }
        EPI_BAR();
        bf16_t* O = (bf16_t*)u.p0; const int ldc = u.i0; int r0 = wr * 64 + fr, c0 = wc * 32 + 8 * fq; asm volatile("" : "+v"(r0), "+v"(c0));
#pragma unroll
        for (int ai = 0; ai < 2; ++ai)
#pragma unroll
            for (int m = 0; m < 4; ++m) { const int r = r0 + ai * 128 + m * 16; const f32x2v a = X[r * 4 + 0], b = X[r * 4 + 1], c = X[r * 4 + 2], d = X[r * 4 + 3];
                const float M = fmaxf(fmaxf(a.x, b.x), fmaxf(c.x, d.x));
                const float tot = a.y * __builtin_amdgcn_exp2f(a.x - M) + b.y * __builtin_amdgcn_exp2f(b.x - M) + c.y * __builtin_amdgcn_exp2f(c.x - M) + d.y * __builtin_amdgcn_exp2f(d.x - M);
                const float f = __builtin_amdgcn_exp2f(ml[ai][m] - M) / tot; bf16_t* rowp = O + (size_t)r * ldc + c0;
#pragma unroll
                for (int bj = 0; bj < 2; ++bj) { const f32x4 v0 = acc[ai][bj][m][0] * f, v1 = acc[ai][bj][m][1] * f;
                    u32x4 w; w.x = pg8::cvt_pk_bf16(v0[0], v0[1]); w.y = pg8::cvt_pk_bf16(v0[2], v0[3]); w.z = pg8::cvt_pk_bf16(v1[0], v1[1]); w.w = pg8::cvt_pk_bf16(v1[2], v1[3]);
                    pg8::st16<6>(rowp + bj * 128, w); } }
    }
};
struct SchedPV {
    int G, c; unsigned char* ws;
    __device__ __forceinline__ bool next(int i, pg8::Unit& u) const {
        const int L = i * G + c; constexpr int NU = (NTOK / 256) * MH; if (L >= NU) return false; const int w = pg8::xcd_remap(L, NU), pm = w >> 2, h = w & 3, b = pm >> 4;
        u.A = (const char*)(ws + WS_PM) + ((size_t)pm * 256 * D + h * NMEM) * 2; u.B = (const char*)(ws + WS_VMT) + ((size_t)b * D + h * MHD) * NMEM * 2;
        u.p0 = (bf16_t*)(ws + WS_OM) + (size_t)pm * 256 * D + h * MHD; u.p1 = nullptr; u.p2 = nullptr; u.p3 = nullptr; u.i0 = D; u.i1 = 0; u.pm = pm; u.pn = h; return true;
    }
};

__device__ __forceinline__ void p8_route(const Args& a, LAS unsigned char* lds, int bx, int G, int wave, int lane, int* CNT) {
    unsigned char* ws = a.ws; const bf16_t* x2 = (const bf16_t*)(ws + WS_S0); const float* SSQ2 = (const float*)(ws + OFF_SSQ2); const float* br = a.in[16];
    const bf16_t* WRH = (const bf16_t*)(ws + WS_WRH); const bf16_t* WRL = (const bf16_t*)(ws + WS_WRL);
    int* LSLOT = (int*)(ws + WS_LSLOT); float* LGATE = (float*)(ws + WS_LGATE);
    LAS float* LG = (LAS float*)(lds + RING_OFF) + wave * 16 * 33;
    LAS int* hist = (LAS int*)(lds + RING_OFF + 32768); LAS int* base = hist + 32;
    const int tid = wave * 64 + lane;
    for (int t0 = bx * 128; t0 < NTOK; t0 += G * 128) {
        if (tid < 32) hist[tid] = 0;
        const int r16 = lane & 15, kq = lane >> 4; const int trow = t0 + wave * 16 + r16;
        const bf16_t* xp = x2 + (size_t)trow * D + kq * 8;
        f32x4 acc[2] = {(f32x4){0.f, 0.f, 0.f, 0.f}, (f32x4){0.f, 0.f, 0.f, 0.f}};
#pragma unroll 8
        for (int ks = 0; ks < 32; ++ks) {
            const bf16x8 ah = *(const bf16x8*)(xp + ks * 32);
#pragma unroll
            for (int nb = 0; nb < 2; ++nb) { const size_t wo = (size_t)(nb * 16 + r16) * D + ks * 32 + kq * 8;
                const bf16x8 bh = *(const bf16x8*)(WRH + wo), bl = *(const bf16x8*)(WRL + wo);
                acc[nb] = __builtin_amdgcn_mfma_f32_16x16x32_bf16(ah, bh, acc[nb], 0, 0, 0);
                acc[nb] = __builtin_amdgcn_mfma_f32_16x16x32_bf16(ah, bl, acc[nb], 0, 0, 0); }
        }
#pragma unroll
        for (int nb = 0; nb < 2; ++nb)
#pragma unroll
            for (int r = 0; r < 4; ++r) { const int tl = kq * 4 + r; const int tk = t0 + wave * 16 + tl; const float rs = 1.0f / sqrtf(SSQ2[tk] * (1.0f / D) + EPS);
                LG[tl * 33 + nb * 16 + r16] = acc[nb][r] * rs + br[nb * 16 + r16]; }
        LDS_WAIT(); __syncthreads();
        int te[4] = {0, 0, 0, 0}; float tg[4] = {0.f, 0.f, 0.f, 0.f}; int rk[4] = {0, 0, 0, 0};
        if (lane < 16) {
            float tv[4] = {-INFINITY, -INFINITY, -INFINITY, -INFINITY};
            for (int e = 0; e < NE; ++e) { const float v = LG[lane * 33 + e];
                if (v > tv[3]) { if (v > tv[2]) { tv[3] = tv[2]; te[3] = te[2]; if (v > tv[1]) { tv[2] = tv[1]; te[2] = te[1]; if (v > tv[0]) { tv[1] = tv[0]; te[1] = te[0]; tv[0] = v; te[0] = e; } else { tv[1] = v; te[1] = e; } } else { tv[2] = v; te[2] = e; } } else { tv[3] = v; te[3] = e; } } }
            float gs = 0.f;
#pragma unroll
            for (int k = 0; k < 4; ++k) { tg[k] = __expf(tv[k] - tv[0]); gs += tg[k]; }
            gs = 1.0f / gs;
#pragma unroll
            for (int k = 0; k < 4; ++k) { tg[k] *= gs; rk[k] = __hip_atomic_fetch_add(hist + te[k], 1, __ATOMIC_RELAXED, __HIP_MEMORY_SCOPE_WORKGROUP); }
        }
        LDS_WAIT(); __syncthreads();
        if (tid < 32) { const int n = hist[tid]; base[tid] = n ? atomicAdd(CNT + tid, n) : 0; }
        LDS_WAIT(); __syncthreads();
        if (lane < 16) { const int tk = t0 + wave * 16 + lane;
#pragma unroll
            for (int k = 0; k < 4; ++k) { const size_t p = (size_t)te[k] * LCAP + base[te[k]] + rk[k]; pg8::st4_wt(LSLOT + p, (unsigned)(tk * 4 + k)); pg8::st4_wt(LGATE + p, __float_as_uint(tg[k])); } }
        LDS_WAIT(); __syncthreads();
    }
}

__device__ __forceinline__ void moe_table(const Args& a, volatile LAS unsigned* MISC, int tid) {
    const int* CNT = (const int*)(a.ws + OFF_CNT);
    if (tid < 32) MISC[16 + tid] = (unsigned)CNT[tid];
    LDS_WAIT(); __syncthreads();
    if (tid == 0) { unsigned tb = 0; for (int e = 0; e < NE; ++e) { MISC[48 + e] = tb; tb += (MISC[16 + e] + 255u) >> 8; } MISC[48 + NE] = tb; }
    LDS_WAIT(); __syncthreads();
}
template <int NPN, bool W1> struct SchedMoE {
    int G, c; unsigned char* ws; volatile LAS unsigned* MISC;
    __device__ __forceinline__ bool next(int i, pg8::Unit& u) const {
        const int T = __builtin_amdgcn_readfirstlane((int)MISC[48 + NE]); const int NU = T * NPN; const int L = i * G + c; if (L >= NU) return false;
        const int w = pg8::xcd_remap(L, NU);
        int e = 0;
#pragma unroll
        for (int s = 16; s >= 1; s >>= 1) { if ((int)MISC[48 + e + s] * NPN <= w) e += s; }
        e = __builtin_amdgcn_readfirstlane(e);
        const int tb = __builtin_amdgcn_readfirstlane((int)MISC[48 + e]), cnt = __builtin_amdgcn_readfirstlane((int)MISC[16 + e]), nte = (cnt + 255) >> 8; const int idx = w - tb * NPN, pn = __builtin_amdgcn_readfirstlane(idx / nte), mt = idx - pn * nte;
        u.pm = tb + mt; u.pn = pn; u.i1 = e; const int nv = cnt - mt * 256; u.i0 = nv < 256 ? nv : 256;
        u.p3 = (int*)(ws + WS_LSLOT) + (size_t)e * LCAP + mt * 256; u.p2 = (float*)(ws + WS_LGATE) + (size_t)e * LCAP + mt * 256; u.p0 = nullptr; u.p1 = nullptr;
        if (W1) { u.A = (const char*)(ws + WS_X2F8); u.B = (const char*)(ws + WS_W1) + ((size_t)e * 2 * DFF + pn * 256) * D; }
        else { u.A = (const char*)(ws + WS_ACT) + (size_t)(tb + mt) * 256 * DFF; u.B = (const char*)(ws + WS_W2) + ((size_t)e * D + pn * 256) * DFF; }
        return true;
    }
};
struct EpiSwiGLU {
    static constexpr bool PERM = true; static constexpr int MIDK = -1; const float* ssq2; const float* b1; unsigned char* act;
    __device__ __forceinline__ void midk(f32x4 (&)[2][2][4][2], const pg8::Unit&, int, int) const {}
    __device__ __forceinline__ void operator()(f32x4 (&acc)[2][2][4][2], const pg8::Unit& u, int wr, int wc, int fr, int fq, int, int, LAS unsigned char*) const {
        const int e = u.i1, nvalid = u.i0; const int* slots = (const int*)u.p3; int r0 = wr * 64 + fr, c0 = wc * 32 + 8 * fq; asm volatile("" : "+v"(r0), "+v"(c0));     const int gc0 = u.pn * 128 + c0;
        f32x4 bg[2], bu[2];
#pragma unroll
        for (int n = 0; n < 2; ++n) { bg[n] = *(const f32x4*)(b1 + (size_t)e * 2 * DFF + gc0 + 4 * n); bu[n] = *(const f32x4*)(b1 + (size_t)e * 2 * DFF + DFF + gc0 + 4 * n); }
#pragma unroll
        for (int ai = 0; ai < 2; ++ai)
#pragma unroll
            for (int m = 0; m < 4; ++m) { const int r = r0 + ai * 128 + m * 16; const bool valid = r < nvalid; const int tok = valid ? (slots[r] >> 2) : 0;
                const float rs = (1.0f / WSCALE) / sqrtf(ssq2[tok] * (1.0f / D) + EPS); int wv[2];
#pragma unroll
                for (int n = 0; n < 2; ++n) { float o[4];
#pragma unroll
                    for (int j = 0; j < 4; ++j) { float g = acc[ai][0][m][n][j] * rs + bg[n][j], up = acc[ai][1][m][n][j] * rs + bu[n][j];
                        g = fminf(g, SW_LIMIT); up = fminf(fmaxf(up, -SW_LIMIT), SW_LIMIT);
                        o[j] = (up + 1.0f) * g * __builtin_amdgcn_rcpf(1.0f + __builtin_amdgcn_exp2f(-SW_ALPHA * LOG2E * g)); }
                    wv[n] = __builtin_amdgcn_cvt_pk_fp8_f32(o[0], o[1], 0, false); wv[n] = __builtin_amdgcn_cvt_pk_fp8_f32(o[2], o[3], wv[n], true); }
                if (valid) pg8::st8_wt(act + ((size_t)u.pm * 256 + r) * DFF + gc0, (unsigned long long)(unsigned)wv[0] | ((unsigned long long)(unsigned)wv[1] << 32)); }
    }
};
struct EpiW2 {
    static constexpr bool PERM = true; static constexpr int MIDK = -1; const float* b2; bf16_t* Y;
    __device__ __forceinline__ void midk(f32x4 (&)[2][2][4][2], const pg8::Unit&, int, int) const {}
    __device__ __forceinline__ void operator()(f32x4 (&acc)[2][2][4][2], const pg8::Unit& u, int wr, int wc, int fr, int fq, int, int, LAS unsigned char*) const {
        const int e = u.i1, nvalid = u.i0; const int* slots = (const int*)u.p3; const float* gates = (const float*)u.p2; int r0 = wr * 64 + fr, c0 = u.pn * 256 + wc * 32 + 8 * fq; asm volatile("" : "+v"(r0), "+v"(c0));
        f32x4 bv[2][2];
#pragma unroll
        for (int bj = 0; bj < 2; ++bj)
#pragma unroll
            for (int n = 0; n < 2; ++n) bv[bj][n] = *(const f32x4*)(b2 + (size_t)e * D + c0 + bj * 128 + 4 * n);
#pragma unroll
        for (int ai = 0; ai < 2; ++ai)
#pragma unroll
            for (int m = 0; m < 4; ++m) { const int r = r0 + ai * 128 + m * 16; const bool valid = r < nvalid; const int slot = valid ? slots[r] : 0; const float g = valid ? gates[r] : 0.f;
#pragma unroll
                for (int bj = 0; bj < 2; ++bj) { const f32x4 v0 = (acc[ai][bj][m][0] * (1.0f / WSCALE) + bv[bj][0]) * g, v1 = (acc[ai][bj][m][1] * (1.0f / WSCALE) + bv[bj][1]) * g;
                    u32x4 w; w.x = pg8::cvt_pk_bf16(v0[0], v0[1]); w.y = pg8::cvt_pk_bf16(v0[2], v0[3]); w.z = pg8::cvt_pk_bf16(v1[0], v1[1]); w.w = pg8::cvt_pk_bf16(v1[2], v1[3]);
                    if (valid) pg8::st16<7>(Y + (size_t)slot * D + c0 + bj * 128, w); } }
    }
};

__device__ __forceinline__ void p11_final(const Args& a, int vcu, int G, int wave, int lane, float* dst) {
    const bf16_t* x2 = (const bf16_t*)(a.ws + WS_S0); const bf16_t* Y = (const bf16_t*)(a.ws + WS_Y); const float* gf = a.in[21];
    const int gw = vcu * NWAVES + wave, NGW = G * NWAVES;
    f32x4 g4[4];
#pragma unroll
    for (int j = 0; j < 4; ++j) g4[j] = *(const f32x4*)(gf + 4 * lane + 256 * j);
    for (int tok = gw; tok < NTOK; tok += NGW) {
        f32x4 v[4]; float s = 0.f;
#pragma unroll
        for (int j = 0; j < 4; ++j) { { const unsigned long long w = *(const unsigned long long*)(x2 + (size_t)tok * D + 4 * lane + 256 * j);
                v[j] = (f32x4){__builtin_bit_cast(float, (unsigned)(w << 16)), __builtin_bit_cast(float, (unsigned)w & 0xffff0000u), __builtin_bit_cast(float, (unsigned)(w >> 32) << 16), __builtin_bit_cast(float, (unsigned)(w >> 32) & 0xffff0000u)}; }
#pragma unroll
            for (int k = 0; k < 4; ++k) { const unsigned long long w = *(const unsigned long long*)(Y + ((size_t)tok * 4 + k) * D + 4 * lane + 256 * j);
                v[j][0] += __builtin_bit_cast(float, (unsigned)(w << 16)); v[j][1] += __builtin_bit_cast(float, (unsigned)w & 0xffff0000u);
                v[j][2] += __builtin_bit_cast(float, (unsigned)(w >> 32) << 16); v[j][3] += __builtin_bit_cast(float, (unsigned)(w >> 32) & 0xffff0000u); }
            s += (v[j][0] * v[j][0] + v[j][1] * v[j][1]) + (v[j][2] * v[j][2] + v[j][3] * v[j][3]); }
        const float rs = 1.0f / sqrtf(wave_sum(s) * (1.0f / D) + EPS);
#pragma unroll
        for (int j = 0; j < 4; ++j) pg8::st16<8>(dst + (size_t)tok * D + 4 * lane + 256 * j, (f32x4)(v[j] * rs * g4[j]));
    }
}
typedef float f32x16 __attribute__((ext_vector_type(16)));
typedef short s16x4 __attribute__((ext_vector_type(4)));
__device__ __forceinline__ int crow(int r, int hi) { return (r & 3) + 8 * (r >> 2) + 4 * hi; }
constexpr int SB_FLAG_OFF = 32768, SB_STG_OFF = 36864;
__device__ __forceinline__ void sb_unit(int b, int h, int qb, const bf16_t* QKVU, bf16_t* MIXED, float* SSQSB, LAS unsigned char* shm, int wid, int lane) {
    const int r32 = lane & 31, hi = lane >> 5;
    const size_t rowbase = (size_t)b * S; const int q0 = qb * 256;
    const bf16_t* Qw = QKVU + (rowbase + q0 + wid * 32) * INP + h * HD;
    const bf16_t* Kh = QKVU + rowbase * INP + SBW + h * HD; const bf16_t* Vh = Kh + SBW;
    bf16x8 qr[4];
#pragma unroll
    for (int d0 = 0; d0 < 4; ++d0) qr[d0] = *(const bf16x8*)(Qw + (size_t)r32 * INP + d0 * 16 + hi * 8);
    f32x16 o[2];
#pragma unroll
    for (int r = 0; r < 16; ++r) { o[0][r] = 0.f; o[1][r] = 0.f; }
    float carry = 1.0f; bool alive = true;
    const int jtop = 4 * qb + 3, jmax_w = 4 * qb + (wid >> 1);
    const int qabs = q0 + wid * 32 + r32;
    const bf16_t* ksrc = Kh + (size_t)lane * INP + wid * 8;
    const bf16_t* vsrc = Vh + (size_t)(16 * (wid & 3) + (lane >> 2)) * INP + (wid >> 2) * 32 + (lane & 3) * 8;
    const int stoff = wid * 1024 + lane * 16;
    LAS unsigned* flags = (LAS unsigned*)(shm + SB_FLAG_OFF);
    u32x4 kreg = *(const u32x4*)(ksrc + (size_t)jtop * 64 * INP), vreg = *(const u32x4*)(vsrc + (size_t)jtop * 64 * INP);
    int p = 0;
    for (int j = jtop; j >= 0; --j) {
        LAS unsigned char* Kb = shm + p * 16384; LAS unsigned char* Vb = Kb + 8192;
        *(LAS u32x4*)(Kb + stoff) = kreg; *(LAS u32x4*)(Vb + stoff) = vreg;
        LDS_WAIT(); __syncthreads();
        if (j < jtop) { const LAS unsigned* fl = flags + (p ^ 1) * 8; const unsigned any = (fl[0] | fl[1]) | (fl[2] | fl[3]) | (fl[4] | fl[5]) | (fl[6] | fl[7]);
            if (__builtin_amdgcn_readfirstlane(any) == 0u) break; }
        if (j > 0) { kreg = *(const u32x4*)(ksrc + (size_t)(j - 1) * 64 * INP); vreg = *(const u32x4*)(vsrc + (size_t)(j - 1) * 64 * INP); }
        if (j <= jmax_w && alive) {
            f32x16 p0, p1;
#pragma unroll
            for (int r = 0; r < 16; ++r) { p0[r] = 0.f; p1[r] = 0.f; }
            const LAS unsigned char* kb = Kb + hi * 1024 + r32 * 16;
#pragma unroll
            for (int d0 = 0; d0 < 4; ++d0) { const bf16x8 b0 = *(const LAS bf16x8*)(kb + d0 * 2048), b1 = *(const LAS bf16x8*)(kb + d0 * 2048 + 512);
                p0 = __builtin_amdgcn_mfma_f32_32x32x16_bf16(b0, qr[d0], p0, 0, 0, 0); p1 = __builtin_amdgcn_mfma_f32_32x32x16_bf16(b1, qr[d0], p1, 0, 0, 0); }
            const bool diag = (j == jmax_w); const int kbase = 64 * j + 4 * hi;
#pragma unroll
            for (int r = 0; r < 16; ++r) { const int k0 = kbase + (r & 3) + 8 * (r >> 2);
                float e0 = __builtin_amdgcn_exp2f(p0[r]), e1 = __builtin_amdgcn_exp2f(p1[r]);
                float r0 = __builtin_amdgcn_rcpf(1.0f + e0), r1 = __builtin_amdgcn_rcpf(1.0f + e1);
                if (diag) { if (k0 >= qabs) r0 = 1.0f; if (k0 + 32 >= qabs) r1 = 1.0f; }
                p0[r] = r0; p1[r] = r1; }
            float sfx[8][3], A[8];
#pragma unroll
            for (int i = 0; i < 8; ++i) { const float x0 = (i < 4) ? p0[4 * i] : p1[4 * i - 16], x1 = (i < 4) ? p0[4 * i + 1] : p1[4 * i - 15], x2 = (i < 4) ? p0[4 * i + 2] : p1[4 * i - 14], x3 = (i < 4) ? p0[4 * i + 3] : p1[4 * i - 13];
                sfx[i][2] = x3; sfx[i][1] = x3 * x2; sfx[i][0] = sfx[i][1] * x1; A[i] = sfx[i][0] * x0; }
            float T = carry, E[8];
#pragma unroll
            for (int i = 7; i >= 0; --i) { const auto sw = __builtin_amdgcn_permlane32_swap(__float_as_uint(A[i]), __float_as_uint(A[i]), false, false);
                const float own_or_a = __uint_as_float(sw[0]), own_or_b = __uint_as_float(sw[1]);
                const float partner = hi ? own_or_a : own_or_b;
                E[i] = hi ? T : T * partner; T = T * (A[i] * partner); }
            carry = T;
            unsigned pw[4][4];
#pragma unroll
            for (int i = 0; i < 8; ++i) { float w4[4];
#pragma unroll
                for (int jj = 0; jj < 4; ++jj) { const float rv = (i < 4) ? p0[4 * i + jj] : p1[4 * i - 16 + jj]; const float beta = 1.0f - rv;
                    w4[jj] = beta * ((jj == 3) ? E[i] : E[i] * sfx[i][jj]); }
                pw[i >> 1][(i & 1) * 2] = pg8::cvt_pk_bf16(w4[0], w4[1]); pw[i >> 1][(i & 1) * 2 + 1] = pg8::cvt_pk_bf16(w4[2], w4[3]); }
            const LAS unsigned char* vb = Vb + ((lane >> 4) & 1) * 32 + (lane & 3) * 8 + (4 * hi + ((lane & 15) >> 2)) * 64;
#pragma unroll
            for (int d0 = 0; d0 < 2; ++d0)
#pragma unroll
                for (int ks = 0; ks < 4; ++ks) {
                    const s16x4 lo = __builtin_bit_cast(s16x4, __builtin_amdgcn_ds_read_tr16_b64_v4i16((LAS s16x4*)(vb + d0 * 4096 + ks * 1024)));
                    const s16x4 hh = __builtin_bit_cast(s16x4, __builtin_amdgcn_ds_read_tr16_b64_v4i16((LAS s16x4*)(vb + d0 * 4096 + ks * 1024 + 512)));
                    const bf16x8 vf = (bf16x8){lo[0], lo[1], lo[2], lo[3], hh[0], hh[1], hh[2], hh[3]};
                    const bf16x8 pa = __builtin_bit_cast(bf16x8, (u32x4){pw[ks][0], pw[ks][1], pw[ks][2], pw[ks][3]});
                    o[d0] = __builtin_amdgcn_mfma_f32_32x32x16_bf16(pa, vf, o[d0], 0, 0, 0); }
            alive = __any(carry != 0.0f);
        }
        if (lane == 0) flags[p * 8 + wid] = (j > jmax_w || alive) ? 1u : 0u;
        p ^= 1;
    }
    LAS bf16_t* stg = (LAS bf16_t*)(shm + SB_STG_OFF + wid * 4096);
#pragma unroll
    for (int r = 0; r < 16; ++r) { const int orow = crow(r, hi);
#pragma unroll
        for (int d0 = 0; d0 < 2; ++d0) stg[orow * 64 + d0 * 32 + r32] = (bf16_t)f2bf(o[d0][r]); }
    LDS_WAIT();
    bf16_t* Ow = MIXED + (rowbase + q0 + wid * 32) * D + h * HD;
#pragma unroll
    for (int i = 0; i < 4; ++i) { const int row = i * 8 + (lane >> 3), ch = lane & 7; const u32x4 v = *(const LAS u32x4*)(stg + row * 64 + ch * 8);
        pg8::st16<2>(Ow + (size_t)row * D + ch * 8, v); float q = 0.f;
#pragma unroll
        for (int k = 0; k < 4; ++k) { const float a = __builtin_bit_cast(float, v[k] << 16), c = __builtin_bit_cast(float, v[k] & 0xffff0000u); q += a * a + c * c; }
        q += __shfl_xor(q, 1); q += __shfl_xor(q, 2); q += __shfl_xor(q, 4);
        if (ch == 0) unsafeAtomicAdd(SSQSB + rowbase + q0 + wid * 32 + row, q); }
    LDS_WAIT(); __syncthreads();
}

constexpr int PL_PITCH = 1040, PL_PART_OFF = 83968, PL_RSTD_OFF = 86016;
__device__ __forceinline__ void pool_unit(int tile, const bf16_t* QKVU, const bf16_t* WPT, bf16_t* MIXED, LAS unsigned char* shm, int wid, int lane, int stop = 9) {
    const int tok0 = tile * 64, tpos0 = tok0 & (S - 1); const int tid = wid * 64 + lane;
    { u32x4 v[10];
#pragma unroll
      for (int i = 0; i < 10; ++i) { const int c = tid + i * NWAVES * 64; const int row = c >> 6, ch = c & 63; const int t = tpos0 - 15 + row;
          v[i] = (u32x4){0u, 0u, 0u, 0u}; if (c < 79 * 64 && t >= 0) v[i] = *(const u32x4*)(QKVU + (size_t)(tok0 - 15 + row) * INP + 3 * SBW + ch * 8); }
#pragma unroll
      for (int i = 0; i < 10; ++i) { const int c = tid + i * NWAVES * 64; const int row = c >> 6, ch = c & 63; if (c < 79 * 64) *(LAS u32x4*)(shm + row * PL_PITCH + ch * 16) = v[i]; } }
    LDS_WAIT(); __syncthreads();
    if (stop == 0) return;
    const int mb = wid & 3, gs = wid >> 2, r16 = lane & 15, kq = lane >> 4;
    const int lrow = 15 + mb * 16 + r16; const int tp1 = tpos0 + mb * 16 + r16 + 1;
    f32x4 acc[2][8]; float rowq[4] = {0.f, 0.f, 0.f, 0.f};
#pragma unroll
    for (int gi = 0; gi < 2; ++gi) {
        const int g = gs ? (1 + gi) : (gi ? 3 : 0); const int win = 2 << g; const int n = tp1 < win ? tp1 : win; const float inv = 1.0f / (float)n;
        bf16x8 Af[4];
#pragma unroll
        for (int ks = 0; ks < 4; ++ks) { float s[8];
#pragma unroll
            for (int q = 0; q < 8; ++q) s[q] = 0.f;
            const LAS unsigned char* up = shm + lrow * PL_PITCH + (g * PGD + ks * 32 + kq * 8) * 2;
            for (int jw = 0; jw < win; ++jw) { const u32x4 v = *(const LAS u32x4*)(up - jw * PL_PITCH);
#pragma unroll
                for (int k = 0; k < 4; ++k) { s[2 * k] += __builtin_bit_cast(float, v[k] << 16); s[2 * k + 1] += __builtin_bit_cast(float, v[k] & 0xffff0000u); } }
            const u32x4 self = *(const LAS u32x4*)up; u32x4 pk;
#pragma unroll
            for (int k = 0; k < 4; ++k) pk[k] = pg8::cvt_pk_bf16(s[2 * k] * inv - __builtin_bit_cast(float, self[k] << 16), s[2 * k + 1] * inv - __builtin_bit_cast(float, self[k] & 0xffff0000u));
            Af[ks] = __builtin_bit_cast(bf16x8, pk); }
        if (stop == 1) { asm volatile("" :: "v"(Af[0]), "v"(Af[1]), "v"(Af[2]), "v"(Af[3])); continue; }
#pragma unroll
        for (int nb = 0; nb < 8; ++nb) { f32x4 a = (f32x4){0.f, 0.f, 0.f, 0.f};
#pragma unroll
            for (int ks = 0; ks < 4; ++ks) { const bf16x8 bf = *(const bf16x8*)(WPT + ((size_t)(g * PGD + nb * 16 + r16)) * PGD + ks * 32 + kq * 8);
                a = __builtin_amdgcn_mfma_f32_16x16x32_bf16(Af[ks], bf, a, 0, 0, 0); }
            acc[gi][nb] = a;
#pragma unroll
            for (int r = 0; r < 4; ++r) rowq[r] += a[r] * a[r]; }
    }
    if (stop == 1) { LDS_WAIT(); __syncthreads(); return; }
    if (stop == 2) { asm volatile("" :: "v"(rowq[0]), "v"(rowq[1]), "v"(rowq[2]), "v"(rowq[3])); LDS_WAIT(); __syncthreads(); return; }
    LAS float* part = (LAS float*)(shm + PL_PART_OFF); LAS float* rstd = (LAS float*)(shm + PL_RSTD_OFF);
#pragma unroll
    for (int r = 0; r < 4; ++r) { float q = rowq[r]; q += __shfl_xor(q, 1); q += __shfl_xor(q, 2); q += __shfl_xor(q, 4); q += __shfl_xor(q, 8);
        if (r16 == 0) part[gs * 64 + mb * 16 + kq * 4 + r] = q; }
    LDS_WAIT(); __syncthreads();
    if (tid < 64) rstd[tid] = 1.0f / sqrtf((part[tid] + part[64 + tid]) * (1.0f / PW) + EPS);
    LDS_WAIT(); __syncthreads();
#pragma unroll
    for (int gi = 0; gi < 2; ++gi) { const int g = gs ? (1 + gi) : (gi ? 3 : 0);
#pragma unroll
        for (int r = 0; r < 4; ++r) { const int row = mb * 16 + kq * 4 + r; const float rs = rstd[row]; LAS bf16_t* op = (LAS bf16_t*)(shm + row * PL_PITCH) + g * PGD + r16;
#pragma unroll
            for (int nb = 0; nb < 8; ++nb) op[nb * 16] = (bf16_t)f2bf(acc[gi][nb][r] * rs); } }
    LDS_WAIT(); __syncthreads();
    if (stop == 3) { LDS_WAIT(); __syncthreads(); return; }
#pragma unroll
    for (int i = 0; i < 8; ++i) { const int c = tid + i * NWAVES * 64; const int row = c >> 6, ch = c & 63;
        pg8::st16<3>(MIXED + (size_t)(tok0 + row) * D + SBW + ch * 8, (u32x4)*(const LAS u32x4*)(shm + row * PL_PITCH + ch * 16)); }
    LDS_WAIT(); __syncthreads();
}
__device__ __forceinline__ void p2_mix(const Args& a, LAS unsigned char* lds, int bx, int G, int wid, int lane, float* SSQSB, int which = 3, int pstop = 9, bf16_t* pool_dst = nullptr) {
    unsigned char* ws = a.ws; const bf16_t* QKVU = (const bf16_t*)(ws + WS_QKVU); bf16_t* MIXED = (bf16_t*)(ws + WS_MIXED);
    constexpr int NA = B * NH * (S / 256);
    if (which & 1) for (int i = 0; i * G + bx < NA; ++i) { const int w = pg8::xcd_remap(i * G + bx, NA); const int bh = w >> 4, qb = w & 15; sb_unit(bh >> 3, bh & 7, qb, QKVU, MIXED, SSQSB, lds + RING_OFF, wid, lane); }
    if (which & 2) for (int t = bx; t < NTOK / 64; t += G) pool_unit(t, QKVU, (const bf16_t*)(ws + WS_WP), pool_dst ? pool_dst : MIXED, lds + RING_OFF, wid, lane, pstop);
}
constexpr size_t BAR_REGION_OFF = 1 * MiB, BAR_REGION_STRIDE = 16 * 1024;
__global__ void __launch_bounds__(NWAVES * 64, 2) mega(Args args) {
    const int li = args.li;
    extern __shared__ __attribute__((aligned(16))) unsigned char lds_raw[];
    LAS unsigned char* lds = (LAS unsigned char*)lds_raw;
    volatile LAS unsigned* MISC = (volatile LAS unsigned*)(lds + MISC_OFF);
    const int wave = __builtin_amdgcn_readfirstlane((int)threadIdx.x >> 6);
#define LANE_ID() ({ int l_; asm volatile("v_mbcnt_lo_u32_b32 %0, -1, 0\n\tv_mbcnt_hi_u32_b32 %0, -1, %0" : "=v"(l_)); l_; })
    const int G = gridDim.x; const int bx = blockIdx.x; const int vcu = (G % 8 == 0) ? (bx % 8) * (G / 8) + bx / 8 : bx;
    for (int u = wave * 64 + LANE_ID(); u < MISC_BYTES / 4; u += NWAVES * 64) MISC[u] = 0u;
    __syncthreads();
    unsigned char* ws = args.ws;
    XcdBarrier bar = xcd_barrier_post((unsigned*)(ws + BAR_REGION_OFF + (size_t)li * BAR_REGION_STRIDE), MISC + 8);
    const int lo = args.ph_lo, hi = args.ph_hi;
    LAS unsigned char* ring = lds + RING_OFF; LAS unsigned char* epi = lds + EPI_OFF; LAS unsigned* gtab = (LAS unsigned*)(lds + GTAB_OFF);
#ifndef TIME_PHASE
#define TIME_PHASE -1
#endif
#define REP_OF(k) ((TIME_PHASE == (k)) ? 2 : 1)
#define REPE_OF(k) ((TIME_PHASE == 20 + (k)) ? 2 : 1)
#define IN(k) (lo <= (k) && (k) < hi)
#ifndef TSK
#define TSK -1
#endif
#ifndef TSCALE
#define TSCALE 1.0f
#endif
#define STAMP(i) do { if (TSK >= 0 && bx == 0 && wave == 0) { const unsigned long long t_ = __builtin_amdgcn_s_memrealtime(); MISC[128 + 2 * (i)] = (unsigned)t_; MISC[129 + 2 * (i)] = (unsigned)(t_ >> 32); } } while (0)
#define SEAM(k) do { if (IN(k) && IN((k) + 1)) xcd_barrier(bar); STAMP((k) + 1); } while (0)
    STAMP(0);
    if (IN(0)) { p0_prologue(args, lds, vcu, G, wave, LANE_ID()); if (TIME_PHASE == 0) { xcd_barrier(bar); p0_prologue(args, lds, vcu, G, wave, LANE_ID()); } SEAM(0); }
    if (IN(1)) { SchedP1 S{G, bx, ws}; pg8::EpiBf16S E; pg8::gemm_phase<pg8::EpiBf16S, SchedP1, false, REP_OF(1), REPE_OF(1)>(wave, ring, epi, gtab, D * 2, D * 2, D / 64, S, E); SEAM(1); }
    {
    const float* xin0 = args.in[0]; float* outp = args.out;
    bf16_t* S0p = (bf16_t*)(ws + WS_S0); float* SSQSBp = (float*)(ws + OFF_SSQSB); float* SSQ1p = (float*)(ws + OFF_SSQ1); float* SSQ2p = (float*)(ws + OFF_SSQ2);
    constexpr size_t TSTEP = (size_t)256 * D * 2;
    #if !defined(PH_ONLY) || PH_ONLY == 2
    if (IN(2)) { if (TIME_PHASE == 42) { p2_mix(args, lds, bx, G, wave, LANE_ID(), (float*)(ws + 1536 * 1024), 2); xcd_barrier(bar); p2_mix(args, lds, bx, G, wave, LANE_ID(), (float*)(ws + 1536 * 1024), 2); xcd_barrier(bar); }
    if (TIME_PHASE == 2 || TIME_PHASE == 40 || TIME_PHASE == 41) { p2_mix(args, lds, bx, G, wave, LANE_ID(), (float*)(ws + 1536 * 1024), TIME_PHASE == 40 ? 1 : (TIME_PHASE == 41 ? 2 : 3)); xcd_barrier(bar); } p2_mix(args, lds, bx, G, wave, LANE_ID(), (float*)(ws + OFF_SSQSB)); SEAM(2); }
#endif

#if !defined(PH_ONLY) || PH_ONLY == 3
    if (IN(3)) { SchedReg S{G, bx, NTOK / 256, D / 256, (const char*)(ws + WS_MIXED), (const char*)(ws + WS_WOUT), TSTEP, TSTEP, nullptr, D, nullptr, nullptr};
        EpiResid<8, false, false> E{xin0, S0p, nullptr, SSQ1p, SSQSBp}; pg8::gemm_phase<EpiResid<8, false, false>, SchedReg, false, REP_OF(3)>(wave, ring, epi, gtab, D * 2, D * 2, D / 64, S, E); SEAM(3); }
#endif
#if !defined(PH_ONLY) || PH_ONLY == 4
    if (IN(4)) { SchedReg S{G, bx, NTOK / 256, D / 256, (const char*)(ws + WS_S0), (const char*)(ws + WS_WQ), TSTEP, TSTEP, (bf16_t*)(ws + WS_QM), D, SSQ1p, nullptr};
        EpiBf16Ssq E{1.0f / D, C2_MEM}; pg8::gemm_phase<EpiBf16Ssq, SchedReg, false, REP_OF(4)>(wave, ring, epi, gtab, D * 2, D * 2, D / 64, S, E); SEAM(4); }
#endif
#if !defined(PH_ONLY) || PH_ONLY == 5
    if (IN(5)) { SchedMS S{G, bx, ws}; EpiSoftmax E; pg8::gemm_phase<EpiSoftmax, SchedMS, false, REP_OF(5)>(wave, ring, epi, gtab, D * 2, D * 2, MHD / 64, S, E); SEAM(5); }
#endif
#if !defined(PH_ONLY) || PH_ONLY == 6
    if (IN(6)) { SchedPV S{G, bx, ws}; pg8::EpiBf16S E; pg8::gemm_phase<pg8::EpiBf16S, SchedPV, false, REP_OF(6)>(wave, ring, epi, gtab, D * 2, NMEM * 2, NMEM / 64, S, E); SEAM(6); }
#endif
#if !defined(PH_ONLY) || PH_ONLY == 7
    if (IN(7)) { SchedReg S{G, bx, NTOK / 256, D / 256, (const char*)(ws + WS_OM), (const char*)(ws + WS_WO), TSTEP, TSTEP, nullptr, D, nullptr, nullptr};
        EpiResid<-1, true, true> E{nullptr, S0p, ws + WS_X2F8, SSQ2p, nullptr}; pg8::gemm_phase<EpiResid<-1, true, true>, SchedReg, false, REP_OF(7)>(wave, ring, epi, gtab, D * 2, D * 2, D / 64, S, E); SEAM(7); }
#endif
#if !defined(PH_ONLY) || PH_ONLY == 8
    if (IN(8)) { if (TIME_PHASE == 8) { p8_route(args, lds, bx, G, wave, LANE_ID(), (int*)(ws + 1536 * 1024)); xcd_barrier(bar); } p8_route(args, lds, bx, G, wave, LANE_ID(), (int*)(ws + OFF_CNT)); SEAM(8); }
#endif
#if !defined(PH_ONLY) || PH_ONLY == 9
    if (IN(9)) { moe_table(args, MISC, wave * 64 + LANE_ID()); SchedMoE<8, true> S{G, bx, ws, MISC}; EpiSwiGLU E{SSQ2p, args.in[18], ws + WS_ACT};
        pg8::gemm_phase<EpiSwiGLU, SchedMoE<8, true>, true, REP_OF(9), REPE_OF(9), true>(wave, ring, epi, gtab, D, D, D / 128, S, E); SEAM(9); }
#endif
#if !defined(PH_ONLY) || PH_ONLY == 10
    if (IN(10)) { moe_table(args, MISC, wave * 64 + LANE_ID()); SchedMoE<4, false> S{G, bx, ws, MISC}; EpiW2 E{args.in[20], (bf16_t*)(ws + WS_Y)};
        pg8::gemm_phase<EpiW2, SchedMoE<4, false>, false, REP_OF(10), REPE_OF(10), true>(wave, ring, epi, gtab, DFF, DFF, DFF / 128, S, E); SEAM(10); }
#endif
#if !defined(PH_ONLY) || PH_ONLY == 11
    if (IN(11)) { if (TIME_PHASE == 11) { p11_final(args, vcu, G, wave, LANE_ID(), (float*)(ws + WS_ACT)); xcd_barrier(bar); } p11_final(args, vcu, G, wave, LANE_ID(), args.out); }
#endif
}

    if (TSK >= 0) { STAMP(12); __syncthreads(); if (bx == 0 && wave == 0 && LANE_ID() == 0) { asm volatile("s_waitcnt vmcnt(0)" ::: "memory");
        const unsigned long long t0 = ((unsigned long long)MISC[129 + 2 * TSK] << 32) | MISC[128 + 2 * TSK], t1 = ((unsigned long long)MISC[131 + 2 * TSK] << 32) | MISC[130 + 2 * TSK];
        args.out[0] = (float)(t1 - t0) * 0.01f * TSCALE; } }
    if (TIME_PHASE == 12) { for (int q = 0; q < 10; ++q) xcd_barrier(bar); }
#undef IN
#undef SEAM
}
}

#ifndef MEGA_MASK
#define MEGA_MASK 0xFFF
#endif
extern "C" void kernel_launch(void* const* d_in, const int* in_sizes, int n_in, void* d_out, int out_size, void* d_ws, size_t ws_size, hipStream_t stream) {
    if (n_in != 22 || out_size != NTOK * D || ws_size < WS_END) { fprintf(stderr, "kernel_launch: unexpected shapes (n_in %d out %d ws %zu)\n", n_in, out_size, ws_size); return; }
    static int grid = 0;
    if (grid == 0) {
        int dev = 0, cus = 0;
        if (hipGetDevice(&dev) != hipSuccess || hipDeviceGetAttribute(&cus, hipDeviceAttributeMultiprocessorCount, dev) != hipSuccess) { grid = -1; return; }
        if (hipFuncSetAttribute((const void*)mk::mega, hipFuncAttributeMaxDynamicSharedMemorySize, mk::LDS_BYTES) != hipSuccess) { fprintf(stderr, "kernel_launch: hipFuncSetAttribute failed\n"); grid = -1; return; }
        int per_cu = 0; (void)hipOccupancyMaxActiveBlocksPerMultiprocessor(&per_cu, (const void*)mk::mega, mk::NWAVES * 64, mk::LDS_BYTES); (void)hipGetLastError();
        if (per_cu < 1) fprintf(stderr, "kernel_launch: occupancy query reports %d blocks per CU\n", per_cu);
        grid = cus;
    }
    if (grid < 0) return;
    const float* x = (const float*)d_in[0]; const float* mem = (const float*)d_in[1]; const float* g_mix = (const float*)d_in[2]; const float* w_in = (const float*)d_in[3];
    const float* g_sb = (const float*)d_in[4]; const float* g_pool = (const float*)d_in[5]; const float* w_pool = (const float*)d_in[6]; const float* pool_scale = (const float*)d_in[7];
    const float* w_out = (const float*)d_in[8]; const float* g_mem_q = (const float*)d_in[9]; const float* g_mem_kv = (const float*)d_in[10]; const float* w_mem_q = (const float*)d_in[11];
    const float* w_mem_kv = (const float*)d_in[12]; const float* w_mem_o = (const float*)d_in[13]; const float* g_ffn = (const float*)d_in[14]; const float* w_router = (const float*)d_in[15];
    const float* b_router = (const float*)d_in[16]; const float* w_e_in = (const float*)d_in[17]; const float* b_e_in = (const float*)d_in[18]; const float* w_e_out = (const float*)d_in[19];
    const float* b_e_out = (const float*)d_in[20]; const float* g_final = (const float*)d_in[21];
    float* out = (float*)d_out; unsigned char* ws = (unsigned char*)d_ws;
    bf16_t* WIN = (bf16_t*)(ws + WS_WIN); bf16_t* WOUT = (bf16_t*)(ws + WS_WOUT); bf16_t* WQ = (bf16_t*)(ws + WS_WQ); bf16_t* WKV = (bf16_t*)(ws + WS_WKV); bf16_t* WO = (bf16_t*)(ws + WS_WO);
    bf16_t* WP = (bf16_t*)(ws + WS_WP); float* WR = (float*)(ws + WS_WR); float* RSTDX = (float*)(ws + WS_RSTDX); float* RSTDM = (float*)(ws + WS_RSTDM);
    bf16_t* W1 = (bf16_t*)(ws + WS_W1); bf16_t* W2 = (bf16_t*)(ws + WS_W2); bf16_t* S0 = (bf16_t*)(ws + WS_S0); bf16_t* QKVU = (bf16_t*)(ws + WS_QKVU);
    bf16_t* QM = (bf16_t*)(ws + WS_QM); bf16_t* OM = (bf16_t*)(ws + WS_OM); bf16_t* MIXED = (bf16_t*)(ws + WS_MIXED); bf16_t* PM = (bf16_t*)(ws + WS_PM); bf16_t* ACT = (bf16_t*)(ws + WS_ACT);
    bf16_t* KM = (bf16_t*)(ws + WS_KM); bf16_t* VMT = (bf16_t*)(ws + WS_VMT); bf16_t* MEMB = (bf16_t*)(ws + WS_MEMB); int* LSLOT = (int*)(ws + WS_LSLOT); float* LGATE = (float*)(ws + WS_LGATE);
    bf16_t* Y = (bf16_t*)(ws + WS_Y); float* SCR_S = (float*)(ws + WS_SCR_S); bf16_t* POOLED = (bf16_t*)(ws + WS_SCR_POOLED); float* POOLO = (float*)(ws + WS_SCR_POOLO);
    int* CNT = (int*)(ws + OFF_CNT); float* SSQSB = (float*)(ws + OFF_SSQSB); float* SSQ1 = (float*)(ws + OFF_SSQ1); float* SSQ2 = (float*)(ws + OFF_SSQ2);

    (void)hipMemsetAsync(ws + WS_CTL, 0, CTL_BYTES, stream);
    mk::Args a{}; for (int i = 0; i < 22; ++i) a.in[i] = (const float*)d_in[i]; a.out = out; a.ws = ws;
    const dim3 tb(32, 8); const int BIG = 1 << 30; int li = 0;
    for (int p = 0; p < mk::NPHASE;) {
        if ((MEGA_MASK >> p) & 1) { int q = p; while (q < mk::NPHASE && ((MEGA_MASK >> q) & 1)) ++q;
            a.ph_lo = p; a.ph_hi = q; a.li = li; hipLaunchKernelGGL(mk::mega, dim3(grid), dim3(mk::NWAVES * 64), mk::LDS_BYTES, stream, a); ++li; p = q; continue; }
        switch (p) {
        case 0:
            nv::k_cvt_w<<<dim3(INP / 32, D / 32, 1), tb, 0, stream>>>(w_in, D, INP, WIN, INP, g_mix, nullptr, BIG, nullptr, 0, 0);
            nv::k_cvt_w<<<dim3(D / 32, D / 32, 1), tb, 0, stream>>>(w_out, D, D, WOUT, D, g_sb, g_pool, SBW, nullptr, 0, 0);
            nv::k_cvt_w<<<dim3(D / 32, D / 32, 1), tb, 0, stream>>>(w_mem_q, D, D, WQ, D, g_mem_q, nullptr, BIG, nullptr, 0, 0);
            nv::k_cvt_w<<<dim3(2 * D / 32, D / 32, 1), tb, 0, stream>>>(w_mem_kv, D, 2 * D, WKV, 2 * D, g_mem_kv, nullptr, BIG, nullptr, 0, 0);
            nv::k_cvt_w<<<dim3(D / 32, D / 32, 1), tb, 0, stream>>>(w_mem_o, D, D, WO, D, nullptr, nullptr, BIG, nullptr, 0, 0);
            nv::k_cvt_w<<<dim3(2 * DFF / 32, D / 32, NE), tb, 0, stream>>>(w_e_in, D, 2 * DFF, W1, 2 * DFF, g_ffn, nullptr, BIG, nullptr, 0, 1);
            nv::k_cvt_w<<<dim3(D / 32, DFF / 32, NE), tb, 0, stream>>>(w_e_out, DFF, D, W2, D, nullptr, nullptr, BIG, nullptr, 0, 0);
            nv::k_cvt_w<<<dim3(PGD / 32, PGD / 32, PG), tb, 0, stream>>>(w_pool, PGD, PGD, WP, PGD, nullptr, nullptr, BIG, pool_scale, PGD, 0);
            nv::k_cvt_router<<<NE * D / 256, 256, 0, stream>>>(w_router, g_ffn, WR);
            nv::k_rowstat_cvt<<<NTOK / 4, 256, 0, stream>>>(x, S0, RSTDX, NTOK);
            nv::k_rowstat_cvt<<<NMROWS / 4, 256, 0, stream>>>(mem, MEMB, RSTDM, NMROWS);
            break;
        case 1:
            nv::k_g1<<<dim3(INP / 64, NTOK / 64), 256, 0, stream>>>(S0, WIN, RSTDX, QKVU);
            nv::k_g1b<<<dim3(2 * D / 64, NMROWS / 64), 256, 0, stream>>>(MEMB, WKV, RSTDM, KM, VMT);
            break;
        case 2:
            nv::k_sb<<<B * NH * S / 256, 256, 0, stream>>>(QKVU, MIXED, SSQSB);
            nv::k_pool1<<<(unsigned)((size_t)NTOK * PW / 256), 256, 0, stream>>>(QKVU, POOLED);
            nv::k_pool2<<<dim3(PGD / 64, NTOK / 64, PG), 256, 0, stream>>>(POOLED, WP, POOLO);
            nv::k_pool3<<<NTOK / 4, 256, 0, stream>>>(POOLO, MIXED);
            break;
        case 3: nv::k_resid<<<dim3(D / 64, NTOK / 64), 256, 0, stream>>>(MIXED, WOUT, x, out, S0, SSQ1, SSQSB, SBW); break;
        case 4: nv::k_g3<<<dim3(D / 64, NTOK / 64), 256, 0, stream>>>(S0, WQ, SSQ1, QM); break;
        case 5:
            nv::k_ms<<<dim3(NMEM / 64, NTOK / 64, MH), 256, 0, stream>>>(QM, KM, SCR_S);
            nv::k_msoftmax<<<NTOK * MH / 4, 256, 0, stream>>>(SCR_S, PM);
            break;
        case 6: nv::k_mpv<<<dim3(MHD / 64, NTOK / 64, MH), 256, 0, stream>>>(PM, VMT, OM); break;
        case 7: nv::k_resid<<<dim3(D / 64, NTOK / 64), 256, 0, stream>>>(OM, WO, out, out, S0, SSQ2, SSQ2, -1); break;
        case 8: nv::k_route<<<NTOK / 4, 256, 0, stream>>>(out, SSQ2, WR, b_router, CNT, LSLOT, LGATE); break;
        case 9: nv::k_w1<<<dim3(DFF / 32, LCAP / 64, NE), 256, 0, stream>>>(S0, SSQ2, W1, b_e_in, CNT, LSLOT, ACT); break;
        case 10: nv::k_w2<<<dim3(D / 64, LCAP / 64, NE), 256, 0, stream>>>(ACT, W2, b_e_out, CNT, LSLOT, LGATE, Y); break;
        case 11: nv::k_final<<<NTOK / 4, 256, 0, stream>>>(out, Y, g_final); break;
        }
        ++p;
    }
}
```

```cpp
#include <hip/hip_runtime.h>
#include <cstdio>
#include <cstdint>

typedef unsigned short bf16_t;
typedef short bf16x8 __attribute__((ext_vector_type(8)));
typedef float f32x4 __attribute__((ext_vector_type(4)));
typedef unsigned u32x4 __attribute__((ext_vector_type(4)));

namespace cfg {
constexpr int B = 8, S = 4096, D = 1024, NTOK = B * S;
constexpr int SBW = 512, NH = 8, HD = 64, PW = 512, PG = 4, PGD = 128, INP = 2048;
constexpr int NMEM = 256, MH = 4, MHD = 256, NMROWS = B * NMEM;
constexpr int NE = 32, TOPK = 4, DFF = 1024, LCAP = NTOK;
constexpr float EPS = 1e-5f, LOG2E = 1.4426950408889634f;
constexpr float C2_SB = 0.125f * LOG2E, C2_MEM = 0.0625f * LOG2E;
constexpr float SW_LIMIT = 7.0f, SW_ALPHA = 1.702f;
constexpr int MAXTILES = 544;
constexpr size_t MiB = 1u << 20;
constexpr size_t WS_CTL = 0, CTL_BYTES = 2 * MiB;
constexpr size_t OFF_CNT = 64 * 1024, OFF_SSQSB = 512 * 1024, OFF_SSQ1 = 640 * 1024, OFF_SSQ2 = 768 * 1024;
constexpr size_t WS_WIN = 2 * MiB, WS_WOUT = 6 * MiB, WS_WQ = 8 * MiB, WS_WKV = 10 * MiB, WS_WO = 14 * MiB, WS_WP = 16 * MiB, WS_WR = 17 * MiB;
constexpr size_t WS_RSTDX = 18 * MiB, WS_RSTDM = 18 * MiB + 512 * 1024;
constexpr size_t WS_W1 = 20 * MiB, WS_W2 = 148 * MiB;
constexpr size_t WS_S0 = 212 * MiB;
constexpr size_t WS_QKVU = 276 * MiB;
constexpr size_t WS_QM = 276 * MiB, WS_OM = 340 * MiB;
constexpr size_t WS_MIXED = 404 * MiB;
constexpr size_t WS_PM = 404 * MiB;
constexpr size_t WS_ACT = 276 * MiB;
constexpr size_t WS_KM = 548 * MiB, WS_VMT = 552 * MiB, WS_MEMB = 556 * MiB, WS_LSLOT = 560 * MiB, WS_LGATE = 564 * MiB;
constexpr size_t WS_Y = 568 * MiB;
constexpr size_t WS_SCR_S = 568 * MiB, WS_SCR_POOLED = 696 * MiB, WS_SCR_POOLO = 728 * MiB;
constexpr size_t WS_END = 824 * MiB;
}
using namespace cfg;

__device__ __forceinline__ unsigned f2bf(float f) { unsigned u = __builtin_bit_cast(unsigned, f); return (u + 0x7fffu + ((u >> 16) & 1u)) >> 16; }
__device__ __forceinline__ float bf2f(bf16_t h) { return __builtin_bit_cast(float, (unsigned)h << 16); }
__device__ __forceinline__ float wave_sum(float v) {
#pragma unroll
    for (int o = 1; o < 64; o <<= 1) v += __shfl_xor(v, o);
    return v;
}

namespace nv {
__global__ void k_cvt_w(const float* src, int K, int N, bf16_t* dst, int ND, const float* gk, const float* gk2, int ksplit, const float* gn, int gnz, int mode) {
    __shared__ float t[32][33];
    const int nd0 = blockIdx.x * 32, k0 = blockIdx.y * 32, z = blockIdx.z;
    int ns0 = nd0;
    if (mode == 1) { const int pn = nd0 >> 8, j = nd0 & 255; ns0 = (j < 128) ? 128 * pn + j : 1024 + 128 * pn + (j - 128); }
    src += (size_t)z * K * N; dst += (size_t)z * ND * K;
    for (int i = threadIdx.y; i < 32; i += 8) { const int k = k0 + i, n = ns0 + threadIdx.x;
        float v = src[(size_t)k * N + n]; if (gk) v *= (k < ksplit) ? gk[k] : gk2[k - ksplit]; if (gn) v *= gn[z * gnz + n]; t[i][threadIdx.x] = v; }
    __syncthreads();
    for (int i = threadIdx.y; i < 32; i += 8) dst[(size_t)(nd0 + i) * K + k0 + threadIdx.x] = (bf16_t)f2bf(t[threadIdx.x][i]);
}
__global__ void k_cvt_router(const float* wr, const float* g, float* dst) {
    const int i = blockIdx.x * 256 + threadIdx.x; if (i >= NE * D) return; const int e = i / D, k = i % D; dst[i] = g[k] * wr[k * NE + e];
}
__global__ void k_rowstat_cvt(const float* x, bf16_t* xb, float* rstd, int rows) {
    const int row = blockIdx.x * 4 + (threadIdx.x >> 6), lane = threadIdx.x & 63; if (row >= rows) return;
    const float* xr = x + (size_t)row * D; float s = 0.f;
    for (int j = lane; j < D; j += 64) { const float v = xr[j]; s += v * v; xb[(size_t)row * D + j] = (bf16_t)f2bf(v); }
    s = wave_sum(s); if (lane == 0) rstd[row] = 1.0f / sqrtf(s * (1.0f / D) + EPS);
}

template <class RA, class RB, class MID, class EPI>
__device__ __forceinline__ void wave_gemm(int m0, int n0, int K, int kmid, RA ra, RB rb, MID mid, EPI epi) {
    const int lane = threadIdx.x & 63, r16 = lane & 15, kq = lane >> 4;
    const bf16_t* pa[2]; const bf16_t* pb[2];
#pragma unroll
    for (int i = 0; i < 2; ++i) { pa[i] = ra(m0 + i * 16 + r16) + kq * 8; pb[i] = rb(n0 + i * 16 + r16) + kq * 8; }
    f32x4 acc[2][2];
#pragma unroll
    for (int i = 0; i < 2; ++i)
#pragma unroll
        for (int j = 0; j < 2; ++j) acc[i][j] = (f32x4){0.f, 0.f, 0.f, 0.f};
    for (int k = 0; k < K; k += 32) {
        if (k == kmid) {
#pragma unroll
            for (int i = 0; i < 2; ++i)
#pragma unroll
                for (int r = 0; r < 4; ++r) { const float s = mid(m0 + i * 16 + kq * 4 + r); acc[i][0][r] *= s; acc[i][1][r] *= s; }
        }
        bf16x8 a[2], b[2];
#pragma unroll
        for (int i = 0; i < 2; ++i) { a[i] = *(const bf16x8*)(pa[i] + k); b[i] = *(const bf16x8*)(pb[i] + k); }
#pragma unroll
        for (int i = 0; i < 2; ++i)
#pragma unroll
            for (int j = 0; j < 2; ++j) acc[i][j] = __builtin_amdgcn_mfma_f32_16x16x32_bf16(a[i], b[j], acc[i][j], 0, 0, 0);
    }
#pragma unroll
    for (int i = 0; i < 2; ++i)
#pragma unroll
        for (int r = 0; r < 4; ++r) epi(m0 + i * 16 + kq * 4 + r, n0 + r16, n0 + 16 + r16, acc[i][0][r], acc[i][1][r]);
}
struct NoMid { __device__ float operator()(int) const { return 1.f; } };

#define NV_TILE() const int w = threadIdx.x >> 6, m0 = blockIdx.y * 64 + (w >> 1) * 32, n0 = blockIdx.x * 64 + (w & 1) * 32

__global__ void k_g1(const bf16_t* XB, const bf16_t* WT, const float* rstd, bf16_t* QKVU) {
    NV_TILE();
    wave_gemm(m0, n0, D, -1, [=](int r) { return XB + (size_t)r * D; }, [=](int c) { return WT + (size_t)c * D; }, NoMid(),
        [=](int r, int c0, int c1, float v0, float v1) { const float s = rstd[r];
            v0 *= s; v1 *= s; if (c0 < SBW) v0 *= C2_SB; if (c1 < SBW) v1 *= C2_SB;
            QKVU[(size_t)r * INP + c0] = (bf16_t)f2bf(v0); QKVU[(size_t)r * INP + c1] = (bf16_t)f2bf(v1); });
}
__global__ void k_g1b(const bf16_t* MEMB, const bf16_t* WT, const float* rstd, bf16_t* KM, bf16_t* VMT) {
    NV_TILE();
    wave_gemm(m0, n0, D, -1, [=](int r) { return MEMB + (size_t)r * D; }, [=](int c) { return WT + (size_t)c * D; }, NoMid(),
        [=](int r, int c0, int c1, float v0, float v1) { const float s = rstd[r]; const int cc[2] = {c0, c1}; const float vv[2] = {v0 * s, v1 * s};
#pragma unroll
            for (int q = 0; q < 2; ++q) { const int c = cc[q];
                if (c < D) KM[(size_t)r * D + c] = (bf16_t)f2bf(vv[q]);
                else VMT[((size_t)(r >> 8) * D + (c - D)) * NMEM + (r & 255)] = (bf16_t)f2bf(vv[q]); } });
}
__global__ void __launch_bounds__(256) k_sb(const bf16_t* QKVU, bf16_t* MIXED, float* SSQSB) {
    const int gid = blockIdx.x * 256 + threadIdx.x; const int t = gid & (S - 1), h = (gid >> 12) & 7, b = gid >> 15;
    const bf16_t* base = QKVU + (size_t)b * S * INP;
    float q[HD], o[HD];
    { const bf16_t* qp = base + (size_t)t * INP + h * HD;
#pragma unroll
      for (int d = 0; d < HD; ++d) { q[d] = bf2f(qp[d]); o[d] = 0.f; } }
    float P = 1.f;
    for (int s = t - 1; s >= 0; --s) {
        const bf16_t* kp = base + (size_t)s * INP + SBW + h * HD; const bf16_t* vp = kp + SBW;
        float z = 0.f;
#pragma unroll
        for (int d = 0; d < HD; ++d) z += q[d] * bf2f(kp[d]);
        const float e = exp2f(z), r = 1.0f / (1.0f + e), beta = 1.0f - r;
        const float w = bf2f((bf16_t)f2bf(beta * P));
#pragma unroll
        for (int d = 0; d < HD; ++d) o[d] += w * bf2f(vp[d]);
        P *= r;
        if (P == 0.f) break;
    }
    float ss = 0.f; bf16_t* op = MIXED + (size_t)(b * S + t) * D + h * HD;
#pragma unroll
    for (int d = 0; d < HD; ++d) { ss += o[d] * o[d]; op[d] = (bf16_t)f2bf(o[d]); }
    unsafeAtomicAdd(SSQSB + b * S + t, ss);
}
__global__ void k_pool1(const bf16_t* QKVU, bf16_t* POOLED) {
    const size_t gid = (size_t)blockIdx.x * 256 + threadIdx.x; const int c = gid & 511; const int tok = (int)(gid >> 9), t = tok & (S - 1);
    const int win = 2 << (c >> 7); const int n = (t + 1 < win) ? t + 1 : win;
    const bf16_t* up = QKVU + (size_t)tok * INP + 3 * SBW + c; float s = 0.f;
    for (int j = 0; j < n; ++j) s += bf2f(up[-(ptrdiff_t)j * INP]);
    POOLED[gid] = (bf16_t)f2bf(s / (float)n - bf2f(up[0]));
}
__global__ void k_pool2(const bf16_t* POOLED, const bf16_t* WPT, float* POOLO) {
    NV_TILE(); const int g = blockIdx.z;
    wave_gemm(m0, n0, PGD, -1, [=](int r) { return POOLED + (size_t)r * PW + g * PGD; }, [=](int c) { return WPT + ((size_t)g * PGD + c) * PGD; }, NoMid(),
        [=](int r, int c0, int c1, float v0, float v1) { POOLO[(size_t)r * PW + g * PGD + c0] = v0; POOLO[(size_t)r * PW + g * PGD + c1] = v1; });
}
__global__ void k_pool3(const float* POOLO, bf16_t* MIXED) {
    const int tok = blockIdx.x * 4 + (threadIdx.x >> 6), lane = threadIdx.x & 63;
    float v[8], s = 0.f;
#pragma unroll
    for (int j = 0; j < 8; ++j) { v[j] = POOLO[(size_t)tok * PW + lane + 64 * j]; s += v[j] * v[j]; }
    const float rs = 1.0f / sqrtf(wave_sum(s) * (1.0f / PW) + EPS);
#pragma unroll
    for (int j = 0; j < 8; ++j) MIXED[(size_t)tok * D + SBW + lane + 64 * j] = (bf16_t)f2bf(v[j] * rs);
}
__global__ void k_resid(const bf16_t* A, const bf16_t* WT, const float* xin, float* xout, bf16_t* XB, float* SSQ, const float* ssq_mid, int kmid) {
    NV_TILE();
    wave_gemm(m0, n0, D, kmid, [=](int r) { return A + (size_t)r * D; }, [=](int c) { return WT + (size_t)c * D; },
        [=](int r) { return 1.0f / sqrtf(ssq_mid[r] * (1.0f / SBW) + EPS); },
        [=](int r, int c0, int c1, float v0, float v1) {
            const float x0 = xin[(size_t)r * D + c0] + v0, x1 = xin[(size_t)r * D + c1] + v1;
            xout[(size_t)r * D + c0] = x0; xout[(size_t)r * D + c1] = x1;
            XB[(size_t)r * D + c0] = (bf16_t)f2bf(x0); XB[(size_t)r * D + c1] = (bf16_t)f2bf(x1);
            float q = x0 * x0 + x1 * x1; q += __shfl_xor(q, 1); q += __shfl_xor(q, 2); q += __shfl_xor(q, 4); q += __shfl_xor(q, 8);
            if ((threadIdx.x & 15) == 0) unsafeAtomicAdd(SSQ + r, q); });
}
__global__ void k_g3(const bf16_t* X1B, const bf16_t* WT, const float* SSQ1, bf16_t* QM) {
    NV_TILE();
    wave_gemm(m0, n0, D, -1, [=](int r) { return X1B + (size_t)r * D; }, [=](int c) { return WT + (size_t)c * D; }, NoMid(),
        [=](int r, int c0, int c1, float v0, float v1) { const float s = C2_MEM / sqrtf(SSQ1[r] * (1.0f / D) + EPS);
            QM[(size_t)r * D + c0] = (bf16_t)f2bf(v0 * s); QM[(size_t)r * D + c1] = (bf16_t)f2bf(v1 * s); });
}
__global__ void k_ms(const bf16_t* QM, const bf16_t* KM, float* SCR) {
    NV_TILE(); const int h = blockIdx.z; const int b = m0 >> 12;
    wave_gemm(m0, n0, MHD, -1, [=](int r) { return QM + (size_t)r * D + h * MHD; }, [=](int c) { return KM + ((size_t)b * NMEM + c) * D + h * MHD; }, NoMid(),
        [=](int r, int c0, int c1, float v0, float v1) { SCR[((size_t)r * MH + h) * NMEM + c0] = v0; SCR[((size_t)r * MH + h) * NMEM + c1] = v1; });
}
__global__ void k_msoftmax(const float* SCR, bf16_t* PM) {
    const int row = blockIdx.x * 4 + (threadIdx.x >> 6), lane = threadIdx.x & 63;
    float v[4], m = -INFINITY;
#pragma unroll
    for (int j = 0; j < 4; ++j) { v[j] = SCR[(size_t)row * NMEM + lane + 64 * j]; m = fmaxf(m, v[j]); }
#pragma unroll
    for (int o = 1; o < 64; o <<= 1) m = fmaxf(m, __shfl_xor(m, o));
    float s = 0.f;
#pragma unroll
    for (int j = 0; j < 4; ++j) { v[j] = exp2f(v[j] - m); s += v[j]; }
    s = 1.0f / wave_sum(s);
#pragma unroll
    for (int j = 0; j < 4; ++j) PM[(size_t)row * NMEM + lane + 64 * j] = (bf16_t)f2bf(v[j] * s);
}
__global__ void k_mpv(const bf16_t* PM, const bf16_t* VMT, bf16_t* OM) {
    NV_TILE(); const int h = blockIdx.z; const int b = m0 >> 12;
    wave_gemm(m0, n0, NMEM, -1, [=](int r) { return PM + ((size_t)r * MH + h) * NMEM; }, [=](int c) { return VMT + ((size_t)b * D + h * MHD + c) * NMEM; }, NoMid(),
        [=](int r, int c0, int c1, float v0, float v1) { OM[(size_t)r * D + h * MHD + c0] = (bf16_t)f2bf(v0); OM[(size_t)r * D + h * MHD + c1] = (bf16_t)f2bf(v1); });
}
__global__ void k_route(const float* x2, const float* SSQ2, const float* WR, const float* br, int* CNT, int* LSLOT, float* LGATE) {
    const int tok = blockIdx.x * 4 + (threadIdx.x >> 6), lane = threadIdx.x & 63;
    float xv[16];
#pragma unroll
    for (int j = 0; j < 16; ++j) xv[j] = x2[(size_t)tok * D + lane + 64 * j];
    const float rs = 1.0f / sqrtf(SSQ2[tok] * (1.0f / D) + EPS);
    float mine = 0.f;
    for (int e = 0; e < NE; ++e) { float s = 0.f;
#pragma unroll
        for (int j = 0; j < 16; ++j) s += xv[j] * WR[e * D + lane + 64 * j];
        s = wave_sum(s); if (lane == e) mine = s * rs + br[e]; }
    float tv[4]; int ti[4]; float cur = (lane < NE) ? mine : -INFINITY;
#pragma unroll
    for (int k = 0; k < 4; ++k) { float m = cur; int mi = lane;
#pragma unroll
        for (int o = 1; o < 64; o <<= 1) { const float om = __shfl_xor(m, o); const int oi = __shfl_xor(mi, o); if (om > m || (om == m && oi < mi)) { m = om; mi = oi; } }
        tv[k] = m; ti[k] = mi; if (lane == mi) cur = -INFINITY; }
    float g[4], gs = 0.f;
#pragma unroll
    for (int k = 0; k < 4; ++k) { g[k] = expf(tv[k] - tv[0]); gs += g[k]; }
    if (lane < 4) { int e = ti[0]; float gg = g[0];
        if (lane == 1) { e = ti[1]; gg = g[1]; } if (lane == 2) { e = ti[2]; gg = g[2]; } if (lane == 3) { e = ti[3]; gg = g[3]; }
        const int pos = atomicAdd(CNT + e, 1); LSLOT[(size_t)e * LCAP + pos] = tok * 4 + lane; LGATE[(size_t)e * LCAP + pos] = gg / gs; }
}
__device__ __forceinline__ int tile_base(const int* CNT, int e) { int tb = 0; for (int i = 0; i < e; ++i) tb += (CNT[i] + 255) >> 8; return tb; }
__global__ void k_w1(const bf16_t* X2B, const float* SSQ2, const bf16_t* W1T, const float* b1, const int* CNT, const int* LSLOT, bf16_t* ACT) {
    const int e = blockIdx.z, cnt = CNT[e]; const int w = threadIdx.x >> 6; const int m0 = blockIdx.y * 64 + (w >> 1) * 32; if (blockIdx.y * 64 >= cnt) return;
    const int gc0 = blockIdx.x * 32 + (w & 1) * 16;
    const int pn = gc0 >> 7, j0 = gc0 & 127; const int n0 = pn * 256 + j0;
    const int tb = tile_base(CNT, e); const bf16_t* Wt = W1T + (size_t)e * 2 * DFF * D; const int* ls = LSLOT + (size_t)e * LCAP;
    wave_gemm(m0, 0, D, -1, [=](int r) { const int tok = (r < cnt) ? (ls[r] >> 2) : 0; return X2B + (size_t)tok * D; },
        [=](int c) { const int rowb = (c < 16) ? n0 + c : n0 + 128 + (c - 16); return Wt + (size_t)rowb * D; }, NoMid(),
        [=](int r, int c0, int c1, float vg, float vu) { if (r >= cnt) return; const int tok = ls[r] >> 2; const float rs = 1.0f / sqrtf(SSQ2[tok] * (1.0f / D) + EPS);
            const int gc = gc0 + c0;
            float gate = vg * rs + b1[e * 2 * DFF + gc], up = vu * rs + b1[e * 2 * DFF + DFF + gc];
            gate = fminf(gate, SW_LIMIT); up = fminf(fmaxf(up, -SW_LIMIT), SW_LIMIT);
            const float act = (up + 1.0f) * gate / (1.0f + expf(-SW_ALPHA * gate));
            ACT[((size_t)tb * 256 + r) * DFF + gc] = (bf16_t)f2bf(act); (void)c1; });
}
__global__ void k_w2(const bf16_t* ACT, const bf16_t* W2T, const float* b2, const int* CNT, const int* LSLOT, const float* LGATE, bf16_t* Y) {
    const int e = blockIdx.z, cnt = CNT[e]; if (blockIdx.y * 64 >= cnt) return; NV_TILE();
    const int tb = tile_base(CNT, e); const bf16_t* Wt = W2T + (size_t)e * D * DFF; const int* ls = LSLOT + (size_t)e * LCAP; const float* lg = LGATE + (size_t)e * LCAP;
    wave_gemm(m0, n0, DFF, -1, [=](int r) { return ACT + ((size_t)tb * 256 + r) * DFF; }, [=](int c) { return Wt + (size_t)c * DFF; }, NoMid(),
        [=](int r, int c0, int c1, float v0, float v1) { if (r >= cnt) return; const int slot = ls[r]; const float g = lg[r];
            Y[(size_t)slot * D + c0] = (bf16_t)f2bf((v0 + b2[e * D + c0]) * g); Y[(size_t)slot * D + c1] = (bf16_t)f2bf((v1 + b2[e * D + c1]) * g); });
}
__global__ void k_final(float* out, const bf16_t* Y, const float* gf) {
    const int tok = blockIdx.x * 4 + (threadIdx.x >> 6), lane = threadIdx.x & 63;
    float v[16], s = 0.f;
#pragma unroll
    for (int j = 0; j < 16; ++j) { const int c = lane + 64 * j; float a = out[(size_t)tok * D + c];
#pragma unroll
        for (int k = 0; k < 4; ++k) a += bf2f(Y[((size_t)tok * 4 + k) * D + c]);
        v[j] = a; s += a * a; }
    const float rs = 1.0f / sqrtf(wave_sum(s) * (1.0f / D) + EPS);
#pragma unroll
    for (int j = 0; j < 16; ++j) { const int c = lane + 64 * j; out[(size_t)tok * D + c] = v[j] * rs * gf[c]; }
}
}

#define LAS __attribute__((address_space(3)))
#define GAS __attribute__((address_space(1)))
typedef int v4i_t __attribute__((ext_vector_type(4)));
typedef int v8i_t __attribute__((ext_vector_type(8)));
namespace pg8 {
constexpr int BM = 256, BK = 64, HALF = 128, HTB = HALF * BK * 2, STAGE_BYTES = 8 * HTB, NXCD = 8, WGM = 8;
__host__ __device__ __forceinline__ int lds_byte(int r, int c) { const int st = (r >> 4) * 2 + (c >> 5), rr = r & 15, cc = c & 31, ob = rr * 64 + cc * 2; return st * 1024 + (ob ^ (((ob >> 9) & 1) << 5)); }
__host__ __device__ __forceinline__ void stage_rc(int b, int& R, int& C) { const int st = b / 1024, sb = b % 1024, swz = sb ^ (((sb >> 9) & 1) << 5); R = (st >> 1) * 16 + swz / 64; C = (st & 1) * 32 + (swz % 64) / 2; }
__host__ __device__ __forceinline__ int perm32(int rho) { const int n = rho >> 4, i = rho & 15; return 8 * (i >> 2) + 4 * n + (i & 3); }
__device__ __forceinline__ unsigned cvt_pk_bf16(float lo, float hi) { unsigned r; asm volatile("v_cvt_pk_bf16_f32 %0, %1, %2" : "=v"(r) : "v"(lo), "v"(hi)); return r; }

#define WTMASK 0x008
#ifndef WTMASK
#define WTMASK 0x1ff
#endif
#define WT_ON(bit) (((WTMASK) >> (bit)) & 1)
__device__ __forceinline__ void st16_wt(void* p, u32x4 v) { asm volatile("global_store_dwordx4 %0, %1, off sc1\n\ts_nop 1" :: "v"(p), "v"(v)); }
__device__ __forceinline__ void st16_wt(void* p, f32x4 v) { asm volatile("global_store_dwordx4 %0, %1, off sc1\n\ts_nop 1" :: "v"(p), "v"(v)); }
template <int BIT, class V> __device__ __forceinline__ void st16(void* p, V v) { if constexpr (WT_ON(BIT)) st16_wt(p, v); else *(V*)p = v; }
#ifndef WT8
#define WT8 0
#endif
__device__ __forceinline__ void st8_wt(void* p, unsigned long long v) { if (WT8) __hip_atomic_store((unsigned long long*)p, v, __ATOMIC_RELAXED, __HIP_MEMORY_SCOPE_AGENT); else *(unsigned long long*)p = v; }
__device__ __forceinline__ void st4_wt(void* p, unsigned v) { if (WT8) __hip_atomic_store((unsigned*)p, v, __ATOMIC_RELAXED, __HIP_MEMORY_SCOPE_AGENT); else *(unsigned*)p = v; }
__device__ __forceinline__ int fresh_lane() { int l; asm volatile("v_mbcnt_lo_u32_b32 %0, -1, 0\n\tv_mbcnt_hi_u32_b32 %0, -1, %0" : "=v"(l)); return l; }
struct Unit { const char* A; const char* B; void* p0; void* p1; void* p2; void* p3; int pm, pn, i0, i1, ghost; };

__device__ __forceinline__ int xcd_remap(int L, int nwg) { const int q = nwg / NXCD, r = nwg % NXCD, xcd = L % NXCD, off = L / NXCD; return __builtin_amdgcn_readfirstlane((xcd < r ? xcd * (q + 1) : r * (q + 1) + (xcd - r) * q) + off); }
__device__ __forceinline__ void grouped_mn(int wgid, int nM, int nN, int& pm, int& pn) {
    const int nig = WGM * nN, gid = wgid / nig, fm = gid * WGM, gsz = (nM - fm) < WGM ? (nM - fm) : WGM; pm = __builtin_amdgcn_readfirstlane(fm + ((wgid % nig) % gsz)); pn = __builtin_amdgcn_readfirstlane((wgid % nig) / gsz); }

template <class Epi, class Sched, int TABS, int REP = 1, int REPE = 1, bool F8 = false>
__device__ __forceinline__ void gemm_phase(const int wid, LAS unsigned char* lds, LAS unsigned char* epi_lds, LAS unsigned* gtab, const int lda_b, const int ldb_b, const int nt, const Sched& S, const Epi& E) {
    constexpr bool GATHER = (TABS == 1);
    const int wr = wid >> 2, wc = wid & 3;
    unsigned voffA, voffB, voffG[2][2]; int aoff, boff;
    { const int lane = fresh_lane(); int R, C; stage_rc(wid * 1024 + lane * 16, R, C); const int Rb = Epi::PERM ? ((R & ~31) + perm32(R & 31)) : R;
      voffA = (unsigned)(R * lda_b + C * 2); voffB = (unsigned)(Rb * ldb_b + C * 2); voffG[0][0] = voffG[0][1] = voffG[1][0] = voffG[1][1] = 0;
      aoff = lds_byte(wr * 64 + (lane & 15), (lane >> 4) * 8); boff = lds_byte(wc * 32 + (lane & 15), (lane >> 4) * 8); }
    const size_t kstep = (size_t)(BK * 2);
    const size_t hstepA = (size_t)HALF * lda_b, hstepB = (size_t)HALF * ldb_b;
    const unsigned ldsw = (unsigned)wid * 1024u; const unsigned ldsbase = (unsigned)(uintptr_t)lds + ldsw;
#define PG8_SA(b, h) (((b) * 2 + (h)) * HTB)
#define PG8_SB(b, h) ((4 + (b) * 2 + (h)) * HTB)
#define PG8_GLDS(ugp, voff, bufoff, _i) do { unsigned _keep; asm volatile("s_mov_b32 %0, m0\n\ts_mov_b32 m0, %3\n\ts_nop 0\n\tglobal_load_lds_dwordx4 %1, %2\n\ts_mov_b32 m0, %0" \
        : "=&s"(_keep) : "v"(voff), "s"((const char*)(ugp)), "s"(ldsbase + (unsigned)((bufoff) + (_i) * 8192)) : "memory"); } while (0)
#define PG8_STAGE_B(bufoff, gbase) do { _Pragma("unroll") for (int _i = 0; _i < 2; ++_i) PG8_GLDS((const char*)(gbase) + (size_t)_i * 64 * ldb_b, voffB, bufoff, _i); } while (0)
#define PG8_STAGE_A(bufoff, gbase, h) do { if constexpr (GATHER) { _Pragma("unroll") for (int _i = 0; _i < 2; ++_i) PG8_GLDS((const char*)(gbase), voffG[h][_i], bufoff, _i); } \
        else { _Pragma("unroll") for (int _i = 0; _i < 2; ++_i) PG8_GLDS((const char*)(gbase) + (h) * hstepA + (size_t)_i * 64 * lda_b, voffA, bufoff, _i); } } while (0)
#define PG8_LDA(dst, b, h) do { _Pragma("unroll") for (int m = 0; m < 4; ++m) _Pragma("unroll") for (int k = 0; k < 2; ++k) dst[m][k] = *(const LAS bf16x8*)(lds + PG8_SA(b, h) + aoff + m * 2048 + k * 1024); } while (0)
#define PG8_LDB(dst, b, h) do { _Pragma("unroll") for (int n = 0; n < 2; ++n) _Pragma("unroll") for (int k = 0; k < 2; ++k) dst[n][k] = *(const LAS bf16x8*)(lds + PG8_SB(b, h) + boff + n * 2048 + k * 1024); } while (0)
#define PG8_CAT(x0, x1) __builtin_shufflevector(__builtin_bit_cast(v4i_t, x0), __builtin_bit_cast(v4i_t, x1), 0, 1, 2, 3, 4, 5, 6, 7)
#define PG8_MMA(ai, bj, At, Bt) do { __builtin_amdgcn_s_setprio(1); _Pragma("unroll") for (int m = 0; m < 4; ++m) _Pragma("unroll") for (int n = 0; n < 2; ++n) { \
        if constexpr (F8) acc[ai][bj][m][n] = __builtin_amdgcn_mfma_scale_f32_16x16x128_f8f6f4(PG8_CAT(Bt[n][0], Bt[n][1]), PG8_CAT(At[m][0], At[m][1]), acc[ai][bj][m][n], 0, 0, 0, 0, 0, 0); \
        else { _Pragma("unroll") for (int k = 0; k < 2; ++k) acc[ai][bj][m][n] = __builtin_amdgcn_mfma_f32_16x16x32_bf16(Bt[n][k], At[m][k], acc[ai][bj][m][n], 0, 0, 0); } } __builtin_amdgcn_s_setprio(0); } while (0)
#define PG8_WAIT_V(n) asm volatile("s_waitcnt vmcnt(" #n ")" ::: "memory")
#define PG8_WAIT_L(n) asm volatile("s_waitcnt lgkmcnt(" #n ")" ::: "memory")
#define PG8_BAR __builtin_amdgcn_s_barrier()
#define PG8_SCHED __builtin_amdgcn_sched_barrier(0)
#define PG8_GTAB_LOAD(buf, nvalid) do { const int _l = fresh_lane(); int _R, _C; stage_rc(wid * 1024 + _l * 16, _R, _C); _Pragma("unroll") for (int _h = 0; _h < 2; ++_h) _Pragma("unroll") for (int _i = 0; _i < 2; ++_i) { \
        const int _row = _h * HALF + _R + 64 * _i; const unsigned _s = gtab[(buf) * 768 + _row]; voffG[_h][_i] = ((_row < (nvalid)) ? (_s >> 2) * (unsigned)lda_b : 0u) + (unsigned)(_C * 2); } } while (0)
#define PG8_GTAB_DMA(buf, U) do { if (wid < 3) { const int _l = fresh_lane(); const char* _src = (wid == 0) ? (const char*)(U).p3 + _l * 16 : (wid == 1) ? (const char*)(U).p2 + _l * 16 : \
            (TABS == 1 ? (const char*)(U).p1 + (_l & 31) * 16 + (_l >> 5) * (DFF * 4) : (const char*)(U).p1 + _l * 16); \
        __builtin_amdgcn_global_load_lds((const unsigned*)_src, (LAS unsigned*)(gtab + (buf) * 768 + wid * 256), 16, 0, 0); } } while (0)
    auto nextu = [&](int i, Unit& u) -> bool { if constexpr (REP > 1) { const bool ok = S.next(i / REP, u); u.ghost = (i % REP) != REP - 1; return ok; } else { u.ghost = 0; return S.next(i, u); } };
    Unit cur, nxt; int ui = 0;
    if (!nextu(0, cur)) return;
    f32x4 acc[2][2][4][2];
#pragma unroll
    for (int a = 0; a < 2; ++a)
#pragma unroll
        for (int b = 0; b < 2; ++b)
#pragma unroll
            for (int m = 0; m < 4; ++m)
#pragma unroll
                for (int n = 0; n < 2; ++n) acc[a][b][m][n] = (f32x4){0.f, 0.f, 0.f, 0.f};
    bf16x8 At[4][2], B0[2][2], B1[2][2];
    const char* cA = cur.A; const char* cB = cur.B;
    if constexpr (TABS != 0) { PG8_GTAB_DMA(0, cur); PG8_WAIT_V(0); PG8_WAIT_L(0); PG8_BAR; if constexpr (GATHER) PG8_GTAB_LOAD(0, cur.i0); }
    PG8_STAGE_B(PG8_SB(0, 0), cB); PG8_STAGE_B(PG8_SB(0, 1), cB + hstepB); PG8_STAGE_A(PG8_SA(0, 0), cA, 0); PG8_STAGE_A(PG8_SA(0, 1), cA, 1);
    if (wr == 1) PG8_BAR;
    PG8_WAIT_V(2); PG8_BAR;
    PG8_STAGE_B(PG8_SB(1, 0), cB + kstep); PG8_STAGE_A(PG8_SA(1, 0), cA + kstep, 0); PG8_STAGE_B(PG8_SB(1, 1), cB + hstepB + kstep);
    PG8_WAIT_V(6); PG8_BAR;
    for (;;) {
        const bool has_next = nextu(ui + 1, nxt);
        const char* nA = has_next ? nxt.A : cA; const char* nB = has_next ? nxt.B : cB;
#pragma unroll 1
        for (int t = 0; t < nt; t += 2) {
            const bool last = (t == nt - 2);
            const char* a1 = cA + (size_t)(t + 1) * kstep;
            const char* a2 = last ? nA : cA + (size_t)(t + 2) * kstep; const char* b2 = last ? nB : cB + (size_t)(t + 2) * kstep;
            const char* a3 = a2 + kstep; const char* b3 = b2 + kstep;
            if constexpr (Epi::MIDK >= 0) { if (t == Epi::MIDK) E.midk(acc, cur, wr, fresh_lane() & 15); }
            if constexpr (TABS != 0) { if (t == 2 && has_next) PG8_GTAB_DMA((ui + 1) & 1, nxt); }
            if constexpr (GATHER) { PG8_STAGE_A(PG8_SA(1, 1), a1, 1); if (last && has_next) PG8_GTAB_LOAD((ui + 1) & 1, nxt.i0); PG8_SCHED; }
            PG8_LDB(B0, 0, 0); PG8_LDB(B1, 0, 1); PG8_SCHED; PG8_LDA(At, 0, 0); if constexpr (!GATHER) PG8_STAGE_A(PG8_SA(1, 1), a1, 1);
            PG8_WAIT_V(8); PG8_WAIT_L(0); PG8_BAR; PG8_MMA(0, 0, At, B0); PG8_MMA(0, 1, At, B1); PG8_BAR; PG8_SCHED;
            PG8_LDA(At, 0, 1); PG8_STAGE_B(PG8_SB(0, 0), b2); PG8_STAGE_B(PG8_SB(0, 1), b2 + hstepB); PG8_STAGE_A(PG8_SA(0, 0), a2, 0);
            PG8_WAIT_V(8); PG8_WAIT_L(0); PG8_BAR; PG8_MMA(1, 0, At, B0); PG8_MMA(1, 1, At, B1); PG8_BAR; PG8_SCHED;
            PG8_LDB(B0, 1, 0); PG8_LDB(B1, 1, 1); PG8_SCHED; PG8_LDA(At, 1, 0); PG8_STAGE_A(PG8_SA(0, 1), a2, 1);
            PG8_WAIT_V(8); PG8_WAIT_L(0); PG8_BAR; PG8_MMA(0, 0, At, B0); PG8_MMA(0, 1, At, B1); PG8_BAR; PG8_SCHED;
            PG8_LDA(At, 1, 1); PG8_STAGE_B(PG8_SB(1, 0), b3); PG8_STAGE_B(PG8_SB(1, 1), b3 + hstepB); PG8_STAGE_A(PG8_SA(1, 0), a3, 0);
            PG8_WAIT_V(8); PG8_WAIT_L(0); PG8_BAR; PG8_MMA(1, 0, At, B0); PG8_MMA(1, 1, At, B1); PG8_BAR; PG8_SCHED;
        }
        if (wr == 0) PG8_BAR;
        if (!cur.ghost) { const int el = fresh_lane(); LAS unsigned char* ex = (TABS != 0) ? (LAS unsigned char*)(gtab + (ui & 1) * 768) : epi_lds; E(acc, cur, wr, wc, el & 15, el >> 4, wid, el, ex); if constexpr (REPE > 1) { asm volatile("" ::: "memory"); E(acc, cur, wr, wc, el & 15, el >> 4, wid, el, ex); } }
        if (!has_next) break;
#pragma unroll
        for (int a = 0; a < 2; ++a)
#pragma unroll
            for (int b = 0; b < 2; ++b)
#pragma unroll
                for (int m = 0; m < 4; ++m)
#pragma unroll
                    for (int n = 0; n < 2; ++n) acc[a][b][m][n] = (f32x4){0.f, 0.f, 0.f, 0.f};
        cur = nxt; cA = nA; cB = nB; ++ui;
        if (wr == 1) PG8_BAR;
    }
    PG8_WAIT_V(0);
    PG8_BAR;
#undef PG8_SA
#undef PG8_SB
#undef PG8_GLDS
#undef PG8_STAGE_A
#undef PG8_STAGE_B
#undef PG8_LDA
#undef PG8_LDB
#undef PG8_MMA
#undef PG8_CAT
#undef PG8_WAIT_V
#undef PG8_WAIT_L
#undef PG8_BAR
#undef PG8_SCHED
#undef PG8_GTAB_LOAD
#undef PG8_GTAB_DMA
}

struct EpiBf16S {
    static constexpr bool PERM = true; static constexpr int MIDK = -1;
    __device__ __forceinline__ void midk(f32x4 (&)[2][2][4][2], const Unit&, int, int) const {}
    __device__ __forceinline__ void operator()(const f32x4 (&acc)[2][2][4][2], const Unit& u, int wr, int wc, int fr, int fq, int, int, LAS unsigned char*) const {
        bf16_t* O = (bf16_t*)u.p0; const float* rs = (const float*)u.p1; const float* cs = (const float*)u.p2; const int ldc = u.i0;
        int r0 = wr * 64 + fr, c0 = wc * 32 + 8 * fq; asm volatile("" : "+v"(r0), "+v"(c0));
        f32x4 cv[2][2];
#pragma unroll
        for (int bj = 0; bj < 2; ++bj)
#pragma unroll
            for (int n = 0; n < 2; ++n) cv[bj][n] = cs ? *(const f32x4*)(cs + c0 + bj * HALF + 4 * n) : (f32x4){1.f, 1.f, 1.f, 1.f};
#pragma unroll
        for (int ai = 0; ai < 2; ++ai)
#pragma unroll
            for (int m = 0; m < 4; ++m) { const int r = r0 + ai * HALF + m * 16; const float rv = rs ? rs[r] : 1.f; bf16_t* rowp = O + (size_t)r * ldc + c0;
#pragma unroll
                for (int bj = 0; bj < 2; ++bj) { const f32x4 v0 = acc[ai][bj][m][0] * cv[bj][0] * rv, v1 = acc[ai][bj][m][1] * cv[bj][1] * rv;
                    u32x4 w; w.x = cvt_pk_bf16(v0[0], v0[1]); w.y = cvt_pk_bf16(v0[2], v0[3]); w.z = cvt_pk_bf16(v1[0], v1[1]); w.w = cvt_pk_bf16(v1[2], v1[3]);
                    st16<1>(rowp + bj * HALF, w); } }
    }
};
}

namespace mk {
constexpr int NWAVES = 8, NPHASE = 12;
constexpr int RING_OFF = 0, RING_BYTES = 131072, EPI_OFF = 131072, EPI_BYTES = 8192, GTAB_OFF = EPI_OFF + EPI_BYTES, GTAB_BYTES = 6144, MISC_OFF = GTAB_OFF + GTAB_BYTES, MISC_BYTES = 1024;
constexpr int LDS_BYTES = 147456;
static_assert(MISC_OFF + MISC_BYTES <= LDS_BYTES, "LDS map");
constexpr size_t WS_LRS = 84 * MiB;
constexpr size_t WS_X2F8 = WS_Y;
constexpr size_t WS_CSG1 = 19 * MiB, WS_WRH = 19 * MiB + 64 * 1024, WS_WRL = 19 * MiB + 128 * 1024;
constexpr float WSCALE = 32.0f;
constexpr int CW_BAR = 1024;

#define RLX_AGENT __ATOMIC_RELAXED, __HIP_MEMORY_SCOPE_AGENT
#define LDS_WAIT() asm volatile("s_waitcnt lgkmcnt(0)" ::: "memory")
#define VM_WAIT() asm volatile("s_waitcnt vmcnt(0)" ::: "memory")
#define XB_TMO      128
#define XB_XCNT(j)  (256  + 64 * (j))
#define XB_XSUB(j)  (1280 + 64 * (j))
#define XB_XGEN(j)  (2304 + 64 * (j))
#define XB_TOP      3328
#define XB_TOPGEN   3392
#define XCD_BAR_WORDS 3456
#define XB_SPIN_CAP (1u << 20)
__device__ __forceinline__ unsigned xb_ld(unsigned* p)              { return __hip_atomic_load(p, __ATOMIC_RELAXED, __HIP_MEMORY_SCOPE_AGENT); }
__device__ __forceinline__ unsigned xb_add(unsigned* p, unsigned v) { return __hip_atomic_fetch_add(p, v, __ATOMIC_RELAXED, __HIP_MEMORY_SCOPE_AGENT); }
__device__ __forceinline__ unsigned xb_xcc_id() { return (unsigned)__builtin_amdgcn_s_getreg((3 << 11) | 20) & 0xFu; }
#define XB_SPIN(cond, bar) do { unsigned _sp = 0; while (cond) { __builtin_amdgcn_s_sleep(1); \
    if ((++_sp & 255u) == 0u) { if (xb_ld(&(bar)[XB_TMO])) break; if (_sp > XB_SPIN_CAP) { atomicAdd(&(bar)[XB_TMO], 1u); break; } } } } while (0)
struct XcdBarrier { unsigned* bar; unsigned x; volatile LAS unsigned* st; };
__device__ __forceinline__ XcdBarrier xcd_barrier_post(unsigned* bar, volatile LAS unsigned* st) {
    XcdBarrier b; b.bar = bar; b.x = xb_xcc_id(); b.st = st;
    if (threadIdx.x == 0) (void)xb_add(&bar[XB_XCNT(b.x)], 1u);
    return b;
}
__device__ __forceinline__ void xcd_barrier_complete(unsigned* bar, unsigned x, unsigned& nloc, unsigned& nx) {
    const unsigned G = gridDim.x * gridDim.y * gridDim.z;
    unsigned sum, cnt, mine, sp = 0u;
    for (;;) {
        sum = 0u; cnt = 0u; mine = 0u;
#pragma unroll
        for (unsigned j = 0; j < 16; ++j) { const unsigned c = xb_ld(&bar[XB_XCNT(j)]); sum += c; cnt += (c > 0u) ? 1u : 0u; mine = (j == x) ? c : mine; }
        if (sum == G) break;
        __builtin_amdgcn_s_sleep(1);
        if ((++sp & 255u) == 0u) { if (xb_ld(&bar[XB_TMO])) break; if (sp > XB_SPIN_CAP) { atomicAdd(&bar[XB_TMO], 1u); break; } }
    }
    nloc = mine > 0u ? mine : 1u; nx = cnt > 0u ? cnt : 1u;
}
__device__ __forceinline__ void xcd_barrier(const XcdBarrier& b) {
    asm volatile("s_waitcnt vmcnt(0)" ::: "memory");
    __syncthreads();
    if (threadIdx.x == 0) {
        unsigned* bar = b.bar;
        __builtin_amdgcn_s_waitcnt(0);
        unsigned nloc = b.st[0], nx = b.st[1];
        if (nloc == 0u) { xcd_barrier_complete(bar, b.x, nloc, nx); b.st[0] = nloc; b.st[1] = nx; }
        const unsigned old = xb_add(&bar[XB_XSUB(b.x)], 1u);
        const unsigned gen = old / nloc;
        if (old + 1u == (gen + 1u) * nloc) {
            __builtin_amdgcn_fence(__ATOMIC_RELEASE, "agent");
            asm volatile("s_waitcnt vmcnt(0)" ::: "memory");
            const unsigned og = xb_add(&bar[XB_TOP], 1u);
            const unsigned tg = og / nx;
            if (og + 1u == (tg + 1u) * nx) xb_add(&bar[XB_TOPGEN], 1u);
            else XB_SPIN(xb_ld(&bar[XB_TOPGEN]) == tg, bar);
            __builtin_amdgcn_fence(__ATOMIC_ACQUIRE, "agent");
            xb_add(&bar[XB_XGEN(b.x)], 1u);
            asm volatile("s_waitcnt vmcnt(0)" ::: "memory");
        } else {
            XB_SPIN(xb_ld(&bar[XB_XGEN(b.x)]) == gen, bar);
            __builtin_amdgcn_fence(__ATOMIC_ACQUIRE, "agent");
            asm volatile("s_waitcnt vmcnt(0)" ::: "memory");
        }
    }
    __syncthreads();
}

struct Args { const float* in[22]; float* out; unsigned char* ws; int ph_lo, ph_hi, li, pad; };

template <bool F8OUT>
__device__ __forceinline__ void p0_item(const float* W, int K, int N, void* WTv, const float* gk, const float* gk2, int ksplit, const float* gn, int mode, LAS float* scr, int item, int lane, float mult = 1.0f) {
    const int nblk = N / 32, kb = item / nblk, nb = item % nblk, k0 = 64 * kb, nd0 = 32 * nb;
    int ns0 = nd0; if (mode == 1) { const int pn = nd0 >> 8, j = nd0 & 255; ns0 = (j < 128) ? 128 * pn + j : 1024 + 128 * pn + (j - 128); }
    const int kr = lane >> 3, n4 = (lane & 7) * 4;
    f32x4 v[8];
#pragma unroll
    for (int i = 0; i < 8; ++i) v[i] = *(const f32x4*)(W + (size_t)(k0 + 8 * i + kr) * N + ns0 + n4);
    f32x4 gnv = (f32x4){1.f, 1.f, 1.f, 1.f}; if (gn) gnv = *(const f32x4*)(gn + ns0 + n4);
#pragma unroll
    for (int i = 0; i < 8; ++i) { const int kk = 8 * i + kr, k = k0 + kk; float g = 1.f; if (gk) g = (k < ksplit) ? gk[k] : gk2[k - ksplit];
        const f32x4 t = v[i] * gnv * (g * mult); LAS float* d = scr + kk * 33 + n4; d[0] = t[0]; d[1] = t[1]; d[2] = t[2]; d[3] = t[3]; }
    LDS_WAIT(); asm volatile("" ::: "memory");
    const int c = lane & 7;
#pragma unroll
    for (int j = 0; j < 4; ++j) { const int n = (lane >> 3) + 8 * j; const LAS float* s = scr + (8 * c) * 33 + n;
        if constexpr (F8OUT) { int lo = __builtin_amdgcn_cvt_pk_fp8_f32(s[0 * 33], s[1 * 33], 0, false); lo = __builtin_amdgcn_cvt_pk_fp8_f32(s[2 * 33], s[3 * 33], lo, true);
            int hi2 = __builtin_amdgcn_cvt_pk_fp8_f32(s[4 * 33], s[5 * 33], 0, false); hi2 = __builtin_amdgcn_cvt_pk_fp8_f32(s[6 * 33], s[7 * 33], hi2, true);
            pg8::st8_wt((unsigned char*)WTv + (size_t)(nd0 + n) * K + k0 + 8 * c, (unsigned long long)(unsigned)lo | ((unsigned long long)(unsigned)hi2 << 32)); }
        else { u32x4 o; o.x = pg8::cvt_pk_bf16(s[0 * 33], s[1 * 33]); o.y = pg8::cvt_pk_bf16(s[2 * 33], s[3 * 33]); o.z = pg8::cvt_pk_bf16(s[4 * 33], s[5 * 33]); o.w = pg8::cvt_pk_bf16(s[6 * 33], s[7 * 33]);
            pg8::st16<0>((bf16_t*)WTv + (size_t)(nd0 + n) * K + k0 + 8 * c, o); } }
    LDS_WAIT(); asm volatile("" ::: "memory");
}
__device__ __forceinline__ void p0_row(const float* xrow, bf16_t* orow, float* rstd, int lane) {
    const f32x4* xr = (const f32x4*)xrow + 2 * lane; f32x4 v[4]; float s = 0.f;
#pragma unroll
    for (int j = 0; j < 4; ++j) { v[j] = xr[(j >> 1) * 128 + (j & 1)]; s += (v[j].x * v[j].x + v[j].y * v[j].y) + (v[j].z * v[j].z + v[j].w * v[j].w); }
    s = wave_sum(s); if (lane == 0) *rstd = 1.0f / sqrtf(s * (1.0f / D) + EPS);
#pragma unroll
    for (int j = 0; j < 2; ++j) { u32x4 o; o.x = pg8::cvt_pk_bf16(v[2 * j].x, v[2 * j].y); o.y = pg8::cvt_pk_bf16(v[2 * j].z, v[2 * j].w); o.z = pg8::cvt_pk_bf16(v[2 * j + 1].x, v[2 * j + 1].y); o.w = pg8::cvt_pk_bf16(v[2 * j + 1].z, v[2 * j + 1].w);
        pg8::st16<0>(orow + j * 512 + 8 * lane, o); }
}
__device__ __forceinline__ void p0_prologue(const Args& a, LAS unsigned char* lds, int vcu, int G, int wave, int lane) {
    unsigned char* ws = a.ws;
    LAS float* scr = (LAS float*)(lds + RING_OFF + wave * 16384);
    const int gw = vcu * NWAVES + wave, NGW = G * NWAVES;
    constexpr int I_E1 = (D / 64) * (2 * DFF / 32), I_E2 = (DFF / 64) * (D / 32);
    constexpr int I_IN = (D / 64) * (INP / 32), I_SQ = (D / 64) * (D / 32), I_KV = (D / 64) * (2 * D / 32), I_P = (PGD / 64) * (PGD / 32);
    constexpr int N1 = NE * I_E1, N2 = NE * I_E2, NITEMS = N1 + N2 + I_IN + 3 * I_SQ + I_KV + PG * I_P;
    const int BIG = 1 << 30;
    for (int it = gw; it < NITEMS; it += NGW) {
        int r = it;
        if (r < N1) { const int e = r / I_E1; p0_item<true>(a.in[17] + (size_t)e * D * 2 * DFF, D, 2 * DFF, ws + WS_W1 + (size_t)e * 2 * DFF * D, a.in[14], nullptr, BIG, nullptr, 1, scr, r % I_E1, lane, WSCALE); continue; } r -= N1;
        if (r < N2) { const int e = r / I_E2; p0_item<true>(a.in[19] + (size_t)e * DFF * D, DFF, D, ws + WS_W2 + (size_t)e * D * DFF, nullptr, nullptr, BIG, nullptr, 0, scr, r % I_E2, lane, WSCALE); continue; } r -= N2;
        if (r < I_IN) { p0_item<false>(a.in[3], D, INP, (bf16_t*)(ws + WS_WIN), a.in[2], nullptr, BIG, nullptr, 0, scr, r, lane); continue; } r -= I_IN;
        if (r < I_SQ) { p0_item<false>(a.in[8], D, D, (bf16_t*)(ws + WS_WOUT), a.in[4], a.in[5], SBW, nullptr, 0, scr, r, lane); continue; } r -= I_SQ;
        if (r < I_SQ) { p0_item<false>(a.in[11], D, D, (bf16_t*)(ws + WS_WQ), a.in[9], nullptr, BIG, nullptr, 0, scr, r, lane); continue; } r -= I_SQ;
        if (r < I_KV) { p0_item<false>(a.in[12], D, 2 * D, (bf16_t*)(ws + WS_WKV), a.in[10], nullptr, BIG, nullptr, 0, scr, r, lane); continue; } r -= I_KV;
        if (r < I_SQ) { p0_item<false>(a.in[13], D, D, (bf16_t*)(ws + WS_WO), nullptr, nullptr, BIG, nullptr, 0, scr, r, lane); continue; } r -= I_SQ;
        { const int g = r / I_P; p0_item<false>(a.in[6] + (size_t)g * PGD * PGD, PGD, PGD, (bf16_t*)(ws + WS_WP) + (size_t)g * PGD * PGD, nullptr, nullptr, BIG, a.in[7] + g * PGD, 0, scr, r % I_P, lane); }
    }
    for (int m = gw; m < NTOK; m += NGW) p0_row(a.in[0] + (size_t)m * D, (bf16_t*)(ws + WS_S0) + (size_t)m * D, (float*)(ws + WS_RSTDX) + m, lane);
    for (int m = gw; m < NMROWS; m += NGW) p0_row(a.in[1] + (size_t)m * D, (bf16_t*)(ws + WS_MEMB) + (size_t)m * D, (float*)(ws + WS_RSTDM) + m, lane);
    const int gt = gw * 64 + lane, NGT = NGW * 64;
    for (int i = gt; i < INP; i += NGT) ((float*)(ws + WS_CSG1))[i] = (i < SBW) ? C2_SB : 1.0f;
    for (int i = gt; i < NE * D; i += NGT) { const int e = i / D, k = i % D; const float v = a.in[14][k] * a.in[15][k * NE + e];
        ((float*)(ws + WS_WR))[i] = v; const unsigned h = f2bf(v); ((bf16_t*)(ws + WS_WRH))[i] = (bf16_t)h; ((bf16_t*)(ws + WS_WRL))[i] = (bf16_t)f2bf(v - bf2f((bf16_t)h)); }
}

struct SchedP1 {
    int G, c; unsigned char* ws;
    __device__ __forceinline__ bool next(int i, pg8::Unit& u) const {
        const int L = i * G + c; constexpr int NQ = (NTOK / 256) * (INP / 256);
        if (L >= NQ + 64) return false;
        if (L < NQ) { int pm, pn; pg8::grouped_mn(pg8::xcd_remap(L, NQ), NTOK / 256, INP / 256, pm, pn);
            u.A = (const char*)(ws + WS_S0) + (size_t)pm * 256 * D * 2; u.B = (const char*)(ws + WS_WIN) + (size_t)pn * 256 * D * 2;
            u.p0 = (bf16_t*)(ws + WS_QKVU) + (size_t)pm * 256 * INP + pn * 256; u.p1 = (float*)(ws + WS_RSTDX) + pm * 256; u.p2 = (float*)(ws + WS_CSG1) + pn * 256; u.i0 = INP; u.pm = pm; u.pn = pn; }
        else if (L < NQ + 32) { const int k = L - NQ, pm = k >> 2, pn = k & 3;
            u.A = (const char*)(ws + WS_MEMB) + (size_t)pm * 256 * D * 2; u.B = (const char*)(ws + WS_WKV) + (size_t)pn * 256 * D * 2;
            u.p0 = (bf16_t*)(ws + WS_KM) + (size_t)pm * 256 * D + pn * 256; u.p1 = (float*)(ws + WS_RSTDM) + pm * 256; u.p2 = nullptr; u.i0 = D; u.pm = pm; u.pn = pn; }
        else { const int v = L - NQ - 32, b = v >> 2, dt = v & 3;
            u.A = (const char*)(ws + WS_WKV) + (size_t)(D + dt * 256) * D * 2; u.B = (const char*)(ws + WS_MEMB) + (size_t)b * 256 * D * 2;
            u.p0 = (bf16_t*)(ws + WS_VMT) + ((size_t)b * D + dt * 256) * NMEM; u.p1 = nullptr; u.p2 = (float*)(ws + WS_RSTDM) + b * 256; u.i0 = NMEM; u.pm = dt; u.pn = b; }
        u.p3 = nullptr; u.i1 = 0; return true;
    }
};
#define EPI_BAR() asm volatile("s_waitcnt lgkmcnt(0)\n\ts_barrier" ::: "memory")
struct SchedReg {
    int G, c, nM, nN; const char* A; const char* B; size_t astep, bstep; bf16_t* O; int ldc; const float* rs; const float* cs;
    __device__ __forceinline__ bool next(int i, pg8::Unit& u) const {
        const int L = i * G + c; if (L >= nM * nN) return false; int pm, pn; pg8::grouped_mn(pg8::xcd_remap(L, nM * nN), nM, nN, pm, pn);
        u.A = A + (size_t)pm * astep; u.B = B + (size_t)pn * bstep; u.pm = pm; u.pn = pn; u.i0 = ldc; u.i1 = 0;
        u.p0 = O ? (void*)(O + (size_t)pm * 256 * ldc + pn * 256) : nullptr; u.p1 = rs ? (void*)(rs + pm * 256) : nullptr; u.p2 = cs ? (void*)(cs + pn * 256) : nullptr; u.p3 = nullptr; return true;
    }
};
struct EpiBf16Ssq {
    static constexpr bool PERM = true; static constexpr int MIDK = -1; float inv_n, mult;
    __device__ __forceinline__ void midk(f32x4 (&)[2][2][4][2], const pg8::Unit&, int, int) const {}
    __device__ __forceinline__ void operator()(f32x4 (&acc)[2][2][4][2], const pg8::Unit& u, int wr, int wc, int fr, int fq, int, int, LAS unsigned char*) const {
        bf16_t* O = (bf16_t*)u.p0; const float* sq = (const float*)u.p1; const int ldc = u.i0; int r0 = wr * 64 + fr, c0 = wc * 32 + 8 * fq; asm volatile("" : "+v"(r0), "+v"(c0));
#pragma unroll
        for (int ai = 0; ai < 2; ++ai)
#pragma unroll
            for (int m = 0; m < 4; ++m) { const int r = r0 + ai * 128 + m * 16; const float rv = mult / sqrtf(sq[r] * inv_n + EPS); bf16_t* rowp = O + (size_t)r * ldc + c0;
#pragma unroll
                for (int bj = 0; bj < 2; ++bj) { const f32x4 v0 = acc[ai][bj][m][0] * rv, v1 = acc[ai][bj][m][1] * rv;
                    u32x4 w; w.x = pg8::cvt_pk_bf16(v0[0], v0[1]); w.y = pg8::cvt_pk_bf16(v0[2], v0[3]); w.z = pg8::cvt_pk_bf16(v1[0], v1[1]); w.w = pg8::cvt_pk_bf16(v1[2], v1[3]);
                    pg8::st16<5>(rowp + bj * 128, w); } }
    }
};
template <int MIDK_, bool XIN_BF16, bool F8OUT> struct EpiResid {
    static constexpr bool PERM = true; static constexpr int MIDK = MIDK_;
    const float* xin; bf16_t* xb; unsigned char* x8; float* ssq; const float* ssq_mid;
    __device__ __forceinline__ void midk(f32x4 (&acc)[2][2][4][2], const pg8::Unit& u, int wr, int fr) const {
#pragma unroll
        for (int ai = 0; ai < 2; ++ai)
#pragma unroll
            for (int m = 0; m < 4; ++m) { const int r = u.pm * 256 + ai * 128 + wr * 64 + m * 16 + fr; const float s = 1.0f / sqrtf(ssq_mid[r] * (1.0f / SBW) + EPS);
#pragma unroll
                for (int bj = 0; bj < 2; ++bj)
#pragma unroll
                    for (int n = 0; n < 2; ++n) acc[ai][bj][m][n] *= s; }
    }
    __device__ __forceinline__ void operator()(f32x4 (&acc)[2][2][4][2], const pg8::Unit& u, int wr, int wc, int fr, int fq, int, int, LAS unsigned char*) const {
        int row0 = u.pm * 256 + wr * 64 + fr, col0 = u.pn * 256 + wc * 32 + 8 * fq; asm volatile("" : "+v"(row0), "+v"(col0));
#pragma unroll
        for (int ai = 0; ai < 2; ++ai)
#pragma unroll
            for (int m = 0; m < 4; ++m) { const int r = row0 + ai * 128 + m * 16; const size_t off = (size_t)r * D + col0; float q = 0.f;
#pragma unroll
                for (int bj = 0; bj < 2; ++bj) { const size_t o2 = off + bj * 128; f32x4 o0, o1;
                    if constexpr (XIN_BF16) { const u32x4 xv = *(const u32x4*)(xb + o2);
                        o0 = (f32x4){__builtin_bit_cast(float, xv.x << 16), __builtin_bit_cast(float, xv.x & 0xffff0000u), __builtin_bit_cast(float, xv.y << 16), __builtin_bit_cast(float, xv.y & 0xffff0000u)};
                        o1 = (f32x4){__builtin_bit_cast(float, xv.z << 16), __builtin_bit_cast(float, xv.z & 0xffff0000u), __builtin_bit_cast(float, xv.w << 16), __builtin_bit_cast(float, xv.w & 0xffff0000u)}; }
                    else { o0 = *(const f32x4*)(xin + o2); o1 = *(const f32x4*)(xin + o2 + 4); }
                    o0 += acc[ai][bj][m][0]; o1 += acc[ai][bj][m][1];
                    q += (o0[0] * o0[0] + o0[1] * o0[1]) + (o0[2] * o0[2] + o0[3] * o0[3]) + (o1[0] * o1[0] + o1[1] * o1[1]) + (o1[2] * o1[2] + o1[3] * o1[3]);
                    if constexpr (F8OUT) { int w0 = __builtin_amdgcn_cvt_pk_fp8_f32(o0[0], o0[1], 0, false); w0 = __builtin_amdgcn_cvt_pk_fp8_f32(o0[2], o0[3], w0, true);
                        int w1 = __builtin_amdgcn_cvt_pk_fp8_f32(o1[0], o1[1], 0, false); w1 = __builtin_amdgcn_cvt_pk_fp8_f32(o1[2], o1[3], w1, true);
                        pg8::st8_wt(x8 + o2, (unsigned long long)(unsigned)w0 | ((unsigned long long)(unsigned)w1 << 32)); }
                    u32x4 w; w.x = pg8::cvt_pk_bf16(o0[0], o0[1]); w.y = pg8::cvt_pk_bf16(o0[2], o0[3]); w.z = pg8::cvt_pk_bf16(o1[0], o1[1]); w.w = pg8::cvt_pk_bf16(o1[2], o1[3]); pg8::st16<4>(xb + o2, w); }
                q += __shfl_xor(q, 16); q += __shfl_xor(q, 32);
                if (fq == 0) unsafeAtomicAdd(ssq + r, q);
                if (m & 1) asm volatile("" ::: "memory"); }
    }
};
struct SchedMS {
    int G, c; unsigned char* ws;
    __device__ __forceinline__ bool next(int i, pg8::Unit& u) const {
        const int L = i * G + c; constexpr int NU = (NTOK / 256) * MH; if (L >= NU) return false; const int w = pg8::xcd_remap(L, NU), pm = w >> 2, h = w & 3, b = pm >> 4;
        u.A = (const char*)(ws + WS_QM) + ((size_t)pm * 256 * D + h * MHD) * 2; u.B = (const char*)(ws + WS_KM) + ((size_t)b * NMEM * D + h * MHD) * 2;
        u.p0 = (bf16_t*)(ws + WS_PM) + (size_t)pm * 256 * D + h * NMEM; u.p1 = nullptr; u.p2 = nullptr; u.p3 = nullptr; u.i0 = D; u.i1 = 0; u.pm = pm; u.pn = h; return true;
    }
};
struct EpiSoftmax {
    static constexpr bool PERM = true; static constexpr int MIDK = -1;
    __device__ __forceinline__ void midk(f32x4 (&)[2][2][4][2], const pg8::Unit&, int, int) const {}
    __device__ __forceinline__ void operator()(f32x4 (&acc)[2][2][4][2], const pg8::Unit& u, int wr, int wc, int fr, int fq, int, int, LAS unsigned char* xl) const {
        typedef float f32x2v __attribute__((ext_vector_type(2)));
        LAS f32x2v* X = (LAS f32x2v*)xl;
        float ml[2][4];
#pragma unroll
        for (int ai = 0; ai < 2; ++ai)
#pragma unroll
            for (int m = 0; m < 4; ++m) { float mx = -INFINITY;
#pragma unroll
                for (int bj = 0; bj < 2; ++bj)
#pragma unroll
                    for (int n = 0; n < 2; ++n) { const f32x4 v = acc[ai][bj][m][n]; mx = fmaxf(fmaxf(mx, fmaxf(v[0], v[1])), fmaxf(v[2], v[3])); }
                mx = fmaxf(mx, __shfl_xor(mx, 16)); mx = fmaxf(mx, __shfl_xor(mx, 32)); ml[ai][m] = mx; float s = 0.f;
#pragma unroll
                for (int bj = 0; bj < 2; ++bj)
#pragma unroll
                    for (int n = 0; n < 2; ++n) { f32x4 v = acc[ai][bj][m][n];
#pragma unroll
                        for (int j = 0; j < 4; ++j) { v[j] = __builtin_amdgcn_exp2f(v[j] - mx); s += v[j]; }
                        acc[ai][bj][m][n] = v; }
                s += __shfl_xor(s, 16); s += __shfl_xor(s, 32);
                if (fq == 0) X[(ai * 128 + wr * 64 + m * 16 + fr) * 4 + wc] = (f32x2v){mx, s}; }
        EPI_BAR();
        bf16_t* O = (bf16_t*)u.p0; const int ldc = u.i0; int r0 = wr * 64 + fr, c0 = wc * 32 + 8 * fq; asm volatile("" : "+v"(r0), "+v"(c0));
#pragma unroll
        for (int ai = 0; ai < 2; ++ai)
#pragma unroll
            for (int m = 0; m < 4; ++m) { const int r = r0 + ai * 128 + m * 16; const f32x2v a = X[r * 4 + 0], b = X[r * 4 + 1], c = X[r * 4 + 2], d = X[r * 4 + 3];
                const float M = fmaxf(fmaxf(a.x, b.x), fmaxf(c.x, d.x));
                const float tot = a.y * __builtin_amdgcn_exp2f(a.x - M) + b.y * __builtin_amdgcn_exp2f(b.x - M) + c.y * __builtin_amdgcn_exp2f(c.x - M) + d.y * __builtin_amdgcn_exp2f(d.x - M);
                const float f = __builtin_amdgcn_exp2f(ml[ai][m] - M) / tot; bf16_t* rowp = O + (size_t)r * ldc + c0;
#pragma unroll
                for (int bj = 0; bj < 2; ++bj) { const f32x4 v0 = acc[ai][bj][m][0] * f, v1 = acc[ai][bj][m][1] * f;
                    u32x4 w; w.x = pg8::cvt_pk_bf16(v0[0], v0[1]); w.y = pg8::cvt_pk_bf16(v0[2], v0[3]); w.z = pg8::cvt_pk_bf16(v1[0], v1[1]); w.w = pg8::cvt_pk_bf16(v1[2], v1[3]);
                    pg8::st16<6>(rowp + bj * 128, w); } }
    }
};
struct SchedPV {
    int G, c; unsigned char* ws;
    __device__ __forceinline__ bool next(int i, pg8::Unit& u) const {
        const int L = i * G + c; constexpr int NU = (NTOK / 256) * MH; if (L >= NU) return false; const int w = pg8::xcd_remap(L, NU), pm = w >> 2, h = w & 3, b = pm >> 4;
        u.A = (const char*)(ws + WS_PM) + ((size_t)pm * 256 * D + h * NMEM) * 2; u.B = (const char*)(ws + WS_VMT) + ((size_t)b * D + h * MHD) * NMEM * 2;
        u.p0 = (bf16_t*)(ws + WS_OM) + (size_t)pm * 256 * D + h * MHD; u.p1 = nullptr; u.p2 = nullptr; u.p3 = nullptr; u.i0 = D; u.i1 = 0; u.pm = pm; u.pn = h; return true;
    }
};

__device__ __forceinline__ void p8_route(const Args& a, LAS unsigned char* lds, int bx, int G, int wave, int lane, int* CNT) {
    unsigned char* ws = a.ws; const bf16_t* x2 = (const bf16_t*)(ws + WS_S0); const float* SSQ2 = (const float*)(ws + OFF_SSQ2); const float* br = a.in[16];
    const bf16_t* WRH = (const bf16_t*)(ws + WS_WRH); const bf16_t* WRL = (const bf16_t*)(ws + WS_WRL);
    int* LSLOT = (int*)(ws + WS_LSLOT); float* LGATE = (float*)(ws + WS_LGATE); float* LRS = (float*)(ws + WS_LRS);
    LAS float* LG = (LAS float*)(lds + RING_OFF) + wave * 16 * 33;
    LAS int* hist = (LAS int*)(lds + RING_OFF + 32768); LAS int* base = hist + 32;
    const int tid = wave * 64 + lane;
    for (int t0 = bx * 128; t0 < NTOK; t0 += G * 128) {
        if (tid < 32) hist[tid] = 0;
        const int r16 = lane & 15, kq = lane >> 4; const int trow = t0 + wave * 16 + r16;
        const bf16_t* xp = x2 + (size_t)trow * D + kq * 8;
        f32x4 acc[2] = {(f32x4){0.f, 0.f, 0.f, 0.f}, (f32x4){0.f, 0.f, 0.f, 0.f}};
#pragma unroll 8
        for (int ks = 0; ks < 32; ++ks) {
            const bf16x8 ah = *(const bf16x8*)(xp + ks * 32);
#pragma unroll
            for (int nb = 0; nb < 2; ++nb) { const size_t wo = (size_t)(nb * 16 + r16) * D + ks * 32 + kq * 8;
                const bf16x8 bh = *(const bf16x8*)(WRH + wo), bl = *(const bf16x8*)(WRL + wo);
                acc[nb] = __builtin_amdgcn_mfma_f32_16x16x32_bf16(ah, bh, acc[nb], 0, 0, 0);
                acc[nb] = __builtin_amdgcn_mfma_f32_16x16x32_bf16(ah, bl, acc[nb], 0, 0, 0); }
        }
#pragma unroll
        for (int nb = 0; nb < 2; ++nb)
#pragma unroll
            for (int r = 0; r < 4; ++r) { const int tl = kq * 4 + r; const int tk = t0 + wave * 16 + tl; const float rs = 1.0f / sqrtf(SSQ2[tk] * (1.0f / D) + EPS);
                LG[tl * 33 + nb * 16 + r16] = acc[nb][r] * rs + br[nb * 16 + r16]; }
        LDS_WAIT(); __syncthreads();
        int te[4] = {0, 0, 0, 0}; float tg[4] = {0.f, 0.f, 0.f, 0.f}; int rk[4] = {0, 0, 0, 0};
        if (lane < 16) {
            float tv[4] = {-INFINITY, -INFINITY, -INFINITY, -INFINITY};
            for (int e = 0; e < NE; ++e) { const float v = LG[lane * 33 + e];
                if (v > tv[3]) { if (v > tv[2]) { tv[3] = tv[2]; te[3] = te[2]; if (v > tv[1]) { tv[2] = tv[1]; te[2] = te[1]; if (v > tv[0]) { tv[1] = tv[0]; te[1] = te[0]; tv[0] = v; te[0] = e; } else { tv[1] = v; te[1] = e; } } else { tv[2] = v; te[2] = e; } } else { tv[3] = v; te[3] = e; } } }
            float gs = 0.f;
#pragma unroll
            for (int k = 0; k < 4; ++k) { tg[k] = __expf(tv[k] - tv[0]); gs += tg[k]; }
            gs = 1.0f / gs;
#pragma unroll
            for (int k = 0; k < 4; ++k) { tg[k] *= gs; rk[k] = __hip_atomic_fetch_add(hist + te[k], 1, __ATOMIC_RELAXED, __HIP_MEMORY_SCOPE_WORKGROUP); }
        }
        LDS_WAIT(); __syncthreads();
        if (tid < 32) { const int n = hist[tid]; base[tid] = n ? atomicAdd(CNT + tid, n) : 0; }
        LDS_WAIT(); __syncthreads();
        if (lane < 16) { const int tk = t0 + wave * 16 + lane; const float rsw = (1.0f / WSCALE) / sqrtf(SSQ2[tk] * (1.0f / D) + EPS);
#pragma unroll
            for (int k = 0; k < 4; ++k) { const size_t p = (size_t)te[k] * LCAP + base[te[k]] + rk[k]; pg8::st4_wt(LSLOT + p, (unsigned)(tk * 4 + k)); pg8::st4_wt(LGATE + p, __float_as_uint(tg[k])); pg8::st4_wt(LRS + p, __float_as_uint(rsw)); } }
        LDS_WAIT(); __syncthreads();
    }
}

__device__ __forceinline__ void moe_table(const Args& a, volatile LAS unsigned* MISC, int tid) {
    const int* CNT = (const int*)(a.ws + OFF_CNT);
    if (tid < 32) MISC[16 + tid] = (unsigned)CNT[tid];
    LDS_WAIT(); __syncthreads();
    if (tid == 0) { unsigned tb = 0; for (int e = 0; e < NE; ++e) { MISC[48 + e] = tb; tb += (MISC[16 + e] + 255u) >> 8; } MISC[48 + NE] = tb; }
    LDS_WAIT(); __syncthreads();
}
template <int NPN, bool W1> struct SchedMoE {
    int G, c; unsigned char* ws; volatile LAS unsigned* MISC; const float* bias;
    __device__ __forceinline__ bool next(int i, pg8::Unit& u) const {
        unsigned mb_ = (unsigned)(uintptr_t)MISC; asm volatile("" : "+s"(mb_)); const LAS unsigned* M = (const LAS unsigned*)(uintptr_t)mb_;
        const int T = __builtin_amdgcn_readfirstlane((int)M[48 + NE]); const int NU = T * NPN; const int L = i * G + c; if (L >= NU) return false;
        const int w = pg8::xcd_remap(L, NU);
        int e = 0;
#pragma unroll
        for (int s = 16; s >= 1; s >>= 1) { if ((int)M[48 + e + s] * NPN <= w) e += s; }
        e = __builtin_amdgcn_readfirstlane(e);
        const int tb = __builtin_amdgcn_readfirstlane((int)M[48 + e]), cnt = __builtin_amdgcn_readfirstlane((int)M[16 + e]), nte = (cnt + 255) >> 8; const int idx = w - tb * NPN, pn = __builtin_amdgcn_readfirstlane(idx / nte), mt = idx - pn * nte;
        u.pm = tb + mt; u.pn = pn; u.i1 = e; const int nv = cnt - mt * 256; u.i0 = nv < 256 ? nv : 256;
        u.p3 = (int*)(ws + WS_LSLOT) + (size_t)e * LCAP + mt * 256; u.p2 = (float*)(ws + (W1 ? WS_LRS : WS_LGATE)) + (size_t)e * LCAP + mt * 256; u.p0 = nullptr;
        u.p1 = W1 ? (void*)(bias + (size_t)e * 2 * DFF + pn * 128) : (void*)(bias + (size_t)e * D + pn * 256);
        if (W1) { u.A = (const char*)(ws + WS_X2F8); u.B = (const char*)(ws + WS_W1) + ((size_t)e * 2 * DFF + pn * 256) * D; }
        else { u.A = (const char*)(ws + WS_ACT) + (size_t)(tb + mt) * 256 * DFF; u.B = (const char*)(ws + WS_W2) + ((size_t)e * D + pn * 256) * DFF; }
        return true;
    }
};
typedef float f32x2 __attribute__((ext_vector_type(2)));
struct EpiSwiGLU {
    static constexpr bool PERM = true; static constexpr int MIDK = -1; unsigned char* act;
    __device__ __forceinline__ void midk(f32x4 (&)[2][2][4][2], const pg8::Unit&, int, int) const {}
    __device__ __forceinline__ void operator()(f32x4 (&acc)[2][2][4][2], const pg8::Unit& u, int wr, int wc, int fr, int fq, int, int, LAS unsigned char* tab) const {
        const int nvalid = u.i0; const LAS float* T1 = (const LAS float*)tab + 256; const LAS float* T2 = (const LAS float*)tab + 512;
        int r0 = wr * 64 + fr, c0 = wc * 32 + 8 * fq; asm volatile("" : "+v"(r0), "+v"(c0)); const int gc0 = u.pn * 128 + c0;
        f32x4 bg[2], bu[2];
#pragma unroll
        for (int n = 0; n < 2; ++n) { bg[n] = *(const LAS f32x4*)(T2 + c0 + 4 * n); bu[n] = *(const LAS f32x4*)(T2 + 128 + c0 + 4 * n); }
#pragma unroll
        for (int ai = 0; ai < 2; ++ai)
#pragma unroll
            for (int m = 0; m < 4; ++m) { const int r = r0 + ai * 128 + m * 16; const float rs = T1[r]; int wv[2];
#pragma unroll
                for (int n = 0; n < 2; ++n) { f32x2 o[2];
#pragma unroll
                    for (int h = 0; h < 2; ++h) { f32x2 g = (f32x2){acc[ai][0][m][n][2 * h], acc[ai][0][m][n][2 * h + 1]} * rs + (f32x2){bg[n][2 * h], bg[n][2 * h + 1]};
                        f32x2 up = (f32x2){acc[ai][1][m][n][2 * h], acc[ai][1][m][n][2 * h + 1]} * rs + (f32x2){bu[n][2 * h], bu[n][2 * h + 1]};
                        g.x = fminf(g.x, SW_LIMIT); g.y = fminf(g.y, SW_LIMIT); up.x = fminf(fmaxf(up.x, -SW_LIMIT), SW_LIMIT); up.y = fminf(fmaxf(up.y, -SW_LIMIT), SW_LIMIT);
                        const f32x2 tt = g * (-SW_ALPHA * LOG2E); f32x2 d; d.x = __builtin_amdgcn_exp2f(tt.x); d.y = __builtin_amdgcn_exp2f(tt.y); d = d + 1.0f;
                        f32x2 rr; rr.x = __builtin_amdgcn_rcpf(d.x); rr.y = __builtin_amdgcn_rcpf(d.y);
                        o[h] = (up + 1.0f) * g * rr; }
                    wv[n] = __builtin_amdgcn_cvt_pk_fp8_f32(o[0].x, o[0].y, 0, false); wv[n] = __builtin_amdgcn_cvt_pk_fp8_f32(o[1].x, o[1].y, wv[n], true); }
                if (r < nvalid) pg8::st8_wt(act + ((size_t)u.pm * 256 + r) * DFF + gc0, (unsigned long long)(unsigned)wv[0] | ((unsigned long long)(unsigned)wv[1] << 32)); }
    }
};
struct EpiW2 {
    static constexpr bool PERM = true; static constexpr int MIDK = -1; bf16_t* Y;
    __device__ __forceinline__ void midk(f32x4 (&)[2][2][4][2], const pg8::Unit&, int, int) const {}
    __device__ __forceinline__ void operator()(f32x4 (&acc)[2][2][4][2], const pg8::Unit& u, int wr, int wc, int fr, int fq, int, int, LAS unsigned char* tab) const {
        const int nvalid = u.i0; const LAS unsigned* T0 = (const LAS unsigned*)tab; const LAS float* T1 = (const LAS float*)tab + 256; const LAS float* T2 = (const LAS float*)tab + 512;
        int r0 = wr * 64 + fr, cl = wc * 32 + 8 * fq; asm volatile("" : "+v"(r0), "+v"(cl)); const int c0 = u.pn * 256 + cl;
        f32x4 bv[2][2];
#pragma unroll
        for (int bj = 0; bj < 2; ++bj)
#pragma unroll
            for (int n = 0; n < 2; ++n) bv[bj][n] = *(const LAS f32x4*)(T2 + cl + bj * 128 + 4 * n);
#pragma unroll
        for (int ai = 0; ai < 2; ++ai)
#pragma unroll
            for (int m = 0; m < 4; ++m) { const int r = r0 + ai * 128 + m * 16; const bool valid = r < nvalid; const unsigned slot = T0[r]; const float g = T1[r];
#pragma unroll
                for (int bj = 0; bj < 2; ++bj) { const f32x4 v0 = (acc[ai][bj][m][0] * (1.0f / WSCALE) + bv[bj][0]) * g, v1 = (acc[ai][bj][m][1] * (1.0f / WSCALE) + bv[bj][1]) * g;
                    u32x4 w; w.x = pg8::cvt_pk_bf16(v0[0], v0[1]); w.y = pg8::cvt_pk_bf16(v0[2], v0[3]); w.z = pg8::cvt_pk_bf16(v1[0], v1[1]); w.w = pg8::cvt_pk_bf16(v1[2], v1[3]);
                    if (valid) pg8::st16<7>(Y + (size_t)slot * D + c0 + bj * 128, w); } }
    }
};

__device__ __forceinline__ void p11_final(const Args& a, int vcu, int G, int wave, int lane, float* dst) {
    const bf16_t* x2 = (const bf16_t*)(a.ws + WS_S0); const bf16_t* Y = (const bf16_t*)(a.ws + WS_Y); const float* gf = a.in[21];
    const int gw = vcu * NWAVES + wave, NGW = G * NWAVES;
    f32x4 g4[4];
#pragma unroll
    for (int j = 0; j < 4; ++j) g4[j] = *(const f32x4*)(gf + 4 * lane + 256 * j);
    for (int tok = gw; tok < NTOK; tok += NGW) {
        f32x4 v[4]; float s = 0.f;
#pragma unroll
        for (int j = 0; j < 4; ++j) { { const unsigned long long w = *(const unsigned long long*)(x2 + (size_t)tok * D + 4 * lane + 256 * j);
                v[j] = (f32x4){__builtin_bit_cast(float, (unsigned)(w << 16)), __builtin_bit_cast(float, (unsigned)w & 0xffff0000u), __builtin_bit_cast(float, (unsigned)(w >> 32) << 16), __builtin_bit_cast(float, (unsigned)(w >> 32) & 0xffff0000u)}; }
#pragma unroll
            for (int k = 0; k < 4; ++k) { const unsigned long long w = *(const unsigned long long*)(Y + ((size_t)tok * 4 + k) * D + 4 * lane + 256 * j);
                v[j][0] += __builtin_bit_cast(float, (unsigned)(w << 16)); v[j][1] += __builtin_bit_cast(float, (unsigned)w & 0xffff0000u);
                v[j][2] += __builtin_bit_cast(float, (unsigned)(w >> 32) << 16); v[j][3] += __builtin_bit_cast(float, (unsigned)(w >> 32) & 0xffff0000u); }
            s += (v[j][0] * v[j][0] + v[j][1] * v[j][1]) + (v[j][2] * v[j][2] + v[j][3] * v[j][3]); }
        const float rs = 1.0f / sqrtf(wave_sum(s) * (1.0f / D) + EPS);
#pragma unroll
        for (int j = 0; j < 4; ++j) pg8::st16<8>(dst + (size_t)tok * D + 4 * lane + 256 * j, (f32x4)(v[j] * rs * g4[j]));
    }
}
typedef float f32x16 __attribute__((ext_vector_type(16)));
typedef short s16x4 __attribute__((ext_vector_type(4)));
__device__ __forceinline__ int crow(int r, int hi) { return (r & 3) + 8 * (r >> 2) + 4 * hi; }
constexpr int SB_FLAG_OFF = 32768, SB_STG_OFF = 36864;
__device__ __forceinline__ void sb_unit(int b, int h, int qb, const bf16_t* QKVU, bf16_t* MIXED, float* SSQSB, LAS unsigned char* shm, int wid, int lane) {
    const int r32 = lane & 31, hi = lane >> 5;
    const size_t rowbase = (size_t)b * S; const int q0 = qb * 256;
    const bf16_t* Qw = QKVU + (rowbase + q0 + wid * 32) * INP + h * HD;
    const bf16_t* Kh = QKVU + rowbase * INP + SBW + h * HD; const bf16_t* Vh = Kh + SBW;
    bf16x8 qr[4];
#pragma unroll
    for (int d0 = 0; d0 < 4; ++d0) qr[d0] = *(const bf16x8*)(Qw + (size_t)r32 * INP + d0 * 16 + hi * 8);
    f32x16 o[2];
#pragma unroll
    for (int r = 0; r < 16; ++r) { o[0][r] = 0.f; o[1][r] = 0.f; }
    float carry = 1.0f; bool alive = true;
    const int jtop = 4 * qb + 3, jmax_w = 4 * qb + (wid >> 1);
    const int qabs = q0 + wid * 32 + r32;
    const bf16_t* ksrc = Kh + (size_t)lane * INP + wid * 8;
    const bf16_t* vsrc = Vh + (size_t)(16 * (wid & 3) + (lane >> 2)) * INP + (wid >> 2) * 32 + (lane & 3) * 8;
    const int stoff = wid * 1024 + lane * 16;
    LAS unsigned* flags = (LAS unsigned*)(shm + SB_FLAG_OFF);
    u32x4 kreg = *(const u32x4*)(ksrc + (size_t)jtop * 64 * INP), vreg = *(const u32x4*)(vsrc + (size_t)jtop * 64 * INP);
    int p = 0;
    for (int j = jtop; j >= 0; --j) {
        LAS unsigned char* Kb = shm + p * 16384; LAS unsigned char* Vb = Kb + 8192;
        *(LAS u32x4*)(Kb + stoff) = kreg; *(LAS u32x4*)(Vb + stoff) = vreg;
        LDS_WAIT(); __syncthreads();
        if (j < jtop) { const LAS unsigned* fl = flags + (p ^ 1) * 8; const unsigned any = (fl[0] | fl[1]) | (fl[2] | fl[3]) | (fl[4] | fl[5]) | (fl[6] | fl[7]);
            if (__builtin_amdgcn_readfirstlane(any) == 0u) break; }
        if (j > 0) { kreg = *(const u32x4*)(ksrc + (size_t)(j - 1) * 64 * INP); vreg = *(const u32x4*)(vsrc + (size_t)(j - 1) * 64 * INP); }
        if (j <= jmax_w && alive) {
            f32x16 p0, p1;
#pragma unroll
            for (int r = 0; r < 16; ++r) { p0[r] = 0.f; p1[r] = 0.f; }
            const LAS unsigned char* kb = Kb + hi * 1024 + r32 * 16;
#pragma unroll
            for (int d0 = 0; d0 < 4; ++d0) { const bf16x8 b0 = *(const LAS bf16x8*)(kb + d0 * 2048), b1 = *(const LAS bf16x8*)(kb + d0 * 2048 + 512);
                p0 = __builtin_amdgcn_mfma_f32_32x32x16_bf16(b0, qr[d0], p0, 0, 0, 0); p1 = __builtin_amdgcn_mfma_f32_32x32x16_bf16(b1, qr[d0], p1, 0, 0, 0); }
            const bool diag = (j == jmax_w); const int kbase = 64 * j + 4 * hi;
#pragma unroll
            for (int r = 0; r < 16; ++r) { const int k0 = kbase + (r & 3) + 8 * (r >> 2);
                float e0 = __builtin_amdgcn_exp2f(p0[r]), e1 = __builtin_amdgcn_exp2f(p1[r]);
                float r0 = __builtin_amdgcn_rcpf(1.0f + e0), r1 = __builtin_amdgcn_rcpf(1.0f + e1);
                if (diag) { if (k0 >= qabs) r0 = 1.0f; if (k0 + 32 >= qabs) r1 = 1.0f; }
                p0[r] = r0; p1[r] = r1; }
            float sfx[8][3], A[8];
#pragma unroll
            for (int i = 0; i < 8; ++i) { const float x0 = (i < 4) ? p0[4 * i] : p1[4 * i - 16], x1 = (i < 4) ? p0[4 * i + 1] : p1[4 * i - 15], x2 = (i < 4) ? p0[4 * i + 2] : p1[4 * i - 14], x3 = (i < 4) ? p0[4 * i + 3] : p1[4 * i - 13];
                sfx[i][2] = x3; sfx[i][1] = x3 * x2; sfx[i][0] = sfx[i][1] * x1; A[i] = sfx[i][0] * x0; }
            float T = carry, E[8];
#pragma unroll
            for (int i = 7; i >= 0; --i) { const auto sw = __builtin_amdgcn_permlane32_swap(__float_as_uint(A[i]), __float_as_uint(A[i]), false, false);
                const float own_or_a = __uint_as_float(sw[0]), own_or_b = __uint_as_float(sw[1]);
                const float partner = hi ? own_or_a : own_or_b;
                E[i] = hi ? T : T * partner; T = T * (A[i] * partner); }
            carry = T;
            unsigned pw[4][4];
#pragma unroll
            for (int i = 0; i < 8; ++i) { float w4[4];
#pragma unroll
                for (int jj = 0; jj < 4; ++jj) { const float rv = (i < 4) ? p0[4 * i + jj] : p1[4 * i - 16 + jj]; const float beta = 1.0f - rv;
                    w4[jj] = beta * ((jj == 3) ? E[i] : E[i] * sfx[i][jj]); }
                pw[i >> 1][(i & 1) * 2] = pg8::cvt_pk_bf16(w4[0], w4[1]); pw[i >> 1][(i & 1) * 2 + 1] = pg8::cvt_pk_bf16(w4[2], w4[3]); }
            const LAS unsigned char* vb = Vb + ((lane >> 4) & 1) * 32 + (lane & 3) * 8 + (4 * hi + ((lane & 15) >> 2)) * 64;
#pragma unroll
            for (int d0 = 0; d0 < 2; ++d0)
#pragma unroll
                for (int ks = 0; ks < 4; ++ks) {
                    const s16x4 lo = __builtin_bit_cast(s16x4, __builtin_amdgcn_ds_read_tr16_b64_v4i16((LAS s16x4*)(vb + d0 * 4096 + ks * 1024)));
                    const s16x4 hh = __builtin_bit_cast(s16x4, __builtin_amdgcn_ds_read_tr16_b64_v4i16((LAS s16x4*)(vb + d0 * 4096 + ks * 1024 + 512)));
                    const bf16x8 vf = (bf16x8){lo[0], lo[1], lo[2], lo[3], hh[0], hh[1], hh[2], hh[3]};
                    const bf16x8 pa = __builtin_bit_cast(bf16x8, (u32x4){pw[ks][0], pw[ks][1], pw[ks][2], pw[ks][3]});
                    o[d0] = __builtin_amdgcn_mfma_f32_32x32x16_bf16(pa, vf, o[d0], 0, 0, 0); }
            alive = __any(carry != 0.0f);
        }
        if (lane == 0) flags[p * 8 + wid] = (j > jmax_w || alive) ? 1u : 0u;
        p ^= 1;
    }
    LAS bf16_t* stg = (LAS bf16_t*)(shm + SB_STG_OFF + wid * 4096);
#pragma unroll
    for (int r = 0; r < 16; ++r) { const int orow = crow(r, hi);
#pragma unroll
        for (int d0 = 0; d0 < 2; ++d0) stg[orow * 64 + d0 * 32 + r32] = (bf16_t)f2bf(o[d0][r]); }
    LDS_WAIT();
    bf16_t* Ow = MIXED + (rowbase + q0 + wid * 32) * D + h * HD;
#pragma unroll
    for (int i = 0; i < 4; ++i) { const int row = i * 8 + (lane >> 3), ch = lane & 7; const u32x4 v = *(const LAS u32x4*)(stg + row * 64 + ch * 8);
        pg8::st16<2>(Ow + (size_t)row * D + ch * 8, v); float q = 0.f;
#pragma unroll
        for (int k = 0; k < 4; ++k) { const float a = __builtin_bit_cast(float, v[k] << 16), c = __builtin_bit_cast(float, v[k] & 0xffff0000u); q += a * a + c * c; }
        q += __shfl_xor(q, 1); q += __shfl_xor(q, 2); q += __shfl_xor(q, 4);
        if (ch == 0) unsafeAtomicAdd(SSQSB + rowbase + q0 + wid * 32 + row, q); }
    LDS_WAIT(); __syncthreads();
}

constexpr int PL_PITCH = 1040, PL_PART_OFF = 83968, PL_RSTD_OFF = 86016;
__device__ __forceinline__ void pool_unit(int tile, const bf16_t* QKVU, const bf16_t* WPT, bf16_t* MIXED, LAS unsigned char* shm, int wid, int lane, int stop = 9) {
    const int tok0 = tile * 64, tpos0 = tok0 & (S - 1); const int tid = wid * 64 + lane;
    { u32x4 v[10];
#pragma unroll
      for (int i = 0; i < 10; ++i) { const int c = tid + i * NWAVES * 64; const int row = c >> 6, ch = c & 63; const int t = tpos0 - 15 + row;
          v[i] = (u32x4){0u, 0u, 0u, 0u}; if (c < 79 * 64 && t >= 0) v[i] = *(const u32x4*)(QKVU + (size_t)(tok0 - 15 + row) * INP + 3 * SBW + ch * 8); }
#pragma unroll
      for (int i = 0; i < 10; ++i) { const int c = tid + i * NWAVES * 64; const int row = c >> 6, ch = c & 63; if (c < 79 * 64) *(LAS u32x4*)(shm + row * PL_PITCH + ch * 16) = v[i]; } }
    LDS_WAIT(); __syncthreads();
    if (stop == 0) return;
    const int mb = wid & 3, gs = wid >> 2, r16 = lane & 15, kq = lane >> 4;
    const int lrow = 15 + mb * 16 + r16; const int tp1 = tpos0 + mb * 16 + r16 + 1;
    f32x4 acc[2][8]; float rowq[4] = {0.f, 0.f, 0.f, 0.f};
#pragma unroll
    for (int gi = 0; gi < 2; ++gi) {
        const int g = gs ? (1 + gi) : (gi ? 3 : 0); const int win = 2 << g; const int n = tp1 < win ? tp1 : win; const float inv = 1.0f / (float)n;
        bf16x8 Af[4];
#pragma unroll
        for (int ks = 0; ks < 4; ++ks) { float s[8];
#pragma unroll
            for (int q = 0; q < 8; ++q) s[q] = 0.f;
            const LAS unsigned char* up = shm + lrow * PL_PITCH + (g * PGD + ks * 32 + kq * 8) * 2;
            for (int jw = 0; jw < win; ++jw) { const u32x4 v = *(const LAS u32x4*)(up - jw * PL_PITCH);
#pragma unroll
                for (int k = 0; k < 4; ++k) { s[2 * k] += __builtin_bit_cast(float, v[k] << 16); s[2 * k + 1] += __builtin_bit_cast(float, v[k] & 0xffff0000u); } }
            const u32x4 self = *(const LAS u32x4*)up; u32x4 pk;
#pragma unroll
            for (int k = 0; k < 4; ++k) pk[k] = pg8::cvt_pk_bf16(s[2 * k] * inv - __builtin_bit_cast(float, self[k] << 16), s[2 * k + 1] * inv - __builtin_bit_cast(float, self[k] & 0xffff0000u));
            Af[ks] = __builtin_bit_cast(bf16x8, pk); }
        if (stop == 1) { asm volatile("" :: "v"(Af[0]), "v"(Af[1]), "v"(Af[2]), "v"(Af[3])); continue; }
#pragma unroll
        for (int nb = 0; nb < 8; ++nb) { f32x4 a = (f32x4){0.f, 0.f, 0.f, 0.f};
#pragma unroll
            for (int ks = 0; ks < 4; ++ks) { const bf16x8 bf = *(const bf16x8*)(WPT + ((size_t)(g * PGD + nb * 16 + r16)) * PGD + ks * 32 + kq * 8);
                a = __builtin_amdgcn_mfma_f32_16x16x32_bf16(Af[ks], bf, a, 0, 0, 0); }
            acc[gi][nb] = a;
#pragma unroll
            for (int r = 0; r < 4; ++r) rowq[r] += a[r] * a[r]; }
    }
    if (stop == 1) { LDS_WAIT(); __syncthreads(); return; }
    if (stop == 2) { asm volatile("" :: "v"(rowq[0]), "v"(rowq[1]), "v"(rowq[2]), "v"(rowq[3])); LDS_WAIT(); __syncthreads(); return; }
    LAS float* part = (LAS float*)(shm + PL_PART_OFF); LAS float* rstd = (LAS float*)(shm + PL_RSTD_OFF);
#pragma unroll
    for (int r = 0; r < 4; ++r) { float q = rowq[r]; q += __shfl_xor(q, 1); q += __shfl_xor(q, 2); q += __shfl_xor(q, 4); q += __shfl_xor(q, 8);
        if (r16 == 0) part[gs * 64 + mb * 16 + kq * 4 + r] = q; }
    LDS_WAIT(); __syncthreads();
    if (tid < 64) rstd[tid] = 1.0f / sqrtf((part[tid] + part[64 + tid]) * (1.0f / PW) + EPS);
    LDS_WAIT(); __syncthreads();
#pragma unroll
    for (int gi = 0; gi < 2; ++gi) { const int g = gs ? (1 + gi) : (gi ? 3 : 0);
#pragma unroll
        for (int r = 0; r < 4; ++r) { const int row = mb * 16 + kq * 4 + r; const float rs = rstd[row]; LAS bf16_t* op = (LAS bf16_t*)(shm + row * PL_PITCH) + g * PGD + r16;
#pragma unroll
            for (int nb = 0; nb < 8; ++nb) op[nb * 16] = (bf16_t)f2bf(acc[gi][nb][r] * rs); } }
    LDS_WAIT(); __syncthreads();
    if (stop == 3) { LDS_WAIT(); __syncthreads(); return; }
#pragma unroll
    for (int i = 0; i < 8; ++i) { const int c = tid + i * NWAVES * 64; const int row = c >> 6, ch = c & 63;
        pg8::st16<3>(MIXED + (size_t)(tok0 + row) * D + SBW + ch * 8, (u32x4)*(const LAS u32x4*)(shm + row * PL_PITCH + ch * 16)); }
    LDS_WAIT(); __syncthreads();
}
__device__ __forceinline__ void p2_mix(const Args& a, LAS unsigned char* lds, int bx, int G, int wid, int lane, float* SSQSB, int which = 3, int pstop = 9, bf16_t* pool_dst = nullptr) {
    unsigned char* ws = a.ws; const bf16_t* QKVU = (const bf16_t*)(ws + WS_QKVU); bf16_t* MIXED = (bf16_t*)(ws + WS_MIXED);
    constexpr int NA = B * NH * (S / 256);
    if (which & 1) for (int i = 0; i * G + bx < NA; ++i) { const int w = pg8::xcd_remap(i * G + bx, NA); const int bh = w >> 4, qb = w & 15; sb_unit(bh >> 3, bh & 7, qb, QKVU, MIXED, SSQSB, lds + RING_OFF, wid, lane); }
    if (which & 2) for (int t = bx; t < NTOK / 64; t += G) pool_unit(t, QKVU, (const bf16_t*)(ws + WS_WP), pool_dst ? pool_dst : MIXED, lds + RING_OFF, wid, lane, pstop);
}
constexpr size_t BAR_REGION_OFF = 1 * MiB, BAR_REGION_STRIDE = 16 * 1024;
__global__ void __launch_bounds__(NWAVES * 64, 2) mega(Args args) {
    const int li = args.li;
    extern __shared__ __attribute__((aligned(16))) unsigned char lds_raw[];
    LAS unsigned char* lds = (LAS unsigned char*)lds_raw;
    volatile LAS unsigned* MISC = (volatile LAS unsigned*)(lds + MISC_OFF);
    const int wave = __builtin_amdgcn_readfirstlane((int)threadIdx.x >> 6);
#define LANE_ID() ({ int l_; asm volatile("v_mbcnt_lo_u32_b32 %0, -1, 0\n\tv_mbcnt_hi_u32_b32 %0, -1, %0" : "=v"(l_)); l_; })
    const int G = gridDim.x; const int bx = blockIdx.x; const int vcu = (G % 8 == 0) ? (bx % 8) * (G / 8) + bx / 8 : bx;
    for (int u = wave * 64 + LANE_ID(); u < MISC_BYTES / 4; u += NWAVES * 64) MISC[u] = 0u;
    __syncthreads();
    unsigned char* ws = args.ws;
    XcdBarrier bar = xcd_barrier_post((unsigned*)(ws + BAR_REGION_OFF + (size_t)li * BAR_REGION_STRIDE), MISC + 8);
    const int lo = args.ph_lo, hi = args.ph_hi;
    LAS unsigned char* ring = lds + RING_OFF; LAS unsigned char* epi = lds + EPI_OFF; LAS unsigned* gtab = (LAS unsigned*)(lds + GTAB_OFF);
#ifndef TIME_PHASE
#define TIME_PHASE -1
#endif
#define REP_OF(k) ((TIME_PHASE == (k)) ? 2 : 1)
#define REPE_OF(k) ((TIME_PHASE == 20 + (k)) ? 2 : 1)
#define IN(k) (lo <= (k) && (k) < hi)
#ifndef TSK
#define TSK -1
#endif
#ifndef TSCALE
#define TSCALE 1.0f
#endif
#define STAMP(i) do { if (TSK >= 0 && bx == 0 && wave == 0) { const unsigned long long t_ = __builtin_amdgcn_s_memrealtime(); MISC[128 + 2 * (i)] = (unsigned)t_; MISC[129 + 2 * (i)] = (unsigned)(t_ >> 32); } } while (0)
#define SEAM(k) do { if (IN(k) && IN((k) + 1)) xcd_barrier(bar); STAMP((k) + 1); } while (0)
    STAMP(0);
    if (IN(0)) { p0_prologue(args, lds, vcu, G, wave, LANE_ID()); if (TIME_PHASE == 0) { xcd_barrier(bar); p0_prologue(args, lds, vcu, G, wave, LANE_ID()); } SEAM(0); }
    if (IN(1)) { SchedP1 S{G, bx, ws}; pg8::EpiBf16S E; pg8::gemm_phase<pg8::EpiBf16S, SchedP1, 0, REP_OF(1), REPE_OF(1)>(wave, ring, epi, gtab, D * 2, D * 2, D / 64, S, E); SEAM(1); }
    {
    const float* xin0 = args.in[0]; float* outp = args.out;
    bf16_t* S0p = (bf16_t*)(ws + WS_S0); float* SSQSBp = (float*)(ws + OFF_SSQSB); float* SSQ1p = (float*)(ws + OFF_SSQ1); float* SSQ2p = (float*)(ws + OFF_SSQ2);
    constexpr size_t TSTEP = (size_t)256 * D * 2;
    #if !defined(PH_ONLY) || PH_ONLY == 2
    if (IN(2)) { if (TIME_PHASE == 42) { p2_mix(args, lds, bx, G, wave, LANE_ID(), (float*)(ws + 1536 * 1024), 2); xcd_barrier(bar); p2_mix(args, lds, bx, G, wave, LANE_ID(), (float*)(ws + 1536 * 1024), 2); xcd_barrier(bar); }
    if (TIME_PHASE == 2 || TIME_PHASE == 40 || TIME_PHASE == 41) { p2_mix(args, lds, bx, G, wave, LANE_ID(), (float*)(ws + 1536 * 1024), TIME_PHASE == 40 ? 1 : (TIME_PHASE == 41 ? 2 : 3)); xcd_barrier(bar); } p2_mix(args, lds, bx, G, wave, LANE_ID(), (float*)(ws + OFF_SSQSB)); SEAM(2); }
#endif

#if !defined(PH_ONLY) || PH_ONLY == 3
    if (IN(3)) { SchedReg S{G, bx, NTOK / 256, D / 256, (const char*)(ws + WS_MIXED), (const char*)(ws + WS_WOUT), TSTEP, TSTEP, nullptr, D, nullptr, nullptr};
        EpiResid<8, false, false> E{xin0, S0p, nullptr, SSQ1p, SSQSBp}; pg8::gemm_phase<EpiResid<8, false, false>, SchedReg, 0, REP_OF(3)>(wave, ring, epi, gtab, D * 2, D * 2, D / 64, S, E); SEAM(3); }
#endif
#if !defined(PH_ONLY) || PH_ONLY == 4
    if (IN(4)) { SchedReg S{G, bx, NTOK / 256, D / 256, (const char*)(ws + WS_S0), (const char*)(ws + WS_WQ), TSTEP, TSTEP, (bf16_t*)(ws + WS_QM), D, SSQ1p, nullptr};
        EpiBf16Ssq E{1.0f / D, C2_MEM}; pg8::gemm_phase<EpiBf16Ssq, SchedReg, 0, REP_OF(4)>(wave, ring, epi, gtab, D * 2, D * 2, D / 64, S, E); SEAM(4); }
#endif
#if !defined(PH_ONLY) || PH_ONLY == 5
    if (IN(5)) { SchedMS S{G, bx, ws}; EpiSoftmax E; pg8::gemm_phase<EpiSoftmax, SchedMS, 0, REP_OF(5)>(wave, ring, epi, gtab, D * 2, D * 2, MHD / 64, S, E); SEAM(5); }
#endif
#if !defined(PH_ONLY) || PH_ONLY == 6
    if (IN(6)) { SchedPV S{G, bx, ws}; pg8::EpiBf16S E; pg8::gemm_phase<pg8::EpiBf16S, SchedPV, 0, REP_OF(6)>(wave, ring, epi, gtab, D * 2, NMEM * 2, NMEM / 64, S, E); SEAM(6); }
#endif
#if !defined(PH_ONLY) || PH_ONLY == 7
    if (IN(7)) { SchedReg S{G, bx, NTOK / 256, D / 256, (const char*)(ws + WS_OM), (const char*)(ws + WS_WO), TSTEP, TSTEP, nullptr, D, nullptr, nullptr};
        EpiResid<-1, true, true> E{nullptr, S0p, ws + WS_X2F8, SSQ2p, nullptr}; pg8::gemm_phase<EpiResid<-1, true, true>, SchedReg, 0, REP_OF(7)>(wave, ring, epi, gtab, D * 2, D * 2, D / 64, S, E); SEAM(7); }
#endif
#if !defined(PH_ONLY) || PH_ONLY == 8
    if (IN(8)) { if (TIME_PHASE == 8) { p8_route(args, lds, bx, G, wave, LANE_ID(), (int*)(ws + 1536 * 1024)); xcd_barrier(bar); } p8_route(args, lds, bx, G, wave, LANE_ID(), (int*)(ws + OFF_CNT)); SEAM(8); }
#endif
#if !defined(PH_ONLY) || PH_ONLY == 9
    if (IN(9)) { moe_table(args, MISC, wave * 64 + LANE_ID()); SchedMoE<8, true> S{G, bx, ws, MISC, args.in[18]}; EpiSwiGLU E{ws + WS_ACT};
        pg8::gemm_phase<EpiSwiGLU, SchedMoE<8, true>, 1, REP_OF(9), REPE_OF(9), true>(wave, ring, epi, gtab, D, D, D / 128, S, E); SEAM(9); }
#endif
#if !defined(PH_ONLY) || PH_ONLY == 10
    if (IN(10)) { moe_table(args, MISC, wave * 64 + LANE_ID()); SchedMoE<4, false> S{G, bx, ws, MISC, args.in[20]}; EpiW2 E{(bf16_t*)(ws + WS_Y)};
        pg8::gemm_phase<EpiW2, SchedMoE<4, false>, 2, REP_OF(10), REPE_OF(10), true>(wave, ring, epi, gtab, DFF, DFF, DFF / 128, S, E); SEAM(10); }
#endif
#if !defined(PH_ONLY) || PH_ONLY == 11
    if (IN(11)) { if (TIME_PHASE == 11) { p11_final(args, vcu, G, wave, LANE_ID(), (float*)(ws + WS_ACT)); xcd_barrier(bar); } p11_final(args, vcu, G, wave, LANE_ID(), args.out); }
#endif
}

    if (TSK >= 0) { STAMP(12); __syncthreads(); if (bx == 0 && wave == 0 && LANE_ID() == 0) { asm volatile("s_waitcnt vmcnt(0)" ::: "memory");
        const unsigned long long t0 = ((unsigned long long)MISC[129 + 2 * TSK] << 32) | MISC[128 + 2 * TSK], t1 = ((unsigned long long)MISC[131 + 2 * TSK] << 32) | MISC[130 + 2 * TSK];
        args.out[0] = (float)(t1 - t0) * 0.01f * TSCALE; } }
    if (TIME_PHASE == 12) { for (int q = 0; q < 10; ++q) xcd_barrier(bar); }
#undef IN
#undef SEAM
}
}

#ifndef MEGA_MASK
#define MEGA_MASK 0xFFF
#endif
extern "C" void kernel_launch(void* const* d_in, const int* in_sizes, int n_in, void* d_out, int out_size, void* d_ws, size_t ws_size, hipStream_t stream) {
    if (n_in != 22 || out_size != NTOK * D || ws_size < WS_END) { fprintf(stderr, "kernel_launch: unexpected shapes (n_in %d out %d ws %zu)\n", n_in, out_size, ws_size); return; }
    static int grid = 0;
    if (grid == 0) {
        int dev = 0, cus = 0;
        if (hipGetDevice(&dev) != hipSuccess || hipDeviceGetAttribute(&cus, hipDeviceAttributeMultiprocessorCount, dev) != hipSuccess) { grid = -1; return; }
        if (hipFuncSetAttribute((const void*)mk::mega, hipFuncAttributeMaxDynamicSharedMemorySize, mk::LDS_BYTES) != hipSuccess) { fprintf(stderr, "kernel_launch: hipFuncSetAttribute failed\n"); grid = -1; return; }
        int per_cu = 0; (void)hipOccupancyMaxActiveBlocksPerMultiprocessor(&per_cu, (const void*)mk::mega, mk::NWAVES * 64, mk::LDS_BYTES); (void)hipGetLastError();
        if (per_cu < 1) fprintf(stderr, "kernel_launch: occupancy query reports %d blocks per CU\n", per_cu);
        grid = cus;
    }
    if (grid < 0) return;
    const float* x = (const float*)d_in[0]; const float* mem = (const float*)d_in[1]; const float* g_mix = (const float*)d_in[2]; const float* w_in = (const float*)d_in[3];
    const float* g_sb = (const float*)d_in[4]; const float* g_pool = (const float*)d_in[5]; const float* w_pool = (const float*)d_in[6]; const float* pool_scale = (const float*)d_in[7];
    const float* w_out = (const float*)d_in[8]; const float* g_mem_q = (const float*)d_in[9]; const float* g_mem_kv = (const float*)d_in[10]; const float* w_mem_q = (const float*)d_in[11];
    const float* w_mem_kv = (const float*)d_in[12]; const float* w_mem_o = (const float*)d_in[13]; const float* g_ffn = (const float*)d_in[14]; const float* w_router = (const float*)d_in[15];
    const float* b_router = (const float*)d_in[16]; const float* w_e_in = (const float*)d_in[17]; const float* b_e_in = (const float*)d_in[18]; const float* w_e_out = (const float*)d_in[19];
    const float* b_e_out = (const float*)d_in[20]; const float* g_final = (const float*)d_in[21];
    float* out = (float*)d_out; unsigned char* ws = (unsigned char*)d_ws;
    bf16_t* WIN = (bf16_t*)(ws + WS_WIN); bf16_t* WOUT = (bf16_t*)(ws + WS_WOUT); bf16_t* WQ = (bf16_t*)(ws + WS_WQ); bf16_t* WKV = (bf16_t*)(ws + WS_WKV); bf16_t* WO = (bf16_t*)(ws + WS_WO);
    bf16_t* WP = (bf16_t*)(ws + WS_WP); float* WR = (float*)(ws + WS_WR); float* RSTDX = (float*)(ws + WS_RSTDX); float* RSTDM = (float*)(ws + WS_RSTDM);
    bf16_t* W1 = (bf16_t*)(ws + WS_W1); bf16_t* W2 = (bf16_t*)(ws + WS_W2); bf16_t* S0 = (bf16_t*)(ws + WS_S0); bf16_t* QKVU = (bf16_t*)(ws + WS_QKVU);
    bf16_t* QM = (bf16_t*)(ws + WS_QM); bf16_t* OM = (bf16_t*)(ws + WS_OM); bf16_t* MIXED = (bf16_t*)(ws + WS_MIXED); bf16_t* PM = (bf16_t*)(ws + WS_PM); bf16_t* ACT = (bf16_t*)(ws + WS_ACT);
    bf16_t* KM = (bf16_t*)(ws + WS_KM); bf16_t* VMT = (bf16_t*)(ws + WS_VMT); bf16_t* MEMB = (bf16_t*)(ws + WS_MEMB); int* LSLOT = (int*)(ws + WS_LSLOT); float* LGATE = (float*)(ws + WS_LGATE);
    bf16_t* Y = (bf16_t*)(ws + WS_Y); float* SCR_S = (float*)(ws + WS_SCR_S); bf16_t* POOLED = (bf16_t*)(ws + WS_SCR_POOLED); float* POOLO = (float*)(ws + WS_SCR_POOLO);
    int* CNT = (int*)(ws + OFF_CNT); float* SSQSB = (float*)(ws + OFF_SSQSB); float* SSQ1 = (float*)(ws + OFF_SSQ1); float* SSQ2 = (float*)(ws + OFF_SSQ2);

    (void)hipMemsetAsync(ws + WS_CTL, 0, CTL_BYTES, stream);
    mk::Args a{}; for (int i = 0; i < 22; ++i) a.in[i] = (const float*)d_in[i]; a.out = out; a.ws = ws;
    const dim3 tb(32, 8); const int BIG = 1 << 30; int li = 0;
    for (int p = 0; p < mk::NPHASE;) {
        if ((MEGA_MASK >> p) & 1) { int q = p; while (q < mk::NPHASE && ((MEGA_MASK >> q) & 1)) ++q;
            a.ph_lo = p; a.ph_hi = q; a.li = li; hipLaunchKernelGGL(mk::mega, dim3(grid), dim3(mk::NWAVES * 64), mk::LDS_BYTES, stream, a); ++li; p = q; continue; }
        switch (p) {
        case 0:
            nv::k_cvt_w<<<dim3(INP / 32, D / 32, 1), tb, 0, stream>>>(w_in, D, INP, WIN, INP, g_mix, nullptr, BIG, nullptr, 0, 0);
            nv::k_cvt_w<<<dim3(D / 32, D / 32, 1), tb, 0, stream>>>(w_out, D, D, WOUT, D, g_sb, g_pool, SBW, nullptr, 0, 0);
            nv::k_cvt_w<<<dim3(D / 32, D / 32, 1), tb, 0, stream>>>(w_mem_q, D, D, WQ, D, g_mem_q, nullptr, BIG, nullptr, 0, 0);
            nv::k_cvt_w<<<dim3(2 * D / 32, D / 32, 1), tb, 0, stream>>>(w_mem_kv, D, 2 * D, WKV, 2 * D, g_mem_kv, nullptr, BIG, nullptr, 0, 0);
            nv::k_cvt_w<<<dim3(D / 32, D / 32, 1), tb, 0, stream>>>(w_mem_o, D, D, WO, D, nullptr, nullptr, BIG, nullptr, 0, 0);
            nv::k_cvt_w<<<dim3(2 * DFF / 32, D / 32, NE), tb, 0, stream>>>(w_e_in, D, 2 * DFF, W1, 2 * DFF, g_ffn, nullptr, BIG, nullptr, 0, 1);
            nv::k_cvt_w<<<dim3(D / 32, DFF / 32, NE), tb, 0, stream>>>(w_e_out, DFF, D, W2, D, nullptr, nullptr, BIG, nullptr, 0, 0);
            nv::k_cvt_w<<<dim3(PGD / 32, PGD / 32, PG), tb, 0, stream>>>(w_pool, PGD, PGD, WP, PGD, nullptr, nullptr, BIG, pool_scale, PGD, 0);
            nv::k_cvt_router<<<NE * D / 256, 256, 0, stream>>>(w_router, g_ffn, WR);
            nv::k_rowstat_cvt<<<NTOK / 4, 256, 0, stream>>>(x, S0, RSTDX, NTOK);
            nv::k_rowstat_cvt<<<NMROWS / 4, 256, 0, stream>>>(mem, MEMB, RSTDM, NMROWS);
            break;
        case 1:
            nv::k_g1<<<dim3(INP / 64, NTOK / 64), 256, 0, stream>>>(S0, WIN, RSTDX, QKVU);
            nv::k_g1b<<<dim3(2 * D / 64, NMROWS / 64), 256, 0, stream>>>(MEMB, WKV, RSTDM, KM, VMT);
            break;
        case 2:
            nv::k_sb<<<B * NH * S / 256, 256, 0, stream>>>(QKVU, MIXED, SSQSB);
            nv::k_pool1<<<(unsigned)((size_t)NTOK * PW / 256), 256, 0, stream>>>(QKVU, POOLED);
            nv::k_pool2<<<dim3(PGD / 64, NTOK / 64, PG), 256, 0, stream>>>(POOLED, WP, POOLO);
            nv::k_pool3<<<NTOK / 4, 256, 0, stream>>>(POOLO, MIXED);
            break;
        case 3: nv::k_resid<<<dim3(D / 64, NTOK / 64), 256, 0, stream>>>(MIXED, WOUT, x, out, S0, SSQ1, SSQSB, SBW); break;
        case 4: nv::k_g3<<<dim3(D / 64, NTOK / 64), 256, 0, stream>>>(S0, WQ, SSQ1, QM); break;
        case 5:
            nv::k_ms<<<dim3(NMEM / 64, NTOK / 64, MH), 256, 0, stream>>>(QM, KM, SCR_S);
            nv::k_msoftmax<<<NTOK * MH / 4, 256, 0, stream>>>(SCR_S, PM);
            break;
        case 6: nv::k_mpv<<<dim3(MHD / 64, NTOK / 64, MH), 256, 0, stream>>>(PM, VMT, OM); break;
        case 7: nv::k_resid<<<dim3(D / 64, NTOK / 64), 256, 0, stream>>>(OM, WO, out, out, S0, SSQ2, SSQ2, -1); break;
        case 8: nv::k_route<<<NTOK / 4, 256, 0, stream>>>(out, SSQ2, WR, b_router, CNT, LSLOT, LGATE); break;
        case 9: nv::k_w1<<<dim3(DFF / 32, LCAP / 64, NE), 256, 0, stream>>>(S0, SSQ2, W1, b_e_in, CNT, LSLOT, ACT); break;
        case 10: nv::k_w2<<<dim3(D / 64, LCAP / 64, NE), 256, 0, stream>>>(ACT, W2, b_e_out, CNT, LSLOT, LGATE, Y); break;
        case 11: nv::k_final<<<NTOK / 4, 256, 0, stream>>>(out, Y, g_final); break;
        }
        ++p;
    }
}
```

```cpp
#include <hip/hip_runtime.h>
#include <cstdio>
#include <cstdint>

typedef unsigned short bf16_t;
typedef short bf16x8 __attribute__((ext_vector_type(8)));
typedef float f32x4 __attribute__((ext_vector_type(4)));
typedef unsigned u32x4 __attribute__((ext_vector_type(4)));

namespace cfg {
constexpr int B = 8, S = 4096, D = 1024, NTOK = B * S;
constexpr int SBW = 512, NH = 8, HD = 64, PW = 512, PG = 4, PGD = 128, INP = 2048;
constexpr int NMEM = 256, MH = 4, MHD = 256, NMROWS = B * NMEM;
constexpr int NE = 32, TOPK = 4, DFF = 1024, LCAP = NTOK;
constexpr float EPS = 1e-5f, LOG2E = 1.4426950408889634f;
constexpr float C2_SB = 0.125f * LOG2E, C2_MEM = 0.0625f * LOG2E;
constexpr float SW_LIMIT = 7.0f, SW_ALPHA = 1.702f;
constexpr int MAXTILES = 544;
constexpr size_t MiB = 1u << 20;
constexpr size_t WS_CTL = 0, CTL_BYTES = 2 * MiB;
constexpr size_t OFF_CNT = 64 * 1024, OFF_SSQSB = 512 * 1024, OFF_SSQ1 = 640 * 1024, OFF_SSQ2 = 768 * 1024;
constexpr size_t WS_WIN = 2 * MiB, WS_WOUT = 6 * MiB, WS_WQ = 8 * MiB, WS_WKV = 10 * MiB, WS_WO = 14 * MiB, WS_WP = 16 * MiB, WS_WR = 17 * MiB;
constexpr size_t WS_RSTDX = 18 * MiB, WS_RSTDM = 18 * MiB + 512 * 1024;
constexpr size_t WS_W1 = 20 * MiB, WS_W2 = 148 * MiB;
constexpr size_t WS_S0 = 212 * MiB;
constexpr size_t WS_QKVU = 276 * MiB;
constexpr size_t WS_QM = 276 * MiB, WS_OM = 340 * MiB;
constexpr size_t WS_MIXED = 600 * MiB;
constexpr size_t WS_PM = 404 * MiB;
constexpr size_t WS_ACT = 276 * MiB;
constexpr size_t WS_KM = 548 * MiB, WS_VMT = 552 * MiB, WS_MEMB = 556 * MiB, WS_LSLOT = 560 * MiB, WS_LGATE = 564 * MiB;
constexpr size_t WS_Y = 568 * MiB;
constexpr size_t WS_SCR_S = 568 * MiB, WS_SCR_POOLED = 696 * MiB, WS_SCR_POOLO = 728 * MiB;
constexpr size_t WS_END = 824 * MiB;
}
using namespace cfg;

__device__ __forceinline__ unsigned f2bf(float f) { unsigned u = __builtin_bit_cast(unsigned, f); return (u + 0x7fffu + ((u >> 16) & 1u)) >> 16; }
__device__ __forceinline__ float bf2f(bf16_t h) { return __builtin_bit_cast(float, (unsigned)h << 16); }
__device__ __forceinline__ float wave_sum(float v) {
#pragma unroll
    for (int o = 1; o < 64; o <<= 1) v += __shfl_xor(v, o);
    return v;
}

namespace nv {
__global__ void k_cvt_w(const float* src, int K, int N, bf16_t* dst, int ND, const float* gk, const float* gk2, int ksplit, const float* gn, int gnz, int mode) {
    __shared__ float t[32][33];
    const int nd0 = blockIdx.x * 32, k0 = blockIdx.y * 32, z = blockIdx.z;
    int ns0 = nd0;
    if (mode == 1) { const int pn = nd0 >> 8, j = nd0 & 255; ns0 = (j < 128) ? 128 * pn + j : 1024 + 128 * pn + (j - 128); }
    src += (size_t)z * K * N; dst += (size_t)z * ND * K;
    for (int i = threadIdx.y; i < 32; i += 8) { const int k = k0 + i, n = ns0 + threadIdx.x;
        float v = src[(size_t)k * N + n]; if (gk) v *= (k < ksplit) ? gk[k] : gk2[k - ksplit]; if (gn) v *= gn[z * gnz + n]; t[i][threadIdx.x] = v; }
    __syncthreads();
    for (int i = threadIdx.y; i < 32; i += 8) dst[(size_t)(nd0 + i) * K + k0 + threadIdx.x] = (bf16_t)f2bf(t[threadIdx.x][i]);
}
__global__ void k_cvt_router(const float* wr, const float* g, float* dst) {
    const int i = blockIdx.x * 256 + threadIdx.x; if (i >= NE * D) return; const int e = i / D, k = i % D; dst[i] = g[k] * wr[k * NE + e];
}
__global__ void k_rowstat_cvt(const float* x, bf16_t* xb, float* rstd, int rows) {
    const int row = blockIdx.x * 4 + (threadIdx.x >> 6), lane = threadIdx.x & 63; if (row >= rows) return;
    const float* xr = x + (size_t)row * D; float s = 0.f;
    for (int j = lane; j < D; j += 64) { const float v = xr[j]; s += v * v; xb[(size_t)row * D + j] = (bf16_t)f2bf(v); }
    s = wave_sum(s); if (lane == 0) rstd[row] = 1.0f / sqrtf(s * (1.0f / D) + EPS);
}

template <class RA, class RB, class MID, class EPI>
__device__ __forceinline__ void wave_gemm(int m0, int n0, int K, int kmid, RA ra, RB rb, MID mid, EPI epi) {
    const int lane = threadIdx.x & 63, r16 = lane & 15, kq = lane >> 4;
    const bf16_t* pa[2]; const bf16_t* pb[2];
#pragma unroll
    for (int i = 0; i < 2; ++i) { pa[i] = ra(m0 + i * 16 + r16) + kq * 8; pb[i] = rb(n0 + i * 16 + r16) + kq * 8; }
    f32x4 acc[2][2];
#pragma unroll
    for (int i = 0; i < 2; ++i)
#pragma unroll
        for (int j = 0; j < 2; ++j) acc[i][j] = (f32x4){0.f, 0.f, 0.f, 0.f};
    for (int k = 0; k < K; k += 32) {
        if (k == kmid) {
#pragma unroll
            for (int i = 0; i < 2; ++i)
#pragma unroll
                for (int r = 0; r < 4; ++r) { const float s = mid(m0 + i * 16 + kq * 4 + r); acc[i][0][r] *= s; acc[i][1][r] *= s; }
        }
        bf16x8 a[2], b[2];
#pragma unroll
        for (int i = 0; i < 2; ++i) { a[i] = *(const bf16x8*)(pa[i] + k); b[i] = *(const bf16x8*)(pb[i] + k); }
#pragma unroll
        for (int i = 0; i < 2; ++i)
#pragma unroll
            for (int j = 0; j < 2; ++j) acc[i][j] = __builtin_amdgcn_mfma_f32_16x16x32_bf16(a[i], b[j], acc[i][j], 0, 0, 0);
    }
#pragma unroll
    for (int i = 0; i < 2; ++i)
#pragma unroll
        for (int r = 0; r < 4; ++r) epi(m0 + i * 16 + kq * 4 + r, n0 + r16, n0 + 16 + r16, acc[i][0][r], acc[i][1][r]);
}
struct NoMid { __device__ float operator()(int) const { return 1.f; } };

#define NV_TILE() const int w = threadIdx.x >> 6, m0 = blockIdx.y * 64 + (w >> 1) * 32, n0 = blockIdx.x * 64 + (w & 1) * 32

__global__ void k_g1(const bf16_t* XB, const bf16_t* WT, const float* rstd, bf16_t* QKVU) {
    NV_TILE();
    wave_gemm(m0, n0, D, -1, [=](int r) { return XB + (size_t)r * D; }, [=](int c) { return WT + (size_t)c * D; }, NoMid(),
        [=](int r, int c0, int c1, float v0, float v1) { const float s = rstd[r];
            v0 *= s; v1 *= s; if (c0 < SBW) v0 *= C2_SB; if (c1 < SBW) v1 *= C2_SB;
            QKVU[(size_t)r * INP + c0] = (bf16_t)f2bf(v0); QKVU[(size_t)r * INP + c1] = (bf16_t)f2bf(v1); });
}
__global__ void k_g1b(const bf16_t* MEMB, const bf16_t* WT, const float* rstd, bf16_t* KM, bf16_t* VMT) {
    NV_TILE();
    wave_gemm(m0, n0, D, -1, [=](int r) { return MEMB + (size_t)r * D; }, [=](int c) { return WT + (size_t)c * D; }, NoMid(),
        [=](int r, int c0, int c1, float v0, float v1) { const float s = rstd[r]; const int cc[2] = {c0, c1}; const float vv[2] = {v0 * s, v1 * s};
#pragma unroll
            for (int q = 0; q < 2; ++q) { const int c = cc[q];
                if (c < D) KM[(size_t)r * D + c] = (bf16_t)f2bf(vv[q]);
                else VMT[((size_t)(r >> 8) * D + (c - D)) * NMEM + (r & 255)] = (bf16_t)f2bf(vv[q]); } });
}
__global__ void __launch_bounds__(256) k_sb(const bf16_t* QKVU, bf16_t* MIXED, float* SSQSB) {
    const int gid = blockIdx.x * 256 + threadIdx.x; const int t = gid & (S - 1), h = (gid >> 12) & 7, b = gid >> 15;
    const bf16_t* base = QKVU + (size_t)b * S * INP;
    float q[HD], o[HD];
    { const bf16_t* qp = base + (size_t)t * INP + h * HD;
#pragma unroll
      for (int d = 0; d < HD; ++d) { q[d] = bf2f(qp[d]); o[d] = 0.f; } }
    float P = 1.f;
    for (int s = t - 1; s >= 0; --s) {
        const bf16_t* kp = base + (size_t)s * INP + SBW + h * HD; const bf16_t* vp = kp + SBW;
        float z = 0.f;
#pragma unroll
        for (int d = 0; d < HD; ++d) z += q[d] * bf2f(kp[d]);
        const float e = exp2f(z), r = 1.0f / (1.0f + e), beta = 1.0f - r;
        const float w = bf2f((bf16_t)f2bf(beta * P));
#pragma unroll
        for (int d = 0; d < HD; ++d) o[d] += w * bf2f(vp[d]);
        P *= r;
        if (P == 0.f) break;
    }
    float ss = 0.f; bf16_t* op = MIXED + (size_t)(b * S + t) * D + h * HD;
#pragma unroll
    for (int d = 0; d < HD; ++d) { ss += o[d] * o[d]; op[d] = (bf16_t)f2bf(o[d]); }
    unsafeAtomicAdd(SSQSB + b * S + t, ss);
}
__global__ void k_pool1(const bf16_t* QKVU, bf16_t* POOLED) {
    const size_t gid = (size_t)blockIdx.x * 256 + threadIdx.x; const int c = gid & 511; const int tok = (int)(gid >> 9), t = tok & (S - 1);
    const int win = 2 << (c >> 7); const int n = (t + 1 < win) ? t + 1 : win;
    const bf16_t* up = QKVU + (size_t)tok * INP + 3 * SBW + c; float s = 0.f;
    for (int j = 0; j < n; ++j) s += bf2f(up[-(ptrdiff_t)j * INP]);
    POOLED[gid] = (bf16_t)f2bf(s / (float)n - bf2f(up[0]));
}
__global__ void k_pool2(const bf16_t* POOLED, const bf16_t* WPT, float* POOLO) {
    NV_TILE(); const int g = blockIdx.z;
    wave_gemm(m0, n0, PGD, -1, [=](int r) { return POOLED + (size_t)r * PW + g * PGD; }, [=](int c) { return WPT + ((size_t)g * PGD + c) * PGD; }, NoMid(),
        [=](int r, int c0, int c1, float v0, float v1) { POOLO[(size_t)r * PW + g * PGD + c0] = v0; POOLO[(size_t)r * PW + g * PGD + c1] = v1; });
}
__global__ void k_pool3(const float* POOLO, bf16_t* MIXED) {
    const int tok = blockIdx.x * 4 + (threadIdx.x >> 6), lane = threadIdx.x & 63;
    float v[8], s = 0.f;
#pragma unroll
    for (int j = 0; j < 8; ++j) { v[j] = POOLO[(size_t)tok * PW + lane + 64 * j]; s += v[j] * v[j]; }
    const float rs = 1.0f / sqrtf(wave_sum(s) * (1.0f / PW) + EPS);
#pragma unroll
    for (int j = 0; j < 8; ++j) MIXED[(size_t)tok * D + SBW + lane + 64 * j] = (bf16_t)f2bf(v[j] * rs);
}
__global__ void k_resid(const bf16_t* A, const bf16_t* WT, const float* xin, float* xout, bf16_t* XB, float* SSQ, const float* ssq_mid, int kmid) {
    NV_TILE();
    wave_gemm(m0, n0, D, kmid, [=](int r) { return A + (size_t)r * D; }, [=](int c) { return WT + (size_t)c * D; },
        [=](int r) { return 1.0f / sqrtf(ssq_mid[r] * (1.0f / SBW) + EPS); },
        [=](int r, int c0, int c1, float v0, float v1) {
            const float x0 = xin[(size_t)r * D + c0] + v0, x1 = xin[(size_t)r * D + c1] + v1;
            xout[(size_t)r * D + c0] = x0; xout[(size_t)r * D + c1] = x1;
            XB[(size_t)r * D + c0] = (bf16_t)f2bf(x0); XB[(size_t)r * D + c1] = (bf16_t)f2bf(x1);
            float q = x0 * x0 + x1 * x1; q += __shfl_xor(q, 1); q += __shfl_xor(q, 2); q += __shfl_xor(q, 4); q += __shfl_xor(q, 8);
            if ((threadIdx.x & 15) == 0) unsafeAtomicAdd(SSQ + r, q); });
}
__global__ void k_g3(const bf16_t* X1B, const bf16_t* WT, const float* SSQ1, bf16_t* QM) {
    NV_TILE();
    wave_gemm(m0, n0, D, -1, [=](int r) { return X1B + (size_t)r * D; }, [=](int c) { return WT + (size_t)c * D; }, NoMid(),
        [=](int r, int c0, int c1, float v0, float v1) { const float s = C2_MEM / sqrtf(SSQ1[r] * (1.0f / D) + EPS);
            QM[(size_t)r * D + c0] = (bf16_t)f2bf(v0 * s); QM[(size_t)r * D + c1] = (bf16_t)f2bf(v1 * s); });
}
__global__ void k_ms(const bf16_t* QM, const bf16_t* KM, float* SCR) {
    NV_TILE(); const int h = blockIdx.z; const int b = m0 >> 12;
    wave_gemm(m0, n0, MHD, -1, [=](int r) { return QM + (size_t)r * D + h * MHD; }, [=](int c) { return KM + ((size_t)b * NMEM + c) * D + h * MHD; }, NoMid(),
        [=](int r, int c0, int c1, float v0, float v1) { SCR[((size_t)r * MH + h) * NMEM + c0] = v0; SCR[((size_t)r * MH + h) * NMEM + c1] = v1; });
}
__global__ void k_msoftmax(const float* SCR, bf16_t* PM) {
    const int row = blockIdx.x * 4 + (threadIdx.x >> 6), lane = threadIdx.x & 63;
    float v[4], m = -INFINITY;
#pragma unroll
    for (int j = 0; j < 4; ++j) { v[j] = SCR[(size_t)row * NMEM + lane + 64 * j]; m = fmaxf(m, v[j]); }
#pragma unroll
    for (int o = 1; o < 64; o <<= 1) m = fmaxf(m, __shfl_xor(m, o));
    float s = 0.f;
#pragma unroll
    for (int j = 0; j < 4; ++j) { v[j] = exp2f(v[j] - m); s += v[j]; }
    s = 1.0f / wave_sum(s);
#pragma unroll
    for (int j = 0; j < 4; ++j) PM[(size_t)row * NMEM + lane + 64 * j] = (bf16_t)f2bf(v[j] * s);
}
__global__ void k_mpv(const bf16_t* PM, const bf16_t* VMT, bf16_t* OM) {
    NV_TILE(); const int h = blockIdx.z; const int b = m0 >> 12;
    wave_gemm(m0, n0, NMEM, -1, [=](int r) { return PM + ((size_t)r * MH + h) * NMEM; }, [=](int c) { return VMT + ((size_t)b * D + h * MHD + c) * NMEM; }, NoMid(),
        [=](int r, int c0, int c1, float v0, float v1) { OM[(size_t)r * D + h * MHD + c0] = (bf16_t)f2bf(v0); OM[(size_t)r * D + h * MHD + c1] = (bf16_t)f2bf(v1); });
}
__global__ void k_route(const float* x2, const float* SSQ2, const float* WR, const float* br, int* CNT, int* LSLOT, float* LGATE) {
    const int tok = blockIdx.x * 4 + (threadIdx.x >> 6), lane = threadIdx.x & 63;
    float xv[16];
#pragma unroll
    for (int j = 0; j < 16; ++j) xv[j] = x2[(size_t)tok * D + lane + 64 * j];
    const float rs = 1.0f / sqrtf(SSQ2[tok] * (1.0f / D) + EPS);
    float mine = 0.f;
    for (int e = 0; e < NE; ++e) { float s = 0.f;
#pragma unroll
        for (int j = 0; j < 16; ++j) s += xv[j] * WR[e * D + lane + 64 * j];
        s = wave_sum(s); if (lane == e) mine = s * rs + br[e]; }
    float tv[4]; int ti[4]; float cur = (lane < NE) ? mine : -INFINITY;
#pragma unroll
    for (int k = 0; k < 4; ++k) { float m = cur; int mi = lane;
#pragma unroll
        for (int o = 1; o < 64; o <<= 1) { const float om = __shfl_xor(m, o); const int oi = __shfl_xor(mi, o); if (om > m || (om == m && oi < mi)) { m = om; mi = oi; } }
        tv[k] = m; ti[k] = mi; if (lane == mi) cur = -INFINITY; }
    float g[4], gs = 0.f;
#pragma unroll
    for (int k = 0; k < 4; ++k) { g[k] = expf(tv[k] - tv[0]); gs += g[k]; }
    if (lane < 4) { int e = ti[0]; float gg = g[0];
        if (lane == 1) { e = ti[1]; gg = g[1]; } if (lane == 2) { e = ti[2]; gg = g[2]; } if (lane == 3) { e = ti[3]; gg = g[3]; }
        const int pos = atomicAdd(CNT + e, 1); LSLOT[(size_t)e * LCAP + pos] = tok * 4 + lane; LGATE[(size_t)e * LCAP + pos] = gg / gs; }
}
__device__ __forceinline__ int tile_base(const int* CNT, int e) { int tb = 0; for (int i = 0; i < e; ++i) tb += (CNT[i] + 255) >> 8; return tb; }
__global__ void k_w1(const bf16_t* X2B, const float* SSQ2, const bf16_t* W1T, const float* b1, const int* CNT, const int* LSLOT, bf16_t* ACT) {
    const int e = blockIdx.z, cnt = CNT[e]; const int w = threadIdx.x >> 6; const int m0 = blockIdx.y * 64 + (w >> 1) * 32; if (blockIdx.y * 64 >= cnt) return;
    const int gc0 = blockIdx.x * 32 + (w & 1) * 16;
    const int pn = gc0 >> 7, j0 = gc0 & 127; const int n0 = pn * 256 + j0;
    const int tb = tile_base(CNT, e); const bf16_t* Wt = W1T + (size_t)e * 2 * DFF * D; const int* ls = LSLOT + (size_t)e * LCAP;
    wave_gemm(m0, 0, D, -1, [=](int r) { const int tok = (r < cnt) ? (ls[r] >> 2) : 0; return X2B + (size_t)tok * D; },
        [=](int c) { const int rowb = (c < 16) ? n0 + c : n0 + 128 + (c - 16); return Wt + (size_t)rowb * D; }, NoMid(),
        [=](int r, int c0, int c1, float vg, float vu) { if (r >= cnt) return; const int tok = ls[r] >> 2; const float rs = 1.0f / sqrtf(SSQ2[tok] * (1.0f / D) + EPS);
            const int gc = gc0 + c0;
            float gate = vg * rs + b1[e * 2 * DFF + gc], up = vu * rs + b1[e * 2 * DFF + DFF + gc];
            gate = fminf(gate, SW_LIMIT); up = fminf(fmaxf(up, -SW_LIMIT), SW_LIMIT);
            const float act = (up + 1.0f) * gate / (1.0f + expf(-SW_ALPHA * gate));
            ACT[((size_t)tb * 256 + r) * DFF + gc] = (bf16_t)f2bf(act); (void)c1; });
}
__global__ void k_w2(const bf16_t* ACT, const bf16_t* W2T, const float* b2, const int* CNT, const int* LSLOT, const float* LGATE, bf16_t* Y) {
    const int e = blockIdx.z, cnt = CNT[e]; if (blockIdx.y * 64 >= cnt) return; NV_TILE();
    const int tb = tile_base(CNT, e); const bf16_t* Wt = W2T + (size_t)e * D * DFF; const int* ls = LSLOT + (size_t)e * LCAP; const float* lg = LGATE + (size_t)e * LCAP;
    wave_gemm(m0, n0, DFF, -1, [=](int r) { return ACT + ((size_t)tb * 256 + r) * DFF; }, [=](int c) { return Wt + (size_t)c * DFF; }, NoMid(),
        [=](int r, int c0, int c1, float v0, float v1) { if (r >= cnt) return; const int slot = ls[r]; const float g = lg[r];
            Y[(size_t)slot * D + c0] = (bf16_t)f2bf((v0 + b2[e * D + c0]) * g); Y[(size_t)slot * D + c1] = (bf16_t)f2bf((v1 + b2[e * D + c1]) * g); });
}
__global__ void k_final(float* out, const bf16_t* Y, const float* gf) {
    const int tok = blockIdx.x * 4 + (threadIdx.x >> 6), lane = threadIdx.x & 63;
    float v[16], s = 0.f;
#pragma unroll
    for (int j = 0; j < 16; ++j) { const int c = lane + 64 * j; float a = out[(size_t)tok * D + c];
#pragma unroll
        for (int k = 0; k < 4; ++k) a += bf2f(Y[((size_t)tok * 4 + k) * D + c]);
        v[j] = a; s += a * a; }
    const float rs = 1.0f / sqrtf(wave_sum(s) * (1.0f / D) + EPS);
#pragma unroll
    for (int j = 0; j < 16; ++j) { const int c = lane + 64 * j; out[(size_t)tok * D + c] = v[j] * rs * gf[c]; }
}
}

#define LAS __attribute__((address_space(3)))
#define GAS __attribute__((address_space(1)))
typedef int v4i_t __attribute__((ext_vector_type(4)));
typedef int v8i_t __attribute__((ext_vector_type(8)));
namespace pg8 {
constexpr int BM = 256, BK = 64, HALF = 128, HTB = HALF * BK * 2, STAGE_BYTES = 8 * HTB, NXCD = 8, WGM = 8;
__host__ __device__ __forceinline__ int lds_byte(int r, int c) { const int st = (r >> 4) * 2 + (c >> 5), rr = r & 15, cc = c & 31, ob = rr * 64 + cc * 2; return st * 1024 + (ob ^ (((ob >> 9) & 1) << 5)); }
__host__ __device__ __forceinline__ void stage_rc(int b, int& R, int& C) { const int st = b / 1024, sb = b % 1024, swz = sb ^ (((sb >> 9) & 1) << 5); R = (st >> 1) * 16 + swz / 64; C = (st & 1) * 32 + (swz % 64) / 2; }
__host__ __device__ __forceinline__ int perm32(int rho) { const int n = rho >> 4, i = rho & 15; return 8 * (i >> 2) + 4 * n + (i & 3); }
__device__ __forceinline__ unsigned cvt_pk_bf16(float lo, float hi) { unsigned r; asm volatile("v_cvt_pk_bf16_f32 %0, %1, %2" : "=v"(r) : "v"(lo), "v"(hi)); return r; }

#define WTMASK 0x008
#ifndef WTMASK
#define WTMASK 0x1ff
#endif
#define WT_ON(bit) (((WTMASK) >> (bit)) & 1)
__device__ __forceinline__ void st16_wt(void* p, u32x4 v) { asm volatile("global_store_dwordx4 %0, %1, off sc1\n\ts_nop 1" :: "v"(p), "v"(v)); }
__device__ __forceinline__ void st16_wt(void* p, f32x4 v) { asm volatile("global_store_dwordx4 %0, %1, off sc1\n\ts_nop 1" :: "v"(p), "v"(v)); }
template <int BIT, class V> __device__ __forceinline__ void st16(void* p, V v) { if constexpr (WT_ON(BIT)) st16_wt(p, v); else *(V*)p = v; }
#ifndef WT8
#define WT8 0
#endif
__device__ __forceinline__ void st8_wt(void* p, unsigned long long v) { if (WT8) __hip_atomic_store((unsigned long long*)p, v, __ATOMIC_RELAXED, __HIP_MEMORY_SCOPE_AGENT); else *(unsigned long long*)p = v; }
__device__ __forceinline__ void st4_wt(void* p, unsigned v) { if (WT8) __hip_atomic_store((unsigned*)p, v, __ATOMIC_RELAXED, __HIP_MEMORY_SCOPE_AGENT); else *(unsigned*)p = v; }
__device__ __forceinline__ int fresh_lane() { int l; asm volatile("v_mbcnt_lo_u32_b32 %0, -1, 0\n\tv_mbcnt_hi_u32_b32 %0, -1, %0" : "=v"(l)); return l; }
struct Unit { const char* A; const char* B; void* p0; void* p1; void* p2; void* p3; int pm, pn, i0, i1, ghost; };

__device__ __forceinline__ int xcd_remap(int L, int nwg) { const int q = nwg / NXCD, r = nwg % NXCD, xcd = L % NXCD, off = L / NXCD; return __builtin_amdgcn_readfirstlane((xcd < r ? xcd * (q + 1) : r * (q + 1) + (xcd - r) * q) + off); }
__device__ __forceinline__ void grouped_mn(int wgid, int nM, int nN, int& pm, int& pn) {
    const int nig = WGM * nN, gid = wgid / nig, fm = gid * WGM, gsz = (nM - fm) < WGM ? (nM - fm) : WGM; pm = __builtin_amdgcn_readfirstlane(fm + ((wgid % nig) % gsz)); pn = __builtin_amdgcn_readfirstlane((wgid % nig) / gsz); }

template <class Epi, class Sched, int TABS, int REP = 1, int REPE = 1, bool F8 = false>
__device__ __forceinline__ void gemm_phase(const int wid, LAS unsigned char* lds, LAS unsigned char* epi_lds, LAS unsigned* gtab, const int lda_b, const int ldb_b, const int nt, const Sched& S, const Epi& E) {
    constexpr bool GATHER = (TABS == 1);
    const int wr = wid >> 2, wc = wid & 3;
    unsigned voffA, voffB, voffG[2][2]; int aoff, boff;
    { const int lane = fresh_lane(); int R, C; stage_rc(wid * 1024 + lane * 16, R, C); const int Rb = Epi::PERM ? ((R & ~31) + perm32(R & 31)) : R;
      voffA = (unsigned)(R * lda_b + C * 2); voffB = (unsigned)(Rb * ldb_b + C * 2); voffG[0][0] = voffG[0][1] = voffG[1][0] = voffG[1][1] = 0;
      aoff = lds_byte(wr * 64 + (lane & 15), (lane >> 4) * 8); boff = lds_byte(wc * 32 + (lane & 15), (lane >> 4) * 8); }
    const size_t kstep = (size_t)(BK * 2);
    const size_t hstepA = (size_t)HALF * lda_b, hstepB = (size_t)HALF * ldb_b;
    const unsigned ldsw = (unsigned)wid * 1024u; const unsigned ldsbase = (unsigned)(uintptr_t)lds + ldsw;
#define PG8_SA(b, h) (((b) * 2 + (h)) * HTB)
#define PG8_SB(b, h) ((4 + (b) * 2 + (h)) * HTB)
#define PG8_GLDS(ugp, voff, bufoff, _i) do { unsigned _keep; asm volatile("s_mov_b32 %0, m0\n\ts_mov_b32 m0, %3\n\ts_nop 0\n\tglobal_load_lds_dwordx4 %1, %2\n\ts_mov_b32 m0, %0" \
        : "=&s"(_keep) : "v"(voff), "s"((const char*)(ugp)), "s"(ldsbase + (unsigned)((bufoff) + (_i) * 8192)) : "memory"); } while (0)
#define PG8_STAGE_B(bufoff, gbase) do { _Pragma("unroll") for (int _i = 0; _i < 2; ++_i) PG8_GLDS((const char*)(gbase) + (size_t)_i * 64 * ldb_b, voffB, bufoff, _i); } while (0)
#define PG8_STAGE_A(bufoff, gbase, h) do { if constexpr (GATHER) { _Pragma("unroll") for (int _i = 0; _i < 2; ++_i) PG8_GLDS((const char*)(gbase), voffG[h][_i], bufoff, _i); } \
        else { _Pragma("unroll") for (int _i = 0; _i < 2; ++_i) PG8_GLDS((const char*)(gbase) + (h) * hstepA + (size_t)_i * 64 * lda_b, voffA, bufoff, _i); } } while (0)
#define PG8_LDA(dst, b, h) do { _Pragma("unroll") for (int m = 0; m < 4; ++m) _Pragma("unroll") for (int k = 0; k < 2; ++k) dst[m][k] = *(const LAS bf16x8*)(lds + PG8_SA(b, h) + aoff + m * 2048 + k * 1024); } while (0)
#define PG8_LDB(dst, b, h) do { _Pragma("unroll") for (int n = 0; n < 2; ++n) _Pragma("unroll") for (int k = 0; k < 2; ++k) dst[n][k] = *(const LAS bf16x8*)(lds + PG8_SB(b, h) + boff + n * 2048 + k * 1024); } while (0)
#define PG8_CAT(x0, x1) __builtin_shufflevector(__builtin_bit_cast(v4i_t, x0), __builtin_bit_cast(v4i_t, x1), 0, 1, 2, 3, 4, 5, 6, 7)
#define PG8_MMA(ai, bj, At, Bt) do { __builtin_amdgcn_s_setprio(1); _Pragma("unroll") for (int m = 0; m < 4; ++m) _Pragma("unroll") for (int n = 0; n < 2; ++n) { \
        if constexpr (F8) acc[ai][bj][m][n] = __builtin_amdgcn_mfma_scale_f32_16x16x128_f8f6f4(PG8_CAT(Bt[n][0], Bt[n][1]), PG8_CAT(At[m][0], At[m][1]), acc[ai][bj][m][n], 0, 0, 0, 0, 0, 0); \
        else { _Pragma("unroll") for (int k = 0; k < 2; ++k) acc[ai][bj][m][n] = __builtin_amdgcn_mfma_f32_16x16x32_bf16(Bt[n][k], At[m][k], acc[ai][bj][m][n], 0, 0, 0); } } __builtin_amdgcn_s_setprio(0); } while (0)
#define PG8_WAIT_V(n) asm volatile("s_waitcnt vmcnt(" #n ")" ::: "memory")
#define PG8_WAIT_L(n) asm volatile("s_waitcnt lgkmcnt(" #n ")" ::: "memory")
#define PG8_BAR __builtin_amdgcn_s_barrier()
#define PG8_SCHED __builtin_amdgcn_sched_barrier(0)
#define PG8_GTAB_LOAD(buf, nvalid) do { const int _l = fresh_lane(); int _R, _C; stage_rc(wid * 1024 + _l * 16, _R, _C); _Pragma("unroll") for (int _h = 0; _h < 2; ++_h) _Pragma("unroll") for (int _i = 0; _i < 2; ++_i) { \
        const int _row = _h * HALF + _R + 64 * _i; const unsigned _s = gtab[(buf) * 768 + _row]; voffG[_h][_i] = ((_row < (nvalid)) ? (_s >> 2) * (unsigned)lda_b : 0u) + (unsigned)(_C * 2); } } while (0)
#define PG8_GTAB_DMA(buf, U) do { if (wid < 3) { const int _l = fresh_lane(); const char* _src = (wid == 0) ? (const char*)(U).p3 + _l * 16 : (wid == 1) ? (const char*)(U).p2 + _l * 16 : \
            (TABS == 1 ? (const char*)(U).p1 + (_l & 31) * 16 + (_l >> 5) * (DFF * 4) : (const char*)(U).p1 + _l * 16); \
        __builtin_amdgcn_global_load_lds((const unsigned*)_src, (LAS unsigned*)(gtab + (buf) * 768 + wid * 256), 16, 0, 0); } } while (0)
    auto nextu = [&](int i, Unit& u) -> bool { if constexpr (REP > 1) { const bool ok = S.next(i / REP, u); u.ghost = (i % REP) != REP - 1; return ok; } else { u.ghost = 0; return S.next(i, u); } };
    Unit cur, nxt; int ui = 0;
    if (!nextu(0, cur)) return;
    f32x4 acc[2][2][4][2];
#pragma unroll
    for (int a = 0; a < 2; ++a)
#pragma unroll
        for (int b = 0; b < 2; ++b)
#pragma unroll
            for (int m = 0; m < 4; ++m)
#pragma unroll
                for (int n = 0; n < 2; ++n) acc[a][b][m][n] = (f32x4){0.f, 0.f, 0.f, 0.f};
    bf16x8 At[4][2], B0[2][2], B1[2][2];
    const char* cA = cur.A; const char* cB = cur.B;
    if constexpr (TABS != 0) { PG8_GTAB_DMA(0, cur); PG8_WAIT_V(0); PG8_WAIT_L(0); PG8_BAR; if constexpr (GATHER) PG8_GTAB_LOAD(0, cur.i0); }
    PG8_STAGE_B(PG8_SB(0, 0), cB); PG8_STAGE_B(PG8_SB(0, 1), cB + hstepB); PG8_STAGE_A(PG8_SA(0, 0), cA, 0); PG8_STAGE_A(PG8_SA(0, 1), cA, 1);
    if (wr == 1) PG8_BAR;
    PG8_WAIT_V(2); PG8_BAR;
    PG8_STAGE_B(PG8_SB(1, 0), cB + kstep); PG8_STAGE_A(PG8_SA(1, 0), cA + kstep, 0); PG8_STAGE_B(PG8_SB(1, 1), cB + hstepB + kstep);
    PG8_WAIT_V(6); PG8_BAR;
    for (;;) {
        const bool has_next = nextu(ui + 1, nxt);
        const char* nA = has_next ? nxt.A : cA; const char* nB = has_next ? nxt.B : cB;
#pragma unroll 1
        for (int t = 0; t < nt; t += 2) {
            const bool last = (t == nt - 2);
            const char* a1 = cA + (size_t)(t + 1) * kstep;
            const char* a2 = last ? nA : cA + (size_t)(t + 2) * kstep; const char* b2 = last ? nB : cB + (size_t)(t + 2) * kstep;
            const char* a3 = a2 + kstep; const char* b3 = b2 + kstep;
            if constexpr (Epi::MIDK >= 0) { if (t == Epi::MIDK) E.midk(acc, cur, wr, fresh_lane() & 15); }
            if constexpr (TABS != 0) { if (t == 2 && has_next) PG8_GTAB_DMA((ui + 1) & 1, nxt); }
            if constexpr (GATHER) { PG8_STAGE_A(PG8_SA(1, 1), a1, 1); if (last && has_next) PG8_GTAB_LOAD((ui + 1) & 1, nxt.i0); PG8_SCHED; }
            PG8_LDB(B0, 0, 0); PG8_LDB(B1, 0, 1); PG8_SCHED; PG8_LDA(At, 0, 0); if constexpr (!GATHER) PG8_STAGE_A(PG8_SA(1, 1), a1, 1);
            PG8_WAIT_V(8); PG8_WAIT_L(0); PG8_BAR; PG8_MMA(0, 0, At, B0); PG8_MMA(0, 1, At, B1); PG8_BAR; PG8_SCHED;
            PG8_LDA(At, 0, 1); PG8_STAGE_B(PG8_SB(0, 0), b2); PG8_STAGE_B(PG8_SB(0, 1), b2 + hstepB); PG8_STAGE_A(PG8_SA(0, 0), a2, 0);
            PG8_WAIT_V(8); PG8_WAIT_L(0); PG8_BAR; PG8_MMA(1, 0, At, B0); PG8_MMA(1, 1, At, B1); PG8_BAR; PG8_SCHED;
            PG8_LDB(B0, 1, 0); PG8_LDB(B1, 1, 1); PG8_SCHED; PG8_LDA(At, 1, 0); PG8_STAGE_A(PG8_SA(0, 1), a2, 1);
            PG8_WAIT_V(8); PG8_WAIT_L(0); PG8_BAR; PG8_MMA(0, 0, At, B0); PG8_MMA(0, 1, At, B1); PG8_BAR; PG8_SCHED;
            PG8_LDA(At, 1, 1); PG8_STAGE_B(PG8_SB(1, 0), b3); PG8_STAGE_B(PG8_SB(1, 1), b3 + hstepB); PG8_STAGE_A(PG8_SA(1, 0), a3, 0);
            PG8_WAIT_V(8); PG8_WAIT_L(0); PG8_BAR; PG8_MMA(1, 0, At, B0); PG8_MMA(1, 1, At, B1); PG8_BAR; PG8_SCHED;
        }
        if (wr == 0) PG8_BAR;
        if (!cur.ghost) { const int el = fresh_lane(); LAS unsigned char* ex = (TABS != 0) ? (LAS unsigned char*)(gtab + (ui & 1) * 768) : epi_lds; E(acc, cur, wr, wc, el & 15, el >> 4, wid, el, ex); if constexpr (REPE > 1) { asm volatile("" ::: "memory"); E(acc, cur, wr, wc, el & 15, el >> 4, wid, el, ex); } }
        if (!has_next) break;
#pragma unroll
        for (int a = 0; a < 2; ++a)
#pragma unroll
            for (int b = 0; b < 2; ++b)
#pragma unroll
                for (int m = 0; m < 4; ++m)
#pragma unroll
                    for (int n = 0; n < 2; ++n) acc[a][b][m][n] = (f32x4){0.f, 0.f, 0.f, 0.f};
        cur = nxt; cA = nA; cB = nB; ++ui;
        if (wr == 1) PG8_BAR;
    }
    PG8_WAIT_V(0);
    PG8_BAR;
#undef PG8_SA
#undef PG8_SB
#undef PG8_GLDS
#undef PG8_STAGE_A
#undef PG8_STAGE_B
#undef PG8_LDA
#undef PG8_LDB
#undef PG8_MMA
#undef PG8_CAT
#undef PG8_WAIT_V
#undef PG8_WAIT_L
#undef PG8_BAR
#undef PG8_SCHED
#undef PG8_GTAB_LOAD
#undef PG8_GTAB_DMA
}

struct EpiBf16S {
    static constexpr bool PERM = true; static constexpr int MIDK = -1;
    __device__ __forceinline__ void midk(f32x4 (&)[2][2][4][2], const Unit&, int, int) const {}
    __device__ __forceinline__ void operator()(const f32x4 (&acc)[2][2][4][2], const Unit& u, int wr, int wc, int fr, int fq, int, int, LAS unsigned char*) const {
        bf16_t* O = (bf16_t*)u.p0; const float* rs = (const float*)u.p1; const float* cs = (const float*)u.p2; const int ldc = u.i0;
        int r0 = wr * 64 + fr, c0 = wc * 32 + 8 * fq; asm volatile("" : "+v"(r0), "+v"(c0));
        f32x4 cv[2][2];
#pragma unroll
        for (int bj = 0; bj < 2; ++bj)
#pragma unroll
            for (int n = 0; n < 2; ++n) cv[bj][n] = cs ? *(const f32x4*)(cs + c0 + bj * HALF + 4 * n) : (f32x4){1.f, 1.f, 1.f, 1.f};
#pragma unroll
        for (int ai = 0; ai < 2; ++ai)
#pragma unroll
            for (int m = 0; m < 4; ++m) { const int r = r0 + ai * HALF + m * 16; const float rv = rs ? rs[r] : 1.f; bf16_t* rowp = O + (size_t)r * ldc + c0;
#pragma unroll
                for (int bj = 0; bj < 2; ++bj) { const f32x4 v0 = acc[ai][bj][m][0] * cv[bj][0] * rv, v1 = acc[ai][bj][m][1] * cv[bj][1] * rv;
                    u32x4 w; w.x = cvt_pk_bf16(v0[0], v0[1]); w.y = cvt_pk_bf16(v0[2], v0[3]); w.z = cvt_pk_bf16(v1[0], v1[1]); w.w = cvt_pk_bf16(v1[2], v1[3]);
                    st16<1>(rowp + bj * HALF, w); } }
    }
};
}

namespace mk {
constexpr int NWAVES = 8, NPHASE = 12;
constexpr int RING_OFF = 0, RING_BYTES = 131072, EPI_OFF = 131072, EPI_BYTES = 8192, GTAB_OFF = EPI_OFF + EPI_BYTES, GTAB_BYTES = 6144, MISC_OFF = GTAB_OFF + GTAB_BYTES, MISC_BYTES = 1024;
constexpr int LDS_BYTES = 147456;
static_assert(MISC_OFF + MISC_BYTES <= LDS_BYTES, "LDS map");
constexpr size_t WS_LRS = 84 * MiB;
constexpr size_t WS_X2F8 = WS_Y;
constexpr size_t WS_CSG1 = 19 * MiB, WS_WRH = 19 * MiB + 64 * 1024, WS_WRL = 19 * MiB + 128 * 1024;
constexpr float WSCALE = 32.0f;
constexpr int CW_BAR = 1024;

#define RLX_AGENT __ATOMIC_RELAXED, __HIP_MEMORY_SCOPE_AGENT
#define LDS_WAIT() asm volatile("s_waitcnt lgkmcnt(0)" ::: "memory")
#define VM_WAIT() asm volatile("s_waitcnt vmcnt(0)" ::: "memory")
#define XB_TMO      128
#define XB_XCNT(j)  (256  + 64 * (j))
#define XB_XSUB(j)  (1280 + 64 * (j))
#define XB_XGEN(j)  (2304 + 64 * (j))
#define XB_TOP      3328
#define XB_TOPGEN   3392
#define XCD_BAR_WORDS 3456
#define XB_SPIN_CAP (1u << 20)
__device__ __forceinline__ unsigned xb_ld(unsigned* p)              { return __hip_atomic_load(p, __ATOMIC_RELAXED, __HIP_MEMORY_SCOPE_AGENT); }
__device__ __forceinline__ unsigned xb_add(unsigned* p, unsigned v) { return __hip_atomic_fetch_add(p, v, __ATOMIC_RELAXED, __HIP_MEMORY_SCOPE_AGENT); }
__device__ __forceinline__ unsigned xb_xcc_id() { return (unsigned)__builtin_amdgcn_s_getreg((3 << 11) | 20) & 0xFu; }
#define XB_SPIN(cond, bar) do { unsigned _sp = 0; while (cond) { __builtin_amdgcn_s_sleep(1); \
    if ((++_sp & 255u) == 0u) { if (xb_ld(&(bar)[XB_TMO])) break; if (_sp > XB_SPIN_CAP) { atomicAdd(&(bar)[XB_TMO], 1u); break; } } } } while (0)
struct XcdBarrier { unsigned* bar; unsigned x; volatile LAS unsigned* st; };
__device__ __forceinline__ XcdBarrier xcd_barrier_post(unsigned* bar, volatile LAS unsigned* st) {
    XcdBarrier b; b.bar = bar; b.x = xb_xcc_id(); b.st = st;
    if (threadIdx.x == 0) (void)xb_add(&bar[XB_XCNT(b.x)], 1u);
    return b;
}
__device__ __forceinline__ void xcd_barrier_complete(unsigned* bar, unsigned x, unsigned& nloc, unsigned& nx) {
    const unsigned G = gridDim.x * gridDim.y * gridDim.z;
    unsigned sum, cnt, mine, sp = 0u;
    for (;;) {
        sum = 0u; cnt = 0u; mine = 0u;
#pragma unroll
        for (unsigned j = 0; j < 16; ++j) { const unsigned c = xb_ld(&bar[XB_XCNT(j)]); sum += c; cnt += (c > 0u) ? 1u : 0u; mine = (j == x) ? c : mine; }
        if (sum == G) break;
        __builtin_amdgcn_s_sleep(1);
        if ((++sp & 255u) == 0u) { if (xb_ld(&bar[XB_TMO])) break; if (sp > XB_SPIN_CAP) { atomicAdd(&bar[XB_TMO], 1u); break; } }
    }
    nloc = mine > 0u ? mine : 1u; nx = cnt > 0u ? cnt : 1u;
}
__device__ __forceinline__ void xcd_barrier(const XcdBarrier& b) {
    asm volatile("s_waitcnt vmcnt(0)" ::: "memory");
    __syncthreads();
    if (threadIdx.x == 0) {
        unsigned* bar = b.bar;
        __builtin_amdgcn_s_waitcnt(0);
        unsigned nloc = b.st[0], nx = b.st[1];
        if (nloc == 0u) { xcd_barrier_complete(bar, b.x, nloc, nx); b.st[0] = nloc; b.st[1] = nx; }
        const unsigned old = xb_add(&bar[XB_XSUB(b.x)], 1u);
        const unsigned gen = old / nloc;
        if (old + 1u == (gen + 1u) * nloc) {
            __builtin_amdgcn_fence(__ATOMIC_RELEASE, "agent");
            asm volatile("s_waitcnt vmcnt(0)" ::: "memory");
            const unsigned og = xb_add(&bar[XB_TOP], 1u);
            const unsigned tg = og / nx;
            if (og + 1u == (tg + 1u) * nx) xb_add(&bar[XB_TOPGEN], 1u);
            else XB_SPIN(xb_ld(&bar[XB_TOPGEN]) == tg, bar);
            __builtin_amdgcn_fence(__ATOMIC_ACQUIRE, "agent");
            xb_add(&bar[XB_XGEN(b.x)], 1u);
            asm volatile("s_waitcnt vmcnt(0)" ::: "memory");
        } else {
            XB_SPIN(xb_ld(&bar[XB_XGEN(b.x)]) == gen, bar);
            __builtin_amdgcn_fence(__ATOMIC_ACQUIRE, "agent");
            asm volatile("s_waitcnt vmcnt(0)" ::: "memory");
        }
    }
    __syncthreads();
}

struct Args { const float* in[22]; float* out; unsigned char* ws; int ph_lo, ph_hi, li, pad; };

template <bool F8OUT>
__device__ __forceinline__ void p0_item(const float* W, int K, int N, void* WTv, const float* gk, const float* gk2, int ksplit, const float* gn, int mode, LAS float* scr, int item, int lane, float mult = 1.0f, int nblk_dec = 0) {
    const int nblk = nblk_dec ? nblk_dec : N / 32, kb = item / nblk, nb = item % nblk, k0 = 64 * kb, nd0 = 32 * nb;
    int ns0 = nd0; if (mode == 1) { const int pn = nd0 >> 8, j = nd0 & 255; ns0 = (j < 128) ? 128 * pn + j : 1024 + 128 * pn + (j - 128); }
    const int kr = lane >> 3, n4 = (lane & 7) * 4;
    f32x4 v[8];
#pragma unroll
    for (int i = 0; i < 8; ++i) v[i] = *(const f32x4*)(W + (size_t)(k0 + 8 * i + kr) * N + ns0 + n4);
    f32x4 gnv = (f32x4){1.f, 1.f, 1.f, 1.f}; if (gn) gnv = *(const f32x4*)(gn + ns0 + n4);
#pragma unroll
    for (int i = 0; i < 8; ++i) { const int kk = 8 * i + kr, k = k0 + kk; float g = 1.f; if (gk) g = (k < ksplit) ? gk[k] : gk2[k - ksplit];
        const f32x4 t = v[i] * gnv * (g * mult); LAS float* d = scr + kk * 33 + n4; d[0] = t[0]; d[1] = t[1]; d[2] = t[2]; d[3] = t[3]; }
    LDS_WAIT(); asm volatile("" ::: "memory");
    const int c = lane & 7;
#pragma unroll
    for (int j = 0; j < 4; ++j) { const int n = (lane >> 3) + 8 * j; const LAS float* s = scr + (8 * c) * 33 + n;
        if constexpr (F8OUT) { int lo = __builtin_amdgcn_cvt_pk_fp8_f32(s[0 * 33], s[1 * 33], 0, false); lo = __builtin_amdgcn_cvt_pk_fp8_f32(s[2 * 33], s[3 * 33], lo, true);
            int hi2 = __builtin_amdgcn_cvt_pk_fp8_f32(s[4 * 33], s[5 * 33], 0, false); hi2 = __builtin_amdgcn_cvt_pk_fp8_f32(s[6 * 33], s[7 * 33], hi2, true);
            pg8::st8_wt((unsigned char*)WTv + (size_t)(nd0 + n) * K + k0 + 8 * c, (unsigned long long)(unsigned)lo | ((unsigned long long)(unsigned)hi2 << 32)); }
        else { u32x4 o; o.x = pg8::cvt_pk_bf16(s[0 * 33], s[1 * 33]); o.y = pg8::cvt_pk_bf16(s[2 * 33], s[3 * 33]); o.z = pg8::cvt_pk_bf16(s[4 * 33], s[5 * 33]); o.w = pg8::cvt_pk_bf16(s[6 * 33], s[7 * 33]);
            pg8::st16<0>((bf16_t*)WTv + (size_t)(nd0 + n) * K + k0 + 8 * c, o); } }
    LDS_WAIT(); asm volatile("" ::: "memory");
}
__device__ __forceinline__ void p0_fused_pool_item(const float* w_in, const float* g_mix, const float* w_pool, const float* pool_scale, bf16_t* WIN_T, int item, int lane) {
    const int eb = item & 7, kb = (item >> 3) & 15, g = item >> 7; const int k = kb * 64 + lane, e0 = eb * 16;
    const float* ap = w_in + (size_t)k * INP + 3 * SBW + g * PGD; const float* bp = w_pool + (size_t)g * PGD * PGD + e0;
    float acc[16];
#pragma unroll
    for (int j = 0; j < 16; ++j) acc[j] = 0.f;
#pragma unroll 4
    for (int c = 0; c < PGD; ++c) { const float a = ap[c];
#pragma unroll
        for (int j = 0; j < 16; ++j) acc[j] += a * bp[c * PGD + j]; }
    const float gk = g_mix[k];
#pragma unroll
    for (int j = 0; j < 16; ++j) WIN_T[(size_t)(3 * SBW + g * PGD + e0 + j) * D + k] = (bf16_t)f2bf(acc[j] * gk * pool_scale[g * PGD + e0 + j]);
}
__device__ __forceinline__ void p0_row(const float* xrow, bf16_t* orow, float* rstd, int lane) {
    const f32x4* xr = (const f32x4*)xrow + 2 * lane; f32x4 v[4]; float s = 0.f;
#pragma unroll
    for (int j = 0; j < 4; ++j) { v[j] = xr[(j >> 1) * 128 + (j & 1)]; s += (v[j].x * v[j].x + v[j].y * v[j].y) + (v[j].z * v[j].z + v[j].w * v[j].w); }
    s = wave_sum(s); if (lane == 0) *rstd = 1.0f / sqrtf(s * (1.0f / D) + EPS);
#pragma unroll
    for (int j = 0; j < 2; ++j) { u32x4 o; o.x = pg8::cvt_pk_bf16(v[2 * j].x, v[2 * j].y); o.y = pg8::cvt_pk_bf16(v[2 * j].z, v[2 * j].w); o.z = pg8::cvt_pk_bf16(v[2 * j + 1].x, v[2 * j + 1].y); o.w = pg8::cvt_pk_bf16(v[2 * j + 1].z, v[2 * j + 1].w);
        pg8::st16<0>(orow + j * 512 + 8 * lane, o); }
}
__device__ __forceinline__ void p0_prologue(const Args& a, LAS unsigned char* lds, int vcu, int G, int wave, int lane) {
    unsigned char* ws = a.ws;
    LAS float* scr = (LAS float*)(lds + RING_OFF + wave * 16384);
    const int gw = vcu * NWAVES + wave, NGW = G * NWAVES;
    constexpr int I_E1 = (D / 64) * (2 * DFF / 32), I_E2 = (DFF / 64) * (D / 32);
    constexpr int I_IN = (D / 64) * (3 * SBW / 32), I_FP = PG * 16 * 8, I_SQ = (D / 64) * (D / 32), I_KV = (D / 64) * (2 * D / 32), I_P = (PGD / 64) * (PGD / 32);
    constexpr int N1 = NE * I_E1, N2 = NE * I_E2, NITEMS = N1 + N2 + I_IN + 3 * I_SQ + I_KV + I_FP;
    const int BIG = 1 << 30;
    for (int it = gw; it < NITEMS; it += NGW) {
        int r = it;
        if (r < N1) { const int e = r / I_E1; p0_item<true>(a.in[17] + (size_t)e * D * 2 * DFF, D, 2 * DFF, ws + WS_W1 + (size_t)e * 2 * DFF * D, a.in[14], nullptr, BIG, nullptr, 1, scr, r % I_E1, lane, WSCALE); continue; } r -= N1;
        if (r < N2) { const int e = r / I_E2; p0_item<true>(a.in[19] + (size_t)e * DFF * D, DFF, D, ws + WS_W2 + (size_t)e * D * DFF, nullptr, nullptr, BIG, nullptr, 0, scr, r % I_E2, lane, WSCALE); continue; } r -= N2;
        if (r < I_IN) { p0_item<false>(a.in[3], D, INP, (bf16_t*)(ws + WS_WIN), a.in[2], nullptr, BIG, nullptr, 0, scr, r, lane, 1.0f, 3 * SBW / 32); continue; } r -= I_IN;
        if (r < I_SQ) { p0_item<false>(a.in[8], D, D, (bf16_t*)(ws + WS_WOUT), a.in[4], a.in[5], SBW, nullptr, 0, scr, r, lane); continue; } r -= I_SQ;
        if (r < I_SQ) { p0_item<false>(a.in[11], D, D, (bf16_t*)(ws + WS_WQ), a.in[9], nullptr, BIG, nullptr, 0, scr, r, lane); continue; } r -= I_SQ;
        if (r < I_KV) { p0_item<false>(a.in[12], D, 2 * D, (bf16_t*)(ws + WS_WKV), a.in[10], nullptr, BIG, nullptr, 0, scr, r, lane); continue; } r -= I_KV;
        if (r < I_SQ) { p0_item<false>(a.in[13], D, D, (bf16_t*)(ws + WS_WO), nullptr, nullptr, BIG, nullptr, 0, scr, r, lane); continue; } r -= I_SQ;
        p0_fused_pool_item(a.in[3], a.in[2], a.in[6], a.in[7], (bf16_t*)(ws + WS_WIN), r, lane);
    }
    for (int m = gw; m < NTOK; m += NGW) p0_row(a.in[0] + (size_t)m * D, (bf16_t*)(ws + WS_S0) + (size_t)m * D, (float*)(ws + WS_RSTDX) + m, lane);
    for (int m = gw; m < NMROWS; m += NGW) p0_row(a.in[1] + (size_t)m * D, (bf16_t*)(ws + WS_MEMB) + (size_t)m * D, (float*)(ws + WS_RSTDM) + m, lane);
    const int gt = gw * 64 + lane, NGT = NGW * 64;
    for (int i = gt; i < INP; i += NGT) ((float*)(ws + WS_CSG1))[i] = (i < SBW) ? C2_SB : 1.0f;
    for (int i = gt; i < NE * D; i += NGT) { const int e = i / D, k = i % D; const float v = a.in[14][k] * a.in[15][k * NE + e];
        ((float*)(ws + WS_WR))[i] = v; const unsigned h = f2bf(v); ((bf16_t*)(ws + WS_WRH))[i] = (bf16_t)h; ((bf16_t*)(ws + WS_WRL))[i] = (bf16_t)f2bf(v - bf2f((bf16_t)h)); }
}

struct SchedP1 {
    int G, c; unsigned char* ws;
    __device__ __forceinline__ bool next(int i, pg8::Unit& u) const {
        const int L = i * G + c; constexpr int NQ = (NTOK / 256) * (INP / 256);
        if (L >= NQ + 64) return false;
        if (L < NQ) { int pm, pn; pg8::grouped_mn(pg8::xcd_remap(L, NQ), NTOK / 256, INP / 256, pm, pn);
            u.A = (const char*)(ws + WS_S0) + (size_t)pm * 256 * D * 2; u.B = (const char*)(ws + WS_WIN) + (size_t)pn * 256 * D * 2;
            u.p0 = (bf16_t*)(ws + WS_QKVU) + (size_t)pm * 256 * INP + pn * 256; u.p1 = (float*)(ws + WS_RSTDX) + pm * 256; u.p2 = (float*)(ws + WS_CSG1) + pn * 256; u.i0 = INP; u.pm = pm; u.pn = pn; }
        else if (L < NQ + 32) { const int k = L - NQ, pm = k >> 2, pn = k & 3;
            u.A = (const char*)(ws + WS_MEMB) + (size_t)pm * 256 * D * 2; u.B = (const char*)(ws + WS_WKV) + (size_t)pn * 256 * D * 2;
            u.p0 = (bf16_t*)(ws + WS_KM) + (size_t)pm * 256 * D + pn * 256; u.p1 = (float*)(ws + WS_RSTDM) + pm * 256; u.p2 = nullptr; u.i0 = D; u.pm = pm; u.pn = pn; }
        else { const int v = L - NQ - 32, b = v >> 2, dt = v & 3;
            u.A = (const char*)(ws + WS_WKV) + (size_t)(D + dt * 256) * D * 2; u.B = (const char*)(ws + WS_MEMB) + (size_t)b * 256 * D * 2;
            u.p0 = (bf16_t*)(ws + WS_VMT) + ((size_t)b * D + dt * 256) * NMEM; u.p1 = nullptr; u.p2 = (float*)(ws + WS_RSTDM) + b * 256; u.i0 = NMEM; u.pm = dt; u.pn = b; }
        u.p3 = nullptr; u.i1 = 0; return true;
    }
};
#define EPI_BAR() asm volatile("s_waitcnt lgkmcnt(0)\n\ts_barrier" ::: "memory")
struct SchedReg {
    int G, c, nM, nN; const char* A; const char* B; size_t astep, bstep; bf16_t* O; int ldc; const float* rs; const float* cs;
    __device__ __forceinline__ bool next(int i, pg8::Unit& u) const {
        const int L = i * G + c; if (L >= nM * nN) return false; int pm, pn; pg8::grouped_mn(pg8::xcd_remap(L, nM * nN), nM, nN, pm, pn);
        u.A = A + (size_t)pm * astep; u.B = B + (size_t)pn * bstep; u.pm = pm; u.pn = pn; u.i0 = ldc; u.i1 = 0;
        u.p0 = O ? (void*)(O + (size_t)pm * 256 * ldc + pn * 256) : nullptr; u.p1 = rs ? (void*)(rs + pm * 256) : nullptr; u.p2 = cs ? (void*)(cs + pn * 256) : nullptr; u.p3 = nullptr; return true;
    }
};
struct EpiBf16Ssq {
    static constexpr bool PERM = true; static constexpr int MIDK = -1; float inv_n, mult;
    __device__ __forceinline__ void midk(f32x4 (&)[2][2][4][2], const pg8::Unit&, int, int) const {}
    __device__ __forceinline__ void operator()(f32x4 (&acc)[2][2][4][2], const pg8::Unit& u, int wr, int wc, int fr, int fq, int, int, LAS unsigned char*) const {
        bf16_t* O = (bf16_t*)u.p0; const float* sq = (const float*)u.p1; const int ldc = u.i0; int r0 = wr * 64 + fr, c0 = wc * 32 + 8 * fq; asm volatile("" : "+v"(r0), "+v"(c0));
#pragma unroll
        for (int ai = 0; ai < 2; ++ai)
#pragma unroll
            for (int m = 0; m < 4; ++m) { const int r = r0 + ai * 128 + m * 16; const float rv = mult / sqrtf(sq[r] * inv_n + EPS); bf16_t* rowp = O + (size_t)r * ldc + c0;
#pragma unroll
                for (int bj = 0; bj < 2; ++bj) { const f32x4 v0 = acc[ai][bj][m][0] * rv, v1 = acc[ai][bj][m][1] * rv;
                    u32x4 w; w.x = pg8::cvt_pk_bf16(v0[0], v0[1]); w.y = pg8::cvt_pk_bf16(v0[2], v0[3]); w.z = pg8::cvt_pk_bf16(v1[0], v1[1]); w.w = pg8::cvt_pk_bf16(v1[2], v1[3]);
                    pg8::st16<5>(rowp + bj * 128, w); } }
    }
};
template <int MIDK_, bool XIN_BF16, bool F8OUT> struct EpiResid {
    static constexpr bool PERM = true; static constexpr int MIDK = MIDK_;
    const float* xin; bf16_t* xb; unsigned char* x8; float* ssq; const float* ssq_mid;
    __device__ __forceinline__ void midk(f32x4 (&acc)[2][2][4][2], const pg8::Unit& u, int wr, int fr) const {
#pragma unroll
        for (int ai = 0; ai < 2; ++ai)
#pragma unroll
            for (int m = 0; m < 4; ++m) { const int r = u.pm * 256 + ai * 128 + wr * 64 + m * 16 + fr; const float s = 1.0f / sqrtf(ssq_mid[r] * (1.0f / SBW) + EPS);
#pragma unroll
                for (int bj = 0; bj < 2; ++bj)
#pragma unroll
                    for (int n = 0; n < 2; ++n) acc[ai][bj][m][n] *= s; }
    }
    __device__ __forceinline__ void operator()(f32x4 (&acc)[2][2][4][2], const pg8::Unit& u, int wr, int wc, int fr, int fq, int, int, LAS unsigned char*) const {
        int row0 = u.pm * 256 + wr * 64 + fr, col0 = u.pn * 256 + wc * 32 + 8 * fq; asm volatile("" : "+v"(row0), "+v"(col0));
#pragma unroll
        for (int ai = 0; ai < 2; ++ai)
#pragma unroll
            for (int m = 0; m < 4; ++m) { const int r = row0 + ai * 128 + m * 16; const size_t off = (size_t)r * D + col0; float q = 0.f;
#pragma unroll
                for (int bj = 0; bj < 2; ++bj) { const size_t o2 = off + bj * 128; f32x4 o0, o1;
                    if constexpr (XIN_BF16) { const u32x4 xv = *(const u32x4*)(xb + o2);
                        o0 = (f32x4){__builtin_bit_cast(float, xv.x << 16), __builtin_bit_cast(float, xv.x & 0xffff0000u), __builtin_bit_cast(float, xv.y << 16), __builtin_bit_cast(float, xv.y & 0xffff0000u)};
                        o1 = (f32x4){__builtin_bit_cast(float, xv.z << 16), __builtin_bit_cast(float, xv.z & 0xffff0000u), __builtin_bit_cast(float, xv.w << 16), __builtin_bit_cast(float, xv.w & 0xffff0000u)}; }
                    else { o0 = *(const f32x4*)(xin + o2); o1 = *(const f32x4*)(xin + o2 + 4); }
                    o0 += acc[ai][bj][m][0]; o1 += acc[ai][bj][m][1];
                    q += (o0[0] * o0[0] + o0[1] * o0[1]) + (o0[2] * o0[2] + o0[3] * o0[3]) + (o1[0] * o1[0] + o1[1] * o1[1]) + (o1[2] * o1[2] + o1[3] * o1[3]);
                    if constexpr (F8OUT) { int w0 = __builtin_amdgcn_cvt_pk_fp8_f32(o0[0], o0[1], 0, false); w0 = __builtin_amdgcn_cvt_pk_fp8_f32(o0[2], o0[3], w0, true);
                        int w1 = __builtin_amdgcn_cvt_pk_fp8_f32(o1[0], o1[1], 0, false); w1 = __builtin_amdgcn_cvt_pk_fp8_f32(o1[2], o1[3], w1, true);
                        pg8::st8_wt(x8 + o2, (unsigned long long)(unsigned)w0 | ((unsigned long long)(unsigned)w1 << 32)); }
                    u32x4 w; w.x = pg8::cvt_pk_bf16(o0[0], o0[1]); w.y = pg8::cvt_pk_bf16(o0[2], o0[3]); w.z = pg8::cvt_pk_bf16(o1[0], o1[1]); w.w = pg8::cvt_pk_bf16(o1[2], o1[3]); pg8::st16<4>(xb + o2, w); }
                q += __shfl_xor(q, 16); q += __shfl_xor(q, 32);
                if (fq == 0) unsafeAtomicAdd(ssq + r, q);
                if (m & 1) asm volatile("" ::: "memory"); }
    }
};
struct SchedMS {
    int G, c; unsigned char* ws;
    __device__ __forceinline__ bool next(int i, pg8::Unit& u) const {
        const int L = i * G + c; constexpr int NU = (NTOK / 256) * MH; if (L >= NU) return false; const int w = pg8::xcd_remap(L, NU), pm = w >> 2, h = w & 3, b = pm >> 4;
        u.A = (const char*)(ws + WS_QM) + ((size_t)pm * 256 * D + h * MHD) * 2; u.B = (const char*)(ws + WS_KM) + ((size_t)b * NMEM * D + h * MHD) * 2;
        u.p0 = (bf16_t*)(ws + WS_PM) + (size_t)pm * 256 * D + h * NMEM; u.p1 = nullptr; u.p2 = nullptr; u.p3 = nullptr; u.i0 = D; u.i1 = 0; u.pm = pm; u.pn = h; return true;
    }
};
struct EpiSoftmax {
    static constexpr bool PERM = true; static constexpr int MIDK = -1;
    __device__ __forceinline__ void midk(f32x4 (&)[2][2][4][2], const pg8::Unit&, int, int) const {}
    __device__ __forceinline__ void operator()(f32x4 (&acc)[2][2][4][2], const pg8::Unit& u, int wr, int wc, int fr, int fq, int, int, LAS unsigned char* xl) const {
        typedef float f32x2v __attribute__((ext_vector_type(2)));
        LAS f32x2v* X = (LAS f32x2v*)xl;
        float ml[2][4];
#pragma unroll
        for (int ai = 0; ai < 2; ++ai)
#pragma unroll
            for (int m = 0; m < 4; ++m) { float mx = -INFINITY;
#pragma unroll
                for (int bj = 0; bj < 2; ++bj)
#pragma unroll
                    for (int n = 0; n < 2; ++n) { const f32x4 v = acc[ai][bj][m][n]; mx = fmaxf(fmaxf(mx, fmaxf(v[0], v[1])), fmaxf(v[2], v[3])); }
                mx = fmaxf(mx, __shfl_xor(mx, 16)); mx = fmaxf(mx, __shfl_xor(mx, 32)); ml[ai][m] = mx; float s = 0.f;
#pragma unroll
                for (int bj = 0; bj < 2; ++bj)
#pragma unroll
                    for (int n = 0; n < 2; ++n) { f32x4 v = acc[ai][bj][m][n];
#pragma unroll
                        for (int j = 0; j < 4; ++j) { v[j] = __builtin_amdgcn_exp2f(v[j] - mx); s += v[j]; }
                        acc[ai][bj][m][n] = v; }
                s += __shfl_xor(s, 16); s += __shfl_xor(s, 32);
                if (fq == 0) X[(ai * 128 + wr * 64 + m * 16 + fr) * 4 + wc] = (f32x2v){mx, s}; }
        EPI_BAR();
        bf16_t* O = (bf16_t*)u.p0; const int ldc = u.i0; int r0 = wr * 64 + fr, c0 = wc * 32 + 8 * fq; asm volatile("" : "+v"(r0), "+v"(c0));
#pragma unroll
        for (int ai = 0; ai < 2; ++ai)
#pragma unroll
            for (int m = 0; m < 4; ++m) { const int r = r0 + ai * 128 + m * 16; const f32x2v a = X[r * 4 + 0], b = X[r * 4 + 1], c = X[r * 4 + 2], d = X[r * 4 + 3];
                const float M = fmaxf(fmaxf(a.x, b.x), fmaxf(c.x, d.x));
                const float tot = a.y * __builtin_amdgcn_exp2f(a.x - M) + b.y * __builtin_amdgcn_exp2f(b.x - M) + c.y * __builtin_amdgcn_exp2f(c.x - M) + d.y * __builtin_amdgcn_exp2f(d.x - M);
                const float f = __builtin_amdgcn_exp2f(ml[ai][m] - M) / tot; bf16_t* rowp = O + (size_t)r * ldc + c0;
#pragma unroll
                for (int bj = 0; bj < 2; ++bj) { const f32x4 v0 = acc[ai][bj][m][0] * f, v1 = acc[ai][bj][m][1] * f;
                    u32x4 w; w.x = pg8::cvt_pk_bf16(v0[0], v0[1]); w.y = pg8::cvt_pk_bf16(v0[2], v0[3]); w.z = pg8::cvt_pk_bf16(v1[0], v1[1]); w.w = pg8::cvt_pk_bf16(v1[2], v1[3]);
                    pg8::st16<6>(rowp + bj * 128, w); } }
    }
};
struct SchedPV {
    int G, c; unsigned char* ws;
    __device__ __forceinline__ bool next(int i, pg8::Unit& u) const {
        const int L = i * G + c; constexpr int NU = (NTOK / 256) * MH; if (L >= NU) return false; const int w = pg8::xcd_remap(L, NU), pm = w >> 2, h = w & 3, b = pm >> 4;
        u.A = (const char*)(ws + WS_PM) + ((size_t)pm * 256 * D + h * NMEM) * 2; u.B = (const char*)(ws + WS_VMT) + ((size_t)b * D + h * MHD) * NMEM * 2;
        u.p0 = (bf16_t*)(ws + WS_OM) + (size_t)pm * 256 * D + h * MHD; u.p1 = nullptr; u.p2 = nullptr; u.p3 = nullptr; u.i0 = D; u.i1 = 0; u.pm = pm; u.pn = h; return true;
    }
};

__device__ __forceinline__ void p8_route(const Args& a, LAS unsigned char* lds, int bx, int G, int wave, int lane, int* CNT) {
    unsigned char* ws = a.ws; const bf16_t* x2 = (const bf16_t*)(ws + WS_S0); const float* SSQ2 = (const float*)(ws + OFF_SSQ2); const float* br = a.in[16];
    const bf16_t* WRH = (const bf16_t*)(ws + WS_WRH);
    int* LSLOT = (int*)(ws + WS_LSLOT); float* LGATE = (float*)(ws + WS_LGATE); float* LRS = (float*)(ws + WS_LRS);
    constexpr int WPITCH = 2064;
    LAS float* LG = (LAS float*)(lds + RING_OFF + 69632) + wave * 16 * 33;
    LAS int* hist = (LAS int*)(lds + RING_OFF + 90112); LAS int* base = hist + 32;
    const int tid = wave * 64 + lane;
    { u32x4 v[8];
#pragma unroll
      for (int i = 0; i < 8; ++i) v[i] = *(const u32x4*)(WRH + (size_t)(tid + i * 512) * 8);
#pragma unroll
      for (int i = 0; i < 8; ++i) { const int c = tid + i * 512; *(LAS u32x4*)(lds + RING_OFF + (c >> 7) * WPITCH + (c & 127) * 16) = v[i]; } }
    LDS_WAIT(); __syncthreads();
    for (int t0 = bx * 128; t0 < NTOK; t0 += G * 128) {
        if (tid < 32) hist[tid] = 0;
        const int r16 = lane & 15, kq = lane >> 4; const int trow = t0 + wave * 16 + r16;
        const bf16_t* xp = x2 + (size_t)trow * D + kq * 8;
        bf16x8 ah[32];
#pragma unroll
        for (int ks = 0; ks < 32; ++ks) ah[ks] = *(const bf16x8*)(xp + ks * 32);
        f32x4 acc[2] = {(f32x4){0.f, 0.f, 0.f, 0.f}, (f32x4){0.f, 0.f, 0.f, 0.f}};
        const LAS unsigned char* wp = lds + RING_OFF + r16 * WPITCH + kq * 16;
#pragma unroll
        for (int ks = 0; ks < 32; ++ks) {
#pragma unroll
            for (int nb = 0; nb < 2; ++nb) { const bf16x8 bh = *(const LAS bf16x8*)(wp + nb * 16 * WPITCH + ks * 64);
                acc[nb] = __builtin_amdgcn_mfma_f32_16x16x32_bf16(ah[ks], bh, acc[nb], 0, 0, 0); } }
#pragma unroll
        for (int nb = 0; nb < 2; ++nb)
#pragma unroll
            for (int r = 0; r < 4; ++r) { const int tl = kq * 4 + r; const int tk = t0 + wave * 16 + tl; const float rs = 1.0f / sqrtf(SSQ2[tk] * (1.0f / D) + EPS);
                LG[tl * 33 + nb * 16 + r16] = acc[nb][r] * rs + br[nb * 16 + r16]; }
        LDS_WAIT(); __syncthreads();
        int te[4] = {0, 0, 0, 0}; float tg[4] = {0.f, 0.f, 0.f, 0.f}; int rk[4] = {0, 0, 0, 0};
        if (lane < 16) {
            float tv[4] = {-INFINITY, -INFINITY, -INFINITY, -INFINITY};
            for (int e = 0; e < NE; ++e) { const float v = LG[lane * 33 + e];
                if (v > tv[3]) { if (v > tv[2]) { tv[3] = tv[2]; te[3] = te[2]; if (v > tv[1]) { tv[2] = tv[1]; te[2] = te[1]; if (v > tv[0]) { tv[1] = tv[0]; te[1] = te[0]; tv[0] = v; te[0] = e; } else { tv[1] = v; te[1] = e; } } else { tv[2] = v; te[2] = e; } } else { tv[3] = v; te[3] = e; } } }
            float gs = 0.f;
#pragma unroll
            for (int k = 0; k < 4; ++k) { tg[k] = __expf(tv[k] - tv[0]); gs += tg[k]; }
            gs = 1.0f / gs;
#pragma unroll
            for (int k = 0; k < 4; ++k) { tg[k] *= gs; rk[k] = __hip_atomic_fetch_add(hist + te[k], 1, __ATOMIC_RELAXED, __HIP_MEMORY_SCOPE_WORKGROUP); }
        }
        LDS_WAIT(); __syncthreads();
        if (tid < 32) { const int n = hist[tid]; base[tid] = n ? atomicAdd(CNT + tid, n) : 0; }
        LDS_WAIT(); __syncthreads();
        if (lane < 16) { const int tk = t0 + wave * 16 + lane; const float rsw = (1.0f / WSCALE) / sqrtf(SSQ2[tk] * (1.0f / D) + EPS);
#pragma unroll
            for (int k = 0; k < 4; ++k) { const size_t p = (size_t)te[k] * LCAP + base[te[k]] + rk[k]; pg8::st4_wt(LSLOT + p, (unsigned)(tk * 4 + k)); pg8::st4_wt(LGATE + p, __float_as_uint(tg[k])); pg8::st4_wt(LRS + p, __float_as_uint(rsw)); } }
        LDS_WAIT(); __syncthreads();
    }
}

__device__ __forceinline__ void moe_table(const Args& a, volatile LAS unsigned* MISC, int tid) {
    const int* CNT = (const int*)(a.ws + OFF_CNT);
    if (tid < 32) MISC[16 + tid] = (unsigned)CNT[tid];
    LDS_WAIT(); __syncthreads();
    if (tid == 0) { unsigned tb = 0; for (int e = 0; e < NE; ++e) { MISC[48 + e] = tb; tb += (MISC[16 + e] + 255u) >> 8; } MISC[48 + NE] = tb; }
    LDS_WAIT(); __syncthreads();
}
template <int NPN, bool W1> struct SchedMoE {
    int G, c; unsigned char* ws; volatile LAS unsigned* MISC; const float* bias;
    __device__ __forceinline__ bool next(int i, pg8::Unit& u) const {
        unsigned mb_ = (unsigned)(uintptr_t)MISC; asm volatile("" : "+s"(mb_)); const LAS unsigned* M = (const LAS unsigned*)(uintptr_t)mb_;
        const int T = __builtin_amdgcn_readfirstlane((int)M[48 + NE]); const int NU = T * NPN; const int L = i * G + c; if (L >= NU) return false;
        const int w = pg8::xcd_remap(L, NU);
        int e = 0;
#pragma unroll
        for (int s = 16; s >= 1; s >>= 1) { if ((int)M[48 + e + s] * NPN <= w) e += s; }
        e = __builtin_amdgcn_readfirstlane(e);
        const int tb = __builtin_amdgcn_readfirstlane((int)M[48 + e]), cnt = __builtin_amdgcn_readfirstlane((int)M[16 + e]), nte = (cnt + 255) >> 8; const int idx = w - tb * NPN, pn = __builtin_amdgcn_readfirstlane(idx / nte), mt = idx - pn * nte;
        u.pm = tb + mt; u.pn = pn; u.i1 = e; const int nv = cnt - mt * 256; u.i0 = nv < 256 ? nv : 256;
        u.p3 = (int*)(ws + WS_LSLOT) + (size_t)e * LCAP + mt * 256; u.p2 = (float*)(ws + (W1 ? WS_LRS : WS_LGATE)) + (size_t)e * LCAP + mt * 256; u.p0 = nullptr;
        u.p1 = W1 ? (void*)(bias + (size_t)e * 2 * DFF + pn * 128) : (void*)(bias + (size_t)e * D + pn * 256);
        if (W1) { u.A = (const char*)(ws + WS_X2F8); u.B = (const char*)(ws + WS_W1) + ((size_t)e * 2 * DFF + pn * 256) * D; }
        else { u.A = (const char*)(ws + WS_ACT) + (size_t)(tb + mt) * 256 * DFF; u.B = (const char*)(ws + WS_W2) + ((size_t)e * D + pn * 256) * DFF; }
        return true;
    }
};
typedef float f32x2 __attribute__((ext_vector_type(2)));
struct EpiSwiGLU {
    static constexpr bool PERM = true; static constexpr int MIDK = -1; unsigned char* act;
    __device__ __forceinline__ void midk(f32x4 (&)[2][2][4][2], const pg8::Unit&, int, int) const {}
    __device__ __forceinline__ void operator()(f32x4 (&acc)[2][2][4][2], const pg8::Unit& u, int wr, int wc, int fr, int fq, int, int, LAS unsigned char* tab) const {
        const int nvalid = u.i0; const LAS float* T1 = (const LAS float*)tab + 256; const LAS float* T2 = (const LAS float*)tab + 512;
        int r0 = wr * 64 + fr, c0 = wc * 32 + 8 * fq; asm volatile("" : "+v"(r0), "+v"(c0)); const int gc0 = u.pn * 128 + c0;
        f32x4 bg[2], bu[2];
#pragma unroll
        for (int n = 0; n < 2; ++n) { bg[n] = *(const LAS f32x4*)(T2 + c0 + 4 * n); bu[n] = *(const LAS f32x4*)(T2 + 128 + c0 + 4 * n); }
#pragma unroll
        for (int ai = 0; ai < 2; ++ai)
#pragma unroll
            for (int m = 0; m < 4; ++m) { const int r = r0 + ai * 128 + m * 16; const float rs = T1[r]; int wv[2];
#pragma unroll
                for (int n = 0; n < 2; ++n) { f32x2 o[2];
#pragma unroll
                    for (int h = 0; h < 2; ++h) { f32x2 g = (f32x2){acc[ai][0][m][n][2 * h], acc[ai][0][m][n][2 * h + 1]} * rs + (f32x2){bg[n][2 * h], bg[n][2 * h + 1]};
                        f32x2 up = (f32x2){acc[ai][1][m][n][2 * h], acc[ai][1][m][n][2 * h + 1]} * rs + (f32x2){bu[n][2 * h], bu[n][2 * h + 1]};
                        g.x = fminf(g.x, SW_LIMIT); g.y = fminf(g.y, SW_LIMIT); up.x = fminf(fmaxf(up.x, -SW_LIMIT), SW_LIMIT); up.y = fminf(fmaxf(up.y, -SW_LIMIT), SW_LIMIT);
                        const f32x2 tt = g * (-SW_ALPHA * LOG2E); f32x2 d; d.x = __builtin_amdgcn_exp2f(tt.x); d.y = __builtin_amdgcn_exp2f(tt.y); d = d + 1.0f;
                        f32x2 rr; rr.x = __builtin_amdgcn_rcpf(d.x); rr.y = __builtin_amdgcn_rcpf(d.y);
                        o[h] = (up + 1.0f) * g * rr; }
                    wv[n] = __builtin_amdgcn_cvt_pk_fp8_f32(o[0].x, o[0].y, 0, false); wv[n] = __builtin_amdgcn_cvt_pk_fp8_f32(o[1].x, o[1].y, wv[n], true); }
                if (r < nvalid) pg8::st8_wt(act + ((size_t)u.pm * 256 + r) * DFF + gc0, (unsigned long long)(unsigned)wv[0] | ((unsigned long long)(unsigned)wv[1] << 32)); }
    }
};
struct EpiW2 {
    static constexpr bool PERM = true; static constexpr int MIDK = -1; bf16_t* Y;
    __device__ __forceinline__ void midk(f32x4 (&)[2][2][4][2], const pg8::Unit&, int, int) const {}
    __device__ __forceinline__ void operator()(f32x4 (&acc)[2][2][4][2], const pg8::Unit& u, int wr, int wc, int fr, int fq, int, int, LAS unsigned char* tab) const {
        const int nvalid = u.i0; const LAS unsigned* T0 = (const LAS unsigned*)tab; const LAS float* T1 = (const LAS float*)tab + 256; const LAS float* T2 = (const LAS float*)tab + 512;
        int r0 = wr * 64 + fr, cl = wc * 32 + 8 * fq; asm volatile("" : "+v"(r0), "+v"(cl)); const int c0 = u.pn * 256 + cl;
        f32x4 bv[2][2];
#pragma unroll
        for (int bj = 0; bj < 2; ++bj)
#pragma unroll
            for (int n = 0; n < 2; ++n) bv[bj][n] = *(const LAS f32x4*)(T2 + cl + bj * 128 + 4 * n);
#pragma unroll
        for (int ai = 0; ai < 2; ++ai)
#pragma unroll
            for (int m = 0; m < 4; ++m) { const int r = r0 + ai * 128 + m * 16; const bool valid = r < nvalid; const unsigned slot = T0[r]; const float g = T1[r];
#pragma unroll
                for (int bj = 0; bj < 2; ++bj) { const f32x4 v0 = (acc[ai][bj][m][0] * (1.0f / WSCALE) + bv[bj][0]) * g, v1 = (acc[ai][bj][m][1] * (1.0f / WSCALE) + bv[bj][1]) * g;
                    u32x4 w; w.x = pg8::cvt_pk_bf16(v0[0], v0[1]); w.y = pg8::cvt_pk_bf16(v0[2], v0[3]); w.z = pg8::cvt_pk_bf16(v1[0], v1[1]); w.w = pg8::cvt_pk_bf16(v1[2], v1[3]);
                    if (valid) pg8::st16<7>(Y + (size_t)slot * D + c0 + bj * 128, w); } }
    }
};

__device__ __forceinline__ void p11_final(const Args& a, int vcu, int G, int wave, int lane, float* dst) {
    const bf16_t* x2 = (const bf16_t*)(a.ws + WS_S0); const bf16_t* Y = (const bf16_t*)(a.ws + WS_Y); const float* gf = a.in[21];
    const int gw = vcu * NWAVES + wave, NGW = G * NWAVES;
    f32x4 g4[4];
#pragma unroll
    for (int j = 0; j < 4; ++j) g4[j] = *(const f32x4*)(gf + 4 * lane + 256 * j);
    for (int tok = gw; tok < NTOK; tok += NGW) {
        f32x4 v[4]; float s = 0.f;
#pragma unroll
        for (int j = 0; j < 4; ++j) { { const unsigned long long w = *(const unsigned long long*)(x2 + (size_t)tok * D + 4 * lane + 256 * j);
                v[j] = (f32x4){__builtin_bit_cast(float, (unsigned)(w << 16)), __builtin_bit_cast(float, (unsigned)w & 0xffff0000u), __builtin_bit_cast(float, (unsigned)(w >> 32) << 16), __builtin_bit_cast(float, (unsigned)(w >> 32) & 0xffff0000u)}; }
#pragma unroll
            for (int k = 0; k < 4; ++k) { const unsigned long long w = *(const unsigned long long*)(Y + ((size_t)tok * 4 + k) * D + 4 * lane + 256 * j);
                v[j][0] += __builtin_bit_cast(float, (unsigned)(w << 16)); v[j][1] += __builtin_bit_cast(float, (unsigned)w & 0xffff0000u);
                v[j][2] += __builtin_bit_cast(float, (unsigned)(w >> 32) << 16); v[j][3] += __builtin_bit_cast(float, (unsigned)(w >> 32) & 0xffff0000u); }
            s += (v[j][0] * v[j][0] + v[j][1] * v[j][1]) + (v[j][2] * v[j][2] + v[j][3] * v[j][3]); }
        const float rs = 1.0f / sqrtf(wave_sum(s) * (1.0f / D) + EPS);
#pragma unroll
        for (int j = 0; j < 4; ++j) pg8::st16<8>(dst + (size_t)tok * D + 4 * lane + 256 * j, (f32x4)(v[j] * rs * g4[j]));
    }
}
typedef float f32x16 __attribute__((ext_vector_type(16)));
typedef short s16x4 __attribute__((ext_vector_type(4)));
__device__ __forceinline__ int crow(int r, int hi) { return (r & 3) + 8 * (r >> 2) + 4 * hi; }
#define SB_DMA(ubase, voff, ldsaddr) do { unsigned keep_; asm volatile("s_mov_b32 %0, m0\n\ts_mov_b32 m0, %3\n\ts_nop 0\n\tglobal_load_lds_dwordx4 %1, %2\n\ts_mov_b32 m0, %0" \
        : "=&s"(keep_) : "v"(voff), "s"((const char*)(ubase)), "s"(ldsaddr) : "memory"); } while (0)
__device__ __forceinline__ void sb_item(int b, int h, int qs  , const bf16_t* QKVU, bf16_t* MIXED, float* SSQSB, LAS unsigned char* wl  , int lane) {
    const int r32 = lane & 31, hi = lane >> 5;
    const size_t rowbase = (size_t)b * S; const int q0 = qs * 32;
    const bf16_t* Qw = QKVU + (rowbase + q0) * INP + h * HD;
    const char* Kh = (const char*)(QKVU + rowbase * INP + SBW + h * HD); const char* Vh = Kh + SBW * 2;
    bf16x8 qr[4];
#pragma unroll
    for (int d0 = 0; d0 < 4; ++d0) qr[d0] = *(const bf16x8*)(Qw + (size_t)r32 * INP + d0 * 16 + hi * 8);
    f32x16 o[2];
#pragma unroll
    for (int r = 0; r < 16; ++r) { o[0][r] = 0.f; o[1][r] = 0.f; }
    float carry = 1.0f;
    const int jd = qs >> 1;
    const int qabs = q0 + r32;
    const unsigned kvoff = (unsigned)lane * (INP * 2);
    const unsigned vvoff = (unsigned)(lane >> 2) * (INP * 2) + (unsigned)(lane & 3) * 16;
    const unsigned lk = (unsigned)(uintptr_t)wl, lv = lk + 8192;
#define SB_LOAD_K(j) do { const char* kb_ = Kh + (size_t)(j) * 64 * INP * 2; _Pragma("unroll") for (int c_ = 0; c_ < 8; ++c_) SB_DMA(kb_ + c_ * 16, kvoff, lk + c_ * 1024); } while (0)
#define SB_LOAD_V(j) do { const char* vb_ = Vh + (size_t)(j) * 64 * INP * 2; _Pragma("unroll") for (int c_ = 0; c_ < 8; ++c_) SB_DMA(vb_ + (size_t)(c_ & 3) * 16 * INP * 2 + (c_ >> 2) * 64, vvoff, lv + c_ * 1024); } while (0)
    SB_LOAD_K(jd); SB_LOAD_V(jd);
    const LAS unsigned char* kb = wl + hi * 1024 + r32 * 16;
    const LAS unsigned char* vb = wl + 8192 + ((lane >> 4) & 1) * 32 + (lane & 3) * 8 + (4 * hi + ((lane & 15) >> 2)) * 64;
    for (int j = jd; j >= 0; --j) {
        asm volatile("s_waitcnt vmcnt(8)" ::: "memory"); __builtin_amdgcn_sched_barrier(0);
        bf16x8 kf[8];
#pragma unroll
        for (int d0 = 0; d0 < 4; ++d0) { kf[2 * d0] = *(const LAS bf16x8*)(kb + d0 * 2048); kf[2 * d0 + 1] = *(const LAS bf16x8*)(kb + d0 * 2048 + 512); }
        asm volatile("s_waitcnt lgkmcnt(0)" ::: "memory"); __builtin_amdgcn_sched_barrier(0);
        if (j > 0) SB_LOAD_K(j - 1);
        f32x16 p0, p1;
#pragma unroll
        for (int r = 0; r < 16; ++r) { p0[r] = 0.f; p1[r] = 0.f; }
#pragma unroll
        for (int d0 = 0; d0 < 4; ++d0) { p0 = __builtin_amdgcn_mfma_f32_32x32x16_bf16(kf[2 * d0], qr[d0], p0, 0, 0, 0); p1 = __builtin_amdgcn_mfma_f32_32x32x16_bf16(kf[2 * d0 + 1], qr[d0], p1, 0, 0, 0); }
        const bool diag = (j == jd); const int kbase = 64 * j + 4 * hi;
#pragma unroll
        for (int r = 0; r < 16; ++r) { const int k0 = kbase + (r & 3) + 8 * (r >> 2);
            float e0 = __builtin_amdgcn_exp2f(p0[r]), e1 = __builtin_amdgcn_exp2f(p1[r]);
            float r0 = __builtin_amdgcn_rcpf(1.0f + e0), r1 = __builtin_amdgcn_rcpf(1.0f + e1);
            if (diag) { if (k0 >= qabs) r0 = 1.0f; if (k0 + 32 >= qabs) r1 = 1.0f; }
            p0[r] = r0; p1[r] = r1; }
        float sfx[8][3], A[8];
#pragma unroll
        for (int i = 0; i < 8; ++i) { const float x0 = (i < 4) ? p0[4 * i] : p1[4 * i - 16], x1 = (i < 4) ? p0[4 * i + 1] : p1[4 * i - 15], x2 = (i < 4) ? p0[4 * i + 2] : p1[4 * i - 14], x3 = (i < 4) ? p0[4 * i + 3] : p1[4 * i - 13];
            sfx[i][2] = x3; sfx[i][1] = x3 * x2; sfx[i][0] = sfx[i][1] * x1; A[i] = sfx[i][0] * x0; }
        float T = carry, E[8];
#pragma unroll
        for (int i = 7; i >= 0; --i) { const auto sw = __builtin_amdgcn_permlane32_swap(__float_as_uint(A[i]), __float_as_uint(A[i]), false, false);
            const float partner = hi ? __uint_as_float(sw[0]) : __uint_as_float(sw[1]);
            E[i] = hi ? T : T * partner; T = T * (A[i] * partner); }
        carry = T;
        unsigned pw[4][4];
#pragma unroll
        for (int i = 0; i < 8; ++i) { float w4[4];
#pragma unroll
            for (int jj = 0; jj < 4; ++jj) { const float rv = (i < 4) ? p0[4 * i + jj] : p1[4 * i - 16 + jj]; const float beta = 1.0f - rv;
                w4[jj] = beta * ((jj == 3) ? E[i] : E[i] * sfx[i][jj]); }
            pw[i >> 1][(i & 1) * 2] = pg8::cvt_pk_bf16(w4[0], w4[1]); pw[i >> 1][(i & 1) * 2 + 1] = pg8::cvt_pk_bf16(w4[2], w4[3]); }
        if (j > 0) asm volatile("s_waitcnt vmcnt(8)" ::: "memory"); else asm volatile("s_waitcnt vmcnt(0)" ::: "memory");
        __builtin_amdgcn_sched_barrier(0);
        bf16x8 vf[8];
#pragma unroll
        for (int d0 = 0; d0 < 2; ++d0)
#pragma unroll
            for (int ks = 0; ks < 4; ++ks) {
                const s16x4 lo = __builtin_bit_cast(s16x4, __builtin_amdgcn_ds_read_tr16_b64_v4i16((LAS s16x4*)(vb + d0 * 4096 + ks * 1024)));
                const s16x4 hh = __builtin_bit_cast(s16x4, __builtin_amdgcn_ds_read_tr16_b64_v4i16((LAS s16x4*)(vb + d0 * 4096 + ks * 1024 + 512)));
                vf[d0 * 4 + ks] = (bf16x8){lo[0], lo[1], lo[2], lo[3], hh[0], hh[1], hh[2], hh[3]}; }
        asm volatile("s_waitcnt lgkmcnt(0)" ::: "memory"); __builtin_amdgcn_sched_barrier(0);
        const bool more = (j > 0) && __any(carry != 0.0f);
        if (more) SB_LOAD_V(j - 1);
#pragma unroll
        for (int d0 = 0; d0 < 2; ++d0)
#pragma unroll
            for (int ks = 0; ks < 4; ++ks) { const bf16x8 pa = __builtin_bit_cast(bf16x8, (u32x4){pw[ks][0], pw[ks][1], pw[ks][2], pw[ks][3]});
                o[d0] = __builtin_amdgcn_mfma_f32_32x32x16_bf16(pa, vf[d0 * 4 + ks], o[d0], 0, 0, 0); }
        if (!more) break;
    }
    asm volatile("s_waitcnt vmcnt(0)" ::: "memory");
    LAS bf16_t* stg = (LAS bf16_t*)wl;
#pragma unroll
    for (int r = 0; r < 16; ++r) { const int orow = crow(r, hi);
#pragma unroll
        for (int d0 = 0; d0 < 2; ++d0) stg[orow * 64 + d0 * 32 + r32] = (bf16_t)f2bf(o[d0][r]); }
    LDS_WAIT();
    bf16_t* Ow = MIXED + (rowbase + q0) * D + h * HD;
#pragma unroll
    for (int i = 0; i < 4; ++i) { const int row = i * 8 + (lane >> 3), ch = lane & 7; const u32x4 v = *(const LAS u32x4*)(stg + row * 64 + ch * 8);
        pg8::st16<2>(Ow + (size_t)row * D + ch * 8, v); float q = 0.f;
#pragma unroll
        for (int k = 0; k < 4; ++k) { const float a = __builtin_bit_cast(float, v[k] << 16), c = __builtin_bit_cast(float, v[k] & 0xffff0000u); q += a * a + c * c; }
        q += __shfl_xor(q, 1); q += __shfl_xor(q, 2); q += __shfl_xor(q, 4);
        if (ch == 0) unsafeAtomicAdd(SSQSB + rowbase + q0 + row, q); }
    LDS_WAIT();
#undef SB_LOAD_K
#undef SB_LOAD_V
}

constexpr int PL_PITCH = 1040, PL_PART_OFF = 83968;
__device__ __forceinline__ void pool_unit(int tile, const bf16_t* QKVU, bf16_t* MIXED, LAS unsigned char* shm, int wid, int lane) {
    const int tok0 = tile * 64, tpos0 = tok0 & (S - 1); const int tid = wid * 64 + lane;
    { u32x4 v[10];
#pragma unroll
      for (int i = 0; i < 10; ++i) { const int c = tid + i * NWAVES * 64; const int row = c >> 6, ch = c & 63; const int t = tpos0 - 15 + row;
          v[i] = (u32x4){0u, 0u, 0u, 0u}; if (c < 79 * 64 && t >= 0) v[i] = *(const u32x4*)(QKVU + (size_t)(tok0 - 15 + row) * INP + 3 * SBW + ch * 8); }
#pragma unroll
      for (int i = 0; i < 10; ++i) { const int c = tid + i * NWAVES * 64; const int row = c >> 6, ch = c & 63; if (c < 79 * 64) *(LAS u32x4*)(shm + row * PL_PITCH + ch * 16) = v[i]; } }
    LDS_WAIT(); __syncthreads();
    const int win = 2 << (wid >> 1); const int tp1 = tpos0 + lane + 1; const int n = tp1 < win ? tp1 : win; const float inv = 1.0f / (float)n;
    const LAS unsigned char* up = shm + (15 + lane) * PL_PITCH + wid * 128;
    float o[64]; float q = 0.f;
#pragma unroll
    for (int ch = 0; ch < 8; ++ch) { float s[8];
#pragma unroll
        for (int k = 0; k < 8; ++k) s[k] = 0.f;
        for (int jw = 0; jw < win; ++jw) { const u32x4 v = *(const LAS u32x4*)(up + ch * 16 - jw * PL_PITCH);
#pragma unroll
            for (int k = 0; k < 4; ++k) { s[2 * k] += __builtin_bit_cast(float, v[k] << 16); s[2 * k + 1] += __builtin_bit_cast(float, v[k] & 0xffff0000u); } }
        const u32x4 self = *(const LAS u32x4*)(up + ch * 16);
#pragma unroll
        for (int k = 0; k < 4; ++k) { const float a = s[2 * k] * inv - __builtin_bit_cast(float, self[k] << 16), c = s[2 * k + 1] * inv - __builtin_bit_cast(float, self[k] & 0xffff0000u);
            o[ch * 8 + 2 * k] = a; o[ch * 8 + 2 * k + 1] = c; q += a * a + c * c; } }
    LAS float* part = (LAS float*)(shm + PL_PART_OFF);
    part[wid * 64 + lane] = q;
    LDS_WAIT(); __syncthreads();
    float tot = 0.f;
#pragma unroll
    for (int w = 0; w < 8; ++w) tot += part[w * 64 + lane];
    const float rs = 1.0f / sqrtf(tot * (1.0f / PW) + EPS);
    LAS unsigned char* op = shm + lane * PL_PITCH + wid * 128;
#pragma unroll
    for (int ch = 0; ch < 8; ++ch) { u32x4 w;
#pragma unroll
        for (int k = 0; k < 4; ++k) w[k] = pg8::cvt_pk_bf16(o[ch * 8 + 2 * k] * rs, o[ch * 8 + 2 * k + 1] * rs);
        *(LAS u32x4*)(op + ch * 16) = w; }
    LDS_WAIT(); __syncthreads();
#pragma unroll
    for (int i = 0; i < 8; ++i) { const int c = tid + i * NWAVES * 64; const int row = c >> 6, ch = c & 63;
        pg8::st16<3>(MIXED + (size_t)(tok0 + row) * D + SBW + ch * 8, (u32x4)*(const LAS u32x4*)(shm + row * PL_PITCH + ch * 16)); }
    LDS_WAIT(); __syncthreads();
}
__device__ __forceinline__ void p2_mix(const Args& a, LAS unsigned char* lds, int bx, int G, int wid, int lane, float* SSQSB, int which = 3, int pstop = 9, bf16_t* pool_dst = nullptr, volatile LAS unsigned* stp = nullptr) {
    unsigned char* ws = a.ws; const bf16_t* QKVU = (const bf16_t*)(ws + WS_QKVU); bf16_t* MIXED = (bf16_t*)(ws + WS_MIXED);
    constexpr int NA = B * NH * (S / 256);
    if (which & 1) for (int i = 0; i * G + bx < NA; ++i) { const int w = pg8::xcd_remap(i * G + bx, NA); const int bh = w >> 4, qb = w & 15;
        sb_item(bh >> 3, bh & 7, qb * 8 + wid, QKVU, MIXED, SSQSB, lds + RING_OFF + wid * 16384, lane); }
    __syncthreads();
    if (which & 2) for (int t = bx; t < NTOK / 64; t += G) pool_unit(t, QKVU, pool_dst ? pool_dst : MIXED, lds + RING_OFF, wid, lane);
}
constexpr size_t BAR_REGION_OFF = 1 * MiB, BAR_REGION_STRIDE = 16 * 1024;
__global__ void __launch_bounds__(NWAVES * 64, 2) mega(Args args) {
    const int li = args.li;
    extern __shared__ __attribute__((aligned(16))) unsigned char lds_raw[];
    LAS unsigned char* lds = (LAS unsigned char*)lds_raw;
    volatile LAS unsigned* MISC = (volatile LAS unsigned*)(lds + MISC_OFF);
    const int wave = __builtin_amdgcn_readfirstlane((int)threadIdx.x >> 6);
#define LANE_ID() ({ int l_; asm volatile("v_mbcnt_lo_u32_b32 %0, -1, 0\n\tv_mbcnt_hi_u32_b32 %0, -1, %0" : "=v"(l_)); l_; })
    const int G = gridDim.x; const int bx = blockIdx.x; const int vcu = (G % 8 == 0) ? (bx % 8) * (G / 8) + bx / 8 : bx;
    for (int u = wave * 64 + LANE_ID(); u < MISC_BYTES / 4; u += NWAVES * 64) MISC[u] = 0u;
    __syncthreads();
    unsigned char* ws = args.ws;
    XcdBarrier bar = xcd_barrier_post((unsigned*)(ws + BAR_REGION_OFF + (size_t)li * BAR_REGION_STRIDE), MISC + 8);
    const int lo = args.ph_lo, hi = args.ph_hi;
    LAS unsigned char* ring = lds + RING_OFF; LAS unsigned char* epi = lds + EPI_OFF; LAS unsigned* gtab = (LAS unsigned*)(lds + GTAB_OFF);
#ifndef TIME_PHASE
#define TIME_PHASE -1
#endif
#define REP_OF(k) ((TIME_PHASE == (k)) ? 2 : 1)
#define REPE_OF(k) ((TIME_PHASE == 20 + (k)) ? 2 : 1)
#define IN(k) (lo <= (k) && (k) < hi)
#ifndef TSK
#define TSK -1
#endif
#ifndef TSCALE
#define TSCALE 1.0f
#endif
#define STAMP(i) do { if (TSK >= 0 && wave == 0) { const unsigned long long t_ = __builtin_amdgcn_s_memrealtime(); MISC[128 + 2 * (i)] = (unsigned)t_; MISC[129 + 2 * (i)] = (unsigned)(t_ >> 32); } } while (0)
#define SEAM(k) do { if (IN(k) && IN((k) + 1)) xcd_barrier(bar); STAMP((k) + 1); } while (0)
    STAMP(0);
    if (IN(0)) { p0_prologue(args, lds, vcu, G, wave, LANE_ID()); if (TIME_PHASE == 0) { xcd_barrier(bar); p0_prologue(args, lds, vcu, G, wave, LANE_ID()); } SEAM(0); }
    if (IN(1)) { SchedP1 S{G, bx, ws}; pg8::EpiBf16S E; pg8::gemm_phase<pg8::EpiBf16S, SchedP1, 0, REP_OF(1), REPE_OF(1)>(wave, ring, epi, gtab, D * 2, D * 2, D / 64, S, E); SEAM(1); }
    {
    const float* xin0 = args.in[0]; float* outp = args.out;
    bf16_t* S0p = (bf16_t*)(ws + WS_S0); float* SSQSBp = (float*)(ws + OFF_SSQSB); float* SSQ1p = (float*)(ws + OFF_SSQ1); float* SSQ2p = (float*)(ws + OFF_SSQ2);
    constexpr size_t TSTEP = (size_t)256 * D * 2;
    #if !defined(PH_ONLY) || PH_ONLY == 2
    if (IN(2)) { if (TIME_PHASE == 42) { p2_mix(args, lds, bx, G, wave, LANE_ID(), (float*)(ws + 1536 * 1024), 2); xcd_barrier(bar); p2_mix(args, lds, bx, G, wave, LANE_ID(), (float*)(ws + 1536 * 1024), 2); xcd_barrier(bar); }
    if (TIME_PHASE == 2 || TIME_PHASE == 40 || TIME_PHASE == 41) { p2_mix(args, lds, bx, G, wave, LANE_ID(), (float*)(ws + 1536 * 1024), TIME_PHASE == 40 ? 1 : (TIME_PHASE == 41 ? 2 : 3)); xcd_barrier(bar); } STAMP(20); p2_mix(args, lds, bx, G, wave, LANE_ID(), (float*)(ws + OFF_SSQSB), 1); STAMP(21); p2_mix(args, lds, bx, G, wave, LANE_ID(), (float*)(ws + OFF_SSQSB), 2, 9, nullptr, (TSK >= 30 && bx == 0) ? MISC + 128 + 60 : nullptr); STAMP(22); SEAM(2); STAMP(23); }
#endif

#if !defined(PH_ONLY) || PH_ONLY == 3
    if (IN(3)) { SchedReg S{G, bx, NTOK / 256, D / 256, (const char*)(ws + WS_MIXED), (const char*)(ws + WS_WOUT), TSTEP, TSTEP, nullptr, D, nullptr, nullptr};
        EpiResid<8, false, false> E{xin0, S0p, nullptr, SSQ1p, SSQSBp}; pg8::gemm_phase<EpiResid<8, false, false>, SchedReg, 0, REP_OF(3)>(wave, ring, epi, gtab, D * 2, D * 2, D / 64, S, E); SEAM(3); }
#endif
#if !defined(PH_ONLY) || PH_ONLY == 4
    if (IN(4)) { SchedReg S{G, bx, NTOK / 256, D / 256, (const char*)(ws + WS_S0), (const char*)(ws + WS_WQ), TSTEP, TSTEP, (bf16_t*)(ws + WS_QM), D, SSQ1p, nullptr};
        EpiBf16Ssq E{1.0f / D, C2_MEM}; pg8::gemm_phase<EpiBf16Ssq, SchedReg, 0, REP_OF(4)>(wave, ring, epi, gtab, D * 2, D * 2, D / 64, S, E); SEAM(4); }
#endif
#if !defined(PH_ONLY) || PH_ONLY == 5
    if (IN(5)) { SchedMS S{G, bx, ws}; EpiSoftmax E; pg8::gemm_phase<EpiSoftmax, SchedMS, 0, REP_OF(5)>(wave, ring, epi, gtab, D * 2, D * 2, MHD / 64, S, E); SEAM(5); }
#endif
#if !defined(PH_ONLY) || PH_ONLY == 6
    if (IN(6)) { SchedPV S{G, bx, ws}; pg8::EpiBf16S E; pg8::gemm_phase<pg8::EpiBf16S, SchedPV, 0, REP_OF(6)>(wave, ring, epi, gtab, D * 2, NMEM * 2, NMEM / 64, S, E); SEAM(6); }
#endif
#if !defined(PH_ONLY) || PH_ONLY == 7
    if (IN(7)) { SchedReg S{G, bx, NTOK / 256, D / 256, (const char*)(ws + WS_OM), (const char*)(ws + WS_WO), TSTEP, TSTEP, nullptr, D, nullptr, nullptr};
        EpiResid<-1, true, true> E{nullptr, S0p, ws + WS_X2F8, SSQ2p, nullptr}; pg8::gemm_phase<EpiResid<-1, true, true>, SchedReg, 0, REP_OF(7)>(wave, ring, epi, gtab, D * 2, D * 2, D / 64, S, E); SEAM(7); }
#endif
#if !defined(PH_ONLY) || PH_ONLY == 8
    if (IN(8)) { if (TIME_PHASE == 8) { p8_route(args, lds, bx, G, wave, LANE_ID(), (int*)(ws + 1536 * 1024)); xcd_barrier(bar); } p8_route(args, lds, bx, G, wave, LANE_ID(), (int*)(ws + OFF_CNT)); SEAM(8); }
#endif
#if !defined(PH_ONLY) || PH_ONLY == 9
    if (IN(9)) { moe_table(args, MISC, wave * 64 + LANE_ID()); SchedMoE<8, true> S{G, bx, ws, MISC, args.in[18]}; EpiSwiGLU E{ws + WS_ACT};
        pg8::gemm_phase<EpiSwiGLU, SchedMoE<8, true>, 1, REP_OF(9), REPE_OF(9), true>(wave, ring, epi, gtab, D, D, D / 128, S, E); SEAM(9); }
#endif
#if !defined(PH_ONLY) || PH_ONLY == 10
    if (IN(10)) { moe_table(args, MISC, wave * 64 + LANE_ID()); SchedMoE<4, false> S{G, bx, ws, MISC, args.in[20]}; EpiW2 E{(bf16_t*)(ws + WS_Y)};
        pg8::gemm_phase<EpiW2, SchedMoE<4, false>, 2, REP_OF(10), REPE_OF(10), true>(wave, ring, epi, gtab, DFF, DFF, DFF / 128, S, E); SEAM(10); }
#endif
#if !defined(PH_ONLY) || PH_ONLY == 11
    if (IN(11)) { if (TIME_PHASE == 11) { p11_final(args, vcu, G, wave, LANE_ID(), (float*)(ws + WS_ACT)); xcd_barrier(bar); } p11_final(args, vcu, G, wave, LANE_ID(), args.out); }
#endif
}

    if (TSK >= 100) { __syncthreads(); float* dbg = (float*)(ws + 1792 * 1024);
        if (wave == 0 && LANE_ID() == 0) { const int a_ = (TSK >= 200) ? 21 : 20; const unsigned long long t0 = ((unsigned long long)MISC[129 + 2 * a_] << 32) | MISC[128 + 2 * a_], t1 = ((unsigned long long)MISC[131 + 2 * a_] << 32) | MISC[130 + 2 * a_];
            __hip_atomic_store(dbg + bx, (float)(t1 - t0) * 0.01f, __ATOMIC_RELAXED, __HIP_MEMORY_SCOPE_AGENT); }
        xcd_barrier(bar);
        if (bx == 0 && wave == 0) { const int l_ = LANE_ID(); float mx = 0.f, mn = 1e9f; for (int q = l_; q < G; q += 64) { const float v = __hip_atomic_load(dbg + q, __ATOMIC_RELAXED, __HIP_MEMORY_SCOPE_AGENT); mx = fmaxf(mx, v); mn = fminf(mn, v); }
            for (int o_ = 1; o_ < 64; o_ <<= 1) { mx = fmaxf(mx, __shfl_xor(mx, o_)); mn = fminf(mn, __shfl_xor(mn, o_)); }
            if (l_ == 0) { asm volatile("s_waitcnt vmcnt(0)" ::: "memory"); args.out[0] = ((TSK % 100) == 0 ? mx : mn) * TSCALE; } } }
    else if (TSK >= 0) { STAMP(12); __syncthreads(); if (bx == 0 && wave == 0 && LANE_ID() == 0) { asm volatile("s_waitcnt vmcnt(0)" ::: "memory");
        const unsigned long long t0 = ((unsigned long long)MISC[129 + 2 * TSK] << 32) | MISC[128 + 2 * TSK], t1 = ((unsigned long long)MISC[131 + 2 * TSK] << 32) | MISC[130 + 2 * TSK];
        args.out[0] = (float)(t1 - t0) * 0.01f * TSCALE; } }
    if (TIME_PHASE == 12) { for (int q = 0; q < 10; ++q) xcd_barrier(bar); }
#undef IN
#undef SEAM
}
}

#ifndef MEGA_MASK
#define MEGA_MASK 0xFFF
#endif
extern "C" void kernel_launch(void* const* d_in, const int* in_sizes, int n_in, void* d_out, int out_size, void* d_ws, size_t ws_size, hipStream_t stream) {
    if (n_in != 22 || out_size != NTOK * D || ws_size < WS_END) { fprintf(stderr, "kernel_launch: unexpected shapes (n_in %d out %d ws %zu)\n", n_in, out_size, ws_size); return; }
    static int grid = 0;
    if (grid == 0) {
        int dev = 0, cus = 0;
        if (hipGetDevice(&dev) != hipSuccess || hipDeviceGetAttribute(&cus, hipDeviceAttributeMultiprocessorCount, dev) != hipSuccess) { grid = -1; return; }
        if (hipFuncSetAttribute((const void*)mk::mega, hipFuncAttributeMaxDynamicSharedMemorySize, mk::LDS_BYTES) != hipSuccess) { fprintf(stderr, "kernel_launch: hipFuncSetAttribute failed\n"); grid = -1; return; }
        int per_cu = 0; (void)hipOccupancyMaxActiveBlocksPerMultiprocessor(&per_cu, (const void*)mk::mega, mk::NWAVES * 64, mk::LDS_BYTES); (void)hipGetLastError();
        if (per_cu < 1) fprintf(stderr, "kernel_launch: occupancy query reports %d blocks per CU\n", per_cu);
        grid = cus;
    }
    if (grid < 0) return;
    const float* x = (const float*)d_in[0]; const float* mem = (const float*)d_in[1]; const float* g_mix = (const float*)d_in[2]; const float* w_in = (const float*)d_in[3];
    const float* g_sb = (const float*)d_in[4]; const float* g_pool = (const float*)d_in[5]; const float* w_pool = (const float*)d_in[6]; const float* pool_scale = (const float*)d_in[7];
    const float* w_out = (const float*)d_in[8]; const float* g_mem_q = (const float*)d_in[9]; const float* g_mem_kv = (const float*)d_in[10]; const float* w_mem_q = (const float*)d_in[11];
    const float* w_mem_kv = (const float*)d_in[12]; const float* w_mem_o = (const float*)d_in[13]; const float* g_ffn = (const float*)d_in[14]; const float* w_router = (const float*)d_in[15];
    const float* b_router = (const float*)d_in[16]; const float* w_e_in = (const float*)d_in[17]; const float* b_e_in = (const float*)d_in[18]; const float* w_e_out = (const float*)d_in[19];
    const float* b_e_out = (const float*)d_in[20]; const float* g_final = (const float*)d_in[21];
    float* out = (float*)d_out; unsigned char* ws = (unsigned char*)d_ws;
    bf16_t* WIN = (bf16_t*)(ws + WS_WIN); bf16_t* WOUT = (bf16_t*)(ws + WS_WOUT); bf16_t* WQ = (bf16_t*)(ws + WS_WQ); bf16_t* WKV = (bf16_t*)(ws + WS_WKV); bf16_t* WO = (bf16_t*)(ws + WS_WO);
    bf16_t* WP = (bf16_t*)(ws + WS_WP); float* WR = (float*)(ws + WS_WR); float* RSTDX = (float*)(ws + WS_RSTDX); float* RSTDM = (float*)(ws + WS_RSTDM);
    bf16_t* W1 = (bf16_t*)(ws + WS_W1); bf16_t* W2 = (bf16_t*)(ws + WS_W2); bf16_t* S0 = (bf16_t*)(ws + WS_S0); bf16_t* QKVU = (bf16_t*)(ws + WS_QKVU);
    bf16_t* QM = (bf16_t*)(ws + WS_QM); bf16_t* OM = (bf16_t*)(ws + WS_OM); bf16_t* MIXED = (bf16_t*)(ws + WS_MIXED); bf16_t* PM = (bf16_t*)(ws + WS_PM); bf16_t* ACT = (bf16_t*)(ws + WS_ACT);
    bf16_t* KM = (bf16_t*)(ws + WS_KM); bf16_t* VMT = (bf16_t*)(ws + WS_VMT); bf16_t* MEMB = (bf16_t*)(ws + WS_MEMB); int* LSLOT = (int*)(ws + WS_LSLOT); float* LGATE = (float*)(ws + WS_LGATE);
    bf16_t* Y = (bf16_t*)(ws + WS_Y); float* SCR_S = (float*)(ws + WS_SCR_S); bf16_t* POOLED = (bf16_t*)(ws + WS_SCR_POOLED); float* POOLO = (float*)(ws + WS_SCR_POOLO);
    int* CNT = (int*)(ws + OFF_CNT); float* SSQSB = (float*)(ws + OFF_SSQSB); float* SSQ1 = (float*)(ws + OFF_SSQ1); float* SSQ2 = (float*)(ws + OFF_SSQ2);

    (void)hipMemsetAsync(ws + WS_CTL, 0, CTL_BYTES, stream);
    mk::Args a{}; for (int i = 0; i < 22; ++i) a.in[i] = (const float*)d_in[i]; a.out = out; a.ws = ws;
    const dim3 tb(32, 8); const int BIG = 1 << 30; int li = 0;
    for (int p = 0; p < mk::NPHASE;) {
        if ((MEGA_MASK >> p) & 1) { int q = p; while (q < mk::NPHASE && ((MEGA_MASK >> q) & 1)) ++q;
            a.ph_lo = p; a.ph_hi = q; a.li = li; hipLaunchKernelGGL(mk::mega, dim3(grid), dim3(mk::NWAVES * 64), mk::LDS_BYTES, stream, a); ++li; p = q; continue; }
        switch (p) {
        case 0:
            nv::k_cvt_w<<<dim3(INP / 32, D / 32, 1), tb, 0, stream>>>(w_in, D, INP, WIN, INP, g_mix, nullptr, BIG, nullptr, 0, 0);
            nv::k_cvt_w<<<dim3(D / 32, D / 32, 1), tb, 0, stream>>>(w_out, D, D, WOUT, D, g_sb, g_pool, SBW, nullptr, 0, 0);
            nv::k_cvt_w<<<dim3(D / 32, D / 32, 1), tb, 0, stream>>>(w_mem_q, D, D, WQ, D, g_mem_q, nullptr, BIG, nullptr, 0, 0);
            nv::k_cvt_w<<<dim3(2 * D / 32, D / 32, 1), tb, 0, stream>>>(w_mem_kv, D, 2 * D, WKV, 2 * D, g_mem_kv, nullptr, BIG, nullptr, 0, 0);
            nv::k_cvt_w<<<dim3(D / 32, D / 32, 1), tb, 0, stream>>>(w_mem_o, D, D, WO, D, nullptr, nullptr, BIG, nullptr, 0, 0);
            nv::k_cvt_w<<<dim3(2 * DFF / 32, D / 32, NE), tb, 0, stream>>>(w_e_in, D, 2 * DFF, W1, 2 * DFF, g_ffn, nullptr, BIG, nullptr, 0, 1);
            nv::k_cvt_w<<<dim3(D / 32, DFF / 32, NE), tb, 0, stream>>>(w_e_out, DFF, D, W2, D, nullptr, nullptr, BIG, nullptr, 0, 0);
            nv::k_cvt_w<<<dim3(PGD / 32, PGD / 32, PG), tb, 0, stream>>>(w_pool, PGD, PGD, WP, PGD, nullptr, nullptr, BIG, pool_scale, PGD, 0);
            nv::k_cvt_router<<<NE * D / 256, 256, 0, stream>>>(w_router, g_ffn, WR);
            nv::k_rowstat_cvt<<<NTOK / 4, 256, 0, stream>>>(x, S0, RSTDX, NTOK);
            nv::k_rowstat_cvt<<<NMROWS / 4, 256, 0, stream>>>(mem, MEMB, RSTDM, NMROWS);
            break;
        case 1:
            nv::k_g1<<<dim3(INP / 64, NTOK / 64), 256, 0, stream>>>(S0, WIN, RSTDX, QKVU);
            nv::k_g1b<<<dim3(2 * D / 64, NMROWS / 64), 256, 0, stream>>>(MEMB, WKV, RSTDM, KM, VMT);
            break;
        case 2:
            nv::k_sb<<<B * NH * S / 256, 256, 0, stream>>>(QKVU, MIXED, SSQSB);
            nv::k_pool1<<<(unsigned)((size_t)NTOK * PW / 256), 256, 0, stream>>>(QKVU, POOLED);
            nv::k_pool2<<<dim3(PGD / 64, NTOK / 64, PG), 256, 0, stream>>>(POOLED, WP, POOLO);
            nv::k_pool3<<<NTOK / 4, 256, 0, stream>>>(POOLO, MIXED);
            break;
        case 3: nv::k_resid<<<dim3(D / 64, NTOK / 64), 256, 0, stream>>>(MIXED, WOUT, x, out, S0, SSQ1, SSQSB, SBW); break;
        case 4: nv::k_g3<<<dim3(D / 64, NTOK / 64), 256, 0, stream>>>(S0, WQ, SSQ1, QM); break;
        case 5:
            nv::k_ms<<<dim3(NMEM / 64, NTOK / 64, MH), 256, 0, stream>>>(QM, KM, SCR_S);
            nv::k_msoftmax<<<NTOK * MH / 4, 256, 0, stream>>>(SCR_S, PM);
            break;
        case 6: nv::k_mpv<<<dim3(MHD / 64, NTOK / 64, MH), 256, 0, stream>>>(PM, VMT, OM); break;
        case 7: nv::k_resid<<<dim3(D / 64, NTOK / 64), 256, 0, stream>>>(OM, WO, out, out, S0, SSQ2, SSQ2, -1); break;
        case 8: nv::k_route<<<NTOK / 4, 256, 0, stream>>>(out, SSQ2, WR, b_router, CNT, LSLOT, LGATE); break;
        case 9: nv::k_w1<<<dim3(DFF / 32, LCAP / 64, NE), 256, 0, stream>>>(S0, SSQ2, W1, b_e_in, CNT, LSLOT, ACT); break;
        case 10: nv::k_w2<<<dim3(D / 64, LCAP / 64, NE), 256, 0, stream>>>(ACT, W2, b_e_out, CNT, LSLOT, LGATE, Y); break;
        case 11: nv::k_final<<<NTOK / 4, 256, 0, stream>>>(out, Y, g_final); break;
        }
        ++p;
    }
}
```

```cpp
#include <hip/hip_runtime.h>
#include <cstdio>
#include <cstdint>

typedef unsigned short bf16_t;
typedef short bf16x8 __attribute__((ext_vector_type(8)));
typedef float f32x4 __attribute__((ext_vector_type(4)));
typedef unsigned u32x4 __attribute__((ext_vector_type(4)));

namespace cfg {
constexpr int B = 8, S = 4096, D = 1024, NTOK = B * S;
constexpr int SBW = 512, NH = 8, HD = 64, PW = 512, PG = 4, PGD = 128, INP = 2048;
constexpr int NMEM = 256, MH = 4, MHD = 256, NMROWS = B * NMEM;
constexpr int NE = 32, TOPK = 4, DFF = 1024, LCAP = NTOK;
constexpr float EPS = 1e-5f, LOG2E = 1.4426950408889634f;
constexpr float C2_SB = 0.125f * LOG2E, C2_MEM = 0.0625f * LOG2E;
constexpr float SW_LIMIT = 7.0f, SW_ALPHA = 1.702f;
constexpr int MAXTILES = 544;
constexpr size_t MiB = 1u << 20;
constexpr size_t WS_CTL = 0, CTL_BYTES = 2 * MiB;
constexpr size_t OFF_CNT = 64 * 1024, OFF_SSQSB = 512 * 1024, OFF_SSQ1 = 640 * 1024, OFF_SSQ2 = 768 * 1024;
constexpr size_t WS_WIN = 2 * MiB, WS_WOUT = 6 * MiB, WS_WQ = 8 * MiB, WS_WKV = 10 * MiB, WS_WO = 14 * MiB, WS_WP = 16 * MiB, WS_WR = 17 * MiB;
constexpr size_t WS_RSTDX = 18 * MiB, WS_RSTDM = 18 * MiB + 512 * 1024;
constexpr size_t WS_W1 = 20 * MiB, WS_W2 = 148 * MiB;
constexpr size_t WS_S0 = 212 * MiB;
constexpr size_t WS_QKVU = 276 * MiB;
constexpr size_t WS_QM = 276 * MiB, WS_OM = 340 * MiB;
constexpr size_t WS_MIXED = 404 * MiB;
constexpr size_t WS_PM = 404 * MiB;
constexpr size_t WS_ACT = 276 * MiB;
constexpr size_t WS_KM = 548 * MiB, WS_VMT = 552 * MiB, WS_MEMB = 556 * MiB, WS_LSLOT = 560 * MiB, WS_LGATE = 564 * MiB;
constexpr size_t WS_Y = 568 * MiB;
constexpr size_t WS_SCR_S = 568 * MiB, WS_SCR_POOLED = 696 * MiB, WS_SCR_POOLO = 728 * MiB;
constexpr size_t WS_END = 824 * MiB;
}
using namespace cfg;

__device__ __forceinline__ unsigned f2bf(float f) { unsigned u = __builtin_bit_cast(unsigned, f); return (u + 0x7fffu + ((u >> 16) & 1u)) >> 16; }
__device__ __forceinline__ float bf2f(bf16_t h) { return __builtin_bit_cast(float, (unsigned)h << 16); }
__device__ __forceinline__ float wave_sum(float v) {
#pragma unroll
    for (int o = 1; o < 64; o <<= 1) v += __shfl_xor(v, o);
    return v;
}

namespace nv {
__global__ void k_cvt_w(const float* src, int K, int N, bf16_t* dst, int ND, const float* gk, const float* gk2, int ksplit, const float* gn, int gnz, int mode) {
    __shared__ float t[32][33];
    const int nd0 = blockIdx.x * 32, k0 = blockIdx.y * 32, z = blockIdx.z;
    int ns0 = nd0;
    if (mode == 1) { const int pn = nd0 >> 8, j = nd0 & 255; ns0 = (j < 128) ? 128 * pn + j : 1024 + 128 * pn + (j - 128); }
    src += (size_t)z * K * N; dst += (size_t)z * ND * K;
    for (int i = threadIdx.y; i < 32; i += 8) { const int k = k0 + i, n = ns0 + threadIdx.x;
        float v = src[(size_t)k * N + n]; if (gk) v *= (k < ksplit) ? gk[k] : gk2[k - ksplit]; if (gn) v *= gn[z * gnz + n]; t[i][threadIdx.x] = v; }
    __syncthreads();
    for (int i = threadIdx.y; i < 32; i += 8) dst[(size_t)(nd0 + i) * K + k0 + threadIdx.x] = (bf16_t)f2bf(t[threadIdx.x][i]);
}
__global__ void k_cvt_router(const float* wr, const float* g, float* dst) {
    const int i = blockIdx.x * 256 + threadIdx.x; if (i >= NE * D) return; const int e = i / D, k = i % D; dst[i] = g[k] * wr[k * NE + e];
}
__global__ void k_rowstat_cvt(const float* x, bf16_t* xb, float* rstd, int rows) {
    const int row = blockIdx.x * 4 + (threadIdx.x >> 6), lane = threadIdx.x & 63; if (row >= rows) return;
    const float* xr = x + (size_t)row * D; float s = 0.f;
    for (int j = lane; j < D; j += 64) { const float v = xr[j]; s += v * v; xb[(size_t)row * D + j] = (bf16_t)f2bf(v); }
    s = wave_sum(s); if (lane == 0) rstd[row] = 1.0f / sqrtf(s * (1.0f / D) + EPS);
}

template <class RA, class RB, class MID, class EPI>
__device__ __forceinline__ void wave_gemm(int m0, int n0, int K, int kmid, RA ra, RB rb, MID mid, EPI epi) {
    const int lane = threadIdx.x & 63, r16 = lane & 15, kq = lane >> 4;
    const bf16_t* pa[2]; const bf16_t* pb[2];
#pragma unroll
    for (int i = 0; i < 2; ++i) { pa[i] = ra(m0 + i * 16 + r16) + kq * 8; pb[i] = rb(n0 + i * 16 + r16) + kq * 8; }
    f32x4 acc[2][2];
#pragma unroll
    for (int i = 0; i < 2; ++i)
#pragma unroll
        for (int j = 0; j < 2; ++j) acc[i][j] = (f32x4){0.f, 0.f, 0.f, 0.f};
    for (int k = 0; k < K; k += 32) {
        if (k == kmid) {
#pragma unroll
            for (int i = 0; i < 2; ++i)
#pragma unroll
                for (int r = 0; r < 4; ++r) { const float s = mid(m0 + i * 16 + kq * 4 + r); acc[i][0][r] *= s; acc[i][1][r] *= s; }
        }
        bf16x8 a[2], b[2];
#pragma unroll
        for (int i = 0; i < 2; ++i) { a[i] = *(const bf16x8*)(pa[i] + k); b[i] = *(const bf16x8*)(pb[i] + k); }
#pragma unroll
        for (int i = 0; i < 2; ++i)
#pragma unroll
            for (int j = 0; j < 2; ++j) acc[i][j] = __builtin_amdgcn_mfma_f32_16x16x32_bf16(a[i], b[j], acc[i][j], 0, 0, 0);
    }
#pragma unroll
    for (int i = 0; i < 2; ++i)
#pragma unroll
        for (int r = 0; r < 4; ++r) epi(m0 + i * 16 + kq * 4 + r, n0 + r16, n0 + 16 + r16, acc[i][0][r], acc[i][1][r]);
}
struct NoMid { __device__ float operator()(int) const { return 1.f; } };

#define NV_TILE() const int w = threadIdx.x >> 6, m0 = blockIdx.y * 64 + (w >> 1) * 32, n0 = blockIdx.x * 64 + (w & 1) * 32

__global__ void k_g1(const bf16_t* XB, const bf16_t* WT, const float* rstd, bf16_t* QKVU) {
    NV_TILE();
    wave_gemm(m0, n0, D, -1, [=](int r) { return XB + (size_t)r * D; }, [=](int c) { return WT + (size_t)c * D; }, NoMid(),
        [=](int r, int c0, int c1, float v0, float v1) { const float s = rstd[r];
            v0 *= s; v1 *= s; if (c0 < SBW) v0 *= C2_SB; if (c1 < SBW) v1 *= C2_SB;
            QKVU[(size_t)r * INP + c0] = (bf16_t)f2bf(v0); QKVU[(size_t)r * INP + c1] = (bf16_t)f2bf(v1); });
}
__global__ void k_g1b(const bf16_t* MEMB, const bf16_t* WT, const float* rstd, bf16_t* KM, bf16_t* VMT) {
    NV_TILE();
    wave_gemm(m0, n0, D, -1, [=](int r) { return MEMB + (size_t)r * D; }, [=](int c) { return WT + (size_t)c * D; }, NoMid(),
        [=](int r, int c0, int c1, float v0, float v1) { const float s = rstd[r]; const int cc[2] = {c0, c1}; const float vv[2] = {v0 * s, v1 * s};
#pragma unroll
            for (int q = 0; q < 2; ++q) { const int c = cc[q];
                if (c < D) KM[(size_t)r * D + c] = (bf16_t)f2bf(vv[q]);
                else VMT[((size_t)(r >> 8) * D + (c - D)) * NMEM + (r & 255)] = (bf16_t)f2bf(vv[q]); } });
}
__global__ void __launch_bounds__(256) k_sb(const bf16_t* QKVU, bf16_t* MIXED, float* SSQSB) {
    const int gid = blockIdx.x * 256 + threadIdx.x; const int t = gid & (S - 1), h = (gid >> 12) & 7, b = gid >> 15;
    const bf16_t* base = QKVU + (size_t)b * S * INP;
    float q[HD], o[HD];
    { const bf16_t* qp = base + (size_t)t * INP + h * HD;
#pragma unroll
      for (int d = 0; d < HD; ++d) { q[d] = bf2f(qp[d]); o[d] = 0.f; } }
    float P = 1.f;
    for (int s = t - 1; s >= 0; --s) {
        const bf16_t* kp = base + (size_t)s * INP + SBW + h * HD; const bf16_t* vp = kp + SBW;
        float z = 0.f;
#pragma unroll
        for (int d = 0; d < HD; ++d) z += q[d] * bf2f(kp[d]);
        const float e = exp2f(z), r = 1.0f / (1.0f + e), beta = 1.0f - r;
        const float w = bf2f((bf16_t)f2bf(beta * P));
#pragma unroll
        for (int d = 0; d < HD; ++d) o[d] += w * bf2f(vp[d]);
        P *= r;
        if (P == 0.f) break;
    }
    float ss = 0.f; bf16_t* op = MIXED + (size_t)(b * S + t) * D + h * HD;
#pragma unroll
    for (int d = 0; d < HD; ++d) { ss += o[d] * o[d]; op[d] = (bf16_t)f2bf(o[d]); }
    unsafeAtomicAdd(SSQSB + b * S + t, ss);
}
__global__ void k_pool1(const bf16_t* QKVU, bf16_t* POOLED) {
    const size_t gid = (size_t)blockIdx.x * 256 + threadIdx.x; const int c = gid & 511; const int tok = (int)(gid >> 9), t = tok & (S - 1);
    const int win = 2 << (c >> 7); const int n = (t + 1 < win) ? t + 1 : win;
    const bf16_t* up = QKVU + (size_t)tok * INP + 3 * SBW + c; float s = 0.f;
    for (int j = 0; j < n; ++j) s += bf2f(up[-(ptrdiff_t)j * INP]);
    POOLED[gid] = (bf16_t)f2bf(s / (float)n - bf2f(up[0]));
}
__global__ void k_pool2(const bf16_t* POOLED, const bf16_t* WPT, float* POOLO) {
    NV_TILE(); const int g = blockIdx.z;
    wave_gemm(m0, n0, PGD, -1, [=](int r) { return POOLED + (size_t)r * PW + g * PGD; }, [=](int c) { return WPT + ((size_t)g * PGD + c) * PGD; }, NoMid(),
        [=](int r, int c0, int c1, float v0, float v1) { POOLO[(size_t)r * PW + g * PGD + c0] = v0; POOLO[(size_t)r * PW + g * PGD + c1] = v1; });
}
__global__ void k_pool3(const float* POOLO, bf16_t* MIXED) {
    const int tok = blockIdx.x * 4 + (threadIdx.x >> 6), lane = threadIdx.x & 63;
    float v[8], s = 0.f;
#pragma unroll
    for (int j = 0; j < 8; ++j) { v[j] = POOLO[(size_t)tok * PW + lane + 64 * j]; s += v[j] * v[j]; }
    const float rs = 1.0f / sqrtf(wave_sum(s) * (1.0f / PW) + EPS);
#pragma unroll
    for (int j = 0; j < 8; ++j) MIXED[(size_t)tok * D + SBW + lane + 64 * j] = (bf16_t)f2bf(v[j] * rs);
}
__global__ void k_resid(const bf16_t* A, const bf16_t* WT, const float* xin, float* xout, bf16_t* XB, float* SSQ, const float* ssq_mid, int kmid) {
    NV_TILE();
    wave_gemm(m0, n0, D, kmid, [=](int r) { return A + (size_t)r * D; }, [=](int c) { return WT + (size_t)c * D; },
        [=](int r) { return 1.0f / sqrtf(ssq_mid[r] * (1.0f / SBW) + EPS); },
        [=](int r, int c0, int c1, float v0, float v1) {
            const float x0 = xin[(size_t)r * D + c0] + v0, x1 = xin[(size_t)r * D + c1] + v1;
            xout[(size_t)r * D + c0] = x0; xout[(size_t)r * D + c1] = x1;
            XB[(size_t)r * D + c0] = (bf16_t)f2bf(x0); XB[(size_t)r * D + c1] = (bf16_t)f2bf(x1);
            float q = x0 * x0 + x1 * x1; q += __shfl_xor(q, 1); q += __shfl_xor(q, 2); q += __shfl_xor(q, 4); q += __shfl_xor(q, 8);
            if ((threadIdx.x & 15) == 0) unsafeAtomicAdd(SSQ + r, q); });
}
__global__ void k_g3(const bf16_t* X1B, const bf16_t* WT, const float* SSQ1, bf16_t* QM) {
    NV_TILE();
    wave_gemm(m0, n0, D, -1, [=](int r) { return X1B + (size_t)r * D; }, [=](int c) { return WT + (size_t)c * D; }, NoMid(),
        [=](int r, int c0, int c1, float v0, float v1) { const float s = C2_MEM / sqrtf(SSQ1[r] * (1.0f / D) + EPS);
            QM[(size_t)r * D + c0] = (bf16_t)f2bf(v0 * s); QM[(size_t)r * D + c1] = (bf16_t)f2bf(v1 * s); });
}
__global__ void k_ms(const bf16_t* QM, const bf16_t* KM, float* SCR) {
    NV_TILE(); const int h = blockIdx.z; const int b = m0 >> 12;
    wave_gemm(m0, n0, MHD, -1, [=](int r) { return QM + (size_t)r * D + h * MHD; }, [=](int c) { return KM + ((size_t)b * NMEM + c) * D + h * MHD; }, NoMid(),
        [=](int r, int c0, int c1, float v0, float v1) { SCR[((size_t)r * MH + h) * NMEM + c0] = v0; SCR[((size_t)r * MH + h) * NMEM + c1] = v1; });
}
__global__ void k_msoftmax(const float* SCR, bf16_t* PM) {
    const int row = blockIdx.x * 4 + (threadIdx.x >> 6), lane = threadIdx.x & 63;
    float v[4], m = -INFINITY;
#pragma unroll
    for (int j = 0; j < 4; ++j) { v[j] = SCR[(size_t)row * NMEM + lane + 64 * j]; m = fmaxf(m, v[j]); }
#pragma unroll
    for (int o = 1; o < 64; o <<= 1) m = fmaxf(m, __shfl_xor(m, o));
    float s = 0.f;
#pragma unroll
    for (int j = 0; j < 4; ++j) { v[j] = exp2f(v[j] - m); s += v[j]; }
    s = 1.0f / wave_sum(s);
#pragma unroll
    for (int j = 0; j < 4; ++j) PM[(size_t)row * NMEM + lane + 64 * j] = (bf16_t)f2bf(v[j] * s);
}
__global__ void k_mpv(const bf16_t* PM, const bf16_t* VMT, bf16_t* OM) {
    NV_TILE(); const int h = blockIdx.z; const int b = m0 >> 12;
    wave_gemm(m0, n0, NMEM, -1, [=](int r) { return PM + ((size_t)r * MH + h) * NMEM; }, [=](int c) { return VMT + ((size_t)b * D + h * MHD + c) * NMEM; }, NoMid(),
        [=](int r, int c0, int c1, float v0, float v1) { OM[(size_t)r * D + h * MHD + c0] = (bf16_t)f2bf(v0); OM[(size_t)r * D + h * MHD + c1] = (bf16_t)f2bf(v1); });
}
__global__ void k_route(const float* x2, const float* SSQ2, const float* WR, const float* br, int* CNT, int* LSLOT, float* LGATE) {
    const int tok = blockIdx.x * 4 + (threadIdx.x >> 6), lane = threadIdx.x & 63;
    float xv[16];
#pragma unroll
    for (int j = 0; j < 16; ++j) xv[j] = x2[(size_t)tok * D + lane + 64 * j];
    const float rs = 1.0f / sqrtf(SSQ2[tok] * (1.0f / D) + EPS);
    float mine = 0.f;
    for (int e = 0; e < NE; ++e) { float s = 0.f;
#pragma unroll
        for (int j = 0; j < 16; ++j) s += xv[j] * WR[e * D + lane + 64 * j];
        s = wave_sum(s); if (lane == e) mine = s * rs + br[e]; }
    float tv[4]; int ti[4]; float cur = (lane < NE) ? mine : -INFINITY;
#pragma unroll
    for (int k = 0; k < 4; ++k) { float m = cur; int mi = lane;
#pragma unroll
        for (int o = 1; o < 64; o <<= 1) { const float om = __shfl_xor(m, o); const int oi = __shfl_xor(mi, o); if (om > m || (om == m && oi < mi)) { m = om; mi = oi; } }
        tv[k] = m; ti[k] = mi; if (lane == mi) cur = -INFINITY; }
    float g[4], gs = 0.f;
#pragma unroll
    for (int k = 0; k < 4; ++k) { g[k] = expf(tv[k] - tv[0]); gs += g[k]; }
    if (lane < 4) { int e = ti[0]; float gg = g[0];
        if (lane == 1) { e = ti[1]; gg = g[1]; } if (lane == 2) { e = ti[2]; gg = g[2]; } if (lane == 3) { e = ti[3]; gg = g[3]; }
        const int pos = atomicAdd(CNT + e, 1); LSLOT[(size_t)e * LCAP + pos] = tok * 4 + lane; LGATE[(size_t)e * LCAP + pos] = gg / gs; }
}
__device__ __forceinline__ int tile_base(const int* CNT, int e) { int tb = 0; for (int i = 0; i < e; ++i) tb += (CNT[i] + 255) >> 8; return tb; }
__global__ void k_w1(const bf16_t* X2B, const float* SSQ2, const bf16_t* W1T, const float* b1, const int* CNT, const int* LSLOT, bf16_t* ACT) {
    const int e = blockIdx.z, cnt = CNT[e]; const int w = threadIdx.x >> 6; const int m0 = blockIdx.y * 64 + (w >> 1) * 32; if (blockIdx.y * 64 >= cnt) return;
    const int gc0 = blockIdx.x * 32 + (w & 1) * 16;
    const int pn = gc0 >> 7, j0 = gc0 & 127; const int n0 = pn * 256 + j0;
    const int tb = tile_base(CNT, e); const bf16_t* Wt = W1T + (size_t)e * 2 * DFF * D; const int* ls = LSLOT + (size_t)e * LCAP;
    wave_gemm(m0, 0, D, -1, [=](int r) { const int tok = (r < cnt) ? (ls[r] >> 2) : 0; return X2B + (size_t)tok * D; },
        [=](int c) { const int rowb = (c < 16) ? n0 + c : n0 + 128 + (c - 16); return Wt + (size_t)rowb * D; }, NoMid(),
        [=](int r, int c0, int c1, float vg, float vu) { if (r >= cnt) return; const int tok = ls[r] >> 2; const float rs = 1.0f / sqrtf(SSQ2[tok] * (1.0f / D) + EPS);
            const int gc = gc0 + c0;
            float gate = vg * rs + b1[e * 2 * DFF + gc], up = vu * rs + b1[e * 2 * DFF + DFF + gc];
            gate = fminf(gate, SW_LIMIT); up = fminf(fmaxf(up, -SW_LIMIT), SW_LIMIT);
            const float act = (up + 1.0f) * gate / (1.0f + expf(-SW_ALPHA * gate));
            ACT[((size_t)tb * 256 + r) * DFF + gc] = (bf16_t)f2bf(act); (void)c1; });
}
__global__ void k_w2(const bf16_t* ACT, const bf16_t* W2T, const float* b2, const int* CNT, const int* LSLOT, const float* LGATE, bf16_t* Y) {
    const int e = blockIdx.z, cnt = CNT[e]; if (blockIdx.y * 64 >= cnt) return; NV_TILE();
    const int tb = tile_base(CNT, e); const bf16_t* Wt = W2T + (size_t)e * D * DFF; const int* ls = LSLOT + (size_t)e * LCAP; const float* lg = LGATE + (size_t)e * LCAP;
    wave_gemm(m0, n0, DFF, -1, [=](int r) { return ACT + ((size_t)tb * 256 + r) * DFF; }, [=](int c) { return Wt + (size_t)c * DFF; }, NoMid(),
        [=](int r, int c0, int c1, float v0, float v1) { if (r >= cnt) return; const int slot = ls[r]; const float g = lg[r];
            Y[(size_t)slot * D + c0] = (bf16_t)f2bf((v0 + b2[e * D + c0]) * g); Y[(size_t)slot * D + c1] = (bf16_t)f2bf((v1 + b2[e * D + c1]) * g); });
}
__global__ void k_final(float* out, const bf16_t* Y, const float* gf) {
    const int tok = blockIdx.x * 4 + (threadIdx.x >> 6), lane = threadIdx.x & 63;
    float v[16], s = 0.f;
#pragma unroll
    for (int j = 0; j < 16; ++j) { const int c = lane + 64 * j; float a = out[(size_t)tok * D + c];
#pragma unroll
        for (int k = 0; k < 4; ++k) a += bf2f(Y[((size_t)tok * 4 + k) * D + c]);
        v[j] = a; s += a * a; }
    const float rs = 1.0f / sqrtf(wave_sum(s) * (1.0f / D) + EPS);
#pragma unroll
    for (int j = 0; j < 16; ++j) { const int c = lane + 64 * j; out[(size_t)tok * D + c] = v[j] * rs * gf[c]; }
}
}

#define LAS __attribute__((address_space(3)))
#define GAS __attribute__((address_space(1)))
typedef int v4i_t __attribute__((ext_vector_type(4)));
typedef int v8i_t __attribute__((ext_vector_type(8)));
namespace pg8 {
constexpr int BM = 256, BK = 64, HALF = 128, HTB = HALF * BK * 2, STAGE_BYTES = 8 * HTB, NXCD = 8, WGM = 8;
__host__ __device__ __forceinline__ int lds_byte(int r, int c) { const int st = (r >> 4) * 2 + (c >> 5), rr = r & 15, cc = c & 31, ob = rr * 64 + cc * 2; return st * 1024 + (ob ^ (((ob >> 9) & 1) << 5)); }
__host__ __device__ __forceinline__ void stage_rc(int b, int& R, int& C) { const int st = b / 1024, sb = b % 1024, swz = sb ^ (((sb >> 9) & 1) << 5); R = (st >> 1) * 16 + swz / 64; C = (st & 1) * 32 + (swz % 64) / 2; }
__host__ __device__ __forceinline__ int perm32(int rho) { const int n = rho >> 4, i = rho & 15; return 8 * (i >> 2) + 4 * n + (i & 3); }
__device__ __forceinline__ unsigned cvt_pk_bf16(float lo, float hi) { unsigned r; asm volatile("v_cvt_pk_bf16_f32 %0, %1, %2" : "=v"(r) : "v"(lo), "v"(hi)); return r; }

#define WTMASK 0x008
#ifndef WTMASK
#define WTMASK 0x1ff
#endif
#define WT_ON(bit) (((WTMASK) >> (bit)) & 1)
__device__ __forceinline__ void st16_wt(void* p, u32x4 v) { asm volatile("global_store_dwordx4 %0, %1, off sc1\n\ts_nop 1" :: "v"(p), "v"(v)); }
__device__ __forceinline__ void st16_wt(void* p, f32x4 v) { asm volatile("global_store_dwordx4 %0, %1, off sc1\n\ts_nop 1" :: "v"(p), "v"(v)); }
template <int BIT, class V> __device__ __forceinline__ void st16(void* p, V v) { if constexpr (WT_ON(BIT)) st16_wt(p, v); else *(V*)p = v; }
#ifndef WT8
#define WT8 0
#endif
__device__ __forceinline__ void st8_wt(void* p, unsigned long long v) { if (WT8) __hip_atomic_store((unsigned long long*)p, v, __ATOMIC_RELAXED, __HIP_MEMORY_SCOPE_AGENT); else *(unsigned long long*)p = v; }
__device__ __forceinline__ void st4_wt(void* p, unsigned v) { if (WT8) __hip_atomic_store((unsigned*)p, v, __ATOMIC_RELAXED, __HIP_MEMORY_SCOPE_AGENT); else *(unsigned*)p = v; }
__device__ __forceinline__ int fresh_lane() { int l; asm volatile("v_mbcnt_lo_u32_b32 %0, -1, 0\n\tv_mbcnt_hi_u32_b32 %0, -1, %0" : "=v"(l)); return l; }
struct Unit { const char* A; const char* B; void* p0; void* p1; void* p2; void* p3; int pm, pn, i0, i1, ghost; };

__device__ __forceinline__ int xcd_remap(int L, int nwg) { const int q = nwg / NXCD, r = nwg % NXCD, xcd = L % NXCD, off = L / NXCD; return __builtin_amdgcn_readfirstlane((xcd < r ? xcd * (q + 1) : r * (q + 1) + (xcd - r) * q) + off); }
__device__ __forceinline__ void grouped_mn(int wgid, int nM, int nN, int& pm, int& pn) {
    const int nig = WGM * nN, gid = wgid / nig, fm = gid * WGM, gsz = (nM - fm) < WGM ? (nM - fm) : WGM; pm = __builtin_amdgcn_readfirstlane(fm + ((wgid % nig) % gsz)); pn = __builtin_amdgcn_readfirstlane((wgid % nig) / gsz); }

template <class Epi, class Sched, int TABS, int REP = 1, int REPE = 1, bool F8 = false>
__device__ __forceinline__ void gemm_phase(const int wid, LAS unsigned char* lds, LAS unsigned char* epi_lds, LAS unsigned* gtab, const int lda_b, const int ldb_b, const int nt, const Sched& S, const Epi& E) {
    constexpr bool GATHER = (TABS == 1);
    const int wr = wid >> 2, wc = wid & 3;
    unsigned voffA, voffB, voffG[2][2]; int aoff, boff;
    { const int lane = fresh_lane(); int R, C; stage_rc(wid * 1024 + lane * 16, R, C); const int Rb = Epi::PERM ? ((R & ~31) + perm32(R & 31)) : R;
      voffA = (unsigned)(R * lda_b + C * 2); voffB = (unsigned)(Rb * ldb_b + C * 2); voffG[0][0] = voffG[0][1] = voffG[1][0] = voffG[1][1] = 0;
      aoff = lds_byte(wr * 64 + (lane & 15), (lane >> 4) * 8); boff = lds_byte(wc * 32 + (lane & 15), (lane >> 4) * 8); }
    const size_t kstep = (size_t)(BK * 2);
    const size_t hstepA = (size_t)HALF * lda_b, hstepB = (size_t)HALF * ldb_b;
    const unsigned ldsw = (unsigned)wid * 1024u; const unsigned ldsbase = (unsigned)(uintptr_t)lds + ldsw;
#define PG8_SA(b, h) (((b) * 2 + (h)) * HTB)
#define PG8_SB(b, h) ((4 + (b) * 2 + (h)) * HTB)
#define PG8_GLDS(ugp, voff, bufoff, _i) do { unsigned _keep; asm volatile("s_mov_b32 %0, m0\n\ts_mov_b32 m0, %3\n\ts_nop 0\n\tglobal_load_lds_dwordx4 %1, %2\n\ts_mov_b32 m0, %0" \
        : "=&s"(_keep) : "v"(voff), "s"((const char*)(ugp)), "s"(ldsbase + (unsigned)((bufoff) + (_i) * 8192)) : "memory"); } while (0)
#define PG8_STAGE_B(bufoff, gbase) do { _Pragma("unroll") for (int _i = 0; _i < 2; ++_i) PG8_GLDS((const char*)(gbase) + (size_t)_i * 64 * ldb_b, voffB, bufoff, _i); } while (0)
#define PG8_STAGE_A(bufoff, gbase, h) do { if constexpr (GATHER) { _Pragma("unroll") for (int _i = 0; _i < 2; ++_i) PG8_GLDS((const char*)(gbase), voffG[h][_i], bufoff, _i); } \
        else { _Pragma("unroll") for (int _i = 0; _i < 2; ++_i) PG8_GLDS((const char*)(gbase) + (h) * hstepA + (size_t)_i * 64 * lda_b, voffA, bufoff, _i); } } while (0)
#define PG8_LDA(dst, b, h) do { _Pragma("unroll") for (int m = 0; m < 4; ++m) _Pragma("unroll") for (int k = 0; k < 2; ++k) dst[m][k] = *(const LAS bf16x8*)(lds + PG8_SA(b, h) + aoff + m * 2048 + k * 1024); } while (0)
#define PG8_LDB(dst, b, h) do { _Pragma("unroll") for (int n = 0; n < 2; ++n) _Pragma("unroll") for (int k = 0; k < 2; ++k) dst[n][k] = *(const LAS bf16x8*)(lds + PG8_SB(b, h) + boff + n * 2048 + k * 1024); } while (0)
#define PG8_CAT(x0, x1) __builtin_shufflevector(__builtin_bit_cast(v4i_t, x0), __builtin_bit_cast(v4i_t, x1), 0, 1, 2, 3, 4, 5, 6, 7)
#define PG8_MMA(ai, bj, At, Bt) do { __builtin_amdgcn_s_setprio(1); _Pragma("unroll") for (int m = 0; m < 4; ++m) _Pragma("unroll") for (int n = 0; n < 2; ++n) { \
        if constexpr (F8) acc[ai][bj][m][n] = __builtin_amdgcn_mfma_scale_f32_16x16x128_f8f6f4(PG8_CAT(Bt[n][0], Bt[n][1]), PG8_CAT(At[m][0], At[m][1]), acc[ai][bj][m][n], 0, 0, 0, 0, 0, 0); \
        else { _Pragma("unroll") for (int k = 0; k < 2; ++k) acc[ai][bj][m][n] = __builtin_amdgcn_mfma_f32_16x16x32_bf16(Bt[n][k], At[m][k], acc[ai][bj][m][n], 0, 0, 0); } } __builtin_amdgcn_s_setprio(0); } while (0)
#define PG8_WAIT_V(n) asm volatile("s_waitcnt vmcnt(" #n ")" ::: "memory")
#define PG8_WAIT_L(n) asm volatile("s_waitcnt lgkmcnt(" #n ")" ::: "memory")
#define PG8_BAR __builtin_amdgcn_s_barrier()
#define PG8_SCHED __builtin_amdgcn_sched_barrier(0)
#define PG8_GTAB_LOAD(buf, nvalid) do { const int _l = fresh_lane(); int _R, _C; stage_rc(wid * 1024 + _l * 16, _R, _C); _Pragma("unroll") for (int _h = 0; _h < 2; ++_h) _Pragma("unroll") for (int _i = 0; _i < 2; ++_i) { \
        const int _row = _h * HALF + _R + 64 * _i; const unsigned _s = gtab[(buf) * 768 + _row]; voffG[_h][_i] = ((_row < (nvalid)) ? (_s >> 2) * (unsigned)lda_b : 0u) + (unsigned)(_C * 2); } } while (0)
#define PG8_GTAB_DMA(buf, U) do { if (wid < 3) { const int _l = fresh_lane(); const char* _src = (wid == 0) ? (const char*)(U).p3 + _l * 16 : (wid == 1) ? (const char*)(U).p2 + _l * 16 : \
            (TABS == 1 ? (const char*)(U).p1 + (_l & 31) * 16 + (_l >> 5) * (DFF * 4) : (const char*)(U).p1 + _l * 16); \
        __builtin_amdgcn_global_load_lds((const unsigned*)_src, (LAS unsigned*)(gtab + (buf) * 768 + wid * 256), 16, 0, 0); } } while (0)
    auto nextu = [&](int i, Unit& u) -> bool { if constexpr (REP > 1) { const bool ok = S.next(i / REP, u); u.ghost = (i % REP) != REP - 1; return ok; } else { u.ghost = 0; return S.next(i, u); } };
    Unit cur, nxt; int ui = 0;
    if (!nextu(0, cur)) return;
    f32x4 acc[2][2][4][2];
#pragma unroll
    for (int a = 0; a < 2; ++a)
#pragma unroll
        for (int b = 0; b < 2; ++b)
#pragma unroll
            for (int m = 0; m < 4; ++m)
#pragma unroll
                for (int n = 0; n < 2; ++n) acc[a][b][m][n] = (f32x4){0.f, 0.f, 0.f, 0.f};
    bf16x8 At[4][2], B0[2][2], B1[2][2];
    const char* cA = cur.A; const char* cB = cur.B;
    if constexpr (TABS != 0) { PG8_GTAB_DMA(0, cur); PG8_WAIT_V(0); PG8_WAIT_L(0); PG8_BAR; if constexpr (GATHER) PG8_GTAB_LOAD(0, cur.i0); }
    PG8_STAGE_B(PG8_SB(0, 0), cB); PG8_STAGE_B(PG8_SB(0, 1), cB + hstepB); PG8_STAGE_A(PG8_SA(0, 0), cA, 0); PG8_STAGE_A(PG8_SA(0, 1), cA, 1);
    if (wr == 1) PG8_BAR;
    PG8_WAIT_V(2); PG8_BAR;
    PG8_STAGE_B(PG8_SB(1, 0), cB + kstep); PG8_STAGE_A(PG8_SA(1, 0), cA + kstep, 0); PG8_STAGE_B(PG8_SB(1, 1), cB + hstepB + kstep);
    PG8_WAIT_V(6); PG8_BAR;
    for (;;) {
        const bool has_next = nextu(ui + 1, nxt);
        const char* nA = has_next ? nxt.A : cA; const char* nB = has_next ? nxt.B : cB;
#pragma unroll 1
        for (int t = 0; t < nt; t += 2) {
            const bool last = (t == nt - 2);
            const char* a1 = cA + (size_t)(t + 1) * kstep;
            const char* a2 = last ? nA : cA + (size_t)(t + 2) * kstep; const char* b2 = last ? nB : cB + (size_t)(t + 2) * kstep;
            const char* a3 = a2 + kstep; const char* b3 = b2 + kstep;
            if constexpr (Epi::MIDK >= 0) { if (t == Epi::MIDK) E.midk(acc, cur, wr, fresh_lane() & 15); }
            if constexpr (TABS != 0) { if (t == 2 && has_next) PG8_GTAB_DMA((ui + 1) & 1, nxt); }
            if constexpr (GATHER) { PG8_STAGE_A(PG8_SA(1, 1), a1, 1); if (last && has_next) PG8_GTAB_LOAD((ui + 1) & 1, nxt.i0); PG8_SCHED; }
            PG8_LDB(B0, 0, 0); PG8_LDB(B1, 0, 1); PG8_SCHED; PG8_LDA(At, 0, 0); if constexpr (!GATHER) PG8_STAGE_A(PG8_SA(1, 1), a1, 1);
            PG8_WAIT_V(8); PG8_WAIT_L(0); PG8_BAR; PG8_MMA(0, 0, At, B0); PG8_MMA(0, 1, At, B1); PG8_BAR; PG8_SCHED;
            PG8_LDA(At, 0, 1); PG8_STAGE_B(PG8_SB(0, 0), b2); PG8_STAGE_B(PG8_SB(0, 1), b2 + hstepB); PG8_STAGE_A(PG8_SA(0, 0), a2, 0);
            PG8_WAIT_V(8); PG8_WAIT_L(0); PG8_BAR; PG8_MMA(1, 0, At, B0); PG8_MMA(1, 1, At, B1); PG8_BAR; PG8_SCHED;
            PG8_LDB(B0, 1, 0); PG8_LDB(B1, 1, 1); PG8_SCHED; PG8_LDA(At, 1, 0); PG8_STAGE_A(PG8_SA(0, 1), a2, 1);
            PG8_WAIT_V(8); PG8_WAIT_L(0); PG8_BAR; PG8_MMA(0, 0, At, B0); PG8_MMA(0, 1, At, B1); PG8_BAR; PG8_SCHED;
            PG8_LDA(At, 1, 1); PG8_STAGE_B(PG8_SB(1, 0), b3); PG8_STAGE_B(PG8_SB(1, 1), b3 + hstepB); PG8_STAGE_A(PG8_SA(1, 0), a3, 0);
            PG8_WAIT_V(8); PG8_WAIT_L(0); PG8_BAR; PG8_MMA(1, 0, At, B0); PG8_MMA(1, 1, At, B1); PG8_BAR; PG8_SCHED;
        }
        if (wr == 0) PG8_BAR;
        if (!cur.ghost) { const int el = fresh_lane(); LAS unsigned char* ex = (TABS != 0) ? (LAS unsigned char*)(gtab + (ui & 1) * 768) : epi_lds; E(acc, cur, wr, wc, el & 15, el >> 4, wid, el, ex); if constexpr (REPE > 1) { asm volatile("" ::: "memory"); E(acc, cur, wr, wc, el & 15, el >> 4, wid, el, ex); } }
        if (!has_next) break;
#pragma unroll
        for (int a = 0; a < 2; ++a)
#pragma unroll
            for (int b = 0; b < 2; ++b)
#pragma unroll
                for (int m = 0; m < 4; ++m)
#pragma unroll
                    for (int n = 0; n < 2; ++n) acc[a][b][m][n] = (f32x4){0.f, 0.f, 0.f, 0.f};
        cur = nxt; cA = nA; cB = nB; ++ui;
        if (wr == 1) PG8_BAR;
    }
    PG8_WAIT_V(0);
    PG8_BAR;
#undef PG8_SA
#undef PG8_SB
#undef PG8_GLDS
#undef PG8_STAGE_A
#undef PG8_STAGE_B
#undef PG8_LDA
#undef PG8_LDB
#undef PG8_MMA
#undef PG8_CAT
#undef PG8_WAIT_V
#undef PG8_WAIT_L
#undef PG8_BAR
#undef PG8_SCHED
#undef PG8_GTAB_LOAD
#undef PG8_GTAB_DMA
}

template <bool F8O> struct EpiBf16SX {
    static constexpr bool PERM = true; static constexpr int MIDK = -1;
    __device__ __forceinline__ void midk(f32x4 (&)[2][2][4][2], const Unit&, int, int) const {}
    __device__ __forceinline__ void operator()(const f32x4 (&acc)[2][2][4][2], const Unit& u, int wr, int wc, int fr, int fq, int, int, LAS unsigned char*) const {
        bf16_t* O = (bf16_t*)u.p0; unsigned char* O8 = (unsigned char*)u.p0; const float* rs = (const float*)u.p1; const float* cs = (const float*)u.p2; const int ldc = u.i0;
        int r0 = wr * 64 + fr, c0 = wc * 32 + 8 * fq; asm volatile("" : "+v"(r0), "+v"(c0));
        f32x4 cv[2][2];
#pragma unroll
        for (int bj = 0; bj < 2; ++bj)
#pragma unroll
            for (int n = 0; n < 2; ++n) cv[bj][n] = cs ? *(const f32x4*)(cs + c0 + bj * HALF + 4 * n) : (f32x4){1.f, 1.f, 1.f, 1.f};
#pragma unroll
        for (int ai = 0; ai < 2; ++ai)
#pragma unroll
            for (int m = 0; m < 4; ++m) { const int r = r0 + ai * HALF + m * 16; const float rv = rs ? rs[r] : 1.f; bf16_t* rowp = O + (size_t)r * ldc + c0;
#pragma unroll
                for (int bj = 0; bj < 2; ++bj) { const f32x4 v0 = acc[ai][bj][m][0] * cv[bj][0] * rv, v1 = acc[ai][bj][m][1] * cv[bj][1] * rv;
                    if constexpr (F8O) { int w0 = __builtin_amdgcn_cvt_pk_fp8_f32(v0[0], v0[1], 0, false); w0 = __builtin_amdgcn_cvt_pk_fp8_f32(v0[2], v0[3], w0, true); int w1 = __builtin_amdgcn_cvt_pk_fp8_f32(v1[0], v1[1], 0, false); w1 = __builtin_amdgcn_cvt_pk_fp8_f32(v1[2], v1[3], w1, true);
                        st8_wt(O8 + (size_t)r * ldc + c0 + bj * HALF, (unsigned long long)(unsigned)w0 | ((unsigned long long)(unsigned)w1 << 32)); }
                    else { u32x4 w; w.x = cvt_pk_bf16(v0[0], v0[1]); w.y = cvt_pk_bf16(v0[2], v0[3]); w.z = cvt_pk_bf16(v1[0], v1[1]); w.w = cvt_pk_bf16(v1[2], v1[3]);
                    st16<1>(rowp + bj * HALF, w); } } }
    }
};
typedef EpiBf16SX<false> EpiBf16S;
}

namespace mk {
constexpr int NWAVES = 8, NPHASE = 12;
constexpr int RING_OFF = 0, RING_BYTES = 131072, EPI_OFF = 131072, EPI_BYTES = 8192, GTAB_OFF = EPI_OFF + EPI_BYTES, GTAB_BYTES = 6144, MISC_OFF = GTAB_OFF + GTAB_BYTES, MISC_BYTES = 1024;
constexpr int LDS_BYTES = 147456;
static_assert(MISC_OFF + MISC_BYTES <= LDS_BYTES, "LDS map");
constexpr size_t WS_LRS = 84 * MiB;
constexpr size_t WS_X2F8 = WS_Y, WS_X1F8 = WS_Y + 32 * MiB;
constexpr size_t WS_CSG1 = 19 * MiB, WS_WRH = 19 * MiB + 64 * 1024, WS_WRL = 19 * MiB + 128 * 1024;
typedef unsigned ssq_t;
constexpr size_t MK_SSQSB = 256 * 1024, MK_SSQ1 = 512 * 1024, MK_SSQ2 = 768 * 1024;
__device__ __forceinline__ void ssq_add(ssq_t* p, float q) { (void)__hip_atomic_fetch_add(p, (ssq_t)__float2uint_rn(q * 16384.0f), __ATOMIC_RELAXED, __HIP_MEMORY_SCOPE_AGENT); }
__device__ __forceinline__ float ssq_get(const ssq_t* p) { return (float)(*p) * (1.0f / 16384.0f); }
constexpr float WSCALE = 32.0f;
constexpr int CW_BAR = 1024;

#define RLX_AGENT __ATOMIC_RELAXED, __HIP_MEMORY_SCOPE_AGENT
#define LDS_WAIT() asm volatile("s_waitcnt lgkmcnt(0)" ::: "memory")
#define VM_WAIT() asm volatile("s_waitcnt vmcnt(0)" ::: "memory")
#define XB_TMO      128
#define XB_XCNT(j)  (256  + 64 * (j))
#define XB_XSUB(j)  (1280 + 64 * (j))
#define XB_XGEN(j)  (2304 + 64 * (j))
#define XB_TOP      3328
#define XB_TOPGEN   3392
#define XCD_BAR_WORDS 3456
#define XB_SPIN_CAP (1u << 20)
__device__ __forceinline__ unsigned xb_ld(unsigned* p)              { return __hip_atomic_load(p, __ATOMIC_RELAXED, __HIP_MEMORY_SCOPE_AGENT); }
__device__ __forceinline__ unsigned xb_add(unsigned* p, unsigned v) { return __hip_atomic_fetch_add(p, v, __ATOMIC_RELAXED, __HIP_MEMORY_SCOPE_AGENT); }
__device__ __forceinline__ unsigned xb_xcc_id() { return (unsigned)__builtin_amdgcn_s_getreg((3 << 11) | 20) & 0xFu; }
#define XB_SPIN(cond, bar) do { unsigned _sp = 0; while (cond) { __builtin_amdgcn_s_sleep(1); \
    if ((++_sp & 255u) == 0u) { if (xb_ld(&(bar)[XB_TMO])) break; if (_sp > XB_SPIN_CAP) { atomicAdd(&(bar)[XB_TMO], 1u); break; } } } } while (0)
struct XcdBarrier { unsigned* bar; unsigned x; volatile LAS unsigned* st; };
__device__ __forceinline__ XcdBarrier xcd_barrier_post(unsigned* bar, volatile LAS unsigned* st) {
    XcdBarrier b; b.bar = bar; b.x = xb_xcc_id(); b.st = st;
    if (threadIdx.x == 0) (void)xb_add(&bar[XB_XCNT(b.x)], 1u);
    return b;
}
__device__ __forceinline__ void xcd_barrier_complete(unsigned* bar, unsigned x, unsigned& nloc, unsigned& nx) {
    const unsigned G = gridDim.x * gridDim.y * gridDim.z;
    unsigned sum, cnt, mine, sp = 0u;
    for (;;) {
        sum = 0u; cnt = 0u; mine = 0u;
#pragma unroll
        for (unsigned j = 0; j < 16; ++j) { const unsigned c = xb_ld(&bar[XB_XCNT(j)]); sum += c; cnt += (c > 0u) ? 1u : 0u; mine = (j == x) ? c : mine; }
        if (sum == G) break;
        __builtin_amdgcn_s_sleep(1);
        if ((++sp & 255u) == 0u) { if (xb_ld(&bar[XB_TMO])) break; if (sp > XB_SPIN_CAP) { atomicAdd(&bar[XB_TMO], 1u); break; } }
    }
    nloc = mine > 0u ? mine : 1u; nx = cnt > 0u ? cnt : 1u;
}
__device__ __forceinline__ void xcd_barrier(const XcdBarrier& b) {
    asm volatile("s_waitcnt vmcnt(0)" ::: "memory");
    __syncthreads();
    if (threadIdx.x == 0) {
        unsigned* bar = b.bar;
        __builtin_amdgcn_s_waitcnt(0);
        unsigned nloc = b.st[0], nx = b.st[1];
        if (nloc == 0u) { xcd_barrier_complete(bar, b.x, nloc, nx); b.st[0] = nloc; b.st[1] = nx; }
        const unsigned old = xb_add(&bar[XB_XSUB(b.x)], 1u);
        const unsigned gen = old / nloc;
        if (old + 1u == (gen + 1u) * nloc) {
            __builtin_amdgcn_fence(__ATOMIC_RELEASE, "agent");
            asm volatile("s_waitcnt vmcnt(0)" ::: "memory");
            const unsigned og = xb_add(&bar[XB_TOP], 1u);
            const unsigned tg = og / nx;
            if (og + 1u == (tg + 1u) * nx) xb_add(&bar[XB_TOPGEN], 1u);
            else XB_SPIN(xb_ld(&bar[XB_TOPGEN]) == tg, bar);
            __builtin_amdgcn_fence(__ATOMIC_ACQUIRE, "agent");
            xb_add(&bar[XB_XGEN(b.x)], 1u);
            asm volatile("s_waitcnt vmcnt(0)" ::: "memory");
        } else {
            XB_SPIN(xb_ld(&bar[XB_XGEN(b.x)]) == gen, bar);
            __builtin_amdgcn_fence(__ATOMIC_ACQUIRE, "agent");
            asm volatile("s_waitcnt vmcnt(0)" ::: "memory");
        }
    }
    __syncthreads();
}

struct Args { const float* in[22]; float* out; unsigned char* ws; int ph_lo, ph_hi, li, pad; };

template <bool F8OUT>
__device__ __forceinline__ void p0_item(const float* W, int K, int N, void* WTv, const float* gk, const float* gk2, int ksplit, const float* gn, int mode, LAS float* scr, int item, int lane, float mult = 1.0f, int nblk_dec = 0) {
    const int nblk = nblk_dec ? nblk_dec : N / 32, kb = item / nblk, nb = item % nblk, k0 = 64 * kb, nd0 = 32 * nb;
    int ns0 = nd0; if (mode == 1) { const int pn = nd0 >> 8, j = nd0 & 255; ns0 = (j < 128) ? 128 * pn + j : 1024 + 128 * pn + (j - 128); }
    const int kr = lane >> 3, n4 = (lane & 7) * 4;
    f32x4 v[8];
#pragma unroll
    for (int i = 0; i < 8; ++i) v[i] = *(const f32x4*)(W + (size_t)(k0 + 8 * i + kr) * N + ns0 + n4);
    f32x4 gnv = (f32x4){1.f, 1.f, 1.f, 1.f}; if (gn) gnv = *(const f32x4*)(gn + ns0 + n4);
#pragma unroll
    for (int i = 0; i < 8; ++i) { const int kk = 8 * i + kr, k = k0 + kk; float g = 1.f; if (gk) g = (k < ksplit) ? gk[k] : gk2[k - ksplit];
        const f32x4 t = v[i] * gnv * (g * mult); LAS float* d = scr + kk * 33 + n4; d[0] = t[0]; d[1] = t[1]; d[2] = t[2]; d[3] = t[3]; }
    LDS_WAIT(); asm volatile("" ::: "memory");
    const int c = lane & 7;
#pragma unroll
    for (int j = 0; j < 4; ++j) { const int n = (lane >> 3) + 8 * j; const LAS float* s = scr + (8 * c) * 33 + n;
        if constexpr (F8OUT) { int lo = __builtin_amdgcn_cvt_pk_fp8_f32(s[0 * 33], s[1 * 33], 0, false); lo = __builtin_amdgcn_cvt_pk_fp8_f32(s[2 * 33], s[3 * 33], lo, true);
            int hi2 = __builtin_amdgcn_cvt_pk_fp8_f32(s[4 * 33], s[5 * 33], 0, false); hi2 = __builtin_amdgcn_cvt_pk_fp8_f32(s[6 * 33], s[7 * 33], hi2, true);
            pg8::st8_wt((unsigned char*)WTv + (size_t)(nd0 + n) * K + k0 + 8 * c, (unsigned long long)(unsigned)lo | ((unsigned long long)(unsigned)hi2 << 32)); }
        else { u32x4 o; o.x = pg8::cvt_pk_bf16(s[0 * 33], s[1 * 33]); o.y = pg8::cvt_pk_bf16(s[2 * 33], s[3 * 33]); o.z = pg8::cvt_pk_bf16(s[4 * 33], s[5 * 33]); o.w = pg8::cvt_pk_bf16(s[6 * 33], s[7 * 33]);
            pg8::st16<0>((bf16_t*)WTv + (size_t)(nd0 + n) * K + k0 + 8 * c, o); } }
    LDS_WAIT(); asm volatile("" ::: "memory");
}
__device__ __forceinline__ void p0_fused_pool_item(const float* w_in, const float* g_mix, const float* w_pool, const float* pool_scale, bf16_t* WIN_T, int item, int lane) {
    const int eb = item & 7, kb = (item >> 3) & 15, g = item >> 7; const int k = kb * 64 + lane, e0 = eb * 16;
    const float* ap = w_in + (size_t)k * INP + 3 * SBW + g * PGD; const float* bp = w_pool + (size_t)g * PGD * PGD + e0;
    float acc[16];
#pragma unroll
    for (int j = 0; j < 16; ++j) acc[j] = 0.f;
#pragma unroll 4
    for (int c = 0; c < PGD; ++c) { const float a = ap[c];
#pragma unroll
        for (int j = 0; j < 16; ++j) acc[j] += a * bp[c * PGD + j]; }
    const float gk = g_mix[k];
#pragma unroll
    for (int j = 0; j < 16; ++j) WIN_T[(size_t)(3 * SBW + g * PGD + e0 + j) * D + k] = (bf16_t)f2bf(acc[j] * gk * pool_scale[g * PGD + e0 + j]);
}
__device__ __forceinline__ void p0_row(const float* xrow, bf16_t* orow, float* rstd, int lane) {
    const f32x4* xr = (const f32x4*)xrow + 2 * lane; f32x4 v[4]; float s = 0.f;
#pragma unroll
    for (int j = 0; j < 4; ++j) { v[j] = xr[(j >> 1) * 128 + (j & 1)]; s += (v[j].x * v[j].x + v[j].y * v[j].y) + (v[j].z * v[j].z + v[j].w * v[j].w); }
    s = wave_sum(s); if (lane == 0) *rstd = 1.0f / sqrtf(s * (1.0f / D) + EPS);
#pragma unroll
    for (int j = 0; j < 2; ++j) { u32x4 o; o.x = pg8::cvt_pk_bf16(v[2 * j].x, v[2 * j].y); o.y = pg8::cvt_pk_bf16(v[2 * j].z, v[2 * j].w); o.z = pg8::cvt_pk_bf16(v[2 * j + 1].x, v[2 * j + 1].y); o.w = pg8::cvt_pk_bf16(v[2 * j + 1].z, v[2 * j + 1].w);
        pg8::st16<0>(orow + j * 512 + 8 * lane, o); }
}
__device__ __forceinline__ void p0_prologue(const Args& a, LAS unsigned char* lds, int vcu, int G, int wave, int lane) {
    unsigned char* ws = a.ws;
    LAS float* scr = (LAS float*)(lds + RING_OFF + wave * 16384);
    const int gw = vcu * NWAVES + wave, NGW = G * NWAVES;
    constexpr int I_E1 = (D / 64) * (2 * DFF / 32), I_E2 = (DFF / 64) * (D / 32);
    constexpr int I_IN = (D / 64) * (3 * SBW / 32), I_FP = PG * 16 * 8, I_SQ = (D / 64) * (D / 32), I_KV = (D / 64) * (2 * D / 32), I_P = (PGD / 64) * (PGD / 32);
    constexpr int N1 = NE * I_E1, N2 = NE * I_E2, NITEMS = N1 + N2 + I_IN + 3 * I_SQ + I_KV + I_FP;
    const int BIG = 1 << 30;
    for (int it = gw; it < NITEMS; it += NGW) {
        int r = it;
        if (r < N1) { const int e = r / I_E1; p0_item<true>(a.in[17] + (size_t)e * D * 2 * DFF, D, 2 * DFF, ws + WS_W1 + (size_t)e * 2 * DFF * D, a.in[14], nullptr, BIG, nullptr, 1, scr, r % I_E1, lane, WSCALE); continue; } r -= N1;
        if (r < N2) { const int e = r / I_E2; p0_item<true>(a.in[19] + (size_t)e * DFF * D, DFF, D, ws + WS_W2 + (size_t)e * D * DFF, nullptr, nullptr, BIG, nullptr, 0, scr, r % I_E2, lane, WSCALE); continue; } r -= N2;
        if (r < I_IN) { p0_item<false>(a.in[3], D, INP, (bf16_t*)(ws + WS_WIN), a.in[2], nullptr, BIG, nullptr, 0, scr, r, lane, 1.0f, 3 * SBW / 32); continue; } r -= I_IN;
        if (r < I_SQ) { p0_item<false>(a.in[8], D, D, (bf16_t*)(ws + WS_WOUT), a.in[4], a.in[5], SBW, nullptr, 0, scr, r, lane); continue; } r -= I_SQ;
        if (r < I_SQ) { p0_item<true>(a.in[11], D, D, ws + WS_WQ, a.in[9], nullptr, BIG, nullptr, 0, scr, r, lane, WSCALE); continue; } r -= I_SQ;
        if (r < I_KV) { p0_item<false>(a.in[12], D, 2 * D, (bf16_t*)(ws + WS_WKV), a.in[10], nullptr, BIG, nullptr, 0, scr, r, lane); continue; } r -= I_KV;
        if (r < I_SQ) { p0_item<false>(a.in[13], D, D, (bf16_t*)(ws + WS_WO), nullptr, nullptr, BIG, nullptr, 0, scr, r, lane); continue; } r -= I_SQ;
        p0_fused_pool_item(a.in[3], a.in[2], a.in[6], a.in[7], (bf16_t*)(ws + WS_WIN), r, lane);
    }
    for (int m = gw; m < NTOK; m += NGW) p0_row(a.in[0] + (size_t)m * D, (bf16_t*)(ws + WS_S0) + (size_t)m * D, (float*)(ws + WS_RSTDX) + m, lane);
    for (int m = gw; m < NMROWS; m += NGW) p0_row(a.in[1] + (size_t)m * D, (bf16_t*)(ws + WS_MEMB) + (size_t)m * D, (float*)(ws + WS_RSTDM) + m, lane);
    const int gt = gw * 64 + lane, NGT = NGW * 64;
    for (int i = gt; i < INP; i += NGT) ((float*)(ws + WS_CSG1))[i] = (i < SBW) ? C2_SB : 1.0f;
    for (int i = gt; i < NE * D; i += NGT) { const int e = i / D, k = i % D; const float v = a.in[14][k] * a.in[15][k * NE + e];
        ((float*)(ws + WS_WR))[i] = v; const unsigned h = f2bf(v); ((bf16_t*)(ws + WS_WRH))[i] = (bf16_t)h; ((bf16_t*)(ws + WS_WRL))[i] = (bf16_t)f2bf(v - bf2f((bf16_t)h)); }
}

struct SchedP1 {
    int G, c; unsigned char* ws;
    __device__ __forceinline__ bool next(int i, pg8::Unit& u) const {
        const int L = i * G + c; constexpr int NQ = (NTOK / 256) * (INP / 256);
        if (L >= NQ + 64) return false;
        if (L < NQ) { int pm, pn; pg8::grouped_mn(pg8::xcd_remap(L, NQ), NTOK / 256, INP / 256, pm, pn);
            u.A = (const char*)(ws + WS_S0) + (size_t)pm * 256 * D * 2; u.B = (const char*)(ws + WS_WIN) + (size_t)pn * 256 * D * 2;
            u.p0 = (bf16_t*)(ws + WS_QKVU) + (size_t)pm * 256 * INP + pn * 256; u.p1 = (float*)(ws + WS_RSTDX) + pm * 256; u.p2 = (float*)(ws + WS_CSG1) + pn * 256; u.i0 = INP; u.pm = pm; u.pn = pn; }
        else if (L < NQ + 32) { const int k = L - NQ, pm = k >> 2, pn = k & 3;
            u.A = (const char*)(ws + WS_MEMB) + (size_t)pm * 256 * D * 2; u.B = (const char*)(ws + WS_WKV) + (size_t)pn * 256 * D * 2;
            u.p0 = (bf16_t*)(ws + WS_KM) + (size_t)pm * 256 * D + pn * 256; u.p1 = (float*)(ws + WS_RSTDM) + pm * 256; u.p2 = nullptr; u.i0 = D; u.pm = pm; u.pn = pn; }
        else { const int v = L - NQ - 32, b = v >> 2, dt = v & 3;
            u.A = (const char*)(ws + WS_WKV) + (size_t)(D + dt * 256) * D * 2; u.B = (const char*)(ws + WS_MEMB) + (size_t)b * 256 * D * 2;
            u.p0 = (bf16_t*)(ws + WS_VMT) + ((size_t)b * D + dt * 256) * NMEM; u.p1 = nullptr; u.p2 = (float*)(ws + WS_RSTDM) + b * 256; u.i0 = NMEM; u.pm = dt; u.pn = b; }
        u.p3 = nullptr; u.i1 = 0; return true;
    }
};
#define EPI_BAR() asm volatile("s_waitcnt lgkmcnt(0)\n\ts_barrier" ::: "memory")
struct SchedReg {
    int G, c, nM, nN; const char* A; const char* B; size_t astep, bstep; bf16_t* O; int ldc; const float* rs; const float* cs; const ssq_t* sq = nullptr;
    __device__ __forceinline__ bool next(int i, pg8::Unit& u) const {
        const int L = i * G + c; if (L >= nM * nN) return false; int pm, pn; pg8::grouped_mn(pg8::xcd_remap(L, nM * nN), nM, nN, pm, pn);
        u.A = A + (size_t)pm * astep; u.B = B + (size_t)pn * bstep; u.pm = pm; u.pn = pn; u.i0 = ldc; u.i1 = 0;
        u.p0 = O ? (void*)(O + (size_t)pm * 256 * ldc + pn * 256) : nullptr; u.p1 = sq ? (void*)(sq + pm * 256) : (rs ? (void*)(rs + pm * 256) : nullptr); u.p2 = cs ? (void*)(cs + pn * 256) : nullptr; u.p3 = nullptr; return true;
    }
};
struct EpiBf16Ssq {
    static constexpr bool PERM = true; static constexpr int MIDK = -1; float inv_n, mult;
    __device__ __forceinline__ void midk(f32x4 (&)[2][2][4][2], const pg8::Unit&, int, int) const {}
    __device__ __forceinline__ void operator()(f32x4 (&acc)[2][2][4][2], const pg8::Unit& u, int wr, int wc, int fr, int fq, int, int, LAS unsigned char*) const {
        bf16_t* O = (bf16_t*)u.p0; const ssq_t* sq = (const ssq_t*)u.p1; const int ldc = u.i0; int r0 = wr * 64 + fr, c0 = wc * 32 + 8 * fq; asm volatile("" : "+v"(r0), "+v"(c0));
#pragma unroll
        for (int ai = 0; ai < 2; ++ai)
#pragma unroll
            for (int m = 0; m < 4; ++m) { const int r = r0 + ai * 128 + m * 16; const float rv = mult / sqrtf(ssq_get(sq + r) * inv_n + EPS); bf16_t* rowp = O + (size_t)r * ldc + c0;
#pragma unroll
                for (int bj = 0; bj < 2; ++bj) { const f32x4 v0 = acc[ai][bj][m][0] * rv, v1 = acc[ai][bj][m][1] * rv;
                    u32x4 w; w.x = pg8::cvt_pk_bf16(v0[0], v0[1]); w.y = pg8::cvt_pk_bf16(v0[2], v0[3]); w.z = pg8::cvt_pk_bf16(v1[0], v1[1]); w.w = pg8::cvt_pk_bf16(v1[2], v1[3]);
                    pg8::st16<5>(rowp + bj * 128, w); } }
    }
};
template <int MIDK_, bool XIN_BF16, bool F8OUT> struct EpiResid {
    static constexpr bool PERM = true; static constexpr int MIDK = MIDK_;
    const float* xin; bf16_t* xb; unsigned char* x8; ssq_t* ssq; const ssq_t* ssq_mid; float accs;
    __device__ __forceinline__ void midk(f32x4 (&acc)[2][2][4][2], const pg8::Unit& u, int wr, int fr) const {
#pragma unroll
        for (int ai = 0; ai < 2; ++ai)
#pragma unroll
            for (int m = 0; m < 4; ++m) { const int r = u.pm * 256 + ai * 128 + wr * 64 + m * 16 + fr; const float s = 1.0f / sqrtf(ssq_get(ssq_mid + r) * (1.0f / SBW) + EPS);
#pragma unroll
                for (int bj = 0; bj < 2; ++bj)
#pragma unroll
                    for (int n = 0; n < 2; ++n) acc[ai][bj][m][n] *= s; }
    }
    __device__ __forceinline__ void operator()(f32x4 (&acc)[2][2][4][2], const pg8::Unit& u, int wr, int wc, int fr, int fq, int, int, LAS unsigned char*) const {
        int row0 = u.pm * 256 + wr * 64 + fr, col0 = u.pn * 256 + wc * 32 + 8 * fq; asm volatile("" : "+v"(row0), "+v"(col0));
#pragma unroll
        for (int ai = 0; ai < 2; ++ai)
#pragma unroll
            for (int m = 0; m < 4; ++m) { const int r = row0 + ai * 128 + m * 16; const size_t off = (size_t)r * D + col0; float q = 0.f;
#pragma unroll
                for (int bj = 0; bj < 2; ++bj) { const size_t o2 = off + bj * 128; f32x4 o0, o1;
                    if constexpr (XIN_BF16) { const u32x4 xv = *(const u32x4*)(xb + o2);
                        o0 = (f32x4){__builtin_bit_cast(float, xv.x << 16), __builtin_bit_cast(float, xv.x & 0xffff0000u), __builtin_bit_cast(float, xv.y << 16), __builtin_bit_cast(float, xv.y & 0xffff0000u)};
                        o1 = (f32x4){__builtin_bit_cast(float, xv.z << 16), __builtin_bit_cast(float, xv.z & 0xffff0000u), __builtin_bit_cast(float, xv.w << 16), __builtin_bit_cast(float, xv.w & 0xffff0000u)}; }
                    else { o0 = *(const f32x4*)(xin + o2); o1 = *(const f32x4*)(xin + o2 + 4); }
                    o0 += acc[ai][bj][m][0] * accs; o1 += acc[ai][bj][m][1] * accs;
                    q += (o0[0] * o0[0] + o0[1] * o0[1]) + (o0[2] * o0[2] + o0[3] * o0[3]) + (o1[0] * o1[0] + o1[1] * o1[1]) + (o1[2] * o1[2] + o1[3] * o1[3]);
                    if constexpr (F8OUT) { int w0 = __builtin_amdgcn_cvt_pk_fp8_f32(o0[0], o0[1], 0, false); w0 = __builtin_amdgcn_cvt_pk_fp8_f32(o0[2], o0[3], w0, true);
                        int w1 = __builtin_amdgcn_cvt_pk_fp8_f32(o1[0], o1[1], 0, false); w1 = __builtin_amdgcn_cvt_pk_fp8_f32(o1[2], o1[3], w1, true);
                        pg8::st8_wt(x8 + o2, (unsigned long long)(unsigned)w0 | ((unsigned long long)(unsigned)w1 << 32)); }
                    u32x4 w; w.x = pg8::cvt_pk_bf16(o0[0], o0[1]); w.y = pg8::cvt_pk_bf16(o0[2], o0[3]); w.z = pg8::cvt_pk_bf16(o1[0], o1[1]); w.w = pg8::cvt_pk_bf16(o1[2], o1[3]); pg8::st16<4>(xb + o2, w); }
                q += __shfl_xor(q, 16); q += __shfl_xor(q, 32);
                if (fq == 0) ssq_add(ssq + r, q);
                if (m & 1) asm volatile("" ::: "memory"); }
    }
};
struct SchedMS {
    int G, c; unsigned char* ws;
    __device__ __forceinline__ bool next(int i, pg8::Unit& u) const {
        const int L = i * G + c; constexpr int NU = (NTOK / 256) * MH; if (L >= NU) return false; const int w = pg8::xcd_remap(L, NU), pm = w >> 2, h = w & 3, b = pm >> 4;
        u.A = (const char*)(ws + WS_QM) + ((size_t)pm * 256 * D + h * MHD) * 2; u.B = (const char*)(ws + WS_KM) + ((size_t)b * NMEM * D + h * MHD) * 2;
        u.p0 = (bf16_t*)(ws + WS_PM) + (size_t)pm * 256 * D + h * NMEM; u.p1 = nullptr; u.p2 = nullptr; u.p3 = nullptr; u.i0 = D; u.i1 = 0; u.pm = pm; u.pn = h; return true;
    }
};
struct EpiSoftmax {
    static constexpr bool PERM = true; static constexpr int MIDK = -1;
    __device__ __forceinline__ void midk(f32x4 (&)[2][2][4][2], const pg8::Unit&, int, int) const {}
    __device__ __forceinline__ void operator()(f32x4 (&acc)[2][2][4][2], const pg8::Unit& u, int wr, int wc, int fr, int fq, int, int, LAS unsigned char* xl) const {
        typedef float f32x2v __attribute__((ext_vector_type(2)));
        LAS f32x2v* X = (LAS f32x2v*)xl;
        float ml[2][4];
#pragma unroll
        for (int ai = 0; ai < 2; ++ai)
#pragma unroll
            for (int m = 0; m < 4; ++m) { float mx = -INFINITY;
#pragma unroll
                for (int bj = 0; bj < 2; ++bj)
#pragma unroll
                    for (int n = 0; n < 2; ++n) { const f32x4 v = acc[ai][bj][m][n]; mx = fmaxf(fmaxf(mx, fmaxf(v[0], v[1])), fmaxf(v[2], v[3])); }
                mx = fmaxf(mx, __shfl_xor(mx, 16)); mx = fmaxf(mx, __shfl_xor(mx, 32)); ml[ai][m] = mx; float s = 0.f;
#pragma unroll
                for (int bj = 0; bj < 2; ++bj)
#pragma unroll
                    for (int n = 0; n < 2; ++n) { f32x4 v = acc[ai][bj][m][n];
#pragma unroll
                        for (int j = 0; j < 4; ++j) { v[j] = __builtin_amdgcn_exp2f(v[j] - mx); s += v[j]; }
                        acc[ai][bj][m][n] = v; }
                s += __shfl_xor(s, 16); s += __shfl_xor(s, 32);
                if (fq == 0) X[(ai * 128 + wr * 64 + m * 16 + fr) * 4 + wc] = (f32x2v){mx, s}; }
        EPI_BAR();
        bf16_t* O = (bf16_t*)u.p0; const int ldc = u.i0; int r0 = wr * 64 + fr, c0 = wc * 32 + 8 * fq; asm volatile("" : "+v"(r0), "+v"(c0));
#pragma unroll
        for (int ai = 0; ai < 2; ++ai)
#pragma unroll
            for (int m = 0; m < 4; ++m) { const int r = r0 + ai * 128 + m * 16; const f32x2v a = X[r * 4 + 0], b = X[r * 4 + 1], c = X[r * 4 + 2], d = X[r * 4 + 3];
                const float M = fmaxf(fmaxf(a.x, b.x), fmaxf(c.x, d.x));
                const float tot = a.y * __builtin_amdgcn_exp2f(a.x - M) + b.y * __builtin_amdgcn_exp2f(b.x - M) + c.y * __builtin_amdgcn_exp2f(c.x - M) + d.y * __builtin_amdgcn_exp2f(d.x - M);
                const float f = __builtin_amdgcn_exp2f(ml[ai][m] - M) / tot; bf16_t* rowp = O + (size_t)r * ldc + c0;
#pragma unroll
                for (int bj = 0; bj < 2; ++bj) { const f32x4 v0 = acc[ai][bj][m][0] * f, v1 = acc[ai][bj][m][1] * f;
                    u32x4 w; w.x = pg8::cvt_pk_bf16(v0[0], v0[1]); w.y = pg8::cvt_pk_bf16(v0[2], v0[3]); w.z = pg8::cvt_pk_bf16(v1[0], v1[1]); w.w = pg8::cvt_pk_bf16(v1[2], v1[3]);
                    pg8::st16<6>(rowp + bj * 128, w); } }
    }
};
struct SchedPV {
    int G, c; unsigned char* ws;
    __device__ __forceinline__ bool next(int i, pg8::Unit& u) const {
        const int L = i * G + c; constexpr int NU = (NTOK / 256) * MH; if (L >= NU) return false; const int w = pg8::xcd_remap(L, NU), pm = w >> 2, h = w & 3, b = pm >> 4;
        u.A = (const char*)(ws + WS_PM) + ((size_t)pm * 256 * D + h * NMEM) * 2; u.B = (const char*)(ws + WS_VMT) + ((size_t)b * D + h * MHD) * NMEM * 2;
        u.p0 = (bf16_t*)(ws + WS_OM) + (size_t)pm * 256 * D + h * MHD; u.p1 = nullptr; u.p2 = nullptr; u.p3 = nullptr; u.i0 = D; u.i1 = 0; u.pm = pm; u.pn = h; return true;
    }
};

__device__ __forceinline__ void p8_route(const Args& a, LAS unsigned char* lds, int bx, int G, int wave, int lane, int* CNT) {
    unsigned char* ws = a.ws; const bf16_t* x2 = (const bf16_t*)(ws + WS_S0); const ssq_t* SSQ2 = (const ssq_t*)(ws + MK_SSQ2); const float* br = a.in[16];
    const bf16_t* WRH = (const bf16_t*)(ws + WS_WRH);
    int* LSLOT = (int*)(ws + WS_LSLOT); float* LGATE = (float*)(ws + WS_LGATE); float* LRS = (float*)(ws + WS_LRS);
    constexpr int WPITCH = 2064;
    LAS float* LG = (LAS float*)(lds + RING_OFF + 69632) + wave * 16 * 33;
    LAS int* hist = (LAS int*)(lds + RING_OFF + 90112); LAS int* base = hist + 32;
    const int tid = wave * 64 + lane;
    { u32x4 v[8];
#pragma unroll
      for (int i = 0; i < 8; ++i) v[i] = *(const u32x4*)(WRH + (size_t)(tid + i * 512) * 8);
#pragma unroll
      for (int i = 0; i < 8; ++i) { const int c = tid + i * 512; *(LAS u32x4*)(lds + RING_OFF + (c >> 7) * WPITCH + (c & 127) * 16) = v[i]; } }
    LDS_WAIT(); __syncthreads();
    for (int t0 = bx * 128; t0 < NTOK; t0 += G * 128) {
        if (tid < 32) hist[tid] = 0;
        const int r16 = lane & 15, kq = lane >> 4; const int trow = t0 + wave * 16 + r16;
        const bf16_t* xp = x2 + (size_t)trow * D + kq * 8;
        bf16x8 ah[32];
#pragma unroll
        for (int ks = 0; ks < 32; ++ks) ah[ks] = *(const bf16x8*)(xp + ks * 32);
        f32x4 acc[2] = {(f32x4){0.f, 0.f, 0.f, 0.f}, (f32x4){0.f, 0.f, 0.f, 0.f}};
        const LAS unsigned char* wp = lds + RING_OFF + r16 * WPITCH + kq * 16;
#pragma unroll
        for (int ks = 0; ks < 32; ++ks) {
#pragma unroll
            for (int nb = 0; nb < 2; ++nb) { const bf16x8 bh = *(const LAS bf16x8*)(wp + nb * 16 * WPITCH + ks * 64);
                acc[nb] = __builtin_amdgcn_mfma_f32_16x16x32_bf16(ah[ks], bh, acc[nb], 0, 0, 0); } }
#pragma unroll
        for (int nb = 0; nb < 2; ++nb)
#pragma unroll
            for (int r = 0; r < 4; ++r) { const int tl = kq * 4 + r; const int tk = t0 + wave * 16 + tl; const float rs = 1.0f / sqrtf(ssq_get(SSQ2 + tk) * (1.0f / D) + EPS);
                LG[tl * 33 + nb * 16 + r16] = acc[nb][r] * rs + br[nb * 16 + r16]; }
        LDS_WAIT(); __syncthreads();
        int te[4] = {0, 0, 0, 0}; float tg[4] = {0.f, 0.f, 0.f, 0.f}; int rk[4] = {0, 0, 0, 0};
        if (lane < 16) {
            float tv[4] = {-INFINITY, -INFINITY, -INFINITY, -INFINITY};
            for (int e = 0; e < NE; ++e) { const float v = LG[lane * 33 + e];
                if (v > tv[3]) { if (v > tv[2]) { tv[3] = tv[2]; te[3] = te[2]; if (v > tv[1]) { tv[2] = tv[1]; te[2] = te[1]; if (v > tv[0]) { tv[1] = tv[0]; te[1] = te[0]; tv[0] = v; te[0] = e; } else { tv[1] = v; te[1] = e; } } else { tv[2] = v; te[2] = e; } } else { tv[3] = v; te[3] = e; } } }
            float gs = 0.f;
#pragma unroll
            for (int k = 0; k < 4; ++k) { tg[k] = __expf(tv[k] - tv[0]); gs += tg[k]; }
            gs = 1.0f / gs;
#pragma unroll
            for (int k = 0; k < 4; ++k) { tg[k] *= gs; rk[k] = __hip_atomic_fetch_add(hist + te[k], 1, __ATOMIC_RELAXED, __HIP_MEMORY_SCOPE_WORKGROUP); }
        }
        LDS_WAIT(); __syncthreads();
        if (tid < 32) { const int n = hist[tid]; base[tid] = n ? atomicAdd(CNT + tid, n) : 0; }
        LDS_WAIT(); __syncthreads();
        if (lane < 16) { const int tk = t0 + wave * 16 + lane; const float rsw = (1.0f / WSCALE) / sqrtf(ssq_get(SSQ2 + tk) * (1.0f / D) + EPS);
#pragma unroll
            for (int k = 0; k < 4; ++k) { const size_t p = (size_t)te[k] * LCAP + base[te[k]] + rk[k]; pg8::st4_wt(LSLOT + p, (unsigned)(tk * 4 + k)); pg8::st4_wt(LGATE + p, __float_as_uint(tg[k])); pg8::st4_wt(LRS + p, __float_as_uint(rsw)); } }
        LDS_WAIT(); __syncthreads();
    }
}

__device__ __forceinline__ void moe_table(const Args& a, volatile LAS unsigned* MISC, int tid) {
    const int* CNT = (const int*)(a.ws + OFF_CNT);
    if (tid < 32) MISC[16 + tid] = (unsigned)CNT[tid];
    LDS_WAIT(); __syncthreads();
    if (tid == 0) { unsigned tb = 0; for (int e = 0; e < NE; ++e) { MISC[48 + e] = tb; tb += (MISC[16 + e] + 255u) >> 8; } MISC[48 + NE] = tb; }
    LDS_WAIT(); __syncthreads();
}
template <int NPN, bool W1> struct SchedMoE {
    int G, c; unsigned char* ws; volatile LAS unsigned* MISC; const float* bias;
    __device__ __forceinline__ bool next(int i, pg8::Unit& u) const {
        unsigned mb_ = (unsigned)(uintptr_t)MISC; asm volatile("" : "+s"(mb_)); const LAS unsigned* M = (const LAS unsigned*)(uintptr_t)mb_;
        const int T = __builtin_amdgcn_readfirstlane((int)M[48 + NE]); const int NU = T * NPN; const int L = i * G + c; if (L >= NU) return false;
        const int w = pg8::xcd_remap(L, NU);
        int e = 0;
#pragma unroll
        for (int s = 16; s >= 1; s >>= 1) { if ((int)M[48 + e + s] * NPN <= w) e += s; }
        e = __builtin_amdgcn_readfirstlane(e);
        const int tb = __builtin_amdgcn_readfirstlane((int)M[48 + e]), cnt = __builtin_amdgcn_readfirstlane((int)M[16 + e]), nte = (cnt + 255) >> 8; const int idx = w - tb * NPN, pn = __builtin_amdgcn_readfirstlane(idx / nte), mt = idx - pn * nte;
        u.pm = tb + mt; u.pn = pn; u.i1 = e; const int nv = cnt - mt * 256; u.i0 = nv < 256 ? nv : 256;
        u.p3 = (int*)(ws + WS_LSLOT) + (size_t)e * LCAP + mt * 256; u.p2 = (float*)(ws + (W1 ? WS_LRS : WS_LGATE)) + (size_t)e * LCAP + mt * 256; u.p0 = nullptr;
        u.p1 = W1 ? (void*)(bias + (size_t)e * 2 * DFF + pn * 128) : (void*)(bias + (size_t)e * D + pn * 256);
        if (W1) { u.A = (const char*)(ws + WS_X2F8); u.B = (const char*)(ws + WS_W1) + ((size_t)e * 2 * DFF + pn * 256) * D; }
        else { u.A = (const char*)(ws + WS_ACT) + (size_t)(tb + mt) * 256 * DFF; u.B = (const char*)(ws + WS_W2) + ((size_t)e * D + pn * 256) * DFF; }
        return true;
    }
};
typedef float f32x2 __attribute__((ext_vector_type(2)));
struct EpiSwiGLU {
    static constexpr bool PERM = true; static constexpr int MIDK = -1; unsigned char* act;
    __device__ __forceinline__ void midk(f32x4 (&)[2][2][4][2], const pg8::Unit&, int, int) const {}
    __device__ __forceinline__ void operator()(f32x4 (&acc)[2][2][4][2], const pg8::Unit& u, int wr, int wc, int fr, int fq, int, int, LAS unsigned char* tab) const {
        const int nvalid = u.i0; const LAS float* T1 = (const LAS float*)tab + 256; const LAS float* T2 = (const LAS float*)tab + 512;
        int r0 = wr * 64 + fr, c0 = wc * 32 + 8 * fq; asm volatile("" : "+v"(r0), "+v"(c0)); const int gc0 = u.pn * 128 + c0;
        f32x4 bg[2], bu[2];
#pragma unroll
        for (int n = 0; n < 2; ++n) { bg[n] = *(const LAS f32x4*)(T2 + c0 + 4 * n); bu[n] = *(const LAS f32x4*)(T2 + 128 + c0 + 4 * n); }
#pragma unroll
        for (int ai = 0; ai < 2; ++ai)
#pragma unroll
            for (int m = 0; m < 4; ++m) { const int r = r0 + ai * 128 + m * 16; const float rs = T1[r]; int wv[2];
#pragma unroll
                for (int n = 0; n < 2; ++n) { f32x2 o[2];
#pragma unroll
                    for (int h = 0; h < 2; ++h) { f32x2 g = (f32x2){acc[ai][0][m][n][2 * h], acc[ai][0][m][n][2 * h + 1]} * rs + (f32x2){bg[n][2 * h], bg[n][2 * h + 1]};
                        f32x2 up = (f32x2){acc[ai][1][m][n][2 * h], acc[ai][1][m][n][2 * h + 1]} * rs + (f32x2){bu[n][2 * h], bu[n][2 * h + 1]};
                        g.x = fminf(g.x, SW_LIMIT); g.y = fminf(g.y, SW_LIMIT); up.x = fminf(fmaxf(up.x, -SW_LIMIT), SW_LIMIT); up.y = fminf(fmaxf(up.y, -SW_LIMIT), SW_LIMIT);
                        const f32x2 tt = g * (-SW_ALPHA * LOG2E); f32x2 d; d.x = __builtin_amdgcn_exp2f(tt.x); d.y = __builtin_amdgcn_exp2f(tt.y); d = d + 1.0f;
                        f32x2 rr; rr.x = __builtin_amdgcn_rcpf(d.x); rr.y = __builtin_amdgcn_rcpf(d.y);
                        o[h] = (up + 1.0f) * g * rr; }
                    wv[n] = __builtin_amdgcn_cvt_pk_fp8_f32(o[0].x, o[0].y, 0, false); wv[n] = __builtin_amdgcn_cvt_pk_fp8_f32(o[1].x, o[1].y, wv[n], true); }
                if (r < nvalid) pg8::st8_wt(act + ((size_t)u.pm * 256 + r) * DFF + gc0, (unsigned long long)(unsigned)wv[0] | ((unsigned long long)(unsigned)wv[1] << 32)); }
    }
};
struct EpiW2 {
    static constexpr bool PERM = true; static constexpr int MIDK = -1; bf16_t* Y;
    __device__ __forceinline__ void midk(f32x4 (&)[2][2][4][2], const pg8::Unit&, int, int) const {}
    __device__ __forceinline__ void operator()(f32x4 (&acc)[2][2][4][2], const pg8::Unit& u, int wr, int wc, int fr, int fq, int, int, LAS unsigned char* tab) const {
        const int nvalid = u.i0; const LAS unsigned* T0 = (const LAS unsigned*)tab; const LAS float* T1 = (const LAS float*)tab + 256; const LAS float* T2 = (const LAS float*)tab + 512;
        int r0 = wr * 64 + fr, cl = wc * 32 + 8 * fq; asm volatile("" : "+v"(r0), "+v"(cl)); const int c0 = u.pn * 256 + cl;
        f32x4 bv[2][2];
#pragma unroll
        for (int bj = 0; bj < 2; ++bj)
#pragma unroll
            for (int n = 0; n < 2; ++n) bv[bj][n] = *(const LAS f32x4*)(T2 + cl + bj * 128 + 4 * n);
#pragma unroll
        for (int ai = 0; ai < 2; ++ai)
#pragma unroll
            for (int m = 0; m < 4; ++m) { const int r = r0 + ai * 128 + m * 16; const bool valid = r < nvalid; const unsigned slot = T0[r]; const float g = T1[r];
#pragma unroll
                for (int bj = 0; bj < 2; ++bj) { const f32x4 v0 = (acc[ai][bj][m][0] * (1.0f / WSCALE) + bv[bj][0]) * g, v1 = (acc[ai][bj][m][1] * (1.0f / WSCALE) + bv[bj][1]) * g;
                    u32x4 w; w.x = pg8::cvt_pk_bf16(v0[0], v0[1]); w.y = pg8::cvt_pk_bf16(v0[2], v0[3]); w.z = pg8::cvt_pk_bf16(v1[0], v1[1]); w.w = pg8::cvt_pk_bf16(v1[2], v1[3]);
                    if (valid) pg8::st16<7>(Y + (size_t)slot * D + c0 + bj * 128, w); } }
    }
};

__device__ __forceinline__ void p11_final(const Args& a, int vcu, int G, int wave, int lane, float* dst) {
    const bf16_t* x2 = (const bf16_t*)(a.ws + WS_S0); const bf16_t* Y = (const bf16_t*)(a.ws + WS_Y); const float* gf = a.in[21];
    const int gw = vcu * NWAVES + wave, NGW = G * NWAVES;
    f32x4 g4[4];
#pragma unroll
    for (int j = 0; j < 4; ++j) g4[j] = *(const f32x4*)(gf + 4 * lane + 256 * j);
    for (int tok = gw; tok < NTOK; tok += NGW) {
        f32x4 v[4]; float s = 0.f;
#pragma unroll
        for (int j = 0; j < 4; ++j) { { const unsigned long long w = *(const unsigned long long*)(x2 + (size_t)tok * D + 4 * lane + 256 * j);
                v[j] = (f32x4){__builtin_bit_cast(float, (unsigned)(w << 16)), __builtin_bit_cast(float, (unsigned)w & 0xffff0000u), __builtin_bit_cast(float, (unsigned)(w >> 32) << 16), __builtin_bit_cast(float, (unsigned)(w >> 32) & 0xffff0000u)}; }
#pragma unroll
            for (int k = 0; k < 4; ++k) { const unsigned long long w = *(const unsigned long long*)(Y + ((size_t)tok * 4 + k) * D + 4 * lane + 256 * j);
                v[j][0] += __builtin_bit_cast(float, (unsigned)(w << 16)); v[j][1] += __builtin_bit_cast(float, (unsigned)w & 0xffff0000u);
                v[j][2] += __builtin_bit_cast(float, (unsigned)(w >> 32) << 16); v[j][3] += __builtin_bit_cast(float, (unsigned)(w >> 32) & 0xffff0000u); }
            s += (v[j][0] * v[j][0] + v[j][1] * v[j][1]) + (v[j][2] * v[j][2] + v[j][3] * v[j][3]); }
        const float rs = 1.0f / sqrtf(wave_sum(s) * (1.0f / D) + EPS);
#pragma unroll
        for (int j = 0; j < 4; ++j) pg8::st16<8>(dst + (size_t)tok * D + 4 * lane + 256 * j, (f32x4)(v[j] * rs * g4[j]));
    }
}
typedef float f32x16 __attribute__((ext_vector_type(16)));
typedef short s16x4 __attribute__((ext_vector_type(4)));
__device__ __forceinline__ int crow(int r, int hi) { return (r & 3) + 8 * (r >> 2) + 4 * hi; }
#define SB_DMA(ubase, voff, ldsaddr) do { unsigned keep_; asm volatile("s_mov_b32 %0, m0\n\ts_mov_b32 m0, %3\n\ts_nop 0\n\tglobal_load_lds_dwordx4 %1, %2\n\ts_mov_b32 m0, %0" \
        : "=&s"(keep_) : "v"(voff), "s"((const char*)(ubase)), "s"(ldsaddr) : "memory"); } while (0)
__device__ __forceinline__ void sb_item(int b, int h, int qs  , const bf16_t* QKVU, bf16_t* MIXED, ssq_t* SSQSB, LAS unsigned char* wl  , int lane) {
    const int r32 = lane & 31, hi = lane >> 5;
    const size_t rowbase = (size_t)b * S; const int q0 = qs * 32;
    const bf16_t* Qw = QKVU + (rowbase + q0) * INP + h * HD;
    const char* Kh = (const char*)(QKVU + rowbase * INP + SBW + h * HD); const char* Vh = Kh + SBW * 2;
    bf16x8 qr[4];
#pragma unroll
    for (int d0 = 0; d0 < 4; ++d0) qr[d0] = *(const bf16x8*)(Qw + (size_t)r32 * INP + d0 * 16 + hi * 8);
    f32x16 o[2];
#pragma unroll
    for (int r = 0; r < 16; ++r) { o[0][r] = 0.f; o[1][r] = 0.f; }
    float carry = 1.0f;
    const int jd = qs >> 1;
    const int qabs = q0 + r32;
    const unsigned kvoff = (unsigned)lane * (INP * 2);
    const unsigned vvoff = (unsigned)(lane >> 2) * (INP * 2) + (unsigned)(lane & 3) * 16;
    const unsigned lk = (unsigned)(uintptr_t)wl, lv = lk + 8192;
#define SB_LOAD_K(j) do { const char* kb_ = Kh + (size_t)(j) * 64 * INP * 2; _Pragma("unroll") for (int c_ = 0; c_ < 8; ++c_) SB_DMA(kb_ + c_ * 16, kvoff, lk + c_ * 1024); } while (0)
#define SB_LOAD_V(j) do { const char* vb_ = Vh + (size_t)(j) * 64 * INP * 2; _Pragma("unroll") for (int c_ = 0; c_ < 8; ++c_) SB_DMA(vb_ + (size_t)(c_ & 3) * 16 * INP * 2 + (c_ >> 2) * 64, vvoff, lv + c_ * 1024); } while (0)
    SB_LOAD_K(jd); SB_LOAD_V(jd);
    const LAS unsigned char* kb = wl + hi * 1024 + r32 * 16;
    const LAS unsigned char* vb = wl + 8192 + ((lane >> 4) & 1) * 32 + (lane & 3) * 8 + (4 * hi + ((lane & 15) >> 2)) * 64;
    for (int j = jd; j >= 0; --j) {
        asm volatile("s_waitcnt vmcnt(8)" ::: "memory"); __builtin_amdgcn_sched_barrier(0);
        bf16x8 kf[8];
#pragma unroll
        for (int d0 = 0; d0 < 4; ++d0) { kf[2 * d0] = *(const LAS bf16x8*)(kb + d0 * 2048); kf[2 * d0 + 1] = *(const LAS bf16x8*)(kb + d0 * 2048 + 512); }
        asm volatile("s_waitcnt lgkmcnt(0)" ::: "memory"); __builtin_amdgcn_sched_barrier(0);
        if (j > 0) SB_LOAD_K(j - 1);
        f32x16 p0, p1;
#pragma unroll
        for (int r = 0; r < 16; ++r) { p0[r] = 0.f; p1[r] = 0.f; }
#pragma unroll
        for (int d0 = 0; d0 < 4; ++d0) { p0 = __builtin_amdgcn_mfma_f32_32x32x16_bf16(kf[2 * d0], qr[d0], p0, 0, 0, 0); p1 = __builtin_amdgcn_mfma_f32_32x32x16_bf16(kf[2 * d0 + 1], qr[d0], p1, 0, 0, 0); }
        const bool diag = (j == jd); const int kbase = 64 * j + 4 * hi;
#pragma unroll
        for (int r = 0; r < 16; ++r) { const int k0 = kbase + (r & 3) + 8 * (r >> 2);
            float e0 = __builtin_amdgcn_exp2f(p0[r]), e1 = __builtin_amdgcn_exp2f(p1[r]);
            float r0 = __builtin_amdgcn_rcpf(1.0f + e0), r1 = __builtin_amdgcn_rcpf(1.0f + e1);
            if (diag) { if (k0 >= qabs) r0 = 1.0f; if (k0 + 32 >= qabs) r1 = 1.0f; }
            p0[r] = r0; p1[r] = r1; }
        float sfx[8][3], A[8];
#pragma unroll
        for (int i = 0; i < 8; ++i) { const float x0 = (i < 4) ? p0[4 * i] : p1[4 * i - 16], x1 = (i < 4) ? p0[4 * i + 1] : p1[4 * i - 15], x2 = (i < 4) ? p0[4 * i + 2] : p1[4 * i - 14], x3 = (i < 4) ? p0[4 * i + 3] : p1[4 * i - 13];
            sfx[i][2] = x3; sfx[i][1] = x3 * x2; sfx[i][0] = sfx[i][1] * x1; A[i] = sfx[i][0] * x0; }
        float T = carry, E[8];
#pragma unroll
        for (int i = 7; i >= 0; --i) { const auto sw = __builtin_amdgcn_permlane32_swap(__float_as_uint(A[i]), __float_as_uint(A[i]), false, false);
            const float partner = hi ? __uint_as_float(sw[0]) : __uint_as_float(sw[1]);
            E[i] = hi ? T : T * partner; T = T * (A[i] * partner); }
        carry = T;
        unsigned pw[4][4];
#pragma unroll
        for (int i = 0; i < 8; ++i) { float w4[4];
#pragma unroll
            for (int jj = 0; jj < 4; ++jj) { const float rv = (i < 4) ? p0[4 * i + jj] : p1[4 * i - 16 + jj]; const float beta = 1.0f - rv;
                w4[jj] = beta * ((jj == 3) ? E[i] : E[i] * sfx[i][jj]); }
            pw[i >> 1][(i & 1) * 2] = pg8::cvt_pk_bf16(w4[0], w4[1]); pw[i >> 1][(i & 1) * 2 + 1] = pg8::cvt_pk_bf16(w4[2], w4[3]); }
        if (j > 0) asm volatile("s_waitcnt vmcnt(8)" ::: "memory"); else asm volatile("s_waitcnt vmcnt(0)" ::: "memory");
        __builtin_amdgcn_sched_barrier(0);
        bf16x8 vf[8];
#pragma unroll
        for (int d0 = 0; d0 < 2; ++d0)
#pragma unroll
            for (int ks = 0; ks < 4; ++ks) {
                const s16x4 lo = __builtin_bit_cast(s16x4, __builtin_amdgcn_ds_read_tr16_b64_v4i16((LAS s16x4*)(vb + d0 * 4096 + ks * 1024)));
                const s16x4 hh = __builtin_bit_cast(s16x4, __builtin_amdgcn_ds_read_tr16_b64_v4i16((LAS s16x4*)(vb + d0 * 4096 + ks * 1024 + 512)));
                vf[d0 * 4 + ks] = (bf16x8){lo[0], lo[1], lo[2], lo[3], hh[0], hh[1], hh[2], hh[3]}; }
        asm volatile("s_waitcnt lgkmcnt(0)" ::: "memory"); __builtin_amdgcn_sched_barrier(0);
        const bool more = (j > 0) && __any(carry != 0.0f);
        if (more) SB_LOAD_V(j - 1);
#pragma unroll
        for (int d0 = 0; d0 < 2; ++d0)
#pragma unroll
            for (int ks = 0; ks < 4; ++ks) { const bf16x8 pa = __builtin_bit_cast(bf16x8, (u32x4){pw[ks][0], pw[ks][1], pw[ks][2], pw[ks][3]});
                o[d0] = __builtin_amdgcn_mfma_f32_32x32x16_bf16(pa, vf[d0 * 4 + ks], o[d0], 0, 0, 0); }
        if (!more) break;
    }
    asm volatile("s_waitcnt vmcnt(0)" ::: "memory");
    LAS bf16_t* stg = (LAS bf16_t*)wl;
#pragma unroll
    for (int r = 0; r < 16; ++r) { const int orow = crow(r, hi);
#pragma unroll
        for (int d0 = 0; d0 < 2; ++d0) stg[orow * 64 + d0 * 32 + r32] = (bf16_t)f2bf(o[d0][r]); }
    LDS_WAIT();
    bf16_t* Ow = MIXED + (rowbase + q0) * D + h * HD;
#pragma unroll
    for (int i = 0; i < 4; ++i) { const int row = i * 8 + (lane >> 3), ch = lane & 7; const u32x4 v = *(const LAS u32x4*)(stg + row * 64 + ch * 8);
        pg8::st16<2>(Ow + (size_t)row * D + ch * 8, v); float q = 0.f;
#pragma unroll
        for (int k = 0; k < 4; ++k) { const float a = __builtin_bit_cast(float, v[k] << 16), c = __builtin_bit_cast(float, v[k] & 0xffff0000u); q += a * a + c * c; }
        q += __shfl_xor(q, 1); q += __shfl_xor(q, 2); q += __shfl_xor(q, 4);
        if (ch == 0) ssq_add(SSQSB + rowbase + q0 + row, q); }
    LDS_WAIT();
#undef SB_LOAD_K
#undef SB_LOAD_V
}

constexpr int PL_PITCH = 1040, PL_PART_OFF = 83968;
__device__ __forceinline__ void pool_unit(int tile, const bf16_t* QKVU, bf16_t* MIXED, LAS unsigned char* shm, int wid, int lane) {
    const int tok0 = tile * 64, tpos0 = tok0 & (S - 1); const int tid = wid * 64 + lane;
    { u32x4 v[10];
#pragma unroll
      for (int i = 0; i < 10; ++i) { const int c = tid + i * NWAVES * 64; const int row = c >> 6, ch = c & 63; const int t = tpos0 - 15 + row;
          v[i] = (u32x4){0u, 0u, 0u, 0u}; if (c < 79 * 64 && t >= 0) v[i] = *(const u32x4*)(QKVU + (size_t)(tok0 - 15 + row) * INP + 3 * SBW + ch * 8); }
#pragma unroll
      for (int i = 0; i < 10; ++i) { const int c = tid + i * NWAVES * 64; const int row = c >> 6, ch = c & 63; if (c < 79 * 64) *(LAS u32x4*)(shm + row * PL_PITCH + ch * 16) = v[i]; } }
    LDS_WAIT(); __syncthreads();
    const int win = 2 << (wid >> 1); const int tp1 = tpos0 + lane + 1; const int n = tp1 < win ? tp1 : win; const float inv = 1.0f / (float)n;
    const LAS unsigned char* up = shm + (15 + lane) * PL_PITCH + wid * 128;
    float o[64]; float q = 0.f;
#pragma unroll
    for (int ch = 0; ch < 8; ++ch) { float s[8];
#pragma unroll
        for (int k = 0; k < 8; ++k) s[k] = 0.f;
        for (int jw = 0; jw < win; ++jw) { const u32x4 v = *(const LAS u32x4*)(up + ch * 16 - jw * PL_PITCH);
#pragma unroll
            for (int k = 0; k < 4; ++k) { s[2 * k] += __builtin_bit_cast(float, v[k] << 16); s[2 * k + 1] += __builtin_bit_cast(float, v[k] & 0xffff0000u); } }
        const u32x4 self = *(const LAS u32x4*)(up + ch * 16);
#pragma unroll
        for (int k = 0; k < 4; ++k) { const float a = s[2 * k] * inv - __builtin_bit_cast(float, self[k] << 16), c = s[2 * k + 1] * inv - __builtin_bit_cast(float, self[k] & 0xffff0000u);
            o[ch * 8 + 2 * k] = a; o[ch * 8 + 2 * k + 1] = c; q += a * a + c * c; } }
    LAS float* part = (LAS float*)(shm + PL_PART_OFF);
    part[wid * 64 + lane] = q;
    LDS_WAIT(); __syncthreads();
    float tot = 0.f;
#pragma unroll
    for (int w = 0; w < 8; ++w) tot += part[w * 64 + lane];
    const float rs = 1.0f / sqrtf(tot * (1.0f / PW) + EPS);
    LAS unsigned char* op = shm + lane * PL_PITCH + wid * 128;
#pragma unroll
    for (int ch = 0; ch < 8; ++ch) { u32x4 w;
#pragma unroll
        for (int k = 0; k < 4; ++k) w[k] = pg8::cvt_pk_bf16(o[ch * 8 + 2 * k] * rs, o[ch * 8 + 2 * k + 1] * rs);
        *(LAS u32x4*)(op + ch * 16) = w; }
    LDS_WAIT(); __syncthreads();
#pragma unroll
    for (int i = 0; i < 8; ++i) { const int c = tid + i * NWAVES * 64; const int row = c >> 6, ch = c & 63;
        pg8::st16<3>(MIXED + (size_t)(tok0 + row) * D + SBW + ch * 8, (u32x4)*(const LAS u32x4*)(shm + row * PL_PITCH + ch * 16)); }
    LDS_WAIT(); __syncthreads();
}
__device__ __forceinline__ void p2_mix(const Args& a, LAS unsigned char* lds, int bx, int G, int wid, int lane, ssq_t* SSQSB, int which = 3, int pstop = 9, bf16_t* pool_dst = nullptr, volatile LAS unsigned* stp = nullptr) {
    unsigned char* ws = a.ws; const bf16_t* QKVU = (const bf16_t*)(ws + WS_QKVU); bf16_t* MIXED = (bf16_t*)(ws + WS_MIXED);
    constexpr int NA = B * NH * (S / 256);
    if (which & 1) for (int i = 0; i * G + bx < NA; ++i) { const int w = pg8::xcd_remap(i * G + bx, NA); const int bh = w >> 4, qb = w & 15;
        sb_item(bh >> 3, bh & 7, qb * 8 + wid, QKVU, MIXED, SSQSB, lds + RING_OFF + wid * 16384, lane); }
    __syncthreads();
    if (which & 2) for (int t = bx; t < NTOK / 64; t += G) pool_unit(t, QKVU, pool_dst ? pool_dst : MIXED, lds + RING_OFF, wid, lane);
}
constexpr size_t BAR_REGION_OFF = 1 * MiB, BAR_REGION_STRIDE = 16 * 1024;
__global__ void __launch_bounds__(NWAVES * 64, 2) mega(Args args) {
    const int li = args.li;
    extern __shared__ __attribute__((aligned(16))) unsigned char lds_raw[];
    LAS unsigned char* lds = (LAS unsigned char*)lds_raw;
    volatile LAS unsigned* MISC = (volatile LAS unsigned*)(lds + MISC_OFF);
    const int wave = __builtin_amdgcn_readfirstlane((int)threadIdx.x >> 6);
#define LANE_ID() ({ int l_; asm volatile("v_mbcnt_lo_u32_b32 %0, -1, 0\n\tv_mbcnt_hi_u32_b32 %0, -1, %0" : "=v"(l_)); l_; })
    const int G = gridDim.x; const int bx = blockIdx.x; const int vcu = (G % 8 == 0) ? (bx % 8) * (G / 8) + bx / 8 : bx;
    for (int u = wave * 64 + LANE_ID(); u < MISC_BYTES / 4; u += NWAVES * 64) MISC[u] = 0u;
    __syncthreads();
    unsigned char* ws = args.ws;
    XcdBarrier bar = xcd_barrier_post((unsigned*)(ws + BAR_REGION_OFF + (size_t)li * BAR_REGION_STRIDE), MISC + 8);
    const int lo = args.ph_lo, hi = args.ph_hi;
    LAS unsigned char* ring = lds + RING_OFF; LAS unsigned char* epi = lds + EPI_OFF; LAS unsigned* gtab = (LAS unsigned*)(lds + GTAB_OFF);
#ifndef TIME_PHASE
#define TIME_PHASE -1
#endif
#define REP_OF(k) ((TIME_PHASE == (k)) ? 2 : 1)
#define REPE_OF(k) ((TIME_PHASE == 20 + (k)) ? 2 : 1)
#define IN(k) (lo <= (k) && (k) < hi)
#ifndef TSK
#define TSK -1
#endif
#ifndef TSCALE
#define TSCALE 1.0f
#endif
#define STAMP(i) do { if (TSK >= 0 && wave == 0) { const unsigned long long t_ = __builtin_amdgcn_s_memrealtime(); MISC[128 + 2 * (i)] = (unsigned)t_; MISC[129 + 2 * (i)] = (unsigned)(t_ >> 32); } } while (0)
#define SEAM(k) do { if (IN(k) && IN((k) + 1)) xcd_barrier(bar); STAMP((k) + 1); } while (0)
    STAMP(0);
    if (IN(0)) { p0_prologue(args, lds, vcu, G, wave, LANE_ID()); if (TIME_PHASE == 0) { xcd_barrier(bar); p0_prologue(args, lds, vcu, G, wave, LANE_ID()); } SEAM(0); }
    if (IN(1)) { SchedP1 S{G, bx, ws}; pg8::EpiBf16S E; pg8::gemm_phase<pg8::EpiBf16S, SchedP1, 0, REP_OF(1), REPE_OF(1)>(wave, ring, epi, gtab, D * 2, D * 2, D / 64, S, E); SEAM(1); }
    {
    const float* xin0 = args.in[0]; float* outp = args.out;
    bf16_t* S0p = (bf16_t*)(ws + WS_S0); ssq_t* SSQSBp = (ssq_t*)(ws + MK_SSQSB); ssq_t* SSQ1p = (ssq_t*)(ws + MK_SSQ1); ssq_t* SSQ2p = (ssq_t*)(ws + MK_SSQ2);
    constexpr size_t TSTEP = (size_t)256 * D * 2;
    #if !defined(PH_ONLY) || PH_ONLY == 2
    if (IN(2)) { if (TIME_PHASE == 42) { p2_mix(args, lds, bx, G, wave, LANE_ID(), (ssq_t*)(ws + 1280 * 1024), 2); xcd_barrier(bar); p2_mix(args, lds, bx, G, wave, LANE_ID(), (ssq_t*)(ws + 1280 * 1024), 2); xcd_barrier(bar); }
    if (TIME_PHASE == 2 || TIME_PHASE == 40 || TIME_PHASE == 41) { p2_mix(args, lds, bx, G, wave, LANE_ID(), (ssq_t*)(ws + 1280 * 1024), TIME_PHASE == 40 ? 1 : (TIME_PHASE == 41 ? 2 : 3)); xcd_barrier(bar); } STAMP(20); p2_mix(args, lds, bx, G, wave, LANE_ID(), (ssq_t*)(ws + MK_SSQSB), 1); STAMP(21); p2_mix(args, lds, bx, G, wave, LANE_ID(), (ssq_t*)(ws + MK_SSQSB), 2, 9, nullptr, (TSK >= 30 && bx == 0) ? MISC + 128 + 60 : nullptr); STAMP(22); SEAM(2); STAMP(23); }
#endif

#if !defined(PH_ONLY) || PH_ONLY == 3
    if (IN(3)) { SchedReg S{G, bx, NTOK / 256, D / 256, (const char*)(ws + WS_MIXED), (const char*)(ws + WS_WOUT), TSTEP, TSTEP, nullptr, D, nullptr, nullptr};
        EpiResid<8, false, true> E{xin0, S0p, ws + WS_X1F8, SSQ1p, SSQSBp, 1.0f}; pg8::gemm_phase<EpiResid<8, false, true>, SchedReg, 0, REP_OF(3)>(wave, ring, epi, gtab, D * 2, D * 2, D / 64, S, E); SEAM(3); }
#endif
#if !defined(PH_ONLY) || PH_ONLY == 4
    if (IN(4)) { SchedReg S{G, bx, NTOK / 256, D / 256, (const char*)(ws + WS_X1F8), (const char*)(ws + WS_WQ), TSTEP / 2, TSTEP / 2, (bf16_t*)(ws + WS_QM), D, nullptr, nullptr, SSQ1p};
        EpiBf16Ssq E{1.0f / D, C2_MEM / WSCALE}; pg8::gemm_phase<EpiBf16Ssq, SchedReg, 0, REP_OF(4), 1, true>(wave, ring, epi, gtab, D, D, D / 128, S, E); SEAM(4); }
#endif
#if !defined(PH_ONLY) || PH_ONLY == 5
    if (IN(5)) { SchedMS S{G, bx, ws}; EpiSoftmax E; pg8::gemm_phase<EpiSoftmax, SchedMS, 0, REP_OF(5)>(wave, ring, epi, gtab, D * 2, D * 2, MHD / 64, S, E); SEAM(5); }
#endif
#if !defined(PH_ONLY) || PH_ONLY == 6
    if (IN(6)) { SchedPV S{G, bx, ws}; pg8::EpiBf16S E; pg8::gemm_phase<pg8::EpiBf16S, SchedPV, 0, REP_OF(6)>(wave, ring, epi, gtab, D * 2, NMEM * 2, NMEM / 64, S, E); SEAM(6); }
#endif
#if !defined(PH_ONLY) || PH_ONLY == 7
    if (IN(7)) { SchedReg S{G, bx, NTOK / 256, D / 256, (const char*)(ws + WS_OM), (const char*)(ws + WS_WO), TSTEP, TSTEP, nullptr, D, nullptr, nullptr};
        EpiResid<-1, true, true> E{nullptr, S0p, ws + WS_X2F8, SSQ2p, nullptr, 1.0f}; pg8::gemm_phase<EpiResid<-1, true, true>, SchedReg, 0, REP_OF(7)>(wave, ring, epi, gtab, D * 2, D * 2, D / 64, S, E); SEAM(7); }
#endif
#if !defined(PH_ONLY) || PH_ONLY == 8
    if (IN(8)) { if (TIME_PHASE == 8) { p8_route(args, lds, bx, G, wave, LANE_ID(), (int*)(ws + 1536 * 1024)); xcd_barrier(bar); } p8_route(args, lds, bx, G, wave, LANE_ID(), (int*)(ws + OFF_CNT)); SEAM(8); }
#endif
#if !defined(PH_ONLY) || PH_ONLY == 9
    if (IN(9)) { moe_table(args, MISC, wave * 64 + LANE_ID()); SchedMoE<8, true> S{G, bx, ws, MISC, args.in[18]}; EpiSwiGLU E{ws + WS_ACT};
        pg8::gemm_phase<EpiSwiGLU, SchedMoE<8, true>, 1, REP_OF(9), REPE_OF(9), true>(wave, ring, epi, gtab, D, D, D / 128, S, E); SEAM(9); }
#endif
#if !defined(PH_ONLY) || PH_ONLY == 10
    if (IN(10)) { moe_table(args, MISC, wave * 64 + LANE_ID()); SchedMoE<4, false> S{G, bx, ws, MISC, args.in[20]}; EpiW2 E{(bf16_t*)(ws + WS_Y)};
        pg8::gemm_phase<EpiW2, SchedMoE<4, false>, 2, REP_OF(10), REPE_OF(10), true>(wave, ring, epi, gtab, DFF, DFF, DFF / 128, S, E); SEAM(10); }
#endif
#if !defined(PH_ONLY) || PH_ONLY == 11
    if (IN(11)) { if (TIME_PHASE == 11) { p11_final(args, vcu, G, wave, LANE_ID(), (float*)(ws + WS_ACT)); xcd_barrier(bar); } p11_final(args, vcu, G, wave, LANE_ID(), args.out); }
#endif
}

    if (TSK >= 100) { __syncthreads(); float* dbg = (float*)(ws + 1792 * 1024);
        if (wave == 0 && LANE_ID() == 0) { const int a_ = (TSK >= 200) ? 21 : 20; const unsigned long long t0 = ((unsigned long long)MISC[129 + 2 * a_] << 32) | MISC[128 + 2 * a_], t1 = ((unsigned long long)MISC[131 + 2 * a_] << 32) | MISC[130 + 2 * a_];
            __hip_atomic_store(dbg + bx, (float)(t1 - t0) * 0.01f, __ATOMIC_RELAXED, __HIP_MEMORY_SCOPE_AGENT); }
        xcd_barrier(bar);
        if (bx == 0 && wave == 0) { const int l_ = LANE_ID(); float mx = 0.f, mn = 1e9f; for (int q = l_; q < G; q += 64) { const float v = __hip_atomic_load(dbg + q, __ATOMIC_RELAXED, __HIP_MEMORY_SCOPE_AGENT); mx = fmaxf(mx, v); mn = fminf(mn, v); }
            for (int o_ = 1; o_ < 64; o_ <<= 1) { mx = fmaxf(mx, __shfl_xor(mx, o_)); mn = fminf(mn, __shfl_xor(mn, o_)); }
            if (l_ == 0) { asm volatile("s_waitcnt vmcnt(0)" ::: "memory"); args.out[0] = ((TSK % 100) == 0 ? mx : mn) * TSCALE; } } }
    else if (TSK >= 0) { STAMP(12); __syncthreads(); if (bx == 0 && wave == 0 && LANE_ID() == 0) { asm volatile("s_waitcnt vmcnt(0)" ::: "memory");
        const unsigned long long t0 = ((unsigned long long)MISC[129 + 2 * TSK] << 32) | MISC[128 + 2 * TSK], t1 = ((unsigned long long)MISC[131 + 2 * TSK] << 32) | MISC[130 + 2 * TSK];
        args.out[0] = (float)(t1 - t0) * 0.01f * TSCALE; } }
    if (TIME_PHASE == 12) { for (int q = 0; q < 10; ++q) xcd_barrier(bar); }
#undef IN
#undef SEAM
}
}

#ifndef MEGA_MASK
#define MEGA_MASK 0xFFF
#endif
extern "C" void kernel_launch(void* const* d_in, const int* in_sizes, int n_in, void* d_out, int out_size, void* d_ws, size_t ws_size, hipStream_t stream) {
    if (n_in != 22 || out_size != NTOK * D || ws_size < WS_END) { fprintf(stderr, "kernel_launch: unexpected shapes (n_in %d out %d ws %zu)\n", n_in, out_size, ws_size); return; }
    static int grid = 0;
    if (grid == 0) {
        int dev = 0, cus = 0;
        if (hipGetDevice(&dev) != hipSuccess || hipDeviceGetAttribute(&cus, hipDeviceAttributeMultiprocessorCount, dev) != hipSuccess) { grid = -1; return; }
        if (hipFuncSetAttribute((const void*)mk::mega, hipFuncAttributeMaxDynamicSharedMemorySize, mk::LDS_BYTES) != hipSuccess) { fprintf(stderr, "kernel_launch: hipFuncSetAttribute failed\n"); grid = -1; return; }
        int per_cu = 0; (void)hipOccupancyMaxActiveBlocksPerMultiprocessor(&per_cu, (const void*)mk::mega, mk::NWAVES * 64, mk::LDS_BYTES); (void)hipGetLastError();
        if (per_cu < 1) fprintf(stderr, "kernel_launch: occupancy query reports %d blocks per CU\n", per_cu);
        grid = cus;
    }
    if (grid < 0) return;
    const float* x = (const float*)d_in[0]; const float* mem = (const float*)d_in[1]; const float* g_mix = (const float*)d_in[2]; const float* w_in = (const float*)d_in[3];
    const float* g_sb = (const float*)d_in[4]; const float* g_pool = (const float*)d_in[5]; const float* w_pool = (const float*)d_in[6]; const float* pool_scale = (const float*)d_in[7];
    const float* w_out = (const float*)d_in[8]; const float* g_mem_q = (const float*)d_in[9]; const float* g_mem_kv = (const float*)d_in[10]; const float* w_mem_q = (const float*)d_in[11];
    const float* w_mem_kv = (const float*)d_in[12]; const float* w_mem_o = (const float*)d_in[13]; const float* g_ffn = (const float*)d_in[14]; const float* w_router = (const float*)d_in[15];
    const float* b_router = (const float*)d_in[16]; const float* w_e_in = (const float*)d_in[17]; const float* b_e_in = (const float*)d_in[18]; const float* w_e_out = (const float*)d_in[19];
    const float* b_e_out = (const float*)d_in[20]; const float* g_final = (const float*)d_in[21];
    float* out = (float*)d_out; unsigned char* ws = (unsigned char*)d_ws;
    bf16_t* WIN = (bf16_t*)(ws + WS_WIN); bf16_t* WOUT = (bf16_t*)(ws + WS_WOUT); bf16_t* WQ = (bf16_t*)(ws + WS_WQ); bf16_t* WKV = (bf16_t*)(ws + WS_WKV); bf16_t* WO = (bf16_t*)(ws + WS_WO);
    bf16_t* WP = (bf16_t*)(ws + WS_WP); float* WR = (float*)(ws + WS_WR); float* RSTDX = (float*)(ws + WS_RSTDX); float* RSTDM = (float*)(ws + WS_RSTDM);
    bf16_t* W1 = (bf16_t*)(ws + WS_W1); bf16_t* W2 = (bf16_t*)(ws + WS_W2); bf16_t* S0 = (bf16_t*)(ws + WS_S0); bf16_t* QKVU = (bf16_t*)(ws + WS_QKVU);
    bf16_t* QM = (bf16_t*)(ws + WS_QM); bf16_t* OM = (bf16_t*)(ws + WS_OM); bf16_t* MIXED = (bf16_t*)(ws + WS_MIXED); bf16_t* PM = (bf16_t*)(ws + WS_PM); bf16_t* ACT = (bf16_t*)(ws + WS_ACT);
    bf16_t* KM = (bf16_t*)(ws + WS_KM); bf16_t* VMT = (bf16_t*)(ws + WS_VMT); bf16_t* MEMB = (bf16_t*)(ws + WS_MEMB); int* LSLOT = (int*)(ws + WS_LSLOT); float* LGATE = (float*)(ws + WS_LGATE);
    bf16_t* Y = (bf16_t*)(ws + WS_Y); float* SCR_S = (float*)(ws + WS_SCR_S); bf16_t* POOLED = (bf16_t*)(ws + WS_SCR_POOLED); float* POOLO = (float*)(ws + WS_SCR_POOLO);
    int* CNT = (int*)(ws + OFF_CNT); float* SSQSB = (float*)(ws + OFF_SSQSB); float* SSQ1 = (float*)(ws + OFF_SSQ1); float* SSQ2 = (float*)(ws + OFF_SSQ2);

    (void)hipMemsetAsync(ws + WS_CTL, 0, CTL_BYTES, stream);
    mk::Args a{}; for (int i = 0; i < 22; ++i) a.in[i] = (const float*)d_in[i]; a.out = out; a.ws = ws;
    const dim3 tb(32, 8); const int BIG = 1 << 30; int li = 0;
    for (int p = 0; p < mk::NPHASE;) {
        if ((MEGA_MASK >> p) & 1) { int q = p; while (q < mk::NPHASE && ((MEGA_MASK >> q) & 1)) ++q;
            a.ph_lo = p; a.ph_hi = q; a.li = li; hipLaunchKernelGGL(mk::mega, dim3(grid), dim3(mk::NWAVES * 64), mk::LDS_BYTES, stream, a); ++li; p = q; continue; }
        switch (p) {
        case 0:
            nv::k_cvt_w<<<dim3(INP / 32, D / 32, 1), tb, 0, stream>>>(w_in, D, INP, WIN, INP, g_mix, nullptr, BIG, nullptr, 0, 0);
            nv::k_cvt_w<<<dim3(D / 32, D / 32, 1), tb, 0, stream>>>(w_out, D, D, WOUT, D, g_sb, g_pool, SBW, nullptr, 0, 0);
            nv::k_cvt_w<<<dim3(D / 32, D / 32, 1), tb, 0, stream>>>(w_mem_q, D, D, WQ, D, g_mem_q, nullptr, BIG, nullptr, 0, 0);
            nv::k_cvt_w<<<dim3(2 * D / 32, D / 32, 1), tb, 0, stream>>>(w_mem_kv, D, 2 * D, WKV, 2 * D, g_mem_kv, nullptr, BIG, nullptr, 0, 0);
            nv::k_cvt_w<<<dim3(D / 32, D / 32, 1), tb, 0, stream>>>(w_mem_o, D, D, WO, D, nullptr, nullptr, BIG, nullptr, 0, 0);
            nv::k_cvt_w<<<dim3(2 * DFF / 32, D / 32, NE), tb, 0, stream>>>(w_e_in, D, 2 * DFF, W1, 2 * DFF, g_ffn, nullptr, BIG, nullptr, 0, 1);
            nv::k_cvt_w<<<dim3(D / 32, DFF / 32, NE), tb, 0, stream>>>(w_e_out, DFF, D, W2, D, nullptr, nullptr, BIG, nullptr, 0, 0);
            nv::k_cvt_w<<<dim3(PGD / 32, PGD / 32, PG), tb, 0, stream>>>(w_pool, PGD, PGD, WP, PGD, nullptr, nullptr, BIG, pool_scale, PGD, 0);
            nv::k_cvt_router<<<NE * D / 256, 256, 0, stream>>>(w_router, g_ffn, WR);
            nv::k_rowstat_cvt<<<NTOK / 4, 256, 0, stream>>>(x, S0, RSTDX, NTOK);
            nv::k_rowstat_cvt<<<NMROWS / 4, 256, 0, stream>>>(mem, MEMB, RSTDM, NMROWS);
            break;
        case 1:
            nv::k_g1<<<dim3(INP / 64, NTOK / 64), 256, 0, stream>>>(S0, WIN, RSTDX, QKVU);
            nv::k_g1b<<<dim3(2 * D / 64, NMROWS / 64), 256, 0, stream>>>(MEMB, WKV, RSTDM, KM, VMT);
            break;
        case 2:
            nv::k_sb<<<B * NH * S / 256, 256, 0, stream>>>(QKVU, MIXED, SSQSB);
            nv::k_pool1<<<(unsigned)((size_t)NTOK * PW / 256), 256, 0, stream>>>(QKVU, POOLED);
            nv::k_pool2<<<dim3(PGD / 64, NTOK / 64, PG), 256, 0, stream>>>(POOLED, WP, POOLO);
            nv::k_pool3<<<NTOK / 4, 256, 0, stream>>>(POOLO, MIXED);
            break;
        case 3: nv::k_resid<<<dim3(D / 64, NTOK / 64), 256, 0, stream>>>(MIXED, WOUT, x, out, S0, SSQ1, SSQSB, SBW); break;
        case 4: nv::k_g3<<<dim3(D / 64, NTOK / 64), 256, 0, stream>>>(S0, WQ, SSQ1, QM); break;
        case 5:
            nv::k_ms<<<dim3(NMEM / 64, NTOK / 64, MH), 256, 0, stream>>>(QM, KM, SCR_S);
            nv::k_msoftmax<<<NTOK * MH / 4, 256, 0, stream>>>(SCR_S, PM);
            break;
        case 6: nv::k_mpv<<<dim3(MHD / 64, NTOK / 64, MH), 256, 0, stream>>>(PM, VMT, OM); break;
        case 7: nv::k_resid<<<dim3(D / 64, NTOK / 64), 256, 0, stream>>>(OM, WO, out, out, S0, SSQ2, SSQ2, -1); break;
        case 8: nv::k_route<<<NTOK / 4, 256, 0, stream>>>(out, SSQ2, WR, b_router, CNT, LSLOT, LGATE); break;
        case 9: nv::k_w1<<<dim3(DFF / 32, LCAP / 64, NE), 256, 0, stream>>>(S0, SSQ2, W1, b_e_in, CNT, LSLOT, ACT); break;
        case 10: nv::k_w2<<<dim3(D / 64, LCAP / 64, NE), 256, 0, stream>>>(ACT, W2, b_e_out, CNT, LSLOT, LGATE, Y); break;
        case 11: nv::k_final<<<NTOK / 4, 256, 0, stream>>>(out, Y, g_final); break;
        }
        ++p;
    }
}
```

```cpp
#include <hip/hip_runtime.h>
#include <cstdio>
#include <cstdint>

typedef unsigned short bf16_t;
typedef short bf16x8 __attribute__((ext_vector_type(8)));
typedef float f32x4 __attribute__((ext_vector_type(4)));
typedef unsigned u32x4 __attribute__((ext_vector_type(4)));

namespace cfg {
constexpr int B = 8, S = 4096, D = 1024, NTOK = B * S;
constexpr int SBW = 512, NH = 8, HD = 64, PW = 512, PG = 4, PGD = 128, INP = 2048;
constexpr int NMEM = 256, MH = 4, MHD = 256, NMROWS = B * NMEM;
constexpr int NE = 32, TOPK = 4, DFF = 1024, LCAP = NTOK;
constexpr float EPS = 1e-5f, LOG2E = 1.4426950408889634f;
constexpr float C2_SB = 0.125f * LOG2E, C2_MEM = 0.0625f * LOG2E;
constexpr float SW_LIMIT = 7.0f, SW_ALPHA = 1.702f;
constexpr int MAXTILES = 544;
constexpr size_t MiB = 1u << 20;
constexpr size_t WS_CTL = 0, CTL_BYTES = 2 * MiB;
constexpr size_t OFF_CNT = 64 * 1024, OFF_SSQSB = 512 * 1024, OFF_SSQ1 = 640 * 1024, OFF_SSQ2 = 768 * 1024;
constexpr size_t WS_WIN = 2 * MiB, WS_WOUT = 6 * MiB, WS_WQ = 8 * MiB, WS_WKV = 10 * MiB, WS_WO = 14 * MiB, WS_WP = 16 * MiB, WS_WR = 17 * MiB;
constexpr size_t WS_RSTDX = 18 * MiB, WS_RSTDM = 18 * MiB + 512 * 1024;
constexpr size_t WS_W1 = 20 * MiB, WS_W2 = 148 * MiB;
constexpr size_t WS_S0 = 212 * MiB;
constexpr size_t WS_QKVU = 276 * MiB;
constexpr size_t WS_QM = 276 * MiB, WS_OM = 340 * MiB;
constexpr size_t WS_MIXED = 404 * MiB;
constexpr size_t WS_PM = 404 * MiB;
constexpr size_t WS_ACT = 276 * MiB;
constexpr size_t WS_KM = 548 * MiB, WS_VMT = 552 * MiB, WS_MEMB = 556 * MiB, WS_LSLOT = 560 * MiB, WS_LGATE = 564 * MiB;
constexpr size_t WS_Y = 568 * MiB;
constexpr size_t WS_SCR_S = 568 * MiB, WS_SCR_POOLED = 696 * MiB, WS_SCR_POOLO = 728 * MiB;
constexpr size_t WS_END = 824 * MiB;
}
using namespace cfg;

__device__ __forceinline__ unsigned f2bf(float f) { unsigned u = __builtin_bit_cast(unsigned, f); return (u + 0x7fffu + ((u >> 16) & 1u)) >> 16; }
__device__ __forceinline__ float bf2f(bf16_t h) { return __builtin_bit_cast(float, (unsigned)h << 16); }
__device__ __forceinline__ float wave_sum(float v) {
#pragma unroll
    for (int o = 1; o < 64; o <<= 1) v += __shfl_xor(v, o);
    return v;
}

namespace nv {
__global__ void k_cvt_w(const float* src, int K, int N, bf16_t* dst, int ND, const float* gk, const float* gk2, int ksplit, const float* gn, int gnz, int mode) {
    __shared__ float t[32][33];
    const int nd0 = blockIdx.x * 32, k0 = blockIdx.y * 32, z = blockIdx.z;
    int ns0 = nd0;
    if (mode == 1) { const int pn = nd0 >> 8, j = nd0 & 255; ns0 = (j < 128) ? 128 * pn + j : 1024 + 128 * pn + (j - 128); }
    src += (size_t)z * K * N; dst += (size_t)z * ND * K;
    for (int i = threadIdx.y; i < 32; i += 8) { const int k = k0 + i, n = ns0 + threadIdx.x;
        float v = src[(size_t)k * N + n]; if (gk) v *= (k < ksplit) ? gk[k] : gk2[k - ksplit]; if (gn) v *= gn[z * gnz + n]; t[i][threadIdx.x] = v; }
    __syncthreads();
    for (int i = threadIdx.y; i < 32; i += 8) dst[(size_t)(nd0 + i) * K + k0 + threadIdx.x] = (bf16_t)f2bf(t[threadIdx.x][i]);
}
__global__ void k_cvt_router(const float* wr, const float* g, float* dst) {
    const int i = blockIdx.x * 256 + threadIdx.x; if (i >= NE * D) return; const int e = i / D, k = i % D; dst[i] = g[k] * wr[k * NE + e];
}
__global__ void k_rowstat_cvt(const float* x, bf16_t* xb, float* rstd, int rows) {
    const int row = blockIdx.x * 4 + (threadIdx.x >> 6), lane = threadIdx.x & 63; if (row >= rows) return;
    const float* xr = x + (size_t)row * D; float s = 0.f;
    for (int j = lane; j < D; j += 64) { const float v = xr[j]; s += v * v; xb[(size_t)row * D + j] = (bf16_t)f2bf(v); }
    s = wave_sum(s); if (lane == 0) rstd[row] = 1.0f / sqrtf(s * (1.0f / D) + EPS);
}

template <class RA, class RB, class MID, class EPI>
__device__ __forceinline__ void wave_gemm(int m0, int n0, int K, int kmid, RA ra, RB rb, MID mid, EPI epi) {
    const int lane = threadIdx.x & 63, r16 = lane & 15, kq = lane >> 4;
    const bf16_t* pa[2]; const bf16_t* pb[2];
#pragma unroll
    for (int i = 0; i < 2; ++i) { pa[i] = ra(m0 + i * 16 + r16) + kq * 8; pb[i] = rb(n0 + i * 16 + r16) + kq * 8; }
    f32x4 acc[2][2];
#pragma unroll
    for (int i = 0; i < 2; ++i)
#pragma unroll
        for (int j = 0; j < 2; ++j) acc[i][j] = (f32x4){0.f, 0.f, 0.f, 0.f};
    for (int k = 0; k < K; k += 32) {
        if (k == kmid) {
#pragma unroll
            for (int i = 0; i < 2; ++i)
#pragma unroll
                for (int r = 0; r < 4; ++r) { const float s = mid(m0 + i * 16 + kq * 4 + r); acc[i][0][r] *= s; acc[i][1][r] *= s; }
        }
        bf16x8 a[2], b[2];
#pragma unroll
        for (int i = 0; i < 2; ++i) { a[i] = *(const bf16x8*)(pa[i] + k); b[i] = *(const bf16x8*)(pb[i] + k); }
#pragma unroll
        for (int i = 0; i < 2; ++i)
#pragma unroll
            for (int j = 0; j < 2; ++j) acc[i][j] = __builtin_amdgcn_mfma_f32_16x16x32_bf16(a[i], b[j], acc[i][j], 0, 0, 0);
    }
#pragma unroll
    for (int i = 0; i < 2; ++i)
#pragma unroll
        for (int r = 0; r < 4; ++r) epi(m0 + i * 16 + kq * 4 + r, n0 + r16, n0 + 16 + r16, acc[i][0][r], acc[i][1][r]);
}
struct NoMid { __device__ float operator()(int) const { return 1.f; } };

#define NV_TILE() const int w = threadIdx.x >> 6, m0 = blockIdx.y * 64 + (w >> 1) * 32, n0 = blockIdx.x * 64 + (w & 1) * 32

__global__ void k_g1(const bf16_t* XB, const bf16_t* WT, const float* rstd, bf16_t* QKVU) {
    NV_TILE();
    wave_gemm(m0, n0, D, -1, [=](int r) { return XB + (size_t)r * D; }, [=](int c) { return WT + (size_t)c * D; }, NoMid(),
        [=](int r, int c0, int c1, float v0, float v1) { const float s = rstd[r];
            v0 *= s; v1 *= s; if (c0 < SBW) v0 *= C2_SB; if (c1 < SBW) v1 *= C2_SB;
            QKVU[(size_t)r * INP + c0] = (bf16_t)f2bf(v0); QKVU[(size_t)r * INP + c1] = (bf16_t)f2bf(v1); });
}
__global__ void k_g1b(const bf16_t* MEMB, const bf16_t* WT, const float* rstd, bf16_t* KM, bf16_t* VMT) {
    NV_TILE();
    wave_gemm(m0, n0, D, -1, [=](int r) { return MEMB + (size_t)r * D; }, [=](int c) { return WT + (size_t)c * D; }, NoMid(),
        [=](int r, int c0, int c1, float v0, float v1) { const float s = rstd[r]; const int cc[2] = {c0, c1}; const float vv[2] = {v0 * s, v1 * s};
#pragma unroll
            for (int q = 0; q < 2; ++q) { const int c = cc[q];
                if (c < D) KM[(size_t)r * D + c] = (bf16_t)f2bf(vv[q]);
                else VMT[((size_t)(r >> 8) * D + (c - D)) * NMEM + (r & 255)] = (bf16_t)f2bf(vv[q]); } });
}
__global__ void __launch_bounds__(256) k_sb(const bf16_t* QKVU, bf16_t* MIXED, float* SSQSB) {
    const int gid = blockIdx.x * 256 + threadIdx.x; const int t = gid & (S - 1), h = (gid >> 12) & 7, b = gid >> 15;
    const bf16_t* base = QKVU + (size_t)b * S * INP;
    float q[HD], o[HD];
    { const bf16_t* qp = base + (size_t)t * INP + h * HD;
#pragma unroll
      for (int d = 0; d < HD; ++d) { q[d] = bf2f(qp[d]); o[d] = 0.f; } }
    float P = 1.f;
    for (int s = t - 1; s >= 0; --s) {
        const bf16_t* kp = base + (size_t)s * INP + SBW + h * HD; const bf16_t* vp = kp + SBW;
        float z = 0.f;
#pragma unroll
        for (int d = 0; d < HD; ++d) z += q[d] * bf2f(kp[d]);
        const float e = exp2f(z), r = 1.0f / (1.0f + e), beta = 1.0f - r;
        const float w = bf2f((bf16_t)f2bf(beta * P));
#pragma unroll
        for (int d = 0; d < HD; ++d) o[d] += w * bf2f(vp[d]);
        P *= r;
        if (P == 0.f) break;
    }
    float ss = 0.f; bf16_t* op = MIXED + (size_t)(b * S + t) * D + h * HD;
#pragma unroll
    for (int d = 0; d < HD; ++d) { ss += o[d] * o[d]; op[d] = (bf16_t)f2bf(o[d]); }
    unsafeAtomicAdd(SSQSB + b * S + t, ss);
}
__global__ void k_pool1(const bf16_t* QKVU, bf16_t* POOLED) {
    const size_t gid = (size_t)blockIdx.x * 256 + threadIdx.x; const int c = gid & 511; const int tok = (int)(gid >> 9), t = tok & (S - 1);
    const int win = 2 << (c >> 7); const int n = (t + 1 < win) ? t + 1 : win;
    const bf16_t* up = QKVU + (size_t)tok * INP + 3 * SBW + c; float s = 0.f;
    for (int j = 0; j < n; ++j) s += bf2f(up[-(ptrdiff_t)j * INP]);
    POOLED[gid] = (bf16_t)f2bf(s / (float)n - bf2f(up[0]));
}
__global__ void k_pool2(const bf16_t* POOLED, const bf16_t* WPT, float* POOLO) {
    NV_TILE(); const int g = blockIdx.z;
    wave_gemm(m0, n0, PGD, -1, [=](int r) { return POOLED + (size_t)r * PW + g * PGD; }, [=](int c) { return WPT + ((size_t)g * PGD + c) * PGD; }, NoMid(),
        [=](int r, int c0, int c1, float v0, float v1) { POOLO[(size_t)r * PW + g * PGD + c0] = v0; POOLO[(size_t)r * PW + g * PGD + c1] = v1; });
}
__global__ void k_pool3(const float* POOLO, bf16_t* MIXED) {
    const int tok = blockIdx.x * 4 + (threadIdx.x >> 6), lane = threadIdx.x & 63;
    float v[8], s = 0.f;
#pragma unroll
    for (int j = 0; j < 8; ++j) { v[j] = POOLO[(size_t)tok * PW + lane + 64 * j]; s += v[j] * v[j]; }
    const float rs = 1.0f / sqrtf(wave_sum(s) * (1.0f / PW) + EPS);
#pragma unroll
    for (int j = 0; j < 8; ++j) MIXED[(size_t)tok * D + SBW + lane + 64 * j] = (bf16_t)f2bf(v[j] * rs);
}
__global__ void k_resid(const bf16_t* A, const bf16_t* WT, const float* xin, float* xout, bf16_t* XB, float* SSQ, const float* ssq_mid, int kmid) {
    NV_TILE();
    wave_gemm(m0, n0, D, kmid, [=](int r) { return A + (size_t)r * D; }, [=](int c) { return WT + (size_t)c * D; },
        [=](int r) { return 1.0f / sqrtf(ssq_mid[r] * (1.0f / SBW) + EPS); },
        [=](int r, int c0, int c1, float v0, float v1) {
            const float x0 = xin[(size_t)r * D + c0] + v0, x1 = xin[(size_t)r * D + c1] + v1;
            xout[(size_t)r * D + c0] = x0; xout[(size_t)r * D + c1] = x1;
            XB[(size_t)r * D + c0] = (bf16_t)f2bf(x0); XB[(size_t)r * D + c1] = (bf16_t)f2bf(x1);
            float q = x0 * x0 + x1 * x1; q += __shfl_xor(q, 1); q += __shfl_xor(q, 2); q += __shfl_xor(q, 4); q += __shfl_xor(q, 8);
            if ((threadIdx.x & 15) == 0) unsafeAtomicAdd(SSQ + r, q); });
}
__global__ void k_g3(const bf16_t* X1B, const bf16_t* WT, const float* SSQ1, bf16_t* QM) {
    NV_TILE();
    wave_gemm(m0, n0, D, -1, [=](int r) { return X1B + (size_t)r * D; }, [=](int c) { return WT + (size_t)c * D; }, NoMid(),
        [=](int r, int c0, int c1, float v0, float v1) { const float s = C2_MEM / sqrtf(SSQ1[r] * (1.0f / D) + EPS);
            QM[(size_t)r * D + c0] = (bf16_t)f2bf(v0 * s); QM[(size_t)r * D + c1] = (bf16_t)f2bf(v1 * s); });
}
__global__ void k_ms(const bf16_t* QM, const bf16_t* KM, float* SCR) {
    NV_TILE(); const int h = blockIdx.z; const int b = m0 >> 12;
    wave_gemm(m0, n0, MHD, -1, [=](int r) { return QM + (size_t)r * D + h * MHD; }, [=](int c) { return KM + ((size_t)b * NMEM + c) * D + h * MHD; }, NoMid(),
        [=](int r, int c0, int c1, float v0, float v1) { SCR[((size_t)r * MH + h) * NMEM + c0] = v0; SCR[((size_t)r * MH + h) * NMEM + c1] = v1; });
}
__global__ void k_msoftmax(const float* SCR, bf16_t* PM) {
    const int row = blockIdx.x * 4 + (threadIdx.x >> 6), lane = threadIdx.x & 63;
    float v[4], m = -INFINITY;
#pragma unroll
    for (int j = 0; j < 4; ++j) { v[j] = SCR[(size_t)row * NMEM + lane + 64 * j]; m = fmaxf(m, v[j]); }
#pragma unroll
    for (int o = 1; o < 64; o <<= 1) m = fmaxf(m, __shfl_xor(m, o));
    float s = 0.f;
#pragma unroll
    for (int j = 0; j < 4; ++j) { v[j] = exp2f(v[j] - m); s += v[j]; }
    s = 1.0f / wave_sum(s);
#pragma unroll
    for (int j = 0; j < 4; ++j) PM[(size_t)row * NMEM + lane + 64 * j] = (bf16_t)f2bf(v[j] * s);
}
__global__ void k_mpv(const bf16_t* PM, const bf16_t* VMT, bf16_t* OM) {
    NV_TILE(); const int h = blockIdx.z; const int b = m0 >> 12;
    wave_gemm(m0, n0, NMEM, -1, [=](int r) { return PM + ((size_t)r * MH + h) * NMEM; }, [=](int c) { return VMT + ((size_t)b * D + h * MHD + c) * NMEM; }, NoMid(),
        [=](int r, int c0, int c1, float v0, float v1) { OM[(size_t)r * D + h * MHD + c0] = (bf16_t)f2bf(v0); OM[(size_t)r * D + h * MHD + c1] = (bf16_t)f2bf(v1); });
}
__global__ void k_route(const float* x2, const float* SSQ2, const float* WR, const float* br, int* CNT, int* LSLOT, float* LGATE) {
    const int tok = blockIdx.x * 4 + (threadIdx.x >> 6), lane = threadIdx.x & 63;
    float xv[16];
#pragma unroll
    for (int j = 0; j < 16; ++j) xv[j] = x2[(size_t)tok * D + lane + 64 * j];
    const float rs = 1.0f / sqrtf(SSQ2[tok] * (1.0f / D) + EPS);
    float mine = 0.f;
    for (int e = 0; e < NE; ++e) { float s = 0.f;
#pragma unroll
        for (int j = 0; j < 16; ++j) s += xv[j] * WR[e * D + lane + 64 * j];
        s = wave_sum(s); if (lane == e) mine = s * rs + br[e]; }
    float tv[4]; int ti[4]; float cur = (lane < NE) ? mine : -INFINITY;
#pragma unroll
    for (int k = 0; k < 4; ++k) { float m = cur; int mi = lane;
#pragma unroll
        for (int o = 1; o < 64; o <<= 1) { const float om = __shfl_xor(m, o); const int oi = __shfl_xor(mi, o); if (om > m || (om == m && oi < mi)) { m = om; mi = oi; } }
        tv[k] = m; ti[k] = mi; if (lane == mi) cur = -INFINITY; }
    float g[4], gs = 0.f;
#pragma unroll
    for (int k = 0; k < 4; ++k) { g[k] = expf(tv[k] - tv[0]); gs += g[k]; }
    if (lane < 4) { int e = ti[0]; float gg = g[0];
        if (lane == 1) { e = ti[1]; gg = g[1]; } if (lane == 2) { e = ti[2]; gg = g[2]; } if (lane == 3) { e = ti[3]; gg = g[3]; }
        const int pos = atomicAdd(CNT + e, 1); LSLOT[(size_t)e * LCAP + pos] = tok * 4 + lane; LGATE[(size_t)e * LCAP + pos] = gg / gs; }
}
__device__ __forceinline__ int tile_base(const int* CNT, int e) { int tb = 0; for (int i = 0; i < e; ++i) tb += (CNT[i] + 255) >> 8; return tb; }
__global__ void k_w1(const bf16_t* X2B, const float* SSQ2, const bf16_t* W1T, const float* b1, const int* CNT, const int* LSLOT, bf16_t* ACT) {
    const int e = blockIdx.z, cnt = CNT[e]; const int w = threadIdx.x >> 6; const int m0 = blockIdx.y * 64 + (w >> 1) * 32; if (blockIdx.y * 64 >= cnt) return;
    const int gc0 = blockIdx.x * 32 + (w & 1) * 16;
    const int pn = gc0 >> 7, j0 = gc0 & 127; const int n0 = pn * 256 + j0;
    const int tb = tile_base(CNT, e); const bf16_t* Wt = W1T + (size_t)e * 2 * DFF * D; const int* ls = LSLOT + (size_t)e * LCAP;
    wave_gemm(m0, 0, D, -1, [=](int r) { const int tok = (r < cnt) ? (ls[r] >> 2) : 0; return X2B + (size_t)tok * D; },
        [=](int c) { const int rowb = (c < 16) ? n0 + c : n0 + 128 + (c - 16); return Wt + (size_t)rowb * D; }, NoMid(),
        [=](int r, int c0, int c1, float vg, float vu) { if (r >= cnt) return; const int tok = ls[r] >> 2; const float rs = 1.0f / sqrtf(SSQ2[tok] * (1.0f / D) + EPS);
            const int gc = gc0 + c0;
            float gate = vg * rs + b1[e * 2 * DFF + gc], up = vu * rs + b1[e * 2 * DFF + DFF + gc];
            gate = fminf(gate, SW_LIMIT); up = fminf(fmaxf(up, -SW_LIMIT), SW_LIMIT);
            const float act = (up + 1.0f) * gate / (1.0f + expf(-SW_ALPHA * gate));
            ACT[((size_t)tb * 256 + r) * DFF + gc] = (bf16_t)f2bf(act); (void)c1; });
}
__global__ void k_w2(const bf16_t* ACT, const bf16_t* W2T, const float* b2, const int* CNT, const int* LSLOT, const float* LGATE, bf16_t* Y) {
    const int e = blockIdx.z, cnt = CNT[e]; if (blockIdx.y * 64 >= cnt) return; NV_TILE();
    const int tb = tile_base(CNT, e); const bf16_t* Wt = W2T + (size_t)e * D * DFF; const int* ls = LSLOT + (size_t)e * LCAP; const float* lg = LGATE + (size_t)e * LCAP;
    wave_gemm(m0, n0, DFF, -1, [=](int r) { return ACT + ((size_t)tb * 256 + r) * DFF; }, [=](int c) { return Wt + (size_t)c * DFF; }, NoMid(),
        [=](int r, int c0, int c1, float v0, float v1) { if (r >= cnt) return; const int slot = ls[r]; const float g = lg[r];
            Y[(size_t)slot * D + c0] = (bf16_t)f2bf((v0 + b2[e * D + c0]) * g); Y[(size_t)slot * D + c1] = (bf16_t)f2bf((v1 + b2[e * D + c1]) * g); });
}
__global__ void k_final(float* out, const bf16_t* Y, const float* gf) {
    const int tok = blockIdx.x * 4 + (threadIdx.x >> 6), lane = threadIdx.x & 63;
    float v[16], s = 0.f;
#pragma unroll
    for (int j = 0; j < 16; ++j) { const int c = lane + 64 * j; float a = out[(size_t)tok * D + c];
#pragma unroll
        for (int k = 0; k < 4; ++k) a += bf2f(Y[((size_t)tok * 4 + k) * D + c]);
        v[j] = a; s += a * a; }
    const float rs = 1.0f / sqrtf(wave_sum(s) * (1.0f / D) + EPS);
#pragma unroll
    for (int j = 0; j < 16; ++j) { const int c = lane + 64 * j; out[(size_t)tok * D + c] = v[j] * rs * gf[c]; }
}
}

#define LAS __attribute__((address_space(3)))
#define GAS __attribute__((address_space(1)))
typedef int v4i_t __attribute__((ext_vector_type(4)));
typedef int v8i_t __attribute__((ext_vector_type(8)));
namespace pg8 {
constexpr int BM = 256, BK = 64, HALF = 128, HTB = HALF * BK * 2, STAGE_BYTES = 8 * HTB, NXCD = 8, WGM = 8;
__host__ __device__ __forceinline__ int lds_byte(int r, int c) { const int st = (r >> 4) * 2 + (c >> 5), rr = r & 15, cc = c & 31, ob = rr * 64 + cc * 2; return st * 1024 + (ob ^ (((ob >> 9) & 1) << 5)); }
__host__ __device__ __forceinline__ void stage_rc(int b, int& R, int& C) { const int st = b / 1024, sb = b % 1024, swz = sb ^ (((sb >> 9) & 1) << 5); R = (st >> 1) * 16 + swz / 64; C = (st & 1) * 32 + (swz % 64) / 2; }
__host__ __device__ __forceinline__ int perm32(int rho) { const int n = rho >> 4, i = rho & 15; return 8 * (i >> 2) + 4 * n + (i & 3); }
__device__ __forceinline__ unsigned cvt_pk_bf16(float lo, float hi) { unsigned r; asm volatile("v_cvt_pk_bf16_f32 %0, %1, %2" : "=v"(r) : "v"(lo), "v"(hi)); return r; }

#define WTMASK 0x008
#ifndef WTMASK
#define WTMASK 0x1ff
#endif
#define WT_ON(bit) (((WTMASK) >> (bit)) & 1)
__device__ __forceinline__ void st16_wt(void* p, u32x4 v) { asm volatile("global_store_dwordx4 %0, %1, off sc1\n\ts_nop 1" :: "v"(p), "v"(v)); }
__device__ __forceinline__ void st16_wt(void* p, f32x4 v) { asm volatile("global_store_dwordx4 %0, %1, off sc1\n\ts_nop 1" :: "v"(p), "v"(v)); }
template <int BIT, class V> __device__ __forceinline__ void st16(void* p, V v) { if constexpr (WT_ON(BIT)) st16_wt(p, v); else *(V*)p = v; }
#ifndef WT8
#define WT8 0
#endif
__device__ __forceinline__ void st8_wt(void* p, unsigned long long v) { if (WT8) __hip_atomic_store((unsigned long long*)p, v, __ATOMIC_RELAXED, __HIP_MEMORY_SCOPE_AGENT); else *(unsigned long long*)p = v; }
__device__ __forceinline__ void st4_wt(void* p, unsigned v) { if (WT8) __hip_atomic_store((unsigned*)p, v, __ATOMIC_RELAXED, __HIP_MEMORY_SCOPE_AGENT); else *(unsigned*)p = v; }
__device__ __forceinline__ int fresh_lane() { int l; asm volatile("v_mbcnt_lo_u32_b32 %0, -1, 0\n\tv_mbcnt_hi_u32_b32 %0, -1, %0" : "=v"(l)); return l; }
struct Unit { const char* A; const char* B; void* p0; void* p1; void* p2; void* p3; int pm, pn, i0, i1, ghost; };

__device__ __forceinline__ int xcd_remap(int L, int nwg) { const int q = nwg / NXCD, r = nwg % NXCD, xcd = L % NXCD, off = L / NXCD; return __builtin_amdgcn_readfirstlane((xcd < r ? xcd * (q + 1) : r * (q + 1) + (xcd - r) * q) + off); }
__device__ __forceinline__ void grouped_mn(int wgid, int nM, int nN, int& pm, int& pn) {
    const int nig = WGM * nN, gid = wgid / nig, fm = gid * WGM, gsz = (nM - fm) < WGM ? (nM - fm) : WGM; pm = __builtin_amdgcn_readfirstlane(fm + ((wgid % nig) % gsz)); pn = __builtin_amdgcn_readfirstlane((wgid % nig) / gsz); }

template <class Epi, class Sched, int TABS, int REP = 1, int REPE = 1, bool F8 = false>
__device__ __forceinline__ void gemm_phase(const int wid, LAS unsigned char* lds, LAS unsigned char* epi_lds, LAS unsigned* gtab, const int lda_b, const int ldb_b, const int nt, const Sched& S, const Epi& E) {
    constexpr bool GATHER = (TABS == 1);
    const int wr = wid >> 2, wc = wid & 3;
    unsigned voffA, voffB, voffG[2][2]; int aoff, boff;
    { const int lane = fresh_lane(); int R, C; stage_rc(wid * 1024 + lane * 16, R, C); const int Rb = Epi::PERM ? ((R & ~31) + perm32(R & 31)) : R;
      voffA = (unsigned)(R * lda_b + C * 2); voffB = (unsigned)(Rb * ldb_b + C * 2); voffG[0][0] = voffG[0][1] = voffG[1][0] = voffG[1][1] = 0;
      aoff = lds_byte(wr * 64 + (lane & 15), (lane >> 4) * 8); boff = lds_byte(wc * 32 + (lane & 15), (lane >> 4) * 8); }
    const size_t kstep = (size_t)(BK * 2);
    const size_t hstepA = (size_t)HALF * lda_b, hstepB = (size_t)HALF * ldb_b;
    const unsigned ldsw = (unsigned)wid * 1024u; const unsigned ldsbase = (unsigned)(uintptr_t)lds + ldsw;
#define PG8_SA(b, h) (((b) * 2 + (h)) * HTB)
#define PG8_SB(b, h) ((4 + (b) * 2 + (h)) * HTB)
#define PG8_GLDS(ugp, voff, bufoff, _i) do { unsigned _keep; asm volatile("s_mov_b32 %0, m0\n\ts_mov_b32 m0, %3\n\ts_nop 0\n\tglobal_load_lds_dwordx4 %1, %2\n\ts_mov_b32 m0, %0" \
        : "=&s"(_keep) : "v"(voff), "s"((const char*)(ugp)), "s"(ldsbase + (unsigned)((bufoff) + (_i) * 8192)) : "memory"); } while (0)
#define PG8_STAGE_B(bufoff, gbase) do { _Pragma("unroll") for (int _i = 0; _i < 2; ++_i) PG8_GLDS((const char*)(gbase) + (size_t)_i * 64 * ldb_b, voffB, bufoff, _i); } while (0)
#define PG8_STAGE_A(bufoff, gbase, h) do { if constexpr (GATHER) { _Pragma("unroll") for (int _i = 0; _i < 2; ++_i) PG8_GLDS((const char*)(gbase), voffG[h][_i], bufoff, _i); } \
        else { _Pragma("unroll") for (int _i = 0; _i < 2; ++_i) PG8_GLDS((const char*)(gbase) + (h) * hstepA + (size_t)_i * 64 * lda_b, voffA, bufoff, _i); } } while (0)
#define PG8_LDA(dst, b, h) do { _Pragma("unroll") for (int m = 0; m < 4; ++m) _Pragma("unroll") for (int k = 0; k < 2; ++k) dst[m][k] = *(const LAS bf16x8*)(lds + PG8_SA(b, h) + aoff + m * 2048 + k * 1024); } while (0)
#define PG8_LDB(dst, b, h) do { _Pragma("unroll") for (int n = 0; n < 2; ++n) _Pragma("unroll") for (int k = 0; k < 2; ++k) dst[n][k] = *(const LAS bf16x8*)(lds + PG8_SB(b, h) + boff + n * 2048 + k * 1024); } while (0)
#define PG8_CAT(x0, x1) __builtin_shufflevector(__builtin_bit_cast(v4i_t, x0), __builtin_bit_cast(v4i_t, x1), 0, 1, 2, 3, 4, 5, 6, 7)
#define PG8_MMA(ai, bj, At, Bt) do { __builtin_amdgcn_s_setprio(1); _Pragma("unroll") for (int m = 0; m < 4; ++m) _Pragma("unroll") for (int n = 0; n < 2; ++n) { \
        if constexpr (F8) acc[ai][bj][m][n] = __builtin_amdgcn_mfma_scale_f32_16x16x128_f8f6f4(PG8_CAT(Bt[n][0], Bt[n][1]), PG8_CAT(At[m][0], At[m][1]), acc[ai][bj][m][n], 0, 0, 0, 0, 0, 0); \
        else { _Pragma("unroll") for (int k = 0; k < 2; ++k) acc[ai][bj][m][n] = __builtin_amdgcn_mfma_f32_16x16x32_bf16(Bt[n][k], At[m][k], acc[ai][bj][m][n], 0, 0, 0); } } __builtin_amdgcn_s_setprio(0); } while (0)
#define PG8_WAIT_V(n) asm volatile("s_waitcnt vmcnt(" #n ")" ::: "memory")
#define PG8_WAIT_L(n) asm volatile("s_waitcnt lgkmcnt(" #n ")" ::: "memory")
#define PG8_BAR __builtin_amdgcn_s_barrier()
#define PG8_SCHED __builtin_amdgcn_sched_barrier(0)
#define PG8_GTAB_LOAD(buf, nvalid) do { const int _l = fresh_lane(); int _R, _C; stage_rc(wid * 1024 + _l * 16, _R, _C); _Pragma("unroll") for (int _h = 0; _h < 2; ++_h) _Pragma("unroll") for (int _i = 0; _i < 2; ++_i) { \
        const int _row = _h * HALF + _R + 64 * _i; const unsigned _s = gtab[(buf) * 768 + _row]; voffG[_h][_i] = ((_row < (nvalid)) ? (_s >> 2) * (unsigned)lda_b : 0u) + (unsigned)(_C * 2); } } while (0)
#define PG8_GTAB_DMA(buf, U) do { if (wid < 3) { const int _l = fresh_lane(); const char* _src = (wid == 0) ? (const char*)(U).p3 + _l * 16 : (wid == 1) ? (const char*)(U).p2 + _l * 16 : \
            (TABS == 1 ? (const char*)(U).p1 + (_l & 31) * 16 + (_l >> 5) * (DFF * 4) : (const char*)(U).p1 + _l * 16); \
        __builtin_amdgcn_global_load_lds((const unsigned*)_src, (LAS unsigned*)(gtab + (buf) * 768 + wid * 256), 16, 0, 0); } } while (0)
    auto nextu = [&](int i, Unit& u) -> bool { if constexpr (REP > 1) { const bool ok = S.next(i / REP, u); u.ghost = (i % REP) != REP - 1; return ok; } else { u.ghost = 0; return S.next(i, u); } };
    Unit cur, nxt; int ui = 0;
    if (!nextu(0, cur)) return;
    f32x4 acc[2][2][4][2];
#pragma unroll
    for (int a = 0; a < 2; ++a)
#pragma unroll
        for (int b = 0; b < 2; ++b)
#pragma unroll
            for (int m = 0; m < 4; ++m)
#pragma unroll
                for (int n = 0; n < 2; ++n) acc[a][b][m][n] = (f32x4){0.f, 0.f, 0.f, 0.f};
    bf16x8 At[4][2], B0[2][2], B1[2][2];
    const char* cA = cur.A; const char* cB = cur.B;
    if constexpr (TABS != 0) { PG8_GTAB_DMA(0, cur); PG8_WAIT_V(0); PG8_WAIT_L(0); PG8_BAR; if constexpr (GATHER) PG8_GTAB_LOAD(0, cur.i0); }
    PG8_STAGE_B(PG8_SB(0, 0), cB); PG8_STAGE_B(PG8_SB(0, 1), cB + hstepB); PG8_STAGE_A(PG8_SA(0, 0), cA, 0); PG8_STAGE_A(PG8_SA(0, 1), cA, 1);
    if (wr == 1) PG8_BAR;
    PG8_WAIT_V(2); PG8_BAR;
    PG8_STAGE_B(PG8_SB(1, 0), cB + kstep); PG8_STAGE_A(PG8_SA(1, 0), cA + kstep, 0); PG8_STAGE_B(PG8_SB(1, 1), cB + hstepB + kstep);
    PG8_WAIT_V(6); PG8_BAR;
    for (;;) {
        const bool has_next = nextu(ui + 1, nxt);
        const char* nA = has_next ? nxt.A : cA; const char* nB = has_next ? nxt.B : cB;
#pragma unroll 1
        for (int t = 0; t < nt; t += 2) {
            const bool last = (t == nt - 2);
            const char* a1 = cA + (size_t)(t + 1) * kstep;
            const char* a2 = last ? nA : cA + (size_t)(t + 2) * kstep; const char* b2 = last ? nB : cB + (size_t)(t + 2) * kstep;
            const char* a3 = a2 + kstep; const char* b3 = b2 + kstep;
            if constexpr (Epi::MIDK >= 0) { if (t == Epi::MIDK) E.midk(acc, cur, wr, fresh_lane() & 15); }
            if constexpr (TABS != 0) { if (t == 2 && has_next) PG8_GTAB_DMA((ui + 1) & 1, nxt); }
            if constexpr (GATHER) { PG8_STAGE_A(PG8_SA(1, 1), a1, 1); if (last && has_next) PG8_GTAB_LOAD((ui + 1) & 1, nxt.i0); PG8_SCHED; }
            PG8_LDB(B0, 0, 0); PG8_LDB(B1, 0, 1); PG8_SCHED; PG8_LDA(At, 0, 0); if constexpr (!GATHER) PG8_STAGE_A(PG8_SA(1, 1), a1, 1);
            PG8_WAIT_V(8); PG8_WAIT_L(0); PG8_BAR; PG8_MMA(0, 0, At, B0); PG8_MMA(0, 1, At, B1); PG8_BAR; PG8_SCHED;
            PG8_LDA(At, 0, 1); PG8_STAGE_B(PG8_SB(0, 0), b2); PG8_STAGE_B(PG8_SB(0, 1), b2 + hstepB); PG8_STAGE_A(PG8_SA(0, 0), a2, 0);
            PG8_WAIT_V(8); PG8_WAIT_L(0); PG8_BAR; PG8_MMA(1, 0, At, B0); PG8_MMA(1, 1, At, B1); PG8_BAR; PG8_SCHED;
            PG8_LDB(B0, 1, 0); PG8_LDB(B1, 1, 1); PG8_SCHED; PG8_LDA(At, 1, 0); PG8_STAGE_A(PG8_SA(0, 1), a2, 1);
            PG8_WAIT_V(8); PG8_WAIT_L(0); PG8_BAR; PG8_MMA(0, 0, At, B0); PG8_MMA(0, 1, At, B1); PG8_BAR; PG8_SCHED;
            PG8_LDA(At, 1, 1); PG8_STAGE_B(PG8_SB(1, 0), b3); PG8_STAGE_B(PG8_SB(1, 1), b3 + hstepB); PG8_STAGE_A(PG8_SA(1, 0), a3, 0);
            PG8_WAIT_V(8); PG8_WAIT_L(0); PG8_BAR; PG8_MMA(1, 0, At, B0); PG8_MMA(1, 1, At, B1); PG8_BAR; PG8_SCHED;
        }
        if (wr == 0) PG8_BAR;
        if (!cur.ghost) { const int el = fresh_lane(); LAS unsigned char* ex = (TABS != 0) ? (LAS unsigned char*)(gtab + (ui & 1) * 768) : epi_lds; E(acc, cur, wr, wc, el & 15, el >> 4, wid, el, ex); if constexpr (REPE > 1) { asm volatile("" ::: "memory"); E(acc, cur, wr, wc, el & 15, el >> 4, wid, el, ex); } }
        if (!has_next) break;
#pragma unroll
        for (int a = 0; a < 2; ++a)
#pragma unroll
            for (int b = 0; b < 2; ++b)
#pragma unroll
                for (int m = 0; m < 4; ++m)
#pragma unroll
                    for (int n = 0; n < 2; ++n) acc[a][b][m][n] = (f32x4){0.f, 0.f, 0.f, 0.f};
        cur = nxt; cA = nA; cB = nB; ++ui;
        if (wr == 1) PG8_BAR;
    }
    PG8_WAIT_V(0);
    PG8_BAR;
#undef PG8_SA
#undef PG8_SB
#undef PG8_GLDS
#undef PG8_STAGE_A
#undef PG8_STAGE_B
#undef PG8_LDA
#undef PG8_LDB
#undef PG8_MMA
#undef PG8_CAT
#undef PG8_WAIT_V
#undef PG8_WAIT_L
#undef PG8_BAR
#undef PG8_SCHED
#undef PG8_GTAB_LOAD
#undef PG8_GTAB_DMA
}

template <bool F8O> struct EpiBf16SX {
    static constexpr bool PERM = true; static constexpr int MIDK = -1;
    __device__ __forceinline__ void midk(f32x4 (&)[2][2][4][2], const Unit&, int, int) const {}
    __device__ __forceinline__ void operator()(const f32x4 (&acc)[2][2][4][2], const Unit& u, int wr, int wc, int fr, int fq, int, int, LAS unsigned char*) const {
        bf16_t* O = (bf16_t*)u.p0; unsigned char* O8 = (unsigned char*)u.p0; const float* rs = (const float*)u.p1; const float* cs = (const float*)u.p2; const int ldc = u.i0;
        int r0 = wr * 64 + fr, c0 = wc * 32 + 8 * fq; asm volatile("" : "+v"(r0), "+v"(c0));
        f32x4 cv[2][2];
#pragma unroll
        for (int bj = 0; bj < 2; ++bj)
#pragma unroll
            for (int n = 0; n < 2; ++n) cv[bj][n] = cs ? *(const f32x4*)(cs + c0 + bj * HALF + 4 * n) : (f32x4){1.f, 1.f, 1.f, 1.f};
#pragma unroll
        for (int ai = 0; ai < 2; ++ai)
#pragma unroll
            for (int m = 0; m < 4; ++m) { const int r = r0 + ai * HALF + m * 16; const float rv = rs ? rs[r] : 1.f; bf16_t* rowp = O + (size_t)r * ldc + c0;
#pragma unroll
                for (int bj = 0; bj < 2; ++bj) { const f32x4 v0 = acc[ai][bj][m][0] * cv[bj][0] * rv, v1 = acc[ai][bj][m][1] * cv[bj][1] * rv;
                    if constexpr (F8O) { int w0 = __builtin_amdgcn_cvt_pk_fp8_f32(v0[0], v0[1], 0, false); w0 = __builtin_amdgcn_cvt_pk_fp8_f32(v0[2], v0[3], w0, true); int w1 = __builtin_amdgcn_cvt_pk_fp8_f32(v1[0], v1[1], 0, false); w1 = __builtin_amdgcn_cvt_pk_fp8_f32(v1[2], v1[3], w1, true);
                        st8_wt(O8 + (size_t)r * ldc + c0 + bj * HALF, (unsigned long long)(unsigned)w0 | ((unsigned long long)(unsigned)w1 << 32)); }
                    else { u32x4 w; w.x = cvt_pk_bf16(v0[0], v0[1]); w.y = cvt_pk_bf16(v0[2], v0[3]); w.z = cvt_pk_bf16(v1[0], v1[1]); w.w = cvt_pk_bf16(v1[2], v1[3]);
                    st16<1>(rowp + bj * HALF, w); } } }
    }
};
typedef EpiBf16SX<false> EpiBf16S;
}

namespace mk {
constexpr int NWAVES = 8, NPHASE = 12;
constexpr int RING_OFF = 0, RING_BYTES = 131072, EPI_OFF = 131072, EPI_BYTES = 8192, GTAB_OFF = EPI_OFF + EPI_BYTES, GTAB_BYTES = 6144, MISC_OFF = GTAB_OFF + GTAB_BYTES, MISC_BYTES = 1024;
constexpr int LDS_BYTES = 147456;
static_assert(MISC_OFF + MISC_BYTES <= LDS_BYTES, "LDS map");
constexpr size_t WS_LRS = 84 * MiB;
constexpr size_t WS_X2F8 = WS_Y, WS_X1F8 = WS_Y + 32 * MiB;
constexpr size_t WS_CSG1 = 19 * MiB, WS_WRH = 19 * MiB + 64 * 1024, WS_WRL = 19 * MiB + 128 * 1024;
typedef unsigned ssq_t;
constexpr size_t MK_SSQSB = 256 * 1024, MK_SSQ1 = 512 * 1024, MK_SSQ2 = 768 * 1024;
__device__ __forceinline__ void ssq_add(ssq_t* p, float q) { (void)__hip_atomic_fetch_add(p, (ssq_t)__float2uint_rn(q * 16384.0f), __ATOMIC_RELAXED, __HIP_MEMORY_SCOPE_AGENT); }
__device__ __forceinline__ float ssq_get(const ssq_t* p) { return (float)(*p) * (1.0f / 16384.0f); }
constexpr float WSCALE = 32.0f;
constexpr int CW_BAR = 1024;

#define RLX_AGENT __ATOMIC_RELAXED, __HIP_MEMORY_SCOPE_AGENT
#define LDS_WAIT() asm volatile("s_waitcnt lgkmcnt(0)" ::: "memory")
#define VM_WAIT() asm volatile("s_waitcnt vmcnt(0)" ::: "memory")
#define XB_TMO      128
#define XB_XCNT(j)  (256  + 64 * (j))
#define XB_XSUB(j)  (1280 + 64 * (j))
#define XB_XGEN(j)  (2304 + 64 * (j))
#define XB_TOP      3328
#define XB_TOPGEN   3392
#define XCD_BAR_WORDS 3456
#define XB_SPIN_CAP (1u << 20)
__device__ __forceinline__ unsigned xb_ld(unsigned* p)              { return __hip_atomic_load(p, __ATOMIC_RELAXED, __HIP_MEMORY_SCOPE_AGENT); }
__device__ __forceinline__ unsigned xb_add(unsigned* p, unsigned v) { return __hip_atomic_fetch_add(p, v, __ATOMIC_RELAXED, __HIP_MEMORY_SCOPE_AGENT); }
__device__ __forceinline__ unsigned xb_xcc_id() { return (unsigned)__builtin_amdgcn_s_getreg((3 << 11) | 20) & 0xFu; }
#define XB_SPIN(cond, bar) do { unsigned _sp = 0; while (cond) { __builtin_amdgcn_s_sleep(1); \
    if ((++_sp & 255u) == 0u) { if (xb_ld(&(bar)[XB_TMO])) break; if (_sp > XB_SPIN_CAP) { atomicAdd(&(bar)[XB_TMO], 1u); break; } } } } while (0)
struct XcdBarrier { unsigned* bar; unsigned x; volatile LAS unsigned* st; };
__device__ __forceinline__ XcdBarrier xcd_barrier_post(unsigned* bar, volatile LAS unsigned* st) {
    XcdBarrier b; b.bar = bar; b.x = xb_xcc_id(); b.st = st;
    if (threadIdx.x == 0) (void)xb_add(&bar[XB_XCNT(b.x)], 1u);
    return b;
}
__device__ __forceinline__ void xcd_barrier_complete(unsigned* bar, unsigned x, unsigned& nloc, unsigned& nx) {
    const unsigned G = gridDim.x * gridDim.y * gridDim.z;
    unsigned sum, cnt, mine, sp = 0u;
    for (;;) {
        sum = 0u; cnt = 0u; mine = 0u;
#pragma unroll
        for (unsigned j = 0; j < 16; ++j) { const unsigned c = xb_ld(&bar[XB_XCNT(j)]); sum += c; cnt += (c > 0u) ? 1u : 0u; mine = (j == x) ? c : mine; }
        if (sum == G) break;
        __builtin_amdgcn_s_sleep(1);
        if ((++sp & 255u) == 0u) { if (xb_ld(&bar[XB_TMO])) break; if (sp > XB_SPIN_CAP) { atomicAdd(&bar[XB_TMO], 1u); break; } }
    }
    nloc = mine > 0u ? mine : 1u; nx = cnt > 0u ? cnt : 1u;
}
__device__ __forceinline__ void xcd_barrier(const XcdBarrier& b) {
    asm volatile("s_waitcnt vmcnt(0)" ::: "memory");
    __syncthreads();
    if (threadIdx.x == 0) {
        unsigned* bar = b.bar;
        __builtin_amdgcn_s_waitcnt(0);
        unsigned nloc = b.st[0], nx = b.st[1];
        if (nloc == 0u) { xcd_barrier_complete(bar, b.x, nloc, nx); b.st[0] = nloc; b.st[1] = nx; }
        const unsigned old = xb_add(&bar[XB_XSUB(b.x)], 1u);
        const unsigned gen = old / nloc;
        if (old + 1u == (gen + 1u) * nloc) {
            __builtin_amdgcn_fence(__ATOMIC_RELEASE, "agent");
            asm volatile("s_waitcnt vmcnt(0)" ::: "memory");
            const unsigned og = xb_add(&bar[XB_TOP], 1u);
            const unsigned tg = og / nx;
            if (og + 1u == (tg + 1u) * nx) xb_add(&bar[XB_TOPGEN], 1u);
            else XB_SPIN(xb_ld(&bar[XB_TOPGEN]) == tg, bar);
            __builtin_amdgcn_fence(__ATOMIC_ACQUIRE, "agent");
            xb_add(&bar[XB_XGEN(b.x)], 1u);
            asm volatile("s_waitcnt vmcnt(0)" ::: "memory");
        } else {
            XB_SPIN(xb_ld(&bar[XB_XGEN(b.x)]) == gen, bar);
            __builtin_amdgcn_fence(__ATOMIC_ACQUIRE, "agent");
            asm volatile("s_waitcnt vmcnt(0)" ::: "memory");
        }
    }
    __syncthreads();
}

struct Args { const float* in[22]; float* out; unsigned char* ws; int ph_lo, ph_hi, li, pad; };

template <bool F8OUT>
__device__ __forceinline__ void p0_item(const float* W, int K, int N, void* WTv, const float* gk, const float* gk2, int ksplit, const float* gn, int mode, LAS float* scr, int item, int lane, float mult = 1.0f, int nblk_dec = 0) {
    const int nblk = nblk_dec ? nblk_dec : N / 32, kb = item / nblk, nb = item % nblk, k0 = 64 * kb, nd0 = 32 * nb;
    int ns0 = nd0; if (mode == 1) { const int pn = nd0 >> 8, j = nd0 & 255; ns0 = (j < 128) ? 128 * pn + j : 1024 + 128 * pn + (j - 128); }
    const int kr = lane >> 3, n4 = (lane & 7) * 4;
    f32x4 v[8];
#pragma unroll
    for (int i = 0; i < 8; ++i) v[i] = *(const f32x4*)(W + (size_t)(k0 + 8 * i + kr) * N + ns0 + n4);
    f32x4 gnv = (f32x4){1.f, 1.f, 1.f, 1.f}; if (gn) gnv = *(const f32x4*)(gn + ns0 + n4);
#pragma unroll
    for (int i = 0; i < 8; ++i) { const int kk = 8 * i + kr, k = k0 + kk; float g = 1.f; if (gk) g = (k < ksplit) ? gk[k] : gk2[k - ksplit];
        const f32x4 t = v[i] * gnv * (g * mult); LAS float* d = scr + kk * 33 + n4; d[0] = t[0]; d[1] = t[1]; d[2] = t[2]; d[3] = t[3]; }
    LDS_WAIT(); asm volatile("" ::: "memory");
    const int c = lane & 7;
#pragma unroll
    for (int j = 0; j < 4; ++j) { const int n = (lane >> 3) + 8 * j; const LAS float* s = scr + (8 * c) * 33 + n;
        if constexpr (F8OUT) { int lo = __builtin_amdgcn_cvt_pk_fp8_f32(s[0 * 33], s[1 * 33], 0, false); lo = __builtin_amdgcn_cvt_pk_fp8_f32(s[2 * 33], s[3 * 33], lo, true);
            int hi2 = __builtin_amdgcn_cvt_pk_fp8_f32(s[4 * 33], s[5 * 33], 0, false); hi2 = __builtin_amdgcn_cvt_pk_fp8_f32(s[6 * 33], s[7 * 33], hi2, true);
            pg8::st8_wt((unsigned char*)WTv + (size_t)(nd0 + n) * K + k0 + 8 * c, (unsigned long long)(unsigned)lo | ((unsigned long long)(unsigned)hi2 << 32)); }
        else { u32x4 o; o.x = pg8::cvt_pk_bf16(s[0 * 33], s[1 * 33]); o.y = pg8::cvt_pk_bf16(s[2 * 33], s[3 * 33]); o.z = pg8::cvt_pk_bf16(s[4 * 33], s[5 * 33]); o.w = pg8::cvt_pk_bf16(s[6 * 33], s[7 * 33]);
            pg8::st16<0>((bf16_t*)WTv + (size_t)(nd0 + n) * K + k0 + 8 * c, o); } }
    LDS_WAIT(); asm volatile("" ::: "memory");
}
__device__ __forceinline__ void p0_fused_pool_item(const float* w_in, const float* g_mix, const float* w_pool, const float* pool_scale, bf16_t* WIN_T, int item, int lane) {
    const int eb = item & 7, kb = (item >> 3) & 15, g = item >> 7; const int k = kb * 64 + lane, e0 = eb * 16;
    const float* ap = w_in + (size_t)k * INP + 3 * SBW + g * PGD; const float* bp = w_pool + (size_t)g * PGD * PGD + e0;
    float acc[16];
#pragma unroll
    for (int j = 0; j < 16; ++j) acc[j] = 0.f;
#pragma unroll 4
    for (int c = 0; c < PGD; ++c) { const float a = ap[c];
#pragma unroll
        for (int j = 0; j < 16; ++j) acc[j] += a * bp[c * PGD + j]; }
    const float gk = g_mix[k];
#pragma unroll
    for (int j = 0; j < 16; ++j) WIN_T[(size_t)(3 * SBW + g * PGD + e0 + j) * D + k] = (bf16_t)f2bf(acc[j] * gk * pool_scale[g * PGD + e0 + j]);
}
__device__ __forceinline__ void p0_row(const float* xrow, bf16_t* orow, float* rstd, int lane) {
    const f32x4* xr = (const f32x4*)xrow + 2 * lane; f32x4 v[4]; float s = 0.f;
#pragma unroll
    for (int j = 0; j < 4; ++j) { v[j] = xr[(j >> 1) * 128 + (j & 1)]; s += (v[j].x * v[j].x + v[j].y * v[j].y) + (v[j].z * v[j].z + v[j].w * v[j].w); }
    s = wave_sum(s); if (lane == 0) *rstd = 1.0f / sqrtf(s * (1.0f / D) + EPS);
#pragma unroll
    for (int j = 0; j < 2; ++j) { u32x4 o; o.x = pg8::cvt_pk_bf16(v[2 * j].x, v[2 * j].y); o.y = pg8::cvt_pk_bf16(v[2 * j].z, v[2 * j].w); o.z = pg8::cvt_pk_bf16(v[2 * j + 1].x, v[2 * j + 1].y); o.w = pg8::cvt_pk_bf16(v[2 * j + 1].z, v[2 * j + 1].w);
        pg8::st16<0>(orow + j * 512 + 8 * lane, o); }
}
__device__ __forceinline__ void p0_prologue(const Args& a, LAS unsigned char* lds, int vcu, int G, int wave, int lane) {
    unsigned char* ws = a.ws;
    LAS float* scr = (LAS float*)(lds + RING_OFF + wave * 16384);
    const int gw = vcu * NWAVES + wave, NGW = G * NWAVES;
    constexpr int I_E1 = (D / 64) * (2 * DFF / 32), I_E2 = (DFF / 64) * (D / 32);
    constexpr int I_IN = (D / 64) * (3 * SBW / 32), I_FP = PG * 16 * 8, I_SQ = (D / 64) * (D / 32), I_KV = (D / 64) * (2 * D / 32), I_P = (PGD / 64) * (PGD / 32);
    constexpr int N1 = NE * I_E1, N2 = NE * I_E2, NITEMS = N1 + N2 + I_IN + 3 * I_SQ + I_KV + I_FP;
    const int BIG = 1 << 30;
    for (int it = gw; it < NITEMS; it += NGW) {
        int r = it;
        if (r < N1) { const int e = r / I_E1; p0_item<true>(a.in[17] + (size_t)e * D * 2 * DFF, D, 2 * DFF, ws + WS_W1 + (size_t)e * 2 * DFF * D, a.in[14], nullptr, BIG, nullptr, 1, scr, r % I_E1, lane, WSCALE); continue; } r -= N1;
        if (r < N2) { const int e = r / I_E2; p0_item<true>(a.in[19] + (size_t)e * DFF * D, DFF, D, ws + WS_W2 + (size_t)e * D * DFF, nullptr, nullptr, BIG, nullptr, 0, scr, r % I_E2, lane, WSCALE); continue; } r -= N2;
        if (r < I_IN) { p0_item<false>(a.in[3], D, INP, (bf16_t*)(ws + WS_WIN), a.in[2], nullptr, BIG, nullptr, 0, scr, r, lane, 1.0f, 3 * SBW / 32); continue; } r -= I_IN;
        if (r < I_SQ) { p0_item<false>(a.in[8], D, D, (bf16_t*)(ws + WS_WOUT), a.in[4], a.in[5], SBW, nullptr, 0, scr, r, lane); continue; } r -= I_SQ;
        if (r < I_SQ) { p0_item<true>(a.in[11], D, D, ws + WS_WQ, a.in[9], nullptr, BIG, nullptr, 0, scr, r, lane, WSCALE); continue; } r -= I_SQ;
        if (r < I_KV) { p0_item<false>(a.in[12], D, 2 * D, (bf16_t*)(ws + WS_WKV), a.in[10], nullptr, BIG, nullptr, 0, scr, r, lane); continue; } r -= I_KV;
        if (r < I_SQ) { p0_item<false>(a.in[13], D, D, (bf16_t*)(ws + WS_WO), nullptr, nullptr, BIG, nullptr, 0, scr, r, lane); continue; } r -= I_SQ;
        p0_fused_pool_item(a.in[3], a.in[2], a.in[6], a.in[7], (bf16_t*)(ws + WS_WIN), r, lane);
    }
    for (int m = gw; m < NTOK; m += NGW) p0_row(a.in[0] + (size_t)m * D, (bf16_t*)(ws + WS_S0) + (size_t)m * D, (float*)(ws + WS_RSTDX) + m, lane);
    for (int m = gw; m < NMROWS; m += NGW) p0_row(a.in[1] + (size_t)m * D, (bf16_t*)(ws + WS_MEMB) + (size_t)m * D, (float*)(ws + WS_RSTDM) + m, lane);
    const int gt = gw * 64 + lane, NGT = NGW * 64;
    for (int i = gt; i < INP; i += NGT) ((float*)(ws + WS_CSG1))[i] = (i < SBW) ? C2_SB : 1.0f;
    for (int i = gt; i < NE * D; i += NGT) { const int e = i / D, k = i % D; const float v = a.in[14][k] * a.in[15][k * NE + e];
        ((float*)(ws + WS_WR))[i] = v; const unsigned h = f2bf(v); ((bf16_t*)(ws + WS_WRH))[i] = (bf16_t)h; ((bf16_t*)(ws + WS_WRL))[i] = (bf16_t)f2bf(v - bf2f((bf16_t)h)); }
}

struct SchedP1 {
    int G, c; unsigned char* ws;
    __device__ __forceinline__ bool next(int i, pg8::Unit& u) const {
        const int L = i * G + c; constexpr int NQ = (NTOK / 256) * (INP / 256);
        if (L >= NQ + 64) return false;
        if (L < NQ) { int pm, pn; pg8::grouped_mn(pg8::xcd_remap(L, NQ), NTOK / 256, INP / 256, pm, pn);
            u.A = (const char*)(ws + WS_S0) + (size_t)pm * 256 * D * 2; u.B = (const char*)(ws + WS_WIN) + (size_t)pn * 256 * D * 2;
            u.p0 = (bf16_t*)(ws + WS_QKVU) + (size_t)pm * 256 * INP + pn * 256; u.p1 = (float*)(ws + WS_RSTDX) + pm * 256; u.p2 = (float*)(ws + WS_CSG1) + pn * 256; u.i0 = INP; u.pm = pm; u.pn = pn; }
        else if (L < NQ + 32) { const int k = L - NQ, pm = k >> 2, pn = k & 3;
            u.A = (const char*)(ws + WS_MEMB) + (size_t)pm * 256 * D * 2; u.B = (const char*)(ws + WS_WKV) + (size_t)pn * 256 * D * 2;
            u.p0 = (bf16_t*)(ws + WS_KM) + (size_t)pm * 256 * D + pn * 256; u.p1 = (float*)(ws + WS_RSTDM) + pm * 256; u.p2 = nullptr; u.i0 = D; u.pm = pm; u.pn = pn; }
        else { const int v = L - NQ - 32, b = v >> 2, dt = v & 3;
            u.A = (const char*)(ws + WS_WKV) + (size_t)(D + dt * 256) * D * 2; u.B = (const char*)(ws + WS_MEMB) + (size_t)b * 256 * D * 2;
            u.p0 = (bf16_t*)(ws + WS_VMT) + ((size_t)b * D + dt * 256) * NMEM; u.p1 = nullptr; u.p2 = (float*)(ws + WS_RSTDM) + b * 256; u.i0 = NMEM; u.pm = dt; u.pn = b; }
        u.p3 = nullptr; u.i1 = 0; return true;
    }
};
#define EPI_BAR() asm volatile("s_waitcnt lgkmcnt(0)\n\ts_barrier" ::: "memory")
struct SchedReg {
    int G, c, nM, nN; const char* A; const char* B; size_t astep, bstep; bf16_t* O; int ldc; const float* rs; const float* cs; const ssq_t* sq = nullptr;
    __device__ __forceinline__ bool next(int i, pg8::Unit& u) const {
        const int L = i * G + c; if (L >= nM * nN) return false; int pm, pn; pg8::grouped_mn(pg8::xcd_remap(L, nM * nN), nM, nN, pm, pn);
        u.A = A + (size_t)pm * astep; u.B = B + (size_t)pn * bstep; u.pm = pm; u.pn = pn; u.i0 = ldc; u.i1 = 0;
        u.p0 = O ? (void*)(O + (size_t)pm * 256 * ldc + pn * 256) : nullptr; u.p1 = sq ? (void*)(sq + pm * 256) : (rs ? (void*)(rs + pm * 256) : nullptr); u.p2 = cs ? (void*)(cs + pn * 256) : nullptr; u.p3 = nullptr; return true;
    }
};
struct EpiBf16Ssq {
    static constexpr bool PERM = true; static constexpr int MIDK = -1; float inv_n, mult;
    __device__ __forceinline__ void midk(f32x4 (&)[2][2][4][2], const pg8::Unit&, int, int) const {}
    __device__ __forceinline__ void operator()(f32x4 (&acc)[2][2][4][2], const pg8::Unit& u, int wr, int wc, int fr, int fq, int, int, LAS unsigned char*) const {
        bf16_t* O = (bf16_t*)u.p0; const ssq_t* sq = (const ssq_t*)u.p1; const int ldc = u.i0; int r0 = wr * 64 + fr, c0 = wc * 32 + 8 * fq; asm volatile("" : "+v"(r0), "+v"(c0));
#pragma unroll
        for (int ai = 0; ai < 2; ++ai)
#pragma unroll
            for (int m = 0; m < 4; ++m) { const int r = r0 + ai * 128 + m * 16; const float rv = mult / sqrtf(ssq_get(sq + r) * inv_n + EPS); bf16_t* rowp = O + (size_t)r * ldc + c0;
#pragma unroll
                for (int bj = 0; bj < 2; ++bj) { const f32x4 v0 = acc[ai][bj][m][0] * rv, v1 = acc[ai][bj][m][1] * rv;
                    u32x4 w; w.x = pg8::cvt_pk_bf16(v0[0], v0[1]); w.y = pg8::cvt_pk_bf16(v0[2], v0[3]); w.z = pg8::cvt_pk_bf16(v1[0], v1[1]); w.w = pg8::cvt_pk_bf16(v1[2], v1[3]);
                    pg8::st16<5>(rowp + bj * 128, w); } }
    }
};
template <int MIDK_, bool XIN_BF16, bool F8OUT> struct EpiResid {
    static constexpr bool PERM = true; static constexpr int MIDK = MIDK_;
    const float* xin; bf16_t* xb; unsigned char* x8; ssq_t* ssq; const ssq_t* ssq_mid; float accs;
    __device__ __forceinline__ void midk(f32x4 (&acc)[2][2][4][2], const pg8::Unit& u, int wr, int fr) const {
#pragma unroll
        for (int ai = 0; ai < 2; ++ai)
#pragma unroll
            for (int m = 0; m < 4; ++m) { const int r = u.pm * 256 + ai * 128 + wr * 64 + m * 16 + fr; const float s = 1.0f / sqrtf(ssq_get(ssq_mid + r) * (1.0f / SBW) + EPS);
#pragma unroll
                for (int bj = 0; bj < 2; ++bj)
#pragma unroll
                    for (int n = 0; n < 2; ++n) acc[ai][bj][m][n] *= s; }
    }
    __device__ __forceinline__ void operator()(f32x4 (&acc)[2][2][4][2], const pg8::Unit& u, int wr, int wc, int fr, int fq, int, int, LAS unsigned char*) const {
        int row0 = u.pm * 256 + wr * 64 + fr, col0 = u.pn * 256 + wc * 32 + 8 * fq; asm volatile("" : "+v"(row0), "+v"(col0));
#pragma unroll
        for (int ai = 0; ai < 2; ++ai)
#pragma unroll
            for (int m = 0; m < 4; ++m) { const int r = row0 + ai * 128 + m * 16; const size_t off = (size_t)r * D + col0; float q = 0.f;
#pragma unroll
                for (int bj = 0; bj < 2; ++bj) { const size_t o2 = off + bj * 128; f32x4 o0, o1;
                    if constexpr (XIN_BF16) { const u32x4 xv = *(const u32x4*)(xb + o2);
                        o0 = (f32x4){__builtin_bit_cast(float, xv.x << 16), __builtin_bit_cast(float, xv.x & 0xffff0000u), __builtin_bit_cast(float, xv.y << 16), __builtin_bit_cast(float, xv.y & 0xffff0000u)};
                        o1 = (f32x4){__builtin_bit_cast(float, xv.z << 16), __builtin_bit_cast(float, xv.z & 0xffff0000u), __builtin_bit_cast(float, xv.w << 16), __builtin_bit_cast(float, xv.w & 0xffff0000u)}; }
                    else { o0 = *(const f32x4*)(xin + o2); o1 = *(const f32x4*)(xin + o2 + 4); }
                    o0 += acc[ai][bj][m][0] * accs; o1 += acc[ai][bj][m][1] * accs;
                    q += (o0[0] * o0[0] + o0[1] * o0[1]) + (o0[2] * o0[2] + o0[3] * o0[3]) + (o1[0] * o1[0] + o1[1] * o1[1]) + (o1[2] * o1[2] + o1[3] * o1[3]);
                    if constexpr (F8OUT) { int w0 = __builtin_amdgcn_cvt_pk_fp8_f32(o0[0], o0[1], 0, false); w0 = __builtin_amdgcn_cvt_pk_fp8_f32(o0[2], o0[3], w0, true);
                        int w1 = __builtin_amdgcn_cvt_pk_fp8_f32(o1[0], o1[1], 0, false); w1 = __builtin_amdgcn_cvt_pk_fp8_f32(o1[2], o1[3], w1, true);
                        pg8::st8_wt(x8 + o2, (unsigned long long)(unsigned)w0 | ((unsigned long long)(unsigned)w1 << 32)); }
                    u32x4 w; w.x = pg8::cvt_pk_bf16(o0[0], o0[1]); w.y = pg8::cvt_pk_bf16(o0[2], o0[3]); w.z = pg8::cvt_pk_bf16(o1[0], o1[1]); w.w = pg8::cvt_pk_bf16(o1[2], o1[3]); pg8::st16<4>(xb + o2, w); }
                q += __shfl_xor(q, 16); q += __shfl_xor(q, 32);
                if (fq == 0) ssq_add(ssq + r, q);
                if (m & 1) asm volatile("" ::: "memory"); }
    }
};
struct SchedMS {
    int G, c; unsigned char* ws;
    __device__ __forceinline__ bool next(int i, pg8::Unit& u) const {
        const int L = i * G + c; constexpr int NU = (NTOK / 256) * MH; if (L >= NU) return false; const int w = pg8::xcd_remap(L, NU), pm = w >> 2, h = w & 3, b = pm >> 4;
        u.A = (const char*)(ws + WS_QM) + ((size_t)pm * 256 * D + h * MHD) * 2; u.B = (const char*)(ws + WS_KM) + ((size_t)b * NMEM * D + h * MHD) * 2;
        u.p0 = (bf16_t*)(ws + WS_PM) + (size_t)pm * 256 * D + h * NMEM; u.p1 = nullptr; u.p2 = nullptr; u.p3 = nullptr; u.i0 = D; u.i1 = 0; u.pm = pm; u.pn = h; return true;
    }
};
struct EpiSoftmax {
    static constexpr bool PERM = true; static constexpr int MIDK = -1;
    __device__ __forceinline__ void midk(f32x4 (&)[2][2][4][2], const pg8::Unit&, int, int) const {}
    __device__ __forceinline__ void operator()(f32x4 (&acc)[2][2][4][2], const pg8::Unit& u, int wr, int wc, int fr, int fq, int, int, LAS unsigned char* xl) const {
        typedef float f32x2v __attribute__((ext_vector_type(2)));
        LAS f32x2v* X = (LAS f32x2v*)xl;
        float ml[2][4];
#pragma unroll
        for (int ai = 0; ai < 2; ++ai)
#pragma unroll
            for (int m = 0; m < 4; ++m) { float mx = -INFINITY;
#pragma unroll
                for (int bj = 0; bj < 2; ++bj)
#pragma unroll
                    for (int n = 0; n < 2; ++n) { const f32x4 v = acc[ai][bj][m][n]; mx = fmaxf(fmaxf(mx, fmaxf(v[0], v[1])), fmaxf(v[2], v[3])); }
                mx = fmaxf(mx, __shfl_xor(mx, 16)); mx = fmaxf(mx, __shfl_xor(mx, 32)); ml[ai][m] = mx; float s = 0.f;
#pragma unroll
                for (int bj = 0; bj < 2; ++bj)
#pragma unroll
                    for (int n = 0; n < 2; ++n) { f32x4 v = acc[ai][bj][m][n];
#pragma unroll
                        for (int j = 0; j < 4; ++j) { v[j] = __builtin_amdgcn_exp2f(v[j] - mx); s += v[j]; }
                        acc[ai][bj][m][n] = v; }
                s += __shfl_xor(s, 16); s += __shfl_xor(s, 32);
                if (fq == 0) X[(ai * 128 + wr * 64 + m * 16 + fr) * 4 + wc] = (f32x2v){mx, s}; }
        EPI_BAR();
        bf16_t* O = (bf16_t*)u.p0; const int ldc = u.i0; int r0 = wr * 64 + fr, c0 = wc * 32 + 8 * fq; asm volatile("" : "+v"(r0), "+v"(c0));
#pragma unroll
        for (int ai = 0; ai < 2; ++ai)
#pragma unroll
            for (int m = 0; m < 4; ++m) { const int r = r0 + ai * 128 + m * 16; const f32x2v a = X[r * 4 + 0], b = X[r * 4 + 1], c = X[r * 4 + 2], d = X[r * 4 + 3];
                const float M = fmaxf(fmaxf(a.x, b.x), fmaxf(c.x, d.x));
                const float tot = a.y * __builtin_amdgcn_exp2f(a.x - M) + b.y * __builtin_amdgcn_exp2f(b.x - M) + c.y * __builtin_amdgcn_exp2f(c.x - M) + d.y * __builtin_amdgcn_exp2f(d.x - M);
                const float f = __builtin_amdgcn_exp2f(ml[ai][m] - M) / tot; bf16_t* rowp = O + (size_t)r * ldc + c0;
#pragma unroll
                for (int bj = 0; bj < 2; ++bj) { const f32x4 v0 = acc[ai][bj][m][0] * f, v1 = acc[ai][bj][m][1] * f;
                    u32x4 w; w.x = pg8::cvt_pk_bf16(v0[0], v0[1]); w.y = pg8::cvt_pk_bf16(v0[2], v0[3]); w.z = pg8::cvt_pk_bf16(v1[0], v1[1]); w.w = pg8::cvt_pk_bf16(v1[2], v1[3]);
                    pg8::st16<6>(rowp + bj * 128, w); } }
    }
};
struct SchedPV {
    int G, c; unsigned char* ws;
    __device__ __forceinline__ bool next(int i, pg8::Unit& u) const {
        const int L = i * G + c; constexpr int NU = (NTOK / 256) * MH; if (L >= NU) return false; const int w = pg8::xcd_remap(L, NU), pm = w >> 2, h = w & 3, b = pm >> 4;
        u.A = (const char*)(ws + WS_PM) + ((size_t)pm * 256 * D + h * NMEM) * 2; u.B = (const char*)(ws + WS_VMT) + ((size_t)b * D + h * MHD) * NMEM * 2;
        u.p0 = (bf16_t*)(ws + WS_OM) + (size_t)pm * 256 * D + h * MHD; u.p1 = nullptr; u.p2 = nullptr; u.p3 = nullptr; u.i0 = D; u.i1 = 0; u.pm = pm; u.pn = h; return true;
    }
};

__device__ __forceinline__ void p8_route(const Args& a, LAS unsigned char* lds, int bx, int G, int wave, int lane, int* CNT) {
    unsigned char* ws = a.ws; const bf16_t* x2 = (const bf16_t*)(ws + WS_S0); const ssq_t* SSQ2 = (const ssq_t*)(ws + MK_SSQ2); const float* br = a.in[16];
    const bf16_t* WRH = (const bf16_t*)(ws + WS_WRH);
    int* LSLOT = (int*)(ws + WS_LSLOT); float* LGATE = (float*)(ws + WS_LGATE); float* LRS = (float*)(ws + WS_LRS);
    constexpr int WPITCH = 2064;
    LAS float* LG = (LAS float*)(lds + RING_OFF + 69632) + wave * 16 * 33;
    LAS int* hist = (LAS int*)(lds + RING_OFF + 90112); LAS int* base = hist + 32;
    const int tid = wave * 64 + lane;
    { u32x4 v[8];
#pragma unroll
      for (int i = 0; i < 8; ++i) v[i] = *(const u32x4*)(WRH + (size_t)(tid + i * 512) * 8);
#pragma unroll
      for (int i = 0; i < 8; ++i) { const int c = tid + i * 512; *(LAS u32x4*)(lds + RING_OFF + (c >> 7) * WPITCH + (c & 127) * 16) = v[i]; } }
    LDS_WAIT(); __syncthreads();
    for (int t0 = bx * 128; t0 < NTOK; t0 += G * 128) {
        if (tid < 32) hist[tid] = 0;
        const int r16 = lane & 15, kq = lane >> 4; const int trow = t0 + wave * 16 + r16;
        const bf16_t* xp = x2 + (size_t)trow * D + kq * 8;
        bf16x8 ah[32];
#pragma unroll
        for (int ks = 0; ks < 32; ++ks) ah[ks] = *(const bf16x8*)(xp + ks * 32);
        f32x4 acc[2] = {(f32x4){0.f, 0.f, 0.f, 0.f}, (f32x4){0.f, 0.f, 0.f, 0.f}};
        const LAS unsigned char* wp = lds + RING_OFF + r16 * WPITCH + kq * 16;
#pragma unroll
        for (int ks = 0; ks < 32; ++ks) {
#pragma unroll
            for (int nb = 0; nb < 2; ++nb) { const bf16x8 bh = *(const LAS bf16x8*)(wp + nb * 16 * WPITCH + ks * 64);
                acc[nb] = __builtin_amdgcn_mfma_f32_16x16x32_bf16(ah[ks], bh, acc[nb], 0, 0, 0); } }
#pragma unroll
        for (int nb = 0; nb < 2; ++nb)
#pragma unroll
            for (int r = 0; r < 4; ++r) { const int tl = kq * 4 + r; const int tk = t0 + wave * 16 + tl; const float rs = 1.0f / sqrtf(ssq_get(SSQ2 + tk) * (1.0f / D) + EPS);
                LG[tl * 33 + nb * 16 + r16] = acc[nb][r] * rs + br[nb * 16 + r16]; }
        LDS_WAIT(); __syncthreads();
        int te[4] = {0, 0, 0, 0}; float tg[4] = {0.f, 0.f, 0.f, 0.f}; int rk[4] = {0, 0, 0, 0};
        if (lane < 16) {
            float tv[4] = {-INFINITY, -INFINITY, -INFINITY, -INFINITY};
            for (int e = 0; e < NE; ++e) { const float v = LG[lane * 33 + e];
                if (v > tv[3]) { if (v > tv[2]) { tv[3] = tv[2]; te[3] = te[2]; if (v > tv[1]) { tv[2] = tv[1]; te[2] = te[1]; if (v > tv[0]) { tv[1] = tv[0]; te[1] = te[0]; tv[0] = v; te[0] = e; } else { tv[1] = v; te[1] = e; } } else { tv[2] = v; te[2] = e; } } else { tv[3] = v; te[3] = e; } } }
            float gs = 0.f;
#pragma unroll
            for (int k = 0; k < 4; ++k) { tg[k] = __expf(tv[k] - tv[0]); gs += tg[k]; }
            gs = 1.0f / gs;
#pragma unroll
            for (int k = 0; k < 4; ++k) { tg[k] *= gs; rk[k] = __hip_atomic_fetch_add(hist + te[k], 1, __ATOMIC_RELAXED, __HIP_MEMORY_SCOPE_WORKGROUP); }
        }
        LDS_WAIT(); __syncthreads();
        if (tid < 32) { const int n = hist[tid]; base[tid] = n ? atomicAdd(CNT + tid, n) : 0; }
        LDS_WAIT(); __syncthreads();
        if (lane < 16) { const int tk = t0 + wave * 16 + lane; const float rsw = (1.0f / WSCALE) / sqrtf(ssq_get(SSQ2 + tk) * (1.0f / D) + EPS);
#pragma unroll
            for (int k = 0; k < 4; ++k) { const size_t p = (size_t)te[k] * LCAP + base[te[k]] + rk[k]; pg8::st4_wt(LSLOT + p, (unsigned)(tk * 4 + k)); pg8::st4_wt(LGATE + p, __float_as_uint(tg[k])); pg8::st4_wt(LRS + p, __float_as_uint(rsw)); } }
        LDS_WAIT(); __syncthreads();
    }
}

__device__ __forceinline__ void moe_table(const Args& a, volatile LAS unsigned* MISC, int tid) {
    const int* CNT = (const int*)(a.ws + OFF_CNT);
    if (tid < 32) MISC[16 + tid] = (unsigned)CNT[tid];
    LDS_WAIT(); __syncthreads();
    if (tid == 0) { unsigned tb = 0; for (int e = 0; e < NE; ++e) { MISC[48 + e] = tb; tb += (MISC[16 + e] + 255u) >> 8; } MISC[48 + NE] = tb; }
    LDS_WAIT(); __syncthreads();
}
template <int NPN, bool W1> struct SchedMoE {
    int G, c; unsigned char* ws; volatile LAS unsigned* MISC; const float* bias;
    __device__ __forceinline__ bool next(int i, pg8::Unit& u) const {
        unsigned mb_ = (unsigned)(uintptr_t)MISC; asm volatile("" : "+s"(mb_)); const LAS unsigned* M = (const LAS unsigned*)(uintptr_t)mb_;
        const int T = __builtin_amdgcn_readfirstlane((int)M[48 + NE]); const int NU = T * NPN; const int L = i * G + c; if (L >= NU) return false;
        const int w = pg8::xcd_remap(L, NU);
        int e = 0;
#pragma unroll
        for (int s = 16; s >= 1; s >>= 1) { if ((int)M[48 + e + s] * NPN <= w) e += s; }
        e = __builtin_amdgcn_readfirstlane(e);
        const int tb = __builtin_amdgcn_readfirstlane((int)M[48 + e]), cnt = __builtin_amdgcn_readfirstlane((int)M[16 + e]), nte = (cnt + 255) >> 8; const int idx = w - tb * NPN, pn = __builtin_amdgcn_readfirstlane(idx / nte), mt = idx - pn * nte;
        u.pm = tb + mt; u.pn = pn; u.i1 = e; const int nv = cnt - mt * 256; u.i0 = nv < 256 ? nv : 256;
        u.p3 = (int*)(ws + WS_LSLOT) + (size_t)e * LCAP + mt * 256; u.p2 = (float*)(ws + (W1 ? WS_LRS : WS_LGATE)) + (size_t)e * LCAP + mt * 256; u.p0 = nullptr;
        u.p1 = W1 ? (void*)(bias + (size_t)e * 2 * DFF + pn * 128) : (void*)(bias + (size_t)e * D + pn * 256);
        if (W1) { u.A = (const char*)(ws + WS_X2F8); u.B = (const char*)(ws + WS_W1) + ((size_t)e * 2 * DFF + pn * 256) * D; }
        else { u.A = (const char*)(ws + WS_ACT) + (size_t)(tb + mt) * 256 * DFF; u.B = (const char*)(ws + WS_W2) + ((size_t)e * D + pn * 256) * DFF; }
        return true;
    }
};
typedef float f32x2 __attribute__((ext_vector_type(2)));
struct EpiSwiGLU {
    static constexpr bool PERM = true; static constexpr int MIDK = -1; unsigned char* act;
    __device__ __forceinline__ void midk(f32x4 (&)[2][2][4][2], const pg8::Unit&, int, int) const {}
    __device__ __forceinline__ void operator()(f32x4 (&acc)[2][2][4][2], const pg8::Unit& u, int wr, int wc, int fr, int fq, int, int, LAS unsigned char* tab) const {
        const int nvalid = u.i0; const LAS float* T1 = (const LAS float*)tab + 256; const LAS float* T2 = (const LAS float*)tab + 512;
        int r0 = wr * 64 + fr, c0 = wc * 32 + 8 * fq; asm volatile("" : "+v"(r0), "+v"(c0)); const int gc0 = u.pn * 128 + c0;
        f32x4 bg[2], bu[2];
#pragma unroll
        for (int n = 0; n < 2; ++n) { bg[n] = *(const LAS f32x4*)(T2 + c0 + 4 * n); bu[n] = *(const LAS f32x4*)(T2 + 128 + c0 + 4 * n); }
#pragma unroll
        for (int ai = 0; ai < 2; ++ai)
#pragma unroll
            for (int m = 0; m < 4; ++m) { const int r = r0 + ai * 128 + m * 16; const float rs = T1[r]; int wv[2];
#pragma unroll
                for (int n = 0; n < 2; ++n) { f32x2 o[2];
#pragma unroll
                    for (int h = 0; h < 2; ++h) { f32x2 g = (f32x2){acc[ai][0][m][n][2 * h], acc[ai][0][m][n][2 * h + 1]} * rs + (f32x2){bg[n][2 * h], bg[n][2 * h + 1]};
                        f32x2 up = (f32x2){acc[ai][1][m][n][2 * h], acc[ai][1][m][n][2 * h + 1]} * rs + (f32x2){bu[n][2 * h], bu[n][2 * h + 1]};
                        g.x = fminf(g.x, SW_LIMIT); g.y = fminf(g.y, SW_LIMIT); up.x = fminf(fmaxf(up.x, -SW_LIMIT), SW_LIMIT); up.y = fminf(fmaxf(up.y, -SW_LIMIT), SW_LIMIT);
                        const f32x2 tt = g * (-SW_ALPHA * LOG2E); f32x2 d; d.x = __builtin_amdgcn_exp2f(tt.x); d.y = __builtin_amdgcn_exp2f(tt.y); d = d + 1.0f;
                        f32x2 rr; rr.x = __builtin_amdgcn_rcpf(d.x); rr.y = __builtin_amdgcn_rcpf(d.y);
                        o[h] = (up + 1.0f) * g * rr; }
                    wv[n] = __builtin_amdgcn_cvt_pk_fp8_f32(o[0].x, o[0].y, 0, false); wv[n] = __builtin_amdgcn_cvt_pk_fp8_f32(o[1].x, o[1].y, wv[n], true); }
                if (r < nvalid) pg8::st8_wt(act + ((size_t)u.pm * 256 + r) * DFF + gc0, (unsigned long long)(unsigned)wv[0] | ((unsigned long long)(unsigned)wv[1] << 32)); }
    }
};
struct EpiW2 {
    static constexpr bool PERM = true; static constexpr int MIDK = -1; unsigned char* Y;
    __device__ __forceinline__ void midk(f32x4 (&)[2][2][4][2], const pg8::Unit&, int, int) const {}
    __device__ __forceinline__ void operator()(f32x4 (&acc)[2][2][4][2], const pg8::Unit& u, int wr, int wc, int fr, int fq, int, int, LAS unsigned char* tab) const {
        const int nvalid = u.i0; const LAS unsigned* T0 = (const LAS unsigned*)tab; const LAS float* T1 = (const LAS float*)tab + 256; const LAS float* T2 = (const LAS float*)tab + 512;
        int r0 = wr * 64 + fr, cl = wc * 32 + 8 * fq; asm volatile("" : "+v"(r0), "+v"(cl)); const int c0 = u.pn * 256 + cl;
        f32x4 bv[2][2];
#pragma unroll
        for (int bj = 0; bj < 2; ++bj)
#pragma unroll
            for (int n = 0; n < 2; ++n) bv[bj][n] = *(const LAS f32x4*)(T2 + cl + bj * 128 + 4 * n);
#pragma unroll
        for (int ai = 0; ai < 2; ++ai)
#pragma unroll
            for (int m = 0; m < 4; ++m) { const int r = r0 + ai * 128 + m * 16; const bool valid = r < nvalid; const unsigned slot = T0[r]; const float g = T1[r];
#pragma unroll
                for (int bj = 0; bj < 2; ++bj) { const f32x4 v0 = (acc[ai][bj][m][0] * (1.0f / WSCALE) + bv[bj][0]) * g, v1 = (acc[ai][bj][m][1] * (1.0f / WSCALE) + bv[bj][1]) * g;
                    int w0 = __builtin_amdgcn_cvt_pk_fp8_f32(v0[0], v0[1], 0, false); w0 = __builtin_amdgcn_cvt_pk_fp8_f32(v0[2], v0[3], w0, true);
                    int w1 = __builtin_amdgcn_cvt_pk_fp8_f32(v1[0], v1[1], 0, false); w1 = __builtin_amdgcn_cvt_pk_fp8_f32(v1[2], v1[3], w1, true);
                    if (valid) pg8::st8_wt(Y + (size_t)slot * D + c0 + bj * 128, (unsigned long long)(unsigned)w0 | ((unsigned long long)(unsigned)w1 << 32)); } }
    }
};

__device__ __forceinline__ void p11_final(const Args& a, int vcu, int G, int wave, int lane, float* dst) {
    const bf16_t* x2 = (const bf16_t*)(a.ws + WS_S0); const unsigned char* Y = a.ws + WS_Y; const float* gf = a.in[21];
    const int gw = vcu * NWAVES + wave, NGW = G * NWAVES;
    f32x4 g4[4];
#pragma unroll
    for (int j = 0; j < 4; ++j) g4[j] = *(const f32x4*)(gf + 16 * lane + 4 * j);
    for (int tok = gw; tok < NTOK; tok += NGW) {
        const u32x4 xa = *(const u32x4*)(x2 + (size_t)tok * D + 16 * lane), xc = *(const u32x4*)(x2 + (size_t)tok * D + 16 * lane + 8);
        u32x4 yv[4];
#pragma unroll
        for (int k = 0; k < 4; ++k) yv[k] = *(const u32x4*)(Y + ((size_t)tok * 4 + k) * D + 16 * lane);
        float v[16];
#pragma unroll
        for (int q = 0; q < 4; ++q) { v[2 * q] = __builtin_bit_cast(float, xa[q] << 16); v[2 * q + 1] = __builtin_bit_cast(float, xa[q] & 0xffff0000u); v[8 + 2 * q] = __builtin_bit_cast(float, xc[q] << 16); v[8 + 2 * q + 1] = __builtin_bit_cast(float, xc[q] & 0xffff0000u); }
#pragma unroll
        for (int k = 0; k < 4; ++k)
#pragma unroll
            for (int q = 0; q < 4; ++q) { const auto lo = __builtin_amdgcn_cvt_pk_f32_fp8((int)yv[k][q], false), hi2 = __builtin_amdgcn_cvt_pk_f32_fp8((int)yv[k][q], true);
                v[4 * q] += lo[0]; v[4 * q + 1] += lo[1]; v[4 * q + 2] += hi2[0]; v[4 * q + 3] += hi2[1]; }
        float s = 0.f;
#pragma unroll
        for (int q = 0; q < 16; ++q) s += v[q] * v[q];
        const float rs = 1.0f / sqrtf(wave_sum(s) * (1.0f / D) + EPS);
#pragma unroll
        for (int j = 0; j < 4; ++j) pg8::st16<8>(dst + (size_t)tok * D + 16 * lane + 4 * j, (f32x4){v[4 * j] * rs * g4[j][0], v[4 * j + 1] * rs * g4[j][1], v[4 * j + 2] * rs * g4[j][2], v[4 * j + 3] * rs * g4[j][3]});
    }
}
typedef float f32x16 __attribute__((ext_vector_type(16)));
typedef short s16x4 __attribute__((ext_vector_type(4)));
__device__ __forceinline__ int crow(int r, int hi) { return (r & 3) + 8 * (r >> 2) + 4 * hi; }
#define SB_DMA(ubase, voff, ldsaddr) do { unsigned keep_; asm volatile("s_mov_b32 %0, m0\n\ts_mov_b32 m0, %3\n\ts_nop 0\n\tglobal_load_lds_dwordx4 %1, %2\n\ts_mov_b32 m0, %0" \
        : "=&s"(keep_) : "v"(voff), "s"((const char*)(ubase)), "s"(ldsaddr) : "memory"); } while (0)
__device__ __forceinline__ void sb_item(int b, int h, int qs  , const bf16_t* QKVU, bf16_t* MIXED, ssq_t* SSQSB, LAS unsigned char* wl  , int lane) {
    const int r32 = lane & 31, hi = lane >> 5;
    const size_t rowbase = (size_t)b * S; const int q0 = qs * 32;
    const bf16_t* Qw = QKVU + (rowbase + q0) * INP + h * HD;
    const char* Kh = (const char*)(QKVU + rowbase * INP + SBW + h * HD); const char* Vh = Kh + SBW * 2;
    bf16x8 qr[4];
#pragma unroll
    for (int d0 = 0; d0 < 4; ++d0) qr[d0] = *(const bf16x8*)(Qw + (size_t)r32 * INP + d0 * 16 + hi * 8);
    f32x16 o[2];
#pragma unroll
    for (int r = 0; r < 16; ++r) { o[0][r] = 0.f; o[1][r] = 0.f; }
    float carry = 1.0f;
    const int jd = qs >> 1;
    const int qabs = q0 + r32;
    const unsigned kvoff = (unsigned)lane * (INP * 2);
    const unsigned vvoff = (unsigned)(lane >> 2) * (INP * 2) + (unsigned)(lane & 3) * 16;
    const unsigned lk = (unsigned)(uintptr_t)wl, lv = lk + 8192;
#define SB_LOAD_K(j) do { const char* kb_ = Kh + (size_t)(j) * 64 * INP * 2; _Pragma("unroll") for (int c_ = 0; c_ < 8; ++c_) SB_DMA(kb_ + c_ * 16, kvoff, lk + c_ * 1024); } while (0)
#define SB_LOAD_V(j) do { const char* vb_ = Vh + (size_t)(j) * 64 * INP * 2; _Pragma("unroll") for (int c_ = 0; c_ < 8; ++c_) SB_DMA(vb_ + (size_t)(c_ & 3) * 16 * INP * 2 + (c_ >> 2) * 64, vvoff, lv + c_ * 1024); } while (0)
    SB_LOAD_K(jd); SB_LOAD_V(jd);
    const LAS unsigned char* kb = wl + hi * 1024 + r32 * 16;
    const LAS unsigned char* vb = wl + 8192 + ((lane >> 4) & 1) * 32 + (lane & 3) * 8 + (4 * hi + ((lane & 15) >> 2)) * 64;
    for (int j = jd; j >= 0; --j) {
        asm volatile("s_waitcnt vmcnt(8)" ::: "memory"); __builtin_amdgcn_sched_barrier(0);
        bf16x8 kf[8];
#pragma unroll
        for (int d0 = 0; d0 < 4; ++d0) { kf[2 * d0] = *(const LAS bf16x8*)(kb + d0 * 2048); kf[2 * d0 + 1] = *(const LAS bf16x8*)(kb + d0 * 2048 + 512); }
        asm volatile("s_waitcnt lgkmcnt(0)" ::: "memory"); __builtin_amdgcn_sched_barrier(0);
        if (j > 0) SB_LOAD_K(j - 1);
        f32x16 p0, p1;
#pragma unroll
        for (int r = 0; r < 16; ++r) { p0[r] = 0.f; p1[r] = 0.f; }
#pragma unroll
        for (int d0 = 0; d0 < 4; ++d0) { p0 = __builtin_amdgcn_mfma_f32_32x32x16_bf16(kf[2 * d0], qr[d0], p0, 0, 0, 0); p1 = __builtin_amdgcn_mfma_f32_32x32x16_bf16(kf[2 * d0 + 1], qr[d0], p1, 0, 0, 0); }
        const bool diag = (j == jd); const int kbase = 64 * j + 4 * hi;
#pragma unroll
        for (int r = 0; r < 16; ++r) { const int k0 = kbase + (r & 3) + 8 * (r >> 2);
            float e0 = __builtin_amdgcn_exp2f(p0[r]), e1 = __builtin_amdgcn_exp2f(p1[r]);
            float r0 = __builtin_amdgcn_rcpf(1.0f + e0), r1 = __builtin_amdgcn_rcpf(1.0f + e1);
            if (diag) { if (k0 >= qabs) r0 = 1.0f; if (k0 + 32 >= qabs) r1 = 1.0f; }
            p0[r] = r0; p1[r] = r1; }
        float sfx[8][3], A[8];
#pragma unroll
        for (int i = 0; i < 8; ++i) { const float x0 = (i < 4) ? p0[4 * i] : p1[4 * i - 16], x1 = (i < 4) ? p0[4 * i + 1] : p1[4 * i - 15], x2 = (i < 4) ? p0[4 * i + 2] : p1[4 * i - 14], x3 = (i < 4) ? p0[4 * i + 3] : p1[4 * i - 13];
            sfx[i][2] = x3; sfx[i][1] = x3 * x2; sfx[i][0] = sfx[i][1] * x1; A[i] = sfx[i][0] * x0; }
        float T = carry, E[8];
#pragma unroll
        for (int i = 7; i >= 0; --i) { const auto sw = __builtin_amdgcn_permlane32_swap(__float_as_uint(A[i]), __float_as_uint(A[i]), false, false);
            const float partner = hi ? __uint_as_float(sw[0]) : __uint_as_float(sw[1]);
            E[i] = hi ? T : T * partner; T = T * (A[i] * partner); }
        carry = T;
        unsigned pw[4][4];
#pragma unroll
        for (int i = 0; i < 8; ++i) { float w4[4];
#pragma unroll
            for (int jj = 0; jj < 4; ++jj) { const float rv = (i < 4) ? p0[4 * i + jj] : p1[4 * i - 16 + jj]; const float beta = 1.0f - rv;
                w4[jj] = beta * ((jj == 3) ? E[i] : E[i] * sfx[i][jj]); }
            pw[i >> 1][(i & 1) * 2] = pg8::cvt_pk_bf16(w4[0], w4[1]); pw[i >> 1][(i & 1) * 2 + 1] = pg8::cvt_pk_bf16(w4[2], w4[3]); }
        if (j > 0) asm volatile("s_waitcnt vmcnt(8)" ::: "memory"); else asm volatile("s_waitcnt vmcnt(0)" ::: "memory");
        __builtin_amdgcn_sched_barrier(0);
        bf16x8 vf[8];
#pragma unroll
        for (int d0 = 0; d0 < 2; ++d0)
#pragma unroll
            for (int ks = 0; ks < 4; ++ks) {
                const s16x4 lo = __builtin_bit_cast(s16x4, __builtin_amdgcn_ds_read_tr16_b64_v4i16((LAS s16x4*)(vb + d0 * 4096 + ks * 1024)));
                const s16x4 hh = __builtin_bit_cast(s16x4, __builtin_amdgcn_ds_read_tr16_b64_v4i16((LAS s16x4*)(vb + d0 * 4096 + ks * 1024 + 512)));
                vf[d0 * 4 + ks] = (bf16x8){lo[0], lo[1], lo[2], lo[3], hh[0], hh[1], hh[2], hh[3]}; }
        asm volatile("s_waitcnt lgkmcnt(0)" ::: "memory"); __builtin_amdgcn_sched_barrier(0);
        const bool more = (j > 0) && __any(carry != 0.0f);
        if (more) SB_LOAD_V(j - 1);
#pragma unroll
        for (int d0 = 0; d0 < 2; ++d0)
#pragma unroll
            for (int ks = 0; ks < 4; ++ks) { const bf16x8 pa = __builtin_bit_cast(bf16x8, (u32x4){pw[ks][0], pw[ks][1], pw[ks][2], pw[ks][3]});
                o[d0] = __builtin_amdgcn_mfma_f32_32x32x16_bf16(pa, vf[d0 * 4 + ks], o[d0], 0, 0, 0); }
        if (!more) break;
    }
    asm volatile("s_waitcnt vmcnt(0)" ::: "memory");
    LAS bf16_t* stg = (LAS bf16_t*)wl;
#pragma unroll
    for (int r = 0; r < 16; ++r) { const int orow = crow(r, hi);
#pragma unroll
        for (int d0 = 0; d0 < 2; ++d0) stg[orow * 64 + d0 * 32 + r32] = (bf16_t)f2bf(o[d0][r]); }
    LDS_WAIT();
    bf16_t* Ow = MIXED + (rowbase + q0) * D + h * HD;
#pragma unroll
    for (int i = 0; i < 4; ++i) { const int row = i * 8 + (lane >> 3), ch = lane & 7; const u32x4 v = *(const LAS u32x4*)(stg + row * 64 + ch * 8);
        pg8::st16<2>(Ow + (size_t)row * D + ch * 8, v); float q = 0.f;
#pragma unroll
        for (int k = 0; k < 4; ++k) { const float a = __builtin_bit_cast(float, v[k] << 16), c = __builtin_bit_cast(float, v[k] & 0xffff0000u); q += a * a + c * c; }
        q += __shfl_xor(q, 1); q += __shfl_xor(q, 2); q += __shfl_xor(q, 4);
        if (ch == 0) ssq_add(SSQSB + rowbase + q0 + row, q); }
    LDS_WAIT();
#undef SB_LOAD_K
#undef SB_LOAD_V
}

constexpr int PL_PITCH = 1040, PL_PART_OFF = 83968;
__device__ __forceinline__ void pool_unit(int tile, const bf16_t* QKVU, bf16_t* MIXED, LAS unsigned char* shm, int wid, int lane) {
    const int tok0 = tile * 64, tpos0 = tok0 & (S - 1); const int tid = wid * 64 + lane;
    { u32x4 v[10];
#pragma unroll
      for (int i = 0; i < 10; ++i) { const int c = tid + i * NWAVES * 64; const int row = c >> 6, ch = c & 63; const int t = tpos0 - 15 + row;
          v[i] = (u32x4){0u, 0u, 0u, 0u}; if (c < 79 * 64 && t >= 0) v[i] = *(const u32x4*)(QKVU + (size_t)(tok0 - 15 + row) * INP + 3 * SBW + ch * 8); }
#pragma unroll
      for (int i = 0; i < 10; ++i) { const int c = tid + i * NWAVES * 64; const int row = c >> 6, ch = c & 63; if (c < 79 * 64) *(LAS u32x4*)(shm + row * PL_PITCH + ch * 16) = v[i]; } }
    LDS_WAIT(); __syncthreads();
    const int win = 2 << (wid >> 1); const int tp1 = tpos0 + lane + 1; const int n = tp1 < win ? tp1 : win; const float inv = 1.0f / (float)n;
    const LAS unsigned char* up = shm + (15 + lane) * PL_PITCH + wid * 128;
    float o[64]; float q = 0.f;
#pragma unroll
    for (int ch = 0; ch < 8; ++ch) { float s[8];
#pragma unroll
        for (int k = 0; k < 8; ++k) s[k] = 0.f;
        for (int jw = 0; jw < win; ++jw) { const u32x4 v = *(const LAS u32x4*)(up + ch * 16 - jw * PL_PITCH);
#pragma unroll
            for (int k = 0; k < 4; ++k) { s[2 * k] += __builtin_bit_cast(float, v[k] << 16); s[2 * k + 1] += __builtin_bit_cast(float, v[k] & 0xffff0000u); } }
        const u32x4 self = *(const LAS u32x4*)(up + ch * 16);
#pragma unroll
        for (int k = 0; k < 4; ++k) { const float a = s[2 * k] * inv - __builtin_bit_cast(float, self[k] << 16), c = s[2 * k + 1] * inv - __builtin_bit_cast(float, self[k] & 0xffff0000u);
            o[ch * 8 + 2 * k] = a; o[ch * 8 + 2 * k + 1] = c; q += a * a + c * c; } }
    LAS float* part = (LAS float*)(shm + PL_PART_OFF);
    part[wid * 64 + lane] = q;
    LDS_WAIT(); __syncthreads();
    float tot = 0.f;
#pragma unroll
    for (int w = 0; w < 8; ++w) tot += part[w * 64 + lane];
    const float rs = 1.0f / sqrtf(tot * (1.0f / PW) + EPS);
    LAS unsigned char* op = shm + lane * PL_PITCH + wid * 128;
#pragma unroll
    for (int ch = 0; ch < 8; ++ch) { u32x4 w;
#pragma unroll
        for (int k = 0; k < 4; ++k) w[k] = pg8::cvt_pk_bf16(o[ch * 8 + 2 * k] * rs, o[ch * 8 + 2 * k + 1] * rs);
        *(LAS u32x4*)(op + ch * 16) = w; }
    LDS_WAIT(); __syncthreads();
#pragma unroll
    for (int i = 0; i < 8; ++i) { const int c = tid + i * NWAVES * 64; const int row = c >> 6, ch = c & 63;
        pg8::st16<3>(MIXED + (size_t)(tok0 + row) * D + SBW + ch * 8, (u32x4)*(const LAS u32x4*)(shm + row * PL_PITCH + ch * 16)); }
    LDS_WAIT(); __syncthreads();
}
__device__ __forceinline__ void p2_mix(const Args& a, LAS unsigned char* lds, int bx, int G, int wid, int lane, ssq_t* SSQSB, int which = 3, int pstop = 9, bf16_t* pool_dst = nullptr, volatile LAS unsigned* stp = nullptr) {
    unsigned char* ws = a.ws; const bf16_t* QKVU = (const bf16_t*)(ws + WS_QKVU); bf16_t* MIXED = (bf16_t*)(ws + WS_MIXED);
    constexpr int NA = B * NH * (S / 256);
    if (which & 1) for (int i = 0; i * G + bx < NA; ++i) { const int w = pg8::xcd_remap(i * G + bx, NA); const int bh = w >> 4, qb = w & 15;
        sb_item(bh >> 3, bh & 7, qb * 8 + wid, QKVU, MIXED, SSQSB, lds + RING_OFF + wid * 16384, lane); }
    __syncthreads();
    if (which & 2) for (int t = bx; t < NTOK / 64; t += G) pool_unit(t, QKVU, pool_dst ? pool_dst : MIXED, lds + RING_OFF, wid, lane);
}
constexpr size_t BAR_REGION_OFF = 1 * MiB, BAR_REGION_STRIDE = 16 * 1024;
__global__ void __launch_bounds__(NWAVES * 64, 2) mega(Args args) {
    const int li = args.li;
    extern __shared__ __attribute__((aligned(16))) unsigned char lds_raw[];
    LAS unsigned char* lds = (LAS unsigned char*)lds_raw;
    volatile LAS unsigned* MISC = (volatile LAS unsigned*)(lds + MISC_OFF);
    const int wave = __builtin_amdgcn_readfirstlane((int)threadIdx.x >> 6);
#define LANE_ID() ({ int l_; asm volatile("v_mbcnt_lo_u32_b32 %0, -1, 0\n\tv_mbcnt_hi_u32_b32 %0, -1, %0" : "=v"(l_)); l_; })
    const int G = gridDim.x; const int bx = blockIdx.x; const int vcu = (G % 8 == 0) ? (bx % 8) * (G / 8) + bx / 8 : bx;
    for (int u = wave * 64 + LANE_ID(); u < MISC_BYTES / 4; u += NWAVES * 64) MISC[u] = 0u;
    __syncthreads();
    unsigned char* ws = args.ws;
    XcdBarrier bar = xcd_barrier_post((unsigned*)(ws + BAR_REGION_OFF + (size_t)li * BAR_REGION_STRIDE), MISC + 8);
    const int lo = args.ph_lo, hi = args.ph_hi;
    LAS unsigned char* ring = lds + RING_OFF; LAS unsigned char* epi = lds + EPI_OFF; LAS unsigned* gtab = (LAS unsigned*)(lds + GTAB_OFF);
#ifndef TIME_PHASE
#define TIME_PHASE -1
#endif
#define REP_OF(k) ((TIME_PHASE == (k)) ? 2 : 1)
#define REPE_OF(k) ((TIME_PHASE == 20 + (k)) ? 2 : 1)
#define IN(k) (lo <= (k) && (k) < hi)
#ifndef TSK
#define TSK -1
#endif
#ifndef TSCALE
#define TSCALE 1.0f
#endif
#define STAMP(i) do { if (TSK >= 0 && wave == 0) { const unsigned long long t_ = __builtin_amdgcn_s_memrealtime(); MISC[128 + 2 * (i)] = (unsigned)t_; MISC[129 + 2 * (i)] = (unsigned)(t_ >> 32); } } while (0)
#define SEAM(k) do { if (IN(k) && IN((k) + 1)) xcd_barrier(bar); STAMP((k) + 1); } while (0)
    STAMP(0);
    if (IN(0)) { p0_prologue(args, lds, vcu, G, wave, LANE_ID()); if (TIME_PHASE == 0) { xcd_barrier(bar); p0_prologue(args, lds, vcu, G, wave, LANE_ID()); } SEAM(0); }
    if (IN(1)) { SchedP1 S{G, bx, ws}; pg8::EpiBf16S E; pg8::gemm_phase<pg8::EpiBf16S, SchedP1, 0, REP_OF(1), REPE_OF(1)>(wave, ring, epi, gtab, D * 2, D * 2, D / 64, S, E); SEAM(1); }
    {
    const float* xin0 = args.in[0]; float* outp = args.out;
    bf16_t* S0p = (bf16_t*)(ws + WS_S0); ssq_t* SSQSBp = (ssq_t*)(ws + MK_SSQSB); ssq_t* SSQ1p = (ssq_t*)(ws + MK_SSQ1); ssq_t* SSQ2p = (ssq_t*)(ws + MK_SSQ2);
    constexpr size_t TSTEP = (size_t)256 * D * 2;
    #if !defined(PH_ONLY) || PH_ONLY == 2
    if (IN(2)) { if (TIME_PHASE == 42) { p2_mix(args, lds, bx, G, wave, LANE_ID(), (ssq_t*)(ws + 1280 * 1024), 2); xcd_barrier(bar); p2_mix(args, lds, bx, G, wave, LANE_ID(), (ssq_t*)(ws + 1280 * 1024), 2); xcd_barrier(bar); }
    if (TIME_PHASE == 2 || TIME_PHASE == 40 || TIME_PHASE == 41) { p2_mix(args, lds, bx, G, wave, LANE_ID(), (ssq_t*)(ws + 1280 * 1024), TIME_PHASE == 40 ? 1 : (TIME_PHASE == 41 ? 2 : 3)); xcd_barrier(bar); } STAMP(20); p2_mix(args, lds, bx, G, wave, LANE_ID(), (ssq_t*)(ws + MK_SSQSB), 1); STAMP(21); p2_mix(args, lds, bx, G, wave, LANE_ID(), (ssq_t*)(ws + MK_SSQSB), 2, 9, nullptr, (TSK >= 30 && bx == 0) ? MISC + 128 + 60 : nullptr); STAMP(22); SEAM(2); STAMP(23); }
#endif

#if !defined(PH_ONLY) || PH_ONLY == 3
    if (IN(3)) { SchedReg S{G, bx, NTOK / 256, D / 256, (const char*)(ws + WS_MIXED), (const char*)(ws + WS_WOUT), TSTEP, TSTEP, nullptr, D, nullptr, nullptr};
        EpiResid<8, false, true> E{xin0, S0p, ws + WS_X1F8, SSQ1p, SSQSBp, 1.0f}; pg8::gemm_phase<EpiResid<8, false, true>, SchedReg, 0, REP_OF(3)>(wave, ring, epi, gtab, D * 2, D * 2, D / 64, S, E); SEAM(3); }
#endif
#if !defined(PH_ONLY) || PH_ONLY == 4
    if (IN(4)) { SchedReg S{G, bx, NTOK / 256, D / 256, (const char*)(ws + WS_X1F8), (const char*)(ws + WS_WQ), TSTEP / 2, TSTEP / 2, (bf16_t*)(ws + WS_QM), D, nullptr, nullptr, SSQ1p};
        EpiBf16Ssq E{1.0f / D, C2_MEM / WSCALE}; pg8::gemm_phase<EpiBf16Ssq, SchedReg, 0, REP_OF(4), 1, true>(wave, ring, epi, gtab, D, D, D / 128, S, E); SEAM(4); }
#endif
#if !defined(PH_ONLY) || PH_ONLY == 5
    if (IN(5)) { SchedMS S{G, bx, ws}; EpiSoftmax E; pg8::gemm_phase<EpiSoftmax, SchedMS, 0, REP_OF(5)>(wave, ring, epi, gtab, D * 2, D * 2, MHD / 64, S, E); SEAM(5); }
#endif
#if !defined(PH_ONLY) || PH_ONLY == 6
    if (IN(6)) { SchedPV S{G, bx, ws}; pg8::EpiBf16S E; pg8::gemm_phase<pg8::EpiBf16S, SchedPV, 0, REP_OF(6)>(wave, ring, epi, gtab, D * 2, NMEM * 2, NMEM / 64, S, E); SEAM(6); }
#endif
#if !defined(PH_ONLY) || PH_ONLY == 7
    if (IN(7)) { SchedReg S{G, bx, NTOK / 256, D / 256, (const char*)(ws + WS_OM), (const char*)(ws + WS_WO), TSTEP, TSTEP, nullptr, D, nullptr, nullptr};
        EpiResid<-1, true, true> E{nullptr, S0p, ws + WS_X2F8, SSQ2p, nullptr, 1.0f}; pg8::gemm_phase<EpiResid<-1, true, true>, SchedReg, 0, REP_OF(7)>(wave, ring, epi, gtab, D * 2, D * 2, D / 64, S, E); SEAM(7); }
#endif
#if !defined(PH_ONLY) || PH_ONLY == 8
    if (IN(8)) { if (TIME_PHASE == 8) { p8_route(args, lds, bx, G, wave, LANE_ID(), (int*)(ws + 1536 * 1024)); xcd_barrier(bar); } p8_route(args, lds, bx, G, wave, LANE_ID(), (int*)(ws + OFF_CNT)); SEAM(8); }
#endif
#if !defined(PH_ONLY) || PH_ONLY == 9
    if (IN(9)) { moe_table(args, MISC, wave * 64 + LANE_ID()); SchedMoE<8, true> S{G, bx, ws, MISC, args.in[18]}; EpiSwiGLU E{ws + WS_ACT};
        pg8::gemm_phase<EpiSwiGLU, SchedMoE<8, true>, 1, REP_OF(9), REPE_OF(9), true>(wave, ring, epi, gtab, D, D, D / 128, S, E); SEAM(9); }
#endif
#if !defined(PH_ONLY) || PH_ONLY == 10
    if (IN(10)) { moe_table(args, MISC, wave * 64 + LANE_ID()); SchedMoE<4, false> S{G, bx, ws, MISC, args.in[20]}; EpiW2 E{ws + WS_Y};
        pg8::gemm_phase<EpiW2, SchedMoE<4, false>, 2, REP_OF(10), REPE_OF(10), true>(wave, ring, epi, gtab, DFF, DFF, DFF / 128, S, E); SEAM(10); }
#endif
#if !defined(PH_ONLY) || PH_ONLY == 11
    if (IN(11)) { if (TIME_PHASE == 11) { p11_final(args, vcu, G, wave, LANE_ID(), (float*)(ws + WS_ACT)); xcd_barrier(bar); } p11_final(args, vcu, G, wave, LANE_ID(), args.out); }
#endif
}

    if (TSK >= 100) { __syncthreads(); float* dbg = (float*)(ws + 1792 * 1024);
        if (wave == 0 && LANE_ID() == 0) { const int a_ = (TSK >= 200) ? 21 : 20; const unsigned long long t0 = ((unsigned long long)MISC[129 + 2 * a_] << 32) | MISC[128 + 2 * a_], t1 = ((unsigned long long)MISC[131 + 2 * a_] << 32) | MISC[130 + 2 * a_];
            __hip_atomic_store(dbg + bx, (float)(t1 - t0) * 0.01f, __ATOMIC_RELAXED, __HIP_MEMORY_SCOPE_AGENT); }
        xcd_barrier(bar);
        if (bx == 0 && wave == 0) { const int l_ = LANE_ID(); float mx = 0.f, mn = 1e9f; for (int q = l_; q < G; q += 64) { const float v = __hip_atomic_load(dbg + q, __ATOMIC_RELAXED, __HIP_MEMORY_SCOPE_AGENT); mx = fmaxf(mx, v); mn = fminf(mn, v); }
            for (int o_ = 1; o_ < 64; o_ <<= 1) { mx = fmaxf(mx, __shfl_xor(mx, o_)); mn = fminf(mn, __shfl_xor(mn, o_)); }
            if (l_ == 0) { asm volatile("s_waitcnt vmcnt(0)" ::: "memory"); args.out[0] = ((TSK % 100) == 0 ? mx : mn) * TSCALE; } } }
    else if (TSK >= 0) { STAMP(12); __syncthreads(); if (bx == 0 && wave == 0 && LANE_ID() == 0) { asm volatile("s_waitcnt vmcnt(0)" ::: "memory");
        const unsigned long long t0 = ((unsigned long long)MISC[129 + 2 * TSK] << 32) | MISC[128 + 2 * TSK], t1 = ((unsigned long long)MISC[131 + 2 * TSK] << 32) | MISC[130 + 2 * TSK];
        args.out[0] = (float)(t1 - t0) * 0.01f * TSCALE; } }
    if (TIME_PHASE == 12) { for (int q = 0; q < 10; ++q) xcd_barrier(bar); }
#undef IN
#undef SEAM
}
}

#ifndef MEGA_MASK
#define MEGA_MASK 0xFFF
#endif
extern "C" void kernel_launch(void* const* d_in, const int* in_sizes, int n_in, void* d_out, int out_size, void* d_ws, size_t ws_size, hipStream_t stream) {
    if (n_in != 22 || out_size != NTOK * D || ws_size < WS_END) { fprintf(stderr, "kernel_launch: unexpected shapes (n_in %d out %d ws %zu)\n", n_in, out_size, ws_size); return; }
    static int grid = 0;
    if (grid == 0) {
        int dev = 0, cus = 0;
        if (hipGetDevice(&dev) != hipSuccess || hipDeviceGetAttribute(&cus, hipDeviceAttributeMultiprocessorCount, dev) != hipSuccess) { grid = -1; return; }
        if (hipFuncSetAttribute((const void*)mk::mega, hipFuncAttributeMaxDynamicSharedMemorySize, mk::LDS_BYTES) != hipSuccess) { fprintf(stderr, "kernel_launch: hipFuncSetAttribute failed\n"); grid = -1; return; }
        int per_cu = 0; (void)hipOccupancyMaxActiveBlocksPerMultiprocessor(&per_cu, (const void*)mk::mega, mk::NWAVES * 64, mk::LDS_BYTES); (void)hipGetLastError();
        if (per_cu < 1) fprintf(stderr, "kernel_launch: occupancy query reports %d blocks per CU\n", per_cu);
        grid = cus;
    }
    if (grid < 0) return;
    const float* x = (const float*)d_in[0]; const float* mem = (const float*)d_in[1]; const float* g_mix = (const float*)d_in[2]; const float* w_in = (const float*)d_in[3];
    const float* g_sb = (const float*)d_in[4]; const float* g_pool = (const float*)d_in[5]; const float* w_pool = (const float*)d_in[6]; const float* pool_scale = (const float*)d_in[7];
    const float* w_out = (const float*)d_in[8]; const float* g_mem_q = (const float*)d_in[9]; const float* g_mem_kv = (const float*)d_in[10]; const float* w_mem_q = (const float*)d_in[11];
    const float* w_mem_kv = (const float*)d_in[12]; const float* w_mem_o = (const float*)d_in[13]; const float* g_ffn = (const float*)d_in[14]; const float* w_router = (const float*)d_in[15];
    const float* b_router = (const float*)d_in[16]; const float* w_e_in = (const float*)d_in[17]; const float* b_e_in = (const float*)d_in[18]; const float* w_e_out = (const float*)d_in[19];
    const float* b_e_out = (const float*)d_in[20]; const float* g_final = (const float*)d_in[21];
    float* out = (float*)d_out; unsigned char* ws = (unsigned char*)d_ws;
    bf16_t* WIN = (bf16_t*)(ws + WS_WIN); bf16_t* WOUT = (bf16_t*)(ws + WS_WOUT); bf16_t* WQ = (bf16_t*)(ws + WS_WQ); bf16_t* WKV = (bf16_t*)(ws + WS_WKV); bf16_t* WO = (bf16_t*)(ws + WS_WO);
    bf16_t* WP = (bf16_t*)(ws + WS_WP); float* WR = (float*)(ws + WS_WR); float* RSTDX = (float*)(ws + WS_RSTDX); float* RSTDM = (float*)(ws + WS_RSTDM);
    bf16_t* W1 = (bf16_t*)(ws + WS_W1); bf16_t* W2 = (bf16_t*)(ws + WS_W2); bf16_t* S0 = (bf16_t*)(ws + WS_S0); bf16_t* QKVU = (bf16_t*)(ws + WS_QKVU);
    bf16_t* QM = (bf16_t*)(ws + WS_QM); bf16_t* OM = (bf16_t*)(ws + WS_OM); bf16_t* MIXED = (bf16_t*)(ws + WS_MIXED); bf16_t* PM = (bf16_t*)(ws + WS_PM); bf16_t* ACT = (bf16_t*)(ws + WS_ACT);
    bf16_t* KM = (bf16_t*)(ws + WS_KM); bf16_t* VMT = (bf16_t*)(ws + WS_VMT); bf16_t* MEMB = (bf16_t*)(ws + WS_MEMB); int* LSLOT = (int*)(ws + WS_LSLOT); float* LGATE = (float*)(ws + WS_LGATE);
    bf16_t* Y = (bf16_t*)(ws + WS_Y); float* SCR_S = (float*)(ws + WS_SCR_S); bf16_t* POOLED = (bf16_t*)(ws + WS_SCR_POOLED); float* POOLO = (float*)(ws + WS_SCR_POOLO);
    int* CNT = (int*)(ws + OFF_CNT); float* SSQSB = (float*)(ws + OFF_SSQSB); float* SSQ1 = (float*)(ws + OFF_SSQ1); float* SSQ2 = (float*)(ws + OFF_SSQ2);

    (void)hipMemsetAsync(ws + WS_CTL, 0, CTL_BYTES, stream);
    mk::Args a{}; for (int i = 0; i < 22; ++i) a.in[i] = (const float*)d_in[i]; a.out = out; a.ws = ws;
    const dim3 tb(32, 8); const int BIG = 1 << 30; int li = 0;
    for (int p = 0; p < mk::NPHASE;) {
        if ((MEGA_MASK >> p) & 1) { int q = p; while (q < mk::NPHASE && ((MEGA_MASK >> q) & 1)) ++q;
            a.ph_lo = p; a.ph_hi = q; a.li = li; hipLaunchKernelGGL(mk::mega, dim3(grid), dim3(mk::NWAVES * 64), mk::LDS_BYTES, stream, a); ++li; p = q; continue; }
        switch (p) {
        case 0:
            nv::k_cvt_w<<<dim3(INP / 32, D / 32, 1), tb, 0, stream>>>(w_in, D, INP, WIN, INP, g_mix, nullptr, BIG, nullptr, 0, 0);
            nv::k_cvt_w<<<dim3(D / 32, D / 32, 1), tb, 0, stream>>>(w_out, D, D, WOUT, D, g_sb, g_pool, SBW, nullptr, 0, 0);
            nv::k_cvt_w<<<dim3(D / 32, D / 32, 1), tb, 0, stream>>>(w_mem_q, D, D, WQ, D, g_mem_q, nullptr, BIG, nullptr, 0, 0);
            nv::k_cvt_w<<<dim3(2 * D / 32, D / 32, 1), tb, 0, stream>>>(w_mem_kv, D, 2 * D, WKV, 2 * D, g_mem_kv, nullptr, BIG, nullptr, 0, 0);
            nv::k_cvt_w<<<dim3(D / 32, D / 32, 1), tb, 0, stream>>>(w_mem_o, D, D, WO, D, nullptr, nullptr, BIG, nullptr, 0, 0);
            nv::k_cvt_w<<<dim3(2 * DFF / 32, D / 32, NE), tb, 0, stream>>>(w_e_in, D, 2 * DFF, W1, 2 * DFF, g_ffn, nullptr, BIG, nullptr, 0, 1);
            nv::k_cvt_w<<<dim3(D / 32, DFF / 32, NE), tb, 0, stream>>>(w_e_out, DFF, D, W2, D, nullptr, nullptr, BIG, nullptr, 0, 0);
            nv::k_cvt_w<<<dim3(PGD / 32, PGD / 32, PG), tb, 0, stream>>>(w_pool, PGD, PGD, WP, PGD, nullptr, nullptr, BIG, pool_scale, PGD, 0);
            nv::k_cvt_router<<<NE * D / 256, 256, 0, stream>>>(w_router, g_ffn, WR);
            nv::k_rowstat_cvt<<<NTOK / 4, 256, 0, stream>>>(x, S0, RSTDX, NTOK);
            nv::k_rowstat_cvt<<<NMROWS / 4, 256, 0, stream>>>(mem, MEMB, RSTDM, NMROWS);
            break;
        case 1:
            nv::k_g1<<<dim3(INP / 64, NTOK / 64), 256, 0, stream>>>(S0, WIN, RSTDX, QKVU);
            nv::k_g1b<<<dim3(2 * D / 64, NMROWS / 64), 256, 0, stream>>>(MEMB, WKV, RSTDM, KM, VMT);
            break;
        case 2:
            nv::k_sb<<<B * NH * S / 256, 256, 0, stream>>>(QKVU, MIXED, SSQSB);
            nv::k_pool1<<<(unsigned)((size_t)NTOK * PW / 256), 256, 0, stream>>>(QKVU, POOLED);
            nv::k_pool2<<<dim3(PGD / 64, NTOK / 64, PG), 256, 0, stream>>>(POOLED, WP, POOLO);
            nv::k_pool3<<<NTOK / 4, 256, 0, stream>>>(POOLO, MIXED);
            break;
        case 3: nv::k_resid<<<dim3(D / 64, NTOK / 64), 256, 0, stream>>>(MIXED, WOUT, x, out, S0, SSQ1, SSQSB, SBW); break;
        case 4: nv::k_g3<<<dim3(D / 64, NTOK / 64), 256, 0, stream>>>(S0, WQ, SSQ1, QM); break;
        case 5:
            nv::k_ms<<<dim3(NMEM / 64, NTOK / 64, MH), 256, 0, stream>>>(QM, KM, SCR_S);
            nv::k_msoftmax<<<NTOK * MH / 4, 256, 0, stream>>>(SCR_S, PM);
            break;
        case 6: nv::k_mpv<<<dim3(MHD / 64, NTOK / 64, MH), 256, 0, stream>>>(PM, VMT, OM); break;
        case 7: nv::k_resid<<<dim3(D / 64, NTOK / 64), 256, 0, stream>>>(OM, WO, out, out, S0, SSQ2, SSQ2, -1); break;
        case 8: nv::k_route<<<NTOK / 4, 256, 0, stream>>>(out, SSQ2, WR, b_router, CNT, LSLOT, LGATE); break;
        case 9: nv::k_w1<<<dim3(DFF / 32, LCAP / 64, NE), 256, 0, stream>>>(S0, SSQ2, W1, b_e_in, CNT, LSLOT, ACT); break;
        case 10: nv::k_w2<<<dim3(D / 64, LCAP / 64, NE), 256, 0, stream>>>(ACT, W2, b_e_out, CNT, LSLOT, LGATE, Y); break;
        case 11: nv::k_final<<<NTOK / 4, 256, 0, stream>>>(out, Y, g_final); break;
        }
        ++p;
    }
}
```

```cpp
#include <hip/hip_runtime.h>
#include <cstdio>
#include <cstdint>

typedef unsigned short bf16_t;
typedef short bf16x8 __attribute__((ext_vector_type(8)));
typedef float f32x4 __attribute__((ext_vector_type(4)));
typedef unsigned u32x4 __attribute__((ext_vector_type(4)));

namespace cfg {
constexpr int B = 8, S = 4096, D = 1024, NTOK = B * S;
constexpr int SBW = 512, NH = 8, HD = 64, PW = 512, PG = 4, PGD = 128, INP = 2048;
constexpr int NMEM = 256, MH = 4, MHD = 256, NMROWS = B * NMEM;
constexpr int NE = 32, TOPK = 4, DFF = 1024, LCAP = NTOK;
constexpr float EPS = 1e-5f, LOG2E = 1.4426950408889634f;
constexpr float C2_SB = 0.125f * LOG2E, C2_MEM = 0.0625f * LOG2E;
constexpr float SW_LIMIT = 7.0f, SW_ALPHA = 1.702f;
constexpr int MAXTILES = 544;
constexpr size_t MiB = 1u << 20;
constexpr size_t WS_CTL = 0, CTL_BYTES = 2 * MiB;
constexpr size_t OFF_CNT = 64 * 1024, OFF_SSQSB = 512 * 1024, OFF_SSQ1 = 640 * 1024, OFF_SSQ2 = 768 * 1024;
constexpr size_t WS_WIN = 2 * MiB, WS_WOUT = 6 * MiB, WS_WQ = 8 * MiB, WS_WKV = 10 * MiB, WS_WO = 14 * MiB, WS_WP = 16 * MiB, WS_WR = 17 * MiB;
constexpr size_t WS_RSTDX = 18 * MiB, WS_RSTDM = 18 * MiB + 512 * 1024;
constexpr size_t WS_W1 = 20 * MiB, WS_W2 = 148 * MiB;
constexpr size_t WS_S0 = 212 * MiB;
constexpr size_t WS_QKVU = 276 * MiB;
constexpr size_t WS_QM = 276 * MiB, WS_OM = 340 * MiB;
constexpr size_t WS_MIXED = 404 * MiB;
constexpr size_t WS_PM = 404 * MiB;
constexpr size_t WS_ACT = 276 * MiB;
constexpr size_t WS_KM = 548 * MiB, WS_VMT = 552 * MiB, WS_MEMB = 556 * MiB, WS_LSLOT = 560 * MiB, WS_LGATE = 564 * MiB;
constexpr size_t WS_Y = 568 * MiB;
constexpr size_t WS_SCR_S = 568 * MiB, WS_SCR_POOLED = 696 * MiB, WS_SCR_POOLO = 728 * MiB;
constexpr size_t WS_END = 824 * MiB;
}
using namespace cfg;

__device__ __forceinline__ unsigned f2bf(float f) { unsigned u = __builtin_bit_cast(unsigned, f); return (u + 0x7fffu + ((u >> 16) & 1u)) >> 16; }
__device__ __forceinline__ float bf2f(bf16_t h) { return __builtin_bit_cast(float, (unsigned)h << 16); }
__device__ __forceinline__ float wave_sum(float v) {
#pragma unroll
    for (int o = 1; o < 64; o <<= 1) v += __shfl_xor(v, o);
    return v;
}

namespace nv {
__global__ void k_cvt_w(const float* src, int K, int N, bf16_t* dst, int ND, const float* gk, const float* gk2, int ksplit, const float* gn, int gnz, int mode) {
    __shared__ float t[32][33];
    const int nd0 = blockIdx.x * 32, k0 = blockIdx.y * 32, z = blockIdx.z;
    int ns0 = nd0;
    if (mode == 1) { const int pn = nd0 >> 8, j = nd0 & 255; ns0 = (j < 128) ? 128 * pn + j : 1024 + 128 * pn + (j - 128); }
    src += (size_t)z * K * N; dst += (size_t)z * ND * K;
    for (int i = threadIdx.y; i < 32; i += 8) { const int k = k0 + i, n = ns0 + threadIdx.x;
        float v = src[(size_t)k * N + n]; if (gk) v *= (k < ksplit) ? gk[k] : gk2[k - ksplit]; if (gn) v *= gn[z * gnz + n]; t[i][threadIdx.x] = v; }
    __syncthreads();
    for (int i = threadIdx.y; i < 32; i += 8) dst[(size_t)(nd0 + i) * K + k0 + threadIdx.x] = (bf16_t)f2bf(t[threadIdx.x][i]);
}
__global__ void k_cvt_router(const float* wr, const float* g, float* dst) {
    const int i = blockIdx.x * 256 + threadIdx.x; if (i >= NE * D) return; const int e = i / D, k = i % D; dst[i] = g[k] * wr[k * NE + e];
}
__global__ void k_rowstat_cvt(const float* x, bf16_t* xb, float* rstd, int rows) {
    const int row = blockIdx.x * 4 + (threadIdx.x >> 6), lane = threadIdx.x & 63; if (row >= rows) return;
    const float* xr = x + (size_t)row * D; float s = 0.f;
    for (int j = lane; j < D; j += 64) { const float v = xr[j]; s += v * v; xb[(size_t)row * D + j] = (bf16_t)f2bf(v); }
    s = wave_sum(s); if (lane == 0) rstd[row] = 1.0f / sqrtf(s * (1.0f / D) + EPS);
}

template <class RA, class RB, class MID, class EPI>
__device__ __forceinline__ void wave_gemm(int m0, int n0, int K, int kmid, RA ra, RB rb, MID mid, EPI epi) {
    const int lane = threadIdx.x & 63, r16 = lane & 15, kq = lane >> 4;
    const bf16_t* pa[2]; const bf16_t* pb[2];
#pragma unroll
    for (int i = 0; i < 2; ++i) { pa[i] = ra(m0 + i * 16 + r16) + kq * 8; pb[i] = rb(n0 + i * 16 + r16) + kq * 8; }
    f32x4 acc[2][2];
#pragma unroll
    for (int i = 0; i < 2; ++i)
#pragma unroll
        for (int j = 0; j < 2; ++j) acc[i][j] = (f32x4){0.f, 0.f, 0.f, 0.f};
    for (int k = 0; k < K; k += 32) {
        if (k == kmid) {
#pragma unroll
            for (int i = 0; i < 2; ++i)
#pragma unroll
                for (int r = 0; r < 4; ++r) { const float s = mid(m0 + i * 16 + kq * 4 + r); acc[i][0][r] *= s; acc[i][1][r] *= s; }
        }
        bf16x8 a[2], b[2];
#pragma unroll
        for (int i = 0; i < 2; ++i) { a[i] = *(const bf16x8*)(pa[i] + k); b[i] = *(const bf16x8*)(pb[i] + k); }
#pragma unroll
        for (int i = 0; i < 2; ++i)
#pragma unroll
            for (int j = 0; j < 2; ++j) acc[i][j] = __builtin_amdgcn_mfma_f32_16x16x32_bf16(a[i], b[j], acc[i][j], 0, 0, 0);
    }
#pragma unroll
    for (int i = 0; i < 2; ++i)
#pragma unroll
        for (int r = 0; r < 4; ++r) epi(m0 + i * 16 + kq * 4 + r, n0 + r16, n0 + 16 + r16, acc[i][0][r], acc[i][1][r]);
}
struct NoMid { __device__ float operator()(int) const { return 1.f; } };

#define NV_TILE() const int w = threadIdx.x >> 6, m0 = blockIdx.y * 64 + (w >> 1) * 32, n0 = blockIdx.x * 64 + (w & 1) * 32

__global__ void k_g1(const bf16_t* XB, const bf16_t* WT, const float* rstd, bf16_t* QKVU) {
    NV_TILE();
    wave_gemm(m0, n0, D, -1, [=](int r) { return XB + (size_t)r * D; }, [=](int c) { return WT + (size_t)c * D; }, NoMid(),
        [=](int r, int c0, int c1, float v0, float v1) { const float s = rstd[r];
            v0 *= s; v1 *= s; if (c0 < SBW) v0 *= C2_SB; if (c1 < SBW) v1 *= C2_SB;
            QKVU[(size_t)r * INP + c0] = (bf16_t)f2bf(v0); QKVU[(size_t)r * INP + c1] = (bf16_t)f2bf(v1); });
}
__global__ void k_g1b(const bf16_t* MEMB, const bf16_t* WT, const float* rstd, bf16_t* KM, bf16_t* VMT) {
    NV_TILE();
    wave_gemm(m0, n0, D, -1, [=](int r) { return MEMB + (size_t)r * D; }, [=](int c) { return WT + (size_t)c * D; }, NoMid(),
        [=](int r, int c0, int c1, float v0, float v1) { const float s = rstd[r]; const int cc[2] = {c0, c1}; const float vv[2] = {v0 * s, v1 * s};
#pragma unroll
            for (int q = 0; q < 2; ++q) { const int c = cc[q];
                if (c < D) KM[(size_t)r * D + c] = (bf16_t)f2bf(vv[q]);
                else VMT[((size_t)(r >> 8) * D + (c - D)) * NMEM + (r & 255)] = (bf16_t)f2bf(vv[q]); } });
}
__global__ void __launch_bounds__(256) k_sb(const bf16_t* QKVU, bf16_t* MIXED, float* SSQSB) {
    const int gid = blockIdx.x * 256 + threadIdx.x; const int t = gid & (S - 1), h = (gid >> 12) & 7, b = gid >> 15;
    const bf16_t* base = QKVU + (size_t)b * S * INP;
    float q[HD], o[HD];
    { const bf16_t* qp = base + (size_t)t * INP + h * HD;
#pragma unroll
      for (int d = 0; d < HD; ++d) { q[d] = bf2f(qp[d]); o[d] = 0.f; } }
    float P = 1.f;
    for (int s = t - 1; s >= 0; --s) {
        const bf16_t* kp = base + (size_t)s * INP + SBW + h * HD; const bf16_t* vp = kp + SBW;
        float z = 0.f;
#pragma unroll
        for (int d = 0; d < HD; ++d) z += q[d] * bf2f(kp[d]);
        const float e = exp2f(z), r = 1.0f / (1.0f + e), beta = 1.0f - r;
        const float w = bf2f((bf16_t)f2bf(beta * P));
#pragma unroll
        for (int d = 0; d < HD; ++d) o[d] += w * bf2f(vp[d]);
        P *= r;
        if (P == 0.f) break;
    }
    float ss = 0.f; bf16_t* op = MIXED + (size_t)(b * S + t) * D + h * HD;
#pragma unroll
    for (int d = 0; d < HD; ++d) { ss += o[d] * o[d]; op[d] = (bf16_t)f2bf(o[d]); }
    unsafeAtomicAdd(SSQSB + b * S + t, ss);
}
__global__ void k_pool1(const bf16_t* QKVU, bf16_t* POOLED) {
    const size_t gid = (size_t)blockIdx.x * 256 + threadIdx.x; const int c = gid & 511; const int tok = (int)(gid >> 9), t = tok & (S - 1);
    const int win = 2 << (c >> 7); const int n = (t + 1 < win) ? t + 1 : win;
    const bf16_t* up = QKVU + (size_t)tok * INP + 3 * SBW + c; float s = 0.f;
    for (int j = 0; j < n; ++j) s += bf2f(up[-(ptrdiff_t)j * INP]);
    POOLED[gid] = (bf16_t)f2bf(s / (float)n - bf2f(up[0]));
}
__global__ void k_pool2(const bf16_t* POOLED, const bf16_t* WPT, float* POOLO) {
    NV_TILE(); const int g = blockIdx.z;
    wave_gemm(m0, n0, PGD, -1, [=](int r) { return POOLED + (size_t)r * PW + g * PGD; }, [=](int c) { return WPT + ((size_t)g * PGD + c) * PGD; }, NoMid(),
        [=](int r, int c0, int c1, float v0, float v1) { POOLO[(size_t)r * PW + g * PGD + c0] = v0; POOLO[(size_t)r * PW + g * PGD + c1] = v1; });
}
__global__ void k_pool3(const float* POOLO, bf16_t* MIXED) {
    const int tok = blockIdx.x * 4 + (threadIdx.x >> 6), lane = threadIdx.x & 63;
    float v[8], s = 0.f;
#pragma unroll
    for (int j = 0; j < 8; ++j) { v[j] = POOLO[(size_t)tok * PW + lane + 64 * j]; s += v[j] * v[j]; }
    const float rs = 1.0f / sqrtf(wave_sum(s) * (1.0f / PW) + EPS);
#pragma unroll
    for (int j = 0; j < 8; ++j) MIXED[(size_t)tok * D + SBW + lane + 64 * j] = (bf16_t)f2bf(v[j] * rs);
}
__global__ void k_resid(const bf16_t* A, const bf16_t* WT, const float* xin, float* xout, bf16_t* XB, float* SSQ, const float* ssq_mid, int kmid) {
    NV_TILE();
    wave_gemm(m0, n0, D, kmid, [=](int r) { return A + (size_t)r * D; }, [=](int c) { return WT + (size_t)c * D; },
        [=](int r) { return 1.0f / sqrtf(ssq_mid[r] * (1.0f / SBW) + EPS); },
        [=](int r, int c0, int c1, float v0, float v1) {
            const float x0 = xin[(size_t)r * D + c0] + v0, x1 = xin[(size_t)r * D + c1] + v1;
            xout[(size_t)r * D + c0] = x0; xout[(size_t)r * D + c1] = x1;
            XB[(size_t)r * D + c0] = (bf16_t)f2bf(x0); XB[(size_t)r * D + c1] = (bf16_t)f2bf(x1);
            float q = x0 * x0 + x1 * x1; q += __shfl_xor(q, 1); q += __shfl_xor(q, 2); q += __shfl_xor(q, 4); q += __shfl_xor(q, 8);
            if ((threadIdx.x & 15) == 0) unsafeAtomicAdd(SSQ + r, q); });
}
__global__ void k_g3(const bf16_t* X1B, const bf16_t* WT, const float* SSQ1, bf16_t* QM) {
    NV_TILE();
    wave_gemm(m0, n0, D, -1, [=](int r) { return X1B + (size_t)r * D; }, [=](int c) { return WT + (size_t)c * D; }, NoMid(),
        [=](int r, int c0, int c1, float v0, float v1) { const float s = C2_MEM / sqrtf(SSQ1[r] * (1.0f / D) + EPS);
            QM[(size_t)r * D + c0] = (bf16_t)f2bf(v0 * s); QM[(size_t)r * D + c1] = (bf16_t)f2bf(v1 * s); });
}
__global__ void k_ms(const bf16_t* QM, const bf16_t* KM, float* SCR) {
    NV_TILE(); const int h = blockIdx.z; const int b = m0 >> 12;
    wave_gemm(m0, n0, MHD, -1, [=](int r) { return QM + (size_t)r * D + h * MHD; }, [=](int c) { return KM + ((size_t)b * NMEM + c) * D + h * MHD; }, NoMid(),
        [=](int r, int c0, int c1, float v0, float v1) { SCR[((size_t)r * MH + h) * NMEM + c0] = v0; SCR[((size_t)r * MH + h) * NMEM + c1] = v1; });
}
__global__ void k_msoftmax(const float* SCR, bf16_t* PM) {
    const int row = blockIdx.x * 4 + (threadIdx.x >> 6), lane = threadIdx.x & 63;
    float v[4], m = -INFINITY;
#pragma unroll
    for (int j = 0; j < 4; ++j) { v[j] = SCR[(size_t)row * NMEM + lane + 64 * j]; m = fmaxf(m, v[j]); }
#pragma unroll
    for (int o = 1; o < 64; o <<= 1) m = fmaxf(m, __shfl_xor(m, o));
    float s = 0.f;
#pragma unroll
    for (int j = 0; j < 4; ++j) { v[j] = exp2f(v[j] - m); s += v[j]; }
    s = 1.0f / wave_sum(s);
#pragma unroll
    for (int j = 0; j < 4; ++j) PM[(size_t)row * NMEM + lane + 64 * j] = (bf16_t)f2bf(v[j] * s);
}
__global__ void k_mpv(const bf16_t* PM, const bf16_t* VMT, bf16_t* OM) {
    NV_TILE(); const int h = blockIdx.z; const int b = m0 >> 12;
    wave_gemm(m0, n0, NMEM, -1, [=](int r) { return PM + ((size_t)r * MH + h) * NMEM; }, [=](int c) { return VMT + ((size_t)b * D + h * MHD + c) * NMEM; }, NoMid(),
        [=](int r, int c0, int c1, float v0, float v1) { OM[(size_t)r * D + h * MHD + c0] = (bf16_t)f2bf(v0); OM[(size_t)r * D + h * MHD + c1] = (bf16_t)f2bf(v1); });
}
__global__ void k_route(const float* x2, const float* SSQ2, const float* WR, const float* br, int* CNT, int* LSLOT, float* LGATE) {
    const int tok = blockIdx.x * 4 + (threadIdx.x >> 6), lane = threadIdx.x & 63;
    float xv[16];
#pragma unroll
    for (int j = 0; j < 16; ++j) xv[j] = x2[(size_t)tok * D + lane + 64 * j];
    const float rs = 1.0f / sqrtf(SSQ2[tok] * (1.0f / D) + EPS);
    float mine = 0.f;
    for (int e = 0; e < NE; ++e) { float s = 0.f;
#pragma unroll
        for (int j = 0; j < 16; ++j) s += xv[j] * WR[e * D + lane + 64 * j];
        s = wave_sum(s); if (lane == e) mine = s * rs + br[e]; }
    float tv[4]; int ti[4]; float cur = (lane < NE) ? mine : -INFINITY;
#pragma unroll
    for (int k = 0; k < 4; ++k) { float m = cur; int mi = lane;
#pragma unroll
        for (int o = 1; o < 64; o <<= 1) { const float om = __shfl_xor(m, o); const int oi = __shfl_xor(mi, o); if (om > m || (om == m && oi < mi)) { m = om; mi = oi; } }
        tv[k] = m; ti[k] = mi; if (lane == mi) cur = -INFINITY; }
    float g[4], gs = 0.f;
#pragma unroll
    for (int k = 0; k < 4; ++k) { g[k] = expf(tv[k] - tv[0]); gs += g[k]; }
    if (lane < 4) { int e = ti[0]; float gg = g[0];
        if (lane == 1) { e = ti[1]; gg = g[1]; } if (lane == 2) { e = ti[2]; gg = g[2]; } if (lane == 3) { e = ti[3]; gg = g[3]; }
        const int pos = atomicAdd(CNT + e, 1); LSLOT[(size_t)e * LCAP + pos] = tok * 4 + lane; LGATE[(size_t)e * LCAP + pos] = gg / gs; }
}
__device__ __forceinline__ int tile_base(const int* CNT, int e) { int tb = 0; for (int i = 0; i < e; ++i) tb += (CNT[i] + 255) >> 8; return tb; }
__global__ void k_w1(const bf16_t* X2B, const float* SSQ2, const bf16_t* W1T, const float* b1, const int* CNT, const int* LSLOT, bf16_t* ACT) {
    const int e = blockIdx.z, cnt = CNT[e]; const int w = threadIdx.x >> 6; const int m0 = blockIdx.y * 64 + (w >> 1) * 32; if (blockIdx.y * 64 >= cnt) return;
    const int gc0 = blockIdx.x * 32 + (w & 1) * 16;
    const int pn = gc0 >> 7, j0 = gc0 & 127; const int n0 = pn * 256 + j0;
    const int tb = tile_base(CNT, e); const bf16_t* Wt = W1T + (size_t)e * 2 * DFF * D; const int* ls = LSLOT + (size_t)e * LCAP;
    wave_gemm(m0, 0, D, -1, [=](int r) { const int tok = (r < cnt) ? (ls[r] >> 2) : 0; return X2B + (size_t)tok * D; },
        [=](int c) { const int rowb = (c < 16) ? n0 + c : n0 + 128 + (c - 16); return Wt + (size_t)rowb * D; }, NoMid(),
        [=](int r, int c0, int c1, float vg, float vu) { if (r >= cnt) return; const int tok = ls[r] >> 2; const float rs = 1.0f / sqrtf(SSQ2[tok] * (1.0f / D) + EPS);
            const int gc = gc0 + c0;
            float gate = vg * rs + b1[e * 2 * DFF + gc], up = vu * rs + b1[e * 2 * DFF + DFF + gc];
            gate = fminf(gate, SW_LIMIT); up = fminf(fmaxf(up, -SW_LIMIT), SW_LIMIT);
            const float act = (up + 1.0f) * gate / (1.0f + expf(-SW_ALPHA * gate));
            ACT[((size_t)tb * 256 + r) * DFF + gc] = (bf16_t)f2bf(act); (void)c1; });
}
__global__ void k_w2(const bf16_t* ACT, const bf16_t* W2T, const float* b2, const int* CNT, const int* LSLOT, const float* LGATE, bf16_t* Y) {
    const int e = blockIdx.z, cnt = CNT[e]; if (blockIdx.y * 64 >= cnt) return; NV_TILE();
    const int tb = tile_base(CNT, e); const bf16_t* Wt = W2T + (size_t)e * D * DFF; const int* ls = LSLOT + (size_t)e * LCAP; const float* lg = LGATE + (size_t)e * LCAP;
    wave_gemm(m0, n0, DFF, -1, [=](int r) { return ACT + ((size_t)tb * 256 + r) * DFF; }, [=](int c) { return Wt + (size_t)c * DFF; }, NoMid(),
        [=](int r, int c0, int c1, float v0, float v1) { if (r >= cnt) return; const int slot = ls[r]; const float g = lg[r];
            Y[(size_t)slot * D + c0] = (bf16_t)f2bf((v0 + b2[e * D + c0]) * g); Y[(size_t)slot * D + c1] = (bf16_t)f2bf((v1 + b2[e * D + c1]) * g); });
}
__global__ void k_final(float* out, const bf16_t* Y, const float* gf) {
    const int tok = blockIdx.x * 4 + (threadIdx.x >> 6), lane = threadIdx.x & 63;
    float v[16], s = 0.f;
#pragma unroll
    for (int j = 0; j < 16; ++j) { const int c = lane + 64 * j; float a = out[(size_t)tok * D + c];
#pragma unroll
        for (int k = 0; k < 4; ++k) a += bf2f(Y[((size_t)tok * 4 + k) * D + c]);
        v[j] = a; s += a * a; }
    const float rs = 1.0f / sqrtf(wave_sum(s) * (1.0f / D) + EPS);
#pragma unroll
    for (int j = 0; j < 16; ++j) { const int c = lane + 64 * j; out[(size_t)tok * D + c] = v[j] * rs * gf[c]; }
}
}

#define LAS __attribute__((address_space(3)))
#define GAS __attribute__((address_space(1)))
typedef int v4i_t __attribute__((ext_vector_type(4)));
typedef int v8i_t __attribute__((ext_vector_type(8)));
namespace pg8 {
constexpr int BM = 256, BK = 64, HALF = 128, HTB = HALF * BK * 2, STAGE_BYTES = 8 * HTB, NXCD = 8, WGM = 8;
__host__ __device__ __forceinline__ int lds_byte(int r, int c) { const int st = (r >> 4) * 2 + (c >> 5), rr = r & 15, cc = c & 31, ob = rr * 64 + cc * 2; return st * 1024 + (ob ^ (((ob >> 9) & 1) << 5)); }
__host__ __device__ __forceinline__ void stage_rc(int b, int& R, int& C) { const int st = b / 1024, sb = b % 1024, swz = sb ^ (((sb >> 9) & 1) << 5); R = (st >> 1) * 16 + swz / 64; C = (st & 1) * 32 + (swz % 64) / 2; }
__host__ __device__ __forceinline__ int perm32(int rho) { const int n = rho >> 4, i = rho & 15; return 8 * (i >> 2) + 4 * n + (i & 3); }
__device__ __forceinline__ unsigned cvt_pk_bf16(float lo, float hi) { unsigned r; asm volatile("v_cvt_pk_bf16_f32 %0, %1, %2" : "=v"(r) : "v"(lo), "v"(hi)); return r; }

#define WTMASK 0x008
#ifndef WTMASK
#define WTMASK 0x1ff
#endif
#define WT_ON(bit) (((WTMASK) >> (bit)) & 1)
__device__ __forceinline__ void st16_wt(void* p, u32x4 v) { asm volatile("global_store_dwordx4 %0, %1, off sc1\n\ts_nop 1" :: "v"(p), "v"(v)); }
__device__ __forceinline__ void st16_wt(void* p, f32x4 v) { asm volatile("global_store_dwordx4 %0, %1, off sc1\n\ts_nop 1" :: "v"(p), "v"(v)); }
template <int BIT, class V> __device__ __forceinline__ void st16(void* p, V v) { if constexpr (WT_ON(BIT)) st16_wt(p, v); else *(V*)p = v; }
#ifndef WT8
#define WT8 0
#endif
__device__ __forceinline__ void st8_wt(void* p, unsigned long long v) { if (WT8) __hip_atomic_store((unsigned long long*)p, v, __ATOMIC_RELAXED, __HIP_MEMORY_SCOPE_AGENT); else *(unsigned long long*)p = v; }
__device__ __forceinline__ void st4_wt(void* p, unsigned v) { if (WT8) __hip_atomic_store((unsigned*)p, v, __ATOMIC_RELAXED, __HIP_MEMORY_SCOPE_AGENT); else *(unsigned*)p = v; }
__device__ __forceinline__ int fresh_lane() { int l; asm volatile("v_mbcnt_lo_u32_b32 %0, -1, 0\n\tv_mbcnt_hi_u32_b32 %0, -1, %0" : "=v"(l)); return l; }
struct Unit { const char* A; const char* B; void* p0; void* p1; void* p2; void* p3; int pm, pn, i0, i1, ghost; };

__device__ __forceinline__ int xcd_remap(int L, int nwg) { const int q = nwg / NXCD, r = nwg % NXCD, xcd = L % NXCD, off = L / NXCD; return __builtin_amdgcn_readfirstlane((xcd < r ? xcd * (q + 1) : r * (q + 1) + (xcd - r) * q) + off); }
__device__ __forceinline__ void grouped_mn(int wgid, int nM, int nN, int& pm, int& pn) {
    const int nig = WGM * nN, gid = wgid / nig, fm = gid * WGM, gsz = (nM - fm) < WGM ? (nM - fm) : WGM; pm = __builtin_amdgcn_readfirstlane(fm + ((wgid % nig) % gsz)); pn = __builtin_amdgcn_readfirstlane((wgid % nig) / gsz); }

template <class Epi, class Sched, int TABS, int REP = 1, int REPE = 1, bool F8 = false>
__device__ __forceinline__ void gemm_phase(const int wid, LAS unsigned char* lds, LAS unsigned char* epi_lds, LAS unsigned* gtab, const int lda_b, const int ldb_b, const int nt, const Sched& S, const Epi& E) {
    constexpr bool GATHER = (TABS == 1);
    const int wr = wid >> 2, wc = wid & 3;
    unsigned voffA, voffB, voffG[2][2]; int aoff, boff;
    { const int lane = fresh_lane(); int R, C; stage_rc(wid * 1024 + lane * 16, R, C); const int Rb = Epi::PERM ? ((R & ~31) + perm32(R & 31)) : R;
      voffA = (unsigned)(R * lda_b + C * 2); voffB = (unsigned)(Rb * ldb_b + C * 2); voffG[0][0] = voffG[0][1] = voffG[1][0] = voffG[1][1] = 0;
      aoff = lds_byte(wr * 64 + (lane & 15), (lane >> 4) * 8); boff = lds_byte(wc * 32 + (lane & 15), (lane >> 4) * 8); }
    const size_t kstep = (size_t)(BK * 2);
    const size_t hstepA = (size_t)HALF * lda_b, hstepB = (size_t)HALF * ldb_b;
    const unsigned ldsw = (unsigned)wid * 1024u; const unsigned ldsbase = (unsigned)(uintptr_t)lds + ldsw;
#define PG8_SA(b, h) (((b) * 2 + (h)) * HTB)
#define PG8_SB(b, h) ((4 + (b) * 2 + (h)) * HTB)
#define PG8_GLDS(ugp, voff, bufoff, _i) do { unsigned _keep; asm volatile("s_mov_b32 %0, m0\n\ts_mov_b32 m0, %3\n\ts_nop 0\n\tglobal_load_lds_dwordx4 %1, %2\n\ts_mov_b32 m0, %0" \
        : "=&s"(_keep) : "v"(voff), "s"((const char*)(ugp)), "s"(ldsbase + (unsigned)((bufoff) + (_i) * 8192)) : "memory"); } while (0)
#define PG8_STAGE_B(bufoff, gbase) do { _Pragma("unroll") for (int _i = 0; _i < 2; ++_i) PG8_GLDS((const char*)(gbase) + (size_t)_i * 64 * ldb_b, voffB, bufoff, _i); } while (0)
#define PG8_STAGE_A(bufoff, gbase, h) do { if constexpr (GATHER) { _Pragma("unroll") for (int _i = 0; _i < 2; ++_i) PG8_GLDS((const char*)(gbase), voffG[h][_i], bufoff, _i); } \
        else { _Pragma("unroll") for (int _i = 0; _i < 2; ++_i) PG8_GLDS((const char*)(gbase) + (h) * hstepA + (size_t)_i * 64 * lda_b, voffA, bufoff, _i); } } while (0)
#define PG8_LDA(dst, b, h) do { _Pragma("unroll") for (int m = 0; m < 4; ++m) _Pragma("unroll") for (int k = 0; k < 2; ++k) dst[m][k] = *(const LAS bf16x8*)(lds + PG8_SA(b, h) + aoff + m * 2048 + k * 1024); } while (0)
#define PG8_LDB(dst, b, h) do { _Pragma("unroll") for (int n = 0; n < 2; ++n) _Pragma("unroll") for (int k = 0; k < 2; ++k) dst[n][k] = *(const LAS bf16x8*)(lds + PG8_SB(b, h) + boff + n * 2048 + k * 1024); } while (0)
#define PG8_CAT(x0, x1) __builtin_shufflevector(__builtin_bit_cast(v4i_t, x0), __builtin_bit_cast(v4i_t, x1), 0, 1, 2, 3, 4, 5, 6, 7)
#define PG8_MMA(ai, bj, At, Bt) do { __builtin_amdgcn_s_setprio(1); _Pragma("unroll") for (int m = 0; m < 4; ++m) _Pragma("unroll") for (int n = 0; n < 2; ++n) { \
        if constexpr (F8) acc[ai][bj][m][n] = __builtin_amdgcn_mfma_scale_f32_16x16x128_f8f6f4(PG8_CAT(Bt[n][0], Bt[n][1]), PG8_CAT(At[m][0], At[m][1]), acc[ai][bj][m][n], 0, 0, 0, 0, 0, 0); \
        else { _Pragma("unroll") for (int k = 0; k < 2; ++k) acc[ai][bj][m][n] = __builtin_amdgcn_mfma_f32_16x16x32_bf16(Bt[n][k], At[m][k], acc[ai][bj][m][n], 0, 0, 0); } } __builtin_amdgcn_s_setprio(0); } while (0)
#define PG8_WAIT_V(n) asm volatile("s_waitcnt vmcnt(" #n ")" ::: "memory")
#define PG8_WAIT_L(n) asm volatile("s_waitcnt lgkmcnt(" #n ")" ::: "memory")
#define PG8_BAR __builtin_amdgcn_s_barrier()
#define PG8_SCHED __builtin_amdgcn_sched_barrier(0)
#define PG8_GTAB_LOAD(buf, nvalid) do { const int _l = fresh_lane(); int _R, _C; stage_rc(wid * 1024 + _l * 16, _R, _C); _Pragma("unroll") for (int _h = 0; _h < 2; ++_h) _Pragma("unroll") for (int _i = 0; _i < 2; ++_i) { \
        const int _row = _h * HALF + _R + 64 * _i; const unsigned _s = gtab[(buf) * 768 + _row]; voffG[_h][_i] = ((_row < (nvalid)) ? (_s >> 2) * (unsigned)lda_b : 0u) + (unsigned)(_C * 2); } } while (0)
#define PG8_GTAB_DMA(buf, U) do { if (wid < 3) { const int _l = fresh_lane(); const char* _src = (wid == 0) ? (const char*)(U).p3 + _l * 16 : (wid == 1) ? (const char*)(U).p2 + _l * 16 : \
            (TABS == 1 ? (const char*)(U).p1 + (_l & 31) * 16 + (_l >> 5) * (DFF * 4) : (const char*)(U).p1 + _l * 16); \
        __builtin_amdgcn_global_load_lds((const unsigned*)_src, (LAS unsigned*)(gtab + (buf) * 768 + wid * 256), 16, 0, 0); } } while (0)
    auto nextu = [&](int i, Unit& u) -> bool { if constexpr (REP > 1) { const bool ok = S.next(i / REP, u); u.ghost = (i % REP) != REP - 1; return ok; } else { u.ghost = 0; return S.next(i, u); } };
    Unit cur, nxt; int ui = 0;
    if (!nextu(0, cur)) return;
    f32x4 acc[2][2][4][2];
#pragma unroll
    for (int a = 0; a < 2; ++a)
#pragma unroll
        for (int b = 0; b < 2; ++b)
#pragma unroll
            for (int m = 0; m < 4; ++m)
#pragma unroll
                for (int n = 0; n < 2; ++n) acc[a][b][m][n] = (f32x4){0.f, 0.f, 0.f, 0.f};
    bf16x8 At[4][2], B0[2][2], B1[2][2];
    const char* cA = cur.A; const char* cB = cur.B;
    if constexpr (TABS != 0) { PG8_GTAB_DMA(0, cur); PG8_WAIT_V(0); PG8_WAIT_L(0); PG8_BAR; if constexpr (GATHER) PG8_GTAB_LOAD(0, cur.i0); }
    PG8_STAGE_B(PG8_SB(0, 0), cB); PG8_STAGE_B(PG8_SB(0, 1), cB + hstepB); PG8_STAGE_A(PG8_SA(0, 0), cA, 0); PG8_STAGE_A(PG8_SA(0, 1), cA, 1);
    if (wr == 1) PG8_BAR;
    PG8_WAIT_V(2); PG8_BAR;
    PG8_STAGE_B(PG8_SB(1, 0), cB + kstep); PG8_STAGE_A(PG8_SA(1, 0), cA + kstep, 0); PG8_STAGE_B(PG8_SB(1, 1), cB + hstepB + kstep);
    PG8_WAIT_V(6); PG8_BAR;
    for (;;) {
        const bool has_next = nextu(ui + 1, nxt);
        const char* nA = has_next ? nxt.A : cA; const char* nB = has_next ? nxt.B : cB;
#pragma unroll 1
        for (int t = 0; t < nt; t += 2) {
            const bool last = (t == nt - 2);
            const char* a1 = cA + (size_t)(t + 1) * kstep;
            const char* a2 = last ? nA : cA + (size_t)(t + 2) * kstep; const char* b2 = last ? nB : cB + (size_t)(t + 2) * kstep;
            const char* a3 = a2 + kstep; const char* b3 = b2 + kstep;
            if constexpr (Epi::MIDK >= 0) { if (t == Epi::MIDK) E.midk(acc, cur, wr, fresh_lane() & 15); }
            if constexpr (TABS != 0) { if (t == 2 && has_next) PG8_GTAB_DMA((ui + 1) & 1, nxt); }
            if constexpr (GATHER) { PG8_STAGE_A(PG8_SA(1, 1), a1, 1); if (last && has_next) PG8_GTAB_LOAD((ui + 1) & 1, nxt.i0); PG8_SCHED; }
            PG8_LDB(B0, 0, 0); PG8_LDB(B1, 0, 1); PG8_SCHED; PG8_LDA(At, 0, 0); if constexpr (!GATHER) PG8_STAGE_A(PG8_SA(1, 1), a1, 1);
            PG8_WAIT_V(8); PG8_WAIT_L(0); PG8_BAR; PG8_MMA(0, 0, At, B0); PG8_MMA(0, 1, At, B1); PG8_BAR; PG8_SCHED;
            PG8_LDA(At, 0, 1); PG8_STAGE_B(PG8_SB(0, 0), b2); PG8_STAGE_B(PG8_SB(0, 1), b2 + hstepB); PG8_STAGE_A(PG8_SA(0, 0), a2, 0);
            PG8_WAIT_V(8); PG8_WAIT_L(0); PG8_BAR; PG8_MMA(1, 0, At, B0); PG8_MMA(1, 1, At, B1); PG8_BAR; PG8_SCHED;
            PG8_LDB(B0, 1, 0); PG8_LDB(B1, 1, 1); PG8_SCHED; PG8_LDA(At, 1, 0); PG8_STAGE_A(PG8_SA(0, 1), a2, 1);
            PG8_WAIT_V(8); PG8_WAIT_L(0); PG8_BAR; PG8_MMA(0, 0, At, B0); PG8_MMA(0, 1, At, B1); PG8_BAR; PG8_SCHED;
            PG8_LDA(At, 1, 1); PG8_STAGE_B(PG8_SB(1, 0), b3); PG8_STAGE_B(PG8_SB(1, 1), b3 + hstepB); PG8_STAGE_A(PG8_SA(1, 0), a3, 0);
            PG8_WAIT_V(8); PG8_WAIT_L(0); PG8_BAR; PG8_MMA(1, 0, At, B0); PG8_MMA(1, 1, At, B1); PG8_BAR; PG8_SCHED;
        }
        if (wr == 0) PG8_BAR;
        if (!cur.ghost) { const int el = fresh_lane(); LAS unsigned char* ex = (TABS != 0) ? (LAS unsigned char*)(gtab + (ui & 1) * 768) : epi_lds; E(acc, cur, wr, wc, el & 15, el >> 4, wid, el, ex); if constexpr (REPE > 1) { asm volatile("" ::: "memory"); E(acc, cur, wr, wc, el & 15, el >> 4, wid, el, ex); } }
        if (!has_next) break;
#pragma unroll
        for (int a = 0; a < 2; ++a)
#pragma unroll
            for (int b = 0; b < 2; ++b)
#pragma unroll
                for (int m = 0; m < 4; ++m)
#pragma unroll
                    for (int n = 0; n < 2; ++n) acc[a][b][m][n] = (f32x4){0.f, 0.f, 0.f, 0.f};
        cur = nxt; cA = nA; cB = nB; ++ui;
        if (wr == 1) PG8_BAR;
    }
    PG8_WAIT_V(0);
    PG8_BAR;
#undef PG8_SA
#undef PG8_SB
#undef PG8_GLDS
#undef PG8_STAGE_A
#undef PG8_STAGE_B
#undef PG8_LDA
#undef PG8_LDB
#undef PG8_MMA
#undef PG8_CAT
#undef PG8_WAIT_V
#undef PG8_WAIT_L
#undef PG8_BAR
#undef PG8_SCHED
#undef PG8_GTAB_LOAD
#undef PG8_GTAB_DMA
}

template <bool F8O> struct EpiBf16SX {
    static constexpr bool PERM = true; static constexpr int MIDK = -1;
    __device__ __forceinline__ void midk(f32x4 (&)[2][2][4][2], const Unit&, int, int) const {}
    __device__ __forceinline__ void operator()(const f32x4 (&acc)[2][2][4][2], const Unit& u, int wr, int wc, int fr, int fq, int, int, LAS unsigned char*) const {
        bf16_t* O = (bf16_t*)u.p0; unsigned char* O8 = (unsigned char*)u.p0; const float* rs = (const float*)u.p1; const float* cs = (const float*)u.p2; const int ldc = u.i0;
        int r0 = wr * 64 + fr, c0 = wc * 32 + 8 * fq; asm volatile("" : "+v"(r0), "+v"(c0));
        f32x4 cv[2][2];
#pragma unroll
        for (int bj = 0; bj < 2; ++bj)
#pragma unroll
            for (int n = 0; n < 2; ++n) cv[bj][n] = cs ? *(const f32x4*)(cs + c0 + bj * HALF + 4 * n) : (f32x4){1.f, 1.f, 1.f, 1.f};
#pragma unroll
        for (int ai = 0; ai < 2; ++ai)
#pragma unroll
            for (int m = 0; m < 4; ++m) { const int r = r0 + ai * HALF + m * 16; const float rv = rs ? rs[r] : 1.f; bf16_t* rowp = O + (size_t)r * ldc + c0;
#pragma unroll
                for (int bj = 0; bj < 2; ++bj) { const f32x4 v0 = acc[ai][bj][m][0] * cv[bj][0] * rv, v1 = acc[ai][bj][m][1] * cv[bj][1] * rv;
                    if constexpr (F8O) { int w0 = __builtin_amdgcn_cvt_pk_fp8_f32(v0[0], v0[1], 0, false); w0 = __builtin_amdgcn_cvt_pk_fp8_f32(v0[2], v0[3], w0, true); int w1 = __builtin_amdgcn_cvt_pk_fp8_f32(v1[0], v1[1], 0, false); w1 = __builtin_amdgcn_cvt_pk_fp8_f32(v1[2], v1[3], w1, true);
                        st8_wt(O8 + (size_t)r * ldc + c0 + bj * HALF, (unsigned long long)(unsigned)w0 | ((unsigned long long)(unsigned)w1 << 32)); }
                    else { u32x4 w; w.x = cvt_pk_bf16(v0[0], v0[1]); w.y = cvt_pk_bf16(v0[2], v0[3]); w.z = cvt_pk_bf16(v1[0], v1[1]); w.w = cvt_pk_bf16(v1[2], v1[3]);
                    st16<1>(rowp + bj * HALF, w); } } }
    }
};
typedef EpiBf16SX<false> EpiBf16S;
}

namespace mk {
constexpr int NWAVES = 8, NPHASE = 12;
constexpr int RING_OFF = 0, RING_BYTES = 131072, EPI_OFF = 131072, EPI_BYTES = 8192, GTAB_OFF = EPI_OFF + EPI_BYTES, GTAB_BYTES = 6144, MISC_OFF = GTAB_OFF + GTAB_BYTES, MISC_BYTES = 1024;
constexpr int LDS_BYTES = 147456;
static_assert(MISC_OFF + MISC_BYTES <= LDS_BYTES, "LDS map");
constexpr size_t WS_LRS = 84 * MiB;
constexpr size_t WS_X2F8 = WS_Y, WS_X1F8 = WS_Y + 32 * MiB;
constexpr size_t WS_CSG1 = 19 * MiB, WS_WRH = 19 * MiB + 64 * 1024, WS_WRL = 19 * MiB + 128 * 1024;
typedef unsigned ssq_t;
constexpr size_t MK_SSQSB = 256 * 1024, MK_SSQ1 = 512 * 1024, MK_SSQ2 = 768 * 1024;
__device__ __forceinline__ void ssq_add(ssq_t* p, float q) { (void)__hip_atomic_fetch_add(p, (ssq_t)__float2uint_rn(q * 16384.0f), __ATOMIC_RELAXED, __HIP_MEMORY_SCOPE_AGENT); }
__device__ __forceinline__ float ssq_get(const ssq_t* p) { return (float)(*p) * (1.0f / 16384.0f); }
constexpr float WSCALE = 32.0f;
constexpr int CW_BAR = 1024;

#define RLX_AGENT __ATOMIC_RELAXED, __HIP_MEMORY_SCOPE_AGENT
#define LDS_WAIT() asm volatile("s_waitcnt lgkmcnt(0)" ::: "memory")
#define VM_WAIT() asm volatile("s_waitcnt vmcnt(0)" ::: "memory")
#define XB_TMO      128
#define XB_XCNT(j)  (256  + 64 * (j))
#define XB_XSUB(j)  (1280 + 64 * (j))
#define XB_XGEN(j)  (2304 + 64 * (j))
#define XB_TOP      3328
#define XB_TOPGEN   3392
#define XCD_BAR_WORDS 3456
#define XB_SPIN_CAP (1u << 20)
__device__ __forceinline__ unsigned xb_ld(unsigned* p)              { return __hip_atomic_load(p, __ATOMIC_RELAXED, __HIP_MEMORY_SCOPE_AGENT); }
__device__ __forceinline__ unsigned xb_add(unsigned* p, unsigned v) { return __hip_atomic_fetch_add(p, v, __ATOMIC_RELAXED, __HIP_MEMORY_SCOPE_AGENT); }
__device__ __forceinline__ unsigned xb_xcc_id() { return (unsigned)__builtin_amdgcn_s_getreg((3 << 11) | 20) & 0xFu; }
#define XB_SPIN(cond, bar) do { unsigned _sp = 0; while (cond) { __builtin_amdgcn_s_sleep(1); \
    if ((++_sp & 255u) == 0u) { if (xb_ld(&(bar)[XB_TMO])) break; if (_sp > XB_SPIN_CAP) { atomicAdd(&(bar)[XB_TMO], 1u); break; } } } } while (0)
struct XcdBarrier { unsigned* bar; unsigned x; volatile LAS unsigned* st; };
__device__ __forceinline__ XcdBarrier xcd_barrier_post(unsigned* bar, volatile LAS unsigned* st) {
    XcdBarrier b; b.bar = bar; b.x = xb_xcc_id(); b.st = st;
    if (threadIdx.x == 0) (void)xb_add(&bar[XB_XCNT(b.x)], 1u);
    return b;
}
__device__ __forceinline__ void xcd_barrier_complete(unsigned* bar, unsigned x, unsigned& nloc, unsigned& nx) {
    const unsigned G = gridDim.x * gridDim.y * gridDim.z;
    unsigned sum, cnt, mine, sp = 0u;
    for (;;) {
        sum = 0u; cnt = 0u; mine = 0u;
#pragma unroll
        for (unsigned j = 0; j < 16; ++j) { const unsigned c = xb_ld(&bar[XB_XCNT(j)]); sum += c; cnt += (c > 0u) ? 1u : 0u; mine = (j == x) ? c : mine; }
        if (sum == G) break;
        __builtin_amdgcn_s_sleep(1);
        if ((++sp & 255u) == 0u) { if (xb_ld(&bar[XB_TMO])) break; if (sp > XB_SPIN_CAP) { atomicAdd(&bar[XB_TMO], 1u); break; } }
    }
    nloc = mine > 0u ? mine : 1u; nx = cnt > 0u ? cnt : 1u;
}
__device__ __forceinline__ void xcd_barrier(const XcdBarrier& b) {
    asm volatile("s_waitcnt vmcnt(0)" ::: "memory");
    __syncthreads();
    if (threadIdx.x == 0) {
        unsigned* bar = b.bar;
        __builtin_amdgcn_s_waitcnt(0);
        unsigned nloc = b.st[0], nx = b.st[1];
        if (nloc == 0u) { xcd_barrier_complete(bar, b.x, nloc, nx); b.st[0] = nloc; b.st[1] = nx; }
        const unsigned old = xb_add(&bar[XB_XSUB(b.x)], 1u);
        const unsigned gen = old / nloc;
        if (old + 1u == (gen + 1u) * nloc) {
            __builtin_amdgcn_fence(__ATOMIC_RELEASE, "agent");
            asm volatile("s_waitcnt vmcnt(0)" ::: "memory");
            const unsigned og = xb_add(&bar[XB_TOP], 1u);
            const unsigned tg = og / nx;
            if (og + 1u == (tg + 1u) * nx) xb_add(&bar[XB_TOPGEN], 1u);
            else XB_SPIN(xb_ld(&bar[XB_TOPGEN]) == tg, bar);
            __builtin_amdgcn_fence(__ATOMIC_ACQUIRE, "agent");
            xb_add(&bar[XB_XGEN(b.x)], 1u);
            asm volatile("s_waitcnt vmcnt(0)" ::: "memory");
        } else {
            XB_SPIN(xb_ld(&bar[XB_XGEN(b.x)]) == gen, bar);
            __builtin_amdgcn_fence(__ATOMIC_ACQUIRE, "agent");
            asm volatile("s_waitcnt vmcnt(0)" ::: "memory");
        }
    }
    __syncthreads();
}

struct Args { const float* in[22]; float* out; unsigned char* ws; int ph_lo, ph_hi, li, pad; };

template <bool F8OUT>
__device__ __forceinline__ void p0_item(const float* W, int K, int N, void* WTv, const float* gk, const float* gk2, int ksplit, const float* gn, int mode, LAS float* scr, int item, int lane, float mult = 1.0f, int nblk_dec = 0) {
    const int nblk = nblk_dec ? nblk_dec : N / 32, kb = item / nblk, nb = item % nblk, k0 = 64 * kb, nd0 = 32 * nb;
    int ns0 = nd0; if (mode == 1) { const int pn = nd0 >> 8, j = nd0 & 255; ns0 = (j < 128) ? 128 * pn + j : 1024 + 128 * pn + (j - 128); }
    const int kr = lane >> 3, n4 = (lane & 7) * 4;
    f32x4 v[8];
#pragma unroll
    for (int i = 0; i < 8; ++i) v[i] = *(const f32x4*)(W + (size_t)(k0 + 8 * i + kr) * N + ns0 + n4);
    f32x4 gnv = (f32x4){1.f, 1.f, 1.f, 1.f}; if (gn) gnv = *(const f32x4*)(gn + ns0 + n4);
#pragma unroll
    for (int i = 0; i < 8; ++i) { const int kk = 8 * i + kr, k = k0 + kk; float g = 1.f; if (gk) g = (k < ksplit) ? gk[k] : gk2[k - ksplit];
        const f32x4 t = v[i] * gnv * (g * mult); LAS float* d = scr + kk * 33 + n4; d[0] = t[0]; d[1] = t[1]; d[2] = t[2]; d[3] = t[3]; }
    LDS_WAIT(); asm volatile("" ::: "memory");
    const int c = lane & 7;
#pragma unroll
    for (int j = 0; j < 4; ++j) { const int n = (lane >> 3) + 8 * j; const LAS float* s = scr + (8 * c) * 33 + n;
        if constexpr (F8OUT) { int lo = __builtin_amdgcn_cvt_pk_fp8_f32(s[0 * 33], s[1 * 33], 0, false); lo = __builtin_amdgcn_cvt_pk_fp8_f32(s[2 * 33], s[3 * 33], lo, true);
            int hi2 = __builtin_amdgcn_cvt_pk_fp8_f32(s[4 * 33], s[5 * 33], 0, false); hi2 = __builtin_amdgcn_cvt_pk_fp8_f32(s[6 * 33], s[7 * 33], hi2, true);
            pg8::st8_wt((unsigned char*)WTv + (size_t)(nd0 + n) * K + k0 + 8 * c, (unsigned long long)(unsigned)lo | ((unsigned long long)(unsigned)hi2 << 32)); }
        else { u32x4 o; o.x = pg8::cvt_pk_bf16(s[0 * 33], s[1 * 33]); o.y = pg8::cvt_pk_bf16(s[2 * 33], s[3 * 33]); o.z = pg8::cvt_pk_bf16(s[4 * 33], s[5 * 33]); o.w = pg8::cvt_pk_bf16(s[6 * 33], s[7 * 33]);
            pg8::st16<0>((bf16_t*)WTv + (size_t)(nd0 + n) * K + k0 + 8 * c, o); } }
    LDS_WAIT(); asm volatile("" ::: "memory");
}
__device__ __forceinline__ void p0_fused_pool_item(const float* w_in, const float* g_mix, const float* w_pool, const float* pool_scale, bf16_t* WIN_T, int item, int lane) {
    const int eb = item & 7, kb = (item >> 3) & 15, g = item >> 7; const int k = kb * 64 + lane, e0 = eb * 16;
    const float* ap = w_in + (size_t)k * INP + 3 * SBW + g * PGD; const float* bp = w_pool + (size_t)g * PGD * PGD + e0;
    float acc[16];
#pragma unroll
    for (int j = 0; j < 16; ++j) acc[j] = 0.f;
#pragma unroll 4
    for (int c = 0; c < PGD; ++c) { const float a = ap[c];
#pragma unroll
        for (int j = 0; j < 16; ++j) acc[j] += a * bp[c * PGD + j]; }
    const float gk = g_mix[k];
#pragma unroll
    for (int j = 0; j < 16; ++j) WIN_T[(size_t)(3 * SBW + g * PGD + e0 + j) * D + k] = (bf16_t)f2bf(acc[j] * gk * pool_scale[g * PGD + e0 + j]);
}
__device__ __forceinline__ void p0_row(const float* xrow, bf16_t* orow, float* rstd, int lane) {
    const f32x4* xr = (const f32x4*)xrow + 2 * lane; f32x4 v[4]; float s = 0.f;
#pragma unroll
    for (int j = 0; j < 4; ++j) { v[j] = xr[(j >> 1) * 128 + (j & 1)]; s += (v[j].x * v[j].x + v[j].y * v[j].y) + (v[j].z * v[j].z + v[j].w * v[j].w); }
    s = wave_sum(s); if (lane == 0) *rstd = 1.0f / sqrtf(s * (1.0f / D) + EPS);
#pragma unroll
    for (int j = 0; j < 2; ++j) { u32x4 o; o.x = pg8::cvt_pk_bf16(v[2 * j].x, v[2 * j].y); o.y = pg8::cvt_pk_bf16(v[2 * j].z, v[2 * j].w); o.z = pg8::cvt_pk_bf16(v[2 * j + 1].x, v[2 * j + 1].y); o.w = pg8::cvt_pk_bf16(v[2 * j + 1].z, v[2 * j + 1].w);
        pg8::st16<0>(orow + j * 512 + 8 * lane, o); }
}
__device__ __forceinline__ void p0_prologue(const Args& a, LAS unsigned char* lds, int vcu, int G, int wave, int lane) {
    unsigned char* ws = a.ws;
    LAS float* scr = (LAS float*)(lds + RING_OFF + wave * 16384);
    const int gw = vcu * NWAVES + wave, NGW = G * NWAVES;
    constexpr int I_E1 = (D / 64) * (2 * DFF / 32), I_E2 = (DFF / 64) * (D / 32);
    constexpr int I_IN = (D / 64) * (3 * SBW / 32), I_FP = PG * 16 * 8, I_SQ = (D / 64) * (D / 32), I_KV = (D / 64) * (2 * D / 32), I_P = (PGD / 64) * (PGD / 32);
    constexpr int N1 = NE * I_E1, N2 = NE * I_E2, NITEMS = N1 + N2 + I_IN + 3 * I_SQ + I_KV + I_FP;
    const int BIG = 1 << 30;
    for (int it = gw; it < NITEMS; it += NGW) {
        int r = it;
        if (r < N1) { const int e = r / I_E1; p0_item<true>(a.in[17] + (size_t)e * D * 2 * DFF, D, 2 * DFF, ws + WS_W1 + (size_t)e * 2 * DFF * D, a.in[14], nullptr, BIG, nullptr, 1, scr, r % I_E1, lane, WSCALE); continue; } r -= N1;
        if (r < N2) { const int e = r / I_E2; p0_item<true>(a.in[19] + (size_t)e * DFF * D, DFF, D, ws + WS_W2 + (size_t)e * D * DFF, nullptr, nullptr, BIG, nullptr, 0, scr, r % I_E2, lane, WSCALE); continue; } r -= N2;
        if (r < I_IN) { p0_item<false>(a.in[3], D, INP, (bf16_t*)(ws + WS_WIN), a.in[2], nullptr, BIG, nullptr, 0, scr, r, lane, 1.0f, 3 * SBW / 32); continue; } r -= I_IN;
        if (r < I_SQ) { p0_item<false>(a.in[8], D, D, (bf16_t*)(ws + WS_WOUT), a.in[4], a.in[5], SBW, nullptr, 0, scr, r, lane); continue; } r -= I_SQ;
        if (r < I_SQ) { p0_item<true>(a.in[11], D, D, ws + WS_WQ, a.in[9], nullptr, BIG, nullptr, 0, scr, r, lane, WSCALE); continue; } r -= I_SQ;
        if (r < I_KV) { p0_item<false>(a.in[12], D, 2 * D, (bf16_t*)(ws + WS_WKV), a.in[10], nullptr, BIG, nullptr, 0, scr, r, lane); continue; } r -= I_KV;
        if (r < I_SQ) { p0_item<false>(a.in[13], D, D, (bf16_t*)(ws + WS_WO), nullptr, nullptr, BIG, nullptr, 0, scr, r, lane); continue; } r -= I_SQ;
        p0_fused_pool_item(a.in[3], a.in[2], a.in[6], a.in[7], (bf16_t*)(ws + WS_WIN), r, lane);
    }
    for (int m = gw; m < NTOK; m += NGW) p0_row(a.in[0] + (size_t)m * D, (bf16_t*)(ws + WS_S0) + (size_t)m * D, (float*)(ws + WS_RSTDX) + m, lane);
    for (int m = gw; m < NMROWS; m += NGW) p0_row(a.in[1] + (size_t)m * D, (bf16_t*)(ws + WS_MEMB) + (size_t)m * D, (float*)(ws + WS_RSTDM) + m, lane);
    const int gt = gw * 64 + lane, NGT = NGW * 64;
    for (int i = gt; i < INP; i += NGT) ((float*)(ws + WS_CSG1))[i] = (i < SBW) ? C2_SB : 1.0f;
    for (int i = gt; i < NE * D; i += NGT) { const int e = i / D, k = i % D; const float v = a.in[14][k] * a.in[15][k * NE + e];
        ((float*)(ws + WS_WR))[i] = v; const unsigned h = f2bf(v); ((bf16_t*)(ws + WS_WRH))[i] = (bf16_t)h; ((bf16_t*)(ws + WS_WRL))[i] = (bf16_t)f2bf(v - bf2f((bf16_t)h)); }
}

struct SchedP1 {
    int G, c; unsigned char* ws;
    __device__ __forceinline__ bool next(int i, pg8::Unit& u) const {
        const int L = i * G + c; constexpr int NQ = (NTOK / 256) * (INP / 256);
        if (L >= NQ + 64) return false;
        if (L < NQ) { int pm, pn; pg8::grouped_mn(pg8::xcd_remap(L, NQ), NTOK / 256, INP / 256, pm, pn);
            u.A = (const char*)(ws + WS_S0) + (size_t)pm * 256 * D * 2; u.B = (const char*)(ws + WS_WIN) + (size_t)pn * 256 * D * 2;
            u.p0 = (bf16_t*)(ws + WS_QKVU) + (size_t)pm * 256 * INP + pn * 256; u.p1 = (float*)(ws + WS_RSTDX) + pm * 256; u.p2 = (float*)(ws + WS_CSG1) + pn * 256; u.i0 = INP; u.pm = pm; u.pn = pn; }
        else if (L < NQ + 32) { const int k = L - NQ, pm = k >> 2, pn = k & 3;
            u.A = (const char*)(ws + WS_MEMB) + (size_t)pm * 256 * D * 2; u.B = (const char*)(ws + WS_WKV) + (size_t)pn * 256 * D * 2;
            u.p0 = (bf16_t*)(ws + WS_KM) + (size_t)pm * 256 * D + pn * 256; u.p1 = (float*)(ws + WS_RSTDM) + pm * 256; u.p2 = nullptr; u.i0 = D; u.pm = pm; u.pn = pn; }
        else { const int v = L - NQ - 32, b = v >> 2, dt = v & 3;
            u.A = (const char*)(ws + WS_WKV) + (size_t)(D + dt * 256) * D * 2; u.B = (const char*)(ws + WS_MEMB) + (size_t)b * 256 * D * 2;
            u.p0 = (bf16_t*)(ws + WS_VMT) + ((size_t)b * D + dt * 256) * NMEM; u.p1 = nullptr; u.p2 = (float*)(ws + WS_RSTDM) + b * 256; u.i0 = NMEM; u.pm = dt; u.pn = b; }
        u.p3 = nullptr; u.i1 = 0; return true;
    }
};
#define EPI_BAR() asm volatile("s_waitcnt lgkmcnt(0)\n\ts_barrier" ::: "memory")
struct SchedReg {
    int G, c, nM, nN; const char* A; const char* B; size_t astep, bstep; bf16_t* O; int ldc; const float* rs; const float* cs; const ssq_t* sq = nullptr;
    __device__ __forceinline__ bool next(int i, pg8::Unit& u) const {
        const int L = i * G + c; if (L >= nM * nN) return false; int pm, pn; pg8::grouped_mn(pg8::xcd_remap(L, nM * nN), nM, nN, pm, pn);
        u.A = A + (size_t)pm * astep; u.B = B + (size_t)pn * bstep; u.pm = pm; u.pn = pn; u.i0 = ldc; u.i1 = 0;
        u.p0 = O ? (void*)(O + (size_t)pm * 256 * ldc + pn * 256) : nullptr; u.p1 = sq ? (void*)(sq + pm * 256) : (rs ? (void*)(rs + pm * 256) : nullptr); u.p2 = cs ? (void*)(cs + pn * 256) : nullptr; u.p3 = nullptr; return true;
    }
};
struct EpiBf16Ssq {
    static constexpr bool PERM = true; static constexpr int MIDK = -1; float inv_n, mult;
    __device__ __forceinline__ void midk(f32x4 (&)[2][2][4][2], const pg8::Unit&, int, int) const {}
    __device__ __forceinline__ void operator()(f32x4 (&acc)[2][2][4][2], const pg8::Unit& u, int wr, int wc, int fr, int fq, int, int, LAS unsigned char*) const {
        bf16_t* O = (bf16_t*)u.p0; const ssq_t* sq = (const ssq_t*)u.p1; const int ldc = u.i0; int r0 = wr * 64 + fr, c0 = wc * 32 + 8 * fq; asm volatile("" : "+v"(r0), "+v"(c0));
#pragma unroll
        for (int ai = 0; ai < 2; ++ai)
#pragma unroll
            for (int m = 0; m < 4; ++m) { const int r = r0 + ai * 128 + m * 16; const float rv = mult / sqrtf(ssq_get(sq + r) * inv_n + EPS); bf16_t* rowp = O + (size_t)r * ldc + c0;
#pragma unroll
                for (int bj = 0; bj < 2; ++bj) { const f32x4 v0 = acc[ai][bj][m][0] * rv, v1 = acc[ai][bj][m][1] * rv;
                    u32x4 w; w.x = pg8::cvt_pk_bf16(v0[0], v0[1]); w.y = pg8::cvt_pk_bf16(v0[2], v0[3]); w.z = pg8::cvt_pk_bf16(v1[0], v1[1]); w.w = pg8::cvt_pk_bf16(v1[2], v1[3]);
                    pg8::st16<5>(rowp + bj * 128, w); } }
    }
};
template <int MIDK_, bool XIN_BF16, bool F8OUT> struct EpiResid {
    static constexpr bool PERM = true; static constexpr int MIDK = MIDK_;
    const float* xin; bf16_t* xb; unsigned char* x8; ssq_t* ssq; const ssq_t* ssq_mid; float accs;
    __device__ __forceinline__ void midk(f32x4 (&acc)[2][2][4][2], const pg8::Unit& u, int wr, int fr) const {
#pragma unroll
        for (int ai = 0; ai < 2; ++ai)
#pragma unroll
            for (int m = 0; m < 4; ++m) { const int r = u.pm * 256 + ai * 128 + wr * 64 + m * 16 + fr; const float s = 1.0f / sqrtf(ssq_get(ssq_mid + r) * (1.0f / SBW) + EPS);
#pragma unroll
                for (int bj = 0; bj < 2; ++bj)
#pragma unroll
                    for (int n = 0; n < 2; ++n) acc[ai][bj][m][n] *= s; }
    }
    __device__ __forceinline__ void operator()(f32x4 (&acc)[2][2][4][2], const pg8::Unit& u, int wr, int wc, int fr, int fq, int, int, LAS unsigned char*) const {
        int row0 = u.pm * 256 + wr * 64 + fr, col0 = u.pn * 256 + wc * 32 + 8 * fq; asm volatile("" : "+v"(row0), "+v"(col0));
#pragma unroll
        for (int ai = 0; ai < 2; ++ai)
#pragma unroll
            for (int m = 0; m < 4; ++m) { const int r = row0 + ai * 128 + m * 16; const size_t off = (size_t)r * D + col0; float q = 0.f;
#pragma unroll
                for (int bj = 0; bj < 2; ++bj) { const size_t o2 = off + bj * 128; f32x4 o0, o1;
                    if constexpr (XIN_BF16) { const u32x4 xv = *(const u32x4*)(xb + o2);
                        o0 = (f32x4){__builtin_bit_cast(float, xv.x << 16), __builtin_bit_cast(float, xv.x & 0xffff0000u), __builtin_bit_cast(float, xv.y << 16), __builtin_bit_cast(float, xv.y & 0xffff0000u)};
                        o1 = (f32x4){__builtin_bit_cast(float, xv.z << 16), __builtin_bit_cast(float, xv.z & 0xffff0000u), __builtin_bit_cast(float, xv.w << 16), __builtin_bit_cast(float, xv.w & 0xffff0000u)}; }
                    else { o0 = *(const f32x4*)(xin + o2); o1 = *(const f32x4*)(xin + o2 + 4); }
                    o0 += acc[ai][bj][m][0] * accs; o1 += acc[ai][bj][m][1] * accs;
                    q += (o0[0] * o0[0] + o0[1] * o0[1]) + (o0[2] * o0[2] + o0[3] * o0[3]) + (o1[0] * o1[0] + o1[1] * o1[1]) + (o1[2] * o1[2] + o1[3] * o1[3]);
                    if constexpr (F8OUT) { int w0 = __builtin_amdgcn_cvt_pk_fp8_f32(o0[0], o0[1], 0, false); w0 = __builtin_amdgcn_cvt_pk_fp8_f32(o0[2], o0[3], w0, true);
                        int w1 = __builtin_amdgcn_cvt_pk_fp8_f32(o1[0], o1[1], 0, false); w1 = __builtin_amdgcn_cvt_pk_fp8_f32(o1[2], o1[3], w1, true);
                        pg8::st8_wt(x8 + o2, (unsigned long long)(unsigned)w0 | ((unsigned long long)(unsigned)w1 << 32)); }
                    u32x4 w; w.x = pg8::cvt_pk_bf16(o0[0], o0[1]); w.y = pg8::cvt_pk_bf16(o0[2], o0[3]); w.z = pg8::cvt_pk_bf16(o1[0], o1[1]); w.w = pg8::cvt_pk_bf16(o1[2], o1[3]); pg8::st16<4>(xb + o2, w); }
                q += __shfl_xor(q, 16); q += __shfl_xor(q, 32);
                if (fq == 0) ssq_add(ssq + r, q);
                if (m & 1) asm volatile("" ::: "memory"); }
    }
};
struct SchedMS {
    int G, c; unsigned char* ws;
    __device__ __forceinline__ bool next(int i, pg8::Unit& u) const {
        const int L = i * G + c; constexpr int NU = (NTOK / 256) * MH; if (L >= NU) return false; const int w = pg8::xcd_remap(L, NU), pm = w >> 2, h = w & 3, b = pm >> 4;
        u.A = (const char*)(ws + WS_QM) + ((size_t)pm * 256 * D + h * MHD) * 2; u.B = (const char*)(ws + WS_KM) + ((size_t)b * NMEM * D + h * MHD) * 2;
        u.p0 = (bf16_t*)(ws + WS_PM) + (size_t)pm * 256 * D + h * NMEM; u.p1 = nullptr; u.p2 = nullptr; u.p3 = nullptr; u.i0 = D; u.i1 = 0; u.pm = pm; u.pn = h; return true;
    }
};
struct EpiSoftmax {
    static constexpr bool PERM = true; static constexpr int MIDK = -1;
    __device__ __forceinline__ void midk(f32x4 (&)[2][2][4][2], const pg8::Unit&, int, int) const {}
    __device__ __forceinline__ void operator()(f32x4 (&acc)[2][2][4][2], const pg8::Unit& u, int wr, int wc, int fr, int fq, int, int, LAS unsigned char* xl) const {
        typedef float f32x2v __attribute__((ext_vector_type(2)));
        LAS f32x2v* X = (LAS f32x2v*)xl;
        float ml[2][4];
#pragma unroll
        for (int ai = 0; ai < 2; ++ai)
#pragma unroll
            for (int m = 0; m < 4; ++m) { float mx = -INFINITY;
#pragma unroll
                for (int bj = 0; bj < 2; ++bj)
#pragma unroll
                    for (int n = 0; n < 2; ++n) { const f32x4 v = acc[ai][bj][m][n]; mx = fmaxf(fmaxf(mx, fmaxf(v[0], v[1])), fmaxf(v[2], v[3])); }
                mx = fmaxf(mx, __shfl_xor(mx, 16)); mx = fmaxf(mx, __shfl_xor(mx, 32)); ml[ai][m] = mx; float s = 0.f;
#pragma unroll
                for (int bj = 0; bj < 2; ++bj)
#pragma unroll
                    for (int n = 0; n < 2; ++n) { f32x4 v = acc[ai][bj][m][n];
#pragma unroll
                        for (int j = 0; j < 4; ++j) { v[j] = __builtin_amdgcn_exp2f(v[j] - mx); s += v[j]; }
                        acc[ai][bj][m][n] = v; }
                s += __shfl_xor(s, 16); s += __shfl_xor(s, 32);
                if (fq == 0) X[(ai * 128 + wr * 64 + m * 16 + fr) * 4 + wc] = (f32x2v){mx, s}; }
        EPI_BAR();
        bf16_t* O = (bf16_t*)u.p0; const int ldc = u.i0; int r0 = wr * 64 + fr, c0 = wc * 32 + 8 * fq; asm volatile("" : "+v"(r0), "+v"(c0));
#pragma unroll
        for (int ai = 0; ai < 2; ++ai)
#pragma unroll
            for (int m = 0; m < 4; ++m) { const int r = r0 + ai * 128 + m * 16; const f32x2v a = X[r * 4 + 0], b = X[r * 4 + 1], c = X[r * 4 + 2], d = X[r * 4 + 3];
                const float M = fmaxf(fmaxf(a.x, b.x), fmaxf(c.x, d.x));
                const float tot = a.y * __builtin_amdgcn_exp2f(a.x - M) + b.y * __builtin_amdgcn_exp2f(b.x - M) + c.y * __builtin_amdgcn_exp2f(c.x - M) + d.y * __builtin_amdgcn_exp2f(d.x - M);
                const float f = __builtin_amdgcn_exp2f(ml[ai][m] - M) / tot; bf16_t* rowp = O + (size_t)r * ldc + c0;
#pragma unroll
                for (int bj = 0; bj < 2; ++bj) { const f32x4 v0 = acc[ai][bj][m][0] * f, v1 = acc[ai][bj][m][1] * f;
                    u32x4 w; w.x = pg8::cvt_pk_bf16(v0[0], v0[1]); w.y = pg8::cvt_pk_bf16(v0[2], v0[3]); w.z = pg8::cvt_pk_bf16(v1[0], v1[1]); w.w = pg8::cvt_pk_bf16(v1[2], v1[3]);
                    pg8::st16<6>(rowp + bj * 128, w); } }
    }
};
struct SchedPV {
    int G, c; unsigned char* ws;
    __device__ __forceinline__ bool next(int i, pg8::Unit& u) const {
        const int L = i * G + c; constexpr int NU = (NTOK / 256) * MH; if (L >= NU) return false; const int w = pg8::xcd_remap(L, NU), pm = w >> 2, h = w & 3, b = pm >> 4;
        u.A = (const char*)(ws + WS_PM) + ((size_t)pm * 256 * D + h * NMEM) * 2; u.B = (const char*)(ws + WS_VMT) + ((size_t)b * D + h * MHD) * NMEM * 2;
        u.p0 = (bf16_t*)(ws + WS_OM) + (size_t)pm * 256 * D + h * MHD; u.p1 = nullptr; u.p2 = nullptr; u.p3 = nullptr; u.i0 = D; u.i1 = 0; u.pm = pm; u.pn = h; return true;
    }
};

__device__ __forceinline__ void p8_route(const Args& a, LAS unsigned char* lds, int bx, int G, int wave, int lane, int* CNT) {
    unsigned char* ws = a.ws; const bf16_t* x2 = (const bf16_t*)(ws + WS_S0); const ssq_t* SSQ2 = (const ssq_t*)(ws + MK_SSQ2); const float* br = a.in[16];
    const bf16_t* WRH = (const bf16_t*)(ws + WS_WRH);
    int* LSLOT = (int*)(ws + WS_LSLOT); float* LGATE = (float*)(ws + WS_LGATE); float* LRS = (float*)(ws + WS_LRS);
    constexpr int WPITCH = 2064;
    LAS float* LG = (LAS float*)(lds + RING_OFF + 69632) + wave * 16 * 33;
    LAS int* hist = (LAS int*)(lds + RING_OFF + 90112); LAS int* base = hist + 32;
    const int tid = wave * 64 + lane;
    { u32x4 v[8];
#pragma unroll
      for (int i = 0; i < 8; ++i) v[i] = *(const u32x4*)(WRH + (size_t)(tid + i * 512) * 8);
#pragma unroll
      for (int i = 0; i < 8; ++i) { const int c = tid + i * 512; *(LAS u32x4*)(lds + RING_OFF + (c >> 7) * WPITCH + (c & 127) * 16) = v[i]; } }
    LDS_WAIT(); __syncthreads();
    for (int t0 = bx * 128; t0 < NTOK; t0 += G * 128) {
        if (tid < 32) hist[tid] = 0;
        const int r16 = lane & 15, kq = lane >> 4; const int trow = t0 + wave * 16 + r16;
        const bf16_t* xp = x2 + (size_t)trow * D + kq * 8;
        bf16x8 ah[32];
#pragma unroll
        for (int ks = 0; ks < 32; ++ks) ah[ks] = *(const bf16x8*)(xp + ks * 32);
        f32x4 acc[2] = {(f32x4){0.f, 0.f, 0.f, 0.f}, (f32x4){0.f, 0.f, 0.f, 0.f}};
        const LAS unsigned char* wp = lds + RING_OFF + r16 * WPITCH + kq * 16;
#pragma unroll
        for (int ks = 0; ks < 32; ++ks) {
#pragma unroll
            for (int nb = 0; nb < 2; ++nb) { const bf16x8 bh = *(const LAS bf16x8*)(wp + nb * 16 * WPITCH + ks * 64);
                acc[nb] = __builtin_amdgcn_mfma_f32_16x16x32_bf16(ah[ks], bh, acc[nb], 0, 0, 0); } }
#pragma unroll
        for (int nb = 0; nb < 2; ++nb)
#pragma unroll
            for (int r = 0; r < 4; ++r) { const int tl = kq * 4 + r; const int tk = t0 + wave * 16 + tl; const float rs = 1.0f / sqrtf(ssq_get(SSQ2 + tk) * (1.0f / D) + EPS);
                LG[tl * 33 + nb * 16 + r16] = acc[nb][r] * rs + br[nb * 16 + r16]; }
        LDS_WAIT(); __syncthreads();
        int te[4] = {0, 0, 0, 0}; float tg[4] = {0.f, 0.f, 0.f, 0.f}; int rk[4] = {0, 0, 0, 0};
        if (lane < 16) {
            float tv[4] = {-INFINITY, -INFINITY, -INFINITY, -INFINITY};
            for (int e = 0; e < NE; ++e) { const float v = LG[lane * 33 + e];
                if (v > tv[3]) { if (v > tv[2]) { tv[3] = tv[2]; te[3] = te[2]; if (v > tv[1]) { tv[2] = tv[1]; te[2] = te[1]; if (v > tv[0]) { tv[1] = tv[0]; te[1] = te[0]; tv[0] = v; te[0] = e; } else { tv[1] = v; te[1] = e; } } else { tv[2] = v; te[2] = e; } } else { tv[3] = v; te[3] = e; } } }
            float gs = 0.f;
#pragma unroll
            for (int k = 0; k < 4; ++k) { tg[k] = __expf(tv[k] - tv[0]); gs += tg[k]; }
            gs = 1.0f / gs;
#pragma unroll
            for (int k = 0; k < 4; ++k) { tg[k] *= gs; rk[k] = __hip_atomic_fetch_add(hist + te[k], 1, __ATOMIC_RELAXED, __HIP_MEMORY_SCOPE_WORKGROUP); }
        }
        LDS_WAIT(); __syncthreads();
        if (tid < 32) { const int n = hist[tid]; base[tid] = n ? atomicAdd(CNT + tid, n) : 0; }
        LDS_WAIT(); __syncthreads();
        if (lane < 16) { const int tk = t0 + wave * 16 + lane; const float rsw = (1.0f / WSCALE) / sqrtf(ssq_get(SSQ2 + tk) * (1.0f / D) + EPS);
#pragma unroll
            for (int k = 0; k < 4; ++k) { const size_t p = (size_t)te[k] * LCAP + base[te[k]] + rk[k]; pg8::st4_wt(LSLOT + p, (unsigned)(tk * 4 + k)); pg8::st4_wt(LGATE + p, __float_as_uint(tg[k])); pg8::st4_wt(LRS + p, __float_as_uint(rsw)); } }
        LDS_WAIT(); __syncthreads();
    }
}

__device__ __forceinline__ void moe_table(const Args& a, volatile LAS unsigned* MISC, int tid) {
    const int* CNT = (const int*)(a.ws + OFF_CNT);
    if (tid < 32) MISC[16 + tid] = (unsigned)CNT[tid];
    LDS_WAIT(); __syncthreads();
    if (tid == 0) { unsigned tb = 0; for (int e = 0; e < NE; ++e) { MISC[48 + e] = tb; tb += (MISC[16 + e] + 255u) >> 8; } MISC[48 + NE] = tb; }
    LDS_WAIT(); __syncthreads();
}
template <int NPN, bool W1> struct SchedMoE {
    int G, c; unsigned char* ws; volatile LAS unsigned* MISC; const float* bias;
    __device__ __forceinline__ bool next(int i, pg8::Unit& u) const {
        unsigned mb_ = (unsigned)(uintptr_t)MISC; asm volatile("" : "+s"(mb_)); const LAS unsigned* M = (const LAS unsigned*)(uintptr_t)mb_;
        const int T = __builtin_amdgcn_readfirstlane((int)M[48 + NE]); const int NU = T * NPN; const int L = i * G + c; if (L >= NU) return false;
        const int w = pg8::xcd_remap(L, NU);
        int e = 0;
#pragma unroll
        for (int s = 16; s >= 1; s >>= 1) { if ((int)M[48 + e + s] * NPN <= w) e += s; }
        e = __builtin_amdgcn_readfirstlane(e);
        const int tb = __builtin_amdgcn_readfirstlane((int)M[48 + e]), cnt = __builtin_amdgcn_readfirstlane((int)M[16 + e]), nte = (cnt + 255) >> 8; const int idx = w - tb * NPN, pn = __builtin_amdgcn_readfirstlane(idx / nte), mt = idx - pn * nte;
        u.pm = tb + mt; u.pn = pn; u.i1 = e; const int nv = cnt - mt * 256; u.i0 = nv < 256 ? nv : 256;
        u.p3 = (int*)(ws + WS_LSLOT) + (size_t)e * LCAP + mt * 256; u.p2 = (float*)(ws + (W1 ? WS_LRS : WS_LGATE)) + (size_t)e * LCAP + mt * 256; u.p0 = nullptr;
        u.p1 = W1 ? (void*)(bias + (size_t)e * 2 * DFF + pn * 128) : (void*)(bias + (size_t)e * D + pn * 256);
        if (W1) { u.A = (const char*)(ws + WS_X2F8); u.B = (const char*)(ws + WS_W1) + ((size_t)e * 2 * DFF + pn * 256) * D; }
        else { u.A = (const char*)(ws + WS_ACT) + (size_t)(tb + mt) * 256 * DFF; u.B = (const char*)(ws + WS_W2) + ((size_t)e * D + pn * 256) * DFF; }
        return true;
    }
};
typedef float f32x2 __attribute__((ext_vector_type(2)));
struct EpiSwiGLU {
    static constexpr bool PERM = true; static constexpr int MIDK = -1; unsigned char* act;
    __device__ __forceinline__ void midk(f32x4 (&)[2][2][4][2], const pg8::Unit&, int, int) const {}
    __device__ __forceinline__ void operator()(f32x4 (&acc)[2][2][4][2], const pg8::Unit& u, int wr, int wc, int fr, int fq, int, int, LAS unsigned char* tab) const {
        const int nvalid = u.i0; const LAS float* T1 = (const LAS float*)tab + 256; const LAS float* T2 = (const LAS float*)tab + 512;
        int r0 = wr * 64 + fr, c0 = wc * 32 + 8 * fq; asm volatile("" : "+v"(r0), "+v"(c0)); const int gc0 = u.pn * 128 + c0;
        f32x4 bg[2], bu[2];
#pragma unroll
        for (int n = 0; n < 2; ++n) { bg[n] = *(const LAS f32x4*)(T2 + c0 + 4 * n); bu[n] = *(const LAS f32x4*)(T2 + 128 + c0 + 4 * n); }
#pragma unroll
        for (int ai = 0; ai < 2; ++ai)
#pragma unroll
            for (int m = 0; m < 4; ++m) { const int r = r0 + ai * 128 + m * 16; const float rs = T1[r]; int wv[2];
#pragma unroll
                for (int n = 0; n < 2; ++n) { f32x2 o[2];
#pragma unroll
                    for (int h = 0; h < 2; ++h) { f32x2 g = (f32x2){acc[ai][0][m][n][2 * h], acc[ai][0][m][n][2 * h + 1]} * rs + (f32x2){bg[n][2 * h], bg[n][2 * h + 1]};
                        f32x2 up = (f32x2){acc[ai][1][m][n][2 * h], acc[ai][1][m][n][2 * h + 1]} * rs + (f32x2){bu[n][2 * h], bu[n][2 * h + 1]};
                        g.x = fminf(g.x, SW_LIMIT); g.y = fminf(g.y, SW_LIMIT); up.x = fminf(fmaxf(up.x, -SW_LIMIT), SW_LIMIT); up.y = fminf(fmaxf(up.y, -SW_LIMIT), SW_LIMIT);
                        const f32x2 tt = g * (-SW_ALPHA * LOG2E); f32x2 d; d.x = __builtin_amdgcn_exp2f(tt.x); d.y = __builtin_amdgcn_exp2f(tt.y); d = d + 1.0f;
                        f32x2 rr; rr.x = __builtin_amdgcn_rcpf(d.x); rr.y = __builtin_amdgcn_rcpf(d.y);
                        o[h] = (up + 1.0f) * g * rr; }
                    wv[n] = __builtin_amdgcn_cvt_pk_fp8_f32(o[0].x, o[0].y, 0, false); wv[n] = __builtin_amdgcn_cvt_pk_fp8_f32(o[1].x, o[1].y, wv[n], true); }
                if (r < nvalid) pg8::st8_wt(act + ((size_t)u.pm * 256 + r) * DFF + gc0, (unsigned long long)(unsigned)wv[0] | ((unsigned long long)(unsigned)wv[1] << 32)); }
    }
};
struct EpiW2 {
    static constexpr bool PERM = true; static constexpr int MIDK = -1; unsigned char* Y;
    __device__ __forceinline__ void midk(f32x4 (&)[2][2][4][2], const pg8::Unit&, int, int) const {}
    __device__ __forceinline__ void operator()(f32x4 (&acc)[2][2][4][2], const pg8::Unit& u, int wr, int wc, int fr, int fq, int, int, LAS unsigned char* tab) const {
        const int nvalid = u.i0; const LAS unsigned* T0 = (const LAS unsigned*)tab; const LAS float* T1 = (const LAS float*)tab + 256; const LAS float* T2 = (const LAS float*)tab + 512;
        int r0 = wr * 64 + fr, cl = wc * 32 + 8 * fq; asm volatile("" : "+v"(r0), "+v"(cl)); const int c0 = u.pn * 256 + cl;
        f32x4 bv[2][2];
#pragma unroll
        for (int bj = 0; bj < 2; ++bj)
#pragma unroll
            for (int n = 0; n < 2; ++n) bv[bj][n] = *(const LAS f32x4*)(T2 + cl + bj * 128 + 4 * n);
#pragma unroll
        for (int ai = 0; ai < 2; ++ai)
#pragma unroll
            for (int m = 0; m < 4; ++m) { const int r = r0 + ai * 128 + m * 16; const bool valid = r < nvalid; const unsigned slot = T0[r]; const float g = T1[r];
#pragma unroll
                for (int bj = 0; bj < 2; ++bj) { const f32x4 v0 = (acc[ai][bj][m][0] * (1.0f / WSCALE) + bv[bj][0]) * g, v1 = (acc[ai][bj][m][1] * (1.0f / WSCALE) + bv[bj][1]) * g;
                    int w0 = __builtin_amdgcn_cvt_pk_fp8_f32(v0[0], v0[1], 0, false); w0 = __builtin_amdgcn_cvt_pk_fp8_f32(v0[2], v0[3], w0, true);
                    int w1 = __builtin_amdgcn_cvt_pk_fp8_f32(v1[0], v1[1], 0, false); w1 = __builtin_amdgcn_cvt_pk_fp8_f32(v1[2], v1[3], w1, true);
                    if (valid) pg8::st8_wt(Y + (size_t)slot * D + c0 + bj * 128, (unsigned long long)(unsigned)w0 | ((unsigned long long)(unsigned)w1 << 32)); } }
    }
};

__device__ __forceinline__ void p11_final(const Args& a, int vcu, int G, int wave, int lane, float* dst) {
    const bf16_t* x2 = (const bf16_t*)(a.ws + WS_S0); const unsigned char* Y = a.ws + WS_Y; const float* gf = a.in[21];
    const int gw = vcu * NWAVES + wave, NGW = G * NWAVES;
    f32x4 g4[4];
#pragma unroll
    for (int j = 0; j < 4; ++j) g4[j] = *(const f32x4*)(gf + 16 * lane + 4 * j);
    for (int tok = gw; tok < NTOK; tok += NGW) {
        const u32x4 xa = *(const u32x4*)(x2 + (size_t)tok * D + 16 * lane), xc = *(const u32x4*)(x2 + (size_t)tok * D + 16 * lane + 8);
        u32x4 yv[4];
#pragma unroll
        for (int k = 0; k < 4; ++k) yv[k] = *(const u32x4*)(Y + ((size_t)tok * 4 + k) * D + 16 * lane);
        float v[16];
#pragma unroll
        for (int q = 0; q < 4; ++q) { v[2 * q] = __builtin_bit_cast(float, xa[q] << 16); v[2 * q + 1] = __builtin_bit_cast(float, xa[q] & 0xffff0000u); v[8 + 2 * q] = __builtin_bit_cast(float, xc[q] << 16); v[8 + 2 * q + 1] = __builtin_bit_cast(float, xc[q] & 0xffff0000u); }
#pragma unroll
        for (int k = 0; k < 4; ++k)
#pragma unroll
            for (int q = 0; q < 4; ++q) { const auto lo = __builtin_amdgcn_cvt_pk_f32_fp8((int)yv[k][q], false), hi2 = __builtin_amdgcn_cvt_pk_f32_fp8((int)yv[k][q], true);
                v[4 * q] += lo[0]; v[4 * q + 1] += lo[1]; v[4 * q + 2] += hi2[0]; v[4 * q + 3] += hi2[1]; }
        float s = 0.f;
#pragma unroll
        for (int q = 0; q < 16; ++q) s += v[q] * v[q];
        const float rs = 1.0f / sqrtf(wave_sum(s) * (1.0f / D) + EPS);
#pragma unroll
        for (int j = 0; j < 4; ++j) pg8::st16<8>(dst + (size_t)tok * D + 16 * lane + 4 * j, (f32x4){v[4 * j] * rs * g4[j][0], v[4 * j + 1] * rs * g4[j][1], v[4 * j + 2] * rs * g4[j][2], v[4 * j + 3] * rs * g4[j][3]});
    }
}
typedef float f32x16 __attribute__((ext_vector_type(16)));
typedef short s16x4 __attribute__((ext_vector_type(4)));
__device__ __forceinline__ int crow(int r, int hi) { return (r & 3) + 8 * (r >> 2) + 4 * hi; }
#define SB_DMA(ubase, voff, ldsaddr) do { unsigned keep_; asm volatile("s_mov_b32 %0, m0\n\ts_mov_b32 m0, %3\n\ts_nop 0\n\tglobal_load_lds_dwordx4 %1, %2\n\ts_mov_b32 m0, %0" \
        : "=&s"(keep_) : "v"(voff), "s"((const char*)(ubase)), "s"(ldsaddr) : "memory"); } while (0)
__device__ __forceinline__ void sb_item(int b, int h, int qi  , const bf16_t* QKVU, bf16_t* MIXED, ssq_t* SSQSB, LAS unsigned char* wl  , int lane) {
    const int r32 = lane & 31, hi = lane >> 5;
    const size_t rowbase = (size_t)b * S; const int q0 = qi * 64;
    const bf16_t* Qw = QKVU + (rowbase + q0) * INP + h * HD;
    const char* Kh = (const char*)(QKVU + rowbase * INP + SBW + h * HD); const char* Vh = Kh + SBW * 2;
    bf16x8 qr[2][4];
#pragma unroll
    for (int s = 0; s < 2; ++s)
#pragma unroll
        for (int d0 = 0; d0 < 4; ++d0) qr[s][d0] = *(const bf16x8*)(Qw + (size_t)(s * 32 + r32) * INP + d0 * 16 + hi * 8);
    f32x16 o[2][2];
#pragma unroll
    for (int r = 0; r < 16; ++r) { o[0][0][r] = 0.f; o[0][1][r] = 0.f; o[1][0][r] = 0.f; o[1][1][r] = 0.f; }
    float carry[2] = {1.0f, 1.0f}; bool alive[2] = {true, true};
    const int jd = qi;
    const unsigned kvoff = (unsigned)lane * (INP * 2);
    const unsigned vvoff = (unsigned)(lane >> 2) * (INP * 2) + (unsigned)(lane & 3) * 16;
    const unsigned lk = (unsigned)(uintptr_t)wl, lv = lk + 8192;
#define SB_LOAD_K(j) do { const char* kb_ = Kh + (size_t)(j) * 64 * INP * 2; _Pragma("unroll") for (int c_ = 0; c_ < 8; ++c_) SB_DMA(kb_ + c_ * 16, kvoff, lk + c_ * 1024); } while (0)
#define SB_LOAD_V(j) do { const char* vb_ = Vh + (size_t)(j) * 64 * INP * 2; _Pragma("unroll") for (int c_ = 0; c_ < 8; ++c_) SB_DMA(vb_ + (size_t)(c_ & 3) * 16 * INP * 2 + (c_ >> 2) * 64, vvoff, lv + c_ * 1024); } while (0)
    SB_LOAD_K(jd); SB_LOAD_V(jd);
    const LAS unsigned char* kb = wl + hi * 1024 + r32 * 16;
    const LAS unsigned char* vb = wl + 8192 + ((lane >> 4) & 1) * 32 + (lane & 3) * 8 + (4 * hi + ((lane & 15) >> 2)) * 64;
    for (int j = jd; j >= 0; --j) {
        asm volatile("s_waitcnt vmcnt(8)" ::: "memory"); __builtin_amdgcn_sched_barrier(0);
        bf16x8 kf[8];
#pragma unroll
        for (int d0 = 0; d0 < 4; ++d0) { kf[2 * d0] = *(const LAS bf16x8*)(kb + d0 * 2048); kf[2 * d0 + 1] = *(const LAS bf16x8*)(kb + d0 * 2048 + 512); }
        asm volatile("s_waitcnt lgkmcnt(0)" ::: "memory"); __builtin_amdgcn_sched_barrier(0);
        if (j > 0) SB_LOAD_K(j - 1);
        unsigned pw[2][4][4];
#pragma unroll
        for (int s = 0; s < 2; ++s) {
            if (!alive[s]) {
#pragma unroll
                for (int x = 0; x < 4; ++x)
#pragma unroll
                    for (int y = 0; y < 4; ++y) pw[s][x][y] = 0u;
                continue; }
            f32x16 p0, p1;
#pragma unroll
            for (int r = 0; r < 16; ++r) { p0[r] = 0.f; p1[r] = 0.f; }
#pragma unroll
            for (int d0 = 0; d0 < 4; ++d0) { p0 = __builtin_amdgcn_mfma_f32_32x32x16_bf16(kf[2 * d0], qr[s][d0], p0, 0, 0, 0); p1 = __builtin_amdgcn_mfma_f32_32x32x16_bf16(kf[2 * d0 + 1], qr[s][d0], p1, 0, 0, 0); }
            const bool diag = (j == jd); const int kbase = 64 * j + 4 * hi; const int qabs = q0 + s * 32 + r32;
#pragma unroll
            for (int r = 0; r < 16; ++r) { const int k0 = kbase + (r & 3) + 8 * (r >> 2);
                float e0 = __builtin_amdgcn_exp2f(p0[r]), e1 = __builtin_amdgcn_exp2f(p1[r]);
                float r0 = __builtin_amdgcn_rcpf(1.0f + e0), r1 = __builtin_amdgcn_rcpf(1.0f + e1);
                if (diag) { if (k0 >= qabs) r0 = 1.0f; if (k0 + 32 >= qabs) r1 = 1.0f; }
                p0[r] = r0; p1[r] = r1; }
            float sfx[8][3], A[8];
#pragma unroll
            for (int i = 0; i < 8; ++i) { const float x0 = (i < 4) ? p0[4 * i] : p1[4 * i - 16], x1 = (i < 4) ? p0[4 * i + 1] : p1[4 * i - 15], x2 = (i < 4) ? p0[4 * i + 2] : p1[4 * i - 14], x3 = (i < 4) ? p0[4 * i + 3] : p1[4 * i - 13];
                sfx[i][2] = x3; sfx[i][1] = x3 * x2; sfx[i][0] = sfx[i][1] * x1; A[i] = sfx[i][0] * x0; }
            float T = carry[s], E[8];
#pragma unroll
            for (int i = 7; i >= 0; --i) { const auto sw = __builtin_amdgcn_permlane32_swap(__float_as_uint(A[i]), __float_as_uint(A[i]), false, false);
                const float partner = hi ? __uint_as_float(sw[0]) : __uint_as_float(sw[1]);
                E[i] = hi ? T : T * partner; T = T * (A[i] * partner); }
            carry[s] = T;
#pragma unroll
            for (int i = 0; i < 8; ++i) { float w4[4];
#pragma unroll
                for (int jj = 0; jj < 4; ++jj) { const float rv = (i < 4) ? p0[4 * i + jj] : p1[4 * i - 16 + jj]; const float beta = 1.0f - rv;
                    w4[jj] = beta * ((jj == 3) ? E[i] : E[i] * sfx[i][jj]); }
                pw[s][i >> 1][(i & 1) * 2] = pg8::cvt_pk_bf16(w4[0], w4[1]); pw[s][i >> 1][(i & 1) * 2 + 1] = pg8::cvt_pk_bf16(w4[2], w4[3]); }
        }
        if (j > 0) asm volatile("s_waitcnt vmcnt(8)" ::: "memory"); else asm volatile("s_waitcnt vmcnt(0)" ::: "memory");
        __builtin_amdgcn_sched_barrier(0);
        bf16x8 vf[8];
#pragma unroll
        for (int d0 = 0; d0 < 2; ++d0)
#pragma unroll
            for (int ks = 0; ks < 4; ++ks) {
                const s16x4 lo = __builtin_bit_cast(s16x4, __builtin_amdgcn_ds_read_tr16_b64_v4i16((LAS s16x4*)(vb + d0 * 4096 + ks * 1024)));
                const s16x4 hh = __builtin_bit_cast(s16x4, __builtin_amdgcn_ds_read_tr16_b64_v4i16((LAS s16x4*)(vb + d0 * 4096 + ks * 1024 + 512)));
                vf[d0 * 4 + ks] = (bf16x8){lo[0], lo[1], lo[2], lo[3], hh[0], hh[1], hh[2], hh[3]}; }
        asm volatile("s_waitcnt lgkmcnt(0)" ::: "memory"); __builtin_amdgcn_sched_barrier(0);
        const bool a0 = alive[0] && __any(carry[0] != 0.0f), a1 = alive[1] && __any(carry[1] != 0.0f);
        const bool more = (j > 0) && (a0 || a1);
        if (more) SB_LOAD_V(j - 1);
#pragma unroll
        for (int s = 0; s < 2; ++s) { if (!alive[s]) continue;
#pragma unroll
            for (int d0 = 0; d0 < 2; ++d0)
#pragma unroll
                for (int ks = 0; ks < 4; ++ks) { const bf16x8 pa = __builtin_bit_cast(bf16x8, (u32x4){pw[s][ks][0], pw[s][ks][1], pw[s][ks][2], pw[s][ks][3]});
                    o[s][d0] = __builtin_amdgcn_mfma_f32_32x32x16_bf16(pa, vf[d0 * 4 + ks], o[s][d0], 0, 0, 0); } }
        alive[0] = a0; alive[1] = a1;
        if (!more) break;
    }
    asm volatile("s_waitcnt vmcnt(0)" ::: "memory");
    LAS bf16_t* stg = (LAS bf16_t*)wl; const int l2 = pg8::fresh_lane();
#pragma unroll
    for (int s = 0; s < 2; ++s) {
#pragma unroll
        for (int r = 0; r < 16; ++r) { const int orow = crow(r, hi);
#pragma unroll
            for (int d0 = 0; d0 < 2; ++d0) stg[orow * 64 + d0 * 32 + r32] = (bf16_t)f2bf(o[s][d0][r]); }
        LDS_WAIT();
        bf16_t* Ow = MIXED + (rowbase + q0 + s * 32) * D + h * HD;
#pragma unroll
        for (int i = 0; i < 4; ++i) { const int row = i * 8 + (l2 >> 3), ch = l2 & 7; const u32x4 v = *(const LAS u32x4*)(stg + row * 64 + ch * 8);
            pg8::st16<2>(Ow + (size_t)row * D + ch * 8, v); float q = 0.f;
#pragma unroll
            for (int k = 0; k < 4; ++k) { const float a = __builtin_bit_cast(float, v[k] << 16), c = __builtin_bit_cast(float, v[k] & 0xffff0000u); q += a * a + c * c; }
            q += __shfl_xor(q, 1); q += __shfl_xor(q, 2); q += __shfl_xor(q, 4);
            if (ch == 0) ssq_add(SSQSB + rowbase + q0 + s * 32 + row, q); }
        LDS_WAIT();
    }
#undef SB_LOAD_K
#undef SB_LOAD_V
}

constexpr int PL_PITCH = 1040, PL_PART_OFF = 83968;
__device__ __forceinline__ void pool_unit(int tile, const bf16_t* QKVU, bf16_t* MIXED, LAS unsigned char* shm, int wid, int lane) {
    const int tok0 = tile * 64, tpos0 = tok0 & (S - 1); const int tid = wid * 64 + lane;
    { u32x4 v[10];
#pragma unroll
      for (int i = 0; i < 10; ++i) { const int c = tid + i * NWAVES * 64; const int row = c >> 6, ch = c & 63; const int t = tpos0 - 15 + row;
          v[i] = (u32x4){0u, 0u, 0u, 0u}; if (c < 79 * 64 && t >= 0) v[i] = *(const u32x4*)(QKVU + (size_t)(tok0 - 15 + row) * INP + 3 * SBW + ch * 8); }
#pragma unroll
      for (int i = 0; i < 10; ++i) { const int c = tid + i * NWAVES * 64; const int row = c >> 6, ch = c & 63; if (c < 79 * 64) *(LAS u32x4*)(shm + row * PL_PITCH + ch * 16) = v[i]; } }
    LDS_WAIT(); __syncthreads();
    const int win = 2 << (wid >> 1); const int tp1 = tpos0 + lane + 1; const int n = tp1 < win ? tp1 : win; const float inv = 1.0f / (float)n;
    const LAS unsigned char* up = shm + (15 + lane) * PL_PITCH + wid * 128;
    float o[64]; float q = 0.f;
#pragma unroll
    for (int ch = 0; ch < 8; ++ch) { float s[8];
#pragma unroll
        for (int k = 0; k < 8; ++k) s[k] = 0.f;
        for (int jw = 0; jw < win; ++jw) { const u32x4 v = *(const LAS u32x4*)(up + ch * 16 - jw * PL_PITCH);
#pragma unroll
            for (int k = 0; k < 4; ++k) { s[2 * k] += __builtin_bit_cast(float, v[k] << 16); s[2 * k + 1] += __builtin_bit_cast(float, v[k] & 0xffff0000u); } }
        const u32x4 self = *(const LAS u32x4*)(up + ch * 16);
#pragma unroll
        for (int k = 0; k < 4; ++k) { const float a = s[2 * k] * inv - __builtin_bit_cast(float, self[k] << 16), c = s[2 * k + 1] * inv - __builtin_bit_cast(float, self[k] & 0xffff0000u);
            o[ch * 8 + 2 * k] = a; o[ch * 8 + 2 * k + 1] = c; q += a * a + c * c; } }
    LAS float* part = (LAS float*)(shm + PL_PART_OFF);
    part[wid * 64 + lane] = q;
    LDS_WAIT(); __syncthreads();
    float tot = 0.f;
#pragma unroll
    for (int w = 0; w < 8; ++w) tot += part[w * 64 + lane];
    const float rs = 1.0f / sqrtf(tot * (1.0f / PW) + EPS);
    LAS unsigned char* op = shm + lane * PL_PITCH + wid * 128;
#pragma unroll
    for (int ch = 0; ch < 8; ++ch) { u32x4 w;
#pragma unroll
        for (int k = 0; k < 4; ++k) w[k] = pg8::cvt_pk_bf16(o[ch * 8 + 2 * k] * rs, o[ch * 8 + 2 * k + 1] * rs);
        *(LAS u32x4*)(op + ch * 16) = w; }
    LDS_WAIT(); __syncthreads();
#pragma unroll
    for (int i = 0; i < 8; ++i) { const int c = tid + i * NWAVES * 64; const int row = c >> 6, ch = c & 63;
        pg8::st16<3>(MIXED + (size_t)(tok0 + row) * D + SBW + ch * 8, (u32x4)*(const LAS u32x4*)(shm + row * PL_PITCH + ch * 16)); }
    LDS_WAIT(); __syncthreads();
}
__device__ __forceinline__ void p2_mix(const Args& a, LAS unsigned char* lds, int bx, int G, int wid, int lane, ssq_t* SSQSB, int which = 3, int pstop = 9, bf16_t* pool_dst = nullptr, volatile LAS unsigned* stp = nullptr) {
    unsigned char* ws = a.ws; const bf16_t* QKVU = (const bf16_t*)(ws + WS_QKVU); bf16_t* MIXED = (bf16_t*)(ws + WS_MIXED);
    constexpr int NA = B * NH * (S / 512);
    if (which & 1) for (int i = 0; i * G + bx < NA; ++i) { const int w = pg8::xcd_remap(i * G + bx, NA); const int bh = w >> 3, qb = w & 7;
        sb_item(bh >> 3, bh & 7, qb * 8 + wid, QKVU, MIXED, SSQSB, lds + RING_OFF + wid * 16384, lane); }
    __syncthreads();
    if (which & 2) for (int t = bx; t < NTOK / 64; t += G) pool_unit(t, QKVU, pool_dst ? pool_dst : MIXED, lds + RING_OFF, wid, lane);
}
constexpr size_t BAR_REGION_OFF = 1 * MiB, BAR_REGION_STRIDE = 16 * 1024;
__global__ void __launch_bounds__(NWAVES * 64, 2) mega(Args args) {
    const int li = args.li;
    extern __shared__ __attribute__((aligned(16))) unsigned char lds_raw[];
    LAS unsigned char* lds = (LAS unsigned char*)lds_raw;
    volatile LAS unsigned* MISC = (volatile LAS unsigned*)(lds + MISC_OFF);
    const int wave = __builtin_amdgcn_readfirstlane((int)threadIdx.x >> 6);
#define LANE_ID() ({ int l_; asm volatile("v_mbcnt_lo_u32_b32 %0, -1, 0\n\tv_mbcnt_hi_u32_b32 %0, -1, %0" : "=v"(l_)); l_; })
    const int G = gridDim.x; const int bx = blockIdx.x; const int vcu = (G % 8 == 0) ? (bx % 8) * (G / 8) + bx / 8 : bx;
    for (int u = wave * 64 + LANE_ID(); u < MISC_BYTES / 4; u += NWAVES * 64) MISC[u] = 0u;
    __syncthreads();
    unsigned char* ws = args.ws;
    XcdBarrier bar = xcd_barrier_post((unsigned*)(ws + BAR_REGION_OFF + (size_t)li * BAR_REGION_STRIDE), MISC + 8);
    const int lo = args.ph_lo, hi = args.ph_hi;
    LAS unsigned char* ring = lds + RING_OFF; LAS unsigned char* epi = lds + EPI_OFF; LAS unsigned* gtab = (LAS unsigned*)(lds + GTAB_OFF);
#ifndef TIME_PHASE
#define TIME_PHASE -1
#endif
#define REP_OF(k) ((TIME_PHASE == (k)) ? 2 : 1)
#define REPE_OF(k) ((TIME_PHASE == 20 + (k)) ? 2 : 1)
#define IN(k) (lo <= (k) && (k) < hi)
#ifndef TSK
#define TSK -1
#endif
#ifndef TSCALE
#define TSCALE 1.0f
#endif
#define STAMP(i) do { if (TSK >= 0 && wave == 0) { const unsigned long long t_ = __builtin_amdgcn_s_memrealtime(); MISC[128 + 2 * (i)] = (unsigned)t_; MISC[129 + 2 * (i)] = (unsigned)(t_ >> 32); } } while (0)
#define SEAM(k) do { if (IN(k) && IN((k) + 1)) xcd_barrier(bar); STAMP((k) + 1); } while (0)
    STAMP(0);
    if (IN(0)) { p0_prologue(args, lds, vcu, G, wave, LANE_ID()); if (TIME_PHASE == 0) { xcd_barrier(bar); p0_prologue(args, lds, vcu, G, wave, LANE_ID()); } SEAM(0); }
    if (IN(1)) { SchedP1 S{G, bx, ws}; pg8::EpiBf16S E; pg8::gemm_phase<pg8::EpiBf16S, SchedP1, 0, REP_OF(1), REPE_OF(1)>(wave, ring, epi, gtab, D * 2, D * 2, D / 64, S, E); SEAM(1); }
    {
    const float* xin0 = args.in[0]; float* outp = args.out;
    bf16_t* S0p = (bf16_t*)(ws + WS_S0); ssq_t* SSQSBp = (ssq_t*)(ws + MK_SSQSB); ssq_t* SSQ1p = (ssq_t*)(ws + MK_SSQ1); ssq_t* SSQ2p = (ssq_t*)(ws + MK_SSQ2);
    constexpr size_t TSTEP = (size_t)256 * D * 2;
    #if !defined(PH_ONLY) || PH_ONLY == 2
    if (IN(2)) { if (TIME_PHASE == 42) { p2_mix(args, lds, bx, G, wave, LANE_ID(), (ssq_t*)(ws + 1280 * 1024), 2); xcd_barrier(bar); p2_mix(args, lds, bx, G, wave, LANE_ID(), (ssq_t*)(ws + 1280 * 1024), 2); xcd_barrier(bar); }
    if (TIME_PHASE == 2 || TIME_PHASE == 40 || TIME_PHASE == 41) { p2_mix(args, lds, bx, G, wave, LANE_ID(), (ssq_t*)(ws + 1280 * 1024), TIME_PHASE == 40 ? 1 : (TIME_PHASE == 41 ? 2 : 3)); xcd_barrier(bar); } STAMP(20); p2_mix(args, lds, bx, G, wave, LANE_ID(), (ssq_t*)(ws + MK_SSQSB), 1); STAMP(21); p2_mix(args, lds, bx, G, wave, LANE_ID(), (ssq_t*)(ws + MK_SSQSB), 2, 9, nullptr, (TSK >= 30 && bx == 0) ? MISC + 128 + 60 : nullptr); STAMP(22); SEAM(2); STAMP(23); }
#endif

#if !defined(PH_ONLY) || PH_ONLY == 3
    if (IN(3)) { SchedReg S{G, bx, NTOK / 256, D / 256, (const char*)(ws + WS_MIXED), (const char*)(ws + WS_WOUT), TSTEP, TSTEP, nullptr, D, nullptr, nullptr};
        EpiResid<8, false, true> E{xin0, S0p, ws + WS_X1F8, SSQ1p, SSQSBp, 1.0f}; pg8::gemm_phase<EpiResid<8, false, true>, SchedReg, 0, REP_OF(3)>(wave, ring, epi, gtab, D * 2, D * 2, D / 64, S, E); SEAM(3); }
#endif
#if !defined(PH_ONLY) || PH_ONLY == 4
    if (IN(4)) { SchedReg S{G, bx, NTOK / 256, D / 256, (const char*)(ws + WS_X1F8), (const char*)(ws + WS_WQ), TSTEP / 2, TSTEP / 2, (bf16_t*)(ws + WS_QM), D, nullptr, nullptr, SSQ1p};
        EpiBf16Ssq E{1.0f / D, C2_MEM / WSCALE}; pg8::gemm_phase<EpiBf16Ssq, SchedReg, 0, REP_OF(4), 1, true>(wave, ring, epi, gtab, D, D, D / 128, S, E); SEAM(4); }
#endif
#if !defined(PH_ONLY) || PH_ONLY == 5
    if (IN(5)) { SchedMS S{G, bx, ws}; EpiSoftmax E; pg8::gemm_phase<EpiSoftmax, SchedMS, 0, REP_OF(5)>(wave, ring, epi, gtab, D * 2, D * 2, MHD / 64, S, E); SEAM(5); }
#endif
#if !defined(PH_ONLY) || PH_ONLY == 6
    if (IN(6)) { SchedPV S{G, bx, ws}; pg8::EpiBf16S E; pg8::gemm_phase<pg8::EpiBf16S, SchedPV, 0, REP_OF(6)>(wave, ring, epi, gtab, D * 2, NMEM * 2, NMEM / 64, S, E); SEAM(6); }
#endif
#if !defined(PH_ONLY) || PH_ONLY == 7
    if (IN(7)) { SchedReg S{G, bx, NTOK / 256, D / 256, (const char*)(ws + WS_OM), (const char*)(ws + WS_WO), TSTEP, TSTEP, nullptr, D, nullptr, nullptr};
        EpiResid<-1, true, true> E{nullptr, S0p, ws + WS_X2F8, SSQ2p, nullptr, 1.0f}; pg8::gemm_phase<EpiResid<-1, true, true>, SchedReg, 0, REP_OF(7)>(wave, ring, epi, gtab, D * 2, D * 2, D / 64, S, E); SEAM(7); }
#endif
#if !defined(PH_ONLY) || PH_ONLY == 8
    if (IN(8)) { if (TIME_PHASE == 8) { p8_route(args, lds, bx, G, wave, LANE_ID(), (int*)(ws + 1536 * 1024)); xcd_barrier(bar); } p8_route(args, lds, bx, G, wave, LANE_ID(), (int*)(ws + OFF_CNT)); SEAM(8); }
#endif
#if !defined(PH_ONLY) || PH_ONLY == 9
    if (IN(9)) { moe_table(args, MISC, wave * 64 + LANE_ID()); SchedMoE<8, true> S{G, bx, ws, MISC, args.in[18]}; EpiSwiGLU E{ws + WS_ACT};
        pg8::gemm_phase<EpiSwiGLU, SchedMoE<8, true>, 1, REP_OF(9), REPE_OF(9), true>(wave, ring, epi, gtab, D, D, D / 128, S, E); SEAM(9); }
#endif
#if !defined(PH_ONLY) || PH_ONLY == 10
    if (IN(10)) { moe_table(args, MISC, wave * 64 + LANE_ID()); SchedMoE<4, false> S{G, bx, ws, MISC, args.in[20]}; EpiW2 E{ws + WS_Y};
        pg8::gemm_phase<EpiW2, SchedMoE<4, false>, 2, REP_OF(10), REPE_OF(10), true>(wave, ring, epi, gtab, DFF, DFF, DFF / 128, S, E); SEAM(10); }
#endif
#if !defined(PH_ONLY) || PH_ONLY == 11
    if (IN(11)) { if (TIME_PHASE == 11) { p11_final(args, vcu, G, wave, LANE_ID(), (float*)(ws + WS_ACT)); xcd_barrier(bar); } p11_final(args, vcu, G, wave, LANE_ID(), args.out); }
#endif
}

    if (TSK >= 100) { __syncthreads(); float* dbg = (float*)(ws + 1792 * 1024);
        if (wave == 0 && LANE_ID() == 0) { const int a_ = (TSK >= 200) ? 21 : 20; const unsigned long long t0 = ((unsigned long long)MISC[129 + 2 * a_] << 32) | MISC[128 + 2 * a_], t1 = ((unsigned long long)MISC[131 + 2 * a_] << 32) | MISC[130 + 2 * a_];
            __hip_atomic_store(dbg + bx, (float)(t1 - t0) * 0.01f, __ATOMIC_RELAXED, __HIP_MEMORY_SCOPE_AGENT); }
        xcd_barrier(bar);
        if (bx == 0 && wave == 0) { const int l_ = LANE_ID(); float mx = 0.f, mn = 1e9f; for (int q = l_; q < G; q += 64) { const float v = __hip_atomic_load(dbg + q, __ATOMIC_RELAXED, __HIP_MEMORY_SCOPE_AGENT); mx = fmaxf(mx, v); mn = fminf(mn, v); }
            for (int o_ = 1; o_ < 64; o_ <<= 1) { mx = fmaxf(mx, __shfl_xor(mx, o_)); mn = fminf(mn, __shfl_xor(mn, o_)); }
            if (l_ == 0) { asm volatile("s_waitcnt vmcnt(0)" ::: "memory"); args.out[0] = ((TSK % 100) == 0 ? mx : mn) * TSCALE; } } }
    else if (TSK >= 0) { STAMP(12); __syncthreads(); if (bx == 0 && wave == 0 && LANE_ID() == 0) { asm volatile("s_waitcnt vmcnt(0)" ::: "memory");
        const unsigned long long t0 = ((unsigned long long)MISC[129 + 2 * TSK] << 32) | MISC[128 + 2 * TSK], t1 = ((unsigned long long)MISC[131 + 2 * TSK] << 32) | MISC[130 + 2 * TSK];
        args.out[0] = (float)(t1 - t0) * 0.01f * TSCALE; } }
    if (TIME_PHASE == 12) { for (int q = 0; q < 10; ++q) xcd_barrier(bar); }
#undef IN
#undef SEAM
}
}

#ifndef MEGA_MASK
#define MEGA_MASK 0xFFF
#endif
extern "C" void kernel_launch(void* const* d_in, const int* in_sizes, int n_in, void* d_out, int out_size, void* d_ws, size_t ws_size, hipStream_t stream) {
    if (n_in != 22 || out_size != NTOK * D || ws_size < WS_END) { fprintf(stderr, "kernel_launch: unexpected shapes (n_in %d out %d ws %zu)\n", n_in, out_size, ws_size); return; }
    static int grid = 0;
    if (grid == 0) {
        int dev = 0, cus = 0;
        if (hipGetDevice(&dev) != hipSuccess || hipDeviceGetAttribute(&cus, hipDeviceAttributeMultiprocessorCount, dev) != hipSuccess) { grid = -1; return; }
        if (hipFuncSetAttribute((const void*)mk::mega, hipFuncAttributeMaxDynamicSharedMemorySize, mk::LDS_BYTES) != hipSuccess) { fprintf(stderr, "kernel_launch: hipFuncSetAttribute failed\n"); grid = -1; return; }
        int per_cu = 0; (void)hipOccupancyMaxActiveBlocksPerMultiprocessor(&per_cu, (const void*)mk::mega, mk::NWAVES * 64, mk::LDS_BYTES); (void)hipGetLastError();
        if (per_cu < 1) fprintf(stderr, "kernel_launch: occupancy query reports %d blocks per CU\n", per_cu);
        grid = cus;
    }
    if (grid < 0) return;
    const float* x = (const float*)d_in[0]; const float* mem = (const float*)d_in[1]; const float* g_mix = (const float*)d_in[2]; const float* w_in = (const float*)d_in[3];
    const float* g_sb = (const float*)d_in[4]; const float* g_pool = (const float*)d_in[5]; const float* w_pool = (const float*)d_in[6]; const float* pool_scale = (const float*)d_in[7];
    const float* w_out = (const float*)d_in[8]; const float* g_mem_q = (const float*)d_in[9]; const float* g_mem_kv = (const float*)d_in[10]; const float* w_mem_q = (const float*)d_in[11];
    const float* w_mem_kv = (const float*)d_in[12]; const float* w_mem_o = (const float*)d_in[13]; const float* g_ffn = (const float*)d_in[14]; const float* w_router = (const float*)d_in[15];
    const float* b_router = (const float*)d_in[16]; const float* w_e_in = (const float*)d_in[17]; const float* b_e_in = (const float*)d_in[18]; const float* w_e_out = (const float*)d_in[19];
    const float* b_e_out = (const float*)d_in[20]; const float* g_final = (const float*)d_in[21];
    float* out = (float*)d_out; unsigned char* ws = (unsigned char*)d_ws;
    bf16_t* WIN = (bf16_t*)(ws + WS_WIN); bf16_t* WOUT = (bf16_t*)(ws + WS_WOUT); bf16_t* WQ = (bf16_t*)(ws + WS_WQ); bf16_t* WKV = (bf16_t*)(ws + WS_WKV); bf16_t* WO = (bf16_t*)(ws + WS_WO);
    bf16_t* WP = (bf16_t*)(ws + WS_WP); float* WR = (float*)(ws + WS_WR); float* RSTDX = (float*)(ws + WS_RSTDX); float* RSTDM = (float*)(ws + WS_RSTDM);
    bf16_t* W1 = (bf16_t*)(ws + WS_W1); bf16_t* W2 = (bf16_t*)(ws + WS_W2); bf16_t* S0 = (bf16_t*)(ws + WS_S0); bf16_t* QKVU = (bf16_t*)(ws + WS_QKVU);
    bf16_t* QM = (bf16_t*)(ws + WS_QM); bf16_t* OM = (bf16_t*)(ws + WS_OM); bf16_t* MIXED = (bf16_t*)(ws + WS_MIXED); bf16_t* PM = (bf16_t*)(ws + WS_PM); bf16_t* ACT = (bf16_t*)(ws + WS_ACT);
    bf16_t* KM = (bf16_t*)(ws + WS_KM); bf16_t* VMT = (bf16_t*)(ws + WS_VMT); bf16_t* MEMB = (bf16_t*)(ws + WS_MEMB); int* LSLOT = (int*)(ws + WS_LSLOT); float* LGATE = (float*)(ws + WS_LGATE);
    bf16_t* Y = (bf16_t*)(ws + WS_Y); float* SCR_S = (float*)(ws + WS_SCR_S); bf16_t* POOLED = (bf16_t*)(ws + WS_SCR_POOLED); float* POOLO = (float*)(ws + WS_SCR_POOLO);
    int* CNT = (int*)(ws + OFF_CNT); float* SSQSB = (float*)(ws + OFF_SSQSB); float* SSQ1 = (float*)(ws + OFF_SSQ1); float* SSQ2 = (float*)(ws + OFF_SSQ2);

    (void)hipMemsetAsync(ws + WS_CTL, 0, CTL_BYTES, stream);
    mk::Args a{}; for (int i = 0; i < 22; ++i) a.in[i] = (const float*)d_in[i]; a.out = out; a.ws = ws;
    const dim3 tb(32, 8); const int BIG = 1 << 30; int li = 0;
    for (int p = 0; p < mk::NPHASE;) {
        if ((MEGA_MASK >> p) & 1) { int q = p; while (q < mk::NPHASE && ((MEGA_MASK >> q) & 1)) ++q;
            a.ph_lo = p; a.ph_hi = q; a.li = li; hipLaunchKernelGGL(mk::mega, dim3(grid), dim3(mk::NWAVES * 64), mk::LDS_BYTES, stream, a); ++li; p = q; continue; }
        switch (p) {
        case 0:
            nv::k_cvt_w<<<dim3(INP / 32, D / 32, 1), tb, 0, stream>>>(w_in, D, INP, WIN, INP, g_mix, nullptr, BIG, nullptr, 0, 0);
            nv::k_cvt_w<<<dim3(D / 32, D / 32, 1), tb, 0, stream>>>(w_out, D, D, WOUT, D, g_sb, g_pool, SBW, nullptr, 0, 0);
            nv::k_cvt_w<<<dim3(D / 32, D / 32, 1), tb, 0, stream>>>(w_mem_q, D, D, WQ, D, g_mem_q, nullptr, BIG, nullptr, 0, 0);
            nv::k_cvt_w<<<dim3(2 * D / 32, D / 32, 1), tb, 0, stream>>>(w_mem_kv, D, 2 * D, WKV, 2 * D, g_mem_kv, nullptr, BIG, nullptr, 0, 0);
            nv::k_cvt_w<<<dim3(D / 32, D / 32, 1), tb, 0, stream>>>(w_mem_o, D, D, WO, D, nullptr, nullptr, BIG, nullptr, 0, 0);
            nv::k_cvt_w<<<dim3(2 * DFF / 32, D / 32, NE), tb, 0, stream>>>(w_e_in, D, 2 * DFF, W1, 2 * DFF, g_ffn, nullptr, BIG, nullptr, 0, 1);
            nv::k_cvt_w<<<dim3(D / 32, DFF / 32, NE), tb, 0, stream>>>(w_e_out, DFF, D, W2, D, nullptr, nullptr, BIG, nullptr, 0, 0);
            nv::k_cvt_w<<<dim3(PGD / 32, PGD / 32, PG), tb, 0, stream>>>(w_pool, PGD, PGD, WP, PGD, nullptr, nullptr, BIG, pool_scale, PGD, 0);
            nv::k_cvt_router<<<NE * D / 256, 256, 0, stream>>>(w_router, g_ffn, WR);
            nv::k_rowstat_cvt<<<NTOK / 4, 256, 0, stream>>>(x, S0, RSTDX, NTOK);
            nv::k_rowstat_cvt<<<NMROWS / 4, 256, 0, stream>>>(mem, MEMB, RSTDM, NMROWS);
            break;
        case 1:
            nv::k_g1<<<dim3(INP / 64, NTOK / 64), 256, 0, stream>>>(S0, WIN, RSTDX, QKVU);
            nv::k_g1b<<<dim3(2 * D / 64, NMROWS / 64), 256, 0, stream>>>(MEMB, WKV, RSTDM, KM, VMT);
            break;
        case 2:
            nv::k_sb<<<B * NH * S / 256, 256, 0, stream>>>(QKVU, MIXED, SSQSB);
            nv::k_pool1<<<(unsigned)((size_t)NTOK * PW / 256), 256, 0, stream>>>(QKVU, POOLED);
            nv::k_pool2<<<dim3(PGD / 64, NTOK / 64, PG), 256, 0, stream>>>(POOLED, WP, POOLO);
            nv::k_pool3<<<NTOK / 4, 256, 0, stream>>>(POOLO, MIXED);
            break;
        case 3: nv::k_resid<<<dim3(D / 64, NTOK / 64), 256, 0, stream>>>(MIXED, WOUT, x, out, S0, SSQ1, SSQSB, SBW); break;
        case 4: nv::k_g3<<<dim3(D / 64, NTOK / 64), 256, 0, stream>>>(S0, WQ, SSQ1, QM); break;
        case 5:
            nv::k_ms<<<dim3(NMEM / 64, NTOK / 64, MH), 256, 0, stream>>>(QM, KM, SCR_S);
            nv::k_msoftmax<<<NTOK * MH / 4, 256, 0, stream>>>(SCR_S, PM);
            break;
        case 6: nv::k_mpv<<<dim3(MHD / 64, NTOK / 64, MH), 256, 0, stream>>>(PM, VMT, OM); break;
        case 7: nv::k_resid<<<dim3(D / 64, NTOK / 64), 256, 0, stream>>>(OM, WO, out, out, S0, SSQ2, SSQ2, -1); break;
        case 8: nv::k_route<<<NTOK / 4, 256, 0, stream>>>(out, SSQ2, WR, b_router, CNT, LSLOT, LGATE); break;
        case 9: nv::k_w1<<<dim3(DFF / 32, LCAP / 64, NE), 256, 0, stream>>>(S0, SSQ2, W1, b_e_in, CNT, LSLOT, ACT); break;
        case 10: nv::k_w2<<<dim3(D / 64, LCAP / 64, NE), 256, 0, stream>>>(ACT, W2, b_e_out, CNT, LSLOT, LGATE, Y); break;
        case 11: nv::k_final<<<NTOK / 4, 256, 0, stream>>>(out, Y, g_final); break;
        }
        ++p;
    }
}
```

```cpp
#include <hip/hip_runtime.h>
#include <cstdio>
#include <cstdint>

typedef unsigned short bf16_t;
typedef short bf16x8 __attribute__((ext_vector_type(8)));
typedef float f32x4 __attribute__((ext_vector_type(4)));
typedef unsigned u32x4 __attribute__((ext_vector_type(4)));

namespace cfg {
constexpr int B = 8, S = 4096, D = 1024, NTOK = B * S;
constexpr int SBW = 512, NH = 8, HD = 64, PW = 512, PG = 4, PGD = 128, INP = 2048;
constexpr int NMEM = 256, MH = 4, MHD = 256, NMROWS = B * NMEM;
constexpr int NE = 32, TOPK = 4, DFF = 1024, LCAP = NTOK;
constexpr float EPS = 1e-5f, LOG2E = 1.4426950408889634f;
constexpr float C2_SB = 0.125f * LOG2E, C2_MEM = 0.0625f * LOG2E;
constexpr float SW_LIMIT = 7.0f, SW_ALPHA = 1.702f;
constexpr int MAXTILES = 544;
constexpr size_t MiB = 1u << 20;
constexpr size_t WS_CTL = 0, CTL_BYTES = 2 * MiB;
constexpr size_t OFF_CNT = 64 * 1024, OFF_SSQSB = 512 * 1024, OFF_SSQ1 = 640 * 1024, OFF_SSQ2 = 768 * 1024;
constexpr size_t WS_WIN = 2 * MiB, WS_WOUT = 6 * MiB, WS_WQ = 8 * MiB, WS_WKV = 10 * MiB, WS_WO = 14 * MiB, WS_WP = 16 * MiB, WS_WR = 17 * MiB;
constexpr size_t WS_RSTDX = 18 * MiB, WS_RSTDM = 18 * MiB + 512 * 1024;
constexpr size_t WS_W1 = 20 * MiB, WS_W2 = 148 * MiB;
constexpr size_t WS_S0 = 212 * MiB;
constexpr size_t WS_QKVU = 276 * MiB;
constexpr size_t WS_QM = 276 * MiB, WS_OM = 340 * MiB;
constexpr size_t WS_MIXED = 404 * MiB;
constexpr size_t WS_PM = 404 * MiB;
constexpr size_t WS_ACT = 276 * MiB;
constexpr size_t WS_KM = 548 * MiB, WS_VMT = 552 * MiB, WS_MEMB = 556 * MiB, WS_LSLOT = 560 * MiB, WS_LGATE = 564 * MiB;
constexpr size_t WS_Y = 568 * MiB;
constexpr size_t WS_SCR_S = 568 * MiB, WS_SCR_POOLED = 696 * MiB, WS_SCR_POOLO = 728 * MiB;
constexpr size_t WS_END = 824 * MiB;
}
using namespace cfg;

__device__ __forceinline__ unsigned f2bf(float f) { unsigned u = __builtin_bit_cast(unsigned, f); return (u + 0x7fffu + ((u >> 16) & 1u)) >> 16; }
__device__ __forceinline__ float bf2f(bf16_t h) { return __builtin_bit_cast(float, (unsigned)h << 16); }
__device__ __forceinline__ float wave_sum(float v) {
#pragma unroll
    for (int o = 1; o < 64; o <<= 1) v += __shfl_xor(v, o);
    return v;
}

namespace nv {
__global__ void k_cvt_w(const float* src, int K, int N, bf16_t* dst, int ND, const float* gk, const float* gk2, int ksplit, const float* gn, int gnz, int mode) {
    __shared__ float t[32][33];
    const int nd0 = blockIdx.x * 32, k0 = blockIdx.y * 32, z = blockIdx.z;
    int ns0 = nd0;
    if (mode == 1) { const int pn = nd0 >> 8, j = nd0 & 255; ns0 = (j < 128) ? 128 * pn + j : 1024 + 128 * pn + (j - 128); }
    src += (size_t)z * K * N; dst += (size_t)z * ND * K;
    for (int i = threadIdx.y; i < 32; i += 8) { const int k = k0 + i, n = ns0 + threadIdx.x;
        float v = src[(size_t)k * N + n]; if (gk) v *= (k < ksplit) ? gk[k] : gk2[k - ksplit]; if (gn) v *= gn[z * gnz + n]; t[i][threadIdx.x] = v; }
    __syncthreads();
    for (int i = threadIdx.y; i < 32; i += 8) dst[(size_t)(nd0 + i) * K + k0 + threadIdx.x] = (bf16_t)f2bf(t[threadIdx.x][i]);
}
__global__ void k_cvt_router(const float* wr, const float* g, float* dst) {
    const int i = blockIdx.x * 256 + threadIdx.x; if (i >= NE * D) return; const int e = i / D, k = i % D; dst[i] = g[k] * wr[k * NE + e];
}
__global__ void k_rowstat_cvt(const float* x, bf16_t* xb, float* rstd, int rows) {
    const int row = blockIdx.x * 4 + (threadIdx.x >> 6), lane = threadIdx.x & 63; if (row >= rows) return;
    const float* xr = x + (size_t)row * D; float s = 0.f;
    for (int j = lane; j < D; j += 64) { const float v = xr[j]; s += v * v; xb[(size_t)row * D + j] = (bf16_t)f2bf(v); }
    s = wave_sum(s); if (lane == 0) rstd[row] = 1.0f / sqrtf(s * (1.0f / D) + EPS);
}

template <class RA, class RB, class MID, class EPI>
__device__ __forceinline__ void wave_gemm(int m0, int n0, int K, int kmid, RA ra, RB rb, MID mid, EPI epi) {
    const int lane = threadIdx.x & 63, r16 = lane & 15, kq = lane >> 4;
    const bf16_t* pa[2]; const bf16_t* pb[2];
#pragma unroll
    for (int i = 0; i < 2; ++i) { pa[i] = ra(m0 + i * 16 + r16) + kq * 8; pb[i] = rb(n0 + i * 16 + r16) + kq * 8; }
    f32x4 acc[2][2];
#pragma unroll
    for (int i = 0; i < 2; ++i)
#pragma unroll
        for (int j = 0; j < 2; ++j) acc[i][j] = (f32x4){0.f, 0.f, 0.f, 0.f};
    for (int k = 0; k < K; k += 32) {
        if (k == kmid) {
#pragma unroll
            for (int i = 0; i < 2; ++i)
#pragma unroll
                for (int r = 0; r < 4; ++r) { const float s = mid(m0 + i * 16 + kq * 4 + r); acc[i][0][r] *= s; acc[i][1][r] *= s; }
        }
        bf16x8 a[2], b[2];
#pragma unroll
        for (int i = 0; i < 2; ++i) { a[i] = *(const bf16x8*)(pa[i] + k); b[i] = *(const bf16x8*)(pb[i] + k); }
#pragma unroll
        for (int i = 0; i < 2; ++i)
#pragma unroll
            for (int j = 0; j < 2; ++j) acc[i][j] = __builtin_amdgcn_mfma_f32_16x16x32_bf16(a[i], b[j], acc[i][j], 0, 0, 0);
    }
#pragma unroll
    for (int i = 0; i < 2; ++i)
#pragma unroll
        for (int r = 0; r < 4; ++r) epi(m0 + i * 16 + kq * 4 + r, n0 + r16, n0 + 16 + r16, acc[i][0][r], acc[i][1][r]);
}
struct NoMid { __device__ float operator()(int) const { return 1.f; } };

#define NV_TILE() const int w = threadIdx.x >> 6, m0 = blockIdx.y * 64 + (w >> 1) * 32, n0 = blockIdx.x * 64 + (w & 1) * 32

__global__ void k_g1(const bf16_t* XB, const bf16_t* WT, const float* rstd, bf16_t* QKVU) {
    NV_TILE();
    wave_gemm(m0, n0, D, -1, [=](int r) { return XB + (size_t)r * D; }, [=](int c) { return WT + (size_t)c * D; }, NoMid(),
        [=](int r, int c0, int c1, float v0, float v1) { const float s = rstd[r];
            v0 *= s; v1 *= s; if (c0 < SBW) v0 *= C2_SB; if (c1 < SBW) v1 *= C2_SB;
            QKVU[(size_t)r * INP + c0] = (bf16_t)f2bf(v0); QKVU[(size_t)r * INP + c1] = (bf16_t)f2bf(v1); });
}
__global__ void k_g1b(const bf16_t* MEMB, const bf16_t* WT, const float* rstd, bf16_t* KM, bf16_t* VMT) {
    NV_TILE();
    wave_gemm(m0, n0, D, -1, [=](int r) { return MEMB + (size_t)r * D; }, [=](int c) { return WT + (size_t)c * D; }, NoMid(),
        [=](int r, int c0, int c1, float v0, float v1) { const float s = rstd[r]; const int cc[2] = {c0, c1}; const float vv[2] = {v0 * s, v1 * s};
#pragma unroll
            for (int q = 0; q < 2; ++q) { const int c = cc[q];
                if (c < D) KM[(size_t)r * D + c] = (bf16_t)f2bf(vv[q]);
                else VMT[((size_t)(r >> 8) * D + (c - D)) * NMEM + (r & 255)] = (bf16_t)f2bf(vv[q]); } });
}
__global__ void __launch_bounds__(256) k_sb(const bf16_t* QKVU, bf16_t* MIXED, float* SSQSB) {
    const int gid = blockIdx.x * 256 + threadIdx.x; const int t = gid & (S - 1), h = (gid >> 12) & 7, b = gid >> 15;
    const bf16_t* base = QKVU + (size_t)b * S * INP;
    float q[HD], o[HD];
    { const bf16_t* qp = base + (size_t)t * INP + h * HD;
#pragma unroll
      for (int d = 0; d < HD; ++d) { q[d] = bf2f(qp[d]); o[d] = 0.f; } }
    float P = 1.f;
    for (int s = t - 1; s >= 0; --s) {
        const bf16_t* kp = base + (size_t)s * INP + SBW + h * HD; const bf16_t* vp = kp + SBW;
        float z = 0.f;
#pragma unroll
        for (int d = 0; d < HD; ++d) z += q[d] * bf2f(kp[d]);
        const float e = exp2f(z), r = 1.0f / (1.0f + e), beta = 1.0f - r;
        const float w = bf2f((bf16_t)f2bf(beta * P));
#pragma unroll
        for (int d = 0; d < HD; ++d) o[d] += w * bf2f(vp[d]);
        P *= r;
        if (P == 0.f) break;
    }
    float ss = 0.f; bf16_t* op = MIXED + (size_t)(b * S + t) * D + h * HD;
#pragma unroll
    for (int d = 0; d < HD; ++d) { ss += o[d] * o[d]; op[d] = (bf16_t)f2bf(o[d]); }
    unsafeAtomicAdd(SSQSB + b * S + t, ss);
}
__global__ void k_pool1(const bf16_t* QKVU, bf16_t* POOLED) {
    const size_t gid = (size_t)blockIdx.x * 256 + threadIdx.x; const int c = gid & 511; const int tok = (int)(gid >> 9), t = tok & (S - 1);
    const int win = 2 << (c >> 7); const int n = (t + 1 < win) ? t + 1 : win;
    const bf16_t* up = QKVU + (size_t)tok * INP + 3 * SBW + c; float s = 0.f;
    for (int j = 0; j < n; ++j) s += bf2f(up[-(ptrdiff_t)j * INP]);
    POOLED[gid] = (bf16_t)f2bf(s / (float)n - bf2f(up[0]));
}
__global__ void k_pool2(const bf16_t* POOLED, const bf16_t* WPT, float* POOLO) {
    NV_TILE(); const int g = blockIdx.z;
    wave_gemm(m0, n0, PGD, -1, [=](int r) { return POOLED + (size_t)r * PW + g * PGD; }, [=](int c) { return WPT + ((size_t)g * PGD + c) * PGD; }, NoMid(),
        [=](int r, int c0, int c1, float v0, float v1) { POOLO[(size_t)r * PW + g * PGD + c0] = v0; POOLO[(size_t)r * PW + g * PGD + c1] = v1; });
}
__global__ void k_pool3(const float* POOLO, bf16_t* MIXED) {
    const int tok = blockIdx.x * 4 + (threadIdx.x >> 6), lane = threadIdx.x & 63;
    float v[8], s = 0.f;
#pragma unroll
    for (int j = 0; j < 8; ++j) { v[j] = POOLO[(size_t)tok * PW + lane + 64 * j]; s += v[j] * v[j]; }
    const float rs = 1.0f / sqrtf(wave_sum(s) * (1.0f / PW) + EPS);
#pragma unroll
    for (int j = 0; j < 8; ++j) MIXED[(size_t)tok * D + SBW + lane + 64 * j] = (bf16_t)f2bf(v[j] * rs);
}
__global__ void k_resid(const bf16_t* A, const bf16_t* WT, const float* xin, float* xout, bf16_t* XB, float* SSQ, const float* ssq_mid, int kmid) {
    NV_TILE();
    wave_gemm(m0, n0, D, kmid, [=](int r) { return A + (size_t)r * D; }, [=](int c) { return WT + (size_t)c * D; },
        [=](int r) { return 1.0f / sqrtf(ssq_mid[r] * (1.0f / SBW) + EPS); },
        [=](int r, int c0, int c1, float v0, float v1) {
            const float x0 = xin[(size_t)r * D + c0] + v0, x1 = xin[(size_t)r * D + c1] + v1;
            xout[(size_t)r * D + c0] = x0; xout[(size_t)r * D + c1] = x1;
            XB[(size_t)r * D + c0] = (bf16_t)f2bf(x0); XB[(size_t)r * D + c1] = (bf16_t)f2bf(x1);
            float q = x0 * x0 + x1 * x1; q += __shfl_xor(q, 1); q += __shfl_xor(q, 2); q += __shfl_xor(q, 4); q += __shfl_xor(q, 8);
            if ((threadIdx.x & 15) == 0) unsafeAtomicAdd(SSQ + r, q); });
}
__global__ void k_g3(const bf16_t* X1B, const bf16_t* WT, const float* SSQ1, bf16_t* QM) {
    NV_TILE();
    wave_gemm(m0, n0, D, -1, [=](int r) { return X1B + (size_t)r * D; }, [=](int c) { return WT + (size_t)c * D; }, NoMid(),
        [=](int r, int c0, int c1, float v0, float v1) { const float s = C2_MEM / sqrtf(SSQ1[r] * (1.0f / D) + EPS);
            QM[(size_t)r * D + c0] = (bf16_t)f2bf(v0 * s); QM[(size_t)r * D + c1] = (bf16_t)f2bf(v1 * s); });
}
__global__ void k_ms(const bf16_t* QM, const bf16_t* KM, float* SCR) {
    NV_TILE(); const int h = blockIdx.z; const int b = m0 >> 12;
    wave_gemm(m0, n0, MHD, -1, [=](int r) { return QM + (size_t)r * D + h * MHD; }, [=](int c) { return KM + ((size_t)b * NMEM + c) * D + h * MHD; }, NoMid(),
        [=](int r, int c0, int c1, float v0, float v1) { SCR[((size_t)r * MH + h) * NMEM + c0] = v0; SCR[((size_t)r * MH + h) * NMEM + c1] = v1; });
}
__global__ void k_msoftmax(const float* SCR, bf16_t* PM) {
    const int row = blockIdx.x * 4 + (threadIdx.x >> 6), lane = threadIdx.x & 63;
    float v[4], m = -INFINITY;
#pragma unroll
    for (int j = 0; j < 4; ++j) { v[j] = SCR[(size_t)row * NMEM + lane + 64 * j]; m = fmaxf(m, v[j]); }
#pragma unroll
    for (int o = 1; o < 64; o <<= 1) m = fmaxf(m, __shfl_xor(m, o));
    float s = 0.f;
#pragma unroll
    for (int j = 0; j < 4; ++j) { v[j] = exp2f(v[j] - m); s += v[j]; }
    s = 1.0f / wave_sum(s);
#pragma unroll
    for (int j = 0; j < 4; ++j) PM[(size_t)row * NMEM + lane + 64 * j] = (bf16_t)f2bf(v[j] * s);
}
__global__ void k_mpv(const bf16_t* PM, const bf16_t* VMT, bf16_t* OM) {
    NV_TILE(); const int h = blockIdx.z; const int b = m0 >> 12;
    wave_gemm(m0, n0, NMEM, -1, [=](int r) { return PM + ((size_t)r * MH + h) * NMEM; }, [=](int c) { return VMT + ((size_t)b * D + h * MHD + c) * NMEM; }, NoMid(),
        [=](int r, int c0, int c1, float v0, float v1) { OM[(size_t)r * D + h * MHD + c0] = (bf16_t)f2bf(v0); OM[(size_t)r * D + h * MHD + c1] = (bf16_t)f2bf(v1); });
}
__global__ void k_route(const float* x2, const float* SSQ2, const float* WR, const float* br, int* CNT, int* LSLOT, float* LGATE) {
    const int tok = blockIdx.x * 4 + (threadIdx.x >> 6), lane = threadIdx.x & 63;
    float xv[16];
#pragma unroll
    for (int j = 0; j < 16; ++j) xv[j] = x2[(size_t)tok * D + lane + 64 * j];
    const float rs = 1.0f / sqrtf(SSQ2[tok] * (1.0f / D) + EPS);
    float mine = 0.f;
    for (int e = 0; e < NE; ++e) { float s = 0.f;
#pragma unroll
        for (int j = 0; j < 16; ++j) s += xv[j] * WR[e * D + lane + 64 * j];
        s = wave_sum(s); if (lane == e) mine = s * rs + br[e]; }
    float tv[4]; int ti[4]; float cur = (lane < NE) ? mine : -INFINITY;
#pragma unroll
    for (int k = 0; k < 4; ++k) { float m = cur; int mi = lane;
#pragma unroll
        for (int o = 1; o < 64; o <<= 1) { const float om = __shfl_xor(m, o); const int oi = __shfl_xor(mi, o); if (om > m || (om == m && oi < mi)) { m = om; mi = oi; } }
        tv[k] = m; ti[k] = mi; if (lane == mi) cur = -INFINITY; }
    float g[4], gs = 0.f;
#pragma unroll
    for (int k = 0; k < 4; ++k) { g[k] = expf(tv[k] - tv[0]); gs += g[k]; }
    if (lane < 4) { int e = ti[0]; float gg = g[0];
        if (lane == 1) { e = ti[1]; gg = g[1]; } if (lane == 2) { e = ti[2]; gg = g[2]; } if (lane == 3) { e = ti[3]; gg = g[3]; }
        const int pos = atomicAdd(CNT + e, 1); LSLOT[(size_t)e * LCAP + pos] = tok * 4 + lane; LGATE[(size_t)e * LCAP + pos] = gg / gs; }
}
__device__ __forceinline__ int tile_base(const int* CNT, int e) { int tb = 0; for (int i = 0; i < e; ++i) tb += (CNT[i] + 255) >> 8; return tb; }
__global__ void k_w1(const bf16_t* X2B, const float* SSQ2, const bf16_t* W1T, const float* b1, const int* CNT, const int* LSLOT, bf16_t* ACT) {
    const int e = blockIdx.z, cnt = CNT[e]; const int w = threadIdx.x >> 6; const int m0 = blockIdx.y * 64 + (w >> 1) * 32; if (blockIdx.y * 64 >= cnt) return;
    const int gc0 = blockIdx.x * 32 + (w & 1) * 16;
    const int pn = gc0 >> 7, j0 = gc0 & 127; const int n0 = pn * 256 + j0;
    const int tb = tile_base(CNT, e); const bf16_t* Wt = W1T + (size_t)e * 2 * DFF * D; const int* ls = LSLOT + (size_t)e * LCAP;
    wave_gemm(m0, 0, D, -1, [=](int r) { const int tok = (r < cnt) ? (ls[r] >> 2) : 0; return X2B + (size_t)tok * D; },
        [=](int c) { const int rowb = (c < 16) ? n0 + c : n0 + 128 + (c - 16); return Wt + (size_t)rowb * D; }, NoMid(),
        [=](int r, int c0, int c1, float vg, float vu) { if (r >= cnt) return; const int tok = ls[r] >> 2; const float rs = 1.0f / sqrtf(SSQ2[tok] * (1.0f / D) + EPS);
            const int gc = gc0 + c0;
            float gate = vg * rs + b1[e * 2 * DFF + gc], up = vu * rs + b1[e * 2 * DFF + DFF + gc];
            gate = fminf(gate, SW_LIMIT); up = fminf(fmaxf(up, -SW_LIMIT), SW_LIMIT);
            const float act = (up + 1.0f) * gate / (1.0f + expf(-SW_ALPHA * gate));
            ACT[((size_t)tb * 256 + r) * DFF + gc] = (bf16_t)f2bf(act); (void)c1; });
}
__global__ void k_w2(const bf16_t* ACT, const bf16_t* W2T, const float* b2, const int* CNT, const int* LSLOT, const float* LGATE, bf16_t* Y) {
    const int e = blockIdx.z, cnt = CNT[e]; if (blockIdx.y * 64 >= cnt) return; NV_TILE();
    const int tb = tile_base(CNT, e); const bf16_t* Wt = W2T + (size_t)e * D * DFF; const int* ls = LSLOT + (size_t)e * LCAP; const float* lg = LGATE + (size_t)e * LCAP;
    wave_gemm(m0, n0, DFF, -1, [=](int r) { return ACT + ((size_t)tb * 256 + r) * DFF; }, [=](int c) { return Wt + (size_t)c * DFF; }, NoMid(),
        [=](int r, int c0, int c1, float v0, float v1) { if (r >= cnt) return; const int slot = ls[r]; const float g = lg[r];
            Y[(size_t)slot * D + c0] = (bf16_t)f2bf((v0 + b2[e * D + c0]) * g); Y[(size_t)slot * D + c1] = (bf16_t)f2bf((v1 + b2[e * D + c1]) * g); });
}
__global__ void k_final(float* out, const bf16_t* Y, const float* gf) {
    const int tok = blockIdx.x * 4 + (threadIdx.x >> 6), lane = threadIdx.x & 63;
    float v[16], s = 0.f;
#pragma unroll
    for (int j = 0; j < 16; ++j) { const int c = lane + 64 * j; float a = out[(size_t)tok * D + c];
#pragma unroll
        for (int k = 0; k < 4; ++k) a += bf2f(Y[((size_t)tok * 4 + k) * D + c]);
        v[j] = a; s += a * a; }
    const float rs = 1.0f / sqrtf(wave_sum(s) * (1.0f / D) + EPS);
#pragma unroll
    for (int j = 0; j < 16; ++j) { const int c = lane + 64 * j; out[(size_t)tok * D + c] = v[j] * rs * gf[c]; }
}
}

#define LAS __attribute__((address_space(3)))
#define GAS __attribute__((address_space(1)))
typedef int v4i_t __attribute__((ext_vector_type(4)));
typedef int v8i_t __attribute__((ext_vector_type(8)));
namespace pg8 {
constexpr int BM = 256, BK = 64, HALF = 128, HTB = HALF * BK * 2, STAGE_BYTES = 8 * HTB, NXCD = 8, WGM = 8;
__host__ __device__ __forceinline__ int lds_byte(int r, int c) { const int st = (r >> 4) * 2 + (c >> 5), rr = r & 15, cc = c & 31, ob = rr * 64 + cc * 2; return st * 1024 + (ob ^ (((ob >> 9) & 1) << 5)); }
__host__ __device__ __forceinline__ void stage_rc(int b, int& R, int& C) { const int st = b / 1024, sb = b % 1024, swz = sb ^ (((sb >> 9) & 1) << 5); R = (st >> 1) * 16 + swz / 64; C = (st & 1) * 32 + (swz % 64) / 2; }
__host__ __device__ __forceinline__ int perm32(int rho) { const int n = rho >> 4, i = rho & 15; return 8 * (i >> 2) + 4 * n + (i & 3); }
__device__ __forceinline__ unsigned cvt_pk_bf16(float lo, float hi) { unsigned r; asm volatile("v_cvt_pk_bf16_f32 %0, %1, %2" : "=v"(r) : "v"(lo), "v"(hi)); return r; }

#define WTMASK 0x008
#ifndef WTMASK
#define WTMASK 0x1ff
#endif
#define WT_ON(bit) (((WTMASK) >> (bit)) & 1)
__device__ __forceinline__ void st16_wt(void* p, u32x4 v) { asm volatile("global_store_dwordx4 %0, %1, off sc1\n\ts_nop 1" :: "v"(p), "v"(v)); }
__device__ __forceinline__ void st16_wt(void* p, f32x4 v) { asm volatile("global_store_dwordx4 %0, %1, off sc1\n\ts_nop 1" :: "v"(p), "v"(v)); }
template <int BIT, class V> __device__ __forceinline__ void st16(void* p, V v) { if constexpr (WT_ON(BIT)) st16_wt(p, v); else *(V*)p = v; }
#ifndef WT8
#define WT8 0
#endif
__device__ __forceinline__ void st8_wt(void* p, unsigned long long v) { if (WT8) __hip_atomic_store((unsigned long long*)p, v, __ATOMIC_RELAXED, __HIP_MEMORY_SCOPE_AGENT); else *(unsigned long long*)p = v; }
__device__ __forceinline__ void st4_wt(void* p, unsigned v) { if (WT8) __hip_atomic_store((unsigned*)p, v, __ATOMIC_RELAXED, __HIP_MEMORY_SCOPE_AGENT); else *(unsigned*)p = v; }
__device__ __forceinline__ int fresh_lane() { int l; asm volatile("v_mbcnt_lo_u32_b32 %0, -1, 0\n\tv_mbcnt_hi_u32_b32 %0, -1, %0" : "=v"(l)); return l; }
struct Unit { const char* A; const char* B; void* p0; void* p1; void* p2; void* p3; int pm, pn, i0, i1, ghost; };

__device__ __forceinline__ int xcd_remap(int L, int nwg) { const int q = nwg / NXCD, r = nwg % NXCD, xcd = L % NXCD, off = L / NXCD; return __builtin_amdgcn_readfirstlane((xcd < r ? xcd * (q + 1) : r * (q + 1) + (xcd - r) * q) + off); }
__device__ __forceinline__ void grouped_mn(int wgid, int nM, int nN, int& pm, int& pn) {
    const int nig = WGM * nN, gid = wgid / nig, fm = gid * WGM, gsz = (nM - fm) < WGM ? (nM - fm) : WGM; pm = __builtin_amdgcn_readfirstlane(fm + ((wgid % nig) % gsz)); pn = __builtin_amdgcn_readfirstlane((wgid % nig) / gsz); }

template <class Epi, class Sched, int TABS, int REP = 1, int REPE = 1, bool F8 = false>
__device__ __forceinline__ void gemm_phase(const int wid, LAS unsigned char* lds, LAS unsigned char* epi_lds, LAS unsigned* gtab, const int lda_b, const int ldb_b, const int nt, const Sched& S, const Epi& E) {
    constexpr bool GATHER = (TABS == 1);
    const int wr = wid >> 2, wc = wid & 3;
    unsigned voffA, voffB, voffG[2][2]; int aoff, boff;
    { const int lane = fresh_lane(); int R, C; stage_rc(wid * 1024 + lane * 16, R, C); const int Rb = Epi::PERM ? ((R & ~31) + perm32(R & 31)) : R;
      voffA = (unsigned)(R * lda_b + C * 2); voffB = (unsigned)(Rb * ldb_b + C * 2); voffG[0][0] = voffG[0][1] = voffG[1][0] = voffG[1][1] = 0;
      aoff = lds_byte(wr * 64 + (lane & 15), (lane >> 4) * 8); boff = lds_byte(wc * 32 + (lane & 15), (lane >> 4) * 8); }
    const size_t kstep = (size_t)(BK * 2);
    const size_t hstepA = (size_t)HALF * lda_b, hstepB = (size_t)HALF * ldb_b;
    const unsigned ldsw = (unsigned)wid * 1024u; const unsigned ldsbase = (unsigned)(uintptr_t)lds + ldsw;
#define PG8_SA(b, h) (((b) * 2 + (h)) * HTB)
#define PG8_SB(b, h) ((4 + (b) * 2 + (h)) * HTB)
#define PG8_GLDS(ugp, voff, bufoff, _i) do { unsigned _keep; asm volatile("s_mov_b32 %0, m0\n\ts_mov_b32 m0, %3\n\ts_nop 0\n\tglobal_load_lds_dwordx4 %1, %2\n\ts_mov_b32 m0, %0" \
        : "=&s"(_keep) : "v"(voff), "s"((const char*)(ugp)), "s"(ldsbase + (unsigned)((bufoff) + (_i) * 8192)) : "memory"); } while (0)
#define PG8_STAGE_B(bufoff, gbase) do { _Pragma("unroll") for (int _i = 0; _i < 2; ++_i) PG8_GLDS((const char*)(gbase) + (size_t)_i * 64 * ldb_b, voffB, bufoff, _i); } while (0)
#define PG8_STAGE_A(bufoff, gbase, h) do { if constexpr (GATHER) { _Pragma("unroll") for (int _i = 0; _i < 2; ++_i) PG8_GLDS((const char*)(gbase), voffG[h][_i], bufoff, _i); } \
        else { _Pragma("unroll") for (int _i = 0; _i < 2; ++_i) PG8_GLDS((const char*)(gbase) + (h) * hstepA + (size_t)_i * 64 * lda_b, voffA, bufoff, _i); } } while (0)
#define PG8_LDA(dst, b, h) do { _Pragma("unroll") for (int m = 0; m < 4; ++m) _Pragma("unroll") for (int k = 0; k < 2; ++k) dst[m][k] = *(const LAS bf16x8*)(lds + PG8_SA(b, h) + aoff + m * 2048 + k * 1024); } while (0)
#define PG8_LDB(dst, b, h) do { _Pragma("unroll") for (int n = 0; n < 2; ++n) _Pragma("unroll") for (int k = 0; k < 2; ++k) dst[n][k] = *(const LAS bf16x8*)(lds + PG8_SB(b, h) + boff + n * 2048 + k * 1024); } while (0)
#define PG8_CAT(x0, x1) __builtin_shufflevector(__builtin_bit_cast(v4i_t, x0), __builtin_bit_cast(v4i_t, x1), 0, 1, 2, 3, 4, 5, 6, 7)
#define PG8_MMA(ai, bj, At, Bt) do { __builtin_amdgcn_s_setprio(1); _Pragma("unroll") for (int m = 0; m < 4; ++m) _Pragma("unroll") for (int n = 0; n < 2; ++n) { \
        if constexpr (F8) acc[ai][bj][m][n] = __builtin_amdgcn_mfma_scale_f32_16x16x128_f8f6f4(PG8_CAT(Bt[n][0], Bt[n][1]), PG8_CAT(At[m][0], At[m][1]), acc[ai][bj][m][n], 0, 0, 0, 0, 0, 0); \
        else { _Pragma("unroll") for (int k = 0; k < 2; ++k) acc[ai][bj][m][n] = __builtin_amdgcn_mfma_f32_16x16x32_bf16(Bt[n][k], At[m][k], acc[ai][bj][m][n], 0, 0, 0); } } __builtin_amdgcn_s_setprio(0); } while (0)
#define PG8_WAIT_V(n) asm volatile("s_waitcnt vmcnt(" #n ")" ::: "memory")
#define PG8_WAIT_L(n) asm volatile("s_waitcnt lgkmcnt(" #n ")" ::: "memory")
#define PG8_BAR __builtin_amdgcn_s_barrier()
#define PG8_SCHED __builtin_amdgcn_sched_barrier(0)
#define PG8_GTAB_LOAD(buf, nvalid) do { const int _l = fresh_lane(); int _R, _C; stage_rc(wid * 1024 + _l * 16, _R, _C); _Pragma("unroll") for (int _h = 0; _h < 2; ++_h) _Pragma("unroll") for (int _i = 0; _i < 2; ++_i) { \
        const int _row = _h * HALF + _R + 64 * _i; const unsigned _s = gtab[(buf) * 768 + _row]; voffG[_h][_i] = ((_row < (nvalid)) ? (_s >> 2) * (unsigned)lda_b : 0u) + (unsigned)(_C * 2); } } while (0)
#define PG8_GTAB_DMA(buf, U) do { if (wid < 3) { const int _l = fresh_lane(); const char* _src = (wid == 0) ? (const char*)(U).p3 + _l * 16 : (wid == 1) ? (const char*)(U).p2 + _l * 16 : \
            (TABS == 1 ? (const char*)(U).p1 + (_l & 31) * 16 + (_l >> 5) * (DFF * 4) : (const char*)(U).p1 + _l * 16); \
        __builtin_amdgcn_global_load_lds((const unsigned*)_src, (LAS unsigned*)(gtab + (buf) * 768 + wid * 256), 16, 0, 0); } } while (0)
    auto nextu = [&](int i, Unit& u) -> bool { if constexpr (REP > 1) { const bool ok = S.next(i / REP, u); u.ghost = (i % REP) != REP - 1; return ok; } else { u.ghost = 0; return S.next(i, u); } };
    Unit cur, nxt; int ui = 0;
    if (!nextu(0, cur)) return;
    f32x4 acc[2][2][4][2];
#pragma unroll
    for (int a = 0; a < 2; ++a)
#pragma unroll
        for (int b = 0; b < 2; ++b)
#pragma unroll
            for (int m = 0; m < 4; ++m)
#pragma unroll
                for (int n = 0; n < 2; ++n) acc[a][b][m][n] = (f32x4){0.f, 0.f, 0.f, 0.f};
    bf16x8 At[4][2], B0[2][2], B1[2][2];
    const char* cA = cur.A; const char* cB = cur.B;
    if constexpr (TABS != 0) { PG8_GTAB_DMA(0, cur); PG8_WAIT_V(0); PG8_WAIT_L(0); PG8_BAR; if constexpr (GATHER) PG8_GTAB_LOAD(0, cur.i0); }
    PG8_STAGE_B(PG8_SB(0, 0), cB); PG8_STAGE_B(PG8_SB(0, 1), cB + hstepB); PG8_STAGE_A(PG8_SA(0, 0), cA, 0); PG8_STAGE_A(PG8_SA(0, 1), cA, 1);
    if (wr == 1) PG8_BAR;
    PG8_WAIT_V(2); PG8_BAR;
    PG8_STAGE_B(PG8_SB(1, 0), cB + kstep); PG8_STAGE_A(PG8_SA(1, 0), cA + kstep, 0); PG8_STAGE_B(PG8_SB(1, 1), cB + hstepB + kstep);
    PG8_WAIT_V(6); PG8_BAR;
    for (;;) {
        const bool has_next = nextu(ui + 1, nxt);
        const char* nA = has_next ? nxt.A : cA; const char* nB = has_next ? nxt.B : cB;
#pragma unroll 1
        for (int t = 0; t < nt; t += 2) {
            const bool last = (t == nt - 2);
            const char* a1 = cA + (size_t)(t + 1) * kstep;
            const char* a2 = last ? nA : cA + (size_t)(t + 2) * kstep; const char* b2 = last ? nB : cB + (size_t)(t + 2) * kstep;
            const char* a3 = a2 + kstep; const char* b3 = b2 + kstep;
            if constexpr (Epi::MIDK >= 0) { if (t == Epi::MIDK) E.midk(acc, cur, wr, fresh_lane() & 15); }
            if constexpr (TABS != 0) { if (t == 2 && has_next) PG8_GTAB_DMA((ui + 1) & 1, nxt); }
            if constexpr (GATHER) { PG8_STAGE_A(PG8_SA(1, 1), a1, 1); if (last && has_next) PG8_GTAB_LOAD((ui + 1) & 1, nxt.i0); PG8_SCHED; }
            PG8_LDB(B0, 0, 0); PG8_LDB(B1, 0, 1); PG8_SCHED; PG8_LDA(At, 0, 0); if constexpr (!GATHER) PG8_STAGE_A(PG8_SA(1, 1), a1, 1);
            PG8_WAIT_V(8); PG8_WAIT_L(0); PG8_BAR; PG8_MMA(0, 0, At, B0); PG8_MMA(0, 1, At, B1); PG8_BAR; PG8_SCHED;
            PG8_LDA(At, 0, 1); PG8_STAGE_B(PG8_SB(0, 0), b2); PG8_STAGE_B(PG8_SB(0, 1), b2 + hstepB); PG8_STAGE_A(PG8_SA(0, 0), a2, 0);
            PG8_WAIT_V(8); PG8_WAIT_L(0); PG8_BAR; PG8_MMA(1, 0, At, B0); PG8_MMA(1, 1, At, B1); PG8_BAR; PG8_SCHED;
            PG8_LDB(B0, 1, 0); PG8_LDB(B1, 1, 1); PG8_SCHED; PG8_LDA(At, 1, 0); PG8_STAGE_A(PG8_SA(0, 1), a2, 1);
            PG8_WAIT_V(8); PG8_WAIT_L(0); PG8_BAR; PG8_MMA(0, 0, At, B0); PG8_MMA(0, 1, At, B1); PG8_BAR; PG8_SCHED;
            PG8_LDA(At, 1, 1); PG8_STAGE_B(PG8_SB(1, 0), b3); PG8_STAGE_B(PG8_SB(1, 1), b3 + hstepB); PG8_STAGE_A(PG8_SA(1, 0), a3, 0);
            PG8_WAIT_V(8); PG8_WAIT_L(0); PG8_BAR; PG8_MMA(1, 0, At, B0); PG8_MMA(1, 1, At, B1); PG8_BAR; PG8_SCHED;
        }
        if (wr == 0) PG8_BAR;
        if (!cur.ghost) { const int el = fresh_lane(); LAS unsigned char* ex = (TABS != 0) ? (LAS unsigned char*)(gtab + (ui & 1) * 768) : epi_lds; E(acc, cur, wr, wc, el & 15, el >> 4, wid, el, ex); if constexpr (REPE > 1) { asm volatile("" ::: "memory"); E(acc, cur, wr, wc, el & 15, el >> 4, wid, el, ex); } }
        if (!has_next) break;
#pragma unroll
        for (int a = 0; a < 2; ++a)
#pragma unroll
            for (int b = 0; b < 2; ++b)
#pragma unroll
                for (int m = 0; m < 4; ++m)
#pragma unroll
                    for (int n = 0; n < 2; ++n) acc[a][b][m][n] = (f32x4){0.f, 0.f, 0.f, 0.f};
        cur = nxt; cA = nA; cB = nB; ++ui;
        if (wr == 1) PG8_BAR;
    }
    PG8_WAIT_V(0);
    PG8_BAR;
#undef PG8_SA
#undef PG8_SB
#undef PG8_GLDS
#undef PG8_STAGE_A
#undef PG8_STAGE_B
#undef PG8_LDA
#undef PG8_LDB
#undef PG8_MMA
#undef PG8_CAT
#undef PG8_WAIT_V
#undef PG8_WAIT_L
#undef PG8_BAR
#undef PG8_SCHED
#undef PG8_GTAB_LOAD
#undef PG8_GTAB_DMA
}

template <bool F8O> struct EpiBf16SX {
    static constexpr bool PERM = true; static constexpr int MIDK = -1;
    __device__ __forceinline__ void midk(f32x4 (&)[2][2][4][2], const Unit&, int, int) const {}
    __device__ __forceinline__ void operator()(const f32x4 (&acc)[2][2][4][2], const Unit& u, int wr, int wc, int fr, int fq, int, int, LAS unsigned char*) const {
        bf16_t* O = (bf16_t*)u.p0; unsigned char* O8 = (unsigned char*)u.p0; const float* rs = (const float*)u.p1; const float* cs = (const float*)u.p2; const int ldc = u.i0;
        int r0 = wr * 64 + fr, c0 = wc * 32 + 8 * fq; asm volatile("" : "+v"(r0), "+v"(c0));
        f32x4 cv[2][2];
#pragma unroll
        for (int bj = 0; bj < 2; ++bj)
#pragma unroll
            for (int n = 0; n < 2; ++n) cv[bj][n] = cs ? *(const f32x4*)(cs + c0 + bj * HALF + 4 * n) : (f32x4){1.f, 1.f, 1.f, 1.f};
#pragma unroll
        for (int ai = 0; ai < 2; ++ai)
#pragma unroll
            for (int m = 0; m < 4; ++m) { const int r = r0 + ai * HALF + m * 16; const float rv = rs ? rs[r] : 1.f; bf16_t* rowp = O + (size_t)r * ldc + c0;
#pragma unroll
                for (int bj = 0; bj < 2; ++bj) { const f32x4 v0 = acc[ai][bj][m][0] * cv[bj][0] * rv, v1 = acc[ai][bj][m][1] * cv[bj][1] * rv;
                    if constexpr (F8O) { int w0 = __builtin_amdgcn_cvt_pk_fp8_f32(v0[0], v0[1], 0, false); w0 = __builtin_amdgcn_cvt_pk_fp8_f32(v0[2], v0[3], w0, true); int w1 = __builtin_amdgcn_cvt_pk_fp8_f32(v1[0], v1[1], 0, false); w1 = __builtin_amdgcn_cvt_pk_fp8_f32(v1[2], v1[3], w1, true);
                        st8_wt(O8 + (size_t)r * ldc + c0 + bj * HALF, (unsigned long long)(unsigned)w0 | ((unsigned long long)(unsigned)w1 << 32)); }
                    else { u32x4 w; w.x = cvt_pk_bf16(v0[0], v0[1]); w.y = cvt_pk_bf16(v0[2], v0[3]); w.z = cvt_pk_bf16(v1[0], v1[1]); w.w = cvt_pk_bf16(v1[2], v1[3]);
                    st16<1>(rowp + bj * HALF, w); } } }
    }
};
typedef EpiBf16SX<false> EpiBf16S;
}

namespace mk {
constexpr int NWAVES = 8, NPHASE = 12;
constexpr int RING_OFF = 0, RING_BYTES = 131072, EPI_OFF = 131072, EPI_BYTES = 8192, GTAB_OFF = EPI_OFF + EPI_BYTES, GTAB_BYTES = 6144, MISC_OFF = GTAB_OFF + GTAB_BYTES, MISC_BYTES = 1024;
constexpr int LDS_BYTES = 147456;
static_assert(MISC_OFF + MISC_BYTES <= LDS_BYTES, "LDS map");
constexpr size_t WS_LRS = 84 * MiB;
constexpr size_t WS_X2F8 = WS_Y, WS_X1F8 = WS_Y + 32 * MiB;
constexpr size_t WS_CSG1 = 19 * MiB, WS_WRH = 19 * MiB + 64 * 1024, WS_WRL = 19 * MiB + 128 * 1024;
typedef unsigned ssq_t;
constexpr size_t MK_SSQSB = 256 * 1024, MK_SSQ1 = 512 * 1024, MK_SSQ2 = 768 * 1024;
__device__ __forceinline__ void ssq_add(ssq_t* p, float q) { (void)__hip_atomic_fetch_add(p, (ssq_t)__float2uint_rn(q * 16384.0f), __ATOMIC_RELAXED, __HIP_MEMORY_SCOPE_AGENT); }
__device__ __forceinline__ float ssq_get(const ssq_t* p) { return (float)(*p) * (1.0f / 16384.0f); }
constexpr float WSCALE = 32.0f;
constexpr int P0_DEFER = 192 * 8 * 6;
constexpr int CW_BAR = 1024;

#define RLX_AGENT __ATOMIC_RELAXED, __HIP_MEMORY_SCOPE_AGENT
#define LDS_WAIT() asm volatile("s_waitcnt lgkmcnt(0)" ::: "memory")
#define VM_WAIT() asm volatile("s_waitcnt vmcnt(0)" ::: "memory")
#define XB_TMO      128
#define XB_XCNT(j)  (256  + 64 * (j))
#define XB_XSUB(j)  (1280 + 64 * (j))
#define XB_XGEN(j)  (2304 + 64 * (j))
#define XB_TOP      3328
#define XB_TOPGEN   3392
#define XCD_BAR_WORDS 3456
#define XB_SPIN_CAP (1u << 20)
__device__ __forceinline__ unsigned xb_ld(unsigned* p)              { return __hip_atomic_load(p, __ATOMIC_RELAXED, __HIP_MEMORY_SCOPE_AGENT); }
__device__ __forceinline__ unsigned xb_add(unsigned* p, unsigned v) { return __hip_atomic_fetch_add(p, v, __ATOMIC_RELAXED, __HIP_MEMORY_SCOPE_AGENT); }
__device__ __forceinline__ unsigned xb_xcc_id() { return (unsigned)__builtin_amdgcn_s_getreg((3 << 11) | 20) & 0xFu; }
#define XB_SPIN(cond, bar) do { unsigned _sp = 0; while (cond) { __builtin_amdgcn_s_sleep(1); \
    if ((++_sp & 255u) == 0u) { if (xb_ld(&(bar)[XB_TMO])) break; if (_sp > XB_SPIN_CAP) { atomicAdd(&(bar)[XB_TMO], 1u); break; } } } } while (0)
struct XcdBarrier { unsigned* bar; unsigned x; volatile LAS unsigned* st; };
__device__ __forceinline__ XcdBarrier xcd_barrier_post(unsigned* bar, volatile LAS unsigned* st) {
    XcdBarrier b; b.bar = bar; b.x = xb_xcc_id(); b.st = st;
    if (threadIdx.x == 0) (void)xb_add(&bar[XB_XCNT(b.x)], 1u);
    return b;
}
__device__ __forceinline__ void xcd_barrier_complete(unsigned* bar, unsigned x, unsigned& nloc, unsigned& nx) {
    const unsigned G = gridDim.x * gridDim.y * gridDim.z;
    unsigned sum, cnt, mine, sp = 0u;
    for (;;) {
        sum = 0u; cnt = 0u; mine = 0u;
#pragma unroll
        for (unsigned j = 0; j < 16; ++j) { const unsigned c = xb_ld(&bar[XB_XCNT(j)]); sum += c; cnt += (c > 0u) ? 1u : 0u; mine = (j == x) ? c : mine; }
        if (sum == G) break;
        __builtin_amdgcn_s_sleep(1);
        if ((++sp & 255u) == 0u) { if (xb_ld(&bar[XB_TMO])) break; if (sp > XB_SPIN_CAP) { atomicAdd(&bar[XB_TMO], 1u); break; } }
    }
    nloc = mine > 0u ? mine : 1u; nx = cnt > 0u ? cnt : 1u;
}
__device__ __forceinline__ void xcd_barrier(const XcdBarrier& b) {
    asm volatile("s_waitcnt vmcnt(0)" ::: "memory");
    __syncthreads();
    if (threadIdx.x == 0) {
        unsigned* bar = b.bar;
        __builtin_amdgcn_s_waitcnt(0);
        unsigned nloc = b.st[0], nx = b.st[1];
        if (nloc == 0u) { xcd_barrier_complete(bar, b.x, nloc, nx); b.st[0] = nloc; b.st[1] = nx; }
        const unsigned old = xb_add(&bar[XB_XSUB(b.x)], 1u);
        const unsigned gen = old / nloc;
        if (old + 1u == (gen + 1u) * nloc) {
            __builtin_amdgcn_fence(__ATOMIC_RELEASE, "agent");
            asm volatile("s_waitcnt vmcnt(0)" ::: "memory");
            const unsigned og = xb_add(&bar[XB_TOP], 1u);
            const unsigned tg = og / nx;
            if (og + 1u == (tg + 1u) * nx) xb_add(&bar[XB_TOPGEN], 1u);
            else XB_SPIN(xb_ld(&bar[XB_TOPGEN]) == tg, bar);
            __builtin_amdgcn_fence(__ATOMIC_ACQUIRE, "agent");
            xb_add(&bar[XB_XGEN(b.x)], 1u);
            asm volatile("s_waitcnt vmcnt(0)" ::: "memory");
        } else {
            XB_SPIN(xb_ld(&bar[XB_XGEN(b.x)]) == gen, bar);
            __builtin_amdgcn_fence(__ATOMIC_ACQUIRE, "agent");
            asm volatile("s_waitcnt vmcnt(0)" ::: "memory");
        }
    }
    __syncthreads();
}

struct Args { const float* in[22]; float* out; unsigned char* ws; int ph_lo, ph_hi, li, pad; };

template <bool F8OUT>
__device__ __forceinline__ void p0_item(const float* W, int K, int N, void* WTv, const float* gk, const float* gk2, int ksplit, const float* gn, int mode, LAS float* scr, int item, int lane, float mult = 1.0f, int nblk_dec = 0) {
    const int nblk = nblk_dec ? nblk_dec : N / 32, kb = item / nblk, nb = item % nblk, k0 = 64 * kb, nd0 = 32 * nb;
    int ns0 = nd0; if (mode == 1) { const int pn = nd0 >> 8, j = nd0 & 255; ns0 = (j < 128) ? 128 * pn + j : 1024 + 128 * pn + (j - 128); }
    const int kr = lane >> 3, n4 = (lane & 7) * 4;
    f32x4 v[8];
#pragma unroll
    for (int i = 0; i < 8; ++i) v[i] = *(const f32x4*)(W + (size_t)(k0 + 8 * i + kr) * N + ns0 + n4);
    f32x4 gnv = (f32x4){1.f, 1.f, 1.f, 1.f}; if (gn) gnv = *(const f32x4*)(gn + ns0 + n4);
#pragma unroll
    for (int i = 0; i < 8; ++i) { const int kk = 8 * i + kr, k = k0 + kk; float g = 1.f; if (gk) g = (k < ksplit) ? gk[k] : gk2[k - ksplit];
        const f32x4 t = v[i] * gnv * (g * mult); LAS float* d = scr + kk * 33 + n4; d[0] = t[0]; d[1] = t[1]; d[2] = t[2]; d[3] = t[3]; }
    LDS_WAIT(); asm volatile("" ::: "memory");
    const int c = lane & 7;
#pragma unroll
    for (int j = 0; j < 4; ++j) { const int n = (lane >> 3) + 8 * j; const LAS float* s = scr + (8 * c) * 33 + n;
        if constexpr (F8OUT) { int lo = __builtin_amdgcn_cvt_pk_fp8_f32(s[0 * 33], s[1 * 33], 0, false); lo = __builtin_amdgcn_cvt_pk_fp8_f32(s[2 * 33], s[3 * 33], lo, true);
            int hi2 = __builtin_amdgcn_cvt_pk_fp8_f32(s[4 * 33], s[5 * 33], 0, false); hi2 = __builtin_amdgcn_cvt_pk_fp8_f32(s[6 * 33], s[7 * 33], hi2, true);
            pg8::st8_wt((unsigned char*)WTv + (size_t)(nd0 + n) * K + k0 + 8 * c, (unsigned long long)(unsigned)lo | ((unsigned long long)(unsigned)hi2 << 32)); }
        else { u32x4 o; o.x = pg8::cvt_pk_bf16(s[0 * 33], s[1 * 33]); o.y = pg8::cvt_pk_bf16(s[2 * 33], s[3 * 33]); o.z = pg8::cvt_pk_bf16(s[4 * 33], s[5 * 33]); o.w = pg8::cvt_pk_bf16(s[6 * 33], s[7 * 33]);
            pg8::st16<0>((bf16_t*)WTv + (size_t)(nd0 + n) * K + k0 + 8 * c, o); } }
    LDS_WAIT(); asm volatile("" ::: "memory");
}
__device__ __forceinline__ void p0_fused_pool_item(const float* w_in, const float* g_mix, const float* w_pool, const float* pool_scale, bf16_t* WIN_T, int item, int lane) {
    const int eb = item & 7, kb = (item >> 3) & 15, g = item >> 7; const int k = kb * 64 + lane, e0 = eb * 16;
    const float* ap = w_in + (size_t)k * INP + 3 * SBW + g * PGD; const float* bp = w_pool + (size_t)g * PGD * PGD + e0;
    float acc[16];
#pragma unroll
    for (int j = 0; j < 16; ++j) acc[j] = 0.f;
#pragma unroll 4
    for (int c = 0; c < PGD; ++c) { const float a = ap[c];
#pragma unroll
        for (int j = 0; j < 16; ++j) acc[j] += a * bp[c * PGD + j]; }
    const float gk = g_mix[k];
#pragma unroll
    for (int j = 0; j < 16; ++j) WIN_T[(size_t)(3 * SBW + g * PGD + e0 + j) * D + k] = (bf16_t)f2bf(acc[j] * gk * pool_scale[g * PGD + e0 + j]);
}
__device__ __forceinline__ void p0_row(const float* xrow, bf16_t* orow, float* rstd, int lane) {
    const f32x4* xr = (const f32x4*)xrow + 2 * lane; f32x4 v[4]; float s = 0.f;
#pragma unroll
    for (int j = 0; j < 4; ++j) { v[j] = xr[(j >> 1) * 128 + (j & 1)]; s += (v[j].x * v[j].x + v[j].y * v[j].y) + (v[j].z * v[j].z + v[j].w * v[j].w); }
    s = wave_sum(s); if (lane == 0) *rstd = 1.0f / sqrtf(s * (1.0f / D) + EPS);
#pragma unroll
    for (int j = 0; j < 2; ++j) { u32x4 o; o.x = pg8::cvt_pk_bf16(v[2 * j].x, v[2 * j].y); o.y = pg8::cvt_pk_bf16(v[2 * j].z, v[2 * j].w); o.z = pg8::cvt_pk_bf16(v[2 * j + 1].x, v[2 * j + 1].y); o.w = pg8::cvt_pk_bf16(v[2 * j + 1].z, v[2 * j + 1].w);
        pg8::st16<0>(orow + j * 512 + 8 * lane, o); }
}
__device__ __forceinline__ void p0_prologue(const Args& a, LAS unsigned char* lds, int vcu, int G, int wave, int lane) {
    unsigned char* ws = a.ws;
    LAS float* scr = (LAS float*)(lds + RING_OFF + wave * 16384);
    const int gw = vcu * NWAVES + wave, NGW = G * NWAVES;
    constexpr int I_E1 = (D / 64) * (2 * DFF / 32), I_E2 = (DFF / 64) * (D / 32);
    constexpr int I_IN = (D / 64) * (3 * SBW / 32), I_FP = PG * 16 * 8, I_SQ = (D / 64) * (D / 32), I_KV = (D / 64) * (2 * D / 32), I_P = (PGD / 64) * (PGD / 32);
    constexpr int N1 = NE * I_E1, N2 = NE * I_E2, NITEMS = N1 + N2 + I_IN + 3 * I_SQ + I_KV + I_FP;
    const int BIG = 1 << 30;
    for (int it = gw; it < NITEMS; it += NGW) {
        int r = it;
        if (r < N1 + N2 && r >= N1 + N2 - P0_DEFER) continue;
        if (r < N1) { const int e = r / I_E1; p0_item<true>(a.in[17] + (size_t)e * D * 2 * DFF, D, 2 * DFF, ws + WS_W1 + (size_t)e * 2 * DFF * D, a.in[14], nullptr, BIG, nullptr, 1, scr, r % I_E1, lane, WSCALE); continue; } r -= N1;
        if (r < N2) { const int e = r / I_E2; p0_item<true>(a.in[19] + (size_t)e * DFF * D, DFF, D, ws + WS_W2 + (size_t)e * D * DFF, nullptr, nullptr, BIG, nullptr, 0, scr, r % I_E2, lane, WSCALE); continue; } r -= N2;
        if (r < I_IN) { p0_item<false>(a.in[3], D, INP, (bf16_t*)(ws + WS_WIN), a.in[2], nullptr, BIG, nullptr, 0, scr, r, lane, 1.0f, 3 * SBW / 32); continue; } r -= I_IN;
        if (r < I_SQ) { p0_item<false>(a.in[8], D, D, (bf16_t*)(ws + WS_WOUT), a.in[4], a.in[5], SBW, nullptr, 0, scr, r, lane); continue; } r -= I_SQ;
        if (r < I_SQ) { p0_item<true>(a.in[11], D, D, ws + WS_WQ, a.in[9], nullptr, BIG, nullptr, 0, scr, r, lane, WSCALE); continue; } r -= I_SQ;
        if (r < I_KV) { p0_item<false>(a.in[12], D, 2 * D, (bf16_t*)(ws + WS_WKV), a.in[10], nullptr, BIG, nullptr, 0, scr, r, lane); continue; } r -= I_KV;
        if (r < I_SQ) { p0_item<false>(a.in[13], D, D, (bf16_t*)(ws + WS_WO), nullptr, nullptr, BIG, nullptr, 0, scr, r, lane); continue; } r -= I_SQ;
        p0_fused_pool_item(a.in[3], a.in[2], a.in[6], a.in[7], (bf16_t*)(ws + WS_WIN), r, lane);
    }
    for (int m = gw; m < NTOK; m += NGW) p0_row(a.in[0] + (size_t)m * D, (bf16_t*)(ws + WS_S0) + (size_t)m * D, (float*)(ws + WS_RSTDX) + m, lane);
    for (int m = gw; m < NMROWS; m += NGW) p0_row(a.in[1] + (size_t)m * D, (bf16_t*)(ws + WS_MEMB) + (size_t)m * D, (float*)(ws + WS_RSTDM) + m, lane);
    const int gt = gw * 64 + lane, NGT = NGW * 64;
    for (int i = gt; i < INP; i += NGT) ((float*)(ws + WS_CSG1))[i] = (i < SBW) ? C2_SB : 1.0f;
    for (int i = gt; i < NE * D; i += NGT) { const int e = i / D, k = i % D; const float v = a.in[14][k] * a.in[15][k * NE + e];
        ((float*)(ws + WS_WR))[i] = v; const unsigned h = f2bf(v); ((bf16_t*)(ws + WS_WRH))[i] = (bf16_t)h; ((bf16_t*)(ws + WS_WRL))[i] = (bf16_t)f2bf(v - bf2f((bf16_t)h)); }
}

__device__ __forceinline__ void p1_deferred_items(const Args& a, LAS unsigned char* lds, int rank  , int wave, int lane) {
    constexpr int I_E2 = (DFF / 64) * (D / 32), N2 = NE * I_E2;
    LAS float* scr = (LAS float*)(lds + RING_OFF + wave * 16384);
    for (int k = 0; k < P0_DEFER / (192 * 8); ++k) { const int r = N2 - P0_DEFER + (k * 192 + rank) * 8 + wave; const int e = r / I_E2;
        p0_item<true>(a.in[19] + (size_t)e * DFF * D, DFF, D, a.ws + WS_W2 + (size_t)e * D * DFF, nullptr, nullptr, 1 << 30, nullptr, 0, scr, r % I_E2, lane, WSCALE); }
}
struct SchedP1 {
    int G, c; unsigned char* ws;
    __device__ __forceinline__ bool next(int i, pg8::Unit& u) const {
        const int L = i * G + c; constexpr int NQ = (NTOK / 256) * (INP / 256);
        if (L >= NQ + 64) return false;
        if (L < NQ) { int pm, pn; pg8::grouped_mn(pg8::xcd_remap(L, NQ), NTOK / 256, INP / 256, pm, pn);
            u.A = (const char*)(ws + WS_S0) + (size_t)pm * 256 * D * 2; u.B = (const char*)(ws + WS_WIN) + (size_t)pn * 256 * D * 2;
            u.p0 = (bf16_t*)(ws + WS_QKVU) + (size_t)pm * 256 * INP + pn * 256; u.p1 = (float*)(ws + WS_RSTDX) + pm * 256; u.p2 = (float*)(ws + WS_CSG1) + pn * 256; u.i0 = INP; u.pm = pm; u.pn = pn; }
        else if (L < NQ + 32) { const int k = L - NQ, pm = k >> 2, pn = k & 3;
            u.A = (const char*)(ws + WS_MEMB) + (size_t)pm * 256 * D * 2; u.B = (const char*)(ws + WS_WKV) + (size_t)pn * 256 * D * 2;
            u.p0 = (bf16_t*)(ws + WS_KM) + (size_t)pm * 256 * D + pn * 256; u.p1 = (float*)(ws + WS_RSTDM) + pm * 256; u.p2 = nullptr; u.i0 = D; u.pm = pm; u.pn = pn; }
        else { const int v = L - NQ - 32, b = v >> 2, dt = v & 3;
            u.A = (const char*)(ws + WS_WKV) + (size_t)(D + dt * 256) * D * 2; u.B = (const char*)(ws + WS_MEMB) + (size_t)b * 256 * D * 2;
            u.p0 = (bf16_t*)(ws + WS_VMT) + ((size_t)b * D + dt * 256) * NMEM; u.p1 = nullptr; u.p2 = (float*)(ws + WS_RSTDM) + b * 256; u.i0 = NMEM; u.pm = dt; u.pn = b; }
        u.p3 = nullptr; u.i1 = 0; return true;
    }
};
#define EPI_BAR() asm volatile("s_waitcnt lgkmcnt(0)\n\ts_barrier" ::: "memory")
struct SchedReg {
    int G, c, nM, nN; const char* A; const char* B; size_t astep, bstep; bf16_t* O; int ldc; const float* rs; const float* cs; const ssq_t* sq = nullptr;
    __device__ __forceinline__ bool next(int i, pg8::Unit& u) const {
        const int L = i * G + c; if (L >= nM * nN) return false; int pm, pn; pg8::grouped_mn(pg8::xcd_remap(L, nM * nN), nM, nN, pm, pn);
        u.A = A + (size_t)pm * astep; u.B = B + (size_t)pn * bstep; u.pm = pm; u.pn = pn; u.i0 = ldc; u.i1 = 0;
        u.p0 = O ? (void*)(O + (size_t)pm * 256 * ldc + pn * 256) : nullptr; u.p1 = sq ? (void*)(sq + pm * 256) : (rs ? (void*)(rs + pm * 256) : nullptr); u.p2 = cs ? (void*)(cs + pn * 256) : nullptr; u.p3 = nullptr; return true;
    }
};
struct EpiBf16Ssq {
    static constexpr bool PERM = true; static constexpr int MIDK = -1; float inv_n, mult;
    __device__ __forceinline__ void midk(f32x4 (&)[2][2][4][2], const pg8::Unit&, int, int) const {}
    __device__ __forceinline__ void operator()(f32x4 (&acc)[2][2][4][2], const pg8::Unit& u, int wr, int wc, int fr, int fq, int, int, LAS unsigned char*) const {
        bf16_t* O = (bf16_t*)u.p0; const ssq_t* sq = (const ssq_t*)u.p1; const int ldc = u.i0; int r0 = wr * 64 + fr, c0 = wc * 32 + 8 * fq; asm volatile("" : "+v"(r0), "+v"(c0));
#pragma unroll
        for (int ai = 0; ai < 2; ++ai)
#pragma unroll
            for (int m = 0; m < 4; ++m) { const int r = r0 + ai * 128 + m * 16; const float rv = mult / sqrtf(ssq_get(sq + r) * inv_n + EPS); bf16_t* rowp = O + (size_t)r * ldc + c0;
#pragma unroll
                for (int bj = 0; bj < 2; ++bj) { const f32x4 v0 = acc[ai][bj][m][0] * rv, v1 = acc[ai][bj][m][1] * rv;
                    u32x4 w; w.x = pg8::cvt_pk_bf16(v0[0], v0[1]); w.y = pg8::cvt_pk_bf16(v0[2], v0[3]); w.z = pg8::cvt_pk_bf16(v1[0], v1[1]); w.w = pg8::cvt_pk_bf16(v1[2], v1[3]);
                    pg8::st16<5>(rowp + bj * 128, w); } }
    }
};
template <int MIDK_, bool XIN_BF16, bool F8OUT> struct EpiResid {
    static constexpr bool PERM = true; static constexpr int MIDK = MIDK_;
    const float* xin; bf16_t* xb; unsigned char* x8; ssq_t* ssq; const ssq_t* ssq_mid; float accs;
    __device__ __forceinline__ void midk(f32x4 (&acc)[2][2][4][2], const pg8::Unit& u, int wr, int fr) const {
#pragma unroll
        for (int ai = 0; ai < 2; ++ai)
#pragma unroll
            for (int m = 0; m < 4; ++m) { const int r = u.pm * 256 + ai * 128 + wr * 64 + m * 16 + fr; const float s = 1.0f / sqrtf(ssq_get(ssq_mid + r) * (1.0f / SBW) + EPS);
#pragma unroll
                for (int bj = 0; bj < 2; ++bj)
#pragma unroll
                    for (int n = 0; n < 2; ++n) acc[ai][bj][m][n] *= s; }
    }
    __device__ __forceinline__ void operator()(f32x4 (&acc)[2][2][4][2], const pg8::Unit& u, int wr, int wc, int fr, int fq, int, int, LAS unsigned char*) const {
        int row0 = u.pm * 256 + wr * 64 + fr, col0 = u.pn * 256 + wc * 32 + 8 * fq; asm volatile("" : "+v"(row0), "+v"(col0));
        u32x4 xv[2][4][2]; f32x4 xf[XIN_BF16 ? 1 : 2][XIN_BF16 ? 1 : 4][XIN_BF16 ? 1 : 2][2];
#pragma unroll
        for (int ai = 0; ai < 2; ++ai)
#pragma unroll
            for (int m = 0; m < 4; ++m)
#pragma unroll
                for (int bj = 0; bj < 2; ++bj) { const size_t o2 = (size_t)(row0 + ai * 128 + m * 16) * D + col0 + bj * 128;
                    if constexpr (XIN_BF16) xv[ai][m][bj] = *(const u32x4*)(xb + o2); else { xf[ai][m][bj][0] = *(const f32x4*)(xin + o2); xf[ai][m][bj][1] = *(const f32x4*)(xin + o2 + 4); } }
#pragma unroll
        for (int ai = 0; ai < 2; ++ai)
#pragma unroll
            for (int m = 0; m < 4; ++m) { const int r = row0 + ai * 128 + m * 16; const size_t off = (size_t)r * D + col0; float q = 0.f;
#pragma unroll
                for (int bj = 0; bj < 2; ++bj) { const size_t o2 = off + bj * 128; f32x4 o0, o1;
                    if constexpr (XIN_BF16) { const u32x4 x4 = xv[ai][m][bj];
                        o0 = (f32x4){__builtin_bit_cast(float, x4.x << 16), __builtin_bit_cast(float, x4.x & 0xffff0000u), __builtin_bit_cast(float, x4.y << 16), __builtin_bit_cast(float, x4.y & 0xffff0000u)};
                        o1 = (f32x4){__builtin_bit_cast(float, x4.z << 16), __builtin_bit_cast(float, x4.z & 0xffff0000u), __builtin_bit_cast(float, x4.w << 16), __builtin_bit_cast(float, x4.w & 0xffff0000u)}; }
                    else { o0 = xf[ai][m][bj][0]; o1 = xf[ai][m][bj][1]; }
                    o0 += acc[ai][bj][m][0] * accs; o1 += acc[ai][bj][m][1] * accs;
                    q += (o0[0] * o0[0] + o0[1] * o0[1]) + (o0[2] * o0[2] + o0[3] * o0[3]) + (o1[0] * o1[0] + o1[1] * o1[1]) + (o1[2] * o1[2] + o1[3] * o1[3]);
                    if constexpr (F8OUT) { int w0 = __builtin_amdgcn_cvt_pk_fp8_f32(o0[0], o0[1], 0, false); w0 = __builtin_amdgcn_cvt_pk_fp8_f32(o0[2], o0[3], w0, true);
                        int w1 = __builtin_amdgcn_cvt_pk_fp8_f32(o1[0], o1[1], 0, false); w1 = __builtin_amdgcn_cvt_pk_fp8_f32(o1[2], o1[3], w1, true);
                        pg8::st8_wt(x8 + o2, (unsigned long long)(unsigned)w0 | ((unsigned long long)(unsigned)w1 << 32)); }
                    u32x4 w; w.x = pg8::cvt_pk_bf16(o0[0], o0[1]); w.y = pg8::cvt_pk_bf16(o0[2], o0[3]); w.z = pg8::cvt_pk_bf16(o1[0], o1[1]); w.w = pg8::cvt_pk_bf16(o1[2], o1[3]); pg8::st16<4>(xb + o2, w); }
                q += __shfl_xor(q, 16); q += __shfl_xor(q, 32);
                if (fq == 0) ssq_add(ssq + r, q); }
    }
};
struct SchedMS {
    int G, c; unsigned char* ws;
    __device__ __forceinline__ bool next(int i, pg8::Unit& u) const {
        const int L = i * G + c; constexpr int NU = (NTOK / 256) * MH; if (L >= NU) return false; const int w = pg8::xcd_remap(L, NU), pm = w >> 2, h = w & 3, b = pm >> 4;
        u.A = (const char*)(ws + WS_QM) + ((size_t)pm * 256 * D + h * MHD) * 2; u.B = (const char*)(ws + WS_KM) + ((size_t)b * NMEM * D + h * MHD) * 2;
        u.p0 = (bf16_t*)(ws + WS_PM) + (size_t)pm * 256 * D + h * NMEM; u.p1 = nullptr; u.p2 = nullptr; u.p3 = nullptr; u.i0 = D; u.i1 = 0; u.pm = pm; u.pn = h; return true;
    }
};
struct EpiSoftmax {
    static constexpr bool PERM = true; static constexpr int MIDK = -1;
    __device__ __forceinline__ void midk(f32x4 (&)[2][2][4][2], const pg8::Unit&, int, int) const {}
    __device__ __forceinline__ void operator()(f32x4 (&acc)[2][2][4][2], const pg8::Unit& u, int wr, int wc, int fr, int fq, int, int, LAS unsigned char* xl) const {
        typedef float f32x2v __attribute__((ext_vector_type(2)));
        LAS f32x2v* X = (LAS f32x2v*)xl;
        float ml[2][4];
#pragma unroll
        for (int ai = 0; ai < 2; ++ai)
#pragma unroll
            for (int m = 0; m < 4; ++m) { float mx = -INFINITY;
#pragma unroll
                for (int bj = 0; bj < 2; ++bj)
#pragma unroll
                    for (int n = 0; n < 2; ++n) { const f32x4 v = acc[ai][bj][m][n]; mx = fmaxf(fmaxf(mx, fmaxf(v[0], v[1])), fmaxf(v[2], v[3])); }
                mx = fmaxf(mx, __shfl_xor(mx, 16)); mx = fmaxf(mx, __shfl_xor(mx, 32)); ml[ai][m] = mx; float s = 0.f;
#pragma unroll
                for (int bj = 0; bj < 2; ++bj)
#pragma unroll
                    for (int n = 0; n < 2; ++n) { f32x4 v = acc[ai][bj][m][n];
#pragma unroll
                        for (int j = 0; j < 4; ++j) { v[j] = __builtin_amdgcn_exp2f(v[j] - mx); s += v[j]; }
                        acc[ai][bj][m][n] = v; }
                s += __shfl_xor(s, 16); s += __shfl_xor(s, 32);
                if (fq == 0) X[(ai * 128 + wr * 64 + m * 16 + fr) * 4 + wc] = (f32x2v){mx, s}; }
        EPI_BAR();
        bf16_t* O = (bf16_t*)u.p0; const int ldc = u.i0; int r0 = wr * 64 + fr, c0 = wc * 32 + 8 * fq; asm volatile("" : "+v"(r0), "+v"(c0));
#pragma unroll
        for (int ai = 0; ai < 2; ++ai)
#pragma unroll
            for (int m = 0; m < 4; ++m) { const int r = r0 + ai * 128 + m * 16; const f32x2v a = X[r * 4 + 0], b = X[r * 4 + 1], c = X[r * 4 + 2], d = X[r * 4 + 3];
                const float M = fmaxf(fmaxf(a.x, b.x), fmaxf(c.x, d.x));
                const float tot = a.y * __builtin_amdgcn_exp2f(a.x - M) + b.y * __builtin_amdgcn_exp2f(b.x - M) + c.y * __builtin_amdgcn_exp2f(c.x - M) + d.y * __builtin_amdgcn_exp2f(d.x - M);
                const float f = __builtin_amdgcn_exp2f(ml[ai][m] - M) / tot; bf16_t* rowp = O + (size_t)r * ldc + c0;
#pragma unroll
                for (int bj = 0; bj < 2; ++bj) { const f32x4 v0 = acc[ai][bj][m][0] * f, v1 = acc[ai][bj][m][1] * f;
                    u32x4 w; w.x = pg8::cvt_pk_bf16(v0[0], v0[1]); w.y = pg8::cvt_pk_bf16(v0[2], v0[3]); w.z = pg8::cvt_pk_bf16(v1[0], v1[1]); w.w = pg8::cvt_pk_bf16(v1[2], v1[3]);
                    pg8::st16<6>(rowp + bj * 128, w); } }
    }
};
struct SchedPV {
    int G, c; unsigned char* ws;
    __device__ __forceinline__ bool next(int i, pg8::Unit& u) const {
        const int L = i * G + c; constexpr int NU = (NTOK / 256) * MH; if (L >= NU) return false; const int w = pg8::xcd_remap(L, NU), pm = w >> 2, h = w & 3, b = pm >> 4;
        u.A = (const char*)(ws + WS_PM) + ((size_t)pm * 256 * D + h * NMEM) * 2; u.B = (const char*)(ws + WS_VMT) + ((size_t)b * D + h * MHD) * NMEM * 2;
        u.p0 = (bf16_t*)(ws + WS_OM) + (size_t)pm * 256 * D + h * MHD; u.p1 = nullptr; u.p2 = nullptr; u.p3 = nullptr; u.i0 = D; u.i1 = 0; u.pm = pm; u.pn = h; return true;
    }
};

__device__ __forceinline__ void p8_route(const Args& a, LAS unsigned char* lds, int bx, int G, int wave, int lane, int* CNT) {
    unsigned char* ws = a.ws; const bf16_t* x2 = (const bf16_t*)(ws + WS_S0); const ssq_t* SSQ2 = (const ssq_t*)(ws + MK_SSQ2); const float* br = a.in[16];
    const bf16_t* WRH = (const bf16_t*)(ws + WS_WRH);
    int* LSLOT = (int*)(ws + WS_LSLOT); float* LGATE = (float*)(ws + WS_LGATE); float* LRS = (float*)(ws + WS_LRS);
    constexpr int WPITCH = 2064;
    LAS float* LG = (LAS float*)(lds + RING_OFF + 69632) + wave * 16 * 33;
    LAS int* hist = (LAS int*)(lds + RING_OFF + 90112); LAS int* base = hist + 32;
    const int tid = wave * 64 + lane;
    { u32x4 v[8];
#pragma unroll
      for (int i = 0; i < 8; ++i) v[i] = *(const u32x4*)(WRH + (size_t)(tid + i * 512) * 8);
#pragma unroll
      for (int i = 0; i < 8; ++i) { const int c = tid + i * 512; *(LAS u32x4*)(lds + RING_OFF + (c >> 7) * WPITCH + (c & 127) * 16) = v[i]; } }
    LDS_WAIT(); __syncthreads();
    for (int t0 = bx * 128; t0 < NTOK; t0 += G * 128) {
        if (tid < 32) hist[tid] = 0;
        const int r16 = lane & 15, kq = lane >> 4; const int trow = t0 + wave * 16 + r16;
        const bf16_t* xp = x2 + (size_t)trow * D + kq * 8;
        bf16x8 ah[32];
#pragma unroll
        for (int ks = 0; ks < 32; ++ks) ah[ks] = *(const bf16x8*)(xp + ks * 32);
        f32x4 acc[2] = {(f32x4){0.f, 0.f, 0.f, 0.f}, (f32x4){0.f, 0.f, 0.f, 0.f}};
        const LAS unsigned char* wp = lds + RING_OFF + r16 * WPITCH + kq * 16;
#pragma unroll
        for (int ks = 0; ks < 32; ++ks) {
#pragma unroll
            for (int nb = 0; nb < 2; ++nb) { const bf16x8 bh = *(const LAS bf16x8*)(wp + nb * 16 * WPITCH + ks * 64);
                acc[nb] = __builtin_amdgcn_mfma_f32_16x16x32_bf16(ah[ks], bh, acc[nb], 0, 0, 0); } }
#pragma unroll
        for (int nb = 0; nb < 2; ++nb)
#pragma unroll
            for (int r = 0; r < 4; ++r) { const int tl = kq * 4 + r; const int tk = t0 + wave * 16 + tl; const float rs = 1.0f / sqrtf(ssq_get(SSQ2 + tk) * (1.0f / D) + EPS);
                LG[tl * 33 + nb * 16 + r16] = acc[nb][r] * rs + br[nb * 16 + r16]; }
        LDS_WAIT(); __syncthreads();
        int te[4] = {0, 0, 0, 0}; float tg[4] = {0.f, 0.f, 0.f, 0.f}; int rk[4] = {0, 0, 0, 0};
        if (lane < 16) {
            float tv[4] = {-INFINITY, -INFINITY, -INFINITY, -INFINITY};
            for (int e = 0; e < NE; ++e) { const float v = LG[lane * 33 + e];
                if (v > tv[3]) { if (v > tv[2]) { tv[3] = tv[2]; te[3] = te[2]; if (v > tv[1]) { tv[2] = tv[1]; te[2] = te[1]; if (v > tv[0]) { tv[1] = tv[0]; te[1] = te[0]; tv[0] = v; te[0] = e; } else { tv[1] = v; te[1] = e; } } else { tv[2] = v; te[2] = e; } } else { tv[3] = v; te[3] = e; } } }
            float gs = 0.f;
#pragma unroll
            for (int k = 0; k < 4; ++k) { tg[k] = __expf(tv[k] - tv[0]); gs += tg[k]; }
            gs = 1.0f / gs;
#pragma unroll
            for (int k = 0; k < 4; ++k) { tg[k] *= gs; rk[k] = __hip_atomic_fetch_add(hist + te[k], 1, __ATOMIC_RELAXED, __HIP_MEMORY_SCOPE_WORKGROUP); }
        }
        LDS_WAIT(); __syncthreads();
        if (tid < 32) { const int n = hist[tid]; base[tid] = n ? atomicAdd(CNT + tid, n) : 0; }
        LDS_WAIT(); __syncthreads();
        if (lane < 16) { const int tk = t0 + wave * 16 + lane; const float rsw = (1.0f / WSCALE) / sqrtf(ssq_get(SSQ2 + tk) * (1.0f / D) + EPS);
#pragma unroll
            for (int k = 0; k < 4; ++k) { const size_t p = (size_t)te[k] * LCAP + base[te[k]] + rk[k]; pg8::st4_wt(LSLOT + p, (unsigned)(tk * 4 + k)); pg8::st4_wt(LGATE + p, __float_as_uint(tg[k])); pg8::st4_wt(LRS + p, __float_as_uint(rsw)); } }
        LDS_WAIT(); __syncthreads();
    }
}

__device__ __forceinline__ void moe_table(const Args& a, volatile LAS unsigned* MISC, int tid) {
    const int* CNT = (const int*)(a.ws + OFF_CNT);
    if (tid < 32) MISC[16 + tid] = (unsigned)CNT[tid];
    LDS_WAIT(); __syncthreads();
    if (tid == 0) { unsigned tb = 0; for (int e = 0; e < NE; ++e) { MISC[48 + e] = tb; tb += (MISC[16 + e] + 255u) >> 8; } MISC[48 + NE] = tb; }
    LDS_WAIT(); __syncthreads();
}
template <int NPN, bool W1> struct SchedMoE {
    int G, c; unsigned char* ws; volatile LAS unsigned* MISC; const float* bias;
    __device__ __forceinline__ bool next(int i, pg8::Unit& u) const {
        unsigned mb_ = (unsigned)(uintptr_t)MISC; asm volatile("" : "+s"(mb_)); const LAS unsigned* M = (const LAS unsigned*)(uintptr_t)mb_;
        const int T = __builtin_amdgcn_readfirstlane((int)M[48 + NE]); const int NU = T * NPN; const int L = i * G + c; if (L >= NU) return false;
        const int w = pg8::xcd_remap(L, NU);
        int e = 0;
#pragma unroll
        for (int s = 16; s >= 1; s >>= 1) { if ((int)M[48 + e + s] * NPN <= w) e += s; }
        e = __builtin_amdgcn_readfirstlane(e);
        const int tb = __builtin_amdgcn_readfirstlane((int)M[48 + e]), cnt = __builtin_amdgcn_readfirstlane((int)M[16 + e]), nte = (cnt + 255) >> 8; const int idx = w - tb * NPN, pn = __builtin_amdgcn_readfirstlane(idx / nte), mt = idx - pn * nte;
        u.pm = tb + mt; u.pn = pn; u.i1 = e; const int nv = cnt - mt * 256; u.i0 = nv < 256 ? nv : 256;
        u.p3 = (int*)(ws + WS_LSLOT) + (size_t)e * LCAP + mt * 256; u.p2 = (float*)(ws + (W1 ? WS_LRS : WS_LGATE)) + (size_t)e * LCAP + mt * 256; u.p0 = nullptr;
        u.p1 = W1 ? (void*)(bias + (size_t)e * 2 * DFF + pn * 128) : (void*)(bias + (size_t)e * D + pn * 256);
        if (W1) { u.A = (const char*)(ws + WS_X2F8); u.B = (const char*)(ws + WS_W1) + ((size_t)e * 2 * DFF + pn * 256) * D; }
        else { u.A = (const char*)(ws + WS_ACT) + (size_t)(tb + mt) * 256 * DFF; u.B = (const char*)(ws + WS_W2) + ((size_t)e * D + pn * 256) * DFF; }
        return true;
    }
};
typedef float f32x2 __attribute__((ext_vector_type(2)));
struct EpiSwiGLU {
    static constexpr bool PERM = true; static constexpr int MIDK = -1; unsigned char* act;
    __device__ __forceinline__ void midk(f32x4 (&)[2][2][4][2], const pg8::Unit&, int, int) const {}
    __device__ __forceinline__ void operator()(f32x4 (&acc)[2][2][4][2], const pg8::Unit& u, int wr, int wc, int fr, int fq, int, int, LAS unsigned char* tab) const {
        const int nvalid = u.i0; const LAS float* T1 = (const LAS float*)tab + 256; const LAS float* T2 = (const LAS float*)tab + 512;
        int r0 = wr * 64 + fr, c0 = wc * 32 + 8 * fq; asm volatile("" : "+v"(r0), "+v"(c0)); const int gc0 = u.pn * 128 + c0;
        f32x4 bg[2], bu[2];
#pragma unroll
        for (int n = 0; n < 2; ++n) { bg[n] = *(const LAS f32x4*)(T2 + c0 + 4 * n); bu[n] = *(const LAS f32x4*)(T2 + 128 + c0 + 4 * n); }
#pragma unroll
        for (int ai = 0; ai < 2; ++ai)
#pragma unroll
            for (int m = 0; m < 4; ++m) { const int r = r0 + ai * 128 + m * 16; const float rs = T1[r]; int wv[2];
#pragma unroll
                for (int n = 0; n < 2; ++n) { f32x2 o[2];
#pragma unroll
                    for (int h = 0; h < 2; ++h) { f32x2 g = (f32x2){acc[ai][0][m][n][2 * h], acc[ai][0][m][n][2 * h + 1]} * rs + (f32x2){bg[n][2 * h], bg[n][2 * h + 1]};
                        f32x2 up = (f32x2){acc[ai][1][m][n][2 * h], acc[ai][1][m][n][2 * h + 1]} * rs + (f32x2){bu[n][2 * h], bu[n][2 * h + 1]};
                        g.x = fminf(g.x, SW_LIMIT); g.y = fminf(g.y, SW_LIMIT); up.x = fminf(fmaxf(up.x, -SW_LIMIT), SW_LIMIT); up.y = fminf(fmaxf(up.y, -SW_LIMIT), SW_LIMIT);
                        const f32x2 tt = g * (-SW_ALPHA * LOG2E); f32x2 d; d.x = __builtin_amdgcn_exp2f(tt.x); d.y = __builtin_amdgcn_exp2f(tt.y); d = d + 1.0f;
                        f32x2 rr; rr.x = __builtin_amdgcn_rcpf(d.x); rr.y = __builtin_amdgcn_rcpf(d.y);
                        o[h] = (up + 1.0f) * g * rr; }
                    wv[n] = __builtin_amdgcn_cvt_pk_fp8_f32(o[0].x, o[0].y, 0, false); wv[n] = __builtin_amdgcn_cvt_pk_fp8_f32(o[1].x, o[1].y, wv[n], true); }
                if (r < nvalid) pg8::st8_wt(act + ((size_t)u.pm * 256 + r) * DFF + gc0, (unsigned long long)(unsigned)wv[0] | ((unsigned long long)(unsigned)wv[1] << 32)); }
    }
};
struct EpiW2 {
    static constexpr bool PERM = true; static constexpr int MIDK = -1; unsigned char* Y;
    __device__ __forceinline__ void midk(f32x4 (&)[2][2][4][2], const pg8::Unit&, int, int) const {}
    __device__ __forceinline__ void operator()(f32x4 (&acc)[2][2][4][2], const pg8::Unit& u, int wr, int wc, int fr, int fq, int, int, LAS unsigned char* tab) const {
        const int nvalid = u.i0; const LAS unsigned* T0 = (const LAS unsigned*)tab; const LAS float* T1 = (const LAS float*)tab + 256; const LAS float* T2 = (const LAS float*)tab + 512;
        int r0 = wr * 64 + fr, cl = wc * 32 + 8 * fq; asm volatile("" : "+v"(r0), "+v"(cl)); const int c0 = u.pn * 256 + cl;
        f32x4 bv[2][2];
#pragma unroll
        for (int bj = 0; bj < 2; ++bj)
#pragma unroll
            for (int n = 0; n < 2; ++n) bv[bj][n] = *(const LAS f32x4*)(T2 + cl + bj * 128 + 4 * n);
#pragma unroll
        for (int ai = 0; ai < 2; ++ai)
#pragma unroll
            for (int m = 0; m < 4; ++m) { const int r = r0 + ai * 128 + m * 16; const bool valid = r < nvalid; const unsigned slot = T0[r]; const float g = T1[r];
#pragma unroll
                for (int bj = 0; bj < 2; ++bj) { const f32x4 v0 = (acc[ai][bj][m][0] * (1.0f / WSCALE) + bv[bj][0]) * g, v1 = (acc[ai][bj][m][1] * (1.0f / WSCALE) + bv[bj][1]) * g;
                    int w0 = __builtin_amdgcn_cvt_pk_fp8_f32(v0[0], v0[1], 0, false); w0 = __builtin_amdgcn_cvt_pk_fp8_f32(v0[2], v0[3], w0, true);
                    int w1 = __builtin_amdgcn_cvt_pk_fp8_f32(v1[0], v1[1], 0, false); w1 = __builtin_amdgcn_cvt_pk_fp8_f32(v1[2], v1[3], w1, true);
                    if (valid) pg8::st8_wt(Y + (size_t)slot * D + c0 + bj * 128, (unsigned long long)(unsigned)w0 | ((unsigned long long)(unsigned)w1 << 32)); } }
    }
};

__device__ __forceinline__ void p11_final(const Args& a, int vcu, int G, int wave, int lane, float* dst) {
    const bf16_t* x2 = (const bf16_t*)(a.ws + WS_S0); const unsigned char* Y = a.ws + WS_Y; const float* gf = a.in[21];
    const int gw = vcu * NWAVES + wave, NGW = G * NWAVES;
    f32x4 g4[4];
#pragma unroll
    for (int j = 0; j < 4; ++j) g4[j] = *(const f32x4*)(gf + 16 * lane + 4 * j);
    for (int tok = gw; tok < NTOK; tok += NGW) {
        const u32x4 xa = *(const u32x4*)(x2 + (size_t)tok * D + 16 * lane), xc = *(const u32x4*)(x2 + (size_t)tok * D + 16 * lane + 8);
        u32x4 yv[4];
#pragma unroll
        for (int k = 0; k < 4; ++k) yv[k] = *(const u32x4*)(Y + ((size_t)tok * 4 + k) * D + 16 * lane);
        float v[16];
#pragma unroll
        for (int q = 0; q < 4; ++q) { v[2 * q] = __builtin_bit_cast(float, xa[q] << 16); v[2 * q + 1] = __builtin_bit_cast(float, xa[q] & 0xffff0000u); v[8 + 2 * q] = __builtin_bit_cast(float, xc[q] << 16); v[8 + 2 * q + 1] = __builtin_bit_cast(float, xc[q] & 0xffff0000u); }
#pragma unroll
        for (int k = 0; k < 4; ++k)
#pragma unroll
            for (int q = 0; q < 4; ++q) { const auto lo = __builtin_amdgcn_cvt_pk_f32_fp8((int)yv[k][q], false), hi2 = __builtin_amdgcn_cvt_pk_f32_fp8((int)yv[k][q], true);
                v[4 * q] += lo[0]; v[4 * q + 1] += lo[1]; v[4 * q + 2] += hi2[0]; v[4 * q + 3] += hi2[1]; }
        float s = 0.f;
#pragma unroll
        for (int q = 0; q < 16; ++q) s += v[q] * v[q];
        const float rs = 1.0f / sqrtf(wave_sum(s) * (1.0f / D) + EPS);
#pragma unroll
        for (int j = 0; j < 4; ++j) pg8::st16<8>(dst + (size_t)tok * D + 16 * lane + 4 * j, (f32x4){v[4 * j] * rs * g4[j][0], v[4 * j + 1] * rs * g4[j][1], v[4 * j + 2] * rs * g4[j][2], v[4 * j + 3] * rs * g4[j][3]});
    }
}
typedef float f32x16 __attribute__((ext_vector_type(16)));
typedef short s16x4 __attribute__((ext_vector_type(4)));
__device__ __forceinline__ int crow(int r, int hi) { return (r & 3) + 8 * (r >> 2) + 4 * hi; }
#define SB_DMA(ubase, voff, ldsaddr) do { unsigned keep_; asm volatile("s_mov_b32 %0, m0\n\ts_mov_b32 m0, %3\n\ts_nop 0\n\tglobal_load_lds_dwordx4 %1, %2\n\ts_mov_b32 m0, %0" \
        : "=&s"(keep_) : "v"(voff), "s"((const char*)(ubase)), "s"(ldsaddr) : "memory"); } while (0)
__device__ __forceinline__ void sb_item(int b, int h, int qi  , const bf16_t* QKVU, bf16_t* MIXED, ssq_t* SSQSB, LAS unsigned char* wl  , int lane) {
    const int r32 = lane & 31, hi = lane >> 5;
    const size_t rowbase = (size_t)b * S; const int q0 = qi * 64;
    const bf16_t* Qw = QKVU + (rowbase + q0) * INP + h * HD;
    const char* Kh = (const char*)(QKVU + rowbase * INP + SBW + h * HD); const char* Vh = Kh + SBW * 2;
    bf16x8 qr[2][4];
#pragma unroll
    for (int s = 0; s < 2; ++s)
#pragma unroll
        for (int d0 = 0; d0 < 4; ++d0) qr[s][d0] = *(const bf16x8*)(Qw + (size_t)(s * 32 + r32) * INP + d0 * 16 + hi * 8);
    f32x16 o[2][2];
#pragma unroll
    for (int r = 0; r < 16; ++r) { o[0][0][r] = 0.f; o[0][1][r] = 0.f; o[1][0][r] = 0.f; o[1][1][r] = 0.f; }
    float carry[2] = {1.0f, 1.0f}; bool alive[2] = {true, true};
    const int jd = qi;
    const unsigned kvoff = (unsigned)lane * (INP * 2);
    const unsigned vvoff = (unsigned)(lane >> 2) * (INP * 2) + (unsigned)(lane & 3) * 16;
    const unsigned lk = (unsigned)(uintptr_t)wl, lv = lk + 8192;
#define SB_LOAD_K(j) do { const char* kb_ = Kh + (size_t)(j) * 64 * INP * 2; _Pragma("unroll") for (int c_ = 0; c_ < 8; ++c_) SB_DMA(kb_ + c_ * 16, kvoff, lk + c_ * 1024); } while (0)
#define SB_LOAD_V(j) do { const char* vb_ = Vh + (size_t)(j) * 64 * INP * 2; _Pragma("unroll") for (int c_ = 0; c_ < 8; ++c_) SB_DMA(vb_ + (size_t)(c_ & 3) * 16 * INP * 2 + (c_ >> 2) * 64, vvoff, lv + c_ * 1024); } while (0)
    SB_LOAD_K(jd); SB_LOAD_V(jd);
    const LAS unsigned char* kb = wl + hi * 1024 + r32 * 16;
    const LAS unsigned char* vb = wl + 8192 + ((lane >> 4) & 1) * 32 + (lane & 3) * 8 + (4 * hi + ((lane & 15) >> 2)) * 64;
    for (int j = jd; j >= 0; --j) {
        asm volatile("s_waitcnt vmcnt(8)" ::: "memory"); __builtin_amdgcn_sched_barrier(0);
        bf16x8 kf[8];
#pragma unroll
        for (int d0 = 0; d0 < 4; ++d0) { kf[2 * d0] = *(const LAS bf16x8*)(kb + d0 * 2048); kf[2 * d0 + 1] = *(const LAS bf16x8*)(kb + d0 * 2048 + 512); }
        asm volatile("s_waitcnt lgkmcnt(0)" ::: "memory"); __builtin_amdgcn_sched_barrier(0);
        if (j > 0) SB_LOAD_K(j - 1);
        unsigned pw[2][4][4];
#pragma unroll
        for (int s = 0; s < 2; ++s) {
            if (!alive[s]) {
#pragma unroll
                for (int x = 0; x < 4; ++x)
#pragma unroll
                    for (int y = 0; y < 4; ++y) pw[s][x][y] = 0u;
                continue; }
            f32x16 p0, p1;
#pragma unroll
            for (int r = 0; r < 16; ++r) { p0[r] = 0.f; p1[r] = 0.f; }
#pragma unroll
            for (int d0 = 0; d0 < 4; ++d0) { p0 = __builtin_amdgcn_mfma_f32_32x32x16_bf16(kf[2 * d0], qr[s][d0], p0, 0, 0, 0); p1 = __builtin_amdgcn_mfma_f32_32x32x16_bf16(kf[2 * d0 + 1], qr[s][d0], p1, 0, 0, 0); }
            const bool diag = (j == jd); const int kbase = 64 * j + 4 * hi; const int qabs = q0 + s * 32 + r32;
#pragma unroll
            for (int r = 0; r < 16; ++r) { const int k0 = kbase + (r & 3) + 8 * (r >> 2);
                float e0 = __builtin_amdgcn_exp2f(p0[r]), e1 = __builtin_amdgcn_exp2f(p1[r]);
                float r0 = __builtin_amdgcn_rcpf(1.0f + e0), r1 = __builtin_amdgcn_rcpf(1.0f + e1);
                if (diag) { if (k0 >= qabs) r0 = 1.0f; if (k0 + 32 >= qabs) r1 = 1.0f; }
                p0[r] = r0; p1[r] = r1; }
            float sfx[8][3], A[8];
#pragma unroll
            for (int i = 0; i < 8; ++i) { const float x0 = (i < 4) ? p0[4 * i] : p1[4 * i - 16], x1 = (i < 4) ? p0[4 * i + 1] : p1[4 * i - 15], x2 = (i < 4) ? p0[4 * i + 2] : p1[4 * i - 14], x3 = (i < 4) ? p0[4 * i + 3] : p1[4 * i - 13];
                sfx[i][2] = x3; sfx[i][1] = x3 * x2; sfx[i][0] = sfx[i][1] * x1; A[i] = sfx[i][0] * x0; }
            float T = carry[s], E[8];
#pragma unroll
            for (int i = 7; i >= 0; --i) { const auto sw = __builtin_amdgcn_permlane32_swap(__float_as_uint(A[i]), __float_as_uint(A[i]), false, false);
                const float partner = hi ? __uint_as_float(sw[0]) : __uint_as_float(sw[1]);
                E[i] = hi ? T : T * partner; T = T * (A[i] * partner); }
            carry[s] = T;
#pragma unroll
            for (int i = 0; i < 8; ++i) { float w4[4];
#pragma unroll
                for (int jj = 0; jj < 4; ++jj) { const float rv = (i < 4) ? p0[4 * i + jj] : p1[4 * i - 16 + jj]; const float beta = 1.0f - rv;
                    w4[jj] = beta * ((jj == 3) ? E[i] : E[i] * sfx[i][jj]); }
                pw[s][i >> 1][(i & 1) * 2] = pg8::cvt_pk_bf16(w4[0], w4[1]); pw[s][i >> 1][(i & 1) * 2 + 1] = pg8::cvt_pk_bf16(w4[2], w4[3]); }
        }
        if (j > 0) asm volatile("s_waitcnt vmcnt(8)" ::: "memory"); else asm volatile("s_waitcnt vmcnt(0)" ::: "memory");
        __builtin_amdgcn_sched_barrier(0);
        bf16x8 vf[8];
#pragma unroll
        for (int d0 = 0; d0 < 2; ++d0)
#pragma unroll
            for (int ks = 0; ks < 4; ++ks) {
                const s16x4 lo = __builtin_bit_cast(s16x4, __builtin_amdgcn_ds_read_tr16_b64_v4i16((LAS s16x4*)(vb + d0 * 4096 + ks * 1024)));
                const s16x4 hh = __builtin_bit_cast(s16x4, __builtin_amdgcn_ds_read_tr16_b64_v4i16((LAS s16x4*)(vb + d0 * 4096 + ks * 1024 + 512)));
                vf[d0 * 4 + ks] = (bf16x8){lo[0], lo[1], lo[2], lo[3], hh[0], hh[1], hh[2], hh[3]}; }
        asm volatile("s_waitcnt lgkmcnt(0)" ::: "memory"); __builtin_amdgcn_sched_barrier(0);
        const bool a0 = alive[0] && __any(carry[0] != 0.0f), a1 = alive[1] && __any(carry[1] != 0.0f);
        const bool more = (j > 0) && (a0 || a1);
        if (more) SB_LOAD_V(j - 1);
#pragma unroll
        for (int s = 0; s < 2; ++s) { if (!alive[s]) continue;
#pragma unroll
            for (int d0 = 0; d0 < 2; ++d0)
#pragma unroll
                for (int ks = 0; ks < 4; ++ks) { const bf16x8 pa = __builtin_bit_cast(bf16x8, (u32x4){pw[s][ks][0], pw[s][ks][1], pw[s][ks][2], pw[s][ks][3]});
                    o[s][d0] = __builtin_amdgcn_mfma_f32_32x32x16_bf16(pa, vf[d0 * 4 + ks], o[s][d0], 0, 0, 0); } }
        alive[0] = a0; alive[1] = a1;
        if (!more) break;
    }
    asm volatile("s_waitcnt vmcnt(0)" ::: "memory");
    LAS bf16_t* stg = (LAS bf16_t*)wl; const int l2 = pg8::fresh_lane();
#pragma unroll
    for (int s = 0; s < 2; ++s) {
#pragma unroll
        for (int r = 0; r < 16; ++r) { const int orow = crow(r, hi);
#pragma unroll
            for (int d0 = 0; d0 < 2; ++d0) stg[orow * 64 + d0 * 32 + r32] = (bf16_t)f2bf(o[s][d0][r]); }
        LDS_WAIT();
        bf16_t* Ow = MIXED + (rowbase + q0 + s * 32) * D + h * HD;
#pragma unroll
        for (int i = 0; i < 4; ++i) { const int row = i * 8 + (l2 >> 3), ch = l2 & 7; const u32x4 v = *(const LAS u32x4*)(stg + row * 64 + ch * 8);
            pg8::st16<2>(Ow + (size_t)row * D + ch * 8, v); float q = 0.f;
#pragma unroll
            for (int k = 0; k < 4; ++k) { const float a = __builtin_bit_cast(float, v[k] << 16), c = __builtin_bit_cast(float, v[k] & 0xffff0000u); q += a * a + c * c; }
            q += __shfl_xor(q, 1); q += __shfl_xor(q, 2); q += __shfl_xor(q, 4);
            if (ch == 0) ssq_add(SSQSB + rowbase + q0 + s * 32 + row, q); }
        LDS_WAIT();
    }
#undef SB_LOAD_K
#undef SB_LOAD_V
}

constexpr int PL_PITCH = 1040, PL_PART_OFF = 83968;
__device__ __forceinline__ void pool_unit(int tile, const bf16_t* QKVU, bf16_t* MIXED, LAS unsigned char* shm, int wid, int lane) {
    const int tok0 = tile * 64, tpos0 = tok0 & (S - 1); const int tid = wid * 64 + lane;
    { u32x4 v[10];
#pragma unroll
      for (int i = 0; i < 10; ++i) { const int c = tid + i * NWAVES * 64; const int row = c >> 6, ch = c & 63; const int t = tpos0 - 15 + row;
          v[i] = (u32x4){0u, 0u, 0u, 0u}; if (c < 79 * 64 && t >= 0) v[i] = *(const u32x4*)(QKVU + (size_t)(tok0 - 15 + row) * INP + 3 * SBW + ch * 8); }
#pragma unroll
      for (int i = 0; i < 10; ++i) { const int c = tid + i * NWAVES * 64; const int row = c >> 6, ch = c & 63; if (c < 79 * 64) *(LAS u32x4*)(shm + row * PL_PITCH + ch * 16) = v[i]; } }
    LDS_WAIT(); __syncthreads();
    const int win = 2 << (wid >> 1); const int tp1 = tpos0 + lane + 1; const int n = tp1 < win ? tp1 : win; const float inv = 1.0f / (float)n;
    const LAS unsigned char* up = shm + (15 + lane) * PL_PITCH + wid * 128;
    float o[64]; float q = 0.f;
#pragma unroll
    for (int ch = 0; ch < 8; ++ch) { float s[8];
#pragma unroll
        for (int k = 0; k < 8; ++k) s[k] = 0.f;
        for (int jw = 0; jw < win; ++jw) { const u32x4 v = *(const LAS u32x4*)(up + ch * 16 - jw * PL_PITCH);
#pragma unroll
            for (int k = 0; k < 4; ++k) { s[2 * k] += __builtin_bit_cast(float, v[k] << 16); s[2 * k + 1] += __builtin_bit_cast(float, v[k] & 0xffff0000u); } }
        const u32x4 self = *(const LAS u32x4*)(up + ch * 16);
#pragma unroll
        for (int k = 0; k < 4; ++k) { const float a = s[2 * k] * inv - __builtin_bit_cast(float, self[k] << 16), c = s[2 * k + 1] * inv - __builtin_bit_cast(float, self[k] & 0xffff0000u);
            o[ch * 8 + 2 * k] = a; o[ch * 8 + 2 * k + 1] = c; q += a * a + c * c; } }
    LAS float* part = (LAS float*)(shm + PL_PART_OFF);
    part[wid * 64 + lane] = q;
    LDS_WAIT(); __syncthreads();
    float tot = 0.f;
#pragma unroll
    for (int w = 0; w < 8; ++w) tot += part[w * 64 + lane];
    const float rs = 1.0f / sqrtf(tot * (1.0f / PW) + EPS);
    LAS unsigned char* op = shm + lane * PL_PITCH + wid * 128;
#pragma unroll
    for (int ch = 0; ch < 8; ++ch) { u32x4 w;
#pragma unroll
        for (int k = 0; k < 4; ++k) w[k] = pg8::cvt_pk_bf16(o[ch * 8 + 2 * k] * rs, o[ch * 8 + 2 * k + 1] * rs);
        *(LAS u32x4*)(op + ch * 16) = w; }
    LDS_WAIT(); __syncthreads();
#pragma unroll
    for (int i = 0; i < 8; ++i) { const int c = tid + i * NWAVES * 64; const int row = c >> 6, ch = c & 63;
        pg8::st16<3>(MIXED + (size_t)(tok0 + row) * D + SBW + ch * 8, (u32x4)*(const LAS u32x4*)(shm + row * PL_PITCH + ch * 16)); }
    LDS_WAIT(); __syncthreads();
}
__device__ __forceinline__ void p2_mix(const Args& a, LAS unsigned char* lds, int bx, int G, int wid, int lane, ssq_t* SSQSB, int which = 3, int pstop = 9, bf16_t* pool_dst = nullptr, volatile LAS unsigned* stp = nullptr) {
    unsigned char* ws = a.ws; const bf16_t* QKVU = (const bf16_t*)(ws + WS_QKVU); bf16_t* MIXED = (bf16_t*)(ws + WS_MIXED);
    constexpr int NA = B * NH * (S / 512);
    if (which & 1) for (int i = 0; i * G + bx < NA; ++i) { const int w = pg8::xcd_remap(i * G + bx, NA); const int bh = w >> 3, qb = w & 7;
        sb_item(bh >> 3, bh & 7, qb * 8 + wid, QKVU, MIXED, SSQSB, lds + RING_OFF + wid * 16384, lane); }
    __syncthreads();
    if (which & 2) for (int t = bx; t < NTOK / 64; t += G) pool_unit(t, QKVU, pool_dst ? pool_dst : MIXED, lds + RING_OFF, wid, lane);
}
constexpr size_t BAR_REGION_OFF = 1 * MiB, BAR_REGION_STRIDE = 16 * 1024;
__global__ void __launch_bounds__(NWAVES * 64, 2) mega(Args args) {
    const int li = args.li;
    extern __shared__ __attribute__((aligned(16))) unsigned char lds_raw[];
    LAS unsigned char* lds = (LAS unsigned char*)lds_raw;
    volatile LAS unsigned* MISC = (volatile LAS unsigned*)(lds + MISC_OFF);
    const int wave = __builtin_amdgcn_readfirstlane((int)threadIdx.x >> 6);
#define LANE_ID() ({ int l_; asm volatile("v_mbcnt_lo_u32_b32 %0, -1, 0\n\tv_mbcnt_hi_u32_b32 %0, -1, %0" : "=v"(l_)); l_; })
    const int G = gridDim.x; const int bx = blockIdx.x; const int vcu = (G % 8 == 0) ? (bx % 8) * (G / 8) + bx / 8 : bx;
    for (int u = wave * 64 + LANE_ID(); u < MISC_BYTES / 4; u += NWAVES * 64) MISC[u] = 0u;
    __syncthreads();
    unsigned char* ws = args.ws;
    XcdBarrier bar = xcd_barrier_post((unsigned*)(ws + BAR_REGION_OFF + (size_t)li * BAR_REGION_STRIDE), MISC + 8);
    const int lo = args.ph_lo, hi = args.ph_hi;
    LAS unsigned char* ring = lds + RING_OFF; LAS unsigned char* epi = lds + EPI_OFF; LAS unsigned* gtab = (LAS unsigned*)(lds + GTAB_OFF);
#ifndef TIME_PHASE
#define TIME_PHASE -1
#endif
#define REP_OF(k) ((TIME_PHASE == (k)) ? 2 : 1)
#define REPE_OF(k) ((TIME_PHASE == 20 + (k)) ? 2 : 1)
#define IN(k) (lo <= (k) && (k) < hi)
#ifndef TSK
#define TSK -1
#endif
#ifndef TSCALE
#define TSCALE 1.0f
#endif
#define STAMP(i) do { if (TSK >= 0 && wave == 0) { const unsigned long long t_ = __builtin_amdgcn_s_memrealtime(); MISC[128 + 2 * (i)] = (unsigned)t_; MISC[129 + 2 * (i)] = (unsigned)(t_ >> 32); } } while (0)
#define SEAM(k) do { if (IN(k) && IN((k) + 1)) xcd_barrier(bar); STAMP((k) + 1); } while (0)
    STAMP(0);
    if (IN(0)) { p0_prologue(args, lds, vcu, G, wave, LANE_ID()); if (TIME_PHASE == 0) { xcd_barrier(bar); p0_prologue(args, lds, vcu, G, wave, LANE_ID()); } SEAM(0); }
    if (IN(1)) { SchedP1 S{G, bx, ws}; pg8::EpiBf16S E; pg8::gemm_phase<pg8::EpiBf16S, SchedP1, 0, REP_OF(1), REPE_OF(1)>(wave, ring, epi, gtab, D * 2, D * 2, D / 64, S, E);
        if (G == 256 && bx >= 64) p1_deferred_items(args, lds, bx - 64, wave, LANE_ID());
        else if (G != 256 && bx == 0) { for (int rk = 0; rk < 192; ++rk) p1_deferred_items(args, lds, rk, wave, LANE_ID()); }
        SEAM(1); }
    {
    const float* xin0 = args.in[0]; float* outp = args.out;
    bf16_t* S0p = (bf16_t*)(ws + WS_S0); ssq_t* SSQSBp = (ssq_t*)(ws + MK_SSQSB); ssq_t* SSQ1p = (ssq_t*)(ws + MK_SSQ1); ssq_t* SSQ2p = (ssq_t*)(ws + MK_SSQ2);
    constexpr size_t TSTEP = (size_t)256 * D * 2;
    #if !defined(PH_ONLY) || PH_ONLY == 2
    if (IN(2)) { if (TIME_PHASE == 42) { p2_mix(args, lds, bx, G, wave, LANE_ID(), (ssq_t*)(ws + 1280 * 1024), 2); xcd_barrier(bar); p2_mix(args, lds, bx, G, wave, LANE_ID(), (ssq_t*)(ws + 1280 * 1024), 2); xcd_barrier(bar); }
    if (TIME_PHASE == 2 || TIME_PHASE == 40 || TIME_PHASE == 41) { p2_mix(args, lds, bx, G, wave, LANE_ID(), (ssq_t*)(ws + 1280 * 1024), TIME_PHASE == 40 ? 1 : (TIME_PHASE == 41 ? 2 : 3)); xcd_barrier(bar); } STAMP(20); p2_mix(args, lds, bx, G, wave, LANE_ID(), (ssq_t*)(ws + MK_SSQSB), 1); STAMP(21); p2_mix(args, lds, bx, G, wave, LANE_ID(), (ssq_t*)(ws + MK_SSQSB), 2, 9, nullptr, (TSK >= 30 && bx == 0) ? MISC + 128 + 60 : nullptr); STAMP(22); SEAM(2); STAMP(23); }
#endif

#if !defined(PH_ONLY) || PH_ONLY == 3
    if (IN(3)) { SchedReg S{G, bx, NTOK / 256, D / 256, (const char*)(ws + WS_MIXED), (const char*)(ws + WS_WOUT), TSTEP, TSTEP, nullptr, D, nullptr, nullptr};
        EpiResid<8, true, true> E{nullptr, S0p, ws + WS_X1F8, SSQ1p, SSQSBp, 1.0f}; pg8::gemm_phase<EpiResid<8, true, true>, SchedReg, 0, REP_OF(3)>    (wave, ring, epi, gtab, D * 2, D * 2, D / 64, S, E); SEAM(3); }
#endif
#if !defined(PH_ONLY) || PH_ONLY == 4
    if (IN(4)) { SchedReg S{G, bx, NTOK / 256, D / 256, (const char*)(ws + WS_X1F8), (const char*)(ws + WS_WQ), TSTEP / 2, TSTEP / 2, (bf16_t*)(ws + WS_QM), D, nullptr, nullptr, SSQ1p};
        EpiBf16Ssq E{1.0f / D, C2_MEM / WSCALE}; pg8::gemm_phase<EpiBf16Ssq, SchedReg, 0, REP_OF(4), 1, true>(wave, ring, epi, gtab, D, D, D / 128, S, E); SEAM(4); }
#endif
#if !defined(PH_ONLY) || PH_ONLY == 5
    if (IN(5)) { SchedMS S{G, bx, ws}; EpiSoftmax E; pg8::gemm_phase<EpiSoftmax, SchedMS, 0, REP_OF(5)>(wave, ring, epi, gtab, D * 2, D * 2, MHD / 64, S, E); SEAM(5); }
#endif
#if !defined(PH_ONLY) || PH_ONLY == 6
    if (IN(6)) { SchedPV S{G, bx, ws}; pg8::EpiBf16S E; pg8::gemm_phase<pg8::EpiBf16S, SchedPV, 0, REP_OF(6)>(wave, ring, epi, gtab, D * 2, NMEM * 2, NMEM / 64, S, E); SEAM(6); }
#endif
#if !defined(PH_ONLY) || PH_ONLY == 7
    if (IN(7)) { SchedReg S{G, bx, NTOK / 256, D / 256, (const char*)(ws + WS_OM), (const char*)(ws + WS_WO), TSTEP, TSTEP, nullptr, D, nullptr, nullptr};
        EpiResid<-1, true, true> E{nullptr, S0p, ws + WS_X2F8, SSQ2p, nullptr, 1.0f}; pg8::gemm_phase<EpiResid<-1, true, true>, SchedReg, 0, REP_OF(7)>(wave, ring, epi, gtab, D * 2, D * 2, D / 64, S, E); SEAM(7); }
#endif
#if !defined(PH_ONLY) || PH_ONLY == 8
    if (IN(8)) { if (TIME_PHASE == 8) { p8_route(args, lds, bx, G, wave, LANE_ID(), (int*)(ws + 1536 * 1024)); xcd_barrier(bar); } p8_route(args, lds, bx, G, wave, LANE_ID(), (int*)(ws + OFF_CNT)); SEAM(8); }
#endif
#if !defined(PH_ONLY) || PH_ONLY == 9
    if (IN(9)) { moe_table(args, MISC, wave * 64 + LANE_ID()); SchedMoE<8, true> S{G, bx, ws, MISC, args.in[18]}; EpiSwiGLU E{ws + WS_ACT};
        pg8::gemm_phase<EpiSwiGLU, SchedMoE<8, true>, 1, REP_OF(9), REPE_OF(9), true>(wave, ring, epi, gtab, D, D, D / 128, S, E); SEAM(9); }
#endif
#if !defined(PH_ONLY) || PH_ONLY == 10
    if (IN(10)) { moe_table(args, MISC, wave * 64 + LANE_ID()); SchedMoE<4, false> S{G, bx, ws, MISC, args.in[20]}; EpiW2 E{ws + WS_Y};
        pg8::gemm_phase<EpiW2, SchedMoE<4, false>, 2, REP_OF(10), REPE_OF(10), true>(wave, ring, epi, gtab, DFF, DFF, DFF / 128, S, E); SEAM(10); }
#endif
#if !defined(PH_ONLY) || PH_ONLY == 11
    if (IN(11)) { if (TIME_PHASE == 11) { p11_final(args, vcu, G, wave, LANE_ID(), (float*)(ws + WS_ACT)); xcd_barrier(bar); } p11_final(args, vcu, G, wave, LANE_ID(), args.out); }
#endif
}

    if (TSK >= 100) { __syncthreads(); float* dbg = (float*)(ws + 1792 * 1024);
        if (wave == 0 && LANE_ID() == 0) { const int a_ = (TSK >= 200) ? 21 : 20; const unsigned long long t0 = ((unsigned long long)MISC[129 + 2 * a_] << 32) | MISC[128 + 2 * a_], t1 = ((unsigned long long)MISC[131 + 2 * a_] << 32) | MISC[130 + 2 * a_];
            __hip_atomic_store(dbg + bx, (float)(t1 - t0) * 0.01f, __ATOMIC_RELAXED, __HIP_MEMORY_SCOPE_AGENT); }
        xcd_barrier(bar);
        if (bx == 0 && wave == 0) { const int l_ = LANE_ID(); float mx = 0.f, mn = 1e9f; for (int q = l_; q < G; q += 64) { const float v = __hip_atomic_load(dbg + q, __ATOMIC_RELAXED, __HIP_MEMORY_SCOPE_AGENT); mx = fmaxf(mx, v); mn = fminf(mn, v); }
            for (int o_ = 1; o_ < 64; o_ <<= 1) { mx = fmaxf(mx, __shfl_xor(mx, o_)); mn = fminf(mn, __shfl_xor(mn, o_)); }
            if (l_ == 0) { asm volatile("s_waitcnt vmcnt(0)" ::: "memory"); args.out[0] = ((TSK % 100) == 0 ? mx : mn) * TSCALE; } } }
    else if (TSK >= 0) { STAMP(12); __syncthreads(); if (bx == 0 && wave == 0 && LANE_ID() == 0) { asm volatile("s_waitcnt vmcnt(0)" ::: "memory");
        const unsigned long long t0 = ((unsigned long long)MISC[129 + 2 * TSK] << 32) | MISC[128 + 2 * TSK], t1 = ((unsigned long long)MISC[131 + 2 * TSK] << 32) | MISC[130 + 2 * TSK];
        args.out[0] = (float)(t1 - t0) * 0.01f * TSCALE; } }
    if (TIME_PHASE == 12) { for (int q = 0; q < 10; ++q) xcd_barrier(bar); }
#undef IN
#undef SEAM
}
}

#ifndef MEGA_MASK
#define MEGA_MASK 0xFFF
#endif
extern "C" void kernel_launch(void* const* d_in, const int* in_sizes, int n_in, void* d_out, int out_size, void* d_ws, size_t ws_size, hipStream_t stream) {
    if (n_in != 22 || out_size != NTOK * D || ws_size < WS_END) { fprintf(stderr, "kernel_launch: unexpected shapes (n_in %d out %d ws %zu)\n", n_in, out_size, ws_size); return; }
    static int grid = 0;
    if (grid == 0) {
        int dev = 0, cus = 0;
        if (hipGetDevice(&dev) != hipSuccess || hipDeviceGetAttribute(&cus, hipDeviceAttributeMultiprocessorCount, dev) != hipSuccess) { grid = -1; return; }
        if (hipFuncSetAttribute((const void*)mk::mega, hipFuncAttributeMaxDynamicSharedMemorySize, mk::LDS_BYTES) != hipSuccess) { fprintf(stderr, "kernel_launch: hipFuncSetAttribute failed\n"); grid = -1; return; }
        int per_cu = 0; (void)hipOccupancyMaxActiveBlocksPerMultiprocessor(&per_cu, (const void*)mk::mega, mk::NWAVES * 64, mk::LDS_BYTES); (void)hipGetLastError();
        if (per_cu < 1) fprintf(stderr, "kernel_launch: occupancy query reports %d blocks per CU\n", per_cu);
        grid = cus;
    }
    if (grid < 0) return;
    const float* x = (const float*)d_in[0]; const float* mem = (const float*)d_in[1]; const float* g_mix = (const float*)d_in[2]; const float* w_in = (const float*)d_in[3];
    const float* g_sb = (const float*)d_in[4]; const float* g_pool = (const float*)d_in[5]; const float* w_pool = (const float*)d_in[6]; const float* pool_scale = (const float*)d_in[7];
    const float* w_out = (const float*)d_in[8]; const float* g_mem_q = (const float*)d_in[9]; const float* g_mem_kv = (const float*)d_in[10]; const float* w_mem_q = (const float*)d_in[11];
    const float* w_mem_kv = (const float*)d_in[12]; const float* w_mem_o = (const float*)d_in[13]; const float* g_ffn = (const float*)d_in[14]; const float* w_router = (const float*)d_in[15];
    const float* b_router = (const float*)d_in[16]; const float* w_e_in = (const float*)d_in[17]; const float* b_e_in = (const float*)d_in[18]; const float* w_e_out = (const float*)d_in[19];
    const float* b_e_out = (const float*)d_in[20]; const float* g_final = (const float*)d_in[21];
    float* out = (float*)d_out; unsigned char* ws = (unsigned char*)d_ws;
    bf16_t* WIN = (bf16_t*)(ws + WS_WIN); bf16_t* WOUT = (bf16_t*)(ws + WS_WOUT); bf16_t* WQ = (bf16_t*)(ws + WS_WQ); bf16_t* WKV = (bf16_t*)(ws + WS_WKV); bf16_t* WO = (bf16_t*)(ws + WS_WO);
    bf16_t* WP = (bf16_t*)(ws + WS_WP); float* WR = (float*)(ws + WS_WR); float* RSTDX = (float*)(ws + WS_RSTDX); float* RSTDM = (float*)(ws + WS_RSTDM);
    bf16_t* W1 = (bf16_t*)(ws + WS_W1); bf16_t* W2 = (bf16_t*)(ws + WS_W2); bf16_t* S0 = (bf16_t*)(ws + WS_S0); bf16_t* QKVU = (bf16_t*)(ws + WS_QKVU);
    bf16_t* QM = (bf16_t*)(ws + WS_QM); bf16_t* OM = (bf16_t*)(ws + WS_OM); bf16_t* MIXED = (bf16_t*)(ws + WS_MIXED); bf16_t* PM = (bf16_t*)(ws + WS_PM); bf16_t* ACT = (bf16_t*)(ws + WS_ACT);
    bf16_t* KM = (bf16_t*)(ws + WS_KM); bf16_t* VMT = (bf16_t*)(ws + WS_VMT); bf16_t* MEMB = (bf16_t*)(ws + WS_MEMB); int* LSLOT = (int*)(ws + WS_LSLOT); float* LGATE = (float*)(ws + WS_LGATE);
    bf16_t* Y = (bf16_t*)(ws + WS_Y); float* SCR_S = (float*)(ws + WS_SCR_S); bf16_t* POOLED = (bf16_t*)(ws + WS_SCR_POOLED); float* POOLO = (float*)(ws + WS_SCR_POOLO);
    int* CNT = (int*)(ws + OFF_CNT); float* SSQSB = (float*)(ws + OFF_SSQSB); float* SSQ1 = (float*)(ws + OFF_SSQ1); float* SSQ2 = (float*)(ws + OFF_SSQ2);

    (void)hipMemsetAsync(ws + WS_CTL, 0, CTL_BYTES, stream);
    mk::Args a{}; for (int i = 0; i < 22; ++i) a.in[i] = (const float*)d_in[i]; a.out = out; a.ws = ws;
    const dim3 tb(32, 8); const int BIG = 1 << 30; int li = 0;
    for (int p = 0; p < mk::NPHASE;) {
        if ((MEGA_MASK >> p) & 1) { int q = p; while (q < mk::NPHASE && ((MEGA_MASK >> q) & 1)) ++q;
            a.ph_lo = p; a.ph_hi = q; a.li = li; hipLaunchKernelGGL(mk::mega, dim3(grid), dim3(mk::NWAVES * 64), mk::LDS_BYTES, stream, a); ++li; p = q; continue; }
        switch (p) {
        case 0:
            nv::k_cvt_w<<<dim3(INP / 32, D / 32, 1), tb, 0, stream>>>(w_in, D, INP, WIN, INP, g_mix, nullptr, BIG, nullptr, 0, 0);
            nv::k_cvt_w<<<dim3(D / 32, D / 32, 1), tb, 0, stream>>>(w_out, D, D, WOUT, D, g_sb, g_pool, SBW, nullptr, 0, 0);
            nv::k_cvt_w<<<dim3(D / 32, D / 32, 1), tb, 0, stream>>>(w_mem_q, D, D, WQ, D, g_mem_q, nullptr, BIG, nullptr, 0, 0);
            nv::k_cvt_w<<<dim3(2 * D / 32, D / 32, 1), tb, 0, stream>>>(w_mem_kv, D, 2 * D, WKV, 2 * D, g_mem_kv, nullptr, BIG, nullptr, 0, 0);
            nv::k_cvt_w<<<dim3(D / 32, D / 32, 1), tb, 0, stream>>>(w_mem_o, D, D, WO, D, nullptr, nullptr, BIG, nullptr, 0, 0);
            nv::k_cvt_w<<<dim3(2 * DFF / 32, D / 32, NE), tb, 0, stream>>>(w_e_in, D, 2 * DFF, W1, 2 * DFF, g_ffn, nullptr, BIG, nullptr, 0, 1);
            nv::k_cvt_w<<<dim3(D / 32, DFF / 32, NE), tb, 0, stream>>>(w_e_out, DFF, D, W2, D, nullptr, nullptr, BIG, nullptr, 0, 0);
            nv::k_cvt_w<<<dim3(PGD / 32, PGD / 32, PG), tb, 0, stream>>>(w_pool, PGD, PGD, WP, PGD, nullptr, nullptr, BIG, pool_scale, PGD, 0);
            nv::k_cvt_router<<<NE * D / 256, 256, 0, stream>>>(w_router, g_ffn, WR);
            nv::k_rowstat_cvt<<<NTOK / 4, 256, 0, stream>>>(x, S0, RSTDX, NTOK);
            nv::k_rowstat_cvt<<<NMROWS / 4, 256, 0, stream>>>(mem, MEMB, RSTDM, NMROWS);
            break;
        case 1:
            nv::k_g1<<<dim3(INP / 64, NTOK / 64), 256, 0, stream>>>(S0, WIN, RSTDX, QKVU);
            nv::k_g1b<<<dim3(2 * D / 64, NMROWS / 64), 256, 0, stream>>>(MEMB, WKV, RSTDM, KM, VMT);
            break;
        case 2:
            nv::k_sb<<<B * NH * S / 256, 256, 0, stream>>>(QKVU, MIXED, SSQSB);
            nv::k_pool1<<<(unsigned)((size_t)NTOK * PW / 256), 256, 0, stream>>>(QKVU, POOLED);
            nv::k_pool2<<<dim3(PGD / 64, NTOK / 64, PG), 256, 0, stream>>>(POOLED, WP, POOLO);
            nv::k_pool3<<<NTOK / 4, 256, 0, stream>>>(POOLO, MIXED);
            break;
        case 3: nv::k_resid<<<dim3(D / 64, NTOK / 64), 256, 0, stream>>>(MIXED, WOUT, x, out, S0, SSQ1, SSQSB, SBW); break;
        case 4: nv::k_g3<<<dim3(D / 64, NTOK / 64), 256, 0, stream>>>(S0, WQ, SSQ1, QM); break;
        case 5:
            nv::k_ms<<<dim3(NMEM / 64, NTOK / 64, MH), 256, 0, stream>>>(QM, KM, SCR_S);
            nv::k_msoftmax<<<NTOK * MH / 4, 256, 0, stream>>>(SCR_S, PM);
            break;
        case 6: nv::k_mpv<<<dim3(MHD / 64, NTOK / 64, MH), 256, 0, stream>>>(PM, VMT, OM); break;
        case 7: nv::k_resid<<<dim3(D / 64, NTOK / 64), 256, 0, stream>>>(OM, WO, out, out, S0, SSQ2, SSQ2, -1); break;
        case 8: nv::k_route<<<NTOK / 4, 256, 0, stream>>>(out, SSQ2, WR, b_router, CNT, LSLOT, LGATE); break;
        case 9: nv::k_w1<<<dim3(DFF / 32, LCAP / 64, NE), 256, 0, stream>>>(S0, SSQ2, W1, b_e_in, CNT, LSLOT, ACT); break;
        case 10: nv::k_w2<<<dim3(D / 64, LCAP / 64, NE), 256, 0, stream>>>(ACT, W2, b_e_out, CNT, LSLOT, LGATE, Y); break;
        case 11: nv::k_final<<<NTOK / 4, 256, 0, stream>>>(out, Y, g_final); break;
        }
        ++p;
    }
}
```

```cpp
#include <hip/hip_runtime.h>
#include <cstdio>
#include <cstdint>

typedef unsigned short bf16_t;
typedef short bf16x8 __attribute__((ext_vector_type(8)));
typedef float f32x4 __attribute__((ext_vector_type(4)));
typedef unsigned u32x4 __attribute__((ext_vector_type(4)));

namespace cfg {
constexpr int B = 8, S = 4096, D = 1024, NTOK = B * S;
constexpr int SBW = 512, NH = 8, HD = 64, PW = 512, PG = 4, PGD = 128, INP = 2048;
constexpr int NMEM = 256, MH = 4, MHD = 256, NMROWS = B * NMEM;
constexpr int NE = 32, TOPK = 4, DFF = 1024, LCAP = NTOK;
constexpr float EPS = 1e-5f, LOG2E = 1.4426950408889634f;
constexpr float C2_SB = 0.125f * LOG2E, C2_MEM = 0.0625f * LOG2E;
constexpr float SW_LIMIT = 7.0f, SW_ALPHA = 1.702f;
constexpr int MAXTILES = 544;
constexpr size_t MiB = 1u << 20;
constexpr size_t WS_CTL = 0, CTL_BYTES = 2 * MiB;
constexpr size_t OFF_CNT = 64 * 1024, OFF_SSQSB = 512 * 1024, OFF_SSQ1 = 640 * 1024, OFF_SSQ2 = 768 * 1024;
constexpr size_t WS_WIN = 2 * MiB, WS_WOUT = 6 * MiB, WS_WQ = 8 * MiB, WS_WKV = 10 * MiB, WS_WO = 14 * MiB, WS_WP = 16 * MiB, WS_WR = 17 * MiB;
constexpr size_t WS_RSTDX = 18 * MiB, WS_RSTDM = 18 * MiB + 512 * 1024;
constexpr size_t WS_W1 = 20 * MiB, WS_W2 = 148 * MiB;
constexpr size_t WS_S0 = 212 * MiB;
constexpr size_t WS_QKVU = 276 * MiB;
constexpr size_t WS_QM = 276 * MiB, WS_OM = 340 * MiB;
constexpr size_t WS_MIXED = 404 * MiB;
constexpr size_t WS_PM = 404 * MiB;
constexpr size_t WS_ACT = 276 * MiB;
constexpr size_t WS_KM = 548 * MiB, WS_VMT = 552 * MiB, WS_MEMB = 556 * MiB, WS_LSLOT = 560 * MiB, WS_LGATE = 564 * MiB;
constexpr size_t WS_Y = 568 * MiB;
constexpr size_t WS_SCR_S = 568 * MiB, WS_SCR_POOLED = 696 * MiB, WS_SCR_POOLO = 728 * MiB;
constexpr size_t WS_END = 824 * MiB;
}
using namespace cfg;

__device__ __forceinline__ unsigned f2bf(float f) { unsigned u = __builtin_bit_cast(unsigned, f); return (u + 0x7fffu + ((u >> 16) & 1u)) >> 16; }
__device__ __forceinline__ float bf2f(bf16_t h) { return __builtin_bit_cast(float, (unsigned)h << 16); }
__device__ __forceinline__ float wave_sum(float v) {
#pragma unroll
    for (int o = 1; o < 64; o <<= 1) v += __shfl_xor(v, o);
    return v;
}


#define LAS __attribute__((address_space(3)))
#define GAS __attribute__((address_space(1)))
typedef int v4i_t __attribute__((ext_vector_type(4)));
typedef int v8i_t __attribute__((ext_vector_type(8)));
namespace pg8 {
constexpr int BM = 256, BK = 64, HALF = 128, HTB = HALF * BK * 2, STAGE_BYTES = 8 * HTB, NXCD = 8, WGM = 8;
__host__ __device__ __forceinline__ int lds_byte(int r, int c) { const int st = (r >> 4) * 2 + (c >> 5), rr = r & 15, cc = c & 31, ob = rr * 64 + cc * 2; return st * 1024 + (ob ^ (((ob >> 9) & 1) << 5)); }
__host__ __device__ __forceinline__ void stage_rc(int b, int& R, int& C) { const int st = b / 1024, sb = b % 1024, swz = sb ^ (((sb >> 9) & 1) << 5); R = (st >> 1) * 16 + swz / 64; C = (st & 1) * 32 + (swz % 64) / 2; }
__host__ __device__ __forceinline__ int perm32(int rho) { const int n = rho >> 4, i = rho & 15; return 8 * (i >> 2) + 4 * n + (i & 3); }
__device__ __forceinline__ unsigned cvt_pk_bf16(float lo, float hi) { unsigned r; asm volatile("v_cvt_pk_bf16_f32 %0, %1, %2" : "=v"(r) : "v"(lo), "v"(hi)); return r; }

#define WTMASK 0x008
#ifndef WTMASK
#define WTMASK 0x1ff
#endif
#define WT_ON(bit) (((WTMASK) >> (bit)) & 1)
__device__ __forceinline__ void st16_wt(void* p, u32x4 v) { asm volatile("global_store_dwordx4 %0, %1, off sc1\n\ts_nop 1" :: "v"(p), "v"(v)); }
__device__ __forceinline__ void st16_wt(void* p, f32x4 v) { asm volatile("global_store_dwordx4 %0, %1, off sc1\n\ts_nop 1" :: "v"(p), "v"(v)); }
template <int BIT, class V> __device__ __forceinline__ void st16(void* p, V v) { if constexpr (WT_ON(BIT)) st16_wt(p, v); else *(V*)p = v; }
#ifndef WT8
#define WT8 0
#endif
__device__ __forceinline__ void st8_wt(void* p, unsigned long long v) { if (WT8) __hip_atomic_store((unsigned long long*)p, v, __ATOMIC_RELAXED, __HIP_MEMORY_SCOPE_AGENT); else *(unsigned long long*)p = v; }
__device__ __forceinline__ void st4_wt(void* p, unsigned v) { if (WT8) __hip_atomic_store((unsigned*)p, v, __ATOMIC_RELAXED, __HIP_MEMORY_SCOPE_AGENT); else *(unsigned*)p = v; }
__device__ __forceinline__ int fresh_lane() { int l; asm volatile("v_mbcnt_lo_u32_b32 %0, -1, 0\n\tv_mbcnt_hi_u32_b32 %0, -1, %0" : "=v"(l)); return l; }
struct Unit { const char* A; const char* B; void* p0; void* p1; void* p2; void* p3; int pm, pn, i0, i1, ghost; };

__device__ __forceinline__ int xcd_remap(int L, int nwg) { const int q = nwg / NXCD, r = nwg % NXCD, xcd = L % NXCD, off = L / NXCD; return __builtin_amdgcn_readfirstlane((xcd < r ? xcd * (q + 1) : r * (q + 1) + (xcd - r) * q) + off); }
__device__ __forceinline__ void grouped_mn(int wgid, int nM, int nN, int& pm, int& pn) {
    const int nig = WGM * nN, gid = wgid / nig, fm = gid * WGM, gsz = (nM - fm) < WGM ? (nM - fm) : WGM; pm = __builtin_amdgcn_readfirstlane(fm + ((wgid % nig) % gsz)); pn = __builtin_amdgcn_readfirstlane((wgid % nig) / gsz); }

template <class Epi, class Sched, int TABS, int REP = 1, int REPE = 1, bool F8 = false>
__device__ __forceinline__ void gemm_phase(const int wid, LAS unsigned char* lds, LAS unsigned char* epi_lds, LAS unsigned* gtab, const int lda_b, const int ldb_b, const int nt, const Sched& S, const Epi& E) {
    constexpr bool GATHER = (TABS == 1);
    const int wr = wid >> 2, wc = wid & 3;
    unsigned voffA, voffB, voffG[2][2]; int aoff, boff;
    { const int lane = fresh_lane(); int R, C; stage_rc(wid * 1024 + lane * 16, R, C); const int Rb = Epi::PERM ? ((R & ~31) + perm32(R & 31)) : R;
      voffA = (unsigned)(R * lda_b + C * 2); voffB = (unsigned)(Rb * ldb_b + C * 2); voffG[0][0] = voffG[0][1] = voffG[1][0] = voffG[1][1] = 0;
      aoff = lds_byte(wr * 64 + (lane & 15), (lane >> 4) * 8); boff = lds_byte(wc * 32 + (lane & 15), (lane >> 4) * 8); }
    const size_t kstep = (size_t)(BK * 2);
    const size_t hstepA = (size_t)HALF * lda_b, hstepB = (size_t)HALF * ldb_b;
    const unsigned ldsw = (unsigned)wid * 1024u; const unsigned ldsbase = (unsigned)(uintptr_t)lds + ldsw;
#define PG8_SA(b, h) (((b) * 2 + (h)) * HTB)
#define PG8_SB(b, h) ((4 + (b) * 2 + (h)) * HTB)
#define PG8_GLDS(ugp, voff, bufoff, _i) do { unsigned _keep; asm volatile("s_mov_b32 %0, m0\n\ts_mov_b32 m0, %3\n\ts_nop 0\n\tglobal_load_lds_dwordx4 %1, %2\n\ts_mov_b32 m0, %0" \
        : "=&s"(_keep) : "v"(voff), "s"((const char*)(ugp)), "s"(ldsbase + (unsigned)((bufoff) + (_i) * 8192)) : "memory"); } while (0)
#define PG8_STAGE_B(bufoff, gbase) do { _Pragma("unroll") for (int _i = 0; _i < 2; ++_i) PG8_GLDS((const char*)(gbase) + (size_t)_i * 64 * ldb_b, voffB, bufoff, _i); } while (0)
#define PG8_STAGE_A(bufoff, gbase, h) do { if constexpr (GATHER) { _Pragma("unroll") for (int _i = 0; _i < 2; ++_i) PG8_GLDS((const char*)(gbase), voffG[h][_i], bufoff, _i); } \
        else { _Pragma("unroll") for (int _i = 0; _i < 2; ++_i) PG8_GLDS((const char*)(gbase) + (h) * hstepA + (size_t)_i * 64 * lda_b, voffA, bufoff, _i); } } while (0)
#define PG8_LDA(dst, b, h) do { _Pragma("unroll") for (int m = 0; m < 4; ++m) _Pragma("unroll") for (int k = 0; k < 2; ++k) dst[m][k] = *(const LAS bf16x8*)(lds + PG8_SA(b, h) + aoff + m * 2048 + k * 1024); } while (0)
#define PG8_LDB(dst, b, h) do { _Pragma("unroll") for (int n = 0; n < 2; ++n) _Pragma("unroll") for (int k = 0; k < 2; ++k) dst[n][k] = *(const LAS bf16x8*)(lds + PG8_SB(b, h) + boff + n * 2048 + k * 1024); } while (0)
#define PG8_CAT(x0, x1) __builtin_shufflevector(__builtin_bit_cast(v4i_t, x0), __builtin_bit_cast(v4i_t, x1), 0, 1, 2, 3, 4, 5, 6, 7)
#define PG8_MMA(ai, bj, At, Bt) do { __builtin_amdgcn_s_setprio(1); _Pragma("unroll") for (int m = 0; m < 4; ++m) _Pragma("unroll") for (int n = 0; n < 2; ++n) { \
        if constexpr (F8) acc[ai][bj][m][n] = __builtin_amdgcn_mfma_scale_f32_16x16x128_f8f6f4(PG8_CAT(Bt[n][0], Bt[n][1]), PG8_CAT(At[m][0], At[m][1]), acc[ai][bj][m][n], 0, 0, 0, 0, 0, 0); \
        else { _Pragma("unroll") for (int k = 0; k < 2; ++k) acc[ai][bj][m][n] = __builtin_amdgcn_mfma_f32_16x16x32_bf16(Bt[n][k], At[m][k], acc[ai][bj][m][n], 0, 0, 0); } } __builtin_amdgcn_s_setprio(0); } while (0)
#define PG8_WAIT_V(n) asm volatile("s_waitcnt vmcnt(" #n ")" ::: "memory")
#define PG8_WAIT_L(n) asm volatile("s_waitcnt lgkmcnt(" #n ")" ::: "memory")
#define PG8_BAR __builtin_amdgcn_s_barrier()
#define PG8_SCHED __builtin_amdgcn_sched_barrier(0)
#define PG8_GTAB_LOAD(buf, nvalid) do { const int _l = fresh_lane(); int _R, _C; stage_rc(wid * 1024 + _l * 16, _R, _C); _Pragma("unroll") for (int _h = 0; _h < 2; ++_h) _Pragma("unroll") for (int _i = 0; _i < 2; ++_i) { \
        const int _row = _h * HALF + _R + 64 * _i; const unsigned _s = gtab[(buf) * 768 + _row]; voffG[_h][_i] = ((_row < (nvalid)) ? (_s >> 2) * (unsigned)lda_b : 0u) + (unsigned)(_C * 2); } } while (0)
#define PG8_GTAB_DMA(buf, U) do { if (wid < 3) { const int _l = fresh_lane(); const char* _src = (wid == 0) ? (const char*)(U).p3 + _l * 16 : (wid == 1) ? (const char*)(U).p2 + _l * 16 : \
            (TABS == 1 ? (const char*)(U).p1 + (_l & 31) * 16 + (_l >> 5) * (DFF * 4) : (const char*)(U).p1 + _l * 16); \
        __builtin_amdgcn_global_load_lds((const unsigned*)_src, (LAS unsigned*)(gtab + (buf) * 768 + wid * 256), 16, 0, 0); } } while (0)
    auto nextu = [&](int i, Unit& u) -> bool { if constexpr (REP > 1) { const bool ok = S.next(i / REP, u); u.ghost = (i % REP) != REP - 1; return ok; } else { u.ghost = 0; return S.next(i, u); } };
    Unit cur, nxt; int ui = 0;
    if (!nextu(0, cur)) return;
    f32x4 acc[2][2][4][2];
#pragma unroll
    for (int a = 0; a < 2; ++a)
#pragma unroll
        for (int b = 0; b < 2; ++b)
#pragma unroll
            for (int m = 0; m < 4; ++m)
#pragma unroll
                for (int n = 0; n < 2; ++n) acc[a][b][m][n] = (f32x4){0.f, 0.f, 0.f, 0.f};
    bf16x8 At[4][2], B0[2][2], B1[2][2];
    const char* cA = cur.A; const char* cB = cur.B;
    if constexpr (TABS != 0) { PG8_GTAB_DMA(0, cur); PG8_WAIT_V(0); PG8_WAIT_L(0); PG8_BAR; if constexpr (GATHER) PG8_GTAB_LOAD(0, cur.i0); }
    PG8_STAGE_B(PG8_SB(0, 0), cB); PG8_STAGE_B(PG8_SB(0, 1), cB + hstepB); PG8_STAGE_A(PG8_SA(0, 0), cA, 0); PG8_STAGE_A(PG8_SA(0, 1), cA, 1);
    if (wr == 1) PG8_BAR;
    PG8_WAIT_V(2); PG8_BAR;
    PG8_STAGE_B(PG8_SB(1, 0), cB + kstep); PG8_STAGE_A(PG8_SA(1, 0), cA + kstep, 0); PG8_STAGE_B(PG8_SB(1, 1), cB + hstepB + kstep);
    PG8_WAIT_V(6); PG8_BAR;
    for (;;) {
        const bool has_next = nextu(ui + 1, nxt);
        const char* nA = has_next ? nxt.A : cA; const char* nB = has_next ? nxt.B : cB;
#pragma unroll 1
        for (int t = 0; t < nt; t += 2) {
            const bool last = (t == nt - 2);
            const char* a1 = cA + (size_t)(t + 1) * kstep;
            const char* a2 = last ? nA : cA + (size_t)(t + 2) * kstep; const char* b2 = last ? nB : cB + (size_t)(t + 2) * kstep;
            const char* a3 = a2 + kstep; const char* b3 = b2 + kstep;
            if constexpr (Epi::MIDK >= 0) { if (t == Epi::MIDK) E.midk(acc, cur, wr, fresh_lane() & 15); }
            if constexpr (TABS != 0) { if (t == 2 && has_next) PG8_GTAB_DMA((ui + 1) & 1, nxt); }
            if constexpr (GATHER) { PG8_STAGE_A(PG8_SA(1, 1), a1, 1); if (last && has_next) PG8_GTAB_LOAD((ui + 1) & 1, nxt.i0); PG8_SCHED; }
            PG8_LDB(B0, 0, 0); PG8_LDB(B1, 0, 1); PG8_SCHED; PG8_LDA(At, 0, 0); if constexpr (!GATHER) PG8_STAGE_A(PG8_SA(1, 1), a1, 1);
            PG8_WAIT_V(8); PG8_WAIT_L(0); PG8_BAR; PG8_MMA(0, 0, At, B0); PG8_MMA(0, 1, At, B1); PG8_BAR; PG8_SCHED;
            PG8_LDA(At, 0, 1); PG8_STAGE_B(PG8_SB(0, 0), b2); PG8_STAGE_B(PG8_SB(0, 1), b2 + hstepB); PG8_STAGE_A(PG8_SA(0, 0), a2, 0);
            PG8_WAIT_V(8); PG8_WAIT_L(0); PG8_BAR; PG8_MMA(1, 0, At, B0); PG8_MMA(1, 1, At, B1); PG8_BAR; PG8_SCHED;
            PG8_LDB(B0, 1, 0); PG8_LDB(B1, 1, 1); PG8_SCHED; PG8_LDA(At, 1, 0); PG8_STAGE_A(PG8_SA(0, 1), a2, 1);
            PG8_WAIT_V(8); PG8_WAIT_L(0); PG8_BAR; PG8_MMA(0, 0, At, B0); PG8_MMA(0, 1, At, B1); PG8_BAR; PG8_SCHED;
            PG8_LDA(At, 1, 1); PG8_STAGE_B(PG8_SB(1, 0), b3); PG8_STAGE_B(PG8_SB(1, 1), b3 + hstepB); PG8_STAGE_A(PG8_SA(1, 0), a3, 0);
            PG8_WAIT_V(8); PG8_WAIT_L(0); PG8_BAR; PG8_MMA(1, 0, At, B0); PG8_MMA(1, 1, At, B1); PG8_BAR; PG8_SCHED;
        }
        if (wr == 0) PG8_BAR;
        if (!cur.ghost) { const int el = fresh_lane(); LAS unsigned char* ex = (TABS != 0) ? (LAS unsigned char*)(gtab + (ui & 1) * 768) : epi_lds; E(acc, cur, wr, wc, el & 15, el >> 4, wid, el, ex); if constexpr (REPE > 1) { asm volatile("" ::: "memory"); E(acc, cur, wr, wc, el & 15, el >> 4, wid, el, ex); } }
        if (!has_next) break;
#pragma unroll
        for (int a = 0; a < 2; ++a)
#pragma unroll
            for (int b = 0; b < 2; ++b)
#pragma unroll
                for (int m = 0; m < 4; ++m)
#pragma unroll
                    for (int n = 0; n < 2; ++n) acc[a][b][m][n] = (f32x4){0.f, 0.f, 0.f, 0.f};
        cur = nxt; cA = nA; cB = nB; ++ui;
        if (wr == 1) PG8_BAR;
    }
    PG8_WAIT_V(0);
    PG8_BAR;
#undef PG8_SA
#undef PG8_SB
#undef PG8_GLDS
#undef PG8_STAGE_A
#undef PG8_STAGE_B
#undef PG8_LDA
#undef PG8_LDB
#undef PG8_MMA
#undef PG8_CAT
#undef PG8_WAIT_V
#undef PG8_WAIT_L
#undef PG8_BAR
#undef PG8_SCHED
#undef PG8_GTAB_LOAD
#undef PG8_GTAB_DMA
}

template <bool F8O> struct EpiBf16SX {
    static constexpr bool PERM = true; static constexpr int MIDK = -1;
    __device__ __forceinline__ void midk(f32x4 (&)[2][2][4][2], const Unit&, int, int) const {}
    __device__ __forceinline__ void operator()(const f32x4 (&acc)[2][2][4][2], const Unit& u, int wr, int wc, int fr, int fq, int, int, LAS unsigned char*) const {
        bf16_t* O = (bf16_t*)u.p0; unsigned char* O8 = (unsigned char*)u.p0; const float* rs = (const float*)u.p1; const float* cs = (const float*)u.p2; const int ldc = u.i0;
        int r0 = wr * 64 + fr, c0 = wc * 32 + 8 * fq; asm volatile("" : "+v"(r0), "+v"(c0));
        f32x4 cv[2][2];
#pragma unroll
        for (int bj = 0; bj < 2; ++bj)
#pragma unroll
            for (int n = 0; n < 2; ++n) cv[bj][n] = cs ? *(const f32x4*)(cs + c0 + bj * HALF + 4 * n) : (f32x4){1.f, 1.f, 1.f, 1.f};
#pragma unroll
        for (int ai = 0; ai < 2; ++ai)
#pragma unroll
            for (int m = 0; m < 4; ++m) { const int r = r0 + ai * HALF + m * 16; const float rv = rs ? rs[r] : 1.f; bf16_t* rowp = O + (size_t)r * ldc + c0;
#pragma unroll
                for (int bj = 0; bj < 2; ++bj) { const f32x4 v0 = acc[ai][bj][m][0] * cv[bj][0] * rv, v1 = acc[ai][bj][m][1] * cv[bj][1] * rv;
                    if constexpr (F8O) { int w0 = __builtin_amdgcn_cvt_pk_fp8_f32(v0[0], v0[1], 0, false); w0 = __builtin_amdgcn_cvt_pk_fp8_f32(v0[2], v0[3], w0, true); int w1 = __builtin_amdgcn_cvt_pk_fp8_f32(v1[0], v1[1], 0, false); w1 = __builtin_amdgcn_cvt_pk_fp8_f32(v1[2], v1[3], w1, true);
                        st8_wt(O8 + (size_t)r * ldc + c0 + bj * HALF, (unsigned long long)(unsigned)w0 | ((unsigned long long)(unsigned)w1 << 32)); }
                    else { u32x4 w; w.x = cvt_pk_bf16(v0[0], v0[1]); w.y = cvt_pk_bf16(v0[2], v0[3]); w.z = cvt_pk_bf16(v1[0], v1[1]); w.w = cvt_pk_bf16(v1[2], v1[3]);
                    st16<1>(rowp + bj * HALF, w); } } }
    }
};
typedef EpiBf16SX<false> EpiBf16S;
}

namespace mk {
constexpr int NWAVES = 8, NPHASE = 12;
constexpr int RING_OFF = 0, RING_BYTES = 131072, EPI_OFF = 131072, EPI_BYTES = 8192, GTAB_OFF = EPI_OFF + EPI_BYTES, GTAB_BYTES = 6144, MISC_OFF = GTAB_OFF + GTAB_BYTES, MISC_BYTES = 1024;
constexpr int LDS_BYTES = 147456;
static_assert(MISC_OFF + MISC_BYTES <= LDS_BYTES, "LDS map");
constexpr size_t WS_LRS = 84 * MiB;
constexpr size_t WS_X2F8 = WS_Y, WS_X1F8 = WS_Y + 32 * MiB;
constexpr size_t WS_CSG1 = 19 * MiB, WS_WRH = 19 * MiB + 64 * 1024, WS_WRL = 19 * MiB + 128 * 1024;
typedef unsigned ssq_t;
constexpr size_t MK_SSQSB = 256 * 1024, MK_SSQ1 = 512 * 1024, MK_SSQ2 = 768 * 1024;
__device__ __forceinline__ void ssq_add(ssq_t* p, float q) { (void)__hip_atomic_fetch_add(p, (ssq_t)__float2uint_rn(q * 16384.0f), __ATOMIC_RELAXED, __HIP_MEMORY_SCOPE_AGENT); }
__device__ __forceinline__ float ssq_get(const ssq_t* p) { return (float)(*p) * (1.0f / 16384.0f); }
constexpr float WSCALE = 32.0f;
constexpr int P0_DEFER = 192 * 8 * 6;
constexpr int CW_BAR = 1024;

#define RLX_AGENT __ATOMIC_RELAXED, __HIP_MEMORY_SCOPE_AGENT
#define LDS_WAIT() asm volatile("s_waitcnt lgkmcnt(0)" ::: "memory")
#define VM_WAIT() asm volatile("s_waitcnt vmcnt(0)" ::: "memory")
#define XB_TMO      128
#define XB_XCNT(j)  (256  + 64 * (j))
#define XB_XSUB(j)  (1280 + 64 * (j))
#define XB_XGEN(j)  (2304 + 64 * (j))
#define XB_TOP      3328
#define XB_TOPGEN   3392
#define XCD_BAR_WORDS 3456
#define XB_SPIN_CAP (1u << 20)
__device__ __forceinline__ unsigned xb_ld(unsigned* p)              { return __hip_atomic_load(p, __ATOMIC_RELAXED, __HIP_MEMORY_SCOPE_AGENT); }
__device__ __forceinline__ unsigned xb_add(unsigned* p, unsigned v) { return __hip_atomic_fetch_add(p, v, __ATOMIC_RELAXED, __HIP_MEMORY_SCOPE_AGENT); }
__device__ __forceinline__ unsigned xb_xcc_id() { return (unsigned)__builtin_amdgcn_s_getreg((3 << 11) | 20) & 0xFu; }
#define XB_SPIN(cond, bar) do { unsigned _sp = 0; while (cond) { __builtin_amdgcn_s_sleep(1); \
    if ((++_sp & 255u) == 0u) { if (xb_ld(&(bar)[XB_TMO])) break; if (_sp > XB_SPIN_CAP) { atomicAdd(&(bar)[XB_TMO], 1u); break; } } } } while (0)
struct XcdBarrier { unsigned* bar; unsigned x; volatile LAS unsigned* st; };
__device__ __forceinline__ XcdBarrier xcd_barrier_post(unsigned* bar, volatile LAS unsigned* st) {
    XcdBarrier b; b.bar = bar; b.x = xb_xcc_id(); b.st = st;
    if (threadIdx.x == 0) (void)xb_add(&bar[XB_XCNT(b.x)], 1u);
    return b;
}
__device__ __forceinline__ void xcd_barrier_complete(unsigned* bar, unsigned x, unsigned& nloc, unsigned& nx) {
    const unsigned G = gridDim.x * gridDim.y * gridDim.z;
    unsigned sum, cnt, mine, sp = 0u;
    for (;;) {
        sum = 0u; cnt = 0u; mine = 0u;
#pragma unroll
        for (unsigned j = 0; j < 16; ++j) { const unsigned c = xb_ld(&bar[XB_XCNT(j)]); sum += c; cnt += (c > 0u) ? 1u : 0u; mine = (j == x) ? c : mine; }
        if (sum == G) break;
        __builtin_amdgcn_s_sleep(1);
        if ((++sp & 255u) == 0u) { if (xb_ld(&bar[XB_TMO])) break; if (sp > XB_SPIN_CAP) { atomicAdd(&bar[XB_TMO], 1u); break; } }
    }
    nloc = mine > 0u ? mine : 1u; nx = cnt > 0u ? cnt : 1u;
}
__device__ __forceinline__ void xcd_barrier(const XcdBarrier& b) {
    asm volatile("s_waitcnt vmcnt(0)" ::: "memory");
    __syncthreads();
    if (threadIdx.x == 0) {
        unsigned* bar = b.bar;
        __builtin_amdgcn_s_waitcnt(0);
        unsigned nloc = b.st[0], nx = b.st[1];
        if (nloc == 0u) { xcd_barrier_complete(bar, b.x, nloc, nx); b.st[0] = nloc; b.st[1] = nx; }
        const unsigned old = xb_add(&bar[XB_XSUB(b.x)], 1u);
        const unsigned gen = old / nloc;
        if (old + 1u == (gen + 1u) * nloc) {
            __builtin_amdgcn_fence(__ATOMIC_RELEASE, "agent");
            asm volatile("s_waitcnt vmcnt(0)" ::: "memory");
            const unsigned og = xb_add(&bar[XB_TOP], 1u);
            const unsigned tg = og / nx;
            if (og + 1u == (tg + 1u) * nx) xb_add(&bar[XB_TOPGEN], 1u);
            else XB_SPIN(xb_ld(&bar[XB_TOPGEN]) == tg, bar);
            __builtin_amdgcn_fence(__ATOMIC_ACQUIRE, "agent");
            xb_add(&bar[XB_XGEN(b.x)], 1u);
            asm volatile("s_waitcnt vmcnt(0)" ::: "memory");
        } else {
            XB_SPIN(xb_ld(&bar[XB_XGEN(b.x)]) == gen, bar);
            __builtin_amdgcn_fence(__ATOMIC_ACQUIRE, "agent");
            asm volatile("s_waitcnt vmcnt(0)" ::: "memory");
        }
    }
    __syncthreads();
}

struct Args { const float* in[22]; float* out; unsigned char* ws; int ph_lo, ph_hi, li, pad; };

template <bool F8OUT>
__device__ __forceinline__ void p0_item(const float* W, int K, int N, void* WTv, const float* gk, const float* gk2, int ksplit, const float* gn, int mode, LAS float* scr, int item, int lane, float mult = 1.0f, int nblk_dec = 0) {
    const int nblk = nblk_dec ? nblk_dec : N / 32, kb = item / nblk, nb = item % nblk, k0 = 64 * kb, nd0 = 32 * nb;
    int ns0 = nd0; if (mode == 1) { const int pn = nd0 >> 8, j = nd0 & 255; ns0 = (j < 128) ? 128 * pn + j : 1024 + 128 * pn + (j - 128); }
    const int kr = lane >> 3, n4 = (lane & 7) * 4;
    f32x4 v[8];
#pragma unroll
    for (int i = 0; i < 8; ++i) v[i] = *(const f32x4*)(W + (size_t)(k0 + 8 * i + kr) * N + ns0 + n4);
    f32x4 gnv = (f32x4){1.f, 1.f, 1.f, 1.f}; if (gn) gnv = *(const f32x4*)(gn + ns0 + n4);
#pragma unroll
    for (int i = 0; i < 8; ++i) { const int kk = 8 * i + kr, k = k0 + kk; float g = 1.f; if (gk) g = (k < ksplit) ? gk[k] : gk2[k - ksplit];
        const f32x4 t = v[i] * gnv * (g * mult); LAS float* d = scr + kk * 33 + n4; d[0] = t[0]; d[1] = t[1]; d[2] = t[2]; d[3] = t[3]; }
    LDS_WAIT(); asm volatile("" ::: "memory");
    const int c = lane & 7;
#pragma unroll
    for (int j = 0; j < 4; ++j) { const int n = (lane >> 3) + 8 * j; const LAS float* s = scr + (8 * c) * 33 + n;
        if constexpr (F8OUT) { int lo = __builtin_amdgcn_cvt_pk_fp8_f32(s[0 * 33], s[1 * 33], 0, false); lo = __builtin_amdgcn_cvt_pk_fp8_f32(s[2 * 33], s[3 * 33], lo, true);
            int hi2 = __builtin_amdgcn_cvt_pk_fp8_f32(s[4 * 33], s[5 * 33], 0, false); hi2 = __builtin_amdgcn_cvt_pk_fp8_f32(s[6 * 33], s[7 * 33], hi2, true);
            pg8::st8_wt((unsigned char*)WTv + (size_t)(nd0 + n) * K + k0 + 8 * c, (unsigned long long)(unsigned)lo | ((unsigned long long)(unsigned)hi2 << 32)); }
        else { u32x4 o; o.x = pg8::cvt_pk_bf16(s[0 * 33], s[1 * 33]); o.y = pg8::cvt_pk_bf16(s[2 * 33], s[3 * 33]); o.z = pg8::cvt_pk_bf16(s[4 * 33], s[5 * 33]); o.w = pg8::cvt_pk_bf16(s[6 * 33], s[7 * 33]);
            pg8::st16<0>((bf16_t*)WTv + (size_t)(nd0 + n) * K + k0 + 8 * c, o); } }
    LDS_WAIT(); asm volatile("" ::: "memory");
}
__device__ __forceinline__ void p0_fused_pool_item(const float* w_in, const float* g_mix, const float* w_pool, const float* pool_scale, bf16_t* WIN_T, int item, int lane) {
    const int eb = item & 7, kb = (item >> 3) & 15, g = item >> 7; const int k = kb * 64 + lane, e0 = eb * 16;
    const float* ap = w_in + (size_t)k * INP + 3 * SBW + g * PGD; const float* bp = w_pool + (size_t)g * PGD * PGD + e0;
    float acc[16];
#pragma unroll
    for (int j = 0; j < 16; ++j) acc[j] = 0.f;
#pragma unroll 4
    for (int c = 0; c < PGD; ++c) { const float a = ap[c];
#pragma unroll
        for (int j = 0; j < 16; ++j) acc[j] += a * bp[c * PGD + j]; }
    const float gk = g_mix[k];
#pragma unroll
    for (int j = 0; j < 16; ++j) WIN_T[(size_t)(3 * SBW + g * PGD + e0 + j) * D + k] = (bf16_t)f2bf(acc[j] * gk * pool_scale[g * PGD + e0 + j]);
}
__device__ __forceinline__ void p0_row(const float* xrow, bf16_t* orow, float* rstd, int lane) {
    const f32x4* xr = (const f32x4*)xrow + 2 * lane; f32x4 v[4]; float s = 0.f;
#pragma unroll
    for (int j = 0; j < 4; ++j) { v[j] = xr[(j >> 1) * 128 + (j & 1)]; s += (v[j].x * v[j].x + v[j].y * v[j].y) + (v[j].z * v[j].z + v[j].w * v[j].w); }
    s = wave_sum(s); if (lane == 0) *rstd = 1.0f / sqrtf(s * (1.0f / D) + EPS);
#pragma unroll
    for (int j = 0; j < 2; ++j) { u32x4 o; o.x = pg8::cvt_pk_bf16(v[2 * j].x, v[2 * j].y); o.y = pg8::cvt_pk_bf16(v[2 * j].z, v[2 * j].w); o.z = pg8::cvt_pk_bf16(v[2 * j + 1].x, v[2 * j + 1].y); o.w = pg8::cvt_pk_bf16(v[2 * j + 1].z, v[2 * j + 1].w);
        pg8::st16<0>(orow + j * 512 + 8 * lane, o); }
}
__device__ __forceinline__ void p0_prologue(const Args& a, LAS unsigned char* lds, int vcu, int G, int wave, int lane) {
    unsigned char* ws = a.ws;
    LAS float* scr = (LAS float*)(lds + RING_OFF + wave * 16384);
    const int gw = vcu * NWAVES + wave, NGW = G * NWAVES;
    constexpr int I_E1 = (D / 64) * (2 * DFF / 32), I_E2 = (DFF / 64) * (D / 32);
    constexpr int I_IN = (D / 64) * (3 * SBW / 32), I_FP = PG * 16 * 8, I_SQ = (D / 64) * (D / 32), I_KV = (D / 64) * (2 * D / 32), I_P = (PGD / 64) * (PGD / 32);
    constexpr int N1 = NE * I_E1, N2 = NE * I_E2, NITEMS = N1 + N2 + I_IN + 3 * I_SQ + I_KV + I_FP;
    const int BIG = 1 << 30;
    for (int it = gw; it < NITEMS; it += NGW) {
        int r = it;
        if (r < N1 + N2 && r >= N1 + N2 - P0_DEFER) continue;
        if (r < N1) { const int e = r / I_E1; p0_item<true>(a.in[17] + (size_t)e * D * 2 * DFF, D, 2 * DFF, ws + WS_W1 + (size_t)e * 2 * DFF * D, a.in[14], nullptr, BIG, nullptr, 1, scr, r % I_E1, lane, WSCALE); continue; } r -= N1;
        if (r < N2) { const int e = r / I_E2; p0_item<true>(a.in[19] + (size_t)e * DFF * D, DFF, D, ws + WS_W2 + (size_t)e * D * DFF, nullptr, nullptr, BIG, nullptr, 0, scr, r % I_E2, lane, WSCALE); continue; } r -= N2;
        if (r < I_IN) { p0_item<false>(a.in[3], D, INP, (bf16_t*)(ws + WS_WIN), a.in[2], nullptr, BIG, nullptr, 0, scr, r, lane, 1.0f, 3 * SBW / 32); continue; } r -= I_IN;
        if (r < I_SQ) { p0_item<false>(a.in[8], D, D, (bf16_t*)(ws + WS_WOUT), a.in[4], a.in[5], SBW, nullptr, 0, scr, r, lane); continue; } r -= I_SQ;
        if (r < I_SQ) { p0_item<true>(a.in[11], D, D, ws + WS_WQ, a.in[9], nullptr, BIG, nullptr, 0, scr, r, lane, WSCALE); continue; } r -= I_SQ;
        if (r < I_KV) { p0_item<false>(a.in[12], D, 2 * D, (bf16_t*)(ws + WS_WKV), a.in[10], nullptr, BIG, nullptr, 0, scr, r, lane); continue; } r -= I_KV;
        if (r < I_SQ) { p0_item<false>(a.in[13], D, D, (bf16_t*)(ws + WS_WO), nullptr, nullptr, BIG, nullptr, 0, scr, r, lane); continue; } r -= I_SQ;
        p0_fused_pool_item(a.in[3], a.in[2], a.in[6], a.in[7], (bf16_t*)(ws + WS_WIN), r, lane);
    }
    for (int m = gw; m < NTOK; m += NGW) p0_row(a.in[0] + (size_t)m * D, (bf16_t*)(ws + WS_S0) + (size_t)m * D, (float*)(ws + WS_RSTDX) + m, lane);
    for (int m = gw; m < NMROWS; m += NGW) p0_row(a.in[1] + (size_t)m * D, (bf16_t*)(ws + WS_MEMB) + (size_t)m * D, (float*)(ws + WS_RSTDM) + m, lane);
    const int gt = gw * 64 + lane, NGT = NGW * 64;
    for (int i = gt; i < INP; i += NGT) ((float*)(ws + WS_CSG1))[i] = (i < SBW) ? C2_SB : 1.0f;
    for (int i = gt; i < NE * D; i += NGT) { const int e = i / D, k = i % D; const float v = a.in[14][k] * a.in[15][k * NE + e];
        ((float*)(ws + WS_WR))[i] = v; const unsigned h = f2bf(v); ((bf16_t*)(ws + WS_WRH))[i] = (bf16_t)h; ((bf16_t*)(ws + WS_WRL))[i] = (bf16_t)f2bf(v - bf2f((bf16_t)h)); }
}

__device__ __forceinline__ void p1_deferred_items(const Args& a, LAS unsigned char* lds, int rank  , int wave, int lane) {
    constexpr int I_E2 = (DFF / 64) * (D / 32), N2 = NE * I_E2;
    LAS float* scr = (LAS float*)(lds + RING_OFF + wave * 16384);
    for (int k = 0; k < P0_DEFER / (192 * 8); ++k) { const int r = N2 - P0_DEFER + (k * 192 + rank) * 8 + wave; const int e = r / I_E2;
        p0_item<true>(a.in[19] + (size_t)e * DFF * D, DFF, D, a.ws + WS_W2 + (size_t)e * D * DFF, nullptr, nullptr, 1 << 30, nullptr, 0, scr, r % I_E2, lane, WSCALE); }
}
struct SchedP1 {
    int G, c; unsigned char* ws;
    __device__ __forceinline__ bool next(int i, pg8::Unit& u) const {
        const int L = i * G + c; constexpr int NQ = (NTOK / 256) * (INP / 256);
        if (L >= NQ + 64) return false;
        if (L < NQ) { int pm, pn; pg8::grouped_mn(pg8::xcd_remap(L, NQ), NTOK / 256, INP / 256, pm, pn);
            u.A = (const char*)(ws + WS_S0) + (size_t)pm * 256 * D * 2; u.B = (const char*)(ws + WS_WIN) + (size_t)pn * 256 * D * 2;
            u.p0 = (bf16_t*)(ws + WS_QKVU) + (size_t)pm * 256 * INP + pn * 256; u.p1 = (float*)(ws + WS_RSTDX) + pm * 256; u.p2 = (float*)(ws + WS_CSG1) + pn * 256; u.i0 = INP; u.pm = pm; u.pn = pn; }
        else if (L < NQ + 32) { const int k = L - NQ, pm = k >> 2, pn = k & 3;
            u.A = (const char*)(ws + WS_MEMB) + (size_t)pm * 256 * D * 2; u.B = (const char*)(ws + WS_WKV) + (size_t)pn * 256 * D * 2;
            u.p0 = (bf16_t*)(ws + WS_KM) + (size_t)pm * 256 * D + pn * 256; u.p1 = (float*)(ws + WS_RSTDM) + pm * 256; u.p2 = nullptr; u.i0 = D; u.pm = pm; u.pn = pn; }
        else { const int v = L - NQ - 32, b = v >> 2, dt = v & 3;
            u.A = (const char*)(ws + WS_WKV) + (size_t)(D + dt * 256) * D * 2; u.B = (const char*)(ws + WS_MEMB) + (size_t)b * 256 * D * 2;
            u.p0 = (bf16_t*)(ws + WS_VMT) + ((size_t)b * D + dt * 256) * NMEM; u.p1 = nullptr; u.p2 = (float*)(ws + WS_RSTDM) + b * 256; u.i0 = NMEM; u.pm = dt; u.pn = b; }
        u.p3 = nullptr; u.i1 = 0; return true;
    }
};
#define EPI_BAR() asm volatile("s_waitcnt lgkmcnt(0)\n\ts_barrier" ::: "memory")
struct SchedReg {
    int G, c, nM, nN; const char* A; const char* B; size_t astep, bstep; bf16_t* O; int ldc; const float* rs; const float* cs; const ssq_t* sq = nullptr;
    __device__ __forceinline__ bool next(int i, pg8::Unit& u) const {
        const int L = i * G + c; if (L >= nM * nN) return false; int pm, pn; pg8::grouped_mn(pg8::xcd_remap(L, nM * nN), nM, nN, pm, pn);
        u.A = A + (size_t)pm * astep; u.B = B + (size_t)pn * bstep; u.pm = pm; u.pn = pn; u.i0 = ldc; u.i1 = 0;
        u.p0 = O ? (void*)(O + (size_t)pm * 256 * ldc + pn * 256) : nullptr; u.p1 = sq ? (void*)(sq + pm * 256) : (rs ? (void*)(rs + pm * 256) : nullptr); u.p2 = cs ? (void*)(cs + pn * 256) : nullptr; u.p3 = nullptr; return true;
    }
};
struct EpiBf16Ssq {
    static constexpr bool PERM = true; static constexpr int MIDK = -1; float inv_n, mult;
    __device__ __forceinline__ void midk(f32x4 (&)[2][2][4][2], const pg8::Unit&, int, int) const {}
    __device__ __forceinline__ void operator()(f32x4 (&acc)[2][2][4][2], const pg8::Unit& u, int wr, int wc, int fr, int fq, int, int, LAS unsigned char*) const {
        bf16_t* O = (bf16_t*)u.p0; const ssq_t* sq = (const ssq_t*)u.p1; const int ldc = u.i0; int r0 = wr * 64 + fr, c0 = wc * 32 + 8 * fq; asm volatile("" : "+v"(r0), "+v"(c0));
#pragma unroll
        for (int ai = 0; ai < 2; ++ai)
#pragma unroll
            for (int m = 0; m < 4; ++m) { const int r = r0 + ai * 128 + m * 16; const float rv = mult / sqrtf(ssq_get(sq + r) * inv_n + EPS); bf16_t* rowp = O + (size_t)r * ldc + c0;
#pragma unroll
                for (int bj = 0; bj < 2; ++bj) { const f32x4 v0 = acc[ai][bj][m][0] * rv, v1 = acc[ai][bj][m][1] * rv;
                    u32x4 w; w.x = pg8::cvt_pk_bf16(v0[0], v0[1]); w.y = pg8::cvt_pk_bf16(v0[2], v0[3]); w.z = pg8::cvt_pk_bf16(v1[0], v1[1]); w.w = pg8::cvt_pk_bf16(v1[2], v1[3]);
                    pg8::st16<5>(rowp + bj * 128, w); } }
    }
};
template <int MIDK_, bool XIN_BF16, bool F8OUT> struct EpiResid {
    static constexpr bool PERM = true; static constexpr int MIDK = MIDK_;
    const float* xin; bf16_t* xb; unsigned char* x8; ssq_t* ssq; const ssq_t* ssq_mid; float accs;
    __device__ __forceinline__ void midk(f32x4 (&acc)[2][2][4][2], const pg8::Unit& u, int wr, int fr) const {
#pragma unroll
        for (int ai = 0; ai < 2; ++ai)
#pragma unroll
            for (int m = 0; m < 4; ++m) { const int r = u.pm * 256 + ai * 128 + wr * 64 + m * 16 + fr; const float s = 1.0f / sqrtf(ssq_get(ssq_mid + r) * (1.0f / SBW) + EPS);
#pragma unroll
                for (int bj = 0; bj < 2; ++bj)
#pragma unroll
                    for (int n = 0; n < 2; ++n) acc[ai][bj][m][n] *= s; }
    }
    __device__ __forceinline__ void operator()(f32x4 (&acc)[2][2][4][2], const pg8::Unit& u, int wr, int wc, int fr, int fq, int, int, LAS unsigned char*) const {
        int row0 = u.pm * 256 + wr * 64 + fr, col0 = u.pn * 256 + wc * 32 + 8 * fq; asm volatile("" : "+v"(row0), "+v"(col0));
        u32x4 xv[2][4][2]; f32x4 xf[XIN_BF16 ? 1 : 2][XIN_BF16 ? 1 : 4][XIN_BF16 ? 1 : 2][2];
#pragma unroll
        for (int ai = 0; ai < 2; ++ai)
#pragma unroll
            for (int m = 0; m < 4; ++m)
#pragma unroll
                for (int bj = 0; bj < 2; ++bj) { const size_t o2 = (size_t)(row0 + ai * 128 + m * 16) * D + col0 + bj * 128;
                    if constexpr (XIN_BF16) xv[ai][m][bj] = *(const u32x4*)(xb + o2); else { xf[ai][m][bj][0] = *(const f32x4*)(xin + o2); xf[ai][m][bj][1] = *(const f32x4*)(xin + o2 + 4); } }
#pragma unroll
        for (int ai = 0; ai < 2; ++ai)
#pragma unroll
            for (int m = 0; m < 4; ++m) { const int r = row0 + ai * 128 + m * 16; const size_t off = (size_t)r * D + col0; float q = 0.f;
#pragma unroll
                for (int bj = 0; bj < 2; ++bj) { const size_t o2 = off + bj * 128; f32x4 o0, o1;
                    if constexpr (XIN_BF16) { const u32x4 x4 = xv[ai][m][bj];
                        o0 = (f32x4){__builtin_bit_cast(float, x4.x << 16), __builtin_bit_cast(float, x4.x & 0xffff0000u), __builtin_bit_cast(float, x4.y << 16), __builtin_bit_cast(float, x4.y & 0xffff0000u)};
                        o1 = (f32x4){__builtin_bit_cast(float, x4.z << 16), __builtin_bit_cast(float, x4.z & 0xffff0000u), __builtin_bit_cast(float, x4.w << 16), __builtin_bit_cast(float, x4.w & 0xffff0000u)}; }
                    else { o0 = xf[ai][m][bj][0]; o1 = xf[ai][m][bj][1]; }
                    o0 += acc[ai][bj][m][0] * accs; o1 += acc[ai][bj][m][1] * accs;
                    q += (o0[0] * o0[0] + o0[1] * o0[1]) + (o0[2] * o0[2] + o0[3] * o0[3]) + (o1[0] * o1[0] + o1[1] * o1[1]) + (o1[2] * o1[2] + o1[3] * o1[3]);
                    if constexpr (F8OUT) { int w0 = __builtin_amdgcn_cvt_pk_fp8_f32(o0[0], o0[1], 0, false); w0 = __builtin_amdgcn_cvt_pk_fp8_f32(o0[2], o0[3], w0, true);
                        int w1 = __builtin_amdgcn_cvt_pk_fp8_f32(o1[0], o1[1], 0, false); w1 = __builtin_amdgcn_cvt_pk_fp8_f32(o1[2], o1[3], w1, true);
                        pg8::st8_wt(x8 + o2, (unsigned long long)(unsigned)w0 | ((unsigned long long)(unsigned)w1 << 32)); }
                    u32x4 w; w.x = pg8::cvt_pk_bf16(o0[0], o0[1]); w.y = pg8::cvt_pk_bf16(o0[2], o0[3]); w.z = pg8::cvt_pk_bf16(o1[0], o1[1]); w.w = pg8::cvt_pk_bf16(o1[2], o1[3]); pg8::st16<4>(xb + o2, w); }
                q += __shfl_xor(q, 16); q += __shfl_xor(q, 32);
                if (fq == 0) ssq_add(ssq + r, q); }
    }
};
struct SchedMS {
    int G, c; unsigned char* ws;
    __device__ __forceinline__ bool next(int i, pg8::Unit& u) const {
        const int L = i * G + c; constexpr int NU = (NTOK / 256) * MH; if (L >= NU) return false; const int w = pg8::xcd_remap(L, NU), pm = w >> 2, h = w & 3, b = pm >> 4;
        u.A = (const char*)(ws + WS_QM) + ((size_t)pm * 256 * D + h * MHD) * 2; u.B = (const char*)(ws + WS_KM) + ((size_t)b * NMEM * D + h * MHD) * 2;
        u.p0 = (bf16_t*)(ws + WS_PM) + (size_t)pm * 256 * D + h * NMEM; u.p1 = nullptr; u.p2 = nullptr; u.p3 = nullptr; u.i0 = D; u.i1 = 0; u.pm = pm; u.pn = h; return true;
    }
};
struct EpiSoftmax {
    static constexpr bool PERM = true; static constexpr int MIDK = -1;
    __device__ __forceinline__ void midk(f32x4 (&)[2][2][4][2], const pg8::Unit&, int, int) const {}
    __device__ __forceinline__ void operator()(f32x4 (&acc)[2][2][4][2], const pg8::Unit& u, int wr, int wc, int fr, int fq, int, int, LAS unsigned char* xl) const {
        typedef float f32x2v __attribute__((ext_vector_type(2)));
        LAS f32x2v* X = (LAS f32x2v*)xl;
        float ml[2][4];
#pragma unroll
        for (int ai = 0; ai < 2; ++ai)
#pragma unroll
            for (int m = 0; m < 4; ++m) { float mx = -INFINITY;
#pragma unroll
                for (int bj = 0; bj < 2; ++bj)
#pragma unroll
                    for (int n = 0; n < 2; ++n) { const f32x4 v = acc[ai][bj][m][n]; mx = fmaxf(fmaxf(mx, fmaxf(v[0], v[1])), fmaxf(v[2], v[3])); }
                mx = fmaxf(mx, __shfl_xor(mx, 16)); mx = fmaxf(mx, __shfl_xor(mx, 32)); ml[ai][m] = mx; float s = 0.f;
#pragma unroll
                for (int bj = 0; bj < 2; ++bj)
#pragma unroll
                    for (int n = 0; n < 2; ++n) { f32x4 v = acc[ai][bj][m][n];
#pragma unroll
                        for (int j = 0; j < 4; ++j) { v[j] = __builtin_amdgcn_exp2f(v[j] - mx); s += v[j]; }
                        acc[ai][bj][m][n] = v; }
                s += __shfl_xor(s, 16); s += __shfl_xor(s, 32);
                if (fq == 0) X[(ai * 128 + wr * 64 + m * 16 + fr) * 4 + wc] = (f32x2v){mx, s}; }
        EPI_BAR();
        bf16_t* O = (bf16_t*)u.p0; const int ldc = u.i0; int r0 = wr * 64 + fr, c0 = wc * 32 + 8 * fq; asm volatile("" : "+v"(r0), "+v"(c0));
#pragma unroll
        for (int ai = 0; ai < 2; ++ai)
#pragma unroll
            for (int m = 0; m < 4; ++m) { const int r = r0 + ai * 128 + m * 16; const f32x2v a = X[r * 4 + 0], b = X[r * 4 + 1], c = X[r * 4 + 2], d = X[r * 4 + 3];
                const float M = fmaxf(fmaxf(a.x, b.x), fmaxf(c.x, d.x));
                const float tot = a.y * __builtin_amdgcn_exp2f(a.x - M) + b.y * __builtin_amdgcn_exp2f(b.x - M) + c.y * __builtin_amdgcn_exp2f(c.x - M) + d.y * __builtin_amdgcn_exp2f(d.x - M);
                const float f = __builtin_amdgcn_exp2f(ml[ai][m] - M) / tot; bf16_t* rowp = O + (size_t)r * ldc + c0;
#pragma unroll
                for (int bj = 0; bj < 2; ++bj) { const f32x4 v0 = acc[ai][bj][m][0] * f, v1 = acc[ai][bj][m][1] * f;
                    u32x4 w; w.x = pg8::cvt_pk_bf16(v0[0], v0[1]); w.y = pg8::cvt_pk_bf16(v0[2], v0[3]); w.z = pg8::cvt_pk_bf16(v1[0], v1[1]); w.w = pg8::cvt_pk_bf16(v1[2], v1[3]);
                    pg8::st16<6>(rowp + bj * 128, w); } }
    }
};
struct SchedPV {
    int G, c; unsigned char* ws;
    __device__ __forceinline__ bool next(int i, pg8::Unit& u) const {
        const int L = i * G + c; constexpr int NU = (NTOK / 256) * MH; if (L >= NU) return false; const int w = pg8::xcd_remap(L, NU), pm = w >> 2, h = w & 3, b = pm >> 4;
        u.A = (const char*)(ws + WS_PM) + ((size_t)pm * 256 * D + h * NMEM) * 2; u.B = (const char*)(ws + WS_VMT) + ((size_t)b * D + h * MHD) * NMEM * 2;
        u.p0 = (bf16_t*)(ws + WS_OM) + (size_t)pm * 256 * D + h * MHD; u.p1 = nullptr; u.p2 = nullptr; u.p3 = nullptr; u.i0 = D; u.i1 = 0; u.pm = pm; u.pn = h; return true;
    }
};

__device__ __forceinline__ void p8_route(const Args& a, LAS unsigned char* lds, int bx, int G, int wave, int lane, int* CNT) {
    unsigned char* ws = a.ws; const bf16_t* x2 = (const bf16_t*)(ws + WS_S0); const ssq_t* SSQ2 = (const ssq_t*)(ws + MK_SSQ2); const float* br = a.in[16];
    const bf16_t* WRH = (const bf16_t*)(ws + WS_WRH);
    int* LSLOT = (int*)(ws + WS_LSLOT); float* LGATE = (float*)(ws + WS_LGATE); float* LRS = (float*)(ws + WS_LRS);
    constexpr int WPITCH = 2064;
    LAS float* LG = (LAS float*)(lds + RING_OFF + 69632) + wave * 16 * 33;
    LAS int* hist = (LAS int*)(lds + RING_OFF + 90112); LAS int* base = hist + 32;
    const int tid = wave * 64 + lane;
    { u32x4 v[8];
#pragma unroll
      for (int i = 0; i < 8; ++i) v[i] = *(const u32x4*)(WRH + (size_t)(tid + i * 512) * 8);
#pragma unroll
      for (int i = 0; i < 8; ++i) { const int c = tid + i * 512; *(LAS u32x4*)(lds + RING_OFF + (c >> 7) * WPITCH + (c & 127) * 16) = v[i]; } }
    LDS_WAIT(); __syncthreads();
    for (int t0 = bx * 128; t0 < NTOK; t0 += G * 128) {
        if (tid < 32) hist[tid] = 0;
        const int r16 = lane & 15, kq = lane >> 4; const int trow = t0 + wave * 16 + r16;
        const bf16_t* xp = x2 + (size_t)trow * D + kq * 8;
        bf16x8 ah[32];
#pragma unroll
        for (int ks = 0; ks < 32; ++ks) ah[ks] = *(const bf16x8*)(xp + ks * 32);
        f32x4 acc[2] = {(f32x4){0.f, 0.f, 0.f, 0.f}, (f32x4){0.f, 0.f, 0.f, 0.f}};
        const LAS unsigned char* wp = lds + RING_OFF + r16 * WPITCH + kq * 16;
#pragma unroll
        for (int ks = 0; ks < 32; ++ks) {
#pragma unroll
            for (int nb = 0; nb < 2; ++nb) { const bf16x8 bh = *(const LAS bf16x8*)(wp + nb * 16 * WPITCH + ks * 64);
                acc[nb] = __builtin_amdgcn_mfma_f32_16x16x32_bf16(ah[ks], bh, acc[nb], 0, 0, 0); } }
#pragma unroll
        for (int nb = 0; nb < 2; ++nb)
#pragma unroll
            for (int r = 0; r < 4; ++r) { const int tl = kq * 4 + r; const int tk = t0 + wave * 16 + tl; const float rs = 1.0f / sqrtf(ssq_get(SSQ2 + tk) * (1.0f / D) + EPS);
                LG[tl * 33 + nb * 16 + r16] = acc[nb][r] * rs + br[nb * 16 + r16]; }
        LDS_WAIT(); __syncthreads();
        int te[4] = {0, 0, 0, 0}; float tg[4] = {0.f, 0.f, 0.f, 0.f}; int rk[4] = {0, 0, 0, 0};
        if (lane < 16) {
            float tv[4] = {-INFINITY, -INFINITY, -INFINITY, -INFINITY};
            for (int e = 0; e < NE; ++e) { const float v = LG[lane * 33 + e];
                if (v > tv[3]) { if (v > tv[2]) { tv[3] = tv[2]; te[3] = te[2]; if (v > tv[1]) { tv[2] = tv[1]; te[2] = te[1]; if (v > tv[0]) { tv[1] = tv[0]; te[1] = te[0]; tv[0] = v; te[0] = e; } else { tv[1] = v; te[1] = e; } } else { tv[2] = v; te[2] = e; } } else { tv[3] = v; te[3] = e; } } }
            float gs = 0.f;
#pragma unroll
            for (int k = 0; k < 4; ++k) { tg[k] = __expf(tv[k] - tv[0]); gs += tg[k]; }
            gs = 1.0f / gs;
#pragma unroll
            for (int k = 0; k < 4; ++k) { tg[k] *= gs; rk[k] = __hip_atomic_fetch_add(hist + te[k], 1, __ATOMIC_RELAXED, __HIP_MEMORY_SCOPE_WORKGROUP); }
        }
        LDS_WAIT(); __syncthreads();
        if (tid < 32) { const int n = hist[tid]; base[tid] = n ? atomicAdd(CNT + tid, n) : 0; }
        LDS_WAIT(); __syncthreads();
        if (lane < 16) { const int tk = t0 + wave * 16 + lane; const float rsw = (1.0f / WSCALE) / sqrtf(ssq_get(SSQ2 + tk) * (1.0f / D) + EPS);
#pragma unroll
            for (int k = 0; k < 4; ++k) { const size_t p = (size_t)te[k] * LCAP + base[te[k]] + rk[k]; pg8::st4_wt(LSLOT + p, (unsigned)(tk * 4 + k)); pg8::st4_wt(LGATE + p, __float_as_uint(tg[k])); pg8::st4_wt(LRS + p, __float_as_uint(rsw)); } }
        LDS_WAIT(); __syncthreads();
    }
}

__device__ __forceinline__ void moe_table(const Args& a, volatile LAS unsigned* MISC, int tid) {
    const int* CNT = (const int*)(a.ws + OFF_CNT);
    if (tid < 32) MISC[16 + tid] = (unsigned)CNT[tid];
    LDS_WAIT(); __syncthreads();
    if (tid == 0) { unsigned tb = 0; for (int e = 0; e < NE; ++e) { MISC[48 + e] = tb; tb += (MISC[16 + e] + 255u) >> 8; } MISC[48 + NE] = tb; }
    LDS_WAIT(); __syncthreads();
}
template <int NPN, bool W1> struct SchedMoE {
    int G, c; unsigned char* ws; volatile LAS unsigned* MISC; const float* bias;
    __device__ __forceinline__ bool next(int i, pg8::Unit& u) const {
        unsigned mb_ = (unsigned)(uintptr_t)MISC; asm volatile("" : "+s"(mb_)); const LAS unsigned* M = (const LAS unsigned*)(uintptr_t)mb_;
        const int T = __builtin_amdgcn_readfirstlane((int)M[48 + NE]); const int NU = T * NPN; const int L = i * G + c; if (L >= NU) return false;
        const int w = pg8::xcd_remap(L, NU);
        int e = 0;
#pragma unroll
        for (int s = 16; s >= 1; s >>= 1) { if ((int)M[48 + e + s] * NPN <= w) e += s; }
        e = __builtin_amdgcn_readfirstlane(e);
        const int tb = __builtin_amdgcn_readfirstlane((int)M[48 + e]), cnt = __builtin_amdgcn_readfirstlane((int)M[16 + e]), nte = (cnt + 255) >> 8; const int idx = w - tb * NPN, pn = __builtin_amdgcn_readfirstlane(idx / nte), mt = idx - pn * nte;
        u.pm = tb + mt; u.pn = pn; u.i1 = e; const int nv = cnt - mt * 256; u.i0 = nv < 256 ? nv : 256;
        u.p3 = (int*)(ws + WS_LSLOT) + (size_t)e * LCAP + mt * 256; u.p2 = (float*)(ws + (W1 ? WS_LRS : WS_LGATE)) + (size_t)e * LCAP + mt * 256; u.p0 = nullptr;
        u.p1 = W1 ? (void*)(bias + (size_t)e * 2 * DFF + pn * 128) : (void*)(bias + (size_t)e * D + pn * 256);
        if (W1) { u.A = (const char*)(ws + WS_X2F8); u.B = (const char*)(ws + WS_W1) + ((size_t)e * 2 * DFF + pn * 256) * D; }
        else { u.A = (const char*)(ws + WS_ACT) + (size_t)(tb + mt) * 256 * DFF; u.B = (const char*)(ws + WS_W2) + ((size_t)e * D + pn * 256) * DFF; }
        return true;
    }
};
typedef float f32x2 __attribute__((ext_vector_type(2)));
struct EpiSwiGLU {
    static constexpr bool PERM = true; static constexpr int MIDK = -1; unsigned char* act;
    __device__ __forceinline__ void midk(f32x4 (&)[2][2][4][2], const pg8::Unit&, int, int) const {}
    __device__ __forceinline__ void operator()(f32x4 (&acc)[2][2][4][2], const pg8::Unit& u, int wr, int wc, int fr, int fq, int, int, LAS unsigned char* tab) const {
        const int nvalid = u.i0; const LAS float* T1 = (const LAS float*)tab + 256; const LAS float* T2 = (const LAS float*)tab + 512;
        int r0 = wr * 64 + fr, c0 = wc * 32 + 8 * fq; asm volatile("" : "+v"(r0), "+v"(c0)); const int gc0 = u.pn * 128 + c0;
        f32x4 bg[2], bu[2];
#pragma unroll
        for (int n = 0; n < 2; ++n) { bg[n] = *(const LAS f32x4*)(T2 + c0 + 4 * n); bu[n] = *(const LAS f32x4*)(T2 + 128 + c0 + 4 * n); }
#pragma unroll
        for (int ai = 0; ai < 2; ++ai)
#pragma unroll
            for (int m = 0; m < 4; ++m) { const int r = r0 + ai * 128 + m * 16; const float rs = T1[r]; int wv[2];
#pragma unroll
                for (int n = 0; n < 2; ++n) { f32x2 o[2];
#pragma unroll
                    for (int h = 0; h < 2; ++h) { f32x2 g = (f32x2){acc[ai][0][m][n][2 * h], acc[ai][0][m][n][2 * h + 1]} * rs + (f32x2){bg[n][2 * h], bg[n][2 * h + 1]};
                        f32x2 up = (f32x2){acc[ai][1][m][n][2 * h], acc[ai][1][m][n][2 * h + 1]} * rs + (f32x2){bu[n][2 * h], bu[n][2 * h + 1]};
                        g.x = fminf(g.x, SW_LIMIT); g.y = fminf(g.y, SW_LIMIT); up.x = fminf(fmaxf(up.x, -SW_LIMIT), SW_LIMIT); up.y = fminf(fmaxf(up.y, -SW_LIMIT), SW_LIMIT);
                        const f32x2 tt = g * (-SW_ALPHA * LOG2E); f32x2 d; d.x = __builtin_amdgcn_exp2f(tt.x); d.y = __builtin_amdgcn_exp2f(tt.y); d = d + 1.0f;
                        f32x2 rr; rr.x = __builtin_amdgcn_rcpf(d.x); rr.y = __builtin_amdgcn_rcpf(d.y);
                        o[h] = (up + 1.0f) * g * rr; }
                    wv[n] = __builtin_amdgcn_cvt_pk_fp8_f32(o[0].x, o[0].y, 0, false); wv[n] = __builtin_amdgcn_cvt_pk_fp8_f32(o[1].x, o[1].y, wv[n], true); }
                if (r < nvalid) pg8::st8_wt(act + ((size_t)u.pm * 256 + r) * DFF + gc0, (unsigned long long)(unsigned)wv[0] | ((unsigned long long)(unsigned)wv[1] << 32)); }
    }
};
struct EpiW2 {
    static constexpr bool PERM = true; static constexpr int MIDK = -1; unsigned char* Y;
    __device__ __forceinline__ void midk(f32x4 (&)[2][2][4][2], const pg8::Unit&, int, int) const {}
    __device__ __forceinline__ void operator()(f32x4 (&acc)[2][2][4][2], const pg8::Unit& u, int wr, int wc, int fr, int fq, int, int, LAS unsigned char* tab) const {
        const int nvalid = u.i0; const LAS unsigned* T0 = (const LAS unsigned*)tab; const LAS float* T1 = (const LAS float*)tab + 256; const LAS float* T2 = (const LAS float*)tab + 512;
        int r0 = wr * 64 + fr, cl = wc * 32 + 8 * fq; asm volatile("" : "+v"(r0), "+v"(cl)); const int c0 = u.pn * 256 + cl;
        f32x4 bv[2][2];
#pragma unroll
        for (int bj = 0; bj < 2; ++bj)
#pragma unroll
            for (int n = 0; n < 2; ++n) bv[bj][n] = *(const LAS f32x4*)(T2 + cl + bj * 128 + 4 * n);
#pragma unroll
        for (int ai = 0; ai < 2; ++ai)
#pragma unroll
            for (int m = 0; m < 4; ++m) { const int r = r0 + ai * 128 + m * 16; const bool valid = r < nvalid; const unsigned slot = T0[r]; const float g = T1[r];
#pragma unroll
                for (int bj = 0; bj < 2; ++bj) { const f32x4 v0 = (acc[ai][bj][m][0] * (1.0f / WSCALE) + bv[bj][0]) * g, v1 = (acc[ai][bj][m][1] * (1.0f / WSCALE) + bv[bj][1]) * g;
                    int w0 = __builtin_amdgcn_cvt_pk_fp8_f32(v0[0], v0[1], 0, false); w0 = __builtin_amdgcn_cvt_pk_fp8_f32(v0[2], v0[3], w0, true);
                    int w1 = __builtin_amdgcn_cvt_pk_fp8_f32(v1[0], v1[1], 0, false); w1 = __builtin_amdgcn_cvt_pk_fp8_f32(v1[2], v1[3], w1, true);
                    if (valid) pg8::st8_wt(Y + (size_t)slot * D + c0 + bj * 128, (unsigned long long)(unsigned)w0 | ((unsigned long long)(unsigned)w1 << 32)); } }
    }
};

__device__ __forceinline__ void p11_final(const Args& a, int vcu, int G, int wave, int lane, float* dst) {
    const bf16_t* x2 = (const bf16_t*)(a.ws + WS_S0); const unsigned char* Y = a.ws + WS_Y; const float* gf = a.in[21];
    const int gw = vcu * NWAVES + wave, NGW = G * NWAVES;
    f32x4 g4[4];
#pragma unroll
    for (int j = 0; j < 4; ++j) g4[j] = *(const f32x4*)(gf + 16 * lane + 4 * j);
    for (int tok = gw; tok < NTOK; tok += NGW) {
        const u32x4 xa = *(const u32x4*)(x2 + (size_t)tok * D + 16 * lane), xc = *(const u32x4*)(x2 + (size_t)tok * D + 16 * lane + 8);
        u32x4 yv[4];
#pragma unroll
        for (int k = 0; k < 4; ++k) yv[k] = *(const u32x4*)(Y + ((size_t)tok * 4 + k) * D + 16 * lane);
        float v[16];
#pragma unroll
        for (int q = 0; q < 4; ++q) { v[2 * q] = __builtin_bit_cast(float, xa[q] << 16); v[2 * q + 1] = __builtin_bit_cast(float, xa[q] & 0xffff0000u); v[8 + 2 * q] = __builtin_bit_cast(float, xc[q] << 16); v[8 + 2 * q + 1] = __builtin_bit_cast(float, xc[q] & 0xffff0000u); }
#pragma unroll
        for (int k = 0; k < 4; ++k)
#pragma unroll
            for (int q = 0; q < 4; ++q) { const auto lo = __builtin_amdgcn_cvt_pk_f32_fp8((int)yv[k][q], false), hi2 = __builtin_amdgcn_cvt_pk_f32_fp8((int)yv[k][q], true);
                v[4 * q] += lo[0]; v[4 * q + 1] += lo[1]; v[4 * q + 2] += hi2[0]; v[4 * q + 3] += hi2[1]; }
        float s = 0.f;
#pragma unroll
        for (int q = 0; q < 16; ++q) s += v[q] * v[q];
        const float rs = 1.0f / sqrtf(wave_sum(s) * (1.0f / D) + EPS);
#pragma unroll
        for (int j = 0; j < 4; ++j) pg8::st16<8>(dst + (size_t)tok * D + 16 * lane + 4 * j, (f32x4){v[4 * j] * rs * g4[j][0], v[4 * j + 1] * rs * g4[j][1], v[4 * j + 2] * rs * g4[j][2], v[4 * j + 3] * rs * g4[j][3]});
    }
}
typedef float f32x16 __attribute__((ext_vector_type(16)));
typedef short s16x4 __attribute__((ext_vector_type(4)));
__device__ __forceinline__ int crow(int r, int hi) { return (r & 3) + 8 * (r >> 2) + 4 * hi; }
#define SB_DMA(ubase, voff, ldsaddr) do { unsigned keep_; asm volatile("s_mov_b32 %0, m0\n\ts_mov_b32 m0, %3\n\ts_nop 0\n\tglobal_load_lds_dwordx4 %1, %2\n\ts_mov_b32 m0, %0" \
        : "=&s"(keep_) : "v"(voff), "s"((const char*)(ubase)), "s"(ldsaddr) : "memory"); } while (0)
__device__ __forceinline__ void sb_item(int b, int h, int qi  , const bf16_t* QKVU, bf16_t* MIXED, ssq_t* SSQSB, LAS unsigned char* wl  , int lane) {
    const int r32 = lane & 31, hi = lane >> 5;
    const size_t rowbase = (size_t)b * S; const int q0 = qi * 64;
    const bf16_t* Qw = QKVU + (rowbase + q0) * INP + h * HD;
    const char* Kh = (const char*)(QKVU + rowbase * INP + SBW + h * HD); const char* Vh = Kh + SBW * 2;
    bf16x8 qr[2][4];
#pragma unroll
    for (int s = 0; s < 2; ++s)
#pragma unroll
        for (int d0 = 0; d0 < 4; ++d0) qr[s][d0] = *(const bf16x8*)(Qw + (size_t)(s * 32 + r32) * INP + d0 * 16 + hi * 8);
    f32x16 o[2][2];
#pragma unroll
    for (int r = 0; r < 16; ++r) { o[0][0][r] = 0.f; o[0][1][r] = 0.f; o[1][0][r] = 0.f; o[1][1][r] = 0.f; }
    float carry[2] = {1.0f, 1.0f}; bool alive[2] = {true, true};
    const int jd = qi;
    const unsigned kvoff = (unsigned)lane * (INP * 2);
    const unsigned vvoff = (unsigned)(lane >> 2) * (INP * 2) + (unsigned)(lane & 3) * 16;
    const unsigned lk = (unsigned)(uintptr_t)wl, lv = lk + 8192;
#define SB_LOAD_K(j) do { const char* kb_ = Kh + (size_t)(j) * 64 * INP * 2; _Pragma("unroll") for (int c_ = 0; c_ < 8; ++c_) SB_DMA(kb_ + c_ * 16, kvoff, lk + c_ * 1024); } while (0)
#define SB_LOAD_V(j) do { const char* vb_ = Vh + (size_t)(j) * 64 * INP * 2; _Pragma("unroll") for (int c_ = 0; c_ < 8; ++c_) SB_DMA(vb_ + (size_t)(c_ & 3) * 16 * INP * 2 + (c_ >> 2) * 64, vvoff, lv + c_ * 1024); } while (0)
    SB_LOAD_K(jd); SB_LOAD_V(jd);
    const LAS unsigned char* kb = wl + hi * 1024 + r32 * 16;
    const LAS unsigned char* vb = wl + 8192 + ((lane >> 4) & 1) * 32 + (lane & 3) * 8 + (4 * hi + ((lane & 15) >> 2)) * 64;
    for (int j = jd; j >= 0; --j) {
        asm volatile("s_waitcnt vmcnt(8)" ::: "memory"); __builtin_amdgcn_sched_barrier(0);
        bf16x8 kf[8];
#pragma unroll
        for (int d0 = 0; d0 < 4; ++d0) { kf[2 * d0] = *(const LAS bf16x8*)(kb + d0 * 2048); kf[2 * d0 + 1] = *(const LAS bf16x8*)(kb + d0 * 2048 + 512); }
        asm volatile("s_waitcnt lgkmcnt(0)" ::: "memory"); __builtin_amdgcn_sched_barrier(0);
        if (j > 0) SB_LOAD_K(j - 1);
        unsigned pw[2][4][4];
#pragma unroll
        for (int s = 0; s < 2; ++s) {
            if (!alive[s]) {
#pragma unroll
                for (int x = 0; x < 4; ++x)
#pragma unroll
                    for (int y = 0; y < 4; ++y) pw[s][x][y] = 0u;
                continue; }
            f32x16 p0, p1;
#pragma unroll
            for (int r = 0; r < 16; ++r) { p0[r] = 0.f; p1[r] = 0.f; }
#pragma unroll
            for (int d0 = 0; d0 < 4; ++d0) { p0 = __builtin_amdgcn_mfma_f32_32x32x16_bf16(kf[2 * d0], qr[s][d0], p0, 0, 0, 0); p1 = __builtin_amdgcn_mfma_f32_32x32x16_bf16(kf[2 * d0 + 1], qr[s][d0], p1, 0, 0, 0); }
            const bool diag = (j == jd); const int kbase = 64 * j + 4 * hi; const int qabs = q0 + s * 32 + r32;
#pragma unroll
            for (int r = 0; r < 16; ++r) { const int k0 = kbase + (r & 3) + 8 * (r >> 2);
                float e0 = __builtin_amdgcn_exp2f(p0[r]), e1 = __builtin_amdgcn_exp2f(p1[r]);
                float r0 = __builtin_amdgcn_rcpf(1.0f + e0), r1 = __builtin_amdgcn_rcpf(1.0f + e1);
                if (diag) { if (k0 >= qabs) r0 = 1.0f; if (k0 + 32 >= qabs) r1 = 1.0f; }
                p0[r] = r0; p1[r] = r1; }
            float sfx[8][3], A[8];
#pragma unroll
            for (int i = 0; i < 8; ++i) { const float x0 = (i < 4) ? p0[4 * i] : p1[4 * i - 16], x1 = (i < 4) ? p0[4 * i + 1] : p1[4 * i - 15], x2 = (i < 4) ? p0[4 * i + 2] : p1[4 * i - 14], x3 = (i < 4) ? p0[4 * i + 3] : p1[4 * i - 13];
                sfx[i][2] = x3; sfx[i][1] = x3 * x2; sfx[i][0] = sfx[i][1] * x1; A[i] = sfx[i][0] * x0; }
            float T = carry[s], E[8];
#pragma unroll
            for (int i = 7; i >= 0; --i) { const auto sw = __builtin_amdgcn_permlane32_swap(__float_as_uint(A[i]), __float_as_uint(A[i]), false, false);
                const float partner = hi ? __uint_as_float(sw[0]) : __uint_as_float(sw[1]);
                E[i] = hi ? T : T * partner; T = T * (A[i] * partner); }
            carry[s] = T;
#pragma unroll
            for (int i = 0; i < 8; ++i) { float w4[4];
#pragma unroll
                for (int jj = 0; jj < 4; ++jj) { const float rv = (i < 4) ? p0[4 * i + jj] : p1[4 * i - 16 + jj]; const float beta = 1.0f - rv;
                    w4[jj] = beta * ((jj == 3) ? E[i] : E[i] * sfx[i][jj]); }
                pw[s][i >> 1][(i & 1) * 2] = pg8::cvt_pk_bf16(w4[0], w4[1]); pw[s][i >> 1][(i & 1) * 2 + 1] = pg8::cvt_pk_bf16(w4[2], w4[3]); }
        }
        if (j > 0) asm volatile("s_waitcnt vmcnt(8)" ::: "memory"); else asm volatile("s_waitcnt vmcnt(0)" ::: "memory");
        __builtin_amdgcn_sched_barrier(0);
        bf16x8 vf[8];
#pragma unroll
        for (int d0 = 0; d0 < 2; ++d0)
#pragma unroll
            for (int ks = 0; ks < 4; ++ks) {
                const s16x4 lo = __builtin_bit_cast(s16x4, __builtin_amdgcn_ds_read_tr16_b64_v4i16((LAS s16x4*)(vb + d0 * 4096 + ks * 1024)));
                const s16x4 hh = __builtin_bit_cast(s16x4, __builtin_amdgcn_ds_read_tr16_b64_v4i16((LAS s16x4*)(vb + d0 * 4096 + ks * 1024 + 512)));
                vf[d0 * 4 + ks] = (bf16x8){lo[0], lo[1], lo[2], lo[3], hh[0], hh[1], hh[2], hh[3]}; }
        asm volatile("s_waitcnt lgkmcnt(0)" ::: "memory"); __builtin_amdgcn_sched_barrier(0);
        const bool a0 = alive[0] && __any(carry[0] != 0.0f), a1 = alive[1] && __any(carry[1] != 0.0f);
        const bool more = (j > 0) && (a0 || a1);
        if (more) SB_LOAD_V(j - 1);
#pragma unroll
        for (int s = 0; s < 2; ++s) { if (!alive[s]) continue;
#pragma unroll
            for (int d0 = 0; d0 < 2; ++d0)
#pragma unroll
                for (int ks = 0; ks < 4; ++ks) { const bf16x8 pa = __builtin_bit_cast(bf16x8, (u32x4){pw[s][ks][0], pw[s][ks][1], pw[s][ks][2], pw[s][ks][3]});
                    o[s][d0] = __builtin_amdgcn_mfma_f32_32x32x16_bf16(pa, vf[d0 * 4 + ks], o[s][d0], 0, 0, 0); } }
        alive[0] = a0; alive[1] = a1;
        if (!more) break;
    }
    asm volatile("s_waitcnt vmcnt(0)" ::: "memory");
    LAS bf16_t* stg = (LAS bf16_t*)wl; const int l2 = pg8::fresh_lane();
#pragma unroll
    for (int s = 0; s < 2; ++s) {
#pragma unroll
        for (int r = 0; r < 16; ++r) { const int orow = crow(r, hi);
#pragma unroll
            for (int d0 = 0; d0 < 2; ++d0) stg[orow * 64 + d0 * 32 + r32] = (bf16_t)f2bf(o[s][d0][r]); }
        LDS_WAIT();
        bf16_t* Ow = MIXED + (rowbase + q0 + s * 32) * D + h * HD;
#pragma unroll
        for (int i = 0; i < 4; ++i) { const int row = i * 8 + (l2 >> 3), ch = l2 & 7; const u32x4 v = *(const LAS u32x4*)(stg + row * 64 + ch * 8);
            pg8::st16<2>(Ow + (size_t)row * D + ch * 8, v); float q = 0.f;
#pragma unroll
            for (int k = 0; k < 4; ++k) { const float a = __builtin_bit_cast(float, v[k] << 16), c = __builtin_bit_cast(float, v[k] & 0xffff0000u); q += a * a + c * c; }
            q += __shfl_xor(q, 1); q += __shfl_xor(q, 2); q += __shfl_xor(q, 4);
            if (ch == 0) ssq_add(SSQSB + rowbase + q0 + s * 32 + row, q); }
        LDS_WAIT();
    }
#undef SB_LOAD_K
#undef SB_LOAD_V
}

__device__ __forceinline__ f32x4 bf_lo(u32x4 v) { return (f32x4){__builtin_bit_cast(float, v.x << 16), __builtin_bit_cast(float, v.y << 16), __builtin_bit_cast(float, v.z << 16), __builtin_bit_cast(float, v.w << 16)}; }
__device__ __forceinline__ f32x4 bf_hi(u32x4 v) { return (f32x4){__builtin_bit_cast(float, v.x & 0xffff0000u), __builtin_bit_cast(float, v.y & 0xffff0000u), __builtin_bit_cast(float, v.z & 0xffff0000u), __builtin_bit_cast(float, v.w & 0xffff0000u)}; }
__device__ __forceinline__ void pool_item(int item, const bf16_t* QKVU, bf16_t* MIXED, int lane) {
    const int t0 = item * 8, tpos0 = t0 & (S - 1); const int g = lane >> 4, win = 2 << g;
    const bf16_t* zp = QKVU + (size_t)(t0 - 15) * INP + 3 * SBW + lane * 8;
    u32x4 v[23];
#pragma unroll
    for (int r = 0; r < 23; ++r) { v[r] = (u32x4){0u, 0u, 0u, 0u}; if (tpos0 - 15 + r >= 0) v[r] = *(const u32x4*)(zp + (size_t)r * INP); }
    f32x4 slo = (f32x4){0.f, 0.f, 0.f, 0.f}, shi = slo;
#pragma unroll
    for (int j = 0; j < 16; ++j) { const float mk = (j < win) ? 1.0f : 0.0f; slo += bf_lo(v[15 - j]) * mk; shi += bf_hi(v[15 - j]) * mk; }
    bf16_t* op = MIXED + (size_t)t0 * D + SBW + lane * 8;
#pragma unroll
    for (int i = 0; i < 8; ++i) {
        if (i > 0) { const u32x4 old = (g == 0) ? v[i + 13] : (g == 1) ? v[i + 11] : (g == 2) ? v[i + 7] : v[i - 1];
            slo += bf_lo(v[15 + i]) - bf_lo(old); shi += bf_hi(v[15 + i]) - bf_hi(old); }
        const int tp1 = tpos0 + i + 1; const float inv = 1.0f / (float)(tp1 < win ? tp1 : win);
        const f32x4 olo = slo * inv - bf_lo(v[15 + i]), ohi = shi * inv - bf_hi(v[15 + i]);
        float q = (olo[0] * olo[0] + olo[1] * olo[1]) + (olo[2] * olo[2] + olo[3] * olo[3]) + (ohi[0] * ohi[0] + ohi[1] * ohi[1]) + (ohi[2] * ohi[2] + ohi[3] * ohi[3]);
        const float rs = 1.0f / sqrtf(wave_sum(q) * (1.0f / PW) + EPS);
        u32x4 w;
#pragma unroll
        for (int k = 0; k < 4; ++k) w[k] = pg8::cvt_pk_bf16(olo[k] * rs, ohi[k] * rs);
        pg8::st16<3>(op + (size_t)i * D, w);
    }
}
__device__ __forceinline__ void p2_mix(const Args& a, LAS unsigned char* lds, int bx, int G, int wid, int lane, ssq_t* SSQSB, int which = 3, int pstop = 9, bf16_t* pool_dst = nullptr, volatile LAS unsigned* stp = nullptr) {
    unsigned char* ws = a.ws; const bf16_t* QKVU = (const bf16_t*)(ws + WS_QKVU); bf16_t* MIXED = (bf16_t*)(ws + WS_MIXED);
    constexpr int NA = B * NH * (S / 512);
    if (which & 1) for (int i = 0; i * G + bx < NA; ++i) { const int w = pg8::xcd_remap(i * G + bx, NA); const int bh = w >> 3, qb = w & 7;
        sb_item(bh >> 3, bh & 7, qb * 8 + wid, QKVU, MIXED, SSQSB, lds + RING_OFF + wid * 16384, lane); }
    if (which & 2) for (int it = bx * NWAVES + wid; it < NTOK / 8; it += G * NWAVES) pool_item(it, QKVU, pool_dst ? pool_dst : MIXED, lane);
}
constexpr size_t BAR_REGION_OFF = 1 * MiB, BAR_REGION_STRIDE = 16 * 1024;
__global__ void __launch_bounds__(NWAVES * 64, 2) mega(Args args) {
    const int li = args.li;
    extern __shared__ __attribute__((aligned(16))) unsigned char lds_raw[];
    LAS unsigned char* lds = (LAS unsigned char*)lds_raw;
    volatile LAS unsigned* MISC = (volatile LAS unsigned*)(lds + MISC_OFF);
    const int wave = __builtin_amdgcn_readfirstlane((int)threadIdx.x >> 6);
#define LANE_ID() ({ int l_; asm volatile("v_mbcnt_lo_u32_b32 %0, -1, 0\n\tv_mbcnt_hi_u32_b32 %0, -1, %0" : "=v"(l_)); l_; })
    const int G = gridDim.x; const int bx = blockIdx.x; const int vcu = (G % 8 == 0) ? (bx % 8) * (G / 8) + bx / 8 : bx;
    for (int u = wave * 64 + LANE_ID(); u < MISC_BYTES / 4; u += NWAVES * 64) MISC[u] = 0u;
    __syncthreads();
    unsigned char* ws = args.ws;
    XcdBarrier bar = xcd_barrier_post((unsigned*)(ws + BAR_REGION_OFF + (size_t)li * BAR_REGION_STRIDE), MISC + 8);
    const int lo = args.ph_lo, hi = args.ph_hi;
    LAS unsigned char* ring = lds + RING_OFF; LAS unsigned char* epi = lds + EPI_OFF; LAS unsigned* gtab = (LAS unsigned*)(lds + GTAB_OFF);
#ifndef TIME_PHASE
#define TIME_PHASE -1
#endif
#define REP_OF(k) ((TIME_PHASE == (k)) ? 2 : 1)
#define REPE_OF(k) ((TIME_PHASE == 20 + (k)) ? 2 : 1)
#define IN(k) (lo <= (k) && (k) < hi)
#ifndef TSK
#define TSK -1
#endif
#ifndef TSCALE
#define TSCALE 1.0f
#endif
#define STAMP(i) do { if (TSK >= 0 && wave == 0) { const unsigned long long t_ = __builtin_amdgcn_s_memrealtime(); MISC[128 + 2 * (i)] = (unsigned)t_; MISC[129 + 2 * (i)] = (unsigned)(t_ >> 32); } } while (0)
#define SEAM(k) do { if (IN(k) && IN((k) + 1)) xcd_barrier(bar); STAMP((k) + 1); } while (0)

    STAMP(0);
    if (IN(0)) { p0_prologue(args, lds, vcu, G, wave, LANE_ID()); if (TIME_PHASE == 0) { xcd_barrier(bar); p0_prologue(args, lds, vcu, G, wave, LANE_ID()); } SEAM(0); }
    if (IN(1)) { SchedP1 S{G, bx, ws}; pg8::EpiBf16S E; pg8::gemm_phase<pg8::EpiBf16S, SchedP1, 0, REP_OF(1), REPE_OF(1)>(wave, ring, epi, gtab, D * 2, D * 2, D / 64, S, E);
        if (G == 256 && bx >= 64) p1_deferred_items(args, lds, bx - 64, wave, LANE_ID());
        else if (G != 256 && bx == 0) { for (int rk = 0; rk < 192; ++rk) p1_deferred_items(args, lds, rk, wave, LANE_ID()); }
        SEAM(1); }
    {
    const float* xin0 = args.in[0]; float* outp = args.out;
    bf16_t* S0p = (bf16_t*)(ws + WS_S0); ssq_t* SSQSBp = (ssq_t*)(ws + MK_SSQSB); ssq_t* SSQ1p = (ssq_t*)(ws + MK_SSQ1); ssq_t* SSQ2p = (ssq_t*)(ws + MK_SSQ2);
    constexpr size_t TSTEP = (size_t)256 * D * 2;
    #if !defined(PH_ONLY) || PH_ONLY == 2
    if (IN(2)) { if (TIME_PHASE == 42) { p2_mix(args, lds, bx, G, wave, LANE_ID(), (ssq_t*)(ws + 1280 * 1024), 2); xcd_barrier(bar); p2_mix(args, lds, bx, G, wave, LANE_ID(), (ssq_t*)(ws + 1280 * 1024), 2); xcd_barrier(bar); }
    if (TIME_PHASE == 2 || TIME_PHASE == 40 || TIME_PHASE == 41) { p2_mix(args, lds, bx, G, wave, LANE_ID(), (ssq_t*)(ws + 1280 * 1024), TIME_PHASE == 40 ? 1 : (TIME_PHASE == 41 ? 2 : 3)); xcd_barrier(bar); } STAMP(20); p2_mix(args, lds, bx, G, wave, LANE_ID(), (ssq_t*)(ws + MK_SSQSB), 1); STAMP(21); p2_mix(args, lds, bx, G, wave, LANE_ID(), (ssq_t*)(ws + MK_SSQSB), 2, 9, nullptr, (TSK >= 30 && bx == 0) ? MISC + 128 + 60 : nullptr); STAMP(22); SEAM(2); STAMP(23); }
#endif

#if !defined(PH_ONLY) || PH_ONLY == 3
    if (IN(3)) { SchedReg S{G, bx, NTOK / 256, D / 256, (const char*)(ws + WS_MIXED), (const char*)(ws + WS_WOUT), TSTEP, TSTEP, nullptr, D, nullptr, nullptr};
        EpiResid<8, true, true> E{nullptr, S0p, ws + WS_X1F8, SSQ1p, SSQSBp, 1.0f}; pg8::gemm_phase<EpiResid<8, true, true>, SchedReg, 0, REP_OF(3)>    (wave, ring, epi, gtab, D * 2, D * 2, D / 64, S, E); SEAM(3); }
#endif
#if !defined(PH_ONLY) || PH_ONLY == 4
    if (IN(4)) { SchedReg S{G, bx, NTOK / 256, D / 256, (const char*)(ws + WS_X1F8), (const char*)(ws + WS_WQ), TSTEP / 2, TSTEP / 2, (bf16_t*)(ws + WS_QM), D, nullptr, nullptr, SSQ1p};
        EpiBf16Ssq E{1.0f / D, C2_MEM / WSCALE}; pg8::gemm_phase<EpiBf16Ssq, SchedReg, 0, REP_OF(4), 1, true>(wave, ring, epi, gtab, D, D, D / 128, S, E); SEAM(4); }
#endif
#if !defined(PH_ONLY) || PH_ONLY == 5
    if (IN(5)) { SchedMS S{G, bx, ws}; EpiSoftmax E; pg8::gemm_phase<EpiSoftmax, SchedMS, 0, REP_OF(5)>(wave, ring, epi, gtab, D * 2, D * 2, MHD / 64, S, E); SEAM(5); }
#endif
#if !defined(PH_ONLY) || PH_ONLY == 6
    if (IN(6)) { SchedPV S{G, bx, ws}; pg8::EpiBf16S E; pg8::gemm_phase<pg8::EpiBf16S, SchedPV, 0, REP_OF(6)>(wave, ring, epi, gtab, D * 2, NMEM * 2, NMEM / 64, S, E); SEAM(6); }
#endif
#if !defined(PH_ONLY) || PH_ONLY == 7
    if (IN(7)) { SchedReg S{G, bx, NTOK / 256, D / 256, (const char*)(ws + WS_OM), (const char*)(ws + WS_WO), TSTEP, TSTEP, nullptr, D, nullptr, nullptr};
        EpiResid<-1, true, true> E{nullptr, S0p, ws + WS_X2F8, SSQ2p, nullptr, 1.0f}; pg8::gemm_phase<EpiResid<-1, true, true>, SchedReg, 0, REP_OF(7)>(wave, ring, epi, gtab, D * 2, D * 2, D / 64, S, E); SEAM(7); }
#endif
#if !defined(PH_ONLY) || PH_ONLY == 8
    if (IN(8)) { if (TIME_PHASE == 8) { p8_route(args, lds, bx, G, wave, LANE_ID(), (int*)(ws + 1536 * 1024)); xcd_barrier(bar); } p8_route(args, lds, bx, G, wave, LANE_ID(), (int*)(ws + OFF_CNT)); SEAM(8); }
#endif
#if !defined(PH_ONLY) || PH_ONLY == 9
    if (IN(9)) { moe_table(args, MISC, wave * 64 + LANE_ID()); SchedMoE<8, true> S{G, bx, ws, MISC, args.in[18]}; EpiSwiGLU E{ws + WS_ACT};
        pg8::gemm_phase<EpiSwiGLU, SchedMoE<8, true>, 1, REP_OF(9), REPE_OF(9), true>(wave, ring, epi, gtab, D, D, D / 128, S, E); SEAM(9); }
#endif
#if !defined(PH_ONLY) || PH_ONLY == 10
    if (IN(10)) { moe_table(args, MISC, wave * 64 + LANE_ID()); SchedMoE<4, false> S{G, bx, ws, MISC, args.in[20]}; EpiW2 E{ws + WS_Y};
        pg8::gemm_phase<EpiW2, SchedMoE<4, false>, 2, REP_OF(10), REPE_OF(10), true>(wave, ring, epi, gtab, DFF, DFF, DFF / 128, S, E); SEAM(10); }
#endif
#if !defined(PH_ONLY) || PH_ONLY == 11
    if (IN(11)) { if (TIME_PHASE == 11) { p11_final(args, vcu, G, wave, LANE_ID(), (float*)(ws + WS_ACT)); xcd_barrier(bar); } p11_final(args, vcu, G, wave, LANE_ID(), args.out); }
#endif
}

    if (TSK >= 100) { __syncthreads(); float* dbg = (float*)(ws + 1792 * 1024);
        if (wave == 0 && LANE_ID() == 0) { const int a_ = (TSK >= 200) ? 21 : 20; const unsigned long long t0 = ((unsigned long long)MISC[129 + 2 * a_] << 32) | MISC[128 + 2 * a_], t1 = ((unsigned long long)MISC[131 + 2 * a_] << 32) | MISC[130 + 2 * a_];
            __hip_atomic_store(dbg + bx, (float)(t1 - t0) * 0.01f, __ATOMIC_RELAXED, __HIP_MEMORY_SCOPE_AGENT); }
        xcd_barrier(bar);
        if (bx == 0 && wave == 0) { const int l_ = LANE_ID(); float mx = 0.f, mn = 1e9f; for (int q = l_; q < G; q += 64) { const float v = __hip_atomic_load(dbg + q, __ATOMIC_RELAXED, __HIP_MEMORY_SCOPE_AGENT); mx = fmaxf(mx, v); mn = fminf(mn, v); }
            for (int o_ = 1; o_ < 64; o_ <<= 1) { mx = fmaxf(mx, __shfl_xor(mx, o_)); mn = fminf(mn, __shfl_xor(mn, o_)); }
            if (l_ == 0) { asm volatile("s_waitcnt vmcnt(0)" ::: "memory"); args.out[0] = ((TSK % 100) == 0 ? mx : mn) * TSCALE; } } }
    else if (TSK >= 0) { STAMP(12); __syncthreads(); if (bx == 0 && wave == 0 && LANE_ID() == 0) { asm volatile("s_waitcnt vmcnt(0)" ::: "memory");
        const unsigned long long t0 = ((unsigned long long)MISC[129 + 2 * TSK] << 32) | MISC[128 + 2 * TSK], t1 = ((unsigned long long)MISC[131 + 2 * TSK] << 32) | MISC[130 + 2 * TSK];
        args.out[0] = (float)(t1 - t0) * 0.01f * TSCALE; } }
    if (TIME_PHASE == 12) { for (int q = 0; q < 10; ++q) xcd_barrier(bar); }
#undef IN
#undef SEAM
}
}

extern "C" void kernel_launch(void* const* d_in, const int* in_sizes, int n_in, void* d_out, int out_size, void* d_ws, size_t ws_size, hipStream_t stream) {
    if (n_in != 22 || out_size != NTOK * D || ws_size < WS_END) { fprintf(stderr, "kernel_launch: unexpected shapes (n_in %d out %d ws %zu)\n", n_in, out_size, ws_size); return; }
    static int grid = 0;
    if (grid == 0) {
        int dev = 0, cus = 0;
        if (hipGetDevice(&dev) != hipSuccess || hipDeviceGetAttribute(&cus, hipDeviceAttributeMultiprocessorCount, dev) != hipSuccess) { grid = -1; return; }
        if (hipFuncSetAttribute((const void*)mk::mega, hipFuncAttributeMaxDynamicSharedMemorySize, mk::LDS_BYTES) != hipSuccess) { fprintf(stderr, "kernel_launch: hipFuncSetAttribute failed\n"); grid = -1; return; }
        int per_cu = 0; (void)hipOccupancyMaxActiveBlocksPerMultiprocessor(&per_cu, (const void*)mk::mega, mk::NWAVES * 64, mk::LDS_BYTES); (void)hipGetLastError();
        if (per_cu < 1) fprintf(stderr, "kernel_launch: occupancy query reports %d blocks per CU\n", per_cu);
        grid = cus;
    }
    if (grid < 0) return;
    (void)hipMemsetAsync((unsigned char*)d_ws + WS_CTL, 0, CTL_BYTES, stream);
    mk::Args a{}; for (int i = 0; i < 22; ++i) a.in[i] = (const float*)d_in[i]; a.out = (float*)d_out; a.ws = (unsigned char*)d_ws;
    a.ph_lo = 0; a.ph_hi = mk::NPHASE; a.li = 0;
    hipLaunchKernelGGL(mk::mega, dim3(grid), dim3(mk::NWAVES * 64), mk::LDS_BYTES, stream, a);
}
```

```cpp
#include <hip/hip_runtime.h>
#include <cstdio>
#include <cstdint>

typedef unsigned short bf16_t;
typedef short bf16x8 __attribute__((ext_vector_type(8)));
typedef float f32x4 __attribute__((ext_vector_type(4)));
typedef unsigned u32x4 __attribute__((ext_vector_type(4)));

namespace cfg {
constexpr int B = 8, S = 4096, D = 1024, NTOK = B * S;
constexpr int SBW = 512, NH = 8, HD = 64, PW = 512, PG = 4, PGD = 128, INP = 2048;
constexpr int NMEM = 256, MH = 4, MHD = 256, NMROWS = B * NMEM;
constexpr int NE = 32, TOPK = 4, DFF = 1024, LCAP = NTOK;
constexpr float EPS = 1e-5f, LOG2E = 1.4426950408889634f;
constexpr float C2_SB = 0.125f * LOG2E, C2_MEM = 0.0625f * LOG2E;
constexpr float SW_LIMIT = 7.0f, SW_ALPHA = 1.702f;
constexpr int MAXTILES = 544;
constexpr size_t MiB = 1u << 20;
constexpr size_t WS_CTL = 0, CTL_BYTES = 2 * MiB;
constexpr size_t OFF_CNT = 64 * 1024, OFF_SSQSB = 512 * 1024, OFF_SSQ1 = 640 * 1024, OFF_SSQ2 = 768 * 1024;
constexpr size_t WS_WIN = 2 * MiB, WS_WOUT = 6 * MiB, WS_WQ = 8 * MiB, WS_WKV = 10 * MiB, WS_WO = 14 * MiB, WS_WP = 16 * MiB, WS_WR = 17 * MiB;
constexpr size_t WS_RSTDX = 18 * MiB, WS_RSTDM = 18 * MiB + 512 * 1024;
constexpr size_t WS_W1 = 20 * MiB, WS_W2 = 148 * MiB;
constexpr size_t WS_S0 = 212 * MiB;
constexpr size_t WS_QKVU = 276 * MiB;
constexpr size_t WS_QM = 276 * MiB, WS_OM = 340 * MiB;
constexpr size_t WS_MIXED = 404 * MiB;
constexpr size_t WS_PM = 404 * MiB;
constexpr size_t WS_ACT = 276 * MiB;
constexpr size_t WS_KM = 548 * MiB, WS_VMT = 552 * MiB, WS_MEMB = 556 * MiB, WS_LSLOT = 560 * MiB, WS_LGATE = 564 * MiB;
constexpr size_t WS_Y = 568 * MiB;
constexpr size_t WS_SCR_S = 568 * MiB, WS_SCR_POOLED = 696 * MiB, WS_SCR_POOLO = 728 * MiB;
constexpr size_t WS_END = 824 * MiB;
}
using namespace cfg;

__device__ __forceinline__ unsigned f2bf(float f) { unsigned u = __builtin_bit_cast(unsigned, f); return (u + 0x7fffu + ((u >> 16) & 1u)) >> 16; }
__device__ __forceinline__ float bf2f(bf16_t h) { return __builtin_bit_cast(float, (unsigned)h << 16); }
__device__ __forceinline__ float wave_sum(float v) {
#pragma unroll
    for (int o = 1; o < 64; o <<= 1) v += __shfl_xor(v, o);
    return v;
}


#define LAS __attribute__((address_space(3)))
#define GAS __attribute__((address_space(1)))
typedef int v4i_t __attribute__((ext_vector_type(4)));
typedef int v8i_t __attribute__((ext_vector_type(8)));
namespace pg8 {
constexpr int BM = 256, BK = 64, HALF = 128, HTB = HALF * BK * 2, STAGE_BYTES = 8 * HTB, NXCD = 8, WGM = 8;
__host__ __device__ __forceinline__ int lds_byte(int r, int c) { const int st = (r >> 4) * 2 + (c >> 5), rr = r & 15, cc = c & 31, ob = rr * 64 + cc * 2; return st * 1024 + (ob ^ (((ob >> 9) & 1) << 5)); }
__host__ __device__ __forceinline__ void stage_rc(int b, int& R, int& C) { const int st = b / 1024, sb = b % 1024, swz = sb ^ (((sb >> 9) & 1) << 5); R = (st >> 1) * 16 + swz / 64; C = (st & 1) * 32 + (swz % 64) / 2; }
__host__ __device__ __forceinline__ int perm32(int rho) { const int n = rho >> 4, i = rho & 15; return 8 * (i >> 2) + 4 * n + (i & 3); }
__device__ __forceinline__ unsigned cvt_pk_bf16(float lo, float hi) { unsigned r; asm volatile("v_cvt_pk_bf16_f32 %0, %1, %2" : "=v"(r) : "v"(lo), "v"(hi)); return r; }

#define WTMASK 0x008
#ifndef WTMASK
#define WTMASK 0x1ff
#endif
#define WT_ON(bit) (((WTMASK) >> (bit)) & 1)
__device__ __forceinline__ void st16_wt(void* p, u32x4 v) { asm volatile("global_store_dwordx4 %0, %1, off sc1\n\ts_nop 1" :: "v"(p), "v"(v)); }
__device__ __forceinline__ void st16_wt(void* p, f32x4 v) { asm volatile("global_store_dwordx4 %0, %1, off sc1\n\ts_nop 1" :: "v"(p), "v"(v)); }
template <int BIT, class V> __device__ __forceinline__ void st16(void* p, V v) { if constexpr (WT_ON(BIT)) st16_wt(p, v); else *(V*)p = v; }
#ifndef WT8
#define WT8 0
#endif
__device__ __forceinline__ void st8_wt(void* p, unsigned long long v) { if (WT8) __hip_atomic_store((unsigned long long*)p, v, __ATOMIC_RELAXED, __HIP_MEMORY_SCOPE_AGENT); else *(unsigned long long*)p = v; }
__device__ __forceinline__ void st4_wt(void* p, unsigned v) { if (WT8) __hip_atomic_store((unsigned*)p, v, __ATOMIC_RELAXED, __HIP_MEMORY_SCOPE_AGENT); else *(unsigned*)p = v; }
__device__ __forceinline__ int fresh_lane() { int l; asm volatile("v_mbcnt_lo_u32_b32 %0, -1, 0\n\tv_mbcnt_hi_u32_b32 %0, -1, %0" : "=v"(l)); return l; }
struct Unit { const char* A; const char* B; void* p0; void* p1; void* p2; void* p3; int pm, pn, i0, i1, ghost; };

__device__ __forceinline__ int xcd_remap(int L, int nwg) { const int q = nwg / NXCD, r = nwg % NXCD, xcd = L % NXCD, off = L / NXCD; return __builtin_amdgcn_readfirstlane((xcd < r ? xcd * (q + 1) : r * (q + 1) + (xcd - r) * q) + off); }
__device__ __forceinline__ void grouped_mn(int wgid, int nM, int nN, int& pm, int& pn) {
    const int nig = WGM * nN, gid = wgid / nig, fm = gid * WGM, gsz = (nM - fm) < WGM ? (nM - fm) : WGM; pm = __builtin_amdgcn_readfirstlane(fm + ((wgid % nig) % gsz)); pn = __builtin_amdgcn_readfirstlane((wgid % nig) / gsz); }

template <class Epi, class Sched, int TABS, int REP = 1, int REPE = 1, bool F8 = false>
__device__ __forceinline__ void gemm_phase(const int wid, LAS unsigned char* lds, LAS unsigned char* epi_lds, LAS unsigned* gtab, const int lda_b, const int ldb_b, const int nt, const Sched& S, const Epi& E) {
    constexpr bool GATHER = (TABS == 1);
    const int wr = wid >> 2, wc = wid & 3;
    unsigned voffA, voffB, voffG[2][2]; int aoff, boff;
    { const int lane = fresh_lane(); int R, C; stage_rc(wid * 1024 + lane * 16, R, C); const int Rb = Epi::PERM ? ((R & ~31) + perm32(R & 31)) : R;
      voffA = (unsigned)(R * lda_b + C * 2); voffB = (unsigned)(Rb * ldb_b + C * 2); voffG[0][0] = voffG[0][1] = voffG[1][0] = voffG[1][1] = 0;
      aoff = lds_byte(wr * 64 + (lane & 15), (lane >> 4) * 8); boff = lds_byte(wc * 32 + (lane & 15), (lane >> 4) * 8); }
    const size_t kstep = (size_t)(BK * 2);
    const size_t hstepA = (size_t)HALF * lda_b, hstepB = (size_t)HALF * ldb_b;
    const unsigned ldsw = (unsigned)wid * 1024u; const unsigned ldsbase = (unsigned)(uintptr_t)lds + ldsw;
#define PG8_SA(b, h) (((b) * 2 + (h)) * HTB)
#define PG8_SB(b, h) ((4 + (b) * 2 + (h)) * HTB)
#define PG8_GLDS(ugp, voff, bufoff, _i) do { unsigned _keep; asm volatile("s_mov_b32 %0, m0\n\ts_mov_b32 m0, %3\n\ts_nop 0\n\tglobal_load_lds_dwordx4 %1, %2\n\ts_mov_b32 m0, %0" \
        : "=&s"(_keep) : "v"(voff), "s"((const char*)(ugp)), "s"(ldsbase + (unsigned)((bufoff) + (_i) * 8192)) : "memory"); } while (0)
#define PG8_STAGE_B(bufoff, gbase) do { _Pragma("unroll") for (int _i = 0; _i < 2; ++_i) PG8_GLDS((const char*)(gbase) + (size_t)_i * 64 * ldb_b, voffB, bufoff, _i); } while (0)
#define PG8_STAGE_A(bufoff, gbase, h) do { if constexpr (GATHER) { _Pragma("unroll") for (int _i = 0; _i < 2; ++_i) PG8_GLDS((const char*)(gbase), voffG[h][_i], bufoff, _i); } \
        else { _Pragma("unroll") for (int _i = 0; _i < 2; ++_i) PG8_GLDS((const char*)(gbase) + (h) * hstepA + (size_t)_i * 64 * lda_b, voffA, bufoff, _i); } } while (0)
#define PG8_LDA(dst, b, h) do { _Pragma("unroll") for (int m = 0; m < 4; ++m) _Pragma("unroll") for (int k = 0; k < 2; ++k) dst[m][k] = *(const LAS bf16x8*)(lds + PG8_SA(b, h) + aoff + m * 2048 + k * 1024); } while (0)
#define PG8_LDB(dst, b, h) do { _Pragma("unroll") for (int n = 0; n < 2; ++n) _Pragma("unroll") for (int k = 0; k < 2; ++k) dst[n][k] = *(const LAS bf16x8*)(lds + PG8_SB(b, h) + boff + n * 2048 + k * 1024); } while (0)
#define PG8_CAT(x0, x1) __builtin_shufflevector(__builtin_bit_cast(v4i_t, x0), __builtin_bit_cast(v4i_t, x1), 0, 1, 2, 3, 4, 5, 6, 7)
#define PG8_MMA(ai, bj, At, Bt) do { __builtin_amdgcn_s_setprio(1); _Pragma("unroll") for (int m = 0; m < 4; ++m) _Pragma("unroll") for (int n = 0; n < 2; ++n) { \
        if constexpr (F8) acc[ai][bj][m][n] = __builtin_amdgcn_mfma_scale_f32_16x16x128_f8f6f4(PG8_CAT(Bt[n][0], Bt[n][1]), PG8_CAT(At[m][0], At[m][1]), acc[ai][bj][m][n], 0, 0, 0, 0, 0, 0); \
        else { _Pragma("unroll") for (int k = 0; k < 2; ++k) acc[ai][bj][m][n] = __builtin_amdgcn_mfma_f32_16x16x32_bf16(Bt[n][k], At[m][k], acc[ai][bj][m][n], 0, 0, 0); } } __builtin_amdgcn_s_setprio(0); } while (0)
#define PG8_WAIT_V(n) asm volatile("s_waitcnt vmcnt(" #n ")" ::: "memory")
#define PG8_WAIT_L(n) asm volatile("s_waitcnt lgkmcnt(" #n ")" ::: "memory")
#define PG8_BAR __builtin_amdgcn_s_barrier()
#define PG8_SCHED __builtin_amdgcn_sched_barrier(0)
#define PG8_GTAB_LOAD(buf, nvalid) do { const int _l = fresh_lane(); int _R, _C; stage_rc(wid * 1024 + _l * 16, _R, _C); _Pragma("unroll") for (int _h = 0; _h < 2; ++_h) _Pragma("unroll") for (int _i = 0; _i < 2; ++_i) { \
        const int _row = _h * HALF + _R + 64 * _i; const unsigned _s = gtab[(buf) * 768 + _row]; voffG[_h][_i] = ((_row < (nvalid)) ? (_s >> 2) * (unsigned)lda_b : 0u) + (unsigned)(_C * 2); } } while (0)
#define PG8_GTAB_DMA(buf, U) do { if (wid < 3) { const int _l = fresh_lane(); const char* _src = (wid == 0) ? (const char*)(U).p3 + _l * 16 : (wid == 1) ? (const char*)(U).p2 + _l * 16 : \
            (TABS == 1 ? (const char*)(U).p1 + (_l & 31) * 16 + (_l >> 5) * (DFF * 4) : (const char*)(U).p1 + _l * 16); \
        __builtin_amdgcn_global_load_lds((const unsigned*)_src, (LAS unsigned*)(gtab + (buf) * 768 + wid * 256), 16, 0, 0); } } while (0)
    auto nextu = [&](int i, Unit& u) -> bool { if constexpr (REP > 1) { const bool ok = S.next(i / REP, u); u.ghost = (i % REP) != REP - 1; return ok; } else { u.ghost = 0; return S.next(i, u); } };
    Unit cur, nxt; int ui = 0;
    if (!nextu(0, cur)) return;
    f32x4 acc[2][2][4][2];
#pragma unroll
    for (int a = 0; a < 2; ++a)
#pragma unroll
        for (int b = 0; b < 2; ++b)
#pragma unroll
            for (int m = 0; m < 4; ++m)
#pragma unroll
                for (int n = 0; n < 2; ++n) acc[a][b][m][n] = (f32x4){0.f, 0.f, 0.f, 0.f};
    bf16x8 At[4][2], B0[2][2], B1[2][2];
    const char* cA = cur.A; const char* cB = cur.B;
    if constexpr (TABS != 0) { PG8_GTAB_DMA(0, cur); PG8_WAIT_V(0); PG8_WAIT_L(0); PG8_BAR; if constexpr (GATHER) PG8_GTAB_LOAD(0, cur.i0); }
    PG8_STAGE_B(PG8_SB(0, 0), cB); PG8_STAGE_B(PG8_SB(0, 1), cB + hstepB); PG8_STAGE_A(PG8_SA(0, 0), cA, 0); PG8_STAGE_A(PG8_SA(0, 1), cA, 1);
    if (wr == 1) PG8_BAR;
    PG8_WAIT_V(2); PG8_BAR;
    PG8_STAGE_B(PG8_SB(1, 0), cB + kstep); PG8_STAGE_A(PG8_SA(1, 0), cA + kstep, 0); PG8_STAGE_B(PG8_SB(1, 1), cB + hstepB + kstep);
    PG8_WAIT_V(6); PG8_BAR;
    for (;;) {
        const bool has_next = nextu(ui + 1, nxt);
        const char* nA = has_next ? nxt.A : cA; const char* nB = has_next ? nxt.B : cB;
#pragma unroll 1
        for (int t = 0; t < nt; t += 2) {
            const bool last = (t == nt - 2);
            const char* a1 = cA + (size_t)(t + 1) * kstep;
            const char* a2 = last ? nA : cA + (size_t)(t + 2) * kstep; const char* b2 = last ? nB : cB + (size_t)(t + 2) * kstep;
            const char* a3 = a2 + kstep; const char* b3 = b2 + kstep;
            if constexpr (Epi::MIDK >= 0) { if (t == Epi::MIDK) E.midk(acc, cur, wr, fresh_lane() & 15); }
            if constexpr (TABS != 0) { if (t == 2 && has_next) PG8_GTAB_DMA((ui + 1) & 1, nxt); }
            if constexpr (GATHER) { PG8_STAGE_A(PG8_SA(1, 1), a1, 1); if (last && has_next) PG8_GTAB_LOAD((ui + 1) & 1, nxt.i0); PG8_SCHED; }
            PG8_LDB(B0, 0, 0); PG8_LDB(B1, 0, 1); PG8_SCHED; PG8_LDA(At, 0, 0); if constexpr (!GATHER) PG8_STAGE_A(PG8_SA(1, 1), a1, 1);
            PG8_WAIT_V(8); PG8_WAIT_L(0); PG8_BAR; PG8_MMA(0, 0, At, B0); PG8_MMA(0, 1, At, B1); PG8_BAR; PG8_SCHED;
            PG8_LDA(At, 0, 1); PG8_STAGE_B(PG8_SB(0, 0), b2); PG8_STAGE_B(PG8_SB(0, 1), b2 + hstepB); PG8_STAGE_A(PG8_SA(0, 0), a2, 0);
            PG8_WAIT_V(8); PG8_WAIT_L(0); PG8_BAR; PG8_MMA(1, 0, At, B0); PG8_MMA(1, 1, At, B1); PG8_BAR; PG8_SCHED;
            PG8_LDB(B0, 1, 0); PG8_LDB(B1, 1, 1); PG8_SCHED; PG8_LDA(At, 1, 0); PG8_STAGE_A(PG8_SA(0, 1), a2, 1);
            PG8_WAIT_V(8); PG8_WAIT_L(0); PG8_BAR; PG8_MMA(0, 0, At, B0); PG8_MMA(0, 1, At, B1); PG8_BAR; PG8_SCHED;
            PG8_LDA(At, 1, 1); PG8_STAGE_B(PG8_SB(1, 0), b3); PG8_STAGE_B(PG8_SB(1, 1), b3 + hstepB); PG8_STAGE_A(PG8_SA(1, 0), a3, 0);
            PG8_WAIT_V(8); PG8_WAIT_L(0); PG8_BAR; PG8_MMA(1, 0, At, B0); PG8_MMA(1, 1, At, B1); PG8_BAR; PG8_SCHED;
        }
        if (wr == 0) PG8_BAR;
        if (!cur.ghost) { const int el = fresh_lane(); LAS unsigned char* ex = (TABS != 0) ? (LAS unsigned char*)(gtab + (ui & 1) * 768) : epi_lds; E(acc, cur, wr, wc, el & 15, el >> 4, wid, el, ex); if constexpr (REPE > 1) { asm volatile("" ::: "memory"); E(acc, cur, wr, wc, el & 15, el >> 4, wid, el, ex); } }
        if (!has_next) break;
#pragma unroll
        for (int a = 0; a < 2; ++a)
#pragma unroll
            for (int b = 0; b < 2; ++b)
#pragma unroll
                for (int m = 0; m < 4; ++m)
#pragma unroll
                    for (int n = 0; n < 2; ++n) acc[a][b][m][n] = (f32x4){0.f, 0.f, 0.f, 0.f};
        cur = nxt; cA = nA; cB = nB; ++ui;
        if (wr == 1) PG8_BAR;
    }
    PG8_WAIT_V(0);
    PG8_BAR;
#undef PG8_SA
#undef PG8_SB
#undef PG8_GLDS
#undef PG8_STAGE_A
#undef PG8_STAGE_B
#undef PG8_LDA
#undef PG8_LDB
#undef PG8_MMA
#undef PG8_CAT
#undef PG8_WAIT_V
#undef PG8_WAIT_L
#undef PG8_BAR
#undef PG8_SCHED
#undef PG8_GTAB_LOAD
#undef PG8_GTAB_DMA
}

template <bool F8O> struct EpiBf16SX {
    static constexpr bool PERM = true; static constexpr int MIDK = -1;
    __device__ __forceinline__ void midk(f32x4 (&)[2][2][4][2], const Unit&, int, int) const {}
    __device__ __forceinline__ void operator()(const f32x4 (&acc)[2][2][4][2], const Unit& u, int wr, int wc, int fr, int fq, int, int, LAS unsigned char*) const {
        bf16_t* O = (bf16_t*)u.p0; unsigned char* O8 = (unsigned char*)u.p0; const float* rs = (const float*)u.p1; const float* cs = (const float*)u.p2; const int ldc = u.i0;
        int r0 = wr * 64 + fr, c0 = wc * 32 + 8 * fq; asm volatile("" : "+v"(r0), "+v"(c0));
        f32x4 cv[2][2];
#pragma unroll
        for (int bj = 0; bj < 2; ++bj)
#pragma unroll
            for (int n = 0; n < 2; ++n) cv[bj][n] = cs ? *(const f32x4*)(cs + c0 + bj * HALF + 4 * n) : (f32x4){1.f, 1.f, 1.f, 1.f};
#pragma unroll
        for (int ai = 0; ai < 2; ++ai)
#pragma unroll
            for (int m = 0; m < 4; ++m) { const int r = r0 + ai * HALF + m * 16; const float rv = rs ? rs[r] : 1.f; bf16_t* rowp = O + (size_t)r * ldc + c0;
#pragma unroll
                for (int bj = 0; bj < 2; ++bj) { const f32x4 v0 = acc[ai][bj][m][0] * cv[bj][0] * rv, v1 = acc[ai][bj][m][1] * cv[bj][1] * rv;
                    if constexpr (F8O) { int w0 = __builtin_amdgcn_cvt_pk_fp8_f32(v0[0], v0[1], 0, false); w0 = __builtin_amdgcn_cvt_pk_fp8_f32(v0[2], v0[3], w0, true); int w1 = __builtin_amdgcn_cvt_pk_fp8_f32(v1[0], v1[1], 0, false); w1 = __builtin_amdgcn_cvt_pk_fp8_f32(v1[2], v1[3], w1, true);
                        st8_wt(O8 + (size_t)r * ldc + c0 + bj * HALF, (unsigned long long)(unsigned)w0 | ((unsigned long long)(unsigned)w1 << 32)); }
                    else { u32x4 w; w.x = cvt_pk_bf16(v0[0], v0[1]); w.y = cvt_pk_bf16(v0[2], v0[3]); w.z = cvt_pk_bf16(v1[0], v1[1]); w.w = cvt_pk_bf16(v1[2], v1[3]);
                    st16<1>(rowp + bj * HALF, w); } } }
    }
};
typedef EpiBf16SX<false> EpiBf16S;
}

namespace mk {
constexpr int NWAVES = 8, NPHASE = 12;
constexpr int RING_OFF = 0, RING_BYTES = 131072, EPI_OFF = 131072, EPI_BYTES = 8192, GTAB_OFF = EPI_OFF + EPI_BYTES, GTAB_BYTES = 6144, MISC_OFF = GTAB_OFF + GTAB_BYTES, MISC_BYTES = 1024;
constexpr int LDS_BYTES = 147456;
static_assert(MISC_OFF + MISC_BYTES <= LDS_BYTES, "LDS map");
constexpr size_t WS_LRS = 84 * MiB;
constexpr size_t WS_X2F8 = WS_Y, WS_X1F8 = WS_Y + 32 * MiB;
constexpr size_t WS_CSG1 = 19 * MiB, WS_WRH = 19 * MiB + 64 * 1024, WS_WRL = 19 * MiB + 128 * 1024;
typedef unsigned ssq_t;
constexpr size_t MK_SSQSB = 256 * 1024, MK_SSQ1 = 512 * 1024, MK_SSQ2 = 768 * 1024;
__device__ __forceinline__ void ssq_add(ssq_t* p, float q) { (void)__hip_atomic_fetch_add(p, (ssq_t)__float2uint_rn(q * 16384.0f), __ATOMIC_RELAXED, __HIP_MEMORY_SCOPE_AGENT); }
__device__ __forceinline__ float ssq_get(const ssq_t* p) { return (float)(*p) * (1.0f / 16384.0f); }
constexpr float WSCALE = 32.0f;
constexpr int P0_DEFER = 192 * 8 * 6;
constexpr int CW_BAR = 1024;

#define RLX_AGENT __ATOMIC_RELAXED, __HIP_MEMORY_SCOPE_AGENT
#define LDS_WAIT() asm volatile("s_waitcnt lgkmcnt(0)" ::: "memory")
#define VM_WAIT() asm volatile("s_waitcnt vmcnt(0)" ::: "memory")
#define XB_TMO      128
#define XB_XCNT(j)  (256  + 64 * (j))
#define XB_XSUB(j)  (1280 + 64 * (j))
#define XB_XGEN(j)  (2304 + 64 * (j))
#define XB_TOP      3328
#define XB_TOPGEN   3392
#define XCD_BAR_WORDS 3456
#define XB_SPIN_CAP (1u << 20)
__device__ __forceinline__ unsigned xb_ld(unsigned* p)              { return __hip_atomic_load(p, __ATOMIC_RELAXED, __HIP_MEMORY_SCOPE_AGENT); }
__device__ __forceinline__ unsigned xb_add(unsigned* p, unsigned v) { return __hip_atomic_fetch_add(p, v, __ATOMIC_RELAXED, __HIP_MEMORY_SCOPE_AGENT); }
__device__ __forceinline__ unsigned xb_xcc_id() { return (unsigned)__builtin_amdgcn_s_getreg((3 << 11) | 20) & 0xFu; }
#define XB_SPIN(cond, bar) do { unsigned _sp = 0; while (cond) { __builtin_amdgcn_s_sleep(1); \
    if ((++_sp & 255u) == 0u) { if (xb_ld(&(bar)[XB_TMO])) break; if (_sp > XB_SPIN_CAP) { atomicAdd(&(bar)[XB_TMO], 1u); break; } } } } while (0)
struct XcdBarrier { unsigned* bar; unsigned x; volatile LAS unsigned* st; };
__device__ __forceinline__ XcdBarrier xcd_barrier_post(unsigned* bar, volatile LAS unsigned* st) {
    XcdBarrier b; b.bar = bar; b.x = xb_xcc_id(); b.st = st;
    if (threadIdx.x == 0) (void)xb_add(&bar[XB_XCNT(b.x)], 1u);
    return b;
}
__device__ __forceinline__ void xcd_barrier_complete(unsigned* bar, unsigned x, unsigned& nloc, unsigned& nx) {
    const unsigned G = gridDim.x * gridDim.y * gridDim.z;
    unsigned sum, cnt, mine, sp = 0u;
    for (;;) {
        sum = 0u; cnt = 0u; mine = 0u;
#pragma unroll
        for (unsigned j = 0; j < 16; ++j) { const unsigned c = xb_ld(&bar[XB_XCNT(j)]); sum += c; cnt += (c > 0u) ? 1u : 0u; mine = (j == x) ? c : mine; }
        if (sum == G) break;
        __builtin_amdgcn_s_sleep(1);
        if ((++sp & 255u) == 0u) { if (xb_ld(&bar[XB_TMO])) break; if (sp > XB_SPIN_CAP) { atomicAdd(&bar[XB_TMO], 1u); break; } }
    }
    nloc = mine > 0u ? mine : 1u; nx = cnt > 0u ? cnt : 1u;
}
__device__ __forceinline__ void xcd_barrier(const XcdBarrier& b) {
    asm volatile("s_waitcnt vmcnt(0)" ::: "memory");
    __syncthreads();
    if (threadIdx.x == 0) {
        unsigned* bar = b.bar;
        __builtin_amdgcn_s_waitcnt(0);
        unsigned nloc = b.st[0], nx = b.st[1];
        if (nloc == 0u) { xcd_barrier_complete(bar, b.x, nloc, nx); b.st[0] = nloc; b.st[1] = nx; }
        const unsigned old = xb_add(&bar[XB_XSUB(b.x)], 1u);
        const unsigned gen = old / nloc;
        if (old + 1u == (gen + 1u) * nloc) {
            __builtin_amdgcn_fence(__ATOMIC_RELEASE, "agent");
            asm volatile("s_waitcnt vmcnt(0)" ::: "memory");
            const unsigned og = xb_add(&bar[XB_TOP], 1u);
            const unsigned tg = og / nx;
            if (og + 1u == (tg + 1u) * nx) xb_add(&bar[XB_TOPGEN], 1u);
            else XB_SPIN(xb_ld(&bar[XB_TOPGEN]) == tg, bar);
            __builtin_amdgcn_fence(__ATOMIC_ACQUIRE, "agent");
            xb_add(&bar[XB_XGEN(b.x)], 1u);
            asm volatile("s_waitcnt vmcnt(0)" ::: "memory");
        } else {
            XB_SPIN(xb_ld(&bar[XB_XGEN(b.x)]) == gen, bar);
            __builtin_amdgcn_fence(__ATOMIC_ACQUIRE, "agent");
            asm volatile("s_waitcnt vmcnt(0)" ::: "memory");
        }
    }
    __syncthreads();
}

struct Args { const float* in[22]; float* out; unsigned char* ws; int ph_lo, ph_hi, li, pad; };

template <bool F8OUT>
__device__ __forceinline__ void p0_item(const float* W, int K, int N, void* WTv, const float* gk, const float* gk2, int ksplit, const float* gn, int mode, LAS float* scr, int item, int lane, float mult = 1.0f, int nblk_dec = 0) {
    const int nblk = nblk_dec ? nblk_dec : N / 32, kb = item / nblk, nb = item % nblk, k0 = 64 * kb, nd0 = 32 * nb;
    int ns0 = nd0; if (mode == 1) { const int pn = nd0 >> 8, j = nd0 & 255; ns0 = (j < 128) ? 128 * pn + j : 1024 + 128 * pn + (j - 128); }
    const int kr = lane >> 3, n4 = (lane & 7) * 4;
    f32x4 v[8];
#pragma unroll
    for (int i = 0; i < 8; ++i) v[i] = *(const f32x4*)(W + (size_t)(k0 + 8 * i + kr) * N + ns0 + n4);
    f32x4 gnv = (f32x4){1.f, 1.f, 1.f, 1.f}; if (gn) gnv = *(const f32x4*)(gn + ns0 + n4);
#pragma unroll
    for (int i = 0; i < 8; ++i) { const int kk = 8 * i + kr, k = k0 + kk; float g = 1.f; if (gk) g = (k < ksplit) ? gk[k] : gk2[k - ksplit];
        const f32x4 t = v[i] * gnv * (g * mult); LAS float* d = scr + kk * 33 + n4; d[0] = t[0]; d[1] = t[1]; d[2] = t[2]; d[3] = t[3]; }
    LDS_WAIT(); asm volatile("" ::: "memory");
    const int c = lane & 7;
#pragma unroll
    for (int j = 0; j < 4; ++j) { const int n = (lane >> 3) + 8 * j; const LAS float* s = scr + (8 * c) * 33 + n;
        if constexpr (F8OUT) { int lo = __builtin_amdgcn_cvt_pk_fp8_f32(s[0 * 33], s[1 * 33], 0, false); lo = __builtin_amdgcn_cvt_pk_fp8_f32(s[2 * 33], s[3 * 33], lo, true);
            int hi2 = __builtin_amdgcn_cvt_pk_fp8_f32(s[4 * 33], s[5 * 33], 0, false); hi2 = __builtin_amdgcn_cvt_pk_fp8_f32(s[6 * 33], s[7 * 33], hi2, true);
            pg8::st8_wt((unsigned char*)WTv + (size_t)(nd0 + n) * K + k0 + 8 * c, (unsigned long long)(unsigned)lo | ((unsigned long long)(unsigned)hi2 << 32)); }
        else { u32x4 o; o.x = pg8::cvt_pk_bf16(s[0 * 33], s[1 * 33]); o.y = pg8::cvt_pk_bf16(s[2 * 33], s[3 * 33]); o.z = pg8::cvt_pk_bf16(s[4 * 33], s[5 * 33]); o.w = pg8::cvt_pk_bf16(s[6 * 33], s[7 * 33]);
            pg8::st16<0>((bf16_t*)WTv + (size_t)(nd0 + n) * K + k0 + 8 * c, o); } }
    LDS_WAIT(); asm volatile("" ::: "memory");
}
__device__ __forceinline__ void p0_fused_pool_item(const float* w_in, const float* g_mix, const float* w_pool, const float* pool_scale, bf16_t* WIN_T, int item, int lane) {
    const int eb = item & 7, kb = (item >> 3) & 15, g = item >> 7; const int k = kb * 64 + lane, e0 = eb * 16;
    const float* ap = w_in + (size_t)k * INP + 3 * SBW + g * PGD; const float* bp = w_pool + (size_t)g * PGD * PGD + e0;
    float acc[16];
#pragma unroll
    for (int j = 0; j < 16; ++j) acc[j] = 0.f;
#pragma unroll 4
    for (int c = 0; c < PGD; ++c) { const float a = ap[c];
#pragma unroll
        for (int j = 0; j < 16; ++j) acc[j] += a * bp[c * PGD + j]; }
    const float gk = g_mix[k];
#pragma unroll
    for (int j = 0; j < 16; ++j) WIN_T[(size_t)(3 * SBW + g * PGD + e0 + j) * D + k] = (bf16_t)f2bf(acc[j] * gk * pool_scale[g * PGD + e0 + j]);
}
__device__ __forceinline__ void p0_row(const float* xrow, bf16_t* orow, float* rstd, int lane) {
    const f32x4* xr = (const f32x4*)xrow + 2 * lane; f32x4 v[4]; float s = 0.f;
#pragma unroll
    for (int j = 0; j < 4; ++j) { v[j] = xr[(j >> 1) * 128 + (j & 1)]; s += (v[j].x * v[j].x + v[j].y * v[j].y) + (v[j].z * v[j].z + v[j].w * v[j].w); }
    s = wave_sum(s); if (lane == 0) *rstd = 1.0f / sqrtf(s * (1.0f / D) + EPS);
#pragma unroll
    for (int j = 0; j < 2; ++j) { u32x4 o; o.x = pg8::cvt_pk_bf16(v[2 * j].x, v[2 * j].y); o.y = pg8::cvt_pk_bf16(v[2 * j].z, v[2 * j].w); o.z = pg8::cvt_pk_bf16(v[2 * j + 1].x, v[2 * j + 1].y); o.w = pg8::cvt_pk_bf16(v[2 * j + 1].z, v[2 * j + 1].w);
        pg8::st16<0>(orow + j * 512 + 8 * lane, o); }
}
__device__ __forceinline__ void p0_prologue(const Args& a, LAS unsigned char* lds, int vcu, int G, int wave, int lane) {
    unsigned char* ws = a.ws;
    LAS float* scr = (LAS float*)(lds + RING_OFF + wave * 16384);
    const int gw = vcu * NWAVES + wave, NGW = G * NWAVES;
    constexpr int I_E1 = (D / 64) * (2 * DFF / 32), I_E2 = (DFF / 64) * (D / 32);
    constexpr int I_IN = (D / 64) * (3 * SBW / 32), I_FP = PG * 16 * 8, I_SQ = (D / 64) * (D / 32), I_KV = (D / 64) * (2 * D / 32), I_P = (PGD / 64) * (PGD / 32);
    constexpr int N1 = NE * I_E1, N2 = NE * I_E2, NITEMS = N1 + N2 + I_IN + 3 * I_SQ + I_KV + I_FP;
    const int BIG = 1 << 30;
    for (int it = gw; it < NITEMS; it += NGW) {
        int r = it;
        if (r < N1 + N2 && r >= N1 + N2 - P0_DEFER) continue;
        if (r < N1) { const int e = r / I_E1; p0_item<true>(a.in[17] + (size_t)e * D * 2 * DFF, D, 2 * DFF, ws + WS_W1 + (size_t)e * 2 * DFF * D, a.in[14], nullptr, BIG, nullptr, 1, scr, r % I_E1, lane, WSCALE); continue; } r -= N1;
        if (r < N2) { const int e = r / I_E2; p0_item<true>(a.in[19] + (size_t)e * DFF * D, DFF, D, ws + WS_W2 + (size_t)e * D * DFF, nullptr, nullptr, BIG, nullptr, 0, scr, r % I_E2, lane, WSCALE); continue; } r -= N2;
        if (r < I_IN) { p0_item<false>(a.in[3], D, INP, (bf16_t*)(ws + WS_WIN), a.in[2], nullptr, BIG, nullptr, 0, scr, r, lane, 1.0f, 3 * SBW / 32); continue; } r -= I_IN;
        if (r < I_SQ) { p0_item<false>(a.in[8], D, D, (bf16_t*)(ws + WS_WOUT), a.in[4], a.in[5], SBW, nullptr, 0, scr, r, lane); continue; } r -= I_SQ;
        if (r < I_SQ) { p0_item<true>(a.in[11], D, D, ws + WS_WQ, a.in[9], nullptr, BIG, nullptr, 0, scr, r, lane, WSCALE); continue; } r -= I_SQ;
        if (r < I_KV) { p0_item<false>(a.in[12], D, 2 * D, (bf16_t*)(ws + WS_WKV), a.in[10], nullptr, BIG, nullptr, 0, scr, r, lane); continue; } r -= I_KV;
        if (r < I_SQ) { p0_item<false>(a.in[13], D, D, (bf16_t*)(ws + WS_WO), nullptr, nullptr, BIG, nullptr, 0, scr, r, lane); continue; } r -= I_SQ;
        p0_fused_pool_item(a.in[3], a.in[2], a.in[6], a.in[7], (bf16_t*)(ws + WS_WIN), r, lane);
    }
    for (int m = gw; m < NTOK; m += NGW) p0_row(a.in[0] + (size_t)m * D, (bf16_t*)(ws + WS_S0) + (size_t)m * D, (float*)(ws + WS_RSTDX) + m, lane);
    for (int m = gw; m < NMROWS; m += NGW) p0_row(a.in[1] + (size_t)m * D, (bf16_t*)(ws + WS_MEMB) + (size_t)m * D, (float*)(ws + WS_RSTDM) + m, lane);
    const int gt = gw * 64 + lane, NGT = NGW * 64;
    for (int i = gt; i < INP; i += NGT) ((float*)(ws + WS_CSG1))[i] = (i < SBW) ? C2_SB : 1.0f;
    for (int i = gt; i < NE * D; i += NGT) { const int e = i / D, k = i % D; const float v = a.in[14][k] * a.in[15][k * NE + e];
        ((float*)(ws + WS_WR))[i] = v; const unsigned h = f2bf(v); ((bf16_t*)(ws + WS_WRH))[i] = (bf16_t)h; ((bf16_t*)(ws + WS_WRL))[i] = (bf16_t)f2bf(v - bf2f((bf16_t)h)); }
}

__device__ __forceinline__ void p1_deferred_items(const Args& a, LAS unsigned char* lds, int rank  , int wave, int lane) {
    constexpr int I_E2 = (DFF / 64) * (D / 32), N2 = NE * I_E2;
    LAS float* scr = (LAS float*)(lds + RING_OFF + wave * 16384);
    for (int k = 0; k < P0_DEFER / (192 * 8); ++k) { const int r = N2 - P0_DEFER + (k * 192 + rank) * 8 + wave; const int e = r / I_E2;
        p0_item<true>(a.in[19] + (size_t)e * DFF * D, DFF, D, a.ws + WS_W2 + (size_t)e * D * DFF, nullptr, nullptr, 1 << 30, nullptr, 0, scr, r % I_E2, lane, WSCALE); }
}
struct SchedP1 {
    int G, c; unsigned char* ws;
    __device__ __forceinline__ bool next(int i, pg8::Unit& u) const {
        const int L = i * G + c; constexpr int NQ = (NTOK / 256) * (INP / 256);
        if (L >= NQ + 64) return false;
        if (L < NQ) { int pm, pn; pg8::grouped_mn(pg8::xcd_remap(L, NQ), NTOK / 256, INP / 256, pm, pn);
            u.A = (const char*)(ws + WS_S0) + (size_t)pm * 256 * D * 2; u.B = (const char*)(ws + WS_WIN) + (size_t)pn * 256 * D * 2;
            u.p0 = (bf16_t*)(ws + WS_QKVU) + (size_t)pm * 256 * INP + pn * 256; u.p1 = (float*)(ws + WS_RSTDX) + pm * 256; u.p2 = (float*)(ws + WS_CSG1) + pn * 256; u.i0 = INP; u.pm = pm; u.pn = pn; }
        else if (L < NQ + 32) { const int k = L - NQ, pm = k >> 2, pn = k & 3;
            u.A = (const char*)(ws + WS_MEMB) + (size_t)pm * 256 * D * 2; u.B = (const char*)(ws + WS_WKV) + (size_t)pn * 256 * D * 2;
            u.p0 = (bf16_t*)(ws + WS_KM) + (size_t)pm * 256 * D + pn * 256; u.p1 = (float*)(ws + WS_RSTDM) + pm * 256; u.p2 = nullptr; u.i0 = D; u.pm = pm; u.pn = pn; }
        else { const int v = L - NQ - 32, b = v >> 2, dt = v & 3;
            u.A = (const char*)(ws + WS_WKV) + (size_t)(D + dt * 256) * D * 2; u.B = (const char*)(ws + WS_MEMB) + (size_t)b * 256 * D * 2;
            u.p0 = (bf16_t*)(ws + WS_VMT) + ((size_t)b * D + dt * 256) * NMEM; u.p1 = nullptr; u.p2 = (float*)(ws + WS_RSTDM) + b * 256; u.i0 = NMEM; u.pm = dt; u.pn = b; }
        u.p3 = nullptr; u.i1 = 0; return true;
    }
};
#define EPI_BAR() asm volatile("s_waitcnt lgkmcnt(0)\n\ts_barrier" ::: "memory")
struct SchedReg {
    int G, c, nM, nN; const char* A; const char* B; size_t astep, bstep; bf16_t* O; int ldc; const float* rs; const float* cs; const ssq_t* sq = nullptr;
    __device__ __forceinline__ bool next(int i, pg8::Unit& u) const {
        const int L = i * G + c; if (L >= nM * nN) return false; int pm, pn; pg8::grouped_mn(pg8::xcd_remap(L, nM * nN), nM, nN, pm, pn);
        u.A = A + (size_t)pm * astep; u.B = B + (size_t)pn * bstep; u.pm = pm; u.pn = pn; u.i0 = ldc; u.i1 = 0;
        u.p0 = O ? (void*)(O + (size_t)pm * 256 * ldc + pn * 256) : nullptr; u.p1 = sq ? (void*)(sq + pm * 256) : (rs ? (void*)(rs + pm * 256) : nullptr); u.p2 = cs ? (void*)(cs + pn * 256) : nullptr; u.p3 = nullptr; return true;
    }
};
struct EpiBf16Ssq {
    static constexpr bool PERM = true; static constexpr int MIDK = -1; float inv_n, mult;
    __device__ __forceinline__ void midk(f32x4 (&)[2][2][4][2], const pg8::Unit&, int, int) const {}
    __device__ __forceinline__ void operator()(f32x4 (&acc)[2][2][4][2], const pg8::Unit& u, int wr, int wc, int fr, int fq, int, int, LAS unsigned char*) const {
        bf16_t* O = (bf16_t*)u.p0; const ssq_t* sq = (const ssq_t*)u.p1; const int ldc = u.i0; int r0 = wr * 64 + fr, c0 = wc * 32 + 8 * fq; asm volatile("" : "+v"(r0), "+v"(c0));
#pragma unroll
        for (int ai = 0; ai < 2; ++ai)
#pragma unroll
            for (int m = 0; m < 4; ++m) { const int r = r0 + ai * 128 + m * 16; const float rv = mult / sqrtf(ssq_get(sq + r) * inv_n + EPS); bf16_t* rowp = O + (size_t)r * ldc + c0;
#pragma unroll
                for (int bj = 0; bj < 2; ++bj) { const f32x4 v0 = acc[ai][bj][m][0] * rv, v1 = acc[ai][bj][m][1] * rv;
                    u32x4 w; w.x = pg8::cvt_pk_bf16(v0[0], v0[1]); w.y = pg8::cvt_pk_bf16(v0[2], v0[3]); w.z = pg8::cvt_pk_bf16(v1[0], v1[1]); w.w = pg8::cvt_pk_bf16(v1[2], v1[3]);
                    pg8::st16<5>(rowp + bj * 128, w); } }
    }
};
template <int MIDK_, bool XIN_BF16, bool F8OUT> struct EpiResid {
    static constexpr bool PERM = true; static constexpr int MIDK = MIDK_;
    const float* xin; bf16_t* xb; unsigned char* x8; ssq_t* ssq; const ssq_t* ssq_mid; float accs;
    __device__ __forceinline__ void midk(f32x4 (&acc)[2][2][4][2], const pg8::Unit& u, int wr, int fr) const {
#pragma unroll
        for (int ai = 0; ai < 2; ++ai)
#pragma unroll
            for (int m = 0; m < 4; ++m) { const int r = u.pm * 256 + ai * 128 + wr * 64 + m * 16 + fr; const float s = 1.0f / sqrtf(ssq_get(ssq_mid + r) * (1.0f / SBW) + EPS);
#pragma unroll
                for (int bj = 0; bj < 2; ++bj)
#pragma unroll
                    for (int n = 0; n < 2; ++n) acc[ai][bj][m][n] *= s; }
    }
    __device__ __forceinline__ void operator()(f32x4 (&acc)[2][2][4][2], const pg8::Unit& u, int wr, int wc, int fr, int fq, int, int, LAS unsigned char*) const {
        int row0 = u.pm * 256 + wr * 64 + fr, col0 = u.pn * 256 + wc * 32 + 8 * fq; asm volatile("" : "+v"(row0), "+v"(col0));
        u32x4 xv[2][4][2]; f32x4 xf[XIN_BF16 ? 1 : 2][XIN_BF16 ? 1 : 4][XIN_BF16 ? 1 : 2][2];
#pragma unroll
        for (int ai = 0; ai < 2; ++ai)
#pragma unroll
            for (int m = 0; m < 4; ++m)
#pragma unroll
                for (int bj = 0; bj < 2; ++bj) { const size_t o2 = (size_t)(row0 + ai * 128 + m * 16) * D + col0 + bj * 128;
                    if constexpr (XIN_BF16) xv[ai][m][bj] = *(const u32x4*)(xb + o2); else { xf[ai][m][bj][0] = *(const f32x4*)(xin + o2); xf[ai][m][bj][1] = *(const f32x4*)(xin + o2 + 4); } }
#pragma unroll
        for (int ai = 0; ai < 2; ++ai)
#pragma unroll
            for (int m = 0; m < 4; ++m) { const int r = row0 + ai * 128 + m * 16; const size_t off = (size_t)r * D + col0; float q = 0.f;
#pragma unroll
                for (int bj = 0; bj < 2; ++bj) { const size_t o2 = off + bj * 128; f32x4 o0, o1;
                    if constexpr (XIN_BF16) { const u32x4 x4 = xv[ai][m][bj];
                        o0 = (f32x4){__builtin_bit_cast(float, x4.x << 16), __builtin_bit_cast(float, x4.x & 0xffff0000u), __builtin_bit_cast(float, x4.y << 16), __builtin_bit_cast(float, x4.y & 0xffff0000u)};
                        o1 = (f32x4){__builtin_bit_cast(float, x4.z << 16), __builtin_bit_cast(float, x4.z & 0xffff0000u), __builtin_bit_cast(float, x4.w << 16), __builtin_bit_cast(float, x4.w & 0xffff0000u)}; }
                    else { o0 = xf[ai][m][bj][0]; o1 = xf[ai][m][bj][1]; }
                    o0 += acc[ai][bj][m][0] * accs; o1 += acc[ai][bj][m][1] * accs;
                    q += (o0[0] * o0[0] + o0[1] * o0[1]) + (o0[2] * o0[2] + o0[3] * o0[3]) + (o1[0] * o1[0] + o1[1] * o1[1]) + (o1[2] * o1[2] + o1[3] * o1[3]);
                    if constexpr (F8OUT) { int w0 = __builtin_amdgcn_cvt_pk_fp8_f32(o0[0], o0[1], 0, false); w0 = __builtin_amdgcn_cvt_pk_fp8_f32(o0[2], o0[3], w0, true);
                        int w1 = __builtin_amdgcn_cvt_pk_fp8_f32(o1[0], o1[1], 0, false); w1 = __builtin_amdgcn_cvt_pk_fp8_f32(o1[2], o1[3], w1, true);
                        pg8::st8_wt(x8 + o2, (unsigned long long)(unsigned)w0 | ((unsigned long long)(unsigned)w1 << 32)); }
                    u32x4 w; w.x = pg8::cvt_pk_bf16(o0[0], o0[1]); w.y = pg8::cvt_pk_bf16(o0[2], o0[3]); w.z = pg8::cvt_pk_bf16(o1[0], o1[1]); w.w = pg8::cvt_pk_bf16(o1[2], o1[3]); pg8::st16<4>(xb + o2, w); }
                q += __shfl_xor(q, 16); q += __shfl_xor(q, 32);
                if (fq == 0) ssq_add(ssq + r, q); }
    }
};
struct SchedMS {
    int G, c; unsigned char* ws;
    __device__ __forceinline__ bool next(int i, pg8::Unit& u) const {
        const int L = i * G + c; constexpr int NU = (NTOK / 256) * MH; if (L >= NU) return false; int pm, h; pg8::grouped_mn(pg8::xcd_remap(L, NU), NTOK / 256, MH, pm, h); const int b = pm >> 4;
        u.A = (const char*)(ws + WS_QM) + ((size_t)pm * 256 * D + h * MHD) * 2; u.B = (const char*)(ws + WS_KM) + ((size_t)b * NMEM * D + h * MHD) * 2;
        u.p0 = (bf16_t*)(ws + WS_PM) + (size_t)pm * 256 * D + h * NMEM; u.p1 = nullptr; u.p2 = nullptr; u.p3 = nullptr; u.i0 = D; u.i1 = 0; u.pm = pm; u.pn = h; return true;
    }
};
struct EpiSoftmax {
    static constexpr bool PERM = true; static constexpr int MIDK = -1;
    __device__ __forceinline__ void midk(f32x4 (&)[2][2][4][2], const pg8::Unit&, int, int) const {}
    __device__ __forceinline__ void operator()(f32x4 (&acc)[2][2][4][2], const pg8::Unit& u, int wr, int wc, int fr, int fq, int, int, LAS unsigned char* xl) const {
        typedef float f32x2v __attribute__((ext_vector_type(2)));
        LAS f32x2v* X = (LAS f32x2v*)xl;
        float ml[2][4];
#pragma unroll
        for (int ai = 0; ai < 2; ++ai)
#pragma unroll
            for (int m = 0; m < 4; ++m) { float mx = -INFINITY;
#pragma unroll
                for (int bj = 0; bj < 2; ++bj)
#pragma unroll
                    for (int n = 0; n < 2; ++n) { const f32x4 v = acc[ai][bj][m][n]; mx = fmaxf(fmaxf(mx, fmaxf(v[0], v[1])), fmaxf(v[2], v[3])); }
                mx = fmaxf(mx, __shfl_xor(mx, 16)); mx = fmaxf(mx, __shfl_xor(mx, 32)); ml[ai][m] = mx; float s = 0.f;
#pragma unroll
                for (int bj = 0; bj < 2; ++bj)
#pragma unroll
                    for (int n = 0; n < 2; ++n) { f32x4 v = acc[ai][bj][m][n];
#pragma unroll
                        for (int j = 0; j < 4; ++j) { v[j] = __builtin_amdgcn_exp2f(v[j] - mx); s += v[j]; }
                        acc[ai][bj][m][n] = v; }
                s += __shfl_xor(s, 16); s += __shfl_xor(s, 32);
                if (fq == 0) X[(ai * 128 + wr * 64 + m * 16 + fr) * 4 + wc] = (f32x2v){mx, s}; }
        EPI_BAR();
        bf16_t* O = (bf16_t*)u.p0; const int ldc = u.i0; int r0 = wr * 64 + fr, c0 = wc * 32 + 8 * fq; asm volatile("" : "+v"(r0), "+v"(c0));
#pragma unroll
        for (int ai = 0; ai < 2; ++ai)
#pragma unroll
            for (int m = 0; m < 4; ++m) { const int r = r0 + ai * 128 + m * 16; const f32x2v a = X[r * 4 + 0], b = X[r * 4 + 1], c = X[r * 4 + 2], d = X[r * 4 + 3];
                const float M = fmaxf(fmaxf(a.x, b.x), fmaxf(c.x, d.x));
                const float tot = a.y * __builtin_amdgcn_exp2f(a.x - M) + b.y * __builtin_amdgcn_exp2f(b.x - M) + c.y * __builtin_amdgcn_exp2f(c.x - M) + d.y * __builtin_amdgcn_exp2f(d.x - M);
                const float f = __builtin_amdgcn_exp2f(ml[ai][m] - M) / tot; bf16_t* rowp = O + (size_t)r * ldc + c0;
#pragma unroll
                for (int bj = 0; bj < 2; ++bj) { const f32x4 v0 = acc[ai][bj][m][0] * f, v1 = acc[ai][bj][m][1] * f;
                    u32x4 w; w.x = pg8::cvt_pk_bf16(v0[0], v0[1]); w.y = pg8::cvt_pk_bf16(v0[2], v0[3]); w.z = pg8::cvt_pk_bf16(v1[0], v1[1]); w.w = pg8::cvt_pk_bf16(v1[2], v1[3]);
                    pg8::st16<6>(rowp + bj * 128, w); } }
    }
};
struct SchedPV {
    int G, c; unsigned char* ws;
    __device__ __forceinline__ bool next(int i, pg8::Unit& u) const {
        const int L = i * G + c; constexpr int NU = (NTOK / 256) * MH; if (L >= NU) return false; int pm, h; pg8::grouped_mn(pg8::xcd_remap(L, NU), NTOK / 256, MH, pm, h); const int b = pm >> 4;
        u.A = (const char*)(ws + WS_PM) + ((size_t)pm * 256 * D + h * NMEM) * 2; u.B = (const char*)(ws + WS_VMT) + ((size_t)b * D + h * MHD) * NMEM * 2;
        u.p0 = (bf16_t*)(ws + WS_OM) + (size_t)pm * 256 * D + h * MHD; u.p1 = nullptr; u.p2 = nullptr; u.p3 = nullptr; u.i0 = D; u.i1 = 0; u.pm = pm; u.pn = h; return true;
    }
};

__device__ __forceinline__ void p8_route(const Args& a, LAS unsigned char* lds, int bx, int G, int wave, int lane, int* CNT) {
    unsigned char* ws = a.ws; const bf16_t* x2 = (const bf16_t*)(ws + WS_S0); const ssq_t* SSQ2 = (const ssq_t*)(ws + MK_SSQ2); const float* br = a.in[16];
    const bf16_t* WRH = (const bf16_t*)(ws + WS_WRH);
    int* LSLOT = (int*)(ws + WS_LSLOT); float* LGATE = (float*)(ws + WS_LGATE); float* LRS = (float*)(ws + WS_LRS);
    constexpr int WPITCH = 2064;
    LAS float* LG = (LAS float*)(lds + RING_OFF + 69632) + wave * 16 * 33;
    LAS int* hist = (LAS int*)(lds + RING_OFF + 90112); LAS int* base = hist + 32;
    const int tid = wave * 64 + lane;
    { u32x4 v[8];
#pragma unroll
      for (int i = 0; i < 8; ++i) v[i] = *(const u32x4*)(WRH + (size_t)(tid + i * 512) * 8);
#pragma unroll
      for (int i = 0; i < 8; ++i) { const int c = tid + i * 512; *(LAS u32x4*)(lds + RING_OFF + (c >> 7) * WPITCH + (c & 127) * 16) = v[i]; } }
    LDS_WAIT(); __syncthreads();
    for (int t0 = bx * 128; t0 < NTOK; t0 += G * 128) {
        if (tid < 32) hist[tid] = 0;
        const int r16 = lane & 15, kq = lane >> 4; const int trow = t0 + wave * 16 + r16;
        const bf16_t* xp = x2 + (size_t)trow * D + kq * 8;
        bf16x8 ah[32];
#pragma unroll
        for (int ks = 0; ks < 32; ++ks) ah[ks] = *(const bf16x8*)(xp + ks * 32);
        f32x4 acc[2] = {(f32x4){0.f, 0.f, 0.f, 0.f}, (f32x4){0.f, 0.f, 0.f, 0.f}};
        const LAS unsigned char* wp = lds + RING_OFF + r16 * WPITCH + kq * 16;
#pragma unroll
        for (int ks = 0; ks < 32; ++ks) {
#pragma unroll
            for (int nb = 0; nb < 2; ++nb) { const bf16x8 bh = *(const LAS bf16x8*)(wp + nb * 16 * WPITCH + ks * 64);
                acc[nb] = __builtin_amdgcn_mfma_f32_16x16x32_bf16(ah[ks], bh, acc[nb], 0, 0, 0); } }
#pragma unroll
        for (int nb = 0; nb < 2; ++nb)
#pragma unroll
            for (int r = 0; r < 4; ++r) { const int tl = kq * 4 + r; const int tk = t0 + wave * 16 + tl; const float rs = 1.0f / sqrtf(ssq_get(SSQ2 + tk) * (1.0f / D) + EPS);
                LG[tl * 33 + nb * 16 + r16] = acc[nb][r] * rs + br[nb * 16 + r16]; }
        LDS_WAIT(); __syncthreads();
        int te[4] = {0, 0, 0, 0}; float tg[4] = {0.f, 0.f, 0.f, 0.f}; int rk[4] = {0, 0, 0, 0};
        if (lane < 16) {
            float tv[4] = {-INFINITY, -INFINITY, -INFINITY, -INFINITY};
            for (int e = 0; e < NE; ++e) { const float v = LG[lane * 33 + e];
                if (v > tv[3]) { if (v > tv[2]) { tv[3] = tv[2]; te[3] = te[2]; if (v > tv[1]) { tv[2] = tv[1]; te[2] = te[1]; if (v > tv[0]) { tv[1] = tv[0]; te[1] = te[0]; tv[0] = v; te[0] = e; } else { tv[1] = v; te[1] = e; } } else { tv[2] = v; te[2] = e; } } else { tv[3] = v; te[3] = e; } } }
            float gs = 0.f;
#pragma unroll
            for (int k = 0; k < 4; ++k) { tg[k] = __expf(tv[k] - tv[0]); gs += tg[k]; }
            gs = 1.0f / gs;
#pragma unroll
            for (int k = 0; k < 4; ++k) { tg[k] *= gs; rk[k] = __hip_atomic_fetch_add(hist + te[k], 1, __ATOMIC_RELAXED, __HIP_MEMORY_SCOPE_WORKGROUP); }
        }
        LDS_WAIT(); __syncthreads();
        if (tid < 32) { const int n = hist[tid]; base[tid] = n ? atomicAdd(CNT + tid, n) : 0; }
        LDS_WAIT(); __syncthreads();
        if (lane < 16) { const int tk = t0 + wave * 16 + lane; const float rsw = (1.0f / WSCALE) / sqrtf(ssq_get(SSQ2 + tk) * (1.0f / D) + EPS);
#pragma unroll
            for (int k = 0; k < 4; ++k) { const size_t p = (size_t)te[k] * LCAP + base[te[k]] + rk[k]; pg8::st4_wt(LSLOT + p, (unsigned)(tk * 4 + k)); pg8::st4_wt(LGATE + p, __float_as_uint(tg[k])); pg8::st4_wt(LRS + p, __float_as_uint(rsw)); } }
        LDS_WAIT(); __syncthreads();
    }
}

__device__ __forceinline__ void moe_table(const Args& a, volatile LAS unsigned* MISC, int tid) {
    const int* CNT = (const int*)(a.ws + OFF_CNT);
    if (tid < 32) MISC[16 + tid] = (unsigned)CNT[tid];
    LDS_WAIT(); __syncthreads();
    if (tid == 0) { unsigned tb = 0; for (int e = 0; e < NE; ++e) { MISC[48 + e] = tb; tb += (MISC[16 + e] + 255u) >> 8; } MISC[48 + NE] = tb; }
    LDS_WAIT(); __syncthreads();
}
template <int NPN, bool W1> struct SchedMoE {
    int G, c; unsigned char* ws; volatile LAS unsigned* MISC; const float* bias;
    __device__ __forceinline__ bool next(int i, pg8::Unit& u) const {
        unsigned mb_ = (unsigned)(uintptr_t)MISC; asm volatile("" : "+s"(mb_)); const LAS unsigned* M = (const LAS unsigned*)(uintptr_t)mb_;
        const int T = __builtin_amdgcn_readfirstlane((int)M[48 + NE]); const int NU = T * NPN; const int L = i * G + c; if (L >= NU) return false;
        const int w = pg8::xcd_remap(L, NU);
        int e = 0;
#pragma unroll
        for (int s = 16; s >= 1; s >>= 1) { if ((int)M[48 + e + s] * NPN <= w) e += s; }
        e = __builtin_amdgcn_readfirstlane(e);
        const int tb = __builtin_amdgcn_readfirstlane((int)M[48 + e]), cnt = __builtin_amdgcn_readfirstlane((int)M[16 + e]), nte = (cnt + 255) >> 8; const int idx = w - tb * NPN, pn = __builtin_amdgcn_readfirstlane(idx / nte), mt = idx - pn * nte;
        u.pm = tb + mt; u.pn = pn; u.i1 = e; const int nv = cnt - mt * 256; u.i0 = nv < 256 ? nv : 256;
        u.p3 = (int*)(ws + WS_LSLOT) + (size_t)e * LCAP + mt * 256; u.p2 = (float*)(ws + (W1 ? WS_LRS : WS_LGATE)) + (size_t)e * LCAP + mt * 256; u.p0 = nullptr;
        u.p1 = W1 ? (void*)(bias + (size_t)e * 2 * DFF + pn * 128) : (void*)(bias + (size_t)e * D + pn * 256);
        if (W1) { u.A = (const char*)(ws + WS_X2F8); u.B = (const char*)(ws + WS_W1) + ((size_t)e * 2 * DFF + pn * 256) * D; }
        else { u.A = (const char*)(ws + WS_ACT) + (size_t)(tb + mt) * 256 * DFF; u.B = (const char*)(ws + WS_W2) + ((size_t)e * D + pn * 256) * DFF; }
        return true;
    }
};
typedef float f32x2 __attribute__((ext_vector_type(2)));
struct EpiSwiGLU {
    static constexpr bool PERM = true; static constexpr int MIDK = -1; unsigned char* act;
    __device__ __forceinline__ void midk(f32x4 (&)[2][2][4][2], const pg8::Unit&, int, int) const {}
    __device__ __forceinline__ void operator()(f32x4 (&acc)[2][2][4][2], const pg8::Unit& u, int wr, int wc, int fr, int fq, int, int, LAS unsigned char* tab) const {
        const int nvalid = u.i0; const LAS float* T1 = (const LAS float*)tab + 256; const LAS float* T2 = (const LAS float*)tab + 512;
        int r0 = wr * 64 + fr, c0 = wc * 32 + 8 * fq; asm volatile("" : "+v"(r0), "+v"(c0)); const int gc0 = u.pn * 128 + c0;
        f32x4 bg[2], bu[2];
#pragma unroll
        for (int n = 0; n < 2; ++n) { bg[n] = *(const LAS f32x4*)(T2 + c0 + 4 * n); bu[n] = *(const LAS f32x4*)(T2 + 128 + c0 + 4 * n); }
#pragma unroll
        for (int ai = 0; ai < 2; ++ai)
#pragma unroll
            for (int m = 0; m < 4; ++m) { const int r = r0 + ai * 128 + m * 16; const float rs = T1[r]; int wv[2];
#pragma unroll
                for (int n = 0; n < 2; ++n) { f32x2 o[2];
#pragma unroll
                    for (int h = 0; h < 2; ++h) { f32x2 g = (f32x2){acc[ai][0][m][n][2 * h], acc[ai][0][m][n][2 * h + 1]} * rs + (f32x2){bg[n][2 * h], bg[n][2 * h + 1]};
                        f32x2 up = (f32x2){acc[ai][1][m][n][2 * h], acc[ai][1][m][n][2 * h + 1]} * rs + (f32x2){bu[n][2 * h], bu[n][2 * h + 1]};
                        g.x = fminf(g.x, SW_LIMIT); g.y = fminf(g.y, SW_LIMIT); up.x = fminf(fmaxf(up.x, -SW_LIMIT), SW_LIMIT); up.y = fminf(fmaxf(up.y, -SW_LIMIT), SW_LIMIT);
                        const f32x2 tt = g * (-SW_ALPHA * LOG2E); f32x2 d; d.x = __builtin_amdgcn_exp2f(tt.x); d.y = __builtin_amdgcn_exp2f(tt.y); d = d + 1.0f;
                        f32x2 rr; rr.x = __builtin_amdgcn_rcpf(d.x); rr.y = __builtin_amdgcn_rcpf(d.y);
                        o[h] = (up + 1.0f) * g * rr; }
                    wv[n] = __builtin_amdgcn_cvt_pk_fp8_f32(o[0].x, o[0].y, 0, false); wv[n] = __builtin_amdgcn_cvt_pk_fp8_f32(o[1].x, o[1].y, wv[n], true); }
                if (r < nvalid) pg8::st8_wt(act + ((size_t)u.pm * 256 + r) * DFF + gc0, (unsigned long long)(unsigned)wv[0] | ((unsigned long long)(unsigned)wv[1] << 32)); }
    }
};
struct EpiW2 {
    static constexpr bool PERM = true; static constexpr int MIDK = -1; unsigned char* Y;
    __device__ __forceinline__ void midk(f32x4 (&)[2][2][4][2], const pg8::Unit&, int, int) const {}
    __device__ __forceinline__ void operator()(f32x4 (&acc)[2][2][4][2], const pg8::Unit& u, int wr, int wc, int fr, int fq, int, int, LAS unsigned char* tab) const {
        const int nvalid = u.i0; const LAS unsigned* T0 = (const LAS unsigned*)tab; const LAS float* T1 = (const LAS float*)tab + 256; const LAS float* T2 = (const LAS float*)tab + 512;
        int r0 = wr * 64 + fr, cl = wc * 32 + 8 * fq; asm volatile("" : "+v"(r0), "+v"(cl)); const int c0 = u.pn * 256 + cl;
        f32x4 bv[2][2];
#pragma unroll
        for (int bj = 0; bj < 2; ++bj)
#pragma unroll
            for (int n = 0; n < 2; ++n) bv[bj][n] = *(const LAS f32x4*)(T2 + cl + bj * 128 + 4 * n);
#pragma unroll
        for (int ai = 0; ai < 2; ++ai)
#pragma unroll
            for (int m = 0; m < 4; ++m) { const int r = r0 + ai * 128 + m * 16; const bool valid = r < nvalid; const unsigned slot = T0[r]; const float g = T1[r];
#pragma unroll
                for (int bj = 0; bj < 2; ++bj) { const f32x4 v0 = (acc[ai][bj][m][0] * (1.0f / WSCALE) + bv[bj][0]) * g, v1 = (acc[ai][bj][m][1] * (1.0f / WSCALE) + bv[bj][1]) * g;
                    int w0 = __builtin_amdgcn_cvt_pk_fp8_f32(v0[0], v0[1], 0, false); w0 = __builtin_amdgcn_cvt_pk_fp8_f32(v0[2], v0[3], w0, true);
                    int w1 = __builtin_amdgcn_cvt_pk_fp8_f32(v1[0], v1[1], 0, false); w1 = __builtin_amdgcn_cvt_pk_fp8_f32(v1[2], v1[3], w1, true);
                    if (valid) pg8::st8_wt(Y + (size_t)slot * D + c0 + bj * 128, (unsigned long long)(unsigned)w0 | ((unsigned long long)(unsigned)w1 << 32)); } }
    }
};

__device__ __forceinline__ void p11_final(const Args& a, int vcu, int G, int wave, int lane, float* dst) {
    const bf16_t* x2 = (const bf16_t*)(a.ws + WS_S0); const unsigned char* Y = a.ws + WS_Y; const float* gf = a.in[21];
    const int gw = vcu * NWAVES + wave, NGW = G * NWAVES;
    f32x4 g4[4];
#pragma unroll
    for (int j = 0; j < 4; ++j) g4[j] = *(const f32x4*)(gf + 16 * lane + 4 * j);
    for (int tok = gw; tok < NTOK; tok += NGW) {
        const u32x4 xa = *(const u32x4*)(x2 + (size_t)tok * D + 16 * lane), xc = *(const u32x4*)(x2 + (size_t)tok * D + 16 * lane + 8);
        u32x4 yv[4];
#pragma unroll
        for (int k = 0; k < 4; ++k) yv[k] = *(const u32x4*)(Y + ((size_t)tok * 4 + k) * D + 16 * lane);
        float v[16];
#pragma unroll
        for (int q = 0; q < 4; ++q) { v[2 * q] = __builtin_bit_cast(float, xa[q] << 16); v[2 * q + 1] = __builtin_bit_cast(float, xa[q] & 0xffff0000u); v[8 + 2 * q] = __builtin_bit_cast(float, xc[q] << 16); v[8 + 2 * q + 1] = __builtin_bit_cast(float, xc[q] & 0xffff0000u); }
#pragma unroll
        for (int k = 0; k < 4; ++k)
#pragma unroll
            for (int q = 0; q < 4; ++q) { const auto lo = __builtin_amdgcn_cvt_pk_f32_fp8((int)yv[k][q], false), hi2 = __builtin_amdgcn_cvt_pk_f32_fp8((int)yv[k][q], true);
                v[4 * q] += lo[0]; v[4 * q + 1] += lo[1]; v[4 * q + 2] += hi2[0]; v[4 * q + 3] += hi2[1]; }
        float s = 0.f;
#pragma unroll
        for (int q = 0; q < 16; ++q) s += v[q] * v[q];
        const float rs = 1.0f / sqrtf(wave_sum(s) * (1.0f / D) + EPS);
#pragma unroll
        for (int j = 0; j < 4; ++j) pg8::st16<8>(dst + (size_t)tok * D + 16 * lane + 4 * j, (f32x4){v[4 * j] * rs * g4[j][0], v[4 * j + 1] * rs * g4[j][1], v[4 * j + 2] * rs * g4[j][2], v[4 * j + 3] * rs * g4[j][3]});
    }
}
typedef float f32x16 __attribute__((ext_vector_type(16)));
typedef short s16x4 __attribute__((ext_vector_type(4)));
__device__ __forceinline__ int crow(int r, int hi) { return (r & 3) + 8 * (r >> 2) + 4 * hi; }
#define SB_DMA(ubase, voff, ldsaddr) do { unsigned keep_; asm volatile("s_mov_b32 %0, m0\n\ts_mov_b32 m0, %3\n\ts_nop 0\n\tglobal_load_lds_dwordx4 %1, %2\n\ts_mov_b32 m0, %0" \
        : "=&s"(keep_) : "v"(voff), "s"((const char*)(ubase)), "s"(ldsaddr) : "memory"); } while (0)
__device__ __forceinline__ void sb_item(int b, int h, int qi  , const bf16_t* QKVU, bf16_t* MIXED, ssq_t* SSQSB, LAS unsigned char* wl  , int lane) {
    const int r32 = lane & 31, hi = lane >> 5;
    const size_t rowbase = (size_t)b * S; const int q0 = qi * 64;
    const bf16_t* Qw = QKVU + (rowbase + q0) * INP + h * HD;
    const char* Kh = (const char*)(QKVU + rowbase * INP + SBW + h * HD); const char* Vh = Kh + SBW * 2;
    bf16x8 qr[2][4];
#pragma unroll
    for (int s = 0; s < 2; ++s)
#pragma unroll
        for (int d0 = 0; d0 < 4; ++d0) qr[s][d0] = *(const bf16x8*)(Qw + (size_t)(s * 32 + r32) * INP + d0 * 16 + hi * 8);
    f32x16 o[2][2];
#pragma unroll
    for (int r = 0; r < 16; ++r) { o[0][0][r] = 0.f; o[0][1][r] = 0.f; o[1][0][r] = 0.f; o[1][1][r] = 0.f; }
    float carry[2] = {1.0f, 1.0f}; bool alive[2] = {true, true};
    const int jd = qi;
    const unsigned kvoff = (unsigned)lane * (INP * 2);
    const unsigned vvoff = (unsigned)(lane >> 2) * (INP * 2) + (unsigned)(lane & 3) * 16;
    const unsigned lk = (unsigned)(uintptr_t)wl, lv = lk + 8192;
#define SB_LOAD_K(j) do { const char* kb_ = Kh + (size_t)(j) * 64 * INP * 2; _Pragma("unroll") for (int c_ = 0; c_ < 8; ++c_) SB_DMA(kb_ + c_ * 16, kvoff, lk + c_ * 1024); } while (0)
#define SB_LOAD_V(j) do { const char* vb_ = Vh + (size_t)(j) * 64 * INP * 2; _Pragma("unroll") for (int c_ = 0; c_ < 8; ++c_) SB_DMA(vb_ + (size_t)(c_ & 3) * 16 * INP * 2 + (c_ >> 2) * 64, vvoff, lv + c_ * 1024); } while (0)
    SB_LOAD_K(jd); SB_LOAD_V(jd);
    const LAS unsigned char* kb = wl + hi * 1024 + r32 * 16;
    const LAS unsigned char* vb = wl + 8192 + ((lane >> 4) & 1) * 32 + (lane & 3) * 8 + (4 * hi + ((lane & 15) >> 2)) * 64;
    for (int j = jd; j >= 0; --j) {
        asm volatile("s_waitcnt vmcnt(8)" ::: "memory"); __builtin_amdgcn_sched_barrier(0);
        bf16x8 kf[8];
#pragma unroll
        for (int d0 = 0; d0 < 4; ++d0) { kf[2 * d0] = *(const LAS bf16x8*)(kb + d0 * 2048); kf[2 * d0 + 1] = *(const LAS bf16x8*)(kb + d0 * 2048 + 512); }
        asm volatile("s_waitcnt lgkmcnt(0)" ::: "memory"); __builtin_amdgcn_sched_barrier(0);
        if (j > 0) SB_LOAD_K(j - 1);
        unsigned pw[2][4][4];
#pragma unroll
        for (int s = 0; s < 2; ++s) {
            if (!alive[s]) {
#pragma unroll
                for (int x = 0; x < 4; ++x)
#pragma unroll
                    for (int y = 0; y < 4; ++y) pw[s][x][y] = 0u;
                continue; }
            f32x16 p0, p1;
#pragma unroll
            for (int r = 0; r < 16; ++r) { p0[r] = 0.f; p1[r] = 0.f; }
#pragma unroll
            for (int d0 = 0; d0 < 4; ++d0) { p0 = __builtin_amdgcn_mfma_f32_32x32x16_bf16(kf[2 * d0], qr[s][d0], p0, 0, 0, 0); p1 = __builtin_amdgcn_mfma_f32_32x32x16_bf16(kf[2 * d0 + 1], qr[s][d0], p1, 0, 0, 0); }
            const bool diag = (j == jd); const int kbase = 64 * j + 4 * hi; const int qabs = q0 + s * 32 + r32;
#pragma unroll
            for (int r = 0; r < 16; ++r) { const int k0 = kbase + (r & 3) + 8 * (r >> 2);
                float e0 = __builtin_amdgcn_exp2f(p0[r]), e1 = __builtin_amdgcn_exp2f(p1[r]);
                float r0 = __builtin_amdgcn_rcpf(1.0f + e0), r1 = __builtin_amdgcn_rcpf(1.0f + e1);
                if (diag) { if (k0 >= qabs) r0 = 1.0f; if (k0 + 32 >= qabs) r1 = 1.0f; }
                p0[r] = r0; p1[r] = r1; }
            float sfx[8][3], A[8];
#pragma unroll
            for (int i = 0; i < 8; ++i) { const float x0 = (i < 4) ? p0[4 * i] : p1[4 * i - 16], x1 = (i < 4) ? p0[4 * i + 1] : p1[4 * i - 15], x2 = (i < 4) ? p0[4 * i + 2] : p1[4 * i - 14], x3 = (i < 4) ? p0[4 * i + 3] : p1[4 * i - 13];
                sfx[i][2] = x3; sfx[i][1] = x3 * x2; sfx[i][0] = sfx[i][1] * x1; A[i] = sfx[i][0] * x0; }
            float T = carry[s], E[8];
#pragma unroll
            for (int i = 7; i >= 0; --i) { const auto sw = __builtin_amdgcn_permlane32_swap(__float_as_uint(A[i]), __float_as_uint(A[i]), false, false);
                const float partner = hi ? __uint_as_float(sw[0]) : __uint_as_float(sw[1]);
                E[i] = hi ? T : T * partner; T = T * (A[i] * partner); }
            carry[s] = T;
#pragma unroll
            for (int i = 0; i < 8; ++i) { float w4[4];
#pragma unroll
                for (int jj = 0; jj < 4; ++jj) { const float rv = (i < 4) ? p0[4 * i + jj] : p1[4 * i - 16 + jj]; const float beta = 1.0f - rv;
                    w4[jj] = beta * ((jj == 3) ? E[i] : E[i] * sfx[i][jj]); }
                pw[s][i >> 1][(i & 1) * 2] = pg8::cvt_pk_bf16(w4[0], w4[1]); pw[s][i >> 1][(i & 1) * 2 + 1] = pg8::cvt_pk_bf16(w4[2], w4[3]); }
        }
        if (j > 0) asm volatile("s_waitcnt vmcnt(8)" ::: "memory"); else asm volatile("s_waitcnt vmcnt(0)" ::: "memory");
        __builtin_amdgcn_sched_barrier(0);
        bf16x8 vf[8];
#pragma unroll
        for (int d0 = 0; d0 < 2; ++d0)
#pragma unroll
            for (int ks = 0; ks < 4; ++ks) {
                const s16x4 lo = __builtin_bit_cast(s16x4, __builtin_amdgcn_ds_read_tr16_b64_v4i16((LAS s16x4*)(vb + d0 * 4096 + ks * 1024)));
                const s16x4 hh = __builtin_bit_cast(s16x4, __builtin_amdgcn_ds_read_tr16_b64_v4i16((LAS s16x4*)(vb + d0 * 4096 + ks * 1024 + 512)));
                vf[d0 * 4 + ks] = (bf16x8){lo[0], lo[1], lo[2], lo[3], hh[0], hh[1], hh[2], hh[3]}; }
        asm volatile("s_waitcnt lgkmcnt(0)" ::: "memory"); __builtin_amdgcn_sched_barrier(0);
        const bool a0 = alive[0] && __any(carry[0] != 0.0f), a1 = alive[1] && __any(carry[1] != 0.0f);
        const bool more = (j > 0) && (a0 || a1);
        if (more) SB_LOAD_V(j - 1);
#pragma unroll
        for (int s = 0; s < 2; ++s) { if (!alive[s]) continue;
#pragma unroll
            for (int d0 = 0; d0 < 2; ++d0)
#pragma unroll
                for (int ks = 0; ks < 4; ++ks) { const bf16x8 pa = __builtin_bit_cast(bf16x8, (u32x4){pw[s][ks][0], pw[s][ks][1], pw[s][ks][2], pw[s][ks][3]});
                    o[s][d0] = __builtin_amdgcn_mfma_f32_32x32x16_bf16(pa, vf[d0 * 4 + ks], o[s][d0], 0, 0, 0); } }
        alive[0] = a0; alive[1] = a1;
        if (!more) break;
    }
    asm volatile("s_waitcnt vmcnt(0)" ::: "memory");
    LAS bf16_t* stg = (LAS bf16_t*)wl; const int l2 = pg8::fresh_lane();
#pragma unroll
    for (int s = 0; s < 2; ++s) {
#pragma unroll
        for (int r = 0; r < 16; ++r) { const int orow = crow(r, hi);
#pragma unroll
            for (int d0 = 0; d0 < 2; ++d0) stg[orow * 64 + d0 * 32 + r32] = (bf16_t)f2bf(o[s][d0][r]); }
        LDS_WAIT();
        bf16_t* Ow = MIXED + (rowbase + q0 + s * 32) * D + h * HD;
#pragma unroll
        for (int i = 0; i < 4; ++i) { const int row = i * 8 + (l2 >> 3), ch = l2 & 7; const u32x4 v = *(const LAS u32x4*)(stg + row * 64 + ch * 8);
            pg8::st16<2>(Ow + (size_t)row * D + ch * 8, v); float q = 0.f;
#pragma unroll
            for (int k = 0; k < 4; ++k) { const float a = __builtin_bit_cast(float, v[k] << 16), c = __builtin_bit_cast(float, v[k] & 0xffff0000u); q += a * a + c * c; }
            q += __shfl_xor(q, 1); q += __shfl_xor(q, 2); q += __shfl_xor(q, 4);
            if (ch == 0) ssq_add(SSQSB + rowbase + q0 + s * 32 + row, q); }
        LDS_WAIT();
    }
#undef SB_LOAD_K
#undef SB_LOAD_V
}

__device__ __forceinline__ f32x4 bf_lo(u32x4 v) { return (f32x4){__builtin_bit_cast(float, v.x << 16), __builtin_bit_cast(float, v.y << 16), __builtin_bit_cast(float, v.z << 16), __builtin_bit_cast(float, v.w << 16)}; }
__device__ __forceinline__ f32x4 bf_hi(u32x4 v) { return (f32x4){__builtin_bit_cast(float, v.x & 0xffff0000u), __builtin_bit_cast(float, v.y & 0xffff0000u), __builtin_bit_cast(float, v.z & 0xffff0000u), __builtin_bit_cast(float, v.w & 0xffff0000u)}; }
__device__ __forceinline__ void pool_item(int item, const bf16_t* QKVU, bf16_t* MIXED, int lane) {
    const int t0 = item * 8, tpos0 = t0 & (S - 1); const int g = lane >> 4, win = 2 << g;
    const bf16_t* zp = QKVU + (size_t)(t0 - 15) * INP + 3 * SBW + lane * 8;
    u32x4 v[23];
#pragma unroll
    for (int r = 0; r < 23; ++r) { v[r] = (u32x4){0u, 0u, 0u, 0u}; if (tpos0 - 15 + r >= 0) v[r] = *(const u32x4*)(zp + (size_t)r * INP); }
    f32x4 slo = (f32x4){0.f, 0.f, 0.f, 0.f}, shi = slo;
#pragma unroll
    for (int j = 0; j < 16; ++j) { const float mk = (j < win) ? 1.0f : 0.0f; slo += bf_lo(v[15 - j]) * mk; shi += bf_hi(v[15 - j]) * mk; }
    bf16_t* op = MIXED + (size_t)t0 * D + SBW + lane * 8;
#pragma unroll
    for (int i = 0; i < 8; ++i) {
        if (i > 0) { const u32x4 old = (g == 0) ? v[i + 13] : (g == 1) ? v[i + 11] : (g == 2) ? v[i + 7] : v[i - 1];
            slo += bf_lo(v[15 + i]) - bf_lo(old); shi += bf_hi(v[15 + i]) - bf_hi(old); }
        const int tp1 = tpos0 + i + 1; const float inv = 1.0f / (float)(tp1 < win ? tp1 : win);
        const f32x4 olo = slo * inv - bf_lo(v[15 + i]), ohi = shi * inv - bf_hi(v[15 + i]);
        float q = (olo[0] * olo[0] + olo[1] * olo[1]) + (olo[2] * olo[2] + olo[3] * olo[3]) + (ohi[0] * ohi[0] + ohi[1] * ohi[1]) + (ohi[2] * ohi[2] + ohi[3] * ohi[3]);
        const float rs = 1.0f / sqrtf(wave_sum(q) * (1.0f / PW) + EPS);
        u32x4 w;
#pragma unroll
        for (int k = 0; k < 4; ++k) w[k] = pg8::cvt_pk_bf16(olo[k] * rs, ohi[k] * rs);
        pg8::st16<3>(op + (size_t)i * D, w);
    }
}
__device__ __forceinline__ void p2_mix(const Args& a, LAS unsigned char* lds, int bx, int G, int wid, int lane, ssq_t* SSQSB, int which = 3, int pstop = 9, bf16_t* pool_dst = nullptr, volatile LAS unsigned* stp = nullptr) {
    unsigned char* ws = a.ws; const bf16_t* QKVU = (const bf16_t*)(ws + WS_QKVU); bf16_t* MIXED = (bf16_t*)(ws + WS_MIXED);
    constexpr int NA = B * NH * (S / 512);
    if (which & 1) for (int i = 0; i * G + bx < NA; ++i) { const int w = pg8::xcd_remap(i * G + bx, NA); const int bh = w >> 3, qb = w & 7;
        sb_item(bh >> 3, bh & 7, qb * 8 + wid, QKVU, MIXED, SSQSB, lds + RING_OFF + wid * 16384, lane); }
    if (which & 2) for (int it = bx * NWAVES + wid; it < NTOK / 8; it += G * NWAVES) pool_item(it, QKVU, pool_dst ? pool_dst : MIXED, lane);
}
constexpr size_t BAR_REGION_OFF = 1 * MiB, BAR_REGION_STRIDE = 16 * 1024;
__global__ void __launch_bounds__(NWAVES * 64, 2) mega(Args args) {
    const int li = args.li;
    extern __shared__ __attribute__((aligned(16))) unsigned char lds_raw[];
    LAS unsigned char* lds = (LAS unsigned char*)lds_raw;
    volatile LAS unsigned* MISC = (volatile LAS unsigned*)(lds + MISC_OFF);
    const int wave = __builtin_amdgcn_readfirstlane((int)threadIdx.x >> 6);
#define LANE_ID() ({ int l_; asm volatile("v_mbcnt_lo_u32_b32 %0, -1, 0\n\tv_mbcnt_hi_u32_b32 %0, -1, %0" : "=v"(l_)); l_; })
    const int G = gridDim.x; const int bx = blockIdx.x; const int vcu = (G % 8 == 0) ? (bx % 8) * (G / 8) + bx / 8 : bx;
    for (int u = wave * 64 + LANE_ID(); u < MISC_BYTES / 4; u += NWAVES * 64) MISC[u] = 0u;
    __syncthreads();
    unsigned char* ws = args.ws;
    XcdBarrier bar = xcd_barrier_post((unsigned*)(ws + BAR_REGION_OFF + (size_t)li * BAR_REGION_STRIDE), MISC + 8);
    const int lo = args.ph_lo, hi = args.ph_hi;
    LAS unsigned char* ring = lds + RING_OFF; LAS unsigned char* epi = lds + EPI_OFF; LAS unsigned* gtab = (LAS unsigned*)(lds + GTAB_OFF);
#ifndef TIME_PHASE
#define TIME_PHASE -1
#endif
#define REP_OF(k) ((TIME_PHASE == (k)) ? 2 : 1)
#define REPE_OF(k) ((TIME_PHASE == 20 + (k)) ? 2 : 1)
#define IN(k) (lo <= (k) && (k) < hi)
#ifndef TSK
#define TSK -1
#endif
#ifndef TSCALE
#define TSCALE 1.0f
#endif
#define STAMP(i) do { if (TSK >= 0 && wave == 0) { const unsigned long long t_ = __builtin_amdgcn_s_memrealtime(); MISC[128 + 2 * (i)] = (unsigned)t_; MISC[129 + 2 * (i)] = (unsigned)(t_ >> 32); } } while (0)
#define SEAM(k) do { if (IN(k) && IN((k) + 1)) xcd_barrier(bar); STAMP((k) + 1); } while (0)

    STAMP(0);
    if (IN(0)) { p0_prologue(args, lds, vcu, G, wave, LANE_ID()); if (TIME_PHASE == 0) { xcd_barrier(bar); p0_prologue(args, lds, vcu, G, wave, LANE_ID()); } SEAM(0); }
    if (IN(1)) { SchedP1 S{G, bx, ws}; pg8::EpiBf16S E; pg8::gemm_phase<pg8::EpiBf16S, SchedP1, 0, REP_OF(1), REPE_OF(1)>(wave, ring, epi, gtab, D * 2, D * 2, D / 64, S, E);
        if (G == 256 && bx >= 64) p1_deferred_items(args, lds, bx - 64, wave, LANE_ID());
        else if (G != 256 && bx == 0) { for (int rk = 0; rk < 192; ++rk) p1_deferred_items(args, lds, rk, wave, LANE_ID()); }
        SEAM(1); }
    {
    const float* xin0 = args.in[0]; float* outp = args.out;
    bf16_t* S0p = (bf16_t*)(ws + WS_S0); ssq_t* SSQSBp = (ssq_t*)(ws + MK_SSQSB); ssq_t* SSQ1p = (ssq_t*)(ws + MK_SSQ1); ssq_t* SSQ2p = (ssq_t*)(ws + MK_SSQ2);
    constexpr size_t TSTEP = (size_t)256 * D * 2;
    #if !defined(PH_ONLY) || PH_ONLY == 2
    if (IN(2)) { if (TIME_PHASE == 42) { p2_mix(args, lds, bx, G, wave, LANE_ID(), (ssq_t*)(ws + 1280 * 1024), 2); xcd_barrier(bar); p2_mix(args, lds, bx, G, wave, LANE_ID(), (ssq_t*)(ws + 1280 * 1024), 2); xcd_barrier(bar); }
    if (TIME_PHASE == 2 || TIME_PHASE == 40 || TIME_PHASE == 41) { p2_mix(args, lds, bx, G, wave, LANE_ID(), (ssq_t*)(ws + 1280 * 1024), TIME_PHASE == 40 ? 1 : (TIME_PHASE == 41 ? 2 : 3)); xcd_barrier(bar); } STAMP(20); p2_mix(args, lds, bx, G, wave, LANE_ID(), (ssq_t*)(ws + MK_SSQSB), 1); STAMP(21); p2_mix(args, lds, bx, G, wave, LANE_ID(), (ssq_t*)(ws + MK_SSQSB), 2, 9, nullptr, (TSK >= 30 && bx == 0) ? MISC + 128 + 60 : nullptr); STAMP(22); SEAM(2); STAMP(23); }
#endif

#if !defined(PH_ONLY) || PH_ONLY == 3
    if (IN(3)) { SchedReg S{G, bx, NTOK / 256, D / 256, (const char*)(ws + WS_MIXED), (const char*)(ws + WS_WOUT), TSTEP, TSTEP, nullptr, D, nullptr, nullptr};
        EpiResid<8, true, true> E{nullptr, S0p, ws + WS_X1F8, SSQ1p, SSQSBp, 1.0f}; pg8::gemm_phase<EpiResid<8, true, true>, SchedReg, 0, REP_OF(3)>    (wave, ring, epi, gtab, D * 2, D * 2, D / 64, S, E); SEAM(3); }
#endif
#if !defined(PH_ONLY) || PH_ONLY == 4
    if (IN(4)) { SchedReg S{G, bx, NTOK / 256, D / 256, (const char*)(ws + WS_X1F8), (const char*)(ws + WS_WQ), TSTEP / 2, TSTEP / 2, (bf16_t*)(ws + WS_QM), D, nullptr, nullptr, SSQ1p};
        EpiBf16Ssq E{1.0f / D, C2_MEM / WSCALE}; pg8::gemm_phase<EpiBf16Ssq, SchedReg, 0, REP_OF(4), 1, true>(wave, ring, epi, gtab, D, D, D / 128, S, E); STAMP(5); }
#endif
#if !defined(PH_ONLY) || PH_ONLY == 5
    if (IN(5)) { SchedMS S{G, bx, ws}; EpiSoftmax E; pg8::gemm_phase<EpiSoftmax, SchedMS, 0, REP_OF(5)>(wave, ring, epi, gtab, D * 2, D * 2, MHD / 64, S, E); STAMP(6); }
#endif
#if !defined(PH_ONLY) || PH_ONLY == 6
    if (IN(6)) { SchedPV S{G, bx, ws}; pg8::EpiBf16S E; pg8::gemm_phase<pg8::EpiBf16S, SchedPV, 0, REP_OF(6)>(wave, ring, epi, gtab, D * 2, NMEM * 2, NMEM / 64, S, E); SEAM(6); }
#endif
#if !defined(PH_ONLY) || PH_ONLY == 7
    if (IN(7)) { SchedReg S{G, bx, NTOK / 256, D / 256, (const char*)(ws + WS_OM), (const char*)(ws + WS_WO), TSTEP, TSTEP, nullptr, D, nullptr, nullptr};
        EpiResid<-1, true, true> E{nullptr, S0p, ws + WS_X2F8, SSQ2p, nullptr, 1.0f}; pg8::gemm_phase<EpiResid<-1, true, true>, SchedReg, 0, REP_OF(7)>(wave, ring, epi, gtab, D * 2, D * 2, D / 64, S, E); SEAM(7); }
#endif
#if !defined(PH_ONLY) || PH_ONLY == 8
    if (IN(8)) { if (TIME_PHASE == 8) { p8_route(args, lds, bx, G, wave, LANE_ID(), (int*)(ws + 1536 * 1024)); xcd_barrier(bar); } p8_route(args, lds, bx, G, wave, LANE_ID(), (int*)(ws + OFF_CNT)); SEAM(8); }
#endif
#if !defined(PH_ONLY) || PH_ONLY == 9
    if (IN(9)) { moe_table(args, MISC, wave * 64 + LANE_ID()); SchedMoE<8, true> S{G, bx, ws, MISC, args.in[18]}; EpiSwiGLU E{ws + WS_ACT};
        pg8::gemm_phase<EpiSwiGLU, SchedMoE<8, true>, 1, REP_OF(9), REPE_OF(9), true>(wave, ring, epi, gtab, D, D, D / 128, S, E); SEAM(9); }
#endif
#if !defined(PH_ONLY) || PH_ONLY == 10
    if (IN(10)) { moe_table(args, MISC, wave * 64 + LANE_ID()); SchedMoE<4, false> S{G, bx, ws, MISC, args.in[20]}; EpiW2 E{ws + WS_Y};
        pg8::gemm_phase<EpiW2, SchedMoE<4, false>, 2, REP_OF(10), REPE_OF(10), true>(wave, ring, epi, gtab, DFF, DFF, DFF / 128, S, E); SEAM(10); }
#endif
#if !defined(PH_ONLY) || PH_ONLY == 11
    if (IN(11)) { if (TIME_PHASE == 11) { p11_final(args, vcu, G, wave, LANE_ID(), (float*)(ws + WS_ACT)); xcd_barrier(bar); } p11_final(args, vcu, G, wave, LANE_ID(), args.out); }
#endif
}

    if (TSK >= 100) { __syncthreads(); float* dbg = (float*)(ws + 1792 * 1024);
        if (wave == 0 && LANE_ID() == 0) { const int a_ = (TSK >= 200) ? 21 : 20; const unsigned long long t0 = ((unsigned long long)MISC[129 + 2 * a_] << 32) | MISC[128 + 2 * a_], t1 = ((unsigned long long)MISC[131 + 2 * a_] << 32) | MISC[130 + 2 * a_];
            __hip_atomic_store(dbg + bx, (float)(t1 - t0) * 0.01f, __ATOMIC_RELAXED, __HIP_MEMORY_SCOPE_AGENT); }
        xcd_barrier(bar);
        if (bx == 0 && wave == 0) { const int l_ = LANE_ID(); float mx = 0.f, mn = 1e9f; for (int q = l_; q < G; q += 64) { const float v = __hip_atomic_load(dbg + q, __ATOMIC_RELAXED, __HIP_MEMORY_SCOPE_AGENT); mx = fmaxf(mx, v); mn = fminf(mn, v); }
            for (int o_ = 1; o_ < 64; o_ <<= 1) { mx = fmaxf(mx, __shfl_xor(mx, o_)); mn = fminf(mn, __shfl_xor(mn, o_)); }
            if (l_ == 0) { asm volatile("s_waitcnt vmcnt(0)" ::: "memory"); args.out[0] = ((TSK % 100) == 0 ? mx : mn) * TSCALE; } } }
    else if (TSK >= 0) { STAMP(12); __syncthreads(); if (bx == 0 && wave == 0 && LANE_ID() == 0) { asm volatile("s_waitcnt vmcnt(0)" ::: "memory");
        const unsigned long long t0 = ((unsigned long long)MISC[129 + 2 * TSK] << 32) | MISC[128 + 2 * TSK], t1 = ((unsigned long long)MISC[131 + 2 * TSK] << 32) | MISC[130 + 2 * TSK];
        args.out[0] = (float)(t1 - t0) * 0.01f * TSCALE; } }
    if (TIME_PHASE == 12) { for (int q = 0; q < 10; ++q) xcd_barrier(bar); }
#undef IN
#undef SEAM
}
}

extern "C" void kernel_launch(void* const* d_in, const int* in_sizes, int n_in, void* d_out, int out_size, void* d_ws, size_t ws_size, hipStream_t stream) {
    if (n_in != 22 || out_size != NTOK * D || ws_size < WS_END) { fprintf(stderr, "kernel_launch: unexpected shapes (n_in %d out %d ws %zu)\n", n_in, out_size, ws_size); return; }
    static int grid = 0;
    if (grid == 0) {
        int dev = 0, cus = 0;
        if (hipGetDevice(&dev) != hipSuccess || hipDeviceGetAttribute(&cus, hipDeviceAttributeMultiprocessorCount, dev) != hipSuccess) { grid = -1; return; }
        if (hipFuncSetAttribute((const void*)mk::mega, hipFuncAttributeMaxDynamicSharedMemorySize, mk::LDS_BYTES) != hipSuccess) { fprintf(stderr, "kernel_launch: hipFuncSetAttribute failed\n"); grid = -1; return; }
        int per_cu = 0; (void)hipOccupancyMaxActiveBlocksPerMultiprocessor(&per_cu, (const void*)mk::mega, mk::NWAVES * 64, mk::LDS_BYTES); (void)hipGetLastError();
        if (per_cu < 1) fprintf(stderr, "kernel_launch: occupancy query reports %d blocks per CU\n", per_cu);
        grid = cus;
    }
    if (grid < 0) return;
    (void)hipMemsetAsync((unsigned char*)d_ws + WS_CTL, 0, CTL_BYTES, stream);
    mk::Args a{}; for (int i = 0; i < 22; ++i) a.in[i] = (const float*)d_in[i]; a.out = (float*)d_out; a.ws = (unsigned char*)d_ws;
    a.ph_lo = 0; a.ph_hi = mk::NPHASE; a.li = 0;
    hipLaunchKernelGGL(mk::mega, dim3(grid), dim3(mk::NWAVES * 64), mk::LDS_BYTES, stream, a);
}
```

```cpp
#include <hip/hip_runtime.h>
#include <cstdio>
#include <cstdint>

typedef unsigned short bf16_t;
typedef short bf16x8 __attribute__((ext_vector_type(8)));
typedef float f32x4 __attribute__((ext_vector_type(4)));
typedef unsigned u32x4 __attribute__((ext_vector_type(4)));

namespace cfg {
constexpr int B = 8, S = 4096, D = 1024, NTOK = B * S;
constexpr int SBW = 512, NH = 8, HD = 64, PW = 512, PG = 4, PGD = 128, INP = 2048;
constexpr int NMEM = 256, MH = 4, MHD = 256, NMROWS = B * NMEM;
constexpr int NE = 32, TOPK = 4, DFF = 1024, LCAP = NTOK;
constexpr float EPS = 1e-5f, LOG2E = 1.4426950408889634f;
constexpr float C2_SB = 0.125f * LOG2E, C2_MEM = 0.0625f * LOG2E;
constexpr float SW_LIMIT = 7.0f, SW_ALPHA = 1.702f;
constexpr int MAXTILES = 544;
constexpr size_t MiB = 1u << 20;
constexpr size_t WS_CTL = 0, CTL_BYTES = 2 * MiB;
constexpr size_t OFF_CNT = 64 * 1024, OFF_SSQSB = 512 * 1024, OFF_SSQ1 = 640 * 1024, OFF_SSQ2 = 768 * 1024;
constexpr size_t WS_WIN = 2 * MiB, WS_WOUT = 6 * MiB, WS_WQ = 8 * MiB, WS_WKV = 10 * MiB, WS_WO = 14 * MiB, WS_WP = 16 * MiB, WS_WR = 17 * MiB;
constexpr size_t WS_RSTDX = 18 * MiB, WS_RSTDM = 18 * MiB + 512 * 1024;
constexpr size_t WS_W1 = 20 * MiB, WS_W2 = 148 * MiB;
constexpr size_t WS_S0 = 212 * MiB;
constexpr size_t WS_QKVU = 276 * MiB;
constexpr size_t WS_QM = 276 * MiB, WS_OM = 340 * MiB;
constexpr size_t WS_MIXED = 404 * MiB;
constexpr size_t WS_PM = 404 * MiB;
constexpr size_t WS_ACT = 276 * MiB;
constexpr size_t WS_KM = 548 * MiB, WS_VMT = 552 * MiB, WS_MEMB = 556 * MiB, WS_LSLOT = 560 * MiB, WS_LGATE = 564 * MiB;
constexpr size_t WS_Y = 568 * MiB;
constexpr size_t WS_SCR_S = 568 * MiB, WS_SCR_POOLED = 696 * MiB, WS_SCR_POOLO = 728 * MiB;
constexpr size_t WS_END = 824 * MiB;
}
using namespace cfg;

__device__ __forceinline__ unsigned f2bf(float f) { unsigned u = __builtin_bit_cast(unsigned, f); return (u + 0x7fffu + ((u >> 16) & 1u)) >> 16; }
__device__ __forceinline__ float bf2f(bf16_t h) { return __builtin_bit_cast(float, (unsigned)h << 16); }
__device__ __forceinline__ float wave_sum(float v) {
#pragma unroll
    for (int o = 1; o < 64; o <<= 1) v += __shfl_xor(v, o);
    return v;
}


#define LAS __attribute__((address_space(3)))
#define GAS __attribute__((address_space(1)))
typedef int v4i_t __attribute__((ext_vector_type(4)));
typedef int v8i_t __attribute__((ext_vector_type(8)));
namespace pg8 {
constexpr int BM = 256, BK = 64, HALF = 128, HTB = HALF * BK * 2, STAGE_BYTES = 8 * HTB, NXCD = 8, WGM = 8;
__host__ __device__ __forceinline__ int lds_byte(int r, int c) { const int st = (r >> 4) * 2 + (c >> 5), rr = r & 15, cc = c & 31, ob = rr * 64 + cc * 2; return st * 1024 + (ob ^ (((ob >> 9) & 1) << 5)); }
__host__ __device__ __forceinline__ void stage_rc(int b, int& R, int& C) { const int st = b / 1024, sb = b % 1024, swz = sb ^ (((sb >> 9) & 1) << 5); R = (st >> 1) * 16 + swz / 64; C = (st & 1) * 32 + (swz % 64) / 2; }
__host__ __device__ __forceinline__ int perm32(int rho) { const int n = rho >> 4, i = rho & 15; return 8 * (i >> 2) + 4 * n + (i & 3); }
__device__ __forceinline__ unsigned cvt_pk_bf16(float lo, float hi) { unsigned r; asm volatile("v_cvt_pk_bf16_f32 %0, %1, %2" : "=v"(r) : "v"(lo), "v"(hi)); return r; }

#define WTMASK 0x008
#ifndef WTMASK
#define WTMASK 0x1ff
#endif
#define WT_ON(bit) (((WTMASK) >> (bit)) & 1)
__device__ __forceinline__ void st16_wt(void* p, u32x4 v) { asm volatile("global_store_dwordx4 %0, %1, off sc1\n\ts_nop 1" :: "v"(p), "v"(v)); }
__device__ __forceinline__ void st16_wt(void* p, f32x4 v) { asm volatile("global_store_dwordx4 %0, %1, off sc1\n\ts_nop 1" :: "v"(p), "v"(v)); }
template <int BIT, class V> __device__ __forceinline__ void st16(void* p, V v) { if constexpr (WT_ON(BIT)) st16_wt(p, v); else *(V*)p = v; }
#ifndef WT8
#define WT8 0
#endif
__device__ __forceinline__ void st8_wt(void* p, unsigned long long v) { if (WT8) __hip_atomic_store((unsigned long long*)p, v, __ATOMIC_RELAXED, __HIP_MEMORY_SCOPE_AGENT); else *(unsigned long long*)p = v; }
__device__ __forceinline__ void st4_wt(void* p, unsigned v) { if (WT8) __hip_atomic_store((unsigned*)p, v, __ATOMIC_RELAXED, __HIP_MEMORY_SCOPE_AGENT); else *(unsigned*)p = v; }
__device__ __forceinline__ int fresh_lane() { int l; asm volatile("v_mbcnt_lo_u32_b32 %0, -1, 0\n\tv_mbcnt_hi_u32_b32 %0, -1, %0" : "=v"(l)); return l; }
struct Unit { const char* A; const char* B; void* p0; void* p1; void* p2; void* p3; int pm, pn, i0, i1, ghost; };

__device__ __forceinline__ int xcd_remap(int L, int nwg) { const int q = nwg / NXCD, r = nwg % NXCD, xcd = L % NXCD, off = L / NXCD; return __builtin_amdgcn_readfirstlane((xcd < r ? xcd * (q + 1) : r * (q + 1) + (xcd - r) * q) + off); }
__device__ __forceinline__ void grouped_mn(int wgid, int nM, int nN, int& pm, int& pn) {
    const int nig = WGM * nN, gid = wgid / nig, fm = gid * WGM, gsz = (nM - fm) < WGM ? (nM - fm) : WGM; pm = __builtin_amdgcn_readfirstlane(fm + ((wgid % nig) % gsz)); pn = __builtin_amdgcn_readfirstlane((wgid % nig) / gsz); }

template <class Epi, class Sched, int TABS, int REP = 1  , int REPE = 1, bool F8 = false>
__device__ __forceinline__ void gemm_phase(const int wid, LAS unsigned char* lds, LAS unsigned char* epi_lds, LAS unsigned* gtab, const int lda_b, const int ldb_b, const int nt, const Sched& S, const Epi& E) {
    constexpr bool GATHER = (TABS == 1);
    const int wr = wid >> 2, wc = wid & 3;
    unsigned voffA, voffB, voffG[2][2]; int aoff, boff;
    { const int lane = fresh_lane(); int R, C; stage_rc(wid * 1024 + lane * 16, R, C); const int Rb = Epi::PERM ? ((R & ~31) + perm32(R & 31)) : R;
      voffA = (unsigned)(R * lda_b + C * 2); voffB = (unsigned)(Rb * ldb_b + C * 2); voffG[0][0] = voffG[0][1] = voffG[1][0] = voffG[1][1] = 0;
      aoff = lds_byte(wr * 64 + (lane & 15), (lane >> 4) * 8); boff = lds_byte(wc * 32 + (lane & 15), (lane >> 4) * 8); }
    const size_t kstep = (size_t)(BK * 2);
    const size_t hstepA = (size_t)HALF * lda_b, hstepB = (size_t)HALF * ldb_b;
    const unsigned ldsw = (unsigned)wid * 1024u; const unsigned ldsbase = (unsigned)(uintptr_t)lds + ldsw;
#define PG8_SA(b, h) (((b) * 2 + (h)) * HTB)
#define PG8_SB(b, h) ((4 + (b) * 2 + (h)) * HTB)
#define PG8_GLDS(ugp, voff, bufoff, _i) do { unsigned _keep; asm volatile("s_mov_b32 %0, m0\n\ts_mov_b32 m0, %3\n\ts_nop 0\n\tglobal_load_lds_dwordx4 %1, %2\n\ts_mov_b32 m0, %0" \
        : "=&s"(_keep) : "v"(voff), "s"((const char*)(ugp)), "s"(ldsbase + (unsigned)((bufoff) + (_i) * 8192)) : "memory"); } while (0)
#define PG8_STAGE_B(bufoff, gbase) do { _Pragma("unroll") for (int _i = 0; _i < 2; ++_i) PG8_GLDS((const char*)(gbase) + (size_t)_i * 64 * ldb_b, voffB, bufoff, _i); } while (0)
#define PG8_STAGE_A(bufoff, gbase, h) do { if constexpr (GATHER) { _Pragma("unroll") for (int _i = 0; _i < 2; ++_i) PG8_GLDS((const char*)(gbase), voffG[h][_i], bufoff, _i); } \
        else { _Pragma("unroll") for (int _i = 0; _i < 2; ++_i) PG8_GLDS((const char*)(gbase) + (h) * hstepA + (size_t)_i * 64 * lda_b, voffA, bufoff, _i); } } while (0)
#define PG8_LDA(dst, b, h) do { _Pragma("unroll") for (int m = 0; m < 4; ++m) _Pragma("unroll") for (int k = 0; k < 2; ++k) dst[m][k] = *(const LAS bf16x8*)(lds + PG8_SA(b, h) + aoff + m * 2048 + k * 1024); } while (0)
#define PG8_LDB(dst, b, h) do { _Pragma("unroll") for (int n = 0; n < 2; ++n) _Pragma("unroll") for (int k = 0; k < 2; ++k) dst[n][k] = *(const LAS bf16x8*)(lds + PG8_SB(b, h) + boff + n * 2048 + k * 1024); } while (0)
#define PG8_CAT(x0, x1) __builtin_shufflevector(__builtin_bit_cast(v4i_t, x0), __builtin_bit_cast(v4i_t, x1), 0, 1, 2, 3, 4, 5, 6, 7)
#define PG8_MMA(ai, bj, At, Bt) do { __builtin_amdgcn_s_setprio(1); _Pragma("unroll") for (int m = 0; m < 4; ++m) _Pragma("unroll") for (int n = 0; n < 2; ++n) { \
        if constexpr (F8) acc[ai][bj][m][n] = __builtin_amdgcn_mfma_scale_f32_16x16x128_f8f6f4(PG8_CAT(Bt[n][0], Bt[n][1]), PG8_CAT(At[m][0], At[m][1]), acc[ai][bj][m][n], 0, 0, 0, 0, 0, 0); \
        else { _Pragma("unroll") for (int k = 0; k < 2; ++k) acc[ai][bj][m][n] = __builtin_amdgcn_mfma_f32_16x16x32_bf16(Bt[n][k], At[m][k], acc[ai][bj][m][n], 0, 0, 0); } } __builtin_amdgcn_s_setprio(0); } while (0)
#define PG8_WAIT_V(n) asm volatile("s_waitcnt vmcnt(" #n ")" ::: "memory")
#define PG8_WAIT_L(n) asm volatile("s_waitcnt lgkmcnt(" #n ")" ::: "memory")
#define PG8_BAR __builtin_amdgcn_s_barrier()
#define PG8_SCHED __builtin_amdgcn_sched_barrier(0)
#define PG8_GTAB_LOAD(buf, nvalid) do { const int _l = fresh_lane(); int _R, _C; stage_rc(wid * 1024 + _l * 16, _R, _C); _Pragma("unroll") for (int _h = 0; _h < 2; ++_h) _Pragma("unroll") for (int _i = 0; _i < 2; ++_i) { \
        const int _row = _h * HALF + _R + 64 * _i; const unsigned _s = gtab[(buf) * 768 + _row]; voffG[_h][_i] = ((_row < (nvalid)) ? (_s >> 2) * (unsigned)lda_b : 0u) + (unsigned)(_C * 2); } } while (0)
#define PG8_GTAB_DMA(buf, U) do { if constexpr (TABS == 3) { if (wid == 1 || wid == 2) { const char* _b = (wid == 1) ? (const char*)(U).p1 : (const char*)(U).p2;     \
            if (_b) __builtin_amdgcn_global_load_lds((const unsigned*)(_b + fresh_lane() * 16), (LAS unsigned*)(gtab + (buf) * 768 + wid * 256), 16, 0, 0); } } \
        else if (wid < 3) { const int _l = fresh_lane(); const char* _src = (wid == 0) ? (const char*)(U).p3 + _l * 16 : (wid == 1) ? (const char*)(U).p2 + _l * 16 : \
            (TABS == 1 ? (const char*)(U).p1 + (_l & 31) * 16 + (_l >> 5) * (DFF * 4) : (const char*)(U).p1 + _l * 16); \
        __builtin_amdgcn_global_load_lds((const unsigned*)_src, (LAS unsigned*)(gtab + (buf) * 768 + wid * 256), 16, 0, 0); } } while (0)
    auto nextu = [&](int i, Unit& u) -> bool { if constexpr (REP > 1) { const bool ok = S.next(i / REP, u); u.ghost = (i % REP) != REP - 1; return ok; } else { u.ghost = 0; return S.next(i, u); } };
    Unit cur, nxt; int ui = 0;
    if (!nextu(0, cur)) return;
    f32x4 acc[2][2][4][2];
#pragma unroll
    for (int a = 0; a < 2; ++a)
#pragma unroll
        for (int b = 0; b < 2; ++b)
#pragma unroll
            for (int m = 0; m < 4; ++m)
#pragma unroll
                for (int n = 0; n < 2; ++n) acc[a][b][m][n] = (f32x4){0.f, 0.f, 0.f, 0.f};
    bf16x8 At[4][2], B0[2][2], B1[2][2];
    const char* cA = cur.A; const char* cB = cur.B;
    if constexpr (TABS != 0) { PG8_GTAB_DMA(0, cur); PG8_WAIT_V(0); PG8_WAIT_L(0); PG8_BAR; if constexpr (GATHER) PG8_GTAB_LOAD(0, cur.i0); }
    PG8_STAGE_B(PG8_SB(0, 0), cB); PG8_STAGE_B(PG8_SB(0, 1), cB + hstepB); PG8_STAGE_A(PG8_SA(0, 0), cA, 0); PG8_STAGE_A(PG8_SA(0, 1), cA, 1);
    if (wr == 1) PG8_BAR;
    PG8_WAIT_V(2); PG8_BAR;
    PG8_STAGE_B(PG8_SB(1, 0), cB + kstep); PG8_STAGE_A(PG8_SA(1, 0), cA + kstep, 0); PG8_STAGE_B(PG8_SB(1, 1), cB + hstepB + kstep);
    PG8_WAIT_V(6); PG8_BAR;
    for (;;) {
        const bool has_next = nextu(ui + 1, nxt);
        const char* nA = has_next ? nxt.A : cA; const char* nB = has_next ? nxt.B : cB;
#pragma unroll 1
        for (int t = 0; t < nt; t += 2) {
            const bool last = (t == nt - 2);
            const char* a1 = cA + (size_t)(t + 1) * kstep;
            const char* a2 = last ? nA : cA + (size_t)(t + 2) * kstep; const char* b2 = last ? nB : cB + (size_t)(t + 2) * kstep;
            const char* a3 = a2 + kstep; const char* b3 = b2 + kstep;
            if constexpr (Epi::MIDK >= 0) { if (t == Epi::MIDK) E.midk(acc, cur, wr, fresh_lane() & 15); }
            if constexpr (TABS != 0) { if (t == 2 && has_next) PG8_GTAB_DMA((ui + 1) & 1, nxt); }
            if constexpr (GATHER) { PG8_STAGE_A(PG8_SA(1, 1), a1, 1); if (last && has_next) PG8_GTAB_LOAD((ui + 1) & 1, nxt.i0); PG8_SCHED; }
            PG8_LDB(B0, 0, 0); PG8_LDB(B1, 0, 1); PG8_SCHED; PG8_LDA(At, 0, 0); if constexpr (!GATHER) PG8_STAGE_A(PG8_SA(1, 1), a1, 1);
            PG8_WAIT_V(8); PG8_WAIT_L(0); PG8_BAR; PG8_MMA(0, 0, At, B0); PG8_MMA(0, 1, At, B1); PG8_BAR; PG8_SCHED;
            PG8_LDA(At, 0, 1); PG8_STAGE_B(PG8_SB(0, 0), b2); PG8_STAGE_B(PG8_SB(0, 1), b2 + hstepB); PG8_STAGE_A(PG8_SA(0, 0), a2, 0);
            PG8_WAIT_V(8); PG8_WAIT_L(0); PG8_BAR; PG8_MMA(1, 0, At, B0); PG8_MMA(1, 1, At, B1); PG8_BAR; PG8_SCHED;
            PG8_LDB(B0, 1, 0); PG8_LDB(B1, 1, 1); PG8_SCHED; PG8_LDA(At, 1, 0); PG8_STAGE_A(PG8_SA(0, 1), a2, 1);
            PG8_WAIT_V(8); PG8_WAIT_L(0); PG8_BAR; PG8_MMA(0, 0, At, B0); PG8_MMA(0, 1, At, B1); PG8_BAR; PG8_SCHED;
            PG8_LDA(At, 1, 1); PG8_STAGE_B(PG8_SB(1, 0), b3); PG8_STAGE_B(PG8_SB(1, 1), b3 + hstepB); PG8_STAGE_A(PG8_SA(1, 0), a3, 0);
            PG8_WAIT_V(8); PG8_WAIT_L(0); PG8_BAR; PG8_MMA(1, 0, At, B0); PG8_MMA(1, 1, At, B1); PG8_BAR; PG8_SCHED;
        }
        if (wr == 0) PG8_BAR;
        if (!cur.ghost) { const int el = fresh_lane(); LAS unsigned char* ex = (TABS != 0) ? (LAS unsigned char*)(gtab + (ui & 1) * 768) : epi_lds; E(acc, cur, wr, wc, el & 15, el >> 4, wid, el, ex); if constexpr (REPE > 1) { asm volatile("" ::: "memory"); E(acc, cur, wr, wc, el & 15, el >> 4, wid, el, ex); } }
        if (!has_next) break;
#pragma unroll
        for (int a = 0; a < 2; ++a)
#pragma unroll
            for (int b = 0; b < 2; ++b)
#pragma unroll
                for (int m = 0; m < 4; ++m)
#pragma unroll
                    for (int n = 0; n < 2; ++n) acc[a][b][m][n] = (f32x4){0.f, 0.f, 0.f, 0.f};
        cur = nxt; cA = nA; cB = nB; ++ui;
        if (wr == 1) PG8_BAR;
    }
    PG8_WAIT_V(0);
    PG8_BAR;
#undef PG8_SA
#undef PG8_SB
#undef PG8_GLDS
#undef PG8_STAGE_A
#undef PG8_STAGE_B
#undef PG8_LDA
#undef PG8_LDB
#undef PG8_MMA
#undef PG8_CAT
#undef PG8_WAIT_V
#undef PG8_WAIT_L
#undef PG8_BAR
#undef PG8_SCHED
#undef PG8_GTAB_LOAD
#undef PG8_GTAB_DMA
}

template <bool F8O> struct EpiBf16SX {
    static constexpr bool PERM = true; static constexpr int MIDK = -1;
    __device__ __forceinline__ void midk(f32x4 (&)[2][2][4][2], const Unit&, int, int) const {}
    __device__ __forceinline__ void operator()(const f32x4 (&acc)[2][2][4][2], const Unit& u, int wr, int wc, int fr, int fq, int, int, LAS unsigned char*) const {
        bf16_t* O = (bf16_t*)u.p0; unsigned char* O8 = (unsigned char*)u.p0; const float* rs = (const float*)u.p1; const float* cs = (const float*)u.p2; const int ldc = u.i0;
        int r0 = wr * 64 + fr, c0 = wc * 32 + 8 * fq; asm volatile("" : "+v"(r0), "+v"(c0));
        f32x4 cv[2][2];
#pragma unroll
        for (int bj = 0; bj < 2; ++bj)
#pragma unroll
            for (int n = 0; n < 2; ++n) cv[bj][n] = cs ? *(const f32x4*)(cs + c0 + bj * HALF + 4 * n) : (f32x4){1.f, 1.f, 1.f, 1.f};
#pragma unroll
        for (int ai = 0; ai < 2; ++ai)
#pragma unroll
            for (int m = 0; m < 4; ++m) { const int r = r0 + ai * HALF + m * 16; const float rv = rs ? rs[r] : 1.f; bf16_t* rowp = O + (size_t)r * ldc + c0;
#pragma unroll
                for (int bj = 0; bj < 2; ++bj) { const f32x4 v0 = acc[ai][bj][m][0] * cv[bj][0] * rv, v1 = acc[ai][bj][m][1] * cv[bj][1] * rv;
                    if constexpr (F8O) { int w0 = __builtin_amdgcn_cvt_pk_fp8_f32(v0[0], v0[1], 0, false); w0 = __builtin_amdgcn_cvt_pk_fp8_f32(v0[2], v0[3], w0, true); int w1 = __builtin_amdgcn_cvt_pk_fp8_f32(v1[0], v1[1], 0, false); w1 = __builtin_amdgcn_cvt_pk_fp8_f32(v1[2], v1[3], w1, true);
                        st8_wt(O8 + (size_t)r * ldc + c0 + bj * HALF, (unsigned long long)(unsigned)w0 | ((unsigned long long)(unsigned)w1 << 32)); }
                    else { u32x4 w; w.x = cvt_pk_bf16(v0[0], v0[1]); w.y = cvt_pk_bf16(v0[2], v0[3]); w.z = cvt_pk_bf16(v1[0], v1[1]); w.w = cvt_pk_bf16(v1[2], v1[3]);
                    st16<1>(rowp + bj * HALF, w); } } }
    }
};
typedef EpiBf16SX<false> EpiBf16S;
struct EpiBf16T {
    static constexpr bool PERM = true; static constexpr int MIDK = -1;
    __device__ __forceinline__ void midk(f32x4 (&)[2][2][4][2], const Unit&, int, int) const {}
    __device__ __forceinline__ void operator()(const f32x4 (&acc)[2][2][4][2], const Unit& u, int wr, int wc, int fr, int fq, int, int, LAS unsigned char* tab) const {
        bf16_t* O = (bf16_t*)u.p0; const bool has_rs = u.p1 != nullptr, has_cs = u.p2 != nullptr; const int ldc = u.i0;
        const LAS float* T1 = (const LAS float*)tab + 256; const LAS float* T2 = (const LAS float*)tab + 512;
        int r0 = wr * 64 + fr, c0 = wc * 32 + 8 * fq; asm volatile("" : "+v"(r0), "+v"(c0));
        f32x4 cv[2][2];
#pragma unroll
        for (int bj = 0; bj < 2; ++bj)
#pragma unroll
            for (int n = 0; n < 2; ++n) cv[bj][n] = has_cs ? *(const LAS f32x4*)(T2 + c0 + bj * HALF + 4 * n) : (f32x4){1.f, 1.f, 1.f, 1.f};
#pragma unroll
        for (int ai = 0; ai < 2; ++ai)
#pragma unroll
            for (int m = 0; m < 4; ++m) { const int r = r0 + ai * HALF + m * 16; const float rv = has_rs ? T1[r] : 1.f; bf16_t* rowp = O + (size_t)r * ldc + c0;
#pragma unroll
                for (int bj = 0; bj < 2; ++bj) { const f32x4 v0 = acc[ai][bj][m][0] * cv[bj][0] * rv, v1 = acc[ai][bj][m][1] * cv[bj][1] * rv;
                    u32x4 w; w.x = cvt_pk_bf16(v0[0], v0[1]); w.y = cvt_pk_bf16(v0[2], v0[3]); w.z = cvt_pk_bf16(v1[0], v1[1]); w.w = cvt_pk_bf16(v1[2], v1[3]);
                    st16<1>(rowp + bj * HALF, w); } }
    }
};
}

namespace mk {
constexpr int NWAVES = 8, NPHASE = 12;
constexpr int RING_OFF = 0, RING_BYTES = 131072, EPI_OFF = 131072, EPI_BYTES = 8192, GTAB_OFF = EPI_OFF + EPI_BYTES, GTAB_BYTES = 6144, MISC_OFF = GTAB_OFF + GTAB_BYTES, MISC_BYTES = 1024;
constexpr int LDS_BYTES = 147456;
static_assert(MISC_OFF + MISC_BYTES <= LDS_BYTES, "LDS map");
constexpr size_t WS_LRS = 84 * MiB;
constexpr size_t WS_X2F8 = WS_Y, WS_X1F8 = WS_Y + 32 * MiB;
constexpr size_t WS_CSG1 = 19 * MiB, WS_WRH = 19 * MiB + 64 * 1024, WS_WRL = 19 * MiB + 128 * 1024;
typedef unsigned ssq_t;
constexpr size_t MK_SSQSB = 256 * 1024, MK_SSQ1 = 512 * 1024, MK_SSQ2 = 768 * 1024;
__device__ __forceinline__ void ssq_add(ssq_t* p, float q) { (void)__hip_atomic_fetch_add(p, (ssq_t)__float2uint_rn(q * 16384.0f), __ATOMIC_RELAXED, __HIP_MEMORY_SCOPE_AGENT); }
__device__ __forceinline__ float ssq_get(const ssq_t* p) { return (float)(*p) * (1.0f / 16384.0f); }
constexpr float WSCALE = 32.0f;
constexpr int P0_DEFER = 192 * 8 * 6;
constexpr int CW_BAR = 1024;

#define RLX_AGENT __ATOMIC_RELAXED, __HIP_MEMORY_SCOPE_AGENT
#define LDS_WAIT() asm volatile("s_waitcnt lgkmcnt(0)" ::: "memory")
#define VM_WAIT() asm volatile("s_waitcnt vmcnt(0)" ::: "memory")
#define XB_TMO      128
#define XB_XCNT(j)  (256  + 64 * (j))
#define XB_XSUB(j)  (1280 + 64 * (j))
#define XB_XGEN(j)  (2304 + 64 * (j))
#define XB_TOP      3328
#define XB_TOPGEN   3392
#define XCD_BAR_WORDS 3456
#define XB_SPIN_CAP (1u << 20)
__device__ __forceinline__ unsigned xb_ld(unsigned* p)              { return __hip_atomic_load(p, __ATOMIC_RELAXED, __HIP_MEMORY_SCOPE_AGENT); }
__device__ __forceinline__ unsigned xb_add(unsigned* p, unsigned v) { return __hip_atomic_fetch_add(p, v, __ATOMIC_RELAXED, __HIP_MEMORY_SCOPE_AGENT); }
__device__ __forceinline__ unsigned xb_xcc_id() { return (unsigned)__builtin_amdgcn_s_getreg((3 << 11) | 20) & 0xFu; }
#define XB_SPIN(cond, bar) do { unsigned _sp = 0; while (cond) { __builtin_amdgcn_s_sleep(1); \
    if ((++_sp & 255u) == 0u) { if (xb_ld(&(bar)[XB_TMO])) break; if (_sp > XB_SPIN_CAP) { atomicAdd(&(bar)[XB_TMO], 1u); break; } } } } while (0)
struct XcdBarrier { unsigned* bar; unsigned x; volatile LAS unsigned* st; };
__device__ __forceinline__ XcdBarrier xcd_barrier_post(unsigned* bar, volatile LAS unsigned* st) {
    XcdBarrier b; b.bar = bar; b.x = xb_xcc_id(); b.st = st;
    if (threadIdx.x == 0) (void)xb_add(&bar[XB_XCNT(b.x)], 1u);
    return b;
}
__device__ __forceinline__ void xcd_barrier_complete(unsigned* bar, unsigned x, unsigned& nloc, unsigned& nx) {
    const unsigned G = gridDim.x * gridDim.y * gridDim.z;
    unsigned sum, cnt, mine, sp = 0u;
    for (;;) {
        sum = 0u; cnt = 0u; mine = 0u;
#pragma unroll
        for (unsigned j = 0; j < 16; ++j) { const unsigned c = xb_ld(&bar[XB_XCNT(j)]); sum += c; cnt += (c > 0u) ? 1u : 0u; mine = (j == x) ? c : mine; }
        if (sum == G) break;
        __builtin_amdgcn_s_sleep(1);
        if ((++sp & 255u) == 0u) { if (xb_ld(&bar[XB_TMO])) break; if (sp > XB_SPIN_CAP) { atomicAdd(&bar[XB_TMO], 1u); break; } }
    }
    nloc = mine > 0u ? mine : 1u; nx = cnt > 0u ? cnt : 1u;
}
__device__ __forceinline__ void xcd_barrier(const XcdBarrier& b) {
    asm volatile("s_waitcnt vmcnt(0)" ::: "memory");
    __syncthreads();
    if (threadIdx.x == 0) {
        unsigned* bar = b.bar;
        __builtin_amdgcn_s_waitcnt(0);
        unsigned nloc = b.st[0], nx = b.st[1];
        if (nloc == 0u) { xcd_barrier_complete(bar, b.x, nloc, nx); b.st[0] = nloc; b.st[1] = nx; }
        const unsigned old = xb_add(&bar[XB_XSUB(b.x)], 1u);
        const unsigned gen = old / nloc;
        if (old + 1u == (gen + 1u) * nloc) {
            __builtin_amdgcn_fence(__ATOMIC_RELEASE, "agent");
            asm volatile("s_waitcnt vmcnt(0)" ::: "memory");
            const unsigned og = xb_add(&bar[XB_TOP], 1u);
            const unsigned tg = og / nx;
            if (og + 1u == (tg + 1u) * nx) xb_add(&bar[XB_TOPGEN], 1u);
            else XB_SPIN(xb_ld(&bar[XB_TOPGEN]) == tg, bar);
            __builtin_amdgcn_fence(__ATOMIC_ACQUIRE, "agent");
            xb_add(&bar[XB_XGEN(b.x)], 1u);
            asm volatile("s_waitcnt vmcnt(0)" ::: "memory");
        } else {
            XB_SPIN(xb_ld(&bar[XB_XGEN(b.x)]) == gen, bar);
            __builtin_amdgcn_fence(__ATOMIC_ACQUIRE, "agent");
            asm volatile("s_waitcnt vmcnt(0)" ::: "memory");
        }
    }
    __syncthreads();
}

struct Args { const float* in[22]; float* out; unsigned char* ws; int ph_lo, ph_hi, li, pad; };

template <bool F8OUT>
__device__ __forceinline__ void p0_item(const float* W, int K, int N, void* WTv, const float* gk, const float* gk2, int ksplit, const float* gn, int mode, LAS float* scr, int item, int lane, float mult = 1.0f, int nblk_dec = 0) {
    const int nblk = nblk_dec ? nblk_dec : N / 32, kb = item / nblk, nb = item % nblk, k0 = 64 * kb, nd0 = 32 * nb;
    int ns0 = nd0; if (mode == 1) { const int pn = nd0 >> 8, j = nd0 & 255; ns0 = (j < 128) ? 128 * pn + j : 1024 + 128 * pn + (j - 128); }
    const int kr = lane >> 3, n4 = (lane & 7) * 4;
    f32x4 v[8];
#pragma unroll
    for (int i = 0; i < 8; ++i) v[i] = *(const f32x4*)(W + (size_t)(k0 + 8 * i + kr) * N + ns0 + n4);
    f32x4 gnv = (f32x4){1.f, 1.f, 1.f, 1.f}; if (gn) gnv = *(const f32x4*)(gn + ns0 + n4);
#pragma unroll
    for (int i = 0; i < 8; ++i) { const int kk = 8 * i + kr, k = k0 + kk; float g = 1.f; if (gk) g = (k < ksplit) ? gk[k] : gk2[k - ksplit];
        const f32x4 t = v[i] * gnv * (g * mult); LAS float* d = scr + kk * 33 + n4; d[0] = t[0]; d[1] = t[1]; d[2] = t[2]; d[3] = t[3]; }
    LDS_WAIT(); asm volatile("" ::: "memory");
    const int c = lane & 7;
#pragma unroll
    for (int j = 0; j < 4; ++j) { const int n = (lane >> 3) + 8 * j; const LAS float* s = scr + (8 * c) * 33 + n;
        if constexpr (F8OUT) { int lo = __builtin_amdgcn_cvt_pk_fp8_f32(s[0 * 33], s[1 * 33], 0, false); lo = __builtin_amdgcn_cvt_pk_fp8_f32(s[2 * 33], s[3 * 33], lo, true);
            int hi2 = __builtin_amdgcn_cvt_pk_fp8_f32(s[4 * 33], s[5 * 33], 0, false); hi2 = __builtin_amdgcn_cvt_pk_fp8_f32(s[6 * 33], s[7 * 33], hi2, true);
            pg8::st8_wt((unsigned char*)WTv + (size_t)(nd0 + n) * K + k0 + 8 * c, (unsigned long long)(unsigned)lo | ((unsigned long long)(unsigned)hi2 << 32)); }
        else { u32x4 o; o.x = pg8::cvt_pk_bf16(s[0 * 33], s[1 * 33]); o.y = pg8::cvt_pk_bf16(s[2 * 33], s[3 * 33]); o.z = pg8::cvt_pk_bf16(s[4 * 33], s[5 * 33]); o.w = pg8::cvt_pk_bf16(s[6 * 33], s[7 * 33]);
            pg8::st16<0>((bf16_t*)WTv + (size_t)(nd0 + n) * K + k0 + 8 * c, o); } }
    LDS_WAIT(); asm volatile("" ::: "memory");
}
__device__ __forceinline__ void p0_fused_pool_item(const float* w_in, const float* g_mix, const float* w_pool, const float* pool_scale, bf16_t* WIN_T, int item, int lane) {
    const int eb = item & 7, kb = (item >> 3) & 15, g = item >> 7; const int k = kb * 64 + lane, e0 = eb * 16;
    const float* ap = w_in + (size_t)k * INP + 3 * SBW + g * PGD; const float* bp = w_pool + (size_t)g * PGD * PGD + e0;
    float acc[16];
#pragma unroll
    for (int j = 0; j < 16; ++j) acc[j] = 0.f;
#pragma unroll 4
    for (int c = 0; c < PGD; ++c) { const float a = ap[c];
#pragma unroll
        for (int j = 0; j < 16; ++j) acc[j] += a * bp[c * PGD + j]; }
    const float gk = g_mix[k];
#pragma unroll
    for (int j = 0; j < 16; ++j) WIN_T[(size_t)(3 * SBW + g * PGD + e0 + j) * D + k] = (bf16_t)f2bf(acc[j] * gk * pool_scale[g * PGD + e0 + j]);
}
__device__ __forceinline__ void p0_row(const float* xrow, bf16_t* orow, float* rstd, int lane) {
    const f32x4* xr = (const f32x4*)xrow + 2 * lane; f32x4 v[4]; float s = 0.f;
#pragma unroll
    for (int j = 0; j < 4; ++j) { v[j] = xr[(j >> 1) * 128 + (j & 1)]; s += (v[j].x * v[j].x + v[j].y * v[j].y) + (v[j].z * v[j].z + v[j].w * v[j].w); }
    s = wave_sum(s); if (lane == 0) *rstd = 1.0f / sqrtf(s * (1.0f / D) + EPS);
#pragma unroll
    for (int j = 0; j < 2; ++j) { u32x4 o; o.x = pg8::cvt_pk_bf16(v[2 * j].x, v[2 * j].y); o.y = pg8::cvt_pk_bf16(v[2 * j].z, v[2 * j].w); o.z = pg8::cvt_pk_bf16(v[2 * j + 1].x, v[2 * j + 1].y); o.w = pg8::cvt_pk_bf16(v[2 * j + 1].z, v[2 * j + 1].w);
        pg8::st16<0>(orow + j * 512 + 8 * lane, o); }
}
__device__ __forceinline__ void p0_prologue(const Args& a, LAS unsigned char* lds, int vcu, int G, int wave, int lane) {
    unsigned char* ws = a.ws;
    LAS float* scr = (LAS float*)(lds + RING_OFF + wave * 16384);
    const int gw = vcu * NWAVES + wave, NGW = G * NWAVES;
    constexpr int I_E1 = (D / 64) * (2 * DFF / 32), I_E2 = (DFF / 64) * (D / 32);
    constexpr int I_IN = (D / 64) * (3 * SBW / 32), I_FP = PG * 16 * 8, I_SQ = (D / 64) * (D / 32), I_KV = (D / 64) * (2 * D / 32), I_P = (PGD / 64) * (PGD / 32);
    constexpr int N1 = NE * I_E1, N2 = NE * I_E2, NITEMS = N1 + N2 + I_IN + 3 * I_SQ + I_KV + I_FP;
    const int BIG = 1 << 30;
    for (int it = gw; it < NITEMS; it += NGW) {
        int r = it;
        if (r < N1 + N2 && r >= N1 + N2 - P0_DEFER) continue;
        if (r < N1) { const int e = r / I_E1; p0_item<true>(a.in[17] + (size_t)e * D * 2 * DFF, D, 2 * DFF, ws + WS_W1 + (size_t)e * 2 * DFF * D, a.in[14], nullptr, BIG, nullptr, 1, scr, r % I_E1, lane, WSCALE); continue; } r -= N1;
        if (r < N2) { const int e = r / I_E2; p0_item<true>(a.in[19] + (size_t)e * DFF * D, DFF, D, ws + WS_W2 + (size_t)e * D * DFF, nullptr, nullptr, BIG, nullptr, 0, scr, r % I_E2, lane, WSCALE); continue; } r -= N2;
        if (r < I_IN) { p0_item<false>(a.in[3], D, INP, (bf16_t*)(ws + WS_WIN), a.in[2], nullptr, BIG, nullptr, 0, scr, r, lane, 1.0f, 3 * SBW / 32); continue; } r -= I_IN;
        if (r < I_SQ) { p0_item<false>(a.in[8], D, D, (bf16_t*)(ws + WS_WOUT), a.in[4], a.in[5], SBW, nullptr, 0, scr, r, lane); continue; } r -= I_SQ;
        if (r < I_SQ) { p0_item<true>(a.in[11], D, D, ws + WS_WQ, a.in[9], nullptr, BIG, nullptr, 0, scr, r, lane, WSCALE); continue; } r -= I_SQ;
        if (r < I_KV) { p0_item<false>(a.in[12], D, 2 * D, (bf16_t*)(ws + WS_WKV), a.in[10], nullptr, BIG, nullptr, 0, scr, r, lane); continue; } r -= I_KV;
        if (r < I_SQ) { p0_item<false>(a.in[13], D, D, (bf16_t*)(ws + WS_WO), nullptr, nullptr, BIG, nullptr, 0, scr, r, lane); continue; } r -= I_SQ;
        p0_fused_pool_item(a.in[3], a.in[2], a.in[6], a.in[7], (bf16_t*)(ws + WS_WIN), r, lane);
    }
    for (int m = gw; m < NTOK; m += NGW) p0_row(a.in[0] + (size_t)m * D, (bf16_t*)(ws + WS_S0) + (size_t)m * D, (float*)(ws + WS_RSTDX) + m, lane);
    for (int m = gw; m < NMROWS; m += NGW) p0_row(a.in[1] + (size_t)m * D, (bf16_t*)(ws + WS_MEMB) + (size_t)m * D, (float*)(ws + WS_RSTDM) + m, lane);
    const int gt = gw * 64 + lane, NGT = NGW * 64;
    for (int i = gt; i < INP; i += NGT) ((float*)(ws + WS_CSG1))[i] = (i < SBW) ? C2_SB : 1.0f;
    for (int i = gt; i < NE * D; i += NGT) { const int e = i / D, k = i % D; const float v = a.in[14][k] * a.in[15][k * NE + e];
        ((float*)(ws + WS_WR))[i] = v; const unsigned h = f2bf(v); ((bf16_t*)(ws + WS_WRH))[i] = (bf16_t)h; ((bf16_t*)(ws + WS_WRL))[i] = (bf16_t)f2bf(v - bf2f((bf16_t)h)); }
}

__device__ __forceinline__ void p1_deferred_items(const Args& a, LAS unsigned char* lds, int rank  , int wave, int lane) {
    constexpr int I_E2 = (DFF / 64) * (D / 32), N2 = NE * I_E2;
    LAS float* scr = (LAS float*)(lds + RING_OFF + wave * 16384);
    for (int k = 0; k < P0_DEFER / (192 * 8); ++k) { const int r = N2 - P0_DEFER + (k * 192 + rank) * 8 + wave; const int e = r / I_E2;
        p0_item<true>(a.in[19] + (size_t)e * DFF * D, DFF, D, a.ws + WS_W2 + (size_t)e * D * DFF, nullptr, nullptr, 1 << 30, nullptr, 0, scr, r % I_E2, lane, WSCALE); }
}
struct SchedP1 {
    int G, c; unsigned char* ws;
    __device__ __forceinline__ bool next(int i, pg8::Unit& u) const {
        const int L = i * G + c; constexpr int NQ = (NTOK / 256) * (INP / 256);
        if (L >= NQ + 64) return false;
        if (L < NQ) { int pm, pn; pg8::grouped_mn(pg8::xcd_remap(L, NQ), NTOK / 256, INP / 256, pm, pn);
            u.A = (const char*)(ws + WS_S0) + (size_t)pm * 256 * D * 2; u.B = (const char*)(ws + WS_WIN) + (size_t)pn * 256 * D * 2;
            u.p0 = (bf16_t*)(ws + WS_QKVU) + (size_t)pm * 256 * INP + pn * 256; u.p1 = (float*)(ws + WS_RSTDX) + pm * 256; u.p2 = (float*)(ws + WS_CSG1) + pn * 256; u.i0 = INP; u.pm = pm; u.pn = pn; }
        else if (L < NQ + 32) { const int k = L - NQ, pm = k >> 2, pn = k & 3;
            u.A = (const char*)(ws + WS_MEMB) + (size_t)pm * 256 * D * 2; u.B = (const char*)(ws + WS_WKV) + (size_t)pn * 256 * D * 2;
            u.p0 = (bf16_t*)(ws + WS_KM) + (size_t)pm * 256 * D + pn * 256; u.p1 = (float*)(ws + WS_RSTDM) + pm * 256; u.p2 = nullptr; u.i0 = D; u.pm = pm; u.pn = pn; }
        else { const int v = L - NQ - 32, b = v >> 2, dt = v & 3;
            u.A = (const char*)(ws + WS_WKV) + (size_t)(D + dt * 256) * D * 2; u.B = (const char*)(ws + WS_MEMB) + (size_t)b * 256 * D * 2;
            u.p0 = (bf16_t*)(ws + WS_VMT) + ((size_t)b * D + dt * 256) * NMEM; u.p1 = nullptr; u.p2 = (float*)(ws + WS_RSTDM) + b * 256; u.i0 = NMEM; u.pm = dt; u.pn = b; }
        u.p3 = nullptr; u.i1 = 0; return true;
    }
};
#define EPI_BAR() asm volatile("s_waitcnt lgkmcnt(0)\n\ts_barrier" ::: "memory")
struct SchedReg {
    int G, c, nM, nN; const char* A; const char* B; size_t astep, bstep; bf16_t* O; int ldc; const float* rs; const float* cs; const ssq_t* sq = nullptr;
    __device__ __forceinline__ bool next(int i, pg8::Unit& u) const {
        const int L = i * G + c; if (L >= nM * nN) return false; int pm, pn; pg8::grouped_mn(pg8::xcd_remap(L, nM * nN), nM, nN, pm, pn);
        u.A = A + (size_t)pm * astep; u.B = B + (size_t)pn * bstep; u.pm = pm; u.pn = pn; u.i0 = ldc; u.i1 = 0;
        u.p0 = O ? (void*)(O + (size_t)pm * 256 * ldc + pn * 256) : nullptr; u.p1 = sq ? (void*)(sq + pm * 256) : (rs ? (void*)(rs + pm * 256) : nullptr); u.p2 = cs ? (void*)(cs + pn * 256) : nullptr; u.p3 = nullptr; return true;
    }
};
struct EpiBf16Ssq {
    static constexpr bool PERM = true; static constexpr int MIDK = -1; float inv_n, mult;
    __device__ __forceinline__ void midk(f32x4 (&)[2][2][4][2], const pg8::Unit&, int, int) const {}
    __device__ __forceinline__ void operator()(f32x4 (&acc)[2][2][4][2], const pg8::Unit& u, int wr, int wc, int fr, int fq, int, int, LAS unsigned char*) const {
        bf16_t* O = (bf16_t*)u.p0; const ssq_t* sq = (const ssq_t*)u.p1; const int ldc = u.i0; int r0 = wr * 64 + fr, c0 = wc * 32 + 8 * fq; asm volatile("" : "+v"(r0), "+v"(c0));
#pragma unroll
        for (int ai = 0; ai < 2; ++ai)
#pragma unroll
            for (int m = 0; m < 4; ++m) { const int r = r0 + ai * 128 + m * 16; const float rv = mult / sqrtf(ssq_get(sq + r) * inv_n + EPS); bf16_t* rowp = O + (size_t)r * ldc + c0;
#pragma unroll
                for (int bj = 0; bj < 2; ++bj) { const f32x4 v0 = acc[ai][bj][m][0] * rv, v1 = acc[ai][bj][m][1] * rv;
                    u32x4 w; w.x = pg8::cvt_pk_bf16(v0[0], v0[1]); w.y = pg8::cvt_pk_bf16(v0[2], v0[3]); w.z = pg8::cvt_pk_bf16(v1[0], v1[1]); w.w = pg8::cvt_pk_bf16(v1[2], v1[3]);
                    pg8::st16<5>(rowp + bj * 128, w); } }
    }
};
template <int MIDK_, bool XIN_BF16, bool F8OUT> struct EpiResid {
    static constexpr bool PERM = true; static constexpr int MIDK = MIDK_;
    const float* xin; bf16_t* xb; unsigned char* x8; ssq_t* ssq; const ssq_t* ssq_mid; float accs;
    __device__ __forceinline__ void midk(f32x4 (&acc)[2][2][4][2], const pg8::Unit& u, int wr, int fr) const {
#pragma unroll
        for (int ai = 0; ai < 2; ++ai)
#pragma unroll
            for (int m = 0; m < 4; ++m) { const int r = u.pm * 256 + ai * 128 + wr * 64 + m * 16 + fr; const float s = 1.0f / sqrtf(ssq_get(ssq_mid + r) * (1.0f / SBW) + EPS);
#pragma unroll
                for (int bj = 0; bj < 2; ++bj)
#pragma unroll
                    for (int n = 0; n < 2; ++n) acc[ai][bj][m][n] *= s; }
    }
    __device__ __forceinline__ void operator()(f32x4 (&acc)[2][2][4][2], const pg8::Unit& u, int wr, int wc, int fr, int fq, int, int, LAS unsigned char*) const {
        int row0 = u.pm * 256 + wr * 64 + fr, col0 = u.pn * 256 + wc * 32 + 8 * fq; asm volatile("" : "+v"(row0), "+v"(col0));
        u32x4 xv[2][4][2]; f32x4 xf[XIN_BF16 ? 1 : 2][XIN_BF16 ? 1 : 4][XIN_BF16 ? 1 : 2][2];
#pragma unroll
        for (int ai = 0; ai < 2; ++ai)
#pragma unroll
            for (int m = 0; m < 4; ++m)
#pragma unroll
                for (int bj = 0; bj < 2; ++bj) { const size_t o2 = (size_t)(row0 + ai * 128 + m * 16) * D + col0 + bj * 128;
                    if constexpr (XIN_BF16) xv[ai][m][bj] = *(const u32x4*)(xb + o2); else { xf[ai][m][bj][0] = *(const f32x4*)(xin + o2); xf[ai][m][bj][1] = *(const f32x4*)(xin + o2 + 4); } }
#pragma unroll
        for (int ai = 0; ai < 2; ++ai)
#pragma unroll
            for (int m = 0; m < 4; ++m) { const int r = row0 + ai * 128 + m * 16; const size_t off = (size_t)r * D + col0; float q = 0.f;
#pragma unroll
                for (int bj = 0; bj < 2; ++bj) { const size_t o2 = off + bj * 128; f32x4 o0, o1;
                    if constexpr (XIN_BF16) { const u32x4 x4 = xv[ai][m][bj];
                        o0 = (f32x4){__builtin_bit_cast(float, x4.x << 16), __builtin_bit_cast(float, x4.x & 0xffff0000u), __builtin_bit_cast(float, x4.y << 16), __builtin_bit_cast(float, x4.y & 0xffff0000u)};
                        o1 = (f32x4){__builtin_bit_cast(float, x4.z << 16), __builtin_bit_cast(float, x4.z & 0xffff0000u), __builtin_bit_cast(float, x4.w << 16), __builtin_bit_cast(float, x4.w & 0xffff0000u)}; }
                    else { o0 = xf[ai][m][bj][0]; o1 = xf[ai][m][bj][1]; }
                    o0 += acc[ai][bj][m][0] * accs; o1 += acc[ai][bj][m][1] * accs;
                    q += (o0[0] * o0[0] + o0[1] * o0[1]) + (o0[2] * o0[2] + o0[3] * o0[3]) + (o1[0] * o1[0] + o1[1] * o1[1]) + (o1[2] * o1[2] + o1[3] * o1[3]);
                    if constexpr (F8OUT) { int w0 = __builtin_amdgcn_cvt_pk_fp8_f32(o0[0], o0[1], 0, false); w0 = __builtin_amdgcn_cvt_pk_fp8_f32(o0[2], o0[3], w0, true);
                        int w1 = __builtin_amdgcn_cvt_pk_fp8_f32(o1[0], o1[1], 0, false); w1 = __builtin_amdgcn_cvt_pk_fp8_f32(o1[2], o1[3], w1, true);
                        pg8::st8_wt(x8 + o2, (unsigned long long)(unsigned)w0 | ((unsigned long long)(unsigned)w1 << 32)); }
                    u32x4 w; w.x = pg8::cvt_pk_bf16(o0[0], o0[1]); w.y = pg8::cvt_pk_bf16(o0[2], o0[3]); w.z = pg8::cvt_pk_bf16(o1[0], o1[1]); w.w = pg8::cvt_pk_bf16(o1[2], o1[3]); pg8::st16<4>(xb + o2, w); }
                q += __shfl_xor(q, 16); q += __shfl_xor(q, 32);
                if (fq == 0) ssq_add(ssq + r, q); }
    }
};
struct SchedMS {
    int G, c; unsigned char* ws;
    __device__ __forceinline__ bool next(int i, pg8::Unit& u) const {
        const int L = i * G + c; constexpr int NU = (NTOK / 256) * MH; if (L >= NU) return false; int pm, h; pg8::grouped_mn(pg8::xcd_remap(L, NU), NTOK / 256, MH, pm, h); const int b = pm >> 4;
        u.A = (const char*)(ws + WS_QM) + ((size_t)pm * 256 * D + h * MHD) * 2; u.B = (const char*)(ws + WS_KM) + ((size_t)b * NMEM * D + h * MHD) * 2;
        u.p0 = (bf16_t*)(ws + WS_PM) + (size_t)pm * 256 * D + h * NMEM; u.p1 = nullptr; u.p2 = nullptr; u.p3 = nullptr; u.i0 = D; u.i1 = 0; u.pm = pm; u.pn = h; return true;
    }
};
struct EpiSoftmax {
    static constexpr bool PERM = true; static constexpr int MIDK = -1;
    __device__ __forceinline__ void midk(f32x4 (&)[2][2][4][2], const pg8::Unit&, int, int) const {}
    __device__ __forceinline__ void operator()(f32x4 (&acc)[2][2][4][2], const pg8::Unit& u, int wr, int wc, int fr, int fq, int, int, LAS unsigned char* xl) const {
        typedef float f32x2v __attribute__((ext_vector_type(2)));
        LAS f32x2v* X = (LAS f32x2v*)xl;
        float ml[2][4];
#pragma unroll
        for (int ai = 0; ai < 2; ++ai)
#pragma unroll
            for (int m = 0; m < 4; ++m) { float mx = -INFINITY;
#pragma unroll
                for (int bj = 0; bj < 2; ++bj)
#pragma unroll
                    for (int n = 0; n < 2; ++n) { const f32x4 v = acc[ai][bj][m][n]; mx = fmaxf(fmaxf(mx, fmaxf(v[0], v[1])), fmaxf(v[2], v[3])); }
                mx = fmaxf(mx, __shfl_xor(mx, 16)); mx = fmaxf(mx, __shfl_xor(mx, 32)); ml[ai][m] = mx; float s = 0.f;
#pragma unroll
                for (int bj = 0; bj < 2; ++bj)
#pragma unroll
                    for (int n = 0; n < 2; ++n) { f32x4 v = acc[ai][bj][m][n];
#pragma unroll
                        for (int j = 0; j < 4; ++j) { v[j] = __builtin_amdgcn_exp2f(v[j] - mx); s += v[j]; }
                        acc[ai][bj][m][n] = v; }
                s += __shfl_xor(s, 16); s += __shfl_xor(s, 32);
                if (fq == 0) X[(ai * 128 + wr * 64 + m * 16 + fr) * 4 + wc] = (f32x2v){mx, s}; }
        EPI_BAR();
        bf16_t* O = (bf16_t*)u.p0; const int ldc = u.i0; int r0 = wr * 64 + fr, c0 = wc * 32 + 8 * fq; asm volatile("" : "+v"(r0), "+v"(c0));
#pragma unroll
        for (int ai = 0; ai < 2; ++ai)
#pragma unroll
            for (int m = 0; m < 4; ++m) { const int r = r0 + ai * 128 + m * 16; const f32x2v a = X[r * 4 + 0], b = X[r * 4 + 1], c = X[r * 4 + 2], d = X[r * 4 + 3];
                const float M = fmaxf(fmaxf(a.x, b.x), fmaxf(c.x, d.x));
                const float tot = a.y * __builtin_amdgcn_exp2f(a.x - M) + b.y * __builtin_amdgcn_exp2f(b.x - M) + c.y * __builtin_amdgcn_exp2f(c.x - M) + d.y * __builtin_amdgcn_exp2f(d.x - M);
                const float f = __builtin_amdgcn_exp2f(ml[ai][m] - M) / tot; bf16_t* rowp = O + (size_t)r * ldc + c0;
#pragma unroll
                for (int bj = 0; bj < 2; ++bj) { const f32x4 v0 = acc[ai][bj][m][0] * f, v1 = acc[ai][bj][m][1] * f;
                    u32x4 w; w.x = pg8::cvt_pk_bf16(v0[0], v0[1]); w.y = pg8::cvt_pk_bf16(v0[2], v0[3]); w.z = pg8::cvt_pk_bf16(v1[0], v1[1]); w.w = pg8::cvt_pk_bf16(v1[2], v1[3]);
                    pg8::st16<6>(rowp + bj * 128, w); } }
    }
};
struct SchedPV {
    int G, c; unsigned char* ws;
    __device__ __forceinline__ bool next(int i, pg8::Unit& u) const {
        const int L = i * G + c; constexpr int NU = (NTOK / 256) * MH; if (L >= NU) return false; int pm, h; pg8::grouped_mn(pg8::xcd_remap(L, NU), NTOK / 256, MH, pm, h); const int b = pm >> 4;
        u.A = (const char*)(ws + WS_PM) + ((size_t)pm * 256 * D + h * NMEM) * 2; u.B = (const char*)(ws + WS_VMT) + ((size_t)b * D + h * MHD) * NMEM * 2;
        u.p0 = (bf16_t*)(ws + WS_OM) + (size_t)pm * 256 * D + h * MHD; u.p1 = nullptr; u.p2 = nullptr; u.p3 = nullptr; u.i0 = D; u.i1 = 0; u.pm = pm; u.pn = h; return true;
    }
};

__device__ __forceinline__ void p8_route(const Args& a, LAS unsigned char* lds, int bx, int G, int wave, int lane, int* CNT) {
    unsigned char* ws = a.ws; const bf16_t* x2 = (const bf16_t*)(ws + WS_S0); const ssq_t* SSQ2 = (const ssq_t*)(ws + MK_SSQ2); const float* br = a.in[16];
    const bf16_t* WRH = (const bf16_t*)(ws + WS_WRH);
    int* LSLOT = (int*)(ws + WS_LSLOT); float* LGATE = (float*)(ws + WS_LGATE); float* LRS = (float*)(ws + WS_LRS);
    constexpr int WPITCH = 2064;
    LAS float* LG = (LAS float*)(lds + RING_OFF + 69632) + wave * 16 * 33;
    LAS int* hist = (LAS int*)(lds + RING_OFF + 90112); LAS int* base = hist + 32;
    const int tid = wave * 64 + lane;
    { u32x4 v[8];
#pragma unroll
      for (int i = 0; i < 8; ++i) v[i] = *(const u32x4*)(WRH + (size_t)(tid + i * 512) * 8);
#pragma unroll
      for (int i = 0; i < 8; ++i) { const int c = tid + i * 512; *(LAS u32x4*)(lds + RING_OFF + (c >> 7) * WPITCH + (c & 127) * 16) = v[i]; } }
    LDS_WAIT(); __syncthreads();
    for (int t0 = bx * 128; t0 < NTOK; t0 += G * 128) {
        if (tid < 32) hist[tid] = 0;
        const int r16 = lane & 15, kq = lane >> 4; const int trow = t0 + wave * 16 + r16;
        const bf16_t* xp = x2 + (size_t)trow * D + kq * 8;
        bf16x8 ah[32];
#pragma unroll
        for (int ks = 0; ks < 32; ++ks) ah[ks] = *(const bf16x8*)(xp + ks * 32);
        f32x4 acc[2] = {(f32x4){0.f, 0.f, 0.f, 0.f}, (f32x4){0.f, 0.f, 0.f, 0.f}};
        const LAS unsigned char* wp = lds + RING_OFF + r16 * WPITCH + kq * 16;
#pragma unroll
        for (int ks = 0; ks < 32; ++ks) {
#pragma unroll
            for (int nb = 0; nb < 2; ++nb) { const bf16x8 bh = *(const LAS bf16x8*)(wp + nb * 16 * WPITCH + ks * 64);
                acc[nb] = __builtin_amdgcn_mfma_f32_16x16x32_bf16(ah[ks], bh, acc[nb], 0, 0, 0); } }
#pragma unroll
        for (int nb = 0; nb < 2; ++nb)
#pragma unroll
            for (int r = 0; r < 4; ++r) { const int tl = kq * 4 + r; const int tk = t0 + wave * 16 + tl; const float rs = 1.0f / sqrtf(ssq_get(SSQ2 + tk) * (1.0f / D) + EPS);
                LG[tl * 33 + nb * 16 + r16] = acc[nb][r] * rs + br[nb * 16 + r16]; }
        LDS_WAIT(); __syncthreads();
        int te[4] = {0, 0, 0, 0}; float tg[4] = {0.f, 0.f, 0.f, 0.f}; int rk[4] = {0, 0, 0, 0};
        if (lane < 16) {
            float tv[4] = {-INFINITY, -INFINITY, -INFINITY, -INFINITY};
            for (int e = 0; e < NE; ++e) { const float v = LG[lane * 33 + e];
                if (v > tv[3]) { if (v > tv[2]) { tv[3] = tv[2]; te[3] = te[2]; if (v > tv[1]) { tv[2] = tv[1]; te[2] = te[1]; if (v > tv[0]) { tv[1] = tv[0]; te[1] = te[0]; tv[0] = v; te[0] = e; } else { tv[1] = v; te[1] = e; } } else { tv[2] = v; te[2] = e; } } else { tv[3] = v; te[3] = e; } } }
            float gs = 0.f;
#pragma unroll
            for (int k = 0; k < 4; ++k) { tg[k] = __expf(tv[k] - tv[0]); gs += tg[k]; }
            gs = 1.0f / gs;
#pragma unroll
            for (int k = 0; k < 4; ++k) { tg[k] *= gs; rk[k] = __hip_atomic_fetch_add(hist + te[k], 1, __ATOMIC_RELAXED, __HIP_MEMORY_SCOPE_WORKGROUP); }
        }
        LDS_WAIT(); __syncthreads();
        if (tid < 32) { const int n = hist[tid]; base[tid] = n ? atomicAdd(CNT + tid, n) : 0; }
        LDS_WAIT(); __syncthreads();
        if (lane < 16) { const int tk = t0 + wave * 16 + lane; const float rsw = (1.0f / WSCALE) / sqrtf(ssq_get(SSQ2 + tk) * (1.0f / D) + EPS);
#pragma unroll
            for (int k = 0; k < 4; ++k) { const size_t p = (size_t)te[k] * LCAP + base[te[k]] + rk[k]; pg8::st4_wt(LSLOT + p, (unsigned)(tk * 4 + k)); pg8::st4_wt(LGATE + p, __float_as_uint(tg[k])); pg8::st4_wt(LRS + p, __float_as_uint(rsw)); } }
        LDS_WAIT(); __syncthreads();
    }
}

__device__ __forceinline__ void moe_table(const Args& a, volatile LAS unsigned* MISC, int tid) {
    const int* CNT = (const int*)(a.ws + OFF_CNT);
    if (tid < 32) MISC[16 + tid] = (unsigned)CNT[tid];
    LDS_WAIT(); __syncthreads();
    if (tid == 0) { unsigned tb = 0; for (int e = 0; e < NE; ++e) { MISC[48 + e] = tb; tb += (MISC[16 + e] + 255u) >> 8; } MISC[48 + NE] = tb; }
    LDS_WAIT(); __syncthreads();
}
template <int NPN, bool W1> struct SchedMoE {
    int G, c; unsigned char* ws; volatile LAS unsigned* MISC; const float* bias;
    __device__ __forceinline__ bool next(int i, pg8::Unit& u) const {
        unsigned mb_ = (unsigned)(uintptr_t)MISC; asm volatile("" : "+s"(mb_)); const LAS unsigned* M = (const LAS unsigned*)(uintptr_t)mb_;
        const int T = __builtin_amdgcn_readfirstlane((int)M[48 + NE]); const int NU = T * NPN; const int L = i * G + c; if (L >= NU) return false;
        const int w = pg8::xcd_remap(L, NU);
        int e = 0;
#pragma unroll
        for (int s = 16; s >= 1; s >>= 1) { if ((int)M[48 + e + s] * NPN <= w) e += s; }
        e = __builtin_amdgcn_readfirstlane(e);
        const int tb = __builtin_amdgcn_readfirstlane((int)M[48 + e]), cnt = __builtin_amdgcn_readfirstlane((int)M[16 + e]), nte = (cnt + 255) >> 8; const int idx = w - tb * NPN, pn = __builtin_amdgcn_readfirstlane(idx / nte), mt = idx - pn * nte;
        u.pm = tb + mt; u.pn = pn; u.i1 = e; const int nv = cnt - mt * 256; u.i0 = nv < 256 ? nv : 256;
        u.p3 = (int*)(ws + WS_LSLOT) + (size_t)e * LCAP + mt * 256; u.p2 = (float*)(ws + (W1 ? WS_LRS : WS_LGATE)) + (size_t)e * LCAP + mt * 256; u.p0 = nullptr;
        u.p1 = W1 ? (void*)(bias + (size_t)e * 2 * DFF + pn * 128) : (void*)(bias + (size_t)e * D + pn * 256);
        if (W1) { u.A = (const char*)(ws + WS_X2F8); u.B = (const char*)(ws + WS_W1) + ((size_t)e * 2 * DFF + pn * 256) * D; }
        else { u.A = (const char*)(ws + WS_ACT) + (size_t)(tb + mt) * 256 * DFF; u.B = (const char*)(ws + WS_W2) + ((size_t)e * D + pn * 256) * DFF; }
        return true;
    }
};
typedef float f32x2 __attribute__((ext_vector_type(2)));
struct EpiSwiGLU {
    static constexpr bool PERM = true; static constexpr int MIDK = -1; unsigned char* act;
    __device__ __forceinline__ void midk(f32x4 (&)[2][2][4][2], const pg8::Unit&, int, int) const {}
    __device__ __forceinline__ void operator()(f32x4 (&acc)[2][2][4][2], const pg8::Unit& u, int wr, int wc, int fr, int fq, int, int, LAS unsigned char* tab) const {
        const int nvalid = u.i0; const LAS float* T1 = (const LAS float*)tab + 256; const LAS float* T2 = (const LAS float*)tab + 512;
        int r0 = wr * 64 + fr, c0 = wc * 32 + 8 * fq; asm volatile("" : "+v"(r0), "+v"(c0)); const int gc0 = u.pn * 128 + c0;
        f32x4 bg[2], bu[2];
#pragma unroll
        for (int n = 0; n < 2; ++n) { bg[n] = *(const LAS f32x4*)(T2 + c0 + 4 * n); bu[n] = *(const LAS f32x4*)(T2 + 128 + c0 + 4 * n); }
#pragma unroll
        for (int ai = 0; ai < 2; ++ai)
#pragma unroll
            for (int m = 0; m < 4; ++m) { const int r = r0 + ai * 128 + m * 16; const float rs = T1[r]; int wv[2];
#pragma unroll
                for (int n = 0; n < 2; ++n) { f32x2 o[2];
#pragma unroll
                    for (int h = 0; h < 2; ++h) { f32x2 g = (f32x2){acc[ai][0][m][n][2 * h], acc[ai][0][m][n][2 * h + 1]} * rs + (f32x2){bg[n][2 * h], bg[n][2 * h + 1]};
                        f32x2 up = (f32x2){acc[ai][1][m][n][2 * h], acc[ai][1][m][n][2 * h + 1]} * rs + (f32x2){bu[n][2 * h], bu[n][2 * h + 1]};
                        g.x = fminf(g.x, SW_LIMIT); g.y = fminf(g.y, SW_LIMIT); up.x = fminf(fmaxf(up.x, -SW_LIMIT), SW_LIMIT); up.y = fminf(fmaxf(up.y, -SW_LIMIT), SW_LIMIT);
                        const f32x2 tt = g * (-SW_ALPHA * LOG2E); f32x2 d; d.x = __builtin_amdgcn_exp2f(tt.x); d.y = __builtin_amdgcn_exp2f(tt.y); d = d + 1.0f;
                        f32x2 rr; rr.x = __builtin_amdgcn_rcpf(d.x); rr.y = __builtin_amdgcn_rcpf(d.y);
                        o[h] = (up + 1.0f) * g * rr; }
                    wv[n] = __builtin_amdgcn_cvt_pk_fp8_f32(o[0].x, o[0].y, 0, false); wv[n] = __builtin_amdgcn_cvt_pk_fp8_f32(o[1].x, o[1].y, wv[n], true); }
                if (r < nvalid) pg8::st8_wt(act + ((size_t)u.pm * 256 + r) * DFF + gc0, (unsigned long long)(unsigned)wv[0] | ((unsigned long long)(unsigned)wv[1] << 32)); }
    }
};
struct EpiW2 {
    static constexpr bool PERM = true; static constexpr int MIDK = -1; unsigned char* Y;
    __device__ __forceinline__ void midk(f32x4 (&)[2][2][4][2], const pg8::Unit&, int, int) const {}
    __device__ __forceinline__ void operator()(f32x4 (&acc)[2][2][4][2], const pg8::Unit& u, int wr, int wc, int fr, int fq, int, int, LAS unsigned char* tab) const {
        const int nvalid = u.i0; const LAS unsigned* T0 = (const LAS unsigned*)tab; const LAS float* T1 = (const LAS float*)tab + 256; const LAS float* T2 = (const LAS float*)tab + 512;
        int r0 = wr * 64 + fr, cl = wc * 32 + 8 * fq; asm volatile("" : "+v"(r0), "+v"(cl)); const int c0 = u.pn * 256 + cl;
        f32x4 bv[2][2];
#pragma unroll
        for (int bj = 0; bj < 2; ++bj)
#pragma unroll
            for (int n = 0; n < 2; ++n) bv[bj][n] = *(const LAS f32x4*)(T2 + cl + bj * 128 + 4 * n);
#pragma unroll
        for (int ai = 0; ai < 2; ++ai)
#pragma unroll
            for (int m = 0; m < 4; ++m) { const int r = r0 + ai * 128 + m * 16; const bool valid = r < nvalid; const unsigned slot = T0[r]; const float g = T1[r];
#pragma unroll
                for (int bj = 0; bj < 2; ++bj) { const f32x4 v0 = (acc[ai][bj][m][0] * (1.0f / WSCALE) + bv[bj][0]) * g, v1 = (acc[ai][bj][m][1] * (1.0f / WSCALE) + bv[bj][1]) * g;
                    int w0 = __builtin_amdgcn_cvt_pk_fp8_f32(v0[0], v0[1], 0, false); w0 = __builtin_amdgcn_cvt_pk_fp8_f32(v0[2], v0[3], w0, true);
                    int w1 = __builtin_amdgcn_cvt_pk_fp8_f32(v1[0], v1[1], 0, false); w1 = __builtin_amdgcn_cvt_pk_fp8_f32(v1[2], v1[3], w1, true);
                    if (valid) pg8::st8_wt(Y + (size_t)slot * D + c0 + bj * 128, (unsigned long long)(unsigned)w0 | ((unsigned long long)(unsigned)w1 << 32)); } }
    }
};

__device__ __forceinline__ void p11_final(const Args& a, int vcu, int G, int wave, int lane, float* dst) {
    const bf16_t* x2 = (const bf16_t*)(a.ws + WS_S0); const unsigned char* Y = a.ws + WS_Y; const float* gf = a.in[21];
    const int gw = vcu * NWAVES + wave, NGW = G * NWAVES;
    f32x4 g4[4];
#pragma unroll
    for (int j = 0; j < 4; ++j) g4[j] = *(const f32x4*)(gf + 16 * lane + 4 * j);
    for (int tok = gw; tok < NTOK; tok += NGW) {
        const u32x4 xa = *(const u32x4*)(x2 + (size_t)tok * D + 16 * lane), xc = *(const u32x4*)(x2 + (size_t)tok * D + 16 * lane + 8);
        u32x4 yv[4];
#pragma unroll
        for (int k = 0; k < 4; ++k) yv[k] = *(const u32x4*)(Y + ((size_t)tok * 4 + k) * D + 16 * lane);
        float v[16];
#pragma unroll
        for (int q = 0; q < 4; ++q) { v[2 * q] = __builtin_bit_cast(float, xa[q] << 16); v[2 * q + 1] = __builtin_bit_cast(float, xa[q] & 0xffff0000u); v[8 + 2 * q] = __builtin_bit_cast(float, xc[q] << 16); v[8 + 2 * q + 1] = __builtin_bit_cast(float, xc[q] & 0xffff0000u); }
#pragma unroll
        for (int k = 0; k < 4; ++k)
#pragma unroll
            for (int q = 0; q < 4; ++q) { const auto lo = __builtin_amdgcn_cvt_pk_f32_fp8((int)yv[k][q], false), hi2 = __builtin_amdgcn_cvt_pk_f32_fp8((int)yv[k][q], true);
                v[4 * q] += lo[0]; v[4 * q + 1] += lo[1]; v[4 * q + 2] += hi2[0]; v[4 * q + 3] += hi2[1]; }
        float s = 0.f;
#pragma unroll
        for (int q = 0; q < 16; ++q) s += v[q] * v[q];
        const float rs = 1.0f / sqrtf(wave_sum(s) * (1.0f / D) + EPS);
#pragma unroll
        for (int j = 0; j < 4; ++j) pg8::st16<8>(dst + (size_t)tok * D + 16 * lane + 4 * j, (f32x4){v[4 * j] * rs * g4[j][0], v[4 * j + 1] * rs * g4[j][1], v[4 * j + 2] * rs * g4[j][2], v[4 * j + 3] * rs * g4[j][3]});
    }
}
typedef float f32x16 __attribute__((ext_vector_type(16)));
typedef short s16x4 __attribute__((ext_vector_type(4)));
__device__ __forceinline__ int crow(int r, int hi) { return (r & 3) + 8 * (r >> 2) + 4 * hi; }
#define SB_DMA(ubase, voff, ldsaddr) do { unsigned keep_; asm volatile("s_mov_b32 %0, m0\n\ts_mov_b32 m0, %3\n\ts_nop 0\n\tglobal_load_lds_dwordx4 %1, %2\n\ts_mov_b32 m0, %0" \
        : "=&s"(keep_) : "v"(voff), "s"((const char*)(ubase)), "s"(ldsaddr) : "memory"); } while (0)
__device__ __forceinline__ void sb_item(int b, int h, int qi  , const bf16_t* QKVU, bf16_t* MIXED, ssq_t* SSQSB, LAS unsigned char* wl  , int lane) {
    const int r32 = lane & 31, hi = lane >> 5;
    const size_t rowbase = (size_t)b * S; const int q0 = qi * 64;
    const bf16_t* Qw = QKVU + (rowbase + q0) * INP + h * HD;
    const char* Kh = (const char*)(QKVU + rowbase * INP + SBW + h * HD); const char* Vh = Kh + SBW * 2;
    bf16x8 qr[2][4];
#pragma unroll
    for (int s = 0; s < 2; ++s)
#pragma unroll
        for (int d0 = 0; d0 < 4; ++d0) qr[s][d0] = *(const bf16x8*)(Qw + (size_t)(s * 32 + r32) * INP + d0 * 16 + hi * 8);
    f32x16 o[2][2];
#pragma unroll
    for (int r = 0; r < 16; ++r) { o[0][0][r] = 0.f; o[0][1][r] = 0.f; o[1][0][r] = 0.f; o[1][1][r] = 0.f; }
    float carry[2] = {1.0f, 1.0f}; bool alive[2] = {true, true};
    const int jd = qi;
    const unsigned kvoff = (unsigned)lane * (INP * 2);
    const unsigned vvoff = (unsigned)(lane >> 2) * (INP * 2) + (unsigned)(lane & 3) * 16;
    const unsigned lk = (unsigned)(uintptr_t)wl, lv = lk + 8192;
#define SB_LOAD_K(j) do { const char* kb_ = Kh + (size_t)(j) * 64 * INP * 2; _Pragma("unroll") for (int c_ = 0; c_ < 8; ++c_) SB_DMA(kb_ + c_ * 16, kvoff, lk + c_ * 1024); } while (0)
#define SB_LOAD_V(j) do { const char* vb_ = Vh + (size_t)(j) * 64 * INP * 2; _Pragma("unroll") for (int c_ = 0; c_ < 8; ++c_) SB_DMA(vb_ + (size_t)(c_ & 3) * 16 * INP * 2 + (c_ >> 2) * 64, vvoff, lv + c_ * 1024); } while (0)
    SB_LOAD_K(jd); SB_LOAD_V(jd);
    const LAS unsigned char* kb = wl + hi * 1024 + r32 * 16;
    const LAS unsigned char* vb = wl + 8192 + ((lane >> 4) & 1) * 32 + (lane & 3) * 8 + (4 * hi + ((lane & 15) >> 2)) * 64;
    for (int j = jd; j >= 0; --j) {
        asm volatile("s_waitcnt vmcnt(8)" ::: "memory"); __builtin_amdgcn_sched_barrier(0);
        bf16x8 kf[8];
#pragma unroll
        for (int d0 = 0; d0 < 4; ++d0) { kf[2 * d0] = *(const LAS bf16x8*)(kb + d0 * 2048); kf[2 * d0 + 1] = *(const LAS bf16x8*)(kb + d0 * 2048 + 512); }
        asm volatile("s_waitcnt lgkmcnt(0)" ::: "memory"); __builtin_amdgcn_sched_barrier(0);
        if (j > 0) SB_LOAD_K(j - 1);
        unsigned pw[2][4][4];
#pragma unroll
        for (int s = 0; s < 2; ++s) {
            if (!alive[s]) {
#pragma unroll
                for (int x = 0; x < 4; ++x)
#pragma unroll
                    for (int y = 0; y < 4; ++y) pw[s][x][y] = 0u;
                continue; }
            f32x16 p0, p1;
#pragma unroll
            for (int r = 0; r < 16; ++r) { p0[r] = 0.f; p1[r] = 0.f; }
#pragma unroll
            for (int d0 = 0; d0 < 4; ++d0) { p0 = __builtin_amdgcn_mfma_f32_32x32x16_bf16(kf[2 * d0], qr[s][d0], p0, 0, 0, 0); p1 = __builtin_amdgcn_mfma_f32_32x32x16_bf16(kf[2 * d0 + 1], qr[s][d0], p1, 0, 0, 0); }
            const bool diag = (j == jd); const int kbase = 64 * j + 4 * hi; const int qabs = q0 + s * 32 + r32;
#pragma unroll
            for (int r = 0; r < 16; ++r) { const int k0 = kbase + (r & 3) + 8 * (r >> 2);
                float e0 = __builtin_amdgcn_exp2f(p0[r]), e1 = __builtin_amdgcn_exp2f(p1[r]);
                float r0 = __builtin_amdgcn_rcpf(1.0f + e0), r1 = __builtin_amdgcn_rcpf(1.0f + e1);
                if (diag) { if (k0 >= qabs) r0 = 1.0f; if (k0 + 32 >= qabs) r1 = 1.0f; }
                p0[r] = r0; p1[r] = r1; }
            float sfx[8][3], A[8];
#pragma unroll
            for (int i = 0; i < 8; ++i) { const float x0 = (i < 4) ? p0[4 * i] : p1[4 * i - 16], x1 = (i < 4) ? p0[4 * i + 1] : p1[4 * i - 15], x2 = (i < 4) ? p0[4 * i + 2] : p1[4 * i - 14], x3 = (i < 4) ? p0[4 * i + 3] : p1[4 * i - 13];
                sfx[i][2] = x3; sfx[i][1] = x3 * x2; sfx[i][0] = sfx[i][1] * x1; A[i] = sfx[i][0] * x0; }
            float T = carry[s], E[8];
#pragma unroll
            for (int i = 7; i >= 0; --i) { const auto sw = __builtin_amdgcn_permlane32_swap(__float_as_uint(A[i]), __float_as_uint(A[i]), false, false);
                const float partner = hi ? __uint_as_float(sw[0]) : __uint_as_float(sw[1]);
                E[i] = hi ? T : T * partner; T = T * (A[i] * partner); }
            carry[s] = T;
#pragma unroll
            for (int i = 0; i < 8; ++i) { float w4[4];
#pragma unroll
                for (int jj = 0; jj < 4; ++jj) { const float rv = (i < 4) ? p0[4 * i + jj] : p1[4 * i - 16 + jj]; const float beta = 1.0f - rv;
                    w4[jj] = beta * ((jj == 3) ? E[i] : E[i] * sfx[i][jj]); }
                pw[s][i >> 1][(i & 1) * 2] = pg8::cvt_pk_bf16(w4[0], w4[1]); pw[s][i >> 1][(i & 1) * 2 + 1] = pg8::cvt_pk_bf16(w4[2], w4[3]); }
        }
        if (j > 0) asm volatile("s_waitcnt vmcnt(8)" ::: "memory"); else asm volatile("s_waitcnt vmcnt(0)" ::: "memory");
        __builtin_amdgcn_sched_barrier(0);
        bf16x8 vf[8];
#pragma unroll
        for (int d0 = 0; d0 < 2; ++d0)
#pragma unroll
            for (int ks = 0; ks < 4; ++ks) {
                const s16x4 lo = __builtin_bit_cast(s16x4, __builtin_amdgcn_ds_read_tr16_b64_v4i16((LAS s16x4*)(vb + d0 * 4096 + ks * 1024)));
                const s16x4 hh = __builtin_bit_cast(s16x4, __builtin_amdgcn_ds_read_tr16_b64_v4i16((LAS s16x4*)(vb + d0 * 4096 + ks * 1024 + 512)));
                vf[d0 * 4 + ks] = (bf16x8){lo[0], lo[1], lo[2], lo[3], hh[0], hh[1], hh[2], hh[3]}; }
        asm volatile("s_waitcnt lgkmcnt(0)" ::: "memory"); __builtin_amdgcn_sched_barrier(0);
        const bool a0 = alive[0] && __any(carry[0] != 0.0f), a1 = alive[1] && __any(carry[1] != 0.0f);
        const bool more = (j > 0) && (a0 || a1);
        if (more) SB_LOAD_V(j - 1);
#pragma unroll
        for (int s = 0; s < 2; ++s) { if (!alive[s]) continue;
#pragma unroll
            for (int d0 = 0; d0 < 2; ++d0)
#pragma unroll
                for (int ks = 0; ks < 4; ++ks) { const bf16x8 pa = __builtin_bit_cast(bf16x8, (u32x4){pw[s][ks][0], pw[s][ks][1], pw[s][ks][2], pw[s][ks][3]});
                    o[s][d0] = __builtin_amdgcn_mfma_f32_32x32x16_bf16(pa, vf[d0 * 4 + ks], o[s][d0], 0, 0, 0); } }
        alive[0] = a0; alive[1] = a1;
        if (!more) break;
    }
    asm volatile("s_waitcnt vmcnt(0)" ::: "memory");
    LAS bf16_t* stg = (LAS bf16_t*)wl; const int l2 = pg8::fresh_lane();
#pragma unroll
    for (int s = 0; s < 2; ++s) {
#pragma unroll
        for (int r = 0; r < 16; ++r) { const int orow = crow(r, hi);
#pragma unroll
            for (int d0 = 0; d0 < 2; ++d0) stg[orow * 64 + d0 * 32 + r32] = (bf16_t)f2bf(o[s][d0][r]); }
        LDS_WAIT();
        bf16_t* Ow = MIXED + (rowbase + q0 + s * 32) * D + h * HD;
#pragma unroll
        for (int i = 0; i < 4; ++i) { const int row = i * 8 + (l2 >> 3), ch = l2 & 7; const u32x4 v = *(const LAS u32x4*)(stg + row * 64 + ch * 8);
            pg8::st16<2>(Ow + (size_t)row * D + ch * 8, v); float q = 0.f;
#pragma unroll
            for (int k = 0; k < 4; ++k) { const float a = __builtin_bit_cast(float, v[k] << 16), c = __builtin_bit_cast(float, v[k] & 0xffff0000u); q += a * a + c * c; }
            q += __shfl_xor(q, 1); q += __shfl_xor(q, 2); q += __shfl_xor(q, 4);
            if (ch == 0) ssq_add(SSQSB + rowbase + q0 + s * 32 + row, q); }
        LDS_WAIT();
    }
#undef SB_LOAD_K
#undef SB_LOAD_V
}

__device__ __forceinline__ f32x4 bf_lo(u32x4 v) { return (f32x4){__builtin_bit_cast(float, v.x << 16), __builtin_bit_cast(float, v.y << 16), __builtin_bit_cast(float, v.z << 16), __builtin_bit_cast(float, v.w << 16)}; }
__device__ __forceinline__ f32x4 bf_hi(u32x4 v) { return (f32x4){__builtin_bit_cast(float, v.x & 0xffff0000u), __builtin_bit_cast(float, v.y & 0xffff0000u), __builtin_bit_cast(float, v.z & 0xffff0000u), __builtin_bit_cast(float, v.w & 0xffff0000u)}; }
__device__ __forceinline__ void pool_item(int item, const bf16_t* QKVU, bf16_t* MIXED, int lane) {
    const int t0 = item * 8, tpos0 = t0 & (S - 1); const int g = lane >> 4, win = 2 << g;
    const bf16_t* zp = QKVU + (size_t)(t0 - 15) * INP + 3 * SBW + lane * 8;
    u32x4 v[23];
#pragma unroll
    for (int r = 0; r < 23; ++r) { v[r] = (u32x4){0u, 0u, 0u, 0u}; if (tpos0 - 15 + r >= 0) v[r] = *(const u32x4*)(zp + (size_t)r * INP); }
    f32x4 slo = (f32x4){0.f, 0.f, 0.f, 0.f}, shi = slo;
#pragma unroll
    for (int j = 0; j < 16; ++j) { const float mk = (j < win) ? 1.0f : 0.0f; slo += bf_lo(v[15 - j]) * mk; shi += bf_hi(v[15 - j]) * mk; }
    bf16_t* op = MIXED + (size_t)t0 * D + SBW + lane * 8;
#pragma unroll
    for (int i = 0; i < 8; ++i) {
        if (i > 0) { const u32x4 old = (g == 0) ? v[i + 13] : (g == 1) ? v[i + 11] : (g == 2) ? v[i + 7] : v[i - 1];
            slo += bf_lo(v[15 + i]) - bf_lo(old); shi += bf_hi(v[15 + i]) - bf_hi(old); }
        const int tp1 = tpos0 + i + 1; const float inv = 1.0f / (float)(tp1 < win ? tp1 : win);
        const f32x4 olo = slo * inv - bf_lo(v[15 + i]), ohi = shi * inv - bf_hi(v[15 + i]);
        float q = (olo[0] * olo[0] + olo[1] * olo[1]) + (olo[2] * olo[2] + olo[3] * olo[3]) + (ohi[0] * ohi[0] + ohi[1] * ohi[1]) + (ohi[2] * ohi[2] + ohi[3] * ohi[3]);
        const float rs = 1.0f / sqrtf(wave_sum(q) * (1.0f / PW) + EPS);
        u32x4 w;
#pragma unroll
        for (int k = 0; k < 4; ++k) w[k] = pg8::cvt_pk_bf16(olo[k] * rs, ohi[k] * rs);
        pg8::st16<3>(op + (size_t)i * D, w);
    }
}
__device__ __forceinline__ void p2_mix(const Args& a, LAS unsigned char* lds, int bx, int G, int wid, int lane, ssq_t* SSQSB) {
    unsigned char* ws = a.ws; const bf16_t* QKVU = (const bf16_t*)(ws + WS_QKVU); bf16_t* MIXED = (bf16_t*)(ws + WS_MIXED);
    constexpr int NA = B * NH * (S / 512);
    for (int i = 0; i * G + bx < NA; ++i) { const int w = pg8::xcd_remap(i * G + bx, NA); const int bh = w >> 3, qb = w & 7;
        sb_item(bh >> 3, bh & 7, qb * 8 + wid, QKVU, MIXED, SSQSB, lds + RING_OFF + wid * 16384, lane); }
    for (int it = bx * NWAVES + wid; it < NTOK / 8; it += G * NWAVES) pool_item(it, QKVU, MIXED, lane);
}
constexpr size_t BAR_REGION_OFF = 1 * MiB, BAR_REGION_STRIDE = 16 * 1024;
__global__ void __launch_bounds__(NWAVES * 64, 2) mega(Args args) {
    const int li = args.li;
    extern __shared__ __attribute__((aligned(16))) unsigned char lds_raw[];
    LAS unsigned char* lds = (LAS unsigned char*)lds_raw;
    volatile LAS unsigned* MISC = (volatile LAS unsigned*)(lds + MISC_OFF);
    const int wave = __builtin_amdgcn_readfirstlane((int)threadIdx.x >> 6);
#define LANE_ID() ({ int l_; asm volatile("v_mbcnt_lo_u32_b32 %0, -1, 0\n\tv_mbcnt_hi_u32_b32 %0, -1, %0" : "=v"(l_)); l_; })
    const int G = gridDim.x; const int bx = blockIdx.x; const int vcu = (G % 8 == 0) ? (bx % 8) * (G / 8) + bx / 8 : bx;
    for (int u = wave * 64 + LANE_ID(); u < MISC_BYTES / 4; u += NWAVES * 64) MISC[u] = 0u;
    __syncthreads();
    unsigned char* ws = args.ws;
    XcdBarrier bar = xcd_barrier_post((unsigned*)(ws + BAR_REGION_OFF + (size_t)li * BAR_REGION_STRIDE), MISC + 8);
    const int lo = args.ph_lo, hi = args.ph_hi;
    LAS unsigned char* ring = lds + RING_OFF; LAS unsigned char* epi = lds + EPI_OFF; LAS unsigned* gtab = (LAS unsigned*)(lds + GTAB_OFF);
#define IN(k) (lo <= (k) && (k) < hi)
#define SEAM(k) do { if (IN(k) && IN((k) + 1)) xcd_barrier(bar); } while (0)

    if (IN(0)) { p0_prologue(args, lds, vcu, G, wave, LANE_ID()); SEAM(0); }
    if (IN(1)) { SchedP1 S{G, bx, ws}; pg8::EpiBf16S E; pg8::gemm_phase<pg8::EpiBf16S, SchedP1, 0>(wave, ring, epi, gtab, D * 2, D * 2, D / 64, S, E);
        if (G == 256 && bx >= 64) p1_deferred_items(args, lds, bx - 64, wave, LANE_ID());
        else if (G != 256 && bx == 0) { for (int rk = 0; rk < 192; ++rk) p1_deferred_items(args, lds, rk, wave, LANE_ID()); }
        SEAM(1); }
    {
    const float* xin0 = args.in[0]; float* outp = args.out;
    bf16_t* S0p = (bf16_t*)(ws + WS_S0); ssq_t* SSQSBp = (ssq_t*)(ws + MK_SSQSB); ssq_t* SSQ1p = (ssq_t*)(ws + MK_SSQ1); ssq_t* SSQ2p = (ssq_t*)(ws + MK_SSQ2);
    constexpr size_t TSTEP = (size_t)256 * D * 2;
        if (IN(2)) { p2_mix(args, lds, bx, G, wave, LANE_ID(), (ssq_t*)(ws + MK_SSQSB)); SEAM(2); }

    if (IN(3)) { SchedReg S{G, bx, NTOK / 256, D / 256, (const char*)(ws + WS_MIXED), (const char*)(ws + WS_WOUT), TSTEP, TSTEP, nullptr, D, nullptr, nullptr};
        EpiResid<8, true, true> E{nullptr, S0p, ws + WS_X1F8, SSQ1p, SSQSBp, 1.0f}; pg8::gemm_phase<EpiResid<8, true, true>, SchedReg, 0>    (wave, ring, epi, gtab, D * 2, D * 2, D / 64, S, E); SEAM(3); }
    if (IN(4)) { SchedReg S{G, bx, NTOK / 256, D / 256, (const char*)(ws + WS_X1F8), (const char*)(ws + WS_WQ), TSTEP / 2, TSTEP / 2, (bf16_t*)(ws + WS_QM), D, nullptr, nullptr, SSQ1p};
        EpiBf16Ssq E{1.0f / D, C2_MEM / WSCALE}; pg8::gemm_phase<EpiBf16Ssq, SchedReg, 0, 1, 1, true>(wave, ring, epi, gtab, D, D, D / 128, S, E); }
    if (IN(5)) { SchedMS S{G, bx, ws}; EpiSoftmax E; pg8::gemm_phase<EpiSoftmax, SchedMS, 0>(wave, ring, epi, gtab, D * 2, D * 2, MHD / 64, S, E); }
    if (IN(6)) { SchedPV S{G, bx, ws}; pg8::EpiBf16S E; pg8::gemm_phase<pg8::EpiBf16S, SchedPV, 0>(wave, ring, epi, gtab, D * 2, NMEM * 2, NMEM / 64, S, E); SEAM(6); }
    if (IN(7)) { SchedReg S{G, bx, NTOK / 256, D / 256, (const char*)(ws + WS_OM), (const char*)(ws + WS_WO), TSTEP, TSTEP, nullptr, D, nullptr, nullptr};
        EpiResid<-1, true, true> E{nullptr, S0p, ws + WS_X2F8, SSQ2p, nullptr, 1.0f}; pg8::gemm_phase<EpiResid<-1, true, true>, SchedReg, 0>(wave, ring, epi, gtab, D * 2, D * 2, D / 64, S, E); SEAM(7); }
    if (IN(8)) { p8_route(args, lds, bx, G, wave, LANE_ID(), (int*)(ws + OFF_CNT)); SEAM(8); }
    if (IN(9)) { moe_table(args, MISC, wave * 64 + LANE_ID()); SchedMoE<8, true> S{G, bx, ws, MISC, args.in[18]}; EpiSwiGLU E{ws + WS_ACT};
        pg8::gemm_phase<EpiSwiGLU, SchedMoE<8, true>, 1, 1, 1, true>(wave, ring, epi, gtab, D, D, D / 128, S, E); SEAM(9); }
    if (IN(10)) { moe_table(args, MISC, wave * 64 + LANE_ID()); SchedMoE<4, false> S{G, bx, ws, MISC, args.in[20]}; EpiW2 E{ws + WS_Y};
        pg8::gemm_phase<EpiW2, SchedMoE<4, false>, 2, 1, 1, true>(wave, ring, epi, gtab, DFF, DFF, DFF / 128, S, E); SEAM(10); }
    if (IN(11)) { p11_final(args, vcu, G, wave, LANE_ID(), args.out); }
}

#undef IN
#undef SEAM
}
}

extern "C" void kernel_launch(void* const* d_in, const int* in_sizes, int n_in, void* d_out, int out_size, void* d_ws, size_t ws_size, hipStream_t stream) {
    if (n_in != 22 || out_size != NTOK * D || ws_size < WS_END) { fprintf(stderr, "kernel_launch: unexpected shapes (n_in %d out %d ws %zu)\n", n_in, out_size, ws_size); return; }
    static int grid = 0;
    if (grid == 0) {
        int dev = 0, cus = 0;
        if (hipGetDevice(&dev) != hipSuccess || hipDeviceGetAttribute(&cus, hipDeviceAttributeMultiprocessorCount, dev) != hipSuccess) { grid = -1; return; }
        if (hipFuncSetAttribute((const void*)mk::mega, hipFuncAttributeMaxDynamicSharedMemorySize, mk::LDS_BYTES) != hipSuccess) { fprintf(stderr, "kernel_launch: hipFuncSetAttribute failed\n"); grid = -1; return; }
        int per_cu = 0; (void)hipOccupancyMaxActiveBlocksPerMultiprocessor(&per_cu, (const void*)mk::mega, mk::NWAVES * 64, mk::LDS_BYTES); (void)hipGetLastError();
        if (per_cu < 1) fprintf(stderr, "kernel_launch: occupancy query reports %d blocks per CU\n", per_cu);
        grid = cus;
    }
    if (grid < 0) return;
    (void)hipMemsetAsync((unsigned char*)d_ws + WS_CTL, 0, CTL_BYTES, stream);
    mk::Args a{}; for (int i = 0; i < 22; ++i) a.in[i] = (const float*)d_in[i]; a.out = (float*)d_out; a.ws = (unsigned char*)d_ws;
    a.ph_lo = 0; a.ph_hi = mk::NPHASE; a.li = 0;
    hipLaunchKernelGGL(mk::mega, dim3(grid), dim3(mk::NWAVES * 64), mk::LDS_BYTES, stream, a);
}
```

```cpp
#include <hip/hip_runtime.h>
#include <cstdio>
#include <cstdint>

typedef unsigned short bf16_t;
typedef short bf16x8 __attribute__((ext_vector_type(8)));
typedef float f32x4 __attribute__((ext_vector_type(4)));
typedef unsigned u32x4 __attribute__((ext_vector_type(4)));

namespace cfg {
constexpr int B = 8, S = 4096, D = 1024, NTOK = B * S;
constexpr int SBW = 512, NH = 8, HD = 64, PW = 512, PG = 4, PGD = 128, INP = 2048;
constexpr int NMEM = 256, MH = 4, MHD = 256, NMROWS = B * NMEM;
constexpr int NE = 32, TOPK = 4, DFF = 1024, LCAP = NTOK;
constexpr float EPS = 1e-5f, LOG2E = 1.4426950408889634f;
constexpr float C2_SB = 0.125f * LOG2E, C2_MEM = 0.0625f * LOG2E;
constexpr float SW_LIMIT = 7.0f, SW_ALPHA = 1.702f;
constexpr int MAXTILES = 544;
constexpr size_t MiB = 1u << 20;
constexpr size_t WS_CTL = 0, CTL_BYTES = 2 * MiB;
constexpr size_t OFF_CNT = 64 * 1024, OFF_SSQSB = 512 * 1024, OFF_SSQ1 = 640 * 1024, OFF_SSQ2 = 768 * 1024;
constexpr size_t WS_WIN = 2 * MiB, WS_WOUT = 6 * MiB, WS_WQ = 8 * MiB, WS_WKV = 10 * MiB, WS_WO = 14 * MiB, WS_WP = 16 * MiB, WS_WR = 17 * MiB;
constexpr size_t WS_RSTDX = 18 * MiB, WS_RSTDM = 18 * MiB + 512 * 1024;
constexpr size_t WS_W1 = 20 * MiB, WS_W2 = 148 * MiB;
constexpr size_t WS_S0 = 212 * MiB;
constexpr size_t WS_QKVU = 276 * MiB;
constexpr size_t WS_QM = 276 * MiB, WS_OM = 340 * MiB;
constexpr size_t WS_MIXED = 404 * MiB;
constexpr size_t WS_PM = 404 * MiB;
constexpr size_t WS_ACT = 276 * MiB;
constexpr size_t WS_KM = 548 * MiB, WS_VMT = 552 * MiB, WS_MEMB = 556 * MiB, WS_LSLOT = 560 * MiB, WS_LGATE = 564 * MiB;
constexpr size_t WS_Y = 568 * MiB;
constexpr size_t WS_SCR_S = 568 * MiB, WS_SCR_POOLED = 696 * MiB, WS_SCR_POOLO = 728 * MiB;
constexpr size_t WS_END = 824 * MiB;
}
using namespace cfg;

__device__ __forceinline__ unsigned f2bf(float f) { unsigned u = __builtin_bit_cast(unsigned, f); return (u + 0x7fffu + ((u >> 16) & 1u)) >> 16; }
__device__ __forceinline__ float bf2f(bf16_t h) { return __builtin_bit_cast(float, (unsigned)h << 16); }
__device__ __forceinline__ float wave_sum(float v) {
#pragma unroll
    for (int o = 1; o < 64; o <<= 1) v += __shfl_xor(v, o);
    return v;
}


#define LAS __attribute__((address_space(3)))
#define GAS __attribute__((address_space(1)))
typedef int v4i_t __attribute__((ext_vector_type(4)));
typedef int v8i_t __attribute__((ext_vector_type(8)));
namespace pg8 {
constexpr int BM = 256, BK = 64, HALF = 128, HTB = HALF * BK * 2, STAGE_BYTES = 8 * HTB, NXCD = 8, WGM = 8;
__host__ __device__ __forceinline__ int lds_byte(int r, int c) { const int st = (r >> 4) * 2 + (c >> 5), rr = r & 15, cc = c & 31, ob = rr * 64 + cc * 2; return st * 1024 + (ob ^ (((ob >> 9) & 1) << 5)); }
__host__ __device__ __forceinline__ void stage_rc(int b, int& R, int& C) { const int st = b / 1024, sb = b % 1024, swz = sb ^ (((sb >> 9) & 1) << 5); R = (st >> 1) * 16 + swz / 64; C = (st & 1) * 32 + (swz % 64) / 2; }
__host__ __device__ __forceinline__ int perm32(int rho) { const int n = rho >> 4, i = rho & 15; return 8 * (i >> 2) + 4 * n + (i & 3); }
__device__ __forceinline__ unsigned cvt_pk_bf16(float lo, float hi) { unsigned r; asm volatile("v_cvt_pk_bf16_f32 %0, %1, %2" : "=v"(r) : "v"(lo), "v"(hi)); return r; }

#define WTMASK 0x008
#ifndef WTMASK
#define WTMASK 0x1ff
#endif
#define WT_ON(bit) (((WTMASK) >> (bit)) & 1)
__device__ __forceinline__ void st16_wt(void* p, u32x4 v) { asm volatile("global_store_dwordx4 %0, %1, off sc1\n\ts_nop 1" :: "v"(p), "v"(v)); }
__device__ __forceinline__ void st16_wt(void* p, f32x4 v) { asm volatile("global_store_dwordx4 %0, %1, off sc1\n\ts_nop 1" :: "v"(p), "v"(v)); }
template <int BIT, class V> __device__ __forceinline__ void st16(void* p, V v) { if constexpr (WT_ON(BIT)) st16_wt(p, v); else *(V*)p = v; }
#ifndef WT8
#define WT8 0
#endif
__device__ __forceinline__ void st8_wt(void* p, unsigned long long v) { if (WT8) __hip_atomic_store((unsigned long long*)p, v, __ATOMIC_RELAXED, __HIP_MEMORY_SCOPE_AGENT); else *(unsigned long long*)p = v; }
__device__ __forceinline__ void st4_wt(void* p, unsigned v) { if (WT8) __hip_atomic_store((unsigned*)p, v, __ATOMIC_RELAXED, __HIP_MEMORY_SCOPE_AGENT); else *(unsigned*)p = v; }
template <int M> __device__ __forceinline__ float swz_xor(float v) { return __uint_as_float((unsigned)__builtin_amdgcn_ds_swizzle((int)__float_as_uint(v), (M << 10) | 0x1f)); }
__device__ __forceinline__ float half_sum(float v) { const auto sw = __builtin_amdgcn_permlane32_swap(__float_as_uint(v), __float_as_uint(v), false, false); return __uint_as_float(sw[0]) + __uint_as_float(sw[1]); }
__device__ __forceinline__ float half_max(float v) { const auto sw = __builtin_amdgcn_permlane32_swap(__float_as_uint(v), __float_as_uint(v), false, false); return fmaxf(__uint_as_float(sw[0]), __uint_as_float(sw[1])); }
__device__ __forceinline__ float wsum(float v) { v += swz_xor<1>(v); v += swz_xor<2>(v); v += swz_xor<4>(v); v += swz_xor<8>(v); v += swz_xor<16>(v); return half_sum(v); }
__device__ __forceinline__ int fresh_lane() { int l; asm volatile("v_mbcnt_lo_u32_b32 %0, -1, 0\n\tv_mbcnt_hi_u32_b32 %0, -1, %0" : "=v"(l)); return l; }
struct Unit { const char* A; const char* B; void* p0; void* p1; void* p2; void* p3; int pm, pn, i0, i1, ghost; };

__device__ __forceinline__ int xcd_remap(int L, int nwg) { const int q = nwg / NXCD, r = nwg % NXCD, xcd = L % NXCD, off = L / NXCD; return __builtin_amdgcn_readfirstlane((xcd < r ? xcd * (q + 1) : r * (q + 1) + (xcd - r) * q) + off); }
__device__ __forceinline__ void grouped_mn(int wgid, int nM, int nN, int& pm, int& pn) {
    const int nig = WGM * nN, gid = wgid / nig, fm = gid * WGM, gsz = (nM - fm) < WGM ? (nM - fm) : WGM; pm = __builtin_amdgcn_readfirstlane(fm + ((wgid % nig) % gsz)); pn = __builtin_amdgcn_readfirstlane((wgid % nig) / gsz); }

template <class Epi, class Sched, int TABS, int REP = 1  , int REPE = 1, bool F8 = false>
__device__ __forceinline__ void gemm_phase(const int wid, LAS unsigned char* lds, LAS unsigned char* epi_lds, LAS unsigned* gtab, const int lda_b, const int ldb_b, const int nt, const Sched& S, const Epi& E) {
    constexpr bool GATHER = (TABS == 1);
    const int wr = wid >> 2, wc = wid & 3;
    unsigned voffA, voffB, voffG[2][2]; int aoff, boff;
    { const int lane = fresh_lane(); int R, C; stage_rc(wid * 1024 + lane * 16, R, C); const int Rb = Epi::PERM ? ((R & ~31) + perm32(R & 31)) : R;
      voffA = (unsigned)(R * lda_b + C * 2); voffB = (unsigned)(Rb * ldb_b + C * 2); voffG[0][0] = voffG[0][1] = voffG[1][0] = voffG[1][1] = 0;
      aoff = lds_byte(wr * 64 + (lane & 15), (lane >> 4) * 8); boff = lds_byte(wc * 32 + (lane & 15), (lane >> 4) * 8); }
    const size_t kstep = (size_t)(BK * 2);
    const size_t hstepA = (size_t)HALF * lda_b, hstepB = (size_t)HALF * ldb_b;
    const unsigned ldsw = (unsigned)wid * 1024u; const unsigned ldsbase = (unsigned)(uintptr_t)lds + ldsw;
#define PG8_SA(b, h) (((b) * 2 + (h)) * HTB)
#define PG8_SB(b, h) ((4 + (b) * 2 + (h)) * HTB)
#define PG8_GLDS(ugp, voff, bufoff, _i) do { unsigned _keep; asm volatile("s_mov_b32 %0, m0\n\ts_mov_b32 m0, %3\n\ts_nop 0\n\tglobal_load_lds_dwordx4 %1, %2\n\ts_mov_b32 m0, %0" \
        : "=&s"(_keep) : "v"(voff), "s"((const char*)(ugp)), "s"(ldsbase + (unsigned)((bufoff) + (_i) * 8192)) : "memory"); } while (0)
#define PG8_STAGE_B(bufoff, gbase) do { _Pragma("unroll") for (int _i = 0; _i < 2; ++_i) PG8_GLDS((const char*)(gbase) + (size_t)_i * 64 * ldb_b, voffB, bufoff, _i); } while (0)
#define PG8_STAGE_A(bufoff, gbase, h) do { if constexpr (GATHER) { _Pragma("unroll") for (int _i = 0; _i < 2; ++_i) PG8_GLDS((const char*)(gbase), voffG[h][_i], bufoff, _i); } \
        else { _Pragma("unroll") for (int _i = 0; _i < 2; ++_i) PG8_GLDS((const char*)(gbase) + (h) * hstepA + (size_t)_i * 64 * lda_b, voffA, bufoff, _i); } } while (0)
#define PG8_LDA(dst, b, h) do { _Pragma("unroll") for (int m = 0; m < 4; ++m) _Pragma("unroll") for (int k = 0; k < 2; ++k) dst[m][k] = *(const LAS bf16x8*)(lds + PG8_SA(b, h) + aoff + m * 2048 + k * 1024); } while (0)
#define PG8_LDB(dst, b, h) do { _Pragma("unroll") for (int n = 0; n < 2; ++n) _Pragma("unroll") for (int k = 0; k < 2; ++k) dst[n][k] = *(const LAS bf16x8*)(lds + PG8_SB(b, h) + boff + n * 2048 + k * 1024); } while (0)
#define PG8_CAT(x0, x1) __builtin_shufflevector(__builtin_bit_cast(v4i_t, x0), __builtin_bit_cast(v4i_t, x1), 0, 1, 2, 3, 4, 5, 6, 7)
#define PG8_MMA(ai, bj, At, Bt) do { __builtin_amdgcn_s_setprio(1); _Pragma("unroll") for (int m = 0; m < 4; ++m) _Pragma("unroll") for (int n = 0; n < 2; ++n) { \
        if constexpr (F8) acc[ai][bj][m][n] = __builtin_amdgcn_mfma_scale_f32_16x16x128_f8f6f4(PG8_CAT(Bt[n][0], Bt[n][1]), PG8_CAT(At[m][0], At[m][1]), acc[ai][bj][m][n], 0, 0, 0, 0, 0, 0); \
        else { _Pragma("unroll") for (int k = 0; k < 2; ++k) acc[ai][bj][m][n] = __builtin_amdgcn_mfma_f32_16x16x32_bf16(Bt[n][k], At[m][k], acc[ai][bj][m][n], 0, 0, 0); } } __builtin_amdgcn_s_setprio(0); } while (0)
#define PG8_WAIT_V(n) asm volatile("s_waitcnt vmcnt(" #n ")" ::: "memory")
#define PG8_WAIT_L(n) asm volatile("s_waitcnt lgkmcnt(" #n ")" ::: "memory")
#define PG8_BAR __builtin_amdgcn_s_barrier()
#define PG8_SCHED __builtin_amdgcn_sched_barrier(0)
#define PG8_GTAB_LOAD(buf, nvalid) do { const int _l = fresh_lane(); int _R, _C; stage_rc(wid * 1024 + _l * 16, _R, _C); _Pragma("unroll") for (int _h = 0; _h < 2; ++_h) _Pragma("unroll") for (int _i = 0; _i < 2; ++_i) { \
        const int _row = _h * HALF + _R + 64 * _i; const unsigned _s = gtab[(buf) * 768 + _row]; voffG[_h][_i] = ((_row < (nvalid)) ? (_s >> 2) * (unsigned)lda_b : 0u) + (unsigned)(_C * 2); } } while (0)
#define PG8_GTAB_DMA(buf, U) do { if constexpr (TABS == 3) { if (wid == 1 || wid == 2) { const char* _b = (wid == 1) ? (const char*)(U).p1 : (const char*)(U).p2;     \
            if (_b) __builtin_amdgcn_global_load_lds((const unsigned*)(_b + fresh_lane() * 16), (LAS unsigned*)(gtab + (buf) * 768 + wid * 256), 16, 0, 0); } } \
        else if (wid < 3) { const int _l = fresh_lane(); const char* _src = (wid == 0) ? (const char*)(U).p3 + _l * 16 : (wid == 1) ? (const char*)(U).p2 + _l * 16 : \
            (TABS == 1 ? (const char*)(U).p1 + (_l & 31) * 16 + (_l >> 5) * (DFF * 4) : (const char*)(U).p1 + _l * 16); \
        __builtin_amdgcn_global_load_lds((const unsigned*)_src, (LAS unsigned*)(gtab + (buf) * 768 + wid * 256), 16, 0, 0); } } while (0)
    auto nextu = [&](int i, Unit& u) -> bool { if constexpr (REP > 1) { const bool ok = S.next(i / REP, u); u.ghost = (i % REP) != REP - 1; return ok; } else { u.ghost = 0; return S.next(i, u); } };
    Unit cur, nxt; int ui = 0;
    if (!nextu(0, cur)) return;
    f32x4 acc[2][2][4][2];
#pragma unroll
    for (int a = 0; a < 2; ++a)
#pragma unroll
        for (int b = 0; b < 2; ++b)
#pragma unroll
            for (int m = 0; m < 4; ++m)
#pragma unroll
                for (int n = 0; n < 2; ++n) acc[a][b][m][n] = (f32x4){0.f, 0.f, 0.f, 0.f};
    bf16x8 At[4][2], B0[2][2], B1[2][2];
    const char* cA = cur.A; const char* cB = cur.B;
    if constexpr (TABS != 0) { PG8_GTAB_DMA(0, cur); PG8_WAIT_V(0); PG8_WAIT_L(0); PG8_BAR; if constexpr (GATHER) PG8_GTAB_LOAD(0, cur.i0); }
    PG8_STAGE_B(PG8_SB(0, 0), cB); PG8_STAGE_B(PG8_SB(0, 1), cB + hstepB); PG8_STAGE_A(PG8_SA(0, 0), cA, 0); PG8_STAGE_A(PG8_SA(0, 1), cA, 1);
    if (wr == 1) PG8_BAR;
    PG8_WAIT_V(2); PG8_BAR;
    PG8_STAGE_B(PG8_SB(1, 0), cB + kstep); PG8_STAGE_A(PG8_SA(1, 0), cA + kstep, 0); PG8_STAGE_B(PG8_SB(1, 1), cB + hstepB + kstep);
    PG8_WAIT_V(6); PG8_BAR;
    for (;;) {
        const bool has_next = nextu(ui + 1, nxt);
        const char* nA = has_next ? nxt.A : cA; const char* nB = has_next ? nxt.B : cB;
#pragma unroll 1
        for (int t = 0; t < nt; t += 2) {
            const bool last = (t == nt - 2);
            const char* a1 = cA + (size_t)(t + 1) * kstep;
            const char* a2 = last ? nA : cA + (size_t)(t + 2) * kstep; const char* b2 = last ? nB : cB + (size_t)(t + 2) * kstep;
            const char* a3 = a2 + kstep; const char* b3 = b2 + kstep;
            if constexpr (Epi::MIDK >= 0) { if (t == Epi::MIDK) E.midk(acc, cur, wr, fresh_lane() & 15); }
            if constexpr (TABS != 0) { if (t == 2 && has_next) PG8_GTAB_DMA((ui + 1) & 1, nxt); }
            if constexpr (GATHER) { PG8_STAGE_A(PG8_SA(1, 1), a1, 1); if (last && has_next) PG8_GTAB_LOAD((ui + 1) & 1, nxt.i0); PG8_SCHED; }
            PG8_LDB(B0, 0, 0); PG8_LDB(B1, 0, 1); PG8_SCHED; PG8_LDA(At, 0, 0); if constexpr (!GATHER) PG8_STAGE_A(PG8_SA(1, 1), a1, 1);
            PG8_WAIT_V(8); PG8_WAIT_L(0); PG8_BAR; PG8_MMA(0, 0, At, B0); PG8_MMA(0, 1, At, B1); PG8_BAR; PG8_SCHED;
            PG8_LDA(At, 0, 1); PG8_STAGE_B(PG8_SB(0, 0), b2); PG8_STAGE_B(PG8_SB(0, 1), b2 + hstepB); PG8_STAGE_A(PG8_SA(0, 0), a2, 0);
            PG8_WAIT_V(8); PG8_WAIT_L(0); PG8_BAR; PG8_MMA(1, 0, At, B0); PG8_MMA(1, 1, At, B1); PG8_BAR; PG8_SCHED;
            PG8_LDB(B0, 1, 0); PG8_LDB(B1, 1, 1); PG8_SCHED; PG8_LDA(At, 1, 0); PG8_STAGE_A(PG8_SA(0, 1), a2, 1);
            PG8_WAIT_V(8); PG8_WAIT_L(0); PG8_BAR; PG8_MMA(0, 0, At, B0); PG8_MMA(0, 1, At, B1); PG8_BAR; PG8_SCHED;
            PG8_LDA(At, 1, 1); PG8_STAGE_B(PG8_SB(1, 0), b3); PG8_STAGE_B(PG8_SB(1, 1), b3 + hstepB); PG8_STAGE_A(PG8_SA(1, 0), a3, 0);
            PG8_WAIT_V(8); PG8_WAIT_L(0); PG8_BAR; PG8_MMA(1, 0, At, B0); PG8_MMA(1, 1, At, B1); PG8_BAR; PG8_SCHED;
        }
        if (wr == 0) PG8_BAR;
        if (!cur.ghost) { const int el = fresh_lane(); LAS unsigned char* ex = (TABS != 0) ? (LAS unsigned char*)(gtab + (ui & 1) * 768) : epi_lds; E(acc, cur, wr, wc, el & 15, el >> 4, wid, el, ex); if constexpr (REPE > 1) { asm volatile("" ::: "memory"); E(acc, cur, wr, wc, el & 15, el >> 4, wid, el, ex); } }
        if (!has_next) break;
#pragma unroll
        for (int a = 0; a < 2; ++a)
#pragma unroll
            for (int b = 0; b < 2; ++b)
#pragma unroll
                for (int m = 0; m < 4; ++m)
#pragma unroll
                    for (int n = 0; n < 2; ++n) acc[a][b][m][n] = (f32x4){0.f, 0.f, 0.f, 0.f};
        cur = nxt; cA = nA; cB = nB; ++ui;
        if (wr == 1) PG8_BAR;
    }
    PG8_WAIT_V(0);
    PG8_BAR;
#undef PG8_SA
#undef PG8_SB
#undef PG8_GLDS
#undef PG8_STAGE_A
#undef PG8_STAGE_B
#undef PG8_LDA
#undef PG8_LDB
#undef PG8_MMA
#undef PG8_CAT
#undef PG8_WAIT_V
#undef PG8_WAIT_L
#undef PG8_BAR
#undef PG8_SCHED
#undef PG8_GTAB_LOAD
#undef PG8_GTAB_DMA
}

template <bool F8O> struct EpiBf16SX {
    static constexpr bool PERM = true; static constexpr int MIDK = -1;
    __device__ __forceinline__ void midk(f32x4 (&)[2][2][4][2], const Unit&, int, int) const {}
    __device__ __forceinline__ void operator()(const f32x4 (&acc)[2][2][4][2], const Unit& u, int wr, int wc, int fr, int fq, int, int, LAS unsigned char*) const {
        bf16_t* O = (bf16_t*)u.p0; unsigned char* O8 = (unsigned char*)u.p0; const float* rs = (const float*)u.p1; const float* cs = (const float*)u.p2; const int ldc = u.i0;
        int r0 = wr * 64 + fr, c0 = wc * 32 + 8 * fq; asm volatile("" : "+v"(r0), "+v"(c0));
        f32x4 cv[2][2];
#pragma unroll
        for (int bj = 0; bj < 2; ++bj)
#pragma unroll
            for (int n = 0; n < 2; ++n) cv[bj][n] = cs ? *(const f32x4*)(cs + c0 + bj * HALF + 4 * n) : (f32x4){1.f, 1.f, 1.f, 1.f};
#pragma unroll
        for (int ai = 0; ai < 2; ++ai)
#pragma unroll
            for (int m = 0; m < 4; ++m) { const int r = r0 + ai * HALF + m * 16; const float rv = rs ? rs[r] : 1.f; bf16_t* rowp = O + (size_t)r * ldc + c0;
#pragma unroll
                for (int bj = 0; bj < 2; ++bj) { const f32x4 v0 = acc[ai][bj][m][0] * cv[bj][0] * rv, v1 = acc[ai][bj][m][1] * cv[bj][1] * rv;
                    if constexpr (F8O) { int w0 = __builtin_amdgcn_cvt_pk_fp8_f32(v0[0], v0[1], 0, false); w0 = __builtin_amdgcn_cvt_pk_fp8_f32(v0[2], v0[3], w0, true); int w1 = __builtin_amdgcn_cvt_pk_fp8_f32(v1[0], v1[1], 0, false); w1 = __builtin_amdgcn_cvt_pk_fp8_f32(v1[2], v1[3], w1, true);
                        st8_wt(O8 + (size_t)r * ldc + c0 + bj * HALF, (unsigned long long)(unsigned)w0 | ((unsigned long long)(unsigned)w1 << 32)); }
                    else { u32x4 w; w.x = cvt_pk_bf16(v0[0], v0[1]); w.y = cvt_pk_bf16(v0[2], v0[3]); w.z = cvt_pk_bf16(v1[0], v1[1]); w.w = cvt_pk_bf16(v1[2], v1[3]);
                    st16<1>(rowp + bj * HALF, w); } } }
    }
};
typedef EpiBf16SX<false> EpiBf16S;
struct EpiBf16T {
    static constexpr bool PERM = true; static constexpr int MIDK = -1;
    __device__ __forceinline__ void midk(f32x4 (&)[2][2][4][2], const Unit&, int, int) const {}
    __device__ __forceinline__ void operator()(const f32x4 (&acc)[2][2][4][2], const Unit& u, int wr, int wc, int fr, int fq, int, int, LAS unsigned char* tab) const {
        bf16_t* O = (bf16_t*)u.p0; const bool has_rs = u.p1 != nullptr, has_cs = u.p2 != nullptr; const int ldc = u.i0;
        const LAS float* T1 = (const LAS float*)tab + 256; const LAS float* T2 = (const LAS float*)tab + 512;
        int r0 = wr * 64 + fr, c0 = wc * 32 + 8 * fq; asm volatile("" : "+v"(r0), "+v"(c0));
        f32x4 cv[2][2];
#pragma unroll
        for (int bj = 0; bj < 2; ++bj)
#pragma unroll
            for (int n = 0; n < 2; ++n) cv[bj][n] = has_cs ? *(const LAS f32x4*)(T2 + c0 + bj * HALF + 4 * n) : (f32x4){1.f, 1.f, 1.f, 1.f};
#pragma unroll
        for (int ai = 0; ai < 2; ++ai)
#pragma unroll
            for (int m = 0; m < 4; ++m) { const int r = r0 + ai * HALF + m * 16; const float rv = has_rs ? T1[r] : 1.f; bf16_t* rowp = O + (size_t)r * ldc + c0;
#pragma unroll
                for (int bj = 0; bj < 2; ++bj) { const f32x4 v0 = acc[ai][bj][m][0] * cv[bj][0] * rv, v1 = acc[ai][bj][m][1] * cv[bj][1] * rv;
                    u32x4 w; w.x = cvt_pk_bf16(v0[0], v0[1]); w.y = cvt_pk_bf16(v0[2], v0[3]); w.z = cvt_pk_bf16(v1[0], v1[1]); w.w = cvt_pk_bf16(v1[2], v1[3]);
                    st16<1>(rowp + bj * HALF, w); } }
    }
};
}

namespace mk {
constexpr int NWAVES = 8, NPHASE = 12;
constexpr int RING_OFF = 0, RING_BYTES = 131072, EPI_OFF = 131072, EPI_BYTES = 8192, GTAB_OFF = EPI_OFF + EPI_BYTES, GTAB_BYTES = 6144, MISC_OFF = GTAB_OFF + GTAB_BYTES, MISC_BYTES = 1024;
constexpr int LDS_BYTES = 147456;
static_assert(MISC_OFF + MISC_BYTES <= LDS_BYTES, "LDS map");
constexpr size_t WS_LRS = 84 * MiB;
constexpr size_t WS_X2F8 = WS_Y, WS_X1F8 = WS_Y + 32 * MiB;
constexpr size_t WS_CSG1 = 19 * MiB, WS_WRH = 19 * MiB + 64 * 1024, WS_WRL = 19 * MiB + 128 * 1024;
typedef unsigned ssq_t;
constexpr size_t MK_SSQSB = 256 * 1024, MK_SSQ1 = 512 * 1024, MK_SSQ2 = 768 * 1024;
__device__ __forceinline__ void ssq_add(ssq_t* p, float q) { (void)__hip_atomic_fetch_add(p, (ssq_t)__float2uint_rn(q * 16384.0f), __ATOMIC_RELAXED, __HIP_MEMORY_SCOPE_AGENT); }
__device__ __forceinline__ float ssq_get(const ssq_t* p) { return (float)(*p) * (1.0f / 16384.0f); }
constexpr float WSCALE = 32.0f;
constexpr int P2_DEFER = 2048 * 6;
constexpr int P0_DEFER = 192 * 8 * 6;
constexpr int CW_BAR = 1024;

#define RLX_AGENT __ATOMIC_RELAXED, __HIP_MEMORY_SCOPE_AGENT
#define LDS_WAIT() asm volatile("s_waitcnt lgkmcnt(0)" ::: "memory")
#define VM_WAIT() asm volatile("s_waitcnt vmcnt(0)" ::: "memory")
#define XB_TMO      128
#define XB_XCNT(j)  (256  + 64 * (j))
#define XB_XSUB(j)  (1280 + 64 * (j))
#define XB_XGEN(j)  (2304 + 64 * (j))
#define XB_TOP      3328
#define XB_TOPGEN   3392
#define XCD_BAR_WORDS 3456
#define XB_SPIN_CAP (1u << 20)
__device__ __forceinline__ unsigned xb_ld(unsigned* p)              { return __hip_atomic_load(p, __ATOMIC_RELAXED, __HIP_MEMORY_SCOPE_AGENT); }
__device__ __forceinline__ unsigned xb_add(unsigned* p, unsigned v) { return __hip_atomic_fetch_add(p, v, __ATOMIC_RELAXED, __HIP_MEMORY_SCOPE_AGENT); }
__device__ __forceinline__ unsigned xb_xcc_id() { return (unsigned)__builtin_amdgcn_s_getreg((3 << 11) | 20) & 0xFu; }
#define XB_SPIN(cond, bar) do { unsigned _sp = 0; while (cond) { __builtin_amdgcn_s_sleep(1); \
    if ((++_sp & 255u) == 0u) { if (xb_ld(&(bar)[XB_TMO])) break; if (_sp > XB_SPIN_CAP) { atomicAdd(&(bar)[XB_TMO], 1u); break; } } } } while (0)
struct XcdBarrier { unsigned* bar; unsigned x; volatile LAS unsigned* st; };
__device__ __forceinline__ XcdBarrier xcd_barrier_post(unsigned* bar, volatile LAS unsigned* st) {
    XcdBarrier b; b.bar = bar; b.x = xb_xcc_id(); b.st = st;
    if (threadIdx.x == 0) (void)xb_add(&bar[XB_XCNT(b.x)], 1u);
    return b;
}
__device__ __forceinline__ void xcd_barrier_complete(unsigned* bar, unsigned x, unsigned& nloc, unsigned& nx) {
    const unsigned G = gridDim.x * gridDim.y * gridDim.z;
    unsigned sum, cnt, mine, sp = 0u;
    for (;;) {
        sum = 0u; cnt = 0u; mine = 0u;
#pragma unroll
        for (unsigned j = 0; j < 16; ++j) { const unsigned c = xb_ld(&bar[XB_XCNT(j)]); sum += c; cnt += (c > 0u) ? 1u : 0u; mine = (j == x) ? c : mine; }
        if (sum == G) break;
        __builtin_amdgcn_s_sleep(1);
        if ((++sp & 255u) == 0u) { if (xb_ld(&bar[XB_TMO])) break; if (sp > XB_SPIN_CAP) { atomicAdd(&bar[XB_TMO], 1u); break; } }
    }
    nloc = mine > 0u ? mine : 1u; nx = cnt > 0u ? cnt : 1u;
}
__device__ __forceinline__ void xcd_barrier(const XcdBarrier& b) {
    asm volatile("s_waitcnt vmcnt(0)" ::: "memory");
    __syncthreads();
    if (threadIdx.x == 0) {
        unsigned* bar = b.bar;
        __builtin_amdgcn_s_waitcnt(0);
        unsigned nloc = b.st[0], nx = b.st[1];
        if (nloc == 0u) { xcd_barrier_complete(bar, b.x, nloc, nx); b.st[0] = nloc; b.st[1] = nx; }
        const unsigned old = xb_add(&bar[XB_XSUB(b.x)], 1u);
        const unsigned gen = old / nloc;
        if (old + 1u == (gen + 1u) * nloc) {
            __builtin_amdgcn_fence(__ATOMIC_RELEASE, "agent");
            asm volatile("s_waitcnt vmcnt(0)" ::: "memory");
            const unsigned og = xb_add(&bar[XB_TOP], 1u);
            const unsigned tg = og / nx;
            if (og + 1u == (tg + 1u) * nx) xb_add(&bar[XB_TOPGEN], 1u);
            else XB_SPIN(xb_ld(&bar[XB_TOPGEN]) == tg, bar);
            __builtin_amdgcn_fence(__ATOMIC_ACQUIRE, "agent");
            xb_add(&bar[XB_XGEN(b.x)], 1u);
            asm volatile("s_waitcnt vmcnt(0)" ::: "memory");
        } else {
            XB_SPIN(xb_ld(&bar[XB_XGEN(b.x)]) == gen, bar);
            __builtin_amdgcn_fence(__ATOMIC_ACQUIRE, "agent");
            asm volatile("s_waitcnt vmcnt(0)" ::: "memory");
        }
    }
    __syncthreads();
}

struct Args { const float* in[22]; float* out; unsigned char* ws; int ph_lo, ph_hi, li, pad; };

template <bool F8OUT>
__device__ __forceinline__ void p0_item(const float* W, int K, int N, void* WTv, const float* gk, const float* gk2, int ksplit, const float* gn, int mode, LAS float* scr, int item, int lane, float mult = 1.0f, int nblk_dec = 0) {
    const int nblk = nblk_dec ? nblk_dec : N / 32, kb = item / nblk, nb = item % nblk, k0 = 64 * kb, nd0 = 32 * nb;
    int ns0 = nd0; if (mode == 1) { const int pn = nd0 >> 8, j = nd0 & 255; ns0 = (j < 128) ? 128 * pn + j : 1024 + 128 * pn + (j - 128); }
    const int kr = lane >> 3, n4 = (lane & 7) * 4;
    f32x4 v[8];
#pragma unroll
    for (int i = 0; i < 8; ++i) v[i] = __builtin_nontemporal_load((const f32x4*)(W + (size_t)(k0 + 8 * i + kr) * N + ns0 + n4));
    f32x4 gnv = (f32x4){1.f, 1.f, 1.f, 1.f}; if (gn) gnv = *(const f32x4*)(gn + ns0 + n4);
#pragma unroll
    for (int i = 0; i < 8; ++i) { const int kk = 8 * i + kr, k = k0 + kk; float g = 1.f; if (gk) g = (k < ksplit) ? gk[k] : gk2[k - ksplit];
        const f32x4 t = v[i] * gnv * (g * mult); LAS float* d = scr + kk * 33 + n4; d[0] = t[0]; d[1] = t[1]; d[2] = t[2]; d[3] = t[3]; }
    LDS_WAIT(); asm volatile("" ::: "memory");
    const int c = lane & 7;
#pragma unroll
    for (int j = 0; j < 4; ++j) { const int n = (lane >> 3) + 8 * j; const LAS float* s = scr + (8 * c) * 33 + n;
        if constexpr (F8OUT) { int lo = __builtin_amdgcn_cvt_pk_fp8_f32(s[0 * 33], s[1 * 33], 0, false); lo = __builtin_amdgcn_cvt_pk_fp8_f32(s[2 * 33], s[3 * 33], lo, true);
            int hi2 = __builtin_amdgcn_cvt_pk_fp8_f32(s[4 * 33], s[5 * 33], 0, false); hi2 = __builtin_amdgcn_cvt_pk_fp8_f32(s[6 * 33], s[7 * 33], hi2, true);
            pg8::st8_wt((unsigned char*)WTv + (size_t)(nd0 + n) * K + k0 + 8 * c, (unsigned long long)(unsigned)lo | ((unsigned long long)(unsigned)hi2 << 32)); }
        else { u32x4 o; o.x = pg8::cvt_pk_bf16(s[0 * 33], s[1 * 33]); o.y = pg8::cvt_pk_bf16(s[2 * 33], s[3 * 33]); o.z = pg8::cvt_pk_bf16(s[4 * 33], s[5 * 33]); o.w = pg8::cvt_pk_bf16(s[6 * 33], s[7 * 33]);
            pg8::st16<0>((bf16_t*)WTv + (size_t)(nd0 + n) * K + k0 + 8 * c, o); } }
    LDS_WAIT(); asm volatile("" ::: "memory");
}
__device__ __forceinline__ void p0_fused_pool_item(const float* w_in, const float* g_mix, const float* w_pool, const float* pool_scale, bf16_t* WIN_T, int item, int lane) {
    const int eb = item & 7, kb = (item >> 3) & 15, g = item >> 7; const int k = kb * 64 + lane, e0 = eb * 16;
    const float* ap = w_in + (size_t)k * INP + 3 * SBW + g * PGD; const float* bp = w_pool + (size_t)g * PGD * PGD + e0;
    float acc[16];
#pragma unroll
    for (int j = 0; j < 16; ++j) acc[j] = 0.f;
#pragma unroll 4
    for (int c = 0; c < PGD; ++c) { const float a = ap[c];
#pragma unroll
        for (int j = 0; j < 16; ++j) acc[j] += a * bp[c * PGD + j]; }
    const float gk = g_mix[k];
#pragma unroll
    for (int j = 0; j < 16; ++j) WIN_T[(size_t)(3 * SBW + g * PGD + e0 + j) * D + k] = (bf16_t)f2bf(acc[j] * gk * pool_scale[g * PGD + e0 + j]);
}
__device__ __forceinline__ void p0_row(const float* xrow, bf16_t* orow, float* rstd, int lane) {
    const f32x4* xr = (const f32x4*)xrow + 2 * lane; f32x4 v[4]; float s = 0.f;
#pragma unroll
    for (int j = 0; j < 4; ++j) { v[j] = __builtin_nontemporal_load(xr + (j >> 1) * 128 + (j & 1)); s += (v[j].x * v[j].x + v[j].y * v[j].y) + (v[j].z * v[j].z + v[j].w * v[j].w); }
    s = pg8::wsum(s); if (lane == 0) *rstd = 1.0f / sqrtf(s * (1.0f / D) + EPS);
#pragma unroll
    for (int j = 0; j < 2; ++j) { u32x4 o; o.x = pg8::cvt_pk_bf16(v[2 * j].x, v[2 * j].y); o.y = pg8::cvt_pk_bf16(v[2 * j].z, v[2 * j].w); o.z = pg8::cvt_pk_bf16(v[2 * j + 1].x, v[2 * j + 1].y); o.w = pg8::cvt_pk_bf16(v[2 * j + 1].z, v[2 * j + 1].w);
        pg8::st16<0>(orow + j * 512 + 8 * lane, o); }
}
__device__ __forceinline__ void p0_prologue(const Args& a, LAS unsigned char* lds, int vcu, int G, int wave, int lane) {
    unsigned char* ws = a.ws;
    LAS float* scr = (LAS float*)(lds + RING_OFF + wave * 16384);
    const int gw = vcu * NWAVES + wave, NGW = G * NWAVES;
    constexpr int I_E1 = (D / 64) * (2 * DFF / 32), I_E2 = (DFF / 64) * (D / 32);
    constexpr int I_IN = (D / 64) * (3 * SBW / 32), I_FP = PG * 16 * 8, I_SQ = (D / 64) * (D / 32), I_KV = (D / 64) * (2 * D / 32), I_P = (PGD / 64) * (PGD / 32);
    constexpr int N1 = NE * I_E1, N2 = NE * I_E2, NITEMS = N1 + N2 + I_IN + 3 * I_SQ + I_KV + I_FP;
    const int BIG = 1 << 30;
    for (int it = gw; it < NITEMS; it += NGW) {
        int r = it;
        if (r < N1 + N2 && r >= N1 + N2 - P0_DEFER - P2_DEFER) continue;
        if (r < N1) { const int e = r / I_E1; p0_item<true>(a.in[17] + (size_t)e * D * 2 * DFF, D, 2 * DFF, ws + WS_W1 + (size_t)e * 2 * DFF * D, a.in[14], nullptr, BIG, nullptr, 1, scr, r % I_E1, lane, WSCALE); continue; } r -= N1;
        if (r < N2) { const int e = r / I_E2; p0_item<true>(a.in[19] + (size_t)e * DFF * D, DFF, D, ws + WS_W2 + (size_t)e * D * DFF, nullptr, nullptr, BIG, nullptr, 0, scr, r % I_E2, lane, WSCALE); continue; } r -= N2;
        if (r < I_IN) { p0_item<false>(a.in[3], D, INP, (bf16_t*)(ws + WS_WIN), a.in[2], nullptr, BIG, nullptr, 0, scr, r, lane, 1.0f, 3 * SBW / 32); continue; } r -= I_IN;
        if (r < I_SQ) { p0_item<false>(a.in[8], D, D, (bf16_t*)(ws + WS_WOUT), a.in[4], a.in[5], SBW, nullptr, 0, scr, r, lane); continue; } r -= I_SQ;
        if (r < I_SQ) { p0_item<true>(a.in[11], D, D, ws + WS_WQ, a.in[9], nullptr, BIG, nullptr, 0, scr, r, lane, WSCALE); continue; } r -= I_SQ;
        if (r < I_KV) { p0_item<false>(a.in[12], D, 2 * D, (bf16_t*)(ws + WS_WKV), a.in[10], nullptr, BIG, nullptr, 0, scr, r, lane); continue; } r -= I_KV;
        if (r < I_SQ) { p0_item<true>(a.in[13], D, D, ws + WS_WO, nullptr, nullptr, BIG, nullptr, 0, scr, r, lane, WSCALE); continue; } r -= I_SQ;
        p0_fused_pool_item(a.in[3], a.in[2], a.in[6], a.in[7], (bf16_t*)(ws + WS_WIN), r, lane);
    }
    for (int m = gw; m < NTOK; m += NGW) p0_row(a.in[0] + (size_t)m * D, (bf16_t*)(ws + WS_S0) + (size_t)m * D, (float*)(ws + WS_RSTDX) + m, lane);
    for (int m = gw; m < NMROWS; m += NGW) p0_row(a.in[1] + (size_t)m * D, (bf16_t*)(ws + WS_MEMB) + (size_t)m * D, (float*)(ws + WS_RSTDM) + m, lane);
    const int gt = gw * 64 + lane, NGT = NGW * 64;
    for (int i = gt; i < INP; i += NGT) ((float*)(ws + WS_CSG1))[i] = (i < SBW) ? C2_SB : 1.0f;
    for (int i = gt; i < NE * D; i += NGT) { const int e = i / D, k = i % D; const float v = a.in[14][k] * a.in[15][k * NE + e];
        ((float*)(ws + WS_WR))[i] = v; const unsigned h = f2bf(v); ((bf16_t*)(ws + WS_WRH))[i] = (bf16_t)h; ((bf16_t*)(ws + WS_WRL))[i] = (bf16_t)f2bf(v - bf2f((bf16_t)h)); }
}

__device__ __forceinline__ void p1_deferred_items(const Args& a, LAS unsigned char* lds, int rank  , int wave, int lane) {
    constexpr int I_E2 = (DFF / 64) * (D / 32), N2 = NE * I_E2;
    LAS float* scr = (LAS float*)(lds + RING_OFF + wave * 16384);
    for (int k = 0; k < P0_DEFER / (192 * 8); ++k) { const int r = N2 - P0_DEFER + (k * 192 + rank) * 8 + wave; const int e = r / I_E2;
        p0_item<true>(a.in[19] + (size_t)e * DFF * D, DFF, D, a.ws + WS_W2 + (size_t)e * D * DFF, nullptr, nullptr, 1 << 30, nullptr, 0, scr, r % I_E2, lane, WSCALE); }
}
__device__ __forceinline__ void p2_deferred_item(const Args& a, LAS unsigned char* region, int it, int lane) {
    constexpr int I_E1 = (D / 64) * (2 * DFF / 32), I_E2 = (DFF / 64) * (D / 32), N1 = NE * I_E1, N2 = NE * I_E2;
    static_assert(N1 + N2 - P0_DEFER - P2_DEFER >= 0 && P0_DEFER <= N2, "deferred ranges");
    int r = N1 + N2 - P0_DEFER - P2_DEFER + it;
    if (r < N1) { const int e = r / I_E1; p0_item<true>(a.in[17] + (size_t)e * D * 2 * DFF, D, 2 * DFF, a.ws + WS_W1 + (size_t)e * 2 * DFF * D, a.in[14], nullptr, 1 << 30, nullptr, 1, (LAS float*)region, r % I_E1, lane, WSCALE); return; }
    r -= N1; const int e = r / I_E2;
    p0_item<true>(a.in[19] + (size_t)e * DFF * D, DFF, D, a.ws + WS_W2 + (size_t)e * D * DFF, nullptr, nullptr, 1 << 30, nullptr, 0, (LAS float*)region, r % I_E2, lane, WSCALE);
}
struct SchedP1 {
    int G, c; unsigned char* ws;
    __device__ __forceinline__ bool next(int i, pg8::Unit& u) const {
        const int L = i * G + c; constexpr int NQ = (NTOK / 256) * (INP / 256);
        if (L >= NQ + 64) return false;
        if (L < NQ) { int pm, pn; pg8::grouped_mn(pg8::xcd_remap(L, NQ), NTOK / 256, INP / 256, pm, pn);
            u.A = (const char*)(ws + WS_S0) + (size_t)pm * 256 * D * 2; u.B = (const char*)(ws + WS_WIN) + (size_t)pn * 256 * D * 2;
            u.p0 = (bf16_t*)(ws + WS_QKVU) + (size_t)pm * 256 * INP + pn * 256; u.p1 = (float*)(ws + WS_RSTDX) + pm * 256; u.p2 = (float*)(ws + WS_CSG1) + pn * 256; u.i0 = INP; u.pm = pm; u.pn = pn; }
        else if (L < NQ + 32) { const int k = L - NQ, pm = k >> 2, pn = k & 3;
            u.A = (const char*)(ws + WS_MEMB) + (size_t)pm * 256 * D * 2; u.B = (const char*)(ws + WS_WKV) + (size_t)pn * 256 * D * 2;
            u.p0 = (bf16_t*)(ws + WS_KM) + (size_t)pm * 256 * D + pn * 256; u.p1 = (float*)(ws + WS_RSTDM) + pm * 256; u.p2 = nullptr; u.i0 = D; u.pm = pm; u.pn = pn; }
        else { const int v = L - NQ - 32, b = v >> 2, dt = v & 3;
            u.A = (const char*)(ws + WS_WKV) + (size_t)(D + dt * 256) * D * 2; u.B = (const char*)(ws + WS_MEMB) + (size_t)b * 256 * D * 2;
            u.p0 = (bf16_t*)(ws + WS_VMT) + ((size_t)b * D + dt * 256) * NMEM; u.p1 = nullptr; u.p2 = (float*)(ws + WS_RSTDM) + b * 256; u.i0 = NMEM; u.pm = dt; u.pn = b; }
        u.p3 = nullptr; u.i1 = 0; return true;
    }
};
#define EPI_BAR() asm volatile("s_waitcnt lgkmcnt(0)\n\ts_barrier" ::: "memory")
struct SchedReg {
    int G, c, nM, nN; const char* A; const char* B; size_t astep, bstep; bf16_t* O; int ldc; const float* rs; const float* cs; const ssq_t* sq = nullptr;
    __device__ __forceinline__ bool next(int i, pg8::Unit& u) const {
        const int L = i * G + c; if (L >= nM * nN) return false; int pm, pn; pg8::grouped_mn(pg8::xcd_remap(L, nM * nN), nM, nN, pm, pn);
        u.A = A + (size_t)pm * astep; u.B = B + (size_t)pn * bstep; u.pm = pm; u.pn = pn; u.i0 = ldc; u.i1 = 0;
        u.p0 = O ? (void*)(O + (size_t)pm * 256 * ldc + pn * 256) : nullptr; u.p1 = sq ? (void*)(sq + pm * 256) : (rs ? (void*)(rs + pm * 256) : nullptr); u.p2 = cs ? (void*)(cs + pn * 256) : nullptr; u.p3 = nullptr; return true;
    }
};
struct EpiBf16Ssq {
    static constexpr bool PERM = true; static constexpr int MIDK = -1; float inv_n, mult;
    __device__ __forceinline__ void midk(f32x4 (&)[2][2][4][2], const pg8::Unit&, int, int) const {}
    __device__ __forceinline__ void operator()(f32x4 (&acc)[2][2][4][2], const pg8::Unit& u, int wr, int wc, int fr, int fq, int, int, LAS unsigned char*) const {
        bf16_t* O = (bf16_t*)u.p0; const ssq_t* sq = (const ssq_t*)u.p1; const int ldc = u.i0; int r0 = wr * 64 + fr, c0 = wc * 32 + 8 * fq; asm volatile("" : "+v"(r0), "+v"(c0));
#pragma unroll
        for (int ai = 0; ai < 2; ++ai)
#pragma unroll
            for (int m = 0; m < 4; ++m) { const int r = r0 + ai * 128 + m * 16; const float rv = mult / sqrtf(ssq_get(sq + r) * inv_n + EPS); bf16_t* rowp = O + (size_t)r * ldc + c0;
#pragma unroll
                for (int bj = 0; bj < 2; ++bj) { const f32x4 v0 = acc[ai][bj][m][0] * rv, v1 = acc[ai][bj][m][1] * rv;
                    u32x4 w; w.x = pg8::cvt_pk_bf16(v0[0], v0[1]); w.y = pg8::cvt_pk_bf16(v0[2], v0[3]); w.z = pg8::cvt_pk_bf16(v1[0], v1[1]); w.w = pg8::cvt_pk_bf16(v1[2], v1[3]);
                    pg8::st16<5>(rowp + bj * 128, w); } }
    }
};
template <int MIDK_, bool XIN_BF16, bool F8OUT> struct EpiResid {
    static constexpr bool PERM = true; static constexpr int MIDK = MIDK_;
    const float* xin; bf16_t* xb; unsigned char* x8; ssq_t* ssq; const ssq_t* ssq_mid; float accs;
    __device__ __forceinline__ void midk(f32x4 (&acc)[2][2][4][2], const pg8::Unit& u, int wr, int fr) const {
#pragma unroll
        for (int ai = 0; ai < 2; ++ai)
#pragma unroll
            for (int m = 0; m < 4; ++m) { const int r = u.pm * 256 + ai * 128 + wr * 64 + m * 16 + fr; const float s = 1.0f / sqrtf(ssq_get(ssq_mid + r) * (1.0f / SBW) + EPS);
#pragma unroll
                for (int bj = 0; bj < 2; ++bj)
#pragma unroll
                    for (int n = 0; n < 2; ++n) acc[ai][bj][m][n] *= s; }
    }
    __device__ __forceinline__ void operator()(f32x4 (&acc)[2][2][4][2], const pg8::Unit& u, int wr, int wc, int fr, int fq, int, int, LAS unsigned char*) const {
        int row0 = u.pm * 256 + wr * 64 + fr, col0 = u.pn * 256 + wc * 32 + 8 * fq; asm volatile("" : "+v"(row0), "+v"(col0));
        u32x4 xv[2][4][2]; f32x4 xf[XIN_BF16 ? 1 : 2][XIN_BF16 ? 1 : 4][XIN_BF16 ? 1 : 2][2];
#pragma unroll
        for (int ai = 0; ai < 2; ++ai)
#pragma unroll
            for (int m = 0; m < 4; ++m)
#pragma unroll
                for (int bj = 0; bj < 2; ++bj) { const size_t o2 = (size_t)(row0 + ai * 128 + m * 16) * D + col0 + bj * 128;
                    if constexpr (XIN_BF16) xv[ai][m][bj] = *(const u32x4*)(xb + o2); else { xf[ai][m][bj][0] = *(const f32x4*)(xin + o2); xf[ai][m][bj][1] = *(const f32x4*)(xin + o2 + 4); } }
#pragma unroll
        for (int ai = 0; ai < 2; ++ai)
#pragma unroll
            for (int m = 0; m < 4; ++m) { const int r = row0 + ai * 128 + m * 16; const size_t off = (size_t)r * D + col0; float q = 0.f;
#pragma unroll
                for (int bj = 0; bj < 2; ++bj) { const size_t o2 = off + bj * 128; f32x4 o0, o1;
                    if constexpr (XIN_BF16) { const u32x4 x4 = xv[ai][m][bj];
                        o0 = (f32x4){__builtin_bit_cast(float, x4.x << 16), __builtin_bit_cast(float, x4.x & 0xffff0000u), __builtin_bit_cast(float, x4.y << 16), __builtin_bit_cast(float, x4.y & 0xffff0000u)};
                        o1 = (f32x4){__builtin_bit_cast(float, x4.z << 16), __builtin_bit_cast(float, x4.z & 0xffff0000u), __builtin_bit_cast(float, x4.w << 16), __builtin_bit_cast(float, x4.w & 0xffff0000u)}; }
                    else { o0 = xf[ai][m][bj][0]; o1 = xf[ai][m][bj][1]; }
                    o0 += acc[ai][bj][m][0] * accs; o1 += acc[ai][bj][m][1] * accs;
                    q += (o0[0] * o0[0] + o0[1] * o0[1]) + (o0[2] * o0[2] + o0[3] * o0[3]) + (o1[0] * o1[0] + o1[1] * o1[1]) + (o1[2] * o1[2] + o1[3] * o1[3]);
                    if constexpr (F8OUT) { int w0 = __builtin_amdgcn_cvt_pk_fp8_f32(o0[0], o0[1], 0, false); w0 = __builtin_amdgcn_cvt_pk_fp8_f32(o0[2], o0[3], w0, true);
                        int w1 = __builtin_amdgcn_cvt_pk_fp8_f32(o1[0], o1[1], 0, false); w1 = __builtin_amdgcn_cvt_pk_fp8_f32(o1[2], o1[3], w1, true);
                        pg8::st8_wt(x8 + o2, (unsigned long long)(unsigned)w0 | ((unsigned long long)(unsigned)w1 << 32)); }
                    u32x4 w; w.x = pg8::cvt_pk_bf16(o0[0], o0[1]); w.y = pg8::cvt_pk_bf16(o0[2], o0[3]); w.z = pg8::cvt_pk_bf16(o1[0], o1[1]); w.w = pg8::cvt_pk_bf16(o1[2], o1[3]); pg8::st16<4>(xb + o2, w); }
                q += pg8::swz_xor<16>(q); q = pg8::half_sum(q);
                if (fq == 0) ssq_add(ssq + r, q); }
    }
};
struct SchedMS {
    int G, c; unsigned char* ws;
    __device__ __forceinline__ bool next(int i, pg8::Unit& u) const {
        const int L = i * G + c; constexpr int NU = (NTOK / 256) * MH; if (L >= NU) return false; int pm, h; pg8::grouped_mn(pg8::xcd_remap(L, NU), NTOK / 256, MH, pm, h); const int b = pm >> 4;
        u.A = (const char*)(ws + WS_QM) + ((size_t)pm * 256 * D + h * MHD) * 2; u.B = (const char*)(ws + WS_KM) + ((size_t)b * NMEM * D + h * MHD) * 2;
        u.p0 = (bf16_t*)(ws + WS_PM) + (size_t)pm * 256 * D + h * NMEM; u.p1 = nullptr; u.p2 = nullptr; u.p3 = nullptr; u.i0 = D; u.i1 = 0; u.pm = pm; u.pn = h; return true;
    }
};
struct EpiSoftmax {
    static constexpr bool PERM = true; static constexpr int MIDK = -1;
    __device__ __forceinline__ void midk(f32x4 (&)[2][2][4][2], const pg8::Unit&, int, int) const {}
    __device__ __forceinline__ void operator()(f32x4 (&acc)[2][2][4][2], const pg8::Unit& u, int wr, int wc, int fr, int fq, int, int, LAS unsigned char* xl) const {
        typedef float f32x2v __attribute__((ext_vector_type(2)));
        LAS f32x2v* X = (LAS f32x2v*)xl;
        float ml[2][4];
#pragma unroll
        for (int ai = 0; ai < 2; ++ai)
#pragma unroll
            for (int m = 0; m < 4; ++m) { float mx = -INFINITY;
#pragma unroll
                for (int bj = 0; bj < 2; ++bj)
#pragma unroll
                    for (int n = 0; n < 2; ++n) { const f32x4 v = acc[ai][bj][m][n]; mx = fmaxf(fmaxf(mx, fmaxf(v[0], v[1])), fmaxf(v[2], v[3])); }
                mx = fmaxf(mx, pg8::swz_xor<16>(mx)); mx = pg8::half_max(mx); ml[ai][m] = mx; float s = 0.f;
#pragma unroll
                for (int bj = 0; bj < 2; ++bj)
#pragma unroll
                    for (int n = 0; n < 2; ++n) { f32x4 v = acc[ai][bj][m][n];
#pragma unroll
                        for (int j = 0; j < 4; ++j) { v[j] = __builtin_amdgcn_exp2f(v[j] - mx); s += v[j]; }
                        acc[ai][bj][m][n] = v; }
                s += pg8::swz_xor<16>(s); s = pg8::half_sum(s);
                if (fq == 0) X[(ai * 128 + wr * 64 + m * 16 + fr) * 4 + wc] = (f32x2v){mx, s}; }
        EPI_BAR();
        bf16_t* O = (bf16_t*)u.p0; const int ldc = u.i0; int r0 = wr * 64 + fr, c0 = wc * 32 + 8 * fq; asm volatile("" : "+v"(r0), "+v"(c0));
#pragma unroll
        for (int ai = 0; ai < 2; ++ai)
#pragma unroll
            for (int m = 0; m < 4; ++m) { const int r = r0 + ai * 128 + m * 16; const f32x2v a = X[r * 4 + 0], b = X[r * 4 + 1], c = X[r * 4 + 2], d = X[r * 4 + 3];
                const float M = fmaxf(fmaxf(a.x, b.x), fmaxf(c.x, d.x));
                const float tot = a.y * __builtin_amdgcn_exp2f(a.x - M) + b.y * __builtin_amdgcn_exp2f(b.x - M) + c.y * __builtin_amdgcn_exp2f(c.x - M) + d.y * __builtin_amdgcn_exp2f(d.x - M);
                const float f = __builtin_amdgcn_exp2f(ml[ai][m] - M) / tot; bf16_t* rowp = O + (size_t)r * ldc + c0;
#pragma unroll
                for (int bj = 0; bj < 2; ++bj) { const f32x4 v0 = acc[ai][bj][m][0] * f, v1 = acc[ai][bj][m][1] * f;
                    u32x4 w; w.x = pg8::cvt_pk_bf16(v0[0], v0[1]); w.y = pg8::cvt_pk_bf16(v0[2], v0[3]); w.z = pg8::cvt_pk_bf16(v1[0], v1[1]); w.w = pg8::cvt_pk_bf16(v1[2], v1[3]);
                    pg8::st16<6>(rowp + bj * 128, w); } }
    }
};
struct SchedPV {
    int G, c; unsigned char* ws;
    __device__ __forceinline__ bool next(int i, pg8::Unit& u) const {
        const int L = i * G + c; constexpr int NU = (NTOK / 256) * MH; if (L >= NU) return false; int pm, h; pg8::grouped_mn(pg8::xcd_remap(L, NU), NTOK / 256, MH, pm, h); const int b = pm >> 4;
        u.A = (const char*)(ws + WS_PM) + ((size_t)pm * 256 * D + h * NMEM) * 2; u.B = (const char*)(ws + WS_VMT) + ((size_t)b * D + h * MHD) * NMEM * 2;
        u.p0 = (bf16_t*)(ws + WS_OM) + (size_t)pm * 256 * D + h * MHD; u.p1 = nullptr; u.p2 = nullptr; u.p3 = nullptr; u.i0 = D; u.i1 = 0; u.pm = pm; u.pn = h; return true;
    }
};

__device__ __forceinline__ void p8_route(const Args& a, LAS unsigned char* lds, int bx, int G, int wave, int lane, int* CNT) {
    unsigned char* ws = a.ws; const bf16_t* x2 = (const bf16_t*)(ws + WS_S0); const ssq_t* SSQ2 = (const ssq_t*)(ws + MK_SSQ2); const float* br = a.in[16];
    const bf16_t* WRH = (const bf16_t*)(ws + WS_WRH);
    int* LSLOT = (int*)(ws + WS_LSLOT); float* LGATE = (float*)(ws + WS_LGATE); float* LRS = (float*)(ws + WS_LRS);
    constexpr int WPITCH = 2064;
    LAS float* LG = (LAS float*)(lds + RING_OFF + 69632) + wave * 16 * 33;
    LAS int* hist = (LAS int*)(lds + RING_OFF + 90112); LAS int* base = hist + 32;
    const int tid = wave * 64 + lane;
    { u32x4 v[8];
#pragma unroll
      for (int i = 0; i < 8; ++i) v[i] = *(const u32x4*)(WRH + (size_t)(tid + i * 512) * 8);
#pragma unroll
      for (int i = 0; i < 8; ++i) { const int c = tid + i * 512; *(LAS u32x4*)(lds + RING_OFF + (c >> 7) * WPITCH + (c & 127) * 16) = v[i]; } }
    LDS_WAIT(); __syncthreads();
    for (int t0 = bx * 128; t0 < NTOK; t0 += G * 128) {
        if (tid < 32) hist[tid] = 0;
        const int r16 = lane & 15, kq = lane >> 4; const int trow = t0 + wave * 16 + r16;
        const bf16_t* xp = x2 + (size_t)trow * D + kq * 8;
        bf16x8 ah[32];
#pragma unroll
        for (int ks = 0; ks < 32; ++ks) ah[ks] = *(const bf16x8*)(xp + ks * 32);
        f32x4 acc[2] = {(f32x4){0.f, 0.f, 0.f, 0.f}, (f32x4){0.f, 0.f, 0.f, 0.f}};
        const LAS unsigned char* wp = lds + RING_OFF + r16 * WPITCH + kq * 16;
#pragma unroll
        for (int ks = 0; ks < 32; ++ks) {
#pragma unroll
            for (int nb = 0; nb < 2; ++nb) { const bf16x8 bh = *(const LAS bf16x8*)(wp + nb * 16 * WPITCH + ks * 64);
                acc[nb] = __builtin_amdgcn_mfma_f32_16x16x32_bf16(ah[ks], bh, acc[nb], 0, 0, 0); } }
#pragma unroll
        for (int nb = 0; nb < 2; ++nb)
#pragma unroll
            for (int r = 0; r < 4; ++r) { const int tl = kq * 4 + r; const int tk = t0 + wave * 16 + tl; const float rs = 1.0f / sqrtf(ssq_get(SSQ2 + tk) * (1.0f / D) + EPS);
                LG[tl * 33 + nb * 16 + r16] = acc[nb][r] * rs + br[nb * 16 + r16]; }
        LDS_WAIT(); __syncthreads();
        int te[4] = {0, 0, 0, 0}; float tg[4] = {0.f, 0.f, 0.f, 0.f}; int rk[4] = {0, 0, 0, 0};
        if (lane < 16) {
            float tv[4] = {-INFINITY, -INFINITY, -INFINITY, -INFINITY};
            for (int e = 0; e < NE; ++e) { const float v = LG[lane * 33 + e];
                if (v > tv[3]) { if (v > tv[2]) { tv[3] = tv[2]; te[3] = te[2]; if (v > tv[1]) { tv[2] = tv[1]; te[2] = te[1]; if (v > tv[0]) { tv[1] = tv[0]; te[1] = te[0]; tv[0] = v; te[0] = e; } else { tv[1] = v; te[1] = e; } } else { tv[2] = v; te[2] = e; } } else { tv[3] = v; te[3] = e; } } }
            float gs = 0.f;
#pragma unroll
            for (int k = 0; k < 4; ++k) { tg[k] = __expf(tv[k] - tv[0]); gs += tg[k]; }
            gs = 1.0f / gs;
#pragma unroll
            for (int k = 0; k < 4; ++k) { tg[k] *= gs; rk[k] = __hip_atomic_fetch_add(hist + te[k], 1, __ATOMIC_RELAXED, __HIP_MEMORY_SCOPE_WORKGROUP); }
        }
        LDS_WAIT(); __syncthreads();
        if (tid < 32) { const int n = hist[tid]; base[tid] = n ? atomicAdd(CNT + tid, n) : 0; }
        LDS_WAIT(); __syncthreads();
        if (lane < 16) { const int tk = t0 + wave * 16 + lane; const float rsw = (1.0f / WSCALE) / sqrtf(ssq_get(SSQ2 + tk) * (1.0f / D) + EPS);
#pragma unroll
            for (int k = 0; k < 4; ++k) { const size_t p = (size_t)te[k] * LCAP + base[te[k]] + rk[k]; pg8::st4_wt(LSLOT + p, (unsigned)(tk * 4 + k)); pg8::st4_wt(LGATE + p, __float_as_uint(tg[k])); pg8::st4_wt(LRS + p, __float_as_uint(rsw)); } }
        LDS_WAIT(); __syncthreads();
    }
}

__device__ __forceinline__ void moe_table(const Args& a, volatile LAS unsigned* MISC, int tid) {
    const int* CNT = (const int*)(a.ws + OFF_CNT);
    if (tid < 32) MISC[16 + tid] = (unsigned)CNT[tid];
    LDS_WAIT(); __syncthreads();
    if (tid == 0) { unsigned tb = 0; for (int e = 0; e < NE; ++e) { MISC[48 + e] = tb; tb += (MISC[16 + e] + 255u) >> 8; } MISC[48 + NE] = tb; }
    LDS_WAIT(); __syncthreads();
}
template <int NPN, bool W1> struct SchedMoE {
    int G, c; unsigned char* ws; volatile LAS unsigned* MISC; const float* bias;
    __device__ __forceinline__ bool next(int i, pg8::Unit& u) const {
        unsigned mb_ = (unsigned)(uintptr_t)MISC; asm volatile("" : "+s"(mb_)); const LAS unsigned* M = (const LAS unsigned*)(uintptr_t)mb_;
        const int T = __builtin_amdgcn_readfirstlane((int)M[48 + NE]); const int NU = T * NPN; const int L = i * G + c; if (L >= NU) return false;
        const int w = pg8::xcd_remap(L, NU);
        int e = 0;
#pragma unroll
        for (int s = 16; s >= 1; s >>= 1) { if ((int)M[48 + e + s] * NPN <= w) e += s; }
        e = __builtin_amdgcn_readfirstlane(e);
        const int tb = __builtin_amdgcn_readfirstlane((int)M[48 + e]), cnt = __builtin_amdgcn_readfirstlane((int)M[16 + e]), nte = (cnt + 255) >> 8; const int idx = w - tb * NPN, pn = __builtin_amdgcn_readfirstlane(idx / nte), mt = idx - pn * nte;
        u.pm = tb + mt; u.pn = pn; u.i1 = e; const int nv = cnt - mt * 256; u.i0 = nv < 256 ? nv : 256;
        u.p3 = (int*)(ws + WS_LSLOT) + (size_t)e * LCAP + mt * 256; u.p2 = (float*)(ws + (W1 ? WS_LRS : WS_LGATE)) + (size_t)e * LCAP + mt * 256; u.p0 = nullptr;
        u.p1 = W1 ? (void*)(bias + (size_t)e * 2 * DFF + pn * 128) : (void*)(bias + (size_t)e * D + pn * 256);
        if (W1) { u.A = (const char*)(ws + WS_X2F8); u.B = (const char*)(ws + WS_W1) + ((size_t)e * 2 * DFF + pn * 256) * D; }
        else { u.A = (const char*)(ws + WS_ACT) + (size_t)(tb + mt) * 256 * DFF; u.B = (const char*)(ws + WS_W2) + ((size_t)e * D + pn * 256) * DFF; }
        return true;
    }
};
typedef float f32x2 __attribute__((ext_vector_type(2)));
struct EpiSwiGLU {
    static constexpr bool PERM = true; static constexpr int MIDK = -1; unsigned char* act;
    __device__ __forceinline__ void midk(f32x4 (&)[2][2][4][2], const pg8::Unit&, int, int) const {}
    __device__ __forceinline__ void operator()(f32x4 (&acc)[2][2][4][2], const pg8::Unit& u, int wr, int wc, int fr, int fq, int, int, LAS unsigned char* tab) const {
        const int nvalid = u.i0; const LAS float* T1 = (const LAS float*)tab + 256; const LAS float* T2 = (const LAS float*)tab + 512;
        int r0 = wr * 64 + fr, c0 = wc * 32 + 8 * fq; asm volatile("" : "+v"(r0), "+v"(c0)); const int gc0 = u.pn * 128 + c0;
        f32x4 bg[2], bu[2];
#pragma unroll
        for (int n = 0; n < 2; ++n) { bg[n] = *(const LAS f32x4*)(T2 + c0 + 4 * n); bu[n] = *(const LAS f32x4*)(T2 + 128 + c0 + 4 * n); }
#pragma unroll
        for (int ai = 0; ai < 2; ++ai)
#pragma unroll
            for (int m = 0; m < 4; ++m) { const int r = r0 + ai * 128 + m * 16; const float rs = T1[r]; int wv[2];
#pragma unroll
                for (int n = 0; n < 2; ++n) { f32x2 o[2];
#pragma unroll
                    for (int h = 0; h < 2; ++h) { f32x2 g = (f32x2){acc[ai][0][m][n][2 * h], acc[ai][0][m][n][2 * h + 1]} * rs + (f32x2){bg[n][2 * h], bg[n][2 * h + 1]};
                        f32x2 up = (f32x2){acc[ai][1][m][n][2 * h], acc[ai][1][m][n][2 * h + 1]} * rs + (f32x2){bu[n][2 * h], bu[n][2 * h + 1]};
                        g.x = fminf(g.x, SW_LIMIT); g.y = fminf(g.y, SW_LIMIT); up.x = fminf(fmaxf(up.x, -SW_LIMIT), SW_LIMIT); up.y = fminf(fmaxf(up.y, -SW_LIMIT), SW_LIMIT);
                        const f32x2 tt = g * (-SW_ALPHA * LOG2E); f32x2 d; d.x = __builtin_amdgcn_exp2f(tt.x); d.y = __builtin_amdgcn_exp2f(tt.y); d = d + 1.0f;
                        f32x2 rr; rr.x = __builtin_amdgcn_rcpf(d.x); rr.y = __builtin_amdgcn_rcpf(d.y);
                        o[h] = (up + 1.0f) * g * rr; }
                    wv[n] = __builtin_amdgcn_cvt_pk_fp8_f32(o[0].x, o[0].y, 0, false); wv[n] = __builtin_amdgcn_cvt_pk_fp8_f32(o[1].x, o[1].y, wv[n], true); }
                if (r < nvalid) pg8::st8_wt(act + ((size_t)u.pm * 256 + r) * DFF + gc0, (unsigned long long)(unsigned)wv[0] | ((unsigned long long)(unsigned)wv[1] << 32)); }
    }
};
struct EpiW2 {
    static constexpr bool PERM = true; static constexpr int MIDK = -1; unsigned char* Y;
    __device__ __forceinline__ void midk(f32x4 (&)[2][2][4][2], const pg8::Unit&, int, int) const {}
    __device__ __forceinline__ void operator()(f32x4 (&acc)[2][2][4][2], const pg8::Unit& u, int wr, int wc, int fr, int fq, int, int, LAS unsigned char* tab) const {
        const int nvalid = u.i0; const LAS unsigned* T0 = (const LAS unsigned*)tab; const LAS float* T1 = (const LAS float*)tab + 256; const LAS float* T2 = (const LAS float*)tab + 512;
        int r0 = wr * 64 + fr, cl = wc * 32 + 8 * fq; asm volatile("" : "+v"(r0), "+v"(cl)); const int c0 = u.pn * 256 + cl;
        f32x4 bv[2][2];
#pragma unroll
        for (int bj = 0; bj < 2; ++bj)
#pragma unroll
            for (int n = 0; n < 2; ++n) bv[bj][n] = *(const LAS f32x4*)(T2 + cl + bj * 128 + 4 * n);
#pragma unroll
        for (int ai = 0; ai < 2; ++ai)
#pragma unroll
            for (int m = 0; m < 4; ++m) { const int r = r0 + ai * 128 + m * 16; const bool valid = r < nvalid; const unsigned slot = T0[r]; const float g = T1[r];
#pragma unroll
                for (int bj = 0; bj < 2; ++bj) { const f32x4 v0 = (acc[ai][bj][m][0] * (1.0f / WSCALE) + bv[bj][0]) * g, v1 = (acc[ai][bj][m][1] * (1.0f / WSCALE) + bv[bj][1]) * g;
                    int w0 = __builtin_amdgcn_cvt_pk_fp8_f32(v0[0], v0[1], 0, false); w0 = __builtin_amdgcn_cvt_pk_fp8_f32(v0[2], v0[3], w0, true);
                    int w1 = __builtin_amdgcn_cvt_pk_fp8_f32(v1[0], v1[1], 0, false); w1 = __builtin_amdgcn_cvt_pk_fp8_f32(v1[2], v1[3], w1, true);
                    if (valid) pg8::st8_wt(Y + (size_t)slot * D + c0 + bj * 128, (unsigned long long)(unsigned)w0 | ((unsigned long long)(unsigned)w1 << 32)); } }
    }
};

__device__ __forceinline__ void p11_final(const Args& a, int vcu, int G, int wave, int lane, float* dst) {
    const bf16_t* x2 = (const bf16_t*)(a.ws + WS_S0); const unsigned char* Y = a.ws + WS_Y; const float* gf = a.in[21];
    const int gw = vcu * NWAVES + wave, NGW = G * NWAVES;
    f32x4 g4[4];
#pragma unroll
    for (int j = 0; j < 4; ++j) g4[j] = *(const f32x4*)(gf + 16 * lane + 4 * j);
    for (int tok = gw; tok < NTOK; tok += NGW) {
        const u32x4 xa = __builtin_nontemporal_load((const u32x4*)(x2 + (size_t)tok * D + 16 * lane)), xc = __builtin_nontemporal_load((const u32x4*)(x2 + (size_t)tok * D + 16 * lane + 8));
        u32x4 yv[4];
#pragma unroll
        for (int k = 0; k < 4; ++k) yv[k] = __builtin_nontemporal_load((const u32x4*)(Y + ((size_t)tok * 4 + k) * D + 16 * lane));
        float v[16];
#pragma unroll
        for (int q = 0; q < 4; ++q) { v[2 * q] = __builtin_bit_cast(float, xa[q] << 16); v[2 * q + 1] = __builtin_bit_cast(float, xa[q] & 0xffff0000u); v[8 + 2 * q] = __builtin_bit_cast(float, xc[q] << 16); v[8 + 2 * q + 1] = __builtin_bit_cast(float, xc[q] & 0xffff0000u); }
#pragma unroll
        for (int k = 0; k < 4; ++k)
#pragma unroll
            for (int q = 0; q < 4; ++q) { const auto lo = __builtin_amdgcn_cvt_pk_f32_fp8((int)yv[k][q], false), hi2 = __builtin_amdgcn_cvt_pk_f32_fp8((int)yv[k][q], true);
                v[4 * q] += lo[0]; v[4 * q + 1] += lo[1]; v[4 * q + 2] += hi2[0]; v[4 * q + 3] += hi2[1]; }
        float s = 0.f;
#pragma unroll
        for (int q = 0; q < 16; ++q) s += v[q] * v[q];
        const float rs = 1.0f / sqrtf(pg8::wsum(s) * (1.0f / D) + EPS);
#pragma unroll
        for (int j = 0; j < 4; ++j) __builtin_nontemporal_store((f32x4){v[4 * j] * rs * g4[j][0], v[4 * j + 1] * rs * g4[j][1], v[4 * j + 2] * rs * g4[j][2], v[4 * j + 3] * rs * g4[j][3]}, (f32x4*)(dst + (size_t)tok * D + 16 * lane + 4 * j));
    }
}
typedef float f32x16 __attribute__((ext_vector_type(16)));
typedef short s16x4 __attribute__((ext_vector_type(4)));
__device__ __forceinline__ int crow(int r, int hi) { return (r & 3) + 8 * (r >> 2) + 4 * hi; }
#ifndef SB_ABL
#define SB_ABL 0
#endif
#define SB_DMA(ubase, voff, ldsaddr) do { unsigned keep_; asm volatile("s_mov_b32 %0, m0\n\ts_mov_b32 m0, %3\n\ts_nop 0\n\tglobal_load_lds_dwordx4 %1, %2\n\ts_mov_b32 m0, %0" \
        : "=&s"(keep_) : "v"(voff), "s"((const char*)(ubase)), "s"(ldsaddr) : "memory"); } while (0)
__device__ __forceinline__ void sb_item(int b, int h, int qi  , const bf16_t* QKVU, bf16_t* MIXED, ssq_t* SSQSB, LAS unsigned char* wl  , int) {
    const int lane = pg8::fresh_lane();
    const int r32 = lane & 31, hi = lane >> 5;
    const size_t rowbase = (size_t)b * S; const int q0 = qi * 64;
    const bf16_t* Qw = QKVU + (rowbase + q0) * INP + h * HD;
    const char* Kh = (const char*)(QKVU + rowbase * INP + SBW + h * HD); const char* Vh = Kh + SBW * 2;
    bf16x8 qr[2][4];
#pragma unroll
    for (int s = 0; s < 2; ++s)
#pragma unroll
        for (int d0 = 0; d0 < 4; ++d0) qr[s][d0] = *(const bf16x8*)(Qw + (size_t)(s * 32 + r32) * INP + d0 * 16 + hi * 8);
    f32x16 o[2][2];
#pragma unroll
    for (int r = 0; r < 16; ++r) { o[0][0][r] = 0.f; o[0][1][r] = 0.f; o[1][0][r] = 0.f; o[1][1][r] = 0.f; }
    float carry[2] = {1.0f, 1.0f}; bool alive[2] = {true, true};
    const int jd = qi;
    const unsigned kvoff = (unsigned)lane * (INP * 2);
    const unsigned vvoff = (unsigned)(lane >> 2) * (INP * 2) + (unsigned)(lane & 3) * 16;
    const unsigned lk = (unsigned)(uintptr_t)wl, lv = lk + 8192;
#define SB_LOAD_K(j) do { const char* kb_ = Kh + (size_t)(j) * 64 * INP * 2; _Pragma("unroll") for (int c_ = 0; c_ < 8; ++c_) SB_DMA(kb_ + c_ * 16, kvoff, lk + c_ * 1024); } while (0)
#define SB_LOAD_V(j) do { const char* vb_ = Vh + (size_t)(j) * 64 * INP * 2; _Pragma("unroll") for (int c_ = 0; c_ < 8; ++c_) SB_DMA(vb_ + (size_t)(c_ & 3) * 16 * INP * 2 + (c_ >> 2) * 64, vvoff, lv + c_ * 1024); } while (0)
    SB_LOAD_K(jd); SB_LOAD_V(jd);
    if (SB_ABL == 3) asm volatile("s_waitcnt vmcnt(0)" ::: "memory");
    const LAS unsigned char* kb = wl + hi * 1024 + r32 * 16;
    const LAS unsigned char* vb = wl + 8192 + ((lane >> 4) & 1) * 32 + (lane & 3) * 8 + (4 * hi + ((lane & 15) >> 2)) * 64;
    const int jlo = (SB_ABL != 0) ? ((jd - 4 > 0) ? jd - 4 : 0) : 0;
    for (int j = jd; j >= jlo; --j) {
        if (SB_ABL != 3) asm volatile("s_waitcnt vmcnt(8)" ::: "memory"); __builtin_amdgcn_sched_barrier(0);
        bf16x8 kf[8];
#pragma unroll
        for (int d0 = 0; d0 < 4; ++d0) { kf[2 * d0] = *(const LAS bf16x8*)(kb + d0 * 2048); kf[2 * d0 + 1] = *(const LAS bf16x8*)(kb + d0 * 2048 + 512); }
        asm volatile("s_waitcnt lgkmcnt(0)" ::: "memory"); __builtin_amdgcn_sched_barrier(0);
        if (j > jlo && SB_ABL != 3) SB_LOAD_K(j - 1);
        unsigned pw[2][4][4]; bool did[2][2] = {{false, false}, {false, false}};
#pragma unroll
        for (int s = 0; s < 2; ++s) {
#pragma unroll
            for (int half = 1; half >= 0; --half) {
                if (!alive[s]) continue;
                const bool diag = (j == jd);
                if (diag && s == 0 && half == 1) continue;
                f32x16 p;
#pragma unroll
                for (int r = 0; r < 16; ++r) p[r] = 0.f;
#pragma unroll
                for (int d0 = 0; d0 < 4; ++d0) p = __builtin_amdgcn_mfma_f32_32x32x16_bf16(kf[2 * d0 + half], qr[s][d0], p, 0, 0, 0);
                const int kbase = 64 * j + 32 * half + 4 * hi; const int qabs = q0 + s * 32 + r32;
#pragma unroll
                for (int r = 0; r < 16; ++r) { const int k0 = kbase + (r & 3) + 8 * (r >> 2);
                    float e0 = __builtin_amdgcn_exp2f(fminf(p[r], 100.0f));
                    if (diag && k0 >= qabs) e0 = 0.0f;
                    p[r] = e0; }
                float A[4];
#pragma unroll
                for (int i = 0; i < 4; ++i) A[i] = ((1.0f + p[4 * i]) * (1.0f + p[4 * i + 1])) * ((1.0f + p[4 * i + 2]) * (1.0f + p[4 * i + 3]));
                float Tq = 1.0f, Q[4];
#pragma unroll
                for (int i = 3; i >= 0; --i) { const auto sw = __builtin_amdgcn_permlane32_swap(__float_as_uint(A[i]), __float_as_uint(A[i]), false, false);
                    const float partner = hi ? __uint_as_float(sw[0]) : __uint_as_float(sw[1]);
                    Q[i] = hi ? Tq : Tq * partner; Tq = Tq * (A[i] * partner); }
                const float cin = carry[s];
#pragma unroll
                for (int i = 0; i < 4; ++i) { const float x0 = p[4 * i], x1 = p[4 * i + 1], x2 = p[4 * i + 2], x3 = p[4 * i + 3];
                    const float R0 = cin * __builtin_amdgcn_rcpf(A[i] * Q[i]);
                    const float R1 = R0 * (1.0f + x0), R2 = R1 * (1.0f + x1), R3 = R2 * (1.0f + x2);
                    pw[s][2 * half + (i >> 1)][(i & 1) * 2] = pg8::cvt_pk_bf16(x0 * R0, x1 * R1); pw[s][2 * half + (i >> 1)][(i & 1) * 2 + 1] = pg8::cvt_pk_bf16(x2 * R2, x3 * R3); }
                carry[s] = cin * __builtin_amdgcn_rcpf(Tq);
                did[s][half] = true;
                if (!__any(carry[s] != 0.0f)) alive[s] = false;
            }
        }
        if (SB_ABL == 3) {} else if (j > jlo) asm volatile("s_waitcnt vmcnt(8)" ::: "memory"); else asm volatile("s_waitcnt vmcnt(0)" ::: "memory");
        __builtin_amdgcn_sched_barrier(0);
        bf16x8 vf[8];
#pragma unroll
        for (int d0 = 0; d0 < 2; ++d0)
#pragma unroll
            for (int ks = 0; ks < 4; ++ks) {
                const s16x4 lo = __builtin_bit_cast(s16x4, __builtin_amdgcn_ds_read_tr16_b64_v4i16((LAS s16x4*)(vb + d0 * 4096 + ks * 1024)));
                const s16x4 hh = __builtin_bit_cast(s16x4, __builtin_amdgcn_ds_read_tr16_b64_v4i16((LAS s16x4*)(vb + d0 * 4096 + ks * 1024 + 512)));
                vf[d0 * 4 + ks] = (bf16x8){lo[0], lo[1], lo[2], lo[3], hh[0], hh[1], hh[2], hh[3]}; }
        asm volatile("s_waitcnt lgkmcnt(0)" ::: "memory"); __builtin_amdgcn_sched_barrier(0);
        const bool more = (SB_ABL != 0) ? (j > jlo) : ((j > 0) && (alive[0] || alive[1]));
        if (more && SB_ABL != 3) SB_LOAD_V(j - 1);
#pragma unroll
        for (int s = 0; s < 2; ++s)
#pragma unroll
            for (int half = 0; half < 2; ++half) { if (!did[s][half]) continue;
#pragma unroll
                for (int d0 = 0; d0 < 2; ++d0)
#pragma unroll
                    for (int kk = 0; kk < 2; ++kk) { const int ks = 2 * half + kk; const bf16x8 pa = __builtin_bit_cast(bf16x8, (u32x4){pw[s][ks][0], pw[s][ks][1], pw[s][ks][2], pw[s][ks][3]});
                        o[s][d0] = __builtin_amdgcn_mfma_f32_32x32x16_bf16(pa, vf[d0 * 4 + ks], o[s][d0], 0, 0, 0); } }
        if (!more) break;
    }
    asm volatile("s_waitcnt vmcnt(0)" ::: "memory");
    LAS bf16_t* stg = (LAS bf16_t*)wl; const int l2 = pg8::fresh_lane();
#pragma unroll
    for (int s = 0; s < 2; ++s) {
#pragma unroll
        for (int r = 0; r < 16; ++r) { const int orow = crow(r, l2 >> 5);
#pragma unroll
            for (int d0 = 0; d0 < 2; ++d0) stg[orow * 64 + d0 * 32 + (l2 & 31)] = (bf16_t)f2bf(o[s][d0][r]); }
        LDS_WAIT();
        bf16_t* Ow = MIXED + (rowbase + q0 + s * 32) * D + h * HD;
#pragma unroll
        for (int i = 0; i < 4; ++i) { const int row = i * 8 + (l2 >> 3), ch = l2 & 7; const u32x4 v = *(const LAS u32x4*)(stg + row * 64 + ch * 8);
            pg8::st16<2>(Ow + (size_t)row * D + ch * 8, v); float q = 0.f;
#pragma unroll
            for (int k = 0; k < 4; ++k) { const float a = __builtin_bit_cast(float, v[k] << 16), c = __builtin_bit_cast(float, v[k] & 0xffff0000u); q += a * a + c * c; }
            q += pg8::swz_xor<1>(q); q += pg8::swz_xor<2>(q); q += pg8::swz_xor<4>(q);
            if (ch == 0) ssq_add(SSQSB + rowbase + q0 + s * 32 + row, q); }
        LDS_WAIT();
    }
#undef SB_LOAD_K
#undef SB_LOAD_V
}

__device__ __forceinline__ f32x4 bf_lo(u32x4 v) { return (f32x4){__builtin_bit_cast(float, v.x << 16), __builtin_bit_cast(float, v.y << 16), __builtin_bit_cast(float, v.z << 16), __builtin_bit_cast(float, v.w << 16)}; }
__device__ __forceinline__ f32x4 bf_hi(u32x4 v) { return (f32x4){__builtin_bit_cast(float, v.x & 0xffff0000u), __builtin_bit_cast(float, v.y & 0xffff0000u), __builtin_bit_cast(float, v.z & 0xffff0000u), __builtin_bit_cast(float, v.w & 0xffff0000u)}; }
__device__ __forceinline__ void pool_item(int item, const bf16_t* QKVU, bf16_t* MIXED, int lane) {
    const int t0 = item * 8, tpos0 = t0 & (S - 1); const int g = lane >> 4, win = 2 << g;
    const bf16_t* zp = QKVU + (size_t)(t0 - 15) * INP + 3 * SBW + lane * 8;
    u32x4 v[23];
#pragma unroll
    for (int r = 0; r < 23; ++r) { v[r] = (u32x4){0u, 0u, 0u, 0u}; if (tpos0 - 15 + r >= 0) v[r] = *(const u32x4*)(zp + (size_t)r * INP); }
    f32x4 slo = (f32x4){0.f, 0.f, 0.f, 0.f}, shi = slo;
#pragma unroll
    for (int j = 0; j < 16; ++j) { const float mk = (j < win) ? 1.0f : 0.0f; slo += bf_lo(v[15 - j]) * mk; shi += bf_hi(v[15 - j]) * mk; }
    bf16_t* op = MIXED + (size_t)t0 * D + SBW + lane * 8;
#pragma unroll
    for (int i = 0; i < 8; ++i) {
        if (i > 0) { const u32x4 old = (g == 0) ? v[i + 13] : (g == 1) ? v[i + 11] : (g == 2) ? v[i + 7] : v[i - 1];
            slo += bf_lo(v[15 + i]) - bf_lo(old); shi += bf_hi(v[15 + i]) - bf_hi(old); }
        const int tp1 = tpos0 + i + 1; const float inv = 1.0f / (float)(tp1 < win ? tp1 : win);
        const f32x4 olo = slo * inv - bf_lo(v[15 + i]), ohi = shi * inv - bf_hi(v[15 + i]);
        float q = (olo[0] * olo[0] + olo[1] * olo[1]) + (olo[2] * olo[2] + olo[3] * olo[3]) + (ohi[0] * ohi[0] + ohi[1] * ohi[1]) + (ohi[2] * ohi[2] + ohi[3] * ohi[3]);
        const float rs = 1.0f / sqrtf(pg8::wsum(q) * (1.0f / PW) + EPS);
        u32x4 w;
#pragma unroll
        for (int k = 0; k < 4; ++k) w[k] = pg8::cvt_pk_bf16(olo[k] * rs, ohi[k] * rs);
        pg8::st16<3>(op + (size_t)i * D, w);
    }
}
constexpr int P2_DK = 3;
__device__ __forceinline__ void p2_mix(const Args& a, LAS unsigned char* lds, int bx, int G, int wid, int lane, ssq_t* SSQSB, int which = 3, int pstop = 9, bf16_t* pool_dst = nullptr, volatile LAS unsigned* stp = nullptr) {
    unsigned char* ws = a.ws; const bf16_t* QKVU = (const bf16_t*)(ws + WS_QKVU); bf16_t* MIXED = (bf16_t*)(ws + WS_MIXED);
    constexpr int NA = B * NH * (S / 512);
    if (which & 1) for (int i = 0; i * G + bx < NA; ++i) { const int w = pg8::xcd_remap(i * G + bx, NA); const int bh = w >> 3, qb = w & 7;
        sb_item(bh >> 3, bh & 7, qb * 8 + wid, QKVU, MIXED, SSQSB, lds + RING_OFF + wid * 16384, lane);
        if (P2_DEFER && which == 1) for (int j = i * P2_DK; j < (i + 1) * P2_DK; ++j) { const int it = j * G * NWAVES + bx * NWAVES + wid; if (it < P2_DEFER) p2_deferred_item(a, lds + RING_OFF + wid * 16384, it, pg8::fresh_lane()); } }
    if (P2_DEFER && which == 1) for (int j = ((NA + G - 1 - bx) / G) * P2_DK; j * G * NWAVES + bx * NWAVES + wid < P2_DEFER; ++j) p2_deferred_item(a, lds + RING_OFF + wid * 16384, j * G * NWAVES + bx * NWAVES + wid, pg8::fresh_lane());
    if (which & 2) for (int it = bx * NWAVES + wid; it < NTOK / 8; it += G * NWAVES) pool_item(it, QKVU, pool_dst ? pool_dst : MIXED, pg8::fresh_lane());
}
constexpr size_t BAR_REGION_OFF = 1 * MiB, BAR_REGION_STRIDE = 16 * 1024;
__global__ void __launch_bounds__(NWAVES * 64, 2) mega(Args args) {
    const int li = args.li;
    extern __shared__ __attribute__((aligned(16))) unsigned char lds_raw[];
    LAS unsigned char* lds = (LAS unsigned char*)lds_raw;
    volatile LAS unsigned* MISC = (volatile LAS unsigned*)(lds + MISC_OFF);
    const int wave = __builtin_amdgcn_readfirstlane((int)threadIdx.x >> 6);
#define LANE_ID() ({ int l_; asm volatile("v_mbcnt_lo_u32_b32 %0, -1, 0\n\tv_mbcnt_hi_u32_b32 %0, -1, %0" : "=v"(l_)); l_; })
    const int G = gridDim.x; const int bx = blockIdx.x; const int vcu = (G % 8 == 0) ? (bx % 8) * (G / 8) + bx / 8 : bx;
    for (int u = wave * 64 + LANE_ID(); u < MISC_BYTES / 4; u += NWAVES * 64) MISC[u] = 0u;
    __syncthreads();
    unsigned char* ws = args.ws;
    XcdBarrier bar = xcd_barrier_post((unsigned*)(ws + BAR_REGION_OFF + (size_t)li * BAR_REGION_STRIDE), MISC + 8);
    const int lo = args.ph_lo, hi = args.ph_hi;
    LAS unsigned char* ring = lds + RING_OFF; LAS unsigned char* epi = lds + EPI_OFF; LAS unsigned* gtab = (LAS unsigned*)(lds + GTAB_OFF);
#ifndef TIME_PHASE
#define TIME_PHASE -1
#endif
#define REP_OF(k) ((TIME_PHASE == (k)) ? 2 : 1)
#define REPE_OF(k) ((TIME_PHASE == 20 + (k)) ? 2 : 1)
#define IN(k) (lo <= (k) && (k) < hi)
#ifndef TSK
#define TSK -1
#endif
#ifndef TSCALE
#define TSCALE 1.0f
#endif
#define STAMP(i) do { if (TSK >= 0 && wave == 0) { const unsigned long long t_ = __builtin_amdgcn_s_memrealtime(); MISC[128 + 2 * (i)] = (unsigned)t_; MISC[129 + 2 * (i)] = (unsigned)(t_ >> 32); } } while (0)
#define SEAM(k) do { if (IN(k) && IN((k) + 1)) xcd_barrier(bar); STAMP((k) + 1); } while (0)

    STAMP(0);
    if (IN(0)) { p0_prologue(args, lds, vcu, G, wave, LANE_ID()); if (TIME_PHASE == 0) { xcd_barrier(bar); p0_prologue(args, lds, vcu, G, wave, LANE_ID()); } SEAM(0); }
    if (IN(1)) { SchedP1 S{G, bx, ws}; pg8::EpiBf16S E; pg8::gemm_phase<pg8::EpiBf16S, SchedP1, 0, REP_OF(1), REPE_OF(1)>(wave, ring, epi, gtab, D * 2, D * 2, D / 64, S, E);
        if (G == 256 && bx >= 64) p1_deferred_items(args, lds, bx - 64, wave, LANE_ID());
        else if (G != 256 && bx == 0) { for (int rk = 0; rk < 192; ++rk) p1_deferred_items(args, lds, rk, wave, LANE_ID()); }
        SEAM(1); }
    {
    const float* xin0 = args.in[0]; float* outp = args.out;
    bf16_t* S0p = (bf16_t*)(ws + WS_S0); ssq_t* SSQSBp = (ssq_t*)(ws + MK_SSQSB); ssq_t* SSQ1p = (ssq_t*)(ws + MK_SSQ1); ssq_t* SSQ2p = (ssq_t*)(ws + MK_SSQ2);
    constexpr size_t TSTEP = (size_t)256 * D * 2;
    #if !defined(PH_ONLY) || PH_ONLY == 2
    if (IN(2)) { if (TIME_PHASE == 42) { p2_mix(args, lds, bx, G, wave, LANE_ID(), (ssq_t*)(ws + 1280 * 1024), 2); xcd_barrier(bar); p2_mix(args, lds, bx, G, wave, LANE_ID(), (ssq_t*)(ws + 1280 * 1024), 2); xcd_barrier(bar); }
    if (TIME_PHASE == 2 || TIME_PHASE == 40 || TIME_PHASE == 41) { p2_mix(args, lds, bx, G, wave, LANE_ID(), (ssq_t*)(ws + 1280 * 1024), TIME_PHASE == 40 ? 1 : (TIME_PHASE == 41 ? 2 : 3)); xcd_barrier(bar); } STAMP(20); p2_mix(args, lds, bx, G, wave, LANE_ID(), (ssq_t*)(ws + MK_SSQSB), 1); STAMP(21); p2_mix(args, lds, bx, G, wave, LANE_ID(), (ssq_t*)(ws + MK_SSQSB), 2, 9, nullptr, (TSK >= 30 && bx == 0) ? MISC + 128 + 60 : nullptr); STAMP(22); SEAM(2); STAMP(23); }
#endif

#if !defined(PH_ONLY) || PH_ONLY == 3
    if (IN(3)) { SchedReg S{G, bx, NTOK / 256, D / 256, (const char*)(ws + WS_MIXED), (const char*)(ws + WS_WOUT), TSTEP, TSTEP, nullptr, D, nullptr, nullptr};
        EpiResid<8, true, true> E{nullptr, S0p, ws + WS_X1F8, SSQ1p, SSQSBp, 1.0f}; pg8::gemm_phase<EpiResid<8, true, true>, SchedReg, 0, REP_OF(3)>    (wave, ring, epi, gtab, D * 2, D * 2, D / 64, S, E); SEAM(3); }
#endif
#if !defined(PH_ONLY) || PH_ONLY == 4
    if (IN(4)) { SchedReg S{G, bx, NTOK / 256, D / 256, (const char*)(ws + WS_X1F8), (const char*)(ws + WS_WQ), TSTEP / 2, TSTEP / 2, (bf16_t*)(ws + WS_QM), D, nullptr, nullptr, SSQ1p};
        EpiBf16Ssq E{1.0f / D, C2_MEM / WSCALE}; pg8::gemm_phase<EpiBf16Ssq, SchedReg, 0, REP_OF(4), 1, true>(wave, ring, epi, gtab, D, D, D / 128, S, E); STAMP(5); }
#endif
#if !defined(PH_ONLY) || PH_ONLY == 5
    if (IN(5)) { SchedMS S{G, bx, ws}; EpiSoftmax E; pg8::gemm_phase<EpiSoftmax, SchedMS, 0, REP_OF(5)>(wave, ring, epi, gtab, D * 2, D * 2, MHD / 64, S, E); STAMP(6); }
#endif
#if !defined(PH_ONLY) || PH_ONLY == 6
    if (IN(6)) { SchedPV S{G, bx, ws}; pg8::EpiBf16S E; pg8::gemm_phase<pg8::EpiBf16S, SchedPV, 0, REP_OF(6)>(wave, ring, epi, gtab, D * 2, NMEM * 2, NMEM / 64, S, E);
        {
            const bf16_t* om = (const bf16_t*)(ws + WS_OM); unsigned char* om8 = ws + WS_Y + 64 * MiB;     const int t_ = wave * 64 + LANE_ID(); pg8::Unit u_;
            for (int i_ = 0; S.next(i_, u_); ++i_) { const size_t base = (size_t)u_.pm * 256 * D + u_.pn * MHD;
                for (int h_ = 0; h_ < 2; ++h_) {
                u32x4 v_[8];
#pragma unroll
                for (int q_ = 0; q_ < 8; ++q_) { const int c_ = t_ + (h_ * 8 + q_) * NWAVES * 64; v_[q_] = *(const u32x4*)(om + base + (size_t)(c_ >> 5) * D + (c_ & 31) * 8); }
#pragma unroll
                for (int q_ = 0; q_ < 8; ++q_) { const int c_ = t_ + (h_ * 8 + q_) * NWAVES * 64; const size_t o_ = base + (size_t)(c_ >> 5) * D + (c_ & 31) * 8; const u32x4 v = v_[q_];
                    int w0 = __builtin_amdgcn_cvt_pk_fp8_f32(__builtin_bit_cast(float, v.x << 16), __builtin_bit_cast(float, v.x & 0xffff0000u), 0, false); w0 = __builtin_amdgcn_cvt_pk_fp8_f32(__builtin_bit_cast(float, v.y << 16), __builtin_bit_cast(float, v.y & 0xffff0000u), w0, true);
                    int w1 = __builtin_amdgcn_cvt_pk_fp8_f32(__builtin_bit_cast(float, v.z << 16), __builtin_bit_cast(float, v.z & 0xffff0000u), 0, false); w1 = __builtin_amdgcn_cvt_pk_fp8_f32(__builtin_bit_cast(float, v.w << 16), __builtin_bit_cast(float, v.w & 0xffff0000u), w1, true);
                    *(unsigned long long*)(om8 + o_) = (unsigned long long)(unsigned)w0 | ((unsigned long long)(unsigned)w1 << 32); } } } }
        SEAM(6); }
#endif
#if !defined(PH_ONLY) || PH_ONLY == 7
    if (IN(7)) { SchedReg S{G, bx, NTOK / 256, D / 256, (const char*)(ws + WS_Y + 64 * MiB), (const char*)(ws + WS_WO), TSTEP / 2, TSTEP / 2, nullptr, D, nullptr, nullptr};
        EpiResid<-1, true, true> E{nullptr, S0p, ws + WS_X2F8, SSQ2p, nullptr, 1.0f / WSCALE}; pg8::gemm_phase<EpiResid<-1, true, true>, SchedReg, 0, REP_OF(7), 1, true>(wave, ring, epi, gtab, D, D, D / 128, S, E); SEAM(7); }
#endif
#if !defined(PH_ONLY) || PH_ONLY == 8
    if (IN(8)) { if (TIME_PHASE == 8) { p8_route(args, lds, bx, G, wave, LANE_ID(), (int*)(ws + 1536 * 1024)); xcd_barrier(bar); } p8_route(args, lds, bx, G, wave, LANE_ID(), (int*)(ws + OFF_CNT)); SEAM(8); }
#endif
#if !defined(PH_ONLY) || PH_ONLY == 9
    if (IN(9)) { moe_table(args, MISC, wave * 64 + LANE_ID()); SchedMoE<8, true> S{G, bx, ws, MISC, args.in[18]}; EpiSwiGLU E{ws + WS_ACT};
        pg8::gemm_phase<EpiSwiGLU, SchedMoE<8, true>, 1, REP_OF(9), REPE_OF(9), true>(wave, ring, epi, gtab, D, D, D / 128, S, E); SEAM(9); }
#endif
#if !defined(PH_ONLY) || PH_ONLY == 10
    if (IN(10)) { moe_table(args, MISC, wave * 64 + LANE_ID()); SchedMoE<4, false> S{G, bx, ws, MISC, args.in[20]}; EpiW2 E{ws + WS_Y};
        pg8::gemm_phase<EpiW2, SchedMoE<4, false>, 2, REP_OF(10), REPE_OF(10), true>(wave, ring, epi, gtab, DFF, DFF, DFF / 128, S, E); SEAM(10); }
#endif
#if !defined(PH_ONLY) || PH_ONLY == 11
    if (IN(11)) { if (TIME_PHASE == 11) { p11_final(args, vcu, G, wave, LANE_ID(), (float*)(ws + WS_ACT)); xcd_barrier(bar); } p11_final(args, vcu, G, wave, LANE_ID(), args.out); }
#endif
}

    if (TSK >= 100) { __syncthreads(); float* dbg = (float*)(ws + 1792 * 1024);
        if (wave == 0 && LANE_ID() == 0) { const int a_ = (TSK >= 200) ? 21 : 20; const unsigned long long t0 = ((unsigned long long)MISC[129 + 2 * a_] << 32) | MISC[128 + 2 * a_], t1 = ((unsigned long long)MISC[131 + 2 * a_] << 32) | MISC[130 + 2 * a_];
            __hip_atomic_store(dbg + bx, (float)(t1 - t0) * 0.01f, __ATOMIC_RELAXED, __HIP_MEMORY_SCOPE_AGENT); }
        xcd_barrier(bar);
        if (bx == 0 && wave == 0) { const int l_ = LANE_ID(); float mx = 0.f, mn = 1e9f; for (int q = l_; q < G; q += 64) { const float v = __hip_atomic_load(dbg + q, __ATOMIC_RELAXED, __HIP_MEMORY_SCOPE_AGENT); mx = fmaxf(mx, v); mn = fminf(mn, v); }
            for (int o_ = 1; o_ < 64; o_ <<= 1) { mx = fmaxf(mx, __shfl_xor(mx, o_)); mn = fminf(mn, __shfl_xor(mn, o_)); }
            if (l_ == 0) { asm volatile("s_waitcnt vmcnt(0)" ::: "memory"); args.out[0] = ((TSK % 100) == 0 ? mx : mn) * TSCALE; } } }
    else if (TSK >= 0) { STAMP(12); __syncthreads(); if (bx == 0 && wave == 0 && LANE_ID() == 0) { asm volatile("s_waitcnt vmcnt(0)" ::: "memory");
        const unsigned long long t0 = ((unsigned long long)MISC[129 + 2 * TSK] << 32) | MISC[128 + 2 * TSK], t1 = ((unsigned long long)MISC[131 + 2 * TSK] << 32) | MISC[130 + 2 * TSK];
        args.out[0] = (float)(t1 - t0) * 0.01f * TSCALE; } }
    if (TIME_PHASE == 12) { for (int q = 0; q < 10; ++q) xcd_barrier(bar); }
#undef IN
#undef SEAM
}
}

extern "C" void kernel_launch(void* const* d_in, const int* in_sizes, int n_in, void* d_out, int out_size, void* d_ws, size_t ws_size, hipStream_t stream) {
    if (n_in != 22 || out_size != NTOK * D || ws_size < WS_END) { fprintf(stderr, "kernel_launch: unexpected shapes (n_in %d out %d ws %zu)\n", n_in, out_size, ws_size); return; }
    static int grid = 0;
    if (grid == 0) {
        int dev = 0, cus = 0;
        if (hipGetDevice(&dev) != hipSuccess || hipDeviceGetAttribute(&cus, hipDeviceAttributeMultiprocessorCount, dev) != hipSuccess) { grid = -1; return; }
        if (hipFuncSetAttribute((const void*)mk::mega, hipFuncAttributeMaxDynamicSharedMemorySize, mk::LDS_BYTES) != hipSuccess) { fprintf(stderr, "kernel_launch: hipFuncSetAttribute failed\n"); grid = -1; return; }
        int per_cu = 0; (void)hipOccupancyMaxActiveBlocksPerMultiprocessor(&per_cu, (const void*)mk::mega, mk::NWAVES * 64, mk::LDS_BYTES); (void)hipGetLastError();
        if (per_cu < 1) fprintf(stderr, "kernel_launch: occupancy query reports %d blocks per CU\n", per_cu);
        grid = cus;
    }
    if (grid < 0) return;
    (void)hipMemsetAsync((unsigned char*)d_ws + WS_CTL, 0, CTL_BYTES, stream);
    mk::Args a{}; for (int i = 0; i < 22; ++i) a.in[i] = (const float*)d_in[i]; a.out = (float*)d_out; a.ws = (unsigned char*)d_ws;
    a.ph_lo = 0; a.ph_hi = mk::NPHASE; a.li = 0;
    hipLaunchKernelGGL(mk::mega, dim3(grid), dim3(mk::NWAVES * 64), mk::LDS_BYTES, stream, a);
}
```

```cpp
#include <hip/hip_runtime.h>
#include <cstdio>
#include <cstdint>

typedef unsigned short bf16_t;
typedef short bf16x8 __attribute__((ext_vector_type(8)));
typedef float f32x4 __attribute__((ext_vector_type(4)));
typedef unsigned u32x4 __attribute__((ext_vector_type(4)));

namespace cfg {
constexpr int B = 8, S = 4096, D = 1024, NTOK = B * S;
constexpr int SBW = 512, NH = 8, HD = 64, PW = 512, PG = 4, PGD = 128, INP = 2048;
constexpr int NMEM = 256, MH = 4, MHD = 256, NMROWS = B * NMEM;
constexpr int NE = 32, TOPK = 4, DFF = 1024, LCAP = NTOK;
constexpr float EPS = 1e-5f, LOG2E = 1.4426950408889634f;
constexpr float C2_SB = 0.125f * LOG2E, C2_MEM = 0.0625f * LOG2E;
constexpr float SW_LIMIT = 7.0f, SW_ALPHA = 1.702f;
constexpr int MAXTILES = 544;
constexpr size_t MiB = 1u << 20;
constexpr size_t WS_CTL = 0, CTL_BYTES = 2 * MiB;
constexpr size_t OFF_CNT = 64 * 1024, OFF_SSQSB = 512 * 1024, OFF_SSQ1 = 640 * 1024, OFF_SSQ2 = 768 * 1024;
constexpr size_t WS_WIN = 2 * MiB, WS_WOUT = 6 * MiB, WS_WQ = 8 * MiB, WS_WKV = 10 * MiB, WS_WO = 14 * MiB, WS_WP = 16 * MiB, WS_WR = 17 * MiB;
constexpr size_t WS_RSTDX = 18 * MiB, WS_RSTDM = 18 * MiB + 512 * 1024;
constexpr size_t WS_W1 = 20 * MiB, WS_W2 = 148 * MiB;
constexpr size_t WS_S0 = 212 * MiB;
constexpr size_t WS_QKVU = 276 * MiB;
constexpr size_t WS_QM = 276 * MiB, WS_OM = 340 * MiB;
constexpr size_t WS_MIXED = 404 * MiB;
constexpr size_t WS_PM = 404 * MiB;
constexpr size_t WS_ACT = 276 * MiB;
constexpr size_t WS_KM = 548 * MiB, WS_VMT = 552 * MiB, WS_MEMB = 556 * MiB, WS_LSLOT = 560 * MiB, WS_LGATE = 564 * MiB;
constexpr size_t WS_Y = 568 * MiB;
constexpr size_t WS_SCR_S = 568 * MiB, WS_SCR_POOLED = 696 * MiB, WS_SCR_POOLO = 728 * MiB;
constexpr size_t WS_END = 824 * MiB;
}
using namespace cfg;

__device__ __forceinline__ unsigned f2bf(float f) { unsigned u = __builtin_bit_cast(unsigned, f); return (u + 0x7fffu + ((u >> 16) & 1u)) >> 16; }
__device__ __forceinline__ float bf2f(bf16_t h) { return __builtin_bit_cast(float, (unsigned)h << 16); }
__device__ __forceinline__ float wave_sum(float v) {
#pragma unroll
    for (int o = 1; o < 64; o <<= 1) v += __shfl_xor(v, o);
    return v;
}


#define LAS __attribute__((address_space(3)))
#define GAS __attribute__((address_space(1)))
typedef int v4i_t __attribute__((ext_vector_type(4)));
typedef int v8i_t __attribute__((ext_vector_type(8)));
namespace pg8 {
constexpr int BM = 256, BK = 64, HALF = 128, HTB = HALF * BK * 2, STAGE_BYTES = 8 * HTB, NXCD = 8, WGM = 8;
__host__ __device__ __forceinline__ int lds_byte(int r, int c) { const int st = (r >> 4) * 2 + (c >> 5), rr = r & 15, cc = c & 31, ob = rr * 64 + cc * 2; return st * 1024 + (ob ^ (((ob >> 9) & 1) << 5)); }
__host__ __device__ __forceinline__ void stage_rc(int b, int& R, int& C) { const int st = b / 1024, sb = b % 1024, swz = sb ^ (((sb >> 9) & 1) << 5); R = (st >> 1) * 16 + swz / 64; C = (st & 1) * 32 + (swz % 64) / 2; }
__host__ __device__ __forceinline__ int perm32(int rho) { const int n = rho >> 4, i = rho & 15; return 8 * (i >> 2) + 4 * n + (i & 3); }
__device__ __forceinline__ unsigned cvt_pk_bf16(float lo, float hi) { unsigned r; asm volatile("v_cvt_pk_bf16_f32 %0, %1, %2" : "=v"(r) : "v"(lo), "v"(hi)); return r; }

#define WTMASK 0x008
#ifndef WTMASK
#define WTMASK 0x1ff
#endif
#define WT_ON(bit) (((WTMASK) >> (bit)) & 1)
__device__ __forceinline__ void st16_wt(void* p, u32x4 v) { asm volatile("global_store_dwordx4 %0, %1, off sc1\n\ts_nop 1" :: "v"(p), "v"(v)); }
__device__ __forceinline__ void st16_wt(void* p, f32x4 v) { asm volatile("global_store_dwordx4 %0, %1, off sc1\n\ts_nop 1" :: "v"(p), "v"(v)); }
template <int BIT, class V> __device__ __forceinline__ void st16(void* p, V v) { if constexpr (WT_ON(BIT)) st16_wt(p, v); else *(V*)p = v; }
#ifndef WT8
#define WT8 0
#endif
__device__ __forceinline__ void st8_wt(void* p, unsigned long long v) { if (WT8) __hip_atomic_store((unsigned long long*)p, v, __ATOMIC_RELAXED, __HIP_MEMORY_SCOPE_AGENT); else *(unsigned long long*)p = v; }
__device__ __forceinline__ void st4_wt(void* p, unsigned v) { if (WT8) __hip_atomic_store((unsigned*)p, v, __ATOMIC_RELAXED, __HIP_MEMORY_SCOPE_AGENT); else *(unsigned*)p = v; }
template <int M> __device__ __forceinline__ float swz_xor(float v) { return __uint_as_float((unsigned)__builtin_amdgcn_ds_swizzle((int)__float_as_uint(v), (M << 10) | 0x1f)); }
__device__ __forceinline__ float half_sum(float v) { const auto sw = __builtin_amdgcn_permlane32_swap(__float_as_uint(v), __float_as_uint(v), false, false); return __uint_as_float(sw[0]) + __uint_as_float(sw[1]); }
__device__ __forceinline__ float half_max(float v) { const auto sw = __builtin_amdgcn_permlane32_swap(__float_as_uint(v), __float_as_uint(v), false, false); return fmaxf(__uint_as_float(sw[0]), __uint_as_float(sw[1])); }
__device__ __forceinline__ float wsum(float v) { v += swz_xor<1>(v); v += swz_xor<2>(v); v += swz_xor<4>(v); v += swz_xor<8>(v); v += swz_xor<16>(v); return half_sum(v); }
__device__ __forceinline__ int fresh_lane() { int l; asm volatile("v_mbcnt_lo_u32_b32 %0, -1, 0\n\tv_mbcnt_hi_u32_b32 %0, -1, %0" : "=v"(l)); return l; }
struct Unit { const char* A; const char* B; void* p0; void* p1; void* p2; void* p3; int pm, pn, i0, i1, ghost; };

__device__ __forceinline__ int xcd_remap(int L, int nwg) { const int q = nwg / NXCD, r = nwg % NXCD, xcd = L % NXCD, off = L / NXCD; return __builtin_amdgcn_readfirstlane((xcd < r ? xcd * (q + 1) : r * (q + 1) + (xcd - r) * q) + off); }
__device__ __forceinline__ void grouped_mn(int wgid, int nM, int nN, int& pm, int& pn) {
    const int nig = WGM * nN, gid = wgid / nig, fm = gid * WGM, gsz = (nM - fm) < WGM ? (nM - fm) : WGM; pm = __builtin_amdgcn_readfirstlane(fm + ((wgid % nig) % gsz)); pn = __builtin_amdgcn_readfirstlane((wgid % nig) / gsz); }

template <class Epi, class Sched, int TABS, int REP = 1  , int REPE = 1, bool F8 = false>
__device__ __forceinline__ void gemm_phase(const int wid, LAS unsigned char* lds, LAS unsigned char* epi_lds, LAS unsigned* gtab, const int lda_b, const int ldb_b, const int nt, const Sched& S, const Epi& E) {
    constexpr bool GATHER = (TABS == 1);
    const int wr = wid >> 2, wc = wid & 3;
    unsigned voffA, voffB, voffG[2][2]; int aoff, boff;
    { const int lane = fresh_lane(); int R, C; stage_rc(wid * 1024 + lane * 16, R, C); const int Rb = Epi::PERM ? ((R & ~31) + perm32(R & 31)) : R;
      voffA = (unsigned)(R * lda_b + C * 2); voffB = (unsigned)(Rb * ldb_b + C * 2); voffG[0][0] = voffG[0][1] = voffG[1][0] = voffG[1][1] = 0;
      aoff = lds_byte(wr * 64 + (lane & 15), (lane >> 4) * 8); boff = lds_byte(wc * 32 + (lane & 15), (lane >> 4) * 8); }
    const size_t kstep = (size_t)(BK * 2);
    const size_t hstepA = (size_t)HALF * lda_b, hstepB = (size_t)HALF * ldb_b;
    const unsigned ldsw = (unsigned)wid * 1024u; const unsigned ldsbase = (unsigned)(uintptr_t)lds + ldsw;
#define PG8_SA(b, h) (((b) * 2 + (h)) * HTB)
#define PG8_SB(b, h) ((4 + (b) * 2 + (h)) * HTB)
#define PG8_GLDS(ugp, voff, bufoff, _i) do { unsigned _keep; asm volatile("s_mov_b32 %0, m0\n\ts_mov_b32 m0, %3\n\ts_nop 0\n\tglobal_load_lds_dwordx4 %1, %2\n\ts_mov_b32 m0, %0" \
        : "=&s"(_keep) : "v"(voff), "s"((const char*)(ugp)), "s"(ldsbase + (unsigned)((bufoff) + (_i) * 8192)) : "memory"); } while (0)
#define PG8_STAGE_B(bufoff, gbase) do { _Pragma("unroll") for (int _i = 0; _i < 2; ++_i) PG8_GLDS((const char*)(gbase) + (size_t)_i * 64 * ldb_b, voffB, bufoff, _i); } while (0)
#define PG8_STAGE_A(bufoff, gbase, h) do { if constexpr (GATHER) { _Pragma("unroll") for (int _i = 0; _i < 2; ++_i) PG8_GLDS((const char*)(gbase), voffG[h][_i], bufoff, _i); } \
        else { _Pragma("unroll") for (int _i = 0; _i < 2; ++_i) PG8_GLDS((const char*)(gbase) + (h) * hstepA + (size_t)_i * 64 * lda_b, voffA, bufoff, _i); } } while (0)
#define PG8_LDA(dst, b, h) do { _Pragma("unroll") for (int m = 0; m < 4; ++m) _Pragma("unroll") for (int k = 0; k < 2; ++k) dst[m][k] = *(const LAS bf16x8*)(lds + PG8_SA(b, h) + aoff + m * 2048 + k * 1024); } while (0)
#define PG8_LDB(dst, b, h) do { _Pragma("unroll") for (int n = 0; n < 2; ++n) _Pragma("unroll") for (int k = 0; k < 2; ++k) dst[n][k] = *(const LAS bf16x8*)(lds + PG8_SB(b, h) + boff + n * 2048 + k * 1024); } while (0)
#define PG8_CAT(x0, x1) __builtin_shufflevector(__builtin_bit_cast(v4i_t, x0), __builtin_bit_cast(v4i_t, x1), 0, 1, 2, 3, 4, 5, 6, 7)
#define PG8_MMA(ai, bj, At, Bt) do { __builtin_amdgcn_s_setprio(1); _Pragma("unroll") for (int m = 0; m < 4; ++m) _Pragma("unroll") for (int n = 0; n < 2; ++n) { \
        if constexpr (F8) acc[ai][bj][m][n] = __builtin_amdgcn_mfma_scale_f32_16x16x128_f8f6f4(PG8_CAT(Bt[n][0], Bt[n][1]), PG8_CAT(At[m][0], At[m][1]), acc[ai][bj][m][n], 0, 0, 0, 0, 0, 0); \
        else { _Pragma("unroll") for (int k = 0; k < 2; ++k) acc[ai][bj][m][n] = __builtin_amdgcn_mfma_f32_16x16x32_bf16(Bt[n][k], At[m][k], acc[ai][bj][m][n], 0, 0, 0); } } __builtin_amdgcn_s_setprio(0); } while (0)
#define PG8_WAIT_V(n) asm volatile("s_waitcnt vmcnt(" #n ")" ::: "memory")
#define PG8_WAIT_L(n) asm volatile("s_waitcnt lgkmcnt(" #n ")" ::: "memory")
#define PG8_BAR __builtin_amdgcn_s_barrier()
#define PG8_SCHED __builtin_amdgcn_sched_barrier(0)
#define PG8_GTAB_LOAD(buf, nvalid) do { const int _l = fresh_lane(); int _R, _C; stage_rc(wid * 1024 + _l * 16, _R, _C); _Pragma("unroll") for (int _h = 0; _h < 2; ++_h) _Pragma("unroll") for (int _i = 0; _i < 2; ++_i) { \
        const int _row = _h * HALF + _R + 64 * _i; const unsigned _s = gtab[(buf) * 768 + _row]; voffG[_h][_i] = ((_row < (nvalid)) ? (_s >> 2) * (unsigned)lda_b : 0u) + (unsigned)(_C * 2); } } while (0)
#define PG8_GTAB_DMA(buf, U) do { if constexpr (TABS == 3) { if (wid == 1 || wid == 2) { const char* _b = (wid == 1) ? (const char*)(U).p1 : (const char*)(U).p2;     \
            if (_b) __builtin_amdgcn_global_load_lds((const unsigned*)(_b + fresh_lane() * 16), (LAS unsigned*)(gtab + (buf) * 768 + wid * 256), 16, 0, 0); } } \
        else if (wid < 3) { const int _l = fresh_lane(); const char* _src = (wid == 0) ? (const char*)(U).p3 + _l * 16 : (wid == 1) ? (const char*)(U).p2 + _l * 16 : \
            (TABS == 1 ? (const char*)(U).p1 + (_l & 31) * 16 + (_l >> 5) * (DFF * 4) : (const char*)(U).p1 + _l * 16); \
        __builtin_amdgcn_global_load_lds((const unsigned*)_src, (LAS unsigned*)(gtab + (buf) * 768 + wid * 256), 16, 0, 0); } } while (0)
    auto nextu = [&](int i, Unit& u) -> bool { if constexpr (REP > 1) { const bool ok = S.next(i / REP, u); u.ghost = (i % REP) != REP - 1; return ok; } else { u.ghost = 0; return S.next(i, u); } };
    Unit cur, nxt; int ui = 0;
    if (!nextu(0, cur)) return;
    f32x4 acc[2][2][4][2];
#pragma unroll
    for (int a = 0; a < 2; ++a)
#pragma unroll
        for (int b = 0; b < 2; ++b)
#pragma unroll
            for (int m = 0; m < 4; ++m)
#pragma unroll
                for (int n = 0; n < 2; ++n) acc[a][b][m][n] = (f32x4){0.f, 0.f, 0.f, 0.f};
    bf16x8 At[4][2], B0[2][2], B1[2][2];
    const char* cA = cur.A; const char* cB = cur.B;
    if constexpr (TABS != 0) { PG8_GTAB_DMA(0, cur); PG8_WAIT_V(0); PG8_WAIT_L(0); PG8_BAR; if constexpr (GATHER) PG8_GTAB_LOAD(0, cur.i0); }
    PG8_STAGE_B(PG8_SB(0, 0), cB); PG8_STAGE_B(PG8_SB(0, 1), cB + hstepB); PG8_STAGE_A(PG8_SA(0, 0), cA, 0); PG8_STAGE_A(PG8_SA(0, 1), cA, 1);
    if (wr == 1) PG8_BAR;
    PG8_WAIT_V(2); PG8_BAR;
    PG8_STAGE_B(PG8_SB(1, 0), cB + kstep); PG8_STAGE_A(PG8_SA(1, 0), cA + kstep, 0); PG8_STAGE_B(PG8_SB(1, 1), cB + hstepB + kstep);
    PG8_WAIT_V(6); PG8_BAR;
    for (;;) {
        const bool has_next = nextu(ui + 1, nxt);
        const char* nA = has_next ? nxt.A : cA; const char* nB = has_next ? nxt.B : cB;
#pragma unroll 1
        for (int t = 0; t < nt; t += 2) {
            const bool last = (t == nt - 2);
            const char* a1 = cA + (size_t)(t + 1) * kstep;
            const char* a2 = last ? nA : cA + (size_t)(t + 2) * kstep; const char* b2 = last ? nB : cB + (size_t)(t + 2) * kstep;
            const char* a3 = a2 + kstep; const char* b3 = b2 + kstep;
            if constexpr (Epi::MIDK >= 0) { if (t == Epi::MIDK) E.midk(acc, cur, wr, fresh_lane() & 15); }
            if constexpr (TABS != 0) { if (t == 2 && has_next) PG8_GTAB_DMA((ui + 1) & 1, nxt); }
            if constexpr (GATHER) { PG8_STAGE_A(PG8_SA(1, 1), a1, 1); if (last && has_next) PG8_GTAB_LOAD((ui + 1) & 1, nxt.i0); PG8_SCHED; }
            PG8_LDB(B0, 0, 0); PG8_LDB(B1, 0, 1); PG8_SCHED; PG8_LDA(At, 0, 0); if constexpr (!GATHER) PG8_STAGE_A(PG8_SA(1, 1), a1, 1);
            PG8_WAIT_V(8); PG8_WAIT_L(0); PG8_BAR; PG8_MMA(0, 0, At, B0); PG8_MMA(0, 1, At, B1); PG8_BAR; PG8_SCHED;
            PG8_LDA(At, 0, 1); PG8_STAGE_B(PG8_SB(0, 0), b2); PG8_STAGE_B(PG8_SB(0, 1), b2 + hstepB); PG8_STAGE_A(PG8_SA(0, 0), a2, 0);
            PG8_WAIT_V(8); PG8_WAIT_L(0); PG8_BAR; PG8_MMA(1, 0, At, B0); PG8_MMA(1, 1, At, B1); PG8_BAR; PG8_SCHED;
            PG8_LDB(B0, 1, 0); PG8_LDB(B1, 1, 1); PG8_SCHED; PG8_LDA(At, 1, 0); PG8_STAGE_A(PG8_SA(0, 1), a2, 1);
            PG8_WAIT_V(8); PG8_WAIT_L(0); PG8_BAR; PG8_MMA(0, 0, At, B0); PG8_MMA(0, 1, At, B1); PG8_BAR; PG8_SCHED;
            PG8_LDA(At, 1, 1); PG8_STAGE_B(PG8_SB(1, 0), b3); PG8_STAGE_B(PG8_SB(1, 1), b3 + hstepB); PG8_STAGE_A(PG8_SA(1, 0), a3, 0);
            PG8_WAIT_V(8); PG8_WAIT_L(0); PG8_BAR; PG8_MMA(1, 0, At, B0); PG8_MMA(1, 1, At, B1); PG8_BAR; PG8_SCHED;
        }
        if (wr == 0) PG8_BAR;
        if (!cur.ghost) { const int el = fresh_lane(); LAS unsigned char* ex = (TABS != 0) ? (LAS unsigned char*)(gtab + (ui & 1) * 768) : epi_lds; E(acc, cur, wr, wc, el & 15, el >> 4, wid, el, ex); if constexpr (REPE > 1) { asm volatile("" ::: "memory"); E(acc, cur, wr, wc, el & 15, el >> 4, wid, el, ex); } }
        if (!has_next) break;
#pragma unroll
        for (int a = 0; a < 2; ++a)
#pragma unroll
            for (int b = 0; b < 2; ++b)
#pragma unroll
                for (int m = 0; m < 4; ++m)
#pragma unroll
                    for (int n = 0; n < 2; ++n) acc[a][b][m][n] = (f32x4){0.f, 0.f, 0.f, 0.f};
        cur = nxt; cA = nA; cB = nB; ++ui;
        if (wr == 1) PG8_BAR;
    }
    PG8_WAIT_V(0);
    PG8_BAR;
#undef PG8_SA
#undef PG8_SB
#undef PG8_GLDS
#undef PG8_STAGE_A
#undef PG8_STAGE_B
#undef PG8_LDA
#undef PG8_LDB
#undef PG8_MMA
#undef PG8_CAT
#undef PG8_WAIT_V
#undef PG8_WAIT_L
#undef PG8_BAR
#undef PG8_SCHED
#undef PG8_GTAB_LOAD
#undef PG8_GTAB_DMA
}

template <bool F8O> struct EpiBf16SX {
    static constexpr bool PERM = true; static constexpr int MIDK = -1;
    __device__ __forceinline__ void midk(f32x4 (&)[2][2][4][2], const Unit&, int, int) const {}
    __device__ __forceinline__ void operator()(const f32x4 (&acc)[2][2][4][2], const Unit& u, int wr, int wc, int fr, int fq, int, int, LAS unsigned char*) const {
        bf16_t* O = (bf16_t*)u.p0; unsigned char* O8 = (unsigned char*)u.p0; const float* rs = (const float*)u.p1; const float* cs = (const float*)u.p2; const int ldc = u.i0;
        int r0 = wr * 64 + fr, c0 = wc * 32 + 8 * fq; asm volatile("" : "+v"(r0), "+v"(c0));
        f32x4 cv[2][2];
#pragma unroll
        for (int bj = 0; bj < 2; ++bj)
#pragma unroll
            for (int n = 0; n < 2; ++n) cv[bj][n] = cs ? *(const f32x4*)(cs + c0 + bj * HALF + 4 * n) : (f32x4){1.f, 1.f, 1.f, 1.f};
#pragma unroll
        for (int ai = 0; ai < 2; ++ai)
#pragma unroll
            for (int m = 0; m < 4; ++m) { const int r = r0 + ai * HALF + m * 16; const float rv = rs ? rs[r] : 1.f; bf16_t* rowp = O + (size_t)r * ldc + c0;
#pragma unroll
                for (int bj = 0; bj < 2; ++bj) { const f32x4 v0 = acc[ai][bj][m][0] * cv[bj][0] * rv, v1 = acc[ai][bj][m][1] * cv[bj][1] * rv;
                    if constexpr (F8O) { int w0 = __builtin_amdgcn_cvt_pk_fp8_f32(v0[0], v0[1], 0, false); w0 = __builtin_amdgcn_cvt_pk_fp8_f32(v0[2], v0[3], w0, true); int w1 = __builtin_amdgcn_cvt_pk_fp8_f32(v1[0], v1[1], 0, false); w1 = __builtin_amdgcn_cvt_pk_fp8_f32(v1[2], v1[3], w1, true);
                        st8_wt(O8 + (size_t)r * ldc + c0 + bj * HALF, (unsigned long long)(unsigned)w0 | ((unsigned long long)(unsigned)w1 << 32)); }
                    else { u32x4 w; w.x = cvt_pk_bf16(v0[0], v0[1]); w.y = cvt_pk_bf16(v0[2], v0[3]); w.z = cvt_pk_bf16(v1[0], v1[1]); w.w = cvt_pk_bf16(v1[2], v1[3]);
                    st16<1>(rowp + bj * HALF, w); } } }
    }
};
typedef EpiBf16SX<false> EpiBf16S;
struct EpiBf16T {
    static constexpr bool PERM = true; static constexpr int MIDK = -1;
    __device__ __forceinline__ void midk(f32x4 (&)[2][2][4][2], const Unit&, int, int) const {}
    __device__ __forceinline__ void operator()(const f32x4 (&acc)[2][2][4][2], const Unit& u, int wr, int wc, int fr, int fq, int, int, LAS unsigned char* tab) const {
        bf16_t* O = (bf16_t*)u.p0; const bool has_rs = u.p1 != nullptr, has_cs = u.p2 != nullptr; const int ldc = u.i0;
        const LAS float* T1 = (const LAS float*)tab + 256; const LAS float* T2 = (const LAS float*)tab + 512;
        int r0 = wr * 64 + fr, c0 = wc * 32 + 8 * fq; asm volatile("" : "+v"(r0), "+v"(c0));
        f32x4 cv[2][2];
#pragma unroll
        for (int bj = 0; bj < 2; ++bj)
#pragma unroll
            for (int n = 0; n < 2; ++n) cv[bj][n] = has_cs ? *(const LAS f32x4*)(T2 + c0 + bj * HALF + 4 * n) : (f32x4){1.f, 1.f, 1.f, 1.f};
#pragma unroll
        for (int ai = 0; ai < 2; ++ai)
#pragma unroll
            for (int m = 0; m < 4; ++m) { const int r = r0 + ai * HALF + m * 16; const float rv = has_rs ? T1[r] : 1.f; bf16_t* rowp = O + (size_t)r * ldc + c0;
#pragma unroll
                for (int bj = 0; bj < 2; ++bj) { const f32x4 v0 = acc[ai][bj][m][0] * cv[bj][0] * rv, v1 = acc[ai][bj][m][1] * cv[bj][1] * rv;
                    u32x4 w; w.x = cvt_pk_bf16(v0[0], v0[1]); w.y = cvt_pk_bf16(v0[2], v0[3]); w.z = cvt_pk_bf16(v1[0], v1[1]); w.w = cvt_pk_bf16(v1[2], v1[3]);
                    st16<1>(rowp + bj * HALF, w); } }
    }
};
}

namespace mk {
constexpr int NWAVES = 8, NPHASE = 12;
constexpr int RING_OFF = 0, RING_BYTES = 131072, EPI_OFF = 131072, EPI_BYTES = 8192, GTAB_OFF = EPI_OFF + EPI_BYTES, GTAB_BYTES = 6144, MISC_OFF = GTAB_OFF + GTAB_BYTES, MISC_BYTES = 1024;
constexpr int LDS_BYTES = 147456;
static_assert(MISC_OFF + MISC_BYTES <= LDS_BYTES, "LDS map");
constexpr size_t WS_LRS = 84 * MiB;
constexpr size_t WS_X2F8 = WS_Y, WS_X1F8 = WS_Y + 32 * MiB;
constexpr size_t WS_CSG1 = 19 * MiB, WS_WRH = 19 * MiB + 64 * 1024, WS_WRL = 19 * MiB + 128 * 1024;
typedef unsigned ssq_t;
constexpr size_t MK_SSQSB = 256 * 1024, MK_SSQ1 = 512 * 1024, MK_SSQ2 = 768 * 1024;
__device__ __forceinline__ void ssq_add(ssq_t* p, float q) { (void)__hip_atomic_fetch_add(p, (ssq_t)__float2uint_rn(q * 16384.0f), __ATOMIC_RELAXED, __HIP_MEMORY_SCOPE_AGENT); }
__device__ __forceinline__ float ssq_get(const ssq_t* p) { return (float)(*p) * (1.0f / 16384.0f); }
constexpr float WSCALE = 32.0f;
constexpr int P2_DEFER = 2048 * 6;
constexpr int P0_DEFER = 192 * 8 * 6;
constexpr int CW_BAR = 1024;

#define RLX_AGENT __ATOMIC_RELAXED, __HIP_MEMORY_SCOPE_AGENT
#define LDS_WAIT() asm volatile("s_waitcnt lgkmcnt(0)" ::: "memory")
#define VM_WAIT() asm volatile("s_waitcnt vmcnt(0)" ::: "memory")
#define XB_TMO      128
#define XB_XCNT(j)  (256  + 64 * (j))
#define XB_XSUB(j)  (1280 + 64 * (j))
#define XB_XGEN(j)  (2304 + 64 * (j))
#define XB_TOP      3328
#define XB_TOPGEN   3392
#define XCD_BAR_WORDS 3456
#define XB_SPIN_CAP (1u << 20)
__device__ __forceinline__ unsigned xb_ld(unsigned* p)              { return __hip_atomic_load(p, __ATOMIC_RELAXED, __HIP_MEMORY_SCOPE_AGENT); }
__device__ __forceinline__ unsigned xb_add(unsigned* p, unsigned v) { return __hip_atomic_fetch_add(p, v, __ATOMIC_RELAXED, __HIP_MEMORY_SCOPE_AGENT); }
__device__ __forceinline__ unsigned xb_xcc_id() { return (unsigned)__builtin_amdgcn_s_getreg((3 << 11) | 20) & 0xFu; }
#define XB_SPIN(cond, bar) do { unsigned _sp = 0; while (cond) { __builtin_amdgcn_s_sleep(1); \
    if ((++_sp & 255u) == 0u) { if (xb_ld(&(bar)[XB_TMO])) break; if (_sp > XB_SPIN_CAP) { atomicAdd(&(bar)[XB_TMO], 1u); break; } } } } while (0)
struct XcdBarrier { unsigned* bar; unsigned x; volatile LAS unsigned* st; };
__device__ __forceinline__ XcdBarrier xcd_barrier_post(unsigned* bar, volatile LAS unsigned* st) {
    XcdBarrier b; b.bar = bar; b.x = xb_xcc_id(); b.st = st;
    if (threadIdx.x == 0) (void)xb_add(&bar[XB_XCNT(b.x)], 1u);
    return b;
}
__device__ __forceinline__ void xcd_barrier_complete(unsigned* bar, unsigned x, unsigned& nloc, unsigned& nx) {
    const unsigned G = gridDim.x * gridDim.y * gridDim.z;
    unsigned sum, cnt, mine, sp = 0u;
    for (;;) {
        sum = 0u; cnt = 0u; mine = 0u;
#pragma unroll
        for (unsigned j = 0; j < 16; ++j) { const unsigned c = xb_ld(&bar[XB_XCNT(j)]); sum += c; cnt += (c > 0u) ? 1u : 0u; mine = (j == x) ? c : mine; }
        if (sum == G) break;
        __builtin_amdgcn_s_sleep(1);
        if ((++sp & 255u) == 0u) { if (xb_ld(&bar[XB_TMO])) break; if (sp > XB_SPIN_CAP) { atomicAdd(&bar[XB_TMO], 1u); break; } }
    }
    nloc = mine > 0u ? mine : 1u; nx = cnt > 0u ? cnt : 1u;
}
__device__ __forceinline__ void xcd_barrier(const XcdBarrier& b) {
    asm volatile("s_waitcnt vmcnt(0)" ::: "memory");
    __syncthreads();
    if (threadIdx.x == 0) {
        unsigned* bar = b.bar;
        __builtin_amdgcn_s_waitcnt(0);
        unsigned nloc = b.st[0], nx = b.st[1];
        if (nloc == 0u) { xcd_barrier_complete(bar, b.x, nloc, nx); b.st[0] = nloc; b.st[1] = nx; }
        const unsigned old = xb_add(&bar[XB_XSUB(b.x)], 1u);
        const unsigned gen = old / nloc;
        if (old + 1u == (gen + 1u) * nloc) {
            __builtin_amdgcn_fence(__ATOMIC_RELEASE, "agent");
            asm volatile("s_waitcnt vmcnt(0)" ::: "memory");
            const unsigned og = xb_add(&bar[XB_TOP], 1u);
            const unsigned tg = og / nx;
            if (og + 1u == (tg + 1u) * nx) xb_add(&bar[XB_TOPGEN], 1u);
            else XB_SPIN(xb_ld(&bar[XB_TOPGEN]) == tg, bar);
            __builtin_amdgcn_fence(__ATOMIC_ACQUIRE, "agent");
            xb_add(&bar[XB_XGEN(b.x)], 1u);
            asm volatile("s_waitcnt vmcnt(0)" ::: "memory");
        } else {
            XB_SPIN(xb_ld(&bar[XB_XGEN(b.x)]) == gen, bar);
            __builtin_amdgcn_fence(__ATOMIC_ACQUIRE, "agent");
            asm volatile("s_waitcnt vmcnt(0)" ::: "memory");
        }
    }
    __syncthreads();
}

struct Args { const float* in[22]; float* out; unsigned char* ws; int ph_lo, ph_hi, li, pad; };

template <bool F8OUT>
__device__ __forceinline__ void p0_item(const float* W, int K, int N, void* WTv, const float* gk, const float* gk2, int ksplit, const float* gn, int mode, LAS float* scr, int item, int lane, float mult = 1.0f, int nblk_dec = 0) {
    const int nblk = nblk_dec ? nblk_dec : N / 32, kb = item / nblk, nb = item % nblk, k0 = 64 * kb, nd0 = 32 * nb;
    int ns0 = nd0; if (mode == 1) { const int pn = nd0 >> 8, j = nd0 & 255; ns0 = (j < 128) ? 128 * pn + j : 1024 + 128 * pn + (j - 128); }
    const int kr = lane >> 3, n4 = (lane & 7) * 4;
    f32x4 v[8];
#pragma unroll
    for (int i = 0; i < 8; ++i) v[i] = __builtin_nontemporal_load((const f32x4*)(W + (size_t)(k0 + 8 * i + kr) * N + ns0 + n4));
    f32x4 gnv = (f32x4){1.f, 1.f, 1.f, 1.f}; if (gn) gnv = *(const f32x4*)(gn + ns0 + n4);
#pragma unroll
    for (int i = 0; i < 8; ++i) { const int kk = 8 * i + kr, k = k0 + kk; float g = 1.f; if (gk) g = (k < ksplit) ? gk[k] : gk2[k - ksplit];
        const f32x4 t = v[i] * gnv * (g * mult); LAS float* d = scr + kk * 33 + n4; d[0] = t[0]; d[1] = t[1]; d[2] = t[2]; d[3] = t[3]; }
    LDS_WAIT(); asm volatile("" ::: "memory");
    const int c = lane & 7;
#pragma unroll
    for (int j = 0; j < 4; ++j) { const int n = (lane >> 3) + 8 * j; const LAS float* s = scr + (8 * c) * 33 + n;
        if constexpr (F8OUT) { int lo = __builtin_amdgcn_cvt_pk_fp8_f32(s[0 * 33], s[1 * 33], 0, false); lo = __builtin_amdgcn_cvt_pk_fp8_f32(s[2 * 33], s[3 * 33], lo, true);
            int hi2 = __builtin_amdgcn_cvt_pk_fp8_f32(s[4 * 33], s[5 * 33], 0, false); hi2 = __builtin_amdgcn_cvt_pk_fp8_f32(s[6 * 33], s[7 * 33], hi2, true);
            pg8::st8_wt((unsigned char*)WTv + (size_t)(nd0 + n) * K + k0 + 8 * c, (unsigned long long)(unsigned)lo | ((unsigned long long)(unsigned)hi2 << 32)); }
        else { u32x4 o; o.x = pg8::cvt_pk_bf16(s[0 * 33], s[1 * 33]); o.y = pg8::cvt_pk_bf16(s[2 * 33], s[3 * 33]); o.z = pg8::cvt_pk_bf16(s[4 * 33], s[5 * 33]); o.w = pg8::cvt_pk_bf16(s[6 * 33], s[7 * 33]);
            pg8::st16<0>((bf16_t*)WTv + (size_t)(nd0 + n) * K + k0 + 8 * c, o); } }
    LDS_WAIT(); asm volatile("" ::: "memory");
}
__device__ __forceinline__ void p0_fused_pool_item(const float* w_in, const float* g_mix, const float* w_pool, const float* pool_scale, bf16_t* WIN_T, int item, int lane) {
    const int eb = item & 7, kb = (item >> 3) & 15, g = item >> 7; const int k = kb * 64 + lane, e0 = eb * 16;
    const float* ap = w_in + (size_t)k * INP + 3 * SBW + g * PGD; const float* bp = w_pool + (size_t)g * PGD * PGD + e0;
    float acc[16];
#pragma unroll
    for (int j = 0; j < 16; ++j) acc[j] = 0.f;
#pragma unroll 4
    for (int c = 0; c < PGD; ++c) { const float a = ap[c];
#pragma unroll
        for (int j = 0; j < 16; ++j) acc[j] += a * bp[c * PGD + j]; }
    const float gk = g_mix[k];
#pragma unroll
    for (int j = 0; j < 16; ++j) WIN_T[(size_t)(3 * SBW + g * PGD + e0 + j) * D + k] = (bf16_t)f2bf(acc[j] * gk * pool_scale[g * PGD + e0 + j]);
}
__device__ __forceinline__ void p0_row(const float* xrow, bf16_t* orow, float* rstd, int lane) {
    const f32x4* xr = (const f32x4*)xrow + 2 * lane; f32x4 v[4]; float s = 0.f;
#pragma unroll
    for (int j = 0; j < 4; ++j) { v[j] = __builtin_nontemporal_load(xr + (j >> 1) * 128 + (j & 1)); s += (v[j].x * v[j].x + v[j].y * v[j].y) + (v[j].z * v[j].z + v[j].w * v[j].w); }
    s = pg8::wsum(s); if (lane == 0) *rstd = 1.0f / sqrtf(s * (1.0f / D) + EPS);
#pragma unroll
    for (int j = 0; j < 2; ++j) { u32x4 o; o.x = pg8::cvt_pk_bf16(v[2 * j].x, v[2 * j].y); o.y = pg8::cvt_pk_bf16(v[2 * j].z, v[2 * j].w); o.z = pg8::cvt_pk_bf16(v[2 * j + 1].x, v[2 * j + 1].y); o.w = pg8::cvt_pk_bf16(v[2 * j + 1].z, v[2 * j + 1].w);
        pg8::st16<0>(orow + j * 512 + 8 * lane, o); }
}
__device__ __forceinline__ void p0_prologue(const Args& a, LAS unsigned char* lds, int vcu, int G, int wave, int lane) {
    unsigned char* ws = a.ws;
    LAS float* scr = (LAS float*)(lds + RING_OFF + wave * 16384);
    const int gw = vcu * NWAVES + wave, NGW = G * NWAVES;
    constexpr int I_E1 = (D / 64) * (2 * DFF / 32), I_E2 = (DFF / 64) * (D / 32);
    constexpr int I_IN = (D / 64) * (3 * SBW / 32), I_FP = PG * 16 * 8, I_SQ = (D / 64) * (D / 32), I_KV = (D / 64) * (2 * D / 32), I_P = (PGD / 64) * (PGD / 32);
    constexpr int N1 = NE * I_E1, N2 = NE * I_E2, NITEMS = N1 + N2 + I_IN + 3 * I_SQ + I_KV + I_FP;
    const int BIG = 1 << 30;
    for (int it = gw; it < NITEMS; it += NGW) {
        int r = it;
        if (r < N1 + N2 && r >= N1 + N2 - P0_DEFER - P2_DEFER) continue;
        if (r < N1) { const int e = r / I_E1; p0_item<true>(a.in[17] + (size_t)e * D * 2 * DFF, D, 2 * DFF, ws + WS_W1 + (size_t)e * 2 * DFF * D, a.in[14], nullptr, BIG, nullptr, 1, scr, r % I_E1, lane, WSCALE); continue; } r -= N1;
        if (r < N2) { const int e = r / I_E2; p0_item<true>(a.in[19] + (size_t)e * DFF * D, DFF, D, ws + WS_W2 + (size_t)e * D * DFF, nullptr, nullptr, BIG, nullptr, 0, scr, r % I_E2, lane, WSCALE); continue; } r -= N2;
        if (r < I_IN) { p0_item<false>(a.in[3], D, INP, (bf16_t*)(ws + WS_WIN), a.in[2], nullptr, BIG, nullptr, 0, scr, r, lane, 1.0f, 3 * SBW / 32); continue; } r -= I_IN;
        if (r < I_SQ) { p0_item<false>(a.in[8], D, D, (bf16_t*)(ws + WS_WOUT), a.in[4], a.in[5], SBW, nullptr, 0, scr, r, lane); continue; } r -= I_SQ;
        if (r < I_SQ) { p0_item<true>(a.in[11], D, D, ws + WS_WQ, a.in[9], nullptr, BIG, nullptr, 0, scr, r, lane, WSCALE); continue; } r -= I_SQ;
        if (r < I_KV) { p0_item<false>(a.in[12], D, 2 * D, (bf16_t*)(ws + WS_WKV), a.in[10], nullptr, BIG, nullptr, 0, scr, r, lane); continue; } r -= I_KV;
        if (r < I_SQ) { p0_item<true>(a.in[13], D, D, ws + WS_WO, nullptr, nullptr, BIG, nullptr, 0, scr, r, lane, WSCALE); continue; } r -= I_SQ;
        p0_fused_pool_item(a.in[3], a.in[2], a.in[6], a.in[7], (bf16_t*)(ws + WS_WIN), r, lane);
    }
    for (int m = gw; m < NTOK; m += NGW) p0_row(a.in[0] + (size_t)m * D, (bf16_t*)(ws + WS_S0) + (size_t)m * D, (float*)(ws + WS_RSTDX) + m, lane);
    for (int m = gw; m < NMROWS; m += NGW) p0_row(a.in[1] + (size_t)m * D, (bf16_t*)(ws + WS_MEMB) + (size_t)m * D, (float*)(ws + WS_RSTDM) + m, lane);
    const int gt = gw * 64 + lane, NGT = NGW * 64;
    for (int i = gt; i < INP; i += NGT) ((float*)(ws + WS_CSG1))[i] = (i < SBW) ? C2_SB : 1.0f;
    for (int i = gt; i < NE * D; i += NGT) { const int e = i / D, k = i % D; const float v = a.in[14][k] * a.in[15][k * NE + e];
        ((float*)(ws + WS_WR))[i] = v; const unsigned h = f2bf(v); ((bf16_t*)(ws + WS_WRH))[i] = (bf16_t)h; ((bf16_t*)(ws + WS_WRL))[i] = (bf16_t)f2bf(v - bf2f((bf16_t)h)); }
}

__device__ __forceinline__ void p1_deferred_items(const Args& a, LAS unsigned char* lds, int rank  , int wave, int lane) {
    constexpr int I_E2 = (DFF / 64) * (D / 32), N2 = NE * I_E2;
    LAS float* scr = (LAS float*)(lds + RING_OFF + wave * 16384);
    for (int k = 0; k < P0_DEFER / (192 * 8); ++k) { const int r = N2 - P0_DEFER + (k * 192 + rank) * 8 + wave; const int e = r / I_E2;
        p0_item<true>(a.in[19] + (size_t)e * DFF * D, DFF, D, a.ws + WS_W2 + (size_t)e * D * DFF, nullptr, nullptr, 1 << 30, nullptr, 0, scr, r % I_E2, lane, WSCALE); }
}
__device__ __forceinline__ void p2_deferred_item(const Args& a, LAS unsigned char* region, int it, int lane) {
    constexpr int I_E1 = (D / 64) * (2 * DFF / 32), I_E2 = (DFF / 64) * (D / 32), N1 = NE * I_E1, N2 = NE * I_E2;
    static_assert(N1 + N2 - P0_DEFER - P2_DEFER >= 0 && P0_DEFER <= N2, "deferred ranges");
    int r = N1 + N2 - P0_DEFER - P2_DEFER + it;
    if (r < N1) { const int e = r / I_E1; p0_item<true>(a.in[17] + (size_t)e * D * 2 * DFF, D, 2 * DFF, a.ws + WS_W1 + (size_t)e * 2 * DFF * D, a.in[14], nullptr, 1 << 30, nullptr, 1, (LAS float*)region, r % I_E1, lane, WSCALE); return; }
    r -= N1; const int e = r / I_E2;
    p0_item<true>(a.in[19] + (size_t)e * DFF * D, DFF, D, a.ws + WS_W2 + (size_t)e * D * DFF, nullptr, nullptr, 1 << 30, nullptr, 0, (LAS float*)region, r % I_E2, lane, WSCALE);
}
struct SchedP1 {
    int G, c; unsigned char* ws;
    __device__ __forceinline__ bool next(int i, pg8::Unit& u) const {
        const int L = i * G + c; constexpr int NQ = (NTOK / 256) * (INP / 256);
        if (L >= NQ + 64) return false;
        if (L < NQ) { int pm, pn; pg8::grouped_mn(pg8::xcd_remap(L, NQ), NTOK / 256, INP / 256, pm, pn);
            u.A = (const char*)(ws + WS_S0) + (size_t)pm * 256 * D * 2; u.B = (const char*)(ws + WS_WIN) + (size_t)pn * 256 * D * 2;
            u.p0 = (bf16_t*)(ws + WS_QKVU) + (size_t)pm * 256 * INP + pn * 256; u.p1 = (float*)(ws + WS_RSTDX) + pm * 256; u.p2 = (float*)(ws + WS_CSG1) + pn * 256; u.i0 = INP; u.pm = pm; u.pn = pn; }
        else if (L < NQ + 32) { const int k = L - NQ, pm = k >> 2, pn = k & 3;
            u.A = (const char*)(ws + WS_MEMB) + (size_t)pm * 256 * D * 2; u.B = (const char*)(ws + WS_WKV) + (size_t)pn * 256 * D * 2;
            u.p0 = (bf16_t*)(ws + WS_KM) + (size_t)pm * 256 * D + pn * 256; u.p1 = (float*)(ws + WS_RSTDM) + pm * 256; u.p2 = nullptr; u.i0 = D; u.pm = pm; u.pn = pn; }
        else { const int v = L - NQ - 32, b = v >> 2, dt = v & 3;
            u.A = (const char*)(ws + WS_WKV) + (size_t)(D + dt * 256) * D * 2; u.B = (const char*)(ws + WS_MEMB) + (size_t)b * 256 * D * 2;
            u.p0 = (bf16_t*)(ws + WS_VMT) + ((size_t)b * D + dt * 256) * NMEM; u.p1 = nullptr; u.p2 = (float*)(ws + WS_RSTDM) + b * 256; u.i0 = NMEM; u.pm = dt; u.pn = b; }
        u.p3 = nullptr; u.i1 = 0; return true;
    }
};
#define EPI_BAR() asm volatile("s_waitcnt lgkmcnt(0)\n\ts_barrier" ::: "memory")
struct SchedReg {
    int G, c, nM, nN; const char* A; const char* B; size_t astep, bstep; bf16_t* O; int ldc; const float* rs; const float* cs; const ssq_t* sq = nullptr;
    __device__ __forceinline__ bool next(int i, pg8::Unit& u) const {
        const int L = i * G + c; if (L >= nM * nN) return false; int pm, pn; pg8::grouped_mn(pg8::xcd_remap(L, nM * nN), nM, nN, pm, pn);
        u.A = A + (size_t)pm * astep; u.B = B + (size_t)pn * bstep; u.pm = pm; u.pn = pn; u.i0 = ldc; u.i1 = 0;
        u.p0 = O ? (void*)(O + (size_t)pm * 256 * ldc + pn * 256) : nullptr; u.p1 = sq ? (void*)(sq + pm * 256) : (rs ? (void*)(rs + pm * 256) : nullptr); u.p2 = cs ? (void*)(cs + pn * 256) : nullptr; u.p3 = nullptr; return true;
    }
};
struct EpiBf16Ssq {
    static constexpr bool PERM = true; static constexpr int MIDK = -1; float inv_n, mult;
    __device__ __forceinline__ void midk(f32x4 (&)[2][2][4][2], const pg8::Unit&, int, int) const {}
    __device__ __forceinline__ void operator()(f32x4 (&acc)[2][2][4][2], const pg8::Unit& u, int wr, int wc, int fr, int fq, int, int, LAS unsigned char*) const {
        bf16_t* O = (bf16_t*)u.p0; const ssq_t* sq = (const ssq_t*)u.p1; const int ldc = u.i0; int r0 = wr * 64 + fr, c0 = wc * 32 + 8 * fq; asm volatile("" : "+v"(r0), "+v"(c0));
#pragma unroll
        for (int ai = 0; ai < 2; ++ai)
#pragma unroll
            for (int m = 0; m < 4; ++m) { const int r = r0 + ai * 128 + m * 16; const float rv = mult / sqrtf(ssq_get(sq + r) * inv_n + EPS); bf16_t* rowp = O + (size_t)r * ldc + c0;
#pragma unroll
                for (int bj = 0; bj < 2; ++bj) { const f32x4 v0 = acc[ai][bj][m][0] * rv, v1 = acc[ai][bj][m][1] * rv;
                    u32x4 w; w.x = pg8::cvt_pk_bf16(v0[0], v0[1]); w.y = pg8::cvt_pk_bf16(v0[2], v0[3]); w.z = pg8::cvt_pk_bf16(v1[0], v1[1]); w.w = pg8::cvt_pk_bf16(v1[2], v1[3]);
                    pg8::st16<5>(rowp + bj * 128, w); } }
    }
};
template <int MIDK_, bool XIN_BF16, bool F8OUT> struct EpiResid {
    static constexpr bool PERM = true; static constexpr int MIDK = MIDK_;
    const float* xin; bf16_t* xb; unsigned char* x8; ssq_t* ssq; const ssq_t* ssq_mid; float accs;
    __device__ __forceinline__ void midk(f32x4 (&acc)[2][2][4][2], const pg8::Unit& u, int wr, int fr) const {
#pragma unroll
        for (int ai = 0; ai < 2; ++ai)
#pragma unroll
            for (int m = 0; m < 4; ++m) { const int r = u.pm * 256 + ai * 128 + wr * 64 + m * 16 + fr; const float s = 1.0f / sqrtf(ssq_get(ssq_mid + r) * (1.0f / SBW) + EPS);
#pragma unroll
                for (int bj = 0; bj < 2; ++bj)
#pragma unroll
                    for (int n = 0; n < 2; ++n) acc[ai][bj][m][n] *= s; }
    }
    __device__ __forceinline__ void operator()(f32x4 (&acc)[2][2][4][2], const pg8::Unit& u, int wr, int wc, int fr, int fq, int, int, LAS unsigned char*) const {
        int row0 = u.pm * 256 + wr * 64 + fr, col0 = u.pn * 256 + wc * 32 + 8 * fq; asm volatile("" : "+v"(row0), "+v"(col0));
        u32x4 xv[2][4][2]; f32x4 xf[XIN_BF16 ? 1 : 2][XIN_BF16 ? 1 : 4][XIN_BF16 ? 1 : 2][2];
#pragma unroll
        for (int ai = 0; ai < 2; ++ai)
#pragma unroll
            for (int m = 0; m < 4; ++m)
#pragma unroll
                for (int bj = 0; bj < 2; ++bj) { const size_t o2 = (size_t)(row0 + ai * 128 + m * 16) * D + col0 + bj * 128;
                    if constexpr (XIN_BF16) xv[ai][m][bj] = *(const u32x4*)(xb + o2); else { xf[ai][m][bj][0] = *(const f32x4*)(xin + o2); xf[ai][m][bj][1] = *(const f32x4*)(xin + o2 + 4); } }
#pragma unroll
        for (int ai = 0; ai < 2; ++ai)
#pragma unroll
            for (int m = 0; m < 4; ++m) { const int r = row0 + ai * 128 + m * 16; const size_t off = (size_t)r * D + col0; float q = 0.f;
#pragma unroll
                for (int bj = 0; bj < 2; ++bj) { const size_t o2 = off + bj * 128; f32x4 o0, o1;
                    if constexpr (XIN_BF16) { const u32x4 x4 = xv[ai][m][bj];
                        o0 = (f32x4){__builtin_bit_cast(float, x4.x << 16), __builtin_bit_cast(float, x4.x & 0xffff0000u), __builtin_bit_cast(float, x4.y << 16), __builtin_bit_cast(float, x4.y & 0xffff0000u)};
                        o1 = (f32x4){__builtin_bit_cast(float, x4.z << 16), __builtin_bit_cast(float, x4.z & 0xffff0000u), __builtin_bit_cast(float, x4.w << 16), __builtin_bit_cast(float, x4.w & 0xffff0000u)}; }
                    else { o0 = xf[ai][m][bj][0]; o1 = xf[ai][m][bj][1]; }
                    o0 += acc[ai][bj][m][0] * accs; o1 += acc[ai][bj][m][1] * accs;
                    q += (o0[0] * o0[0] + o0[1] * o0[1]) + (o0[2] * o0[2] + o0[3] * o0[3]) + (o1[0] * o1[0] + o1[1] * o1[1]) + (o1[2] * o1[2] + o1[3] * o1[3]);
                    if constexpr (F8OUT) { int w0 = __builtin_amdgcn_cvt_pk_fp8_f32(o0[0], o0[1], 0, false); w0 = __builtin_amdgcn_cvt_pk_fp8_f32(o0[2], o0[3], w0, true);
                        int w1 = __builtin_amdgcn_cvt_pk_fp8_f32(o1[0], o1[1], 0, false); w1 = __builtin_amdgcn_cvt_pk_fp8_f32(o1[2], o1[3], w1, true);
                        pg8::st8_wt(x8 + o2, (unsigned long long)(unsigned)w0 | ((unsigned long long)(unsigned)w1 << 32)); }
                    u32x4 w; w.x = pg8::cvt_pk_bf16(o0[0], o0[1]); w.y = pg8::cvt_pk_bf16(o0[2], o0[3]); w.z = pg8::cvt_pk_bf16(o1[0], o1[1]); w.w = pg8::cvt_pk_bf16(o1[2], o1[3]); pg8::st16<4>(xb + o2, w); }
                q += pg8::swz_xor<16>(q); q = pg8::half_sum(q);
                if (fq == 0) ssq_add(ssq + r, q); }
    }
};
struct SchedMS {
    int G, c; unsigned char* ws;
    __device__ __forceinline__ bool next(int i, pg8::Unit& u) const {
        const int L = i * G + c; constexpr int NU = (NTOK / 256) * MH; if (L >= NU) return false; int pm, h; pg8::grouped_mn(pg8::xcd_remap(L, NU), NTOK / 256, MH, pm, h); const int b = pm >> 4;
        u.A = (const char*)(ws + WS_QM) + ((size_t)pm * 256 * D + h * MHD) * 2; u.B = (const char*)(ws + WS_KM) + ((size_t)b * NMEM * D + h * MHD) * 2;
        u.p0 = (bf16_t*)(ws + WS_PM) + (size_t)pm * 256 * D + h * NMEM; u.p1 = nullptr; u.p2 = nullptr; u.p3 = nullptr; u.i0 = D; u.i1 = 0; u.pm = pm; u.pn = h; return true;
    }
};
struct EpiSoftmax {
    static constexpr bool PERM = true; static constexpr int MIDK = -1;
    __device__ __forceinline__ void midk(f32x4 (&)[2][2][4][2], const pg8::Unit&, int, int) const {}
    __device__ __forceinline__ void operator()(f32x4 (&acc)[2][2][4][2], const pg8::Unit& u, int wr, int wc, int fr, int fq, int, int, LAS unsigned char* xl) const {
        typedef float f32x2v __attribute__((ext_vector_type(2)));
        LAS f32x2v* X = (LAS f32x2v*)xl;
        float ml[2][4];
#pragma unroll
        for (int ai = 0; ai < 2; ++ai)
#pragma unroll
            for (int m = 0; m < 4; ++m) { float mx = -INFINITY;
#pragma unroll
                for (int bj = 0; bj < 2; ++bj)
#pragma unroll
                    for (int n = 0; n < 2; ++n) { const f32x4 v = acc[ai][bj][m][n]; mx = fmaxf(fmaxf(mx, fmaxf(v[0], v[1])), fmaxf(v[2], v[3])); }
                mx = fmaxf(mx, pg8::swz_xor<16>(mx)); mx = pg8::half_max(mx); ml[ai][m] = mx; float s = 0.f;
#pragma unroll
                for (int bj = 0; bj < 2; ++bj)
#pragma unroll
                    for (int n = 0; n < 2; ++n) { f32x4 v = acc[ai][bj][m][n];
#pragma unroll
                        for (int j = 0; j < 4; ++j) { v[j] = __builtin_amdgcn_exp2f(v[j] - mx); s += v[j]; }
                        acc[ai][bj][m][n] = v; }
                s += pg8::swz_xor<16>(s); s = pg8::half_sum(s);
                if (fq == 0) X[(ai * 128 + wr * 64 + m * 16 + fr) * 4 + wc] = (f32x2v){mx, s}; }
        EPI_BAR();
        bf16_t* O = (bf16_t*)u.p0; const int ldc = u.i0; int r0 = wr * 64 + fr, c0 = wc * 32 + 8 * fq; asm volatile("" : "+v"(r0), "+v"(c0));
#pragma unroll
        for (int ai = 0; ai < 2; ++ai)
#pragma unroll
            for (int m = 0; m < 4; ++m) { const int r = r0 + ai * 128 + m * 16; const f32x2v a = X[r * 4 + 0], b = X[r * 4 + 1], c = X[r * 4 + 2], d = X[r * 4 + 3];
                const float M = fmaxf(fmaxf(a.x, b.x), fmaxf(c.x, d.x));
                const float tot = a.y * __builtin_amdgcn_exp2f(a.x - M) + b.y * __builtin_amdgcn_exp2f(b.x - M) + c.y * __builtin_amdgcn_exp2f(c.x - M) + d.y * __builtin_amdgcn_exp2f(d.x - M);
                const float f = __builtin_amdgcn_exp2f(ml[ai][m] - M) / tot; bf16_t* rowp = O + (size_t)r * ldc + c0;
#pragma unroll
                for (int bj = 0; bj < 2; ++bj) { const f32x4 v0 = acc[ai][bj][m][0] * f, v1 = acc[ai][bj][m][1] * f;
                    u32x4 w; w.x = pg8::cvt_pk_bf16(v0[0], v0[1]); w.y = pg8::cvt_pk_bf16(v0[2], v0[3]); w.z = pg8::cvt_pk_bf16(v1[0], v1[1]); w.w = pg8::cvt_pk_bf16(v1[2], v1[3]);
                    pg8::st16<6>(rowp + bj * 128, w); } }
    }
};
struct SchedPV {
    int G, c; unsigned char* ws;
    __device__ __forceinline__ bool next(int i, pg8::Unit& u) const {
        const int L = i * G + c; constexpr int NU = (NTOK / 256) * MH; if (L >= NU) return false; int pm, h; pg8::grouped_mn(pg8::xcd_remap(L, NU), NTOK / 256, MH, pm, h); const int b = pm >> 4;
        u.A = (const char*)(ws + WS_PM) + ((size_t)pm * 256 * D + h * NMEM) * 2; u.B = (const char*)(ws + WS_VMT) + ((size_t)b * D + h * MHD) * NMEM * 2;
        u.p0 = (bf16_t*)(ws + WS_OM) + (size_t)pm * 256 * D + h * MHD; u.p1 = nullptr; u.p2 = nullptr; u.p3 = nullptr; u.i0 = D; u.i1 = 0; u.pm = pm; u.pn = h; return true;
    }
};

__device__ __forceinline__ void p8_route(const Args& a, LAS unsigned char* lds, int bx, int G, int wave, int lane, int* CNT) {
    unsigned char* ws = a.ws; const bf16_t* x2 = (const bf16_t*)(ws + WS_S0); const ssq_t* SSQ2 = (const ssq_t*)(ws + MK_SSQ2); const float* br = a.in[16];
    const bf16_t* WRH = (const bf16_t*)(ws + WS_WRH);
    int* LSLOT = (int*)(ws + WS_LSLOT); float* LGATE = (float*)(ws + WS_LGATE); float* LRS = (float*)(ws + WS_LRS);
    constexpr int WPITCH = 2064;
    LAS float* LG = (LAS float*)(lds + RING_OFF + 69632) + wave * 16 * 33;
    LAS int* hist = (LAS int*)(lds + RING_OFF + 90112); LAS int* base = hist + 32;
    const int tid = wave * 64 + lane;
    { u32x4 v[8];
#pragma unroll
      for (int i = 0; i < 8; ++i) v[i] = *(const u32x4*)(WRH + (size_t)(tid + i * 512) * 8);
#pragma unroll
      for (int i = 0; i < 8; ++i) { const int c = tid + i * 512; *(LAS u32x4*)(lds + RING_OFF + (c >> 7) * WPITCH + (c & 127) * 16) = v[i]; } }
    LDS_WAIT(); __syncthreads();
    for (int t0 = bx * 128; t0 < NTOK; t0 += G * 128) {
        if (tid < 32) hist[tid] = 0;
        const int r16 = lane & 15, kq = lane >> 4; const int trow = t0 + wave * 16 + r16;
        const bf16_t* xp = x2 + (size_t)trow * D + kq * 8;
        bf16x8 ah[32];
#pragma unroll
        for (int ks = 0; ks < 32; ++ks) ah[ks] = *(const bf16x8*)(xp + ks * 32);
        f32x4 acc[2] = {(f32x4){0.f, 0.f, 0.f, 0.f}, (f32x4){0.f, 0.f, 0.f, 0.f}};
        const LAS unsigned char* wp = lds + RING_OFF + r16 * WPITCH + kq * 16;
#pragma unroll
        for (int ks = 0; ks < 32; ++ks) {
#pragma unroll
            for (int nb = 0; nb < 2; ++nb) { const bf16x8 bh = *(const LAS bf16x8*)(wp + nb * 16 * WPITCH + ks * 64);
                acc[nb] = __builtin_amdgcn_mfma_f32_16x16x32_bf16(ah[ks], bh, acc[nb], 0, 0, 0); } }
#pragma unroll
        for (int nb = 0; nb < 2; ++nb)
#pragma unroll
            for (int r = 0; r < 4; ++r) { const int tl = kq * 4 + r; const int tk = t0 + wave * 16 + tl; const float rs = 1.0f / sqrtf(ssq_get(SSQ2 + tk) * (1.0f / D) + EPS);
                LG[tl * 33 + nb * 16 + r16] = acc[nb][r] * rs + br[nb * 16 + r16]; }
        LDS_WAIT(); __syncthreads();
        int te[4] = {0, 0, 0, 0}; float tg[4] = {0.f, 0.f, 0.f, 0.f}; int rk[4] = {0, 0, 0, 0};
        if (lane < 16) {
            float tv[4] = {-INFINITY, -INFINITY, -INFINITY, -INFINITY};
            for (int e = 0; e < NE; ++e) { const float v = LG[lane * 33 + e];
                if (v > tv[3]) { if (v > tv[2]) { tv[3] = tv[2]; te[3] = te[2]; if (v > tv[1]) { tv[2] = tv[1]; te[2] = te[1]; if (v > tv[0]) { tv[1] = tv[0]; te[1] = te[0]; tv[0] = v; te[0] = e; } else { tv[1] = v; te[1] = e; } } else { tv[2] = v; te[2] = e; } } else { tv[3] = v; te[3] = e; } } }
            float gs = 0.f;
#pragma unroll
            for (int k = 0; k < 4; ++k) { tg[k] = __expf(tv[k] - tv[0]); gs += tg[k]; }
            gs = 1.0f / gs;
#pragma unroll
            for (int k = 0; k < 4; ++k) { tg[k] *= gs; rk[k] = __hip_atomic_fetch_add(hist + te[k], 1, __ATOMIC_RELAXED, __HIP_MEMORY_SCOPE_WORKGROUP); }
        }
        LDS_WAIT(); __syncthreads();
        if (tid < 32) { const int n = hist[tid]; base[tid] = n ? atomicAdd(CNT + tid, n) : 0; }
        LDS_WAIT(); __syncthreads();
        if (lane < 16) { const int tk = t0 + wave * 16 + lane; const float rsw = (1.0f / WSCALE) / sqrtf(ssq_get(SSQ2 + tk) * (1.0f / D) + EPS);
#pragma unroll
            for (int k = 0; k < 4; ++k) { const size_t p = (size_t)te[k] * LCAP + base[te[k]] + rk[k]; pg8::st4_wt(LSLOT + p, (unsigned)(tk * 4 + k)); pg8::st4_wt(LGATE + p, __float_as_uint(tg[k])); pg8::st4_wt(LRS + p, __float_as_uint(rsw)); } }
        LDS_WAIT(); __syncthreads();
    }
}

__device__ __forceinline__ void moe_table(const Args& a, volatile LAS unsigned* MISC, int tid) {
    const int* CNT = (const int*)(a.ws + OFF_CNT);
    if (tid < 32) MISC[16 + tid] = (unsigned)CNT[tid];
    LDS_WAIT(); __syncthreads();
    if (tid == 0) { unsigned tb = 0; for (int e = 0; e < NE; ++e) { MISC[48 + e] = tb; tb += (MISC[16 + e] + 255u) >> 8; } MISC[48 + NE] = tb; }
    LDS_WAIT(); __syncthreads();
}
template <int NPN, bool W1> struct SchedMoE {
    int G, c; unsigned char* ws; volatile LAS unsigned* MISC; const float* bias;
    __device__ __forceinline__ bool next(int i, pg8::Unit& u) const {
        unsigned mb_ = (unsigned)(uintptr_t)MISC; asm volatile("" : "+s"(mb_)); const LAS unsigned* M = (const LAS unsigned*)(uintptr_t)mb_;
        const int T = __builtin_amdgcn_readfirstlane((int)M[48 + NE]); const int NU = T * NPN; const int L = i * G + c; if (L >= NU) return false;
        const int w = pg8::xcd_remap(L, NU);
        int e = 0;
#pragma unroll
        for (int s = 16; s >= 1; s >>= 1) { if ((int)M[48 + e + s] * NPN <= w) e += s; }
        e = __builtin_amdgcn_readfirstlane(e);
        const int tb = __builtin_amdgcn_readfirstlane((int)M[48 + e]), cnt = __builtin_amdgcn_readfirstlane((int)M[16 + e]), nte = (cnt + 255) >> 8; const int idx = w - tb * NPN, pn = __builtin_amdgcn_readfirstlane(idx / nte), mt = idx - pn * nte;
        u.pm = tb + mt; u.pn = pn; u.i1 = e; const int nv = cnt - mt * 256; u.i0 = nv < 256 ? nv : 256;
        u.p3 = (int*)(ws + WS_LSLOT) + (size_t)e * LCAP + mt * 256; u.p2 = (float*)(ws + (W1 ? WS_LRS : WS_LGATE)) + (size_t)e * LCAP + mt * 256; u.p0 = nullptr;
        u.p1 = W1 ? (void*)(bias + (size_t)e * 2 * DFF + pn * 128) : (void*)(bias + (size_t)e * D + pn * 256);
        if (W1) { u.A = (const char*)(ws + WS_X2F8); u.B = (const char*)(ws + WS_W1) + ((size_t)e * 2 * DFF + pn * 256) * D; }
        else { u.A = (const char*)(ws + WS_ACT) + (size_t)(tb + mt) * 256 * DFF; u.B = (const char*)(ws + WS_W2) + ((size_t)e * D + pn * 256) * DFF; }
        return true;
    }
};
typedef float f32x2 __attribute__((ext_vector_type(2)));
struct EpiSwiGLU {
    static constexpr bool PERM = true; static constexpr int MIDK = -1; unsigned char* act;
    __device__ __forceinline__ void midk(f32x4 (&)[2][2][4][2], const pg8::Unit&, int, int) const {}
    __device__ __forceinline__ void operator()(f32x4 (&acc)[2][2][4][2], const pg8::Unit& u, int wr, int wc, int fr, int fq, int, int, LAS unsigned char* tab) const {
        const int nvalid = u.i0; const LAS float* T1 = (const LAS float*)tab + 256; const LAS float* T2 = (const LAS float*)tab + 512;
        int r0 = wr * 64 + fr, c0 = wc * 32 + 8 * fq; asm volatile("" : "+v"(r0), "+v"(c0)); const int gc0 = u.pn * 128 + c0;
        f32x4 bg[2], bu[2];
#pragma unroll
        for (int n = 0; n < 2; ++n) { bg[n] = *(const LAS f32x4*)(T2 + c0 + 4 * n); bu[n] = *(const LAS f32x4*)(T2 + 128 + c0 + 4 * n); }
#pragma unroll
        for (int ai = 0; ai < 2; ++ai)
#pragma unroll
            for (int m = 0; m < 4; ++m) { const int r = r0 + ai * 128 + m * 16; const float rs = T1[r]; int wv[2];
#pragma unroll
                for (int n = 0; n < 2; ++n) { f32x2 o[2];
#pragma unroll
                    for (int h = 0; h < 2; ++h) { f32x2 g = (f32x2){acc[ai][0][m][n][2 * h], acc[ai][0][m][n][2 * h + 1]} * rs + (f32x2){bg[n][2 * h], bg[n][2 * h + 1]};
                        f32x2 up = (f32x2){acc[ai][1][m][n][2 * h], acc[ai][1][m][n][2 * h + 1]} * rs + (f32x2){bu[n][2 * h], bu[n][2 * h + 1]};
                        g.x = fminf(g.x, SW_LIMIT); g.y = fminf(g.y, SW_LIMIT); up.x = fminf(fmaxf(up.x, -SW_LIMIT), SW_LIMIT); up.y = fminf(fmaxf(up.y, -SW_LIMIT), SW_LIMIT);
                        const f32x2 tt = g * (-SW_ALPHA * LOG2E); f32x2 d; d.x = __builtin_amdgcn_exp2f(tt.x); d.y = __builtin_amdgcn_exp2f(tt.y); d = d + 1.0f;
                        f32x2 rr; rr.x = __builtin_amdgcn_rcpf(d.x); rr.y = __builtin_amdgcn_rcpf(d.y);
                        o[h] = (up + 1.0f) * g * rr; }
                    wv[n] = __builtin_amdgcn_cvt_pk_fp8_f32(o[0].x, o[0].y, 0, false); wv[n] = __builtin_amdgcn_cvt_pk_fp8_f32(o[1].x, o[1].y, wv[n], true); }
                if (r < nvalid) pg8::st8_wt(act + ((size_t)u.pm * 256 + r) * DFF + gc0, (unsigned long long)(unsigned)wv[0] | ((unsigned long long)(unsigned)wv[1] << 32)); }
    }
};
struct EpiW2 {
    static constexpr bool PERM = true; static constexpr int MIDK = -1; unsigned char* Y;
    __device__ __forceinline__ void midk(f32x4 (&)[2][2][4][2], const pg8::Unit&, int, int) const {}
    __device__ __forceinline__ void operator()(f32x4 (&acc)[2][2][4][2], const pg8::Unit& u, int wr, int wc, int fr, int fq, int, int, LAS unsigned char* tab) const {
        const int nvalid = u.i0; const LAS unsigned* T0 = (const LAS unsigned*)tab; const LAS float* T1 = (const LAS float*)tab + 256; const LAS float* T2 = (const LAS float*)tab + 512;
        int r0 = wr * 64 + fr, cl = wc * 32 + 8 * fq; asm volatile("" : "+v"(r0), "+v"(cl)); const int c0 = u.pn * 256 + cl;
        f32x4 bv[2][2];
#pragma unroll
        for (int bj = 0; bj < 2; ++bj)
#pragma unroll
            for (int n = 0; n < 2; ++n) bv[bj][n] = *(const LAS f32x4*)(T2 + cl + bj * 128 + 4 * n);
#pragma unroll
        for (int ai = 0; ai < 2; ++ai)
#pragma unroll
            for (int m = 0; m < 4; ++m) { const int r = r0 + ai * 128 + m * 16; const bool valid = r < nvalid; const unsigned slot = T0[r]; const float g = T1[r];
#pragma unroll
                for (int bj = 0; bj < 2; ++bj) { const f32x4 v0 = (acc[ai][bj][m][0] * (1.0f / WSCALE) + bv[bj][0]) * g, v1 = (acc[ai][bj][m][1] * (1.0f / WSCALE) + bv[bj][1]) * g;
                    int w0 = __builtin_amdgcn_cvt_pk_fp8_f32(v0[0], v0[1], 0, false); w0 = __builtin_amdgcn_cvt_pk_fp8_f32(v0[2], v0[3], w0, true);
                    int w1 = __builtin_amdgcn_cvt_pk_fp8_f32(v1[0], v1[1], 0, false); w1 = __builtin_amdgcn_cvt_pk_fp8_f32(v1[2], v1[3], w1, true);
                    if (valid) pg8::st8_wt(Y + (size_t)slot * D + c0 + bj * 128, (unsigned long long)(unsigned)w0 | ((unsigned long long)(unsigned)w1 << 32)); } }
    }
};

__device__ __forceinline__ void p11_final(const Args& a, int vcu, int G, int wave, int lane, float* dst) {
    const bf16_t* x2 = (const bf16_t*)(a.ws + WS_S0); const unsigned char* Y = a.ws + WS_Y; const float* gf = a.in[21];
    const int gw = vcu * NWAVES + wave, NGW = G * NWAVES;
    f32x4 g4[4];
#pragma unroll
    for (int j = 0; j < 4; ++j) g4[j] = *(const f32x4*)(gf + 16 * lane + 4 * j);
    for (int tok = gw; tok < NTOK; tok += NGW) {
        const u32x4 xa = __builtin_nontemporal_load((const u32x4*)(x2 + (size_t)tok * D + 16 * lane)), xc = __builtin_nontemporal_load((const u32x4*)(x2 + (size_t)tok * D + 16 * lane + 8));
        u32x4 yv[4];
#pragma unroll
        for (int k = 0; k < 4; ++k) yv[k] = __builtin_nontemporal_load((const u32x4*)(Y + ((size_t)tok * 4 + k) * D + 16 * lane));
        float v[16];
#pragma unroll
        for (int q = 0; q < 4; ++q) { v[2 * q] = __builtin_bit_cast(float, xa[q] << 16); v[2 * q + 1] = __builtin_bit_cast(float, xa[q] & 0xffff0000u); v[8 + 2 * q] = __builtin_bit_cast(float, xc[q] << 16); v[8 + 2 * q + 1] = __builtin_bit_cast(float, xc[q] & 0xffff0000u); }
#pragma unroll
        for (int k = 0; k < 4; ++k)
#pragma unroll
            for (int q = 0; q < 4; ++q) { const auto lo = __builtin_amdgcn_cvt_pk_f32_fp8((int)yv[k][q], false), hi2 = __builtin_amdgcn_cvt_pk_f32_fp8((int)yv[k][q], true);
                v[4 * q] += lo[0]; v[4 * q + 1] += lo[1]; v[4 * q + 2] += hi2[0]; v[4 * q + 3] += hi2[1]; }
        float s = 0.f;
#pragma unroll
        for (int q = 0; q < 16; ++q) s += v[q] * v[q];
        const float rs = 1.0f / sqrtf(pg8::wsum(s) * (1.0f / D) + EPS);
#pragma unroll
        for (int j = 0; j < 4; ++j) pg8::st16<8>(dst + (size_t)tok * D + 16 * lane + 4 * j, (f32x4){v[4 * j] * rs * g4[j][0], v[4 * j + 1] * rs * g4[j][1], v[4 * j + 2] * rs * g4[j][2], v[4 * j + 3] * rs * g4[j][3]});
    }
}
typedef float f32x16 __attribute__((ext_vector_type(16)));
typedef short s16x4 __attribute__((ext_vector_type(4)));
__device__ __forceinline__ int crow(int r, int hi) { return (r & 3) + 8 * (r >> 2) + 4 * hi; }
#ifndef SB_ABL
#define SB_ABL 0
#endif
#define SB_DMA(ubase, voff, ldsaddr) do { unsigned keep_; asm volatile("s_mov_b32 %0, m0\n\ts_mov_b32 m0, %3\n\ts_nop 0\n\tglobal_load_lds_dwordx4 %1, %2\n\ts_mov_b32 m0, %0" \
        : "=&s"(keep_) : "v"(voff), "s"((const char*)(ubase)), "s"(ldsaddr) : "memory"); } while (0)
__device__ __forceinline__ void sb_item(int b, int h, int qi  , const bf16_t* QKVU, bf16_t* MIXED, ssq_t* SSQSB, LAS unsigned char* wl  , int) {
    const int lane = pg8::fresh_lane();
    const int r32 = lane & 31, hi = lane >> 5;
    const size_t rowbase = (size_t)b * S; const int q0 = qi * 64;
    const bf16_t* Qw = QKVU + (rowbase + q0) * INP + h * HD;
    const char* Kh = (const char*)(QKVU + rowbase * INP + SBW + h * HD); const char* Vh = Kh + SBW * 2;
    bf16x8 qr[2][4];
#pragma unroll
    for (int s = 0; s < 2; ++s)
#pragma unroll
        for (int d0 = 0; d0 < 4; ++d0) qr[s][d0] = *(const bf16x8*)(Qw + (size_t)(s * 32 + r32) * INP + d0 * 16 + hi * 8);
    f32x16 o[2][2];
#pragma unroll
    for (int r = 0; r < 16; ++r) { o[0][0][r] = 0.f; o[0][1][r] = 0.f; o[1][0][r] = 0.f; o[1][1][r] = 0.f; }
    float carry[2] = {1.0f, 1.0f}; bool alive[2] = {true, true};
    const int jd = qi;
    const unsigned kvoff = (unsigned)lane * (INP * 2);
    const unsigned vvoff = (unsigned)(lane >> 2) * (INP * 2) + (unsigned)(lane & 3) * 16;
    const unsigned lk = (unsigned)(uintptr_t)wl, lv = lk + 8192;
#define SB_LOAD_K(j) do { const char* kb_ = Kh + (size_t)(j) * 64 * INP * 2; _Pragma("unroll") for (int c_ = 0; c_ < 8; ++c_) SB_DMA(kb_ + c_ * 16, kvoff, lk + c_ * 1024); } while (0)
#define SB_LOAD_V(j) do { const char* vb_ = Vh + (size_t)(j) * 64 * INP * 2; _Pragma("unroll") for (int c_ = 0; c_ < 8; ++c_) SB_DMA(vb_ + (size_t)(c_ & 3) * 16 * INP * 2 + (c_ >> 2) * 64, vvoff, lv + c_ * 1024); } while (0)
    SB_LOAD_K(jd); SB_LOAD_V(jd);
    if (SB_ABL == 3) asm volatile("s_waitcnt vmcnt(0)" ::: "memory");
    const LAS unsigned char* kb = wl + hi * 1024 + r32 * 16;
    const LAS unsigned char* vb = wl + 8192 + ((lane >> 4) & 1) * 32 + (lane & 3) * 8 + (4 * hi + ((lane & 15) >> 2)) * 64;
    const int jlo = (SB_ABL != 0) ? ((jd - 4 > 0) ? jd - 4 : 0) : 0;
    for (int j = jd; j >= jlo; --j) {
        if (SB_ABL != 3) asm volatile("s_waitcnt vmcnt(8)" ::: "memory"); __builtin_amdgcn_sched_barrier(0);
        bf16x8 kf[8];
#pragma unroll
        for (int d0 = 0; d0 < 4; ++d0) { kf[2 * d0] = *(const LAS bf16x8*)(kb + d0 * 2048); kf[2 * d0 + 1] = *(const LAS bf16x8*)(kb + d0 * 2048 + 512); }
        asm volatile("s_waitcnt lgkmcnt(0)" ::: "memory"); __builtin_amdgcn_sched_barrier(0);
        if (j > jlo && SB_ABL != 3) SB_LOAD_K(j - 1);
        unsigned pw[2][4][4]; bool did[2][2] = {{false, false}, {false, false}};
#pragma unroll
        for (int s = 0; s < 2; ++s) {
#pragma unroll
            for (int half = 1; half >= 0; --half) {
                if (!alive[s]) continue;
                const bool diag = (j == jd);
                if (diag && s == 0 && half == 1) continue;
                f32x16 p;
#pragma unroll
                for (int r = 0; r < 16; ++r) p[r] = 0.f;
#pragma unroll
                for (int d0 = 0; d0 < 4; ++d0) p = __builtin_amdgcn_mfma_f32_32x32x16_bf16(kf[2 * d0 + half], qr[s][d0], p, 0, 0, 0);
                const int kbase = 64 * j + 32 * half + 4 * hi; const int qabs = q0 + s * 32 + r32;
#pragma unroll
                for (int r = 0; r < 16; ++r) { const int k0 = kbase + (r & 3) + 8 * (r >> 2);
                    float e0 = __builtin_amdgcn_exp2f(fminf(p[r], 100.0f));
                    if (diag && k0 >= qabs) e0 = 0.0f;
                    p[r] = e0; }
                float A[4];
#pragma unroll
                for (int i = 0; i < 4; ++i) A[i] = ((1.0f + p[4 * i]) * (1.0f + p[4 * i + 1])) * ((1.0f + p[4 * i + 2]) * (1.0f + p[4 * i + 3]));
                float Tq = 1.0f, Q[4];
#pragma unroll
                for (int i = 3; i >= 0; --i) { const auto sw = __builtin_amdgcn_permlane32_swap(__float_as_uint(A[i]), __float_as_uint(A[i]), false, false);
                    const float partner = hi ? __uint_as_float(sw[0]) : __uint_as_float(sw[1]);
                    Q[i] = hi ? Tq : Tq * partner; Tq = Tq * (A[i] * partner); }
                const float cin = carry[s];
#pragma unroll
                for (int i = 0; i < 4; ++i) { const float x0 = p[4 * i], x1 = p[4 * i + 1], x2 = p[4 * i + 2], x3 = p[4 * i + 3];
                    const float R0 = cin * __builtin_amdgcn_rcpf(A[i] * Q[i]);
                    const float R1 = R0 * (1.0f + x0), R2 = R1 * (1.0f + x1), R3 = R2 * (1.0f + x2);
                    pw[s][2 * half + (i >> 1)][(i & 1) * 2] = pg8::cvt_pk_bf16(x0 * R0, x1 * R1); pw[s][2 * half + (i >> 1)][(i & 1) * 2 + 1] = pg8::cvt_pk_bf16(x2 * R2, x3 * R3); }
                carry[s] = cin * __builtin_amdgcn_rcpf(Tq);
                did[s][half] = true;
                if (!__any(carry[s] != 0.0f)) alive[s] = false;
            }
        }
        if (SB_ABL == 3) {} else if (j > jlo) asm volatile("s_waitcnt vmcnt(8)" ::: "memory"); else asm volatile("s_waitcnt vmcnt(0)" ::: "memory");
        __builtin_amdgcn_sched_barrier(0);
        bf16x8 vf[8];
#pragma unroll
        for (int d0 = 0; d0 < 2; ++d0)
#pragma unroll
            for (int ks = 0; ks < 4; ++ks) {
                const s16x4 lo = __builtin_bit_cast(s16x4, __builtin_amdgcn_ds_read_tr16_b64_v4i16((LAS s16x4*)(vb + d0 * 4096 + ks * 1024)));
                const s16x4 hh = __builtin_bit_cast(s16x4, __builtin_amdgcn_ds_read_tr16_b64_v4i16((LAS s16x4*)(vb + d0 * 4096 + ks * 1024 + 512)));
                vf[d0 * 4 + ks] = (bf16x8){lo[0], lo[1], lo[2], lo[3], hh[0], hh[1], hh[2], hh[3]}; }
        asm volatile("s_waitcnt lgkmcnt(0)" ::: "memory"); __builtin_amdgcn_sched_barrier(0);
        const bool more = (SB_ABL != 0) ? (j > jlo) : ((j > 0) && (alive[0] || alive[1]));
        if (more && SB_ABL != 3) SB_LOAD_V(j - 1);
#pragma unroll
        for (int s = 0; s < 2; ++s)
#pragma unroll
            for (int half = 0; half < 2; ++half) { if (!did[s][half]) continue;
#pragma unroll
                for (int d0 = 0; d0 < 2; ++d0)
#pragma unroll
                    for (int kk = 0; kk < 2; ++kk) { const int ks = 2 * half + kk; const bf16x8 pa = __builtin_bit_cast(bf16x8, (u32x4){pw[s][ks][0], pw[s][ks][1], pw[s][ks][2], pw[s][ks][3]});
                        o[s][d0] = __builtin_amdgcn_mfma_f32_32x32x16_bf16(pa, vf[d0 * 4 + ks], o[s][d0], 0, 0, 0); } }
        if (!more) break;
    }
    asm volatile("s_waitcnt vmcnt(0)" ::: "memory");
    LAS bf16_t* stg = (LAS bf16_t*)wl; const int l2 = pg8::fresh_lane();
#pragma unroll
    for (int s = 0; s < 2; ++s) {
#pragma unroll
        for (int r = 0; r < 16; ++r) { const int orow = crow(r, l2 >> 5);
#pragma unroll
            for (int d0 = 0; d0 < 2; ++d0) stg[orow * 64 + d0 * 32 + (l2 & 31)] = (bf16_t)f2bf(o[s][d0][r]); }
        LDS_WAIT();
        bf16_t* Ow = MIXED + (rowbase + q0 + s * 32) * D + h * HD;
#pragma unroll
        for (int i = 0; i < 4; ++i) { const int row = i * 8 + (l2 >> 3), ch = l2 & 7; const u32x4 v = *(const LAS u32x4*)(stg + row * 64 + ch * 8);
            pg8::st16<2>(Ow + (size_t)row * D + ch * 8, v); float q = 0.f;
#pragma unroll
            for (int k = 0; k < 4; ++k) { const float a = __builtin_bit_cast(float, v[k] << 16), c = __builtin_bit_cast(float, v[k] & 0xffff0000u); q += a * a + c * c; }
            q += pg8::swz_xor<1>(q); q += pg8::swz_xor<2>(q); q += pg8::swz_xor<4>(q);
            if (ch == 0) ssq_add(SSQSB + rowbase + q0 + s * 32 + row, q); }
        LDS_WAIT();
    }
#undef SB_LOAD_K
#undef SB_LOAD_V
}

__device__ __forceinline__ f32x4 bf_lo(u32x4 v) { return (f32x4){__builtin_bit_cast(float, v.x << 16), __builtin_bit_cast(float, v.y << 16), __builtin_bit_cast(float, v.z << 16), __builtin_bit_cast(float, v.w << 16)}; }
__device__ __forceinline__ f32x4 bf_hi(u32x4 v) { return (f32x4){__builtin_bit_cast(float, v.x & 0xffff0000u), __builtin_bit_cast(float, v.y & 0xffff0000u), __builtin_bit_cast(float, v.z & 0xffff0000u), __builtin_bit_cast(float, v.w & 0xffff0000u)}; }
__device__ __forceinline__ void pool_item(int item, const bf16_t* QKVU, bf16_t* MIXED, int lane) {
    const int t0 = item * 8, tpos0 = t0 & (S - 1); const int g = lane >> 4, win = 2 << g;
    const bf16_t* zp = QKVU + (size_t)(t0 - 15) * INP + 3 * SBW + lane * 8;
    u32x4 v[23];
#pragma unroll
    for (int r = 0; r < 23; ++r) { v[r] = (u32x4){0u, 0u, 0u, 0u}; if (tpos0 - 15 + r >= 0) v[r] = *(const u32x4*)(zp + (size_t)r * INP); }
    f32x4 slo = (f32x4){0.f, 0.f, 0.f, 0.f}, shi = slo;
#pragma unroll
    for (int j = 0; j < 16; ++j) { const float mk = (j < win) ? 1.0f : 0.0f; slo += bf_lo(v[15 - j]) * mk; shi += bf_hi(v[15 - j]) * mk; }
    bf16_t* op = MIXED + (size_t)t0 * D + SBW + lane * 8;
#pragma unroll
    for (int i = 0; i < 8; ++i) {
        if (i > 0) { const u32x4 old = (g == 0) ? v[i + 13] : (g == 1) ? v[i + 11] : (g == 2) ? v[i + 7] : v[i - 1];
            slo += bf_lo(v[15 + i]) - bf_lo(old); shi += bf_hi(v[15 + i]) - bf_hi(old); }
        const int tp1 = tpos0 + i + 1; const float inv = 1.0f / (float)(tp1 < win ? tp1 : win);
        const f32x4 olo = slo * inv - bf_lo(v[15 + i]), ohi = shi * inv - bf_hi(v[15 + i]);
        float q = (olo[0] * olo[0] + olo[1] * olo[1]) + (olo[2] * olo[2] + olo[3] * olo[3]) + (ohi[0] * ohi[0] + ohi[1] * ohi[1]) + (ohi[2] * ohi[2] + ohi[3] * ohi[3]);
        const float rs = 1.0f / sqrtf(pg8::wsum(q) * (1.0f / PW) + EPS);
        u32x4 w;
#pragma unroll
        for (int k = 0; k < 4; ++k) w[k] = pg8::cvt_pk_bf16(olo[k] * rs, ohi[k] * rs);
        pg8::st16<3>(op + (size_t)i * D, w);
    }
}
constexpr int P2_DK = 3;
__device__ __forceinline__ void p2_mix(const Args& a, LAS unsigned char* lds, int bx, int G, int wid, int lane, ssq_t* SSQSB, int which = 3, int pstop = 9, bf16_t* pool_dst = nullptr, volatile LAS unsigned* stp = nullptr) {
    unsigned char* ws = a.ws; const bf16_t* QKVU = (const bf16_t*)(ws + WS_QKVU); bf16_t* MIXED = (bf16_t*)(ws + WS_MIXED);
    constexpr int NA = B * NH * (S / 512);
    if (which & 1) for (int i = 0; i * G + bx < NA; ++i) { const int w = pg8::xcd_remap(i * G + bx, NA); const int bh = w >> 3, qb = w & 7;
        sb_item(bh >> 3, bh & 7, qb * 8 + wid, QKVU, MIXED, SSQSB, lds + RING_OFF + wid * 16384, lane);
        if (P2_DEFER && which == 1) for (int j = i * P2_DK; j < (i + 1) * P2_DK; ++j) { const int it = j * G * NWAVES + bx * NWAVES + wid; if (it < P2_DEFER) p2_deferred_item(a, lds + RING_OFF + wid * 16384, it, pg8::fresh_lane()); } }
    if (P2_DEFER && which == 1) for (int j = ((NA + G - 1 - bx) / G) * P2_DK; j * G * NWAVES + bx * NWAVES + wid < P2_DEFER; ++j) p2_deferred_item(a, lds + RING_OFF + wid * 16384, j * G * NWAVES + bx * NWAVES + wid, pg8::fresh_lane());
    if (which & 2) for (int it = bx * NWAVES + wid; it < NTOK / 8; it += G * NWAVES) pool_item(it, QKVU, pool_dst ? pool_dst : MIXED, pg8::fresh_lane());
}
constexpr size_t BAR_REGION_OFF = 1 * MiB, BAR_REGION_STRIDE = 16 * 1024;
__global__ void __launch_bounds__(NWAVES * 64, 2) mega(Args args) {
    const int li = args.li;
    extern __shared__ __attribute__((aligned(16))) unsigned char lds_raw[];
    LAS unsigned char* lds = (LAS unsigned char*)lds_raw;
    volatile LAS unsigned* MISC = (volatile LAS unsigned*)(lds + MISC_OFF);
    const int wave = __builtin_amdgcn_readfirstlane((int)threadIdx.x >> 6);
#define LANE_ID() ({ int l_; asm volatile("v_mbcnt_lo_u32_b32 %0, -1, 0\n\tv_mbcnt_hi_u32_b32 %0, -1, %0" : "=v"(l_)); l_; })
    const int G = gridDim.x; const int bx = blockIdx.x; const int vcu = (G % 8 == 0) ? (bx % 8) * (G / 8) + bx / 8 : bx;
    for (int u = wave * 64 + LANE_ID(); u < MISC_BYTES / 4; u += NWAVES * 64) MISC[u] = 0u;
    __syncthreads();
    unsigned char* ws = args.ws;
    XcdBarrier bar = xcd_barrier_post((unsigned*)(ws + BAR_REGION_OFF + (size_t)li * BAR_REGION_STRIDE), MISC + 8);
    const int lo = args.ph_lo, hi = args.ph_hi;
    LAS unsigned char* ring = lds + RING_OFF; LAS unsigned char* epi = lds + EPI_OFF; LAS unsigned* gtab = (LAS unsigned*)(lds + GTAB_OFF);
#ifndef TIME_PHASE
#define TIME_PHASE -1
#endif
#define REP_OF(k) ((TIME_PHASE == (k)) ? 2 : 1)
#define REPE_OF(k) ((TIME_PHASE == 20 + (k)) ? 2 : 1)
#define IN(k) (lo <= (k) && (k) < hi)
#ifndef TSK
#define TSK -1
#endif
#ifndef TSCALE
#define TSCALE 1.0f
#endif
#define STAMP(i) do { if (TSK >= 0 && wave == 0) { const unsigned long long t_ = __builtin_amdgcn_s_memrealtime(); MISC[128 + 2 * (i)] = (unsigned)t_; MISC[129 + 2 * (i)] = (unsigned)(t_ >> 32); } } while (0)
#define SEAM(k) do { if (IN(k) && IN((k) + 1)) xcd_barrier(bar); STAMP((k) + 1); } while (0)

    STAMP(0);
    if (IN(0)) { p0_prologue(args, lds, vcu, G, wave, LANE_ID()); if (TIME_PHASE == 0) { xcd_barrier(bar); p0_prologue(args, lds, vcu, G, wave, LANE_ID()); } SEAM(0); }
    if (IN(1)) { SchedP1 S{G, bx, ws}; pg8::EpiBf16S E; pg8::gemm_phase<pg8::EpiBf16S, SchedP1, 0, REP_OF(1), REPE_OF(1)>(wave, ring, epi, gtab, D * 2, D * 2, D / 64, S, E);
        if (G == 256 && bx >= 64) p1_deferred_items(args, lds, bx - 64, wave, LANE_ID());
        else if (G != 256 && bx == 0) { for (int rk = 0; rk < 192; ++rk) p1_deferred_items(args, lds, rk, wave, LANE_ID()); }
        SEAM(1); }
    {
    const float* xin0 = args.in[0]; float* outp = args.out;
    bf16_t* S0p = (bf16_t*)(ws + WS_S0); ssq_t* SSQSBp = (ssq_t*)(ws + MK_SSQSB); ssq_t* SSQ1p = (ssq_t*)(ws + MK_SSQ1); ssq_t* SSQ2p = (ssq_t*)(ws + MK_SSQ2);
    constexpr size_t TSTEP = (size_t)256 * D * 2;
    #if !defined(PH_ONLY) || PH_ONLY == 2
    if (IN(2)) { if (TIME_PHASE == 42) { p2_mix(args, lds, bx, G, wave, LANE_ID(), (ssq_t*)(ws + 1280 * 1024), 2); xcd_barrier(bar); p2_mix(args, lds, bx, G, wave, LANE_ID(), (ssq_t*)(ws + 1280 * 1024), 2); xcd_barrier(bar); }
    if (TIME_PHASE == 2 || TIME_PHASE == 40 || TIME_PHASE == 41) { p2_mix(args, lds, bx, G, wave, LANE_ID(), (ssq_t*)(ws + 1280 * 1024), TIME_PHASE == 40 ? 1 : (TIME_PHASE == 41 ? 2 : 3)); xcd_barrier(bar); } STAMP(20); p2_mix(args, lds, bx, G, wave, LANE_ID(), (ssq_t*)(ws + MK_SSQSB), 1); STAMP(21); p2_mix(args, lds, bx, G, wave, LANE_ID(), (ssq_t*)(ws + MK_SSQSB), 2, 9, nullptr, (TSK >= 30 && bx == 0) ? MISC + 128 + 60 : nullptr); STAMP(22); SEAM(2); STAMP(23); }
#endif

#if !defined(PH_ONLY) || PH_ONLY == 3
    if (IN(3)) { SchedReg S{G, bx, NTOK / 256, D / 256, (const char*)(ws + WS_MIXED), (const char*)(ws + WS_WOUT), TSTEP, TSTEP, nullptr, D, nullptr, nullptr};
        EpiResid<8, true, true> E{nullptr, S0p, ws + WS_X1F8, SSQ1p, SSQSBp, 1.0f}; pg8::gemm_phase<EpiResid<8, true, true>, SchedReg, 0, REP_OF(3)>    (wave, ring, epi, gtab, D * 2, D * 2, D / 64, S, E); SEAM(3); }
#endif
#if !defined(PH_ONLY) || PH_ONLY == 4
    if (IN(4)) { SchedReg S{G, bx, NTOK / 256, D / 256, (const char*)(ws + WS_X1F8), (const char*)(ws + WS_WQ), TSTEP / 2, TSTEP / 2, (bf16_t*)(ws + WS_QM), D, nullptr, nullptr, SSQ1p};
        EpiBf16Ssq E{1.0f / D, C2_MEM / WSCALE}; pg8::gemm_phase<EpiBf16Ssq, SchedReg, 0, REP_OF(4), 1, true>(wave, ring, epi, gtab, D, D, D / 128, S, E); STAMP(5); }
#endif
#if !defined(PH_ONLY) || PH_ONLY == 5
    if (IN(5)) { SchedMS S{G, bx, ws}; EpiSoftmax E; pg8::gemm_phase<EpiSoftmax, SchedMS, 0, REP_OF(5)>(wave, ring, epi, gtab, D * 2, D * 2, MHD / 64, S, E); STAMP(6); }
#endif
#if !defined(PH_ONLY) || PH_ONLY == 6
    if (IN(6)) { SchedPV S{G, bx, ws}; pg8::EpiBf16S E; pg8::gemm_phase<pg8::EpiBf16S, SchedPV, 0, REP_OF(6)>(wave, ring, epi, gtab, D * 2, NMEM * 2, NMEM / 64, S, E);
        {
            const bf16_t* om = (const bf16_t*)(ws + WS_OM); unsigned char* om8 = ws + WS_Y + 64 * MiB;     const int t_ = wave * 64 + LANE_ID(); pg8::Unit u_;
            for (int i_ = 0; S.next(i_, u_); ++i_) { const size_t base = (size_t)u_.pm * 256 * D + u_.pn * MHD;
                for (int h_ = 0; h_ < 2; ++h_) {
                u32x4 v_[8];
#pragma unroll
                for (int q_ = 0; q_ < 8; ++q_) { const int c_ = t_ + (h_ * 8 + q_) * NWAVES * 64; v_[q_] = *(const u32x4*)(om + base + (size_t)(c_ >> 5) * D + (c_ & 31) * 8); }
#pragma unroll
                for (int q_ = 0; q_ < 8; ++q_) { const int c_ = t_ + (h_ * 8 + q_) * NWAVES * 64; const size_t o_ = base + (size_t)(c_ >> 5) * D + (c_ & 31) * 8; const u32x4 v = v_[q_];
                    int w0 = __builtin_amdgcn_cvt_pk_fp8_f32(__builtin_bit_cast(float, v.x << 16), __builtin_bit_cast(float, v.x & 0xffff0000u), 0, false); w0 = __builtin_amdgcn_cvt_pk_fp8_f32(__builtin_bit_cast(float, v.y << 16), __builtin_bit_cast(float, v.y & 0xffff0000u), w0, true);
                    int w1 = __builtin_amdgcn_cvt_pk_fp8_f32(__builtin_bit_cast(float, v.z << 16), __builtin_bit_cast(float, v.z & 0xffff0000u), 0, false); w1 = __builtin_amdgcn_cvt_pk_fp8_f32(__builtin_bit_cast(float, v.w << 16), __builtin_bit_cast(float, v.w & 0xffff0000u), w1, true);
                    *(unsigned long long*)(om8 + o_) = (unsigned long long)(unsigned)w0 | ((unsigned long long)(unsigned)w1 << 32); } } } }
        SEAM(6); }
#endif
#if !defined(PH_ONLY) || PH_ONLY == 7
    if (IN(7)) { SchedReg S{G, bx, NTOK / 256, D / 256, (const char*)(ws + WS_Y + 64 * MiB), (const char*)(ws + WS_WO), TSTEP / 2, TSTEP / 2, nullptr, D, nullptr, nullptr};
        EpiResid<-1, true, true> E{nullptr, S0p, ws + WS_X2F8, SSQ2p, nullptr, 1.0f / WSCALE}; pg8::gemm_phase<EpiResid<-1, true, true>, SchedReg, 0, REP_OF(7), 1, true>(wave, ring, epi, gtab, D, D, D / 128, S, E); SEAM(7); }
#endif
#if !defined(PH_ONLY) || PH_ONLY == 8
    if (IN(8)) { if (TIME_PHASE == 8) { p8_route(args, lds, bx, G, wave, LANE_ID(), (int*)(ws + 1536 * 1024)); xcd_barrier(bar); } p8_route(args, lds, bx, G, wave, LANE_ID(), (int*)(ws + OFF_CNT)); SEAM(8); }
#endif
#if !defined(PH_ONLY) || PH_ONLY == 9
    if (IN(9)) { moe_table(args, MISC, wave * 64 + LANE_ID()); SchedMoE<8, true> S{G, bx, ws, MISC, args.in[18]}; EpiSwiGLU E{ws + WS_ACT};
        pg8::gemm_phase<EpiSwiGLU, SchedMoE<8, true>, 1, REP_OF(9), REPE_OF(9), true>(wave, ring, epi, gtab, D, D, D / 128, S, E); SEAM(9); }
#endif
#if !defined(PH_ONLY) || PH_ONLY == 10
    if (IN(10)) { moe_table(args, MISC, wave * 64 + LANE_ID()); SchedMoE<4, false> S{G, bx, ws, MISC, args.in[20]}; EpiW2 E{ws + WS_Y};
        pg8::gemm_phase<EpiW2, SchedMoE<4, false>, 2, REP_OF(10), REPE_OF(10), true>(wave, ring, epi, gtab, DFF, DFF, DFF / 128, S, E); SEAM(10); }
#endif
#if !defined(PH_ONLY) || PH_ONLY == 11
    if (IN(11)) { if (TIME_PHASE == 11) { p11_final(args, vcu, G, wave, LANE_ID(), (float*)(ws + WS_ACT)); xcd_barrier(bar); } p11_final(args, vcu, G, wave, LANE_ID(), args.out); }
#endif
}

    if (TSK >= 100) { __syncthreads(); float* dbg = (float*)(ws + 1792 * 1024);
        if (wave == 0 && LANE_ID() == 0) { const int a_ = (TSK >= 200) ? 21 : 20; const unsigned long long t0 = ((unsigned long long)MISC[129 + 2 * a_] << 32) | MISC[128 + 2 * a_], t1 = ((unsigned long long)MISC[131 + 2 * a_] << 32) | MISC[130 + 2 * a_];
            __hip_atomic_store(dbg + bx, (float)(t1 - t0) * 0.01f, __ATOMIC_RELAXED, __HIP_MEMORY_SCOPE_AGENT); }
        xcd_barrier(bar);
        if (bx == 0 && wave == 0) { const int l_ = LANE_ID(); float mx = 0.f, mn = 1e9f; for (int q = l_; q < G; q += 64) { const float v = __hip_atomic_load(dbg + q, __ATOMIC_RELAXED, __HIP_MEMORY_SCOPE_AGENT); mx = fmaxf(mx, v); mn = fminf(mn, v); }
            for (int o_ = 1; o_ < 64; o_ <<= 1) { mx = fmaxf(mx, __shfl_xor(mx, o_)); mn = fminf(mn, __shfl_xor(mn, o_)); }
            if (l_ == 0) { asm volatile("s_waitcnt vmcnt(0)" ::: "memory"); args.out[0] = ((TSK % 100) == 0 ? mx : mn) * TSCALE; } } }
    else if (TSK >= 0) { STAMP(12); __syncthreads(); if (bx == 0 && wave == 0 && LANE_ID() == 0) { asm volatile("s_waitcnt vmcnt(0)" ::: "memory");
        const unsigned long long t0 = ((unsigned long long)MISC[129 + 2 * TSK] << 32) | MISC[128 + 2 * TSK], t1 = ((unsigned long long)MISC[131 + 2 * TSK] << 32) | MISC[130 + 2 * TSK];
        args.out[0] = (float)(t1 - t0) * 0.01f * TSCALE; } }
    if (TIME_PHASE == 12) { for (int q = 0; q < 10; ++q) xcd_barrier(bar); }
#undef IN
#undef SEAM
}
}

extern "C" void kernel_launch(void* const* d_in, const int* in_sizes, int n_in, void* d_out, int out_size, void* d_ws, size_t ws_size, hipStream_t stream) {
    if (n_in != 22 || out_size != NTOK * D || ws_size < WS_END) { fprintf(stderr, "kernel_launch: unexpected shapes (n_in %d out %d ws %zu)\n", n_in, out_size, ws_size); return; }
    static int grid = 0;
    if (grid == 0) {
        int dev = 0, cus = 0;
        if (hipGetDevice(&dev) != hipSuccess || hipDeviceGetAttribute(&cus, hipDeviceAttributeMultiprocessorCount, dev) != hipSuccess) { grid = -1; return; }
        if (hipFuncSetAttribute((const void*)mk::mega, hipFuncAttributeMaxDynamicSharedMemorySize, mk::LDS_BYTES) != hipSuccess) { fprintf(stderr, "kernel_launch: hipFuncSetAttribute failed\n"); grid = -1; return; }
        int per_cu = 0; (void)hipOccupancyMaxActiveBlocksPerMultiprocessor(&per_cu, (const void*)mk::mega, mk::NWAVES * 64, mk::LDS_BYTES); (void)hipGetLastError();
        if (per_cu < 1) fprintf(stderr, "kernel_launch: occupancy query reports %d blocks per CU\n", per_cu);
        grid = cus;
    }
    if (grid < 0) return;
    (void)hipMemsetAsync((unsigned char*)d_ws + WS_CTL, 0, CTL_BYTES, stream);
    mk::Args a{}; for (int i = 0; i < 22; ++i) a.in[i] = (const float*)d_in[i]; a.out = (float*)d_out; a.ws = (unsigned char*)d_ws;
    a.ph_lo = 0; a.ph_hi = mk::NPHASE; a.li = 0;
    hipLaunchKernelGGL(mk::mega, dim3(grid), dim3(mk::NWAVES * 64), mk::LDS_BYTES, stream, a);
}
```

```cpp
#include <hip/hip_runtime.h>
#include <cstdio>
#include <cstdint>

typedef unsigned short bf16_t;
typedef short bf16x8 __attribute__((ext_vector_type(8)));
typedef float f32x4 __attribute__((ext_vector_type(4)));
typedef unsigned u32x4 __attribute__((ext_vector_type(4)));

namespace cfg {
constexpr int B = 8, S = 4096, D = 1024, NTOK = B * S;
constexpr int SBW = 512, NH = 8, HD = 64, PW = 512, PG = 4, PGD = 128, INP = 2048;
constexpr int NMEM = 256, MH = 4, MHD = 256, NMROWS = B * NMEM;
constexpr int NE = 32, TOPK = 4, DFF = 1024, LCAP = NTOK;
constexpr float EPS = 1e-5f, LOG2E = 1.4426950408889634f;
constexpr float C2_SB = 0.125f * LOG2E, C2_MEM = 0.0625f * LOG2E;
constexpr float SW_LIMIT = 7.0f, SW_ALPHA = 1.702f;
constexpr int MAXTILES = 544;
constexpr size_t MiB = 1u << 20;
constexpr size_t WS_CTL = 0, CTL_BYTES = 2 * MiB;
constexpr size_t OFF_CNT = 64 * 1024, OFF_SSQSB = 512 * 1024, OFF_SSQ1 = 640 * 1024, OFF_SSQ2 = 768 * 1024;
constexpr size_t WS_WIN = 2 * MiB, WS_WOUT = 6 * MiB, WS_WQ = 8 * MiB, WS_WKV = 10 * MiB, WS_WO = 14 * MiB, WS_WP = 16 * MiB, WS_WR = 17 * MiB;
constexpr size_t WS_RSTDX = 18 * MiB, WS_RSTDM = 18 * MiB + 512 * 1024;
constexpr size_t WS_W1 = 20 * MiB, WS_W2 = 148 * MiB;
constexpr size_t WS_S0 = 212 * MiB;
constexpr size_t WS_QKVU = 276 * MiB;
constexpr size_t WS_QM = 664 * MiB, WS_OM = 728 * MiB;
constexpr size_t WS_MIXED = 404 * MiB;
constexpr size_t WS_PM = 404 * MiB;
constexpr size_t WS_ACT = 276 * MiB;
constexpr size_t WS_KM = 548 * MiB, WS_VMT = 552 * MiB, WS_MEMB = 556 * MiB, WS_LSLOT = 560 * MiB, WS_LGATE = 564 * MiB;
constexpr size_t WS_Y = 568 * MiB;
constexpr size_t WS_SCR_S = 568 * MiB, WS_SCR_POOLED = 696 * MiB, WS_SCR_POOLO = 728 * MiB;
constexpr size_t WS_END = 824 * MiB;
}
using namespace cfg;

__device__ __forceinline__ unsigned f2bf(float f) { unsigned u = __builtin_bit_cast(unsigned, f); return (u + 0x7fffu + ((u >> 16) & 1u)) >> 16; }
__device__ __forceinline__ float bf2f(bf16_t h) { return __builtin_bit_cast(float, (unsigned)h << 16); }
__device__ __forceinline__ float wave_sum(float v) {
#pragma unroll
    for (int o = 1; o < 64; o <<= 1) v += __shfl_xor(v, o);
    return v;
}


#define LAS __attribute__((address_space(3)))
#define GAS __attribute__((address_space(1)))
typedef int v4i_t __attribute__((ext_vector_type(4)));
typedef int v8i_t __attribute__((ext_vector_type(8)));
namespace pg8 {
constexpr int BM = 256, BK = 64, HALF = 128, HTB = HALF * BK * 2, STAGE_BYTES = 8 * HTB, NXCD = 8, WGM = 8;
__host__ __device__ __forceinline__ int lds_byte(int r, int c) { const int st = (r >> 4) * 2 + (c >> 5), rr = r & 15, cc = c & 31, ob = rr * 64 + cc * 2; return st * 1024 + (ob ^ (((ob >> 9) & 1) << 5)); }
__host__ __device__ __forceinline__ void stage_rc(int b, int& R, int& C) { const int st = b / 1024, sb = b % 1024, swz = sb ^ (((sb >> 9) & 1) << 5); R = (st >> 1) * 16 + swz / 64; C = (st & 1) * 32 + (swz % 64) / 2; }
__host__ __device__ __forceinline__ int perm32(int rho) { const int n = rho >> 4, i = rho & 15; return 8 * (i >> 2) + 4 * n + (i & 3); }
__device__ __forceinline__ unsigned cvt_pk_bf16(float lo, float hi) { unsigned r; asm volatile("v_cvt_pk_bf16_f32 %0, %1, %2" : "=v"(r) : "v"(lo), "v"(hi)); return r; }

#define WTMASK 0x008
#ifndef WTMASK
#define WTMASK 0x1ff
#endif
#define WT_ON(bit) (((WTMASK) >> (bit)) & 1)
__device__ __forceinline__ void st16_wt(void* p, u32x4 v) { asm volatile("global_store_dwordx4 %0, %1, off sc1\n\ts_nop 1" :: "v"(p), "v"(v)); }
__device__ __forceinline__ void st16_wt(void* p, f32x4 v) { asm volatile("global_store_dwordx4 %0, %1, off sc1\n\ts_nop 1" :: "v"(p), "v"(v)); }
template <int BIT, class V> __device__ __forceinline__ void st16(void* p, V v) { if constexpr (WT_ON(BIT)) st16_wt(p, v); else *(V*)p = v; }
#ifndef WT8
#define WT8 0
#endif
__device__ __forceinline__ void st8_wt(void* p, unsigned long long v) { if (WT8) __hip_atomic_store((unsigned long long*)p, v, __ATOMIC_RELAXED, __HIP_MEMORY_SCOPE_AGENT); else *(unsigned long long*)p = v; }
__device__ __forceinline__ void st4_wt(void* p, unsigned v) { if (WT8) __hip_atomic_store((unsigned*)p, v, __ATOMIC_RELAXED, __HIP_MEMORY_SCOPE_AGENT); else *(unsigned*)p = v; }
template <int M> __device__ __forceinline__ float swz_xor(float v) { return __uint_as_float((unsigned)__builtin_amdgcn_ds_swizzle((int)__float_as_uint(v), (M << 10) | 0x1f)); }
__device__ __forceinline__ float half_sum(float v) { const auto sw = __builtin_amdgcn_permlane32_swap(__float_as_uint(v), __float_as_uint(v), false, false); return __uint_as_float(sw[0]) + __uint_as_float(sw[1]); }
__device__ __forceinline__ float half_max(float v) { const auto sw = __builtin_amdgcn_permlane32_swap(__float_as_uint(v), __float_as_uint(v), false, false); return fmaxf(__uint_as_float(sw[0]), __uint_as_float(sw[1])); }
__device__ __forceinline__ float wsum(float v) { v += swz_xor<1>(v); v += swz_xor<2>(v); v += swz_xor<4>(v); v += swz_xor<8>(v); v += swz_xor<16>(v); return half_sum(v); }
__device__ __forceinline__ int fresh_lane() { int l; asm volatile("v_mbcnt_lo_u32_b32 %0, -1, 0\n\tv_mbcnt_hi_u32_b32 %0, -1, %0" : "=v"(l)); return l; }
struct Unit { const char* A; const char* B; void* p0; void* p1; void* p2; void* p3; int pm, pn, i0, i1, ghost; };

__device__ __forceinline__ int xcd_remap(int L, int nwg) { const int q = nwg / NXCD, r = nwg % NXCD, xcd = L % NXCD, off = L / NXCD; return __builtin_amdgcn_readfirstlane((xcd < r ? xcd * (q + 1) : r * (q + 1) + (xcd - r) * q) + off); }
__device__ __forceinline__ void grouped_mn(int wgid, int nM, int nN, int& pm, int& pn) {
    const int nig = WGM * nN, gid = wgid / nig, fm = gid * WGM, gsz = (nM - fm) < WGM ? (nM - fm) : WGM; pm = __builtin_amdgcn_readfirstlane(fm + ((wgid % nig) % gsz)); pn = __builtin_amdgcn_readfirstlane((wgid % nig) / gsz); }

template <class Epi, class Sched, int TABS, int REP = 1  , int REPE = 1, bool F8 = false>
__device__ __forceinline__ void gemm_phase(const int wid, LAS unsigned char* lds, LAS unsigned char* epi_lds, LAS unsigned* gtab, const int lda_b, const int ldb_b, const int nt, const Sched& S, const Epi& E) {
    constexpr bool GATHER = (TABS == 1);
    const int wr = wid >> 2, wc = wid & 3;
    unsigned voffA, voffB, voffG[2][2]; int aoff, boff;
    { const int lane = fresh_lane(); int R, C; stage_rc(wid * 1024 + lane * 16, R, C); const int Rb = Epi::PERM ? ((R & ~31) + perm32(R & 31)) : R;
      voffA = (unsigned)(R * lda_b + C * 2); voffB = (unsigned)(Rb * ldb_b + C * 2); voffG[0][0] = voffG[0][1] = voffG[1][0] = voffG[1][1] = 0;
      aoff = lds_byte(wr * 64 + (lane & 15), (lane >> 4) * 8); boff = lds_byte(wc * 32 + (lane & 15), (lane >> 4) * 8); }
    const size_t kstep = (size_t)(BK * 2);
    const size_t hstepA = (size_t)HALF * lda_b, hstepB = (size_t)HALF * ldb_b;
    const unsigned ldsw = (unsigned)wid * 1024u; const unsigned ldsbase = (unsigned)(uintptr_t)lds + ldsw;
#define PG8_SA(b, h) (((b) * 2 + (h)) * HTB)
#define PG8_SB(b, h) ((4 + (b) * 2 + (h)) * HTB)
#define PG8_GLDS(ugp, voff, bufoff, _i) do { unsigned _keep; asm volatile("s_mov_b32 %0, m0\n\ts_mov_b32 m0, %3\n\ts_nop 0\n\tglobal_load_lds_dwordx4 %1, %2\n\ts_mov_b32 m0, %0" \
        : "=&s"(_keep) : "v"(voff), "s"((const char*)(ugp)), "s"(ldsbase + (unsigned)((bufoff) + (_i) * 8192)) : "memory"); } while (0)
#define PG8_STAGE_B(bufoff, gbase) do { _Pragma("unroll") for (int _i = 0; _i < 2; ++_i) PG8_GLDS((const char*)(gbase) + (size_t)_i * 64 * ldb_b, voffB, bufoff, _i); } while (0)
#define PG8_STAGE_A(bufoff, gbase, h) do { if constexpr (GATHER) { _Pragma("unroll") for (int _i = 0; _i < 2; ++_i) PG8_GLDS((const char*)(gbase), voffG[h][_i], bufoff, _i); } \
        else { _Pragma("unroll") for (int _i = 0; _i < 2; ++_i) PG8_GLDS((const char*)(gbase) + (h) * hstepA + (size_t)_i * 64 * lda_b, voffA, bufoff, _i); } } while (0)
#define PG8_LDA(dst, b, h) do { _Pragma("unroll") for (int m = 0; m < 4; ++m) _Pragma("unroll") for (int k = 0; k < 2; ++k) dst[m][k] = *(const LAS bf16x8*)(lds + PG8_SA(b, h) + aoff + m * 2048 + k * 1024); } while (0)
#define PG8_LDB(dst, b, h) do { _Pragma("unroll") for (int n = 0; n < 2; ++n) _Pragma("unroll") for (int k = 0; k < 2; ++k) dst[n][k] = *(const LAS bf16x8*)(lds + PG8_SB(b, h) + boff + n * 2048 + k * 1024); } while (0)
#define PG8_CAT(x0, x1) __builtin_shufflevector(__builtin_bit_cast(v4i_t, x0), __builtin_bit_cast(v4i_t, x1), 0, 1, 2, 3, 4, 5, 6, 7)
#define PG8_MMA(ai, bj, At, Bt) do { __builtin_amdgcn_s_setprio(1); _Pragma("unroll") for (int m = 0; m < 4; ++m) _Pragma("unroll") for (int n = 0; n < 2; ++n) { \
        if constexpr (F8) acc[ai][bj][m][n] = __builtin_amdgcn_mfma_scale_f32_16x16x128_f8f6f4(PG8_CAT(Bt[n][0], Bt[n][1]), PG8_CAT(At[m][0], At[m][1]), acc[ai][bj][m][n], 0, 0, 0, 0, 0, 0); \
        else { _Pragma("unroll") for (int k = 0; k < 2; ++k) acc[ai][bj][m][n] = __builtin_amdgcn_mfma_f32_16x16x32_bf16(Bt[n][k], At[m][k], acc[ai][bj][m][n], 0, 0, 0); } } __builtin_amdgcn_s_setprio(0); } while (0)
#define PG8_WAIT_V(n) asm volatile("s_waitcnt vmcnt(" #n ")" ::: "memory")
#define PG8_WAIT_L(n) asm volatile("s_waitcnt lgkmcnt(" #n ")" ::: "memory")
#define PG8_BAR __builtin_amdgcn_s_barrier()
#define PG8_SCHED __builtin_amdgcn_sched_barrier(0)
#define PG8_GTAB_LOAD(buf, nvalid) do { const int _l = fresh_lane(); int _R, _C; stage_rc(wid * 1024 + _l * 16, _R, _C); _Pragma("unroll") for (int _h = 0; _h < 2; ++_h) _Pragma("unroll") for (int _i = 0; _i < 2; ++_i) { \
        const int _row = _h * HALF + _R + 64 * _i; const unsigned _s = gtab[(buf) * 768 + _row]; voffG[_h][_i] = ((_row < (nvalid)) ? (_s >> 2) * (unsigned)lda_b : 0u) + (unsigned)(_C * 2); } } while (0)
#define PG8_GTAB_DMA(buf, U) do { if constexpr (TABS == 3) { if (wid == 1 || wid == 2) { const char* _b = (wid == 1) ? (const char*)(U).p1 : (const char*)(U).p2;     \
            if (_b) __builtin_amdgcn_global_load_lds((const unsigned*)(_b + fresh_lane() * 16), (LAS unsigned*)(gtab + (buf) * 768 + wid * 256), 16, 0, 0); } } \
        else if (wid < 3) { const int _l = fresh_lane(); const char* _src = (wid == 0) ? (const char*)(U).p3 + _l * 16 : (wid == 1) ? (const char*)(U).p2 + _l * 16 : \
            (TABS == 1 ? (const char*)(U).p1 + (_l & 31) * 16 + (_l >> 5) * (DFF * 4) : (const char*)(U).p1 + _l * 16); \
        __builtin_amdgcn_global_load_lds((const unsigned*)_src, (LAS unsigned*)(gtab + (buf) * 768 + wid * 256), 16, 0, 0); } } while (0)
    auto nextu = [&](int i, Unit& u) -> bool { if constexpr (REP > 1) { const bool ok = S.next(i / REP, u); u.ghost = (i % REP) != REP - 1; return ok; } else { u.ghost = 0; return S.next(i, u); } };
    Unit cur, nxt; int ui = 0;
    if (!nextu(0, cur)) return;
    f32x4 acc[2][2][4][2];
#pragma unroll
    for (int a = 0; a < 2; ++a)
#pragma unroll
        for (int b = 0; b < 2; ++b)
#pragma unroll
            for (int m = 0; m < 4; ++m)
#pragma unroll
                for (int n = 0; n < 2; ++n) acc[a][b][m][n] = (f32x4){0.f, 0.f, 0.f, 0.f};
    bf16x8 At[4][2], B0[2][2], B1[2][2];
    const char* cA = cur.A; const char* cB = cur.B;
    if constexpr (TABS != 0) { PG8_GTAB_DMA(0, cur); PG8_WAIT_V(0); PG8_WAIT_L(0); PG8_BAR; if constexpr (GATHER) PG8_GTAB_LOAD(0, cur.i0); }
    PG8_STAGE_B(PG8_SB(0, 0), cB); PG8_STAGE_B(PG8_SB(0, 1), cB + hstepB); PG8_STAGE_A(PG8_SA(0, 0), cA, 0); PG8_STAGE_A(PG8_SA(0, 1), cA, 1);
    if (wr == 1) PG8_BAR;
    PG8_WAIT_V(2); PG8_BAR;
    PG8_STAGE_B(PG8_SB(1, 0), cB + kstep); PG8_STAGE_A(PG8_SA(1, 0), cA + kstep, 0); PG8_STAGE_B(PG8_SB(1, 1), cB + hstepB + kstep);
    PG8_WAIT_V(6); PG8_BAR;
    for (;;) {
        const bool has_next = nextu(ui + 1, nxt);
        const char* nA = has_next ? nxt.A : cA; const char* nB = has_next ? nxt.B : cB;
#pragma unroll 1
        for (int t = 0; t < nt; t += 2) {
            const bool last = (t == nt - 2);
            const char* a1 = cA + (size_t)(t + 1) * kstep;
            const char* a2 = last ? nA : cA + (size_t)(t + 2) * kstep; const char* b2 = last ? nB : cB + (size_t)(t + 2) * kstep;
            const char* a3 = a2 + kstep; const char* b3 = b2 + kstep;
            if constexpr (Epi::MIDK >= 0) { if (t == Epi::MIDK) E.midk(acc, cur, wr, fresh_lane() & 15); }
            if constexpr (TABS != 0) { if (t == 2 && has_next) PG8_GTAB_DMA((ui + 1) & 1, nxt); }
            if constexpr (GATHER) { PG8_STAGE_A(PG8_SA(1, 1), a1, 1); if (last && has_next) PG8_GTAB_LOAD((ui + 1) & 1, nxt.i0); PG8_SCHED; }
            PG8_LDB(B0, 0, 0); PG8_LDB(B1, 0, 1); PG8_SCHED; PG8_LDA(At, 0, 0); if constexpr (!GATHER) PG8_STAGE_A(PG8_SA(1, 1), a1, 1);
            PG8_WAIT_V(8); PG8_WAIT_L(0); PG8_BAR; PG8_MMA(0, 0, At, B0); PG8_MMA(0, 1, At, B1); PG8_BAR; PG8_SCHED;
            PG8_LDA(At, 0, 1); PG8_STAGE_B(PG8_SB(0, 0), b2); PG8_STAGE_B(PG8_SB(0, 1), b2 + hstepB); PG8_STAGE_A(PG8_SA(0, 0), a2, 0);
            PG8_WAIT_V(8); PG8_WAIT_L(0); PG8_BAR; PG8_MMA(1, 0, At, B0); PG8_MMA(1, 1, At, B1); PG8_BAR; PG8_SCHED;
            PG8_LDB(B0, 1, 0); PG8_LDB(B1, 1, 1); PG8_SCHED; PG8_LDA(At, 1, 0); PG8_STAGE_A(PG8_SA(0, 1), a2, 1);
            PG8_WAIT_V(8); PG8_WAIT_L(0); PG8_BAR; PG8_MMA(0, 0, At, B0); PG8_MMA(0, 1, At, B1); PG8_BAR; PG8_SCHED;
            PG8_LDA(At, 1, 1); PG8_STAGE_B(PG8_SB(1, 0), b3); PG8_STAGE_B(PG8_SB(1, 1), b3 + hstepB); PG8_STAGE_A(PG8_SA(1, 0), a3, 0);
            PG8_WAIT_V(8); PG8_WAIT_L(0); PG8_BAR; PG8_MMA(1, 0, At, B0); PG8_MMA(1, 1, At, B1); PG8_BAR; PG8_SCHED;
        }
        if (wr == 0) PG8_BAR;
        if (!cur.ghost) { const int el = fresh_lane(); LAS unsigned char* ex = (TABS != 0) ? (LAS unsigned char*)(gtab + (ui & 1) * 768) : epi_lds; E(acc, cur, wr, wc, el & 15, el >> 4, wid, el, ex); if constexpr (REPE > 1) { asm volatile("" ::: "memory"); E(acc, cur, wr, wc, el & 15, el >> 4, wid, el, ex); } }
        if (!has_next) break;
#pragma unroll
        for (int a = 0; a < 2; ++a)
#pragma unroll
            for (int b = 0; b < 2; ++b)
#pragma unroll
                for (int m = 0; m < 4; ++m)
#pragma unroll
                    for (int n = 0; n < 2; ++n) acc[a][b][m][n] = (f32x4){0.f, 0.f, 0.f, 0.f};
        cur = nxt; cA = nA; cB = nB; ++ui;
        if (wr == 1) PG8_BAR;
    }
    PG8_WAIT_V(0);
    PG8_BAR;
#undef PG8_SA
#undef PG8_SB
#undef PG8_GLDS
#undef PG8_STAGE_A
#undef PG8_STAGE_B
#undef PG8_LDA
#undef PG8_LDB
#undef PG8_MMA
#undef PG8_CAT
#undef PG8_WAIT_V
#undef PG8_WAIT_L
#undef PG8_BAR
#undef PG8_SCHED
#undef PG8_GTAB_LOAD
#undef PG8_GTAB_DMA
}

template <bool F8O> struct EpiBf16SX {
    static constexpr bool PERM = true; static constexpr int MIDK = -1;
    __device__ __forceinline__ void midk(f32x4 (&)[2][2][4][2], const Unit&, int, int) const {}
    __device__ __forceinline__ void operator()(const f32x4 (&acc)[2][2][4][2], const Unit& u, int wr, int wc, int fr, int fq, int, int, LAS unsigned char*) const {
        bf16_t* O = (bf16_t*)u.p0; unsigned char* O8 = (unsigned char*)u.p0; const float* rs = (const float*)u.p1; const float* cs = (const float*)u.p2; const int ldc = u.i0;
        int r0 = wr * 64 + fr, c0 = wc * 32 + 8 * fq; asm volatile("" : "+v"(r0), "+v"(c0));
        f32x4 cv[2][2];
#pragma unroll
        for (int bj = 0; bj < 2; ++bj)
#pragma unroll
            for (int n = 0; n < 2; ++n) cv[bj][n] = cs ? *(const f32x4*)(cs + c0 + bj * HALF + 4 * n) : (f32x4){1.f, 1.f, 1.f, 1.f};
#pragma unroll
        for (int ai = 0; ai < 2; ++ai)
#pragma unroll
            for (int m = 0; m < 4; ++m) { const int r = r0 + ai * HALF + m * 16; const float rv = rs ? rs[r] : 1.f; bf16_t* rowp = O + (size_t)r * ldc + c0;
#pragma unroll
                for (int bj = 0; bj < 2; ++bj) { const f32x4 v0 = acc[ai][bj][m][0] * cv[bj][0] * rv, v1 = acc[ai][bj][m][1] * cv[bj][1] * rv;
                    if constexpr (F8O) { int w0 = __builtin_amdgcn_cvt_pk_fp8_f32(v0[0], v0[1], 0, false); w0 = __builtin_amdgcn_cvt_pk_fp8_f32(v0[2], v0[3], w0, true); int w1 = __builtin_amdgcn_cvt_pk_fp8_f32(v1[0], v1[1], 0, false); w1 = __builtin_amdgcn_cvt_pk_fp8_f32(v1[2], v1[3], w1, true);
                        st8_wt(O8 + (size_t)r * ldc + c0 + bj * HALF, (unsigned long long)(unsigned)w0 | ((unsigned long long)(unsigned)w1 << 32)); }
                    else { u32x4 w; w.x = cvt_pk_bf16(v0[0], v0[1]); w.y = cvt_pk_bf16(v0[2], v0[3]); w.z = cvt_pk_bf16(v1[0], v1[1]); w.w = cvt_pk_bf16(v1[2], v1[3]);
                    st16<1>(rowp + bj * HALF, w); } } }
    }
};
typedef EpiBf16SX<false> EpiBf16S;
struct EpiBf16T {
    static constexpr bool PERM = true; static constexpr int MIDK = -1;
    __device__ __forceinline__ void midk(f32x4 (&)[2][2][4][2], const Unit&, int, int) const {}
    __device__ __forceinline__ void operator()(const f32x4 (&acc)[2][2][4][2], const Unit& u, int wr, int wc, int fr, int fq, int, int, LAS unsigned char* tab) const {
        bf16_t* O = (bf16_t*)u.p0; const bool has_rs = u.p1 != nullptr, has_cs = u.p2 != nullptr; const int ldc = u.i0;
        const LAS float* T1 = (const LAS float*)tab + 256; const LAS float* T2 = (const LAS float*)tab + 512;
        int r0 = wr * 64 + fr, c0 = wc * 32 + 8 * fq; asm volatile("" : "+v"(r0), "+v"(c0));
        f32x4 cv[2][2];
#pragma unroll
        for (int bj = 0; bj < 2; ++bj)
#pragma unroll
            for (int n = 0; n < 2; ++n) cv[bj][n] = has_cs ? *(const LAS f32x4*)(T2 + c0 + bj * HALF + 4 * n) : (f32x4){1.f, 1.f, 1.f, 1.f};
#pragma unroll
        for (int ai = 0; ai < 2; ++ai)
#pragma unroll
            for (int m = 0; m < 4; ++m) { const int r = r0 + ai * HALF + m * 16; const float rv = has_rs ? T1[r] : 1.f; bf16_t* rowp = O + (size_t)r * ldc + c0;
#pragma unroll
                for (int bj = 0; bj < 2; ++bj) { const f32x4 v0 = acc[ai][bj][m][0] * cv[bj][0] * rv, v1 = acc[ai][bj][m][1] * cv[bj][1] * rv;
                    u32x4 w; w.x = cvt_pk_bf16(v0[0], v0[1]); w.y = cvt_pk_bf16(v0[2], v0[3]); w.z = cvt_pk_bf16(v1[0], v1[1]); w.w = cvt_pk_bf16(v1[2], v1[3]);
                    st16<1>(rowp + bj * HALF, w); } }
    }
};
}

namespace mk {
constexpr int NWAVES = 8, NPHASE = 12;
constexpr int RING_OFF = 0, RING_BYTES = 131072, EPI_OFF = 131072, EPI_BYTES = 8192, GTAB_OFF = EPI_OFF + EPI_BYTES, GTAB_BYTES = 6144, MISC_OFF = GTAB_OFF + GTAB_BYTES, MISC_BYTES = 1024;
constexpr int LDS_BYTES = 147456;
static_assert(MISC_OFF + MISC_BYTES <= LDS_BYTES, "LDS map");
constexpr size_t WS_LRS = 84 * MiB;
constexpr size_t WS_X2F8 = WS_Y, WS_X1F8 = WS_Y + 32 * MiB;
constexpr size_t WS_CSG1 = 19 * MiB, WS_WRH = 19 * MiB + 64 * 1024, WS_WRL = 19 * MiB + 128 * 1024;
typedef unsigned ssq_t;
constexpr size_t MK_SSQSB = 256 * 1024, MK_SSQ1 = 512 * 1024, MK_SSQ2 = 768 * 1024;
__device__ __forceinline__ void ssq_add(ssq_t* p, float q) { (void)__hip_atomic_fetch_add(p, (ssq_t)__float2uint_rn(q * 16384.0f), __ATOMIC_RELAXED, __HIP_MEMORY_SCOPE_AGENT); }
__device__ __forceinline__ float ssq_get(const ssq_t* p) { return (float)(*p) * (1.0f / 16384.0f); }
constexpr float WSCALE = 32.0f;
constexpr int P2_DEFER = 2048 * 10;
constexpr int P0_DEFER = 192 * 8 * 6;
constexpr int CW_BAR = 1024;

#define RLX_AGENT __ATOMIC_RELAXED, __HIP_MEMORY_SCOPE_AGENT
#define LDS_WAIT() asm volatile("s_waitcnt lgkmcnt(0)" ::: "memory")
#define VM_WAIT() asm volatile("s_waitcnt vmcnt(0)" ::: "memory")
#define XB_TMO      128
#define XB_XCNT(j)  (256  + 64 * (j))
#define XB_XSUB(j)  (1280 + 64 * (j))
#define XB_XGEN(j)  (2304 + 64 * (j))
#define XB_TOP      3328
#define XB_TOPGEN   3392
#define XB_BAD      3424
#define XCD_BAR_WORDS 3456
#define XB_SPIN_CAP (1u << 20)
__device__ __forceinline__ unsigned xb_ld(unsigned* p)              { return __hip_atomic_load(p, __ATOMIC_RELAXED, __HIP_MEMORY_SCOPE_AGENT); }
__device__ __forceinline__ unsigned xb_add(unsigned* p, unsigned v) { return __hip_atomic_fetch_add(p, v, __ATOMIC_RELAXED, __HIP_MEMORY_SCOPE_AGENT); }
__device__ __forceinline__ unsigned xb_xcc_id() { return (unsigned)__builtin_amdgcn_s_getreg((3 << 11) | 20) & 0xFu; }
#define XB_SPIN(cond, bar) do { unsigned _sp = 0; while (cond) { __builtin_amdgcn_s_sleep(1); \
    if ((++_sp & 255u) == 0u) { if (xb_ld(&(bar)[XB_TMO])) break; if (_sp > XB_SPIN_CAP) { atomicAdd(&(bar)[XB_TMO], 1u); break; } } } } while (0)
struct XcdBarrier { unsigned* bar; unsigned x; volatile LAS unsigned* st; };
__device__ __forceinline__ XcdBarrier xcd_barrier_post(unsigned* bar, volatile LAS unsigned* st) {
    XcdBarrier b; b.bar = bar; b.x = xb_xcc_id(); b.st = st;
    if (threadIdx.x == 0) (void)xb_add(&bar[XB_XCNT(b.x)], 1u);
    return b;
}
__device__ __forceinline__ void xcd_barrier_complete(unsigned* bar, unsigned x, unsigned& nloc, unsigned& nx) {
    const unsigned G = gridDim.x * gridDim.y * gridDim.z;
    unsigned sum, cnt, mine, sp = 0u;
    for (;;) {
        sum = 0u; cnt = 0u; mine = 0u;
#pragma unroll
        for (unsigned j = 0; j < 16; ++j) { const unsigned c = xb_ld(&bar[XB_XCNT(j)]); sum += c; cnt += (c > 0u) ? 1u : 0u; mine = (j == x) ? c : mine; }
        if (sum == G) break;
        __builtin_amdgcn_s_sleep(1);
        if ((++sp & 255u) == 0u) { if (xb_ld(&bar[XB_TMO])) break; if (sp > XB_SPIN_CAP) { atomicAdd(&bar[XB_TMO], 1u); break; } }
    }
    nloc = mine > 0u ? mine : 1u; nx = cnt > 0u ? cnt : 1u;
}
__device__ __forceinline__ void xcd_barrier(const XcdBarrier& b, const bool local = false) {
    asm volatile("s_waitcnt vmcnt(0)" ::: "memory");
    __syncthreads();
    if (threadIdx.x == 0) {
        unsigned* bar = b.bar;
        __builtin_amdgcn_s_waitcnt(0);
        unsigned nloc = b.st[0], nx = b.st[1];
        if (nloc == 0u) { xcd_barrier_complete(bar, b.x, nloc, nx); b.st[0] = nloc; b.st[1] = nx; }
        const unsigned old = xb_add(&bar[XB_XSUB(b.x)], 1u);
        const unsigned gen = old / nloc;
        if (old + 1u == (gen + 1u) * nloc) {
            if (!local) {
                __builtin_amdgcn_fence(__ATOMIC_RELEASE, "agent");
                asm volatile("s_waitcnt vmcnt(0)" ::: "memory");
                const unsigned og = xb_add(&bar[XB_TOP], 1u);
                const unsigned tg = og / nx;
                if (og + 1u == (tg + 1u) * nx) xb_add(&bar[XB_TOPGEN], 1u);
                else XB_SPIN(xb_ld(&bar[XB_TOPGEN]) == tg, bar);
            }
            __builtin_amdgcn_fence(__ATOMIC_ACQUIRE, "agent");
            xb_add(&bar[XB_XGEN(b.x)], 1u);
            asm volatile("s_waitcnt vmcnt(0)" ::: "memory");
        } else {
            XB_SPIN(xb_ld(&bar[XB_XGEN(b.x)]) == gen, bar);
            __builtin_amdgcn_fence(__ATOMIC_ACQUIRE, "agent");
            asm volatile("s_waitcnt vmcnt(0)" ::: "memory");
        }
    }
    __syncthreads();
}

struct Args { const float* in[22]; float* out; unsigned char* ws; int ph_lo, ph_hi, li, pad; };

template <bool F8OUT>
__device__ __forceinline__ void p0_item(const float* W, int K, int N, void* WTv, const float* gk, const float* gk2, int ksplit, const float* gn, int mode, LAS float* scr, int item, int lane, float mult = 1.0f, int nblk_dec = 0) {
    const int nblk = nblk_dec ? nblk_dec : N / 32, kb = item / nblk, nb = item % nblk, k0 = 64 * kb, nd0 = 32 * nb;
    int ns0 = nd0; if (mode == 1) { const int pn = nd0 >> 8, j = nd0 & 255; ns0 = (j < 128) ? 128 * pn + j : 1024 + 128 * pn + (j - 128); }
    const int kr = lane >> 3, n4 = (lane & 7) * 4;
    f32x4 v[8];
#pragma unroll
    for (int i = 0; i < 8; ++i) v[i] = __builtin_nontemporal_load((const f32x4*)(W + (size_t)(k0 + 8 * i + kr) * N + ns0 + n4));
    f32x4 gnv = (f32x4){1.f, 1.f, 1.f, 1.f}; if (gn) gnv = *(const f32x4*)(gn + ns0 + n4);
#pragma unroll
    for (int i = 0; i < 8; ++i) { const int kk = 8 * i + kr, k = k0 + kk; float g = 1.f; if (gk) g = (k < ksplit) ? gk[k] : gk2[k - ksplit];
        const f32x4 t = v[i] * gnv * (g * mult); LAS float* d = scr + kk * 33 + n4; d[0] = t[0]; d[1] = t[1]; d[2] = t[2]; d[3] = t[3]; }
    LDS_WAIT(); asm volatile("" ::: "memory");
    const int c = lane & 7;
#pragma unroll
    for (int j = 0; j < 4; ++j) { const int n = (lane >> 3) + 8 * j; const LAS float* s = scr + (8 * c) * 33 + n;
        if constexpr (F8OUT) { int lo = __builtin_amdgcn_cvt_pk_fp8_f32(s[0 * 33], s[1 * 33], 0, false); lo = __builtin_amdgcn_cvt_pk_fp8_f32(s[2 * 33], s[3 * 33], lo, true);
            int hi2 = __builtin_amdgcn_cvt_pk_fp8_f32(s[4 * 33], s[5 * 33], 0, false); hi2 = __builtin_amdgcn_cvt_pk_fp8_f32(s[6 * 33], s[7 * 33], hi2, true);
            pg8::st8_wt((unsigned char*)WTv + (size_t)(nd0 + n) * K + k0 + 8 * c, (unsigned long long)(unsigned)lo | ((unsigned long long)(unsigned)hi2 << 32)); }
        else { u32x4 o; o.x = pg8::cvt_pk_bf16(s[0 * 33], s[1 * 33]); o.y = pg8::cvt_pk_bf16(s[2 * 33], s[3 * 33]); o.z = pg8::cvt_pk_bf16(s[4 * 33], s[5 * 33]); o.w = pg8::cvt_pk_bf16(s[6 * 33], s[7 * 33]);
            pg8::st16<0>((bf16_t*)WTv + (size_t)(nd0 + n) * K + k0 + 8 * c, o); } }
    LDS_WAIT(); asm volatile("" ::: "memory");
}
__device__ __forceinline__ void p0_fused_pool_item(const float* w_in, const float* g_mix, const float* w_pool, const float* pool_scale, bf16_t* WIN_T, int item, int lane) {
    const int eb = item & 7, kb = (item >> 3) & 15, g = item >> 7; const int k = kb * 64 + lane, e0 = eb * 16;
    const float* ap = w_in + (size_t)k * INP + 3 * SBW + g * PGD; const float* bp = w_pool + (size_t)g * PGD * PGD + e0;
    float acc[16];
#pragma unroll
    for (int j = 0; j < 16; ++j) acc[j] = 0.f;
#pragma unroll 4
    for (int c = 0; c < PGD; ++c) { const float a = ap[c];
#pragma unroll
        for (int j = 0; j < 16; ++j) acc[j] += a * bp[c * PGD + j]; }
    const float gk = g_mix[k];
#pragma unroll
    for (int j = 0; j < 16; ++j) WIN_T[(size_t)(3 * SBW + g * PGD + e0 + j) * D + k] = (bf16_t)f2bf(acc[j] * gk * pool_scale[g * PGD + e0 + j]);
}
__device__ __forceinline__ void p0_row(const float* xrow, bf16_t* orow, float* rstd, int lane) {
    const f32x4* xr = (const f32x4*)xrow + 2 * lane; f32x4 v[4]; float s = 0.f;
#pragma unroll
    for (int j = 0; j < 4; ++j) { v[j] = xr[(j >> 1) * 128 + (j & 1)]; s += (v[j].x * v[j].x + v[j].y * v[j].y) + (v[j].z * v[j].z + v[j].w * v[j].w); }
    s = pg8::wsum(s); if (lane == 0) *rstd = 1.0f / sqrtf(s * (1.0f / D) + EPS);
#pragma unroll
    for (int j = 0; j < 2; ++j) { u32x4 o; o.x = pg8::cvt_pk_bf16(v[2 * j].x, v[2 * j].y); o.y = pg8::cvt_pk_bf16(v[2 * j].z, v[2 * j].w); o.z = pg8::cvt_pk_bf16(v[2 * j + 1].x, v[2 * j + 1].y); o.w = pg8::cvt_pk_bf16(v[2 * j + 1].z, v[2 * j + 1].w);
        pg8::st16<0>(orow + j * 512 + 8 * lane, o); }
}
__device__ __forceinline__ void p0_prologue(const Args& a, LAS unsigned char* lds, int vcu, int G, int wave, int lane) {
    unsigned char* ws = a.ws;
    LAS float* scr = (LAS float*)(lds + RING_OFF + wave * 16384);
    const int gw = vcu * NWAVES + wave, NGW = G * NWAVES;
    constexpr int I_E1 = (D / 64) * (2 * DFF / 32), I_E2 = (DFF / 64) * (D / 32);
    constexpr int I_IN = (D / 64) * (3 * SBW / 32), I_FP = PG * 16 * 8, I_SQ = (D / 64) * (D / 32), I_KV = (D / 64) * (2 * D / 32), I_P = (PGD / 64) * (PGD / 32);
    constexpr int N1 = NE * I_E1, N2 = NE * I_E2, NITEMS = N1 + N2 + I_IN + 3 * I_SQ + I_KV + I_FP;
    const int BIG = 1 << 30;
    for (int it = gw; it < NITEMS; it += NGW) {
        int r = it;
        if (r < N1 + N2 && r >= N1 + N2 - P0_DEFER - P2_DEFER) continue;
        if (r < N1) { const int e = r / I_E1; p0_item<true>(a.in[17] + (size_t)e * D * 2 * DFF, D, 2 * DFF, ws + WS_W1 + (size_t)e * 2 * DFF * D, a.in[14], nullptr, BIG, nullptr, 1, scr, r % I_E1, lane, WSCALE); continue; } r -= N1;
        if (r < N2) { const int e = r / I_E2; p0_item<true>(a.in[19] + (size_t)e * DFF * D, DFF, D, ws + WS_W2 + (size_t)e * D * DFF, nullptr, nullptr, BIG, nullptr, 0, scr, r % I_E2, lane, WSCALE); continue; } r -= N2;
        if (r < I_IN) { p0_item<false>(a.in[3], D, INP, (bf16_t*)(ws + WS_WIN), a.in[2], nullptr, BIG, nullptr, 0, scr, r, lane, 1.0f, 3 * SBW / 32); continue; } r -= I_IN;
        if (r < I_SQ) { p0_item<false>(a.in[8], D, D, (bf16_t*)(ws + WS_WOUT), a.in[4], a.in[5], SBW, nullptr, 0, scr, r, lane); continue; } r -= I_SQ;
        if (r < I_SQ) { p0_item<true>(a.in[11], D, D, ws + WS_WQ, a.in[9], nullptr, BIG, nullptr, 0, scr, r, lane, WSCALE); continue; } r -= I_SQ;
        if (r < I_KV) { p0_item<false>(a.in[12], D, 2 * D, (bf16_t*)(ws + WS_WKV), a.in[10], nullptr, BIG, nullptr, 0, scr, r, lane); continue; } r -= I_KV;
        if (r < I_SQ) { p0_item<true>(a.in[13], D, D, ws + WS_WO, nullptr, nullptr, BIG, nullptr, 0, scr, r, lane, WSCALE); continue; } r -= I_SQ;
        p0_fused_pool_item(a.in[3], a.in[2], a.in[6], a.in[7], (bf16_t*)(ws + WS_WIN), r, lane);
    }
    for (int m = gw; m < NTOK; m += NGW) p0_row(a.in[0] + (size_t)m * D, (bf16_t*)(ws + WS_S0) + (size_t)m * D, (float*)(ws + WS_RSTDX) + m, lane);
    for (int m = gw; m < NMROWS; m += NGW) p0_row(a.in[1] + (size_t)m * D, (bf16_t*)(ws + WS_MEMB) + (size_t)m * D, (float*)(ws + WS_RSTDM) + m, lane);
    const int gt = gw * 64 + lane, NGT = NGW * 64;
    for (int i = gt; i < INP; i += NGT) ((float*)(ws + WS_CSG1))[i] = (i < SBW) ? C2_SB : 1.0f;
    for (int i = gt; i < NE * D; i += NGT) { const int e = i / D, k = i % D; const float v = a.in[14][k] * a.in[15][k * NE + e];
        ((float*)(ws + WS_WR))[i] = v; const unsigned h = f2bf(v); ((bf16_t*)(ws + WS_WRH))[i] = (bf16_t)h; ((bf16_t*)(ws + WS_WRL))[i] = (bf16_t)f2bf(v - bf2f((bf16_t)h)); }
}

__device__ __forceinline__ void p1_deferred_items(const Args& a, LAS unsigned char* lds, int rank  , int wave, int lane) {
    constexpr int I_E2 = (DFF / 64) * (D / 32), N2 = NE * I_E2;
    LAS float* scr = (LAS float*)(lds + RING_OFF + wave * 16384);
    for (int k = 0; k < P0_DEFER / (192 * 8); ++k) { const int r = N2 - P0_DEFER + (k * 192 + rank) * 8 + wave; const int e = r / I_E2;
        p0_item<true>(a.in[19] + (size_t)e * DFF * D, DFF, D, a.ws + WS_W2 + (size_t)e * D * DFF, nullptr, nullptr, 1 << 30, nullptr, 0, scr, r % I_E2, lane, WSCALE); }
}
__device__ __forceinline__ void p2_deferred_item(const Args& a, LAS unsigned char* region, int it, int lane) {
    constexpr int I_E1 = (D / 64) * (2 * DFF / 32), I_E2 = (DFF / 64) * (D / 32), N1 = NE * I_E1, N2 = NE * I_E2;
    static_assert(N1 + N2 - P0_DEFER - P2_DEFER >= 0 && P0_DEFER <= N2, "deferred ranges");
    int r = N1 + N2 - P0_DEFER - P2_DEFER + it;
    if (r < N1) { const int e = r / I_E1; p0_item<true>(a.in[17] + (size_t)e * D * 2 * DFF, D, 2 * DFF, a.ws + WS_W1 + (size_t)e * 2 * DFF * D, a.in[14], nullptr, 1 << 30, nullptr, 1, (LAS float*)region, r % I_E1, lane, WSCALE); return; }
    r -= N1; const int e = r / I_E2;
    p0_item<true>(a.in[19] + (size_t)e * DFF * D, DFF, D, a.ws + WS_W2 + (size_t)e * D * DFF, nullptr, nullptr, 1 << 30, nullptr, 0, (LAS float*)region, r % I_E2, lane, WSCALE);
}
struct SchedP1 {
    int G, c; unsigned char* ws;
    __device__ __forceinline__ bool next(int i, pg8::Unit& u) const {
        const int L = i * G + c; constexpr int NQ = (NTOK / 256) * (INP / 256);
        if (L >= NQ + 64) return false;
        if (L < NQ) { int pm, pn; pg8::grouped_mn(pg8::xcd_remap(L, NQ), NTOK / 256, INP / 256, pm, pn);
            u.A = (const char*)(ws + WS_S0) + (size_t)pm * 256 * D * 2; u.B = (const char*)(ws + WS_WIN) + (size_t)pn * 256 * D * 2;
            u.p0 = (bf16_t*)(ws + WS_QKVU) + (size_t)pm * 256 * INP + pn * 256; u.p1 = (float*)(ws + WS_RSTDX) + pm * 256; u.p2 = (float*)(ws + WS_CSG1) + pn * 256; u.i0 = INP; u.pm = pm; u.pn = pn; }
        else if (((L - NQ) >> 3) < 4) { const int k = L - NQ, pm = k & 7, pn = k >> 3;
            u.A = (const char*)(ws + WS_MEMB) + (size_t)pm * 256 * D * 2; u.B = (const char*)(ws + WS_WKV) + (size_t)pn * 256 * D * 2;
            u.p0 = (bf16_t*)(ws + WS_KM) + (size_t)pm * 256 * D + pn * 256; u.p1 = (float*)(ws + WS_RSTDM) + pm * 256; u.p2 = nullptr; u.i0 = D; u.pm = pm; u.pn = pn; }
        else { const int v = L - NQ, b = v & 7, dt = (v >> 3) - 4;
            u.A = (const char*)(ws + WS_WKV) + (size_t)(D + dt * 256) * D * 2; u.B = (const char*)(ws + WS_MEMB) + (size_t)b * 256 * D * 2;
            u.p0 = (bf16_t*)(ws + WS_VMT) + ((size_t)b * D + dt * 256) * NMEM; u.p1 = nullptr; u.p2 = (float*)(ws + WS_RSTDM) + b * 256; u.i0 = NMEM; u.pm = dt; u.pn = b; }
        u.p3 = nullptr; u.i1 = 0; return true;
    }
};
#define EPI_BAR() asm volatile("s_waitcnt lgkmcnt(0)\n\ts_barrier" ::: "memory")
struct SchedReg {
    int G, c, nM, nN; const char* A; const char* B; size_t astep, bstep; bf16_t* O; int ldc; const float* rs; const float* cs; const ssq_t* sq = nullptr;
    __device__ __forceinline__ bool next(int i, pg8::Unit& u) const {
        const int L = i * G + c; if (L >= nM * nN) return false; int pm, pn; pg8::grouped_mn(pg8::xcd_remap(L, nM * nN), nM, nN, pm, pn);
        u.A = A + (size_t)pm * astep; u.B = B + (size_t)pn * bstep; u.pm = pm; u.pn = pn; u.i0 = ldc; u.i1 = 0;
        u.p0 = O ? (void*)(O + (size_t)pm * 256 * ldc + pn * 256) : nullptr; u.p1 = sq ? (void*)(sq + pm * 256) : (rs ? (void*)(rs + pm * 256) : nullptr); u.p2 = cs ? (void*)(cs + pn * 256) : nullptr; u.p3 = nullptr; return true;
    }
};
struct EpiBf16Ssq {
    static constexpr bool PERM = true; static constexpr int MIDK = -1; float inv_n, mult; bf16_t* qt;
    __device__ __forceinline__ void midk(f32x4 (&)[2][2][4][2], const pg8::Unit&, int, int) const {}
    __device__ __forceinline__ void operator()(f32x4 (&acc)[2][2][4][2], const pg8::Unit& u, int wr, int wc, int fr, int fq, int, int, LAS unsigned char*) const {
        bf16_t* O = qt + (size_t)(u.pm * 4 + u.pn) * 65536; const ssq_t* sq = (const ssq_t*)u.p1; const int ldc = u.i0; int r0 = wr * 64 + fr, c0 = wc * 32 + 8 * fq; asm volatile("" : "+v"(r0), "+v"(c0));
#pragma unroll
        for (int ai = 0; ai < 2; ++ai)
#pragma unroll
            for (int m = 0; m < 4; ++m) { const int r = r0 + ai * 128 + m * 16; const float rv = mult / sqrtf(ssq_get(sq + r) * inv_n + EPS); bf16_t* rowp = O + ((size_t)((c0 >> 4) * 256 + r) * 2 + ((c0 >> 3) & 1)) * 8;
#pragma unroll
                for (int bj = 0; bj < 2; ++bj) { const f32x4 v0 = acc[ai][bj][m][0] * rv, v1 = acc[ai][bj][m][1] * rv;
                    u32x4 w; w.x = pg8::cvt_pk_bf16(v0[0], v0[1]); w.y = pg8::cvt_pk_bf16(v0[2], v0[3]); w.z = pg8::cvt_pk_bf16(v1[0], v1[1]); w.w = pg8::cvt_pk_bf16(v1[2], v1[3]);
                    pg8::st16<5>(rowp + bj * (8 * 256 * 2 * 8), w); } }
    }
};
template <int MIDK_, bool XIN_BF16, bool F8OUT> struct EpiResid {
    static constexpr bool PERM = true; static constexpr int MIDK = MIDK_;
    const float* xin; bf16_t* xb; unsigned char* x8; ssq_t* ssq; const ssq_t* ssq_mid; float accs;
    __device__ __forceinline__ void midk(f32x4 (&acc)[2][2][4][2], const pg8::Unit& u, int wr, int fr) const {
#pragma unroll
        for (int ai = 0; ai < 2; ++ai)
#pragma unroll
            for (int m = 0; m < 4; ++m) { const int r = u.pm * 256 + ai * 128 + wr * 64 + m * 16 + fr; const float s = 1.0f / sqrtf(ssq_get(ssq_mid + r) * (1.0f / SBW) + EPS);
#pragma unroll
                for (int bj = 0; bj < 2; ++bj)
#pragma unroll
                    for (int n = 0; n < 2; ++n) acc[ai][bj][m][n] *= s; }
    }
    __device__ __forceinline__ void operator()(f32x4 (&acc)[2][2][4][2], const pg8::Unit& u, int wr, int wc, int fr, int fq, int, int, LAS unsigned char*) const {
        int row0 = u.pm * 256 + wr * 64 + fr, col0 = u.pn * 256 + wc * 32 + 8 * fq; asm volatile("" : "+v"(row0), "+v"(col0));
        u32x4 xv[2][4][2]; f32x4 xf[XIN_BF16 ? 1 : 2][XIN_BF16 ? 1 : 4][XIN_BF16 ? 1 : 2][2];
#pragma unroll
        for (int ai = 0; ai < 2; ++ai)
#pragma unroll
            for (int m = 0; m < 4; ++m)
#pragma unroll
                for (int bj = 0; bj < 2; ++bj) { const size_t o2 = (size_t)(row0 + ai * 128 + m * 16) * D + col0 + bj * 128;
                    if constexpr (XIN_BF16) xv[ai][m][bj] = *(const u32x4*)(xb + o2); else { xf[ai][m][bj][0] = *(const f32x4*)(xin + o2); xf[ai][m][bj][1] = *(const f32x4*)(xin + o2 + 4); } }
#pragma unroll
        for (int ai = 0; ai < 2; ++ai)
#pragma unroll
            for (int mp = 0; mp < 4; mp += 2) { unsigned w8[2][2][2];
#pragma unroll
              for (int mq = 0; mq < 2; ++mq) { const int m = mp + mq; const int r = row0 + ai * 128 + m * 16; const size_t off = (size_t)r * D + col0; float q = 0.f;
#pragma unroll
                for (int bj = 0; bj < 2; ++bj) { const size_t o2 = off + bj * 128; f32x4 o0, o1;
                    if constexpr (XIN_BF16) { const u32x4 x4 = xv[ai][m][bj];
                        o0 = (f32x4){__builtin_bit_cast(float, x4.x << 16), __builtin_bit_cast(float, x4.x & 0xffff0000u), __builtin_bit_cast(float, x4.y << 16), __builtin_bit_cast(float, x4.y & 0xffff0000u)};
                        o1 = (f32x4){__builtin_bit_cast(float, x4.z << 16), __builtin_bit_cast(float, x4.z & 0xffff0000u), __builtin_bit_cast(float, x4.w << 16), __builtin_bit_cast(float, x4.w & 0xffff0000u)}; }
                    else { o0 = xf[ai][m][bj][0]; o1 = xf[ai][m][bj][1]; }
                    o0 += acc[ai][bj][m][0] * accs; o1 += acc[ai][bj][m][1] * accs;
                    q += (o0[0] * o0[0] + o0[1] * o0[1]) + (o0[2] * o0[2] + o0[3] * o0[3]) + (o1[0] * o1[0] + o1[1] * o1[1]) + (o1[2] * o1[2] + o1[3] * o1[3]);
                    if constexpr (F8OUT) { int w0 = __builtin_amdgcn_cvt_pk_fp8_f32(o0[0], o0[1], 0, false); w0 = __builtin_amdgcn_cvt_pk_fp8_f32(o0[2], o0[3], w0, true);
                        int w1 = __builtin_amdgcn_cvt_pk_fp8_f32(o1[0], o1[1], 0, false); w1 = __builtin_amdgcn_cvt_pk_fp8_f32(o1[2], o1[3], w1, true);
                        w8[mq][bj][0] = (unsigned)w0; w8[mq][bj][1] = (unsigned)w1; }
                    u32x4 w; w.x = pg8::cvt_pk_bf16(o0[0], o0[1]); w.y = pg8::cvt_pk_bf16(o0[2], o0[3]); w.z = pg8::cvt_pk_bf16(o1[0], o1[1]); w.w = pg8::cvt_pk_bf16(o1[2], o1[3]); pg8::st16<4>(xb + o2, w); }
                q += pg8::swz_xor<16>(q); q = pg8::half_sum(q);
                if (fq == 0) ssq_add(ssq + r, q); }
              if constexpr (F8OUT) { const int odd = fq & 1; const size_t o8 = (size_t)(row0 + ai * 128 + (mp + odd) * 16) * D + col0 - 8 * odd;
#pragma unroll
                for (int bj = 0; bj < 2; ++bj) { const auto sl = __builtin_amdgcn_permlane16_swap(w8[0][bj][0], w8[1][bj][0], false, false), sh = __builtin_amdgcn_permlane16_swap(w8[0][bj][1], w8[1][bj][1], false, false);
                    *(u32x4*)(x8 + o8 + bj * 128) = (u32x4){sl[0], sh[0], sl[1], sh[1]}; } } }
    }
};
struct SchedMS {
    int G, c; unsigned char* ws;
    __device__ __forceinline__ bool next(int i, pg8::Unit& u) const {
        const int L = i * G + c; constexpr int NU = (NTOK / 256) * MH; if (L >= NU) return false; int pm, h; pg8::grouped_mn(pg8::xcd_remap(L, NU), NTOK / 256, MH, pm, h); const int b = pm >> 4;
        u.A = (const char*)(ws + WS_QM) + ((size_t)pm * 256 * D + h * MHD) * 2; u.B = (const char*)(ws + WS_KM) + ((size_t)b * NMEM * D + h * MHD) * 2;
        u.p0 = (bf16_t*)(ws + WS_PM) + (size_t)pm * 256 * D + h * NMEM; u.p1 = nullptr; u.p2 = nullptr; u.p3 = nullptr; u.i0 = D; u.i1 = 0; u.pm = pm; u.pn = h; return true;
    }
};
struct EpiSoftmax {
    static constexpr bool PERM = true; static constexpr int MIDK = -1;
    __device__ __forceinline__ void midk(f32x4 (&)[2][2][4][2], const pg8::Unit&, int, int) const {}
    __device__ __forceinline__ void operator()(f32x4 (&acc)[2][2][4][2], const pg8::Unit& u, int wr, int wc, int fr, int fq, int, int, LAS unsigned char* xl) const {
        typedef float f32x2v __attribute__((ext_vector_type(2)));
        LAS f32x2v* X = (LAS f32x2v*)xl;
        float ml[2][4];
#pragma unroll
        for (int ai = 0; ai < 2; ++ai)
#pragma unroll
            for (int m = 0; m < 4; ++m) { float mx = -INFINITY;
#pragma unroll
                for (int bj = 0; bj < 2; ++bj)
#pragma unroll
                    for (int n = 0; n < 2; ++n) { const f32x4 v = acc[ai][bj][m][n]; mx = fmaxf(fmaxf(mx, fmaxf(v[0], v[1])), fmaxf(v[2], v[3])); }
                mx = fmaxf(mx, pg8::swz_xor<16>(mx)); mx = pg8::half_max(mx); ml[ai][m] = mx; float s = 0.f;
#pragma unroll
                for (int bj = 0; bj < 2; ++bj)
#pragma unroll
                    for (int n = 0; n < 2; ++n) { f32x4 v = acc[ai][bj][m][n];
#pragma unroll
                        for (int j = 0; j < 4; ++j) { v[j] = __builtin_amdgcn_exp2f(v[j] - mx); s += v[j]; }
                        acc[ai][bj][m][n] = v; }
                s += pg8::swz_xor<16>(s); s = pg8::half_sum(s);
                if (fq == 0) X[(ai * 128 + wr * 64 + m * 16 + fr) * 4 + wc] = (f32x2v){mx, s}; }
        EPI_BAR();
        bf16_t* O = (bf16_t*)u.p0; const int ldc = u.i0; int r0 = wr * 64 + fr, c0 = wc * 32 + 8 * fq; asm volatile("" : "+v"(r0), "+v"(c0));
#pragma unroll
        for (int ai = 0; ai < 2; ++ai)
#pragma unroll
            for (int m = 0; m < 4; ++m) { const int r = r0 + ai * 128 + m * 16; const f32x2v a = X[r * 4 + 0], b = X[r * 4 + 1], c = X[r * 4 + 2], d = X[r * 4 + 3];
                const float M = fmaxf(fmaxf(a.x, b.x), fmaxf(c.x, d.x));
                const float tot = a.y * __builtin_amdgcn_exp2f(a.x - M) + b.y * __builtin_amdgcn_exp2f(b.x - M) + c.y * __builtin_amdgcn_exp2f(c.x - M) + d.y * __builtin_amdgcn_exp2f(d.x - M);
                const float f = __builtin_amdgcn_exp2f(ml[ai][m] - M) / tot; bf16_t* rowp = O + (size_t)r * ldc + c0;
#pragma unroll
                for (int bj = 0; bj < 2; ++bj) { const f32x4 v0 = acc[ai][bj][m][0] * f, v1 = acc[ai][bj][m][1] * f;
                    u32x4 w; w.x = pg8::cvt_pk_bf16(v0[0], v0[1]); w.y = pg8::cvt_pk_bf16(v0[2], v0[3]); w.z = pg8::cvt_pk_bf16(v1[0], v1[1]); w.w = pg8::cvt_pk_bf16(v1[2], v1[3]);
                    pg8::st16<6>(rowp + bj * 128, w); } }
    }
};
struct SchedPV {
    int G, c; unsigned char* ws;
    __device__ __forceinline__ bool next(int i, pg8::Unit& u) const {
        const int L = i * G + c; constexpr int NU = (NTOK / 256) * MH; if (L >= NU) return false; int pm, h; pg8::grouped_mn(pg8::xcd_remap(L, NU), NTOK / 256, MH, pm, h); const int b = pm >> 4;
        u.A = (const char*)(ws + WS_PM) + ((size_t)pm * 256 * D + h * NMEM) * 2; u.B = (const char*)(ws + WS_VMT) + ((size_t)b * D + h * MHD) * NMEM * 2;
        u.p0 = (bf16_t*)(ws + WS_OM) + (size_t)pm * 256 * D + h * MHD; u.p1 = nullptr; u.p2 = nullptr; u.p3 = nullptr; u.i0 = D; u.i1 = 0; u.pm = pm; u.pn = h; return true;
    }
};

__device__ __forceinline__ void p8_preload(const Args& a, LAS unsigned char* lds, int wave, int lane) {
    const bf16_t* WRH = (const bf16_t*)(a.ws + WS_WRH); constexpr int WPITCH = 2064; const int tid = wave * 64 + lane;
    u32x4 v[8];
#pragma unroll
    for (int i = 0; i < 8; ++i) v[i] = *(const u32x4*)(WRH + (size_t)(tid + i * 512) * 8);
#pragma unroll
    for (int i = 0; i < 8; ++i) { const int c = tid + i * 512; *(LAS u32x4*)(lds + RING_OFF + (c >> 7) * WPITCH + (c & 127) * 16) = v[i]; }
    LDS_WAIT();
}
template <bool PRELOADED = false>
__device__ __forceinline__ void p8_route(const Args& a, LAS unsigned char* lds, int bx, int G, int wave, int lane, int* CNT) {
    unsigned char* ws = a.ws; const bf16_t* x2 = (const bf16_t*)(ws + WS_S0); const ssq_t* SSQ2 = (const ssq_t*)(ws + MK_SSQ2); const float* br = a.in[16];
    const bf16_t* WRH = (const bf16_t*)(ws + WS_WRH);
    int* LSLOT = (int*)(ws + WS_LSLOT); float* LGATE = (float*)(ws + WS_LGATE); float* LRS = (float*)(ws + WS_LRS);
    constexpr int WPITCH = 2064;
    LAS float* LG = (LAS float*)(lds + RING_OFF + 69632) + wave * 16 * 33;
    LAS int* hist = (LAS int*)(lds + RING_OFF + 90112); LAS int* base = hist + 32;
    const int tid = wave * 64 + lane;
    if constexpr (!PRELOADED) { u32x4 v[8];
#pragma unroll
      for (int i = 0; i < 8; ++i) v[i] = *(const u32x4*)(WRH + (size_t)(tid + i * 512) * 8);
#pragma unroll
      for (int i = 0; i < 8; ++i) { const int c = tid + i * 512; *(LAS u32x4*)(lds + RING_OFF + (c >> 7) * WPITCH + (c & 127) * 16) = v[i]; } }
    LDS_WAIT(); __syncthreads();
    for (int t0 = bx * 128; t0 < NTOK; t0 += G * 128) {
        if (tid < 32) hist[tid] = 0;
        const int r16 = lane & 15, kq = lane >> 4; const int trow = t0 + wave * 16 + r16;
        const bf16_t* xp = x2 + (size_t)trow * D + kq * 8;
        bf16x8 ah[32];
#pragma unroll
        for (int ks = 0; ks < 32; ++ks) ah[ks] = *(const bf16x8*)(xp + ks * 32);
        f32x4 acc[2] = {(f32x4){0.f, 0.f, 0.f, 0.f}, (f32x4){0.f, 0.f, 0.f, 0.f}};
        const LAS unsigned char* wp = lds + RING_OFF + r16 * WPITCH + kq * 16;
#pragma unroll
        for (int ks = 0; ks < 32; ++ks) {
#pragma unroll
            for (int nb = 0; nb < 2; ++nb) { const bf16x8 bh = *(const LAS bf16x8*)(wp + nb * 16 * WPITCH + ks * 64);
                acc[nb] = __builtin_amdgcn_mfma_f32_16x16x32_bf16(ah[ks], bh, acc[nb], 0, 0, 0); } }
#pragma unroll
        for (int nb = 0; nb < 2; ++nb)
#pragma unroll
            for (int r = 0; r < 4; ++r) { const int tl = kq * 4 + r; const int tk = t0 + wave * 16 + tl; const float rs = 1.0f / sqrtf(ssq_get(SSQ2 + tk) * (1.0f / D) + EPS);
                LG[tl * 33 + nb * 16 + r16] = acc[nb][r] * rs + br[nb * 16 + r16]; }
        LDS_WAIT(); __syncthreads();
        int te[4] = {0, 0, 0, 0}; float tg[4] = {0.f, 0.f, 0.f, 0.f}; int rk[4] = {0, 0, 0, 0};
        if (lane < 16) {
            float tv[4] = {-INFINITY, -INFINITY, -INFINITY, -INFINITY};
            for (int e = 0; e < NE; ++e) { const float v = LG[lane * 33 + e];
                if (v > tv[3]) { if (v > tv[2]) { tv[3] = tv[2]; te[3] = te[2]; if (v > tv[1]) { tv[2] = tv[1]; te[2] = te[1]; if (v > tv[0]) { tv[1] = tv[0]; te[1] = te[0]; tv[0] = v; te[0] = e; } else { tv[1] = v; te[1] = e; } } else { tv[2] = v; te[2] = e; } } else { tv[3] = v; te[3] = e; } } }
            float gs = 0.f;
#pragma unroll
            for (int k = 0; k < 4; ++k) { tg[k] = __expf(tv[k] - tv[0]); gs += tg[k]; }
            gs = 1.0f / gs;
#pragma unroll
            for (int k = 0; k < 4; ++k) { tg[k] *= gs; rk[k] = __hip_atomic_fetch_add(hist + te[k], 1, __ATOMIC_RELAXED, __HIP_MEMORY_SCOPE_WORKGROUP); }
        }
        LDS_WAIT(); __syncthreads();
        if (tid < 32) { const int n = hist[tid]; base[tid] = n ? atomicAdd(CNT + tid, n) : 0; }
        LDS_WAIT(); __syncthreads();
        if (lane < 16) { const int tk = t0 + wave * 16 + lane; const float rsw = (1.0f / WSCALE) / sqrtf(ssq_get(SSQ2 + tk) * (1.0f / D) + EPS);
#pragma unroll
            for (int k = 0; k < 4; ++k) { const size_t p = (size_t)te[k] * LCAP + base[te[k]] + rk[k]; pg8::st4_wt(LSLOT + p, (unsigned)(tk * 4 + k)); pg8::st4_wt(LGATE + p, __float_as_uint(tg[k])); pg8::st4_wt(LRS + p, __float_as_uint(rsw)); } }
        LDS_WAIT(); __syncthreads();
    }
}

__device__ __forceinline__ void moe_table(const Args& a, volatile LAS unsigned* MISC, int tid) {
    const int* CNT = (const int*)(a.ws + OFF_CNT);
    if (tid < 32) MISC[16 + tid] = (unsigned)CNT[tid];
    LDS_WAIT(); __syncthreads();
    if (tid == 0) { unsigned tb = 0; for (int e = 0; e < NE; ++e) { MISC[48 + e] = tb; tb += (MISC[16 + e] + 255u) >> 8; } MISC[48 + NE] = tb; }
    LDS_WAIT(); __syncthreads();
}
template <int NPN, bool W1> struct SchedMoE {
    int G, c; unsigned char* ws; volatile LAS unsigned* MISC; const float* bias;
    __device__ __forceinline__ bool next(int i, pg8::Unit& u) const {
        unsigned mb_ = (unsigned)(uintptr_t)MISC; asm volatile("" : "+s"(mb_)); const LAS unsigned* M = (const LAS unsigned*)(uintptr_t)mb_;
        const int T = __builtin_amdgcn_readfirstlane((int)M[48 + NE]); const int NU = T * NPN; const int L = i * G + c; if (L >= NU) return false;
        const int w = pg8::xcd_remap(L, NU);
        int e = 0;
#pragma unroll
        for (int s = 16; s >= 1; s >>= 1) { if ((int)M[48 + e + s] * NPN <= w) e += s; }
        e = __builtin_amdgcn_readfirstlane(e);
        const int tb = __builtin_amdgcn_readfirstlane((int)M[48 + e]), cnt = __builtin_amdgcn_readfirstlane((int)M[16 + e]), nte = (cnt + 255) >> 8; const int idx = w - tb * NPN, mt = __builtin_amdgcn_readfirstlane(idx / NPN), pn = idx - mt * NPN;     (void)nte;
        u.pm = tb + mt; u.pn = pn; u.i1 = e; const int nv = cnt - mt * 256; u.i0 = nv < 256 ? nv : 256;
        u.p3 = (int*)(ws + WS_LSLOT) + (size_t)e * LCAP + mt * 256; u.p2 = (float*)(ws + (W1 ? WS_LRS : WS_LGATE)) + (size_t)e * LCAP + mt * 256; u.p0 = nullptr;
        u.p1 = W1 ? (void*)(bias + (size_t)e * 2 * DFF + pn * 128) : (void*)(bias + (size_t)e * D + pn * 256);
        if (W1) { u.A = (const char*)(ws + WS_X2F8); u.B = (const char*)(ws + WS_W1) + ((size_t)e * 2 * DFF + pn * 256) * D; }
        else { u.A = (const char*)(ws + WS_ACT) + (size_t)(tb + mt) * 256 * DFF; u.B = (const char*)(ws + WS_W2) + ((size_t)e * D + pn * 256) * DFF; }
        return true;
    }
};
typedef float f32x2 __attribute__((ext_vector_type(2)));
struct EpiSwiGLU {
    static constexpr bool PERM = true; static constexpr int MIDK = -1; unsigned char* act;
    __device__ __forceinline__ void midk(f32x4 (&)[2][2][4][2], const pg8::Unit&, int, int) const {}
    __device__ __forceinline__ void operator()(f32x4 (&acc)[2][2][4][2], const pg8::Unit& u, int wr, int wc, int fr, int fq, int, int, LAS unsigned char* tab) const {
        const int nvalid = u.i0; const LAS float* T1 = (const LAS float*)tab + 256; const LAS float* T2 = (const LAS float*)tab + 512;
        int r0 = wr * 64 + fr, c0 = wc * 32 + 8 * fq; asm volatile("" : "+v"(r0), "+v"(c0)); const int odd = fq & 1; const int gc0 = u.pn * 128 + c0 - 8 * odd;
        f32x4 bg[2], bu[2];
#pragma unroll
        for (int n = 0; n < 2; ++n) { bg[n] = *(const LAS f32x4*)(T2 + c0 + 4 * n); bu[n] = *(const LAS f32x4*)(T2 + 128 + c0 + 4 * n); }
#pragma unroll
        for (int ai = 0; ai < 2; ++ai)
#pragma unroll
            for (int mp = 0; mp < 4; mp += 2) { unsigned wv[2][2];
#pragma unroll
              for (int mq = 0; mq < 2; ++mq) { const int m = mp + mq; const int r = r0 + ai * 128 + m * 16; const float rs = T1[r];
#pragma unroll
                for (int n = 0; n < 2; ++n) { f32x2 o[2];
#pragma unroll
                    for (int h = 0; h < 2; ++h) { f32x2 g = (f32x2){acc[ai][0][m][n][2 * h], acc[ai][0][m][n][2 * h + 1]} * rs + (f32x2){bg[n][2 * h], bg[n][2 * h + 1]};
                        f32x2 up = (f32x2){acc[ai][1][m][n][2 * h], acc[ai][1][m][n][2 * h + 1]} * rs + (f32x2){bu[n][2 * h], bu[n][2 * h + 1]};
                        g.x = fminf(g.x, SW_LIMIT); g.y = fminf(g.y, SW_LIMIT); up.x = fminf(fmaxf(up.x, -SW_LIMIT), SW_LIMIT); up.y = fminf(fmaxf(up.y, -SW_LIMIT), SW_LIMIT);
                        const f32x2 tt = g * (-SW_ALPHA * LOG2E); f32x2 d; d.x = __builtin_amdgcn_exp2f(tt.x); d.y = __builtin_amdgcn_exp2f(tt.y); d = d + 1.0f;
                        f32x2 rr; rr.x = __builtin_amdgcn_rcpf(d.x); rr.y = __builtin_amdgcn_rcpf(d.y);
                        o[h] = (up + 1.0f) * g * rr; }
                    int t_ = __builtin_amdgcn_cvt_pk_fp8_f32(o[0].x, o[0].y, 0, false); t_ = __builtin_amdgcn_cvt_pk_fp8_f32(o[1].x, o[1].y, t_, true); wv[mq][n] = (unsigned)t_; } }
              const int rst = r0 + ai * 128 + (mp + odd) * 16;
              const auto sl = __builtin_amdgcn_permlane16_swap(wv[0][0], wv[1][0], false, false), sh = __builtin_amdgcn_permlane16_swap(wv[0][1], wv[1][1], false, false);
              if (rst < nvalid) *(u32x4*)(act + ((size_t)u.pm * 256 + rst) * DFF + gc0) = (u32x4){sl[0], sh[0], sl[1], sh[1]}; }
    }
};
struct EpiW2 {
    static constexpr bool PERM = true; static constexpr int MIDK = -1; unsigned char* Y;
    __device__ __forceinline__ void midk(f32x4 (&)[2][2][4][2], const pg8::Unit&, int, int) const {}
    __device__ __forceinline__ void operator()(f32x4 (&acc)[2][2][4][2], const pg8::Unit& u, int wr, int wc, int fr, int fq, int, int, LAS unsigned char* tab) const {
        const int nvalid = u.i0; const LAS unsigned* T0 = (const LAS unsigned*)tab; const LAS float* T1 = (const LAS float*)tab + 256; const LAS float* T2 = (const LAS float*)tab + 512;
        int r0 = wr * 64 + fr, cl = wc * 32 + 8 * fq; asm volatile("" : "+v"(r0), "+v"(cl)); const int odd = fq & 1; const int c0 = u.pn * 256 + cl - 8 * odd;
        f32x4 bv[2][2];
#pragma unroll
        for (int bj = 0; bj < 2; ++bj)
#pragma unroll
            for (int n = 0; n < 2; ++n) bv[bj][n] = *(const LAS f32x4*)(T2 + cl + bj * 128 + 4 * n);
#pragma unroll
        for (int ai = 0; ai < 2; ++ai)
#pragma unroll
            for (int mp = 0; mp < 4; mp += 2) { const int ra = r0 + ai * 128 + mp * 16; const float ga = T1[ra], gb = T1[ra + 16];
                const int rst = ra + 16 * odd; const bool valid = rst < nvalid; const unsigned slot = T0[rst];
#pragma unroll
                for (int bj = 0; bj < 2; ++bj) { unsigned w[2][2];
#pragma unroll
                    for (int q = 0; q < 2; ++q) { const float g = q ? gb : ga; const f32x4 v0 = (acc[ai][bj][mp + q][0] * (1.0f / WSCALE) + bv[bj][0]) * g, v1 = (acc[ai][bj][mp + q][1] * (1.0f / WSCALE) + bv[bj][1]) * g;
                        int w0 = __builtin_amdgcn_cvt_pk_fp8_f32(v0[0], v0[1], 0, false); w0 = __builtin_amdgcn_cvt_pk_fp8_f32(v0[2], v0[3], w0, true);
                        int w1 = __builtin_amdgcn_cvt_pk_fp8_f32(v1[0], v1[1], 0, false); w1 = __builtin_amdgcn_cvt_pk_fp8_f32(v1[2], v1[3], w1, true); w[q][0] = (unsigned)w0; w[q][1] = (unsigned)w1; }
                    const auto sl = __builtin_amdgcn_permlane16_swap(w[0][0], w[1][0], false, false), sh = __builtin_amdgcn_permlane16_swap(w[0][1], w[1][1], false, false);
                    if (valid) *(u32x4*)(Y + (size_t)slot * D + c0 + bj * 128) = (u32x4){sl[0], sh[0], sl[1], sh[1]}; } }
    }
};

__device__ __forceinline__ void p11_final(const Args& a, int vcu, int G, int wave, int lane, float* dst) {
    const bf16_t* x2 = (const bf16_t*)(a.ws + WS_S0); const unsigned char* Y = a.ws + WS_Y; const float* gf = a.in[21];
    const int gw = vcu * NWAVES + wave, NGW = G * NWAVES;
    f32x4 g4[4];
#pragma unroll
    for (int j = 0; j < 4; ++j) g4[j] = *(const f32x4*)(gf + 16 * lane + 4 * j);
    for (int tok = gw; tok < NTOK; tok += NGW) {
        const u32x4 xa = *(const u32x4*)(x2 + (size_t)tok * D + 16 * lane), xc = *(const u32x4*)(x2 + (size_t)tok * D + 16 * lane + 8);
        u32x4 yv[4];
#pragma unroll
        for (int k = 0; k < 4; ++k) yv[k] = *(const u32x4*)(Y + ((size_t)tok * 4 + k) * D + 16 * lane);
        float v[16];
#pragma unroll
        for (int q = 0; q < 4; ++q) { v[2 * q] = __builtin_bit_cast(float, xa[q] << 16); v[2 * q + 1] = __builtin_bit_cast(float, xa[q] & 0xffff0000u); v[8 + 2 * q] = __builtin_bit_cast(float, xc[q] << 16); v[8 + 2 * q + 1] = __builtin_bit_cast(float, xc[q] & 0xffff0000u); }
#pragma unroll
        for (int k = 0; k < 4; ++k)
#pragma unroll
            for (int q = 0; q < 4; ++q) { const auto lo = __builtin_amdgcn_cvt_pk_f32_fp8((int)yv[k][q], false), hi2 = __builtin_amdgcn_cvt_pk_f32_fp8((int)yv[k][q], true);
                v[4 * q] += lo[0]; v[4 * q + 1] += lo[1]; v[4 * q + 2] += hi2[0]; v[4 * q + 3] += hi2[1]; }
        float s = 0.f;
#pragma unroll
        for (int q = 0; q < 16; ++q) s += v[q] * v[q];
        const float rs = 1.0f / sqrtf(pg8::wsum(s) * (1.0f / D) + EPS);
#pragma unroll
        for (int j = 0; j < 4; ++j) pg8::st16<8>(dst + (size_t)tok * D + 16 * lane + 4 * j, (f32x4){v[4 * j] * rs * g4[j][0], v[4 * j + 1] * rs * g4[j][1], v[4 * j + 2] * rs * g4[j][2], v[4 * j + 3] * rs * g4[j][3]});
    }
}
typedef float f32x16 __attribute__((ext_vector_type(16)));
typedef short s16x4 __attribute__((ext_vector_type(4)));
__device__ __forceinline__ int crow(int r, int hi) { return (r & 3) + 8 * (r >> 2) + 4 * hi; }
#ifndef SB_ABL
#define SB_ABL 0
#endif
#define SB_DMA(ubase, voff, ldsaddr) do { unsigned keep_; asm volatile("s_mov_b32 %0, m0\n\ts_mov_b32 m0, %3\n\ts_nop 0\n\tglobal_load_lds_dwordx4 %1, %2\n\ts_mov_b32 m0, %0" \
        : "=&s"(keep_) : "v"(voff), "s"((const char*)(ubase)), "s"(ldsaddr) : "memory"); } while (0)
__device__ __forceinline__ void sb_item(int b, int h, int qi  , const bf16_t* QKVU, bf16_t* MIXED, ssq_t* SSQSB, LAS unsigned char* wl  , int) {
    const int lane = pg8::fresh_lane();
    const int r32 = lane & 31, hi = lane >> 5;
    const size_t rowbase = (size_t)b * S; const int q0 = qi * 64;
    const bf16_t* Qw = QKVU + (rowbase + q0) * INP + h * HD;
    const char* Kh = (const char*)(QKVU + rowbase * INP + SBW + h * HD); const char* Vh = Kh + SBW * 2;
    bf16x8 qr[2][4];
#pragma unroll
    for (int s = 0; s < 2; ++s)
#pragma unroll
        for (int d0 = 0; d0 < 4; ++d0) qr[s][d0] = *(const bf16x8*)(Qw + (size_t)(s * 32 + r32) * INP + d0 * 16 + hi * 8);
    f32x16 o[2][2];
#pragma unroll
    for (int r = 0; r < 16; ++r) { o[0][0][r] = 0.f; o[0][1][r] = 0.f; o[1][0][r] = 0.f; o[1][1][r] = 0.f; }
    float carry[2] = {1.0f, 1.0f}; bool alive[2] = {true, true};
    const int jd = qi;
    const unsigned kvoff = (unsigned)lane * (INP * 2);
    const unsigned vvoff = (unsigned)(lane >> 2) * (INP * 2) + (unsigned)(lane & 3) * 16;
    const unsigned lk = (unsigned)(uintptr_t)wl, lv = lk + 8192;
#define SB_LOAD_K(j) do { const char* kb_ = Kh + (size_t)(j) * 64 * INP * 2; _Pragma("unroll") for (int c_ = 0; c_ < 8; ++c_) SB_DMA(kb_ + c_ * 16, kvoff, lk + c_ * 1024); } while (0)
#define SB_LOAD_V(j) do { const char* vb_ = Vh + (size_t)(j) * 64 * INP * 2; _Pragma("unroll") for (int c_ = 0; c_ < 8; ++c_) SB_DMA(vb_ + (size_t)(c_ & 3) * 16 * INP * 2 + (c_ >> 2) * 64, vvoff, lv + c_ * 1024); } while (0)
    SB_LOAD_K(jd); SB_LOAD_V(jd);
    if (SB_ABL == 3) asm volatile("s_waitcnt vmcnt(0)" ::: "memory");
    const LAS unsigned char* kb = wl + hi * 1024 + r32 * 16;
    const LAS unsigned char* vb = wl + 8192 + ((lane >> 4) & 1) * 32 + (lane & 3) * 8 + (4 * hi + ((lane & 15) >> 2)) * 64;
    const int jlo = (SB_ABL != 0) ? ((jd - 4 > 0) ? jd - 4 : 0) : 0;
    for (int j = jd; j >= jlo; --j) {
        if (SB_ABL != 3) asm volatile("s_waitcnt vmcnt(8)" ::: "memory"); __builtin_amdgcn_sched_barrier(0);
        bf16x8 kf[8];
#pragma unroll
        for (int d0 = 0; d0 < 4; ++d0) { kf[2 * d0] = *(const LAS bf16x8*)(kb + d0 * 2048); kf[2 * d0 + 1] = *(const LAS bf16x8*)(kb + d0 * 2048 + 512); }
        asm volatile("s_waitcnt lgkmcnt(0)" ::: "memory"); __builtin_amdgcn_sched_barrier(0);
        if (j > jlo && SB_ABL != 3) SB_LOAD_K(j - 1);
        unsigned pw[2][4][4]; bool did[2][2] = {{false, false}, {false, false}};
#pragma unroll
        for (int s = 0; s < 2; ++s) {
#pragma unroll
            for (int half = 1; half >= 0; --half) {
                if (!alive[s]) continue;
                const bool diag = (j == jd);
                if (diag && s == 0 && half == 1) continue;
                f32x16 p;
#pragma unroll
                for (int r = 0; r < 16; ++r) p[r] = 0.f;
#pragma unroll
                for (int d0 = 0; d0 < 4; ++d0) p = __builtin_amdgcn_mfma_f32_32x32x16_bf16(kf[2 * d0 + half], qr[s][d0], p, 0, 0, 0);
                const int kbase = 64 * j + 32 * half + 4 * hi; const int qabs = q0 + s * 32 + r32;
#pragma unroll
                for (int r = 0; r < 16; ++r) { const int k0 = kbase + (r & 3) + 8 * (r >> 2);
                    float e0 = __builtin_amdgcn_exp2f(fminf(p[r], 100.0f));
                    if (diag && k0 >= qabs) e0 = 0.0f;
                    p[r] = e0; }
                float A[4];
#pragma unroll
                for (int i = 0; i < 4; ++i) A[i] = ((1.0f + p[4 * i]) * (1.0f + p[4 * i + 1])) * ((1.0f + p[4 * i + 2]) * (1.0f + p[4 * i + 3]));
                float Tq = 1.0f, Q[4];
#pragma unroll
                for (int i = 3; i >= 0; --i) { const auto sw = __builtin_amdgcn_permlane32_swap(__float_as_uint(A[i]), __float_as_uint(A[i]), false, false);
                    const float partner = hi ? __uint_as_float(sw[0]) : __uint_as_float(sw[1]);
                    Q[i] = hi ? Tq : Tq * partner; Tq = Tq * (A[i] * partner); }
                const float cin = carry[s];
#pragma unroll
                for (int i = 0; i < 4; ++i) { const float x0 = p[4 * i], x1 = p[4 * i + 1], x2 = p[4 * i + 2], x3 = p[4 * i + 3];
                    const float R0 = cin * __builtin_amdgcn_rcpf(A[i] * Q[i]);
                    const float R1 = R0 * (1.0f + x0), R2 = R1 * (1.0f + x1), R3 = R2 * (1.0f + x2);
                    pw[s][2 * half + (i >> 1)][(i & 1) * 2] = pg8::cvt_pk_bf16(x0 * R0, x1 * R1); pw[s][2 * half + (i >> 1)][(i & 1) * 2 + 1] = pg8::cvt_pk_bf16(x2 * R2, x3 * R3); }
                carry[s] = cin * __builtin_amdgcn_rcpf(Tq);
                did[s][half] = true;
                if (!__any(carry[s] != 0.0f)) alive[s] = false;
            }
        }
        if (SB_ABL == 3) {} else if (j > jlo) asm volatile("s_waitcnt vmcnt(8)" ::: "memory"); else asm volatile("s_waitcnt vmcnt(0)" ::: "memory");
        __builtin_amdgcn_sched_barrier(0);
        bf16x8 vf[8];
#pragma unroll
        for (int d0 = 0; d0 < 2; ++d0)
#pragma unroll
            for (int ks = 0; ks < 4; ++ks) {
                const s16x4 lo = __builtin_bit_cast(s16x4, __builtin_amdgcn_ds_read_tr16_b64_v4i16((LAS s16x4*)(vb + d0 * 4096 + ks * 1024)));
                const s16x4 hh = __builtin_bit_cast(s16x4, __builtin_amdgcn_ds_read_tr16_b64_v4i16((LAS s16x4*)(vb + d0 * 4096 + ks * 1024 + 512)));
                vf[d0 * 4 + ks] = (bf16x8){lo[0], lo[1], lo[2], lo[3], hh[0], hh[1], hh[2], hh[3]}; }
        asm volatile("s_waitcnt lgkmcnt(0)" ::: "memory"); __builtin_amdgcn_sched_barrier(0);
        const bool more = (SB_ABL != 0) ? (j > jlo) : ((j > 0) && (alive[0] || alive[1]));
        if (more && SB_ABL != 3) SB_LOAD_V(j - 1);
#pragma unroll
        for (int s = 0; s < 2; ++s)
#pragma unroll
            for (int half = 0; half < 2; ++half) { if (!did[s][half]) continue;
#pragma unroll
                for (int d0 = 0; d0 < 2; ++d0)
#pragma unroll
                    for (int kk = 0; kk < 2; ++kk) { const int ks = 2 * half + kk; const bf16x8 pa = __builtin_bit_cast(bf16x8, (u32x4){pw[s][ks][0], pw[s][ks][1], pw[s][ks][2], pw[s][ks][3]});
                        o[s][d0] = __builtin_amdgcn_mfma_f32_32x32x16_bf16(pa, vf[d0 * 4 + ks], o[s][d0], 0, 0, 0); } }
        if (!more) break;
    }
    asm volatile("s_waitcnt vmcnt(0)" ::: "memory");
    LAS bf16_t* stg = (LAS bf16_t*)wl; const int l2 = pg8::fresh_lane();
#pragma unroll
    for (int s = 0; s < 2; ++s) {
#pragma unroll
        for (int r = 0; r < 16; ++r) { const int orow = crow(r, l2 >> 5);
#pragma unroll
            for (int d0 = 0; d0 < 2; ++d0) stg[orow * 64 + d0 * 32 + (l2 & 31)] = (bf16_t)f2bf(o[s][d0][r]); }
        LDS_WAIT();
        bf16_t* Ow = MIXED + (rowbase + q0 + s * 32) * D + h * HD;
#pragma unroll
        for (int i = 0; i < 4; ++i) { const int row = i * 8 + (l2 >> 3), ch = l2 & 7; const u32x4 v = *(const LAS u32x4*)(stg + row * 64 + ch * 8);
            pg8::st16<2>(Ow + (size_t)row * D + ch * 8, v); float q = 0.f;
#pragma unroll
            for (int k = 0; k < 4; ++k) { const float a = __builtin_bit_cast(float, v[k] << 16), c = __builtin_bit_cast(float, v[k] & 0xffff0000u); q += a * a + c * c; }
            q += pg8::swz_xor<1>(q); q += pg8::swz_xor<2>(q); q += pg8::swz_xor<4>(q);
            if (ch == 0) ssq_add(SSQSB + rowbase + q0 + s * 32 + row, q); }
        LDS_WAIT();
    }
#undef SB_LOAD_K
#undef SB_LOAD_V
}

__device__ __forceinline__ void memattn_unit(const bf16_t* Qt  , const char* Kg, const char* Vg, unsigned char* O8t  , LAS unsigned char* ring, int wave) {
    const int lane = pg8::fresh_lane(); const int r32 = lane & 31, hi = lane >> 5;
    const unsigned lbase = (unsigned)(uintptr_t)ring;
    const int ch = lane & 31;
#pragma unroll
    for (int j = 0; j < 16; ++j) { const int m = 2 * j + hi; const int tok = 16 * (m >> 4) + 8 * ((m >> 2) & 1) + 4 * ((m >> 3) & 1) + (m & 3);
        const unsigned voff = (unsigned)(32 * wave + tok) * (D * 2) + (unsigned)((ch ^ (m & 15)) * 16); SB_DMA(Kg, voff, lbase + (32 * wave + 2 * j) * 512); }
    bf16x8 qr[16];
#pragma unroll
    for (int ks = 0; ks < 16; ++ks) qr[ks] = *(const bf16x8*)(Qt + ((size_t)(ks * 256 + 32 * wave + r32) * 2 + hi) * 8);
    asm volatile("s_waitcnt vmcnt(0)" ::: "memory"); __syncthreads();
    unsigned fb = (unsigned)(r32 * 512 + (((r32 & 15) ^ hi) * 16));
    f32x16 p[8];
    bf16x8 kf[2][4];
#pragma unroll
    for (int q = 0; q < 4; ++q) kf[0][q] = *(const LAS bf16x8*)(ring + (fb ^ (32u * q)));
#pragma unroll
    for (int kb = 0; kb < 8; ++kb) {
#pragma unroll
        for (int r = 0; r < 16; ++r) p[kb][r] = 0.f;
#pragma unroll
        for (int k4 = 0; k4 < 4; ++k4) { const int g = kb * 4 + k4;
            if (g + 1 < 32) { const int kb2 = (g + 1) >> 2, k42 = (g + 1) & 3;
#pragma unroll
                for (int q = 0; q < 4; ++q) kf[(g + 1) & 1][q] = *(const LAS bf16x8*)(ring + (fb ^ (32u * (4 * k42 + q))) + kb2 * 16384); }
#pragma unroll
            for (int q = 0; q < 4; ++q) p[kb] = __builtin_amdgcn_mfma_f32_32x32x16_bf16(kf[g & 1][q], qr[4 * k4 + q], p[kb], 0, 0, 0);
            __builtin_amdgcn_sched_barrier(0); } }
    float mx = -INFINITY;
#pragma unroll
    for (int kb = 0; kb < 8; ++kb)
#pragma unroll
        for (int r = 0; r < 16; ++r) mx = fmaxf(mx, p[kb][r]);
    mx = pg8::half_max(mx); __builtin_amdgcn_sched_barrier(0);
    asm volatile("s_waitcnt lgkmcnt(0)" ::: "memory"); __syncthreads();
#pragma unroll
    for (int j = 0; j < 16; ++j) { const int m = 2 * j + hi; const unsigned voff = (unsigned)(32 * wave + m) * (NMEM * 2) + (unsigned)((ch ^ (m & 15)) * 16); SB_DMA(Vg, voff, lbase + (32 * wave + 2 * j) * 512); }
    float sum = 0.f; unsigned pw[16][4];
#pragma unroll
    for (int kb = 0; kb < 8; ++kb) {
#pragma unroll
        for (int r = 0; r < 16; r += 2) { const float e0 = __builtin_amdgcn_exp2f(p[kb][r] - mx), e1 = __builtin_amdgcn_exp2f(p[kb][r + 1] - mx); sum += e0 + e1; pw[2 * kb + (r >> 3)][(r & 7) >> 1] = pg8::cvt_pk_bf16(e0, e1); }
        __builtin_amdgcn_sched_barrier(0); }
    sum = pg8::half_sum(sum);
    asm volatile("s_waitcnt vmcnt(0)" ::: "memory"); __syncthreads();
    const float inv = 1.0f / sum;
    asm volatile("" : "+v"(fb));
    unsigned ow[8][4];
    bf16x8 vf[2][8];
#pragma unroll
    for (int q = 0; q < 8; ++q) vf[0][q] = *(const LAS bf16x8*)(ring + (fb ^ (32u * q)));
#pragma unroll
    for (int db = 0; db < 8; ++db) { f32x16 o;
#pragma unroll
        for (int r = 0; r < 16; ++r) o[r] = 0.f;
#pragma unroll
        for (int s8 = 0; s8 < 2; ++s8) { const int g = db * 2 + s8;
            if (g + 1 < 16) { const int db2 = (g + 1) >> 1, s82 = (g + 1) & 1;
#pragma unroll
                for (int q = 0; q < 8; ++q) vf[(g + 1) & 1][q] = *(const LAS bf16x8*)(ring + (fb ^ (32u * (8 * s82 + q))) + db2 * 16384); }
#pragma unroll
            for (int q = 0; q < 8; ++q) { const int s_ = 8 * s8 + q; const bf16x8 pb = __builtin_bit_cast(bf16x8, (u32x4){pw[s_][0], pw[s_][1], pw[s_][2], pw[s_][3]}); o = __builtin_amdgcn_mfma_f32_32x32x16_bf16(vf[g & 1][q], pb, o, 0, 0, 0); }
            __builtin_amdgcn_sched_barrier(0); }
#pragma unroll
        for (int a = 0; a < 4; ++a) { int w = __builtin_amdgcn_cvt_pk_fp8_f32(o[4 * a] * inv, o[4 * a + 1] * inv, 0, false); w = __builtin_amdgcn_cvt_pk_fp8_f32(o[4 * a + 2] * inv, o[4 * a + 3] * inv, w, true); ow[db][a] = (unsigned)w; } }
    asm volatile("s_waitcnt lgkmcnt(0)" ::: "memory"); __syncthreads();
    LAS unsigned char* stg = ring + wave * 16384;
#pragma unroll
    for (int db = 0; db < 8; ++db)
#pragma unroll
        for (int a = 0; a < 4; ++a) *(LAS unsigned*)(stg + r32 * 272 + 32 * db + 8 * a + 4 * hi) = ow[db][a];
    asm volatile("s_waitcnt lgkmcnt(0)" ::: "memory");
    const int l2 = pg8::fresh_lane();
#pragma unroll
    for (int k = 0; k < 8; ++k) { const int idx = l2 + 64 * k, row = idx >> 4, ch = idx & 15; const u32x4 v = *(const LAS u32x4*)(stg + row * 272 + ch * 16);
        *(u32x4*)(O8t + (size_t)(32 * wave + row) * D + ch * 16) = v; }
    asm volatile("s_waitcnt lgkmcnt(0)" ::: "memory"); __syncthreads();
}

__device__ __forceinline__ f32x4 bf_lo(u32x4 v) { return (f32x4){__builtin_bit_cast(float, v.x << 16), __builtin_bit_cast(float, v.y << 16), __builtin_bit_cast(float, v.z << 16), __builtin_bit_cast(float, v.w << 16)}; }
__device__ __forceinline__ f32x4 bf_hi(u32x4 v) { return (f32x4){__builtin_bit_cast(float, v.x & 0xffff0000u), __builtin_bit_cast(float, v.y & 0xffff0000u), __builtin_bit_cast(float, v.z & 0xffff0000u), __builtin_bit_cast(float, v.w & 0xffff0000u)}; }
__device__ __forceinline__ void pool_item(int item, const bf16_t* QKVU, bf16_t* MIXED, int lane) {
    const int t0 = item * 8, tpos0 = t0 & (S - 1); const int g = lane >> 4, win = 2 << g;
    const bf16_t* zp = QKVU + (size_t)(t0 - 15) * INP + 3 * SBW + lane * 8;
    u32x4 v[23];
#pragma unroll
    for (int r = 0; r < 23; ++r) { v[r] = (u32x4){0u, 0u, 0u, 0u}; if (tpos0 - 15 + r >= 0) v[r] = *(const u32x4*)(zp + (size_t)r * INP); }
    f32x4 slo = (f32x4){0.f, 0.f, 0.f, 0.f}, shi = slo;
#pragma unroll
    for (int j = 0; j < 16; ++j) { const float mk = (j < win) ? 1.0f : 0.0f; slo += bf_lo(v[15 - j]) * mk; shi += bf_hi(v[15 - j]) * mk; }
    bf16_t* op = MIXED + (size_t)t0 * D + SBW + lane * 8;
#pragma unroll
    for (int i = 0; i < 8; ++i) {
        if (i > 0) { const u32x4 old = (g == 0) ? v[i + 13] : (g == 1) ? v[i + 11] : (g == 2) ? v[i + 7] : v[i - 1];
            slo += bf_lo(v[15 + i]) - bf_lo(old); shi += bf_hi(v[15 + i]) - bf_hi(old); }
        const int tp1 = tpos0 + i + 1; const float inv = 1.0f / (float)(tp1 < win ? tp1 : win);
        const f32x4 olo = slo * inv - bf_lo(v[15 + i]), ohi = shi * inv - bf_hi(v[15 + i]);
        float q = (olo[0] * olo[0] + olo[1] * olo[1]) + (olo[2] * olo[2] + olo[3] * olo[3]) + (ohi[0] * ohi[0] + ohi[1] * ohi[1]) + (ohi[2] * ohi[2] + ohi[3] * ohi[3]);
        const float rs = 1.0f / sqrtf(pg8::wsum(q) * (1.0f / PW) + EPS);
        u32x4 w;
#pragma unroll
        for (int k = 0; k < 4; ++k) w[k] = pg8::cvt_pk_bf16(olo[k] * rs, ohi[k] * rs);
        pg8::st16<3>(op + (size_t)i * D, w);
    }
}
constexpr int P2_DK = 3;
__device__ __forceinline__ void p2_mix(const Args& a, LAS unsigned char* lds, int bx, int G, int wid, int lane, ssq_t* SSQSB, int which = 3, int pstop = 9, bf16_t* pool_dst = nullptr, volatile LAS unsigned* stp = nullptr) {
    unsigned char* ws = a.ws; const bf16_t* QKVU = (const bf16_t*)(ws + WS_QKVU); bf16_t* MIXED = (bf16_t*)(ws + WS_MIXED);
    constexpr int NA = B * NH * (S / 512);
    if (which == 1 && G == 256) {
        unsigned* ctr = (unsigned*)(ws + 1920 * 1024) + (bx & 7) * 32;
        int idx = (bx >> 3) * NWAVES + wid;
        while (idx < NH * (S / 64)) {
            sb_item(bx & 7, idx >> 6, 63 - (idx & 63), QKVU, MIXED, SSQSB, lds + RING_OFF + wid * 16384, lane);
            unsigned nx = 0; if (pg8::fresh_lane() == 0) nx = __hip_atomic_fetch_add(ctr, 1u, __ATOMIC_RELAXED, __HIP_MEMORY_SCOPE_AGENT);
            idx = NWAVES * 32 + (int)__builtin_amdgcn_readfirstlane(nx);
        }
    }
    else if (which & 1) for (int i = 0; i * G + bx < NA; ++i) { const int w = pg8::xcd_remap(i * G + bx, NA); const int bh = w >> 3, qb = w & 7;
        sb_item(bh >> 3, bh & 7, qb * 8 + wid, QKVU, MIXED, SSQSB, lds + RING_OFF + wid * 16384, lane);
        if (P2_DEFER && which == 1) for (int j = i * P2_DK; j < (i + 1) * P2_DK; ++j) { const int it = j * G * NWAVES + bx * NWAVES + wid; if (it < P2_DEFER) p2_deferred_item(a, lds + RING_OFF + wid * 16384, it, pg8::fresh_lane()); } }
    if (P2_DEFER && which == 1 && G != 256) for (int j = ((NA + G - 1 - bx) / G) * P2_DK; j * G * NWAVES + bx * NWAVES + wid < P2_DEFER; ++j) p2_deferred_item(a, lds + RING_OFF + wid * 16384, j * G * NWAVES + bx * NWAVES + wid, pg8::fresh_lane());
    if (which == 4 && G == 256 && P2_DEFER) {
        unsigned* cctr = (unsigned*)(ws + 1920 * 1024) + (8 + (bx & 7)) * 32;
        constexpr int PER_X = P2_DEFER / 8; static_assert(P2_DEFER % 32 == 0, "P2_DEFER: 8 XCDs x chunks of 4");
        for (;;) { unsigned nx = 0; if (pg8::fresh_lane() == 0) nx = __hip_atomic_fetch_add(cctr, 1u, __ATOMIC_RELAXED, __HIP_MEMORY_SCOPE_AGENT);
            const int c4 = (int)__builtin_amdgcn_readfirstlane(nx) * 4; if (c4 >= PER_X) break;
            for (int q = 0; q < 4; ++q) p2_deferred_item(a, lds + RING_OFF + wid * 16384, (bx & 7) * PER_X + c4 + q, pg8::fresh_lane()); } }
    if (which & 2) { if (G == 256) { for (int k = 0; k < 2; ++k) pool_item((bx & 7) * (S / 8) + (bx >> 3) * NWAVES + wid + 256 * k, QKVU, pool_dst ? pool_dst : MIXED, pg8::fresh_lane()); }
        else for (int it = bx * NWAVES + wid; it < NTOK / 8; it += G * NWAVES) pool_item(it, QKVU, pool_dst ? pool_dst : MIXED, pg8::fresh_lane()); }
}
constexpr size_t BAR_REGION_OFF = 1 * MiB, BAR_REGION_STRIDE = 16 * 1024;
__global__ void __launch_bounds__(NWAVES * 64, 2) mega(Args args) {
    const int li = args.li;
    extern __shared__ __attribute__((aligned(16))) unsigned char lds_raw[];
    LAS unsigned char* lds = (LAS unsigned char*)lds_raw;
    volatile LAS unsigned* MISC = (volatile LAS unsigned*)(lds + MISC_OFF);
    const int wave = __builtin_amdgcn_readfirstlane((int)threadIdx.x >> 6);
#define LANE_ID() ({ int l_; asm volatile("v_mbcnt_lo_u32_b32 %0, -1, 0\n\tv_mbcnt_hi_u32_b32 %0, -1, %0" : "=v"(l_)); l_; })
    const int G = gridDim.x; const int bx = blockIdx.x; const int vcu = (G % 8 == 0) ? (bx % 8) * (G / 8) + bx / 8 : bx;
    for (int u = wave * 64 + LANE_ID(); u < MISC_BYTES / 4; u += NWAVES * 64) MISC[u] = 0u;
    __syncthreads();
    unsigned char* ws = args.ws;
    XcdBarrier bar = xcd_barrier_post((unsigned*)(ws + BAR_REGION_OFF + (size_t)li * BAR_REGION_STRIDE), MISC + 8);
    if (wave == 0 && LANE_ID() == 0 && (G != 256 || xb_xcc_id() != (unsigned)(bx & 7))) (void)xb_add(&bar.bar[XB_BAD], 1u);
    bool local_ok = false;
    const int lo = args.ph_lo, hi = args.ph_hi;
    LAS unsigned char* ring = lds + RING_OFF; LAS unsigned char* epi = lds + EPI_OFF; LAS unsigned* gtab = (LAS unsigned*)(lds + GTAB_OFF);
#ifndef TIME_PHASE
#define TIME_PHASE -1
#endif
#define REP_OF(k) ((TIME_PHASE == (k)) ? 2 : 1)
#define REPE_OF(k) ((TIME_PHASE == 20 + (k)) ? 2 : 1)
#define IN(k) (lo <= (k) && (k) < hi)
#ifndef TSK
#define TSK -1
#endif
#ifndef TSCALE
#define TSCALE 1.0f
#endif
#define STAMP(i) do { if (TSK >= 0 && wave == 0) { const unsigned long long t_ = __builtin_amdgcn_s_memrealtime(); MISC[128 + 2 * (i)] = (unsigned)t_; MISC[129 + 2 * (i)] = (unsigned)(t_ >> 32); } } while (0)
#define SEAM(k) do { if (IN(k) && IN((k) + 1)) xcd_barrier(bar); STAMP((k) + 1); } while (0)
#define SEAM_L(k) do { if (IN(k) && IN((k) + 1)) xcd_barrier(bar, local_ok); STAMP((k) + 1); } while (0)

    STAMP(0);
    if (IN(0)) { p0_prologue(args, lds, vcu, G, wave, LANE_ID()); if (TIME_PHASE == 0) { xcd_barrier(bar); p0_prologue(args, lds, vcu, G, wave, LANE_ID()); } SEAM(0);
        if (IN(1)) { if (wave == 0 && LANE_ID() == 0) MISC[12] = (xb_ld(&bar.bar[XB_BAD]) == 0u) ? 1u : 0u; __syncthreads(); local_ok = __builtin_amdgcn_readfirstlane((int)MISC[12]) != 0; } }
    if (IN(1)) { SchedP1 S{G, bx, ws}; pg8::EpiBf16S E; pg8::gemm_phase<pg8::EpiBf16S, SchedP1, 0, REP_OF(1), REPE_OF(1)>(wave, ring, epi, gtab, D * 2, D * 2, D / 64, S, E);
        if (G == 256 && bx >= 64) p1_deferred_items(args, lds, bx - 64, wave, LANE_ID());
        else if (G != 256 && bx == 0) { for (int rk = 0; rk < 192; ++rk) p1_deferred_items(args, lds, rk, wave, LANE_ID()); }
        SEAM_L(1); }
    {
    const float* xin0 = args.in[0]; float* outp = args.out;
    bf16_t* S0p = (bf16_t*)(ws + WS_S0); ssq_t* SSQSBp = (ssq_t*)(ws + MK_SSQSB); ssq_t* SSQ1p = (ssq_t*)(ws + MK_SSQ1); ssq_t* SSQ2p = (ssq_t*)(ws + MK_SSQ2);
    constexpr size_t TSTEP = (size_t)256 * D * 2;
    #if !defined(PH_ONLY) || PH_ONLY == 2
    if (IN(2)) { if (TIME_PHASE == 42) { p2_mix(args, lds, bx, G, wave, LANE_ID(), (ssq_t*)(ws + 1280 * 1024), 2); xcd_barrier(bar); p2_mix(args, lds, bx, G, wave, LANE_ID(), (ssq_t*)(ws + 1280 * 1024), 2); xcd_barrier(bar); }
    if (TIME_PHASE == 2 || TIME_PHASE == 40 || TIME_PHASE == 41) { p2_mix(args, lds, bx, G, wave, LANE_ID(), (ssq_t*)(ws + 1280 * 1024), TIME_PHASE == 40 ? 1 : (TIME_PHASE == 41 ? 2 : 3)); xcd_barrier(bar); } STAMP(20); p2_mix(args, lds, bx, G, wave, LANE_ID(), (ssq_t*)(ws + MK_SSQSB), 1); STAMP(21); p2_mix(args, lds, bx, G, wave, LANE_ID(), (ssq_t*)(ws + MK_SSQSB), 2, 9, nullptr, (TSK >= 30 && bx == 0) ? MISC + 128 + 60 : nullptr); p2_mix(args, lds, bx, G, wave, LANE_ID(), (ssq_t*)(ws + MK_SSQSB), 4); STAMP(22); SEAM_L(2); STAMP(23); }
#endif

#if !defined(PH_ONLY) || PH_ONLY == 3
    if (IN(3)) { SchedReg S{G, bx, NTOK / 256, D / 256, (const char*)(ws + WS_MIXED), (const char*)(ws + WS_WOUT), TSTEP, TSTEP, nullptr, D, nullptr, nullptr};
        EpiResid<8, true, true> E{nullptr, S0p, ws + WS_X1F8, SSQ1p, SSQSBp, 1.0f}; pg8::gemm_phase<EpiResid<8, true, true>, SchedReg, 0, REP_OF(3)>    (wave, ring, epi, gtab, D * 2, D * 2, D / 64, S, E); SEAM_L(3); }
#endif
#if !defined(PH_ONLY) || PH_ONLY == 4
    if (IN(4)) { SchedReg S{G, bx, NTOK / 256, D / 256, (const char*)(ws + WS_X1F8), (const char*)(ws + WS_WQ), TSTEP / 2, TSTEP / 2, (bf16_t*)(ws + WS_QM), D, nullptr, nullptr, SSQ1p};
        EpiBf16Ssq E{1.0f / D, C2_MEM / WSCALE, (bf16_t*)(ws + WS_QM)}; pg8::gemm_phase<EpiBf16Ssq, SchedReg, 0, REP_OF(4), 1, true>(wave, ring, epi, gtab, D, D, D / 128, S, E); STAMP(5); }
#endif
#if !defined(PH_ONLY) || PH_ONLY == 5
    if (IN(5)) {
        constexpr int NU = (NTOK / 256) * MH;
        for (int i_ = 0; i_ * G + bx < NU; ++i_) { int pm, h; pg8::grouped_mn(pg8::xcd_remap(i_ * G + bx, NU), NTOK / 256, MH, pm, h); const int b = pm >> 4;
            memattn_unit((const bf16_t*)(ws + WS_QM) + (size_t)(pm * 4 + h) * 65536, (const char*)(ws + WS_KM) + ((size_t)b * NMEM * D + h * MHD) * 2, (const char*)(ws + WS_VMT) + ((size_t)b * D + h * MHD) * NMEM * 2,
                         ws + WS_Y + 64 * MiB + (size_t)pm * 256 * D + h * MHD, ring, wave); }
        STAMP(6); }
#endif
#if !defined(PH_ONLY) || PH_ONLY == 6
    if (IN(6)) {
        SEAM_L(6); }
#endif
#if !defined(PH_ONLY) || PH_ONLY == 7
    if (IN(7)) { SchedReg S{G, bx, NTOK / 256, D / 256, (const char*)(ws + WS_Y + 64 * MiB), (const char*)(ws + WS_WO), TSTEP / 2, TSTEP / 2, nullptr, D, nullptr, nullptr};
        EpiResid<-1, true, true> E{nullptr, S0p, ws + WS_X2F8, SSQ2p, nullptr, 1.0f / WSCALE}; pg8::gemm_phase<EpiResid<-1, true, true>, SchedReg, 0, REP_OF(7), 1, true>(wave, ring, epi, gtab, D, D, D / 128, S, E); if (IN(8)) p8_preload(args, lds, wave, LANE_ID()); SEAM_L(7); }
#endif
#if !defined(PH_ONLY) || PH_ONLY == 8
    if (IN(8)) { if (TIME_PHASE == 8) { p8_route<false>(args, lds, bx, G, wave, LANE_ID(), (int*)(ws + 1536 * 1024)); xcd_barrier(bar); } if (IN(7)) p8_route<true>(args, lds, vcu, G, wave, LANE_ID(), (int*)(ws + OFF_CNT)); else p8_route<false>(args, lds, vcu, G, wave, LANE_ID(), (int*)(ws + OFF_CNT)); SEAM(8);     }
#endif
#if !defined(PH_ONLY) || PH_ONLY == 9
    if (IN(9)) { moe_table(args, MISC, wave * 64 + LANE_ID()); SchedMoE<8, true> S{G, bx, ws, MISC, args.in[18]}; EpiSwiGLU E{ws + WS_ACT};
        pg8::gemm_phase<EpiSwiGLU, SchedMoE<8, true>, 1, REP_OF(9), REPE_OF(9), true>(wave, ring, epi, gtab, D, D, D / 128, S, E); SEAM(9); }
#endif
#if !defined(PH_ONLY) || PH_ONLY == 10
    if (IN(10)) { moe_table(args, MISC, wave * 64 + LANE_ID()); SchedMoE<4, false> S{G, bx, ws, MISC, args.in[20]}; EpiW2 E{ws + WS_Y};
        pg8::gemm_phase<EpiW2, SchedMoE<4, false>, 2, REP_OF(10), REPE_OF(10), true>(wave, ring, epi, gtab, DFF, DFF, DFF / 128, S, E); SEAM(10); }
#endif
#if !defined(PH_ONLY) || PH_ONLY == 11
    if (IN(11)) { if (TIME_PHASE == 11) { p11_final(args, vcu, G, wave, LANE_ID(), (float*)(ws + WS_ACT)); xcd_barrier(bar); } p11_final(args, vcu, G, wave, LANE_ID(), args.out); }
#endif
}

    if (TSK >= 100) { __syncthreads(); float* dbg = (float*)(ws + 1792 * 1024);
        if (wave == 0 && LANE_ID() == 0) { const int a_ = (TSK >= 200) ? 21 : 20; const unsigned long long t0 = ((unsigned long long)MISC[129 + 2 * a_] << 32) | MISC[128 + 2 * a_], t1 = ((unsigned long long)MISC[131 + 2 * a_] << 32) | MISC[130 + 2 * a_];
            __hip_atomic_store(dbg + bx, (float)(t1 - t0) * 0.01f, __ATOMIC_RELAXED, __HIP_MEMORY_SCOPE_AGENT); }
        xcd_barrier(bar);
        if (bx == 0 && wave == 0) { const int l_ = LANE_ID(); float mx = 0.f, mn = 1e9f; for (int q = l_; q < G; q += 64) { const float v = __hip_atomic_load(dbg + q, __ATOMIC_RELAXED, __HIP_MEMORY_SCOPE_AGENT); mx = fmaxf(mx, v); mn = fminf(mn, v); }
            for (int o_ = 1; o_ < 64; o_ <<= 1) { mx = fmaxf(mx, __shfl_xor(mx, o_)); mn = fminf(mn, __shfl_xor(mn, o_)); }
            if (l_ == 0) { asm volatile("s_waitcnt vmcnt(0)" ::: "memory"); args.out[0] = ((TSK % 100) == 0 ? mx : mn) * TSCALE; } } }
    else if (TSK >= 0) { STAMP(12); __syncthreads(); if (bx == 0 && wave == 0 && LANE_ID() == 0) { asm volatile("s_waitcnt vmcnt(0)" ::: "memory");
        const int s0_ = (TSK == 40) ? 0 : TSK, s1_ = (TSK == 40) ? 12 : TSK + 1;
        const unsigned long long t0 = ((unsigned long long)MISC[129 + 2 * s0_] << 32) | MISC[128 + 2 * s0_], t1 = ((unsigned long long)MISC[129 + 2 * s1_] << 32) | MISC[128 + 2 * s1_];
        args.out[0] = (float)(t1 - t0) * 0.01f * TSCALE; } }
    if (TIME_PHASE == 12) { for (int q = 0; q < 10; ++q) xcd_barrier(bar); }
#undef IN
#undef SEAM
}
}

extern "C" void kernel_launch(void* const* d_in, const int* in_sizes, int n_in, void* d_out, int out_size, void* d_ws, size_t ws_size, hipStream_t stream) {
    if (n_in != 22 || out_size != NTOK * D || ws_size < WS_END) { fprintf(stderr, "kernel_launch: unexpected shapes (n_in %d out %d ws %zu)\n", n_in, out_size, ws_size); return; }
    static int grid = 0;
    if (grid == 0) {
        int dev = 0, cus = 0;
        if (hipGetDevice(&dev) != hipSuccess || hipDeviceGetAttribute(&cus, hipDeviceAttributeMultiprocessorCount, dev) != hipSuccess) { grid = -1; return; }
        if (hipFuncSetAttribute((const void*)mk::mega, hipFuncAttributeMaxDynamicSharedMemorySize, mk::LDS_BYTES) != hipSuccess) { fprintf(stderr, "kernel_launch: hipFuncSetAttribute failed\n"); grid = -1; return; }
        int per_cu = 0; (void)hipOccupancyMaxActiveBlocksPerMultiprocessor(&per_cu, (const void*)mk::mega, mk::NWAVES * 64, mk::LDS_BYTES); (void)hipGetLastError();
        if (per_cu < 1) fprintf(stderr, "kernel_launch: occupancy query reports %d blocks per CU\n", per_cu);
        grid = cus;
    }
    if (grid < 0) return;
    (void)hipMemsetAsync((unsigned char*)d_ws + WS_CTL, 0, CTL_BYTES, stream);
    mk::Args a{}; for (int i = 0; i < 22; ++i) a.in[i] = (const float*)d_in[i]; a.out = (float*)d_out; a.ws = (unsigned char*)d_ws;
    a.ph_lo = 0; a.ph_hi = mk::NPHASE; a.li = 0;
    hipLaunchKernelGGL(mk::mega, dim3(grid), dim3(mk::NWAVES * 64), mk::LDS_BYTES, stream, a);
}
```
